# Optimizing an MI355X kernel written in HIP

```python
import math
import jax
import jax.numpy as jnp
from jax import lax
import numpy as np

D_MODEL = 1024
BATCH = 2
SEQ = 16384
DEPTH = 4
DEC_BATCH = 16
DEC_SEQ = 2048
PAST_LEN = 128

GRID_W = 64
D_FF = 4 * D_MODEL
EPS = 1e-6
NEG_INF = -1e30
Q_BLOCK = 128

A_HEADS = 8
A_KV_HEADS = 2
A_HEAD_DIM = 64
ROPE_THETA = 10000.0
B_WIDTH = 512
B_BLOCKS = 8
B_BLOCK_DIM = B_WIDTH // B_BLOCKS
B_CONV = 4
RG_C = 8.0
C_HEADS = 4
C_HEAD_DIM = 128
C_WIDTH = C_HEADS * C_HEAD_DIM
C_CONV = 4
C_CHUNK = 64
D_GROUPS = ((128, 1), (512, 4), (2048, 16))
D_HEADS_PER_GROUP = 4
D_HEAD_DIM = 64
D_NHEADS = len(D_GROUPS) * D_HEADS_PER_GROUP
D_WIDTH = D_NHEADS * D_HEAD_DIM
N_BUCKETS = 32
MAX_DISTANCE = 1024

A_Q = A_HEADS * A_HEAD_DIM
A_KV = A_KV_HEADS * A_HEAD_DIM
EVEN_IN = A_Q + 2 * A_KV + 2 * B_WIDTH
EVEN_OUT = A_Q + B_WIDTH
ODD_IN = 4 * C_WIDTH + 4 * C_HEADS + 3 * D_WIDTH
ODD_OUT = C_WIDTH + D_HEADS_PER_GROUP * D_HEAD_DIM
N_EVEN = (DEPTH + 1) // 2
N_ODD = DEPTH // 2

kernel_name = 'hybrid_bidir_encoder'


def _split(x, sizes):
    return jnp.split(x, np.cumsum(sizes)[:-1].tolist(), axis=-1)


def rms_norm(x, g):
    xf = x.astype(jnp.float32)
    y = xf * lax.rsqrt(jnp.mean(xf * xf, axis=-1, keepdims=True) + EPS)
    return (y * g.astype(jnp.float32)).astype(x.dtype)


def l2_norm(x):
    return x * lax.rsqrt(jnp.sum(x * x, axis=-1, keepdims=True) + EPS)


def centred_dwconv(x, w, b=None):
    W = w.shape[0]
    left = W // 2
    S = x.shape[1]
    xp = jnp.pad(x, ((0, 0), (left, W - 1 - left), (0, 0)))
    y = xp[:, 0:S] * w[0]
    for j in range(1, W):
        y = y + xp[:, j:j + S] * w[j]
    if b is not None:
        y = y + b
    return y


def axial_rope_tables(S):
    rows = S // GRID_W
    row = jnp.repeat(jnp.arange(rows, dtype=jnp.float32), GRID_W)
    col = jnp.tile(jnp.arange(GRID_W, dtype=jnp.float32), rows)
    n_freq = A_HEAD_DIM // 4
    inv = ROPE_THETA ** (-jnp.arange(n_freq, dtype=jnp.float32) / n_freq)
    ang = jnp.stack([row[:, None] * inv, col[:, None] * inv], axis=1)
    return jnp.cos(ang), jnp.sin(ang)


def apply_axial_rope(x, cos, sin):
    Bn, S, H, dh = x.shape
    xr = x.astype(jnp.float32).reshape(Bn, S, H, 2, 2, dh // 4)
    a, b = xr[..., 0, :], xr[..., 1, :]
    c = cos[None, :, None]
    s = sin[None, :, None]
    out = jnp.stack([a * c - b * s, a * s + b * c], axis=-2)
    return out.reshape(Bn, S, H, dh)


def gqa_block_attention(q, k, v):
    Bn, S, _, dh = q.shape
    G = A_HEADS // A_KV_HEADS
    nb = S // Q_BLOCK
    qb = q.reshape(Bn, nb, Q_BLOCK, A_KV_HEADS, G, dh).transpose(1, 0, 2, 3, 4, 5)
    scale = dh ** -0.5

    def block(qi):
        s = jnp.einsum('bqhgd,bkhd->bhgqk', qi, k).astype(jnp.float32) * scale
        p = jax.nn.softmax(s, axis=-1)
        return jnp.einsum('bhgqk,bkhd->bqhgd', p.astype(v.dtype), v)

    o = lax.map(block, qb)
    return o.transpose(1, 0, 2, 3, 4, 5).reshape(Bn, S, A_HEADS * dh)


def _lin_combine(left, right):
    a1, b1 = left
    a2, b2 = right
    return a1 * a2, a2 * b1 + b2


def rglru_scan(x, wr, br, wi, bi, lam):
    Bn, S, W = x.shape
    xb = x.reshape(Bn, S, B_BLOCKS, B_BLOCK_DIM)
    r = jax.nn.sigmoid(jnp.einsum('bsnd,nde->bsne', xb, wr.astype(jnp.float32)).reshape(Bn, S, W) + br.astype(jnp.float32))
    i = jax.nn.sigmoid(jnp.einsum('bsnd,nde->bsne', xb, wi.astype(jnp.float32)).reshape(Bn, S, W) + bi.astype(jnp.float32))
    log_a = -RG_C * r * jax.nn.softplus(-lam.astype(jnp.float32))
    a = jnp.exp(log_a)
    u = jnp.sqrt(-jnp.expm1(2.0 * log_a)) * (i * x)
    _, h = lax.associative_scan(_lin_combine, (a, u), axis=1)
    return h


def _even_mixer(h, w_in, w_out, q_gain, k_gain, conv_w, conv_b, wr, br, wi, bi, lam):
    Bn, S, _ = h.shape
    dt = h.dtype
    proj = h @ w_in
    q, k, v, xr, gr = _split(proj, (A_Q, A_KV, A_KV, B_WIDTH, B_WIDTH))
    cos, sin = axial_rope_tables(S)
    q = rms_norm(q.reshape(Bn, S, A_HEADS, A_HEAD_DIM), q_gain)
    k = rms_norm(k.reshape(Bn, S, A_KV_HEADS, A_HEAD_DIM), k_gain)
    q = apply_axial_rope(q, cos, sin).astype(dt)
    k = apply_axial_rope(k, cos, sin).astype(dt)
    v = v.reshape(Bn, S, A_KV_HEADS, A_HEAD_DIM)
    y_a = gqa_block_attention(q, k, v)
    xc = centred_dwconv(xr.astype(jnp.float32), conv_w.astype(jnp.float32), conv_b.astype(jnp.float32))
    y_f = rglru_scan(xc, wr[0], br[0], wi[0], bi[0], lam[0])
    y_r = jnp.flip(rglru_scan(jnp.flip(xc, 1), wr[1], br[1], wi[1], bi[1], lam[1]), 1)
    y_b = (y_f + y_r) * jax.nn.gelu(gr.astype(jnp.float32))
    return jnp.concatenate([y_a, y_b.astype(dt)], axis=-1) @ w_out


def gated_delta_chunked(q, k, v, g, beta):
    Bn, S, H, dk = q.shape
    dv = v.shape[-1]
    C = C_CHUNK
    n = S // C

    def chunks(t):
        t = t.reshape(Bn, n, C, H, *t.shape[3:])
        return jnp.moveaxis(t, (1, 3), (0, 2))

    qc = chunks(q * dk ** -0.5)
    kc = chunks(k)
    vc = chunks(v)
    gc = jnp.cumsum(chunks(g), axis=-1)
    bc = chunks(beta)
    tril = jnp.tril(jnp.ones((C, C), dtype=bool))
    strict = jnp.tril(jnp.ones((C, C), dtype=bool), -1)
    decay = jnp.exp(jnp.where(tril, gc[..., :, None] - gc[..., None, :], -jnp.inf))
    kb = kc * bc[..., None]
    L = jnp.where(strict, jnp.einsum('nbhid,nbhjd->nbhij', kb, kc) * decay, 0.0)
    eye = jnp.eye(C, dtype=L.dtype)
    rhs = jnp.concatenate([vc * bc[..., None], kb * jnp.exp(gc)[..., None]], axis=-1)
    sol = lax.linalg.triangular_solve(L + eye, rhs, left_side=True, lower=True, unit_diagonal=True)
    u = sol[..., :dv]
    w = sol[..., dv:]
    intra = jnp.where(tril, jnp.einsum('nbhid,nbhjd->nbhij', qc, kc) * decay, 0.0)

    def step(state, xs):
        q_i, k_i, u_i, w_i, g_i, a_i = xs
        v_new = u_i - jnp.einsum('bhcd,bhde->bhce', w_i, state)
        o = jnp.einsum('bhcd,bhde->bhce', q_i * jnp.exp(g_i)[..., None], state) + jnp.einsum('bhij,bhje->bhie', a_i, v_new)
        g_last = g_i[..., -1:]
        state = state * jnp.exp(g_last)[..., None] + jnp.einsum('bhcd,bhce->bhde', k_i * jnp.exp(g_last - g_i)[..., None], v_new)
        return state, o

    state0 = jnp.zeros((Bn, H, dk, dv), q.dtype)
    _, o = lax.scan(step, state0, (qc, kc, u, w, gc, intra))
    return jnp.moveaxis(o, (0, 2), (1, 3)).reshape(Bn, S, H, dv)


def t5_bucket(rel):
    nb = N_BUCKETS // 2
    max_exact = nb // 2
    n = np.abs(rel)
    large = max_exact + (np.log(np.maximum(n, 1) / max_exact) / math.log(MAX_DISTANCE / max_exact) * (nb - max_exact)).astype(np.int64)
    large = np.minimum(large, nb - 1)
    return (np.where(rel > 0, nb, 0) + np.where(n < max_exact, n, large)).astype(np.int32)


def banded_dilated_attention(q, k, v, bias, dil, steps):
    Bn, S, H, dh = q.shape
    M = S // dil
    blk = steps
    nb = -(-M // blk)
    Mp = nb * blk
    Z = Bn * dil

    def to_sub(t):
        return t.reshape(Bn, M, dil, H, dh).transpose(0, 2, 1, 3, 4).reshape(Z, M, H, dh)

    def key_windows(t):
        tp = jnp.pad(to_sub(t), ((0, 0), (blk, Mp - M + blk), (0, 0), (0, 0))).reshape(Z, nb + 2, blk, H, dh)
        return jnp.concatenate([tp[:, :-2], tp[:, 1:-1], tp[:, 2:]], axis=2)

    qs = jnp.pad(to_sub(q), ((0, 0), (0, Mp - M), (0, 0), (0, 0))).reshape(Z, nb, blk, H, dh)
    kw = key_windows(k)
    vw = key_windows(v)
    delta = jnp.arange(3 * blk)[None, :] - blk - jnp.arange(blk)[:, None]
    in_band = jnp.abs(delta) <= steps
    kpos = jnp.arange(nb)[:, None] * blk + jnp.arange(3 * blk)[None, :] - blk
    valid = (kpos >= 0) & (kpos < M)
    mask = in_band[None] & valid[:, None, :]
    bias_m = bias.astype(jnp.float32)[:, jnp.clip(delta + steps, 0, 2 * steps)]
    s = jnp.einsum('znqhd,znkhd->znhqk', qs, kw).astype(jnp.float32) * dh ** -0.5 + bias_m[None, None]
    s = jnp.where(mask[None, :, None], s, NEG_INF)
    lse = jax.nn.logsumexp(s, axis=-1)
    p = jnp.exp(s - lse[..., None])
    o = jnp.einsum('znhqk,znkhd->znqhd', p.astype(v.dtype), vw).reshape(Z, Mp, H, dh)[:, :M]
    lse = lse.transpose(0, 1, 3, 2).reshape(Z, Mp, H)[:, :M]

    def from_sub(t):
        return t.reshape(Bn, dil, M, *t.shape[2:]).swapaxes(1, 2).reshape(Bn, S, *t.shape[2:])

    return from_sub(o), from_sub(lse)


def dilated_mixture_attention(q, k, v, rel_bias):
    Bn, S, _ = q.shape
    Hg = D_HEADS_PER_GROUP
    shp = (Bn, S, len(D_GROUPS), Hg, D_HEAD_DIM)
    q = q.reshape(shp)
    k = k.reshape(shp)
    v = v.reshape(shp)
    outs = []
    lses = []
    for gi, (window, dil) in enumerate(D_GROUPS):
        steps = window // (2 * dil)
        buckets = t5_bucket(np.arange(-steps, steps + 1) * dil)
        bias = rel_bias[jnp.asarray(buckets)][:, gi * Hg:(gi + 1) * Hg].T
        o, lse = banded_dilated_attention(q[:, :, gi], k[:, :, gi], v[:, :, gi], bias, dil, steps)
        outs.append(o.astype(jnp.float32))
        lses.append(lse)
    wts = jax.nn.softmax(jnp.stack(lses, axis=0), axis=0)
    o = jnp.sum(wts[..., None] * jnp.stack(outs, axis=0), axis=0)
    return o.reshape(Bn, S, Hg * D_HEAD_DIM)


def _odd_mixer(h, w_in, w_out, conv_w, a_log, dt_bias, o_gain, rel_bias):
    Bn, S, _ = h.shape
    dt = h.dtype
    proj = h @ w_in
    qkv, z, beta_l, alpha_l, dq, dk, dv = _split(proj, (3 * C_WIDTH, C_WIDTH, 2 * C_HEADS, 2 * C_HEADS, D_WIDTH, D_WIDTH, D_WIDTH))
    qkv = jax.nn.silu(centred_dwconv(qkv.astype(jnp.float32), conv_w.astype(jnp.float32)))
    cq, ck, cv = [t.reshape(Bn, S, C_HEADS, C_HEAD_DIM) for t in jnp.split(qkv, 3, axis=-1)]
    cq = l2_norm(cq)
    ck = l2_norm(ck)
    beta = jax.nn.sigmoid(beta_l.astype(jnp.float32)).reshape(Bn, S, 2, C_HEADS)
    g = -jnp.exp(a_log.astype(jnp.float32)) * jax.nn.softplus(alpha_l.astype(jnp.float32).reshape(Bn, S, 2, C_HEADS) + dt_bias.astype(jnp.float32))
    o_f = gated_delta_chunked(cq, ck, cv, g[:, :, 0], beta[:, :, 0])
    rev = lambda t: jnp.flip(t, 1)
    o_r = rev(gated_delta_chunked(rev(cq), rev(ck), rev(cv), rev(g[:, :, 1]), rev(beta[:, :, 1])))
    o_c = rms_norm(o_f + o_r, o_gain) * jax.nn.silu(z.astype(jnp.float32).reshape(Bn, S, C_HEADS, C_HEAD_DIM))
    y_c = o_c.reshape(Bn, S, C_WIDTH).astype(dt)
    y_d = dilated_mixture_attention(dq, dk, dv, rel_bias).astype(dt)
    return jnp.concatenate([y_c, y_d], axis=-1) @ w_out


def _sq_relu_mlp(h, w1, w2):
    return jnp.square(jax.nn.relu(h @ w1)) @ w2


def _trunk(x, p):
    for layer in range(DEPTH):
        h = rms_norm(x, p['norm_mix'][layer])
        j = layer // 2
        if layer % 2 == 0:
            y = _even_mixer(h, p['w_in_e'][j], p['w_out_e'][j], p['a_qnorm'][j], p['a_knorm'][j],
                            p['b_conv_w'][j], p['b_conv_b'][j], p['b_wr'][j], p['b_br'][j],
                            p['b_wi'][j], p['b_bi'][j], p['b_lambda'][j])
        else:
            y = _odd_mixer(h, p['w_in_o'][j], p['w_out_o'][j], p['c_conv_w'][j], p['c_a_log'][j],
                           p['c_dt_bias'][j], p['c_norm'][j], p['rel_bias'])
        x = x + y.astype(x.dtype)
        h = rms_norm(x, p['norm_ff'][layer])
        x = x + _sq_relu_mlp(h, p['w_ff1'][layer], p['w_ff2'][layer]).astype(x.dtype)
    return rms_norm(x, p['norm_final'])


def setup_inputs(seed: int = 0) -> dict:
    key = jax.random.key(seed)
    ks = jax.random.split(key, 25)
    f32 = jnp.float32

    def nrm(k, shape, scale):
        return jax.random.normal(k, shape, f32) * scale

    def gain(k, shape):
        return 1.0 + 0.02 * jax.random.normal(k, shape, f32)

    x_prompt = nrm(ks[0], (BATCH, SEQ, D_MODEL), 1.0)
    x_sample = nrm(ks[1], (DEC_BATCH, DEC_SEQ, D_MODEL), 1.0)
    rel_bias = nrm(ks[2], (N_BUCKETS, D_NHEADS), 0.5)
    norm_mix = gain(ks[3], (DEPTH, D_MODEL))
    norm_ff = gain(ks[4], (DEPTH, D_MODEL))
    norm_final = gain(ks[5], (D_MODEL,))
    w_ff1 = nrm(ks[6], (DEPTH, D_MODEL, D_FF), D_MODEL ** -0.5)
    w_ff2 = nrm(ks[7], (DEPTH, D_FF, D_MODEL), D_FF ** -0.5)
    w_in_e = nrm(ks[8], (N_EVEN, D_MODEL, EVEN_IN), D_MODEL ** -0.5)
    w_out_e = nrm(ks[9], (N_EVEN, EVEN_OUT, D_MODEL), EVEN_OUT ** -0.5)
    a_qnorm = gain(ks[10], (N_EVEN, A_HEAD_DIM))
    a_knorm = gain(ks[11], (N_EVEN, A_HEAD_DIM))
    b_conv_w = nrm(ks[12], (N_EVEN, B_CONV, B_WIDTH), B_CONV ** -0.5)
    b_conv_b = nrm(ks[13], (N_EVEN, B_WIDTH), 0.02)
    b_wr = nrm(ks[14], (N_EVEN, 2, B_BLOCKS, B_BLOCK_DIM, B_BLOCK_DIM), B_BLOCK_DIM ** -0.5)
    b_br = nrm(ks[15], (N_EVEN, 2, B_WIDTH), 0.1)
    b_wi = nrm(ks[16], (N_EVEN, 2, B_BLOCKS, B_BLOCK_DIM, B_BLOCK_DIM), B_BLOCK_DIM ** -0.5)
    b_bi = nrm(ks[17], (N_EVEN, 2, B_WIDTH), 0.1)
    a0 = jax.random.uniform(ks[18], (N_EVEN, 2, B_WIDTH), f32, 0.9, 0.999)
    s0 = a0 ** (1.0 / RG_C)
    b_lambda = jnp.log(s0) - jnp.log1p(-s0)
    w_in_o = nrm(ks[19], (N_ODD, D_MODEL, ODD_IN), D_MODEL ** -0.5)
    w_out_o = nrm(ks[20], (N_ODD, ODD_OUT, D_MODEL), ODD_OUT ** -0.5)
    c_conv_w = nrm(ks[21], (N_ODD, C_CONV, 3 * C_WIDTH), C_CONV ** -0.5)
    c_a_log = jnp.log(jax.random.uniform(ks[22], (N_ODD, 2, C_HEADS), f32, 1.0, 16.0))
    dtv = jnp.exp(jax.random.uniform(ks[23], (N_ODD, 2, C_HEADS), f32, math.log(1e-3), math.log(1e-1)))
    c_dt_bias = dtv + jnp.log(-jnp.expm1(-dtv))
    c_norm = gain(ks[24], (N_ODD, C_HEAD_DIM))
    return {'x_prompt': x_prompt, 'x_sample': x_sample, 'rel_bias': rel_bias,
            'norm_mix': norm_mix, 'norm_ff': norm_ff, 'norm_final': norm_final,
            'w_ff1': w_ff1, 'w_ff2': w_ff2,
            'w_in_e': w_in_e, 'w_out_e': w_out_e, 'a_qnorm': a_qnorm, 'a_knorm': a_knorm,
            'b_conv_w': b_conv_w, 'b_conv_b': b_conv_b, 'b_wr': b_wr, 'b_br': b_br,
            'b_wi': b_wi, 'b_bi': b_bi, 'b_lambda': b_lambda,
            'w_in_o': w_in_o, 'w_out_o': w_out_o, 'c_conv_w': c_conv_w, 'c_a_log': c_a_log,
            'c_dt_bias': c_dt_bias, 'c_norm': c_norm}


def reference(x_prompt, x_sample, rel_bias, norm_mix, norm_ff, norm_final, w_ff1, w_ff2,
              w_in_e, w_out_e, a_qnorm, a_knorm, b_conv_w, b_conv_b, b_wr, b_br, b_wi, b_bi, b_lambda,
              w_in_o, w_out_o, c_conv_w, c_a_log, c_dt_bias, c_norm):
    params = dict(rel_bias=rel_bias, norm_mix=norm_mix, norm_ff=norm_ff, norm_final=norm_final,
                  w_ff1=w_ff1, w_ff2=w_ff2, w_in_e=w_in_e, w_out_e=w_out_e,
                  a_qnorm=a_qnorm, a_knorm=a_knorm, b_conv_w=b_conv_w, b_conv_b=b_conv_b,
                  b_wr=b_wr, b_br=b_br, b_wi=b_wi, b_bi=b_bi, b_lambda=b_lambda,
                  w_in_o=w_in_o, w_out_o=w_out_o, c_conv_w=c_conv_w, c_a_log=c_a_log,
                  c_dt_bias=c_dt_bias, c_norm=c_norm)
    y_prompt = _trunk(x_prompt, params)
    y_sample = _trunk(x_sample, params)
    return (y_prompt, y_sample)
```

```cpp
#include <hip/hip_runtime.h>
#include <hip/hip_cooperative_groups.h>
#include <hip/hip_bf16.h>
#include <cstdio>
#include <cstdint>
#include <cmath>
namespace cg = cooperative_groups;
namespace pg8 {
#define PG8_LAS __attribute__((address_space(3)))
typedef unsigned short bf16_t;
typedef short bf16x8 __attribute__((ext_vector_type(8)));
typedef float f32x4 __attribute__((ext_vector_type(4)));
typedef unsigned u32x4 __attribute__((ext_vector_type(4)));
constexpr int BM = 256, BK = 64, HALF = 128, HTB = HALF * BK * 2  , STAGE_BYTES = 8 * HTB, NXCD = 8, WGM = 8;

__host__ __device__ __forceinline__ int lds_byte(int r, int c) { const int st = (r >> 4) * 2 + (c >> 5), rr = r & 15, cc = c & 31, ob = rr * 64 + cc * 2; return st * 1024 + (ob ^ (((ob >> 9) & 1) << 5)); }
__host__ __device__ __forceinline__ void stage_rc(int b, int& R, int& C) { const int st = b / 1024, sb = b % 1024, swz = sb ^ (((sb >> 9) & 1) << 5); R = (st >> 1) * 16 + swz / 64; C = (st & 1) * 32 + (swz % 64) / 2; }
__host__ __device__ __forceinline__ int perm32(int rho) { const int n = rho >> 4, i = rho & 15; return 8 * (i >> 2) + 4 * n + (i & 3); }

struct Unit { int pm, pn; };
struct Gemm { const bf16_t* A; const bf16_t* Bt; int M, N, K; };

struct StaticOrder {
    int nM, nN, nwg, G, c;
    __host__ __device__ void init(int M, int N, int G_, int c_) { nM = M / BM; nN = N / BM; nwg = nM * nN; G = G_; c = c_; }
    __host__ __device__ bool next(int i, Unit& u) const {
        const long L = (long)i * G + c; if (L >= nwg) return false;
        int wgid = (int)L; { const int q = nwg / NXCD, r = nwg % NXCD, xcd = wgid % NXCD, off = wgid / NXCD; wgid = (xcd < r ? xcd * (q + 1) : r * (q + 1) + (xcd - r) * q) + off; }
        const int nig = WGM * nN, gid = wgid / nig, fm = gid * WGM, gsz = (nM - fm) < WGM ? (nM - fm) : WGM;
        u.pm = fm + ((wgid % nig) % gsz); u.pn = (wgid % nig) / gsz; return true;
    }
    __device__ __forceinline__ void a_ready(const Unit&) const {}
    __device__ __forceinline__ void done(const Unit&) const {}
};

__device__ __forceinline__ unsigned cvt_pk_bf16(float lo, float hi) { unsigned r; asm volatile("v_cvt_pk_bf16_f32 %0, %1, %2" : "=v"(r) : "v"(lo), "v"(hi)); return r; }
typedef float f32x2 __attribute__((ext_vector_type(2)));
__device__ __forceinline__ f32x2 gelu_pk(f32x2 v) {
    const f32x2 av = __builtin_elementwise_abs(v), d = av * 0.2316418882f + 1.0f;
    f32x2 t; t.x = __builtin_amdgcn_rcpf(d.x); t.y = __builtin_amdgcn_rcpf(d.y);
    f32x2 q = t * 0.5307027145f + (-0.7265760135f); q = q * t + 0.7107068705f; q = q * t + (-0.142248368f); q = q * t + 0.127414796f; q = q * t;
    const f32x2 s = (v * v) * (-0.72134752044f);
    f32x2 e; e.x = __builtin_amdgcn_exp2f(s.x); e.y = __builtin_amdgcn_exp2f(s.y);
    const f32x2 m = v * (q * e), r = v - m;
    f32x2 o; o.x = v.x < 0.f ? m.x : r.x; o.y = v.y < 0.f ? m.y : r.y; return o;
}

template <int ACT  > struct EpiBf16 {
    static constexpr bool PERM = true, AFTER_DRAIN = false; static_assert(ACT == 0 || ACT == 1 || ACT == 2, "EpiBf16: ACT 0 none, 1 gelu, 2 relu^2");
    bf16_t* O; int ldc; const float* bias; int split_cols; size_t split_stride; float scale0;
    __device__ __forceinline__ void operator()(const f32x4 (&acc)[2][2][4][2], const Unit& u, int wr, int wc, int fr, int fq) const {
        const int row0 = u.pm * BM + wr * 64 + fr; int colt = u.pn * BM; bf16_t* base = O;
        float sc = 1.f; if (split_cols) { const int t = colt / split_cols; base += (size_t)t * split_stride; colt -= t * split_cols; if (t == 0) sc = scale0; }
        const int col0 = colt + wc * 32 + 8 * fq, bcol0 = u.pn * BM + wc * 32 + 8 * fq;
        f32x4 bv[2][2];
#pragma unroll
        for (int bj = 0; bj < 2; ++bj)
#pragma unroll
            for (int n = 0; n < 2; ++n) bv[bj][n] = bias ? *(const f32x4*)(bias + bcol0 + bj * HALF + 4 * n) : (f32x4){0.f, 0.f, 0.f, 0.f};
#pragma unroll
        for (int ai = 0; ai < 2; ++ai)
#pragma unroll
            for (int m = 0; m < 4; ++m) { bf16_t* rowp = base + (size_t)(row0 + ai * HALF + m * 16) * ldc + col0;
#pragma unroll
                for (int bj = 0; bj < 2; ++bj) { f32x4 v0 = acc[ai][bj][m][0] + bv[bj][0], v1 = acc[ai][bj][m][1] + bv[bj][1];
                    if (ACT == 1) { f32x2 a = gelu_pk((f32x2){v0[0], v0[1]}), b = gelu_pk((f32x2){v0[2], v0[3]}), c = gelu_pk((f32x2){v1[0], v1[1]}), d = gelu_pk((f32x2){v1[2], v1[3]});
                        v0 = (f32x4){a.x, a.y, b.x, b.y}; v1 = (f32x4){c.x, c.y, d.x, d.y}; }
                    if (ACT == 2) { _Pragma("unroll") for (int q_ = 0; q_ < 4; ++q_) { const float a0_ = v0[q_] > 0.f ? v0[q_] : 0.f, a1_ = v1[q_] > 0.f ? v1[q_] : 0.f; v0[q_] = a0_ * a0_; v1[q_] = a1_ * a1_; } }
                    v0 = v0 * sc; v1 = v1 * sc; u32x4 w; w.x = cvt_pk_bf16(v0[0], v0[1]); w.y = cvt_pk_bf16(v0[2], v0[3]); w.z = cvt_pk_bf16(v1[0], v1[1]); w.w = cvt_pk_bf16(v1[2], v1[3]);
                    *(u32x4*)(rowp + bj * HALF) = w; } }
    }
};

template <class Epi, class Sched, bool ALIGN_EPI = false, bool SP2 = false>
__device__ __forceinline__ void gemm_phase(PG8_LAS unsigned char* lds, const Gemm g, const Sched& S, const Epi& E) {
    int tid_ = threadIdx.x; asm volatile("" : "+v"(tid_)); const int tid = tid_, wid = __builtin_amdgcn_readfirstlane(tid >> 6), lane = tid & 63, wr = wid >> 2, wc = wid & 3, fr = lane & 15, fq = lane >> 4;
    const int K = g.K, nt = K / BK;
    unsigned voffA[2], voffB[2];
#pragma unroll
    for (int i = 0; i < 2; ++i) { int R, C; stage_rc(tid * 16 + i * 8192, R, C); const int Rb = Epi::PERM ? ((R & ~31) + perm32(R & 31)) : R;
        voffA[i] = (unsigned)(R * K + C) * 2u; voffB[i] = (unsigned)(Rb * K + C) * 2u; }
    const size_t kstep = (size_t)(BK * 2);
    const size_t hstep = (size_t)HALF * K * 2;
    const size_t tstep = 2 * hstep;
    const unsigned ldsw = (unsigned)wid * 1024u;
    const int aoff = lds_byte(wr * 64 + fr, fq * 8), boff = lds_byte(wc * 32 + fr, fq * 8);
#define PG8_SA(b, h) (((b) * 2 + (h)) * HTB)
#define PG8_SB(b, h) ((4 + (b) * 2 + (h)) * HTB)
#define PG8_STAGE(bufoff, gbase, voff) do { _Pragma("unroll") for (int _i = 0; _i < 2; ++_i) \
        __builtin_amdgcn_global_load_lds((const unsigned*)((const char*)(gbase) + (voff)[_i]), (PG8_LAS unsigned*)(lds + (bufoff) + ldsw + _i * 8192), 16, 0, 0); } while (0)
#define PG8_LDA(dst, b, h) do { _Pragma("unroll") for (int m = 0; m < 4; ++m) _Pragma("unroll") for (int k = 0; k < 2; ++k) dst[m][k] = *(const PG8_LAS bf16x8*)(lds + PG8_SA(b, h) + aoff + m * 2048 + k * 1024); } while (0)
#define PG8_LDB(dst, b, h) do { _Pragma("unroll") for (int n = 0; n < 2; ++n) _Pragma("unroll") for (int k = 0; k < 2; ++k) dst[n][k] = *(const PG8_LAS bf16x8*)(lds + PG8_SB(b, h) + boff + n * 2048 + k * 1024); } while (0)
#define PG8_MMA(ai, bj, At, Bt) do { __builtin_amdgcn_s_setprio(1); _Pragma("unroll") for (int m = 0; m < 4; ++m) _Pragma("unroll") for (int n = 0; n < 2; ++n) _Pragma("unroll") for (int k = 0; k < 2; ++k) \
        acc[ai][bj][m][n] = __builtin_amdgcn_mfma_f32_16x16x32_bf16(Bt[n][k], At[m][k], acc[ai][bj][m][n], 0, 0, 0); __builtin_amdgcn_s_setprio(0); } while (0)
#define PG8_WAIT_V(n) asm volatile("s_waitcnt vmcnt(" #n ")" ::: "memory")
#define PG8_WAIT_L(n) asm volatile("s_waitcnt lgkmcnt(" #n ")" ::: "memory")
#define PG8_BAR __builtin_amdgcn_s_barrier()
#define PG8_SCHED __builtin_amdgcn_sched_barrier(0)
    Unit cur, nxt; int ui = 0;
    if (!S.next(0, cur)) return;
    f32x4 acc[2][2][4][2];
#pragma unroll
    for (int a = 0; a < 2; ++a)
#pragma unroll
        for (int b = 0; b < 2; ++b)
#pragma unroll
            for (int m = 0; m < 4; ++m)
#pragma unroll
                for (int n = 0; n < 2; ++n) acc[a][b][m][n] = (f32x4){0.f, 0.f, 0.f, 0.f};
    bf16x8 At[4][2], B0[2][2], B1[2][2];
    const char* cA = (const char*)g.A + (size_t)cur.pm * tstep; const char* cB = (const char*)g.Bt + (size_t)cur.pn * tstep;
    S.a_ready(cur);
    if constexpr (SP2) {
        PG8_STAGE(PG8_SB(0, 0), cB, voffB); PG8_STAGE(PG8_SB(0, 1), cB + hstep, voffB); PG8_STAGE(PG8_SA(0, 0), cA, voffA); PG8_STAGE(PG8_SA(0, 1), cA + hstep, voffA);
        if (wr == 1) PG8_BAR;
        PG8_WAIT_V(2); PG8_BAR;
        PG8_STAGE(PG8_SB(1, 0), cB + kstep, voffB); PG8_STAGE(PG8_SA(1, 0), cA + kstep, voffA); PG8_STAGE(PG8_SB(1, 1), cB + hstep + kstep, voffB);
        PG8_WAIT_V(6); PG8_BAR;
    } else {
        PG8_STAGE(PG8_SB(0, 0), cB, voffB); PG8_STAGE(PG8_SA(0, 0), cA, voffA); PG8_STAGE(PG8_SB(0, 1), cB + hstep, voffB); PG8_STAGE(PG8_SA(0, 1), cA + hstep, voffA);
        if (wr == 1) PG8_BAR;
        PG8_WAIT_V(4); PG8_BAR;
        PG8_STAGE(PG8_SB(1, 0), cB + kstep, voffB); PG8_STAGE(PG8_SA(1, 0), cA + kstep, voffA); PG8_STAGE(PG8_SB(1, 1), cB + hstep + kstep, voffB);
        PG8_WAIT_V(6); PG8_BAR;
    }
    for (;;) {
        const bool has_next = S.next(ui + 1, nxt);
        const char* nA = has_next ? (const char*)g.A + (size_t)nxt.pm * tstep : cA; const char* nB = has_next ? (const char*)g.Bt + (size_t)nxt.pn * tstep : cB;
        for (int t = 0; t < nt; t += 2) {
            const bool last = (t == nt - 2);
            const char* a1 = cA + (size_t)(t + 1) * kstep;
            const char* a2 = last ? nA : cA + (size_t)(t + 2) * kstep; const char* b2 = last ? nB : cB + (size_t)(t + 2) * kstep;
            const char* a3 = a2 + kstep; const char* b3 = b2 + kstep;
            if (last && has_next) S.a_ready(nxt);
            if constexpr (SP2) {
            PG8_LDB(B0, 0, 0); PG8_LDB(B1, 0, 1); PG8_SCHED; PG8_LDA(At, 0, 0); PG8_STAGE(PG8_SA(1, 1), a1 + hstep, voffA);
            PG8_WAIT_V(8); PG8_WAIT_L(0); PG8_BAR; PG8_MMA(0, 0, At, B0); PG8_MMA(0, 1, At, B1); PG8_BAR; PG8_SCHED;
            PG8_LDA(At, 0, 1); PG8_STAGE(PG8_SB(0, 0), b2, voffB); PG8_STAGE(PG8_SB(0, 1), b2 + hstep, voffB); PG8_STAGE(PG8_SA(0, 0), a2, voffA);
            PG8_WAIT_V(8); PG8_WAIT_L(0); PG8_BAR; PG8_MMA(1, 0, At, B0); PG8_MMA(1, 1, At, B1); PG8_BAR; PG8_SCHED;
            PG8_LDB(B0, 1, 0); PG8_LDB(B1, 1, 1); PG8_SCHED; PG8_LDA(At, 1, 0); PG8_STAGE(PG8_SA(0, 1), a2 + hstep, voffA);
            PG8_WAIT_V(8); PG8_WAIT_L(0); PG8_BAR; PG8_MMA(0, 0, At, B0); PG8_MMA(0, 1, At, B1); PG8_BAR; PG8_SCHED;
            PG8_LDA(At, 1, 1); PG8_STAGE(PG8_SB(1, 0), b3, voffB); PG8_STAGE(PG8_SB(1, 1), b3 + hstep, voffB); PG8_STAGE(PG8_SA(1, 0), a3, voffA);
            PG8_WAIT_V(8); PG8_WAIT_L(0); PG8_BAR; PG8_MMA(1, 0, At, B0); PG8_MMA(1, 1, At, B1); PG8_BAR; PG8_SCHED;
            } else {
            PG8_LDB(B0, 0, 0); PG8_SCHED; PG8_LDA(At, 0, 0); PG8_STAGE(PG8_SA(1, 1), a1 + hstep, voffA);
            PG8_WAIT_L(8); PG8_BAR; PG8_WAIT_L(0); PG8_MMA(0, 0, At, B0); PG8_BAR; PG8_SCHED;
            PG8_LDB(B1, 0, 1); PG8_STAGE(PG8_SB(0, 0), b2, voffB);
            PG8_BAR; PG8_WAIT_L(0); PG8_MMA(0, 1, At, B1); PG8_BAR;
            PG8_LDA(At, 0, 1); PG8_STAGE(PG8_SA(0, 0), a2, voffA);
            PG8_BAR; PG8_WAIT_L(0); PG8_MMA(1, 0, At, B0); PG8_BAR; PG8_SCHED;
            PG8_STAGE(PG8_SB(0, 1), b2 + hstep, voffB);
            PG8_WAIT_V(6); PG8_BAR; PG8_MMA(1, 1, At, B1); PG8_BAR;
            PG8_LDB(B0, 1, 0); PG8_SCHED; PG8_LDA(At, 1, 0); PG8_STAGE(PG8_SA(0, 1), a2 + hstep, voffA);
            PG8_WAIT_L(8); PG8_BAR; PG8_WAIT_L(0); PG8_MMA(0, 0, At, B0); PG8_BAR; PG8_SCHED;
            PG8_LDB(B1, 1, 1); PG8_STAGE(PG8_SB(1, 0), b3, voffB);
            PG8_BAR; PG8_WAIT_L(0); PG8_MMA(0, 1, At, B1); PG8_BAR;
            PG8_LDA(At, 1, 1); PG8_STAGE(PG8_SA(1, 0), a3, voffA);
            PG8_BAR; PG8_WAIT_L(0); PG8_MMA(1, 0, At, B0); PG8_BAR; PG8_SCHED;
            PG8_STAGE(PG8_SB(1, 1), b3 + hstep, voffB);
            PG8_WAIT_V(6); PG8_BAR; PG8_MMA(1, 1, At, B1); PG8_BAR;
            }
        }
        if constexpr (ALIGN_EPI) { if (wr == 0) PG8_BAR; }
        if constexpr (!Epi::AFTER_DRAIN) { E(acc, cur, wr, wc, fr, fq); S.done(cur); }
        if (!has_next) break;
#pragma unroll
        for (int a = 0; a < 2; ++a)
#pragma unroll
            for (int b = 0; b < 2; ++b)
#pragma unroll
                for (int m = 0; m < 4; ++m)
#pragma unroll
                    for (int n = 0; n < 2; ++n) acc[a][b][m][n] = (f32x4){0.f, 0.f, 0.f, 0.f};
        cur = nxt; cA = nA; cB = nB; ++ui;
        if constexpr (ALIGN_EPI) { if (wr == 1) PG8_BAR; }
    }
    PG8_WAIT_V(0);
    if constexpr (!ALIGN_EPI) { if (wr == 0) PG8_BAR; }
    PG8_BAR;
    if constexpr (Epi::AFTER_DRAIN) { E.fused(acc, cur, wr, wc, fr, fq, lds, wid, lane); S.done(cur); }
#undef PG8_SA
#undef PG8_SB
#undef PG8_STAGE
#undef PG8_LDA
#undef PG8_LDB
#undef PG8_MMA
#undef PG8_WAIT_V
#undef PG8_WAIT_L
#undef PG8_BAR
#undef PG8_SCHED
}
}

#ifndef PG8_SP2
#define PG8_SP2 true
#endif
#ifndef PG8_ALIGN
#define PG8_ALIGN true
#endif
#include <hip/hip_bf16.h>
#include <cmath>
namespace attn_body {
using bf16=__hip_bfloat16;
using bf16x8=__attribute__((ext_vector_type(8)))short;
using s16x4=__attribute__((ext_vector_type(4)))short;
using f32x16=__attribute__((ext_vector_type(16)))float;
using u32x4=__attribute__((ext_vector_type(4)))unsigned;
constexpr int D=64;
constexpr int NW=8,QBLK=32,QB=QBLK*NW,KVBLK=64;
__device__ __forceinline__ int crow(int r,int hi){return (r&3)+8*(r>>2)+4*hi;}
#define SBAR() __builtin_amdgcn_sched_barrier(0)
__device__ __forceinline__ void cmask(f32x16&p0,f32x16&p1,int jb,int qrel,int hi){
  const float NEG=-INFINITY; int kb=64*jb+4*hi;
  #pragma unroll
  for(int r=0;r<16;++r){int kv=kb+(r&3)+8*(r>>2); if(kv>qrel)p0[r]=NEG; if(kv+32>qrel)p1[r]=NEG;}
}

constexpr int NSLOT=3, SLOTB=8192;
constexpr int LDS_K=0, LDS_V=NSLOT*SLOTB, LDS_WS=2*NSLOT*SLOTB, LDS_OST=LDS_WS+NW*64*4, LDS_BYTES=LDS_OST+NW*4096;
constexpr float C2=0.125f*1.4426950408889634f;
__device__ __forceinline__ void glds16(const void*gsrc,unsigned lds_dst){unsigned keep;
  asm volatile("s_mov_b32 %0, m0\n\ts_mov_b32 m0, %2\n\ts_nop 0\n\tglobal_load_lds_dwordx4 %1, off\n\ts_mov_b32 m0, %0":"=&s"(keep):"v"(gsrc),"s"(lds_dst):"memory");}
__device__ __forceinline__ float max3f(float a,float b,float c){float r;asm("v_max3_f32 %0, %1, %2, %3":"=v"(r):"v"(a),"v"(b),"v"(c));return r;}
__device__ __forceinline__ float max2f(float a,float b){float r;asm("v_max_f32_e32 %0, %1, %2":"=v"(r):"v"(a),"v"(b));return r;}
__device__ __forceinline__ float fadd_s(float a,float b){float r;asm("v_add_f32_e32 %0, %1, %2":"=v"(r):"v"(a),"v"(b));return r;}
__device__ __forceinline__ float fsub_s(float a,float b){float r;asm("v_sub_f32_e32 %0, %1, %2":"=v"(r):"v"(a),"v"(b));return r;}
typedef float f32x2_t __attribute__((ext_vector_type(2))); typedef __bf16 bf16x2_t __attribute__((ext_vector_type(2)));
__device__ __forceinline__ unsigned cvtpk_s(float lo,float hi){f32x2_t v={lo,hi};bf16x2_t b=__builtin_convertvector(v,bf16x2_t);return __builtin_bit_cast(unsigned,b);}
#define WAIT_BAR(N) asm volatile("s_waitcnt vmcnt(" #N ") lgkmcnt(0)\n\ts_barrier":::"memory")

__device__ __forceinline__ void qkt(f32x16&p0,f32x16&p1,const char*Kslot,const bf16x8*qr,const f32x16&negm,int r32,int hi){
  const char*kb=Kslot+hi*1024+r32*16;
  #pragma unroll
  for(int d0=0;d0<4;++d0){
    const bf16x8 b0=*reinterpret_cast<const bf16x8*>(kb+d0*2048);
    const bf16x8 b1=*reinterpret_cast<const bf16x8*>(kb+d0*2048+512);
    if(d0==0){p0=__builtin_amdgcn_mfma_f32_32x32x16_bf16(b0,qr[0],negm,0,0,0);p1=__builtin_amdgcn_mfma_f32_32x32x16_bf16(b1,qr[0],negm,0,0,0);}
    else{p0=__builtin_amdgcn_mfma_f32_32x32x16_bf16(b0,qr[d0],p0,0,0,0);p1=__builtin_amdgcn_mfma_f32_32x32x16_bf16(b1,qr[d0],p1,0,0,0);}}
}
typedef __attribute__((address_space(3))) const char* lds_cptr;
typedef short v4i16_t __attribute__((ext_vector_type(4)));
__device__ __forceinline__ void kload8(bf16x8*kf,lds_cptr kp){
  kf[0]=*(const __attribute__((address_space(3))) bf16x8*)(kp);      kf[1]=*(const __attribute__((address_space(3))) bf16x8*)(kp+512);
  kf[2]=*(const __attribute__((address_space(3))) bf16x8*)(kp+2048); kf[3]=*(const __attribute__((address_space(3))) bf16x8*)(kp+2560);
  kf[4]=*(const __attribute__((address_space(3))) bf16x8*)(kp+4096); kf[5]=*(const __attribute__((address_space(3))) bf16x8*)(kp+4608);
  kf[6]=*(const __attribute__((address_space(3))) bf16x8*)(kp+6144); kf[7]=*(const __attribute__((address_space(3))) bf16x8*)(kp+6656);
}
__device__ __forceinline__ void kload2(bf16x8*kf,lds_cptr kp,int j){ kf[2*j]=*(const __attribute__((address_space(3))) bf16x8*)(kp+j*2048); kf[2*j+1]=*(const __attribute__((address_space(3))) bf16x8*)(kp+j*2048+512); }
__device__ __forceinline__ s16x4 vtr(lds_cptr p){ return __builtin_bit_cast(s16x4,__builtin_amdgcn_ds_read_tr16_b64_v4i16((__attribute__((address_space(3))) v4i16_t*)p)); }
__device__ __forceinline__ float rowmax(const f32x16&p0,const f32x16&p1){
  float a=max3f(p0[0],p0[1],p1[0]),b=max3f(p0[2],p0[3],p1[1]);a=max3f(a,p1[2],p1[3]);
  #pragma unroll
  for(int r=4;r<16;r+=4){a=max3f(a,p0[r],p0[r+1]);b=max3f(b,p0[r+2],p0[r+3]);a=max3f(a,p1[r],p1[r+1]);b=max3f(b,p1[r+2],p1[r+3]);}
  const float m=max2f(a,b);
  auto rr=__builtin_amdgcn_permlane32_swap(__float_as_uint(m),__float_as_uint(m),false,false);
  return max2f(__uint_as_float(rr[0]),__uint_as_float(rr[1]));
}
__device__ __forceinline__ void pv(f32x16*o,int vb,bf16x8 pa0,bf16x8 pa1,bf16x8 pa2,bf16x8 pa3){
  #pragma unroll
  for(int d0=0;d0<2;++d0){s16x4 lo[4],hi[4];
    #pragma unroll
    for(int ks=0;ks<4;++ks){
      asm volatile("ds_read_b64_tr_b16 %0,%1 offset:%c2":"=&v"(lo[ks]):"v"(vb),"i"(d0*4096+ks*1024):"memory");
      asm volatile("ds_read_b64_tr_b16 %0,%1 offset:%c2":"=&v"(hi[ks]):"v"(vb),"i"(d0*4096+ks*1024+512):"memory");}
    asm volatile("s_waitcnt lgkmcnt(0)":::"memory");SBAR();
    #define PK(k) (bf16x8){lo[k][0],lo[k][1],lo[k][2],lo[k][3],hi[k][0],hi[k][1],hi[k][2],hi[k][3]}
    o[d0]=__builtin_amdgcn_mfma_f32_32x32x16_bf16(pa0,PK(0),o[d0],0,0,0);
    o[d0]=__builtin_amdgcn_mfma_f32_32x32x16_bf16(pa1,PK(1),o[d0],0,0,0);
    o[d0]=__builtin_amdgcn_mfma_f32_32x32x16_bf16(pa2,PK(2),o[d0],0,0,0);
    o[d0]=__builtin_amdgcn_mfma_f32_32x32x16_bf16(pa3,PK(3),o[d0],0,0,0);
    #undef PK
  }
}

#ifndef ATTN_STORE16
#define ATTN_STORE16(p,v) (*(u32x4*)(p)=(v))
#endif
template<int THRL> __device__ __forceinline__ void attn_unit(int qb,int SEQ,const bf16*Q,int QP,const bf16*__restrict__ K,const bf16*__restrict__ V,int KP,bf16*O,int OP,char*shm){
  int tid_=threadIdx.x; asm volatile("":"+v"(tid_)); const int tid=tid_,lane=tid&63,r32=lane&31,hi=lane>>5; const int wid=__builtin_amdgcn_readfirstlane(tid>>6);
  const int q0=qb*QB;
  const bf16*Qw=Q+(long)(q0+wid*QBLK)*QP;
  const bf16*Kh=K,*Vh=V;
  const unsigned lds0=(unsigned)(uintptr_t)shm;
  float*wsf=(float*)(shm+LDS_WS)+wid*64;
  const bf16*ksrc=Kh+(long)lane*KP+wid*8;
  const bf16*vsrc=Vh+(long)(16*(wid&3)+(lane>>2))*KP+(wid>>2)*32+(lane&3)*8;
  const unsigned kdst=lds0+LDS_K+wid*1024, vdst=lds0+LDS_V+wid*1024;
  #define DMA_K(t,slot) glds16(ksrc+(long)(t)*KVBLK*KP,(unsigned)__builtin_amdgcn_readfirstlane(kdst+(slot)))
  #define DMA_V(t,slot) glds16(vsrc+(long)(t)*KVBLK*KP,(unsigned)__builtin_amdgcn_readfirstlane(vdst+(slot)))
  const int vb0=(int)(lds0+LDS_V)+((lane>>4)&1)*32+(lane&3)*8+(4*hi+((lane&15)>>2))*64;
  const char*Kbase=shm+LDS_K; bf16x8 kf[8];
  const lds_cptr shm3=(lds_cptr)shm; const lds_cptr kp0=shm3+LDS_K+hi*1024+r32*16; const lds_cptr vp0=shm3+LDS_V+((lane>>4)&1)*32+(lane&3)*8+(4*hi+((lane&15)>>2))*64;
  const int NT=SEQ/KVBLK;
  DMA_K(0,0);DMA_V(0,0);DMA_K(1,SLOTB);
  bf16x8 qr[4];
  #pragma unroll
  for(int d0=0;d0<4;++d0)qr[d0]=*reinterpret_cast<const bf16x8*>(&Qw[(long)r32*QP+d0*16+hi*8]);
  float mhat=0.f,l_reg=0.f;f32x16 o[2];o[0]=f32x16{};o[1]=f32x16{};f32x16 negm=f32x16{};asm volatile("":"+v"(negm));
  const int qrel=wid*QBLK+r32;
  #define CMASK(P0,P1,t) do{}while(0)
  bool resc=false;
  #define START(P0,P1) do{ const float rm=rowmax(P0,P1); resc=false; \
    { const float dl=rm; mhat=fadd_s(mhat,dl); \
      _Pragma("unroll") for(int r=0;r<16;++r){P0[r]=fsub_s(P0[r],dl);P1[r]=fsub_s(P1[r],dl);} \
      _Pragma("unroll") for(int r=0;r<16;++r)negm[r]=-mhat; asm volatile("":"+v"(negm)); } \
    _Pragma("unroll") for(int r=0;r<16;++r)P0[r]=__builtin_amdgcn_exp2f(P0[r]); }while(0)
  #define RESC() do{ if(resc){ asm volatile("s_waitcnt lgkmcnt(0)":::"memory"); \
      _Pragma("unroll") for(int d_=0;d_<2;++d_) _Pragma("unroll") for(int r=0;r<16;++r)o[d_][r]*=wsf[crow(r,hi)]; } }while(0)
  f32x16 pA0,pA1,pB0,pB1;
  int sl_prev=0,sl_cur=0,sl_next=SLOTB;
  #define ROT() do{sl_prev=sl_cur;sl_cur=sl_next;sl_next=(sl_next==(NSLOT-1)*SLOTB)?0:sl_next+SLOTB;}while(0)
  DMA_K(2,2*SLOTB);
  WAIT_BAR(3);
  qkt(pA0,pA1,Kbase,qr,negm,r32,hi);asm volatile("s_nop 15\n\ts_nop 7":"+v"(pA0),"+v"(pA1));CMASK(pA0,pA1,0);
  START(pA0,pA1);
  _Pragma("unroll") for(int r=0;r<16;++r)pA1[r]=__builtin_amdgcn_exp2f(pA1[r]);
  WAIT_BAR(0);
  DMA_K(3,0);DMA_V(1,SLOTB);
  ROT();
  kload8(kf,kp0+sl_cur);
  WAIT_BAR(2);
  s16x4 vlo[8],vhi[8]; u32x4 pw0,pw1,pw2,pw3;
  #define PKW(P,B) cvtpk_s(P[B],P[B+1])
  #define PAF(k) __builtin_bit_cast(bf16x8,pw##k)
  #define VFR(i) (bf16x8){vlo[i][0],vlo[i][1],vlo[i][2],vlo[i][3],vhi[i][0],vhi[i][1],vhi[i][2],vhi[i][3]}
  #define PIN(x) asm volatile("":"+v"(x))
  #define MX3(a,b,c) __builtin_fmaxf(__builtin_fmaxf((a),(b)),(c))
  #define GAPA(MF,A0,A1,A2,A3,W0,W1,PW) do{ MF; sacc+=A0; sacc+=A1; sacc+=A2; sacc+=A3; PIN(sacc); W0; W1; PIN(PW); SBAR(); }while(0)
  #define EX(v) __builtin_amdgcn_exp2f(v)
  #define GAPB(MF,X,B) do{ MF; X[B]=EX(X[B]); X[B+1]=EX(X[B+1]); X[B+2]=EX(X[B+2]); X[B+3]=EX(X[B+3]); PIN(X); SBAR(); }while(0)
  #define VRD(i) do{ vlo[i]=vtr(vp_+(((i)>>2)*4096+((i)&3)*1024)); vhi[i]=vtr(vp_+(((i)>>2)*4096+((i)&3)*1024+512)); }while(0)
  #define KRD(G,j) do{ if(G){ kload2(kf,kp0+sl_next,j); SBAR(); } }while(0)
  #define STEP(C0,C1,P0,P1,t,GK,GV,GL) do{ SBAR(); \
    const lds_cptr vp_=vp0+sl_prev; \
    VRD(0); SBAR(); float sacc=(P0[0]+P0[1]); \
    GAPA(C0=__builtin_amdgcn_mfma_f32_32x32x16_bf16(kf[0],qr[0],negm,0,0,0), P0[2],P0[3],P0[4],P0[5],     pw0[0]=PKW(P0,0), pw0[1]=PKW(P0,2), pw0); \
    VRD(4); SBAR(); GAPA(C1=__builtin_amdgcn_mfma_f32_32x32x16_bf16(kf[1],qr[0],negm,0,0,0), P0[6],P0[7],P0[8],P0[9],     pw0[2]=PKW(P0,4), pw0[3]=PKW(P0,6), pw0); \
    VRD(1); SBAR(); GAPA(C0=__builtin_amdgcn_mfma_f32_32x32x16_bf16(kf[2],qr[1],C0,0,0,0),   P0[10],P0[11],P0[12],P0[13], pw1[0]=PKW(P0,8), pw1[1]=PKW(P0,10), pw1); \
    VRD(5); SBAR(); GAPA(C1=__builtin_amdgcn_mfma_f32_32x32x16_bf16(kf[3],qr[1],C1,0,0,0),   P0[14],P0[15],P1[0],P1[1],   pw1[2]=PKW(P0,12),pw1[3]=PKW(P0,14), pw1); \
    VRD(2); SBAR(); GAPA(C0=__builtin_amdgcn_mfma_f32_32x32x16_bf16(kf[4],qr[2],C0,0,0,0),   P1[2],P1[3],P1[4],P1[5],     pw2[0]=PKW(P1,0), pw2[1]=PKW(P1,2), pw2); \
    VRD(6); SBAR(); GAPA(C1=__builtin_amdgcn_mfma_f32_32x32x16_bf16(kf[5],qr[2],C1,0,0,0),   P1[6],P1[7],P1[8],P1[9],     pw2[2]=PKW(P1,4), pw2[3]=PKW(P1,6), pw2); \
    VRD(3); SBAR(); GAPA(C0=__builtin_amdgcn_mfma_f32_32x32x16_bf16(kf[6],qr[3],C0,0,0,0),   P1[10],P1[11],P1[12],P1[13], pw3[0]=PKW(P1,8), pw3[1]=PKW(P1,10), pw3); \
    VRD(7); SBAR(); GAPA(C1=__builtin_amdgcn_mfma_f32_32x32x16_bf16(kf[7],qr[3],C1,0,0,0),   P1[14],P1[15],0.f,0.f,       pw3[2]=PKW(P1,12),pw3[3]=PKW(P1,14), pw3); \
    l_reg+=sacc; \
    if(GK){DMA_K((t)+3,sl_cur);} if(GV){DMA_V((t)+1,sl_next);} \
    CMASK(C0,C1,t); \
    { float a=MX3(C0[0],C0[1],C1[0]),b=MX3(C0[2],C0[3],C1[1]); a=MX3(a,C1[2],C1[3]); \
      _Pragma("unroll") for(int r=4;r<16;r+=4){a=MX3(a,C0[r],C0[r+1]);b=MX3(b,C0[r+2],C0[r+3]);a=MX3(a,C1[r],C1[r+1]);b=MX3(b,C1[r+2],C1[r+3]);} \
      float rm=__builtin_fmaxf(a,b); { auto rr=__builtin_amdgcn_permlane32_swap(__float_as_uint(rm),__float_as_uint(rm),false,false); rm=__builtin_fmaxf(__uint_as_float(rr[0]),__uint_as_float(rr[1])); } \
      resc=false; \
      if(__builtin_expect(__any(rm>(float)THRL),0)){ const float dl=__builtin_fmaxf(rm,0.f); mhat+=dl; \
        _Pragma("unroll") for(int r=0;r<16;++r){C0[r]-=dl;C1[r]-=dl;} \
        _Pragma("unroll") for(int r=0;r<16;++r)negm[r]=-mhat; asm volatile("":"+v"(negm)); \
        const float f=__builtin_amdgcn_exp2f(-dl); l_reg*=f; if(hi==0)wsf[r32]=f; resc=true; } } \
    SBAR(); \
    GAPB(o[0]=__builtin_amdgcn_mfma_f32_32x32x16_bf16(PAF(0),VFR(0),o[0],0,0,0), C0,0); \
    GAPB(o[1]=__builtin_amdgcn_mfma_f32_32x32x16_bf16(PAF(0),VFR(4),o[1],0,0,0), C0,4); \
    KRD(GL,0); GAPB(o[0]=__builtin_amdgcn_mfma_f32_32x32x16_bf16(PAF(1),VFR(1),o[0],0,0,0), C0,8); \
    KRD(GL,1); GAPB(o[1]=__builtin_amdgcn_mfma_f32_32x32x16_bf16(PAF(1),VFR(5),o[1],0,0,0), C0,12); \
    KRD(GL,2); GAPB(o[0]=__builtin_amdgcn_mfma_f32_32x32x16_bf16(PAF(2),VFR(2),o[0],0,0,0), C1,0); \
    KRD(GL,3); GAPB(o[1]=__builtin_amdgcn_mfma_f32_32x32x16_bf16(PAF(2),VFR(6),o[1],0,0,0), C1,4); \
    GAPB(o[0]=__builtin_amdgcn_mfma_f32_32x32x16_bf16(PAF(3),VFR(3),o[0],0,0,0), C1,8); \
    GAPB(o[1]=__builtin_amdgcn_mfma_f32_32x32x16_bf16(PAF(3),VFR(7),o[1],0,0,0), C1,12); \
    }while(0)
  int t=1;
  #undef CMASK
  #define CMASK(P0,P1,t) do{}while(0)
  for(;t+5<NT;t+=2){
    STEP(pB0,pB1,pA0,pA1,t,true,true,true);     WAIT_BAR(2); RESC(); ROT();
    STEP(pA0,pA1,pB0,pB1,t+1,true,true,true);   WAIT_BAR(2); RESC(); ROT();
  }
  #undef CMASK
  #define CMASK(P0,P1,t) do{}while(0)
  #define ENDW(tt) do{ if((tt)+3<NT){WAIT_BAR(2);} else if((tt)+2<NT){WAIT_BAR(1);} else {WAIT_BAR(0);} }while(0)
  for(;t+1<NT;t+=2){
    STEP(pB0,pB1,pA0,pA1,t,(t+3<NT),(t+1<NT),(t+1<NT));       ENDW(t);   RESC(); ROT();
    STEP(pA0,pA1,pB0,pB1,t+1,(t+4<NT),(t+2<NT),(t+2<NT));     ENDW(t+1); RESC(); ROT();
  }
  STEP(pB0,pB1,pA0,pA1,NT-1,false,false,false); RESC();
  { float sacc=pB0[0]+pB0[1]; _Pragma("unroll") for(int r=2;r<16;++r)sacc+=pB0[r]; _Pragma("unroll") for(int r=0;r<16;++r)sacc+=pB1[r]; l_reg+=sacc;
    pw0=(u32x4){PKW(pB0,0),PKW(pB0,2),PKW(pB0,4),PKW(pB0,6)};pw1=(u32x4){PKW(pB0,8),PKW(pB0,10),PKW(pB0,12),PKW(pB0,14)};pw2=(u32x4){PKW(pB1,0),PKW(pB1,2),PKW(pB1,4),PKW(pB1,6)};pw3=(u32x4){PKW(pB1,8),PKW(pB1,10),PKW(pB1,12),PKW(pB1,14)};
    SBAR(); pv(o,vb0+sl_cur,PAF(0),PAF(1),PAF(2),PAF(3)); }
  #undef PKW
  #undef PAF
  #undef VFR
  #undef PIN
  #undef MX3
  #undef GAPA
  #undef GAPB
  #undef EX
  #undef VRD
  #undef KRD
  #undef STEP
  #undef ENDW
  {auto rr=__builtin_amdgcn_permlane32_swap(__float_as_uint(l_reg),__float_as_uint(l_reg),false,false);l_reg=__uint_as_float(rr[0])+__uint_as_float(rr[1]);}
  if(hi==0)wsf[32+r32]=l_reg;asm volatile("s_waitcnt lgkmcnt(0)":::"memory");
  float rli[16];
  #pragma unroll
  for(int r=0;r<16;++r)rli[r]=__builtin_amdgcn_rcpf(wsf[32+crow(r,hi)]);
  bf16*Ow=O+(long)(q0+wid*QBLK)*OP;
  { bf16*stg=(bf16*)(shm+LDS_OST)+wid*2048;
    #pragma unroll
    for(int r=0;r<16;++r){const int orow=crow(r,hi);
      #pragma unroll
      for(int d0=0;d0<2;++d0)stg[orow*64+d0*32+r32]=__float2bfloat16(o[d0][r]*rli[r]);}
    asm volatile("s_waitcnt lgkmcnt(0)":::"memory");
    #pragma unroll
    for(int i=0;i<4;++i){const int row=i*8+(lane>>3),ch=lane&7; const u32x4 v=*(const u32x4*)(stg+row*64+ch*8); ATTN_STORE16(Ow+(long)row*OP+ch*8,v);} }
  asm volatile("s_waitcnt lgkmcnt(0)\n\ts_barrier":::"memory");
  #undef DMA_K
  #undef DMA_V
  #undef CMASK
  #undef START
  #undef RESC
  #undef ROT
}
constexpr int ATTN_LDS_BYTES=LDS_BYTES;
#undef SBAR
#undef WAIT_BAR
}

namespace mk {
typedef unsigned short bf16_t;
typedef short bf16x8 __attribute__((ext_vector_type(8)));
typedef float f32x4 __attribute__((ext_vector_type(4)));
typedef unsigned u32x4 __attribute__((ext_vector_type(4)));
typedef unsigned u32x2 __attribute__((ext_vector_type(2)));

constexpr int DMODEL = 1024, TS = 16384, NSEG = 4, DFF = 4096;
constexpr int EIN = 1792, OIN = 4368, OINP = 4608, OOUT = 768;
constexpr float EPS = 1e-6f;
constexpr size_t MiB = (size_t)1 << 20;
constexpr size_t WS_W1T = 1 * MiB, WS_W2T = 33 * MiB, WS_WINE = 65 * MiB, WS_WOUTE = 72 * MiB, WS_WINO = 76 * MiB, WS_WOUTO = 94 * MiB,
                 WS_GW = 97 * MiB, WS_H = 98 * MiB, WS_PROJ = 130 * MiB, WS_SCR = 274 * MiB, WS_END = 512 * MiB;
constexpr size_t SC_HID = 0;
constexpr size_t SC_LA = 0, SC_UU = 64 * MiB, SC_YF = 128 * MiB;
constexpr size_t SC_QKVP = 0, SC_DNI = 48 * MiB, SC_OB = 192 * MiB, SC_LSE = 224 * MiB, SC_EGL = 225 * MiB;
constexpr int DNI_BYTES = 73728, DNI_W = 0, DNI_QT = 16384, DNI_KTT = 32768, DNI_A = 49152, DNI_U = 57344;
constexpr int LDS_BYTES = 147456;
constexpr int NT = 512, NW = 8;

struct Params { const float* in[25]; float* out; unsigned char* ws; };

__device__ __forceinline__ float bf2f(bf16_t v) { return __uint_as_float(((unsigned)v) << 16); }
__device__ __forceinline__ unsigned f2bf(float f) { unsigned u = __float_as_uint(f); return (u + 0x7fffu + ((u >> 16) & 1u)) >> 16; }
__device__ __forceinline__ unsigned pk2(float lo, float hi) { return f2bf(lo) | (f2bf(hi) << 16); }
__device__ __forceinline__ float wave_sum(float v) {
#pragma unroll
    for (int o = 1; o < 64; o <<= 1) v += __shfl_xor(v, o);
    return v;
}
__device__ __forceinline__ float sigm(float x) { return 1.f / (1.f + __expf(-x)); }
__device__ __forceinline__ float softplus(float x) { return x > 20.f ? x : log1pf(__expf(x)); }
__device__ __forceinline__ float silu(float x) { return x * sigm(x); }
__device__ __forceinline__ float gelu_tanh(float x) { const float t = 0.7978845608028654f * (x + 0.044715f * x * x * x); return 0.5f * x * (1.f + tanhf(t)); }
__device__ __forceinline__ void unpack8(const u32x4 v, float* f) {
    f[0] = __uint_as_float(v.x << 16); f[1] = __uint_as_float(v.x & 0xffff0000u); f[2] = __uint_as_float(v.y << 16); f[3] = __uint_as_float(v.y & 0xffff0000u);
    f[4] = __uint_as_float(v.z << 16); f[5] = __uint_as_float(v.z & 0xffff0000u); f[6] = __uint_as_float(v.w << 16); f[7] = __uint_as_float(v.w & 0xffff0000u);
}
#define MK_IDS() int tid = threadIdx.x; asm volatile("" : "+v"(tid)); const int lane = tid & 63, wave = __builtin_amdgcn_readfirstlane(tid >> 6); const int gw = blockIdx.x * NW + wave, NGW = gridDim.x * NW; (void)lane; (void)wave; (void)gw; (void)NGW
#define MFMA16(a, b, c) __builtin_amdgcn_mfma_f32_16x16x32_bf16((a), (b), (c), 0, 0, 0)

__device__ __forceinline__ void transpose_item(const float* W, int K, int Nsrc, int Npad, bf16_t* WT, float* scr, int item, int lane) {
    const int nblk = Npad / 32, kb = item / nblk, nb = item % nblk, k0 = 64 * kb, n0 = 32 * nb;
    const int n = n0 + (lane & 31);
#pragma unroll 8
    for (int i = 0; i < 32; ++i) { const int kk = 2 * i + (lane >> 5); scr[kk * 33 + (lane & 31)] = (n < Nsrc) ? W[(size_t)(k0 + kk) * Nsrc + n] : 0.f; }
    asm volatile("s_waitcnt lgkmcnt(0)" ::: "memory");
    const int c = lane & 7;
#pragma unroll
    for (int j = 0; j < 4; ++j) { const int nn = (lane >> 3) + 8 * j; const float* s = scr + (8 * c) * 33 + nn;
        u32x4 o; o.x = pk2(s[0 * 33], s[1 * 33]); o.y = pk2(s[2 * 33], s[3 * 33]); o.z = pk2(s[4 * 33], s[5 * 33]); o.w = pk2(s[6 * 33], s[7 * 33]);
        *(u32x4*)(WT + (size_t)(n0 + nn) * K + k0 + 8 * c) = o; }
    asm volatile("s_waitcnt lgkmcnt(0)" ::: "memory");
}
__device__ __forceinline__ void phase_prologue(const Params& p, char* lds) {
    MK_IDS();
    float* scr = (float*)(lds + wave * 16384);
    unsigned char* ws = p.ws;
    constexpr int I_F1 = 16 * 128, I_F2 = 64 * 32, I_IE = 16 * 56, I_OE = 16 * 32, I_IO = 16 * 144, I_OO = 12 * 32;
    constexpr int T_F1 = 4 * I_F1, T_F2 = T_F1 + 4 * I_F2, T_IE = T_F2 + 2 * I_IE, T_OE = T_IE + 2 * I_OE, T_IO = T_OE + 2 * I_IO, T_OO = T_IO + 2 * I_OO;
    for (int it = gw; it < T_OO; it += NGW) {
        if (it < T_F1) { const int l = it / I_F1, r = it % I_F1; transpose_item(p.in[6] + (size_t)l * 1024 * 4096, 1024, 4096, 4096, (bf16_t*)(ws + WS_W1T) + (size_t)l * 4096 * 1024, scr, r, lane); }
        else if (it < T_F2) { const int q = it - T_F1, l = q / I_F2, r = q % I_F2; transpose_item(p.in[7] + (size_t)l * 4096 * 1024, 4096, 1024, 1024, (bf16_t*)(ws + WS_W2T) + (size_t)l * 1024 * 4096, scr, r, lane); }
        else if (it < T_IE) { const int q = it - T_F2, l = q / I_IE, r = q % I_IE; transpose_item(p.in[8] + (size_t)l * 1024 * EIN, 1024, EIN, EIN, (bf16_t*)(ws + WS_WINE) + (size_t)l * EIN * 1024, scr, r, lane); }
        else if (it < T_OE) { const int q = it - T_IE, l = q / I_OE, r = q % I_OE; transpose_item(p.in[9] + (size_t)l * 1024 * 1024, 1024, 1024, 1024, (bf16_t*)(ws + WS_WOUTE) + (size_t)l * 1024 * 1024, scr, r, lane); }
        else if (it < T_IO) { const int q = it - T_OE, l = q / I_IO, r = q % I_IO; transpose_item(p.in[19] + (size_t)l * 1024 * OIN, 1024, OIN, OINP, (bf16_t*)(ws + WS_WINO) + (size_t)l * OINP * 1024, scr, r, lane); }
        else { const int q = it - T_IO, l = q / I_OO, r = q % I_OO; transpose_item(p.in[20] + (size_t)l * OOUT * 1024, OOUT, 1024, 1024, (bf16_t*)(ws + WS_WOUTO) + (size_t)l * 1024 * OOUT, scr, r, lane); }
    }
    bf16_t* GW = (bf16_t*)(ws + WS_GW);
    const int gt = gw * 64 + lane, NGT = NGW * 64;
    for (int idx = gt; idx < 2 * 2 * 2 * 8 * 4096; idx += NGT) {
        const int d = idx & 63, e = (idx >> 6) & 63, blk = (idx >> 12) & 7, gate = (idx >> 15) & 1, dir = (idx >> 16) & 1, j = (idx >> 17) & 1;
        const float* src = gate ? p.in[16] : p.in[14];
        GW[idx] = (bf16_t)f2bf(src[((((size_t)j * 2 + dir) * 8 + blk) * 64 + d) * 64 + e]);
    }
}

__device__ __forceinline__ void phase_rmsnorm_bf16(const float* x, const float* g, bf16_t* h) {
    MK_IDS();
    for (int m = gw; m < TS; m += NGW) {
        const f32x4* xr = (const f32x4*)(x + (size_t)m * DMODEL) + lane; const f32x4* gr = (const f32x4*)g + lane;
        f32x4 v[4]; float s = 0.f;
#pragma unroll
        for (int j = 0; j < 4; ++j) { v[j] = xr[64 * j]; s += (v[j].x * v[j].x + v[j].y * v[j].y) + (v[j].z * v[j].z + v[j].w * v[j].w); }
        const float rstd = 1.f / sqrtf(wave_sum(s) * (1.f / DMODEL) + EPS);
        u32x2* o8 = (u32x2*)(h + (size_t)m * DMODEL) + lane;
#pragma unroll
        for (int j = 0; j < 4; ++j) { const f32x4 gg = gr[64 * j]; u32x2 o; o.x = pk2(v[j].x * rstd * gg.x, v[j].y * rstd * gg.y); o.y = pk2(v[j].z * rstd * gg.z, v[j].w * rstd * gg.w); o8[64 * j] = o; }
    }
}
__device__ __forceinline__ void phase_rmsnorm_final(float* x, const float* g) {
    MK_IDS();
    for (int m = gw; m < TS; m += NGW) {
        f32x4* xr = (f32x4*)(x + (size_t)m * DMODEL) + lane; const f32x4* gr = (const f32x4*)g + lane;
        f32x4 v[4]; float s = 0.f;
#pragma unroll
        for (int j = 0; j < 4; ++j) { v[j] = xr[64 * j]; s += (v[j].x * v[j].x + v[j].y * v[j].y) + (v[j].z * v[j].z + v[j].w * v[j].w); }
        const float rstd = 1.f / sqrtf(wave_sum(s) * (1.f / DMODEL) + EPS);
#pragma unroll
        for (int j = 0; j < 4; ++j) { const f32x4 gg = gr[64 * j]; xr[64 * j] = v[j] * rstd * gg; }
    }
}

struct EpiRes {
    static constexpr bool PERM = false, AFTER_DRAIN = false;
    const float* base; float* out; int ldc;
    __device__ __forceinline__ void operator()(const pg8::f32x4 (&acc)[2][2][4][2], const pg8::Unit& u, int wr, int wc, int fr, int fq) const {
        const int col0 = u.pn * pg8::BM + wc * 32 + 4 * fq;
#pragma unroll
        for (int ai = 0; ai < 2; ++ai)
#pragma unroll
            for (int m = 0; m < 4; ++m) { const size_t off = (size_t)(u.pm * pg8::BM + ai * pg8::HALF + wr * 64 + m * 16 + fr) * ldc + col0;
#pragma unroll
                for (int bj = 0; bj < 2; ++bj)
#pragma unroll
                    for (int n = 0; n < 2; ++n) { const pg8::f32x4 bs = *(const pg8::f32x4*)(base + off + bj * pg8::HALF + n * 16); *(pg8::f32x4*)(out + off + bj * pg8::HALF + n * 16) = bs + acc[ai][bj][m][n]; }
                asm volatile("" ::: "memory"); }
    }
};

__device__ __forceinline__ void even_qk_post(bf16_t* proj, const float* qg, const float* kg, int S) {
    MK_IDS();
    const int d = lane, axis = d >> 5, f = d & 15, half = (d >> 4) & 1;
    const float inv = exp2f(-(float)f * (13.287712379549449f / 16.f));
    const float gq = qg[d], gk = kg[d];
    for (int t = gw; t < TS; t += NGW) {
        const int s = t % S; const int pos = axis ? (s & 63) : (s >> 6);
        const float ang = (float)pos * inv; float sn, cs; sincosf(ang, &sn, &cs);
        bf16_t* row = proj + (size_t)t * EIN;
#pragma unroll
        for (int hh = 0; hh < 10; ++hh) {
            const int c0 = hh < 8 ? hh * 64 : 512 + (hh - 8) * 64;
            const float x = bf2f(row[c0 + d]);
            const float ss = wave_sum(x * x);
            const float y = x * (1.f / sqrtf(ss * (1.f / 64.f) + EPS)) * (hh < 8 ? gq : gk);
            const float pr = __shfl_xor(y, 16);
            float o = y * cs + (half ? pr : -pr) * sn;
            if (hh < 8) o *= attn_body::C2;
            row[c0 + d] = (bf16_t)f2bf(o);
        }
    }
}
__device__ __forceinline__ void even_lru_prep(const bf16_t* proj, const float* cw, const float* cb, const bf16_t* GWj, const float* br, const float* bi, const float* lam,
                                              float* LA, float* UU, int S, char* lds) {
    MK_IDS();
    constexpr int XST = 1040;
    for (int tile = blockIdx.x; tile < TS / 64; tile += gridDim.x) {
        const int t0 = tile * 64;
        __syncthreads();
#pragma unroll 2
        for (int k = 0; k < 8; ++k) {
            const int idx = tid + k * NT, i = idx >> 6, cgp = idx & 63, t = t0 + i, s = t % S, ch = cgp * 8;
            float acc[8];
#pragma unroll
            for (int e = 0; e < 8; ++e) acc[e] = cb[ch + e];
#pragma unroll
            for (int j = 0; j < 4; ++j) { const int sp = s + j - 2;
                if (sp >= 0 && sp < S) { const u32x4 v = *(const u32x4*)(proj + (size_t)(t + j - 2) * EIN + 768 + ch); float xv[8]; unpack8(v, xv);
#pragma unroll
                    for (int e = 0; e < 8; ++e) acc[e] += cw[j * 512 + ch + e] * xv[e]; } }
            u32x4 o; o.x = pk2(acc[0], acc[1]); o.y = pk2(acc[2], acc[3]); o.z = pk2(acc[4], acc[5]); o.w = pk2(acc[6], acc[7]);
            *(u32x4*)(lds + i * XST + ch * 2) = o;
        }
        __syncthreads();
        const int G = lane >> 4, l16 = lane & 15, ch0 = wave * 64;
        for (int dir = 0; dir < 2; ++dir)
            for (int nt = 0; nt < 4; ++nt) {
                const int e = nt * 16 + l16, ch = ch0 + e;
                bf16x8 Br[2], Bi[2];
#pragma unroll
                for (int kk = 0; kk < 2; ++kk) {
                    Br[kk] = *(const bf16x8*)(GWj + ((((size_t)dir * 2 + 0) * 8 + wave) * 64 + e) * 64 + kk * 32 + G * 8);
                    Bi[kk] = *(const bf16x8*)(GWj + ((((size_t)dir * 2 + 1) * 8 + wave) * 64 + e) * 64 + kk * 32 + G * 8);
                }
                const float brv = br[dir * 512 + ch], biv = bi[dir * 512 + ch], spl = softplus(-lam[dir * 512 + ch]);
#pragma unroll
                for (int mt = 0; mt < 4; ++mt) {
                    f32x4 ar = {0.f, 0.f, 0.f, 0.f}, ai = {0.f, 0.f, 0.f, 0.f};
#pragma unroll
                    for (int kk = 0; kk < 2; ++kk) { const bf16x8 a = *(const bf16x8*)(lds + (mt * 16 + l16) * XST + (ch0 + kk * 32 + G * 8) * 2); ar = MFMA16(a, Br[kk], ar); ai = MFMA16(a, Bi[kk], ai); }
#pragma unroll
                    for (int r = 0; r < 4; ++r) { const int i = mt * 16 + G * 4 + r;
                        const float xc = bf2f(*(const bf16_t*)(lds + i * XST + ch * 2));
                        const float rg = sigm(ar[r] + brv), ig = sigm(ai[r] + biv);
                        const float la = -8.f * rg * spl; const float uu = sqrtf(fmaxf(-expm1f(2.f * la), 0.f)) * (ig * xc);
                        const size_t o = ((size_t)dir * TS + t0 + i) * 512 + ch; LA[o] = la; UU[o] = uu; }
                }
            }
    }
}
__device__ __forceinline__ void even_lru_scan(const float* LA, const float* UU, float* YF, const bf16_t* proj, bf16_t* Y, int S, int nb, char* lds) {
    MK_IDS();
    const int cl = tid & 31, ck = tid >> 5, CL = S / 16;
    float* agA = (float*)lds; float* agH = agA + 512;
    const int nitems = nb * 16;
    for (int item = (int)(gridDim.x - 1 - blockIdx.x); item < nitems; item += gridDim.x) {
        const int b = item >> 4, ch = (item & 15) * 32 + cl;
        for (int dir = 0; dir < 2; ++dir) {
            const float* la = LA + (size_t)dir * TS * 512; const float* uu = UU + (size_t)dir * TS * 512;
            const int sstart = dir ? ((ck + 1) * CL - 1) : ck * CL; const int sstep = dir ? -1 : 1;
            float h = 0.f, P = 0.f;
            for (int q = 0; q < CL; q += 8) {
                float lv[8], uv[8];
#pragma unroll
                for (int e = 0; e < 8; ++e) { const size_t o = (size_t)(b * S + sstart + sstep * (q + e)) * 512 + ch; lv[e] = la[o]; uv[e] = uu[o]; }
#pragma unroll
                for (int e = 0; e < 8; ++e) { h = __expf(lv[e]) * h + uv[e]; P += lv[e]; }
            }
            __syncthreads();
            agA[ck * 32 + cl] = __expf(P); agH[ck * 32 + cl] = h;
            __syncthreads();
            float c = 0.f;
            if (dir == 0) { for (int k = 0; k < ck; ++k) c = c * agA[k * 32 + cl] + agH[k * 32 + cl]; }
            else { for (int k = 15; k > ck; --k) c = c * agA[k * 32 + cl] + agH[k * 32 + cl]; }
            h = c;
            for (int q = 0; q < CL; q += 8) {
                float lv[8], uv[8], yv[8], gv[8];
#pragma unroll
                for (int e = 0; e < 8; ++e) { const size_t tk = (size_t)(b * S + sstart + sstep * (q + e)); const size_t o = tk * 512 + ch; lv[e] = la[o]; uv[e] = uu[o];
                    if (dir) { yv[e] = YF[o]; gv[e] = bf2f(proj[tk * EIN + 1280 + ch]); } }
#pragma unroll
                for (int e = 0; e < 8; ++e) { h = __expf(lv[e]) * h + uv[e]; const size_t tk = (size_t)(b * S + sstart + sstep * (q + e));
                    if (dir == 0) YF[tk * 512 + ch] = h; else Y[tk * DMODEL + 512 + ch] = (bf16_t)f2bf((yv[e] + h) * gelu_tanh(gv[e])); }
            }
        }
    }
}

__device__ __forceinline__ void odd_conv(const bf16_t* proj, const float* cw, bf16_t* QKVP, int S) {
    MK_IDS();
    for (int t = gw; t < TS; t += NGW) {
        const int s = t % S;
#pragma unroll
        for (int blk = 0; blk < 3; ++blk) {
            const int ch = blk * 512 + lane * 8;
            float acc[8];
#pragma unroll
            for (int e = 0; e < 8; ++e) acc[e] = 0.f;
#pragma unroll
            for (int j = 0; j < 4; ++j) { const int sp = s + j - 2;
                if (sp >= 0 && sp < S) { const u32x4 v = *(const u32x4*)(proj + (size_t)(t + j - 2) * OINP + ch); float xv[8]; unpack8(v, xv);
                    const f32x4 w0 = *(const f32x4*)(cw + j * 1536 + ch), w1 = *(const f32x4*)(cw + j * 1536 + ch + 4);
                    acc[0] += w0.x * xv[0]; acc[1] += w0.y * xv[1]; acc[2] += w0.z * xv[2]; acc[3] += w0.w * xv[3];
                    acc[4] += w1.x * xv[4]; acc[5] += w1.y * xv[5]; acc[6] += w1.z * xv[6]; acc[7] += w1.w * xv[7]; } }
            float ss = 0.f;
#pragma unroll
            for (int e = 0; e < 8; ++e) { acc[e] = silu(acc[e]); ss += acc[e] * acc[e]; }
            if (blk < 2) {
                ss += __shfl_xor(ss, 1); ss += __shfl_xor(ss, 2); ss += __shfl_xor(ss, 4); ss += __shfl_xor(ss, 8);
                const float rn = 1.f / sqrtf(ss + EPS);
#pragma unroll
                for (int e = 0; e < 8; ++e) acc[e] *= rn;
            }
            u32x4 o; o.x = pk2(acc[0], acc[1]); o.y = pk2(acc[2], acc[3]); o.z = pk2(acc[4], acc[5]); o.w = pk2(acc[6], acc[7]);
            *(u32x4*)(QKVP + (size_t)t * 1536 + ch) = o;
        }
    }
}

__device__ __forceinline__ void odd_prep(const bf16_t* QKVP, const bf16_t* proj, const float* alog, const float* dtb, unsigned char* DNI, float* EGL, char* lds) {
    MK_IDS();
    constexpr int RS = 272;
    constexpr int HOFF = 69632;
    const float scale = 0.08838834764831845f;
    for (int it0 = blockIdx.x * 2; it0 < 2048; it0 += gridDim.x * 2) {
        int tq_ = tid; asm volatile("" : "+v"(tq_));
        const int half = tq_ >> 8, ht = tq_ & 255, hwave = __builtin_amdgcn_readfirstlane(ht >> 6), G = (tq_ & 63) >> 4, l16 = tq_ & 15;
        char* L = lds + half * HOFF;
        char* KS = L, *QS = L + 17408, *VS = L + 34816; float* LM = (float*)(L + 52224); float* GC = (float*)(L + 68608); float* BT = GC + 64; float* EG = BT + 64;
        const int it = it0 + half; const int d = it & 1, h = (it >> 1) & 3, c = it >> 3, t0 = c * 64;
        __syncthreads();
#pragma unroll
        for (int k = 0; k < 4; ++k) { const int idx = ht + k * 256, i = idx >> 4, pc = idx & 15; const int tk = d ? t0 + 63 - i : t0 + i;
            const bf16_t* src = QKVP + (size_t)tk * 1536 + h * 128 + pc * 8;
            *(u32x4*)(QS + i * RS + pc * 16) = *(const u32x4*)(src);
            *(u32x4*)(KS + i * RS + pc * 16) = *(const u32x4*)(src + 512);
            *(u32x4*)(VS + i * RS + pc * 16) = *(const u32x4*)(src + 1024); }
        if (hwave == 0) {
            const int i = lane; const int tk = d ? t0 + 63 - i : t0 + i;
            const float bl = bf2f(proj[(size_t)tk * OINP + 2048 + d * 4 + h]), al = bf2f(proj[(size_t)tk * OINP + 2056 + d * 4 + h]);
            const float beta = sigm(bl); float g = -__expf(alog[d * 4 + h]) * softplus(al + dtb[d * 4 + h]);
#pragma unroll
            for (int o = 1; o < 64; o <<= 1) { const float v = __shfl_up(g, o); if (lane >= o) g += v; }
            GC[i] = g; BT[i] = beta; EG[i] = __expf(g);
        }
        __syncthreads();
        {
            const bool isq = hwave >= 2; const char* XS = isq ? QS : KS;
#pragma unroll
            for (int mm = 0; mm < 2; ++mm) { const int mt = (hwave & 1) * 2 + mm;
                bf16x8 a[4];
#pragma unroll
                for (int kk = 0; kk < 4; ++kk) a[kk] = *(const bf16x8*)(XS + (mt * 16 + l16) * RS + (kk * 32 + G * 8) * 2);
#pragma unroll
                for (int nt = 0; nt < 4; ++nt) { f32x4 acc = {0.f, 0.f, 0.f, 0.f};
#pragma unroll
                    for (int kk = 0; kk < 4; ++kk) { const bf16x8 bb = *(const bf16x8*)(KS + (nt * 16 + l16) * RS + (kk * 32 + G * 8) * 2); acc = MFMA16(a[kk], bb, acc); }
                    const int j = nt * 16 + l16; const float gj = GC[j];
#pragma unroll
                    for (int r = 0; r < 4; ++r) { const int i = mt * 16 + G * 4 + r; const float dec = __expf(fminf(GC[i] - gj, 0.f));
                        if (!isq) LM[i * 64 + j] = (j < i) ? BT[i] * acc[r] * dec : 0.f;
                        else ((bf16_t*)(DNI + (size_t)it * DNI_BYTES + DNI_A))[i * 64 + j] = (bf16_t)f2bf((j <= i) ? acc[r] * scale * dec : 0.f); }
                }
            }
        }
        __syncthreads();
        {
            float sol[64];
            const int cc = ht & 127; const bool isw = ht >= 128; const char* XS = isw ? KS : VS;
#pragma unroll
            for (int i = 0; i < 64; ++i) {
                float v = bf2f(*(const bf16_t*)(XS + i * RS + cc * 2)) * BT[i]; if (isw) v *= EG[i];
#pragma unroll
                for (int j4 = 0; j4 < (i + 3) / 4; ++j4) { const f32x4 l4 = *(const f32x4*)(LM + i * 64 + j4 * 4);
                    if (j4 * 4 + 0 < i) v -= l4.x * sol[j4 * 4 + 0]; if (j4 * 4 + 1 < i) v -= l4.y * sol[j4 * 4 + 1];
                    if (j4 * 4 + 2 < i) v -= l4.z * sol[j4 * 4 + 2]; if (j4 * 4 + 3 < i) v -= l4.w * sol[j4 * 4 + 3];
                    if ((j4 & 3) == 3) asm volatile("" ::: "memory"); }
                sol[i] = v;
                ((bf16_t*)(DNI + (size_t)it * DNI_BYTES + (isw ? DNI_W : DNI_U)))[i * 128 + cc] = (bf16_t)f2bf(v);
                asm volatile("" ::: "memory");
            }
        }
        {
            const float gl = GC[63];
#pragma unroll 4
            for (int k = 0; k < 32; ++k) { const int idx = ht + k * 256;
                { const int i = idx >> 7, dm = idx & 127; ((bf16_t*)(DNI + (size_t)it * DNI_BYTES + DNI_QT))[idx] = (bf16_t)f2bf(bf2f(*(const bf16_t*)(QS + i * RS + dm * 2)) * scale * EG[i]); }
                { const int i = idx & 63, dm = idx >> 6; ((bf16_t*)(DNI + (size_t)it * DNI_BYTES + DNI_KTT))[idx] = (bf16_t)f2bf(bf2f(*(const bf16_t*)(KS + i * RS + dm * 2)) * __expf(gl - GC[i])); }
            }
            if (ht == 0) EGL[it] = __expf(gl);
        }
    }
}

__device__ __forceinline__ void odd_scan(const unsigned char* DNI, const float* EGL, bf16_t* OB, int S, int nb, char* lds) {
    MK_IDS();
    constexpr int BUFB = 64512, O_W = 0, O_QT = 17408, O_KTT = 34816, O_A = 53248, O_U = 62464, O_SB = 129024, O_VN = 133376;
    const int NC = S / 64, G = lane >> 4, l16 = lane & 15;
    const int nitems = nb * 64;
    for (int item = blockIdx.x; item < nitems; item += gridDim.x) {
        const int e = item & 7, d = (item >> 3) & 1, h = (item >> 4) & 3, b = item >> 6;
        __syncthreads();
        for (int i = tid; i < 4352 / 4; i += NT) ((unsigned*)(lds + O_SB))[i] = 0u;
        f32x4 Sreg = {0.f, 0.f, 0.f, 0.f};
        u32x4 rW[2], rQ[2], rK[2], rA, rU;
#define DN_LOAD(n) do { const unsigned char* ip = DNI + (size_t)(((b * NC + (d ? NC - 1 - (n) : (n))) * 4 + h) * 2 + d) * DNI_BYTES; \
            _Pragma("unroll") for (int k = 0; k < 2; ++k) { const int idx = tid + k * NT; rW[k] = *(const u32x4*)(ip + DNI_W + idx * 16); rQ[k] = *(const u32x4*)(ip + DNI_QT + idx * 16); rK[k] = *(const u32x4*)(ip + DNI_KTT + idx * 16); } \
            rA = *(const u32x4*)(ip + DNI_A + tid * 16); if (tid < 128) rU = *(const u32x4*)(ip + DNI_U + (tid >> 1) * 256 + e * 32 + (tid & 1) * 16); } while (0)
#define DN_STORE(buf) do { char* bp = lds + (buf) * BUFB; \
            _Pragma("unroll") for (int k = 0; k < 2; ++k) { const int idx = tid + k * NT; *(u32x4*)(bp + O_W + (idx >> 4) * 272 + (idx & 15) * 16) = rW[k]; *(u32x4*)(bp + O_QT + (idx >> 4) * 272 + (idx & 15) * 16) = rQ[k]; \
                *(u32x4*)(bp + O_KTT + (idx >> 3) * 144 + (idx & 7) * 16) = rK[k]; } \
            *(u32x4*)(bp + O_A + (tid >> 3) * 144 + (tid & 7) * 16) = rA; if (tid < 128) *(u32x4*)(bp + O_U + (tid >> 1) * 32 + (tid & 1) * 16) = rU; } while (0)
        DN_LOAD(0); DN_STORE(0);
        __syncthreads();
        for (int n = 0; n < NC; ++n) {
            const int buf = n & 1; const char* bp = lds + buf * BUFB;
            if (n + 1 < NC) DN_LOAD(n + 1);
            const int c = b * NC + (d ? NC - 1 - n : n);
            const float egl = EGL[(c * 4 + h) * 2 + d];
            f32x4 acc = {0.f, 0.f, 0.f, 0.f};
            const int mt = wave & 3;
            {
                const char* XS = bp + (wave < 4 ? O_W : O_QT);
#pragma unroll
                for (int kk = 0; kk < 4; ++kk) { const bf16x8 a = *(const bf16x8*)(XS + (mt * 16 + l16) * 272 + (kk * 32 + G * 8) * 2); const bf16x8 bb = *(const bf16x8*)(lds + O_SB + l16 * 272 + (kk * 32 + G * 8) * 2); acc = MFMA16(a, bb, acc); }
            }
            if (wave < 4) {
                u32x2 o; float v[4];
#pragma unroll
                for (int r = 0; r < 4; ++r) v[r] = bf2f(*(const bf16_t*)(bp + O_U + (mt * 16 + G * 4 + r) * 32 + l16 * 2)) - acc[r];
                o.x = pk2(v[0], v[1]); o.y = pk2(v[2], v[3]);
                *(u32x2*)(lds + O_VN + l16 * 144 + (mt * 16 + G * 4) * 2) = o;
            }
            __syncthreads();
            bf16x8 vb[2];
#pragma unroll
            for (int kk = 0; kk < 2; ++kk) vb[kk] = *(const bf16x8*)(lds + O_VN + l16 * 144 + (kk * 32 + G * 8) * 2);
            if (wave >= 4) {
#pragma unroll
                for (int kk = 0; kk < 2; ++kk) { const bf16x8 a = *(const bf16x8*)(bp + O_A + (mt * 16 + l16) * 144 + (kk * 32 + G * 8) * 2); acc = MFMA16(a, vb[kk], acc); }
                const int t0 = c * 64;
#pragma unroll
                for (int r = 0; r < 4; ++r) { const int i = mt * 16 + G * 4 + r; const int tk = d ? t0 + 63 - i : t0 + i;
                    OB[((size_t)d * TS + tk) * 512 + h * 128 + e * 16 + l16] = (bf16_t)f2bf(acc[r]); }
            }
            {
                Sreg = Sreg * egl;
#pragma unroll
                for (int kk = 0; kk < 2; ++kk) { const bf16x8 a = *(const bf16x8*)(bp + O_KTT + (wave * 16 + l16) * 144 + (kk * 32 + G * 8) * 2); Sreg = MFMA16(a, vb[kk], Sreg); }
                u32x2 o; o.x = pk2(Sreg[0], Sreg[1]); o.y = pk2(Sreg[2], Sreg[3]);
                *(u32x2*)(lds + O_SB + l16 * 272 + (wave * 16 + G * 4) * 2) = o;
            }
            if (n + 1 < NC) DN_STORE(buf ^ 1);
            __syncthreads();
        }
#undef DN_LOAD
#undef DN_STORE
    }
}

__device__ __forceinline__ int t5_bucket(int rel) {
    const int n = rel < 0 ? -rel : rel; int v;
    if (n < 8) v = n; else v = 8 + (n >= 15) + (n >= 27) + (n >= 50) + (n >= 91) + (n >= 166) + (n >= 305) + (n >= 559);
    return (rel > 0 ? 16 : 0) + v;
}
__device__ __forceinline__ void odd_dilated(bf16_t* proj, const float* relb, float* LSE, int S, char* lds, int first_wg, int n_wg) {
    MK_IDS();
    constexpr int KST = 144, VST = 400, HOFF = 27648 + 25600 + 1024;
    const int half = tid >> 8, ht = tid & 255, wv = ht >> 6, G = lane >> 4, l16 = lane & 15;
    char* L = lds + half * HOFF; char* KS = L; char* VT = L + 27648; float* BIAS = (float*)(L + 27648 + 25600);
    const int NBb = S / 64;
    const int wgi = (int)blockIdx.x - first_wg;
    if (wgi < 0) return;
    for (int it0 = wgi * 2; it0 < 3072; it0 += n_wg * 2) {
        const int it = it0 + half; const int zb = it & 255, sl = (it >> 8) & 3, g = it >> 10;
        const int dil = g == 0 ? 1 : (g == 1 ? 4 : 16), lg = g * 2;
        const int M = S >> lg, MB = M / 64;
        const int b = zb / NBb, r0 = zb % NBb, rho = r0 / MB, n = r0 % MB;
        const int hc = (g * 4 + sl) * 64;
        const size_t tb = (size_t)b * S;
        __syncthreads();
#pragma unroll
        for (int k = 0; k < 6; ++k) { const int idx = ht + k * 256, kj = idx >> 3, pc = idx & 7; const int mk = 64 * n - 64 + kj;
            u32x4 kv = {0u, 0u, 0u, 0u}, vv = {0u, 0u, 0u, 0u};
            if (mk >= 0 && mk < M) { const bf16_t* rowp = proj + (tb + (size_t)mk * dil + rho) * OINP; kv = *(const u32x4*)(rowp + 2832 + hc + pc * 8); vv = *(const u32x4*)(rowp + 3600 + hc + pc * 8); }
            *(u32x4*)(KS + kj * KST + pc * 16) = kv;
            const unsigned w[4] = {vv.x, vv.y, vv.z, vv.w};
#pragma unroll
            for (int q = 0; q < 4; ++q) { *(bf16_t*)(VT + (pc * 8 + 2 * q) * VST + kj * 2) = (bf16_t)(w[q] & 0xffffu); *(bf16_t*)(VT + (pc * 8 + 2 * q + 1) * VST + kj * 2) = (bf16_t)(w[q] >> 16); } }
        if (ht < 129) BIAS[ht] = relb[t5_bucket((ht - 64) * dil) * 12 + g * 4 + sl];
        const int mq = 64 * n + 16 * wv + l16; const size_t tq = tb + (size_t)mq * dil + rho;
        bf16x8 qf[2];
#pragma unroll
        for (int kk = 0; kk < 2; ++kk) qf[kk] = *(const bf16x8*)(proj + tq * OINP + 2064 + hc + kk * 32 + G * 8);
        __syncthreads();
        f32x4 sc[9]; float mx = -1e30f;
#pragma unroll
        for (int kt = 0; kt < 9; ++kt) { f32x4 acc = {0.f, 0.f, 0.f, 0.f};
#pragma unroll
            for (int kk = 0; kk < 2; ++kk) { const bf16x8 a = *(const bf16x8*)(KS + ((wv + kt) * 16 + l16) * KST + (kk * 32 + G * 8) * 2); acc = MFMA16(a, qf[kk], acc); }
#pragma unroll
            for (int r = 0; r < 4; ++r) { const int kj = (wv + kt) * 16 + G * 4 + r; const int delta = kj - 64 - 16 * wv - l16; const int mk = 64 * n - 64 + kj;
                const bool ok = (delta >= -64) && (delta <= 64) && (mk >= 0) && (mk < M);
                const float s = ok ? acc[r] * 0.125f + BIAS[(delta < -64 ? -64 : (delta > 64 ? 64 : delta)) + 64] : -1e30f;
                acc[r] = s; mx = fmaxf(mx, s); }
            sc[kt] = acc; }
        mx = fmaxf(mx, __shfl_xor(mx, 16)); mx = fmaxf(mx, __shfl_xor(mx, 32));
        float sum = 0.f;
#pragma unroll
        for (int kt = 0; kt < 9; ++kt)
#pragma unroll
            for (int r = 0; r < 4; ++r) { const float pv_ = (sc[kt][r] > -1e29f) ? __expf(sc[kt][r] - mx) : 0.f; sc[kt][r] = pv_; sum += pv_; }
        sum += __shfl_xor(sum, 16); sum += __shfl_xor(sum, 32);
        f32x4 ot[4];
#pragma unroll
        for (int dt = 0; dt < 4; ++dt) ot[dt] = (f32x4){0.f, 0.f, 0.f, 0.f};
#pragma unroll
        for (int pp = 0; pp < 5; ++pp) {
            u32x4 pb; pb.x = pk2(sc[2 * pp][0], sc[2 * pp][1]); pb.y = pk2(sc[2 * pp][2], sc[2 * pp][3]);
            if (pp < 4) { pb.z = pk2(sc[2 * pp + 1][0], sc[2 * pp + 1][1]); pb.w = pk2(sc[2 * pp + 1][2], sc[2 * pp + 1][3]); } else { pb.z = 0u; pb.w = 0u; }
            const bf16x8 pbf = __builtin_bit_cast(bf16x8, pb);
#pragma unroll
            for (int dt = 0; dt < 4; ++dt) {
                u32x4 av; const u32x2 lo = *(const u32x2*)(VT + (dt * 16 + l16) * VST + ((wv + 2 * pp) * 16 + G * 4) * 2); av.x = lo.x; av.y = lo.y;
                if (pp < 4) { const u32x2 hi = *(const u32x2*)(VT + (dt * 16 + l16) * VST + ((wv + 2 * pp + 1) * 16 + G * 4) * 2); av.z = hi.x; av.w = hi.y; } else { av.z = 0u; av.w = 0u; }
                ot[dt] = MFMA16(__builtin_bit_cast(bf16x8, av), pbf, ot[dt]);
            }
        }
        const float rs = 1.f / sum;
        float* od = (float*)(proj + tq * OINP) + (g * 4 + sl) * 64;
#pragma unroll
        for (int dt = 0; dt < 4; ++dt) *(f32x4*)(od + dt * 16 + G * 4) = ot[dt] * rs;
        if (G == 0) LSE[tq * 12 + g * 4 + sl] = mx + __logf(sum);
    }
}

__device__ __forceinline__ void odd_combine(const bf16_t* OB, const bf16_t* proj, const float* LSE, const float* og, bf16_t* Y) {
    MK_IDS();
    const float g0 = og[lane * 2], g1 = og[lane * 2 + 1];
    for (int t = gw; t < TS; t += NGW) {
        const bf16_t* prow = proj + (size_t)t * OINP;
#pragma unroll
        for (int hh = 0; hh < 4; ++hh) {
            const unsigned a = *(const unsigned*)(OB + (size_t)t * 512 + hh * 128 + lane * 2), bb = *(const unsigned*)(OB + ((size_t)TS + t) * 512 + hh * 128 + lane * 2);
            const unsigned zz = *(const unsigned*)(prow + 1536 + hh * 128 + lane * 2);
            const float o0 = __uint_as_float(a << 16) + __uint_as_float(bb << 16), o1 = __uint_as_float(a & 0xffff0000u) + __uint_as_float(bb & 0xffff0000u);
            const float ss = wave_sum(o0 * o0 + o1 * o1); const float rn = 1.f / sqrtf(ss * (1.f / 128.f) + EPS);
            const float z0 = __uint_as_float(zz << 16), z1 = __uint_as_float(zz & 0xffff0000u);
            *(unsigned*)(Y + (size_t)t * OOUT + hh * 128 + lane * 2) = pk2(o0 * rn * g0 * silu(z0), o1 * rn * g1 * silu(z1));
        }
        const float* od = (const float*)prow;
#pragma unroll
        for (int sl = 0; sl < 4; ++sl) {
            const float l0 = LSE[(size_t)t * 12 + sl], l1 = LSE[(size_t)t * 12 + 4 + sl], l2 = LSE[(size_t)t * 12 + 8 + sl];
            const float m = fmaxf(l0, fmaxf(l1, l2)); const float w0 = __expf(l0 - m), w1 = __expf(l1 - m), w2 = __expf(l2 - m); const float rs = 1.f / (w0 + w1 + w2);
            const float v = (w0 * od[sl * 64 + lane] + w1 * od[256 + sl * 64 + lane] + w2 * od[512 + sl * 64 + lane]) * rs;
            Y[(size_t)t * OOUT + 512 + sl * 64 + lane] = (bf16_t)f2bf(v);
        }
    }
}

__global__ void __launch_bounds__(NT, 2) fwd_megakernel(Params p) {
    extern __shared__ __attribute__((aligned(16))) unsigned char lds_raw[];
    cg::grid_group grid = cg::this_grid();
    char* lds = (char*)lds_raw;
    PG8_LAS unsigned char* ldsl = (PG8_LAS unsigned char*)lds_raw;
    const int Gr = gridDim.x;
    unsigned char* ws = p.ws;
    bf16_t* H = (bf16_t*)(ws + WS_H); bf16_t* PROJ = (bf16_t*)(ws + WS_PROJ); unsigned char* SCR = ws + WS_SCR;

    phase_prologue(p, lds);
    grid.sync();

    for (int seg = 0; seg < NSEG; ++seg) {
        const int S = seg < 2 ? 16384 : 2048, nb = seg < 2 ? 1 : 8;
        const float* xin = (seg < 2 ? p.in[0] : p.in[1]) + (size_t)(seg & 1) * TS * DMODEL;
        float* xo = p.out + (size_t)seg * TS * DMODEL;
        for (int layer = 0; layer < 4; ++layer) {
            const float* xcur = layer == 0 ? xin : xo;
            const int j = layer >> 1; const bool odd = layer & 1;
            phase_rmsnorm_bf16(xcur, p.in[3] + layer * DMODEL, H);
            grid.sync();
            {
                const int N = odd ? OINP : EIN;
                const bf16_t* Bt = odd ? (const bf16_t*)(ws + WS_WINO) + (size_t)j * OINP * 1024 : (const bf16_t*)(ws + WS_WINE) + (size_t)j * EIN * 1024;
                pg8::Gemm g{H, Bt, TS, N, 1024}; pg8::StaticOrder So; So.init(TS, N, Gr, (int)blockIdx.x);
                pg8::EpiBf16<0> E{PROJ, N, nullptr, 0, 0, 1.f};
                pg8::gemm_phase<pg8::EpiBf16<0>, pg8::StaticOrder, true, true>(ldsl, g, So, E);
            }
            grid.sync();
            if (!odd) {
                even_qk_post(PROJ, p.in[10] + j * 64, p.in[11] + j * 64, S);
                even_lru_prep(PROJ, p.in[12] + j * 2048, p.in[13] + j * 512, (const bf16_t*)(ws + WS_GW) + (size_t)j * 2 * 2 * 8 * 4096, p.in[15] + j * 1024, p.in[17] + j * 1024, p.in[18] + j * 1024,
                              (float*)(SCR + SC_LA), (float*)(SCR + SC_UU), S, lds);
                grid.sync();
                {
                    const int nqb = S / 256, nunits = nb * 8 * nqb;
                    for (int u = blockIdx.x; u < nunits; u += Gr) {
                        const int qb = u % nqb, h = (u / nqb) % 8, b = u / (nqb * 8), kvh = h >> 2;
                        const attn_body::bf16* base = (const attn_body::bf16*)PROJ + (size_t)b * S * EIN;
                        attn_body::attn_unit<8>(qb, S, base + h * 64, EIN, base + 512 + kvh * 64, base + 640 + kvh * 64, EIN, (attn_body::bf16*)H + (size_t)b * S * DMODEL + h * 64, DMODEL, lds);
                    }
                }
                __syncthreads();
                even_lru_scan((const float*)(SCR + SC_LA), (const float*)(SCR + SC_UU), (float*)(SCR + SC_YF), PROJ, H, S, nb, lds);
                grid.sync();
                {
                    pg8::Gemm g{H, (const bf16_t*)(ws + WS_WOUTE) + (size_t)j * 1024 * 1024, TS, 1024, 1024}; pg8::StaticOrder So; So.init(TS, 1024, Gr, (int)blockIdx.x);
                    EpiRes E{xcur, xo, DMODEL};
                    pg8::gemm_phase<EpiRes, pg8::StaticOrder, true, true>(ldsl, g, So, E);
                }
            } else {
                odd_conv(PROJ, p.in[21] + j * 4 * 1536, (bf16_t*)(SCR + SC_QKVP), S);
                grid.sync();
                odd_prep((const bf16_t*)(SCR + SC_QKVP), PROJ, p.in[22] + j * 8, p.in[23] + j * 8, SCR + SC_DNI, (float*)(SCR + SC_EGL), lds);
                grid.sync();
                {
                    const int nscan = nb * 64;
                    odd_scan(SCR + SC_DNI, (const float*)(SCR + SC_EGL), (bf16_t*)(SCR + SC_OB), S, nb, lds);
                    const int first = nscan < Gr ? nscan : 0;
                    odd_dilated(PROJ, p.in[2], (float*)(SCR + SC_LSE), S, lds, first, Gr - first);
                }
                grid.sync();
                odd_combine((const bf16_t*)(SCR + SC_OB), PROJ, (const float*)(SCR + SC_LSE), p.in[24] + j * 128, H);
                grid.sync();
                {
                    pg8::Gemm g{H, (const bf16_t*)(ws + WS_WOUTO) + (size_t)j * 1024 * OOUT, TS, 1024, OOUT}; pg8::StaticOrder So; So.init(TS, 1024, Gr, (int)blockIdx.x);
                    EpiRes E{xcur, xo, DMODEL};
                    pg8::gemm_phase<EpiRes, pg8::StaticOrder, true, true>(ldsl, g, So, E);
                }
            }
            grid.sync();
            phase_rmsnorm_bf16(xo, p.in[4] + layer * DMODEL, H);
            grid.sync();
            {
                pg8::Gemm g{H, (const bf16_t*)(ws + WS_W1T) + (size_t)layer * 4096 * 1024, TS, DFF, 1024}; pg8::StaticOrder So; So.init(TS, DFF, Gr, (int)blockIdx.x);
                pg8::EpiBf16<2> E{(bf16_t*)(SCR + SC_HID), DFF, nullptr, 0, 0, 1.f};
                pg8::gemm_phase<pg8::EpiBf16<2>, pg8::StaticOrder, true, true>(ldsl, g, So, E);
            }
            grid.sync();
            {
                pg8::Gemm g{(const bf16_t*)(SCR + SC_HID), (const bf16_t*)(ws + WS_W2T) + (size_t)layer * 1024 * 4096, TS, 1024, DFF}; pg8::StaticOrder So; So.init(TS, 1024, Gr, (int)blockIdx.x);
                EpiRes E{xo, xo, DMODEL};
                pg8::gemm_phase<EpiRes, pg8::StaticOrder, true, true>(ldsl, g, So, E);
            }
            grid.sync();
        }
        phase_rmsnorm_final(xo, p.in[5]);
    }
}
}

extern "C" void kernel_launch(void* const* d_in, const int* in_sizes, int n_in, void* d_out, int out_size, void* d_ws, size_t ws_size, hipStream_t stream) {
    static int grid = 0;
    if (grid == 0) {
        if (n_in != 25 || ws_size < mk::WS_END) { fprintf(stderr, "kernel_launch: unexpected n_in %d / ws_size %zu\n", n_in, ws_size); grid = -1; return; }
        int dev = 0, cus = 0, per_cu = 0;
        hipGetDevice(&dev); hipDeviceGetAttribute(&cus, hipDeviceAttributeMultiprocessorCount, dev);
        if (hipFuncSetAttribute((const void*)mk::fwd_megakernel, hipFuncAttributeMaxDynamicSharedMemorySize, mk::LDS_BYTES) != hipSuccess) { fprintf(stderr, "hipFuncSetAttribute failed\n"); }
        hipOccupancyMaxActiveBlocksPerMultiprocessor(&per_cu, (const void*)mk::fwd_megakernel, mk::NT, mk::LDS_BYTES);
        (void)hipGetLastError();
        if (per_cu < 1) per_cu = 1;
        grid = cus * 1;
        fprintf(stderr, "kernel_launch: cus %d per_cu %d grid %d\n", cus, per_cu, grid);
    }
    if (grid < 0) return;
    mk::Params p{};
    for (int i = 0; i < 25; ++i) p.in[i] = (const float*)d_in[i];
    p.out = (float*)d_out; p.ws = (unsigned char*)d_ws;
    void* args[] = {&p};
    hipError_t e = hipLaunchCooperativeKernel((const void*)mk::fwd_megakernel, dim3(grid), dim3(mk::NT), args, mk::LDS_BYTES, stream);
    if (e != hipSuccess) fprintf(stderr, "cooperative launch failed: %s (grid %d)\n", hipGetErrorString(e), grid);
}
```

```cpp
#include <hip/hip_runtime.h>
#include <hip/hip_cooperative_groups.h>
#include <hip/hip_bf16.h>
#include <cstdio>
#include <cstdint>
#include <cmath>
namespace cg = cooperative_groups;
namespace pg8 {
#define PG8_LAS __attribute__((address_space(3)))
typedef unsigned short bf16_t;
typedef short bf16x8 __attribute__((ext_vector_type(8)));
typedef float f32x4 __attribute__((ext_vector_type(4)));
typedef unsigned u32x4 __attribute__((ext_vector_type(4)));
constexpr int BM = 256, BK = 64, HALF = 128, HTB = HALF * BK * 2  , STAGE_BYTES = 8 * HTB, NXCD = 8, WGM = 8;

__host__ __device__ __forceinline__ int lds_byte(int r, int c) { const int st = (r >> 4) * 2 + (c >> 5), rr = r & 15, cc = c & 31, ob = rr * 64 + cc * 2; return st * 1024 + (ob ^ (((ob >> 9) & 1) << 5)); }
__host__ __device__ __forceinline__ void stage_rc(int b, int& R, int& C) { const int st = b / 1024, sb = b % 1024, swz = sb ^ (((sb >> 9) & 1) << 5); R = (st >> 1) * 16 + swz / 64; C = (st & 1) * 32 + (swz % 64) / 2; }
__host__ __device__ __forceinline__ int perm32(int rho) { const int n = rho >> 4, i = rho & 15; return 8 * (i >> 2) + 4 * n + (i & 3); }

struct Unit { int pm, pn; };
struct Gemm { const bf16_t* A; const bf16_t* Bt; int M, N, K; };

struct StaticOrder {
    int nM, nN, nwg, G, c;
    __host__ __device__ void init(int M, int N, int G_, int c_) { nM = M / BM; nN = N / BM; nwg = nM * nN; G = G_; c = c_; }
    __host__ __device__ bool next(int i, Unit& u) const {
        const long L = (long)i * G + c; if (L >= nwg) return false;
        int wgid = (int)L; { const int q = nwg / NXCD, r = nwg % NXCD, xcd = wgid % NXCD, off = wgid / NXCD; wgid = (xcd < r ? xcd * (q + 1) : r * (q + 1) + (xcd - r) * q) + off; }
        const int nig = WGM * nN, gid = wgid / nig, fm = gid * WGM, gsz = (nM - fm) < WGM ? (nM - fm) : WGM;
        u.pm = fm + ((wgid % nig) % gsz); u.pn = (wgid % nig) / gsz; return true;
    }
    __device__ __forceinline__ void a_ready(const Unit&) const {}
    __device__ __forceinline__ void done(const Unit&) const {}
};

__device__ __forceinline__ unsigned cvt_pk_bf16(float lo, float hi) { unsigned r; asm volatile("v_cvt_pk_bf16_f32 %0, %1, %2" : "=v"(r) : "v"(lo), "v"(hi)); return r; }
typedef float f32x2 __attribute__((ext_vector_type(2)));
__device__ __forceinline__ f32x2 gelu_pk(f32x2 v) {
    const f32x2 av = __builtin_elementwise_abs(v), d = av * 0.2316418882f + 1.0f;
    f32x2 t; t.x = __builtin_amdgcn_rcpf(d.x); t.y = __builtin_amdgcn_rcpf(d.y);
    f32x2 q = t * 0.5307027145f + (-0.7265760135f); q = q * t + 0.7107068705f; q = q * t + (-0.142248368f); q = q * t + 0.127414796f; q = q * t;
    const f32x2 s = (v * v) * (-0.72134752044f);
    f32x2 e; e.x = __builtin_amdgcn_exp2f(s.x); e.y = __builtin_amdgcn_exp2f(s.y);
    const f32x2 m = v * (q * e), r = v - m;
    f32x2 o; o.x = v.x < 0.f ? m.x : r.x; o.y = v.y < 0.f ? m.y : r.y; return o;
}

template <int ACT  > struct EpiBf16 {
    static constexpr bool PERM = true, AFTER_DRAIN = false; static_assert(ACT == 0 || ACT == 1 || ACT == 2, "EpiBf16: ACT 0 none, 1 gelu, 2 relu^2");
    bf16_t* O; int ldc; const float* bias; int split_cols; size_t split_stride; float scale0;
    __device__ __forceinline__ void operator()(const f32x4 (&acc)[2][2][4][2], const Unit& u, int wr, int wc, int fr, int fq) const {
        const int row0 = u.pm * BM + wr * 64 + fr; int colt = u.pn * BM; bf16_t* base = O;
        float sc = 1.f; if (split_cols) { const int t = colt / split_cols; base += (size_t)t * split_stride; colt -= t * split_cols; if (t == 0) sc = scale0; }
        const int col0 = colt + wc * 32 + 8 * fq, bcol0 = u.pn * BM + wc * 32 + 8 * fq;
        f32x4 bv[2][2];
#pragma unroll
        for (int bj = 0; bj < 2; ++bj)
#pragma unroll
            for (int n = 0; n < 2; ++n) bv[bj][n] = bias ? *(const f32x4*)(bias + bcol0 + bj * HALF + 4 * n) : (f32x4){0.f, 0.f, 0.f, 0.f};
#pragma unroll
        for (int ai = 0; ai < 2; ++ai)
#pragma unroll
            for (int m = 0; m < 4; ++m) { bf16_t* rowp = base + (size_t)(row0 + ai * HALF + m * 16) * ldc + col0;
#pragma unroll
                for (int bj = 0; bj < 2; ++bj) { f32x4 v0 = acc[ai][bj][m][0] + bv[bj][0], v1 = acc[ai][bj][m][1] + bv[bj][1];
                    if (ACT == 1) { f32x2 a = gelu_pk((f32x2){v0[0], v0[1]}), b = gelu_pk((f32x2){v0[2], v0[3]}), c = gelu_pk((f32x2){v1[0], v1[1]}), d = gelu_pk((f32x2){v1[2], v1[3]});
                        v0 = (f32x4){a.x, a.y, b.x, b.y}; v1 = (f32x4){c.x, c.y, d.x, d.y}; }
                    if (ACT == 2) { _Pragma("unroll") for (int q_ = 0; q_ < 4; ++q_) { const float a0_ = v0[q_] > 0.f ? v0[q_] : 0.f, a1_ = v1[q_] > 0.f ? v1[q_] : 0.f; v0[q_] = a0_ * a0_; v1[q_] = a1_ * a1_; } }
                    v0 = v0 * sc; v1 = v1 * sc; u32x4 w; w.x = cvt_pk_bf16(v0[0], v0[1]); w.y = cvt_pk_bf16(v0[2], v0[3]); w.z = cvt_pk_bf16(v1[0], v1[1]); w.w = cvt_pk_bf16(v1[2], v1[3]);
                    *(u32x4*)(rowp + bj * HALF) = w; } }
    }
};

template <class Epi, class Sched, bool ALIGN_EPI = false, bool SP2 = false>
__device__ __forceinline__ void gemm_phase(PG8_LAS unsigned char* lds, const Gemm g, const Sched& S, const Epi& E) {
    int tid_ = threadIdx.x; asm volatile("" : "+v"(tid_)); const int tid = tid_, wid = __builtin_amdgcn_readfirstlane(tid >> 6), lane = tid & 63, wr = wid >> 2, wc = wid & 3, fr = lane & 15, fq = lane >> 4;
    const int K = g.K, nt = K / BK;
    unsigned voffA[2], voffB[2];
#pragma unroll
    for (int i = 0; i < 2; ++i) { int R, C; stage_rc(tid * 16 + i * 8192, R, C); const int Rb = Epi::PERM ? ((R & ~31) + perm32(R & 31)) : R;
        voffA[i] = (unsigned)(R * K + C) * 2u; voffB[i] = (unsigned)(Rb * K + C) * 2u; }
    const size_t kstep = (size_t)(BK * 2);
    const size_t hstep = (size_t)HALF * K * 2;
    const size_t tstep = 2 * hstep;
    const unsigned ldsw = (unsigned)wid * 1024u;
    const int aoff = lds_byte(wr * 64 + fr, fq * 8), boff = lds_byte(wc * 32 + fr, fq * 8);
#define PG8_SA(b, h) (((b) * 2 + (h)) * HTB)
#define PG8_SB(b, h) ((4 + (b) * 2 + (h)) * HTB)
#define PG8_STAGE(bufoff, gbase, voff) do { _Pragma("unroll") for (int _i = 0; _i < 2; ++_i) \
        __builtin_amdgcn_global_load_lds((const unsigned*)((const char*)(gbase) + (voff)[_i]), (PG8_LAS unsigned*)(lds + (bufoff) + ldsw + _i * 8192), 16, 0, 0); } while (0)
#define PG8_LDA(dst, b, h) do { _Pragma("unroll") for (int m = 0; m < 4; ++m) _Pragma("unroll") for (int k = 0; k < 2; ++k) dst[m][k] = *(const PG8_LAS bf16x8*)(lds + PG8_SA(b, h) + aoff + m * 2048 + k * 1024); } while (0)
#define PG8_LDB(dst, b, h) do { _Pragma("unroll") for (int n = 0; n < 2; ++n) _Pragma("unroll") for (int k = 0; k < 2; ++k) dst[n][k] = *(const PG8_LAS bf16x8*)(lds + PG8_SB(b, h) + boff + n * 2048 + k * 1024); } while (0)
#define PG8_MMA(ai, bj, At, Bt) do { __builtin_amdgcn_s_setprio(1); _Pragma("unroll") for (int m = 0; m < 4; ++m) _Pragma("unroll") for (int n = 0; n < 2; ++n) _Pragma("unroll") for (int k = 0; k < 2; ++k) \
        acc[ai][bj][m][n] = __builtin_amdgcn_mfma_f32_16x16x32_bf16(Bt[n][k], At[m][k], acc[ai][bj][m][n], 0, 0, 0); __builtin_amdgcn_s_setprio(0); } while (0)
#define PG8_WAIT_V(n) asm volatile("s_waitcnt vmcnt(" #n ")" ::: "memory")
#define PG8_WAIT_L(n) asm volatile("s_waitcnt lgkmcnt(" #n ")" ::: "memory")
#define PG8_BAR __builtin_amdgcn_s_barrier()
#define PG8_SCHED __builtin_amdgcn_sched_barrier(0)
    Unit cur, nxt; int ui = 0;
    if (!S.next(0, cur)) return;
    f32x4 acc[2][2][4][2];
#pragma unroll
    for (int a = 0; a < 2; ++a)
#pragma unroll
        for (int b = 0; b < 2; ++b)
#pragma unroll
            for (int m = 0; m < 4; ++m)
#pragma unroll
                for (int n = 0; n < 2; ++n) acc[a][b][m][n] = (f32x4){0.f, 0.f, 0.f, 0.f};
    bf16x8 At[4][2], B0[2][2], B1[2][2];
    const char* cA = (const char*)g.A + (size_t)cur.pm * tstep; const char* cB = (const char*)g.Bt + (size_t)cur.pn * tstep;
    S.a_ready(cur);
    if constexpr (SP2) {
        PG8_STAGE(PG8_SB(0, 0), cB, voffB); PG8_STAGE(PG8_SB(0, 1), cB + hstep, voffB); PG8_STAGE(PG8_SA(0, 0), cA, voffA); PG8_STAGE(PG8_SA(0, 1), cA + hstep, voffA);
        if (wr == 1) PG8_BAR;
        PG8_WAIT_V(2); PG8_BAR;
        PG8_STAGE(PG8_SB(1, 0), cB + kstep, voffB); PG8_STAGE(PG8_SA(1, 0), cA + kstep, voffA); PG8_STAGE(PG8_SB(1, 1), cB + hstep + kstep, voffB);
        PG8_WAIT_V(6); PG8_BAR;
    } else {
        PG8_STAGE(PG8_SB(0, 0), cB, voffB); PG8_STAGE(PG8_SA(0, 0), cA, voffA); PG8_STAGE(PG8_SB(0, 1), cB + hstep, voffB); PG8_STAGE(PG8_SA(0, 1), cA + hstep, voffA);
        if (wr == 1) PG8_BAR;
        PG8_WAIT_V(4); PG8_BAR;
        PG8_STAGE(PG8_SB(1, 0), cB + kstep, voffB); PG8_STAGE(PG8_SA(1, 0), cA + kstep, voffA); PG8_STAGE(PG8_SB(1, 1), cB + hstep + kstep, voffB);
        PG8_WAIT_V(6); PG8_BAR;
    }
    for (;;) {
        const bool has_next = S.next(ui + 1, nxt);
        const char* nA = has_next ? (const char*)g.A + (size_t)nxt.pm * tstep : cA; const char* nB = has_next ? (const char*)g.Bt + (size_t)nxt.pn * tstep : cB;
        for (int t = 0; t < nt; t += 2) {
            const bool last = (t == nt - 2);
            const char* a1 = cA + (size_t)(t + 1) * kstep;
            const char* a2 = last ? nA : cA + (size_t)(t + 2) * kstep; const char* b2 = last ? nB : cB + (size_t)(t + 2) * kstep;
            const char* a3 = a2 + kstep; const char* b3 = b2 + kstep;
            if (last && has_next) S.a_ready(nxt);
            if constexpr (SP2) {
            PG8_LDB(B0, 0, 0); PG8_LDB(B1, 0, 1); PG8_SCHED; PG8_LDA(At, 0, 0); PG8_STAGE(PG8_SA(1, 1), a1 + hstep, voffA);
            PG8_WAIT_V(8); PG8_WAIT_L(0); PG8_BAR; PG8_MMA(0, 0, At, B0); PG8_MMA(0, 1, At, B1); PG8_BAR; PG8_SCHED;
            PG8_LDA(At, 0, 1); PG8_STAGE(PG8_SB(0, 0), b2, voffB); PG8_STAGE(PG8_SB(0, 1), b2 + hstep, voffB); PG8_STAGE(PG8_SA(0, 0), a2, voffA);
            PG8_WAIT_V(8); PG8_WAIT_L(0); PG8_BAR; PG8_MMA(1, 0, At, B0); PG8_MMA(1, 1, At, B1); PG8_BAR; PG8_SCHED;
            PG8_LDB(B0, 1, 0); PG8_LDB(B1, 1, 1); PG8_SCHED; PG8_LDA(At, 1, 0); PG8_STAGE(PG8_SA(0, 1), a2 + hstep, voffA);
            PG8_WAIT_V(8); PG8_WAIT_L(0); PG8_BAR; PG8_MMA(0, 0, At, B0); PG8_MMA(0, 1, At, B1); PG8_BAR; PG8_SCHED;
            PG8_LDA(At, 1, 1); PG8_STAGE(PG8_SB(1, 0), b3, voffB); PG8_STAGE(PG8_SB(1, 1), b3 + hstep, voffB); PG8_STAGE(PG8_SA(1, 0), a3, voffA);
            PG8_WAIT_V(8); PG8_WAIT_L(0); PG8_BAR; PG8_MMA(1, 0, At, B0); PG8_MMA(1, 1, At, B1); PG8_BAR; PG8_SCHED;
            } else {
            PG8_LDB(B0, 0, 0); PG8_SCHED; PG8_LDA(At, 0, 0); PG8_STAGE(PG8_SA(1, 1), a1 + hstep, voffA);
            PG8_WAIT_L(8); PG8_BAR; PG8_WAIT_L(0); PG8_MMA(0, 0, At, B0); PG8_BAR; PG8_SCHED;
            PG8_LDB(B1, 0, 1); PG8_STAGE(PG8_SB(0, 0), b2, voffB);
            PG8_BAR; PG8_WAIT_L(0); PG8_MMA(0, 1, At, B1); PG8_BAR;
            PG8_LDA(At, 0, 1); PG8_STAGE(PG8_SA(0, 0), a2, voffA);
            PG8_BAR; PG8_WAIT_L(0); PG8_MMA(1, 0, At, B0); PG8_BAR; PG8_SCHED;
            PG8_STAGE(PG8_SB(0, 1), b2 + hstep, voffB);
            PG8_WAIT_V(6); PG8_BAR; PG8_MMA(1, 1, At, B1); PG8_BAR;
            PG8_LDB(B0, 1, 0); PG8_SCHED; PG8_LDA(At, 1, 0); PG8_STAGE(PG8_SA(0, 1), a2 + hstep, voffA);
            PG8_WAIT_L(8); PG8_BAR; PG8_WAIT_L(0); PG8_MMA(0, 0, At, B0); PG8_BAR; PG8_SCHED;
            PG8_LDB(B1, 1, 1); PG8_STAGE(PG8_SB(1, 0), b3, voffB);
            PG8_BAR; PG8_WAIT_L(0); PG8_MMA(0, 1, At, B1); PG8_BAR;
            PG8_LDA(At, 1, 1); PG8_STAGE(PG8_SA(1, 0), a3, voffA);
            PG8_BAR; PG8_WAIT_L(0); PG8_MMA(1, 0, At, B0); PG8_BAR; PG8_SCHED;
            PG8_STAGE(PG8_SB(1, 1), b3 + hstep, voffB);
            PG8_WAIT_V(6); PG8_BAR; PG8_MMA(1, 1, At, B1); PG8_BAR;
            }
        }
        if constexpr (ALIGN_EPI) { if (wr == 0) PG8_BAR; }
        if constexpr (!Epi::AFTER_DRAIN) { E(acc, cur, wr, wc, fr, fq); S.done(cur); }
        if (!has_next) break;
#pragma unroll
        for (int a = 0; a < 2; ++a)
#pragma unroll
            for (int b = 0; b < 2; ++b)
#pragma unroll
                for (int m = 0; m < 4; ++m)
#pragma unroll
                    for (int n = 0; n < 2; ++n) acc[a][b][m][n] = (f32x4){0.f, 0.f, 0.f, 0.f};
        cur = nxt; cA = nA; cB = nB; ++ui;
        if constexpr (ALIGN_EPI) { if (wr == 1) PG8_BAR; }
    }
    PG8_WAIT_V(0);
    if constexpr (!ALIGN_EPI) { if (wr == 0) PG8_BAR; }
    PG8_BAR;
    if constexpr (Epi::AFTER_DRAIN) { E.fused(acc, cur, wr, wc, fr, fq, lds, wid, lane); S.done(cur); }
#undef PG8_SA
#undef PG8_SB
#undef PG8_STAGE
#undef PG8_LDA
#undef PG8_LDB
#undef PG8_MMA
#undef PG8_WAIT_V
#undef PG8_WAIT_L
#undef PG8_BAR
#undef PG8_SCHED
}
}

#ifndef PG8_SP2
#define PG8_SP2 true
#endif
#ifndef PG8_ALIGN
#define PG8_ALIGN true
#endif
#include <hip/hip_bf16.h>
#include <cmath>
namespace attn_body {
using bf16=__hip_bfloat16;
using bf16x8=__attribute__((ext_vector_type(8)))short;
using s16x4=__attribute__((ext_vector_type(4)))short;
using f32x16=__attribute__((ext_vector_type(16)))float;
using u32x4=__attribute__((ext_vector_type(4)))unsigned;
constexpr int D=64;
constexpr int NW=8,QBLK=32,QB=QBLK*NW,KVBLK=64;
__device__ __forceinline__ int crow(int r,int hi){return (r&3)+8*(r>>2)+4*hi;}
#define SBAR() __builtin_amdgcn_sched_barrier(0)
__device__ __forceinline__ void cmask(f32x16&p0,f32x16&p1,int jb,int qrel,int hi){
  const float NEG=-INFINITY; int kb=64*jb+4*hi;
  #pragma unroll
  for(int r=0;r<16;++r){int kv=kb+(r&3)+8*(r>>2); if(kv>qrel)p0[r]=NEG; if(kv+32>qrel)p1[r]=NEG;}
}

constexpr int NSLOT=3, SLOTB=8192;
constexpr int LDS_K=0, LDS_V=NSLOT*SLOTB, LDS_WS=2*NSLOT*SLOTB, LDS_OST=LDS_WS+NW*64*4, LDS_BYTES=LDS_OST+NW*4096;
constexpr float C2=0.125f*1.4426950408889634f;
__device__ __forceinline__ void glds16(const void*gsrc,unsigned lds_dst){unsigned keep;
  asm volatile("s_mov_b32 %0, m0\n\ts_mov_b32 m0, %2\n\ts_nop 0\n\tglobal_load_lds_dwordx4 %1, off\n\ts_mov_b32 m0, %0":"=&s"(keep):"v"(gsrc),"s"(lds_dst):"memory");}
__device__ __forceinline__ float max3f(float a,float b,float c){float r;asm("v_max3_f32 %0, %1, %2, %3":"=v"(r):"v"(a),"v"(b),"v"(c));return r;}
__device__ __forceinline__ float max2f(float a,float b){float r;asm("v_max_f32_e32 %0, %1, %2":"=v"(r):"v"(a),"v"(b));return r;}
__device__ __forceinline__ float fadd_s(float a,float b){float r;asm("v_add_f32_e32 %0, %1, %2":"=v"(r):"v"(a),"v"(b));return r;}
__device__ __forceinline__ float fsub_s(float a,float b){float r;asm("v_sub_f32_e32 %0, %1, %2":"=v"(r):"v"(a),"v"(b));return r;}
typedef float f32x2_t __attribute__((ext_vector_type(2))); typedef __bf16 bf16x2_t __attribute__((ext_vector_type(2)));
__device__ __forceinline__ unsigned cvtpk_s(float lo,float hi){f32x2_t v={lo,hi};bf16x2_t b=__builtin_convertvector(v,bf16x2_t);return __builtin_bit_cast(unsigned,b);}
#define WAIT_BAR(N) asm volatile("s_waitcnt vmcnt(" #N ") lgkmcnt(0)\n\ts_barrier":::"memory")

__device__ __forceinline__ void qkt(f32x16&p0,f32x16&p1,const char*Kslot,const bf16x8*qr,const f32x16&negm,int r32,int hi){
  const char*kb=Kslot+hi*1024+r32*16;
  #pragma unroll
  for(int d0=0;d0<4;++d0){
    const bf16x8 b0=*reinterpret_cast<const bf16x8*>(kb+d0*2048);
    const bf16x8 b1=*reinterpret_cast<const bf16x8*>(kb+d0*2048+512);
    if(d0==0){p0=__builtin_amdgcn_mfma_f32_32x32x16_bf16(b0,qr[0],negm,0,0,0);p1=__builtin_amdgcn_mfma_f32_32x32x16_bf16(b1,qr[0],negm,0,0,0);}
    else{p0=__builtin_amdgcn_mfma_f32_32x32x16_bf16(b0,qr[d0],p0,0,0,0);p1=__builtin_amdgcn_mfma_f32_32x32x16_bf16(b1,qr[d0],p1,0,0,0);}}
}
typedef __attribute__((address_space(3))) const char* lds_cptr;
typedef short v4i16_t __attribute__((ext_vector_type(4)));
__device__ __forceinline__ void kload8(bf16x8*kf,lds_cptr kp){
  kf[0]=*(const __attribute__((address_space(3))) bf16x8*)(kp);      kf[1]=*(const __attribute__((address_space(3))) bf16x8*)(kp+512);
  kf[2]=*(const __attribute__((address_space(3))) bf16x8*)(kp+2048); kf[3]=*(const __attribute__((address_space(3))) bf16x8*)(kp+2560);
  kf[4]=*(const __attribute__((address_space(3))) bf16x8*)(kp+4096); kf[5]=*(const __attribute__((address_space(3))) bf16x8*)(kp+4608);
  kf[6]=*(const __attribute__((address_space(3))) bf16x8*)(kp+6144); kf[7]=*(const __attribute__((address_space(3))) bf16x8*)(kp+6656);
}
__device__ __forceinline__ void kload2(bf16x8*kf,lds_cptr kp,int j){ kf[2*j]=*(const __attribute__((address_space(3))) bf16x8*)(kp+j*2048); kf[2*j+1]=*(const __attribute__((address_space(3))) bf16x8*)(kp+j*2048+512); }
__device__ __forceinline__ s16x4 vtr(lds_cptr p){ return __builtin_bit_cast(s16x4,__builtin_amdgcn_ds_read_tr16_b64_v4i16((__attribute__((address_space(3))) v4i16_t*)p)); }
__device__ __forceinline__ float rowmax(const f32x16&p0,const f32x16&p1){
  float a=max3f(p0[0],p0[1],p1[0]),b=max3f(p0[2],p0[3],p1[1]);a=max3f(a,p1[2],p1[3]);
  #pragma unroll
  for(int r=4;r<16;r+=4){a=max3f(a,p0[r],p0[r+1]);b=max3f(b,p0[r+2],p0[r+3]);a=max3f(a,p1[r],p1[r+1]);b=max3f(b,p1[r+2],p1[r+3]);}
  const float m=max2f(a,b);
  auto rr=__builtin_amdgcn_permlane32_swap(__float_as_uint(m),__float_as_uint(m),false,false);
  return max2f(__uint_as_float(rr[0]),__uint_as_float(rr[1]));
}
__device__ __forceinline__ void pv(f32x16*o,int vb,bf16x8 pa0,bf16x8 pa1,bf16x8 pa2,bf16x8 pa3){
  #pragma unroll
  for(int d0=0;d0<2;++d0){s16x4 lo[4],hi[4];
    #pragma unroll
    for(int ks=0;ks<4;++ks){
      asm volatile("ds_read_b64_tr_b16 %0,%1 offset:%c2":"=&v"(lo[ks]):"v"(vb),"i"(d0*4096+ks*1024):"memory");
      asm volatile("ds_read_b64_tr_b16 %0,%1 offset:%c2":"=&v"(hi[ks]):"v"(vb),"i"(d0*4096+ks*1024+512):"memory");}
    asm volatile("s_waitcnt lgkmcnt(0)":::"memory");SBAR();
    #define PK(k) (bf16x8){lo[k][0],lo[k][1],lo[k][2],lo[k][3],hi[k][0],hi[k][1],hi[k][2],hi[k][3]}
    o[d0]=__builtin_amdgcn_mfma_f32_32x32x16_bf16(pa0,PK(0),o[d0],0,0,0);
    o[d0]=__builtin_amdgcn_mfma_f32_32x32x16_bf16(pa1,PK(1),o[d0],0,0,0);
    o[d0]=__builtin_amdgcn_mfma_f32_32x32x16_bf16(pa2,PK(2),o[d0],0,0,0);
    o[d0]=__builtin_amdgcn_mfma_f32_32x32x16_bf16(pa3,PK(3),o[d0],0,0,0);
    #undef PK
  }
}

#ifndef ATTN_STORE16
#define ATTN_STORE16(p,v) (*(u32x4*)(p)=(v))
#endif
template<int THRL> __device__ __forceinline__ void attn_unit(int qb,int SEQ,const bf16*Q,int QP,const bf16*__restrict__ K,const bf16*__restrict__ V,int KP,bf16*O,int OP,char*shm){
  int tid_=threadIdx.x; asm volatile("":"+v"(tid_)); const int tid=tid_,lane=tid&63,r32=lane&31,hi=lane>>5; const int wid=__builtin_amdgcn_readfirstlane(tid>>6);
  const int q0=qb*QB;
  const bf16*Qw=Q+(long)(q0+wid*QBLK)*QP;
  const bf16*Kh=K,*Vh=V;
  const unsigned lds0=(unsigned)(uintptr_t)shm;
  float*wsf=(float*)(shm+LDS_WS)+wid*64;
  const bf16*ksrc=Kh+(long)lane*KP+wid*8;
  const bf16*vsrc=Vh+(long)(16*(wid&3)+(lane>>2))*KP+(wid>>2)*32+(lane&3)*8;
  const unsigned kdst=lds0+LDS_K+wid*1024, vdst=lds0+LDS_V+wid*1024;
  #define DMA_K(t,slot) glds16(ksrc+(long)(t)*KVBLK*KP,(unsigned)__builtin_amdgcn_readfirstlane(kdst+(slot)))
  #define DMA_V(t,slot) glds16(vsrc+(long)(t)*KVBLK*KP,(unsigned)__builtin_amdgcn_readfirstlane(vdst+(slot)))
  const int vb0=(int)(lds0+LDS_V)+((lane>>4)&1)*32+(lane&3)*8+(4*hi+((lane&15)>>2))*64;
  const char*Kbase=shm+LDS_K; bf16x8 kf[8];
  const lds_cptr shm3=(lds_cptr)shm; const lds_cptr kp0=shm3+LDS_K+hi*1024+r32*16; const lds_cptr vp0=shm3+LDS_V+((lane>>4)&1)*32+(lane&3)*8+(4*hi+((lane&15)>>2))*64;
  const int NT=SEQ/KVBLK;
  DMA_K(0,0);DMA_V(0,0);DMA_K(1,SLOTB);
  bf16x8 qr[4];
  #pragma unroll
  for(int d0=0;d0<4;++d0)qr[d0]=*reinterpret_cast<const bf16x8*>(&Qw[(long)r32*QP+d0*16+hi*8]);
  float mhat=0.f,l_reg=0.f;f32x16 o[2];o[0]=f32x16{};o[1]=f32x16{};f32x16 negm=f32x16{};asm volatile("":"+v"(negm));
  const int qrel=wid*QBLK+r32;
  #define CMASK(P0,P1,t) do{}while(0)
  bool resc=false;
  #define START(P0,P1) do{ const float rm=rowmax(P0,P1); resc=false; \
    { const float dl=rm; mhat=fadd_s(mhat,dl); \
      _Pragma("unroll") for(int r=0;r<16;++r){P0[r]=fsub_s(P0[r],dl);P1[r]=fsub_s(P1[r],dl);} \
      _Pragma("unroll") for(int r=0;r<16;++r)negm[r]=-mhat; asm volatile("":"+v"(negm)); } \
    _Pragma("unroll") for(int r=0;r<16;++r)P0[r]=__builtin_amdgcn_exp2f(P0[r]); }while(0)
  #define RESC() do{ if(resc){ asm volatile("s_waitcnt lgkmcnt(0)":::"memory"); \
      _Pragma("unroll") for(int d_=0;d_<2;++d_) _Pragma("unroll") for(int r=0;r<16;++r)o[d_][r]*=wsf[crow(r,hi)]; } }while(0)
  f32x16 pA0,pA1,pB0,pB1;
  int sl_prev=0,sl_cur=0,sl_next=SLOTB;
  #define ROT() do{sl_prev=sl_cur;sl_cur=sl_next;sl_next=(sl_next==(NSLOT-1)*SLOTB)?0:sl_next+SLOTB;}while(0)
  DMA_K(2,2*SLOTB);
  WAIT_BAR(3);
  qkt(pA0,pA1,Kbase,qr,negm,r32,hi);asm volatile("s_nop 15\n\ts_nop 7":"+v"(pA0),"+v"(pA1));CMASK(pA0,pA1,0);
  START(pA0,pA1);
  _Pragma("unroll") for(int r=0;r<16;++r)pA1[r]=__builtin_amdgcn_exp2f(pA1[r]);
  WAIT_BAR(0);
  DMA_K(3,0);DMA_V(1,SLOTB);
  ROT();
  kload8(kf,kp0+sl_cur);
  WAIT_BAR(2);
  s16x4 vlo[8],vhi[8]; u32x4 pw0,pw1,pw2,pw3;
  #define PKW(P,B) cvtpk_s(P[B],P[B+1])
  #define PAF(k) __builtin_bit_cast(bf16x8,pw##k)
  #define VFR(i) (bf16x8){vlo[i][0],vlo[i][1],vlo[i][2],vlo[i][3],vhi[i][0],vhi[i][1],vhi[i][2],vhi[i][3]}
  #define PIN(x) asm volatile("":"+v"(x))
  #define MX3(a,b,c) __builtin_fmaxf(__builtin_fmaxf((a),(b)),(c))
  #define GAPA(MF,A0,A1,A2,A3,W0,W1,PW) do{ MF; sacc+=A0; sacc+=A1; sacc+=A2; sacc+=A3; PIN(sacc); W0; W1; PIN(PW); SBAR(); }while(0)
  #define EX(v) __builtin_amdgcn_exp2f(v)
  #define GAPB(MF,X,B) do{ MF; X[B]=EX(X[B]); X[B+1]=EX(X[B+1]); X[B+2]=EX(X[B+2]); X[B+3]=EX(X[B+3]); PIN(X); SBAR(); }while(0)
  #define VRD(i) do{ vlo[i]=vtr(vp_+(((i)>>2)*4096+((i)&3)*1024)); vhi[i]=vtr(vp_+(((i)>>2)*4096+((i)&3)*1024+512)); }while(0)
  #define KRD(G,j) do{ if(G){ kload2(kf,kp0+sl_next,j); SBAR(); } }while(0)
  #define STEP(C0,C1,P0,P1,t,GK,GV,GL) do{ SBAR(); \
    const lds_cptr vp_=vp0+sl_prev; \
    VRD(0); SBAR(); float sacc=(P0[0]+P0[1]); \
    GAPA(C0=__builtin_amdgcn_mfma_f32_32x32x16_bf16(kf[0],qr[0],negm,0,0,0), P0[2],P0[3],P0[4],P0[5],     pw0[0]=PKW(P0,0), pw0[1]=PKW(P0,2), pw0); \
    VRD(4); SBAR(); GAPA(C1=__builtin_amdgcn_mfma_f32_32x32x16_bf16(kf[1],qr[0],negm,0,0,0), P0[6],P0[7],P0[8],P0[9],     pw0[2]=PKW(P0,4), pw0[3]=PKW(P0,6), pw0); \
    VRD(1); SBAR(); GAPA(C0=__builtin_amdgcn_mfma_f32_32x32x16_bf16(kf[2],qr[1],C0,0,0,0),   P0[10],P0[11],P0[12],P0[13], pw1[0]=PKW(P0,8), pw1[1]=PKW(P0,10), pw1); \
    VRD(5); SBAR(); GAPA(C1=__builtin_amdgcn_mfma_f32_32x32x16_bf16(kf[3],qr[1],C1,0,0,0),   P0[14],P0[15],P1[0],P1[1],   pw1[2]=PKW(P0,12),pw1[3]=PKW(P0,14), pw1); \
    VRD(2); SBAR(); GAPA(C0=__builtin_amdgcn_mfma_f32_32x32x16_bf16(kf[4],qr[2],C0,0,0,0),   P1[2],P1[3],P1[4],P1[5],     pw2[0]=PKW(P1,0), pw2[1]=PKW(P1,2), pw2); \
    VRD(6); SBAR(); GAPA(C1=__builtin_amdgcn_mfma_f32_32x32x16_bf16(kf[5],qr[2],C1,0,0,0),   P1[6],P1[7],P1[8],P1[9],     pw2[2]=PKW(P1,4), pw2[3]=PKW(P1,6), pw2); \
    VRD(3); SBAR(); GAPA(C0=__builtin_amdgcn_mfma_f32_32x32x16_bf16(kf[6],qr[3],C0,0,0,0),   P1[10],P1[11],P1[12],P1[13], pw3[0]=PKW(P1,8), pw3[1]=PKW(P1,10), pw3); \
    VRD(7); SBAR(); GAPA(C1=__builtin_amdgcn_mfma_f32_32x32x16_bf16(kf[7],qr[3],C1,0,0,0),   P1[14],P1[15],0.f,0.f,       pw3[2]=PKW(P1,12),pw3[3]=PKW(P1,14), pw3); \
    l_reg+=sacc; \
    if(GK){DMA_K((t)+3,sl_cur);} if(GV){DMA_V((t)+1,sl_next);} \
    CMASK(C0,C1,t); \
    { float a=MX3(C0[0],C0[1],C1[0]),b=MX3(C0[2],C0[3],C1[1]); a=MX3(a,C1[2],C1[3]); \
      _Pragma("unroll") for(int r=4;r<16;r+=4){a=MX3(a,C0[r],C0[r+1]);b=MX3(b,C0[r+2],C0[r+3]);a=MX3(a,C1[r],C1[r+1]);b=MX3(b,C1[r+2],C1[r+3]);} \
      float rm=__builtin_fmaxf(a,b); { auto rr=__builtin_amdgcn_permlane32_swap(__float_as_uint(rm),__float_as_uint(rm),false,false); rm=__builtin_fmaxf(__uint_as_float(rr[0]),__uint_as_float(rr[1])); } \
      resc=false; \
      if(__builtin_expect(__any(rm>(float)THRL),0)){ const float dl=__builtin_fmaxf(rm,0.f); mhat+=dl; \
        _Pragma("unroll") for(int r=0;r<16;++r){C0[r]-=dl;C1[r]-=dl;} \
        _Pragma("unroll") for(int r=0;r<16;++r)negm[r]=-mhat; asm volatile("":"+v"(negm)); \
        const float f=__builtin_amdgcn_exp2f(-dl); l_reg*=f; if(hi==0)wsf[r32]=f; resc=true; } } \
    SBAR(); \
    GAPB(o[0]=__builtin_amdgcn_mfma_f32_32x32x16_bf16(PAF(0),VFR(0),o[0],0,0,0), C0,0); \
    GAPB(o[1]=__builtin_amdgcn_mfma_f32_32x32x16_bf16(PAF(0),VFR(4),o[1],0,0,0), C0,4); \
    KRD(GL,0); GAPB(o[0]=__builtin_amdgcn_mfma_f32_32x32x16_bf16(PAF(1),VFR(1),o[0],0,0,0), C0,8); \
    KRD(GL,1); GAPB(o[1]=__builtin_amdgcn_mfma_f32_32x32x16_bf16(PAF(1),VFR(5),o[1],0,0,0), C0,12); \
    KRD(GL,2); GAPB(o[0]=__builtin_amdgcn_mfma_f32_32x32x16_bf16(PAF(2),VFR(2),o[0],0,0,0), C1,0); \
    KRD(GL,3); GAPB(o[1]=__builtin_amdgcn_mfma_f32_32x32x16_bf16(PAF(2),VFR(6),o[1],0,0,0), C1,4); \
    GAPB(o[0]=__builtin_amdgcn_mfma_f32_32x32x16_bf16(PAF(3),VFR(3),o[0],0,0,0), C1,8); \
    GAPB(o[1]=__builtin_amdgcn_mfma_f32_32x32x16_bf16(PAF(3),VFR(7),o[1],0,0,0), C1,12); \
    }while(0)
  int t=1;
  #undef CMASK
  #define CMASK(P0,P1,t) do{}while(0)
  for(;t+5<NT;t+=2){
    STEP(pB0,pB1,pA0,pA1,t,true,true,true);     WAIT_BAR(2); RESC(); ROT();
    STEP(pA0,pA1,pB0,pB1,t+1,true,true,true);   WAIT_BAR(2); RESC(); ROT();
  }
  #undef CMASK
  #define CMASK(P0,P1,t) do{}while(0)
  #define ENDW(tt) do{ if((tt)+3<NT){WAIT_BAR(2);} else if((tt)+2<NT){WAIT_BAR(1);} else {WAIT_BAR(0);} }while(0)
  for(;t+1<NT;t+=2){
    STEP(pB0,pB1,pA0,pA1,t,(t+3<NT),(t+1<NT),(t+1<NT));       ENDW(t);   RESC(); ROT();
    STEP(pA0,pA1,pB0,pB1,t+1,(t+4<NT),(t+2<NT),(t+2<NT));     ENDW(t+1); RESC(); ROT();
  }
  STEP(pB0,pB1,pA0,pA1,NT-1,false,false,false); RESC();
  { float sacc=pB0[0]+pB0[1]; _Pragma("unroll") for(int r=2;r<16;++r)sacc+=pB0[r]; _Pragma("unroll") for(int r=0;r<16;++r)sacc+=pB1[r]; l_reg+=sacc;
    pw0=(u32x4){PKW(pB0,0),PKW(pB0,2),PKW(pB0,4),PKW(pB0,6)};pw1=(u32x4){PKW(pB0,8),PKW(pB0,10),PKW(pB0,12),PKW(pB0,14)};pw2=(u32x4){PKW(pB1,0),PKW(pB1,2),PKW(pB1,4),PKW(pB1,6)};pw3=(u32x4){PKW(pB1,8),PKW(pB1,10),PKW(pB1,12),PKW(pB1,14)};
    SBAR(); pv(o,vb0+sl_cur,PAF(0),PAF(1),PAF(2),PAF(3)); }
  #undef PKW
  #undef PAF
  #undef VFR
  #undef PIN
  #undef MX3
  #undef GAPA
  #undef GAPB
  #undef EX
  #undef VRD
  #undef KRD
  #undef STEP
  #undef ENDW
  {auto rr=__builtin_amdgcn_permlane32_swap(__float_as_uint(l_reg),__float_as_uint(l_reg),false,false);l_reg=__uint_as_float(rr[0])+__uint_as_float(rr[1]);}
  if(hi==0)wsf[32+r32]=l_reg;asm volatile("s_waitcnt lgkmcnt(0)":::"memory");
  float rli[16];
  #pragma unroll
  for(int r=0;r<16;++r)rli[r]=__builtin_amdgcn_rcpf(wsf[32+crow(r,hi)]);
  bf16*Ow=O+(long)(q0+wid*QBLK)*OP;
  { bf16*stg=(bf16*)(shm+LDS_OST)+wid*2048;
    #pragma unroll
    for(int r=0;r<16;++r){const int orow=crow(r,hi);
      #pragma unroll
      for(int d0=0;d0<2;++d0)stg[orow*64+d0*32+r32]=__float2bfloat16(o[d0][r]*rli[r]);}
    asm volatile("s_waitcnt lgkmcnt(0)":::"memory");
    #pragma unroll
    for(int i=0;i<4;++i){const int row=i*8+(lane>>3),ch=lane&7; const u32x4 v=*(const u32x4*)(stg+row*64+ch*8); ATTN_STORE16(Ow+(long)row*OP+ch*8,v);} }
  asm volatile("s_waitcnt lgkmcnt(0)\n\ts_barrier":::"memory");
  #undef DMA_K
  #undef DMA_V
  #undef CMASK
  #undef START
  #undef RESC
  #undef ROT
}
constexpr int ATTN_LDS_BYTES=LDS_BYTES;
#undef SBAR
#undef WAIT_BAR
}
namespace xb {
#define GAS __attribute__((address_space(1)))
#define LAS __attribute__((address_space(3)))
typedef GAS unsigned gu32;
typedef GAS unsigned long long gu64;
#define RLX_AGENT __ATOMIC_RELAXED, __HIP_MEMORY_SCOPE_AGENT
#define LDS_WAIT() asm volatile("s_waitcnt lgkmcnt(0)" ::: "memory")
#define VM_WAIT() asm volatile("s_waitcnt vmcnt(0)" ::: "memory")
__device__ __forceinline__ unsigned long long rt() { return __builtin_amdgcn_s_memrealtime(); }
__device__ __forceinline__ unsigned f2bf(float f) { unsigned u = __builtin_bit_cast(unsigned, f); return (u + 0x7fffu + ((u >> 16) & 1u)) >> 16; }
__device__ __forceinline__ unsigned pk2(float lo, float hi) { return f2bf(lo) | (f2bf(hi) << 16); }

#define XB_TMO      128
#define XB_XCNT(j)  (256  + 64 * (j))
#define XB_XSUB(j)  (1280 + 64 * (j))
#define XB_XGEN(j)  (2304 + 64 * (j))
#define XB_TOP      3328
#define XB_TOPGEN   3392
#define XCD_BAR_WORDS 3456
#define XB_SPIN_CAP (1u << 18)

__device__ __forceinline__ unsigned xb_ld(unsigned* p)              { return __hip_atomic_load(p, __ATOMIC_RELAXED, __HIP_MEMORY_SCOPE_AGENT); }
__device__ __forceinline__ unsigned xb_add(unsigned* p, unsigned v) { return __hip_atomic_fetch_add(p, v, __ATOMIC_RELAXED, __HIP_MEMORY_SCOPE_AGENT); }
__device__ __forceinline__ unsigned xb_xcc_id() { return (unsigned)__builtin_amdgcn_s_getreg((3 << 11) | 20) & 0xFu; }
#define XB_SPIN(cond, bar) do { unsigned _sp = 0; while (cond) { __builtin_amdgcn_s_sleep(1); \
    if ((++_sp & 255u) == 0u) { if (xb_ld(&(bar)[XB_TMO])) break; if (_sp > XB_SPIN_CAP) { atomicAdd(&(bar)[XB_TMO], 1u); break; } } } } while (0)

struct XcdBarrier {
    unsigned* bar; unsigned x;
    volatile LAS unsigned* st;
};

__device__ __forceinline__ XcdBarrier xcd_barrier_post(unsigned* bar, volatile LAS unsigned* st) {
    XcdBarrier b; b.bar = bar; b.x = xb_xcc_id(); b.st = st;
    if (threadIdx.x == 0) (void)xb_add(&bar[XB_XCNT(b.x)], 1u);
    return b;
}
__device__ __forceinline__ void xcd_barrier_complete(unsigned* bar, unsigned x, unsigned& nloc, unsigned& nx) {
    const unsigned G = gridDim.x * gridDim.y * gridDim.z;
    unsigned sum, cnt, mine, sp = 0u;
    for (;;) {
        sum = 0u; cnt = 0u; mine = 0u;
#pragma unroll
        for (unsigned j = 0; j < 16; ++j) { const unsigned c = xb_ld(&bar[XB_XCNT(j)]); sum += c; cnt += (c > 0u) ? 1u : 0u; mine = (j == x) ? c : mine; }
        if (sum == G) break;
        __builtin_amdgcn_s_sleep(1);
        if ((++sp & 255u) == 0u) { if (xb_ld(&bar[XB_TMO])) break; if (sp > XB_SPIN_CAP) { atomicAdd(&bar[XB_TMO], 1u); break; } }
    }
    nloc = mine > 0u ? mine : 1u; nx = cnt > 0u ? cnt : 1u;
}

__device__ __forceinline__ void xcd_barrier(const XcdBarrier& b) {
    asm volatile("s_waitcnt vmcnt(0)" ::: "memory");
    __syncthreads();
    if (threadIdx.x == 0) {
        unsigned* bar = b.bar;
        __builtin_amdgcn_s_waitcnt(0);
        unsigned nloc = b.st[0], nx = b.st[1];
        if (nloc == 0u) { xcd_barrier_complete(bar, b.x, nloc, nx); b.st[0] = nloc; b.st[1] = nx; }
        const unsigned old = xb_add(&bar[XB_XSUB(b.x)], 1u);
        const unsigned gen = old / nloc;
        if (old + 1u == (gen + 1u) * nloc) {
            __builtin_amdgcn_fence(__ATOMIC_RELEASE, "agent");
            asm volatile("s_waitcnt vmcnt(0)" ::: "memory");
            const unsigned og = xb_add(&bar[XB_TOP], 1u);
            const unsigned tg = og / nx;
            if (og + 1u == (tg + 1u) * nx) xb_add(&bar[XB_TOPGEN], 1u);
            else XB_SPIN(xb_ld(&bar[XB_TOPGEN]) == tg, bar);
            __builtin_amdgcn_fence(__ATOMIC_ACQUIRE, "agent");
            xb_add(&bar[XB_XGEN(b.x)], 1u);
            asm volatile("s_waitcnt vmcnt(0)" ::: "memory");
        } else {
            XB_SPIN(xb_ld(&bar[XB_XGEN(b.x)]) == gen, bar);
            __builtin_amdgcn_fence(__ATOMIC_ACQUIRE, "agent");
            asm volatile("s_waitcnt vmcnt(0)" ::: "memory");
        }
    }
    __syncthreads();
}

}

namespace mk {
typedef unsigned short bf16_t;
typedef short bf16x8 __attribute__((ext_vector_type(8)));
typedef float f32x4 __attribute__((ext_vector_type(4)));
typedef unsigned u32x4 __attribute__((ext_vector_type(4)));
typedef unsigned u32x2 __attribute__((ext_vector_type(2)));
typedef float f32x2 __attribute__((ext_vector_type(2)));

constexpr int DMODEL = 1024, TS = 16384, NSEG = 4, DFF = 4096;
constexpr int EIN = 1792, OIN = 4368, OINP = 4608, OOUT = 768;
constexpr float EPS = 1e-6f;
constexpr size_t MiB = (size_t)1 << 20;
constexpr size_t WS_W1T = 1 * MiB, WS_W2T = 33 * MiB, WS_WINE = 65 * MiB, WS_WOUTE = 72 * MiB, WS_WINO = 76 * MiB, WS_WOUTO = 94 * MiB,
                 WS_GW = 97 * MiB, WS_H = 98 * MiB, WS_PROJ = 130 * MiB, WS_SCR = 274 * MiB, WS_END = 512 * MiB;
constexpr size_t SC_HID = 0;
constexpr size_t SC_LA = 0, SC_UU = 64 * MiB, SC_AGG = 128 * MiB;
constexpr size_t SC_QKVP = 0, SC_DNI = 48 * MiB, SC_OB = 192 * MiB, SC_LSE = 224 * MiB, SC_EGL = 225 * MiB;
constexpr int DNI_BYTES = 73728, DNI_W = 0, DNI_QT = 16384, DNI_KTT = 32768, DNI_A = 49152, DNI_U = 57344;
constexpr int LDS_BYTES = 147456;
constexpr int NT = 512, NW = 8;

struct Params { const float* in[25]; float* out; unsigned char* ws; };

__device__ __forceinline__ float bf2f(bf16_t v) { return __uint_as_float(((unsigned)v) << 16); }
__device__ __forceinline__ unsigned f2bf(float f) { unsigned u = __float_as_uint(f); return (u + 0x7fffu + ((u >> 16) & 1u)) >> 16; }
__device__ __forceinline__ unsigned pk2(float lo, float hi) { return f2bf(lo) | (f2bf(hi) << 16); }
__device__ __forceinline__ float wave_sum(float v) {
#pragma unroll
    for (int o = 1; o < 64; o <<= 1) v += __shfl_xor(v, o);
    return v;
}
__device__ __forceinline__ float sigm(float x) { return 1.f / (1.f + __expf(-x)); }
__device__ __forceinline__ float softplus(float x) { return x > 20.f ? x : log1pf(__expf(x)); }
__device__ __forceinline__ float silu(float x) { return x * sigm(x); }
__device__ __forceinline__ float gelu_tanh(float x) { const float t = 0.7978845608028654f * (x + 0.044715f * x * x * x); return 0.5f * x * (1.f + tanhf(t)); }
__device__ __forceinline__ void unpack8(const u32x4 v, float* f) {
    f[0] = __uint_as_float(v.x << 16); f[1] = __uint_as_float(v.x & 0xffff0000u); f[2] = __uint_as_float(v.y << 16); f[3] = __uint_as_float(v.y & 0xffff0000u);
    f[4] = __uint_as_float(v.z << 16); f[5] = __uint_as_float(v.z & 0xffff0000u); f[6] = __uint_as_float(v.w << 16); f[7] = __uint_as_float(v.w & 0xffff0000u);
}
#define MK_IDS() int tid = threadIdx.x; asm volatile("" : "+v"(tid)); const int lane = tid & 63, wave = __builtin_amdgcn_readfirstlane(tid >> 6); const int gw = blockIdx.x * NW + wave, NGW = gridDim.x * NW; (void)lane; (void)wave; (void)gw; (void)NGW
#define MFMA16(a, b, c) __builtin_amdgcn_mfma_f32_16x16x32_bf16((a), (b), (c), 0, 0, 0)

__device__ __forceinline__ void transpose_item(const float* W, int K, int Nsrc, int Npad, bf16_t* WT, float* scr, int item, int lane) {
    const int nblk = Npad / 32, kb = item / nblk, nb = item % nblk, k0 = 64 * kb, n0 = 32 * nb;
    const int n = n0 + (lane & 31);
#pragma unroll 8
    for (int i = 0; i < 32; ++i) { const int kk = 2 * i + (lane >> 5); scr[kk * 33 + (lane & 31)] = (n < Nsrc) ? W[(size_t)(k0 + kk) * Nsrc + n] : 0.f; }
    asm volatile("s_waitcnt lgkmcnt(0)" ::: "memory");
    const int c = lane & 7;
#pragma unroll
    for (int j = 0; j < 4; ++j) { const int nn = (lane >> 3) + 8 * j; const float* s = scr + (8 * c) * 33 + nn;
        u32x4 o; o.x = pk2(s[0 * 33], s[1 * 33]); o.y = pk2(s[2 * 33], s[3 * 33]); o.z = pk2(s[4 * 33], s[5 * 33]); o.w = pk2(s[6 * 33], s[7 * 33]);
        *(u32x4*)(WT + (size_t)(n0 + nn) * K + k0 + 8 * c) = o; }
    asm volatile("s_waitcnt lgkmcnt(0)" ::: "memory");
}
__device__ __forceinline__ void phase_prologue(const Params& p, char* lds) {
    MK_IDS();
    float* scr = (float*)(lds + wave * 16384);
    unsigned char* ws = p.ws;
    constexpr int I_F1 = 16 * 128, I_F2 = 64 * 32, I_IE = 16 * 56, I_OE = 16 * 32, I_IO = 16 * 144, I_OO = 12 * 32;
    constexpr int T_F1 = 4 * I_F1, T_F2 = T_F1 + 4 * I_F2, T_IE = T_F2 + 2 * I_IE, T_OE = T_IE + 2 * I_OE, T_IO = T_OE + 2 * I_IO, T_OO = T_IO + 2 * I_OO;
    for (int it = gw; it < T_OO; it += NGW) {
        if (it < T_F1) { const int l = it / I_F1, r = it % I_F1; transpose_item(p.in[6] + (size_t)l * 1024 * 4096, 1024, 4096, 4096, (bf16_t*)(ws + WS_W1T) + (size_t)l * 4096 * 1024, scr, r, lane); }
        else if (it < T_F2) { const int q = it - T_F1, l = q / I_F2, r = q % I_F2; transpose_item(p.in[7] + (size_t)l * 4096 * 1024, 4096, 1024, 1024, (bf16_t*)(ws + WS_W2T) + (size_t)l * 1024 * 4096, scr, r, lane); }
        else if (it < T_IE) { const int q = it - T_F2, l = q / I_IE, r = q % I_IE; transpose_item(p.in[8] + (size_t)l * 1024 * EIN, 1024, EIN, EIN, (bf16_t*)(ws + WS_WINE) + (size_t)l * EIN * 1024, scr, r, lane); }
        else if (it < T_OE) { const int q = it - T_IE, l = q / I_OE, r = q % I_OE; transpose_item(p.in[9] + (size_t)l * 1024 * 1024, 1024, 1024, 1024, (bf16_t*)(ws + WS_WOUTE) + (size_t)l * 1024 * 1024, scr, r, lane); }
        else if (it < T_IO) { const int q = it - T_OE, l = q / I_IO, r = q % I_IO; transpose_item(p.in[19] + (size_t)l * 1024 * OIN, 1024, OIN, OINP, (bf16_t*)(ws + WS_WINO) + (size_t)l * OINP * 1024, scr, r, lane); }
        else { const int q = it - T_IO, l = q / I_OO, r = q % I_OO; transpose_item(p.in[20] + (size_t)l * OOUT * 1024, OOUT, 1024, 1024, (bf16_t*)(ws + WS_WOUTO) + (size_t)l * 1024 * OOUT, scr, r, lane); }
    }
    bf16_t* GW = (bf16_t*)(ws + WS_GW);
    const int gt = gw * 64 + lane, NGT = NGW * 64;
    for (int idx = gt; idx < 2 * 2 * 2 * 8 * 4096; idx += NGT) {
        const int d = idx & 63, e = (idx >> 6) & 63, blk = (idx >> 12) & 7, gate = (idx >> 15) & 1, dir = (idx >> 16) & 1, j = (idx >> 17) & 1;
        const float* src = gate ? p.in[16] : p.in[14];
        GW[idx] = (bf16_t)f2bf(src[((((size_t)j * 2 + dir) * 8 + blk) * 64 + d) * 64 + e]);
    }
}

__device__ __forceinline__ void phase_rmsnorm_bf16(const float* x, const float* g, bf16_t* h) {
    MK_IDS();
    for (int m = gw; m < TS; m += NGW) {
        const f32x4* xr = (const f32x4*)(x + (size_t)m * DMODEL) + lane; const f32x4* gr = (const f32x4*)g + lane;
        f32x4 v[4]; float s = 0.f;
#pragma unroll
        for (int j = 0; j < 4; ++j) { v[j] = xr[64 * j]; s += (v[j].x * v[j].x + v[j].y * v[j].y) + (v[j].z * v[j].z + v[j].w * v[j].w); }
        const float rstd = 1.f / sqrtf(wave_sum(s) * (1.f / DMODEL) + EPS);
        u32x2* o8 = (u32x2*)(h + (size_t)m * DMODEL) + lane;
#pragma unroll
        for (int j = 0; j < 4; ++j) { const f32x4 gg = gr[64 * j]; u32x2 o; o.x = pk2(v[j].x * rstd * gg.x, v[j].y * rstd * gg.y); o.y = pk2(v[j].z * rstd * gg.z, v[j].w * rstd * gg.w); o8[64 * j] = o; }
    }
}
__device__ __forceinline__ void phase_rmsnorm_final(float* x, const float* g) {
    MK_IDS();
    for (int m = gw; m < TS; m += NGW) {
        f32x4* xr = (f32x4*)(x + (size_t)m * DMODEL) + lane; const f32x4* gr = (const f32x4*)g + lane;
        f32x4 v[4]; float s = 0.f;
#pragma unroll
        for (int j = 0; j < 4; ++j) { v[j] = xr[64 * j]; s += (v[j].x * v[j].x + v[j].y * v[j].y) + (v[j].z * v[j].z + v[j].w * v[j].w); }
        const float rstd = 1.f / sqrtf(wave_sum(s) * (1.f / DMODEL) + EPS);
#pragma unroll
        for (int j = 0; j < 4; ++j) { const f32x4 gg = gr[64 * j]; xr[64 * j] = v[j] * rstd * gg; }
    }
}

struct EpiRes {
    static constexpr bool PERM = false, AFTER_DRAIN = false;
    const float* base; float* out; int ldc;
    __device__ __forceinline__ void operator()(const pg8::f32x4 (&acc)[2][2][4][2], const pg8::Unit& u, int wr, int wc, int fr, int fq) const {
        const int col0 = u.pn * pg8::BM + wc * 32 + 4 * fq;
#pragma unroll
        for (int ai = 0; ai < 2; ++ai)
#pragma unroll
            for (int m = 0; m < 4; ++m) { const size_t off = (size_t)(u.pm * pg8::BM + ai * pg8::HALF + wr * 64 + m * 16 + fr) * ldc + col0;
#pragma unroll
                for (int bj = 0; bj < 2; ++bj)
#pragma unroll
                    for (int n = 0; n < 2; ++n) { const pg8::f32x4 bs = *(const pg8::f32x4*)(base + off + bj * pg8::HALF + n * 16); *(pg8::f32x4*)(out + off + bj * pg8::HALF + n * 16) = bs + acc[ai][bj][m][n]; }
                asm volatile("" ::: "memory"); }
    }
};

__device__ __forceinline__ void even_qk_post(bf16_t* proj, const float* qg, const float* kg, int S) {
    MK_IDS();
    const int d = lane, axis = d >> 5, f = d & 15, half = (d >> 4) & 1;
    const float inv = exp2f(-(float)f * (13.287712379549449f / 16.f));
    const float gq = qg[d], gk = kg[d];
    for (int t = gw; t < TS; t += NGW) {
        const int s = t % S; const int pos = axis ? (s & 63) : (s >> 6);
        const float ang = (float)pos * inv; float sn, cs; sincosf(ang, &sn, &cs);
        bf16_t* row = proj + (size_t)t * EIN;
#pragma unroll
        for (int hh = 0; hh < 10; ++hh) {
            const int c0 = hh < 8 ? hh * 64 : 512 + (hh - 8) * 64;
            const float x = bf2f(row[c0 + d]);
            const float ss = wave_sum(x * x);
            const float y = x * (1.f / sqrtf(ss * (1.f / 64.f) + EPS)) * (hh < 8 ? gq : gk);
            const float pr = __shfl_xor(y, 16);
            float o = y * cs + (half ? pr : -pr) * sn;
            if (hh < 8) o *= attn_body::C2;
            row[c0 + d] = (bf16_t)f2bf(o);
        }
    }
}
__device__ __forceinline__ void even_lru_prep(const bf16_t* proj, const float* cw, const float* cb, const bf16_t* GWj, const float* br, const float* bi, const float* lam,
                                              float* LA, float* UU, f32x2* AGG, int S, char* lds) {
    MK_IDS();
    constexpr int XST = 1040;
    for (int tile = blockIdx.x; tile < TS / 64; tile += gridDim.x) {
        const int t0 = tile * 64;
        __syncthreads();
#pragma unroll 2
        for (int k = 0; k < 8; ++k) {
            const int idx = tid + k * NT, i = idx >> 6, cgp = idx & 63, t = t0 + i, s = t % S, ch = cgp * 8;
            float acc[8];
#pragma unroll
            for (int e = 0; e < 8; ++e) acc[e] = cb[ch + e];
#pragma unroll
            for (int j = 0; j < 4; ++j) { const int sp = s + j - 2;
                if (sp >= 0 && sp < S) { const u32x4 v = *(const u32x4*)(proj + (size_t)(t + j - 2) * EIN + 768 + ch); float xv[8]; unpack8(v, xv);
#pragma unroll
                    for (int e = 0; e < 8; ++e) acc[e] += cw[j * 512 + ch + e] * xv[e]; } }
            u32x4 o; o.x = pk2(acc[0], acc[1]); o.y = pk2(acc[2], acc[3]); o.z = pk2(acc[4], acc[5]); o.w = pk2(acc[6], acc[7]);
            *(u32x4*)(lds + i * XST + ch * 2) = o;
        }
        __syncthreads();
        const int G = lane >> 4, l16 = lane & 15, ch0 = wave * 64;
        for (int dir = 0; dir < 2; ++dir)
            for (int nt = 0; nt < 4; ++nt) {
                const int e = nt * 16 + l16, ch = ch0 + e;
                bf16x8 Br[2], Bi[2];
#pragma unroll
                for (int kk = 0; kk < 2; ++kk) {
                    Br[kk] = *(const bf16x8*)(GWj + ((((size_t)dir * 2 + 0) * 8 + wave) * 64 + e) * 64 + kk * 32 + G * 8);
                    Bi[kk] = *(const bf16x8*)(GWj + ((((size_t)dir * 2 + 1) * 8 + wave) * 64 + e) * 64 + kk * 32 + G * 8);
                }
                const float brv = br[dir * 512 + ch], biv = bi[dir * 512 + ch], spl = softplus(-lam[dir * 512 + ch]);
#pragma unroll
                for (int mt = 0; mt < 4; ++mt) {
                    f32x4 ar = {0.f, 0.f, 0.f, 0.f}, ai = {0.f, 0.f, 0.f, 0.f};
#pragma unroll
                    for (int kk = 0; kk < 2; ++kk) { const bf16x8 a = *(const bf16x8*)(lds + (mt * 16 + l16) * XST + (ch0 + kk * 32 + G * 8) * 2); ar = MFMA16(a, Br[kk], ar); ai = MFMA16(a, Bi[kk], ai); }
#pragma unroll
                    for (int r = 0; r < 4; ++r) { const int i = mt * 16 + G * 4 + r;
                        const float xc = bf2f(*(const bf16_t*)(lds + i * XST + ch * 2));
                        const float rg = sigm(ar[r] + brv), ig = sigm(ai[r] + biv);
                        const float la = -8.f * rg * spl; const float uu = sqrtf(fmaxf(-expm1f(2.f * la), 0.f)) * (ig * xc);
                        const size_t o = ((size_t)dir * TS + t0 + i) * 512 + ch; LA[o] = la; UU[o] = uu; }
                }
            }
        asm volatile("s_waitcnt vmcnt(0)" ::: "memory");
        __syncthreads();
        {
            const int ch = tid;
#pragma unroll
            for (int dir = 0; dir < 2; ++dir) {
                float h = 0.f, P = 0.f;
                const float* la = LA + ((size_t)dir * TS + t0) * 512 + ch; const float* uu = UU + ((size_t)dir * TS + t0) * 512 + ch;
#pragma unroll
                for (int q = 0; q < 64; q += 8) {
                    float lv[8], uv[8];
#pragma unroll
                    for (int e = 0; e < 8; ++e) { const int i = dir ? 63 - (q + e) : q + e; lv[e] = la[(size_t)i * 512]; uv[e] = uu[(size_t)i * 512]; }
#pragma unroll
                    for (int e = 0; e < 8; ++e) { h = __expf(lv[e]) * h + uv[e]; P += lv[e]; }
                }
                AGG[((size_t)dir * (TS / 64) + tile) * 512 + ch] = (f32x2){P, h};
            }
        }
    }
}
__device__ __forceinline__ void even_lru_scan(const float* LA, const float* UU, const f32x2* AGG, const bf16_t* proj, bf16_t* Y, int S) {
    MK_IDS();
    const int ch = tid, TPB = S / 64;
    for (int tile = blockIdx.x; tile < TS / 64; tile += gridDim.x) {
        const int t0 = tile * 64, tb0 = (tile / TPB) * TPB;
        float cf = 0.f, cr = 0.f;
        for (int k = tb0; k < tile; ++k) { const f32x2 a = AGG[(size_t)k * 512 + ch]; cf = cf * __expf(a.x) + a.y; }
        for (int k = tb0 + TPB - 1; k > tile; --k) { const f32x2 a = AGG[((size_t)(TS / 64) + k) * 512 + ch]; cr = cr * __expf(a.x) + a.y; }
        float hf[64];
        {
            const float* la = LA + (size_t)t0 * 512 + ch; const float* uu = UU + (size_t)t0 * 512 + ch; float h = cf;
#pragma unroll
            for (int q = 0; q < 64; q += 8) {
                float lv[8], uv[8];
#pragma unroll
                for (int e = 0; e < 8; ++e) { lv[e] = la[(size_t)(q + e) * 512]; uv[e] = uu[(size_t)(q + e) * 512]; }
#pragma unroll
                for (int e = 0; e < 8; ++e) { h = __expf(lv[e]) * h + uv[e]; hf[q + e] = h; }
            }
        }
        {
            const float* la = LA + ((size_t)TS + t0) * 512 + ch; const float* uu = UU + ((size_t)TS + t0) * 512 + ch; float h = cr;
#pragma unroll
            for (int q = 0; q < 64; q += 8) {
                float lv[8], uv[8], gv[8];
#pragma unroll
                for (int e = 0; e < 8; ++e) { const int i = 63 - (q + e); lv[e] = la[(size_t)i * 512]; uv[e] = uu[(size_t)i * 512]; gv[e] = bf2f(proj[(size_t)(t0 + i) * EIN + 1280 + ch]); }
#pragma unroll
                for (int e = 0; e < 8; ++e) { const int i = 63 - (q + e); h = __expf(lv[e]) * h + uv[e]; Y[(size_t)(t0 + i) * DMODEL + 512 + ch] = (bf16_t)f2bf((hf[i] + h) * gelu_tanh(gv[e])); }
            }
        }
    }
}

__device__ __forceinline__ void odd_conv(const bf16_t* proj, const float* cw, bf16_t* QKVP, int S) {
    MK_IDS();
    for (int t = gw; t < TS; t += NGW) {
        const int s = t % S;
#pragma unroll
        for (int blk = 0; blk < 3; ++blk) {
            const int ch = blk * 512 + lane * 8;
            float acc[8];
#pragma unroll
            for (int e = 0; e < 8; ++e) acc[e] = 0.f;
#pragma unroll
            for (int j = 0; j < 4; ++j) { const int sp = s + j - 2;
                if (sp >= 0 && sp < S) { const u32x4 v = *(const u32x4*)(proj + (size_t)(t + j - 2) * OINP + ch); float xv[8]; unpack8(v, xv);
                    const f32x4 w0 = *(const f32x4*)(cw + j * 1536 + ch), w1 = *(const f32x4*)(cw + j * 1536 + ch + 4);
                    acc[0] += w0.x * xv[0]; acc[1] += w0.y * xv[1]; acc[2] += w0.z * xv[2]; acc[3] += w0.w * xv[3];
                    acc[4] += w1.x * xv[4]; acc[5] += w1.y * xv[5]; acc[6] += w1.z * xv[6]; acc[7] += w1.w * xv[7]; } }
            float ss = 0.f;
#pragma unroll
            for (int e = 0; e < 8; ++e) { acc[e] = silu(acc[e]); ss += acc[e] * acc[e]; }
            if (blk < 2) {
                ss += __shfl_xor(ss, 1); ss += __shfl_xor(ss, 2); ss += __shfl_xor(ss, 4); ss += __shfl_xor(ss, 8);
                const float rn = 1.f / sqrtf(ss + EPS);
#pragma unroll
                for (int e = 0; e < 8; ++e) acc[e] *= rn;
            }
            u32x4 o; o.x = pk2(acc[0], acc[1]); o.y = pk2(acc[2], acc[3]); o.z = pk2(acc[4], acc[5]); o.w = pk2(acc[6], acc[7]);
            *(u32x4*)(QKVP + (size_t)t * 1536 + ch) = o;
        }
    }
}

__device__ __forceinline__ void odd_prep(const bf16_t* QKVP, const bf16_t* proj, const float* alog, const float* dtb, unsigned char* DNI, float* EGL, char* lds) {
    MK_IDS();
    constexpr int RS = 272;
    constexpr int HOFF = 69632;
    const float scale = 0.08838834764831845f;
    for (int it0 = blockIdx.x * 2; it0 < 2048; it0 += gridDim.x * 2) {
        int tq_ = tid; asm volatile("" : "+v"(tq_));
        const int half = tq_ >> 8, ht = tq_ & 255, hwave = __builtin_amdgcn_readfirstlane(ht >> 6), G = (tq_ & 63) >> 4, l16 = tq_ & 15;
        char* L = lds + half * HOFF;
        char* KS = L, *QS = L + 17408, *VS = L + 34816; float* LM = (float*)(L + 52224); float* GC = (float*)(L + 68608); float* BT = GC + 64; float* EG = BT + 64;
        const int it = it0 + half; const int d = it & 1, h = (it >> 1) & 3, c = it >> 3, t0 = c * 64;
        __syncthreads();
#pragma unroll
        for (int k = 0; k < 4; ++k) { const int idx = ht + k * 256, i = idx >> 4, pc = idx & 15; const int tk = d ? t0 + 63 - i : t0 + i;
            const bf16_t* src = QKVP + (size_t)tk * 1536 + h * 128 + pc * 8;
            *(u32x4*)(QS + i * RS + pc * 16) = *(const u32x4*)(src);
            *(u32x4*)(KS + i * RS + pc * 16) = *(const u32x4*)(src + 512);
            *(u32x4*)(VS + i * RS + pc * 16) = *(const u32x4*)(src + 1024); }
        if (hwave == 0) {
            const int i = lane; const int tk = d ? t0 + 63 - i : t0 + i;
            const float bl = bf2f(proj[(size_t)tk * OINP + 2048 + d * 4 + h]), al = bf2f(proj[(size_t)tk * OINP + 2056 + d * 4 + h]);
            const float beta = sigm(bl); float g = -__expf(alog[d * 4 + h]) * softplus(al + dtb[d * 4 + h]);
#pragma unroll
            for (int o = 1; o < 64; o <<= 1) { const float v = __shfl_up(g, o); if (lane >= o) g += v; }
            GC[i] = g; BT[i] = beta; EG[i] = __expf(g);
        }
        __syncthreads();
        {
            const bool isq = hwave >= 2; const char* XS = isq ? QS : KS;
#pragma unroll
            for (int mm = 0; mm < 2; ++mm) { const int mt = (hwave & 1) * 2 + mm;
                bf16x8 a[4];
#pragma unroll
                for (int kk = 0; kk < 4; ++kk) a[kk] = *(const bf16x8*)(XS + (mt * 16 + l16) * RS + (kk * 32 + G * 8) * 2);
#pragma unroll
                for (int nt = 0; nt < 4; ++nt) { f32x4 acc = {0.f, 0.f, 0.f, 0.f};
#pragma unroll
                    for (int kk = 0; kk < 4; ++kk) { const bf16x8 bb = *(const bf16x8*)(KS + (nt * 16 + l16) * RS + (kk * 32 + G * 8) * 2); acc = MFMA16(a[kk], bb, acc); }
                    const int j = nt * 16 + l16; const float gj = GC[j];
#pragma unroll
                    for (int r = 0; r < 4; ++r) { const int i = mt * 16 + G * 4 + r; const float dec = __expf(fminf(GC[i] - gj, 0.f));
                        if (!isq) LM[i * 64 + j] = (j < i) ? BT[i] * acc[r] * dec : 0.f;
                        else ((bf16_t*)(DNI + (size_t)it * DNI_BYTES + DNI_A))[i * 64 + j] = (bf16_t)f2bf((j <= i) ? acc[r] * scale * dec : 0.f); }
                }
            }
        }
        __syncthreads();
        {
            float sol[64];
            const int cc = ht & 127; const bool isw = ht >= 128; const char* XS = isw ? KS : VS;
#pragma unroll
            for (int i = 0; i < 64; ++i) {
                float v = bf2f(*(const bf16_t*)(XS + i * RS + cc * 2)) * BT[i]; if (isw) v *= EG[i];
#pragma unroll
                for (int j4 = 0; j4 < (i + 3) / 4; ++j4) { const f32x4 l4 = *(const f32x4*)(LM + i * 64 + j4 * 4);
                    if (j4 * 4 + 0 < i) v -= l4.x * sol[j4 * 4 + 0]; if (j4 * 4 + 1 < i) v -= l4.y * sol[j4 * 4 + 1];
                    if (j4 * 4 + 2 < i) v -= l4.z * sol[j4 * 4 + 2]; if (j4 * 4 + 3 < i) v -= l4.w * sol[j4 * 4 + 3];
                    if ((j4 & 3) == 3) asm volatile("" ::: "memory"); }
                sol[i] = v;
                ((bf16_t*)(DNI + (size_t)it * DNI_BYTES + (isw ? DNI_W : DNI_U)))[i * 128 + cc] = (bf16_t)f2bf(v);
                asm volatile("" ::: "memory");
            }
        }
        {
            const float gl = GC[63];
#pragma unroll 4
            for (int k = 0; k < 32; ++k) { const int idx = ht + k * 256;
                { const int i = idx >> 7, dm = idx & 127; ((bf16_t*)(DNI + (size_t)it * DNI_BYTES + DNI_QT))[idx] = (bf16_t)f2bf(bf2f(*(const bf16_t*)(QS + i * RS + dm * 2)) * scale * EG[i]); }
                { const int i = idx & 63, dm = idx >> 6; ((bf16_t*)(DNI + (size_t)it * DNI_BYTES + DNI_KTT))[idx] = (bf16_t)f2bf(bf2f(*(const bf16_t*)(KS + i * RS + dm * 2)) * __expf(gl - GC[i])); }
            }
            if (ht == 0) EGL[it] = __expf(gl);
        }
    }
}

__device__ __forceinline__ void odd_scan(const unsigned char* DNI, const float* EGL, bf16_t* OB, int S, int nb, char* lds) {
    MK_IDS();
    constexpr int BUFB = 64512, O_W = 0, O_QT = 17408, O_KTT = 34816, O_A = 53248, O_U = 62464, O_SB = 129024, O_VN = 133376;
    const int NC = S / 64, G = lane >> 4, l16 = lane & 15;
    const int nitems = nb * 64;
    for (int item = blockIdx.x; item < nitems; item += gridDim.x) {
        const int e = (item >> 3) & 7, sq = (item & 7) | ((item >> 6) << 3); const int d = sq & 1, h = (sq >> 1) & 3, b = sq >> 3;
        __syncthreads();
        for (int i = tid; i < 4352 / 4; i += NT) ((unsigned*)(lds + O_SB))[i] = 0u;
        f32x4 Sreg = {0.f, 0.f, 0.f, 0.f};
        u32x4 aW[2], aQ[2], aK[2], aA, aU, bW[2], bQ[2], bK[2], bA, bU;
#define DN_LOAD(n, X) do { const unsigned char* ip = DNI + (size_t)(((b * NC + (d ? NC - 1 - (n) : (n))) * 4 + h) * 2 + d) * DNI_BYTES; \
            _Pragma("unroll") for (int k = 0; k < 2; ++k) { const int idx = tid + k * NT; X##W[k] = *(const u32x4*)(ip + DNI_W + idx * 16); X##Q[k] = *(const u32x4*)(ip + DNI_QT + idx * 16); X##K[k] = *(const u32x4*)(ip + DNI_KTT + idx * 16); } \
            X##A = *(const u32x4*)(ip + DNI_A + tid * 16); if (tid < 128) X##U = *(const u32x4*)(ip + DNI_U + (tid >> 1) * 256 + e * 32 + (tid & 1) * 16); } while (0)
#define DN_STORE(buf, X) do { char* bp_ = lds + (buf) * BUFB; \
            _Pragma("unroll") for (int k = 0; k < 2; ++k) { const int idx = tid + k * NT; *(u32x4*)(bp_ + O_W + (idx >> 4) * 272 + (idx & 15) * 16) = X##W[k]; *(u32x4*)(bp_ + O_QT + (idx >> 4) * 272 + (idx & 15) * 16) = X##Q[k]; \
                *(u32x4*)(bp_ + O_KTT + (idx >> 3) * 144 + (idx & 7) * 16) = X##K[k]; } \
            *(u32x4*)(bp_ + O_A + (tid >> 3) * 144 + (tid & 7) * 16) = X##A; if (tid < 128) *(u32x4*)(bp_ + O_U + (tid >> 1) * 32 + (tid & 1) * 16) = X##U; } while (0)
#define DN_STEP(n, buf, XL, XS) do { const char* bp = lds + (buf) * BUFB; \
            if ((n) + 2 < NC) DN_LOAD((n) + 2, XL); \
            const int c = b * NC + (d ? NC - 1 - (n) : (n)); \
            const float egl = EGL[(c * 4 + h) * 2 + d]; \
            f32x4 acc = {0.f, 0.f, 0.f, 0.f}; \
            const int mt = wave & 3; \
            { const char* XSp = bp + (wave < 4 ? O_W : O_QT); \
              _Pragma("unroll") for (int kk = 0; kk < 4; ++kk) { const bf16x8 a = *(const bf16x8*)(XSp + (mt * 16 + l16) * 272 + (kk * 32 + G * 8) * 2); const bf16x8 bb = *(const bf16x8*)(lds + O_SB + l16 * 272 + (kk * 32 + G * 8) * 2); acc = MFMA16(a, bb, acc); } } \
            if (wave < 4) { u32x2 o; float v[4]; \
              _Pragma("unroll") for (int r = 0; r < 4; ++r) v[r] = bf2f(*(const bf16_t*)(bp + O_U + (mt * 16 + G * 4 + r) * 32 + l16 * 2)) - acc[r]; \
              o.x = pk2(v[0], v[1]); o.y = pk2(v[2], v[3]); \
              *(u32x2*)(lds + O_VN + l16 * 144 + (mt * 16 + G * 4) * 2) = o; } \
            __syncthreads(); \
            bf16x8 vb[2]; \
            _Pragma("unroll") for (int kk = 0; kk < 2; ++kk) vb[kk] = *(const bf16x8*)(lds + O_VN + l16 * 144 + (kk * 32 + G * 8) * 2); \
            if (wave >= 4) { \
              _Pragma("unroll") for (int kk = 0; kk < 2; ++kk) { const bf16x8 a = *(const bf16x8*)(bp + O_A + (mt * 16 + l16) * 144 + (kk * 32 + G * 8) * 2); acc = MFMA16(a, vb[kk], acc); } \
              const int t0 = c * 64; \
              _Pragma("unroll") for (int r = 0; r < 4; ++r) { const int i = mt * 16 + G * 4 + r; const int tk = d ? t0 + 63 - i : t0 + i; \
                OB[((size_t)d * TS + tk) * 512 + h * 128 + e * 16 + l16] = (bf16_t)f2bf(acc[r]); } } \
            { Sreg = Sreg * egl; \
              _Pragma("unroll") for (int kk = 0; kk < 2; ++kk) { const bf16x8 a = *(const bf16x8*)(bp + O_KTT + (wave * 16 + l16) * 144 + (kk * 32 + G * 8) * 2); Sreg = MFMA16(a, vb[kk], Sreg); } \
              u32x2 o; o.x = pk2(Sreg[0], Sreg[1]); o.y = pk2(Sreg[2], Sreg[3]); \
              *(u32x2*)(lds + O_SB + l16 * 272 + (wave * 16 + G * 4) * 2) = o; } \
            if ((n) + 1 < NC) DN_STORE((buf) ^ 1, XS); \
            __syncthreads(); } while (0)
        DN_LOAD(0, a); DN_LOAD(1, b); DN_STORE(0, a);
        __syncthreads();
        for (int n = 0; n < NC; n += 2) {
            DN_STEP(n, 0, a, b);
            DN_STEP(n + 1, 1, b, a);
        }
#undef DN_STEP
#undef DN_LOAD
#undef DN_STORE
    }
}

__device__ __forceinline__ int t5_bucket(int rel) {
    const int n = rel < 0 ? -rel : rel; int v;
    if (n < 8) v = n; else v = 8 + (n >= 15) + (n >= 27) + (n >= 50) + (n >= 91) + (n >= 166) + (n >= 305) + (n >= 559);
    return (rel > 0 ? 16 : 0) + v;
}
__device__ __forceinline__ void odd_dilated(bf16_t* proj, const float* relb, float* LSE, int S, char* lds, int first_wg, int n_wg) {
    MK_IDS();
    constexpr int KST = 144, VST = 400, HOFF = 27648 + 25600 + 1024;
    const int half = tid >> 8, ht = tid & 255, wv = ht >> 6, G = lane >> 4, l16 = lane & 15;
    char* L = lds + half * HOFF; char* KS = L; char* VT = L + 27648; float* BIAS = (float*)(L + 27648 + 25600);
    const int NBb = S / 64;
    const int wgi = (int)blockIdx.x - first_wg;
    if (wgi < 0) return;
    for (int it0 = wgi * 2; it0 < 3072; it0 += n_wg * 2) {
        const int it = it0 + half; const int zb = it & 255, sl = (it >> 8) & 3, g = it >> 10;
        const int dil = g == 0 ? 1 : (g == 1 ? 4 : 16), lg = g * 2;
        const int M = S >> lg, MB = M / 64;
        const int b = zb / NBb, r0 = zb % NBb, rho = r0 / MB, n = r0 % MB;
        const int hc = (g * 4 + sl) * 64;
        const size_t tb = (size_t)b * S;
        __syncthreads();
#pragma unroll
        for (int k = 0; k < 6; ++k) { const int idx = ht + k * 256, kj = idx >> 3, pc = idx & 7; const int mk = 64 * n - 64 + kj;
            u32x4 kv = {0u, 0u, 0u, 0u}, vv = {0u, 0u, 0u, 0u};
            if (mk >= 0 && mk < M) { const bf16_t* rowp = proj + (tb + (size_t)mk * dil + rho) * OINP; kv = *(const u32x4*)(rowp + 2832 + hc + pc * 8); vv = *(const u32x4*)(rowp + 3600 + hc + pc * 8); }
            *(u32x4*)(KS + kj * KST + pc * 16) = kv;
            const unsigned w[4] = {vv.x, vv.y, vv.z, vv.w};
#pragma unroll
            for (int q = 0; q < 4; ++q) { *(bf16_t*)(VT + (pc * 8 + 2 * q) * VST + kj * 2) = (bf16_t)(w[q] & 0xffffu); *(bf16_t*)(VT + (pc * 8 + 2 * q + 1) * VST + kj * 2) = (bf16_t)(w[q] >> 16); } }
        if (ht < 129) BIAS[ht] = relb[t5_bucket((ht - 64) * dil) * 12 + g * 4 + sl];
        const int mq = 64 * n + 16 * wv + l16; const size_t tq = tb + (size_t)mq * dil + rho;
        bf16x8 qf[2];
#pragma unroll
        for (int kk = 0; kk < 2; ++kk) qf[kk] = *(const bf16x8*)(proj + tq * OINP + 2064 + hc + kk * 32 + G * 8);
        __syncthreads();
        f32x4 sc[9]; float mx = -1e30f;
#pragma unroll
        for (int kt = 0; kt < 9; ++kt) { f32x4 acc = {0.f, 0.f, 0.f, 0.f};
#pragma unroll
            for (int kk = 0; kk < 2; ++kk) { const bf16x8 a = *(const bf16x8*)(KS + ((wv + kt) * 16 + l16) * KST + (kk * 32 + G * 8) * 2); acc = MFMA16(a, qf[kk], acc); }
#pragma unroll
            for (int r = 0; r < 4; ++r) { const int kj = (wv + kt) * 16 + G * 4 + r; const int delta = kj - 64 - 16 * wv - l16; const int mk = 64 * n - 64 + kj;
                const bool ok = (delta >= -64) && (delta <= 64) && (mk >= 0) && (mk < M);
                const float s = ok ? acc[r] * 0.125f + BIAS[(delta < -64 ? -64 : (delta > 64 ? 64 : delta)) + 64] : -1e30f;
                acc[r] = s; mx = fmaxf(mx, s); }
            sc[kt] = acc; }
        mx = fmaxf(mx, __shfl_xor(mx, 16)); mx = fmaxf(mx, __shfl_xor(mx, 32));
        float sum = 0.f;
#pragma unroll
        for (int kt = 0; kt < 9; ++kt)
#pragma unroll
            for (int r = 0; r < 4; ++r) { const float pv_ = (sc[kt][r] > -1e29f) ? __expf(sc[kt][r] - mx) : 0.f; sc[kt][r] = pv_; sum += pv_; }
        sum += __shfl_xor(sum, 16); sum += __shfl_xor(sum, 32);
        f32x4 ot[4];
#pragma unroll
        for (int dt = 0; dt < 4; ++dt) ot[dt] = (f32x4){0.f, 0.f, 0.f, 0.f};
#pragma unroll
        for (int pp = 0; pp < 5; ++pp) {
            u32x4 pb; pb.x = pk2(sc[2 * pp][0], sc[2 * pp][1]); pb.y = pk2(sc[2 * pp][2], sc[2 * pp][3]);
            if (pp < 4) { pb.z = pk2(sc[2 * pp + 1][0], sc[2 * pp + 1][1]); pb.w = pk2(sc[2 * pp + 1][2], sc[2 * pp + 1][3]); } else { pb.z = 0u; pb.w = 0u; }
            const bf16x8 pbf = __builtin_bit_cast(bf16x8, pb);
#pragma unroll
            for (int dt = 0; dt < 4; ++dt) {
                u32x4 av; const u32x2 lo = *(const u32x2*)(VT + (dt * 16 + l16) * VST + ((wv + 2 * pp) * 16 + G * 4) * 2); av.x = lo.x; av.y = lo.y;
                if (pp < 4) { const u32x2 hi = *(const u32x2*)(VT + (dt * 16 + l16) * VST + ((wv + 2 * pp + 1) * 16 + G * 4) * 2); av.z = hi.x; av.w = hi.y; } else { av.z = 0u; av.w = 0u; }
                ot[dt] = MFMA16(__builtin_bit_cast(bf16x8, av), pbf, ot[dt]);
            }
        }
        const float rs = 1.f / sum;
        float* od = (float*)(proj + tq * OINP) + (g * 4 + sl) * 64;
#pragma unroll
        for (int dt = 0; dt < 4; ++dt) *(f32x4*)(od + dt * 16 + G * 4) = ot[dt] * rs;
        if (G == 0) LSE[tq * 12 + g * 4 + sl] = mx + __logf(sum);
    }
}

__device__ __forceinline__ void odd_combine(const bf16_t* OB, const bf16_t* proj, const float* LSE, const float* og, bf16_t* Y) {
    MK_IDS();
    const float g0 = og[lane * 2], g1 = og[lane * 2 + 1];
    for (int t = gw; t < TS; t += NGW) {
        const bf16_t* prow = proj + (size_t)t * OINP;
#pragma unroll
        for (int hh = 0; hh < 4; ++hh) {
            const unsigned a = *(const unsigned*)(OB + (size_t)t * 512 + hh * 128 + lane * 2), bb = *(const unsigned*)(OB + ((size_t)TS + t) * 512 + hh * 128 + lane * 2);
            const unsigned zz = *(const unsigned*)(prow + 1536 + hh * 128 + lane * 2);
            const float o0 = __uint_as_float(a << 16) + __uint_as_float(bb << 16), o1 = __uint_as_float(a & 0xffff0000u) + __uint_as_float(bb & 0xffff0000u);
            const float ss = wave_sum(o0 * o0 + o1 * o1); const float rn = 1.f / sqrtf(ss * (1.f / 128.f) + EPS);
            const float z0 = __uint_as_float(zz << 16), z1 = __uint_as_float(zz & 0xffff0000u);
            *(unsigned*)(Y + (size_t)t * OOUT + hh * 128 + lane * 2) = pk2(o0 * rn * g0 * silu(z0), o1 * rn * g1 * silu(z1));
        }
        const float* od = (const float*)prow;
#pragma unroll
        for (int sl = 0; sl < 4; ++sl) {
            const float l0 = LSE[(size_t)t * 12 + sl], l1 = LSE[(size_t)t * 12 + 4 + sl], l2 = LSE[(size_t)t * 12 + 8 + sl];
            const float m = fmaxf(l0, fmaxf(l1, l2)); const float w0 = __expf(l0 - m), w1 = __expf(l1 - m), w2 = __expf(l2 - m); const float rs = 1.f / (w0 + w1 + w2);
            const float v = (w0 * od[sl * 64 + lane] + w1 * od[256 + sl * 64 + lane] + w2 * od[512 + sl * 64 + lane]) * rs;
            Y[(size_t)t * OOUT + 512 + sl * 64 + lane] = (bf16_t)f2bf(v);
        }
    }
}

__global__ void __launch_bounds__(NT, 2) fwd_megakernel(Params p) {
    extern __shared__ __attribute__((aligned(16))) unsigned char lds_raw[];
    cg::grid_group grid = cg::this_grid();
    char* lds = (char*)lds_raw;
    PG8_LAS unsigned char* ldsl = (PG8_LAS unsigned char*)lds_raw;
    const int Gr = gridDim.x;
    volatile LAS unsigned* MISC = (volatile LAS unsigned*)((PG8_LAS unsigned char*)lds_raw + (LDS_BYTES - 128));
    if (threadIdx.x < 32) MISC[threadIdx.x] = 0u;
    __syncthreads();
    xb::XcdBarrier bar = xb::xcd_barrier_post((unsigned*)p.ws, MISC + 8);
#define GSYNC() xb::xcd_barrier(bar)
    unsigned char* ws = p.ws;
    bf16_t* H = (bf16_t*)(ws + WS_H); bf16_t* PROJ = (bf16_t*)(ws + WS_PROJ); unsigned char* SCR = ws + WS_SCR;

    phase_prologue(p, lds);
    grid.sync();

    for (int seg = 0; seg < NSEG; ++seg) {
        const int S = seg < 2 ? 16384 : 2048, nb = seg < 2 ? 1 : 8;
        const float* xin = (seg < 2 ? p.in[0] : p.in[1]) + (size_t)(seg & 1) * TS * DMODEL;
        float* xo = p.out + (size_t)seg * TS * DMODEL;
        for (int layer = 0; layer < 4; ++layer) {
            const float* xcur = layer == 0 ? xin : xo;
            const int j = layer >> 1; const bool odd = layer & 1;
            phase_rmsnorm_bf16(xcur, p.in[3] + layer * DMODEL, H);
            GSYNC();
            {
                const int N = odd ? OINP : EIN;
                const bf16_t* Bt = odd ? (const bf16_t*)(ws + WS_WINO) + (size_t)j * OINP * 1024 : (const bf16_t*)(ws + WS_WINE) + (size_t)j * EIN * 1024;
                pg8::Gemm g{H, Bt, TS, N, 1024}; pg8::StaticOrder So; So.init(TS, N, Gr, (int)blockIdx.x);
                pg8::EpiBf16<0> E{PROJ, N, nullptr, 0, 0, 1.f};
                pg8::gemm_phase<pg8::EpiBf16<0>, pg8::StaticOrder, true, true>(ldsl, g, So, E);
            }
            GSYNC();
            if (!odd) {
                even_qk_post(PROJ, p.in[10] + j * 64, p.in[11] + j * 64, S);
                even_lru_prep(PROJ, p.in[12] + j * 2048, p.in[13] + j * 512, (const bf16_t*)(ws + WS_GW) + (size_t)j * 2 * 2 * 8 * 4096, p.in[15] + j * 1024, p.in[17] + j * 1024, p.in[18] + j * 1024,
                              (float*)(SCR + SC_LA), (float*)(SCR + SC_UU), (f32x2*)(SCR + SC_AGG), S, lds);
                GSYNC();
                {
                    const int nqb = S / 256, nunits = nb * 8 * nqb;
                    for (int u = blockIdx.x; u < nunits; u += Gr) {
                        const int qb = u % nqb, h = (u / nqb) % 8, b = u / (nqb * 8), kvh = h >> 2;
                        const attn_body::bf16* base = (const attn_body::bf16*)PROJ + (size_t)b * S * EIN;
                        attn_body::attn_unit<8>(qb, S, base + h * 64, EIN, base + 512 + kvh * 64, base + 640 + kvh * 64, EIN, (attn_body::bf16*)H + (size_t)b * S * DMODEL + h * 64, DMODEL, lds);
                    }
                }
                __syncthreads();
                even_lru_scan((const float*)(SCR + SC_LA), (const float*)(SCR + SC_UU), (const f32x2*)(SCR + SC_AGG), PROJ, H, S);
                GSYNC();
                {
                    pg8::Gemm g{H, (const bf16_t*)(ws + WS_WOUTE) + (size_t)j * 1024 * 1024, TS, 1024, 1024}; pg8::StaticOrder So; So.init(TS, 1024, Gr, (int)blockIdx.x);
                    EpiRes E{xcur, xo, DMODEL};
                    pg8::gemm_phase<EpiRes, pg8::StaticOrder, true, true>(ldsl, g, So, E);
                }
            } else {
                odd_conv(PROJ, p.in[21] + j * 4 * 1536, (bf16_t*)(SCR + SC_QKVP), S);
                GSYNC();
                odd_prep((const bf16_t*)(SCR + SC_QKVP), PROJ, p.in[22] + j * 8, p.in[23] + j * 8, SCR + SC_DNI, (float*)(SCR + SC_EGL), lds);
                GSYNC();
                {
                    const int nscan = nb * 64;
                    odd_scan(SCR + SC_DNI, (const float*)(SCR + SC_EGL), (bf16_t*)(SCR + SC_OB), S, nb, lds);
                    const int first = nscan < Gr ? nscan : 0;
                    odd_dilated(PROJ, p.in[2], (float*)(SCR + SC_LSE), S, lds, first, Gr - first);
                }
                GSYNC();
                odd_combine((const bf16_t*)(SCR + SC_OB), PROJ, (const float*)(SCR + SC_LSE), p.in[24] + j * 128, H);
                GSYNC();
                {
                    pg8::Gemm g{H, (const bf16_t*)(ws + WS_WOUTO) + (size_t)j * 1024 * OOUT, TS, 1024, OOUT}; pg8::StaticOrder So; So.init(TS, 1024, Gr, (int)blockIdx.x);
                    EpiRes E{xcur, xo, DMODEL};
                    pg8::gemm_phase<EpiRes, pg8::StaticOrder, true, true>(ldsl, g, So, E);
                }
            }
            GSYNC();
            phase_rmsnorm_bf16(xo, p.in[4] + layer * DMODEL, H);
            GSYNC();
            {
                pg8::Gemm g{H, (const bf16_t*)(ws + WS_W1T) + (size_t)layer * 4096 * 1024, TS, DFF, 1024}; pg8::StaticOrder So; So.init(TS, DFF, Gr, (int)blockIdx.x);
                pg8::EpiBf16<2> E{(bf16_t*)(SCR + SC_HID), DFF, nullptr, 0, 0, 1.f};
                pg8::gemm_phase<pg8::EpiBf16<2>, pg8::StaticOrder, true, true>(ldsl, g, So, E);
            }
            GSYNC();
            {
                pg8::Gemm g{(const bf16_t*)(SCR + SC_HID), (const bf16_t*)(ws + WS_W2T) + (size_t)layer * 1024 * 4096, TS, 1024, DFF}; pg8::StaticOrder So; So.init(TS, 1024, Gr, (int)blockIdx.x);
                EpiRes E{xo, xo, DMODEL};
                pg8::gemm_phase<EpiRes, pg8::StaticOrder, true, true>(ldsl, g, So, E);
            }
            GSYNC();
        }
        phase_rmsnorm_final(xo, p.in[5]);
    }
}
}

extern "C" void kernel_launch(void* const* d_in, const int* in_sizes, int n_in, void* d_out, int out_size, void* d_ws, size_t ws_size, hipStream_t stream) {
    static int grid = 0;
    if (grid == 0) {
        if (n_in != 25 || ws_size < mk::WS_END) { fprintf(stderr, "kernel_launch: unexpected n_in %d / ws_size %zu\n", n_in, ws_size); grid = -1; return; }
        int dev = 0, cus = 0, per_cu = 0;
        hipGetDevice(&dev); hipDeviceGetAttribute(&cus, hipDeviceAttributeMultiprocessorCount, dev);
        if (hipFuncSetAttribute((const void*)mk::fwd_megakernel, hipFuncAttributeMaxDynamicSharedMemorySize, mk::LDS_BYTES) != hipSuccess) { fprintf(stderr, "hipFuncSetAttribute failed\n"); }
        hipOccupancyMaxActiveBlocksPerMultiprocessor(&per_cu, (const void*)mk::fwd_megakernel, mk::NT, mk::LDS_BYTES);
        (void)hipGetLastError();
        if (per_cu < 1) per_cu = 1;
        grid = cus * 1;
        fprintf(stderr, "kernel_launch: cus %d per_cu %d grid %d\n", cus, per_cu, grid);
    }
    if (grid < 0) return;
    if (hipMemsetAsync(d_ws, 0, 65536, stream) != hipSuccess) { fprintf(stderr, "memset failed\n"); return; }
    mk::Params p{};
    for (int i = 0; i < 25; ++i) p.in[i] = (const float*)d_in[i];
    p.out = (float*)d_out; p.ws = (unsigned char*)d_ws;
    void* args[] = {&p};
    hipError_t e = hipLaunchCooperativeKernel((const void*)mk::fwd_megakernel, dim3(grid), dim3(mk::NT), args, mk::LDS_BYTES, stream);
    if (e != hipSuccess) fprintf(stderr, "cooperative launch failed: %s (grid %d)\n", hipGetErrorString(e), grid);
}
```

```cpp
#include <hip/hip_runtime.h>
#include <hip/hip_cooperative_groups.h>
#include <hip/hip_bf16.h>
#include <cstdio>
#include <cstdint>
#include <cmath>
namespace cg = cooperative_groups;
namespace pg8 {
#define PG8_LAS __attribute__((address_space(3)))
typedef unsigned short bf16_t;
typedef short bf16x8 __attribute__((ext_vector_type(8)));
typedef float f32x4 __attribute__((ext_vector_type(4)));
typedef unsigned u32x4 __attribute__((ext_vector_type(4)));
constexpr int BM = 256, BK = 64, HALF = 128, HTB = HALF * BK * 2  , STAGE_BYTES = 8 * HTB, NXCD = 8, WGM = 8;

__host__ __device__ __forceinline__ int lds_byte(int r, int c) { const int st = (r >> 4) * 2 + (c >> 5), rr = r & 15, cc = c & 31, ob = rr * 64 + cc * 2; return st * 1024 + (ob ^ (((ob >> 9) & 1) << 5)); }
__host__ __device__ __forceinline__ void stage_rc(int b, int& R, int& C) { const int st = b / 1024, sb = b % 1024, swz = sb ^ (((sb >> 9) & 1) << 5); R = (st >> 1) * 16 + swz / 64; C = (st & 1) * 32 + (swz % 64) / 2; }
__host__ __device__ __forceinline__ int perm32(int rho) { const int n = rho >> 4, i = rho & 15; return 8 * (i >> 2) + 4 * n + (i & 3); }

struct Unit { int pm, pn; };
struct Gemm { const bf16_t* A; const bf16_t* Bt; int M, N, K; };

struct StaticOrder {
    int nM, nN, nwg, G, c;
    __host__ __device__ void init(int M, int N, int G_, int c_) { nM = M / BM; nN = N / BM; nwg = nM * nN; G = G_; c = c_; }
    __host__ __device__ bool next(int i, Unit& u) const {
        const long L = (long)i * G + c; if (L >= nwg) return false;
        int wgid = (int)L; { const int q = nwg / NXCD, r = nwg % NXCD, xcd = wgid % NXCD, off = wgid / NXCD; wgid = (xcd < r ? xcd * (q + 1) : r * (q + 1) + (xcd - r) * q) + off; }
        const int nig = WGM * nN, gid = wgid / nig, fm = gid * WGM, gsz = (nM - fm) < WGM ? (nM - fm) : WGM;
        u.pm = fm + ((wgid % nig) % gsz); u.pn = (wgid % nig) / gsz; return true;
    }
    __device__ __forceinline__ void a_ready(const Unit&) const {}
    __device__ __forceinline__ void done(const Unit&) const {}
};

__device__ __forceinline__ unsigned cvt_pk_bf16(float lo, float hi) { unsigned r; asm volatile("v_cvt_pk_bf16_f32 %0, %1, %2" : "=v"(r) : "v"(lo), "v"(hi)); return r; }
typedef float f32x2 __attribute__((ext_vector_type(2)));
__device__ __forceinline__ f32x2 gelu_pk(f32x2 v) {
    const f32x2 av = __builtin_elementwise_abs(v), d = av * 0.2316418882f + 1.0f;
    f32x2 t; t.x = __builtin_amdgcn_rcpf(d.x); t.y = __builtin_amdgcn_rcpf(d.y);
    f32x2 q = t * 0.5307027145f + (-0.7265760135f); q = q * t + 0.7107068705f; q = q * t + (-0.142248368f); q = q * t + 0.127414796f; q = q * t;
    const f32x2 s = (v * v) * (-0.72134752044f);
    f32x2 e; e.x = __builtin_amdgcn_exp2f(s.x); e.y = __builtin_amdgcn_exp2f(s.y);
    const f32x2 m = v * (q * e), r = v - m;
    f32x2 o; o.x = v.x < 0.f ? m.x : r.x; o.y = v.y < 0.f ? m.y : r.y; return o;
}

template <int ACT  > struct EpiBf16 {
    static constexpr bool PERM = true, AFTER_DRAIN = false; static_assert(ACT == 0 || ACT == 1 || ACT == 2, "EpiBf16: ACT 0 none, 1 gelu, 2 relu^2");
    bf16_t* O; int ldc; const float* bias; int split_cols; size_t split_stride; float scale0;
    __device__ __forceinline__ void operator()(const f32x4 (&acc)[2][2][4][2], const Unit& u, int wr, int wc, int fr, int fq) const {
        const int row0 = u.pm * BM + wr * 64 + fr; int colt = u.pn * BM; bf16_t* base = O;
        float sc = 1.f; if (split_cols) { const int t = colt / split_cols; base += (size_t)t * split_stride; colt -= t * split_cols; if (t == 0) sc = scale0; }
        const int col0 = colt + wc * 32 + 8 * fq, bcol0 = u.pn * BM + wc * 32 + 8 * fq;
        f32x4 bv[2][2];
#pragma unroll
        for (int bj = 0; bj < 2; ++bj)
#pragma unroll
            for (int n = 0; n < 2; ++n) bv[bj][n] = bias ? *(const f32x4*)(bias + bcol0 + bj * HALF + 4 * n) : (f32x4){0.f, 0.f, 0.f, 0.f};
#pragma unroll
        for (int ai = 0; ai < 2; ++ai)
#pragma unroll
            for (int m = 0; m < 4; ++m) { bf16_t* rowp = base + (size_t)(row0 + ai * HALF + m * 16) * ldc + col0;
#pragma unroll
                for (int bj = 0; bj < 2; ++bj) { f32x4 v0 = acc[ai][bj][m][0] + bv[bj][0], v1 = acc[ai][bj][m][1] + bv[bj][1];
                    if (ACT == 1) { f32x2 a = gelu_pk((f32x2){v0[0], v0[1]}), b = gelu_pk((f32x2){v0[2], v0[3]}), c = gelu_pk((f32x2){v1[0], v1[1]}), d = gelu_pk((f32x2){v1[2], v1[3]});
                        v0 = (f32x4){a.x, a.y, b.x, b.y}; v1 = (f32x4){c.x, c.y, d.x, d.y}; }
                    if (ACT == 2) { _Pragma("unroll") for (int q_ = 0; q_ < 4; ++q_) { const float a0_ = v0[q_] > 0.f ? v0[q_] : 0.f, a1_ = v1[q_] > 0.f ? v1[q_] : 0.f; v0[q_] = a0_ * a0_; v1[q_] = a1_ * a1_; } }
                    v0 = v0 * sc; v1 = v1 * sc; u32x4 w; w.x = cvt_pk_bf16(v0[0], v0[1]); w.y = cvt_pk_bf16(v0[2], v0[3]); w.z = cvt_pk_bf16(v1[0], v1[1]); w.w = cvt_pk_bf16(v1[2], v1[3]);
                    *(u32x4*)(rowp + bj * HALF) = w; } }
    }
};

template <class Epi, class Sched, bool ALIGN_EPI = false, bool SP2 = false>
__device__ __forceinline__ void gemm_phase(PG8_LAS unsigned char* lds, const Gemm g, const Sched& S, const Epi& E) {
    int tid_ = threadIdx.x; asm volatile("" : "+v"(tid_)); const int tid = tid_, wid = __builtin_amdgcn_readfirstlane(tid >> 6), lane = tid & 63, wr = wid >> 2, wc = wid & 3, fr = lane & 15, fq = lane >> 4;
    const int K = g.K, nt = K / BK;
    unsigned voffA[2], voffB[2];
#pragma unroll
    for (int i = 0; i < 2; ++i) { int R, C; stage_rc(tid * 16 + i * 8192, R, C); const int Rb = Epi::PERM ? ((R & ~31) + perm32(R & 31)) : R;
        voffA[i] = (unsigned)(R * K + C) * 2u; voffB[i] = (unsigned)(Rb * K + C) * 2u; }
    const size_t kstep = (size_t)(BK * 2);
    const size_t hstep = (size_t)HALF * K * 2;
    const size_t tstep = 2 * hstep;
    const unsigned ldsw = (unsigned)wid * 1024u;
    const int aoff = lds_byte(wr * 64 + fr, fq * 8), boff = lds_byte(wc * 32 + fr, fq * 8);
#define PG8_SA(b, h) (((b) * 2 + (h)) * HTB)
#define PG8_SB(b, h) ((4 + (b) * 2 + (h)) * HTB)
#define PG8_STAGE(bufoff, gbase, voff) do { _Pragma("unroll") for (int _i = 0; _i < 2; ++_i) \
        __builtin_amdgcn_global_load_lds((const unsigned*)((const char*)(gbase) + (voff)[_i]), (PG8_LAS unsigned*)(lds + (bufoff) + ldsw + _i * 8192), 16, 0, 0); } while (0)
#define PG8_LDA(dst, b, h) do { _Pragma("unroll") for (int m = 0; m < 4; ++m) _Pragma("unroll") for (int k = 0; k < 2; ++k) dst[m][k] = *(const PG8_LAS bf16x8*)(lds + PG8_SA(b, h) + aoff + m * 2048 + k * 1024); } while (0)
#define PG8_LDB(dst, b, h) do { _Pragma("unroll") for (int n = 0; n < 2; ++n) _Pragma("unroll") for (int k = 0; k < 2; ++k) dst[n][k] = *(const PG8_LAS bf16x8*)(lds + PG8_SB(b, h) + boff + n * 2048 + k * 1024); } while (0)
#define PG8_MMA(ai, bj, At, Bt) do { __builtin_amdgcn_s_setprio(1); _Pragma("unroll") for (int m = 0; m < 4; ++m) _Pragma("unroll") for (int n = 0; n < 2; ++n) _Pragma("unroll") for (int k = 0; k < 2; ++k) \
        acc[ai][bj][m][n] = __builtin_amdgcn_mfma_f32_16x16x32_bf16(Bt[n][k], At[m][k], acc[ai][bj][m][n], 0, 0, 0); __builtin_amdgcn_s_setprio(0); } while (0)
#define PG8_WAIT_V(n) asm volatile("s_waitcnt vmcnt(" #n ")" ::: "memory")
#define PG8_WAIT_L(n) asm volatile("s_waitcnt lgkmcnt(" #n ")" ::: "memory")
#define PG8_BAR __builtin_amdgcn_s_barrier()
#define PG8_SCHED __builtin_amdgcn_sched_barrier(0)
    Unit cur, nxt; int ui = 0;
    if (!S.next(0, cur)) return;
    f32x4 acc[2][2][4][2];
#pragma unroll
    for (int a = 0; a < 2; ++a)
#pragma unroll
        for (int b = 0; b < 2; ++b)
#pragma unroll
            for (int m = 0; m < 4; ++m)
#pragma unroll
                for (int n = 0; n < 2; ++n) acc[a][b][m][n] = (f32x4){0.f, 0.f, 0.f, 0.f};
    bf16x8 At[4][2], B0[2][2], B1[2][2];
    const char* cA = (const char*)g.A + (size_t)cur.pm * tstep; const char* cB = (const char*)g.Bt + (size_t)cur.pn * tstep;
    S.a_ready(cur);
    if constexpr (SP2) {
        PG8_STAGE(PG8_SB(0, 0), cB, voffB); PG8_STAGE(PG8_SB(0, 1), cB + hstep, voffB); PG8_STAGE(PG8_SA(0, 0), cA, voffA); PG8_STAGE(PG8_SA(0, 1), cA + hstep, voffA);
        if (wr == 1) PG8_BAR;
        PG8_WAIT_V(2); PG8_BAR;
        PG8_STAGE(PG8_SB(1, 0), cB + kstep, voffB); PG8_STAGE(PG8_SA(1, 0), cA + kstep, voffA); PG8_STAGE(PG8_SB(1, 1), cB + hstep + kstep, voffB);
        PG8_WAIT_V(6); PG8_BAR;
    } else {
        PG8_STAGE(PG8_SB(0, 0), cB, voffB); PG8_STAGE(PG8_SA(0, 0), cA, voffA); PG8_STAGE(PG8_SB(0, 1), cB + hstep, voffB); PG8_STAGE(PG8_SA(0, 1), cA + hstep, voffA);
        if (wr == 1) PG8_BAR;
        PG8_WAIT_V(4); PG8_BAR;
        PG8_STAGE(PG8_SB(1, 0), cB + kstep, voffB); PG8_STAGE(PG8_SA(1, 0), cA + kstep, voffA); PG8_STAGE(PG8_SB(1, 1), cB + hstep + kstep, voffB);
        PG8_WAIT_V(6); PG8_BAR;
    }
    for (;;) {
        const bool has_next = S.next(ui + 1, nxt);
        const char* nA = has_next ? (const char*)g.A + (size_t)nxt.pm * tstep : cA; const char* nB = has_next ? (const char*)g.Bt + (size_t)nxt.pn * tstep : cB;
        for (int t = 0; t < nt; t += 2) {
            const bool last = (t == nt - 2);
            const char* a1 = cA + (size_t)(t + 1) * kstep;
            const char* a2 = last ? nA : cA + (size_t)(t + 2) * kstep; const char* b2 = last ? nB : cB + (size_t)(t + 2) * kstep;
            const char* a3 = a2 + kstep; const char* b3 = b2 + kstep;
            if (last && has_next) S.a_ready(nxt);
            if constexpr (SP2) {
            PG8_LDB(B0, 0, 0); PG8_LDB(B1, 0, 1); PG8_SCHED; PG8_LDA(At, 0, 0); PG8_STAGE(PG8_SA(1, 1), a1 + hstep, voffA);
            PG8_WAIT_V(8); PG8_WAIT_L(0); PG8_BAR; PG8_MMA(0, 0, At, B0); PG8_MMA(0, 1, At, B1); PG8_BAR; PG8_SCHED;
            PG8_LDA(At, 0, 1); PG8_STAGE(PG8_SB(0, 0), b2, voffB); PG8_STAGE(PG8_SB(0, 1), b2 + hstep, voffB); PG8_STAGE(PG8_SA(0, 0), a2, voffA);
            PG8_WAIT_V(8); PG8_WAIT_L(0); PG8_BAR; PG8_MMA(1, 0, At, B0); PG8_MMA(1, 1, At, B1); PG8_BAR; PG8_SCHED;
            PG8_LDB(B0, 1, 0); PG8_LDB(B1, 1, 1); PG8_SCHED; PG8_LDA(At, 1, 0); PG8_STAGE(PG8_SA(0, 1), a2 + hstep, voffA);
            PG8_WAIT_V(8); PG8_WAIT_L(0); PG8_BAR; PG8_MMA(0, 0, At, B0); PG8_MMA(0, 1, At, B1); PG8_BAR; PG8_SCHED;
            PG8_LDA(At, 1, 1); PG8_STAGE(PG8_SB(1, 0), b3, voffB); PG8_STAGE(PG8_SB(1, 1), b3 + hstep, voffB); PG8_STAGE(PG8_SA(1, 0), a3, voffA);
            PG8_WAIT_V(8); PG8_WAIT_L(0); PG8_BAR; PG8_MMA(1, 0, At, B0); PG8_MMA(1, 1, At, B1); PG8_BAR; PG8_SCHED;
            } else {
            PG8_LDB(B0, 0, 0); PG8_SCHED; PG8_LDA(At, 0, 0); PG8_STAGE(PG8_SA(1, 1), a1 + hstep, voffA);
            PG8_WAIT_L(8); PG8_BAR; PG8_WAIT_L(0); PG8_MMA(0, 0, At, B0); PG8_BAR; PG8_SCHED;
            PG8_LDB(B1, 0, 1); PG8_STAGE(PG8_SB(0, 0), b2, voffB);
            PG8_BAR; PG8_WAIT_L(0); PG8_MMA(0, 1, At, B1); PG8_BAR;
            PG8_LDA(At, 0, 1); PG8_STAGE(PG8_SA(0, 0), a2, voffA);
            PG8_BAR; PG8_WAIT_L(0); PG8_MMA(1, 0, At, B0); PG8_BAR; PG8_SCHED;
            PG8_STAGE(PG8_SB(0, 1), b2 + hstep, voffB);
            PG8_WAIT_V(6); PG8_BAR; PG8_MMA(1, 1, At, B1); PG8_BAR;
            PG8_LDB(B0, 1, 0); PG8_SCHED; PG8_LDA(At, 1, 0); PG8_STAGE(PG8_SA(0, 1), a2 + hstep, voffA);
            PG8_WAIT_L(8); PG8_BAR; PG8_WAIT_L(0); PG8_MMA(0, 0, At, B0); PG8_BAR; PG8_SCHED;
            PG8_LDB(B1, 1, 1); PG8_STAGE(PG8_SB(1, 0), b3, voffB);
            PG8_BAR; PG8_WAIT_L(0); PG8_MMA(0, 1, At, B1); PG8_BAR;
            PG8_LDA(At, 1, 1); PG8_STAGE(PG8_SA(1, 0), a3, voffA);
            PG8_BAR; PG8_WAIT_L(0); PG8_MMA(1, 0, At, B0); PG8_BAR; PG8_SCHED;
            PG8_STAGE(PG8_SB(1, 1), b3 + hstep, voffB);
            PG8_WAIT_V(6); PG8_BAR; PG8_MMA(1, 1, At, B1); PG8_BAR;
            }
        }
        if constexpr (ALIGN_EPI) { if (wr == 0) PG8_BAR; }
        if constexpr (!Epi::AFTER_DRAIN) { E(acc, cur, wr, wc, fr, fq); S.done(cur); }
        if (!has_next) break;
#pragma unroll
        for (int a = 0; a < 2; ++a)
#pragma unroll
            for (int b = 0; b < 2; ++b)
#pragma unroll
                for (int m = 0; m < 4; ++m)
#pragma unroll
                    for (int n = 0; n < 2; ++n) acc[a][b][m][n] = (f32x4){0.f, 0.f, 0.f, 0.f};
        cur = nxt; cA = nA; cB = nB; ++ui;
        if constexpr (ALIGN_EPI) { if (wr == 1) PG8_BAR; }
    }
    PG8_WAIT_V(0);
    if constexpr (!ALIGN_EPI) { if (wr == 0) PG8_BAR; }
    PG8_BAR;
    if constexpr (Epi::AFTER_DRAIN) { E.fused(acc, cur, wr, wc, fr, fq, lds, wid, lane); S.done(cur); }
#undef PG8_SA
#undef PG8_SB
#undef PG8_STAGE
#undef PG8_LDA
#undef PG8_LDB
#undef PG8_MMA
#undef PG8_WAIT_V
#undef PG8_WAIT_L
#undef PG8_BAR
#undef PG8_SCHED
}
}

#ifndef PG8_SP2
#define PG8_SP2 true
#endif
#ifndef PG8_ALIGN
#define PG8_ALIGN true
#endif
#include <hip/hip_bf16.h>
#include <cmath>
namespace attn_body {
using bf16=__hip_bfloat16;
using bf16x8=__attribute__((ext_vector_type(8)))short;
using s16x4=__attribute__((ext_vector_type(4)))short;
using f32x16=__attribute__((ext_vector_type(16)))float;
using u32x4=__attribute__((ext_vector_type(4)))unsigned;
constexpr int D=64;
constexpr int NW=8,QBLK=32,QB=QBLK*NW,KVBLK=64;
__device__ __forceinline__ int crow(int r,int hi){return (r&3)+8*(r>>2)+4*hi;}
#define SBAR() __builtin_amdgcn_sched_barrier(0)
__device__ __forceinline__ void cmask(f32x16&p0,f32x16&p1,int jb,int qrel,int hi){
  const float NEG=-INFINITY; int kb=64*jb+4*hi;
  #pragma unroll
  for(int r=0;r<16;++r){int kv=kb+(r&3)+8*(r>>2); if(kv>qrel)p0[r]=NEG; if(kv+32>qrel)p1[r]=NEG;}
}

constexpr int NSLOT=3, SLOTB=8192;
constexpr int LDS_K=0, LDS_V=NSLOT*SLOTB, LDS_WS=2*NSLOT*SLOTB, LDS_OST=LDS_WS+NW*64*4, LDS_BYTES=LDS_OST+NW*4096;
constexpr float C2=0.125f*1.4426950408889634f;
__device__ __forceinline__ void glds16(const void*gsrc,unsigned lds_dst){unsigned keep;
  asm volatile("s_mov_b32 %0, m0\n\ts_mov_b32 m0, %2\n\ts_nop 0\n\tglobal_load_lds_dwordx4 %1, off\n\ts_mov_b32 m0, %0":"=&s"(keep):"v"(gsrc),"s"(lds_dst):"memory");}
__device__ __forceinline__ float max3f(float a,float b,float c){float r;asm("v_max3_f32 %0, %1, %2, %3":"=v"(r):"v"(a),"v"(b),"v"(c));return r;}
__device__ __forceinline__ float max2f(float a,float b){float r;asm("v_max_f32_e32 %0, %1, %2":"=v"(r):"v"(a),"v"(b));return r;}
__device__ __forceinline__ float fadd_s(float a,float b){float r;asm("v_add_f32_e32 %0, %1, %2":"=v"(r):"v"(a),"v"(b));return r;}
__device__ __forceinline__ float fsub_s(float a,float b){float r;asm("v_sub_f32_e32 %0, %1, %2":"=v"(r):"v"(a),"v"(b));return r;}
typedef float f32x2_t __attribute__((ext_vector_type(2))); typedef __bf16 bf16x2_t __attribute__((ext_vector_type(2)));
__device__ __forceinline__ unsigned cvtpk_s(float lo,float hi){f32x2_t v={lo,hi};bf16x2_t b=__builtin_convertvector(v,bf16x2_t);return __builtin_bit_cast(unsigned,b);}
#define WAIT_BAR(N) asm volatile("s_waitcnt vmcnt(" #N ") lgkmcnt(0)\n\ts_barrier":::"memory")

__device__ __forceinline__ void qkt(f32x16&p0,f32x16&p1,const char*Kslot,const bf16x8*qr,const f32x16&negm,int r32,int hi){
  const char*kb=Kslot+hi*1024+r32*16;
  #pragma unroll
  for(int d0=0;d0<4;++d0){
    const bf16x8 b0=*reinterpret_cast<const bf16x8*>(kb+d0*2048);
    const bf16x8 b1=*reinterpret_cast<const bf16x8*>(kb+d0*2048+512);
    if(d0==0){p0=__builtin_amdgcn_mfma_f32_32x32x16_bf16(b0,qr[0],negm,0,0,0);p1=__builtin_amdgcn_mfma_f32_32x32x16_bf16(b1,qr[0],negm,0,0,0);}
    else{p0=__builtin_amdgcn_mfma_f32_32x32x16_bf16(b0,qr[d0],p0,0,0,0);p1=__builtin_amdgcn_mfma_f32_32x32x16_bf16(b1,qr[d0],p1,0,0,0);}}
}
typedef __attribute__((address_space(3))) const char* lds_cptr;
typedef short v4i16_t __attribute__((ext_vector_type(4)));
__device__ __forceinline__ void kload8(bf16x8*kf,lds_cptr kp){
  kf[0]=*(const __attribute__((address_space(3))) bf16x8*)(kp);      kf[1]=*(const __attribute__((address_space(3))) bf16x8*)(kp+512);
  kf[2]=*(const __attribute__((address_space(3))) bf16x8*)(kp+2048); kf[3]=*(const __attribute__((address_space(3))) bf16x8*)(kp+2560);
  kf[4]=*(const __attribute__((address_space(3))) bf16x8*)(kp+4096); kf[5]=*(const __attribute__((address_space(3))) bf16x8*)(kp+4608);
  kf[6]=*(const __attribute__((address_space(3))) bf16x8*)(kp+6144); kf[7]=*(const __attribute__((address_space(3))) bf16x8*)(kp+6656);
}
__device__ __forceinline__ void kload2(bf16x8*kf,lds_cptr kp,int j){ kf[2*j]=*(const __attribute__((address_space(3))) bf16x8*)(kp+j*2048); kf[2*j+1]=*(const __attribute__((address_space(3))) bf16x8*)(kp+j*2048+512); }
__device__ __forceinline__ s16x4 vtr(lds_cptr p){ return __builtin_bit_cast(s16x4,__builtin_amdgcn_ds_read_tr16_b64_v4i16((__attribute__((address_space(3))) v4i16_t*)p)); }
__device__ __forceinline__ float rowmax(const f32x16&p0,const f32x16&p1){
  float a=max3f(p0[0],p0[1],p1[0]),b=max3f(p0[2],p0[3],p1[1]);a=max3f(a,p1[2],p1[3]);
  #pragma unroll
  for(int r=4;r<16;r+=4){a=max3f(a,p0[r],p0[r+1]);b=max3f(b,p0[r+2],p0[r+3]);a=max3f(a,p1[r],p1[r+1]);b=max3f(b,p1[r+2],p1[r+3]);}
  const float m=max2f(a,b);
  auto rr=__builtin_amdgcn_permlane32_swap(__float_as_uint(m),__float_as_uint(m),false,false);
  return max2f(__uint_as_float(rr[0]),__uint_as_float(rr[1]));
}
__device__ __forceinline__ void pv(f32x16*o,int vb,bf16x8 pa0,bf16x8 pa1,bf16x8 pa2,bf16x8 pa3){
  #pragma unroll
  for(int d0=0;d0<2;++d0){s16x4 lo[4],hi[4];
    #pragma unroll
    for(int ks=0;ks<4;++ks){
      asm volatile("ds_read_b64_tr_b16 %0,%1 offset:%c2":"=&v"(lo[ks]):"v"(vb),"i"(d0*4096+ks*1024):"memory");
      asm volatile("ds_read_b64_tr_b16 %0,%1 offset:%c2":"=&v"(hi[ks]):"v"(vb),"i"(d0*4096+ks*1024+512):"memory");}
    asm volatile("s_waitcnt lgkmcnt(0)":::"memory");SBAR();
    #define PK(k) (bf16x8){lo[k][0],lo[k][1],lo[k][2],lo[k][3],hi[k][0],hi[k][1],hi[k][2],hi[k][3]}
    o[d0]=__builtin_amdgcn_mfma_f32_32x32x16_bf16(pa0,PK(0),o[d0],0,0,0);
    o[d0]=__builtin_amdgcn_mfma_f32_32x32x16_bf16(pa1,PK(1),o[d0],0,0,0);
    o[d0]=__builtin_amdgcn_mfma_f32_32x32x16_bf16(pa2,PK(2),o[d0],0,0,0);
    o[d0]=__builtin_amdgcn_mfma_f32_32x32x16_bf16(pa3,PK(3),o[d0],0,0,0);
    #undef PK
  }
}

#ifndef ATTN_STORE16
#define ATTN_STORE16(p,v) (*(u32x4*)(p)=(v))
#endif
template<int THRL> __device__ __forceinline__ void attn_unit(int qb,int SEQ,const bf16*Q,int QP,const bf16*__restrict__ K,const bf16*__restrict__ V,int KP,bf16*O,int OP,char*shm){
  int tid_=threadIdx.x; asm volatile("":"+v"(tid_)); const int tid=tid_,lane=tid&63,r32=lane&31,hi=lane>>5; const int wid=__builtin_amdgcn_readfirstlane(tid>>6);
  const int q0=qb*QB;
  const bf16*Qw=Q+(long)(q0+wid*QBLK)*QP;
  const bf16*Kh=K,*Vh=V;
  const unsigned lds0=(unsigned)(uintptr_t)shm;
  float*wsf=(float*)(shm+LDS_WS)+wid*64;
  const bf16*ksrc=Kh+(long)lane*KP+wid*8;
  const bf16*vsrc=Vh+(long)(16*(wid&3)+(lane>>2))*KP+(wid>>2)*32+(lane&3)*8;
  const unsigned kdst=lds0+LDS_K+wid*1024, vdst=lds0+LDS_V+wid*1024;
  #define DMA_K(t,slot) glds16(ksrc+(long)(t)*KVBLK*KP,(unsigned)__builtin_amdgcn_readfirstlane(kdst+(slot)))
  #define DMA_V(t,slot) glds16(vsrc+(long)(t)*KVBLK*KP,(unsigned)__builtin_amdgcn_readfirstlane(vdst+(slot)))
  const int vb0=(int)(lds0+LDS_V)+((lane>>4)&1)*32+(lane&3)*8+(4*hi+((lane&15)>>2))*64;
  const char*Kbase=shm+LDS_K; bf16x8 kf[8];
  const lds_cptr shm3=(lds_cptr)shm; const lds_cptr kp0=shm3+LDS_K+hi*1024+r32*16; const lds_cptr vp0=shm3+LDS_V+((lane>>4)&1)*32+(lane&3)*8+(4*hi+((lane&15)>>2))*64;
  const int NT=SEQ/KVBLK;
  DMA_K(0,0);DMA_V(0,0);DMA_K(1,SLOTB);
  bf16x8 qr[4];
  #pragma unroll
  for(int d0=0;d0<4;++d0)qr[d0]=*reinterpret_cast<const bf16x8*>(&Qw[(long)r32*QP+d0*16+hi*8]);
  float mhat=0.f,l_reg=0.f;f32x16 o[2];o[0]=f32x16{};o[1]=f32x16{};f32x16 negm=f32x16{};asm volatile("":"+v"(negm));
  const int qrel=wid*QBLK+r32;
  #define CMASK(P0,P1,t) do{}while(0)
  bool resc=false;
  #define START(P0,P1) do{ const float rm=rowmax(P0,P1); resc=false; \
    { const float dl=rm; mhat=fadd_s(mhat,dl); \
      _Pragma("unroll") for(int r=0;r<16;++r){P0[r]=fsub_s(P0[r],dl);P1[r]=fsub_s(P1[r],dl);} \
      _Pragma("unroll") for(int r=0;r<16;++r)negm[r]=-mhat; asm volatile("":"+v"(negm)); } \
    _Pragma("unroll") for(int r=0;r<16;++r)P0[r]=__builtin_amdgcn_exp2f(P0[r]); }while(0)
  #define RESC() do{ if(resc){ asm volatile("s_waitcnt lgkmcnt(0)":::"memory"); \
      _Pragma("unroll") for(int d_=0;d_<2;++d_) _Pragma("unroll") for(int r=0;r<16;++r)o[d_][r]*=wsf[crow(r,hi)]; } }while(0)
  f32x16 pA0,pA1,pB0,pB1;
  int sl_prev=0,sl_cur=0,sl_next=SLOTB;
  #define ROT() do{sl_prev=sl_cur;sl_cur=sl_next;sl_next=(sl_next==(NSLOT-1)*SLOTB)?0:sl_next+SLOTB;}while(0)
  DMA_K(2,2*SLOTB);
  WAIT_BAR(3);
  qkt(pA0,pA1,Kbase,qr,negm,r32,hi);asm volatile("s_nop 15\n\ts_nop 7":"+v"(pA0),"+v"(pA1));CMASK(pA0,pA1,0);
  START(pA0,pA1);
  _Pragma("unroll") for(int r=0;r<16;++r)pA1[r]=__builtin_amdgcn_exp2f(pA1[r]);
  WAIT_BAR(0);
  DMA_K(3,0);DMA_V(1,SLOTB);
  ROT();
  kload8(kf,kp0+sl_cur);
  WAIT_BAR(2);
  s16x4 vlo[8],vhi[8]; u32x4 pw0,pw1,pw2,pw3;
  #define PKW(P,B) cvtpk_s(P[B],P[B+1])
  #define PAF(k) __builtin_bit_cast(bf16x8,pw##k)
  #define VFR(i) (bf16x8){vlo[i][0],vlo[i][1],vlo[i][2],vlo[i][3],vhi[i][0],vhi[i][1],vhi[i][2],vhi[i][3]}
  #define PIN(x) asm volatile("":"+v"(x))
  #define MX3(a,b,c) __builtin_fmaxf(__builtin_fmaxf((a),(b)),(c))
  #define GAPA(MF,A0,A1,A2,A3,W0,W1,PW) do{ MF; sacc+=A0; sacc+=A1; sacc+=A2; sacc+=A3; PIN(sacc); W0; W1; PIN(PW); SBAR(); }while(0)
  #define EX(v) __builtin_amdgcn_exp2f(v)
  #define GAPB(MF,X,B) do{ MF; X[B]=EX(X[B]); X[B+1]=EX(X[B+1]); X[B+2]=EX(X[B+2]); X[B+3]=EX(X[B+3]); PIN(X); SBAR(); }while(0)
  #define VRD(i) do{ vlo[i]=vtr(vp_+(((i)>>2)*4096+((i)&3)*1024)); vhi[i]=vtr(vp_+(((i)>>2)*4096+((i)&3)*1024+512)); }while(0)
  #define KRD(G,j) do{ if(G){ kload2(kf,kp0+sl_next,j); SBAR(); } }while(0)
  #define STEP(C0,C1,P0,P1,t,GK,GV,GL) do{ SBAR(); \
    const lds_cptr vp_=vp0+sl_prev; \
    VRD(0); SBAR(); float sacc=(P0[0]+P0[1]); \
    GAPA(C0=__builtin_amdgcn_mfma_f32_32x32x16_bf16(kf[0],qr[0],negm,0,0,0), P0[2],P0[3],P0[4],P0[5],     pw0[0]=PKW(P0,0), pw0[1]=PKW(P0,2), pw0); \
    VRD(4); SBAR(); GAPA(C1=__builtin_amdgcn_mfma_f32_32x32x16_bf16(kf[1],qr[0],negm,0,0,0), P0[6],P0[7],P0[8],P0[9],     pw0[2]=PKW(P0,4), pw0[3]=PKW(P0,6), pw0); \
    VRD(1); SBAR(); GAPA(C0=__builtin_amdgcn_mfma_f32_32x32x16_bf16(kf[2],qr[1],C0,0,0,0),   P0[10],P0[11],P0[12],P0[13], pw1[0]=PKW(P0,8), pw1[1]=PKW(P0,10), pw1); \
    VRD(5); SBAR(); GAPA(C1=__builtin_amdgcn_mfma_f32_32x32x16_bf16(kf[3],qr[1],C1,0,0,0),   P0[14],P0[15],P1[0],P1[1],   pw1[2]=PKW(P0,12),pw1[3]=PKW(P0,14), pw1); \
    VRD(2); SBAR(); GAPA(C0=__builtin_amdgcn_mfma_f32_32x32x16_bf16(kf[4],qr[2],C0,0,0,0),   P1[2],P1[3],P1[4],P1[5],     pw2[0]=PKW(P1,0), pw2[1]=PKW(P1,2), pw2); \
    VRD(6); SBAR(); GAPA(C1=__builtin_amdgcn_mfma_f32_32x32x16_bf16(kf[5],qr[2],C1,0,0,0),   P1[6],P1[7],P1[8],P1[9],     pw2[2]=PKW(P1,4), pw2[3]=PKW(P1,6), pw2); \
    VRD(3); SBAR(); GAPA(C0=__builtin_amdgcn_mfma_f32_32x32x16_bf16(kf[6],qr[3],C0,0,0,0),   P1[10],P1[11],P1[12],P1[13], pw3[0]=PKW(P1,8), pw3[1]=PKW(P1,10), pw3); \
    VRD(7); SBAR(); GAPA(C1=__builtin_amdgcn_mfma_f32_32x32x16_bf16(kf[7],qr[3],C1,0,0,0),   P1[14],P1[15],0.f,0.f,       pw3[2]=PKW(P1,12),pw3[3]=PKW(P1,14), pw3); \
    l_reg+=sacc; \
    if(GK){DMA_K((t)+3,sl_cur);} if(GV){DMA_V((t)+1,sl_next);} \
    CMASK(C0,C1,t); \
    { float a=MX3(C0[0],C0[1],C1[0]),b=MX3(C0[2],C0[3],C1[1]); a=MX3(a,C1[2],C1[3]); \
      _Pragma("unroll") for(int r=4;r<16;r+=4){a=MX3(a,C0[r],C0[r+1]);b=MX3(b,C0[r+2],C0[r+3]);a=MX3(a,C1[r],C1[r+1]);b=MX3(b,C1[r+2],C1[r+3]);} \
      float rm=__builtin_fmaxf(a,b); { auto rr=__builtin_amdgcn_permlane32_swap(__float_as_uint(rm),__float_as_uint(rm),false,false); rm=__builtin_fmaxf(__uint_as_float(rr[0]),__uint_as_float(rr[1])); } \
      resc=false; \
      if(__builtin_expect(__any(rm>(float)THRL),0)){ const float dl=__builtin_fmaxf(rm,0.f); mhat+=dl; \
        _Pragma("unroll") for(int r=0;r<16;++r){C0[r]-=dl;C1[r]-=dl;} \
        _Pragma("unroll") for(int r=0;r<16;++r)negm[r]=-mhat; asm volatile("":"+v"(negm)); \
        const float f=__builtin_amdgcn_exp2f(-dl); l_reg*=f; if(hi==0)wsf[r32]=f; resc=true; } } \
    SBAR(); \
    GAPB(o[0]=__builtin_amdgcn_mfma_f32_32x32x16_bf16(PAF(0),VFR(0),o[0],0,0,0), C0,0); \
    GAPB(o[1]=__builtin_amdgcn_mfma_f32_32x32x16_bf16(PAF(0),VFR(4),o[1],0,0,0), C0,4); \
    KRD(GL,0); GAPB(o[0]=__builtin_amdgcn_mfma_f32_32x32x16_bf16(PAF(1),VFR(1),o[0],0,0,0), C0,8); \
    KRD(GL,1); GAPB(o[1]=__builtin_amdgcn_mfma_f32_32x32x16_bf16(PAF(1),VFR(5),o[1],0,0,0), C0,12); \
    KRD(GL,2); GAPB(o[0]=__builtin_amdgcn_mfma_f32_32x32x16_bf16(PAF(2),VFR(2),o[0],0,0,0), C1,0); \
    KRD(GL,3); GAPB(o[1]=__builtin_amdgcn_mfma_f32_32x32x16_bf16(PAF(2),VFR(6),o[1],0,0,0), C1,4); \
    GAPB(o[0]=__builtin_amdgcn_mfma_f32_32x32x16_bf16(PAF(3),VFR(3),o[0],0,0,0), C1,8); \
    GAPB(o[1]=__builtin_amdgcn_mfma_f32_32x32x16_bf16(PAF(3),VFR(7),o[1],0,0,0), C1,12); \
    }while(0)
  int t=1;
  #undef CMASK
  #define CMASK(P0,P1,t) do{}while(0)
  for(;t+5<NT;t+=2){
    STEP(pB0,pB1,pA0,pA1,t,true,true,true);     WAIT_BAR(2); RESC(); ROT();
    STEP(pA0,pA1,pB0,pB1,t+1,true,true,true);   WAIT_BAR(2); RESC(); ROT();
  }
  #undef CMASK
  #define CMASK(P0,P1,t) do{}while(0)
  #define ENDW(tt) do{ if((tt)+3<NT){WAIT_BAR(2);} else if((tt)+2<NT){WAIT_BAR(1);} else {WAIT_BAR(0);} }while(0)
  for(;t+1<NT;t+=2){
    STEP(pB0,pB1,pA0,pA1,t,(t+3<NT),(t+1<NT),(t+1<NT));       ENDW(t);   RESC(); ROT();
    STEP(pA0,pA1,pB0,pB1,t+1,(t+4<NT),(t+2<NT),(t+2<NT));     ENDW(t+1); RESC(); ROT();
  }
  STEP(pB0,pB1,pA0,pA1,NT-1,false,false,false); RESC();
  { float sacc=pB0[0]+pB0[1]; _Pragma("unroll") for(int r=2;r<16;++r)sacc+=pB0[r]; _Pragma("unroll") for(int r=0;r<16;++r)sacc+=pB1[r]; l_reg+=sacc;
    pw0=(u32x4){PKW(pB0,0),PKW(pB0,2),PKW(pB0,4),PKW(pB0,6)};pw1=(u32x4){PKW(pB0,8),PKW(pB0,10),PKW(pB0,12),PKW(pB0,14)};pw2=(u32x4){PKW(pB1,0),PKW(pB1,2),PKW(pB1,4),PKW(pB1,6)};pw3=(u32x4){PKW(pB1,8),PKW(pB1,10),PKW(pB1,12),PKW(pB1,14)};
    SBAR(); pv(o,vb0+sl_cur,PAF(0),PAF(1),PAF(2),PAF(3)); }
  #undef PKW
  #undef PAF
  #undef VFR
  #undef PIN
  #undef MX3
  #undef GAPA
  #undef GAPB
  #undef EX
  #undef VRD
  #undef KRD
  #undef STEP
  #undef ENDW
  {auto rr=__builtin_amdgcn_permlane32_swap(__float_as_uint(l_reg),__float_as_uint(l_reg),false,false);l_reg=__uint_as_float(rr[0])+__uint_as_float(rr[1]);}
  if(hi==0)wsf[32+r32]=l_reg;asm volatile("s_waitcnt lgkmcnt(0)":::"memory");
  float rli[16];
  #pragma unroll
  for(int r=0;r<16;++r)rli[r]=__builtin_amdgcn_rcpf(wsf[32+crow(r,hi)]);
  bf16*Ow=O+(long)(q0+wid*QBLK)*OP;
  { bf16*stg=(bf16*)(shm+LDS_OST)+wid*2048;
    #pragma unroll
    for(int r=0;r<16;++r){const int orow=crow(r,hi);
      #pragma unroll
      for(int d0=0;d0<2;++d0)stg[orow*64+d0*32+r32]=__float2bfloat16(o[d0][r]*rli[r]);}
    asm volatile("s_waitcnt lgkmcnt(0)":::"memory");
    #pragma unroll
    for(int i=0;i<4;++i){const int row=i*8+(lane>>3),ch=lane&7; const u32x4 v=*(const u32x4*)(stg+row*64+ch*8); ATTN_STORE16(Ow+(long)row*OP+ch*8,v);} }
  asm volatile("s_waitcnt lgkmcnt(0)\n\ts_barrier":::"memory");
  #undef DMA_K
  #undef DMA_V
  #undef CMASK
  #undef START
  #undef RESC
  #undef ROT
}
constexpr int ATTN_LDS_BYTES=LDS_BYTES;
#undef SBAR
#undef WAIT_BAR
}
namespace xb {
#define GAS __attribute__((address_space(1)))
#define LAS __attribute__((address_space(3)))
typedef GAS unsigned gu32;
typedef GAS unsigned long long gu64;
#define RLX_AGENT __ATOMIC_RELAXED, __HIP_MEMORY_SCOPE_AGENT
#define LDS_WAIT() asm volatile("s_waitcnt lgkmcnt(0)" ::: "memory")
#define VM_WAIT() asm volatile("s_waitcnt vmcnt(0)" ::: "memory")
__device__ __forceinline__ unsigned long long rt() { return __builtin_amdgcn_s_memrealtime(); }
__device__ __forceinline__ unsigned f2bf(float f) { unsigned u = __builtin_bit_cast(unsigned, f); return (u + 0x7fffu + ((u >> 16) & 1u)) >> 16; }
__device__ __forceinline__ unsigned pk2(float lo, float hi) { return f2bf(lo) | (f2bf(hi) << 16); }

#define XB_TMO      128
#define XB_XCNT(j)  (256  + 64 * (j))
#define XB_XSUB(j)  (1280 + 64 * (j))
#define XB_XGEN(j)  (2304 + 64 * (j))
#define XB_TOP      3328
#define XB_TOPGEN   3392
#define XCD_BAR_WORDS 3456
#define XB_SPIN_CAP (1u << 18)

__device__ __forceinline__ unsigned xb_ld(unsigned* p)              { return __hip_atomic_load(p, __ATOMIC_RELAXED, __HIP_MEMORY_SCOPE_AGENT); }
__device__ __forceinline__ unsigned xb_add(unsigned* p, unsigned v) { return __hip_atomic_fetch_add(p, v, __ATOMIC_RELAXED, __HIP_MEMORY_SCOPE_AGENT); }
__device__ __forceinline__ unsigned xb_xcc_id() { return (unsigned)__builtin_amdgcn_s_getreg((3 << 11) | 20) & 0xFu; }
#define XB_SPIN(cond, bar) do { unsigned _sp = 0; while (cond) { __builtin_amdgcn_s_sleep(1); \
    if ((++_sp & 255u) == 0u) { if (xb_ld(&(bar)[XB_TMO])) break; if (_sp > XB_SPIN_CAP) { atomicAdd(&(bar)[XB_TMO], 1u); break; } } } } while (0)

struct XcdBarrier {
    unsigned* bar; unsigned x;
    volatile LAS unsigned* st;
};

__device__ __forceinline__ XcdBarrier xcd_barrier_post(unsigned* bar, volatile LAS unsigned* st) {
    XcdBarrier b; b.bar = bar; b.x = xb_xcc_id(); b.st = st;
    if (threadIdx.x == 0) (void)xb_add(&bar[XB_XCNT(b.x)], 1u);
    return b;
}
__device__ __forceinline__ void xcd_barrier_complete(unsigned* bar, unsigned x, unsigned& nloc, unsigned& nx) {
    const unsigned G = gridDim.x * gridDim.y * gridDim.z;
    unsigned sum, cnt, mine, sp = 0u;
    for (;;) {
        sum = 0u; cnt = 0u; mine = 0u;
#pragma unroll
        for (unsigned j = 0; j < 16; ++j) { const unsigned c = xb_ld(&bar[XB_XCNT(j)]); sum += c; cnt += (c > 0u) ? 1u : 0u; mine = (j == x) ? c : mine; }
        if (sum == G) break;
        __builtin_amdgcn_s_sleep(1);
        if ((++sp & 255u) == 0u) { if (xb_ld(&bar[XB_TMO])) break; if (sp > XB_SPIN_CAP) { atomicAdd(&bar[XB_TMO], 1u); break; } }
    }
    nloc = mine > 0u ? mine : 1u; nx = cnt > 0u ? cnt : 1u;
}

__device__ __forceinline__ void xcd_barrier(const XcdBarrier& b) {
    asm volatile("s_waitcnt vmcnt(0)" ::: "memory");
    __syncthreads();
    if (threadIdx.x == 0) {
        unsigned* bar = b.bar;
        __builtin_amdgcn_s_waitcnt(0);
        unsigned nloc = b.st[0], nx = b.st[1];
        if (nloc == 0u) { xcd_barrier_complete(bar, b.x, nloc, nx); b.st[0] = nloc; b.st[1] = nx; }
        const unsigned old = xb_add(&bar[XB_XSUB(b.x)], 1u);
        const unsigned gen = old / nloc;
        if (old + 1u == (gen + 1u) * nloc) {
            __builtin_amdgcn_fence(__ATOMIC_RELEASE, "agent");
            asm volatile("s_waitcnt vmcnt(0)" ::: "memory");
            const unsigned og = xb_add(&bar[XB_TOP], 1u);
            const unsigned tg = og / nx;
            if (og + 1u == (tg + 1u) * nx) xb_add(&bar[XB_TOPGEN], 1u);
            else XB_SPIN(xb_ld(&bar[XB_TOPGEN]) == tg, bar);
            __builtin_amdgcn_fence(__ATOMIC_ACQUIRE, "agent");
            xb_add(&bar[XB_XGEN(b.x)], 1u);
            asm volatile("s_waitcnt vmcnt(0)" ::: "memory");
        } else {
            XB_SPIN(xb_ld(&bar[XB_XGEN(b.x)]) == gen, bar);
            __builtin_amdgcn_fence(__ATOMIC_ACQUIRE, "agent");
            asm volatile("s_waitcnt vmcnt(0)" ::: "memory");
        }
    }
    __syncthreads();
}

}

namespace mk {
typedef unsigned short bf16_t;
typedef short bf16x8 __attribute__((ext_vector_type(8)));
typedef float f32x4 __attribute__((ext_vector_type(4)));
typedef unsigned u32x4 __attribute__((ext_vector_type(4)));
typedef unsigned u32x2 __attribute__((ext_vector_type(2)));
typedef float f32x2 __attribute__((ext_vector_type(2)));

constexpr int DMODEL = 1024, TS = 16384, NSEG = 4, DFF = 4096;
constexpr int EIN = 1792, OIN = 4368, OINP = 4608, OOUT = 768;
constexpr float EPS = 1e-6f;
constexpr size_t MiB = (size_t)1 << 20;
constexpr size_t WS_W1T = 1 * MiB, WS_W2T = 33 * MiB, WS_WINE = 65 * MiB, WS_WOUTE = 72 * MiB, WS_WINO = 76 * MiB, WS_WOUTO = 94 * MiB,
                 WS_GW = 97 * MiB, WS_H = 98 * MiB, WS_PROJ = 130 * MiB, WS_SCR = 274 * MiB, WS_END = 512 * MiB;
constexpr size_t SC_HID = 0;
constexpr size_t SC_LA = 0, SC_UU = 64 * MiB, SC_AGG = 128 * MiB;
constexpr size_t SC_QKVP = 0, SC_DNI = 48 * MiB, SC_OB = 192 * MiB, SC_LSE = 224 * MiB, SC_EGL = 225 * MiB;
constexpr int DNI_BYTES = 73728, DNI_W = 0, DNI_QT = 16384, DNI_KTT = 32768, DNI_A = 49152, DNI_U = 57344;
constexpr int LDS_BYTES = 147456;
constexpr int NT = 512, NW = 8;

struct Params { const float* in[25]; float* out; unsigned char* ws; };

__device__ __forceinline__ float bf2f(bf16_t v) { return __uint_as_float(((unsigned)v) << 16); }
__device__ __forceinline__ unsigned f2bf(float f) { unsigned u = __float_as_uint(f); return (u + 0x7fffu + ((u >> 16) & 1u)) >> 16; }
__device__ __forceinline__ unsigned pk2(float lo, float hi) { return f2bf(lo) | (f2bf(hi) << 16); }
__device__ __forceinline__ float wave_sum(float v) {
#pragma unroll
    for (int o = 1; o < 64; o <<= 1) v += __shfl_xor(v, o);
    return v;
}
__device__ __forceinline__ float sigm(float x) { return 1.f / (1.f + __expf(-x)); }
__device__ __forceinline__ float softplus(float x) { return x > 20.f ? x : log1pf(__expf(x)); }
__device__ __forceinline__ float silu(float x) { return x * sigm(x); }
__device__ __forceinline__ float gelu_tanh(float x) { const float t = 0.7978845608028654f * (x + 0.044715f * x * x * x); return 0.5f * x * (1.f + tanhf(t)); }
__device__ __forceinline__ void unpack8(const u32x4 v, float* f) {
    f[0] = __uint_as_float(v.x << 16); f[1] = __uint_as_float(v.x & 0xffff0000u); f[2] = __uint_as_float(v.y << 16); f[3] = __uint_as_float(v.y & 0xffff0000u);
    f[4] = __uint_as_float(v.z << 16); f[5] = __uint_as_float(v.z & 0xffff0000u); f[6] = __uint_as_float(v.w << 16); f[7] = __uint_as_float(v.w & 0xffff0000u);
}
#define MK_IDS() int tid = threadIdx.x; asm volatile("" : "+v"(tid)); const int lane = tid & 63, wave = __builtin_amdgcn_readfirstlane(tid >> 6); const int gw = blockIdx.x * NW + wave, NGW = gridDim.x * NW; (void)lane; (void)wave; (void)gw; (void)NGW
#define MFMA16(a, b, c) __builtin_amdgcn_mfma_f32_16x16x32_bf16((a), (b), (c), 0, 0, 0)

__device__ __forceinline__ void transpose_item(const float* W, int K, int Nsrc, int Npad, bf16_t* WT, float* scr, int item, int lane) {
    const int nblk = Npad / 32, kb = item / nblk, nb = item % nblk, k0 = 64 * kb, n0 = 32 * nb;
    const int n = n0 + (lane & 31);
#pragma unroll 8
    for (int i = 0; i < 32; ++i) { const int kk = 2 * i + (lane >> 5); scr[kk * 33 + (lane & 31)] = (n < Nsrc) ? W[(size_t)(k0 + kk) * Nsrc + n] : 0.f; }
    asm volatile("s_waitcnt lgkmcnt(0)" ::: "memory");
    const int c = lane & 7;
#pragma unroll
    for (int j = 0; j < 4; ++j) { const int nn = (lane >> 3) + 8 * j; const float* s = scr + (8 * c) * 33 + nn;
        u32x4 o; o.x = pk2(s[0 * 33], s[1 * 33]); o.y = pk2(s[2 * 33], s[3 * 33]); o.z = pk2(s[4 * 33], s[5 * 33]); o.w = pk2(s[6 * 33], s[7 * 33]);
        *(u32x4*)(WT + (size_t)(n0 + nn) * K + k0 + 8 * c) = o; }
    asm volatile("s_waitcnt lgkmcnt(0)" ::: "memory");
}
__device__ __forceinline__ void phase_prologue(const Params& p, char* lds) {
    MK_IDS();
    float* scr = (float*)(lds + wave * 16384);
    unsigned char* ws = p.ws;
    constexpr int I_F1 = 16 * 128, I_F2 = 64 * 32, I_IE = 16 * 56, I_OE = 16 * 32, I_IO = 16 * 144, I_OO = 12 * 32;
    constexpr int T_F1 = 4 * I_F1, T_F2 = T_F1 + 4 * I_F2, T_IE = T_F2 + 2 * I_IE, T_OE = T_IE + 2 * I_OE, T_IO = T_OE + 2 * I_IO, T_OO = T_IO + 2 * I_OO;
    for (int it = gw; it < T_OO; it += NGW) {
        if (it < T_F1) { const int l = it / I_F1, r = it % I_F1; transpose_item(p.in[6] + (size_t)l * 1024 * 4096, 1024, 4096, 4096, (bf16_t*)(ws + WS_W1T) + (size_t)l * 4096 * 1024, scr, r, lane); }
        else if (it < T_F2) { const int q = it - T_F1, l = q / I_F2, r = q % I_F2; transpose_item(p.in[7] + (size_t)l * 4096 * 1024, 4096, 1024, 1024, (bf16_t*)(ws + WS_W2T) + (size_t)l * 1024 * 4096, scr, r, lane); }
        else if (it < T_IE) { const int q = it - T_F2, l = q / I_IE, r = q % I_IE; transpose_item(p.in[8] + (size_t)l * 1024 * EIN, 1024, EIN, EIN, (bf16_t*)(ws + WS_WINE) + (size_t)l * EIN * 1024, scr, r, lane); }
        else if (it < T_OE) { const int q = it - T_IE, l = q / I_OE, r = q % I_OE; transpose_item(p.in[9] + (size_t)l * 1024 * 1024, 1024, 1024, 1024, (bf16_t*)(ws + WS_WOUTE) + (size_t)l * 1024 * 1024, scr, r, lane); }
        else if (it < T_IO) { const int q = it - T_OE, l = q / I_IO, r = q % I_IO; transpose_item(p.in[19] + (size_t)l * 1024 * OIN, 1024, OIN, OINP, (bf16_t*)(ws + WS_WINO) + (size_t)l * OINP * 1024, scr, r, lane); }
        else { const int q = it - T_IO, l = q / I_OO, r = q % I_OO; transpose_item(p.in[20] + (size_t)l * OOUT * 1024, OOUT, 1024, 1024, (bf16_t*)(ws + WS_WOUTO) + (size_t)l * 1024 * OOUT, scr, r, lane); }
    }
    bf16_t* GW = (bf16_t*)(ws + WS_GW);
    const int gt = gw * 64 + lane, NGT = NGW * 64;
    for (int idx = gt; idx < 2 * 2 * 2 * 8 * 4096; idx += NGT) {
        const int d = idx & 63, e = (idx >> 6) & 63, blk = (idx >> 12) & 7, gate = (idx >> 15) & 1, dir = (idx >> 16) & 1, j = (idx >> 17) & 1;
        const float* src = gate ? p.in[16] : p.in[14];
        GW[idx] = (bf16_t)f2bf(src[((((size_t)j * 2 + dir) * 8 + blk) * 64 + d) * 64 + e]);
    }
}

__device__ __forceinline__ void phase_rmsnorm_bf16(const float* x, const float* g, bf16_t* h) {
    MK_IDS();
    for (int m = gw; m < TS; m += NGW) {
        const f32x4* xr = (const f32x4*)(x + (size_t)m * DMODEL) + lane; const f32x4* gr = (const f32x4*)g + lane;
        f32x4 v[4]; float s = 0.f;
#pragma unroll
        for (int j = 0; j < 4; ++j) { v[j] = xr[64 * j]; s += (v[j].x * v[j].x + v[j].y * v[j].y) + (v[j].z * v[j].z + v[j].w * v[j].w); }
        const float rstd = 1.f / sqrtf(wave_sum(s) * (1.f / DMODEL) + EPS);
        u32x2* o8 = (u32x2*)(h + (size_t)m * DMODEL) + lane;
#pragma unroll
        for (int j = 0; j < 4; ++j) { const f32x4 gg = gr[64 * j]; u32x2 o; o.x = pk2(v[j].x * rstd * gg.x, v[j].y * rstd * gg.y); o.y = pk2(v[j].z * rstd * gg.z, v[j].w * rstd * gg.w); o8[64 * j] = o; }
    }
}
__device__ __forceinline__ void phase_rmsnorm_final(float* x, const float* g) {
    MK_IDS();
    for (int m = gw; m < TS; m += NGW) {
        f32x4* xr = (f32x4*)(x + (size_t)m * DMODEL) + lane; const f32x4* gr = (const f32x4*)g + lane;
        f32x4 v[4]; float s = 0.f;
#pragma unroll
        for (int j = 0; j < 4; ++j) { v[j] = xr[64 * j]; s += (v[j].x * v[j].x + v[j].y * v[j].y) + (v[j].z * v[j].z + v[j].w * v[j].w); }
        const float rstd = 1.f / sqrtf(wave_sum(s) * (1.f / DMODEL) + EPS);
#pragma unroll
        for (int j = 0; j < 4; ++j) { const f32x4 gg = gr[64 * j]; xr[64 * j] = v[j] * rstd * gg; }
    }
}

struct EpiRes {
    static constexpr bool PERM = false, AFTER_DRAIN = false;
    const float* base; float* out; int ldc;
    __device__ __forceinline__ void operator()(const pg8::f32x4 (&acc)[2][2][4][2], const pg8::Unit& u, int wr, int wc, int fr, int fq) const {
        const int col0 = u.pn * pg8::BM + wc * 32 + 4 * fq;
#pragma unroll
        for (int ai = 0; ai < 2; ++ai)
#pragma unroll
            for (int m = 0; m < 4; ++m) { const size_t off = (size_t)(u.pm * pg8::BM + ai * pg8::HALF + wr * 64 + m * 16 + fr) * ldc + col0;
#pragma unroll
                for (int bj = 0; bj < 2; ++bj)
#pragma unroll
                    for (int n = 0; n < 2; ++n) { const pg8::f32x4 bs = *(const pg8::f32x4*)(base + off + bj * pg8::HALF + n * 16); *(pg8::f32x4*)(out + off + bj * pg8::HALF + n * 16) = bs + acc[ai][bj][m][n]; }
                asm volatile("" ::: "memory"); }
    }
};

__device__ __forceinline__ void even_qk_post(bf16_t* proj, const float* qg, const float* kg, int S) {
    MK_IDS();
    const int d = lane, axis = d >> 5, f = d & 15, half = (d >> 4) & 1;
    const float inv = exp2f(-(float)f * (13.287712379549449f / 16.f));
    const float gq = qg[d], gk = kg[d];
    for (int t = gw; t < TS; t += NGW) {
        const int s = t % S; const int pos = axis ? (s & 63) : (s >> 6);
        const float ang = (float)pos * inv; float sn, cs; sincosf(ang, &sn, &cs);
        bf16_t* row = proj + (size_t)t * EIN;
#pragma unroll
        for (int hh = 0; hh < 10; ++hh) {
            const int c0 = hh < 8 ? hh * 64 : 512 + (hh - 8) * 64;
            const float x = bf2f(row[c0 + d]);
            const float ss = wave_sum(x * x);
            const float y = x * (1.f / sqrtf(ss * (1.f / 64.f) + EPS)) * (hh < 8 ? gq : gk);
            const float pr = __shfl_xor(y, 16);
            float o = y * cs + (half ? pr : -pr) * sn;
            if (hh < 8) o *= attn_body::C2;
            row[c0 + d] = (bf16_t)f2bf(o);
        }
    }
}
__device__ __forceinline__ void even_lru_prep(const bf16_t* proj, const float* cw, const float* cb, const bf16_t* GWj, const float* br, const float* bi, const float* lam,
                                              float* LA, float* UU, f32x2* AGG, int S, char* lds) {
    MK_IDS();
    constexpr int XST = 1040;
    for (int tile = blockIdx.x; tile < TS / 64; tile += gridDim.x) {
        const int t0 = tile * 64;
        __syncthreads();
#pragma unroll 2
        for (int k = 0; k < 8; ++k) {
            const int idx = tid + k * NT, i = idx >> 6, cgp = idx & 63, t = t0 + i, s = t % S, ch = cgp * 8;
            float acc[8];
#pragma unroll
            for (int e = 0; e < 8; ++e) acc[e] = cb[ch + e];
#pragma unroll
            for (int j = 0; j < 4; ++j) { const int sp = s + j - 2;
                if (sp >= 0 && sp < S) { const u32x4 v = *(const u32x4*)(proj + (size_t)(t + j - 2) * EIN + 768 + ch); float xv[8]; unpack8(v, xv);
#pragma unroll
                    for (int e = 0; e < 8; ++e) acc[e] += cw[j * 512 + ch + e] * xv[e]; } }
            u32x4 o; o.x = pk2(acc[0], acc[1]); o.y = pk2(acc[2], acc[3]); o.z = pk2(acc[4], acc[5]); o.w = pk2(acc[6], acc[7]);
            *(u32x4*)(lds + i * XST + ch * 2) = o;
        }
        __syncthreads();
        const int G = lane >> 4, l16 = lane & 15, ch0 = wave * 64;
        for (int dir = 0; dir < 2; ++dir)
            for (int nt = 0; nt < 4; ++nt) {
                const int e = nt * 16 + l16, ch = ch0 + e;
                bf16x8 Br[2], Bi[2];
#pragma unroll
                for (int kk = 0; kk < 2; ++kk) {
                    Br[kk] = *(const bf16x8*)(GWj + ((((size_t)dir * 2 + 0) * 8 + wave) * 64 + e) * 64 + kk * 32 + G * 8);
                    Bi[kk] = *(const bf16x8*)(GWj + ((((size_t)dir * 2 + 1) * 8 + wave) * 64 + e) * 64 + kk * 32 + G * 8);
                }
                const float brv = br[dir * 512 + ch], biv = bi[dir * 512 + ch], spl = softplus(-lam[dir * 512 + ch]);
#pragma unroll
                for (int mt = 0; mt < 4; ++mt) {
                    f32x4 ar = {0.f, 0.f, 0.f, 0.f}, ai = {0.f, 0.f, 0.f, 0.f};
#pragma unroll
                    for (int kk = 0; kk < 2; ++kk) { const bf16x8 a = *(const bf16x8*)(lds + (mt * 16 + l16) * XST + (ch0 + kk * 32 + G * 8) * 2); ar = MFMA16(a, Br[kk], ar); ai = MFMA16(a, Bi[kk], ai); }
#pragma unroll
                    for (int r = 0; r < 4; ++r) { const int i = mt * 16 + G * 4 + r;
                        const float xc = bf2f(*(const bf16_t*)(lds + i * XST + ch * 2));
                        const float rg = sigm(ar[r] + brv), ig = sigm(ai[r] + biv);
                        const float la = -8.f * rg * spl; const float uu = sqrtf(fmaxf(-expm1f(2.f * la), 0.f)) * (ig * xc);
                        const size_t o = ((size_t)dir * TS + t0 + i) * 512 + ch; LA[o] = la; UU[o] = uu; }
                }
            }
        asm volatile("s_waitcnt vmcnt(0)" ::: "memory");
        __syncthreads();
        {
            const int ch = tid;
#pragma unroll
            for (int dir = 0; dir < 2; ++dir) {
                float h = 0.f, P = 0.f;
                const float* la = LA + ((size_t)dir * TS + t0) * 512 + ch; const float* uu = UU + ((size_t)dir * TS + t0) * 512 + ch;
#pragma unroll
                for (int q = 0; q < 64; q += 8) {
                    float lv[8], uv[8];
#pragma unroll
                    for (int e = 0; e < 8; ++e) { const int i = dir ? 63 - (q + e) : q + e; lv[e] = la[(size_t)i * 512]; uv[e] = uu[(size_t)i * 512]; }
#pragma unroll
                    for (int e = 0; e < 8; ++e) { h = __expf(lv[e]) * h + uv[e]; P += lv[e]; }
                }
                AGG[((size_t)dir * (TS / 64) + tile) * 512 + ch] = (f32x2){P, h};
            }
        }
    }
}
__device__ __forceinline__ void even_lru_scan(const float* LA, const float* UU, const f32x2* AGG, const bf16_t* proj, bf16_t* Y, int S) {
    MK_IDS();
    const int ch = tid, TPB = S / 64;
    for (int tile = blockIdx.x; tile < TS / 64; tile += gridDim.x) {
        const int t0 = tile * 64, tb0 = (tile / TPB) * TPB;
        float cf = 0.f, cr = 0.f;
        for (int k0 = tb0; k0 < tile; k0 += 8) { f32x2 a[8];
#pragma unroll
            for (int q = 0; q < 8; ++q) { const int k = k0 + q < tile ? k0 + q : tile - 1; a[q] = AGG[(size_t)k * 512 + ch]; }
#pragma unroll
            for (int q = 0; q < 8; ++q) if (k0 + q < tile) cf = cf * __expf(a[q].x) + a[q].y; }
        for (int k0 = tb0 + TPB - 1; k0 > tile; k0 -= 8) { f32x2 a[8];
#pragma unroll
            for (int q = 0; q < 8; ++q) { const int k = k0 - q > tile ? k0 - q : tile + 1; a[q] = AGG[((size_t)(TS / 64) + k) * 512 + ch]; }
#pragma unroll
            for (int q = 0; q < 8; ++q) if (k0 - q > tile) cr = cr * __expf(a[q].x) + a[q].y; }
        float hf[64];
        {
            const float* la = LA + (size_t)t0 * 512 + ch; const float* uu = UU + (size_t)t0 * 512 + ch; float h = cf;
#pragma unroll
            for (int q = 0; q < 64; q += 8) {
                float lv[8], uv[8];
#pragma unroll
                for (int e = 0; e < 8; ++e) { lv[e] = la[(size_t)(q + e) * 512]; uv[e] = uu[(size_t)(q + e) * 512]; }
#pragma unroll
                for (int e = 0; e < 8; ++e) { h = __expf(lv[e]) * h + uv[e]; hf[q + e] = h; }
            }
        }
        {
            const float* la = LA + ((size_t)TS + t0) * 512 + ch; const float* uu = UU + ((size_t)TS + t0) * 512 + ch; float h = cr;
#pragma unroll
            for (int q = 0; q < 64; q += 8) {
                float lv[8], uv[8], gv[8];
#pragma unroll
                for (int e = 0; e < 8; ++e) { const int i = 63 - (q + e); lv[e] = la[(size_t)i * 512]; uv[e] = uu[(size_t)i * 512]; gv[e] = bf2f(proj[(size_t)(t0 + i) * EIN + 1280 + ch]); }
#pragma unroll
                for (int e = 0; e < 8; ++e) { const int i = 63 - (q + e); h = __expf(lv[e]) * h + uv[e]; Y[(size_t)(t0 + i) * DMODEL + 512 + ch] = (bf16_t)f2bf((hf[i] + h) * gelu_tanh(gv[e])); }
            }
        }
    }
}

__device__ __forceinline__ void odd_conv(const bf16_t* proj, const float* cw, bf16_t* QKVP, int S) {
    MK_IDS();
    for (int t = gw; t < TS; t += NGW) {
        const int s = t % S;
#pragma unroll
        for (int blk = 0; blk < 3; ++blk) {
            const int ch = blk * 512 + lane * 8;
            float acc[8];
#pragma unroll
            for (int e = 0; e < 8; ++e) acc[e] = 0.f;
#pragma unroll
            for (int j = 0; j < 4; ++j) { const int sp = s + j - 2;
                if (sp >= 0 && sp < S) { const u32x4 v = *(const u32x4*)(proj + (size_t)(t + j - 2) * OINP + ch); float xv[8]; unpack8(v, xv);
                    const f32x4 w0 = *(const f32x4*)(cw + j * 1536 + ch), w1 = *(const f32x4*)(cw + j * 1536 + ch + 4);
                    acc[0] += w0.x * xv[0]; acc[1] += w0.y * xv[1]; acc[2] += w0.z * xv[2]; acc[3] += w0.w * xv[3];
                    acc[4] += w1.x * xv[4]; acc[5] += w1.y * xv[5]; acc[6] += w1.z * xv[6]; acc[7] += w1.w * xv[7]; } }
            float ss = 0.f;
#pragma unroll
            for (int e = 0; e < 8; ++e) { acc[e] = silu(acc[e]); ss += acc[e] * acc[e]; }
            if (blk < 2) {
                ss += __shfl_xor(ss, 1); ss += __shfl_xor(ss, 2); ss += __shfl_xor(ss, 4); ss += __shfl_xor(ss, 8);
                const float rn = 1.f / sqrtf(ss + EPS);
#pragma unroll
                for (int e = 0; e < 8; ++e) acc[e] *= rn;
            }
            u32x4 o; o.x = pk2(acc[0], acc[1]); o.y = pk2(acc[2], acc[3]); o.z = pk2(acc[4], acc[5]); o.w = pk2(acc[6], acc[7]);
            *(u32x4*)(QKVP + (size_t)t * 1536 + ch) = o;
        }
    }
}

__device__ __forceinline__ int frag128(int r, int k) { return ((((r >> 4) * 4 + (k >> 5)) * 64 + ((k >> 3) & 3) * 16 + (r & 15)) << 3) + (k & 7); }
__device__ __forceinline__ int frag64(int r, int k) { return ((((r >> 4) * 2 + (k >> 5)) * 64 + ((k >> 3) & 3) * 16 + (r & 15)) << 3) + (k & 7); }
__device__ __forceinline__ void odd_prep(const bf16_t* QKVP, const bf16_t* proj, const float* alog, const float* dtb, unsigned char* DNI, float* EGL, char* lds) {
    MK_IDS();
    constexpr int RS = 272;
    constexpr int HOFF = 69632;
    const float scale = 0.08838834764831845f;
    for (int it0 = blockIdx.x * 2; it0 < 2048; it0 += gridDim.x * 2) {
        int tq_ = tid; asm volatile("" : "+v"(tq_));
        const int half = tq_ >> 8, ht = tq_ & 255, hwave = __builtin_amdgcn_readfirstlane(ht >> 6), G = (tq_ & 63) >> 4, l16 = tq_ & 15;
        char* L = lds + half * HOFF;
        char* KS = L, *QS = L + 17408, *VS = L + 34816; float* LM = (float*)(L + 52224); float* GC = (float*)(L + 68608); float* BT = GC + 64; float* EG = BT + 64;
        const int it = it0 + half; const int d = it & 1, h = (it >> 1) & 3, c = it >> 3, t0 = c * 64;
        __syncthreads();
#pragma unroll
        for (int k = 0; k < 4; ++k) { const int idx = ht + k * 256, i = idx >> 4, pc = idx & 15; const int tk = d ? t0 + 63 - i : t0 + i;
            const bf16_t* src = QKVP + (size_t)tk * 1536 + h * 128 + pc * 8;
            *(u32x4*)(QS + i * RS + pc * 16) = *(const u32x4*)(src);
            *(u32x4*)(KS + i * RS + pc * 16) = *(const u32x4*)(src + 512);
            *(u32x4*)(VS + i * RS + pc * 16) = *(const u32x4*)(src + 1024); }
        if (hwave == 0) {
            const int i = lane; const int tk = d ? t0 + 63 - i : t0 + i;
            const float bl = bf2f(proj[(size_t)tk * OINP + 2048 + d * 4 + h]), al = bf2f(proj[(size_t)tk * OINP + 2056 + d * 4 + h]);
            const float beta = sigm(bl); float g = -__expf(alog[d * 4 + h]) * softplus(al + dtb[d * 4 + h]);
#pragma unroll
            for (int o = 1; o < 64; o <<= 1) { const float v = __shfl_up(g, o); if (lane >= o) g += v; }
            GC[i] = g; BT[i] = beta; EG[i] = __expf(g);
        }
        __syncthreads();
        {
            const bool isq = hwave >= 2; const char* XS = isq ? QS : KS;
#pragma unroll
            for (int mm = 0; mm < 2; ++mm) { const int mt = (hwave & 1) * 2 + mm;
                bf16x8 a[4];
#pragma unroll
                for (int kk = 0; kk < 4; ++kk) a[kk] = *(const bf16x8*)(XS + (mt * 16 + l16) * RS + (kk * 32 + G * 8) * 2);
#pragma unroll
                for (int nt = 0; nt < 4; ++nt) { f32x4 acc = {0.f, 0.f, 0.f, 0.f};
#pragma unroll
                    for (int kk = 0; kk < 4; ++kk) { const bf16x8 bb = *(const bf16x8*)(KS + (nt * 16 + l16) * RS + (kk * 32 + G * 8) * 2); acc = MFMA16(a[kk], bb, acc); }
                    const int j = nt * 16 + l16; const float gj = GC[j];
#pragma unroll
                    for (int r = 0; r < 4; ++r) { const int i = mt * 16 + G * 4 + r; const float dec = __expf(fminf(GC[i] - gj, 0.f));
                        if (!isq) LM[i * 64 + j] = (j < i) ? BT[i] * acc[r] * dec : 0.f;
                        else ((bf16_t*)(DNI + (size_t)it * DNI_BYTES + DNI_A))[frag64(i, j)] = (bf16_t)f2bf((j <= i) ? acc[r] * scale * dec : 0.f); }
                }
            }
        }
        __syncthreads();
        {
            float sol[64];
            const int cc = ht & 127; const bool isw = ht >= 128; const char* XS = isw ? KS : VS;
#pragma unroll
            for (int i = 0; i < 64; ++i) {
                float v = bf2f(*(const bf16_t*)(XS + i * RS + cc * 2)) * BT[i]; if (isw) v *= EG[i];
#pragma unroll
                for (int j4 = 0; j4 < (i + 3) / 4; ++j4) { const f32x4 l4 = *(const f32x4*)(LM + i * 64 + j4 * 4);
                    if (j4 * 4 + 0 < i) v -= l4.x * sol[j4 * 4 + 0]; if (j4 * 4 + 1 < i) v -= l4.y * sol[j4 * 4 + 1];
                    if (j4 * 4 + 2 < i) v -= l4.z * sol[j4 * 4 + 2]; if (j4 * 4 + 3 < i) v -= l4.w * sol[j4 * 4 + 3];
                    if ((j4 & 3) == 3) asm volatile("" ::: "memory"); }
                sol[i] = v;
                ((bf16_t*)(DNI + (size_t)it * DNI_BYTES + (isw ? DNI_W : DNI_U)))[isw ? frag128(i, cc) : i * 128 + cc] = (bf16_t)f2bf(v);
                asm volatile("" ::: "memory");
            }
        }
        {
            const float gl = GC[63];
#pragma unroll 4
            for (int k = 0; k < 32; ++k) { const int idx = ht + k * 256;
                { const int i = idx >> 7, dm = idx & 127; ((bf16_t*)(DNI + (size_t)it * DNI_BYTES + DNI_QT))[frag128(i, dm)] = (bf16_t)f2bf(bf2f(*(const bf16_t*)(QS + i * RS + dm * 2)) * scale * EG[i]); }
                { const int i = idx & 63, dm = idx >> 6; ((bf16_t*)(DNI + (size_t)it * DNI_BYTES + DNI_KTT))[frag64(dm, i)] = (bf16_t)f2bf(bf2f(*(const bf16_t*)(KS + i * RS + dm * 2)) * __expf(gl - GC[i])); }
            }
            if (ht == 0) EGL[it] = __expf(gl);
        }
    }
}

__device__ __forceinline__ void odd_scan(const unsigned char* DNI, const float* EGL, bf16_t* OB, int S, int nb, char* lds) {
    MK_IDS();
    constexpr int O_SB = 0, O_VN = 4352, O_OUT = 6656;
    const int NC = S / 64, G = lane >> 4, l16 = lane & 15;
    const int nitems = nb * 64;
    const int mt = wave & 3; const bool lo = wave < 4;
    for (int item = blockIdx.x; item < nitems; item += gridDim.x) {
        const int e = (item >> 3) & 7, sq = (item & 7) | ((item >> 6) << 3); const int d = sq & 1, h = (sq >> 1) & 3, b = sq >> 3;
        __syncthreads();
        for (int i = tid; i < 4352 / 4; i += NT) ((unsigned*)(lds + O_SB))[i] = 0u;
        f32x4 Sreg = {0.f, 0.f, 0.f, 0.f};
        const unsigned xoff = (lo ? DNI_W : DNI_QT) + ((mt * 4) * 64 + lane) * 16;
        const unsigned aoff = DNI_A + ((mt * 2) * 64 + lane) * 16;
        const unsigned koff = DNI_KTT + ((wave * 2) * 64 + lane) * 16;
        const unsigned uoff = DNI_U + ((mt * 16 + G * 4) * 128 + e * 16 + l16) * 2;
        u32x4 aX[4], aA[2], aK[2], bX[4], bA[2], bK[2], cX[4], cA[2], cK[2], dX[4], dA[2], dK[2];
        unsigned aU[4], bU[4], cU[4], dU[4]; float aE, bE, cE, dE; unsigned pf_dummy = 0u;
#define DN_LOAD(n, P) do { const int it_ = ((b * NC + (d ? NC - 1 - (n) : (n))) * 4 + h) * 2 + d; const unsigned char* ip = DNI + (size_t)it_ * DNI_BYTES; \
            _Pragma("unroll") for (int kk = 0; kk < 4; ++kk) P##X[kk] = *(const u32x4*)(ip + xoff + kk * 1024); \
            _Pragma("unroll") for (int kk = 0; kk < 2; ++kk) { P##A[kk] = *(const u32x4*)(ip + aoff + kk * 1024); P##K[kk] = *(const u32x4*)(ip + koff + kk * 1024); } \
            _Pragma("unroll") for (int r = 0; r < 4; ++r) P##U[r] = *(const bf16_t*)(ip + uoff + r * 256); \
            P##E = EGL[it_]; } while (0)
#define DN_STEP(n, P, PL) do { \
            { const int nn_ = (n) + 3 < NC ? (n) + 3 : NC - 1; DN_LOAD(nn_, PL); } \
            if (wave < 3) { const int np_ = (n) + PFD < NC ? (n) + PFD : NC - 1; const int itp_ = ((b * NC + (d ? NC - 1 - np_ : np_)) * 4 + h) * 2 + d; \
              const unsigned char* pp_ = DNI + (size_t)itp_ * DNI_BYTES + e * 9216 + (tid < 144 ? tid : 143) * 64; \
              asm volatile("global_load_dword %0, %1, off" : "+v"(pf_dummy) : "v"(pp_) : "memory"); } \
            f32x4 acc = {0.f, 0.f, 0.f, 0.f}; \
            _Pragma("unroll") for (int kk = 0; kk < 4; ++kk) { const bf16x8 bb = *(const bf16x8*)(lds + O_SB + l16 * 272 + (kk * 32 + G * 8) * 2); acc = MFMA16(__builtin_bit_cast(bf16x8, P##X[kk]), bb, acc); } \
            if (lo) { u32x2 o; float v[4]; \
              _Pragma("unroll") for (int r = 0; r < 4; ++r) v[r] = __uint_as_float(P##U[r] << 16) - acc[r]; \
              o.x = pk2(v[0], v[1]); o.y = pk2(v[2], v[3]); \
              *(u32x2*)(lds + O_VN + l16 * 144 + (mt * 16 + G * 4) * 2) = o; } \
            asm volatile("s_waitcnt lgkmcnt(0)\n\ts_barrier" ::: "memory"); \
            bf16x8 vb[2]; \
            _Pragma("unroll") for (int kk = 0; kk < 2; ++kk) vb[kk] = *(const bf16x8*)(lds + O_VN + l16 * 144 + (kk * 32 + G * 8) * 2); \
            Sreg = Sreg * P##E; \
            _Pragma("unroll") for (int kk = 0; kk < 2; ++kk) Sreg = MFMA16(__builtin_bit_cast(bf16x8, P##K[kk]), vb[kk], Sreg); \
            { u32x2 o; o.x = pk2(Sreg[0], Sreg[1]); o.y = pk2(Sreg[2], Sreg[3]); \
              *(u32x2*)(lds + O_SB + l16 * 272 + (wave * 16 + G * 4) * 2) = o; } \
            if (!lo) { \
              _Pragma("unroll") for (int kk = 0; kk < 2; ++kk) acc = MFMA16(__builtin_bit_cast(bf16x8, P##A[kk]), vb[kk], acc); \
              _Pragma("unroll") for (int r = 0; r < 4; ++r) *(bf16_t*)(lds + O_OUT + ((mt * 16 + G * 4 + r) * 16 + l16) * 2) = (bf16_t)f2bf(acc[r]); } \
            asm volatile("s_waitcnt lgkmcnt(0)\n\ts_barrier" ::: "memory"); \
            { const int t0 = (b * NC + (d ? NC - 1 - (n) : (n))) * 64; const int i = tid >> 3; const int tk = d ? t0 + 63 - i : t0 + i; \
              *(unsigned*)(OB + ((size_t)d * TS + tk) * 512 + h * 128 + e * 16 + (tid & 7) * 2) = *(const unsigned*)(lds + O_OUT + tid * 4); } } while (0)
        DN_LOAD(0, a); DN_LOAD(1, b); DN_LOAD(2, c);
        __syncthreads();
        constexpr int PFD = 7;
        for (int n = 0; n < NC; n += 4) {
            DN_STEP(n, a, d);
            DN_STEP(n + 1, b, a);
            DN_STEP(n + 2, c, b);
            DN_STEP(n + 3, d, c);
        }
#undef DN_STEP
#undef DN_LOAD
        asm volatile("s_waitcnt vmcnt(0)" ::: "memory");
        asm volatile("" :: "v"(pf_dummy));
    }
}

__device__ __forceinline__ int t5_bucket(int rel) {
    const int n = rel < 0 ? -rel : rel; int v;
    if (n < 8) v = n; else v = 8 + (n >= 15) + (n >= 27) + (n >= 50) + (n >= 91) + (n >= 166) + (n >= 305) + (n >= 559);
    return (rel > 0 ? 16 : 0) + v;
}
__device__ __forceinline__ void odd_dilated(bf16_t* proj, const float* relb, float* LSE, int S, char* lds, int first_wg, int n_wg) {
    MK_IDS();
    constexpr int KST = 144, VST = 400, HOFF = 27648 + 25600 + 1024;
    const int half = tid >> 8, ht = tid & 255, wv = ht >> 6, G = lane >> 4, l16 = lane & 15;
    char* L = lds + half * HOFF; char* KS = L; char* VT = L + 27648; float* BIAS = (float*)(L + 27648 + 25600);
    const int NBb = S / 64;
    const int wgi = (int)blockIdx.x - first_wg;
    if (wgi < 0) return;
    for (int it0 = wgi * 2; it0 < 3072; it0 += n_wg * 2) {
        const int it = it0 + half; const int zb = it & 255, sl = (it >> 8) & 3, g = it >> 10;
        const int dil = g == 0 ? 1 : (g == 1 ? 4 : 16), lg = g * 2;
        const int M = S >> lg, MB = M / 64;
        const int b = zb / NBb, r0 = zb % NBb, rho = r0 / MB, n = r0 % MB;
        const int hc = (g * 4 + sl) * 64;
        const size_t tb = (size_t)b * S;
        __syncthreads();
#pragma unroll
        for (int k = 0; k < 6; ++k) { const int idx = ht + k * 256, kj = idx >> 3, pc = idx & 7; const int mk = 64 * n - 64 + kj;
            u32x4 kv = {0u, 0u, 0u, 0u}, vv = {0u, 0u, 0u, 0u};
            if (mk >= 0 && mk < M) { const bf16_t* rowp = proj + (tb + (size_t)mk * dil + rho) * OINP; kv = *(const u32x4*)(rowp + 2832 + hc + pc * 8); vv = *(const u32x4*)(rowp + 3600 + hc + pc * 8); }
            *(u32x4*)(KS + kj * KST + pc * 16) = kv;
            const unsigned w[4] = {vv.x, vv.y, vv.z, vv.w};
#pragma unroll
            for (int q = 0; q < 4; ++q) { *(bf16_t*)(VT + (pc * 8 + 2 * q) * VST + kj * 2) = (bf16_t)(w[q] & 0xffffu); *(bf16_t*)(VT + (pc * 8 + 2 * q + 1) * VST + kj * 2) = (bf16_t)(w[q] >> 16); } }
        if (ht < 129) BIAS[ht] = relb[t5_bucket((ht - 64) * dil) * 12 + g * 4 + sl];
        const int mq = 64 * n + 16 * wv + l16; const size_t tq = tb + (size_t)mq * dil + rho;
        bf16x8 qf[2];
#pragma unroll
        for (int kk = 0; kk < 2; ++kk) qf[kk] = *(const bf16x8*)(proj + tq * OINP + 2064 + hc + kk * 32 + G * 8);
        __syncthreads();
        f32x4 sc[9]; float mx = -1e30f;
#pragma unroll
        for (int kt = 0; kt < 9; ++kt) { f32x4 acc = {0.f, 0.f, 0.f, 0.f};
#pragma unroll
            for (int kk = 0; kk < 2; ++kk) { const bf16x8 a = *(const bf16x8*)(KS + ((wv + kt) * 16 + l16) * KST + (kk * 32 + G * 8) * 2); acc = MFMA16(a, qf[kk], acc); }
#pragma unroll
            for (int r = 0; r < 4; ++r) { const int kj = (wv + kt) * 16 + G * 4 + r; const int delta = kj - 64 - 16 * wv - l16; const int mk = 64 * n - 64 + kj;
                const bool ok = (delta >= -64) && (delta <= 64) && (mk >= 0) && (mk < M);
                const float s = ok ? acc[r] * 0.125f + BIAS[(delta < -64 ? -64 : (delta > 64 ? 64 : delta)) + 64] : -1e30f;
                acc[r] = s; mx = fmaxf(mx, s); }
            sc[kt] = acc; }
        mx = fmaxf(mx, __shfl_xor(mx, 16)); mx = fmaxf(mx, __shfl_xor(mx, 32));
        float sum = 0.f;
#pragma unroll
        for (int kt = 0; kt < 9; ++kt)
#pragma unroll
            for (int r = 0; r < 4; ++r) { const float pv_ = (sc[kt][r] > -1e29f) ? __expf(sc[kt][r] - mx) : 0.f; sc[kt][r] = pv_; sum += pv_; }
        sum += __shfl_xor(sum, 16); sum += __shfl_xor(sum, 32);
        f32x4 ot[4];
#pragma unroll
        for (int dt = 0; dt < 4; ++dt) ot[dt] = (f32x4){0.f, 0.f, 0.f, 0.f};
#pragma unroll
        for (int pp = 0; pp < 5; ++pp) {
            u32x4 pb; pb.x = pk2(sc[2 * pp][0], sc[2 * pp][1]); pb.y = pk2(sc[2 * pp][2], sc[2 * pp][3]);
            if (pp < 4) { pb.z = pk2(sc[2 * pp + 1][0], sc[2 * pp + 1][1]); pb.w = pk2(sc[2 * pp + 1][2], sc[2 * pp + 1][3]); } else { pb.z = 0u; pb.w = 0u; }
            const bf16x8 pbf = __builtin_bit_cast(bf16x8, pb);
#pragma unroll
            for (int dt = 0; dt < 4; ++dt) {
                u32x4 av; const u32x2 lo = *(const u32x2*)(VT + (dt * 16 + l16) * VST + ((wv + 2 * pp) * 16 + G * 4) * 2); av.x = lo.x; av.y = lo.y;
                if (pp < 4) { const u32x2 hi = *(const u32x2*)(VT + (dt * 16 + l16) * VST + ((wv + 2 * pp + 1) * 16 + G * 4) * 2); av.z = hi.x; av.w = hi.y; } else { av.z = 0u; av.w = 0u; }
                ot[dt] = MFMA16(__builtin_bit_cast(bf16x8, av), pbf, ot[dt]);
            }
        }
        const float rs = 1.f / sum;
        float* od = (float*)(proj + tq * OINP) + (g * 4 + sl) * 64;
#pragma unroll
        for (int dt = 0; dt < 4; ++dt) *(f32x4*)(od + dt * 16 + G * 4) = ot[dt] * rs;
        if (G == 0) LSE[tq * 12 + g * 4 + sl] = mx + __logf(sum);
    }
}

__device__ __forceinline__ void odd_combine(const bf16_t* OB, const bf16_t* proj, const float* LSE, const float* og, bf16_t* Y) {
    MK_IDS();
    const float g0 = og[lane * 2], g1 = og[lane * 2 + 1];
    for (int t = gw; t < TS; t += NGW) {
        const bf16_t* prow = proj + (size_t)t * OINP;
#pragma unroll
        for (int hh = 0; hh < 4; ++hh) {
            const unsigned a = *(const unsigned*)(OB + (size_t)t * 512 + hh * 128 + lane * 2), bb = *(const unsigned*)(OB + ((size_t)TS + t) * 512 + hh * 128 + lane * 2);
            const unsigned zz = *(const unsigned*)(prow + 1536 + hh * 128 + lane * 2);
            const float o0 = __uint_as_float(a << 16) + __uint_as_float(bb << 16), o1 = __uint_as_float(a & 0xffff0000u) + __uint_as_float(bb & 0xffff0000u);
            const float ss = wave_sum(o0 * o0 + o1 * o1); const float rn = 1.f / sqrtf(ss * (1.f / 128.f) + EPS);
            const float z0 = __uint_as_float(zz << 16), z1 = __uint_as_float(zz & 0xffff0000u);
            *(unsigned*)(Y + (size_t)t * OOUT + hh * 128 + lane * 2) = pk2(o0 * rn * g0 * silu(z0), o1 * rn * g1 * silu(z1));
        }
        const float* od = (const float*)prow;
#pragma unroll
        for (int sl = 0; sl < 4; ++sl) {
            const float l0 = LSE[(size_t)t * 12 + sl], l1 = LSE[(size_t)t * 12 + 4 + sl], l2 = LSE[(size_t)t * 12 + 8 + sl];
            const float m = fmaxf(l0, fmaxf(l1, l2)); const float w0 = __expf(l0 - m), w1 = __expf(l1 - m), w2 = __expf(l2 - m); const float rs = 1.f / (w0 + w1 + w2);
            const float v = (w0 * od[sl * 64 + lane] + w1 * od[256 + sl * 64 + lane] + w2 * od[512 + sl * 64 + lane]) * rs;
            Y[(size_t)t * OOUT + 512 + sl * 64 + lane] = (bf16_t)f2bf(v);
        }
    }
}

__global__ void __launch_bounds__(NT, 2) fwd_megakernel(Params p) {
    extern __shared__ __attribute__((aligned(16))) unsigned char lds_raw[];
    cg::grid_group grid = cg::this_grid();
    char* lds = (char*)lds_raw;
    PG8_LAS unsigned char* ldsl = (PG8_LAS unsigned char*)lds_raw;
    const int Gr = gridDim.x;
    volatile LAS unsigned* MISC = (volatile LAS unsigned*)((PG8_LAS unsigned char*)lds_raw + (LDS_BYTES - 128));
    if (threadIdx.x < 32) MISC[threadIdx.x] = 0u;
    __syncthreads();
    xb::XcdBarrier bar = xb::xcd_barrier_post((unsigned*)p.ws, MISC + 8);
#define GSYNC() xb::xcd_barrier(bar)
    unsigned char* ws = p.ws;
    bf16_t* H = (bf16_t*)(ws + WS_H); bf16_t* PROJ = (bf16_t*)(ws + WS_PROJ); unsigned char* SCR = ws + WS_SCR;

    phase_prologue(p, lds);
    grid.sync();

    for (int seg = 0; seg < NSEG; ++seg) {
        const int S = seg < 2 ? 16384 : 2048, nb = seg < 2 ? 1 : 8;
        const float* xin = (seg < 2 ? p.in[0] : p.in[1]) + (size_t)(seg & 1) * TS * DMODEL;
        float* xo = p.out + (size_t)seg * TS * DMODEL;
        for (int layer = 0; layer < 4; ++layer) {
            const float* xcur = layer == 0 ? xin : xo;
            const int j = layer >> 1; const bool odd = layer & 1;
            phase_rmsnorm_bf16(xcur, p.in[3] + layer * DMODEL, H);
            GSYNC();
            {
                const int N = odd ? OINP : EIN;
                const bf16_t* Bt = odd ? (const bf16_t*)(ws + WS_WINO) + (size_t)j * OINP * 1024 : (const bf16_t*)(ws + WS_WINE) + (size_t)j * EIN * 1024;
                pg8::Gemm g{H, Bt, TS, N, 1024}; pg8::StaticOrder So; So.init(TS, N, Gr, (int)blockIdx.x);
                pg8::EpiBf16<0> E{PROJ, N, nullptr, 0, 0, 1.f};
                pg8::gemm_phase<pg8::EpiBf16<0>, pg8::StaticOrder, true, true>(ldsl, g, So, E);
            }
            GSYNC();
            if (!odd) {
                even_qk_post(PROJ, p.in[10] + j * 64, p.in[11] + j * 64, S);
                even_lru_prep(PROJ, p.in[12] + j * 2048, p.in[13] + j * 512, (const bf16_t*)(ws + WS_GW) + (size_t)j * 2 * 2 * 8 * 4096, p.in[15] + j * 1024, p.in[17] + j * 1024, p.in[18] + j * 1024,
                              (float*)(SCR + SC_LA), (float*)(SCR + SC_UU), (f32x2*)(SCR + SC_AGG), S, lds);
                GSYNC();
                {
                    const int nqb = S / 256, nunits = nb * 8 * nqb;
                    for (int u = blockIdx.x; u < nunits; u += Gr) {
                        const int qb = u % nqb, h = (u / nqb) % 8, b = u / (nqb * 8), kvh = h >> 2;
                        const attn_body::bf16* base = (const attn_body::bf16*)PROJ + (size_t)b * S * EIN;
                        attn_body::attn_unit<8>(qb, S, base + h * 64, EIN, base + 512 + kvh * 64, base + 640 + kvh * 64, EIN, (attn_body::bf16*)H + (size_t)b * S * DMODEL + h * 64, DMODEL, lds);
                    }
                }
                __syncthreads();
                even_lru_scan((const float*)(SCR + SC_LA), (const float*)(SCR + SC_UU), (const f32x2*)(SCR + SC_AGG), PROJ, H, S);
                GSYNC();
                {
                    pg8::Gemm g{H, (const bf16_t*)(ws + WS_WOUTE) + (size_t)j * 1024 * 1024, TS, 1024, 1024}; pg8::StaticOrder So; So.init(TS, 1024, Gr, (int)blockIdx.x);
                    EpiRes E{xcur, xo, DMODEL};
                    pg8::gemm_phase<EpiRes, pg8::StaticOrder, true, true>(ldsl, g, So, E);
                }
            } else {
                odd_conv(PROJ, p.in[21] + j * 4 * 1536, (bf16_t*)(SCR + SC_QKVP), S);
                GSYNC();
                odd_prep((const bf16_t*)(SCR + SC_QKVP), PROJ, p.in[22] + j * 8, p.in[23] + j * 8, SCR + SC_DNI, (float*)(SCR + SC_EGL), lds);
                GSYNC();
                {
                    const int nscan = nb * 64;
                    odd_scan(SCR + SC_DNI, (const float*)(SCR + SC_EGL), (bf16_t*)(SCR + SC_OB), S, nb, lds);
                    const int first = nscan < Gr ? nscan : 0;
                    odd_dilated(PROJ, p.in[2], (float*)(SCR + SC_LSE), S, lds, first, Gr - first);
                }
                GSYNC();
                odd_combine((const bf16_t*)(SCR + SC_OB), PROJ, (const float*)(SCR + SC_LSE), p.in[24] + j * 128, H);
                GSYNC();
                {
                    pg8::Gemm g{H, (const bf16_t*)(ws + WS_WOUTO) + (size_t)j * 1024 * OOUT, TS, 1024, OOUT}; pg8::StaticOrder So; So.init(TS, 1024, Gr, (int)blockIdx.x);
                    EpiRes E{xcur, xo, DMODEL};
                    pg8::gemm_phase<EpiRes, pg8::StaticOrder, true, true>(ldsl, g, So, E);
                }
            }
            GSYNC();
            phase_rmsnorm_bf16(xo, p.in[4] + layer * DMODEL, H);
            GSYNC();
            {
                pg8::Gemm g{H, (const bf16_t*)(ws + WS_W1T) + (size_t)layer * 4096 * 1024, TS, DFF, 1024}; pg8::StaticOrder So; So.init(TS, DFF, Gr, (int)blockIdx.x);
                pg8::EpiBf16<2> E{(bf16_t*)(SCR + SC_HID), DFF, nullptr, 0, 0, 1.f};
                pg8::gemm_phase<pg8::EpiBf16<2>, pg8::StaticOrder, true, true>(ldsl, g, So, E);
            }
            GSYNC();
            {
                pg8::Gemm g{(const bf16_t*)(SCR + SC_HID), (const bf16_t*)(ws + WS_W2T) + (size_t)layer * 1024 * 4096, TS, 1024, DFF}; pg8::StaticOrder So; So.init(TS, 1024, Gr, (int)blockIdx.x);
                EpiRes E{xo, xo, DMODEL};
                pg8::gemm_phase<EpiRes, pg8::StaticOrder, true, true>(ldsl, g, So, E);
            }
            GSYNC();
        }
        phase_rmsnorm_final(xo, p.in[5]);
    }
}
}

extern "C" void kernel_launch(void* const* d_in, const int* in_sizes, int n_in, void* d_out, int out_size, void* d_ws, size_t ws_size, hipStream_t stream) {
    static int grid = 0;
    if (grid == 0) {
        if (n_in != 25 || ws_size < mk::WS_END) { fprintf(stderr, "kernel_launch: unexpected n_in %d / ws_size %zu\n", n_in, ws_size); grid = -1; return; }
        int dev = 0, cus = 0, per_cu = 0;
        hipGetDevice(&dev); hipDeviceGetAttribute(&cus, hipDeviceAttributeMultiprocessorCount, dev);
        if (hipFuncSetAttribute((const void*)mk::fwd_megakernel, hipFuncAttributeMaxDynamicSharedMemorySize, mk::LDS_BYTES) != hipSuccess) { fprintf(stderr, "hipFuncSetAttribute failed\n"); }
        hipOccupancyMaxActiveBlocksPerMultiprocessor(&per_cu, (const void*)mk::fwd_megakernel, mk::NT, mk::LDS_BYTES);
        (void)hipGetLastError();
        if (per_cu < 1) per_cu = 1;
        grid = cus * 1;
        fprintf(stderr, "kernel_launch: cus %d per_cu %d grid %d\n", cus, per_cu, grid);
    }
    if (grid < 0) return;
    if (hipMemsetAsync(d_ws, 0, 65536, stream) != hipSuccess) { fprintf(stderr, "memset failed\n"); return; }
    mk::Params p{};
    for (int i = 0; i < 25; ++i) p.in[i] = (const float*)d_in[i];
    p.out = (float*)d_out; p.ws = (unsigned char*)d_ws;
    void* args[] = {&p};
    hipError_t e = hipLaunchCooperativeKernel((const void*)mk::fwd_megakernel, dim3(grid), dim3(mk::NT), args, mk::LDS_BYTES, stream);
    if (e != hipSuccess) fprintf(stderr, "cooperative launch failed: %s (grid %d)\n", hipGetErrorString(e), grid);
}
```

```cpp
#include <hip/hip_runtime.h>
#include <hip/hip_cooperative_groups.h>
#include <hip/hip_bf16.h>
#include <cstdio>
#include <cstdint>
#include <cmath>
namespace cg = cooperative_groups;
namespace pg8 {
#define PG8_LAS __attribute__((address_space(3)))
typedef unsigned short bf16_t;
typedef short bf16x8 __attribute__((ext_vector_type(8)));
typedef float f32x4 __attribute__((ext_vector_type(4)));
typedef unsigned u32x4 __attribute__((ext_vector_type(4)));
constexpr int BM = 256, BK = 64, HALF = 128, HTB = HALF * BK * 2  , STAGE_BYTES = 8 * HTB, NXCD = 8, WGM = 8;

__host__ __device__ __forceinline__ int lds_byte(int r, int c) { const int st = (r >> 4) * 2 + (c >> 5), rr = r & 15, cc = c & 31, ob = rr * 64 + cc * 2; return st * 1024 + (ob ^ (((ob >> 9) & 1) << 5)); }
__host__ __device__ __forceinline__ void stage_rc(int b, int& R, int& C) { const int st = b / 1024, sb = b % 1024, swz = sb ^ (((sb >> 9) & 1) << 5); R = (st >> 1) * 16 + swz / 64; C = (st & 1) * 32 + (swz % 64) / 2; }
__host__ __device__ __forceinline__ int perm32(int rho) { const int n = rho >> 4, i = rho & 15; return 8 * (i >> 2) + 4 * n + (i & 3); }

struct Unit { int pm, pn; };
struct Gemm { const bf16_t* A; const bf16_t* Bt; int M, N, K; };

struct StaticOrder {
    int nM, nN, nwg, G, c;
    __host__ __device__ void init(int M, int N, int G_, int c_) { nM = M / BM; nN = N / BM; nwg = nM * nN; G = G_; c = c_; }
    __host__ __device__ bool next(int i, Unit& u) const {
        const long L = (long)i * G + c; if (L >= nwg) return false;
        int wgid = (int)L; { const int q = nwg / NXCD, r = nwg % NXCD, xcd = wgid % NXCD, off = wgid / NXCD; wgid = (xcd < r ? xcd * (q + 1) : r * (q + 1) + (xcd - r) * q) + off; }
        const int nig = WGM * nN, gid = wgid / nig, fm = gid * WGM, gsz = (nM - fm) < WGM ? (nM - fm) : WGM;
        u.pm = fm + ((wgid % nig) % gsz); u.pn = (wgid % nig) / gsz; return true;
    }
    __device__ __forceinline__ void a_ready(const Unit&) const {}
    __device__ __forceinline__ void done(const Unit&) const {}
};

__device__ __forceinline__ unsigned cvt_pk_bf16(float lo, float hi) { unsigned r; asm volatile("v_cvt_pk_bf16_f32 %0, %1, %2" : "=v"(r) : "v"(lo), "v"(hi)); return r; }
typedef float f32x2 __attribute__((ext_vector_type(2)));
__device__ __forceinline__ f32x2 gelu_pk(f32x2 v) {
    const f32x2 av = __builtin_elementwise_abs(v), d = av * 0.2316418882f + 1.0f;
    f32x2 t; t.x = __builtin_amdgcn_rcpf(d.x); t.y = __builtin_amdgcn_rcpf(d.y);
    f32x2 q = t * 0.5307027145f + (-0.7265760135f); q = q * t + 0.7107068705f; q = q * t + (-0.142248368f); q = q * t + 0.127414796f; q = q * t;
    const f32x2 s = (v * v) * (-0.72134752044f);
    f32x2 e; e.x = __builtin_amdgcn_exp2f(s.x); e.y = __builtin_amdgcn_exp2f(s.y);
    const f32x2 m = v * (q * e), r = v - m;
    f32x2 o; o.x = v.x < 0.f ? m.x : r.x; o.y = v.y < 0.f ? m.y : r.y; return o;
}

template <int ACT  > struct EpiBf16 {
    static constexpr bool PERM = true, AFTER_DRAIN = false; static_assert(ACT == 0 || ACT == 1 || ACT == 2, "EpiBf16: ACT 0 none, 1 gelu, 2 relu^2");
    bf16_t* O; int ldc; const float* bias; int split_cols; size_t split_stride; float scale0; const float* ssq;
    __device__ __forceinline__ void operator()(const f32x4 (&acc)[2][2][4][2], const Unit& u, int wr, int wc, int fr, int fq) const {
        const int row0 = u.pm * BM + wr * 64 + fr; int colt = u.pn * BM; bf16_t* base = O;
        float sc = 1.f; if (split_cols) { const int t = colt / split_cols; base += (size_t)t * split_stride; colt -= t * split_cols; if (t == 0) sc = scale0; }
        const int col0 = colt + wc * 32 + 8 * fq, bcol0 = u.pn * BM + wc * 32 + 8 * fq;
        float rsc[2][4];
        if (ssq) { f32x4 t_[2][4];
#pragma unroll
            for (int ai = 0; ai < 2; ++ai)
#pragma unroll
                for (int m = 0; m < 4; ++m) t_[ai][m] = *(const f32x4*)(ssq + (size_t)(row0 + ai * HALF + m * 16) * 16 + fq * 4);
#pragma unroll
            for (int ai = 0; ai < 2; ++ai)
#pragma unroll
                for (int m = 0; m < 4; ++m) { float s_ = (t_[ai][m][0] + t_[ai][m][1]) + (t_[ai][m][2] + t_[ai][m][3]); s_ += __shfl_xor(s_, 16); s_ += __shfl_xor(s_, 32); rsc[ai][m] = 1.0f / sqrtf(s_ * (1.0f / 1024.0f) + 1e-6f); }
        } else {
#pragma unroll
            for (int ai = 0; ai < 2; ++ai)
#pragma unroll
                for (int m = 0; m < 4; ++m) rsc[ai][m] = 1.0f; }
        f32x4 bv[2][2];
#pragma unroll
        for (int bj = 0; bj < 2; ++bj)
#pragma unroll
            for (int n = 0; n < 2; ++n) bv[bj][n] = bias ? *(const f32x4*)(bias + bcol0 + bj * HALF + 4 * n) : (f32x4){0.f, 0.f, 0.f, 0.f};
#pragma unroll
        for (int ai = 0; ai < 2; ++ai)
#pragma unroll
            for (int m = 0; m < 4; ++m) { bf16_t* rowp = base + (size_t)(row0 + ai * HALF + m * 16) * ldc + col0; const float rsc_ = rsc[ai][m];
#pragma unroll
                for (int bj = 0; bj < 2; ++bj) { f32x4 v0 = (acc[ai][bj][m][0] + bv[bj][0]) * rsc_, v1 = (acc[ai][bj][m][1] + bv[bj][1]) * rsc_;
                    if (ACT == 1) { f32x2 a = gelu_pk((f32x2){v0[0], v0[1]}), b = gelu_pk((f32x2){v0[2], v0[3]}), c = gelu_pk((f32x2){v1[0], v1[1]}), d = gelu_pk((f32x2){v1[2], v1[3]});
                        v0 = (f32x4){a.x, a.y, b.x, b.y}; v1 = (f32x4){c.x, c.y, d.x, d.y}; }
                    if (ACT == 2) { _Pragma("unroll") for (int q_ = 0; q_ < 4; ++q_) { const float a0_ = v0[q_] > 0.f ? v0[q_] : 0.f, a1_ = v1[q_] > 0.f ? v1[q_] : 0.f; v0[q_] = a0_ * a0_; v1[q_] = a1_ * a1_; } }
                    v0 = v0 * sc; v1 = v1 * sc; u32x4 w; w.x = cvt_pk_bf16(v0[0], v0[1]); w.y = cvt_pk_bf16(v0[2], v0[3]); w.z = cvt_pk_bf16(v1[0], v1[1]); w.w = cvt_pk_bf16(v1[2], v1[3]);
                    *(u32x4*)(rowp + bj * HALF) = w; } }
    }
};

template <class Epi, class Sched, bool ALIGN_EPI = false, bool SP2 = false>
__device__ __forceinline__ void gemm_phase(PG8_LAS unsigned char* lds, const Gemm g, const Sched& S, const Epi& E) {
    int tid_ = threadIdx.x; asm volatile("" : "+v"(tid_)); const int tid = tid_, wid = __builtin_amdgcn_readfirstlane(tid >> 6), lane = tid & 63, wr = wid >> 2, wc = wid & 3, fr = lane & 15, fq = lane >> 4;
    const int K = g.K, nt = K / BK;
    unsigned voffA[2], voffB[2];
#pragma unroll
    for (int i = 0; i < 2; ++i) { int R, C; stage_rc(tid * 16 + i * 8192, R, C); const int Rb = Epi::PERM ? ((R & ~31) + perm32(R & 31)) : R;
        voffA[i] = (unsigned)(R * K + C) * 2u; voffB[i] = (unsigned)(Rb * K + C) * 2u; }
    const size_t kstep = (size_t)(BK * 2);
    const size_t hstep = (size_t)HALF * K * 2;
    const size_t tstep = 2 * hstep;
    const unsigned ldsw = (unsigned)wid * 1024u;
    const int aoff = lds_byte(wr * 64 + fr, fq * 8), boff = lds_byte(wc * 32 + fr, fq * 8);
#define PG8_SA(b, h) (((b) * 2 + (h)) * HTB)
#define PG8_SB(b, h) ((4 + (b) * 2 + (h)) * HTB)
#define PG8_STAGE(bufoff, gbase, voff) do { _Pragma("unroll") for (int _i = 0; _i < 2; ++_i) \
        __builtin_amdgcn_global_load_lds((const unsigned*)((const char*)(gbase) + (voff)[_i]), (PG8_LAS unsigned*)(lds + (bufoff) + ldsw + _i * 8192), 16, 0, 0); } while (0)
#define PG8_LDA(dst, b, h) do { _Pragma("unroll") for (int m = 0; m < 4; ++m) _Pragma("unroll") for (int k = 0; k < 2; ++k) dst[m][k] = *(const PG8_LAS bf16x8*)(lds + PG8_SA(b, h) + aoff + m * 2048 + k * 1024); } while (0)
#define PG8_LDB(dst, b, h) do { _Pragma("unroll") for (int n = 0; n < 2; ++n) _Pragma("unroll") for (int k = 0; k < 2; ++k) dst[n][k] = *(const PG8_LAS bf16x8*)(lds + PG8_SB(b, h) + boff + n * 2048 + k * 1024); } while (0)
#define PG8_MMA(ai, bj, At, Bt) do { __builtin_amdgcn_s_setprio(1); _Pragma("unroll") for (int m = 0; m < 4; ++m) _Pragma("unroll") for (int n = 0; n < 2; ++n) _Pragma("unroll") for (int k = 0; k < 2; ++k) \
        acc[ai][bj][m][n] = __builtin_amdgcn_mfma_f32_16x16x32_bf16(Bt[n][k], At[m][k], acc[ai][bj][m][n], 0, 0, 0); __builtin_amdgcn_s_setprio(0); } while (0)
#define PG8_WAIT_V(n) asm volatile("s_waitcnt vmcnt(" #n ")" ::: "memory")
#define PG8_WAIT_L(n) asm volatile("s_waitcnt lgkmcnt(" #n ")" ::: "memory")
#define PG8_BAR __builtin_amdgcn_s_barrier()
#define PG8_SCHED __builtin_amdgcn_sched_barrier(0)
    Unit cur, nxt; int ui = 0;
    if (!S.next(0, cur)) return;
    f32x4 acc[2][2][4][2];
#pragma unroll
    for (int a = 0; a < 2; ++a)
#pragma unroll
        for (int b = 0; b < 2; ++b)
#pragma unroll
            for (int m = 0; m < 4; ++m)
#pragma unroll
                for (int n = 0; n < 2; ++n) acc[a][b][m][n] = (f32x4){0.f, 0.f, 0.f, 0.f};
    bf16x8 At[4][2], B0[2][2], B1[2][2];
    const char* cA = (const char*)g.A + (size_t)cur.pm * tstep; const char* cB = (const char*)g.Bt + (size_t)cur.pn * tstep;
    S.a_ready(cur);
    if constexpr (SP2) {
        PG8_STAGE(PG8_SB(0, 0), cB, voffB); PG8_STAGE(PG8_SB(0, 1), cB + hstep, voffB); PG8_STAGE(PG8_SA(0, 0), cA, voffA); PG8_STAGE(PG8_SA(0, 1), cA + hstep, voffA);
        if (wr == 1) PG8_BAR;
        PG8_WAIT_V(2); PG8_BAR;
        PG8_STAGE(PG8_SB(1, 0), cB + kstep, voffB); PG8_STAGE(PG8_SA(1, 0), cA + kstep, voffA); PG8_STAGE(PG8_SB(1, 1), cB + hstep + kstep, voffB);
        PG8_WAIT_V(6); PG8_BAR;
    } else {
        PG8_STAGE(PG8_SB(0, 0), cB, voffB); PG8_STAGE(PG8_SA(0, 0), cA, voffA); PG8_STAGE(PG8_SB(0, 1), cB + hstep, voffB); PG8_STAGE(PG8_SA(0, 1), cA + hstep, voffA);
        if (wr == 1) PG8_BAR;
        PG8_WAIT_V(4); PG8_BAR;
        PG8_STAGE(PG8_SB(1, 0), cB + kstep, voffB); PG8_STAGE(PG8_SA(1, 0), cA + kstep, voffA); PG8_STAGE(PG8_SB(1, 1), cB + hstep + kstep, voffB);
        PG8_WAIT_V(6); PG8_BAR;
    }
    for (;;) {
        const bool has_next = S.next(ui + 1, nxt);
        const char* nA = has_next ? (const char*)g.A + (size_t)nxt.pm * tstep : cA; const char* nB = has_next ? (const char*)g.Bt + (size_t)nxt.pn * tstep : cB;
        for (int t = 0; t < nt; t += 2) {
            const bool last = (t == nt - 2);
            const char* a1 = cA + (size_t)(t + 1) * kstep;
            const char* a2 = last ? nA : cA + (size_t)(t + 2) * kstep; const char* b2 = last ? nB : cB + (size_t)(t + 2) * kstep;
            const char* a3 = a2 + kstep; const char* b3 = b2 + kstep;
            if (last && has_next) S.a_ready(nxt);
            if constexpr (SP2) {
            PG8_LDB(B0, 0, 0); PG8_LDB(B1, 0, 1); PG8_SCHED; PG8_LDA(At, 0, 0); PG8_STAGE(PG8_SA(1, 1), a1 + hstep, voffA);
            PG8_WAIT_V(8); PG8_WAIT_L(0); PG8_BAR; PG8_MMA(0, 0, At, B0); PG8_MMA(0, 1, At, B1); PG8_BAR; PG8_SCHED;
            PG8_LDA(At, 0, 1); PG8_STAGE(PG8_SB(0, 0), b2, voffB); PG8_STAGE(PG8_SB(0, 1), b2 + hstep, voffB); PG8_STAGE(PG8_SA(0, 0), a2, voffA);
            PG8_WAIT_V(8); PG8_WAIT_L(0); PG8_BAR; PG8_MMA(1, 0, At, B0); PG8_MMA(1, 1, At, B1); PG8_BAR; PG8_SCHED;
            PG8_LDB(B0, 1, 0); PG8_LDB(B1, 1, 1); PG8_SCHED; PG8_LDA(At, 1, 0); PG8_STAGE(PG8_SA(0, 1), a2 + hstep, voffA);
            PG8_WAIT_V(8); PG8_WAIT_L(0); PG8_BAR; PG8_MMA(0, 0, At, B0); PG8_MMA(0, 1, At, B1); PG8_BAR; PG8_SCHED;
            PG8_LDA(At, 1, 1); PG8_STAGE(PG8_SB(1, 0), b3, voffB); PG8_STAGE(PG8_SB(1, 1), b3 + hstep, voffB); PG8_STAGE(PG8_SA(1, 0), a3, voffA);
            PG8_WAIT_V(8); PG8_WAIT_L(0); PG8_BAR; PG8_MMA(1, 0, At, B0); PG8_MMA(1, 1, At, B1); PG8_BAR; PG8_SCHED;
            } else {
            PG8_LDB(B0, 0, 0); PG8_SCHED; PG8_LDA(At, 0, 0); PG8_STAGE(PG8_SA(1, 1), a1 + hstep, voffA);
            PG8_WAIT_L(8); PG8_BAR; PG8_WAIT_L(0); PG8_MMA(0, 0, At, B0); PG8_BAR; PG8_SCHED;
            PG8_LDB(B1, 0, 1); PG8_STAGE(PG8_SB(0, 0), b2, voffB);
            PG8_BAR; PG8_WAIT_L(0); PG8_MMA(0, 1, At, B1); PG8_BAR;
            PG8_LDA(At, 0, 1); PG8_STAGE(PG8_SA(0, 0), a2, voffA);
            PG8_BAR; PG8_WAIT_L(0); PG8_MMA(1, 0, At, B0); PG8_BAR; PG8_SCHED;
            PG8_STAGE(PG8_SB(0, 1), b2 + hstep, voffB);
            PG8_WAIT_V(6); PG8_BAR; PG8_MMA(1, 1, At, B1); PG8_BAR;
            PG8_LDB(B0, 1, 0); PG8_SCHED; PG8_LDA(At, 1, 0); PG8_STAGE(PG8_SA(0, 1), a2 + hstep, voffA);
            PG8_WAIT_L(8); PG8_BAR; PG8_WAIT_L(0); PG8_MMA(0, 0, At, B0); PG8_BAR; PG8_SCHED;
            PG8_LDB(B1, 1, 1); PG8_STAGE(PG8_SB(1, 0), b3, voffB);
            PG8_BAR; PG8_WAIT_L(0); PG8_MMA(0, 1, At, B1); PG8_BAR;
            PG8_LDA(At, 1, 1); PG8_STAGE(PG8_SA(1, 0), a3, voffA);
            PG8_BAR; PG8_WAIT_L(0); PG8_MMA(1, 0, At, B0); PG8_BAR; PG8_SCHED;
            PG8_STAGE(PG8_SB(1, 1), b3 + hstep, voffB);
            PG8_WAIT_V(6); PG8_BAR; PG8_MMA(1, 1, At, B1); PG8_BAR;
            }
        }
        if constexpr (ALIGN_EPI) { if (wr == 0) PG8_BAR; }
        if constexpr (!Epi::AFTER_DRAIN) { E(acc, cur, wr, wc, fr, fq); S.done(cur); }
        if (!has_next) break;
#pragma unroll
        for (int a = 0; a < 2; ++a)
#pragma unroll
            for (int b = 0; b < 2; ++b)
#pragma unroll
                for (int m = 0; m < 4; ++m)
#pragma unroll
                    for (int n = 0; n < 2; ++n) acc[a][b][m][n] = (f32x4){0.f, 0.f, 0.f, 0.f};
        cur = nxt; cA = nA; cB = nB; ++ui;
        if constexpr (ALIGN_EPI) { if (wr == 1) PG8_BAR; }
    }
    PG8_WAIT_V(0);
    if constexpr (!ALIGN_EPI) { if (wr == 0) PG8_BAR; }
    PG8_BAR;
    if constexpr (Epi::AFTER_DRAIN) { E.fused(acc, cur, wr, wc, fr, fq, lds, wid, lane); S.done(cur); }
#undef PG8_SA
#undef PG8_SB
#undef PG8_STAGE
#undef PG8_LDA
#undef PG8_LDB
#undef PG8_MMA
#undef PG8_WAIT_V
#undef PG8_WAIT_L
#undef PG8_BAR
#undef PG8_SCHED
}
}

#ifndef PG8_SP2
#define PG8_SP2 true
#endif
#ifndef PG8_ALIGN
#define PG8_ALIGN true
#endif
#include <hip/hip_bf16.h>
#include <cmath>
namespace attn_body {
using bf16=__hip_bfloat16;
using bf16x8=__attribute__((ext_vector_type(8)))short;
using s16x4=__attribute__((ext_vector_type(4)))short;
using f32x16=__attribute__((ext_vector_type(16)))float;
using u32x4=__attribute__((ext_vector_type(4)))unsigned;
constexpr int D=64;
constexpr int NW=8,QBLK=32,QB=QBLK*NW,KVBLK=64;
__device__ __forceinline__ int crow(int r,int hi){return (r&3)+8*(r>>2)+4*hi;}
#define SBAR() __builtin_amdgcn_sched_barrier(0)
__device__ __forceinline__ void cmask(f32x16&p0,f32x16&p1,int jb,int qrel,int hi){
  const float NEG=-INFINITY; int kb=64*jb+4*hi;
  #pragma unroll
  for(int r=0;r<16;++r){int kv=kb+(r&3)+8*(r>>2); if(kv>qrel)p0[r]=NEG; if(kv+32>qrel)p1[r]=NEG;}
}

constexpr int NSLOT=3, SLOTB=8192;
constexpr int LDS_K=0, LDS_V=NSLOT*SLOTB, LDS_WS=2*NSLOT*SLOTB, LDS_OST=LDS_WS+NW*64*4, LDS_BYTES=LDS_OST+NW*4096;
constexpr float C2=0.125f*1.4426950408889634f;
__device__ __forceinline__ void glds16(const void*gsrc,unsigned lds_dst){unsigned keep;
  asm volatile("s_mov_b32 %0, m0\n\ts_mov_b32 m0, %2\n\ts_nop 0\n\tglobal_load_lds_dwordx4 %1, off\n\ts_mov_b32 m0, %0":"=&s"(keep):"v"(gsrc),"s"(lds_dst):"memory");}
__device__ __forceinline__ float max3f(float a,float b,float c){float r;asm("v_max3_f32 %0, %1, %2, %3":"=v"(r):"v"(a),"v"(b),"v"(c));return r;}
__device__ __forceinline__ float max2f(float a,float b){float r;asm("v_max_f32_e32 %0, %1, %2":"=v"(r):"v"(a),"v"(b));return r;}
__device__ __forceinline__ float fadd_s(float a,float b){float r;asm("v_add_f32_e32 %0, %1, %2":"=v"(r):"v"(a),"v"(b));return r;}
__device__ __forceinline__ float fsub_s(float a,float b){float r;asm("v_sub_f32_e32 %0, %1, %2":"=v"(r):"v"(a),"v"(b));return r;}
typedef float f32x2_t __attribute__((ext_vector_type(2))); typedef __bf16 bf16x2_t __attribute__((ext_vector_type(2)));
__device__ __forceinline__ unsigned cvtpk_s(float lo,float hi){f32x2_t v={lo,hi};bf16x2_t b=__builtin_convertvector(v,bf16x2_t);return __builtin_bit_cast(unsigned,b);}
#define WAIT_BAR(N) asm volatile("s_waitcnt vmcnt(" #N ") lgkmcnt(0)\n\ts_barrier":::"memory")

__device__ __forceinline__ void qkt(f32x16&p0,f32x16&p1,const char*Kslot,const bf16x8*qr,const f32x16&negm,int r32,int hi){
  const char*kb=Kslot+hi*1024+r32*16;
  #pragma unroll
  for(int d0=0;d0<4;++d0){
    const bf16x8 b0=*reinterpret_cast<const bf16x8*>(kb+d0*2048);
    const bf16x8 b1=*reinterpret_cast<const bf16x8*>(kb+d0*2048+512);
    if(d0==0){p0=__builtin_amdgcn_mfma_f32_32x32x16_bf16(b0,qr[0],negm,0,0,0);p1=__builtin_amdgcn_mfma_f32_32x32x16_bf16(b1,qr[0],negm,0,0,0);}
    else{p0=__builtin_amdgcn_mfma_f32_32x32x16_bf16(b0,qr[d0],p0,0,0,0);p1=__builtin_amdgcn_mfma_f32_32x32x16_bf16(b1,qr[d0],p1,0,0,0);}}
}
typedef __attribute__((address_space(3))) const char* lds_cptr;
typedef short v4i16_t __attribute__((ext_vector_type(4)));
__device__ __forceinline__ void kload8(bf16x8*kf,lds_cptr kp){
  kf[0]=*(const __attribute__((address_space(3))) bf16x8*)(kp);      kf[1]=*(const __attribute__((address_space(3))) bf16x8*)(kp+512);
  kf[2]=*(const __attribute__((address_space(3))) bf16x8*)(kp+2048); kf[3]=*(const __attribute__((address_space(3))) bf16x8*)(kp+2560);
  kf[4]=*(const __attribute__((address_space(3))) bf16x8*)(kp+4096); kf[5]=*(const __attribute__((address_space(3))) bf16x8*)(kp+4608);
  kf[6]=*(const __attribute__((address_space(3))) bf16x8*)(kp+6144); kf[7]=*(const __attribute__((address_space(3))) bf16x8*)(kp+6656);
}
__device__ __forceinline__ void kload2(bf16x8*kf,lds_cptr kp,int j){ kf[2*j]=*(const __attribute__((address_space(3))) bf16x8*)(kp+j*2048); kf[2*j+1]=*(const __attribute__((address_space(3))) bf16x8*)(kp+j*2048+512); }
__device__ __forceinline__ s16x4 vtr(lds_cptr p){ return __builtin_bit_cast(s16x4,__builtin_amdgcn_ds_read_tr16_b64_v4i16((__attribute__((address_space(3))) v4i16_t*)p)); }
__device__ __forceinline__ float rowmax(const f32x16&p0,const f32x16&p1){
  float a=max3f(p0[0],p0[1],p1[0]),b=max3f(p0[2],p0[3],p1[1]);a=max3f(a,p1[2],p1[3]);
  #pragma unroll
  for(int r=4;r<16;r+=4){a=max3f(a,p0[r],p0[r+1]);b=max3f(b,p0[r+2],p0[r+3]);a=max3f(a,p1[r],p1[r+1]);b=max3f(b,p1[r+2],p1[r+3]);}
  const float m=max2f(a,b);
  auto rr=__builtin_amdgcn_permlane32_swap(__float_as_uint(m),__float_as_uint(m),false,false);
  return max2f(__uint_as_float(rr[0]),__uint_as_float(rr[1]));
}
__device__ __forceinline__ void pv(f32x16*o,int vb,bf16x8 pa0,bf16x8 pa1,bf16x8 pa2,bf16x8 pa3){
  #pragma unroll
  for(int d0=0;d0<2;++d0){s16x4 lo[4],hi[4];
    #pragma unroll
    for(int ks=0;ks<4;++ks){
      asm volatile("ds_read_b64_tr_b16 %0,%1 offset:%c2":"=&v"(lo[ks]):"v"(vb),"i"(d0*4096+ks*1024):"memory");
      asm volatile("ds_read_b64_tr_b16 %0,%1 offset:%c2":"=&v"(hi[ks]):"v"(vb),"i"(d0*4096+ks*1024+512):"memory");}
    asm volatile("s_waitcnt lgkmcnt(0)":::"memory");SBAR();
    #define PK(k) (bf16x8){lo[k][0],lo[k][1],lo[k][2],lo[k][3],hi[k][0],hi[k][1],hi[k][2],hi[k][3]}
    o[d0]=__builtin_amdgcn_mfma_f32_32x32x16_bf16(pa0,PK(0),o[d0],0,0,0);
    o[d0]=__builtin_amdgcn_mfma_f32_32x32x16_bf16(pa1,PK(1),o[d0],0,0,0);
    o[d0]=__builtin_amdgcn_mfma_f32_32x32x16_bf16(pa2,PK(2),o[d0],0,0,0);
    o[d0]=__builtin_amdgcn_mfma_f32_32x32x16_bf16(pa3,PK(3),o[d0],0,0,0);
    #undef PK
  }
}

#ifndef ATTN_STORE16
#define ATTN_STORE16(p,v) (*(u32x4*)(p)=(v))
#endif
template<int THRL> __device__ __forceinline__ void attn_unit(int qb,int SEQ,const bf16*Q,int QP,const bf16*__restrict__ K,const bf16*__restrict__ V,int KP,bf16*O,int OP,char*shm){
  int tid_=threadIdx.x; asm volatile("":"+v"(tid_)); const int tid=tid_,lane=tid&63,r32=lane&31,hi=lane>>5; const int wid=__builtin_amdgcn_readfirstlane(tid>>6);
  const int q0=qb*QB;
  const bf16*Qw=Q+(long)(q0+wid*QBLK)*QP;
  const bf16*Kh=K,*Vh=V;
  const unsigned lds0=(unsigned)(uintptr_t)shm;
  float*wsf=(float*)(shm+LDS_WS)+wid*64;
  const bf16*ksrc=Kh+(long)lane*KP+wid*8;
  const bf16*vsrc=Vh+(long)(16*(wid&3)+(lane>>2))*KP+(wid>>2)*32+(lane&3)*8;
  const unsigned kdst=lds0+LDS_K+wid*1024, vdst=lds0+LDS_V+wid*1024;
  #define DMA_K(t,slot) glds16(ksrc+(long)(t)*KVBLK*KP,(unsigned)__builtin_amdgcn_readfirstlane(kdst+(slot)))
  #define DMA_V(t,slot) glds16(vsrc+(long)(t)*KVBLK*KP,(unsigned)__builtin_amdgcn_readfirstlane(vdst+(slot)))
  const int vb0=(int)(lds0+LDS_V)+((lane>>4)&1)*32+(lane&3)*8+(4*hi+((lane&15)>>2))*64;
  const char*Kbase=shm+LDS_K; bf16x8 kf[8];
  const lds_cptr shm3=(lds_cptr)shm; const lds_cptr kp0=shm3+LDS_K+hi*1024+r32*16; const lds_cptr vp0=shm3+LDS_V+((lane>>4)&1)*32+(lane&3)*8+(4*hi+((lane&15)>>2))*64;
  const int NT=SEQ/KVBLK;
  DMA_K(0,0);DMA_V(0,0);DMA_K(1,SLOTB);
  bf16x8 qr[4];
  #pragma unroll
  for(int d0=0;d0<4;++d0)qr[d0]=*reinterpret_cast<const bf16x8*>(&Qw[(long)r32*QP+d0*16+hi*8]);
  float mhat=0.f,l_reg=0.f;f32x16 o[2];o[0]=f32x16{};o[1]=f32x16{};f32x16 negm=f32x16{};asm volatile("":"+v"(negm));
  const int qrel=wid*QBLK+r32;
  #define CMASK(P0,P1,t) do{}while(0)
  bool resc=false;
  #define START(P0,P1) do{ const float rm=rowmax(P0,P1); resc=false; \
    { const float dl=rm; mhat=fadd_s(mhat,dl); \
      _Pragma("unroll") for(int r=0;r<16;++r){P0[r]=fsub_s(P0[r],dl);P1[r]=fsub_s(P1[r],dl);} \
      _Pragma("unroll") for(int r=0;r<16;++r)negm[r]=-mhat; asm volatile("":"+v"(negm)); } \
    _Pragma("unroll") for(int r=0;r<16;++r)P0[r]=__builtin_amdgcn_exp2f(P0[r]); }while(0)
  #define RESC() do{ if(resc){ asm volatile("s_waitcnt lgkmcnt(0)":::"memory"); \
      _Pragma("unroll") for(int d_=0;d_<2;++d_) _Pragma("unroll") for(int r=0;r<16;++r)o[d_][r]*=wsf[crow(r,hi)]; } }while(0)
  f32x16 pA0,pA1,pB0,pB1;
  int sl_prev=0,sl_cur=0,sl_next=SLOTB;
  #define ROT() do{sl_prev=sl_cur;sl_cur=sl_next;sl_next=(sl_next==(NSLOT-1)*SLOTB)?0:sl_next+SLOTB;}while(0)
  DMA_K(2,2*SLOTB);
  WAIT_BAR(3);
  qkt(pA0,pA1,Kbase,qr,negm,r32,hi);asm volatile("s_nop 15\n\ts_nop 7":"+v"(pA0),"+v"(pA1));CMASK(pA0,pA1,0);
  START(pA0,pA1);
  _Pragma("unroll") for(int r=0;r<16;++r)pA1[r]=__builtin_amdgcn_exp2f(pA1[r]);
  WAIT_BAR(0);
  DMA_K(3,0);DMA_V(1,SLOTB);
  ROT();
  kload8(kf,kp0+sl_cur);
  WAIT_BAR(2);
  s16x4 vlo[8],vhi[8]; u32x4 pw0,pw1,pw2,pw3;
  #define PKW(P,B) cvtpk_s(P[B],P[B+1])
  #define PAF(k) __builtin_bit_cast(bf16x8,pw##k)
  #define VFR(i) (bf16x8){vlo[i][0],vlo[i][1],vlo[i][2],vlo[i][3],vhi[i][0],vhi[i][1],vhi[i][2],vhi[i][3]}
  #define PIN(x) asm volatile("":"+v"(x))
  #define MX3(a,b,c) __builtin_fmaxf(__builtin_fmaxf((a),(b)),(c))
  #define GAPA(MF,A0,A1,A2,A3,W0,W1,PW) do{ MF; sacc+=A0; sacc+=A1; sacc+=A2; sacc+=A3; PIN(sacc); W0; W1; PIN(PW); SBAR(); }while(0)
  #define EX(v) __builtin_amdgcn_exp2f(v)
  #define GAPB(MF,X,B) do{ MF; X[B]=EX(X[B]); X[B+1]=EX(X[B+1]); X[B+2]=EX(X[B+2]); X[B+3]=EX(X[B+3]); PIN(X); SBAR(); }while(0)
  #define VRD(i) do{ vlo[i]=vtr(vp_+(((i)>>2)*4096+((i)&3)*1024)); vhi[i]=vtr(vp_+(((i)>>2)*4096+((i)&3)*1024+512)); }while(0)
  #define KRD(G,j) do{ if(G){ kload2(kf,kp0+sl_next,j); SBAR(); } }while(0)
  #define STEP(C0,C1,P0,P1,t,GK,GV,GL) do{ SBAR(); \
    const lds_cptr vp_=vp0+sl_prev; \
    VRD(0); SBAR(); float sacc=(P0[0]+P0[1]); \
    GAPA(C0=__builtin_amdgcn_mfma_f32_32x32x16_bf16(kf[0],qr[0],negm,0,0,0), P0[2],P0[3],P0[4],P0[5],     pw0[0]=PKW(P0,0), pw0[1]=PKW(P0,2), pw0); \
    VRD(4); SBAR(); GAPA(C1=__builtin_amdgcn_mfma_f32_32x32x16_bf16(kf[1],qr[0],negm,0,0,0), P0[6],P0[7],P0[8],P0[9],     pw0[2]=PKW(P0,4), pw0[3]=PKW(P0,6), pw0); \
    VRD(1); SBAR(); GAPA(C0=__builtin_amdgcn_mfma_f32_32x32x16_bf16(kf[2],qr[1],C0,0,0,0),   P0[10],P0[11],P0[12],P0[13], pw1[0]=PKW(P0,8), pw1[1]=PKW(P0,10), pw1); \
    VRD(5); SBAR(); GAPA(C1=__builtin_amdgcn_mfma_f32_32x32x16_bf16(kf[3],qr[1],C1,0,0,0),   P0[14],P0[15],P1[0],P1[1],   pw1[2]=PKW(P0,12),pw1[3]=PKW(P0,14), pw1); \
    VRD(2); SBAR(); GAPA(C0=__builtin_amdgcn_mfma_f32_32x32x16_bf16(kf[4],qr[2],C0,0,0,0),   P1[2],P1[3],P1[4],P1[5],     pw2[0]=PKW(P1,0), pw2[1]=PKW(P1,2), pw2); \
    VRD(6); SBAR(); GAPA(C1=__builtin_amdgcn_mfma_f32_32x32x16_bf16(kf[5],qr[2],C1,0,0,0),   P1[6],P1[7],P1[8],P1[9],     pw2[2]=PKW(P1,4), pw2[3]=PKW(P1,6), pw2); \
    VRD(3); SBAR(); GAPA(C0=__builtin_amdgcn_mfma_f32_32x32x16_bf16(kf[6],qr[3],C0,0,0,0),   P1[10],P1[11],P1[12],P1[13], pw3[0]=PKW(P1,8), pw3[1]=PKW(P1,10), pw3); \
    VRD(7); SBAR(); GAPA(C1=__builtin_amdgcn_mfma_f32_32x32x16_bf16(kf[7],qr[3],C1,0,0,0),   P1[14],P1[15],0.f,0.f,       pw3[2]=PKW(P1,12),pw3[3]=PKW(P1,14), pw3); \
    l_reg+=sacc; \
    if(GK){DMA_K((t)+3,sl_cur);} if(GV){DMA_V((t)+1,sl_next);} \
    CMASK(C0,C1,t); \
    { float a=MX3(C0[0],C0[1],C1[0]),b=MX3(C0[2],C0[3],C1[1]); a=MX3(a,C1[2],C1[3]); \
      _Pragma("unroll") for(int r=4;r<16;r+=4){a=MX3(a,C0[r],C0[r+1]);b=MX3(b,C0[r+2],C0[r+3]);a=MX3(a,C1[r],C1[r+1]);b=MX3(b,C1[r+2],C1[r+3]);} \
      float rm=__builtin_fmaxf(a,b); { auto rr=__builtin_amdgcn_permlane32_swap(__float_as_uint(rm),__float_as_uint(rm),false,false); rm=__builtin_fmaxf(__uint_as_float(rr[0]),__uint_as_float(rr[1])); } \
      resc=false; \
      if(__builtin_expect(__any(rm>(float)THRL),0)){ const float dl=__builtin_fmaxf(rm,0.f); mhat+=dl; \
        _Pragma("unroll") for(int r=0;r<16;++r){C0[r]-=dl;C1[r]-=dl;} \
        _Pragma("unroll") for(int r=0;r<16;++r)negm[r]=-mhat; asm volatile("":"+v"(negm)); \
        const float f=__builtin_amdgcn_exp2f(-dl); l_reg*=f; if(hi==0)wsf[r32]=f; resc=true; } } \
    SBAR(); \
    GAPB(o[0]=__builtin_amdgcn_mfma_f32_32x32x16_bf16(PAF(0),VFR(0),o[0],0,0,0), C0,0); \
    GAPB(o[1]=__builtin_amdgcn_mfma_f32_32x32x16_bf16(PAF(0),VFR(4),o[1],0,0,0), C0,4); \
    KRD(GL,0); GAPB(o[0]=__builtin_amdgcn_mfma_f32_32x32x16_bf16(PAF(1),VFR(1),o[0],0,0,0), C0,8); \
    KRD(GL,1); GAPB(o[1]=__builtin_amdgcn_mfma_f32_32x32x16_bf16(PAF(1),VFR(5),o[1],0,0,0), C0,12); \
    KRD(GL,2); GAPB(o[0]=__builtin_amdgcn_mfma_f32_32x32x16_bf16(PAF(2),VFR(2),o[0],0,0,0), C1,0); \
    KRD(GL,3); GAPB(o[1]=__builtin_amdgcn_mfma_f32_32x32x16_bf16(PAF(2),VFR(6),o[1],0,0,0), C1,4); \
    GAPB(o[0]=__builtin_amdgcn_mfma_f32_32x32x16_bf16(PAF(3),VFR(3),o[0],0,0,0), C1,8); \
    GAPB(o[1]=__builtin_amdgcn_mfma_f32_32x32x16_bf16(PAF(3),VFR(7),o[1],0,0,0), C1,12); \
    }while(0)
  int t=1;
  #undef CMASK
  #define CMASK(P0,P1,t) do{}while(0)
  for(;t+5<NT;t+=2){
    STEP(pB0,pB1,pA0,pA1,t,true,true,true);     WAIT_BAR(2); RESC(); ROT();
    STEP(pA0,pA1,pB0,pB1,t+1,true,true,true);   WAIT_BAR(2); RESC(); ROT();
  }
  #undef CMASK
  #define CMASK(P0,P1,t) do{}while(0)
  #define ENDW(tt) do{ if((tt)+3<NT){WAIT_BAR(2);} else if((tt)+2<NT){WAIT_BAR(1);} else {WAIT_BAR(0);} }while(0)
  for(;t+1<NT;t+=2){
    STEP(pB0,pB1,pA0,pA1,t,(t+3<NT),(t+1<NT),(t+1<NT));       ENDW(t);   RESC(); ROT();
    STEP(pA0,pA1,pB0,pB1,t+1,(t+4<NT),(t+2<NT),(t+2<NT));     ENDW(t+1); RESC(); ROT();
  }
  STEP(pB0,pB1,pA0,pA1,NT-1,false,false,false); RESC();
  { float sacc=pB0[0]+pB0[1]; _Pragma("unroll") for(int r=2;r<16;++r)sacc+=pB0[r]; _Pragma("unroll") for(int r=0;r<16;++r)sacc+=pB1[r]; l_reg+=sacc;
    pw0=(u32x4){PKW(pB0,0),PKW(pB0,2),PKW(pB0,4),PKW(pB0,6)};pw1=(u32x4){PKW(pB0,8),PKW(pB0,10),PKW(pB0,12),PKW(pB0,14)};pw2=(u32x4){PKW(pB1,0),PKW(pB1,2),PKW(pB1,4),PKW(pB1,6)};pw3=(u32x4){PKW(pB1,8),PKW(pB1,10),PKW(pB1,12),PKW(pB1,14)};
    SBAR(); pv(o,vb0+sl_cur,PAF(0),PAF(1),PAF(2),PAF(3)); }
  #undef PKW
  #undef PAF
  #undef VFR
  #undef PIN
  #undef MX3
  #undef GAPA
  #undef GAPB
  #undef EX
  #undef VRD
  #undef KRD
  #undef STEP
  #undef ENDW
  {auto rr=__builtin_amdgcn_permlane32_swap(__float_as_uint(l_reg),__float_as_uint(l_reg),false,false);l_reg=__uint_as_float(rr[0])+__uint_as_float(rr[1]);}
  if(hi==0)wsf[32+r32]=l_reg;asm volatile("s_waitcnt lgkmcnt(0)":::"memory");
  float rli[16];
  #pragma unroll
  for(int r=0;r<16;++r)rli[r]=__builtin_amdgcn_rcpf(wsf[32+crow(r,hi)]);
  bf16*Ow=O+(long)(q0+wid*QBLK)*OP;
  { bf16*stg=(bf16*)(shm+LDS_OST)+wid*2048;
    #pragma unroll
    for(int r=0;r<16;++r){const int orow=crow(r,hi);
      #pragma unroll
      for(int d0=0;d0<2;++d0)stg[orow*64+d0*32+r32]=__float2bfloat16(o[d0][r]*rli[r]);}
    asm volatile("s_waitcnt lgkmcnt(0)":::"memory");
    #pragma unroll
    for(int i=0;i<4;++i){const int row=i*8+(lane>>3),ch=lane&7; const u32x4 v=*(const u32x4*)(stg+row*64+ch*8); ATTN_STORE16(Ow+(long)row*OP+ch*8,v);} }
  asm volatile("s_waitcnt lgkmcnt(0)\n\ts_barrier":::"memory");
  #undef DMA_K
  #undef DMA_V
  #undef CMASK
  #undef START
  #undef RESC
  #undef ROT
}
constexpr int ATTN_LDS_BYTES=LDS_BYTES;
#undef SBAR
#undef WAIT_BAR
}
namespace xb {
#define GAS __attribute__((address_space(1)))
#define LAS __attribute__((address_space(3)))
typedef GAS unsigned gu32;
typedef GAS unsigned long long gu64;
#define RLX_AGENT __ATOMIC_RELAXED, __HIP_MEMORY_SCOPE_AGENT
#define LDS_WAIT() asm volatile("s_waitcnt lgkmcnt(0)" ::: "memory")
#define VM_WAIT() asm volatile("s_waitcnt vmcnt(0)" ::: "memory")
__device__ __forceinline__ unsigned long long rt() { return __builtin_amdgcn_s_memrealtime(); }
__device__ __forceinline__ unsigned f2bf(float f) { unsigned u = __builtin_bit_cast(unsigned, f); return (u + 0x7fffu + ((u >> 16) & 1u)) >> 16; }
__device__ __forceinline__ unsigned pk2(float lo, float hi) { return f2bf(lo) | (f2bf(hi) << 16); }

#define XB_TMO      128
#define XB_XCNT(j)  (256  + 64 * (j))
#define XB_XSUB(j)  (1280 + 64 * (j))
#define XB_XGEN(j)  (2304 + 64 * (j))
#define XB_TOP      3328
#define XB_TOPGEN   3392
#define XCD_BAR_WORDS 3456
#define XB_SPIN_CAP (1u << 18)

__device__ __forceinline__ unsigned xb_ld(unsigned* p)              { return __hip_atomic_load(p, __ATOMIC_RELAXED, __HIP_MEMORY_SCOPE_AGENT); }
__device__ __forceinline__ unsigned xb_add(unsigned* p, unsigned v) { return __hip_atomic_fetch_add(p, v, __ATOMIC_RELAXED, __HIP_MEMORY_SCOPE_AGENT); }
__device__ __forceinline__ unsigned xb_xcc_id() { return (unsigned)__builtin_amdgcn_s_getreg((3 << 11) | 20) & 0xFu; }
#define XB_SPIN(cond, bar) do { unsigned _sp = 0; while (cond) { __builtin_amdgcn_s_sleep(1); \
    if ((++_sp & 255u) == 0u) { if (xb_ld(&(bar)[XB_TMO])) break; if (_sp > XB_SPIN_CAP) { atomicAdd(&(bar)[XB_TMO], 1u); break; } } } } while (0)

struct XcdBarrier {
    unsigned* bar; unsigned x;
    volatile LAS unsigned* st;
};

__device__ __forceinline__ XcdBarrier xcd_barrier_post(unsigned* bar, volatile LAS unsigned* st) {
    XcdBarrier b; b.bar = bar; b.x = xb_xcc_id(); b.st = st;
    if (threadIdx.x == 0) (void)xb_add(&bar[XB_XCNT(b.x)], 1u);
    return b;
}
__device__ __forceinline__ void xcd_barrier_complete(unsigned* bar, unsigned x, unsigned& nloc, unsigned& nx) {
    const unsigned G = gridDim.x * gridDim.y * gridDim.z;
    unsigned sum, cnt, mine, sp = 0u;
    for (;;) {
        sum = 0u; cnt = 0u; mine = 0u;
#pragma unroll
        for (unsigned j = 0; j < 16; ++j) { const unsigned c = xb_ld(&bar[XB_XCNT(j)]); sum += c; cnt += (c > 0u) ? 1u : 0u; mine = (j == x) ? c : mine; }
        if (sum == G) break;
        __builtin_amdgcn_s_sleep(1);
        if ((++sp & 255u) == 0u) { if (xb_ld(&bar[XB_TMO])) break; if (sp > XB_SPIN_CAP) { atomicAdd(&bar[XB_TMO], 1u); break; } }
    }
    nloc = mine > 0u ? mine : 1u; nx = cnt > 0u ? cnt : 1u;
}

__device__ __forceinline__ void xcd_barrier(const XcdBarrier& b) {
    asm volatile("s_waitcnt vmcnt(0)" ::: "memory");
    __syncthreads();
    if (threadIdx.x == 0) {
        unsigned* bar = b.bar;
        __builtin_amdgcn_s_waitcnt(0);
        unsigned nloc = b.st[0], nx = b.st[1];
        if (nloc == 0u) { xcd_barrier_complete(bar, b.x, nloc, nx); b.st[0] = nloc; b.st[1] = nx; }
        const unsigned old = xb_add(&bar[XB_XSUB(b.x)], 1u);
        const unsigned gen = old / nloc;
        if (old + 1u == (gen + 1u) * nloc) {
            __builtin_amdgcn_fence(__ATOMIC_RELEASE, "agent");
            asm volatile("s_waitcnt vmcnt(0)" ::: "memory");
            const unsigned og = xb_add(&bar[XB_TOP], 1u);
            const unsigned tg = og / nx;
            if (og + 1u == (tg + 1u) * nx) xb_add(&bar[XB_TOPGEN], 1u);
            else XB_SPIN(xb_ld(&bar[XB_TOPGEN]) == tg, bar);
            __builtin_amdgcn_fence(__ATOMIC_ACQUIRE, "agent");
            xb_add(&bar[XB_XGEN(b.x)], 1u);
            asm volatile("s_waitcnt vmcnt(0)" ::: "memory");
        } else {
            XB_SPIN(xb_ld(&bar[XB_XGEN(b.x)]) == gen, bar);
            __builtin_amdgcn_fence(__ATOMIC_ACQUIRE, "agent");
            asm volatile("s_waitcnt vmcnt(0)" ::: "memory");
        }
    }
    __syncthreads();
}

}

namespace mk {
typedef unsigned short bf16_t;
typedef short bf16x8 __attribute__((ext_vector_type(8)));
typedef float f32x4 __attribute__((ext_vector_type(4)));
typedef unsigned u32x4 __attribute__((ext_vector_type(4)));
typedef unsigned u32x2 __attribute__((ext_vector_type(2)));
typedef float f32x2 __attribute__((ext_vector_type(2)));

constexpr int DMODEL = 1024, TS = 16384, NSEG = 4, DFF = 4096;
constexpr int EIN = 1792, OIN = 4368, OINP = 4608, OOUT = 768;
constexpr float EPS = 1e-6f;
constexpr size_t MiB = (size_t)1 << 20;
constexpr size_t WS_W1T = 1 * MiB, WS_W2T = 33 * MiB, WS_WINE = 65 * MiB, WS_WOUTE = 72 * MiB, WS_WINO = 76 * MiB, WS_WOUTO = 94 * MiB,
                 WS_GW = 97 * MiB, WS_H = 98 * MiB, WS_PROJ = 130 * MiB, WS_SCR = 274 * MiB, WS_END = 512 * MiB;
constexpr size_t SC_HID = 0;
constexpr size_t SC_LA = 0, SC_UU = 64 * MiB, SC_AGG = 128 * MiB;
constexpr size_t SC_QKVP = 0, SC_DNI = 48 * MiB, SC_OB = 192 * MiB, SC_LSE = 224 * MiB, SC_EGL = 225 * MiB;
constexpr int DNI_BYTES = 73728, DNI_W = 0, DNI_QT = 16384, DNI_KTT = 32768, DNI_A = 49152, DNI_U = 57344;
constexpr int LDS_BYTES = 147456;
constexpr int NT = 512, NW = 8;

struct Params { const float* in[25]; float* out; unsigned char* ws; };

__device__ __forceinline__ float bf2f(bf16_t v) { return __uint_as_float(((unsigned)v) << 16); }
__device__ __forceinline__ unsigned f2bf(float f) { unsigned u = __float_as_uint(f); return (u + 0x7fffu + ((u >> 16) & 1u)) >> 16; }
__device__ __forceinline__ unsigned pk2(float lo, float hi) { return f2bf(lo) | (f2bf(hi) << 16); }
__device__ __forceinline__ float wave_sum(float v) {
#pragma unroll
    for (int o = 1; o < 64; o <<= 1) v += __shfl_xor(v, o);
    return v;
}
__device__ __forceinline__ float sigm(float x) { return 1.f / (1.f + __expf(-x)); }
__device__ __forceinline__ float softplus(float x) { return x > 20.f ? x : log1pf(__expf(x)); }
__device__ __forceinline__ float silu(float x) { return x * sigm(x); }
__device__ __forceinline__ float gelu_tanh(float x) { const float t = 0.7978845608028654f * (x + 0.044715f * x * x * x); return 0.5f * x * (1.f + tanhf(t)); }
__device__ __forceinline__ void unpack8(const u32x4 v, float* f) {
    f[0] = __uint_as_float(v.x << 16); f[1] = __uint_as_float(v.x & 0xffff0000u); f[2] = __uint_as_float(v.y << 16); f[3] = __uint_as_float(v.y & 0xffff0000u);
    f[4] = __uint_as_float(v.z << 16); f[5] = __uint_as_float(v.z & 0xffff0000u); f[6] = __uint_as_float(v.w << 16); f[7] = __uint_as_float(v.w & 0xffff0000u);
}
#define MK_IDS() int tid = threadIdx.x; asm volatile("" : "+v"(tid)); const int lane = tid & 63, wave = __builtin_amdgcn_readfirstlane(tid >> 6); const int gw = blockIdx.x * NW + wave, NGW = gridDim.x * NW; (void)lane; (void)wave; (void)gw; (void)NGW
#define MFMA16(a, b, c) __builtin_amdgcn_mfma_f32_16x16x32_bf16((a), (b), (c), 0, 0, 0)

__device__ __forceinline__ void transpose_item(const float* W, int K, int Nsrc, int Npad, bf16_t* WT, float* scr, int item, int lane, const float* gain = nullptr) {
    const int nblk = Npad / 32, kb = item / nblk, nb = item % nblk, k0 = 64 * kb, n0 = 32 * nb;
    const int n = n0 + (lane & 31);
#pragma unroll 8
    for (int i = 0; i < 32; ++i) { const int kk = 2 * i + (lane >> 5); scr[kk * 33 + (lane & 31)] = (n < Nsrc) ? W[(size_t)(k0 + kk) * Nsrc + n] * (gain ? gain[k0 + kk] : 1.f) : 0.f; }
    asm volatile("s_waitcnt lgkmcnt(0)" ::: "memory");
    const int c = lane & 7;
#pragma unroll
    for (int j = 0; j < 4; ++j) { const int nn = (lane >> 3) + 8 * j; const float* s = scr + (8 * c) * 33 + nn;
        u32x4 o; o.x = pk2(s[0 * 33], s[1 * 33]); o.y = pk2(s[2 * 33], s[3 * 33]); o.z = pk2(s[4 * 33], s[5 * 33]); o.w = pk2(s[6 * 33], s[7 * 33]);
        *(u32x4*)(WT + (size_t)(n0 + nn) * K + k0 + 8 * c) = o; }
    asm volatile("s_waitcnt lgkmcnt(0)" ::: "memory");
}
__device__ __forceinline__ void phase_prologue(const Params& p, char* lds) {
    MK_IDS();
    float* scr = (float*)(lds + wave * 16384);
    unsigned char* ws = p.ws;
    constexpr int I_F1 = 16 * 128, I_F2 = 64 * 32, I_IE = 16 * 56, I_OE = 16 * 32, I_IO = 16 * 144, I_OO = 12 * 32;
    constexpr int T_F1 = 4 * I_F1, T_F2 = T_F1 + 4 * I_F2, T_IE = T_F2 + 2 * I_IE, T_OE = T_IE + 2 * I_OE, T_IO = T_OE + 2 * I_IO, T_OO = T_IO + 2 * I_OO;
    for (int it = gw; it < T_OO; it += NGW) {
        if (it < T_F1) { const int l = it / I_F1, r = it % I_F1; transpose_item(p.in[6] + (size_t)l * 1024 * 4096, 1024, 4096, 4096, (bf16_t*)(ws + WS_W1T) + (size_t)l * 4096 * 1024, scr, r, lane, p.in[4] + l * 1024); }
        else if (it < T_F2) { const int q = it - T_F1, l = q / I_F2, r = q % I_F2; transpose_item(p.in[7] + (size_t)l * 4096 * 1024, 4096, 1024, 1024, (bf16_t*)(ws + WS_W2T) + (size_t)l * 1024 * 4096, scr, r, lane); }
        else if (it < T_IE) { const int q = it - T_F2, l = q / I_IE, r = q % I_IE; transpose_item(p.in[8] + (size_t)l * 1024 * EIN, 1024, EIN, EIN, (bf16_t*)(ws + WS_WINE) + (size_t)l * EIN * 1024, scr, r, lane, p.in[3] + (2 * l) * 1024); }
        else if (it < T_OE) { const int q = it - T_IE, l = q / I_OE, r = q % I_OE; transpose_item(p.in[9] + (size_t)l * 1024 * 1024, 1024, 1024, 1024, (bf16_t*)(ws + WS_WOUTE) + (size_t)l * 1024 * 1024, scr, r, lane); }
        else if (it < T_IO) { const int q = it - T_OE, l = q / I_IO, r = q % I_IO; transpose_item(p.in[19] + (size_t)l * 1024 * OIN, 1024, OIN, OINP, (bf16_t*)(ws + WS_WINO) + (size_t)l * OINP * 1024, scr, r, lane, p.in[3] + (2 * l + 1) * 1024); }
        else { const int q = it - T_IO, l = q / I_OO, r = q % I_OO; transpose_item(p.in[20] + (size_t)l * OOUT * 1024, OOUT, 1024, 1024, (bf16_t*)(ws + WS_WOUTO) + (size_t)l * 1024 * OOUT, scr, r, lane); }
    }
    bf16_t* GW = (bf16_t*)(ws + WS_GW);
    const int gt = gw * 64 + lane, NGT = NGW * 64;
    for (int idx = gt; idx < 2 * 2 * 2 * 8 * 4096; idx += NGT) {
        const int d = idx & 63, e = (idx >> 6) & 63, blk = (idx >> 12) & 7, gate = (idx >> 15) & 1, dir = (idx >> 16) & 1, j = (idx >> 17) & 1;
        const float* src = gate ? p.in[16] : p.in[14];
        GW[idx] = (bf16_t)f2bf(src[((((size_t)j * 2 + dir) * 8 + blk) * 64 + d) * 64 + e]);
    }
}

__device__ __forceinline__ void phase_x0(const float* x, bf16_t* xb, float* ssq) {
    MK_IDS();
    for (int m = gw; m < TS; m += NGW) {
        const f32x4* xr = (const f32x4*)(x + (size_t)m * DMODEL) + lane;
        f32x4 v[4]; float s = 0.f;
#pragma unroll
        for (int j = 0; j < 4; ++j) { v[j] = xr[64 * j]; s += (v[j].x * v[j].x + v[j].y * v[j].y) + (v[j].z * v[j].z + v[j].w * v[j].w); }
        s = wave_sum(s);
        u32x2* o8 = (u32x2*)(xb + (size_t)m * DMODEL) + lane;
#pragma unroll
        for (int j = 0; j < 4; ++j) { u32x2 o; o.x = pk2(v[j].x, v[j].y); o.y = pk2(v[j].z, v[j].w); o8[64 * j] = o; }
        if (lane < 16) ssq[(size_t)m * 16 + lane] = lane == 0 ? s : 0.f;
    }
}
__device__ __forceinline__ void zero_f32(float* ptr, int n) {
    MK_IDS();
    for (int i = gw * 64 + lane; i < n; i += NGW * 64) ptr[i] = 0.f;
}
__device__ __forceinline__ void phase_rmsnorm_final(float* x, const float* g) {
    MK_IDS();
    for (int m = gw; m < TS; m += NGW) {
        f32x4* xr = (f32x4*)(x + (size_t)m * DMODEL) + lane; const f32x4* gr = (const f32x4*)g + lane;
        f32x4 v[4]; float s = 0.f;
#pragma unroll
        for (int j = 0; j < 4; ++j) { v[j] = xr[64 * j]; s += (v[j].x * v[j].x + v[j].y * v[j].y) + (v[j].z * v[j].z + v[j].w * v[j].w); }
        const float rstd = 1.f / sqrtf(wave_sum(s) * (1.f / DMODEL) + EPS);
#pragma unroll
        for (int j = 0; j < 4; ++j) { const f32x4 gg = gr[64 * j]; xr[64 * j] = v[j] * rstd * gg; }
    }
}

struct EpiRes {
    static constexpr bool PERM = false, AFTER_DRAIN = false;
    const float* base; float* out; int ldc; bf16_t* xb; float* ssq;
    __device__ __forceinline__ void operator()(const pg8::f32x4 (&acc)[2][2][4][2], const pg8::Unit& u, int wr, int wc, int fr, int fq) const {
        const int col0 = u.pn * pg8::BM + wc * 32 + 4 * fq;
#pragma unroll
        for (int ai = 0; ai < 2; ++ai)
#pragma unroll
            for (int m = 0; m < 4; ++m) { const int row = u.pm * pg8::BM + ai * pg8::HALF + wr * 64 + m * 16 + fr; const size_t off = (size_t)row * ldc + col0; float sq = 0.f;
#pragma unroll
                for (int bj = 0; bj < 2; ++bj)
#pragma unroll
                    for (int n = 0; n < 2; ++n) { const pg8::f32x4 bs = *(const pg8::f32x4*)(base + off + bj * pg8::HALF + n * 16); const pg8::f32x4 o = bs + acc[ai][bj][m][n];
                        *(pg8::f32x4*)(out + off + bj * pg8::HALF + n * 16) = o;
                        u32x2 w; w.x = pg8::cvt_pk_bf16(o[0], o[1]); w.y = pg8::cvt_pk_bf16(o[2], o[3]); *(u32x2*)(xb + off + bj * pg8::HALF + n * 16) = w;
                        sq += (o[0] * o[0] + o[1] * o[1]) + (o[2] * o[2] + o[3] * o[3]); }
                sq += __shfl_xor(sq, 16); sq += __shfl_xor(sq, 32);
                if (fq == 0) ssq[(size_t)row * 16 + u.pn * 4 + wc] = sq;
                if (m & 1) asm volatile("" ::: "memory"); }
    }
};

__device__ __forceinline__ void even_qk_post(bf16_t* proj, const float* qg, const float* kg, int S) {
    MK_IDS();
    const int d = lane, axis = d >> 5, f = d & 15, half = (d >> 4) & 1;
    const float inv = exp2f(-(float)f * (13.287712379549449f / 16.f));
    const float gq = qg[d], gk = kg[d];
    for (int t = gw; t < TS; t += NGW) {
        const int s = t % S; const int pos = axis ? (s & 63) : (s >> 6);
        const float ang = (float)pos * inv; float sn, cs; sincosf(ang, &sn, &cs);
        bf16_t* row = proj + (size_t)t * EIN;
#pragma unroll
        for (int hh = 0; hh < 10; ++hh) {
            const int c0 = hh < 8 ? hh * 64 : 512 + (hh - 8) * 64;
            const float x = bf2f(row[c0 + d]);
            const float ss = wave_sum(x * x);
            const float y = x * (1.f / sqrtf(ss * (1.f / 64.f) + EPS)) * (hh < 8 ? gq : gk);
            const float pr = __shfl_xor(y, 16);
            float o = y * cs + (half ? pr : -pr) * sn;
            if (hh < 8) o *= attn_body::C2;
            row[c0 + d] = (bf16_t)f2bf(o);
        }
    }
}
__device__ __forceinline__ void even_lru_prep(const bf16_t* proj, const float* cw, const float* cb, const bf16_t* GWj, const float* br, const float* bi, const float* lam,
                                              float* LA, float* UU, f32x2* AGG, int S, char* lds) {
    MK_IDS();
    constexpr int XST = 1040;
    for (int tile = blockIdx.x; tile < TS / 64; tile += gridDim.x) {
        const int t0 = tile * 64;
        __syncthreads();
#pragma unroll 2
        for (int k = 0; k < 8; ++k) {
            const int idx = tid + k * NT, i = idx >> 6, cgp = idx & 63, t = t0 + i, s = t % S, ch = cgp * 8;
            float acc[8];
#pragma unroll
            for (int e = 0; e < 8; ++e) acc[e] = cb[ch + e];
#pragma unroll
            for (int j = 0; j < 4; ++j) { const int sp = s + j - 2;
                if (sp >= 0 && sp < S) { const u32x4 v = *(const u32x4*)(proj + (size_t)(t + j - 2) * EIN + 768 + ch); float xv[8]; unpack8(v, xv);
#pragma unroll
                    for (int e = 0; e < 8; ++e) acc[e] += cw[j * 512 + ch + e] * xv[e]; } }
            u32x4 o; o.x = pk2(acc[0], acc[1]); o.y = pk2(acc[2], acc[3]); o.z = pk2(acc[4], acc[5]); o.w = pk2(acc[6], acc[7]);
            *(u32x4*)(lds + i * XST + ch * 2) = o;
        }
        __syncthreads();
        const int G = lane >> 4, l16 = lane & 15, ch0 = wave * 64;
        for (int dir = 0; dir < 2; ++dir)
            for (int nt = 0; nt < 4; ++nt) {
                const int e = nt * 16 + l16, ch = ch0 + e;
                bf16x8 Br[2], Bi[2];
#pragma unroll
                for (int kk = 0; kk < 2; ++kk) {
                    Br[kk] = *(const bf16x8*)(GWj + ((((size_t)dir * 2 + 0) * 8 + wave) * 64 + e) * 64 + kk * 32 + G * 8);
                    Bi[kk] = *(const bf16x8*)(GWj + ((((size_t)dir * 2 + 1) * 8 + wave) * 64 + e) * 64 + kk * 32 + G * 8);
                }
                const float brv = br[dir * 512 + ch], biv = bi[dir * 512 + ch], spl = softplus(-lam[dir * 512 + ch]);
#pragma unroll
                for (int mt = 0; mt < 4; ++mt) {
                    f32x4 ar = {0.f, 0.f, 0.f, 0.f}, ai = {0.f, 0.f, 0.f, 0.f};
#pragma unroll
                    for (int kk = 0; kk < 2; ++kk) { const bf16x8 a = *(const bf16x8*)(lds + (mt * 16 + l16) * XST + (ch0 + kk * 32 + G * 8) * 2); ar = MFMA16(a, Br[kk], ar); ai = MFMA16(a, Bi[kk], ai); }
#pragma unroll
                    for (int r = 0; r < 4; ++r) { const int i = mt * 16 + G * 4 + r;
                        const float xc = bf2f(*(const bf16_t*)(lds + i * XST + ch * 2));
                        const float rg = __builtin_amdgcn_rcpf(1.f + __expf(-(ar[r] + brv))), ig = __builtin_amdgcn_rcpf(1.f + __expf(-(ai[r] + biv)));
                        const float la = -8.f * rg * spl; const float uu = __builtin_amdgcn_sqrtf(fmaxf(1.f - __expf(2.f * la), 0.f)) * (ig * xc);
                        const size_t o = ((size_t)dir * TS + t0 + i) * 512 + ch; LA[o] = la; UU[o] = uu; }
                }
            }
        asm volatile("s_waitcnt vmcnt(0)" ::: "memory");
        __syncthreads();
        {
            const int ch = tid;
#pragma unroll
            for (int dir = 0; dir < 2; ++dir) {
                float h = 0.f, P = 0.f;
                const float* la = LA + ((size_t)dir * TS + t0) * 512 + ch; const float* uu = UU + ((size_t)dir * TS + t0) * 512 + ch;
#pragma unroll
                for (int q = 0; q < 64; q += 8) {
                    float lv[8], uv[8];
#pragma unroll
                    for (int e = 0; e < 8; ++e) { const int i = dir ? 63 - (q + e) : q + e; lv[e] = la[(size_t)i * 512]; uv[e] = uu[(size_t)i * 512]; }
#pragma unroll
                    for (int e = 0; e < 8; ++e) { h = __expf(lv[e]) * h + uv[e]; P += lv[e]; }
                }
                AGG[((size_t)dir * (TS / 64) + tile) * 512 + ch] = (f32x2){P, h};
            }
        }
    }
}
__device__ __forceinline__ void even_lru_scan(const float* LA, const float* UU, const f32x2* AGG, const bf16_t* proj, bf16_t* Y, int S) {
    MK_IDS();
    const int ch = tid, TPB = S / 64;
    for (int tile = blockIdx.x; tile < TS / 64; tile += gridDim.x) {
        const int t0 = tile * 64, tb0 = (tile / TPB) * TPB;
        float cf = 0.f, cr = 0.f;
        for (int k0 = tb0; k0 < tile; k0 += 8) { f32x2 a[8];
#pragma unroll
            for (int q = 0; q < 8; ++q) { const int k = k0 + q < tile ? k0 + q : tile - 1; a[q] = AGG[(size_t)k * 512 + ch]; }
#pragma unroll
            for (int q = 0; q < 8; ++q) if (k0 + q < tile) cf = cf * __expf(a[q].x) + a[q].y; }
        for (int k0 = tb0 + TPB - 1; k0 > tile; k0 -= 8) { f32x2 a[8];
#pragma unroll
            for (int q = 0; q < 8; ++q) { const int k = k0 - q > tile ? k0 - q : tile + 1; a[q] = AGG[((size_t)(TS / 64) + k) * 512 + ch]; }
#pragma unroll
            for (int q = 0; q < 8; ++q) if (k0 - q > tile) cr = cr * __expf(a[q].x) + a[q].y; }
        float hf[64];
        {
            const float* la = LA + (size_t)t0 * 512 + ch; const float* uu = UU + (size_t)t0 * 512 + ch; float h = cf;
#pragma unroll
            for (int q = 0; q < 64; q += 8) {
                float lv[8], uv[8];
#pragma unroll
                for (int e = 0; e < 8; ++e) { lv[e] = la[(size_t)(q + e) * 512]; uv[e] = uu[(size_t)(q + e) * 512]; }
#pragma unroll
                for (int e = 0; e < 8; ++e) { h = __expf(lv[e]) * h + uv[e]; hf[q + e] = h; }
            }
        }
        {
            const float* la = LA + ((size_t)TS + t0) * 512 + ch; const float* uu = UU + ((size_t)TS + t0) * 512 + ch; float h = cr;
#pragma unroll
            for (int q = 0; q < 64; q += 8) {
                float lv[8], uv[8], gv[8];
#pragma unroll
                for (int e = 0; e < 8; ++e) { const int i = 63 - (q + e); lv[e] = la[(size_t)i * 512]; uv[e] = uu[(size_t)i * 512]; gv[e] = bf2f(proj[(size_t)(t0 + i) * EIN + 1280 + ch]); }
#pragma unroll
                for (int e = 0; e < 8; ++e) { const int i = 63 - (q + e); h = __expf(lv[e]) * h + uv[e]; Y[(size_t)(t0 + i) * DMODEL + 512 + ch] = (bf16_t)f2bf((hf[i] + h) * gelu_tanh(gv[e])); }
            }
        }
    }
}

__device__ __forceinline__ void odd_conv(const bf16_t* proj, const float* cw, bf16_t* QKVP, int S) {
    MK_IDS();
    for (int t = gw; t < TS; t += NGW) {
        const int s = t % S;
#pragma unroll
        for (int blk = 0; blk < 3; ++blk) {
            const int ch = blk * 512 + lane * 8;
            float acc[8];
#pragma unroll
            for (int e = 0; e < 8; ++e) acc[e] = 0.f;
#pragma unroll
            for (int j = 0; j < 4; ++j) { const int sp = s + j - 2;
                if (sp >= 0 && sp < S) { const u32x4 v = *(const u32x4*)(proj + (size_t)(t + j - 2) * OINP + ch); float xv[8]; unpack8(v, xv);
                    const f32x4 w0 = *(const f32x4*)(cw + j * 1536 + ch), w1 = *(const f32x4*)(cw + j * 1536 + ch + 4);
                    acc[0] += w0.x * xv[0]; acc[1] += w0.y * xv[1]; acc[2] += w0.z * xv[2]; acc[3] += w0.w * xv[3];
                    acc[4] += w1.x * xv[4]; acc[5] += w1.y * xv[5]; acc[6] += w1.z * xv[6]; acc[7] += w1.w * xv[7]; } }
            float ss = 0.f;
#pragma unroll
            for (int e = 0; e < 8; ++e) { acc[e] = silu(acc[e]); ss += acc[e] * acc[e]; }
            if (blk < 2) {
                ss += __shfl_xor(ss, 1); ss += __shfl_xor(ss, 2); ss += __shfl_xor(ss, 4); ss += __shfl_xor(ss, 8);
                const float rn = 1.f / sqrtf(ss + EPS);
#pragma unroll
                for (int e = 0; e < 8; ++e) acc[e] *= rn;
            }
            u32x4 o; o.x = pk2(acc[0], acc[1]); o.y = pk2(acc[2], acc[3]); o.z = pk2(acc[4], acc[5]); o.w = pk2(acc[6], acc[7]);
            *(u32x4*)(QKVP + (size_t)t * 1536 + ch) = o;
        }
    }
}

__device__ __forceinline__ int frag128(int r, int k) { return ((((r >> 4) * 4 + (k >> 5)) * 64 + ((k >> 3) & 3) * 16 + (r & 15)) << 3) + (k & 7); }
__device__ __forceinline__ int frag64(int r, int k) { return ((((r >> 4) * 2 + (k >> 5)) * 64 + ((k >> 3) & 3) * 16 + (r & 15)) << 3) + (k & 7); }
__device__ __forceinline__ void odd_prep(const bf16_t* QKVP, const bf16_t* proj, const float* alog, const float* dtb, unsigned char* DNI, float* EGL, char* lds) {
    MK_IDS();
    constexpr int RS = 272;
    constexpr int HOFF = 69632;
    const float scale = 0.08838834764831845f;
    for (int it0 = blockIdx.x * 2; it0 < 2048; it0 += gridDim.x * 2) {
        int tq_ = tid; asm volatile("" : "+v"(tq_));
        const int half = tq_ >> 8, ht = tq_ & 255, hwave = __builtin_amdgcn_readfirstlane(ht >> 6), G = (tq_ & 63) >> 4, l16 = tq_ & 15;
        char* L = lds + half * HOFF;
        char* KS = L, *QS = L + 17408, *VS = L + 34816; float* LM = (float*)(L + 52224); float* GC = (float*)(L + 68608); float* BT = GC + 64; float* EG = BT + 64;
        const int it = it0 + half; const int d = it & 1, h = (it >> 1) & 3, c = it >> 3, t0 = c * 64;
        __syncthreads();
#pragma unroll
        for (int k = 0; k < 4; ++k) { const int idx = ht + k * 256, i = idx >> 4, pc = idx & 15; const int tk = d ? t0 + 63 - i : t0 + i;
            const bf16_t* src = QKVP + (size_t)tk * 1536 + h * 128 + pc * 8;
            *(u32x4*)(QS + i * RS + pc * 16) = *(const u32x4*)(src);
            *(u32x4*)(KS + i * RS + pc * 16) = *(const u32x4*)(src + 512);
            *(u32x4*)(VS + i * RS + pc * 16) = *(const u32x4*)(src + 1024); }
        if (hwave == 0) {
            const int i = lane; const int tk = d ? t0 + 63 - i : t0 + i;
            const float bl = bf2f(proj[(size_t)tk * OINP + 2048 + d * 4 + h]), al = bf2f(proj[(size_t)tk * OINP + 2056 + d * 4 + h]);
            const float beta = sigm(bl); float g = -__expf(alog[d * 4 + h]) * softplus(al + dtb[d * 4 + h]);
#pragma unroll
            for (int o = 1; o < 64; o <<= 1) { const float v = __shfl_up(g, o); if (lane >= o) g += v; }
            GC[i] = g; BT[i] = beta; EG[i] = __expf(g);
        }
        __syncthreads();
        {
            const bool isq = hwave >= 2; const char* XS = isq ? QS : KS;
#pragma unroll
            for (int mm = 0; mm < 2; ++mm) { const int mt = (hwave & 1) * 2 + mm;
                bf16x8 a[4];
#pragma unroll
                for (int kk = 0; kk < 4; ++kk) a[kk] = *(const bf16x8*)(XS + (mt * 16 + l16) * RS + (kk * 32 + G * 8) * 2);
#pragma unroll
                for (int nt = 0; nt < 4; ++nt) { f32x4 acc = {0.f, 0.f, 0.f, 0.f};
#pragma unroll
                    for (int kk = 0; kk < 4; ++kk) { const bf16x8 bb = *(const bf16x8*)(KS + (nt * 16 + l16) * RS + (kk * 32 + G * 8) * 2); acc = MFMA16(a[kk], bb, acc); }
                    const int j = nt * 16 + l16; const float gj = GC[j];
#pragma unroll
                    for (int r = 0; r < 4; ++r) { const int i = mt * 16 + G * 4 + r; const float dec = __expf(fminf(GC[i] - gj, 0.f));
                        if (!isq) LM[i * 64 + j] = (j < i) ? BT[i] * acc[r] * dec : 0.f;
                        else ((bf16_t*)(DNI + (size_t)it * DNI_BYTES + DNI_A))[frag64(i, j)] = (bf16_t)f2bf((j <= i) ? acc[r] * scale * dec : 0.f); }
                }
            }
        }
        __syncthreads();
        {
            float sol[64];
            const int cc = ht & 127; const bool isw = ht >= 128; const char* XS = isw ? KS : VS;
#pragma unroll
            for (int i = 0; i < 64; ++i) {
                float v = bf2f(*(const bf16_t*)(XS + i * RS + cc * 2)) * BT[i]; if (isw) v *= EG[i];
                float a0 = 0.f, a1 = 0.f;
#pragma unroll
                for (int j4 = 0; j4 < (i + 3) / 4; ++j4) { const f32x4 l4 = *(const f32x4*)(LM + i * 64 + j4 * 4);
                    if (j4 * 4 + 0 < i) a0 += l4.x * sol[j4 * 4 + 0]; if (j4 * 4 + 1 < i) a1 += l4.y * sol[j4 * 4 + 1];
                    if (j4 * 4 + 2 < i) a0 += l4.z * sol[j4 * 4 + 2]; if (j4 * 4 + 3 < i) a1 += l4.w * sol[j4 * 4 + 3];
                    if ((j4 & 1) == 1) asm volatile("" ::: "memory"); }
                v -= a0 + a1;
                sol[i] = v;
                ((bf16_t*)(DNI + (size_t)it * DNI_BYTES + (isw ? DNI_W : DNI_U)))[isw ? frag128(i, cc) : i * 128 + cc] = (bf16_t)f2bf(v);
                asm volatile("" ::: "memory");
            }
        }
        {
            const float gl = GC[63];
#pragma unroll 4
            for (int k = 0; k < 32; ++k) { const int idx = ht + k * 256;
                { const int i = idx >> 7, dm = idx & 127; ((bf16_t*)(DNI + (size_t)it * DNI_BYTES + DNI_QT))[frag128(i, dm)] = (bf16_t)f2bf(bf2f(*(const bf16_t*)(QS + i * RS + dm * 2)) * scale * EG[i]); }
                { const int i = idx & 63, dm = idx >> 6; ((bf16_t*)(DNI + (size_t)it * DNI_BYTES + DNI_KTT))[frag64(dm, i)] = (bf16_t)f2bf(bf2f(*(const bf16_t*)(KS + i * RS + dm * 2)) * __expf(gl - GC[i])); }
            }
            if (ht == 0) EGL[it] = __expf(gl);
        }
    }
}

__device__ __forceinline__ void odd_scan(const unsigned char* DNI, const float* EGL, bf16_t* OB, int S, int nb, char* lds) {
    MK_IDS();
    constexpr int O_SB = 0, O_VN = 4352, O_OUT = 6656;
    const int NC = S / 64, G = lane >> 4, l16 = lane & 15;
    const int nitems = nb * 64;
    const int mt = wave & 3; const bool lo = wave < 4;
    for (int item = blockIdx.x; item < nitems; item += gridDim.x) {
        const int e = (item >> 3) & 7, sq = (item & 7) | ((item >> 6) << 3); const int d = sq & 1, h = (sq >> 1) & 3, b = sq >> 3;
        __syncthreads();
        for (int i = tid; i < 4352 / 4; i += NT) ((unsigned*)(lds + O_SB))[i] = 0u;
        f32x4 Sreg = {0.f, 0.f, 0.f, 0.f};
        const unsigned xoff = (lo ? DNI_W : DNI_QT) + ((mt * 4) * 64 + lane) * 16;
        const unsigned aoff = DNI_A + ((mt * 2) * 64 + lane) * 16;
        const unsigned koff = DNI_KTT + ((wave * 2) * 64 + lane) * 16;
        const unsigned uoff = DNI_U + ((mt * 16 + G * 4) * 128 + e * 16 + l16) * 2;
        u32x4 aX[4], aA[2], aK[2], bX[4], bA[2], bK[2], cX[4], cA[2], cK[2], dX[4], dA[2], dK[2];
        unsigned aU[4], bU[4], cU[4], dU[4]; float aE, bE, cE, dE; unsigned pf_dummy = 0u;
#define DN_LOAD(n, P) do { const int it_ = ((b * NC + (d ? NC - 1 - (n) : (n))) * 4 + h) * 2 + d; const unsigned char* ip = DNI + (size_t)it_ * DNI_BYTES; \
            _Pragma("unroll") for (int kk = 0; kk < 4; ++kk) P##X[kk] = *(const u32x4*)(ip + xoff + kk * 1024); \
            _Pragma("unroll") for (int kk = 0; kk < 2; ++kk) { P##A[kk] = *(const u32x4*)(ip + aoff + kk * 1024); P##K[kk] = *(const u32x4*)(ip + koff + kk * 1024); } \
            _Pragma("unroll") for (int r = 0; r < 4; ++r) P##U[r] = *(const bf16_t*)(ip + uoff + r * 256); \
            P##E = EGL[it_]; } while (0)
#define DN_STEP(n, P, PL) do { \
            { const int nn_ = (n) + 3 < NC ? (n) + 3 : NC - 1; DN_LOAD(nn_, PL); } \
            if (wave < 3) { const int np_ = (n) + PFD < NC ? (n) + PFD : NC - 1; const int itp_ = ((b * NC + (d ? NC - 1 - np_ : np_)) * 4 + h) * 2 + d; \
              const unsigned char* pp_ = DNI + (size_t)itp_ * DNI_BYTES + e * 9216 + (tid < 144 ? tid : 143) * 64; \
              asm volatile("global_load_dword %0, %1, off" : "+v"(pf_dummy) : "v"(pp_) : "memory"); } \
            f32x4 acc = {0.f, 0.f, 0.f, 0.f}; \
            _Pragma("unroll") for (int kk = 0; kk < 4; ++kk) { const bf16x8 bb = *(const bf16x8*)(lds + O_SB + l16 * 272 + (kk * 32 + G * 8) * 2); acc = MFMA16(__builtin_bit_cast(bf16x8, P##X[kk]), bb, acc); } \
            if (lo) { u32x2 o; float v[4]; \
              _Pragma("unroll") for (int r = 0; r < 4; ++r) v[r] = __uint_as_float(P##U[r] << 16) - acc[r]; \
              o.x = pk2(v[0], v[1]); o.y = pk2(v[2], v[3]); \
              *(u32x2*)(lds + O_VN + l16 * 144 + (mt * 16 + G * 4) * 2) = o; } \
            asm volatile("s_waitcnt lgkmcnt(0)\n\ts_barrier" ::: "memory"); \
            bf16x8 vb[2]; \
            _Pragma("unroll") for (int kk = 0; kk < 2; ++kk) vb[kk] = *(const bf16x8*)(lds + O_VN + l16 * 144 + (kk * 32 + G * 8) * 2); \
            Sreg = Sreg * P##E; \
            _Pragma("unroll") for (int kk = 0; kk < 2; ++kk) Sreg = MFMA16(__builtin_bit_cast(bf16x8, P##K[kk]), vb[kk], Sreg); \
            { u32x2 o; o.x = pk2(Sreg[0], Sreg[1]); o.y = pk2(Sreg[2], Sreg[3]); \
              *(u32x2*)(lds + O_SB + l16 * 272 + (wave * 16 + G * 4) * 2) = o; } \
            if (!lo) { \
              _Pragma("unroll") for (int kk = 0; kk < 2; ++kk) acc = MFMA16(__builtin_bit_cast(bf16x8, P##A[kk]), vb[kk], acc); \
              _Pragma("unroll") for (int r = 0; r < 4; ++r) *(bf16_t*)(lds + O_OUT + ((mt * 16 + G * 4 + r) * 16 + l16) * 2) = (bf16_t)f2bf(acc[r]); } \
            asm volatile("s_waitcnt lgkmcnt(0)\n\ts_barrier" ::: "memory"); \
            { const int t0 = (b * NC + (d ? NC - 1 - (n) : (n))) * 64; const int i = tid >> 3; const int tk = d ? t0 + 63 - i : t0 + i; \
              *(unsigned*)(OB + ((size_t)d * TS + tk) * 512 + h * 128 + e * 16 + (tid & 7) * 2) = *(const unsigned*)(lds + O_OUT + tid * 4); } } while (0)
        DN_LOAD(0, a); DN_LOAD(1, b); DN_LOAD(2, c);
        __syncthreads();
        constexpr int PFD = 7;
        for (int n = 0; n < NC; n += 4) {
            DN_STEP(n, a, d);
            DN_STEP(n + 1, b, a);
            DN_STEP(n + 2, c, b);
            DN_STEP(n + 3, d, c);
        }
#undef DN_STEP
#undef DN_LOAD
        asm volatile("s_waitcnt vmcnt(0)" ::: "memory");
        asm volatile("" :: "v"(pf_dummy));
    }
}

__device__ __forceinline__ int t5_bucket(int rel) {
    const int n = rel < 0 ? -rel : rel; int v;
    if (n < 8) v = n; else v = 8 + (n >= 15) + (n >= 27) + (n >= 50) + (n >= 91) + (n >= 166) + (n >= 305) + (n >= 559);
    return (rel > 0 ? 16 : 0) + v;
}
__device__ __forceinline__ void odd_dilated(bf16_t* proj, const float* relb, float* LSE, int S, char* lds, int first_wg, int n_wg) {
    MK_IDS();
    constexpr int KST = 144, VST = 400, HOFF = 27648 + 25600 + 1024;
    const int half = tid >> 8, ht = tid & 255, wv = ht >> 6, G = lane >> 4, l16 = lane & 15;
    char* L = lds + half * HOFF; char* KS = L; char* VT = L + 27648; float* BIAS = (float*)(L + 27648 + 25600);
    const int NBb = S / 64;
    const int wgi = (int)blockIdx.x - first_wg;
    if (wgi < 0) return;
    for (int it0 = wgi * 2; it0 < 3072; it0 += n_wg * 2) {
        const int it = it0 + half; const int zb = it & 255, sl = (it >> 8) & 3, g = it >> 10;
        const int dil = g == 0 ? 1 : (g == 1 ? 4 : 16), lg = g * 2;
        const int M = S >> lg, MB = M / 64;
        const int b = zb / NBb, r0 = zb % NBb, rho = r0 / MB, n = r0 % MB;
        const int hc = (g * 4 + sl) * 64;
        const size_t tb = (size_t)b * S;
        __syncthreads();
#pragma unroll
        for (int k = 0; k < 6; ++k) { const int idx = ht + k * 256, kj = idx >> 3, pc = idx & 7; const int mk = 64 * n - 64 + kj;
            u32x4 kv = {0u, 0u, 0u, 0u}, vv = {0u, 0u, 0u, 0u};
            if (mk >= 0 && mk < M) { const bf16_t* rowp = proj + (tb + (size_t)mk * dil + rho) * OINP; kv = *(const u32x4*)(rowp + 2832 + hc + pc * 8); vv = *(const u32x4*)(rowp + 3600 + hc + pc * 8); }
            *(u32x4*)(KS + kj * KST + pc * 16) = kv;
            const unsigned w[4] = {vv.x, vv.y, vv.z, vv.w};
#pragma unroll
            for (int q = 0; q < 4; ++q) { *(bf16_t*)(VT + (pc * 8 + 2 * q) * VST + kj * 2) = (bf16_t)(w[q] & 0xffffu); *(bf16_t*)(VT + (pc * 8 + 2 * q + 1) * VST + kj * 2) = (bf16_t)(w[q] >> 16); } }
        if (ht < 129) BIAS[ht] = relb[t5_bucket((ht - 64) * dil) * 12 + g * 4 + sl];
        const int mq = 64 * n + 16 * wv + l16; const size_t tq = tb + (size_t)mq * dil + rho;
        bf16x8 qf[2];
#pragma unroll
        for (int kk = 0; kk < 2; ++kk) qf[kk] = *(const bf16x8*)(proj + tq * OINP + 2064 + hc + kk * 32 + G * 8);
        __syncthreads();
        f32x4 sc[9]; float mx = -1e30f;
#pragma unroll
        for (int kt = 0; kt < 9; ++kt) { f32x4 acc = {0.f, 0.f, 0.f, 0.f};
#pragma unroll
            for (int kk = 0; kk < 2; ++kk) { const bf16x8 a = *(const bf16x8*)(KS + ((wv + kt) * 16 + l16) * KST + (kk * 32 + G * 8) * 2); acc = MFMA16(a, qf[kk], acc); }
#pragma unroll
            for (int r = 0; r < 4; ++r) { const int kj = (wv + kt) * 16 + G * 4 + r; const int delta = kj - 64 - 16 * wv - l16; const int mk = 64 * n - 64 + kj;
                const bool ok = (delta >= -64) && (delta <= 64) && (mk >= 0) && (mk < M);
                const float s = ok ? acc[r] * 0.125f + BIAS[(delta < -64 ? -64 : (delta > 64 ? 64 : delta)) + 64] : -1e30f;
                acc[r] = s; mx = fmaxf(mx, s); }
            sc[kt] = acc; }
        mx = fmaxf(mx, __shfl_xor(mx, 16)); mx = fmaxf(mx, __shfl_xor(mx, 32));
        float sum = 0.f;
#pragma unroll
        for (int kt = 0; kt < 9; ++kt)
#pragma unroll
            for (int r = 0; r < 4; ++r) { const float pv_ = (sc[kt][r] > -1e29f) ? __expf(sc[kt][r] - mx) : 0.f; sc[kt][r] = pv_; sum += pv_; }
        sum += __shfl_xor(sum, 16); sum += __shfl_xor(sum, 32);
        f32x4 ot[4];
#pragma unroll
        for (int dt = 0; dt < 4; ++dt) ot[dt] = (f32x4){0.f, 0.f, 0.f, 0.f};
#pragma unroll
        for (int pp = 0; pp < 5; ++pp) {
            u32x4 pb; pb.x = pk2(sc[2 * pp][0], sc[2 * pp][1]); pb.y = pk2(sc[2 * pp][2], sc[2 * pp][3]);
            if (pp < 4) { pb.z = pk2(sc[2 * pp + 1][0], sc[2 * pp + 1][1]); pb.w = pk2(sc[2 * pp + 1][2], sc[2 * pp + 1][3]); } else { pb.z = 0u; pb.w = 0u; }
            const bf16x8 pbf = __builtin_bit_cast(bf16x8, pb);
#pragma unroll
            for (int dt = 0; dt < 4; ++dt) {
                u32x4 av; const u32x2 lo = *(const u32x2*)(VT + (dt * 16 + l16) * VST + ((wv + 2 * pp) * 16 + G * 4) * 2); av.x = lo.x; av.y = lo.y;
                if (pp < 4) { const u32x2 hi = *(const u32x2*)(VT + (dt * 16 + l16) * VST + ((wv + 2 * pp + 1) * 16 + G * 4) * 2); av.z = hi.x; av.w = hi.y; } else { av.z = 0u; av.w = 0u; }
                ot[dt] = MFMA16(__builtin_bit_cast(bf16x8, av), pbf, ot[dt]);
            }
        }
        const float rs = 1.f / sum;
        float* od = (float*)(proj + tq * OINP) + (g * 4 + sl) * 64;
#pragma unroll
        for (int dt = 0; dt < 4; ++dt) *(f32x4*)(od + dt * 16 + G * 4) = ot[dt] * rs;
        if (G == 0) LSE[tq * 12 + g * 4 + sl] = mx + __logf(sum);
    }
}

__device__ __forceinline__ void odd_combine(const bf16_t* OB, const bf16_t* proj, const float* LSE, const float* og, bf16_t* Y) {
    MK_IDS();
    const float g0 = og[lane * 2], g1 = og[lane * 2 + 1];
    for (int t = gw; t < TS; t += NGW) {
        const bf16_t* prow = proj + (size_t)t * OINP;
#pragma unroll
        for (int hh = 0; hh < 4; ++hh) {
            const unsigned a = *(const unsigned*)(OB + (size_t)t * 512 + hh * 128 + lane * 2), bb = *(const unsigned*)(OB + ((size_t)TS + t) * 512 + hh * 128 + lane * 2);
            const unsigned zz = *(const unsigned*)(prow + 1536 + hh * 128 + lane * 2);
            const float o0 = __uint_as_float(a << 16) + __uint_as_float(bb << 16), o1 = __uint_as_float(a & 0xffff0000u) + __uint_as_float(bb & 0xffff0000u);
            const float ss = wave_sum(o0 * o0 + o1 * o1); const float rn = 1.f / sqrtf(ss * (1.f / 128.f) + EPS);
            const float z0 = __uint_as_float(zz << 16), z1 = __uint_as_float(zz & 0xffff0000u);
            *(unsigned*)(Y + (size_t)t * OOUT + hh * 128 + lane * 2) = pk2(o0 * rn * g0 * silu(z0), o1 * rn * g1 * silu(z1));
        }
        const float* od = (const float*)prow;
#pragma unroll
        for (int sl = 0; sl < 4; ++sl) {
            const float l0 = LSE[(size_t)t * 12 + sl], l1 = LSE[(size_t)t * 12 + 4 + sl], l2 = LSE[(size_t)t * 12 + 8 + sl];
            const float m = fmaxf(l0, fmaxf(l1, l2)); const float w0 = __expf(l0 - m), w1 = __expf(l1 - m), w2 = __expf(l2 - m); const float rs = 1.f / (w0 + w1 + w2);
            const float v = (w0 * od[sl * 64 + lane] + w1 * od[256 + sl * 64 + lane] + w2 * od[512 + sl * 64 + lane]) * rs;
            Y[(size_t)t * OOUT + 512 + sl * 64 + lane] = (bf16_t)f2bf(v);
        }
    }
}

__global__ void __launch_bounds__(NT, 2) fwd_megakernel(Params p) {
    extern __shared__ __attribute__((aligned(16))) unsigned char lds_raw[];
    cg::grid_group grid = cg::this_grid();
    char* lds = (char*)lds_raw;
    PG8_LAS unsigned char* ldsl = (PG8_LAS unsigned char*)lds_raw;
    const int Gr = gridDim.x;
    volatile LAS unsigned* MISC = (volatile LAS unsigned*)((PG8_LAS unsigned char*)lds_raw + (LDS_BYTES - 128));
    if (threadIdx.x < 32) MISC[threadIdx.x] = 0u;
    __syncthreads();
    xb::XcdBarrier bar = xb::xcd_barrier_post((unsigned*)p.ws, MISC + 8);
#define GSYNC() xb::xcd_barrier(bar)
    unsigned char* ws = p.ws;
    bf16_t* H = (bf16_t*)(ws + WS_H); bf16_t* PROJ = (bf16_t*)(ws + WS_PROJ); unsigned char* SCR = ws + WS_SCR;

    phase_prologue(p, lds);
    grid.sync();

    float* SSQA = (float*)(SCR + 232 * MiB); float* SSQB = (float*)(SCR + 234 * MiB);
    bf16_t* YE = (bf16_t*)(SCR + 192 * MiB); bf16_t* YO = (bf16_t*)(SCR + SC_QKVP);
    for (int seg = 0; seg < NSEG; ++seg) {
        const int S = seg < 2 ? 16384 : 2048, nb = seg < 2 ? 1 : 8;
        const float* xin = (seg < 2 ? p.in[0] : p.in[1]) + (size_t)(seg & 1) * TS * DMODEL;
        float* xo = p.out + (size_t)seg * TS * DMODEL;
        phase_x0(xin, H, SSQB);
        GSYNC();
        for (int layer = 0; layer < 4; ++layer) {
            const float* xcur = layer == 0 ? xin : xo;
            const int j = layer >> 1; const bool odd = layer & 1;
            {
                const int N = odd ? OINP : EIN;
                const bf16_t* Bt = odd ? (const bf16_t*)(ws + WS_WINO) + (size_t)j * OINP * 1024 : (const bf16_t*)(ws + WS_WINE) + (size_t)j * EIN * 1024;
                pg8::Gemm g{H, Bt, TS, N, 1024}; pg8::StaticOrder So; So.init(TS, N, Gr, (int)blockIdx.x);
                pg8::EpiBf16<0> E{PROJ, N, nullptr, 0, 0, 1.f, SSQB};
                pg8::gemm_phase<pg8::EpiBf16<0>, pg8::StaticOrder, true, true>(ldsl, g, So, E);
            }
            GSYNC();
            if (!odd) {
                even_qk_post(PROJ, p.in[10] + j * 64, p.in[11] + j * 64, S);
                even_lru_prep(PROJ, p.in[12] + j * 2048, p.in[13] + j * 512, (const bf16_t*)(ws + WS_GW) + (size_t)j * 2 * 2 * 8 * 4096, p.in[15] + j * 1024, p.in[17] + j * 1024, p.in[18] + j * 1024,
                              (float*)(SCR + SC_LA), (float*)(SCR + SC_UU), (f32x2*)(SCR + SC_AGG), S, lds);
                GSYNC();
                {
                    const int nqb = S / 256, nunits = nb * 8 * nqb;
                    for (int u = blockIdx.x; u < nunits; u += Gr) {
                        const int qb = u % nqb, h = (u / nqb) % 8, b = u / (nqb * 8), kvh = h >> 2;
                        const attn_body::bf16* base = (const attn_body::bf16*)PROJ + (size_t)b * S * EIN;
                        attn_body::attn_unit<8>(qb, S, base + h * 64, EIN, base + 512 + kvh * 64, base + 640 + kvh * 64, EIN, (attn_body::bf16*)YE + (size_t)b * S * DMODEL + h * 64, DMODEL, lds);
                    }
                }
                __syncthreads();
                even_lru_scan((const float*)(SCR + SC_LA), (const float*)(SCR + SC_UU), (const f32x2*)(SCR + SC_AGG), PROJ, YE, S);
                GSYNC();
                {
                    pg8::Gemm g{YE, (const bf16_t*)(ws + WS_WOUTE) + (size_t)j * 1024 * 1024, TS, 1024, 1024}; pg8::StaticOrder So; So.init(TS, 1024, Gr, (int)blockIdx.x);
                    EpiRes E{xcur, xo, DMODEL, H, SSQA};
                    pg8::gemm_phase<EpiRes, pg8::StaticOrder, true, true>(ldsl, g, So, E);
                }
            } else {
                odd_conv(PROJ, p.in[21] + j * 4 * 1536, (bf16_t*)(SCR + SC_QKVP), S);
                GSYNC();
                odd_prep((const bf16_t*)(SCR + SC_QKVP), PROJ, p.in[22] + j * 8, p.in[23] + j * 8, SCR + SC_DNI, (float*)(SCR + SC_EGL), lds);
                GSYNC();
                {
                    const int nscan = nb * 64;
                    odd_scan(SCR + SC_DNI, (const float*)(SCR + SC_EGL), (bf16_t*)(SCR + SC_OB), S, nb, lds);
                    const int first = nscan < Gr ? nscan : 0;
                    odd_dilated(PROJ, p.in[2], (float*)(SCR + SC_LSE), S, lds, first, Gr - first);
                }
                GSYNC();
                odd_combine((const bf16_t*)(SCR + SC_OB), PROJ, (const float*)(SCR + SC_LSE), p.in[24] + j * 128, YO);
                GSYNC();
                {
                    pg8::Gemm g{YO, (const bf16_t*)(ws + WS_WOUTO) + (size_t)j * 1024 * OOUT, TS, 1024, OOUT}; pg8::StaticOrder So; So.init(TS, 1024, Gr, (int)blockIdx.x);
                    EpiRes E{xcur, xo, DMODEL, H, SSQA};
                    pg8::gemm_phase<EpiRes, pg8::StaticOrder, true, true>(ldsl, g, So, E);
                }
            }
            GSYNC();
            {
                pg8::Gemm g{H, (const bf16_t*)(ws + WS_W1T) + (size_t)layer * 4096 * 1024, TS, DFF, 1024}; pg8::StaticOrder So; So.init(TS, DFF, Gr, (int)blockIdx.x);
                pg8::EpiBf16<2> E{(bf16_t*)(SCR + SC_HID), DFF, nullptr, 0, 0, 1.f, SSQA};
                pg8::gemm_phase<pg8::EpiBf16<2>, pg8::StaticOrder, true, true>(ldsl, g, So, E);
            }
            GSYNC();
            {
                pg8::Gemm g{(const bf16_t*)(SCR + SC_HID), (const bf16_t*)(ws + WS_W2T) + (size_t)layer * 1024 * 4096, TS, 1024, DFF}; pg8::StaticOrder So; So.init(TS, 1024, Gr, (int)blockIdx.x);
                EpiRes E{xo, xo, DMODEL, H, SSQB};
                pg8::gemm_phase<EpiRes, pg8::StaticOrder, true, true>(ldsl, g, So, E);
            }
            GSYNC();
        }
        phase_rmsnorm_final(xo, p.in[5]);
    }
}
}

extern "C" void kernel_launch(void* const* d_in, const int* in_sizes, int n_in, void* d_out, int out_size, void* d_ws, size_t ws_size, hipStream_t stream) {
    static int grid = 0;
    if (grid == 0) {
        if (n_in != 25 || ws_size < mk::WS_END) { fprintf(stderr, "kernel_launch: unexpected n_in %d / ws_size %zu\n", n_in, ws_size); grid = -1; return; }
        int dev = 0, cus = 0, per_cu = 0;
        hipGetDevice(&dev); hipDeviceGetAttribute(&cus, hipDeviceAttributeMultiprocessorCount, dev);
        if (hipFuncSetAttribute((const void*)mk::fwd_megakernel, hipFuncAttributeMaxDynamicSharedMemorySize, mk::LDS_BYTES) != hipSuccess) { fprintf(stderr, "hipFuncSetAttribute failed\n"); }
        hipOccupancyMaxActiveBlocksPerMultiprocessor(&per_cu, (const void*)mk::fwd_megakernel, mk::NT, mk::LDS_BYTES);
        (void)hipGetLastError();
        if (per_cu < 1) per_cu = 1;
        grid = cus * 1;
        fprintf(stderr, "kernel_launch: cus %d per_cu %d grid %d\n", cus, per_cu, grid);
    }
    if (grid < 0) return;
    if (hipMemsetAsync(d_ws, 0, 65536, stream) != hipSuccess) { fprintf(stderr, "memset failed\n"); return; }
    mk::Params p{};
    for (int i = 0; i < 25; ++i) p.in[i] = (const float*)d_in[i];
    p.out = (float*)d_out; p.ws = (unsigned char*)d_ws;
    void* args[] = {&p};
    hipError_t e = hipLaunchCooperativeKernel((const void*)mk::fwd_megakernel, dim3(grid), dim3(mk::NT), args, mk::LDS_BYTES, stream);
    if (e != hipSuccess) fprintf(stderr, "cooperative launch failed: %s (grid %d)\n", hipGetErrorString(e), grid);
}
```

```cpp
#include <hip/hip_runtime.h>
#include <hip/hip_cooperative_groups.h>
#include <hip/hip_bf16.h>
#include <cstdio>
#include <cstdint>
#include <cmath>
namespace cg = cooperative_groups;
namespace pg8 {
#define PG8_LAS __attribute__((address_space(3)))
typedef unsigned short bf16_t;
typedef short bf16x8 __attribute__((ext_vector_type(8)));
typedef float f32x4 __attribute__((ext_vector_type(4)));
typedef unsigned u32x4 __attribute__((ext_vector_type(4)));
constexpr int BM = 256, BK = 64, HALF = 128, HTB = HALF * BK * 2  , STAGE_BYTES = 8 * HTB, NXCD = 8, WGM = 8;

__host__ __device__ __forceinline__ int lds_byte(int r, int c) { const int st = (r >> 4) * 2 + (c >> 5), rr = r & 15, cc = c & 31, ob = rr * 64 + cc * 2; return st * 1024 + (ob ^ (((ob >> 9) & 1) << 5)); }
__host__ __device__ __forceinline__ void stage_rc(int b, int& R, int& C) { const int st = b / 1024, sb = b % 1024, swz = sb ^ (((sb >> 9) & 1) << 5); R = (st >> 1) * 16 + swz / 64; C = (st & 1) * 32 + (swz % 64) / 2; }
__host__ __device__ __forceinline__ int perm32(int rho) { const int n = rho >> 4, i = rho & 15; return 8 * (i >> 2) + 4 * n + (i & 3); }

struct Unit { int pm, pn; };
struct Gemm { const bf16_t* A; const bf16_t* Bt; int M, N, K; };

struct StaticOrder {
    int nM, nN, nwg, G, c;
    __host__ __device__ void init(int M, int N, int G_, int c_) { nM = M / BM; nN = N / BM; nwg = nM * nN; G = G_; c = c_; }
    __host__ __device__ bool next(int i, Unit& u) const {
        const long L = (long)i * G + c; if (L >= nwg) return false;
        int wgid = (int)L; { const int q = nwg / NXCD, r = nwg % NXCD, xcd = wgid % NXCD, off = wgid / NXCD; wgid = (xcd < r ? xcd * (q + 1) : r * (q + 1) + (xcd - r) * q) + off; }
        const int nig = WGM * nN, gid = wgid / nig, fm = gid * WGM, gsz = (nM - fm) < WGM ? (nM - fm) : WGM;
        u.pm = fm + ((wgid % nig) % gsz); u.pn = (wgid % nig) / gsz; return true;
    }
    __device__ __forceinline__ void a_ready(const Unit&) const {}
    __device__ __forceinline__ void done(const Unit&) const {}
};

__device__ __forceinline__ unsigned cvt_pk_bf16(float lo, float hi) { unsigned r; asm volatile("v_cvt_pk_bf16_f32 %0, %1, %2" : "=v"(r) : "v"(lo), "v"(hi)); return r; }
typedef float f32x2 __attribute__((ext_vector_type(2)));
__device__ __forceinline__ f32x2 gelu_pk(f32x2 v) {
    const f32x2 av = __builtin_elementwise_abs(v), d = av * 0.2316418882f + 1.0f;
    f32x2 t; t.x = __builtin_amdgcn_rcpf(d.x); t.y = __builtin_amdgcn_rcpf(d.y);
    f32x2 q = t * 0.5307027145f + (-0.7265760135f); q = q * t + 0.7107068705f; q = q * t + (-0.142248368f); q = q * t + 0.127414796f; q = q * t;
    const f32x2 s = (v * v) * (-0.72134752044f);
    f32x2 e; e.x = __builtin_amdgcn_exp2f(s.x); e.y = __builtin_amdgcn_exp2f(s.y);
    const f32x2 m = v * (q * e), r = v - m;
    f32x2 o; o.x = v.x < 0.f ? m.x : r.x; o.y = v.y < 0.f ? m.y : r.y; return o;
}

template <int ACT  > struct EpiBf16 {
    static constexpr bool PERM = true, AFTER_DRAIN = false; static_assert(ACT == 0 || ACT == 1 || ACT == 2, "EpiBf16: ACT 0 none, 1 gelu, 2 relu^2");
    bf16_t* O; int ldc; const float* bias; int split_cols; size_t split_stride; float scale0; const float* ssq;
    __device__ __forceinline__ void operator()(const f32x4 (&acc)[2][2][4][2], const Unit& u, int wr, int wc, int fr, int fq) const {
        const int row0 = u.pm * BM + wr * 64 + fr; int colt = u.pn * BM; bf16_t* base = O;
        float sc = 1.f; if (split_cols) { const int t = colt / split_cols; base += (size_t)t * split_stride; colt -= t * split_cols; if (t == 0) sc = scale0; }
        const int col0 = colt + wc * 32 + 8 * fq, bcol0 = u.pn * BM + wc * 32 + 8 * fq;
        float rsc[2][4];
        if (ssq) { f32x4 t_[2][4];
#pragma unroll
            for (int ai = 0; ai < 2; ++ai)
#pragma unroll
                for (int m = 0; m < 4; ++m) t_[ai][m] = *(const f32x4*)(ssq + (size_t)(row0 + ai * HALF + m * 16) * 16 + fq * 4);
#pragma unroll
            for (int ai = 0; ai < 2; ++ai)
#pragma unroll
                for (int m = 0; m < 4; ++m) { float s_ = (t_[ai][m][0] + t_[ai][m][1]) + (t_[ai][m][2] + t_[ai][m][3]); s_ += __shfl_xor(s_, 16); s_ += __shfl_xor(s_, 32); rsc[ai][m] = 1.0f / sqrtf(s_ * (1.0f / 1024.0f) + 1e-6f); }
        } else {
#pragma unroll
            for (int ai = 0; ai < 2; ++ai)
#pragma unroll
                for (int m = 0; m < 4; ++m) rsc[ai][m] = 1.0f; }
        f32x4 bv[2][2];
#pragma unroll
        for (int bj = 0; bj < 2; ++bj)
#pragma unroll
            for (int n = 0; n < 2; ++n) bv[bj][n] = bias ? *(const f32x4*)(bias + bcol0 + bj * HALF + 4 * n) : (f32x4){0.f, 0.f, 0.f, 0.f};
#pragma unroll
        for (int ai = 0; ai < 2; ++ai)
#pragma unroll
            for (int m = 0; m < 4; ++m) { bf16_t* rowp = base + (size_t)(row0 + ai * HALF + m * 16) * ldc + col0; const float rsc_ = rsc[ai][m];
#pragma unroll
                for (int bj = 0; bj < 2; ++bj) { f32x4 v0 = (acc[ai][bj][m][0] + bv[bj][0]) * rsc_, v1 = (acc[ai][bj][m][1] + bv[bj][1]) * rsc_;
                    if (ACT == 1) { f32x2 a = gelu_pk((f32x2){v0[0], v0[1]}), b = gelu_pk((f32x2){v0[2], v0[3]}), c = gelu_pk((f32x2){v1[0], v1[1]}), d = gelu_pk((f32x2){v1[2], v1[3]});
                        v0 = (f32x4){a.x, a.y, b.x, b.y}; v1 = (f32x4){c.x, c.y, d.x, d.y}; }
                    if (ACT == 2) { _Pragma("unroll") for (int q_ = 0; q_ < 4; ++q_) { const float a0_ = v0[q_] > 0.f ? v0[q_] : 0.f, a1_ = v1[q_] > 0.f ? v1[q_] : 0.f; v0[q_] = a0_ * a0_; v1[q_] = a1_ * a1_; } }
                    v0 = v0 * sc; v1 = v1 * sc; u32x4 w; w.x = cvt_pk_bf16(v0[0], v0[1]); w.y = cvt_pk_bf16(v0[2], v0[3]); w.z = cvt_pk_bf16(v1[0], v1[1]); w.w = cvt_pk_bf16(v1[2], v1[3]);
                    *(u32x4*)(rowp + bj * HALF) = w; } }
    }
};

template <class Epi, class Sched, bool ALIGN_EPI = false, bool SP2 = false>
__device__ __forceinline__ void gemm_phase(PG8_LAS unsigned char* lds, const Gemm g, const Sched& S, const Epi& E) {
    int tid_ = threadIdx.x; asm volatile("" : "+v"(tid_)); const int tid = tid_, wid = __builtin_amdgcn_readfirstlane(tid >> 6), lane = tid & 63, wr = wid >> 2, wc = wid & 3, fr = lane & 15, fq = lane >> 4;
    const int K = g.K, nt = K / BK;
    unsigned voffA[2], voffB[2];
#pragma unroll
    for (int i = 0; i < 2; ++i) { int R, C; stage_rc(tid * 16 + i * 8192, R, C); const int Rb = Epi::PERM ? ((R & ~31) + perm32(R & 31)) : R;
        voffA[i] = (unsigned)(R * K + C) * 2u; voffB[i] = (unsigned)(Rb * K + C) * 2u; }
    const size_t kstep = (size_t)(BK * 2);
    const size_t hstep = (size_t)HALF * K * 2;
    const size_t tstep = 2 * hstep;
    const unsigned ldsw = (unsigned)wid * 1024u;
    const int aoff = lds_byte(wr * 64 + fr, fq * 8), boff = lds_byte(wc * 32 + fr, fq * 8);
#define PG8_SA(b, h) (((b) * 2 + (h)) * HTB)
#define PG8_SB(b, h) ((4 + (b) * 2 + (h)) * HTB)
#define PG8_STAGE(bufoff, gbase, voff) do { _Pragma("unroll") for (int _i = 0; _i < 2; ++_i) \
        __builtin_amdgcn_global_load_lds((const unsigned*)((const char*)(gbase) + (voff)[_i]), (PG8_LAS unsigned*)(lds + (bufoff) + ldsw + _i * 8192), 16, 0, 0); } while (0)
#define PG8_LDA(dst, b, h) do { _Pragma("unroll") for (int m = 0; m < 4; ++m) _Pragma("unroll") for (int k = 0; k < 2; ++k) dst[m][k] = *(const PG8_LAS bf16x8*)(lds + PG8_SA(b, h) + aoff + m * 2048 + k * 1024); } while (0)
#define PG8_LDB(dst, b, h) do { _Pragma("unroll") for (int n = 0; n < 2; ++n) _Pragma("unroll") for (int k = 0; k < 2; ++k) dst[n][k] = *(const PG8_LAS bf16x8*)(lds + PG8_SB(b, h) + boff + n * 2048 + k * 1024); } while (0)
#define PG8_MMA(ai, bj, At, Bt) do { __builtin_amdgcn_s_setprio(1); _Pragma("unroll") for (int m = 0; m < 4; ++m) _Pragma("unroll") for (int n = 0; n < 2; ++n) _Pragma("unroll") for (int k = 0; k < 2; ++k) \
        acc[ai][bj][m][n] = __builtin_amdgcn_mfma_f32_16x16x32_bf16(Bt[n][k], At[m][k], acc[ai][bj][m][n], 0, 0, 0); __builtin_amdgcn_s_setprio(0); } while (0)
#define PG8_WAIT_V(n) asm volatile("s_waitcnt vmcnt(" #n ")" ::: "memory")
#define PG8_WAIT_L(n) asm volatile("s_waitcnt lgkmcnt(" #n ")" ::: "memory")
#define PG8_BAR __builtin_amdgcn_s_barrier()
#define PG8_SCHED __builtin_amdgcn_sched_barrier(0)
    Unit cur, nxt; int ui = 0;
    if (!S.next(0, cur)) return;
    f32x4 acc[2][2][4][2];
#pragma unroll
    for (int a = 0; a < 2; ++a)
#pragma unroll
        for (int b = 0; b < 2; ++b)
#pragma unroll
            for (int m = 0; m < 4; ++m)
#pragma unroll
                for (int n = 0; n < 2; ++n) acc[a][b][m][n] = (f32x4){0.f, 0.f, 0.f, 0.f};
    bf16x8 At[4][2], B0[2][2], B1[2][2];
    const char* cA = (const char*)g.A + (size_t)cur.pm * tstep; const char* cB = (const char*)g.Bt + (size_t)cur.pn * tstep;
    S.a_ready(cur);
    if constexpr (SP2) {
        PG8_STAGE(PG8_SB(0, 0), cB, voffB); PG8_STAGE(PG8_SB(0, 1), cB + hstep, voffB); PG8_STAGE(PG8_SA(0, 0), cA, voffA); PG8_STAGE(PG8_SA(0, 1), cA + hstep, voffA);
        if (wr == 1) PG8_BAR;
        PG8_WAIT_V(2); PG8_BAR;
        PG8_STAGE(PG8_SB(1, 0), cB + kstep, voffB); PG8_STAGE(PG8_SA(1, 0), cA + kstep, voffA); PG8_STAGE(PG8_SB(1, 1), cB + hstep + kstep, voffB);
        PG8_WAIT_V(6); PG8_BAR;
    } else {
        PG8_STAGE(PG8_SB(0, 0), cB, voffB); PG8_STAGE(PG8_SA(0, 0), cA, voffA); PG8_STAGE(PG8_SB(0, 1), cB + hstep, voffB); PG8_STAGE(PG8_SA(0, 1), cA + hstep, voffA);
        if (wr == 1) PG8_BAR;
        PG8_WAIT_V(4); PG8_BAR;
        PG8_STAGE(PG8_SB(1, 0), cB + kstep, voffB); PG8_STAGE(PG8_SA(1, 0), cA + kstep, voffA); PG8_STAGE(PG8_SB(1, 1), cB + hstep + kstep, voffB);
        PG8_WAIT_V(6); PG8_BAR;
    }
    for (;;) {
        const bool has_next = S.next(ui + 1, nxt);
        const char* nA = has_next ? (const char*)g.A + (size_t)nxt.pm * tstep : cA; const char* nB = has_next ? (const char*)g.Bt + (size_t)nxt.pn * tstep : cB;
        for (int t = 0; t < nt; t += 2) {
            const bool last = (t == nt - 2);
            const char* a1 = cA + (size_t)(t + 1) * kstep;
            const char* a2 = last ? nA : cA + (size_t)(t + 2) * kstep; const char* b2 = last ? nB : cB + (size_t)(t + 2) * kstep;
            const char* a3 = a2 + kstep; const char* b3 = b2 + kstep;
            if (last && has_next) S.a_ready(nxt);
            if constexpr (SP2) {
            PG8_LDB(B0, 0, 0); PG8_LDB(B1, 0, 1); PG8_SCHED; PG8_LDA(At, 0, 0); PG8_STAGE(PG8_SA(1, 1), a1 + hstep, voffA);
            PG8_WAIT_V(8); PG8_WAIT_L(0); PG8_BAR; PG8_MMA(0, 0, At, B0); PG8_MMA(0, 1, At, B1); PG8_BAR; PG8_SCHED;
            PG8_LDA(At, 0, 1); PG8_STAGE(PG8_SB(0, 0), b2, voffB); PG8_STAGE(PG8_SB(0, 1), b2 + hstep, voffB); PG8_STAGE(PG8_SA(0, 0), a2, voffA);
            PG8_WAIT_V(8); PG8_WAIT_L(0); PG8_BAR; PG8_MMA(1, 0, At, B0); PG8_MMA(1, 1, At, B1); PG8_BAR; PG8_SCHED;
            PG8_LDB(B0, 1, 0); PG8_LDB(B1, 1, 1); PG8_SCHED; PG8_LDA(At, 1, 0); PG8_STAGE(PG8_SA(0, 1), a2 + hstep, voffA);
            PG8_WAIT_V(8); PG8_WAIT_L(0); PG8_BAR; PG8_MMA(0, 0, At, B0); PG8_MMA(0, 1, At, B1); PG8_BAR; PG8_SCHED;
            PG8_LDA(At, 1, 1); PG8_STAGE(PG8_SB(1, 0), b3, voffB); PG8_STAGE(PG8_SB(1, 1), b3 + hstep, voffB); PG8_STAGE(PG8_SA(1, 0), a3, voffA);
            PG8_WAIT_V(8); PG8_WAIT_L(0); PG8_BAR; PG8_MMA(1, 0, At, B0); PG8_MMA(1, 1, At, B1); PG8_BAR; PG8_SCHED;
            } else {
            PG8_LDB(B0, 0, 0); PG8_SCHED; PG8_LDA(At, 0, 0); PG8_STAGE(PG8_SA(1, 1), a1 + hstep, voffA);
            PG8_WAIT_L(8); PG8_BAR; PG8_WAIT_L(0); PG8_MMA(0, 0, At, B0); PG8_BAR; PG8_SCHED;
            PG8_LDB(B1, 0, 1); PG8_STAGE(PG8_SB(0, 0), b2, voffB);
            PG8_BAR; PG8_WAIT_L(0); PG8_MMA(0, 1, At, B1); PG8_BAR;
            PG8_LDA(At, 0, 1); PG8_STAGE(PG8_SA(0, 0), a2, voffA);
            PG8_BAR; PG8_WAIT_L(0); PG8_MMA(1, 0, At, B0); PG8_BAR; PG8_SCHED;
            PG8_STAGE(PG8_SB(0, 1), b2 + hstep, voffB);
            PG8_WAIT_V(6); PG8_BAR; PG8_MMA(1, 1, At, B1); PG8_BAR;
            PG8_LDB(B0, 1, 0); PG8_SCHED; PG8_LDA(At, 1, 0); PG8_STAGE(PG8_SA(0, 1), a2 + hstep, voffA);
            PG8_WAIT_L(8); PG8_BAR; PG8_WAIT_L(0); PG8_MMA(0, 0, At, B0); PG8_BAR; PG8_SCHED;
            PG8_LDB(B1, 1, 1); PG8_STAGE(PG8_SB(1, 0), b3, voffB);
            PG8_BAR; PG8_WAIT_L(0); PG8_MMA(0, 1, At, B1); PG8_BAR;
            PG8_LDA(At, 1, 1); PG8_STAGE(PG8_SA(1, 0), a3, voffA);
            PG8_BAR; PG8_WAIT_L(0); PG8_MMA(1, 0, At, B0); PG8_BAR; PG8_SCHED;
            PG8_STAGE(PG8_SB(1, 1), b3 + hstep, voffB);
            PG8_WAIT_V(6); PG8_BAR; PG8_MMA(1, 1, At, B1); PG8_BAR;
            }
        }
        if constexpr (ALIGN_EPI) { if (wr == 0) PG8_BAR; }
        if constexpr (!Epi::AFTER_DRAIN) { E(acc, cur, wr, wc, fr, fq); S.done(cur); }
        if (!has_next) break;
#pragma unroll
        for (int a = 0; a < 2; ++a)
#pragma unroll
            for (int b = 0; b < 2; ++b)
#pragma unroll
                for (int m = 0; m < 4; ++m)
#pragma unroll
                    for (int n = 0; n < 2; ++n) acc[a][b][m][n] = (f32x4){0.f, 0.f, 0.f, 0.f};
        cur = nxt; cA = nA; cB = nB; ++ui;
        if constexpr (ALIGN_EPI) { if (wr == 1) PG8_BAR; }
    }
    PG8_WAIT_V(0);
    if constexpr (!ALIGN_EPI) { if (wr == 0) PG8_BAR; }
    PG8_BAR;
    if constexpr (Epi::AFTER_DRAIN) { E.fused(acc, cur, wr, wc, fr, fq, lds, wid, lane); S.done(cur); }
#undef PG8_SA
#undef PG8_SB
#undef PG8_STAGE
#undef PG8_LDA
#undef PG8_LDB
#undef PG8_MMA
#undef PG8_WAIT_V
#undef PG8_WAIT_L
#undef PG8_BAR
#undef PG8_SCHED
}
}

#ifndef PG8_SP2
#define PG8_SP2 true
#endif
#ifndef PG8_ALIGN
#define PG8_ALIGN true
#endif
#include <hip/hip_bf16.h>
#include <cmath>
namespace attn_body {
using bf16=__hip_bfloat16;
using bf16x8=__attribute__((ext_vector_type(8)))short;
using s16x4=__attribute__((ext_vector_type(4)))short;
using f32x16=__attribute__((ext_vector_type(16)))float;
using u32x4=__attribute__((ext_vector_type(4)))unsigned;
constexpr int D=64;
constexpr int NW=8,QBLK=32,QB=QBLK*NW,KVBLK=64;
__device__ __forceinline__ int crow(int r,int hi){return (r&3)+8*(r>>2)+4*hi;}
#define SBAR() __builtin_amdgcn_sched_barrier(0)
__device__ __forceinline__ void cmask(f32x16&p0,f32x16&p1,int jb,int qrel,int hi){
  const float NEG=-INFINITY; int kb=64*jb+4*hi;
  #pragma unroll
  for(int r=0;r<16;++r){int kv=kb+(r&3)+8*(r>>2); if(kv>qrel)p0[r]=NEG; if(kv+32>qrel)p1[r]=NEG;}
}

constexpr int NSLOT=3, SLOTB=8192;
constexpr int LDS_K=0, LDS_V=NSLOT*SLOTB, LDS_WS=2*NSLOT*SLOTB, LDS_OST=LDS_WS+NW*64*4, LDS_BYTES=LDS_OST+NW*4096;
constexpr float C2=0.125f*1.4426950408889634f;
__device__ __forceinline__ void glds16(const void*gsrc,unsigned lds_dst){unsigned keep;
  asm volatile("s_mov_b32 %0, m0\n\ts_mov_b32 m0, %2\n\ts_nop 0\n\tglobal_load_lds_dwordx4 %1, off\n\ts_mov_b32 m0, %0":"=&s"(keep):"v"(gsrc),"s"(lds_dst):"memory");}
__device__ __forceinline__ float max3f(float a,float b,float c){float r;asm("v_max3_f32 %0, %1, %2, %3":"=v"(r):"v"(a),"v"(b),"v"(c));return r;}
__device__ __forceinline__ float max2f(float a,float b){float r;asm("v_max_f32_e32 %0, %1, %2":"=v"(r):"v"(a),"v"(b));return r;}
__device__ __forceinline__ float fadd_s(float a,float b){float r;asm("v_add_f32_e32 %0, %1, %2":"=v"(r):"v"(a),"v"(b));return r;}
__device__ __forceinline__ float fsub_s(float a,float b){float r;asm("v_sub_f32_e32 %0, %1, %2":"=v"(r):"v"(a),"v"(b));return r;}
typedef float f32x2_t __attribute__((ext_vector_type(2))); typedef __bf16 bf16x2_t __attribute__((ext_vector_type(2)));
__device__ __forceinline__ unsigned cvtpk_s(float lo,float hi){f32x2_t v={lo,hi};bf16x2_t b=__builtin_convertvector(v,bf16x2_t);return __builtin_bit_cast(unsigned,b);}
#define WAIT_BAR(N) asm volatile("s_waitcnt vmcnt(" #N ") lgkmcnt(0)\n\ts_barrier":::"memory")

__device__ __forceinline__ void qkt(f32x16&p0,f32x16&p1,const char*Kslot,const bf16x8*qr,const f32x16&negm,int r32,int hi){
  const char*kb=Kslot+hi*1024+r32*16;
  #pragma unroll
  for(int d0=0;d0<4;++d0){
    const bf16x8 b0=*reinterpret_cast<const bf16x8*>(kb+d0*2048);
    const bf16x8 b1=*reinterpret_cast<const bf16x8*>(kb+d0*2048+512);
    if(d0==0){p0=__builtin_amdgcn_mfma_f32_32x32x16_bf16(b0,qr[0],negm,0,0,0);p1=__builtin_amdgcn_mfma_f32_32x32x16_bf16(b1,qr[0],negm,0,0,0);}
    else{p0=__builtin_amdgcn_mfma_f32_32x32x16_bf16(b0,qr[d0],p0,0,0,0);p1=__builtin_amdgcn_mfma_f32_32x32x16_bf16(b1,qr[d0],p1,0,0,0);}}
}
typedef __attribute__((address_space(3))) const char* lds_cptr;
typedef short v4i16_t __attribute__((ext_vector_type(4)));
__device__ __forceinline__ void kload8(bf16x8*kf,lds_cptr kp){
  kf[0]=*(const __attribute__((address_space(3))) bf16x8*)(kp);      kf[1]=*(const __attribute__((address_space(3))) bf16x8*)(kp+512);
  kf[2]=*(const __attribute__((address_space(3))) bf16x8*)(kp+2048); kf[3]=*(const __attribute__((address_space(3))) bf16x8*)(kp+2560);
  kf[4]=*(const __attribute__((address_space(3))) bf16x8*)(kp+4096); kf[5]=*(const __attribute__((address_space(3))) bf16x8*)(kp+4608);
  kf[6]=*(const __attribute__((address_space(3))) bf16x8*)(kp+6144); kf[7]=*(const __attribute__((address_space(3))) bf16x8*)(kp+6656);
}
__device__ __forceinline__ void kload2(bf16x8*kf,lds_cptr kp,int j){ kf[2*j]=*(const __attribute__((address_space(3))) bf16x8*)(kp+j*2048); kf[2*j+1]=*(const __attribute__((address_space(3))) bf16x8*)(kp+j*2048+512); }
__device__ __forceinline__ s16x4 vtr(lds_cptr p){ return __builtin_bit_cast(s16x4,__builtin_amdgcn_ds_read_tr16_b64_v4i16((__attribute__((address_space(3))) v4i16_t*)p)); }
__device__ __forceinline__ float rowmax(const f32x16&p0,const f32x16&p1){
  float a=max3f(p0[0],p0[1],p1[0]),b=max3f(p0[2],p0[3],p1[1]);a=max3f(a,p1[2],p1[3]);
  #pragma unroll
  for(int r=4;r<16;r+=4){a=max3f(a,p0[r],p0[r+1]);b=max3f(b,p0[r+2],p0[r+3]);a=max3f(a,p1[r],p1[r+1]);b=max3f(b,p1[r+2],p1[r+3]);}
  const float m=max2f(a,b);
  auto rr=__builtin_amdgcn_permlane32_swap(__float_as_uint(m),__float_as_uint(m),false,false);
  return max2f(__uint_as_float(rr[0]),__uint_as_float(rr[1]));
}
__device__ __forceinline__ void pv(f32x16*o,int vb,bf16x8 pa0,bf16x8 pa1,bf16x8 pa2,bf16x8 pa3){
  #pragma unroll
  for(int d0=0;d0<2;++d0){s16x4 lo[4],hi[4];
    #pragma unroll
    for(int ks=0;ks<4;++ks){
      asm volatile("ds_read_b64_tr_b16 %0,%1 offset:%c2":"=&v"(lo[ks]):"v"(vb),"i"(d0*4096+ks*1024):"memory");
      asm volatile("ds_read_b64_tr_b16 %0,%1 offset:%c2":"=&v"(hi[ks]):"v"(vb),"i"(d0*4096+ks*1024+512):"memory");}
    asm volatile("s_waitcnt lgkmcnt(0)":::"memory");SBAR();
    #define PK(k) (bf16x8){lo[k][0],lo[k][1],lo[k][2],lo[k][3],hi[k][0],hi[k][1],hi[k][2],hi[k][3]}
    o[d0]=__builtin_amdgcn_mfma_f32_32x32x16_bf16(pa0,PK(0),o[d0],0,0,0);
    o[d0]=__builtin_amdgcn_mfma_f32_32x32x16_bf16(pa1,PK(1),o[d0],0,0,0);
    o[d0]=__builtin_amdgcn_mfma_f32_32x32x16_bf16(pa2,PK(2),o[d0],0,0,0);
    o[d0]=__builtin_amdgcn_mfma_f32_32x32x16_bf16(pa3,PK(3),o[d0],0,0,0);
    #undef PK
  }
}

#ifndef ATTN_STORE16
#define ATTN_STORE16(p,v) (*(u32x4*)(p)=(v))
#endif
template<int THRL> __device__ __forceinline__ void attn_unit(int qb,int SEQ,const bf16*Q,int QP,const bf16*__restrict__ K,const bf16*__restrict__ V,int KP,bf16*O,int OP,char*shm){
  int tid_=threadIdx.x; asm volatile("":"+v"(tid_)); const int tid=tid_,lane=tid&63,r32=lane&31,hi=lane>>5; const int wid=__builtin_amdgcn_readfirstlane(tid>>6);
  const int q0=qb*QB;
  const bf16*Qw=Q+(long)(q0+wid*QBLK)*QP;
  const bf16*Kh=K,*Vh=V;
  const unsigned lds0=(unsigned)(uintptr_t)shm;
  float*wsf=(float*)(shm+LDS_WS)+wid*64;
  const bf16*ksrc=Kh+(long)lane*KP+wid*8;
  const bf16*vsrc=Vh+(long)(16*(wid&3)+(lane>>2))*KP+(wid>>2)*32+(lane&3)*8;
  const unsigned kdst=lds0+LDS_K+wid*1024, vdst=lds0+LDS_V+wid*1024;
  #define DMA_K(t,slot) glds16(ksrc+(long)(t)*KVBLK*KP,(unsigned)__builtin_amdgcn_readfirstlane(kdst+(slot)))
  #define DMA_V(t,slot) glds16(vsrc+(long)(t)*KVBLK*KP,(unsigned)__builtin_amdgcn_readfirstlane(vdst+(slot)))
  const int vb0=(int)(lds0+LDS_V)+((lane>>4)&1)*32+(lane&3)*8+(4*hi+((lane&15)>>2))*64;
  const char*Kbase=shm+LDS_K; bf16x8 kf[8];
  const lds_cptr shm3=(lds_cptr)shm; const lds_cptr kp0=shm3+LDS_K+hi*1024+r32*16; const lds_cptr vp0=shm3+LDS_V+((lane>>4)&1)*32+(lane&3)*8+(4*hi+((lane&15)>>2))*64;
  const int NT=SEQ/KVBLK;
  DMA_K(0,0);DMA_V(0,0);DMA_K(1,SLOTB);
  bf16x8 qr[4];
  #pragma unroll
  for(int d0=0;d0<4;++d0)qr[d0]=*reinterpret_cast<const bf16x8*>(&Qw[(long)r32*QP+d0*16+hi*8]);
  float mhat=0.f,l_reg=0.f;f32x16 o[2];o[0]=f32x16{};o[1]=f32x16{};f32x16 negm=f32x16{};asm volatile("":"+v"(negm));
  const int qrel=wid*QBLK+r32;
  #define CMASK(P0,P1,t) do{}while(0)
  bool resc=false;
  #define START(P0,P1) do{ const float rm=rowmax(P0,P1); resc=false; \
    { const float dl=rm; mhat=fadd_s(mhat,dl); \
      _Pragma("unroll") for(int r=0;r<16;++r){P0[r]=fsub_s(P0[r],dl);P1[r]=fsub_s(P1[r],dl);} \
      _Pragma("unroll") for(int r=0;r<16;++r)negm[r]=-mhat; asm volatile("":"+v"(negm)); } \
    _Pragma("unroll") for(int r=0;r<16;++r)P0[r]=__builtin_amdgcn_exp2f(P0[r]); }while(0)
  #define RESC() do{ if(resc){ asm volatile("s_waitcnt lgkmcnt(0)":::"memory"); \
      _Pragma("unroll") for(int d_=0;d_<2;++d_) _Pragma("unroll") for(int r=0;r<16;++r)o[d_][r]*=wsf[crow(r,hi)]; } }while(0)
  f32x16 pA0,pA1,pB0,pB1;
  int sl_prev=0,sl_cur=0,sl_next=SLOTB;
  #define ROT() do{sl_prev=sl_cur;sl_cur=sl_next;sl_next=(sl_next==(NSLOT-1)*SLOTB)?0:sl_next+SLOTB;}while(0)
  DMA_K(2,2*SLOTB);
  WAIT_BAR(3);
  qkt(pA0,pA1,Kbase,qr,negm,r32,hi);asm volatile("s_nop 15\n\ts_nop 7":"+v"(pA0),"+v"(pA1));CMASK(pA0,pA1,0);
  START(pA0,pA1);
  _Pragma("unroll") for(int r=0;r<16;++r)pA1[r]=__builtin_amdgcn_exp2f(pA1[r]);
  WAIT_BAR(0);
  DMA_K(3,0);DMA_V(1,SLOTB);
  ROT();
  kload8(kf,kp0+sl_cur);
  WAIT_BAR(2);
  s16x4 vlo[8],vhi[8]; u32x4 pw0,pw1,pw2,pw3;
  #define PKW(P,B) cvtpk_s(P[B],P[B+1])
  #define PAF(k) __builtin_bit_cast(bf16x8,pw##k)
  #define VFR(i) (bf16x8){vlo[i][0],vlo[i][1],vlo[i][2],vlo[i][3],vhi[i][0],vhi[i][1],vhi[i][2],vhi[i][3]}
  #define PIN(x) asm volatile("":"+v"(x))
  #define MX3(a,b,c) __builtin_fmaxf(__builtin_fmaxf((a),(b)),(c))
  #define GAPA(MF,A0,A1,A2,A3,W0,W1,PW) do{ MF; sacc+=A0; sacc+=A1; sacc+=A2; sacc+=A3; PIN(sacc); W0; W1; PIN(PW); SBAR(); }while(0)
  #define EX(v) __builtin_amdgcn_exp2f(v)
  #define GAPB(MF,X,B) do{ MF; X[B]=EX(X[B]); X[B+1]=EX(X[B+1]); X[B+2]=EX(X[B+2]); X[B+3]=EX(X[B+3]); PIN(X); SBAR(); }while(0)
  #define VRD(i) do{ vlo[i]=vtr(vp_+(((i)>>2)*4096+((i)&3)*1024)); vhi[i]=vtr(vp_+(((i)>>2)*4096+((i)&3)*1024+512)); }while(0)
  #define KRD(G,j) do{ if(G){ kload2(kf,kp0+sl_next,j); SBAR(); } }while(0)
  #define STEP(C0,C1,P0,P1,t,GK,GV,GL) do{ SBAR(); \
    const lds_cptr vp_=vp0+sl_prev; \
    VRD(0); SBAR(); float sacc=(P0[0]+P0[1]); \
    GAPA(C0=__builtin_amdgcn_mfma_f32_32x32x16_bf16(kf[0],qr[0],negm,0,0,0), P0[2],P0[3],P0[4],P0[5],     pw0[0]=PKW(P0,0), pw0[1]=PKW(P0,2), pw0); \
    VRD(4); SBAR(); GAPA(C1=__builtin_amdgcn_mfma_f32_32x32x16_bf16(kf[1],qr[0],negm,0,0,0), P0[6],P0[7],P0[8],P0[9],     pw0[2]=PKW(P0,4), pw0[3]=PKW(P0,6), pw0); \
    VRD(1); SBAR(); GAPA(C0=__builtin_amdgcn_mfma_f32_32x32x16_bf16(kf[2],qr[1],C0,0,0,0),   P0[10],P0[11],P0[12],P0[13], pw1[0]=PKW(P0,8), pw1[1]=PKW(P0,10), pw1); \
    VRD(5); SBAR(); GAPA(C1=__builtin_amdgcn_mfma_f32_32x32x16_bf16(kf[3],qr[1],C1,0,0,0),   P0[14],P0[15],P1[0],P1[1],   pw1[2]=PKW(P0,12),pw1[3]=PKW(P0,14), pw1); \
    VRD(2); SBAR(); GAPA(C0=__builtin_amdgcn_mfma_f32_32x32x16_bf16(kf[4],qr[2],C0,0,0,0),   P1[2],P1[3],P1[4],P1[5],     pw2[0]=PKW(P1,0), pw2[1]=PKW(P1,2), pw2); \
    VRD(6); SBAR(); GAPA(C1=__builtin_amdgcn_mfma_f32_32x32x16_bf16(kf[5],qr[2],C1,0,0,0),   P1[6],P1[7],P1[8],P1[9],     pw2[2]=PKW(P1,4), pw2[3]=PKW(P1,6), pw2); \
    VRD(3); SBAR(); GAPA(C0=__builtin_amdgcn_mfma_f32_32x32x16_bf16(kf[6],qr[3],C0,0,0,0),   P1[10],P1[11],P1[12],P1[13], pw3[0]=PKW(P1,8), pw3[1]=PKW(P1,10), pw3); \
    VRD(7); SBAR(); GAPA(C1=__builtin_amdgcn_mfma_f32_32x32x16_bf16(kf[7],qr[3],C1,0,0,0),   P1[14],P1[15],0.f,0.f,       pw3[2]=PKW(P1,12),pw3[3]=PKW(P1,14), pw3); \
    l_reg+=sacc; \
    if(GK){DMA_K((t)+3,sl_cur);} if(GV){DMA_V((t)+1,sl_next);} \
    CMASK(C0,C1,t); \
    { float a=MX3(C0[0],C0[1],C1[0]),b=MX3(C0[2],C0[3],C1[1]); a=MX3(a,C1[2],C1[3]); \
      _Pragma("unroll") for(int r=4;r<16;r+=4){a=MX3(a,C0[r],C0[r+1]);b=MX3(b,C0[r+2],C0[r+3]);a=MX3(a,C1[r],C1[r+1]);b=MX3(b,C1[r+2],C1[r+3]);} \
      float rm=__builtin_fmaxf(a,b); { auto rr=__builtin_amdgcn_permlane32_swap(__float_as_uint(rm),__float_as_uint(rm),false,false); rm=__builtin_fmaxf(__uint_as_float(rr[0]),__uint_as_float(rr[1])); } \
      resc=false; \
      if(__builtin_expect(__any(rm>(float)THRL),0)){ const float dl=__builtin_fmaxf(rm,0.f); mhat+=dl; \
        _Pragma("unroll") for(int r=0;r<16;++r){C0[r]-=dl;C1[r]-=dl;} \
        _Pragma("unroll") for(int r=0;r<16;++r)negm[r]=-mhat; asm volatile("":"+v"(negm)); \
        const float f=__builtin_amdgcn_exp2f(-dl); l_reg*=f; if(hi==0)wsf[r32]=f; resc=true; } } \
    SBAR(); \
    GAPB(o[0]=__builtin_amdgcn_mfma_f32_32x32x16_bf16(PAF(0),VFR(0),o[0],0,0,0), C0,0); \
    GAPB(o[1]=__builtin_amdgcn_mfma_f32_32x32x16_bf16(PAF(0),VFR(4),o[1],0,0,0), C0,4); \
    KRD(GL,0); GAPB(o[0]=__builtin_amdgcn_mfma_f32_32x32x16_bf16(PAF(1),VFR(1),o[0],0,0,0), C0,8); \
    KRD(GL,1); GAPB(o[1]=__builtin_amdgcn_mfma_f32_32x32x16_bf16(PAF(1),VFR(5),o[1],0,0,0), C0,12); \
    KRD(GL,2); GAPB(o[0]=__builtin_amdgcn_mfma_f32_32x32x16_bf16(PAF(2),VFR(2),o[0],0,0,0), C1,0); \
    KRD(GL,3); GAPB(o[1]=__builtin_amdgcn_mfma_f32_32x32x16_bf16(PAF(2),VFR(6),o[1],0,0,0), C1,4); \
    GAPB(o[0]=__builtin_amdgcn_mfma_f32_32x32x16_bf16(PAF(3),VFR(3),o[0],0,0,0), C1,8); \
    GAPB(o[1]=__builtin_amdgcn_mfma_f32_32x32x16_bf16(PAF(3),VFR(7),o[1],0,0,0), C1,12); \
    }while(0)
  int t=1;
  #undef CMASK
  #define CMASK(P0,P1,t) do{}while(0)
  for(;t+5<NT;t+=2){
    STEP(pB0,pB1,pA0,pA1,t,true,true,true);     WAIT_BAR(2); RESC(); ROT();
    STEP(pA0,pA1,pB0,pB1,t+1,true,true,true);   WAIT_BAR(2); RESC(); ROT();
  }
  #undef CMASK
  #define CMASK(P0,P1,t) do{}while(0)
  #define ENDW(tt) do{ if((tt)+3<NT){WAIT_BAR(2);} else if((tt)+2<NT){WAIT_BAR(1);} else {WAIT_BAR(0);} }while(0)
  for(;t+1<NT;t+=2){
    STEP(pB0,pB1,pA0,pA1,t,(t+3<NT),(t+1<NT),(t+1<NT));       ENDW(t);   RESC(); ROT();
    STEP(pA0,pA1,pB0,pB1,t+1,(t+4<NT),(t+2<NT),(t+2<NT));     ENDW(t+1); RESC(); ROT();
  }
  STEP(pB0,pB1,pA0,pA1,NT-1,false,false,false); RESC();
  { float sacc=pB0[0]+pB0[1]; _Pragma("unroll") for(int r=2;r<16;++r)sacc+=pB0[r]; _Pragma("unroll") for(int r=0;r<16;++r)sacc+=pB1[r]; l_reg+=sacc;
    pw0=(u32x4){PKW(pB0,0),PKW(pB0,2),PKW(pB0,4),PKW(pB0,6)};pw1=(u32x4){PKW(pB0,8),PKW(pB0,10),PKW(pB0,12),PKW(pB0,14)};pw2=(u32x4){PKW(pB1,0),PKW(pB1,2),PKW(pB1,4),PKW(pB1,6)};pw3=(u32x4){PKW(pB1,8),PKW(pB1,10),PKW(pB1,12),PKW(pB1,14)};
    SBAR(); pv(o,vb0+sl_cur,PAF(0),PAF(1),PAF(2),PAF(3)); }
  #undef PKW
  #undef PAF
  #undef VFR
  #undef PIN
  #undef MX3
  #undef GAPA
  #undef GAPB
  #undef EX
  #undef VRD
  #undef KRD
  #undef STEP
  #undef ENDW
  {auto rr=__builtin_amdgcn_permlane32_swap(__float_as_uint(l_reg),__float_as_uint(l_reg),false,false);l_reg=__uint_as_float(rr[0])+__uint_as_float(rr[1]);}
  if(hi==0)wsf[32+r32]=l_reg;asm volatile("s_waitcnt lgkmcnt(0)":::"memory");
  float rli[16];
  #pragma unroll
  for(int r=0;r<16;++r)rli[r]=__builtin_amdgcn_rcpf(wsf[32+crow(r,hi)]);
  bf16*Ow=O+(long)(q0+wid*QBLK)*OP;
  { bf16*stg=(bf16*)(shm+LDS_OST)+wid*2048;
    #pragma unroll
    for(int r=0;r<16;++r){const int orow=crow(r,hi);
      #pragma unroll
      for(int d0=0;d0<2;++d0)stg[orow*64+d0*32+r32]=__float2bfloat16(o[d0][r]*rli[r]);}
    asm volatile("s_waitcnt lgkmcnt(0)":::"memory");
    #pragma unroll
    for(int i=0;i<4;++i){const int row=i*8+(lane>>3),ch=lane&7; const u32x4 v=*(const u32x4*)(stg+row*64+ch*8); ATTN_STORE16(Ow+(long)row*OP+ch*8,v);} }
  asm volatile("s_waitcnt lgkmcnt(0)\n\ts_barrier":::"memory");
  #undef DMA_K
  #undef DMA_V
  #undef CMASK
  #undef START
  #undef RESC
  #undef ROT
}
constexpr int ATTN_LDS_BYTES=LDS_BYTES;
#undef SBAR
#undef WAIT_BAR
}
namespace xb {
#define GAS __attribute__((address_space(1)))
#define LAS __attribute__((address_space(3)))
typedef GAS unsigned gu32;
typedef GAS unsigned long long gu64;
#define RLX_AGENT __ATOMIC_RELAXED, __HIP_MEMORY_SCOPE_AGENT
#define LDS_WAIT() asm volatile("s_waitcnt lgkmcnt(0)" ::: "memory")
#define VM_WAIT() asm volatile("s_waitcnt vmcnt(0)" ::: "memory")
__device__ __forceinline__ unsigned long long rt() { return __builtin_amdgcn_s_memrealtime(); }
__device__ __forceinline__ unsigned f2bf(float f) { unsigned u = __builtin_bit_cast(unsigned, f); return (u + 0x7fffu + ((u >> 16) & 1u)) >> 16; }
__device__ __forceinline__ unsigned pk2(float lo, float hi) { return f2bf(lo) | (f2bf(hi) << 16); }

#define XB_TMO      128
#define XB_XCNT(j)  (256  + 64 * (j))
#define XB_XSUB(j)  (1280 + 64 * (j))
#define XB_XGEN(j)  (2304 + 64 * (j))
#define XB_TOP      3328
#define XB_TOPGEN   3392
#define XCD_BAR_WORDS 3456
#define XB_SPIN_CAP (1u << 18)

__device__ __forceinline__ unsigned xb_ld(unsigned* p)              { return __hip_atomic_load(p, __ATOMIC_RELAXED, __HIP_MEMORY_SCOPE_AGENT); }
__device__ __forceinline__ unsigned xb_add(unsigned* p, unsigned v) { return __hip_atomic_fetch_add(p, v, __ATOMIC_RELAXED, __HIP_MEMORY_SCOPE_AGENT); }
__device__ __forceinline__ unsigned xb_xcc_id() { return (unsigned)__builtin_amdgcn_s_getreg((3 << 11) | 20) & 0xFu; }
#define XB_SPIN(cond, bar) do { unsigned _sp = 0; while (cond) { __builtin_amdgcn_s_sleep(1); \
    if ((++_sp & 255u) == 0u) { if (xb_ld(&(bar)[XB_TMO])) break; if (_sp > XB_SPIN_CAP) { atomicAdd(&(bar)[XB_TMO], 1u); break; } } } } while (0)

struct XcdBarrier {
    unsigned* bar; unsigned x;
    volatile LAS unsigned* st;
};

__device__ __forceinline__ XcdBarrier xcd_barrier_post(unsigned* bar, volatile LAS unsigned* st) {
    XcdBarrier b; b.bar = bar; b.x = xb_xcc_id(); b.st = st;
    if (threadIdx.x == 0) (void)xb_add(&bar[XB_XCNT(b.x)], 1u);
    return b;
}
__device__ __forceinline__ void xcd_barrier_complete(unsigned* bar, unsigned x, unsigned& nloc, unsigned& nx) {
    const unsigned G = gridDim.x * gridDim.y * gridDim.z;
    unsigned sum, cnt, mine, sp = 0u;
    for (;;) {
        sum = 0u; cnt = 0u; mine = 0u;
#pragma unroll
        for (unsigned j = 0; j < 16; ++j) { const unsigned c = xb_ld(&bar[XB_XCNT(j)]); sum += c; cnt += (c > 0u) ? 1u : 0u; mine = (j == x) ? c : mine; }
        if (sum == G) break;
        __builtin_amdgcn_s_sleep(1);
        if ((++sp & 255u) == 0u) { if (xb_ld(&bar[XB_TMO])) break; if (sp > XB_SPIN_CAP) { atomicAdd(&bar[XB_TMO], 1u); break; } }
    }
    nloc = mine > 0u ? mine : 1u; nx = cnt > 0u ? cnt : 1u;
}

__device__ __forceinline__ void xcd_barrier(const XcdBarrier& b) {
    asm volatile("s_waitcnt vmcnt(0)" ::: "memory");
    __syncthreads();
    if (threadIdx.x == 0) {
        unsigned* bar = b.bar;
        __builtin_amdgcn_s_waitcnt(0);
        unsigned nloc = b.st[0], nx = b.st[1];
        if (nloc == 0u) { xcd_barrier_complete(bar, b.x, nloc, nx); b.st[0] = nloc; b.st[1] = nx; }
        const unsigned old = xb_add(&bar[XB_XSUB(b.x)], 1u);
        const unsigned gen = old / nloc;
        if (old + 1u == (gen + 1u) * nloc) {
            __builtin_amdgcn_fence(__ATOMIC_RELEASE, "agent");
            asm volatile("s_waitcnt vmcnt(0)" ::: "memory");
            const unsigned og = xb_add(&bar[XB_TOP], 1u);
            const unsigned tg = og / nx;
            if (og + 1u == (tg + 1u) * nx) xb_add(&bar[XB_TOPGEN], 1u);
            else XB_SPIN(xb_ld(&bar[XB_TOPGEN]) == tg, bar);
            __builtin_amdgcn_fence(__ATOMIC_ACQUIRE, "agent");
            xb_add(&bar[XB_XGEN(b.x)], 1u);
            asm volatile("s_waitcnt vmcnt(0)" ::: "memory");
        } else {
            XB_SPIN(xb_ld(&bar[XB_XGEN(b.x)]) == gen, bar);
            __builtin_amdgcn_fence(__ATOMIC_ACQUIRE, "agent");
            asm volatile("s_waitcnt vmcnt(0)" ::: "memory");
        }
    }
    __syncthreads();
}

}

namespace mk {
typedef unsigned short bf16_t;
typedef short bf16x8 __attribute__((ext_vector_type(8)));
typedef float f32x4 __attribute__((ext_vector_type(4)));
typedef unsigned u32x4 __attribute__((ext_vector_type(4)));
typedef unsigned u32x2 __attribute__((ext_vector_type(2)));
typedef float f32x2 __attribute__((ext_vector_type(2)));

constexpr int DMODEL = 1024, TS = 16384, NSEG = 4, DFF = 4096;
constexpr int EIN = 1792, OIN = 4368, OINP = 4608, OOUT = 768;
constexpr float EPS = 1e-6f;
constexpr size_t MiB = (size_t)1 << 20;
constexpr size_t WS_W1T = 1 * MiB, WS_W2T = 33 * MiB, WS_WINE = 65 * MiB, WS_WOUTE = 72 * MiB, WS_WINO = 76 * MiB, WS_WOUTO = 94 * MiB,
                 WS_GW = 97 * MiB, WS_H = 98 * MiB, WS_PROJ = 130 * MiB, WS_SCR = 274 * MiB, WS_END = 512 * MiB;
constexpr size_t SC_HID = 0;
constexpr size_t SC_LA = 0, SC_UU = 64 * MiB, SC_AGG = 128 * MiB;
constexpr size_t SC_QKVP = 0, SC_DNI = 48 * MiB, SC_OB = 192 * MiB, SC_LSE = 224 * MiB, SC_EGL = 225 * MiB;
constexpr int DNI_BYTES = 73728, DNI_W = 0, DNI_QT = 16384, DNI_KTT = 32768, DNI_A = 49152, DNI_U = 57344;
constexpr int LDS_BYTES = 147456;
constexpr int NT = 512, NW = 8;

struct Params { const float* in[25]; float* out; unsigned char* ws; };

__device__ __forceinline__ float bf2f(bf16_t v) { return __uint_as_float(((unsigned)v) << 16); }
__device__ __forceinline__ unsigned f2bf(float f) { unsigned u = __float_as_uint(f); return (u + 0x7fffu + ((u >> 16) & 1u)) >> 16; }
__device__ __forceinline__ unsigned pk2(float lo, float hi) { return f2bf(lo) | (f2bf(hi) << 16); }
__device__ __forceinline__ float wave_sum(float v) {
#pragma unroll
    for (int o = 1; o < 64; o <<= 1) v += __shfl_xor(v, o);
    return v;
}
__device__ __forceinline__ float sigm(float x) { return 1.f / (1.f + __expf(-x)); }
__device__ __forceinline__ float softplus(float x) { return x > 20.f ? x : log1pf(__expf(x)); }
__device__ __forceinline__ float silu(float x) { return x * sigm(x); }
__device__ __forceinline__ float gelu_tanh(float x) { const float t = 0.7978845608028654f * (x + 0.044715f * x * x * x); return 0.5f * x * (1.f + tanhf(t)); }
__device__ __forceinline__ void unpack8(const u32x4 v, float* f) {
    f[0] = __uint_as_float(v.x << 16); f[1] = __uint_as_float(v.x & 0xffff0000u); f[2] = __uint_as_float(v.y << 16); f[3] = __uint_as_float(v.y & 0xffff0000u);
    f[4] = __uint_as_float(v.z << 16); f[5] = __uint_as_float(v.z & 0xffff0000u); f[6] = __uint_as_float(v.w << 16); f[7] = __uint_as_float(v.w & 0xffff0000u);
}
#define MK_IDS() int tid = threadIdx.x; asm volatile("" : "+v"(tid)); const int lane = tid & 63, wave = __builtin_amdgcn_readfirstlane(tid >> 6); const int gw = blockIdx.x * NW + wave, NGW = gridDim.x * NW; (void)lane; (void)wave; (void)gw; (void)NGW
#define MFMA16(a, b, c) __builtin_amdgcn_mfma_f32_16x16x32_bf16((a), (b), (c), 0, 0, 0)

__device__ __forceinline__ void transpose_item(const float* W, int K, int Nsrc, int Npad, bf16_t* WT, float* scr, int item, int lane, const float* gain = nullptr) {
    const int nblk = Npad / 32, kb = item / nblk, nb = item % nblk, k0 = 64 * kb, n0 = 32 * nb;
    const int n = n0 + (lane & 31);
#pragma unroll 8
    for (int i = 0; i < 32; ++i) { const int kk = 2 * i + (lane >> 5); scr[kk * 33 + (lane & 31)] = (n < Nsrc) ? W[(size_t)(k0 + kk) * Nsrc + n] * (gain ? gain[k0 + kk] : 1.f) : 0.f; }
    asm volatile("s_waitcnt lgkmcnt(0)" ::: "memory");
    const int c = lane & 7;
#pragma unroll
    for (int j = 0; j < 4; ++j) { const int nn = (lane >> 3) + 8 * j; const float* s = scr + (8 * c) * 33 + nn;
        u32x4 o; o.x = pk2(s[0 * 33], s[1 * 33]); o.y = pk2(s[2 * 33], s[3 * 33]); o.z = pk2(s[4 * 33], s[5 * 33]); o.w = pk2(s[6 * 33], s[7 * 33]);
        *(u32x4*)(WT + (size_t)(n0 + nn) * K + k0 + 8 * c) = o; }
    asm volatile("s_waitcnt lgkmcnt(0)" ::: "memory");
}
__device__ __forceinline__ void phase_prologue(const Params& p, char* lds) {
    MK_IDS();
    float* scr = (float*)(lds + wave * 16384);
    unsigned char* ws = p.ws;
    constexpr int I_F1 = 16 * 128, I_F2 = 64 * 32, I_IE = 16 * 56, I_OE = 16 * 32, I_IO = 16 * 144, I_OO = 12 * 32;
    constexpr int T_F1 = 4 * I_F1, T_F2 = T_F1 + 4 * I_F2, T_IE = T_F2 + 2 * I_IE, T_OE = T_IE + 2 * I_OE, T_IO = T_OE + 2 * I_IO, T_OO = T_IO + 2 * I_OO;
    for (int it = gw; it < T_OO; it += NGW) {
        if (it < T_F1) { const int l = it / I_F1, r = it % I_F1; transpose_item(p.in[6] + (size_t)l * 1024 * 4096, 1024, 4096, 4096, (bf16_t*)(ws + WS_W1T) + (size_t)l * 4096 * 1024, scr, r, lane, p.in[4] + l * 1024); }
        else if (it < T_F2) { const int q = it - T_F1, l = q / I_F2, r = q % I_F2; transpose_item(p.in[7] + (size_t)l * 4096 * 1024, 4096, 1024, 1024, (bf16_t*)(ws + WS_W2T) + (size_t)l * 1024 * 4096, scr, r, lane); }
        else if (it < T_IE) { const int q = it - T_F2, l = q / I_IE, r = q % I_IE; transpose_item(p.in[8] + (size_t)l * 1024 * EIN, 1024, EIN, EIN, (bf16_t*)(ws + WS_WINE) + (size_t)l * EIN * 1024, scr, r, lane, p.in[3] + (2 * l) * 1024); }
        else if (it < T_OE) { const int q = it - T_IE, l = q / I_OE, r = q % I_OE; transpose_item(p.in[9] + (size_t)l * 1024 * 1024, 1024, 1024, 1024, (bf16_t*)(ws + WS_WOUTE) + (size_t)l * 1024 * 1024, scr, r, lane); }
        else if (it < T_IO) { const int q = it - T_OE, l = q / I_IO, r = q % I_IO; transpose_item(p.in[19] + (size_t)l * 1024 * OIN, 1024, OIN, OINP, (bf16_t*)(ws + WS_WINO) + (size_t)l * OINP * 1024, scr, r, lane, p.in[3] + (2 * l + 1) * 1024); }
        else { const int q = it - T_IO, l = q / I_OO, r = q % I_OO; transpose_item(p.in[20] + (size_t)l * OOUT * 1024, OOUT, 1024, 1024, (bf16_t*)(ws + WS_WOUTO) + (size_t)l * 1024 * OOUT, scr, r, lane); }
    }
    bf16_t* GW = (bf16_t*)(ws + WS_GW);
    const int gt = gw * 64 + lane, NGT = NGW * 64;
    for (int idx = gt; idx < 2 * 2 * 2 * 8 * 4096; idx += NGT) {
        const int d = idx & 63, e = (idx >> 6) & 63, blk = (idx >> 12) & 7, gate = (idx >> 15) & 1, dir = (idx >> 16) & 1, j = (idx >> 17) & 1;
        const float* src = gate ? p.in[16] : p.in[14];
        GW[idx] = (bf16_t)f2bf(src[((((size_t)j * 2 + dir) * 8 + blk) * 64 + d) * 64 + e]);
    }
}

__device__ __forceinline__ void phase_x0(const float* x, bf16_t* xb, float* ssq) {
    MK_IDS();
    for (int m = gw; m < TS; m += NGW) {
        const f32x4* xr = (const f32x4*)(x + (size_t)m * DMODEL) + lane;
        f32x4 v[4]; float s = 0.f;
#pragma unroll
        for (int j = 0; j < 4; ++j) { v[j] = xr[64 * j]; s += (v[j].x * v[j].x + v[j].y * v[j].y) + (v[j].z * v[j].z + v[j].w * v[j].w); }
        s = wave_sum(s);
        u32x2* o8 = (u32x2*)(xb + (size_t)m * DMODEL) + lane;
#pragma unroll
        for (int j = 0; j < 4; ++j) { u32x2 o; o.x = pk2(v[j].x, v[j].y); o.y = pk2(v[j].z, v[j].w); o8[64 * j] = o; }
        if (lane < 16) ssq[(size_t)m * 16 + lane] = lane == 0 ? s : 0.f;
    }
}
__device__ __forceinline__ void zero_f32(float* ptr, int n) {
    MK_IDS();
    for (int i = gw * 64 + lane; i < n; i += NGW * 64) ptr[i] = 0.f;
}
__device__ __forceinline__ void phase_rmsnorm_final(float* x, const float* g) {
    MK_IDS();
    for (int m = gw; m < TS; m += NGW) {
        f32x4* xr = (f32x4*)(x + (size_t)m * DMODEL) + lane; const f32x4* gr = (const f32x4*)g + lane;
        f32x4 v[4]; float s = 0.f;
#pragma unroll
        for (int j = 0; j < 4; ++j) { v[j] = xr[64 * j]; s += (v[j].x * v[j].x + v[j].y * v[j].y) + (v[j].z * v[j].z + v[j].w * v[j].w); }
        const float rstd = 1.f / sqrtf(wave_sum(s) * (1.f / DMODEL) + EPS);
#pragma unroll
        for (int j = 0; j < 4; ++j) { const f32x4 gg = gr[64 * j]; xr[64 * j] = v[j] * rstd * gg; }
    }
}

struct EpiRes {
    static constexpr bool PERM = false, AFTER_DRAIN = false;
    const float* base; float* out; int ldc; bf16_t* xb; float* ssq;
    __device__ __forceinline__ void operator()(const pg8::f32x4 (&acc)[2][2][4][2], const pg8::Unit& u, int wr, int wc, int fr, int fq) const {
        const int col0 = u.pn * pg8::BM + wc * 32 + 4 * fq;
#pragma unroll
        for (int ai = 0; ai < 2; ++ai)
#pragma unroll
            for (int m = 0; m < 4; ++m) { const int row = u.pm * pg8::BM + ai * pg8::HALF + wr * 64 + m * 16 + fr; const size_t off = (size_t)row * ldc + col0; float sq = 0.f;
#pragma unroll
                for (int bj = 0; bj < 2; ++bj)
#pragma unroll
                    for (int n = 0; n < 2; ++n) { const pg8::f32x4 bs = *(const pg8::f32x4*)(base + off + bj * pg8::HALF + n * 16); const pg8::f32x4 o = bs + acc[ai][bj][m][n];
                        *(pg8::f32x4*)(out + off + bj * pg8::HALF + n * 16) = o;
                        u32x2 w; w.x = pg8::cvt_pk_bf16(o[0], o[1]); w.y = pg8::cvt_pk_bf16(o[2], o[3]); *(u32x2*)(xb + off + bj * pg8::HALF + n * 16) = w;
                        sq += (o[0] * o[0] + o[1] * o[1]) + (o[2] * o[2] + o[3] * o[3]); }
                sq += __shfl_xor(sq, 16); sq += __shfl_xor(sq, 32);
                if (fq == 0) ssq[(size_t)row * 16 + u.pn * 4 + wc] = sq;
                if (m & 1) asm volatile("" ::: "memory"); }
    }
};

__device__ __forceinline__ void even_qk_post(bf16_t* proj, const float* qg, const float* kg, int S) {
    MK_IDS();
    const int d = lane, axis = d >> 5, f = d & 15, half = (d >> 4) & 1;
    const float inv = exp2f(-(float)f * (13.287712379549449f / 16.f));
    const float gq = qg[d], gk = kg[d];
    for (int t = gw; t < TS; t += NGW) {
        const int s = t % S; const int pos = axis ? (s & 63) : (s >> 6);
        const float ang = (float)pos * inv; float sn, cs; sincosf(ang, &sn, &cs);
        bf16_t* row = proj + (size_t)t * EIN;
#pragma unroll
        for (int hh = 0; hh < 10; ++hh) {
            const int c0 = hh < 8 ? hh * 64 : 512 + (hh - 8) * 64;
            const float x = bf2f(row[c0 + d]);
            const float ss = wave_sum(x * x);
            const float y = x * (1.f / sqrtf(ss * (1.f / 64.f) + EPS)) * (hh < 8 ? gq : gk);
            const float pr = __shfl_xor(y, 16);
            float o = y * cs + (half ? pr : -pr) * sn;
            if (hh < 8) o *= attn_body::C2;
            row[c0 + d] = (bf16_t)f2bf(o);
        }
    }
}
__device__ __forceinline__ void even_lru_prep(const bf16_t* proj, const float* cw, const float* cb, const bf16_t* GWj, const float* br, const float* bi, const float* lam,
                                              bf16_t* LA, bf16_t* UU, f32x2* AGG, int S, char* lds) {
    MK_IDS();
    constexpr int XST = 1040;
    for (int tile = blockIdx.x; tile < TS / 64; tile += gridDim.x) {
        const int t0 = tile * 64;
        __syncthreads();
#pragma unroll 2
        for (int k = 0; k < 8; ++k) {
            const int idx = tid + k * NT, i = idx >> 6, cgp = idx & 63, t = t0 + i, s = t % S, ch = cgp * 8;
            float acc[8];
#pragma unroll
            for (int e = 0; e < 8; ++e) acc[e] = cb[ch + e];
#pragma unroll
            for (int j = 0; j < 4; ++j) { const int sp = s + j - 2;
                if (sp >= 0 && sp < S) { const u32x4 v = *(const u32x4*)(proj + (size_t)(t + j - 2) * EIN + 768 + ch); float xv[8]; unpack8(v, xv);
#pragma unroll
                    for (int e = 0; e < 8; ++e) acc[e] += cw[j * 512 + ch + e] * xv[e]; } }
            u32x4 o; o.x = pk2(acc[0], acc[1]); o.y = pk2(acc[2], acc[3]); o.z = pk2(acc[4], acc[5]); o.w = pk2(acc[6], acc[7]);
            *(u32x4*)(lds + i * XST + ch * 2) = o;
        }
        __syncthreads();
        const int G = lane >> 4, l16 = lane & 15, ch0 = wave * 64;
        for (int dir = 0; dir < 2; ++dir)
            for (int nt = 0; nt < 4; ++nt) {
                const int e = nt * 16 + l16, ch = ch0 + e;
                bf16x8 Br[2], Bi[2];
#pragma unroll
                for (int kk = 0; kk < 2; ++kk) {
                    Br[kk] = *(const bf16x8*)(GWj + ((((size_t)dir * 2 + 0) * 8 + wave) * 64 + e) * 64 + kk * 32 + G * 8);
                    Bi[kk] = *(const bf16x8*)(GWj + ((((size_t)dir * 2 + 1) * 8 + wave) * 64 + e) * 64 + kk * 32 + G * 8);
                }
                const float brv = br[dir * 512 + ch], biv = bi[dir * 512 + ch], spl = softplus(-lam[dir * 512 + ch]);
#pragma unroll
                for (int mt = 0; mt < 4; ++mt) {
                    f32x4 ar = {0.f, 0.f, 0.f, 0.f}, ai = {0.f, 0.f, 0.f, 0.f};
#pragma unroll
                    for (int kk = 0; kk < 2; ++kk) { const bf16x8 a = *(const bf16x8*)(lds + (mt * 16 + l16) * XST + (ch0 + kk * 32 + G * 8) * 2); ar = MFMA16(a, Br[kk], ar); ai = MFMA16(a, Bi[kk], ai); }
#pragma unroll
                    for (int r = 0; r < 4; ++r) { const int i = mt * 16 + G * 4 + r;
                        const float xc = bf2f(*(const bf16_t*)(lds + i * XST + ch * 2));
                        const float rg = __builtin_amdgcn_rcpf(1.f + __expf(-(ar[r] + brv))), ig = __builtin_amdgcn_rcpf(1.f + __expf(-(ai[r] + biv)));
                        const float la = -8.f * rg * spl; const float uu = __builtin_amdgcn_sqrtf(fmaxf(1.f - __expf(2.f * la), 0.f)) * (ig * xc);
                        const size_t o = ((size_t)dir * TS + t0 + i) * 512 + ch; LA[o] = (bf16_t)f2bf(la); UU[o] = (bf16_t)f2bf(uu); }
                }
            }
        asm volatile("s_waitcnt vmcnt(0)" ::: "memory");
        __syncthreads();
        {
            const int ch = tid;
#pragma unroll
            for (int dir = 0; dir < 2; ++dir) {
                float h = 0.f, P = 0.f;
                const bf16_t* la = LA + ((size_t)dir * TS + t0) * 512 + ch; const bf16_t* uu = UU + ((size_t)dir * TS + t0) * 512 + ch;
#pragma unroll
                for (int q = 0; q < 64; q += 8) {
                    float lv[8], uv[8];
#pragma unroll
                    for (int e = 0; e < 8; ++e) { const int i = dir ? 63 - (q + e) : q + e; lv[e] = bf2f(la[(size_t)i * 512]); uv[e] = bf2f(uu[(size_t)i * 512]); }
#pragma unroll
                    for (int e = 0; e < 8; ++e) { h = __expf(lv[e]) * h + uv[e]; P += lv[e]; }
                }
                AGG[((size_t)dir * (TS / 64) + tile) * 512 + ch] = (f32x2){P, h};
            }
        }
    }
}
__device__ __forceinline__ void even_lru_scan(const bf16_t* LA, const bf16_t* UU, const f32x2* AGG, const bf16_t* proj, bf16_t* Y, int S) {
    MK_IDS();
    const int ch = tid, TPB = S / 64;
    for (int tile = blockIdx.x; tile < TS / 64; tile += gridDim.x) {
        const int t0 = tile * 64, tb0 = (tile / TPB) * TPB;
        float cf = 0.f, cr = 0.f;
        for (int k0 = tb0; k0 < tile; k0 += 8) { f32x2 a[8];
#pragma unroll
            for (int q = 0; q < 8; ++q) { const int k = k0 + q < tile ? k0 + q : tile - 1; a[q] = AGG[(size_t)k * 512 + ch]; }
#pragma unroll
            for (int q = 0; q < 8; ++q) if (k0 + q < tile) cf = cf * __expf(a[q].x) + a[q].y; }
        for (int k0 = tb0 + TPB - 1; k0 > tile; k0 -= 8) { f32x2 a[8];
#pragma unroll
            for (int q = 0; q < 8; ++q) { const int k = k0 - q > tile ? k0 - q : tile + 1; a[q] = AGG[((size_t)(TS / 64) + k) * 512 + ch]; }
#pragma unroll
            for (int q = 0; q < 8; ++q) if (k0 - q > tile) cr = cr * __expf(a[q].x) + a[q].y; }
        float hf[64];
        {
            const bf16_t* la = LA + (size_t)t0 * 512 + ch; const bf16_t* uu = UU + (size_t)t0 * 512 + ch; float h = cf;
#pragma unroll
            for (int q = 0; q < 64; q += 8) {
                float lv[8], uv[8];
#pragma unroll
                for (int e = 0; e < 8; ++e) { lv[e] = bf2f(la[(size_t)(q + e) * 512]); uv[e] = bf2f(uu[(size_t)(q + e) * 512]); }
#pragma unroll
                for (int e = 0; e < 8; ++e) { h = __expf(lv[e]) * h + uv[e]; hf[q + e] = h; }
            }
        }
        {
            const bf16_t* la = LA + ((size_t)TS + t0) * 512 + ch; const bf16_t* uu = UU + ((size_t)TS + t0) * 512 + ch; float h = cr;
#pragma unroll
            for (int q = 0; q < 64; q += 8) {
                float lv[8], uv[8], gv[8];
#pragma unroll
                for (int e = 0; e < 8; ++e) { const int i = 63 - (q + e); lv[e] = bf2f(la[(size_t)i * 512]); uv[e] = bf2f(uu[(size_t)i * 512]); gv[e] = bf2f(proj[(size_t)(t0 + i) * EIN + 1280 + ch]); }
#pragma unroll
                for (int e = 0; e < 8; ++e) { const int i = 63 - (q + e); h = __expf(lv[e]) * h + uv[e]; Y[(size_t)(t0 + i) * DMODEL + 512 + ch] = (bf16_t)f2bf((hf[i] + h) * gelu_tanh(gv[e])); }
            }
        }
    }
}

__device__ __forceinline__ void odd_conv(const bf16_t* proj, const float* cw, bf16_t* QKVP, int S) {
    MK_IDS();
    for (int t = gw; t < TS; t += NGW) {
        const int s = t % S;
#pragma unroll
        for (int blk = 0; blk < 3; ++blk) {
            const int ch = blk * 512 + lane * 8;
            float acc[8];
#pragma unroll
            for (int e = 0; e < 8; ++e) acc[e] = 0.f;
#pragma unroll
            for (int j = 0; j < 4; ++j) { const int sp = s + j - 2;
                if (sp >= 0 && sp < S) { const u32x4 v = *(const u32x4*)(proj + (size_t)(t + j - 2) * OINP + ch); float xv[8]; unpack8(v, xv);
                    const f32x4 w0 = *(const f32x4*)(cw + j * 1536 + ch), w1 = *(const f32x4*)(cw + j * 1536 + ch + 4);
                    acc[0] += w0.x * xv[0]; acc[1] += w0.y * xv[1]; acc[2] += w0.z * xv[2]; acc[3] += w0.w * xv[3];
                    acc[4] += w1.x * xv[4]; acc[5] += w1.y * xv[5]; acc[6] += w1.z * xv[6]; acc[7] += w1.w * xv[7]; } }
            float ss = 0.f;
#pragma unroll
            for (int e = 0; e < 8; ++e) { acc[e] = silu(acc[e]); ss += acc[e] * acc[e]; }
            if (blk < 2) {
                ss += __shfl_xor(ss, 1); ss += __shfl_xor(ss, 2); ss += __shfl_xor(ss, 4); ss += __shfl_xor(ss, 8);
                const float rn = 1.f / sqrtf(ss + EPS);
#pragma unroll
                for (int e = 0; e < 8; ++e) acc[e] *= rn;
            }
            u32x4 o; o.x = pk2(acc[0], acc[1]); o.y = pk2(acc[2], acc[3]); o.z = pk2(acc[4], acc[5]); o.w = pk2(acc[6], acc[7]);
            *(u32x4*)(QKVP + (size_t)t * 1536 + ch) = o;
        }
    }
}

__device__ __forceinline__ int frag128(int r, int k) { return ((((r >> 4) * 4 + (k >> 5)) * 64 + ((k >> 3) & 3) * 16 + (r & 15)) << 3) + (k & 7); }
__device__ __forceinline__ int frag64(int r, int k) { return ((((r >> 4) * 2 + (k >> 5)) * 64 + ((k >> 3) & 3) * 16 + (r & 15)) << 3) + (k & 7); }
__device__ __forceinline__ void odd_prep(const bf16_t* QKVP, const bf16_t* proj, const float* alog, const float* dtb, unsigned char* DNI, float* EGL, char* lds) {
    MK_IDS();
    constexpr int RS = 272;
    constexpr int HOFF = 69632;
    const float scale = 0.08838834764831845f;
    for (int it0 = blockIdx.x * 2; it0 < 2048; it0 += gridDim.x * 2) {
        int tq_ = tid; asm volatile("" : "+v"(tq_));
        const int half = tq_ >> 8, ht = tq_ & 255, hwave = __builtin_amdgcn_readfirstlane(ht >> 6), G = (tq_ & 63) >> 4, l16 = tq_ & 15;
        char* L = lds + half * HOFF;
        char* KS = L, *QS = L + 17408, *VS = L + 34816; float* LM = (float*)(L + 52224); float* GC = (float*)(L + 68608); float* BT = GC + 64; float* EG = BT + 64;
        const int it = it0 + half; const int d = it & 1, h = (it >> 1) & 3, c = it >> 3, t0 = c * 64;
        __syncthreads();
#pragma unroll
        for (int k = 0; k < 4; ++k) { const int idx = ht + k * 256, i = idx >> 4, pc = idx & 15; const int tk = d ? t0 + 63 - i : t0 + i;
            const bf16_t* src = QKVP + (size_t)tk * 1536 + h * 128 + pc * 8;
            *(u32x4*)(QS + i * RS + pc * 16) = *(const u32x4*)(src);
            *(u32x4*)(KS + i * RS + pc * 16) = *(const u32x4*)(src + 512);
            *(u32x4*)(VS + i * RS + pc * 16) = *(const u32x4*)(src + 1024); }
        if (hwave == 0) {
            const int i = lane; const int tk = d ? t0 + 63 - i : t0 + i;
            const float bl = bf2f(proj[(size_t)tk * OINP + 2048 + d * 4 + h]), al = bf2f(proj[(size_t)tk * OINP + 2056 + d * 4 + h]);
            const float beta = sigm(bl); float g = -__expf(alog[d * 4 + h]) * softplus(al + dtb[d * 4 + h]);
#pragma unroll
            for (int o = 1; o < 64; o <<= 1) { const float v = __shfl_up(g, o); if (lane >= o) g += v; }
            GC[i] = g; BT[i] = beta; EG[i] = __expf(g);
        }
        __syncthreads();
        {
            const bool isq = hwave >= 2; const char* XS = isq ? QS : KS;
#pragma unroll
            for (int mm = 0; mm < 2; ++mm) { const int mt = (hwave & 1) * 2 + mm;
                bf16x8 a[4];
#pragma unroll
                for (int kk = 0; kk < 4; ++kk) a[kk] = *(const bf16x8*)(XS + (mt * 16 + l16) * RS + (kk * 32 + G * 8) * 2);
#pragma unroll
                for (int nt = 0; nt < 4; ++nt) { f32x4 acc = {0.f, 0.f, 0.f, 0.f};
#pragma unroll
                    for (int kk = 0; kk < 4; ++kk) { const bf16x8 bb = *(const bf16x8*)(KS + (nt * 16 + l16) * RS + (kk * 32 + G * 8) * 2); acc = MFMA16(a[kk], bb, acc); }
                    const int j = nt * 16 + l16; const float gj = GC[j];
#pragma unroll
                    for (int r = 0; r < 4; ++r) { const int i = mt * 16 + G * 4 + r; const float dec = __expf(fminf(GC[i] - gj, 0.f));
                        if (!isq) LM[i * 64 + j] = (j < i) ? BT[i] * acc[r] * dec : 0.f;
                        else ((bf16_t*)(DNI + (size_t)it * DNI_BYTES + DNI_A))[frag64(i, j)] = (bf16_t)f2bf((j <= i) ? acc[r] * scale * dec : 0.f); }
                }
            }
        }
        __syncthreads();
        {
            float sol[64];
            const int cc = ht & 127; const bool isw = ht >= 128; const char* XS = isw ? KS : VS;
#pragma unroll
            for (int i = 0; i < 64; ++i) {
                float v = bf2f(*(const bf16_t*)(XS + i * RS + cc * 2)) * BT[i]; if (isw) v *= EG[i];
                float a0 = 0.f, a1 = 0.f;
#pragma unroll
                for (int j4 = 0; j4 < (i + 3) / 4; ++j4) { const f32x4 l4 = *(const f32x4*)(LM + i * 64 + j4 * 4);
                    if (j4 * 4 + 0 < i) a0 += l4.x * sol[j4 * 4 + 0]; if (j4 * 4 + 1 < i) a1 += l4.y * sol[j4 * 4 + 1];
                    if (j4 * 4 + 2 < i) a0 += l4.z * sol[j4 * 4 + 2]; if (j4 * 4 + 3 < i) a1 += l4.w * sol[j4 * 4 + 3];
                    if ((j4 & 1) == 1) asm volatile("" ::: "memory"); }
                v -= a0 + a1;
                sol[i] = v;
                ((bf16_t*)(DNI + (size_t)it * DNI_BYTES + (isw ? DNI_W : DNI_U)))[isw ? frag128(i, cc) : i * 128 + cc] = (bf16_t)f2bf(v);
                asm volatile("" ::: "memory");
            }
        }
        {
            const float gl = GC[63];
#pragma unroll
            for (int k = 0; k < 4; ++k) { const int idx = ht + k * 256;
                {
                    const int i = idx & 63, kg = idx >> 6; const u32x4 raw = *(const u32x4*)(QS + i * RS + kg * 16); float f[8]; unpack8(raw, f); const float sc = scale * EG[i];
                    u32x4 o; o.x = pk2(f[0] * sc, f[1] * sc); o.y = pk2(f[2] * sc, f[3] * sc); o.z = pk2(f[4] * sc, f[5] * sc); o.w = pk2(f[6] * sc, f[7] * sc);
                    *(u32x4*)((bf16_t*)(DNI + (size_t)it * DNI_BYTES + DNI_QT) + frag128(i, kg * 8)) = o; }
                {
                    const int dm = idx & 127, tg = idx >> 7; float f[8];
#pragma unroll
                    for (int q = 0; q < 8; ++q) { const int i = tg * 8 + q; f[q] = bf2f(*(const bf16_t*)(KS + i * RS + dm * 2)) * __expf(gl - GC[i]); }
                    u32x4 o; o.x = pk2(f[0], f[1]); o.y = pk2(f[2], f[3]); o.z = pk2(f[4], f[5]); o.w = pk2(f[6], f[7]);
                    *(u32x4*)((bf16_t*)(DNI + (size_t)it * DNI_BYTES + DNI_KTT) + frag64(dm, tg * 8)) = o; }
            }
            if (ht == 0) EGL[it] = __expf(gl);
        }
    }
}

__device__ __forceinline__ void odd_scan(const unsigned char* DNI, const float* EGL, bf16_t* OB, int S, int nb, char* lds) {
    MK_IDS();
    constexpr int O_SB = 0, O_VN = 4352, O_OUT = 6656, PFD = 7;
    const int NC = S / 64, G = lane >> 4, l16 = lane & 15;
    const int nitems = nb * 64;
    const int mt = wave & 3; const bool lo = wave < 4;
    for (int item = blockIdx.x; item < nitems; item += gridDim.x) {
        const int e = (item >> 3) & 7, sq = (item & 7) | ((item >> 6) << 3); const int d = sq & 1, h = (sq >> 1) & 3, b = sq >> 3;
        __syncthreads();
        for (int i = tid; i < 4352 / 4; i += NT) ((unsigned*)(lds + O_SB))[i] = 0u;
        f32x4 Sreg = {0.f, 0.f, 0.f, 0.f};
        const long dstep = (long)(d ? -8 : 8) * DNI_BYTES;
        const unsigned char* base0 = DNI + (size_t)(((b * NC + (d ? NC - 1 : 0)) * 4 + h) * 2 + d) * DNI_BYTES;
        const unsigned char* pX = base0 + (lo ? DNI_W : DNI_QT) + ((mt * 4) * 64 + lane) * 16;
        const unsigned char* pA = base0 + DNI_A + ((mt * 2) * 64 + lane) * 16;
        const unsigned char* pK = base0 + DNI_KTT + ((wave * 2) * 64 + lane) * 16;
        const unsigned char* pU = base0 + DNI_U + ((mt * 16 + G * 4) * 128 + e * 16 + l16) * 2;
        const float* pE = EGL + (((b * NC + (d ? NC - 1 : 0)) * 4 + h) * 2 + d);
        const unsigned char* pP = base0 + (long)PFD * dstep + e * 9216 + (tid < 144 ? tid : 143) * 64;
        bf16_t* pO = OB + ((size_t)d * TS + (size_t)(b * NC + (d ? NC - 1 : 0)) * 64 + (d ? 63 - (tid >> 3) : (tid >> 3))) * 512 + h * 128 + e * 16 + (tid & 7) * 2;
        const long ostep = (long)(d ? -64 : 64) * 512;
        u32x4 aX[4], aA[2], aK[2], bX[4], bA[2], bK[2], cX[4], cA[2], cK[2];
        unsigned aU[4], bU[4], cU[4]; float aE, bE, cE; unsigned pf_dummy = 0u;
#define DN_LOAD(P) do { \
            _Pragma("unroll") for (int kk = 0; kk < 4; ++kk) P##X[kk] = *(const u32x4*)(pX + kk * 1024); \
            _Pragma("unroll") for (int kk = 0; kk < 2; ++kk) { P##A[kk] = *(const u32x4*)(pA + kk * 1024); P##K[kk] = *(const u32x4*)(pK + kk * 1024); } \
            _Pragma("unroll") for (int r = 0; r < 4; ++r) P##U[r] = *(const bf16_t*)(pU + r * 256); \
            P##E = *pE; pX += dstep; pA += dstep; pK += dstep; pU += dstep; pE += (d ? -8 : 8); } while (0)
#define DN_STEP(P, PL) do { \
            DN_LOAD(PL); \
            if (wave < 3) { asm volatile("global_load_dword %0, %1, off" : "+v"(pf_dummy) : "v"(pP) : "memory"); } \
            pP += dstep; \
            f32x4 acc = {0.f, 0.f, 0.f, 0.f}, acc2 = {0.f, 0.f, 0.f, 0.f}; \
            { bf16x8 sb_[4]; \
              _Pragma("unroll") for (int kk = 0; kk < 4; ++kk) sb_[kk] = *(const bf16x8*)(lds + O_SB + l16 * 272 + (kk * 32 + G * 8) * 2); \
              asm volatile("s_waitcnt lgkmcnt(0)" : "+v"(sb_[0]), "+v"(sb_[1]), "+v"(sb_[2]), "+v"(sb_[3]) :: "memory"); \
              acc = MFMA16(__builtin_bit_cast(bf16x8, P##X[0]), sb_[0], acc); acc2 = MFMA16(__builtin_bit_cast(bf16x8, P##X[1]), sb_[1], acc2); \
              acc = MFMA16(__builtin_bit_cast(bf16x8, P##X[2]), sb_[2], acc); acc2 = MFMA16(__builtin_bit_cast(bf16x8, P##X[3]), sb_[3], acc2); \
              acc = acc + acc2; } \
            if (lo) { u32x2 o; float v[4]; \
              _Pragma("unroll") for (int r = 0; r < 4; ++r) v[r] = __uint_as_float(P##U[r] << 16) - acc[r]; \
              o.x = attn_body::cvtpk_s(v[0], v[1]); o.y = attn_body::cvtpk_s(v[2], v[3]); \
              *(u32x2*)(lds + O_VN + l16 * 144 + (mt * 16 + G * 4) * 2) = o; } \
            asm volatile("s_waitcnt lgkmcnt(0)\n\ts_barrier" ::: "memory"); \
            bf16x8 vb[2]; \
            _Pragma("unroll") for (int kk = 0; kk < 2; ++kk) vb[kk] = *(const bf16x8*)(lds + O_VN + l16 * 144 + (kk * 32 + G * 8) * 2); \
            asm volatile("s_waitcnt lgkmcnt(0)" : "+v"(vb[0]), "+v"(vb[1]) :: "memory"); \
            Sreg = Sreg * P##E; \
            _Pragma("unroll") for (int kk = 0; kk < 2; ++kk) Sreg = MFMA16(__builtin_bit_cast(bf16x8, P##K[kk]), vb[kk], Sreg); \
            { u32x2 o; o.x = attn_body::cvtpk_s(Sreg[0], Sreg[1]); o.y = attn_body::cvtpk_s(Sreg[2], Sreg[3]); \
              *(u32x2*)(lds + O_SB + l16 * 272 + (wave * 16 + G * 4) * 2) = o; } \
            if (!lo) { \
              _Pragma("unroll") for (int kk = 0; kk < 2; ++kk) acc = MFMA16(__builtin_bit_cast(bf16x8, P##A[kk]), vb[kk], acc); \
              const unsigned w0_ = attn_body::cvtpk_s(acc[0], acc[1]), w1_ = attn_body::cvtpk_s(acc[2], acc[3]); \
              bf16_t* op_ = (bf16_t*)(lds + O_OUT + ((mt * 16 + G * 4) * 16 + l16) * 2); \
              op_[0] = (bf16_t)(w0_ & 0xffffu); op_[16] = (bf16_t)(w0_ >> 16); op_[32] = (bf16_t)(w1_ & 0xffffu); op_[48] = (bf16_t)(w1_ >> 16); } \
            asm volatile("s_waitcnt lgkmcnt(0)\n\ts_barrier" ::: "memory"); \
            *(unsigned*)pO = *(const unsigned*)(lds + O_OUT + tid * 4); pO += ostep; } while (0)
        DN_LOAD(a); DN_LOAD(b);
        __syncthreads();
        int n = 0;
        for (; n + 3 <= NC; n += 3) {
            DN_STEP(a, c);
            DN_STEP(b, a);
            DN_STEP(c, b);
        }
        if (n < NC) { DN_STEP(a, c); }
        if (n + 1 < NC) { DN_STEP(b, a); }
#undef DN_STEP
#undef DN_LOAD
        asm volatile("s_waitcnt vmcnt(0)" ::: "memory");
        asm volatile("" :: "v"(pf_dummy));
    }
}

__device__ __forceinline__ int t5_bucket(int rel) {
    const int n = rel < 0 ? -rel : rel; int v;
    if (n < 8) v = n; else v = 8 + (n >= 15) + (n >= 27) + (n >= 50) + (n >= 91) + (n >= 166) + (n >= 305) + (n >= 559);
    return (rel > 0 ? 16 : 0) + v;
}
__device__ __forceinline__ void odd_dilated(bf16_t* proj, const float* relb, float* LSE, int S, char* lds, int first_wg, int n_wg) {
    MK_IDS();
    constexpr int KST = 144, VST = 400, HOFF = 27648 + 25600 + 1024;
    const int half = tid >> 8, ht = tid & 255, wv = ht >> 6, G = lane >> 4, l16 = lane & 15;
    char* L = lds + half * HOFF; char* KS = L; char* VT = L + 27648; float* BIAS = (float*)(L + 27648 + 25600);
    const int NBb = S / 64;
    const int wgi = (int)blockIdx.x - first_wg;
    if (wgi < 0) return;
    for (int it0 = wgi * 2; it0 < 3072; it0 += n_wg * 2) {
        const int it = it0 + half; const int zb = it & 255, sl = (it >> 8) & 3, g = it >> 10;
        const int dil = g == 0 ? 1 : (g == 1 ? 4 : 16), lg = g * 2;
        const int M = S >> lg, MB = M / 64;
        const int b = zb / NBb, r0 = zb % NBb, rho = r0 / MB, n = r0 % MB;
        const int hc = (g * 4 + sl) * 64;
        const size_t tb = (size_t)b * S;
        __syncthreads();
#pragma unroll
        for (int k = 0; k < 6; ++k) { const int idx = ht + k * 256, kj = idx >> 3, pc = idx & 7; const int mk = 64 * n - 64 + kj;
            u32x4 kv = {0u, 0u, 0u, 0u}, vv = {0u, 0u, 0u, 0u};
            if (mk >= 0 && mk < M) { const bf16_t* rowp = proj + (tb + (size_t)mk * dil + rho) * OINP; kv = *(const u32x4*)(rowp + 2832 + hc + pc * 8); vv = *(const u32x4*)(rowp + 3600 + hc + pc * 8); }
            *(u32x4*)(KS + kj * KST + pc * 16) = kv;
            const unsigned w[4] = {vv.x, vv.y, vv.z, vv.w};
#pragma unroll
            for (int q = 0; q < 4; ++q) { *(bf16_t*)(VT + (pc * 8 + 2 * q) * VST + kj * 2) = (bf16_t)(w[q] & 0xffffu); *(bf16_t*)(VT + (pc * 8 + 2 * q + 1) * VST + kj * 2) = (bf16_t)(w[q] >> 16); } }
        if (ht < 129) BIAS[ht] = relb[t5_bucket((ht - 64) * dil) * 12 + g * 4 + sl];
        const int mq = 64 * n + 16 * wv + l16; const size_t tq = tb + (size_t)mq * dil + rho;
        bf16x8 qf[2];
#pragma unroll
        for (int kk = 0; kk < 2; ++kk) qf[kk] = *(const bf16x8*)(proj + tq * OINP + 2064 + hc + kk * 32 + G * 8);
        __syncthreads();
        f32x4 sc[9]; float mx = -1e30f;
#pragma unroll
        for (int kt = 0; kt < 9; ++kt) { f32x4 acc = {0.f, 0.f, 0.f, 0.f};
#pragma unroll
            for (int kk = 0; kk < 2; ++kk) { const bf16x8 a = *(const bf16x8*)(KS + ((wv + kt) * 16 + l16) * KST + (kk * 32 + G * 8) * 2); acc = MFMA16(a, qf[kk], acc); }
#pragma unroll
            for (int r = 0; r < 4; ++r) { const int kj = (wv + kt) * 16 + G * 4 + r; const int delta = kj - 64 - 16 * wv - l16; const int mk = 64 * n - 64 + kj;
                const bool ok = (delta >= -64) && (delta <= 64) && (mk >= 0) && (mk < M);
                const float s = ok ? acc[r] * 0.125f + BIAS[(delta < -64 ? -64 : (delta > 64 ? 64 : delta)) + 64] : -1e30f;
                acc[r] = s; mx = fmaxf(mx, s); }
            sc[kt] = acc; }
        mx = fmaxf(mx, __shfl_xor(mx, 16)); mx = fmaxf(mx, __shfl_xor(mx, 32));
        float sum = 0.f;
#pragma unroll
        for (int kt = 0; kt < 9; ++kt)
#pragma unroll
            for (int r = 0; r < 4; ++r) { const float pv_ = (sc[kt][r] > -1e29f) ? __expf(sc[kt][r] - mx) : 0.f; sc[kt][r] = pv_; sum += pv_; }
        sum += __shfl_xor(sum, 16); sum += __shfl_xor(sum, 32);
        f32x4 ot[4];
#pragma unroll
        for (int dt = 0; dt < 4; ++dt) ot[dt] = (f32x4){0.f, 0.f, 0.f, 0.f};
#pragma unroll
        for (int pp = 0; pp < 5; ++pp) {
            u32x4 pb; pb.x = pk2(sc[2 * pp][0], sc[2 * pp][1]); pb.y = pk2(sc[2 * pp][2], sc[2 * pp][3]);
            if (pp < 4) { pb.z = pk2(sc[2 * pp + 1][0], sc[2 * pp + 1][1]); pb.w = pk2(sc[2 * pp + 1][2], sc[2 * pp + 1][3]); } else { pb.z = 0u; pb.w = 0u; }
            const bf16x8 pbf = __builtin_bit_cast(bf16x8, pb);
#pragma unroll
            for (int dt = 0; dt < 4; ++dt) {
                u32x4 av; const u32x2 lo = *(const u32x2*)(VT + (dt * 16 + l16) * VST + ((wv + 2 * pp) * 16 + G * 4) * 2); av.x = lo.x; av.y = lo.y;
                if (pp < 4) { const u32x2 hi = *(const u32x2*)(VT + (dt * 16 + l16) * VST + ((wv + 2 * pp + 1) * 16 + G * 4) * 2); av.z = hi.x; av.w = hi.y; } else { av.z = 0u; av.w = 0u; }
                ot[dt] = MFMA16(__builtin_bit_cast(bf16x8, av), pbf, ot[dt]);
            }
        }
        const float rs = 1.f / sum;
        float* od = (float*)(proj + tq * OINP) + (g * 4 + sl) * 64;
#pragma unroll
        for (int dt = 0; dt < 4; ++dt) *(f32x4*)(od + dt * 16 + G * 4) = ot[dt] * rs;
        if (G == 0) LSE[tq * 12 + g * 4 + sl] = mx + __logf(sum);
    }
}

__device__ __forceinline__ void odd_combine(const bf16_t* OB, const bf16_t* proj, const float* LSE, const float* og, bf16_t* Y) {
    MK_IDS();
    const float g0 = og[lane * 2], g1 = og[lane * 2 + 1];
    for (int t = gw; t < TS; t += NGW) {
        const bf16_t* prow = proj + (size_t)t * OINP;
#pragma unroll
        for (int hh = 0; hh < 4; ++hh) {
            const unsigned a = *(const unsigned*)(OB + (size_t)t * 512 + hh * 128 + lane * 2), bb = *(const unsigned*)(OB + ((size_t)TS + t) * 512 + hh * 128 + lane * 2);
            const unsigned zz = *(const unsigned*)(prow + 1536 + hh * 128 + lane * 2);
            const float o0 = __uint_as_float(a << 16) + __uint_as_float(bb << 16), o1 = __uint_as_float(a & 0xffff0000u) + __uint_as_float(bb & 0xffff0000u);
            const float ss = wave_sum(o0 * o0 + o1 * o1); const float rn = 1.f / sqrtf(ss * (1.f / 128.f) + EPS);
            const float z0 = __uint_as_float(zz << 16), z1 = __uint_as_float(zz & 0xffff0000u);
            *(unsigned*)(Y + (size_t)t * OOUT + hh * 128 + lane * 2) = pk2(o0 * rn * g0 * silu(z0), o1 * rn * g1 * silu(z1));
        }
        const float* od = (const float*)prow;
#pragma unroll
        for (int sl = 0; sl < 4; ++sl) {
            const float l0 = LSE[(size_t)t * 12 + sl], l1 = LSE[(size_t)t * 12 + 4 + sl], l2 = LSE[(size_t)t * 12 + 8 + sl];
            const float m = fmaxf(l0, fmaxf(l1, l2)); const float w0 = __expf(l0 - m), w1 = __expf(l1 - m), w2 = __expf(l2 - m); const float rs = 1.f / (w0 + w1 + w2);
            const float v = (w0 * od[sl * 64 + lane] + w1 * od[256 + sl * 64 + lane] + w2 * od[512 + sl * 64 + lane]) * rs;
            Y[(size_t)t * OOUT + 512 + sl * 64 + lane] = (bf16_t)f2bf(v);
        }
    }
}

__global__ void __launch_bounds__(NT, 2) fwd_megakernel(Params p) {
    extern __shared__ __attribute__((aligned(16))) unsigned char lds_raw[];
    cg::grid_group grid = cg::this_grid();
    char* lds = (char*)lds_raw;
    PG8_LAS unsigned char* ldsl = (PG8_LAS unsigned char*)lds_raw;
    const int Gr = gridDim.x;
    volatile LAS unsigned* MISC = (volatile LAS unsigned*)((PG8_LAS unsigned char*)lds_raw + (LDS_BYTES - 128));
    if (threadIdx.x < 32) MISC[threadIdx.x] = 0u;
    __syncthreads();
    xb::XcdBarrier bar = xb::xcd_barrier_post((unsigned*)p.ws, MISC + 8);
#define GSYNC() xb::xcd_barrier(bar)
    unsigned char* ws = p.ws;
    bf16_t* H = (bf16_t*)(ws + WS_H); bf16_t* PROJ = (bf16_t*)(ws + WS_PROJ); unsigned char* SCR = ws + WS_SCR;

    phase_prologue(p, lds);
    grid.sync();

    float* SSQA = (float*)(SCR + 232 * MiB); float* SSQB = (float*)(SCR + 234 * MiB);
    bf16_t* YE = (bf16_t*)(SCR + 192 * MiB); bf16_t* YO = (bf16_t*)(SCR + SC_QKVP);
    for (int seg = 0; seg < NSEG; ++seg) {
        const int S = seg < 2 ? 16384 : 2048, nb = seg < 2 ? 1 : 8;
        const float* xin = (seg < 2 ? p.in[0] : p.in[1]) + (size_t)(seg & 1) * TS * DMODEL;
        float* xo = p.out + (size_t)seg * TS * DMODEL;
        phase_x0(xin, H, SSQB);
        GSYNC();
        for (int layer = 0; layer < 4; ++layer) {
            const float* xcur = layer == 0 ? xin : xo;
            const int j = layer >> 1; const bool odd = layer & 1;
            {
                const int N = odd ? OINP : EIN;
                const bf16_t* Bt = odd ? (const bf16_t*)(ws + WS_WINO) + (size_t)j * OINP * 1024 : (const bf16_t*)(ws + WS_WINE) + (size_t)j * EIN * 1024;
                pg8::Gemm g{H, Bt, TS, N, 1024}; pg8::StaticOrder So; So.init(TS, N, Gr, (int)blockIdx.x);
                pg8::EpiBf16<0> E{PROJ, N, nullptr, 0, 0, 1.f, SSQB};
                pg8::gemm_phase<pg8::EpiBf16<0>, pg8::StaticOrder, true, true>(ldsl, g, So, E);
            }
            GSYNC();
            if (!odd) {
                even_qk_post(PROJ, p.in[10] + j * 64, p.in[11] + j * 64, S);
                even_lru_prep(PROJ, p.in[12] + j * 2048, p.in[13] + j * 512, (const bf16_t*)(ws + WS_GW) + (size_t)j * 2 * 2 * 8 * 4096, p.in[15] + j * 1024, p.in[17] + j * 1024, p.in[18] + j * 1024,
                              (bf16_t*)(SCR + SC_LA), (bf16_t*)(SCR + SC_UU), (f32x2*)(SCR + SC_AGG), S, lds);
                GSYNC();
                {
                    const int nqb = S / 256, nunits = nb * 8 * nqb;
                    for (int u = blockIdx.x; u < nunits; u += Gr) {
                        const int qb = u % nqb, h = (u / nqb) % 8, b = u / (nqb * 8), kvh = h >> 2;
                        const attn_body::bf16* base = (const attn_body::bf16*)PROJ + (size_t)b * S * EIN;
                        attn_body::attn_unit<8>(qb, S, base + h * 64, EIN, base + 512 + kvh * 64, base + 640 + kvh * 64, EIN, (attn_body::bf16*)YE + (size_t)b * S * DMODEL + h * 64, DMODEL, lds);
                    }
                }
                __syncthreads();
                even_lru_scan((const bf16_t*)(SCR + SC_LA), (const bf16_t*)(SCR + SC_UU), (const f32x2*)(SCR + SC_AGG), PROJ, YE, S);
                GSYNC();
                {
                    pg8::Gemm g{YE, (const bf16_t*)(ws + WS_WOUTE) + (size_t)j * 1024 * 1024, TS, 1024, 1024}; pg8::StaticOrder So; So.init(TS, 1024, Gr, (int)blockIdx.x);
                    EpiRes E{xcur, xo, DMODEL, H, SSQA};
                    pg8::gemm_phase<EpiRes, pg8::StaticOrder, true, true>(ldsl, g, So, E);
                }
            } else {
                odd_conv(PROJ, p.in[21] + j * 4 * 1536, (bf16_t*)(SCR + SC_QKVP), S);
                GSYNC();
                odd_prep((const bf16_t*)(SCR + SC_QKVP), PROJ, p.in[22] + j * 8, p.in[23] + j * 8, SCR + SC_DNI, (float*)(SCR + SC_EGL), lds);
                GSYNC();
                {
                    const int nscan = nb * 64;
                    odd_scan(SCR + SC_DNI, (const float*)(SCR + SC_EGL), (bf16_t*)(SCR + SC_OB), S, nb, lds);
                    const int first = nscan < Gr ? nscan : 0;
                    odd_dilated(PROJ, p.in[2], (float*)(SCR + SC_LSE), S, lds, first, Gr - first);
                }
                GSYNC();
                odd_combine((const bf16_t*)(SCR + SC_OB), PROJ, (const float*)(SCR + SC_LSE), p.in[24] + j * 128, YO);
                GSYNC();
                {
                    pg8::Gemm g{YO, (const bf16_t*)(ws + WS_WOUTO) + (size_t)j * 1024 * OOUT, TS, 1024, OOUT}; pg8::StaticOrder So; So.init(TS, 1024, Gr, (int)blockIdx.x);
                    EpiRes E{xcur, xo, DMODEL, H, SSQA};
                    pg8::gemm_phase<EpiRes, pg8::StaticOrder, true, true>(ldsl, g, So, E);
                }
            }
            GSYNC();
            {
                pg8::Gemm g{H, (const bf16_t*)(ws + WS_W1T) + (size_t)layer * 4096 * 1024, TS, DFF, 1024}; pg8::StaticOrder So; So.init(TS, DFF, Gr, (int)blockIdx.x);
                pg8::EpiBf16<2> E{(bf16_t*)(SCR + SC_HID), DFF, nullptr, 0, 0, 1.f, SSQA};
                pg8::gemm_phase<pg8::EpiBf16<2>, pg8::StaticOrder, true, true>(ldsl, g, So, E);
            }
            GSYNC();
            {
                pg8::Gemm g{(const bf16_t*)(SCR + SC_HID), (const bf16_t*)(ws + WS_W2T) + (size_t)layer * 1024 * 4096, TS, 1024, DFF}; pg8::StaticOrder So; So.init(TS, 1024, Gr, (int)blockIdx.x);
                EpiRes E{xo, xo, DMODEL, H, SSQB};
                pg8::gemm_phase<EpiRes, pg8::StaticOrder, true, true>(ldsl, g, So, E);
            }
            GSYNC();
        }
        phase_rmsnorm_final(xo, p.in[5]);
    }
}
}

extern "C" void kernel_launch(void* const* d_in, const int* in_sizes, int n_in, void* d_out, int out_size, void* d_ws, size_t ws_size, hipStream_t stream) {
    static int grid = 0;
    if (grid == 0) {
        if (n_in != 25 || ws_size < mk::WS_END) { fprintf(stderr, "kernel_launch: unexpected n_in %d / ws_size %zu\n", n_in, ws_size); grid = -1; return; }
        int dev = 0, cus = 0, per_cu = 0;
        hipGetDevice(&dev); hipDeviceGetAttribute(&cus, hipDeviceAttributeMultiprocessorCount, dev);
        if (hipFuncSetAttribute((const void*)mk::fwd_megakernel, hipFuncAttributeMaxDynamicSharedMemorySize, mk::LDS_BYTES) != hipSuccess) { fprintf(stderr, "hipFuncSetAttribute failed\n"); }
        hipOccupancyMaxActiveBlocksPerMultiprocessor(&per_cu, (const void*)mk::fwd_megakernel, mk::NT, mk::LDS_BYTES);
        (void)hipGetLastError();
        if (per_cu < 1) per_cu = 1;
        grid = cus * 1;
        fprintf(stderr, "kernel_launch: cus %d per_cu %d grid %d\n", cus, per_cu, grid);
    }
    if (grid < 0) return;
    if (hipMemsetAsync(d_ws, 0, 65536, stream) != hipSuccess) { fprintf(stderr, "memset failed\n"); return; }
    mk::Params p{};
    for (int i = 0; i < 25; ++i) p.in[i] = (const float*)d_in[i];
    p.out = (float*)d_out; p.ws = (unsigned char*)d_ws;
    void* args[] = {&p};
    hipError_t e = hipLaunchCooperativeKernel((const void*)mk::fwd_megakernel, dim3(grid), dim3(mk::NT), args, mk::LDS_BYTES, stream);
    if (e != hipSuccess) fprintf(stderr, "cooperative launch failed: %s (grid %d)\n", hipGetErrorString(e), grid);
}
```

```cpp
#include <hip/hip_runtime.h>
#include <hip/hip_cooperative_groups.h>
#include <hip/hip_bf16.h>
#include <cstdio>
#include <cstdint>
#include <cmath>
namespace cg = cooperative_groups;
namespace pg8 {
#define PG8_LAS __attribute__((address_space(3)))
typedef unsigned short bf16_t;
typedef short bf16x8 __attribute__((ext_vector_type(8)));
typedef float f32x4 __attribute__((ext_vector_type(4)));
typedef unsigned u32x4 __attribute__((ext_vector_type(4)));
constexpr int BM = 256, BK = 64, HALF = 128, HTB = HALF * BK * 2  , STAGE_BYTES = 8 * HTB, NXCD = 8, WGM = 8;

__host__ __device__ __forceinline__ int lds_byte(int r, int c) { const int st = (r >> 4) * 2 + (c >> 5), rr = r & 15, cc = c & 31, ob = rr * 64 + cc * 2; return st * 1024 + (ob ^ (((ob >> 9) & 1) << 5)); }
__host__ __device__ __forceinline__ void stage_rc(int b, int& R, int& C) { const int st = b / 1024, sb = b % 1024, swz = sb ^ (((sb >> 9) & 1) << 5); R = (st >> 1) * 16 + swz / 64; C = (st & 1) * 32 + (swz % 64) / 2; }
__host__ __device__ __forceinline__ int perm32(int rho) { const int n = rho >> 4, i = rho & 15; return 8 * (i >> 2) + 4 * n + (i & 3); }

struct Unit { int pm, pn; };
struct Gemm { const bf16_t* A; const bf16_t* Bt; int M, N, K; };

struct StaticOrder {
    int nM, nN, nwg, G, c;
    __host__ __device__ void init(int M, int N, int G_, int c_) { nM = M / BM; nN = N / BM; nwg = nM * nN; G = G_; c = c_; }
    __host__ __device__ bool next(int i, Unit& u) const {
        const long L = (long)i * G + c; if (L >= nwg) return false;
        int wgid = (int)L; { const int q = nwg / NXCD, r = nwg % NXCD, xcd = wgid % NXCD, off = wgid / NXCD; wgid = (xcd < r ? xcd * (q + 1) : r * (q + 1) + (xcd - r) * q) + off; }
        const int nig = WGM * nN, gid = wgid / nig, fm = gid * WGM, gsz = (nM - fm) < WGM ? (nM - fm) : WGM;
        u.pm = fm + ((wgid % nig) % gsz); u.pn = (wgid % nig) / gsz; return true;
    }
    __device__ __forceinline__ void a_ready(const Unit&) const {}
    __device__ __forceinline__ void done(const Unit&) const {}
};

__device__ __forceinline__ unsigned cvt_pk_bf16(float lo, float hi) { unsigned r; asm volatile("v_cvt_pk_bf16_f32 %0, %1, %2" : "=v"(r) : "v"(lo), "v"(hi)); return r; }
typedef float f32x2 __attribute__((ext_vector_type(2)));
__device__ __forceinline__ f32x2 gelu_pk(f32x2 v) {
    const f32x2 av = __builtin_elementwise_abs(v), d = av * 0.2316418882f + 1.0f;
    f32x2 t; t.x = __builtin_amdgcn_rcpf(d.x); t.y = __builtin_amdgcn_rcpf(d.y);
    f32x2 q = t * 0.5307027145f + (-0.7265760135f); q = q * t + 0.7107068705f; q = q * t + (-0.142248368f); q = q * t + 0.127414796f; q = q * t;
    const f32x2 s = (v * v) * (-0.72134752044f);
    f32x2 e; e.x = __builtin_amdgcn_exp2f(s.x); e.y = __builtin_amdgcn_exp2f(s.y);
    const f32x2 m = v * (q * e), r = v - m;
    f32x2 o; o.x = v.x < 0.f ? m.x : r.x; o.y = v.y < 0.f ? m.y : r.y; return o;
}

template <int ACT  > struct EpiBf16 {
    static constexpr bool PERM = true, AFTER_DRAIN = false; static_assert(ACT == 0 || ACT == 1 || ACT == 2, "EpiBf16: ACT 0 none, 1 gelu, 2 relu^2");
    bf16_t* O; int ldc; const float* bias; int split_cols; size_t split_stride; float scale0; const float* ssq;
    __device__ __forceinline__ void operator()(const f32x4 (&acc)[2][2][4][2], const Unit& u, int wr, int wc, int fr, int fq) const {
        const int row0 = u.pm * BM + wr * 64 + fr; int colt = u.pn * BM; bf16_t* base = O;
        float sc = 1.f; if (split_cols) { const int t = colt / split_cols; base += (size_t)t * split_stride; colt -= t * split_cols; if (t == 0) sc = scale0; }
        const int col0 = colt + wc * 32 + 8 * fq, bcol0 = u.pn * BM + wc * 32 + 8 * fq;
        float rsc[2][4];
        if (ssq) { f32x4 t_[2][4];
#pragma unroll
            for (int ai = 0; ai < 2; ++ai)
#pragma unroll
                for (int m = 0; m < 4; ++m) t_[ai][m] = *(const f32x4*)(ssq + (size_t)(row0 + ai * HALF + m * 16) * 16 + fq * 4);
#pragma unroll
            for (int ai = 0; ai < 2; ++ai)
#pragma unroll
                for (int m = 0; m < 4; ++m) { float s_ = (t_[ai][m][0] + t_[ai][m][1]) + (t_[ai][m][2] + t_[ai][m][3]); s_ += __shfl_xor(s_, 16); s_ += __shfl_xor(s_, 32); rsc[ai][m] = 1.0f / sqrtf(s_ * (1.0f / 1024.0f) + 1e-6f); }
        } else {
#pragma unroll
            for (int ai = 0; ai < 2; ++ai)
#pragma unroll
                for (int m = 0; m < 4; ++m) rsc[ai][m] = 1.0f; }
        f32x4 bv[2][2];
#pragma unroll
        for (int bj = 0; bj < 2; ++bj)
#pragma unroll
            for (int n = 0; n < 2; ++n) bv[bj][n] = bias ? *(const f32x4*)(bias + bcol0 + bj * HALF + 4 * n) : (f32x4){0.f, 0.f, 0.f, 0.f};
#pragma unroll
        for (int ai = 0; ai < 2; ++ai)
#pragma unroll
            for (int m = 0; m < 4; ++m) { bf16_t* rowp = base + (size_t)(row0 + ai * HALF + m * 16) * ldc + col0; const float rsc_ = rsc[ai][m];
#pragma unroll
                for (int bj = 0; bj < 2; ++bj) { f32x4 v0 = (acc[ai][bj][m][0] + bv[bj][0]) * rsc_, v1 = (acc[ai][bj][m][1] + bv[bj][1]) * rsc_;
                    if (ACT == 1) { f32x2 a = gelu_pk((f32x2){v0[0], v0[1]}), b = gelu_pk((f32x2){v0[2], v0[3]}), c = gelu_pk((f32x2){v1[0], v1[1]}), d = gelu_pk((f32x2){v1[2], v1[3]});
                        v0 = (f32x4){a.x, a.y, b.x, b.y}; v1 = (f32x4){c.x, c.y, d.x, d.y}; }
                    if (ACT == 2) { _Pragma("unroll") for (int q_ = 0; q_ < 4; ++q_) { const float a0_ = v0[q_] > 0.f ? v0[q_] : 0.f, a1_ = v1[q_] > 0.f ? v1[q_] : 0.f; v0[q_] = a0_ * a0_; v1[q_] = a1_ * a1_; } }
                    v0 = v0 * sc; v1 = v1 * sc; u32x4 w; w.x = cvt_pk_bf16(v0[0], v0[1]); w.y = cvt_pk_bf16(v0[2], v0[3]); w.z = cvt_pk_bf16(v1[0], v1[1]); w.w = cvt_pk_bf16(v1[2], v1[3]);
                    *(u32x4*)(rowp + bj * HALF) = w; } }
    }
};

template <class Epi, class Sched, bool ALIGN_EPI = false, bool SP2 = false>
__device__ __forceinline__ void gemm_phase(PG8_LAS unsigned char* lds, const Gemm g, const Sched& S, const Epi& E) {
    int tid_ = threadIdx.x; asm volatile("" : "+v"(tid_)); const int tid = tid_, wid = __builtin_amdgcn_readfirstlane(tid >> 6), lane = tid & 63, wr = wid >> 2, wc = wid & 3, fr = lane & 15, fq = lane >> 4;
    const int K = g.K, nt = K / BK;
    unsigned voffA[2], voffB[2];
#pragma unroll
    for (int i = 0; i < 2; ++i) { int R, C; stage_rc(tid * 16 + i * 8192, R, C); const int Rb = Epi::PERM ? ((R & ~31) + perm32(R & 31)) : R;
        voffA[i] = (unsigned)(R * K + C) * 2u; voffB[i] = (unsigned)(Rb * K + C) * 2u; }
    const size_t kstep = (size_t)(BK * 2);
    const size_t hstep = (size_t)HALF * K * 2;
    const size_t tstep = 2 * hstep;
    const unsigned ldsw = (unsigned)wid * 1024u;
    const int aoff = lds_byte(wr * 64 + fr, fq * 8), boff = lds_byte(wc * 32 + fr, fq * 8);
#define PG8_SA(b, h) (((b) * 2 + (h)) * HTB)
#define PG8_SB(b, h) ((4 + (b) * 2 + (h)) * HTB)
#define PG8_STAGE(bufoff, gbase, voff) do { _Pragma("unroll") for (int _i = 0; _i < 2; ++_i) \
        __builtin_amdgcn_global_load_lds((const unsigned*)((const char*)(gbase) + (voff)[_i]), (PG8_LAS unsigned*)(lds + (bufoff) + ldsw + _i * 8192), 16, 0, 0); } while (0)
#define PG8_LDA(dst, b, h) do { _Pragma("unroll") for (int m = 0; m < 4; ++m) _Pragma("unroll") for (int k = 0; k < 2; ++k) dst[m][k] = *(const PG8_LAS bf16x8*)(lds + PG8_SA(b, h) + aoff + m * 2048 + k * 1024); } while (0)
#define PG8_LDB(dst, b, h) do { _Pragma("unroll") for (int n = 0; n < 2; ++n) _Pragma("unroll") for (int k = 0; k < 2; ++k) dst[n][k] = *(const PG8_LAS bf16x8*)(lds + PG8_SB(b, h) + boff + n * 2048 + k * 1024); } while (0)
#define PG8_MMA(ai, bj, At, Bt) do { __builtin_amdgcn_s_setprio(1); _Pragma("unroll") for (int m = 0; m < 4; ++m) _Pragma("unroll") for (int n = 0; n < 2; ++n) _Pragma("unroll") for (int k = 0; k < 2; ++k) \
        acc[ai][bj][m][n] = __builtin_amdgcn_mfma_f32_16x16x32_bf16(Bt[n][k], At[m][k], acc[ai][bj][m][n], 0, 0, 0); __builtin_amdgcn_s_setprio(0); } while (0)
#define PG8_WAIT_V(n) asm volatile("s_waitcnt vmcnt(" #n ")" ::: "memory")
#define PG8_WAIT_L(n) asm volatile("s_waitcnt lgkmcnt(" #n ")" ::: "memory")
#define PG8_BAR __builtin_amdgcn_s_barrier()
#define PG8_SCHED __builtin_amdgcn_sched_barrier(0)
    Unit cur, nxt; int ui = 0;
    if (!S.next(0, cur)) return;
    f32x4 acc[2][2][4][2];
#pragma unroll
    for (int a = 0; a < 2; ++a)
#pragma unroll
        for (int b = 0; b < 2; ++b)
#pragma unroll
            for (int m = 0; m < 4; ++m)
#pragma unroll
                for (int n = 0; n < 2; ++n) acc[a][b][m][n] = (f32x4){0.f, 0.f, 0.f, 0.f};
    bf16x8 At[4][2], B0[2][2], B1[2][2];
    const char* cA = (const char*)g.A + (size_t)cur.pm * tstep; const char* cB = (const char*)g.Bt + (size_t)cur.pn * tstep;
    S.a_ready(cur);
    if constexpr (SP2) {
        PG8_STAGE(PG8_SB(0, 0), cB, voffB); PG8_STAGE(PG8_SB(0, 1), cB + hstep, voffB); PG8_STAGE(PG8_SA(0, 0), cA, voffA); PG8_STAGE(PG8_SA(0, 1), cA + hstep, voffA);
        if (wr == 1) PG8_BAR;
        PG8_WAIT_V(2); PG8_BAR;
        PG8_STAGE(PG8_SB(1, 0), cB + kstep, voffB); PG8_STAGE(PG8_SA(1, 0), cA + kstep, voffA); PG8_STAGE(PG8_SB(1, 1), cB + hstep + kstep, voffB);
        PG8_WAIT_V(6); PG8_BAR;
    } else {
        PG8_STAGE(PG8_SB(0, 0), cB, voffB); PG8_STAGE(PG8_SA(0, 0), cA, voffA); PG8_STAGE(PG8_SB(0, 1), cB + hstep, voffB); PG8_STAGE(PG8_SA(0, 1), cA + hstep, voffA);
        if (wr == 1) PG8_BAR;
        PG8_WAIT_V(4); PG8_BAR;
        PG8_STAGE(PG8_SB(1, 0), cB + kstep, voffB); PG8_STAGE(PG8_SA(1, 0), cA + kstep, voffA); PG8_STAGE(PG8_SB(1, 1), cB + hstep + kstep, voffB);
        PG8_WAIT_V(6); PG8_BAR;
    }
    for (;;) {
        const bool has_next = S.next(ui + 1, nxt);
        const char* nA = has_next ? (const char*)g.A + (size_t)nxt.pm * tstep : cA; const char* nB = has_next ? (const char*)g.Bt + (size_t)nxt.pn * tstep : cB;
        for (int t = 0; t < nt; t += 2) {
            const bool last = (t == nt - 2);
            const char* a1 = cA + (size_t)(t + 1) * kstep;
            const char* a2 = last ? nA : cA + (size_t)(t + 2) * kstep; const char* b2 = last ? nB : cB + (size_t)(t + 2) * kstep;
            const char* a3 = a2 + kstep; const char* b3 = b2 + kstep;
            if (last && has_next) S.a_ready(nxt);
            if constexpr (SP2) {
            PG8_LDB(B0, 0, 0); PG8_LDB(B1, 0, 1); PG8_SCHED; PG8_LDA(At, 0, 0); PG8_STAGE(PG8_SA(1, 1), a1 + hstep, voffA);
            PG8_WAIT_V(8); PG8_WAIT_L(0); PG8_BAR; PG8_MMA(0, 0, At, B0); PG8_MMA(0, 1, At, B1); PG8_BAR; PG8_SCHED;
            PG8_LDA(At, 0, 1); PG8_STAGE(PG8_SB(0, 0), b2, voffB); PG8_STAGE(PG8_SB(0, 1), b2 + hstep, voffB); PG8_STAGE(PG8_SA(0, 0), a2, voffA);
            PG8_WAIT_V(8); PG8_WAIT_L(0); PG8_BAR; PG8_MMA(1, 0, At, B0); PG8_MMA(1, 1, At, B1); PG8_BAR; PG8_SCHED;
            PG8_LDB(B0, 1, 0); PG8_LDB(B1, 1, 1); PG8_SCHED; PG8_LDA(At, 1, 0); PG8_STAGE(PG8_SA(0, 1), a2 + hstep, voffA);
            PG8_WAIT_V(8); PG8_WAIT_L(0); PG8_BAR; PG8_MMA(0, 0, At, B0); PG8_MMA(0, 1, At, B1); PG8_BAR; PG8_SCHED;
            PG8_LDA(At, 1, 1); PG8_STAGE(PG8_SB(1, 0), b3, voffB); PG8_STAGE(PG8_SB(1, 1), b3 + hstep, voffB); PG8_STAGE(PG8_SA(1, 0), a3, voffA);
            PG8_WAIT_V(8); PG8_WAIT_L(0); PG8_BAR; PG8_MMA(1, 0, At, B0); PG8_MMA(1, 1, At, B1); PG8_BAR; PG8_SCHED;
            } else {
            PG8_LDB(B0, 0, 0); PG8_SCHED; PG8_LDA(At, 0, 0); PG8_STAGE(PG8_SA(1, 1), a1 + hstep, voffA);
            PG8_WAIT_L(8); PG8_BAR; PG8_WAIT_L(0); PG8_MMA(0, 0, At, B0); PG8_BAR; PG8_SCHED;
            PG8_LDB(B1, 0, 1); PG8_STAGE(PG8_SB(0, 0), b2, voffB);
            PG8_BAR; PG8_WAIT_L(0); PG8_MMA(0, 1, At, B1); PG8_BAR;
            PG8_LDA(At, 0, 1); PG8_STAGE(PG8_SA(0, 0), a2, voffA);
            PG8_BAR; PG8_WAIT_L(0); PG8_MMA(1, 0, At, B0); PG8_BAR; PG8_SCHED;
            PG8_STAGE(PG8_SB(0, 1), b2 + hstep, voffB);
            PG8_WAIT_V(6); PG8_BAR; PG8_MMA(1, 1, At, B1); PG8_BAR;
            PG8_LDB(B0, 1, 0); PG8_SCHED; PG8_LDA(At, 1, 0); PG8_STAGE(PG8_SA(0, 1), a2 + hstep, voffA);
            PG8_WAIT_L(8); PG8_BAR; PG8_WAIT_L(0); PG8_MMA(0, 0, At, B0); PG8_BAR; PG8_SCHED;
            PG8_LDB(B1, 1, 1); PG8_STAGE(PG8_SB(1, 0), b3, voffB);
            PG8_BAR; PG8_WAIT_L(0); PG8_MMA(0, 1, At, B1); PG8_BAR;
            PG8_LDA(At, 1, 1); PG8_STAGE(PG8_SA(1, 0), a3, voffA);
            PG8_BAR; PG8_WAIT_L(0); PG8_MMA(1, 0, At, B0); PG8_BAR; PG8_SCHED;
            PG8_STAGE(PG8_SB(1, 1), b3 + hstep, voffB);
            PG8_WAIT_V(6); PG8_BAR; PG8_MMA(1, 1, At, B1); PG8_BAR;
            }
        }
        if constexpr (ALIGN_EPI) { if (wr == 0) PG8_BAR; }
        if constexpr (!Epi::AFTER_DRAIN) { E(acc, cur, wr, wc, fr, fq); S.done(cur); }
        if (!has_next) break;
#pragma unroll
        for (int a = 0; a < 2; ++a)
#pragma unroll
            for (int b = 0; b < 2; ++b)
#pragma unroll
                for (int m = 0; m < 4; ++m)
#pragma unroll
                    for (int n = 0; n < 2; ++n) acc[a][b][m][n] = (f32x4){0.f, 0.f, 0.f, 0.f};
        cur = nxt; cA = nA; cB = nB; ++ui;
        if constexpr (ALIGN_EPI) { if (wr == 1) PG8_BAR; }
    }
    PG8_WAIT_V(0);
    if constexpr (!ALIGN_EPI) { if (wr == 0) PG8_BAR; }
    PG8_BAR;
    if constexpr (Epi::AFTER_DRAIN) { E.fused(acc, cur, wr, wc, fr, fq, lds, wid, lane); S.done(cur); }
#undef PG8_SA
#undef PG8_SB
#undef PG8_STAGE
#undef PG8_LDA
#undef PG8_LDB
#undef PG8_MMA
#undef PG8_WAIT_V
#undef PG8_WAIT_L
#undef PG8_BAR
#undef PG8_SCHED
}
}

#ifndef PG8_SP2
#define PG8_SP2 true
#endif
#ifndef PG8_ALIGN
#define PG8_ALIGN true
#endif
#include <hip/hip_bf16.h>
#include <cmath>
namespace attn_body {
using bf16=__hip_bfloat16;
using bf16x8=__attribute__((ext_vector_type(8)))short;
using s16x4=__attribute__((ext_vector_type(4)))short;
using f32x16=__attribute__((ext_vector_type(16)))float;
using u32x4=__attribute__((ext_vector_type(4)))unsigned;
constexpr int D=64;
constexpr int NW=8,QBLK=32,QB=QBLK*NW,KVBLK=64;
__device__ __forceinline__ int crow(int r,int hi){return (r&3)+8*(r>>2)+4*hi;}
#define SBAR() __builtin_amdgcn_sched_barrier(0)
__device__ __forceinline__ void cmask(f32x16&p0,f32x16&p1,int jb,int qrel,int hi){
  const float NEG=-INFINITY; int kb=64*jb+4*hi;
  #pragma unroll
  for(int r=0;r<16;++r){int kv=kb+(r&3)+8*(r>>2); if(kv>qrel)p0[r]=NEG; if(kv+32>qrel)p1[r]=NEG;}
}

constexpr int NSLOT=3, SLOTB=8192;
constexpr int LDS_K=0, LDS_V=NSLOT*SLOTB, LDS_WS=2*NSLOT*SLOTB, LDS_OST=LDS_WS+NW*64*4, LDS_BYTES=LDS_OST+NW*4096;
constexpr float C2=0.125f*1.4426950408889634f;
__device__ __forceinline__ void glds16(const void*gsrc,unsigned lds_dst){unsigned keep;
  asm volatile("s_mov_b32 %0, m0\n\ts_mov_b32 m0, %2\n\ts_nop 0\n\tglobal_load_lds_dwordx4 %1, off\n\ts_mov_b32 m0, %0":"=&s"(keep):"v"(gsrc),"s"(lds_dst):"memory");}
__device__ __forceinline__ float max3f(float a,float b,float c){float r;asm("v_max3_f32 %0, %1, %2, %3":"=v"(r):"v"(a),"v"(b),"v"(c));return r;}
__device__ __forceinline__ float max2f(float a,float b){float r;asm("v_max_f32_e32 %0, %1, %2":"=v"(r):"v"(a),"v"(b));return r;}
__device__ __forceinline__ float fadd_s(float a,float b){float r;asm("v_add_f32_e32 %0, %1, %2":"=v"(r):"v"(a),"v"(b));return r;}
__device__ __forceinline__ float fsub_s(float a,float b){float r;asm("v_sub_f32_e32 %0, %1, %2":"=v"(r):"v"(a),"v"(b));return r;}
typedef float f32x2_t __attribute__((ext_vector_type(2))); typedef __bf16 bf16x2_t __attribute__((ext_vector_type(2)));
__device__ __forceinline__ unsigned cvtpk_s(float lo,float hi){f32x2_t v={lo,hi};bf16x2_t b=__builtin_convertvector(v,bf16x2_t);return __builtin_bit_cast(unsigned,b);}
#define WAIT_BAR(N) asm volatile("s_waitcnt vmcnt(" #N ") lgkmcnt(0)\n\ts_barrier":::"memory")

__device__ __forceinline__ void qkt(f32x16&p0,f32x16&p1,const char*Kslot,const bf16x8*qr,const f32x16&negm,int r32,int hi){
  const char*kb=Kslot+hi*1024+r32*16;
  #pragma unroll
  for(int d0=0;d0<4;++d0){
    const bf16x8 b0=*reinterpret_cast<const bf16x8*>(kb+d0*2048);
    const bf16x8 b1=*reinterpret_cast<const bf16x8*>(kb+d0*2048+512);
    if(d0==0){p0=__builtin_amdgcn_mfma_f32_32x32x16_bf16(b0,qr[0],negm,0,0,0);p1=__builtin_amdgcn_mfma_f32_32x32x16_bf16(b1,qr[0],negm,0,0,0);}
    else{p0=__builtin_amdgcn_mfma_f32_32x32x16_bf16(b0,qr[d0],p0,0,0,0);p1=__builtin_amdgcn_mfma_f32_32x32x16_bf16(b1,qr[d0],p1,0,0,0);}}
}
typedef __attribute__((address_space(3))) const char* lds_cptr;
typedef short v4i16_t __attribute__((ext_vector_type(4)));
__device__ __forceinline__ void kload8(bf16x8*kf,lds_cptr kp){
  kf[0]=*(const __attribute__((address_space(3))) bf16x8*)(kp);      kf[1]=*(const __attribute__((address_space(3))) bf16x8*)(kp+512);
  kf[2]=*(const __attribute__((address_space(3))) bf16x8*)(kp+2048); kf[3]=*(const __attribute__((address_space(3))) bf16x8*)(kp+2560);
  kf[4]=*(const __attribute__((address_space(3))) bf16x8*)(kp+4096); kf[5]=*(const __attribute__((address_space(3))) bf16x8*)(kp+4608);
  kf[6]=*(const __attribute__((address_space(3))) bf16x8*)(kp+6144); kf[7]=*(const __attribute__((address_space(3))) bf16x8*)(kp+6656);
}
__device__ __forceinline__ void kload2(bf16x8*kf,lds_cptr kp,int j){ kf[2*j]=*(const __attribute__((address_space(3))) bf16x8*)(kp+j*2048); kf[2*j+1]=*(const __attribute__((address_space(3))) bf16x8*)(kp+j*2048+512); }
__device__ __forceinline__ s16x4 vtr(lds_cptr p){ return __builtin_bit_cast(s16x4,__builtin_amdgcn_ds_read_tr16_b64_v4i16((__attribute__((address_space(3))) v4i16_t*)p)); }
__device__ __forceinline__ float rowmax(const f32x16&p0,const f32x16&p1){
  float a=max3f(p0[0],p0[1],p1[0]),b=max3f(p0[2],p0[3],p1[1]);a=max3f(a,p1[2],p1[3]);
  #pragma unroll
  for(int r=4;r<16;r+=4){a=max3f(a,p0[r],p0[r+1]);b=max3f(b,p0[r+2],p0[r+3]);a=max3f(a,p1[r],p1[r+1]);b=max3f(b,p1[r+2],p1[r+3]);}
  const float m=max2f(a,b);
  auto rr=__builtin_amdgcn_permlane32_swap(__float_as_uint(m),__float_as_uint(m),false,false);
  return max2f(__uint_as_float(rr[0]),__uint_as_float(rr[1]));
}
__device__ __forceinline__ void pv(f32x16*o,int vb,bf16x8 pa0,bf16x8 pa1,bf16x8 pa2,bf16x8 pa3){
  #pragma unroll
  for(int d0=0;d0<2;++d0){s16x4 lo[4],hi[4];
    #pragma unroll
    for(int ks=0;ks<4;++ks){
      asm volatile("ds_read_b64_tr_b16 %0,%1 offset:%c2":"=&v"(lo[ks]):"v"(vb),"i"(d0*4096+ks*1024):"memory");
      asm volatile("ds_read_b64_tr_b16 %0,%1 offset:%c2":"=&v"(hi[ks]):"v"(vb),"i"(d0*4096+ks*1024+512):"memory");}
    asm volatile("s_waitcnt lgkmcnt(0)":::"memory");SBAR();
    #define PK(k) (bf16x8){lo[k][0],lo[k][1],lo[k][2],lo[k][3],hi[k][0],hi[k][1],hi[k][2],hi[k][3]}
    o[d0]=__builtin_amdgcn_mfma_f32_32x32x16_bf16(pa0,PK(0),o[d0],0,0,0);
    o[d0]=__builtin_amdgcn_mfma_f32_32x32x16_bf16(pa1,PK(1),o[d0],0,0,0);
    o[d0]=__builtin_amdgcn_mfma_f32_32x32x16_bf16(pa2,PK(2),o[d0],0,0,0);
    o[d0]=__builtin_amdgcn_mfma_f32_32x32x16_bf16(pa3,PK(3),o[d0],0,0,0);
    #undef PK
  }
}

#ifndef ATTN_STORE16
#define ATTN_STORE16(p,v) (*(u32x4*)(p)=(v))
#endif
template<int THRL> __device__ __forceinline__ void attn_unit(int qb,int SEQ,const bf16*Q,int QP,const bf16*__restrict__ K,const bf16*__restrict__ V,int KP,bf16*O,int OP,char*shm){
  int tid_=threadIdx.x; asm volatile("":"+v"(tid_)); const int tid=tid_,lane=tid&63,r32=lane&31,hi=lane>>5; const int wid=__builtin_amdgcn_readfirstlane(tid>>6);
  const int q0=qb*QB;
  const bf16*Qw=Q+(long)(q0+wid*QBLK)*QP;
  const bf16*Kh=K,*Vh=V;
  const unsigned lds0=(unsigned)(uintptr_t)shm;
  float*wsf=(float*)(shm+LDS_WS)+wid*64;
  const bf16*ksrc=Kh+(long)lane*KP+wid*8;
  const bf16*vsrc=Vh+(long)(16*(wid&3)+(lane>>2))*KP+(wid>>2)*32+(lane&3)*8;
  const unsigned kdst=lds0+LDS_K+wid*1024, vdst=lds0+LDS_V+wid*1024;
  #define DMA_K(t,slot) glds16(ksrc+(long)(t)*KVBLK*KP,(unsigned)__builtin_amdgcn_readfirstlane(kdst+(slot)))
  #define DMA_V(t,slot) glds16(vsrc+(long)(t)*KVBLK*KP,(unsigned)__builtin_amdgcn_readfirstlane(vdst+(slot)))
  const int vb0=(int)(lds0+LDS_V)+((lane>>4)&1)*32+(lane&3)*8+(4*hi+((lane&15)>>2))*64;
  const char*Kbase=shm+LDS_K; bf16x8 kf[8];
  const lds_cptr shm3=(lds_cptr)shm; const lds_cptr kp0=shm3+LDS_K+hi*1024+r32*16; const lds_cptr vp0=shm3+LDS_V+((lane>>4)&1)*32+(lane&3)*8+(4*hi+((lane&15)>>2))*64;
  const int NT=SEQ/KVBLK;
  DMA_K(0,0);DMA_V(0,0);DMA_K(1,SLOTB);
  bf16x8 qr[4];
  #pragma unroll
  for(int d0=0;d0<4;++d0)qr[d0]=*reinterpret_cast<const bf16x8*>(&Qw[(long)r32*QP+d0*16+hi*8]);
  float mhat=0.f,l_reg=0.f;f32x16 o[2];o[0]=f32x16{};o[1]=f32x16{};f32x16 negm=f32x16{};asm volatile("":"+v"(negm));
  const int qrel=wid*QBLK+r32;
  #define CMASK(P0,P1,t) do{}while(0)
  bool resc=false;
  #define START(P0,P1) do{ const float rm=rowmax(P0,P1); resc=false; \
    { const float dl=rm; mhat=fadd_s(mhat,dl); \
      _Pragma("unroll") for(int r=0;r<16;++r){P0[r]=fsub_s(P0[r],dl);P1[r]=fsub_s(P1[r],dl);} \
      _Pragma("unroll") for(int r=0;r<16;++r)negm[r]=-mhat; asm volatile("":"+v"(negm)); } \
    _Pragma("unroll") for(int r=0;r<16;++r)P0[r]=__builtin_amdgcn_exp2f(P0[r]); }while(0)
  #define RESC() do{ if(resc){ asm volatile("s_waitcnt lgkmcnt(0)":::"memory"); \
      _Pragma("unroll") for(int d_=0;d_<2;++d_) _Pragma("unroll") for(int r=0;r<16;++r)o[d_][r]*=wsf[crow(r,hi)]; } }while(0)
  f32x16 pA0,pA1,pB0,pB1;
  int sl_prev=0,sl_cur=0,sl_next=SLOTB;
  #define ROT() do{sl_prev=sl_cur;sl_cur=sl_next;sl_next=(sl_next==(NSLOT-1)*SLOTB)?0:sl_next+SLOTB;}while(0)
  DMA_K(2,2*SLOTB);
  WAIT_BAR(3);
  qkt(pA0,pA1,Kbase,qr,negm,r32,hi);asm volatile("s_nop 15\n\ts_nop 7":"+v"(pA0),"+v"(pA1));CMASK(pA0,pA1,0);
  START(pA0,pA1);
  _Pragma("unroll") for(int r=0;r<16;++r)pA1[r]=__builtin_amdgcn_exp2f(pA1[r]);
  WAIT_BAR(0);
  DMA_K(3,0);DMA_V(1,SLOTB);
  ROT();
  kload8(kf,kp0+sl_cur);
  WAIT_BAR(2);
  s16x4 vlo[8],vhi[8]; u32x4 pw0,pw1,pw2,pw3;
  #define PKW(P,B) cvtpk_s(P[B],P[B+1])
  #define PAF(k) __builtin_bit_cast(bf16x8,pw##k)
  #define VFR(i) (bf16x8){vlo[i][0],vlo[i][1],vlo[i][2],vlo[i][3],vhi[i][0],vhi[i][1],vhi[i][2],vhi[i][3]}
  #define PIN(x) asm volatile("":"+v"(x))
  #define MX3(a,b,c) __builtin_fmaxf(__builtin_fmaxf((a),(b)),(c))
  #define GAPA(MF,A0,A1,A2,A3,W0,W1,PW) do{ MF; sacc+=A0; sacc+=A1; sacc+=A2; sacc+=A3; PIN(sacc); W0; W1; PIN(PW); SBAR(); }while(0)
  #define EX(v) __builtin_amdgcn_exp2f(v)
  #define GAPB(MF,X,B) do{ MF; X[B]=EX(X[B]); X[B+1]=EX(X[B+1]); X[B+2]=EX(X[B+2]); X[B+3]=EX(X[B+3]); PIN(X); SBAR(); }while(0)
  #define VRD(i) do{ vlo[i]=vtr(vp_+(((i)>>2)*4096+((i)&3)*1024)); vhi[i]=vtr(vp_+(((i)>>2)*4096+((i)&3)*1024+512)); }while(0)
  #define KRD(G,j) do{ if(G){ kload2(kf,kp0+sl_next,j); SBAR(); } }while(0)
  #define STEP(C0,C1,P0,P1,t,GK,GV,GL) do{ SBAR(); \
    const lds_cptr vp_=vp0+sl_prev; \
    VRD(0); SBAR(); float sacc=(P0[0]+P0[1]); \
    GAPA(C0=__builtin_amdgcn_mfma_f32_32x32x16_bf16(kf[0],qr[0],negm,0,0,0), P0[2],P0[3],P0[4],P0[5],     pw0[0]=PKW(P0,0), pw0[1]=PKW(P0,2), pw0); \
    VRD(4); SBAR(); GAPA(C1=__builtin_amdgcn_mfma_f32_32x32x16_bf16(kf[1],qr[0],negm,0,0,0), P0[6],P0[7],P0[8],P0[9],     pw0[2]=PKW(P0,4), pw0[3]=PKW(P0,6), pw0); \
    VRD(1); SBAR(); GAPA(C0=__builtin_amdgcn_mfma_f32_32x32x16_bf16(kf[2],qr[1],C0,0,0,0),   P0[10],P0[11],P0[12],P0[13], pw1[0]=PKW(P0,8), pw1[1]=PKW(P0,10), pw1); \
    VRD(5); SBAR(); GAPA(C1=__builtin_amdgcn_mfma_f32_32x32x16_bf16(kf[3],qr[1],C1,0,0,0),   P0[14],P0[15],P1[0],P1[1],   pw1[2]=PKW(P0,12),pw1[3]=PKW(P0,14), pw1); \
    VRD(2); SBAR(); GAPA(C0=__builtin_amdgcn_mfma_f32_32x32x16_bf16(kf[4],qr[2],C0,0,0,0),   P1[2],P1[3],P1[4],P1[5],     pw2[0]=PKW(P1,0), pw2[1]=PKW(P1,2), pw2); \
    VRD(6); SBAR(); GAPA(C1=__builtin_amdgcn_mfma_f32_32x32x16_bf16(kf[5],qr[2],C1,0,0,0),   P1[6],P1[7],P1[8],P1[9],     pw2[2]=PKW(P1,4), pw2[3]=PKW(P1,6), pw2); \
    VRD(3); SBAR(); GAPA(C0=__builtin_amdgcn_mfma_f32_32x32x16_bf16(kf[6],qr[3],C0,0,0,0),   P1[10],P1[11],P1[12],P1[13], pw3[0]=PKW(P1,8), pw3[1]=PKW(P1,10), pw3); \
    VRD(7); SBAR(); GAPA(C1=__builtin_amdgcn_mfma_f32_32x32x16_bf16(kf[7],qr[3],C1,0,0,0),   P1[14],P1[15],0.f,0.f,       pw3[2]=PKW(P1,12),pw3[3]=PKW(P1,14), pw3); \
    l_reg+=sacc; \
    if(GK){DMA_K((t)+3,sl_cur);} if(GV){DMA_V((t)+1,sl_next);} \
    CMASK(C0,C1,t); \
    { float a=MX3(C0[0],C0[1],C1[0]),b=MX3(C0[2],C0[3],C1[1]); a=MX3(a,C1[2],C1[3]); \
      _Pragma("unroll") for(int r=4;r<16;r+=4){a=MX3(a,C0[r],C0[r+1]);b=MX3(b,C0[r+2],C0[r+3]);a=MX3(a,C1[r],C1[r+1]);b=MX3(b,C1[r+2],C1[r+3]);} \
      float rm=__builtin_fmaxf(a,b); { auto rr=__builtin_amdgcn_permlane32_swap(__float_as_uint(rm),__float_as_uint(rm),false,false); rm=__builtin_fmaxf(__uint_as_float(rr[0]),__uint_as_float(rr[1])); } \
      resc=false; \
      if(__builtin_expect(__any(rm>(float)THRL),0)){ const float dl=__builtin_fmaxf(rm,0.f); mhat+=dl; \
        _Pragma("unroll") for(int r=0;r<16;++r){C0[r]-=dl;C1[r]-=dl;} \
        _Pragma("unroll") for(int r=0;r<16;++r)negm[r]=-mhat; asm volatile("":"+v"(negm)); \
        const float f=__builtin_amdgcn_exp2f(-dl); l_reg*=f; if(hi==0)wsf[r32]=f; resc=true; } } \
    SBAR(); \
    GAPB(o[0]=__builtin_amdgcn_mfma_f32_32x32x16_bf16(PAF(0),VFR(0),o[0],0,0,0), C0,0); \
    GAPB(o[1]=__builtin_amdgcn_mfma_f32_32x32x16_bf16(PAF(0),VFR(4),o[1],0,0,0), C0,4); \
    KRD(GL,0); GAPB(o[0]=__builtin_amdgcn_mfma_f32_32x32x16_bf16(PAF(1),VFR(1),o[0],0,0,0), C0,8); \
    KRD(GL,1); GAPB(o[1]=__builtin_amdgcn_mfma_f32_32x32x16_bf16(PAF(1),VFR(5),o[1],0,0,0), C0,12); \
    KRD(GL,2); GAPB(o[0]=__builtin_amdgcn_mfma_f32_32x32x16_bf16(PAF(2),VFR(2),o[0],0,0,0), C1,0); \
    KRD(GL,3); GAPB(o[1]=__builtin_amdgcn_mfma_f32_32x32x16_bf16(PAF(2),VFR(6),o[1],0,0,0), C1,4); \
    GAPB(o[0]=__builtin_amdgcn_mfma_f32_32x32x16_bf16(PAF(3),VFR(3),o[0],0,0,0), C1,8); \
    GAPB(o[1]=__builtin_amdgcn_mfma_f32_32x32x16_bf16(PAF(3),VFR(7),o[1],0,0,0), C1,12); \
    }while(0)
  int t=1;
  #undef CMASK
  #define CMASK(P0,P1,t) do{}while(0)
  for(;t+5<NT;t+=2){
    STEP(pB0,pB1,pA0,pA1,t,true,true,true);     WAIT_BAR(2); RESC(); ROT();
    STEP(pA0,pA1,pB0,pB1,t+1,true,true,true);   WAIT_BAR(2); RESC(); ROT();
  }
  #undef CMASK
  #define CMASK(P0,P1,t) do{}while(0)
  #define ENDW(tt) do{ if((tt)+3<NT){WAIT_BAR(2);} else if((tt)+2<NT){WAIT_BAR(1);} else {WAIT_BAR(0);} }while(0)
  for(;t+1<NT;t+=2){
    STEP(pB0,pB1,pA0,pA1,t,(t+3<NT),(t+1<NT),(t+1<NT));       ENDW(t);   RESC(); ROT();
    STEP(pA0,pA1,pB0,pB1,t+1,(t+4<NT),(t+2<NT),(t+2<NT));     ENDW(t+1); RESC(); ROT();
  }
  STEP(pB0,pB1,pA0,pA1,NT-1,false,false,false); RESC();
  { float sacc=pB0[0]+pB0[1]; _Pragma("unroll") for(int r=2;r<16;++r)sacc+=pB0[r]; _Pragma("unroll") for(int r=0;r<16;++r)sacc+=pB1[r]; l_reg+=sacc;
    pw0=(u32x4){PKW(pB0,0),PKW(pB0,2),PKW(pB0,4),PKW(pB0,6)};pw1=(u32x4){PKW(pB0,8),PKW(pB0,10),PKW(pB0,12),PKW(pB0,14)};pw2=(u32x4){PKW(pB1,0),PKW(pB1,2),PKW(pB1,4),PKW(pB1,6)};pw3=(u32x4){PKW(pB1,8),PKW(pB1,10),PKW(pB1,12),PKW(pB1,14)};
    SBAR(); pv(o,vb0+sl_cur,PAF(0),PAF(1),PAF(2),PAF(3)); }
  #undef PKW
  #undef PAF
  #undef VFR
  #undef PIN
  #undef MX3
  #undef GAPA
  #undef GAPB
  #undef EX
  #undef VRD
  #undef KRD
  #undef STEP
  #undef ENDW
  {auto rr=__builtin_amdgcn_permlane32_swap(__float_as_uint(l_reg),__float_as_uint(l_reg),false,false);l_reg=__uint_as_float(rr[0])+__uint_as_float(rr[1]);}
  if(hi==0)wsf[32+r32]=l_reg;asm volatile("s_waitcnt lgkmcnt(0)":::"memory");
  float rli[16];
  #pragma unroll
  for(int r=0;r<16;++r)rli[r]=__builtin_amdgcn_rcpf(wsf[32+crow(r,hi)]);
  bf16*Ow=O+(long)(q0+wid*QBLK)*OP;
  { bf16*stg=(bf16*)(shm+LDS_OST)+wid*2048;
    #pragma unroll
    for(int r=0;r<16;++r){const int orow=crow(r,hi);
      #pragma unroll
      for(int d0=0;d0<2;++d0)stg[orow*64+d0*32+r32]=__float2bfloat16(o[d0][r]*rli[r]);}
    asm volatile("s_waitcnt lgkmcnt(0)":::"memory");
    #pragma unroll
    for(int i=0;i<4;++i){const int row=i*8+(lane>>3),ch=lane&7; const u32x4 v=*(const u32x4*)(stg+row*64+ch*8); ATTN_STORE16(Ow+(long)row*OP+ch*8,v);} }
  asm volatile("s_waitcnt lgkmcnt(0)\n\ts_barrier":::"memory");
  #undef DMA_K
  #undef DMA_V
  #undef CMASK
  #undef START
  #undef RESC
  #undef ROT
}
constexpr int ATTN_LDS_BYTES=LDS_BYTES;
#undef SBAR
#undef WAIT_BAR
}
namespace xb {
#define GAS __attribute__((address_space(1)))
#define LAS __attribute__((address_space(3)))
typedef GAS unsigned gu32;
typedef GAS unsigned long long gu64;
#define RLX_AGENT __ATOMIC_RELAXED, __HIP_MEMORY_SCOPE_AGENT
#define LDS_WAIT() asm volatile("s_waitcnt lgkmcnt(0)" ::: "memory")
#define VM_WAIT() asm volatile("s_waitcnt vmcnt(0)" ::: "memory")
__device__ __forceinline__ unsigned long long rt() { return __builtin_amdgcn_s_memrealtime(); }
__device__ __forceinline__ unsigned f2bf(float f) { unsigned u = __builtin_bit_cast(unsigned, f); return (u + 0x7fffu + ((u >> 16) & 1u)) >> 16; }
__device__ __forceinline__ unsigned pk2(float lo, float hi) { return f2bf(lo) | (f2bf(hi) << 16); }

#define XB_TMO      128
#define XB_XCNT(j)  (256  + 64 * (j))
#define XB_XSUB(j)  (1280 + 64 * (j))
#define XB_XGEN(j)  (2304 + 64 * (j))
#define XB_TOP      3328
#define XB_TOPGEN   3392
#define XCD_BAR_WORDS 3456
#define XB_SPIN_CAP (1u << 18)

__device__ __forceinline__ unsigned xb_ld(unsigned* p)              { return __hip_atomic_load(p, __ATOMIC_RELAXED, __HIP_MEMORY_SCOPE_AGENT); }
__device__ __forceinline__ unsigned xb_add(unsigned* p, unsigned v) { return __hip_atomic_fetch_add(p, v, __ATOMIC_RELAXED, __HIP_MEMORY_SCOPE_AGENT); }
__device__ __forceinline__ unsigned xb_xcc_id() { return (unsigned)__builtin_amdgcn_s_getreg((3 << 11) | 20) & 0xFu; }
#define XB_SPIN(cond, bar) do { unsigned _sp = 0; while (cond) { __builtin_amdgcn_s_sleep(1); \
    if ((++_sp & 255u) == 0u) { if (xb_ld(&(bar)[XB_TMO])) break; if (_sp > XB_SPIN_CAP) { atomicAdd(&(bar)[XB_TMO], 1u); break; } } } } while (0)

struct XcdBarrier {
    unsigned* bar; unsigned x;
    volatile LAS unsigned* st;
};

__device__ __forceinline__ XcdBarrier xcd_barrier_post(unsigned* bar, volatile LAS unsigned* st) {
    XcdBarrier b; b.bar = bar; b.x = xb_xcc_id(); b.st = st;
    if (threadIdx.x == 0) (void)xb_add(&bar[XB_XCNT(b.x)], 1u);
    return b;
}
__device__ __forceinline__ void xcd_barrier_complete(unsigned* bar, unsigned x, unsigned& nloc, unsigned& nx) {
    const unsigned G = gridDim.x * gridDim.y * gridDim.z;
    unsigned sum, cnt, mine, sp = 0u;
    for (;;) {
        sum = 0u; cnt = 0u; mine = 0u;
#pragma unroll
        for (unsigned j = 0; j < 16; ++j) { const unsigned c = xb_ld(&bar[XB_XCNT(j)]); sum += c; cnt += (c > 0u) ? 1u : 0u; mine = (j == x) ? c : mine; }
        if (sum == G) break;
        __builtin_amdgcn_s_sleep(1);
        if ((++sp & 255u) == 0u) { if (xb_ld(&bar[XB_TMO])) break; if (sp > XB_SPIN_CAP) { atomicAdd(&bar[XB_TMO], 1u); break; } }
    }
    nloc = mine > 0u ? mine : 1u; nx = cnt > 0u ? cnt : 1u;
}

__device__ __forceinline__ void xcd_barrier(const XcdBarrier& b) {
    asm volatile("s_waitcnt vmcnt(0)" ::: "memory");
    __syncthreads();
    if (threadIdx.x == 0) {
        unsigned* bar = b.bar;
        __builtin_amdgcn_s_waitcnt(0);
        unsigned nloc = b.st[0], nx = b.st[1];
        if (nloc == 0u) { xcd_barrier_complete(bar, b.x, nloc, nx); b.st[0] = nloc; b.st[1] = nx; }
        const unsigned old = xb_add(&bar[XB_XSUB(b.x)], 1u);
        const unsigned gen = old / nloc;
        if (old + 1u == (gen + 1u) * nloc) {
            __builtin_amdgcn_fence(__ATOMIC_RELEASE, "agent");
            asm volatile("s_waitcnt vmcnt(0)" ::: "memory");
            const unsigned og = xb_add(&bar[XB_TOP], 1u);
            const unsigned tg = og / nx;
            if (og + 1u == (tg + 1u) * nx) xb_add(&bar[XB_TOPGEN], 1u);
            else XB_SPIN(xb_ld(&bar[XB_TOPGEN]) == tg, bar);
            __builtin_amdgcn_fence(__ATOMIC_ACQUIRE, "agent");
            xb_add(&bar[XB_XGEN(b.x)], 1u);
            asm volatile("s_waitcnt vmcnt(0)" ::: "memory");
        } else {
            XB_SPIN(xb_ld(&bar[XB_XGEN(b.x)]) == gen, bar);
            __builtin_amdgcn_fence(__ATOMIC_ACQUIRE, "agent");
            asm volatile("s_waitcnt vmcnt(0)" ::: "memory");
        }
    }
    __syncthreads();
}

}

namespace mk {
typedef unsigned short bf16_t;
typedef short bf16x8 __attribute__((ext_vector_type(8)));
typedef float f32x4 __attribute__((ext_vector_type(4)));
typedef unsigned u32x4 __attribute__((ext_vector_type(4)));
typedef unsigned u32x2 __attribute__((ext_vector_type(2)));
typedef float f32x2 __attribute__((ext_vector_type(2)));

constexpr int DMODEL = 1024, TS = 16384, NSEG = 4, DFF = 4096;
constexpr int EIN = 1792, OIN = 4368, OINP = 4608, OOUT = 768;
constexpr float EPS = 1e-6f;
constexpr size_t MiB = (size_t)1 << 20;
constexpr size_t WS_W1T = 1 * MiB, WS_W2T = 33 * MiB, WS_WINE = 65 * MiB, WS_WOUTE = 72 * MiB, WS_WINO = 76 * MiB, WS_WOUTO = 94 * MiB,
                 WS_GW = 97 * MiB, WS_H = 98 * MiB, WS_PROJ = 130 * MiB, WS_SCR = 274 * MiB, WS_END = 512 * MiB;
constexpr size_t SC_HID = 0;
constexpr size_t SC_LA = 0, SC_UU = 64 * MiB, SC_AGG = 128 * MiB;
constexpr size_t SC_QKVP = 0, SC_DNI = 48 * MiB, SC_OB = 192 * MiB, SC_LSE = 224 * MiB, SC_EGL = 225 * MiB;
constexpr int DNI_BYTES = 73728, DNI_W = 0, DNI_QT = 16384, DNI_KTT = 32768, DNI_A = 49152, DNI_U = 57344;
constexpr int LDS_BYTES = 147456;
constexpr int NT = 512, NW = 8;

struct Params { const float* in[25]; float* out; unsigned char* ws; };

__device__ __forceinline__ float bf2f(bf16_t v) { return __uint_as_float(((unsigned)v) << 16); }
__device__ __forceinline__ unsigned f2bf(float f) { unsigned u = __float_as_uint(f); return (u + 0x7fffu + ((u >> 16) & 1u)) >> 16; }
__device__ __forceinline__ unsigned pk2(float lo, float hi) { return f2bf(lo) | (f2bf(hi) << 16); }
__device__ __forceinline__ float wave_sum(float v) {
#pragma unroll
    for (int o = 1; o < 64; o <<= 1) v += __shfl_xor(v, o);
    return v;
}
__device__ __forceinline__ float sigm(float x) { return 1.f / (1.f + __expf(-x)); }
__device__ __forceinline__ float softplus(float x) { return x > 20.f ? x : log1pf(__expf(x)); }
__device__ __forceinline__ float silu(float x) { return x * sigm(x); }
__device__ __forceinline__ float gelu_tanh(float x) { const float t = 0.7978845608028654f * (x + 0.044715f * x * x * x); return 0.5f * x * (1.f + tanhf(t)); }
__device__ __forceinline__ void unpack8(const u32x4 v, float* f) {
    f[0] = __uint_as_float(v.x << 16); f[1] = __uint_as_float(v.x & 0xffff0000u); f[2] = __uint_as_float(v.y << 16); f[3] = __uint_as_float(v.y & 0xffff0000u);
    f[4] = __uint_as_float(v.z << 16); f[5] = __uint_as_float(v.z & 0xffff0000u); f[6] = __uint_as_float(v.w << 16); f[7] = __uint_as_float(v.w & 0xffff0000u);
}
#define MK_IDS() int tid = threadIdx.x; asm volatile("" : "+v"(tid)); const int lane = tid & 63, wave = __builtin_amdgcn_readfirstlane(tid >> 6); const int gw = blockIdx.x * NW + wave, NGW = gridDim.x * NW; (void)lane; (void)wave; (void)gw; (void)NGW
#define MFMA16(a, b, c) __builtin_amdgcn_mfma_f32_16x16x32_bf16((a), (b), (c), 0, 0, 0)

__device__ __forceinline__ void transpose_item(const float* W, int K, int Nsrc, int Npad, bf16_t* WT, float* scr, int item, int lane, const float* gain = nullptr) {
    const int nblk = Npad / 32, kb = item / nblk, nb = item % nblk, k0 = 64 * kb, n0 = 32 * nb;
    const int n = n0 + (lane & 31);
#pragma unroll 8
    for (int i = 0; i < 32; ++i) { const int kk = 2 * i + (lane >> 5); scr[kk * 33 + (lane & 31)] = (n < Nsrc) ? W[(size_t)(k0 + kk) * Nsrc + n] * (gain ? gain[k0 + kk] : 1.f) : 0.f; }
    asm volatile("s_waitcnt lgkmcnt(0)" ::: "memory");
    const int c = lane & 7;
#pragma unroll
    for (int j = 0; j < 4; ++j) { const int nn = (lane >> 3) + 8 * j; const float* s = scr + (8 * c) * 33 + nn;
        u32x4 o; o.x = pk2(s[0 * 33], s[1 * 33]); o.y = pk2(s[2 * 33], s[3 * 33]); o.z = pk2(s[4 * 33], s[5 * 33]); o.w = pk2(s[6 * 33], s[7 * 33]);
        *(u32x4*)(WT + (size_t)(n0 + nn) * K + k0 + 8 * c) = o; }
    asm volatile("s_waitcnt lgkmcnt(0)" ::: "memory");
}
__device__ __forceinline__ void phase_prologue(const Params& p, char* lds) {
    MK_IDS();
    float* scr = (float*)(lds + wave * 16384);
    unsigned char* ws = p.ws;
    constexpr int I_F1 = 16 * 128, I_F2 = 64 * 32, I_IE = 16 * 56, I_OE = 16 * 32, I_IO = 16 * 144, I_OO = 12 * 32;
    constexpr int T_F1 = 4 * I_F1, T_F2 = T_F1 + 4 * I_F2, T_IE = T_F2 + 2 * I_IE, T_OE = T_IE + 2 * I_OE, T_IO = T_OE + 2 * I_IO, T_OO = T_IO + 2 * I_OO;
    for (int it = gw; it < T_OO; it += NGW) {
        if (it < T_F1) { const int l = it / I_F1, r = it % I_F1; transpose_item(p.in[6] + (size_t)l * 1024 * 4096, 1024, 4096, 4096, (bf16_t*)(ws + WS_W1T) + (size_t)l * 4096 * 1024, scr, r, lane, p.in[4] + l * 1024); }
        else if (it < T_F2) { const int q = it - T_F1, l = q / I_F2, r = q % I_F2; transpose_item(p.in[7] + (size_t)l * 4096 * 1024, 4096, 1024, 1024, (bf16_t*)(ws + WS_W2T) + (size_t)l * 1024 * 4096, scr, r, lane); }
        else if (it < T_IE) { const int q = it - T_F2, l = q / I_IE, r = q % I_IE; transpose_item(p.in[8] + (size_t)l * 1024 * EIN, 1024, EIN, EIN, (bf16_t*)(ws + WS_WINE) + (size_t)l * EIN * 1024, scr, r, lane, p.in[3] + (2 * l) * 1024); }
        else if (it < T_OE) { const int q = it - T_IE, l = q / I_OE, r = q % I_OE; transpose_item(p.in[9] + (size_t)l * 1024 * 1024, 1024, 1024, 1024, (bf16_t*)(ws + WS_WOUTE) + (size_t)l * 1024 * 1024, scr, r, lane); }
        else if (it < T_IO) { const int q = it - T_OE, l = q / I_IO, r = q % I_IO; transpose_item(p.in[19] + (size_t)l * 1024 * OIN, 1024, OIN, OINP, (bf16_t*)(ws + WS_WINO) + (size_t)l * OINP * 1024, scr, r, lane, p.in[3] + (2 * l + 1) * 1024); }
        else { const int q = it - T_IO, l = q / I_OO, r = q % I_OO; transpose_item(p.in[20] + (size_t)l * OOUT * 1024, OOUT, 1024, 1024, (bf16_t*)(ws + WS_WOUTO) + (size_t)l * 1024 * OOUT, scr, r, lane); }
    }
    bf16_t* GW = (bf16_t*)(ws + WS_GW);
    const int gt = gw * 64 + lane, NGT = NGW * 64;
    for (int idx = gt; idx < 2 * 2 * 2 * 8 * 4096; idx += NGT) {
        const int d = idx & 63, e = (idx >> 6) & 63, blk = (idx >> 12) & 7, gate = (idx >> 15) & 1, dir = (idx >> 16) & 1, j = (idx >> 17) & 1;
        const float* src = gate ? p.in[16] : p.in[14];
        GW[idx] = (bf16_t)f2bf(src[((((size_t)j * 2 + dir) * 8 + blk) * 64 + d) * 64 + e]);
    }
}

__device__ __forceinline__ void phase_x0(const float* x, bf16_t* xb, float* ssq) {
    MK_IDS();
    for (int m = gw; m < TS; m += NGW) {
        const f32x4* xr = (const f32x4*)(x + (size_t)m * DMODEL) + lane;
        f32x4 v[4]; float s = 0.f;
#pragma unroll
        for (int j = 0; j < 4; ++j) { v[j] = xr[64 * j]; s += (v[j].x * v[j].x + v[j].y * v[j].y) + (v[j].z * v[j].z + v[j].w * v[j].w); }
        s = wave_sum(s);
        u32x2* o8 = (u32x2*)(xb + (size_t)m * DMODEL) + lane;
#pragma unroll
        for (int j = 0; j < 4; ++j) { u32x2 o; o.x = pk2(v[j].x, v[j].y); o.y = pk2(v[j].z, v[j].w); o8[64 * j] = o; }
        if (lane < 16) ssq[(size_t)m * 16 + lane] = lane == 0 ? s : 0.f;
    }
}
__device__ __forceinline__ void zero_f32(float* ptr, int n) {
    MK_IDS();
    for (int i = gw * 64 + lane; i < n; i += NGW * 64) ptr[i] = 0.f;
}
__device__ __forceinline__ void phase_rmsnorm_final(const bf16_t* xb, float* x, const float* g) {
    MK_IDS();
    for (int m = gw; m < TS; m += NGW) {
        const u32x2* xr = (const u32x2*)(xb + (size_t)m * DMODEL) + lane; f32x4* xw = (f32x4*)(x + (size_t)m * DMODEL) + lane; const f32x4* gr = (const f32x4*)g + lane;
        f32x4 v[4]; float s = 0.f;
#pragma unroll
        for (int j = 0; j < 4; ++j) { const u32x2 w = xr[64 * j]; v[j] = (f32x4){__uint_as_float(w.x << 16), __uint_as_float(w.x & 0xffff0000u), __uint_as_float(w.y << 16), __uint_as_float(w.y & 0xffff0000u)};
            s += (v[j].x * v[j].x + v[j].y * v[j].y) + (v[j].z * v[j].z + v[j].w * v[j].w); }
        const float rstd = 1.f / sqrtf(wave_sum(s) * (1.f / DMODEL) + EPS);
#pragma unroll
        for (int j = 0; j < 4; ++j) { const f32x4 gg = gr[64 * j]; xw[64 * j] = v[j] * rstd * gg; }
    }
}
struct EpiRes {
    static constexpr bool PERM = false, AFTER_DRAIN = false;
    bf16_t* xb; float* ssq; int ldc;
    __device__ __forceinline__ void operator()(const pg8::f32x4 (&acc)[2][2][4][2], const pg8::Unit& u, int wr, int wc, int fr, int fq) const {
        const int col0 = u.pn * pg8::BM + wc * 32 + 4 * fq;
#pragma unroll
        for (int ai = 0; ai < 2; ++ai)
#pragma unroll
            for (int m = 0; m < 4; ++m) { const int row = u.pm * pg8::BM + ai * pg8::HALF + wr * 64 + m * 16 + fr; const size_t off = (size_t)row * ldc + col0; float sq = 0.f;
                u32x2 bw[2][2];
#pragma unroll
                for (int bj = 0; bj < 2; ++bj)
#pragma unroll
                    for (int n = 0; n < 2; ++n) bw[bj][n] = *(const u32x2*)(xb + off + bj * pg8::HALF + n * 16);
#pragma unroll
                for (int bj = 0; bj < 2; ++bj)
#pragma unroll
                    for (int n = 0; n < 2; ++n) { const pg8::f32x4 a = acc[ai][bj][m][n];
                        const float o0 = __uint_as_float(bw[bj][n].x << 16) + a[0], o1 = __uint_as_float(bw[bj][n].x & 0xffff0000u) + a[1];
                        const float o2 = __uint_as_float(bw[bj][n].y << 16) + a[2], o3 = __uint_as_float(bw[bj][n].y & 0xffff0000u) + a[3];
                        u32x2 w; w.x = pg8::cvt_pk_bf16(o0, o1); w.y = pg8::cvt_pk_bf16(o2, o3); *(u32x2*)(xb + off + bj * pg8::HALF + n * 16) = w;
                        sq += (o0 * o0 + o1 * o1) + (o2 * o2 + o3 * o3); }
                sq += __shfl_xor(sq, 16); sq += __shfl_xor(sq, 32);
                if (fq == 0) ssq[(size_t)row * 16 + u.pn * 4 + wc] = sq;
                if (m & 1) asm volatile("" ::: "memory"); }
    }
};

__device__ __forceinline__ void even_qk_post(bf16_t* proj, const float* qg, const float* kg, int S) {
    MK_IDS();
    const int d = lane, axis = d >> 5, f = d & 15, half = (d >> 4) & 1;
    const float inv = exp2f(-(float)f * (13.287712379549449f / 16.f));
    const float gq = qg[d], gk = kg[d];
    for (int t = gw; t < TS; t += NGW) {
        const int s = t % S; const int pos = axis ? (s & 63) : (s >> 6);
        const float ang = (float)pos * inv; float sn, cs; sincosf(ang, &sn, &cs);
        bf16_t* row = proj + (size_t)t * EIN;
#pragma unroll
        for (int hh = 0; hh < 10; ++hh) {
            const int c0 = hh < 8 ? hh * 64 : 512 + (hh - 8) * 64;
            const float x = bf2f(row[c0 + d]);
            const float ss = wave_sum(x * x);
            const float y = x * (1.f / sqrtf(ss * (1.f / 64.f) + EPS)) * (hh < 8 ? gq : gk);
            const float pr = __shfl_xor(y, 16);
            float o = y * cs + (half ? pr : -pr) * sn;
            if (hh < 8) o *= attn_body::C2;
            row[c0 + d] = (bf16_t)f2bf(o);
        }
    }
}
__device__ __forceinline__ void even_lru_prep(const bf16_t* proj, const float* cw, const float* cb, const bf16_t* GWj, const float* br, const float* bi, const float* lam,
                                              bf16_t* LA, bf16_t* UU, f32x2* AGG, int S, char* lds) {
    MK_IDS();
    constexpr int XST = 1040;
    for (int tile = blockIdx.x; tile < TS / 64; tile += gridDim.x) {
        const int t0 = tile * 64;
        __syncthreads();
#pragma unroll 2
        for (int k = 0; k < 8; ++k) {
            const int idx = tid + k * NT, i = idx >> 6, cgp = idx & 63, t = t0 + i, s = t % S, ch = cgp * 8;
            float acc[8];
#pragma unroll
            for (int e = 0; e < 8; ++e) acc[e] = cb[ch + e];
#pragma unroll
            for (int j = 0; j < 4; ++j) { const int sp = s + j - 2;
                if (sp >= 0 && sp < S) { const u32x4 v = *(const u32x4*)(proj + (size_t)(t + j - 2) * EIN + 768 + ch); float xv[8]; unpack8(v, xv);
#pragma unroll
                    for (int e = 0; e < 8; ++e) acc[e] += cw[j * 512 + ch + e] * xv[e]; } }
            u32x4 o; o.x = pk2(acc[0], acc[1]); o.y = pk2(acc[2], acc[3]); o.z = pk2(acc[4], acc[5]); o.w = pk2(acc[6], acc[7]);
            *(u32x4*)(lds + i * XST + ch * 2) = o;
        }
        __syncthreads();
        const int G = lane >> 4, l16 = lane & 15, ch0 = wave * 64;
        for (int dir = 0; dir < 2; ++dir)
            for (int nt = 0; nt < 4; ++nt) {
                const int e = nt * 16 + l16, ch = ch0 + e;
                bf16x8 Br[2], Bi[2];
#pragma unroll
                for (int kk = 0; kk < 2; ++kk) {
                    Br[kk] = *(const bf16x8*)(GWj + ((((size_t)dir * 2 + 0) * 8 + wave) * 64 + e) * 64 + kk * 32 + G * 8);
                    Bi[kk] = *(const bf16x8*)(GWj + ((((size_t)dir * 2 + 1) * 8 + wave) * 64 + e) * 64 + kk * 32 + G * 8);
                }
                const float brv = br[dir * 512 + ch], biv = bi[dir * 512 + ch], spl = softplus(-lam[dir * 512 + ch]);
#pragma unroll
                for (int mt = 0; mt < 4; ++mt) {
                    f32x4 ar = {0.f, 0.f, 0.f, 0.f}, ai = {0.f, 0.f, 0.f, 0.f};
#pragma unroll
                    for (int kk = 0; kk < 2; ++kk) { const bf16x8 a = *(const bf16x8*)(lds + (mt * 16 + l16) * XST + (ch0 + kk * 32 + G * 8) * 2); ar = MFMA16(a, Br[kk], ar); ai = MFMA16(a, Bi[kk], ai); }
#pragma unroll
                    for (int r = 0; r < 4; ++r) { const int i = mt * 16 + G * 4 + r;
                        const float xc = bf2f(*(const bf16_t*)(lds + i * XST + ch * 2));
                        const float rg = __builtin_amdgcn_rcpf(1.f + __expf(-(ar[r] + brv))), ig = __builtin_amdgcn_rcpf(1.f + __expf(-(ai[r] + biv)));
                        const float la = -8.f * rg * spl; const float uu = __builtin_amdgcn_sqrtf(fmaxf(1.f - __expf(2.f * la), 0.f)) * (ig * xc);
                        const size_t o = ((size_t)dir * TS + t0 + i) * 512 + ch; LA[o] = (bf16_t)f2bf(la); UU[o] = (bf16_t)f2bf(uu); }
                }
            }
        asm volatile("s_waitcnt vmcnt(0)" ::: "memory");
        __syncthreads();
        {
            const int ch = tid;
#pragma unroll
            for (int dir = 0; dir < 2; ++dir) {
                float h = 0.f, P = 0.f;
                const bf16_t* la = LA + ((size_t)dir * TS + t0) * 512 + ch; const bf16_t* uu = UU + ((size_t)dir * TS + t0) * 512 + ch;
#pragma unroll
                for (int q = 0; q < 64; q += 8) {
                    float lv[8], uv[8];
#pragma unroll
                    for (int e = 0; e < 8; ++e) { const int i = dir ? 63 - (q + e) : q + e; lv[e] = bf2f(la[(size_t)i * 512]); uv[e] = bf2f(uu[(size_t)i * 512]); }
#pragma unroll
                    for (int e = 0; e < 8; ++e) { h = __expf(lv[e]) * h + uv[e]; P += lv[e]; }
                }
                AGG[((size_t)dir * (TS / 64) + tile) * 512 + ch] = (f32x2){P, h};
            }
        }
    }
}
__device__ __forceinline__ void even_lru_scan(const bf16_t* LA, const bf16_t* UU, const f32x2* AGG, const bf16_t* proj, bf16_t* Y, int S) {
    MK_IDS();
    const int ch = tid, TPB = S / 64;
    for (int tile = blockIdx.x; tile < TS / 64; tile += gridDim.x) {
        const int t0 = tile * 64, tb0 = (tile / TPB) * TPB;
        float cf = 0.f, cr = 0.f;
        for (int k0 = tb0; k0 < tile; k0 += 8) { f32x2 a[8];
#pragma unroll
            for (int q = 0; q < 8; ++q) { const int k = k0 + q < tile ? k0 + q : tile - 1; a[q] = AGG[(size_t)k * 512 + ch]; }
#pragma unroll
            for (int q = 0; q < 8; ++q) if (k0 + q < tile) cf = cf * __expf(a[q].x) + a[q].y; }
        for (int k0 = tb0 + TPB - 1; k0 > tile; k0 -= 8) { f32x2 a[8];
#pragma unroll
            for (int q = 0; q < 8; ++q) { const int k = k0 - q > tile ? k0 - q : tile + 1; a[q] = AGG[((size_t)(TS / 64) + k) * 512 + ch]; }
#pragma unroll
            for (int q = 0; q < 8; ++q) if (k0 - q > tile) cr = cr * __expf(a[q].x) + a[q].y; }
        float hf[64];
        {
            const bf16_t* la = LA + (size_t)t0 * 512 + ch; const bf16_t* uu = UU + (size_t)t0 * 512 + ch; float h = cf;
#pragma unroll
            for (int q = 0; q < 64; q += 8) {
                float lv[8], uv[8];
#pragma unroll
                for (int e = 0; e < 8; ++e) { lv[e] = bf2f(la[(size_t)(q + e) * 512]); uv[e] = bf2f(uu[(size_t)(q + e) * 512]); }
#pragma unroll
                for (int e = 0; e < 8; ++e) { h = __expf(lv[e]) * h + uv[e]; hf[q + e] = h; }
            }
        }
        {
            const bf16_t* la = LA + ((size_t)TS + t0) * 512 + ch; const bf16_t* uu = UU + ((size_t)TS + t0) * 512 + ch; float h = cr;
#pragma unroll
            for (int q = 0; q < 64; q += 8) {
                float lv[8], uv[8], gv[8];
#pragma unroll
                for (int e = 0; e < 8; ++e) { const int i = 63 - (q + e); lv[e] = bf2f(la[(size_t)i * 512]); uv[e] = bf2f(uu[(size_t)i * 512]); gv[e] = bf2f(proj[(size_t)(t0 + i) * EIN + 1280 + ch]); }
#pragma unroll
                for (int e = 0; e < 8; ++e) { const int i = 63 - (q + e); h = __expf(lv[e]) * h + uv[e]; Y[(size_t)(t0 + i) * DMODEL + 512 + ch] = (bf16_t)f2bf((hf[i] + h) * gelu_tanh(gv[e])); }
            }
        }
    }
}

__device__ __forceinline__ void odd_conv(const bf16_t* proj, const float* cw, bf16_t* QKVP, int S) {
    MK_IDS();
    for (int t = gw; t < TS; t += NGW) {
        const int s = t % S;
#pragma unroll
        for (int blk = 0; blk < 3; ++blk) {
            const int ch = blk * 512 + lane * 8;
            float acc[8];
#pragma unroll
            for (int e = 0; e < 8; ++e) acc[e] = 0.f;
#pragma unroll
            for (int j = 0; j < 4; ++j) { const int sp = s + j - 2;
                if (sp >= 0 && sp < S) { const u32x4 v = *(const u32x4*)(proj + (size_t)(t + j - 2) * OINP + ch); float xv[8]; unpack8(v, xv);
                    const f32x4 w0 = *(const f32x4*)(cw + j * 1536 + ch), w1 = *(const f32x4*)(cw + j * 1536 + ch + 4);
                    acc[0] += w0.x * xv[0]; acc[1] += w0.y * xv[1]; acc[2] += w0.z * xv[2]; acc[3] += w0.w * xv[3];
                    acc[4] += w1.x * xv[4]; acc[5] += w1.y * xv[5]; acc[6] += w1.z * xv[6]; acc[7] += w1.w * xv[7]; } }
            float ss = 0.f;
#pragma unroll
            for (int e = 0; e < 8; ++e) { acc[e] = silu(acc[e]); ss += acc[e] * acc[e]; }
            if (blk < 2) {
                ss += __shfl_xor(ss, 1); ss += __shfl_xor(ss, 2); ss += __shfl_xor(ss, 4); ss += __shfl_xor(ss, 8);
                const float rn = 1.f / sqrtf(ss + EPS);
#pragma unroll
                for (int e = 0; e < 8; ++e) acc[e] *= rn;
            }
            u32x4 o; o.x = pk2(acc[0], acc[1]); o.y = pk2(acc[2], acc[3]); o.z = pk2(acc[4], acc[5]); o.w = pk2(acc[6], acc[7]);
            *(u32x4*)(QKVP + (size_t)t * 1536 + ch) = o;
        }
    }
}

__device__ __forceinline__ int frag128(int r, int k) { return ((((r >> 4) * 4 + (k >> 5)) * 64 + ((k >> 3) & 3) * 16 + (r & 15)) << 3) + (k & 7); }
__device__ __forceinline__ int frag64(int r, int k) { return ((((r >> 4) * 2 + (k >> 5)) * 64 + ((k >> 3) & 3) * 16 + (r & 15)) << 3) + (k & 7); }
__device__ __forceinline__ void odd_prep(const bf16_t* QKVP, const bf16_t* proj, const float* alog, const float* dtb, unsigned char* DNI, float* EGL, char* lds) {
    MK_IDS();
    constexpr int RS = 272;
    constexpr int HOFF = 69632;
    const float scale = 0.08838834764831845f;
    for (int it0 = blockIdx.x * 2; it0 < 2048; it0 += gridDim.x * 2) {
        int tq_ = tid; asm volatile("" : "+v"(tq_));
        const int half = tq_ >> 8, ht = tq_ & 255, hwave = __builtin_amdgcn_readfirstlane(ht >> 6), G = (tq_ & 63) >> 4, l16 = tq_ & 15;
        char* L = lds + half * HOFF;
        char* KS = L, *QS = L + 17408, *VS = L + 34816; float* LM = (float*)(L + 52224); float* GC = (float*)(L + 68608); float* BT = GC + 64; float* EG = BT + 64;
        const int it = it0 + half; const int d = it & 1, h = (it >> 1) & 3, c = it >> 3, t0 = c * 64;
        __syncthreads();
#pragma unroll
        for (int k = 0; k < 4; ++k) { const int idx = ht + k * 256, i = idx >> 4, pc = idx & 15; const int tk = d ? t0 + 63 - i : t0 + i;
            const bf16_t* src = QKVP + (size_t)tk * 1536 + h * 128 + pc * 8;
            *(u32x4*)(QS + i * RS + pc * 16) = *(const u32x4*)(src);
            *(u32x4*)(KS + i * RS + pc * 16) = *(const u32x4*)(src + 512);
            *(u32x4*)(VS + i * RS + pc * 16) = *(const u32x4*)(src + 1024); }
        if (hwave == 0) {
            const int i = lane; const int tk = d ? t0 + 63 - i : t0 + i;
            const float bl = bf2f(proj[(size_t)tk * OINP + 2048 + d * 4 + h]), al = bf2f(proj[(size_t)tk * OINP + 2056 + d * 4 + h]);
            const float beta = sigm(bl); float g = -__expf(alog[d * 4 + h]) * softplus(al + dtb[d * 4 + h]);
#pragma unroll
            for (int o = 1; o < 64; o <<= 1) { const float v = __shfl_up(g, o); if (lane >= o) g += v; }
            GC[i] = g; BT[i] = beta; EG[i] = __expf(g);
        }
        __syncthreads();
        {
            const bool isq = hwave >= 2; const char* XS = isq ? QS : KS;
#pragma unroll
            for (int mm = 0; mm < 2; ++mm) { const int mt = (hwave & 1) * 2 + mm;
                bf16x8 a[4];
#pragma unroll
                for (int kk = 0; kk < 4; ++kk) a[kk] = *(const bf16x8*)(XS + (mt * 16 + l16) * RS + (kk * 32 + G * 8) * 2);
#pragma unroll
                for (int nt = 0; nt < 4; ++nt) { f32x4 acc = {0.f, 0.f, 0.f, 0.f};
#pragma unroll
                    for (int kk = 0; kk < 4; ++kk) { const bf16x8 bb = *(const bf16x8*)(KS + (nt * 16 + l16) * RS + (kk * 32 + G * 8) * 2); acc = MFMA16(a[kk], bb, acc); }
                    const int j = nt * 16 + l16; const float gj = GC[j];
#pragma unroll
                    for (int r = 0; r < 4; ++r) { const int i = mt * 16 + G * 4 + r; const float dec = __expf(fminf(GC[i] - gj, 0.f));
                        if (!isq) LM[i * 64 + j] = (j < i) ? BT[i] * acc[r] * dec : 0.f;
                        else ((bf16_t*)(DNI + (size_t)it * DNI_BYTES + DNI_A))[frag64(i, j)] = (bf16_t)f2bf((j <= i) ? acc[r] * scale * dec : 0.f); }
                }
            }
        }
        __syncthreads();
        {
            float sol[64];
            const int cc = ht & 127; const bool isw = ht >= 128; const char* XS = isw ? KS : VS;
#pragma unroll
            for (int i = 0; i < 64; ++i) {
                float v = bf2f(*(const bf16_t*)(XS + i * RS + cc * 2)) * BT[i]; if (isw) v *= EG[i];
                float a0 = 0.f, a1 = 0.f;
#pragma unroll
                for (int j4 = 0; j4 < (i + 3) / 4; ++j4) { const f32x4 l4 = *(const f32x4*)(LM + i * 64 + j4 * 4);
                    if (j4 * 4 + 0 < i) a0 += l4.x * sol[j4 * 4 + 0]; if (j4 * 4 + 1 < i) a1 += l4.y * sol[j4 * 4 + 1];
                    if (j4 * 4 + 2 < i) a0 += l4.z * sol[j4 * 4 + 2]; if (j4 * 4 + 3 < i) a1 += l4.w * sol[j4 * 4 + 3];
                    if ((j4 & 1) == 1) asm volatile("" ::: "memory"); }
                v -= a0 + a1;
                sol[i] = v;
                ((bf16_t*)(DNI + (size_t)it * DNI_BYTES + (isw ? DNI_W : DNI_U)))[isw ? frag128(i, cc) : i * 128 + cc] = (bf16_t)f2bf(v);
                asm volatile("" ::: "memory");
            }
        }
        {
            const float gl = GC[63];
#pragma unroll
            for (int k = 0; k < 4; ++k) { const int idx = ht + k * 256;
                {
                    const int i = idx & 63, kg = idx >> 6; const u32x4 raw = *(const u32x4*)(QS + i * RS + kg * 16); float f[8]; unpack8(raw, f); const float sc = scale * EG[i];
                    u32x4 o; o.x = pk2(f[0] * sc, f[1] * sc); o.y = pk2(f[2] * sc, f[3] * sc); o.z = pk2(f[4] * sc, f[5] * sc); o.w = pk2(f[6] * sc, f[7] * sc);
                    *(u32x4*)((bf16_t*)(DNI + (size_t)it * DNI_BYTES + DNI_QT) + frag128(i, kg * 8)) = o; }
                {
                    const int dm = idx & 127, tg = idx >> 7; float f[8];
#pragma unroll
                    for (int q = 0; q < 8; ++q) { const int i = tg * 8 + q; f[q] = bf2f(*(const bf16_t*)(KS + i * RS + dm * 2)) * __expf(gl - GC[i]); }
                    u32x4 o; o.x = pk2(f[0], f[1]); o.y = pk2(f[2], f[3]); o.z = pk2(f[4], f[5]); o.w = pk2(f[6], f[7]);
                    *(u32x4*)((bf16_t*)(DNI + (size_t)it * DNI_BYTES + DNI_KTT) + frag64(dm, tg * 8)) = o; }
            }
            if (ht == 0) EGL[it] = __expf(gl);
        }
    }
}

__device__ __forceinline__ void odd_scan(const unsigned char* DNI, const float* EGL, bf16_t* OB, int S, int nb, char* lds) {
    MK_IDS();
    constexpr int O_SB = 0, O_VN = 4352, O_OUT = 6656, PFD = 7;
    const int NC = S / 64, G = lane >> 4, l16 = lane & 15;
    const int nitems = nb * 64;
    const int mt = wave & 3; const bool lo = wave < 4;
    for (int item = blockIdx.x; item < nitems; item += gridDim.x) {
        const int e = (item >> 3) & 7, sq = (item & 7) | ((item >> 6) << 3); const int d = sq & 1, h = (sq >> 1) & 3, b = sq >> 3;
        __syncthreads();
        for (int i = tid; i < 4352 / 4; i += NT) ((unsigned*)(lds + O_SB))[i] = 0u;
        f32x4 Sreg = {0.f, 0.f, 0.f, 0.f};
        const long dstep = (long)(d ? -8 : 8) * DNI_BYTES;
        const unsigned char* base0 = DNI + (size_t)(((b * NC + (d ? NC - 1 : 0)) * 4 + h) * 2 + d) * DNI_BYTES;
        const unsigned char* pX = base0 + (lo ? DNI_W : DNI_QT) + ((mt * 4) * 64 + lane) * 16;
        const unsigned char* pA = base0 + DNI_A + ((mt * 2) * 64 + lane) * 16;
        const unsigned char* pK = base0 + DNI_KTT + ((wave * 2) * 64 + lane) * 16;
        const unsigned char* pU = base0 + DNI_U + ((mt * 16 + G * 4) * 128 + e * 16 + l16) * 2;
        const float* pE = EGL + (((b * NC + (d ? NC - 1 : 0)) * 4 + h) * 2 + d);
        const unsigned char* pP = base0 + (long)PFD * dstep + e * 9216 + (tid < 144 ? tid : 143) * 64;
        bf16_t* pO = OB + ((size_t)d * TS + (size_t)(b * NC + (d ? NC - 1 : 0)) * 64 + (d ? 63 - (tid >> 3) : (tid >> 3))) * 512 + h * 128 + e * 16 + (tid & 7) * 2;
        const long ostep = (long)(d ? -64 : 64) * 512;
        u32x4 aX[4], aA[2], aK[2], bX[4], bA[2], bK[2], cX[4], cA[2], cK[2];
        unsigned aU[4], bU[4], cU[4]; float aE, bE, cE; unsigned pf_dummy = 0u;
#define DN_LOAD(P) do { \
            _Pragma("unroll") for (int kk = 0; kk < 4; ++kk) P##X[kk] = *(const u32x4*)(pX + kk * 1024); \
            _Pragma("unroll") for (int kk = 0; kk < 2; ++kk) { P##A[kk] = *(const u32x4*)(pA + kk * 1024); P##K[kk] = *(const u32x4*)(pK + kk * 1024); } \
            _Pragma("unroll") for (int r = 0; r < 4; ++r) P##U[r] = *(const bf16_t*)(pU + r * 256); \
            P##E = *pE; pX += dstep; pA += dstep; pK += dstep; pU += dstep; pE += (d ? -8 : 8); } while (0)
#define DN_STEP(P, PL) do { \
            DN_LOAD(PL); \
            if (wave < 3) { asm volatile("global_load_dword %0, %1, off" : "+v"(pf_dummy) : "v"(pP) : "memory"); } \
            pP += dstep; \
            f32x4 acc = {0.f, 0.f, 0.f, 0.f}, acc2 = {0.f, 0.f, 0.f, 0.f}; \
            { bf16x8 sb_[4]; \
              _Pragma("unroll") for (int kk = 0; kk < 4; ++kk) sb_[kk] = *(const bf16x8*)(lds + O_SB + l16 * 272 + (kk * 32 + G * 8) * 2); \
              asm volatile("s_waitcnt lgkmcnt(0)" : "+v"(sb_[0]), "+v"(sb_[1]), "+v"(sb_[2]), "+v"(sb_[3]) :: "memory"); \
              acc = MFMA16(__builtin_bit_cast(bf16x8, P##X[0]), sb_[0], acc); acc2 = MFMA16(__builtin_bit_cast(bf16x8, P##X[1]), sb_[1], acc2); \
              acc = MFMA16(__builtin_bit_cast(bf16x8, P##X[2]), sb_[2], acc); acc2 = MFMA16(__builtin_bit_cast(bf16x8, P##X[3]), sb_[3], acc2); \
              acc = acc + acc2; } \
            if (lo) { u32x2 o; float v[4]; \
              _Pragma("unroll") for (int r = 0; r < 4; ++r) v[r] = __uint_as_float(P##U[r] << 16) - acc[r]; \
              o.x = attn_body::cvtpk_s(v[0], v[1]); o.y = attn_body::cvtpk_s(v[2], v[3]); \
              *(u32x2*)(lds + O_VN + l16 * 144 + (mt * 16 + G * 4) * 2) = o; } \
            asm volatile("s_waitcnt lgkmcnt(0)\n\ts_barrier" ::: "memory"); \
            bf16x8 vb[2]; \
            _Pragma("unroll") for (int kk = 0; kk < 2; ++kk) vb[kk] = *(const bf16x8*)(lds + O_VN + l16 * 144 + (kk * 32 + G * 8) * 2); \
            asm volatile("s_waitcnt lgkmcnt(0)" : "+v"(vb[0]), "+v"(vb[1]) :: "memory"); \
            Sreg = Sreg * P##E; \
            _Pragma("unroll") for (int kk = 0; kk < 2; ++kk) Sreg = MFMA16(__builtin_bit_cast(bf16x8, P##K[kk]), vb[kk], Sreg); \
            { u32x2 o; o.x = attn_body::cvtpk_s(Sreg[0], Sreg[1]); o.y = attn_body::cvtpk_s(Sreg[2], Sreg[3]); \
              *(u32x2*)(lds + O_SB + l16 * 272 + (wave * 16 + G * 4) * 2) = o; } \
            if (!lo) { \
              _Pragma("unroll") for (int kk = 0; kk < 2; ++kk) acc = MFMA16(__builtin_bit_cast(bf16x8, P##A[kk]), vb[kk], acc); \
              const unsigned w0_ = attn_body::cvtpk_s(acc[0], acc[1]), w1_ = attn_body::cvtpk_s(acc[2], acc[3]); \
              bf16_t* op_ = (bf16_t*)(lds + O_OUT + ((mt * 16 + G * 4) * 16 + l16) * 2); \
              op_[0] = (bf16_t)(w0_ & 0xffffu); op_[16] = (bf16_t)(w0_ >> 16); op_[32] = (bf16_t)(w1_ & 0xffffu); op_[48] = (bf16_t)(w1_ >> 16); } \
            asm volatile("s_waitcnt lgkmcnt(0)\n\ts_barrier" ::: "memory"); \
            *(unsigned*)pO = *(const unsigned*)(lds + O_OUT + tid * 4); pO += ostep; } while (0)
        DN_LOAD(a); DN_LOAD(b);
        __syncthreads();
        int n = 0;
        for (; n + 3 <= NC; n += 3) {
            DN_STEP(a, c);
            DN_STEP(b, a);
            DN_STEP(c, b);
        }
        if (n < NC) { DN_STEP(a, c); }
        if (n + 1 < NC) { DN_STEP(b, a); }
#undef DN_STEP
#undef DN_LOAD
        asm volatile("s_waitcnt vmcnt(0)" ::: "memory");
        asm volatile("" :: "v"(pf_dummy));
    }
}

__device__ __forceinline__ int t5_bucket(int rel) {
    const int n = rel < 0 ? -rel : rel; int v;
    if (n < 8) v = n; else v = 8 + (n >= 15) + (n >= 27) + (n >= 50) + (n >= 91) + (n >= 166) + (n >= 305) + (n >= 559);
    return (rel > 0 ? 16 : 0) + v;
}
__device__ __forceinline__ void odd_dilated(bf16_t* proj, const float* relb, float* LSE, int S, char* lds, int first_wg, int n_wg) {
    MK_IDS();
    constexpr int KST = 144, VST = 400, HOFF = 27648 + 25600 + 1024;
    const int half = tid >> 8, ht = tid & 255, wv = ht >> 6, G = lane >> 4, l16 = lane & 15;
    char* L = lds + half * HOFF; char* KS = L; char* VT = L + 27648; float* BIAS = (float*)(L + 27648 + 25600);
    const int NBb = S / 64;
    const int wgi = (int)blockIdx.x - first_wg;
    if (wgi < 0) return;
    for (int it0 = wgi * 2; it0 < 3072; it0 += n_wg * 2) {
        const int it = it0 + half; const int zb = it & 255, sl = (it >> 8) & 3, g = it >> 10;
        const int dil = g == 0 ? 1 : (g == 1 ? 4 : 16), lg = g * 2;
        const int M = S >> lg, MB = M / 64;
        const int b = zb / NBb, r0 = zb % NBb, rho = r0 / MB, n = r0 % MB;
        const int hc = (g * 4 + sl) * 64;
        const size_t tb = (size_t)b * S;
        __syncthreads();
#pragma unroll
        for (int k = 0; k < 6; ++k) { const int idx = ht + k * 256, kj = idx >> 3, pc = idx & 7; const int mk = 64 * n - 64 + kj;
            u32x4 kv = {0u, 0u, 0u, 0u}, vv = {0u, 0u, 0u, 0u};
            if (mk >= 0 && mk < M) { const bf16_t* rowp = proj + (tb + (size_t)mk * dil + rho) * OINP; kv = *(const u32x4*)(rowp + 2832 + hc + pc * 8); vv = *(const u32x4*)(rowp + 3600 + hc + pc * 8); }
            *(u32x4*)(KS + kj * KST + pc * 16) = kv;
            const unsigned w[4] = {vv.x, vv.y, vv.z, vv.w};
#pragma unroll
            for (int q = 0; q < 4; ++q) { *(bf16_t*)(VT + (pc * 8 + 2 * q) * VST + kj * 2) = (bf16_t)(w[q] & 0xffffu); *(bf16_t*)(VT + (pc * 8 + 2 * q + 1) * VST + kj * 2) = (bf16_t)(w[q] >> 16); } }
        if (ht < 129) BIAS[ht] = relb[t5_bucket((ht - 64) * dil) * 12 + g * 4 + sl];
        const int mq = 64 * n + 16 * wv + l16; const size_t tq = tb + (size_t)mq * dil + rho;
        bf16x8 qf[2];
#pragma unroll
        for (int kk = 0; kk < 2; ++kk) qf[kk] = *(const bf16x8*)(proj + tq * OINP + 2064 + hc + kk * 32 + G * 8);
        __syncthreads();
        f32x4 sc[9]; float mx = -1e30f;
#pragma unroll
        for (int kt = 0; kt < 9; ++kt) { f32x4 acc = {0.f, 0.f, 0.f, 0.f};
#pragma unroll
            for (int kk = 0; kk < 2; ++kk) { const bf16x8 a = *(const bf16x8*)(KS + ((wv + kt) * 16 + l16) * KST + (kk * 32 + G * 8) * 2); acc = MFMA16(a, qf[kk], acc); }
#pragma unroll
            for (int r = 0; r < 4; ++r) { const int kj = (wv + kt) * 16 + G * 4 + r; const int delta = kj - 64 - 16 * wv - l16; const int mk = 64 * n - 64 + kj;
                const bool ok = (delta >= -64) && (delta <= 64) && (mk >= 0) && (mk < M);
                const float s = ok ? acc[r] * 0.125f + BIAS[(delta < -64 ? -64 : (delta > 64 ? 64 : delta)) + 64] : -1e30f;
                acc[r] = s; mx = fmaxf(mx, s); }
            sc[kt] = acc; }
        mx = fmaxf(mx, __shfl_xor(mx, 16)); mx = fmaxf(mx, __shfl_xor(mx, 32));
        float sum = 0.f;
#pragma unroll
        for (int kt = 0; kt < 9; ++kt)
#pragma unroll
            for (int r = 0; r < 4; ++r) { const float pv_ = (sc[kt][r] > -1e29f) ? __expf(sc[kt][r] - mx) : 0.f; sc[kt][r] = pv_; sum += pv_; }
        sum += __shfl_xor(sum, 16); sum += __shfl_xor(sum, 32);
        f32x4 ot[4];
#pragma unroll
        for (int dt = 0; dt < 4; ++dt) ot[dt] = (f32x4){0.f, 0.f, 0.f, 0.f};
#pragma unroll
        for (int pp = 0; pp < 5; ++pp) {
            u32x4 pb; pb.x = pk2(sc[2 * pp][0], sc[2 * pp][1]); pb.y = pk2(sc[2 * pp][2], sc[2 * pp][3]);
            if (pp < 4) { pb.z = pk2(sc[2 * pp + 1][0], sc[2 * pp + 1][1]); pb.w = pk2(sc[2 * pp + 1][2], sc[2 * pp + 1][3]); } else { pb.z = 0u; pb.w = 0u; }
            const bf16x8 pbf = __builtin_bit_cast(bf16x8, pb);
#pragma unroll
            for (int dt = 0; dt < 4; ++dt) {
                u32x4 av; const u32x2 lo = *(const u32x2*)(VT + (dt * 16 + l16) * VST + ((wv + 2 * pp) * 16 + G * 4) * 2); av.x = lo.x; av.y = lo.y;
                if (pp < 4) { const u32x2 hi = *(const u32x2*)(VT + (dt * 16 + l16) * VST + ((wv + 2 * pp + 1) * 16 + G * 4) * 2); av.z = hi.x; av.w = hi.y; } else { av.z = 0u; av.w = 0u; }
                ot[dt] = MFMA16(__builtin_bit_cast(bf16x8, av), pbf, ot[dt]);
            }
        }
        const float rs = 1.f / sum;
        float* od = (float*)(proj + tq * OINP) + (g * 4 + sl) * 64;
#pragma unroll
        for (int dt = 0; dt < 4; ++dt) *(f32x4*)(od + dt * 16 + G * 4) = ot[dt] * rs;
        if (G == 0) LSE[tq * 12 + g * 4 + sl] = mx + __logf(sum);
    }
}

__device__ __forceinline__ void odd_combine(const bf16_t* OB, const bf16_t* proj, const float* LSE, const float* og, bf16_t* Y) {
    MK_IDS();
    const float g0 = og[lane * 2], g1 = og[lane * 2 + 1];
    for (int t = gw; t < TS; t += NGW) {
        const bf16_t* prow = proj + (size_t)t * OINP;
#pragma unroll
        for (int hh = 0; hh < 4; ++hh) {
            const unsigned a = *(const unsigned*)(OB + (size_t)t * 512 + hh * 128 + lane * 2), bb = *(const unsigned*)(OB + ((size_t)TS + t) * 512 + hh * 128 + lane * 2);
            const unsigned zz = *(const unsigned*)(prow + 1536 + hh * 128 + lane * 2);
            const float o0 = __uint_as_float(a << 16) + __uint_as_float(bb << 16), o1 = __uint_as_float(a & 0xffff0000u) + __uint_as_float(bb & 0xffff0000u);
            const float ss = wave_sum(o0 * o0 + o1 * o1); const float rn = 1.f / sqrtf(ss * (1.f / 128.f) + EPS);
            const float z0 = __uint_as_float(zz << 16), z1 = __uint_as_float(zz & 0xffff0000u);
            *(unsigned*)(Y + (size_t)t * OOUT + hh * 128 + lane * 2) = pk2(o0 * rn * g0 * silu(z0), o1 * rn * g1 * silu(z1));
        }
        const float* od = (const float*)prow;
#pragma unroll
        for (int sl = 0; sl < 4; ++sl) {
            const float l0 = LSE[(size_t)t * 12 + sl], l1 = LSE[(size_t)t * 12 + 4 + sl], l2 = LSE[(size_t)t * 12 + 8 + sl];
            const float m = fmaxf(l0, fmaxf(l1, l2)); const float w0 = __expf(l0 - m), w1 = __expf(l1 - m), w2 = __expf(l2 - m); const float rs = 1.f / (w0 + w1 + w2);
            const float v = (w0 * od[sl * 64 + lane] + w1 * od[256 + sl * 64 + lane] + w2 * od[512 + sl * 64 + lane]) * rs;
            Y[(size_t)t * OOUT + 512 + sl * 64 + lane] = (bf16_t)f2bf(v);
        }
    }
}

__global__ void __launch_bounds__(NT, 2) fwd_megakernel(Params p) {
    extern __shared__ __attribute__((aligned(16))) unsigned char lds_raw[];
    cg::grid_group grid = cg::this_grid();
    char* lds = (char*)lds_raw;
    PG8_LAS unsigned char* ldsl = (PG8_LAS unsigned char*)lds_raw;
    const int Gr = gridDim.x;
    volatile LAS unsigned* MISC = (volatile LAS unsigned*)((PG8_LAS unsigned char*)lds_raw + (LDS_BYTES - 128));
    if (threadIdx.x < 32) MISC[threadIdx.x] = 0u;
    __syncthreads();
    xb::XcdBarrier bar = xb::xcd_barrier_post((unsigned*)p.ws, MISC + 8);
#define GSYNC() xb::xcd_barrier(bar)
    unsigned char* ws = p.ws;
    bf16_t* H = (bf16_t*)(ws + WS_H); bf16_t* PROJ = (bf16_t*)(ws + WS_PROJ); unsigned char* SCR = ws + WS_SCR;

    phase_prologue(p, lds);
    grid.sync();

    float* SSQA = (float*)(SCR + 232 * MiB); float* SSQB = (float*)(SCR + 234 * MiB);
    bf16_t* YE = (bf16_t*)(SCR + 192 * MiB); bf16_t* YO = (bf16_t*)(SCR + SC_QKVP);
    for (int seg = 0; seg < NSEG; ++seg) {
        const int S = seg < 2 ? 16384 : 2048, nb = seg < 2 ? 1 : 8;
        const float* xin = (seg < 2 ? p.in[0] : p.in[1]) + (size_t)(seg & 1) * TS * DMODEL;
        float* xo = p.out + (size_t)seg * TS * DMODEL;
        phase_x0(xin, H, SSQB);
        GSYNC();
        for (int layer = 0; layer < 4; ++layer) {
            const int j = layer >> 1; const bool odd = layer & 1;
            {
                const int N = odd ? OINP : EIN;
                const bf16_t* Bt = odd ? (const bf16_t*)(ws + WS_WINO) + (size_t)j * OINP * 1024 : (const bf16_t*)(ws + WS_WINE) + (size_t)j * EIN * 1024;
                pg8::Gemm g{H, Bt, TS, N, 1024}; pg8::StaticOrder So; So.init(TS, N, Gr, (int)blockIdx.x);
                pg8::EpiBf16<0> E{PROJ, N, nullptr, 0, 0, 1.f, SSQB};
                pg8::gemm_phase<pg8::EpiBf16<0>, pg8::StaticOrder, true, true>(ldsl, g, So, E);
            }
            GSYNC();
            if (!odd) {
                even_qk_post(PROJ, p.in[10] + j * 64, p.in[11] + j * 64, S);
                even_lru_prep(PROJ, p.in[12] + j * 2048, p.in[13] + j * 512, (const bf16_t*)(ws + WS_GW) + (size_t)j * 2 * 2 * 8 * 4096, p.in[15] + j * 1024, p.in[17] + j * 1024, p.in[18] + j * 1024,
                              (bf16_t*)(SCR + SC_LA), (bf16_t*)(SCR + SC_UU), (f32x2*)(SCR + SC_AGG), S, lds);
                GSYNC();
                {
                    const int nqb = S / 256, nunits = nb * 8 * nqb;
                    for (int u = blockIdx.x; u < nunits; u += Gr) {
                        const int qb = u % nqb, h = (u / nqb) % 8, b = u / (nqb * 8), kvh = h >> 2;
                        const attn_body::bf16* base = (const attn_body::bf16*)PROJ + (size_t)b * S * EIN;
                        attn_body::attn_unit<8>(qb, S, base + h * 64, EIN, base + 512 + kvh * 64, base + 640 + kvh * 64, EIN, (attn_body::bf16*)YE + (size_t)b * S * DMODEL + h * 64, DMODEL, lds);
                    }
                }
                __syncthreads();
                even_lru_scan((const bf16_t*)(SCR + SC_LA), (const bf16_t*)(SCR + SC_UU), (const f32x2*)(SCR + SC_AGG), PROJ, YE, S);
                GSYNC();
                {
                    pg8::Gemm g{YE, (const bf16_t*)(ws + WS_WOUTE) + (size_t)j * 1024 * 1024, TS, 1024, 1024}; pg8::StaticOrder So; So.init(TS, 1024, Gr, (int)blockIdx.x);
                    EpiRes E{H, SSQA, DMODEL};
                    pg8::gemm_phase<EpiRes, pg8::StaticOrder, true, true>(ldsl, g, So, E);
                }
            } else {
                odd_conv(PROJ, p.in[21] + j * 4 * 1536, (bf16_t*)(SCR + SC_QKVP), S);
                GSYNC();
                odd_prep((const bf16_t*)(SCR + SC_QKVP), PROJ, p.in[22] + j * 8, p.in[23] + j * 8, SCR + SC_DNI, (float*)(SCR + SC_EGL), lds);
                GSYNC();
                {
                    const int nscan = nb * 64;
                    odd_scan(SCR + SC_DNI, (const float*)(SCR + SC_EGL), (bf16_t*)(SCR + SC_OB), S, nb, lds);
                    const int first = nscan < Gr ? nscan : 0;
                    odd_dilated(PROJ, p.in[2], (float*)(SCR + SC_LSE), S, lds, first, Gr - first);
                }
                GSYNC();
                odd_combine((const bf16_t*)(SCR + SC_OB), PROJ, (const float*)(SCR + SC_LSE), p.in[24] + j * 128, YO);
                GSYNC();
                {
                    pg8::Gemm g{YO, (const bf16_t*)(ws + WS_WOUTO) + (size_t)j * 1024 * OOUT, TS, 1024, OOUT}; pg8::StaticOrder So; So.init(TS, 1024, Gr, (int)blockIdx.x);
                    EpiRes E{H, SSQA, DMODEL};
                    pg8::gemm_phase<EpiRes, pg8::StaticOrder, true, true>(ldsl, g, So, E);
                }
            }
            GSYNC();
            {
                pg8::Gemm g{H, (const bf16_t*)(ws + WS_W1T) + (size_t)layer * 4096 * 1024, TS, DFF, 1024}; pg8::StaticOrder So; So.init(TS, DFF, Gr, (int)blockIdx.x);
                pg8::EpiBf16<2> E{(bf16_t*)(SCR + SC_HID), DFF, nullptr, 0, 0, 1.f, SSQA};
                pg8::gemm_phase<pg8::EpiBf16<2>, pg8::StaticOrder, true, true>(ldsl, g, So, E);
            }
            GSYNC();
            {
                pg8::Gemm g{(const bf16_t*)(SCR + SC_HID), (const bf16_t*)(ws + WS_W2T) + (size_t)layer * 1024 * 4096, TS, 1024, DFF}; pg8::StaticOrder So; So.init(TS, 1024, Gr, (int)blockIdx.x);
                EpiRes E{H, SSQB, DMODEL};
                pg8::gemm_phase<EpiRes, pg8::StaticOrder, true, true>(ldsl, g, So, E);
            }
            GSYNC();
        }
        phase_rmsnorm_final(H, xo, p.in[5]);
        GSYNC();
    }
}
}

extern "C" void kernel_launch(void* const* d_in, const int* in_sizes, int n_in, void* d_out, int out_size, void* d_ws, size_t ws_size, hipStream_t stream) {
    static int grid = 0;
    if (grid == 0) {
        if (n_in != 25 || ws_size < mk::WS_END) { fprintf(stderr, "kernel_launch: unexpected n_in %d / ws_size %zu\n", n_in, ws_size); grid = -1; return; }
        int dev = 0, cus = 0, per_cu = 0;
        hipGetDevice(&dev); hipDeviceGetAttribute(&cus, hipDeviceAttributeMultiprocessorCount, dev);
        if (hipFuncSetAttribute((const void*)mk::fwd_megakernel, hipFuncAttributeMaxDynamicSharedMemorySize, mk::LDS_BYTES) != hipSuccess) { fprintf(stderr, "hipFuncSetAttribute failed\n"); }
        hipOccupancyMaxActiveBlocksPerMultiprocessor(&per_cu, (const void*)mk::fwd_megakernel, mk::NT, mk::LDS_BYTES);
        (void)hipGetLastError();
        if (per_cu < 1) per_cu = 1;
        grid = cus * 1;
        fprintf(stderr, "kernel_launch: cus %d per_cu %d grid %d\n", cus, per_cu, grid);
    }
    if (grid < 0) return;
    if (hipMemsetAsync(d_ws, 0, 65536, stream) != hipSuccess) { fprintf(stderr, "memset failed\n"); return; }
    mk::Params p{};
    for (int i = 0; i < 25; ++i) p.in[i] = (const float*)d_in[i];
    p.out = (float*)d_out; p.ws = (unsigned char*)d_ws;
    void* args[] = {&p};
    hipError_t e = hipLaunchCooperativeKernel((const void*)mk::fwd_megakernel, dim3(grid), dim3(mk::NT), args, mk::LDS_BYTES, stream);
    if (e != hipSuccess) fprintf(stderr, "cooperative launch failed: %s (grid %d)\n", hipGetErrorString(e), grid);
}
```

```cpp
#include <hip/hip_runtime.h>
#include <hip/hip_cooperative_groups.h>
#include <hip/hip_bf16.h>
#include <cstdio>
#include <cstdint>
#include <cmath>
namespace cg = cooperative_groups;
namespace pg8 {
#define PG8_LAS __attribute__((address_space(3)))
typedef unsigned short bf16_t;
typedef short bf16x8 __attribute__((ext_vector_type(8)));
typedef float f32x4 __attribute__((ext_vector_type(4)));
typedef unsigned u32x4 __attribute__((ext_vector_type(4)));
constexpr int BM = 256, BK = 64, HALF = 128, HTB = HALF * BK * 2  , STAGE_BYTES = 8 * HTB, NXCD = 8, WGM = 8;

__host__ __device__ __forceinline__ int lds_byte(int r, int c) { const int st = (r >> 4) * 2 + (c >> 5), rr = r & 15, cc = c & 31, ob = rr * 64 + cc * 2; return st * 1024 + (ob ^ (((ob >> 9) & 1) << 5)); }
__host__ __device__ __forceinline__ void stage_rc(int b, int& R, int& C) { const int st = b / 1024, sb = b % 1024, swz = sb ^ (((sb >> 9) & 1) << 5); R = (st >> 1) * 16 + swz / 64; C = (st & 1) * 32 + (swz % 64) / 2; }
__host__ __device__ __forceinline__ int perm32(int rho) { const int n = rho >> 4, i = rho & 15; return 8 * (i >> 2) + 4 * n + (i & 3); }

struct Unit { int pm, pn; };
struct Gemm { const bf16_t* A; const bf16_t* Bt; int M, N, K; };

struct StaticOrder {
    int nM, nN, nwg, G, c;
    __host__ __device__ void init(int M, int N, int G_, int c_) { nM = M / BM; nN = N / BM; nwg = nM * nN; G = G_; c = c_; }
    __host__ __device__ bool next(int i, Unit& u) const {
        const long L = (long)i * G + c; if (L >= nwg) return false;
        int wgid = (int)L; { const int q = nwg / NXCD, r = nwg % NXCD, xcd = wgid % NXCD, off = wgid / NXCD; wgid = (xcd < r ? xcd * (q + 1) : r * (q + 1) + (xcd - r) * q) + off; }
        const int nig = WGM * nN, gid = wgid / nig, fm = gid * WGM, gsz = (nM - fm) < WGM ? (nM - fm) : WGM;
        u.pm = fm + ((wgid % nig) % gsz); u.pn = (wgid % nig) / gsz; return true;
    }
    __device__ __forceinline__ void a_ready(const Unit&) const {}
    __device__ __forceinline__ void done(const Unit&) const {}
};

__device__ __forceinline__ unsigned cvt_pk_bf16(float lo, float hi) { unsigned r; asm volatile("v_cvt_pk_bf16_f32 %0, %1, %2" : "=v"(r) : "v"(lo), "v"(hi)); return r; }
typedef float f32x2 __attribute__((ext_vector_type(2)));
__device__ __forceinline__ f32x2 gelu_pk(f32x2 v) {
    const f32x2 av = __builtin_elementwise_abs(v), d = av * 0.2316418882f + 1.0f;
    f32x2 t; t.x = __builtin_amdgcn_rcpf(d.x); t.y = __builtin_amdgcn_rcpf(d.y);
    f32x2 q = t * 0.5307027145f + (-0.7265760135f); q = q * t + 0.7107068705f; q = q * t + (-0.142248368f); q = q * t + 0.127414796f; q = q * t;
    const f32x2 s = (v * v) * (-0.72134752044f);
    f32x2 e; e.x = __builtin_amdgcn_exp2f(s.x); e.y = __builtin_amdgcn_exp2f(s.y);
    const f32x2 m = v * (q * e), r = v - m;
    f32x2 o; o.x = v.x < 0.f ? m.x : r.x; o.y = v.y < 0.f ? m.y : r.y; return o;
}

template <int ACT  > struct EpiBf16 {
    static constexpr bool PERM = true, AFTER_DRAIN = false; static_assert(ACT == 0 || ACT == 1 || ACT == 2, "EpiBf16: ACT 0 none, 1 gelu, 2 relu^2");
    bf16_t* O; int ldc; const float* bias; int split_cols; size_t split_stride; float scale0; const float* ssq;
    __device__ __forceinline__ void operator()(const f32x4 (&acc)[2][2][4][2], const Unit& u, int wr, int wc, int fr, int fq) const {
        const int row0 = u.pm * BM + wr * 64 + fr; int colt = u.pn * BM; bf16_t* base = O;
        float sc = 1.f; if (split_cols) { const int t = colt / split_cols; base += (size_t)t * split_stride; colt -= t * split_cols; if (t == 0) sc = scale0; }
        const int col0 = colt + wc * 32 + 8 * fq, bcol0 = u.pn * BM + wc * 32 + 8 * fq;
        float rsc[2][4];
        if (ssq) { f32x4 t_[2][4];
#pragma unroll
            for (int ai = 0; ai < 2; ++ai)
#pragma unroll
                for (int m = 0; m < 4; ++m) t_[ai][m] = *(const f32x4*)(ssq + (size_t)(row0 + ai * HALF + m * 16) * 16 + fq * 4);
#pragma unroll
            for (int ai = 0; ai < 2; ++ai)
#pragma unroll
                for (int m = 0; m < 4; ++m) { float s_ = (t_[ai][m][0] + t_[ai][m][1]) + (t_[ai][m][2] + t_[ai][m][3]); s_ += __shfl_xor(s_, 16); s_ += __shfl_xor(s_, 32); rsc[ai][m] = 1.0f / sqrtf(s_ * (1.0f / 1024.0f) + 1e-6f); }
        } else {
#pragma unroll
            for (int ai = 0; ai < 2; ++ai)
#pragma unroll
                for (int m = 0; m < 4; ++m) rsc[ai][m] = 1.0f; }
        f32x4 bv[2][2];
#pragma unroll
        for (int bj = 0; bj < 2; ++bj)
#pragma unroll
            for (int n = 0; n < 2; ++n) bv[bj][n] = bias ? *(const f32x4*)(bias + bcol0 + bj * HALF + 4 * n) : (f32x4){0.f, 0.f, 0.f, 0.f};
#pragma unroll
        for (int ai = 0; ai < 2; ++ai)
#pragma unroll
            for (int m = 0; m < 4; ++m) { bf16_t* rowp = base + (size_t)(row0 + ai * HALF + m * 16) * ldc + col0; const float rsc_ = rsc[ai][m];
#pragma unroll
                for (int bj = 0; bj < 2; ++bj) { f32x4 v0 = (acc[ai][bj][m][0] + bv[bj][0]) * rsc_, v1 = (acc[ai][bj][m][1] + bv[bj][1]) * rsc_;
                    if (ACT == 1) { f32x2 a = gelu_pk((f32x2){v0[0], v0[1]}), b = gelu_pk((f32x2){v0[2], v0[3]}), c = gelu_pk((f32x2){v1[0], v1[1]}), d = gelu_pk((f32x2){v1[2], v1[3]});
                        v0 = (f32x4){a.x, a.y, b.x, b.y}; v1 = (f32x4){c.x, c.y, d.x, d.y}; }
                    if (ACT == 2) { _Pragma("unroll") for (int q_ = 0; q_ < 4; ++q_) { const float a0_ = v0[q_] > 0.f ? v0[q_] : 0.f, a1_ = v1[q_] > 0.f ? v1[q_] : 0.f; v0[q_] = a0_ * a0_; v1[q_] = a1_ * a1_; } }
                    v0 = v0 * sc; v1 = v1 * sc; u32x4 w; w.x = cvt_pk_bf16(v0[0], v0[1]); w.y = cvt_pk_bf16(v0[2], v0[3]); w.z = cvt_pk_bf16(v1[0], v1[1]); w.w = cvt_pk_bf16(v1[2], v1[3]);
                    *(u32x4*)(rowp + bj * HALF) = w; } }
    }
};

template <class Epi, class Sched, bool ALIGN_EPI = false, bool SP2 = false>
__device__ __forceinline__ void gemm_phase(PG8_LAS unsigned char* lds, const Gemm g, const Sched& S, const Epi& E) {
    int tid_ = threadIdx.x; asm volatile("" : "+v"(tid_)); const int tid = tid_, wid = __builtin_amdgcn_readfirstlane(tid >> 6), lane = tid & 63, wr = wid >> 2, wc = wid & 3, fr = lane & 15, fq = lane >> 4;
    const int K = g.K, nt = K / BK;
    unsigned voffA[2], voffB[2];
#pragma unroll
    for (int i = 0; i < 2; ++i) { int R, C; stage_rc(tid * 16 + i * 8192, R, C); const int Rb = Epi::PERM ? ((R & ~31) + perm32(R & 31)) : R;
        voffA[i] = (unsigned)(R * K + C) * 2u; voffB[i] = (unsigned)(Rb * K + C) * 2u; }
    const size_t kstep = (size_t)(BK * 2);
    const size_t hstep = (size_t)HALF * K * 2;
    const size_t tstep = 2 * hstep;
    const unsigned ldsw = (unsigned)wid * 1024u;
    const int aoff = lds_byte(wr * 64 + fr, fq * 8), boff = lds_byte(wc * 32 + fr, fq * 8);
#define PG8_SA(b, h) (((b) * 2 + (h)) * HTB)
#define PG8_SB(b, h) ((4 + (b) * 2 + (h)) * HTB)
#define PG8_STAGE(bufoff, gbase, voff) do { _Pragma("unroll") for (int _i = 0; _i < 2; ++_i) \
        __builtin_amdgcn_global_load_lds((const unsigned*)((const char*)(gbase) + (voff)[_i]), (PG8_LAS unsigned*)(lds + (bufoff) + ldsw + _i * 8192), 16, 0, 0); } while (0)
#define PG8_LDA(dst, b, h) do { _Pragma("unroll") for (int m = 0; m < 4; ++m) _Pragma("unroll") for (int k = 0; k < 2; ++k) dst[m][k] = *(const PG8_LAS bf16x8*)(lds + PG8_SA(b, h) + aoff + m * 2048 + k * 1024); } while (0)
#define PG8_LDB(dst, b, h) do { _Pragma("unroll") for (int n = 0; n < 2; ++n) _Pragma("unroll") for (int k = 0; k < 2; ++k) dst[n][k] = *(const PG8_LAS bf16x8*)(lds + PG8_SB(b, h) + boff + n * 2048 + k * 1024); } while (0)
#define PG8_MMA(ai, bj, At, Bt) do { __builtin_amdgcn_s_setprio(1); _Pragma("unroll") for (int m = 0; m < 4; ++m) _Pragma("unroll") for (int n = 0; n < 2; ++n) _Pragma("unroll") for (int k = 0; k < 2; ++k) \
        acc[ai][bj][m][n] = __builtin_amdgcn_mfma_f32_16x16x32_bf16(Bt[n][k], At[m][k], acc[ai][bj][m][n], 0, 0, 0); __builtin_amdgcn_s_setprio(0); } while (0)
#define PG8_WAIT_V(n) asm volatile("s_waitcnt vmcnt(" #n ")" ::: "memory")
#define PG8_WAIT_L(n) asm volatile("s_waitcnt lgkmcnt(" #n ")" ::: "memory")
#define PG8_BAR __builtin_amdgcn_s_barrier()
#define PG8_SCHED __builtin_amdgcn_sched_barrier(0)
    Unit cur, nxt; int ui = 0;
    if (!S.next(0, cur)) return;
    f32x4 acc[2][2][4][2];
#pragma unroll
    for (int a = 0; a < 2; ++a)
#pragma unroll
        for (int b = 0; b < 2; ++b)
#pragma unroll
            for (int m = 0; m < 4; ++m)
#pragma unroll
                for (int n = 0; n < 2; ++n) acc[a][b][m][n] = (f32x4){0.f, 0.f, 0.f, 0.f};
    bf16x8 At[4][2], B0[2][2], B1[2][2];
    const char* cA = (const char*)g.A + (size_t)cur.pm * tstep; const char* cB = (const char*)g.Bt + (size_t)cur.pn * tstep;
    S.a_ready(cur);
    if constexpr (SP2) {
        PG8_STAGE(PG8_SB(0, 0), cB, voffB); PG8_STAGE(PG8_SB(0, 1), cB + hstep, voffB); PG8_STAGE(PG8_SA(0, 0), cA, voffA); PG8_STAGE(PG8_SA(0, 1), cA + hstep, voffA);
        if (wr == 1) PG8_BAR;
        PG8_WAIT_V(2); PG8_BAR;
        PG8_STAGE(PG8_SB(1, 0), cB + kstep, voffB); PG8_STAGE(PG8_SA(1, 0), cA + kstep, voffA); PG8_STAGE(PG8_SB(1, 1), cB + hstep + kstep, voffB);
        PG8_WAIT_V(6); PG8_BAR;
    } else {
        PG8_STAGE(PG8_SB(0, 0), cB, voffB); PG8_STAGE(PG8_SA(0, 0), cA, voffA); PG8_STAGE(PG8_SB(0, 1), cB + hstep, voffB); PG8_STAGE(PG8_SA(0, 1), cA + hstep, voffA);
        if (wr == 1) PG8_BAR;
        PG8_WAIT_V(4); PG8_BAR;
        PG8_STAGE(PG8_SB(1, 0), cB + kstep, voffB); PG8_STAGE(PG8_SA(1, 0), cA + kstep, voffA); PG8_STAGE(PG8_SB(1, 1), cB + hstep + kstep, voffB);
        PG8_WAIT_V(6); PG8_BAR;
    }
    for (;;) {
        const bool has_next = S.next(ui + 1, nxt);
        const char* nA = has_next ? (const char*)g.A + (size_t)nxt.pm * tstep : cA; const char* nB = has_next ? (const char*)g.Bt + (size_t)nxt.pn * tstep : cB;
        for (int t = 0; t < nt; t += 2) {
            const bool last = (t == nt - 2);
            const char* a1 = cA + (size_t)(t + 1) * kstep;
            const char* a2 = last ? nA : cA + (size_t)(t + 2) * kstep; const char* b2 = last ? nB : cB + (size_t)(t + 2) * kstep;
            const char* a3 = a2 + kstep; const char* b3 = b2 + kstep;
            if (last && has_next) S.a_ready(nxt);
            if constexpr (SP2) {
            PG8_LDB(B0, 0, 0); PG8_LDB(B1, 0, 1); PG8_SCHED; PG8_LDA(At, 0, 0); PG8_STAGE(PG8_SA(1, 1), a1 + hstep, voffA);
            PG8_WAIT_V(8); PG8_WAIT_L(0); PG8_BAR; PG8_MMA(0, 0, At, B0); PG8_MMA(0, 1, At, B1); PG8_BAR; PG8_SCHED;
            PG8_LDA(At, 0, 1); PG8_STAGE(PG8_SB(0, 0), b2, voffB); PG8_STAGE(PG8_SB(0, 1), b2 + hstep, voffB); PG8_STAGE(PG8_SA(0, 0), a2, voffA);
            PG8_WAIT_V(8); PG8_WAIT_L(0); PG8_BAR; PG8_MMA(1, 0, At, B0); PG8_MMA(1, 1, At, B1); PG8_BAR; PG8_SCHED;
            PG8_LDB(B0, 1, 0); PG8_LDB(B1, 1, 1); PG8_SCHED; PG8_LDA(At, 1, 0); PG8_STAGE(PG8_SA(0, 1), a2 + hstep, voffA);
            PG8_WAIT_V(8); PG8_WAIT_L(0); PG8_BAR; PG8_MMA(0, 0, At, B0); PG8_MMA(0, 1, At, B1); PG8_BAR; PG8_SCHED;
            PG8_LDA(At, 1, 1); PG8_STAGE(PG8_SB(1, 0), b3, voffB); PG8_STAGE(PG8_SB(1, 1), b3 + hstep, voffB); PG8_STAGE(PG8_SA(1, 0), a3, voffA);
            PG8_WAIT_V(8); PG8_WAIT_L(0); PG8_BAR; PG8_MMA(1, 0, At, B0); PG8_MMA(1, 1, At, B1); PG8_BAR; PG8_SCHED;
            } else {
            PG8_LDB(B0, 0, 0); PG8_SCHED; PG8_LDA(At, 0, 0); PG8_STAGE(PG8_SA(1, 1), a1 + hstep, voffA);
            PG8_WAIT_L(8); PG8_BAR; PG8_WAIT_L(0); PG8_MMA(0, 0, At, B0); PG8_BAR; PG8_SCHED;
            PG8_LDB(B1, 0, 1); PG8_STAGE(PG8_SB(0, 0), b2, voffB);
            PG8_BAR; PG8_WAIT_L(0); PG8_MMA(0, 1, At, B1); PG8_BAR;
            PG8_LDA(At, 0, 1); PG8_STAGE(PG8_SA(0, 0), a2, voffA);
            PG8_BAR; PG8_WAIT_L(0); PG8_MMA(1, 0, At, B0); PG8_BAR; PG8_SCHED;
            PG8_STAGE(PG8_SB(0, 1), b2 + hstep, voffB);
            PG8_WAIT_V(6); PG8_BAR; PG8_MMA(1, 1, At, B1); PG8_BAR;
            PG8_LDB(B0, 1, 0); PG8_SCHED; PG8_LDA(At, 1, 0); PG8_STAGE(PG8_SA(0, 1), a2 + hstep, voffA);
            PG8_WAIT_L(8); PG8_BAR; PG8_WAIT_L(0); PG8_MMA(0, 0, At, B0); PG8_BAR; PG8_SCHED;
            PG8_LDB(B1, 1, 1); PG8_STAGE(PG8_SB(1, 0), b3, voffB);
            PG8_BAR; PG8_WAIT_L(0); PG8_MMA(0, 1, At, B1); PG8_BAR;
            PG8_LDA(At, 1, 1); PG8_STAGE(PG8_SA(1, 0), a3, voffA);
            PG8_BAR; PG8_WAIT_L(0); PG8_MMA(1, 0, At, B0); PG8_BAR; PG8_SCHED;
            PG8_STAGE(PG8_SB(1, 1), b3 + hstep, voffB);
            PG8_WAIT_V(6); PG8_BAR; PG8_MMA(1, 1, At, B1); PG8_BAR;
            }
        }
        if constexpr (ALIGN_EPI) { if (wr == 0) PG8_BAR; }
        if constexpr (!Epi::AFTER_DRAIN) { E(acc, cur, wr, wc, fr, fq); S.done(cur); }
        if (!has_next) break;
#pragma unroll
        for (int a = 0; a < 2; ++a)
#pragma unroll
            for (int b = 0; b < 2; ++b)
#pragma unroll
                for (int m = 0; m < 4; ++m)
#pragma unroll
                    for (int n = 0; n < 2; ++n) acc[a][b][m][n] = (f32x4){0.f, 0.f, 0.f, 0.f};
        cur = nxt; cA = nA; cB = nB; ++ui;
        if constexpr (ALIGN_EPI) { if (wr == 1) PG8_BAR; }
    }
    PG8_WAIT_V(0);
    if constexpr (!ALIGN_EPI) { if (wr == 0) PG8_BAR; }
    PG8_BAR;
    if constexpr (Epi::AFTER_DRAIN) { E.fused(acc, cur, wr, wc, fr, fq, lds, wid, lane); S.done(cur); }
#undef PG8_SA
#undef PG8_SB
#undef PG8_STAGE
#undef PG8_LDA
#undef PG8_LDB
#undef PG8_MMA
#undef PG8_WAIT_V
#undef PG8_WAIT_L
#undef PG8_BAR
#undef PG8_SCHED
}
}

#ifndef PG8_SP2
#define PG8_SP2 true
#endif
#ifndef PG8_ALIGN
#define PG8_ALIGN true
#endif
#include <hip/hip_bf16.h>
#include <cmath>
namespace attn_body {
using bf16=__hip_bfloat16;
using bf16x8=__attribute__((ext_vector_type(8)))short;
using s16x4=__attribute__((ext_vector_type(4)))short;
using f32x16=__attribute__((ext_vector_type(16)))float;
using u32x4=__attribute__((ext_vector_type(4)))unsigned;
constexpr int D=64;
constexpr int NW=8,QBLK=32,QB=QBLK*NW,KVBLK=64;
__device__ __forceinline__ int crow(int r,int hi){return (r&3)+8*(r>>2)+4*hi;}
#define SBAR() __builtin_amdgcn_sched_barrier(0)
__device__ __forceinline__ void cmask(f32x16&p0,f32x16&p1,int jb,int qrel,int hi){
  const float NEG=-INFINITY; int kb=64*jb+4*hi;
  #pragma unroll
  for(int r=0;r<16;++r){int kv=kb+(r&3)+8*(r>>2); if(kv>qrel)p0[r]=NEG; if(kv+32>qrel)p1[r]=NEG;}
}

constexpr int NSLOT=3, SLOTB=8192;
constexpr int LDS_K=0, LDS_V=NSLOT*SLOTB, LDS_WS=2*NSLOT*SLOTB, LDS_OST=LDS_WS+NW*64*4, LDS_BYTES=LDS_OST+NW*4096;
constexpr float C2=0.125f*1.4426950408889634f;
__device__ __forceinline__ void glds16(const void*gsrc,unsigned lds_dst){unsigned keep;
  asm volatile("s_mov_b32 %0, m0\n\ts_mov_b32 m0, %2\n\ts_nop 0\n\tglobal_load_lds_dwordx4 %1, off\n\ts_mov_b32 m0, %0":"=&s"(keep):"v"(gsrc),"s"(lds_dst):"memory");}
__device__ __forceinline__ float max3f(float a,float b,float c){float r;asm("v_max3_f32 %0, %1, %2, %3":"=v"(r):"v"(a),"v"(b),"v"(c));return r;}
__device__ __forceinline__ float max2f(float a,float b){float r;asm("v_max_f32_e32 %0, %1, %2":"=v"(r):"v"(a),"v"(b));return r;}
__device__ __forceinline__ float fadd_s(float a,float b){float r;asm("v_add_f32_e32 %0, %1, %2":"=v"(r):"v"(a),"v"(b));return r;}
__device__ __forceinline__ float fsub_s(float a,float b){float r;asm("v_sub_f32_e32 %0, %1, %2":"=v"(r):"v"(a),"v"(b));return r;}
typedef float f32x2_t __attribute__((ext_vector_type(2))); typedef __bf16 bf16x2_t __attribute__((ext_vector_type(2)));
__device__ __forceinline__ unsigned cvtpk_s(float lo,float hi){f32x2_t v={lo,hi};bf16x2_t b=__builtin_convertvector(v,bf16x2_t);return __builtin_bit_cast(unsigned,b);}
#define WAIT_BAR(N) asm volatile("s_waitcnt vmcnt(" #N ") lgkmcnt(0)\n\ts_barrier":::"memory")

__device__ __forceinline__ void qkt(f32x16&p0,f32x16&p1,const char*Kslot,const bf16x8*qr,const f32x16&negm,int r32,int hi){
  const char*kb=Kslot+hi*1024+r32*16;
  #pragma unroll
  for(int d0=0;d0<4;++d0){
    const bf16x8 b0=*reinterpret_cast<const bf16x8*>(kb+d0*2048);
    const bf16x8 b1=*reinterpret_cast<const bf16x8*>(kb+d0*2048+512);
    if(d0==0){p0=__builtin_amdgcn_mfma_f32_32x32x16_bf16(b0,qr[0],negm,0,0,0);p1=__builtin_amdgcn_mfma_f32_32x32x16_bf16(b1,qr[0],negm,0,0,0);}
    else{p0=__builtin_amdgcn_mfma_f32_32x32x16_bf16(b0,qr[d0],p0,0,0,0);p1=__builtin_amdgcn_mfma_f32_32x32x16_bf16(b1,qr[d0],p1,0,0,0);}}
}
typedef __attribute__((address_space(3))) const char* lds_cptr;
typedef short v4i16_t __attribute__((ext_vector_type(4)));
__device__ __forceinline__ void kload8(bf16x8*kf,lds_cptr kp){
  kf[0]=*(const __attribute__((address_space(3))) bf16x8*)(kp);      kf[1]=*(const __attribute__((address_space(3))) bf16x8*)(kp+512);
  kf[2]=*(const __attribute__((address_space(3))) bf16x8*)(kp+2048); kf[3]=*(const __attribute__((address_space(3))) bf16x8*)(kp+2560);
  kf[4]=*(const __attribute__((address_space(3))) bf16x8*)(kp+4096); kf[5]=*(const __attribute__((address_space(3))) bf16x8*)(kp+4608);
  kf[6]=*(const __attribute__((address_space(3))) bf16x8*)(kp+6144); kf[7]=*(const __attribute__((address_space(3))) bf16x8*)(kp+6656);
}
__device__ __forceinline__ void kload2(bf16x8*kf,lds_cptr kp,int j){ kf[2*j]=*(const __attribute__((address_space(3))) bf16x8*)(kp+j*2048); kf[2*j+1]=*(const __attribute__((address_space(3))) bf16x8*)(kp+j*2048+512); }
__device__ __forceinline__ s16x4 vtr(lds_cptr p){ return __builtin_bit_cast(s16x4,__builtin_amdgcn_ds_read_tr16_b64_v4i16((__attribute__((address_space(3))) v4i16_t*)p)); }
__device__ __forceinline__ float rowmax(const f32x16&p0,const f32x16&p1){
  float a=max3f(p0[0],p0[1],p1[0]),b=max3f(p0[2],p0[3],p1[1]);a=max3f(a,p1[2],p1[3]);
  #pragma unroll
  for(int r=4;r<16;r+=4){a=max3f(a,p0[r],p0[r+1]);b=max3f(b,p0[r+2],p0[r+3]);a=max3f(a,p1[r],p1[r+1]);b=max3f(b,p1[r+2],p1[r+3]);}
  const float m=max2f(a,b);
  auto rr=__builtin_amdgcn_permlane32_swap(__float_as_uint(m),__float_as_uint(m),false,false);
  return max2f(__uint_as_float(rr[0]),__uint_as_float(rr[1]));
}
__device__ __forceinline__ void pv(f32x16*o,int vb,bf16x8 pa0,bf16x8 pa1,bf16x8 pa2,bf16x8 pa3){
  #pragma unroll
  for(int d0=0;d0<2;++d0){s16x4 lo[4],hi[4];
    #pragma unroll
    for(int ks=0;ks<4;++ks){
      asm volatile("ds_read_b64_tr_b16 %0,%1 offset:%c2":"=&v"(lo[ks]):"v"(vb),"i"(d0*4096+ks*1024):"memory");
      asm volatile("ds_read_b64_tr_b16 %0,%1 offset:%c2":"=&v"(hi[ks]):"v"(vb),"i"(d0*4096+ks*1024+512):"memory");}
    asm volatile("s_waitcnt lgkmcnt(0)":::"memory");SBAR();
    #define PK(k) (bf16x8){lo[k][0],lo[k][1],lo[k][2],lo[k][3],hi[k][0],hi[k][1],hi[k][2],hi[k][3]}
    o[d0]=__builtin_amdgcn_mfma_f32_32x32x16_bf16(pa0,PK(0),o[d0],0,0,0);
    o[d0]=__builtin_amdgcn_mfma_f32_32x32x16_bf16(pa1,PK(1),o[d0],0,0,0);
    o[d0]=__builtin_amdgcn_mfma_f32_32x32x16_bf16(pa2,PK(2),o[d0],0,0,0);
    o[d0]=__builtin_amdgcn_mfma_f32_32x32x16_bf16(pa3,PK(3),o[d0],0,0,0);
    #undef PK
  }
}

#ifndef ATTN_STORE16
#define ATTN_STORE16(p,v) (*(u32x4*)(p)=(v))
#endif
template<int THRL> __device__ __forceinline__ void attn_unit(int qb,int SEQ,const bf16*Q,int QP,const bf16*__restrict__ K,const bf16*__restrict__ V,int KP,bf16*O,int OP,char*shm){
  int tid_=threadIdx.x; asm volatile("":"+v"(tid_)); const int tid=tid_,lane=tid&63,r32=lane&31,hi=lane>>5; const int wid=__builtin_amdgcn_readfirstlane(tid>>6);
  const int q0=qb*QB;
  const bf16*Qw=Q+(long)(q0+wid*QBLK)*QP;
  const bf16*Kh=K,*Vh=V;
  const unsigned lds0=(unsigned)(uintptr_t)shm;
  float*wsf=(float*)(shm+LDS_WS)+wid*64;
  const bf16*ksrc=Kh+(long)lane*KP+wid*8;
  const bf16*vsrc=Vh+(long)(16*(wid&3)+(lane>>2))*KP+(wid>>2)*32+(lane&3)*8;
  const unsigned kdst=lds0+LDS_K+wid*1024, vdst=lds0+LDS_V+wid*1024;
  #define DMA_K(t,slot) glds16(ksrc+(long)(t)*KVBLK*KP,(unsigned)__builtin_amdgcn_readfirstlane(kdst+(slot)))
  #define DMA_V(t,slot) glds16(vsrc+(long)(t)*KVBLK*KP,(unsigned)__builtin_amdgcn_readfirstlane(vdst+(slot)))
  const int vb0=(int)(lds0+LDS_V)+((lane>>4)&1)*32+(lane&3)*8+(4*hi+((lane&15)>>2))*64;
  const char*Kbase=shm+LDS_K; bf16x8 kf[8];
  const lds_cptr shm3=(lds_cptr)shm; const lds_cptr kp0=shm3+LDS_K+hi*1024+r32*16; const lds_cptr vp0=shm3+LDS_V+((lane>>4)&1)*32+(lane&3)*8+(4*hi+((lane&15)>>2))*64;
  const int NT=SEQ/KVBLK;
  DMA_K(0,0);DMA_V(0,0);DMA_K(1,SLOTB);
  bf16x8 qr[4];
  #pragma unroll
  for(int d0=0;d0<4;++d0)qr[d0]=*reinterpret_cast<const bf16x8*>(&Qw[(long)r32*QP+d0*16+hi*8]);
  float mhat=0.f,l_reg=0.f;f32x16 o[2];o[0]=f32x16{};o[1]=f32x16{};f32x16 negm=f32x16{};asm volatile("":"+v"(negm));
  const int qrel=wid*QBLK+r32;
  #define CMASK(P0,P1,t) do{}while(0)
  bool resc=false;
  #define START(P0,P1) do{ const float rm=rowmax(P0,P1); resc=false; \
    { const float dl=rm; mhat=fadd_s(mhat,dl); \
      _Pragma("unroll") for(int r=0;r<16;++r){P0[r]=fsub_s(P0[r],dl);P1[r]=fsub_s(P1[r],dl);} \
      _Pragma("unroll") for(int r=0;r<16;++r)negm[r]=-mhat; asm volatile("":"+v"(negm)); } \
    _Pragma("unroll") for(int r=0;r<16;++r)P0[r]=__builtin_amdgcn_exp2f(P0[r]); }while(0)
  #define RESC() do{ if(resc){ asm volatile("s_waitcnt lgkmcnt(0)":::"memory"); \
      _Pragma("unroll") for(int d_=0;d_<2;++d_) _Pragma("unroll") for(int r=0;r<16;++r)o[d_][r]*=wsf[crow(r,hi)]; } }while(0)
  f32x16 pA0,pA1,pB0,pB1;
  int sl_prev=0,sl_cur=0,sl_next=SLOTB;
  #define ROT() do{sl_prev=sl_cur;sl_cur=sl_next;sl_next=(sl_next==(NSLOT-1)*SLOTB)?0:sl_next+SLOTB;}while(0)
  DMA_K(2,2*SLOTB);
  WAIT_BAR(3);
  qkt(pA0,pA1,Kbase,qr,negm,r32,hi);asm volatile("s_nop 15\n\ts_nop 7":"+v"(pA0),"+v"(pA1));CMASK(pA0,pA1,0);
  START(pA0,pA1);
  _Pragma("unroll") for(int r=0;r<16;++r)pA1[r]=__builtin_amdgcn_exp2f(pA1[r]);
  WAIT_BAR(0);
  DMA_K(3,0);DMA_V(1,SLOTB);
  ROT();
  kload8(kf,kp0+sl_cur);
  WAIT_BAR(2);
  s16x4 vlo[8],vhi[8]; u32x4 pw0,pw1,pw2,pw3;
  #define PKW(P,B) cvtpk_s(P[B],P[B+1])
  #define PAF(k) __builtin_bit_cast(bf16x8,pw##k)
  #define VFR(i) (bf16x8){vlo[i][0],vlo[i][1],vlo[i][2],vlo[i][3],vhi[i][0],vhi[i][1],vhi[i][2],vhi[i][3]}
  #define PIN(x) asm volatile("":"+v"(x))
  #define MX3(a,b,c) __builtin_fmaxf(__builtin_fmaxf((a),(b)),(c))
  #define GAPA(MF,A0,A1,A2,A3,W0,W1,PW) do{ MF; sacc+=A0; sacc+=A1; sacc+=A2; sacc+=A3; PIN(sacc); W0; W1; PIN(PW); SBAR(); }while(0)
  #define EX(v) __builtin_amdgcn_exp2f(v)
  #define GAPB(MF,X,B) do{ MF; X[B]=EX(X[B]); X[B+1]=EX(X[B+1]); X[B+2]=EX(X[B+2]); X[B+3]=EX(X[B+3]); PIN(X); SBAR(); }while(0)
  #define VRD(i) do{ vlo[i]=vtr(vp_+(((i)>>2)*4096+((i)&3)*1024)); vhi[i]=vtr(vp_+(((i)>>2)*4096+((i)&3)*1024+512)); }while(0)
  #define KRD(G,j) do{ if(G){ kload2(kf,kp0+sl_next,j); SBAR(); } }while(0)
  #define STEP(C0,C1,P0,P1,t,GK,GV,GL) do{ SBAR(); \
    const lds_cptr vp_=vp0+sl_prev; \
    VRD(0); SBAR(); float sacc=(P0[0]+P0[1]); \
    GAPA(C0=__builtin_amdgcn_mfma_f32_32x32x16_bf16(kf[0],qr[0],negm,0,0,0), P0[2],P0[3],P0[4],P0[5],     pw0[0]=PKW(P0,0), pw0[1]=PKW(P0,2), pw0); \
    VRD(4); SBAR(); GAPA(C1=__builtin_amdgcn_mfma_f32_32x32x16_bf16(kf[1],qr[0],negm,0,0,0), P0[6],P0[7],P0[8],P0[9],     pw0[2]=PKW(P0,4), pw0[3]=PKW(P0,6), pw0); \
    VRD(1); SBAR(); GAPA(C0=__builtin_amdgcn_mfma_f32_32x32x16_bf16(kf[2],qr[1],C0,0,0,0),   P0[10],P0[11],P0[12],P0[13], pw1[0]=PKW(P0,8), pw1[1]=PKW(P0,10), pw1); \
    VRD(5); SBAR(); GAPA(C1=__builtin_amdgcn_mfma_f32_32x32x16_bf16(kf[3],qr[1],C1,0,0,0),   P0[14],P0[15],P1[0],P1[1],   pw1[2]=PKW(P0,12),pw1[3]=PKW(P0,14), pw1); \
    VRD(2); SBAR(); GAPA(C0=__builtin_amdgcn_mfma_f32_32x32x16_bf16(kf[4],qr[2],C0,0,0,0),   P1[2],P1[3],P1[4],P1[5],     pw2[0]=PKW(P1,0), pw2[1]=PKW(P1,2), pw2); \
    VRD(6); SBAR(); GAPA(C1=__builtin_amdgcn_mfma_f32_32x32x16_bf16(kf[5],qr[2],C1,0,0,0),   P1[6],P1[7],P1[8],P1[9],     pw2[2]=PKW(P1,4), pw2[3]=PKW(P1,6), pw2); \
    VRD(3); SBAR(); GAPA(C0=__builtin_amdgcn_mfma_f32_32x32x16_bf16(kf[6],qr[3],C0,0,0,0),   P1[10],P1[11],P1[12],P1[13], pw3[0]=PKW(P1,8), pw3[1]=PKW(P1,10), pw3); \
    VRD(7); SBAR(); GAPA(C1=__builtin_amdgcn_mfma_f32_32x32x16_bf16(kf[7],qr[3],C1,0,0,0),   P1[14],P1[15],0.f,0.f,       pw3[2]=PKW(P1,12),pw3[3]=PKW(P1,14), pw3); \
    l_reg+=sacc; \
    if(GK){DMA_K((t)+3,sl_cur);} if(GV){DMA_V((t)+1,sl_next);} \
    CMASK(C0,C1,t); \
    { float a=MX3(C0[0],C0[1],C1[0]),b=MX3(C0[2],C0[3],C1[1]); a=MX3(a,C1[2],C1[3]); \
      _Pragma("unroll") for(int r=4;r<16;r+=4){a=MX3(a,C0[r],C0[r+1]);b=MX3(b,C0[r+2],C0[r+3]);a=MX3(a,C1[r],C1[r+1]);b=MX3(b,C1[r+2],C1[r+3]);} \
      float rm=__builtin_fmaxf(a,b); { auto rr=__builtin_amdgcn_permlane32_swap(__float_as_uint(rm),__float_as_uint(rm),false,false); rm=__builtin_fmaxf(__uint_as_float(rr[0]),__uint_as_float(rr[1])); } \
      resc=false; \
      if(__builtin_expect(__any(rm>(float)THRL),0)){ const float dl=__builtin_fmaxf(rm,0.f); mhat+=dl; \
        _Pragma("unroll") for(int r=0;r<16;++r){C0[r]-=dl;C1[r]-=dl;} \
        _Pragma("unroll") for(int r=0;r<16;++r)negm[r]=-mhat; asm volatile("":"+v"(negm)); \
        const float f=__builtin_amdgcn_exp2f(-dl); l_reg*=f; if(hi==0)wsf[r32]=f; resc=true; } } \
    SBAR(); \
    GAPB(o[0]=__builtin_amdgcn_mfma_f32_32x32x16_bf16(PAF(0),VFR(0),o[0],0,0,0), C0,0); \
    GAPB(o[1]=__builtin_amdgcn_mfma_f32_32x32x16_bf16(PAF(0),VFR(4),o[1],0,0,0), C0,4); \
    KRD(GL,0); GAPB(o[0]=__builtin_amdgcn_mfma_f32_32x32x16_bf16(PAF(1),VFR(1),o[0],0,0,0), C0,8); \
    KRD(GL,1); GAPB(o[1]=__builtin_amdgcn_mfma_f32_32x32x16_bf16(PAF(1),VFR(5),o[1],0,0,0), C0,12); \
    KRD(GL,2); GAPB(o[0]=__builtin_amdgcn_mfma_f32_32x32x16_bf16(PAF(2),VFR(2),o[0],0,0,0), C1,0); \
    KRD(GL,3); GAPB(o[1]=__builtin_amdgcn_mfma_f32_32x32x16_bf16(PAF(2),VFR(6),o[1],0,0,0), C1,4); \
    GAPB(o[0]=__builtin_amdgcn_mfma_f32_32x32x16_bf16(PAF(3),VFR(3),o[0],0,0,0), C1,8); \
    GAPB(o[1]=__builtin_amdgcn_mfma_f32_32x32x16_bf16(PAF(3),VFR(7),o[1],0,0,0), C1,12); \
    }while(0)
  int t=1;
  #undef CMASK
  #define CMASK(P0,P1,t) do{}while(0)
  for(;t+5<NT;t+=2){
    STEP(pB0,pB1,pA0,pA1,t,true,true,true);     WAIT_BAR(2); RESC(); ROT();
    STEP(pA0,pA1,pB0,pB1,t+1,true,true,true);   WAIT_BAR(2); RESC(); ROT();
  }
  #undef CMASK
  #define CMASK(P0,P1,t) do{}while(0)
  #define ENDW(tt) do{ if((tt)+3<NT){WAIT_BAR(2);} else if((tt)+2<NT){WAIT_BAR(1);} else {WAIT_BAR(0);} }while(0)
  for(;t+1<NT;t+=2){
    STEP(pB0,pB1,pA0,pA1,t,(t+3<NT),(t+1<NT),(t+1<NT));       ENDW(t);   RESC(); ROT();
    STEP(pA0,pA1,pB0,pB1,t+1,(t+4<NT),(t+2<NT),(t+2<NT));     ENDW(t+1); RESC(); ROT();
  }
  STEP(pB0,pB1,pA0,pA1,NT-1,false,false,false); RESC();
  { float sacc=pB0[0]+pB0[1]; _Pragma("unroll") for(int r=2;r<16;++r)sacc+=pB0[r]; _Pragma("unroll") for(int r=0;r<16;++r)sacc+=pB1[r]; l_reg+=sacc;
    pw0=(u32x4){PKW(pB0,0),PKW(pB0,2),PKW(pB0,4),PKW(pB0,6)};pw1=(u32x4){PKW(pB0,8),PKW(pB0,10),PKW(pB0,12),PKW(pB0,14)};pw2=(u32x4){PKW(pB1,0),PKW(pB1,2),PKW(pB1,4),PKW(pB1,6)};pw3=(u32x4){PKW(pB1,8),PKW(pB1,10),PKW(pB1,12),PKW(pB1,14)};
    SBAR(); pv(o,vb0+sl_cur,PAF(0),PAF(1),PAF(2),PAF(3)); }
  #undef PKW
  #undef PAF
  #undef VFR
  #undef PIN
  #undef MX3
  #undef GAPA
  #undef GAPB
  #undef EX
  #undef VRD
  #undef KRD
  #undef STEP
  #undef ENDW
  {auto rr=__builtin_amdgcn_permlane32_swap(__float_as_uint(l_reg),__float_as_uint(l_reg),false,false);l_reg=__uint_as_float(rr[0])+__uint_as_float(rr[1]);}
  if(hi==0)wsf[32+r32]=l_reg;asm volatile("s_waitcnt lgkmcnt(0)":::"memory");
  float rli[16];
  #pragma unroll
  for(int r=0;r<16;++r)rli[r]=__builtin_amdgcn_rcpf(wsf[32+crow(r,hi)]);
  bf16*Ow=O+(long)(q0+wid*QBLK)*OP;
  { bf16*stg=(bf16*)(shm+LDS_OST)+wid*2048;
    #pragma unroll
    for(int r=0;r<16;++r){const int orow=crow(r,hi);
      #pragma unroll
      for(int d0=0;d0<2;++d0)stg[orow*64+d0*32+r32]=__float2bfloat16(o[d0][r]*rli[r]);}
    asm volatile("s_waitcnt lgkmcnt(0)":::"memory");
    #pragma unroll
    for(int i=0;i<4;++i){const int row=i*8+(lane>>3),ch=lane&7; const u32x4 v=*(const u32x4*)(stg+row*64+ch*8); ATTN_STORE16(Ow+(long)row*OP+ch*8,v);} }
  asm volatile("s_waitcnt lgkmcnt(0)\n\ts_barrier":::"memory");
  #undef DMA_K
  #undef DMA_V
  #undef CMASK
  #undef START
  #undef RESC
  #undef ROT
}
constexpr int ATTN_LDS_BYTES=LDS_BYTES;
#undef SBAR
#undef WAIT_BAR
}
namespace xb {
#define GAS __attribute__((address_space(1)))
#define LAS __attribute__((address_space(3)))
typedef GAS unsigned gu32;
typedef GAS unsigned long long gu64;
#define RLX_AGENT __ATOMIC_RELAXED, __HIP_MEMORY_SCOPE_AGENT
#define LDS_WAIT() asm volatile("s_waitcnt lgkmcnt(0)" ::: "memory")
#define VM_WAIT() asm volatile("s_waitcnt vmcnt(0)" ::: "memory")
__device__ __forceinline__ unsigned long long rt() { return __builtin_amdgcn_s_memrealtime(); }
__device__ __forceinline__ unsigned f2bf(float f) { unsigned u = __builtin_bit_cast(unsigned, f); return (u + 0x7fffu + ((u >> 16) & 1u)) >> 16; }
__device__ __forceinline__ unsigned pk2(float lo, float hi) { return f2bf(lo) | (f2bf(hi) << 16); }

#define XB_TMO      128
#define XB_XCNT(j)  (256  + 64 * (j))
#define XB_XSUB(j)  (1280 + 64 * (j))
#define XB_XGEN(j)  (2304 + 64 * (j))
#define XB_TOP      3328
#define XB_TOPGEN   3392
#define XCD_BAR_WORDS 3456
#define XB_SPIN_CAP (1u << 18)

__device__ __forceinline__ unsigned xb_ld(unsigned* p)              { return __hip_atomic_load(p, __ATOMIC_RELAXED, __HIP_MEMORY_SCOPE_AGENT); }
__device__ __forceinline__ unsigned xb_add(unsigned* p, unsigned v) { return __hip_atomic_fetch_add(p, v, __ATOMIC_RELAXED, __HIP_MEMORY_SCOPE_AGENT); }
__device__ __forceinline__ unsigned xb_xcc_id() { return (unsigned)__builtin_amdgcn_s_getreg((3 << 11) | 20) & 0xFu; }
#define XB_SPIN(cond, bar) do { unsigned _sp = 0; while (cond) { __builtin_amdgcn_s_sleep(1); \
    if ((++_sp & 255u) == 0u) { if (xb_ld(&(bar)[XB_TMO])) break; if (_sp > XB_SPIN_CAP) { atomicAdd(&(bar)[XB_TMO], 1u); break; } } } } while (0)

struct XcdBarrier {
    unsigned* bar; unsigned x;
    volatile LAS unsigned* st;
};

__device__ __forceinline__ XcdBarrier xcd_barrier_post(unsigned* bar, volatile LAS unsigned* st) {
    XcdBarrier b; b.bar = bar; b.x = xb_xcc_id(); b.st = st;
    if (threadIdx.x == 0) (void)xb_add(&bar[XB_XCNT(b.x)], 1u);
    return b;
}
__device__ __forceinline__ void xcd_barrier_complete(unsigned* bar, unsigned x, unsigned& nloc, unsigned& nx) {
    const unsigned G = gridDim.x * gridDim.y * gridDim.z;
    unsigned sum, cnt, mine, sp = 0u;
    for (;;) {
        sum = 0u; cnt = 0u; mine = 0u;
#pragma unroll
        for (unsigned j = 0; j < 16; ++j) { const unsigned c = xb_ld(&bar[XB_XCNT(j)]); sum += c; cnt += (c > 0u) ? 1u : 0u; mine = (j == x) ? c : mine; }
        if (sum == G) break;
        __builtin_amdgcn_s_sleep(1);
        if ((++sp & 255u) == 0u) { if (xb_ld(&bar[XB_TMO])) break; if (sp > XB_SPIN_CAP) { atomicAdd(&bar[XB_TMO], 1u); break; } }
    }
    nloc = mine > 0u ? mine : 1u; nx = cnt > 0u ? cnt : 1u;
}

__device__ __forceinline__ void xcd_barrier(const XcdBarrier& b) {
    asm volatile("s_waitcnt vmcnt(0)" ::: "memory");
    __syncthreads();
    if (threadIdx.x == 0) {
        unsigned* bar = b.bar;
        __builtin_amdgcn_s_waitcnt(0);
        unsigned nloc = b.st[0], nx = b.st[1];
        if (nloc == 0u) { xcd_barrier_complete(bar, b.x, nloc, nx); b.st[0] = nloc; b.st[1] = nx; }
        const unsigned old = xb_add(&bar[XB_XSUB(b.x)], 1u);
        const unsigned gen = old / nloc;
        if (old + 1u == (gen + 1u) * nloc) {
            __builtin_amdgcn_fence(__ATOMIC_RELEASE, "agent");
            asm volatile("s_waitcnt vmcnt(0)" ::: "memory");
            const unsigned og = xb_add(&bar[XB_TOP], 1u);
            const unsigned tg = og / nx;
            if (og + 1u == (tg + 1u) * nx) xb_add(&bar[XB_TOPGEN], 1u);
            else XB_SPIN(xb_ld(&bar[XB_TOPGEN]) == tg, bar);
            __builtin_amdgcn_fence(__ATOMIC_ACQUIRE, "agent");
            xb_add(&bar[XB_XGEN(b.x)], 1u);
            asm volatile("s_waitcnt vmcnt(0)" ::: "memory");
        } else {
            XB_SPIN(xb_ld(&bar[XB_XGEN(b.x)]) == gen, bar);
            __builtin_amdgcn_fence(__ATOMIC_ACQUIRE, "agent");
            asm volatile("s_waitcnt vmcnt(0)" ::: "memory");
        }
    }
    __syncthreads();
}

}

namespace mk {
typedef unsigned short bf16_t;
typedef short bf16x8 __attribute__((ext_vector_type(8)));
typedef float f32x4 __attribute__((ext_vector_type(4)));
typedef unsigned u32x4 __attribute__((ext_vector_type(4)));
typedef unsigned u32x2 __attribute__((ext_vector_type(2)));
typedef float f32x2 __attribute__((ext_vector_type(2)));

constexpr int DMODEL = 1024, TS = 16384, NSEG = 4, DFF = 4096;
constexpr int EIN = 1792, OIN = 4368, OINP = 4608, OOUT = 768;
constexpr float EPS = 1e-6f;
constexpr size_t MiB = (size_t)1 << 20;
constexpr size_t WS_W1T = 1 * MiB, WS_W2T = 33 * MiB, WS_WINE = 65 * MiB, WS_WOUTE = 72 * MiB, WS_WINO = 76 * MiB, WS_WOUTO = 94 * MiB,
                 WS_GW = 97 * MiB, WS_H = 98 * MiB, WS_PROJ = 130 * MiB, WS_SCR = 274 * MiB, WS_END = 512 * MiB;
constexpr size_t SC_HID = 0;
constexpr size_t SC_LA = 0, SC_UU = 64 * MiB, SC_AGG = 128 * MiB;
constexpr size_t SC_QKVP = 0, SC_DNI = 48 * MiB, SC_OB = 192 * MiB, SC_LSE = 224 * MiB, SC_EGL = 225 * MiB;
constexpr int DNI_BYTES = 73728, DNI_W = 0, DNI_QT = 16384, DNI_KTT = 32768, DNI_A = 49152, DNI_U = 57344;
constexpr int LDS_BYTES = 147456;
constexpr int NT = 512, NW = 8;

struct Params { const float* in[25]; float* out; unsigned char* ws; };

__device__ __forceinline__ float bf2f(bf16_t v) { return __uint_as_float(((unsigned)v) << 16); }
__device__ __forceinline__ unsigned f2bf(float f) { unsigned u = __float_as_uint(f); return (u + 0x7fffu + ((u >> 16) & 1u)) >> 16; }
__device__ __forceinline__ unsigned pk2(float lo, float hi) { return f2bf(lo) | (f2bf(hi) << 16); }
__device__ __forceinline__ float wave_sum(float v) {
#pragma unroll
    for (int o = 1; o < 64; o <<= 1) v += __shfl_xor(v, o);
    return v;
}
__device__ __forceinline__ float sigm(float x) { return 1.f / (1.f + __expf(-x)); }
__device__ __forceinline__ float softplus(float x) { return x > 20.f ? x : log1pf(__expf(x)); }
__device__ __forceinline__ float silu(float x) { return x * sigm(x); }
__device__ __forceinline__ float gelu_tanh(float x) { const float t = 0.7978845608028654f * (x + 0.044715f * x * x * x); return 0.5f * x * (1.f + tanhf(t)); }
__device__ __forceinline__ void unpack8(const u32x4 v, float* f) {
    f[0] = __uint_as_float(v.x << 16); f[1] = __uint_as_float(v.x & 0xffff0000u); f[2] = __uint_as_float(v.y << 16); f[3] = __uint_as_float(v.y & 0xffff0000u);
    f[4] = __uint_as_float(v.z << 16); f[5] = __uint_as_float(v.z & 0xffff0000u); f[6] = __uint_as_float(v.w << 16); f[7] = __uint_as_float(v.w & 0xffff0000u);
}
#define MK_IDS() int tid = threadIdx.x; asm volatile("" : "+v"(tid)); const int lane = tid & 63, wave = __builtin_amdgcn_readfirstlane(tid >> 6); const int gw = blockIdx.x * NW + wave, NGW = gridDim.x * NW; (void)lane; (void)wave; (void)gw; (void)NGW
#define MFMA16(a, b, c) __builtin_amdgcn_mfma_f32_16x16x32_bf16((a), (b), (c), 0, 0, 0)

__device__ __forceinline__ void transpose_item(const float* W, int K, int Nsrc, int Npad, bf16_t* WT, float* scr, int item, int lane, const float* gain = nullptr) {
    const int nblk = Npad / 32, kb = item / nblk, nb = item % nblk, k0 = 64 * kb, n0 = 32 * nb;
    const int n = n0 + (lane & 31);
#pragma unroll 8
    for (int i = 0; i < 32; ++i) { const int kk = 2 * i + (lane >> 5); scr[kk * 33 + (lane & 31)] = (n < Nsrc) ? W[(size_t)(k0 + kk) * Nsrc + n] * (gain ? gain[k0 + kk] : 1.f) : 0.f; }
    asm volatile("s_waitcnt lgkmcnt(0)" ::: "memory");
    const int c = lane & 7;
#pragma unroll
    for (int j = 0; j < 4; ++j) { const int nn = (lane >> 3) + 8 * j; const float* s = scr + (8 * c) * 33 + nn;
        u32x4 o; o.x = pk2(s[0 * 33], s[1 * 33]); o.y = pk2(s[2 * 33], s[3 * 33]); o.z = pk2(s[4 * 33], s[5 * 33]); o.w = pk2(s[6 * 33], s[7 * 33]);
        *(u32x4*)(WT + (size_t)(n0 + nn) * K + k0 + 8 * c) = o; }
    asm volatile("s_waitcnt lgkmcnt(0)" ::: "memory");
}
__device__ __forceinline__ void phase_prologue(const Params& p, char* lds) {
    MK_IDS();
    float* scr = (float*)(lds + wave * 16384);
    unsigned char* ws = p.ws;
    constexpr int I_F1 = 16 * 128, I_F2 = 64 * 32, I_IE = 16 * 56, I_OE = 16 * 32, I_IO = 16 * 144, I_OO = 12 * 32;
    constexpr int T_F1 = 4 * I_F1, T_F2 = T_F1 + 4 * I_F2, T_IE = T_F2 + 2 * I_IE, T_OE = T_IE + 2 * I_OE, T_IO = T_OE + 2 * I_IO, T_OO = T_IO + 2 * I_OO;
    for (int it = gw; it < T_OO; it += NGW) {
        if (it < T_F1) { const int l = it / I_F1, r = it % I_F1; transpose_item(p.in[6] + (size_t)l * 1024 * 4096, 1024, 4096, 4096, (bf16_t*)(ws + WS_W1T) + (size_t)l * 4096 * 1024, scr, r, lane, p.in[4] + l * 1024); }
        else if (it < T_F2) { const int q = it - T_F1, l = q / I_F2, r = q % I_F2; transpose_item(p.in[7] + (size_t)l * 4096 * 1024, 4096, 1024, 1024, (bf16_t*)(ws + WS_W2T) + (size_t)l * 1024 * 4096, scr, r, lane); }
        else if (it < T_IE) { const int q = it - T_F2, l = q / I_IE, r = q % I_IE; transpose_item(p.in[8] + (size_t)l * 1024 * EIN, 1024, EIN, EIN, (bf16_t*)(ws + WS_WINE) + (size_t)l * EIN * 1024, scr, r, lane, p.in[3] + (2 * l) * 1024); }
        else if (it < T_OE) { const int q = it - T_IE, l = q / I_OE, r = q % I_OE; transpose_item(p.in[9] + (size_t)l * 1024 * 1024, 1024, 1024, 1024, (bf16_t*)(ws + WS_WOUTE) + (size_t)l * 1024 * 1024, scr, r, lane); }
        else if (it < T_IO) { const int q = it - T_OE, l = q / I_IO, r = q % I_IO; transpose_item(p.in[19] + (size_t)l * 1024 * OIN, 1024, OIN, OINP, (bf16_t*)(ws + WS_WINO) + (size_t)l * OINP * 1024, scr, r, lane, p.in[3] + (2 * l + 1) * 1024); }
        else { const int q = it - T_IO, l = q / I_OO, r = q % I_OO; transpose_item(p.in[20] + (size_t)l * OOUT * 1024, OOUT, 1024, 1024, (bf16_t*)(ws + WS_WOUTO) + (size_t)l * 1024 * OOUT, scr, r, lane); }
    }
    bf16_t* GW = (bf16_t*)(ws + WS_GW);
    const int gt = gw * 64 + lane, NGT = NGW * 64;
    for (int idx = gt; idx < 2 * 2 * 2 * 8 * 4096; idx += NGT) {
        const int d = idx & 63, e = (idx >> 6) & 63, blk = (idx >> 12) & 7, gate = (idx >> 15) & 1, dir = (idx >> 16) & 1, j = (idx >> 17) & 1;
        const float* src = gate ? p.in[16] : p.in[14];
        GW[idx] = (bf16_t)f2bf(src[((((size_t)j * 2 + dir) * 8 + blk) * 64 + d) * 64 + e]);
    }
}

__device__ __forceinline__ void phase_x0(const float* x, bf16_t* xb, float* ssq) {
    MK_IDS();
    for (int m = gw; m < TS; m += NGW) {
        const f32x4* xr = (const f32x4*)(x + (size_t)m * DMODEL) + lane;
        f32x4 v[4]; float s = 0.f;
#pragma unroll
        for (int j = 0; j < 4; ++j) { v[j] = xr[64 * j]; s += (v[j].x * v[j].x + v[j].y * v[j].y) + (v[j].z * v[j].z + v[j].w * v[j].w); }
        s = wave_sum(s);
        u32x2* o8 = (u32x2*)(xb + (size_t)m * DMODEL) + lane;
#pragma unroll
        for (int j = 0; j < 4; ++j) { u32x2 o; o.x = pk2(v[j].x, v[j].y); o.y = pk2(v[j].z, v[j].w); o8[64 * j] = o; }
        if (lane < 16) ssq[(size_t)m * 16 + lane] = lane == 0 ? s : 0.f;
    }
}
__device__ __forceinline__ void zero_f32(float* ptr, int n) {
    MK_IDS();
    for (int i = gw * 64 + lane; i < n; i += NGW * 64) ptr[i] = 0.f;
}
__device__ __forceinline__ void phase_rmsnorm_final(const bf16_t* xb, float* x, const float* g) {
    MK_IDS();
    for (int m = gw; m < TS; m += NGW) {
        const u32x2* xr = (const u32x2*)(xb + (size_t)m * DMODEL) + lane; f32x4* xw = (f32x4*)(x + (size_t)m * DMODEL) + lane; const f32x4* gr = (const f32x4*)g + lane;
        f32x4 v[4]; float s = 0.f;
#pragma unroll
        for (int j = 0; j < 4; ++j) { const u32x2 w = xr[64 * j]; v[j] = (f32x4){__uint_as_float(w.x << 16), __uint_as_float(w.x & 0xffff0000u), __uint_as_float(w.y << 16), __uint_as_float(w.y & 0xffff0000u)};
            s += (v[j].x * v[j].x + v[j].y * v[j].y) + (v[j].z * v[j].z + v[j].w * v[j].w); }
        const float rstd = 1.f / sqrtf(wave_sum(s) * (1.f / DMODEL) + EPS);
#pragma unroll
        for (int j = 0; j < 4; ++j) { const f32x4 gg = gr[64 * j]; xw[64 * j] = v[j] * rstd * gg; }
    }
}
struct EpiRes {
    static constexpr bool PERM = false, AFTER_DRAIN = false;
    bf16_t* xb; float* ssq; int ldc;
    __device__ __forceinline__ void operator()(const pg8::f32x4 (&acc)[2][2][4][2], const pg8::Unit& u, int wr, int wc, int fr, int fq) const {
        const int col0 = u.pn * pg8::BM + wc * 32 + 4 * fq;
#pragma unroll
        for (int ai = 0; ai < 2; ++ai)
#pragma unroll
            for (int m = 0; m < 4; ++m) { const int row = u.pm * pg8::BM + ai * pg8::HALF + wr * 64 + m * 16 + fr; const size_t off = (size_t)row * ldc + col0; float sq = 0.f;
                u32x2 bw[2][2];
#pragma unroll
                for (int bj = 0; bj < 2; ++bj)
#pragma unroll
                    for (int n = 0; n < 2; ++n) bw[bj][n] = *(const u32x2*)(xb + off + bj * pg8::HALF + n * 16);
#pragma unroll
                for (int bj = 0; bj < 2; ++bj)
#pragma unroll
                    for (int n = 0; n < 2; ++n) { const pg8::f32x4 a = acc[ai][bj][m][n];
                        const float o0 = __uint_as_float(bw[bj][n].x << 16) + a[0], o1 = __uint_as_float(bw[bj][n].x & 0xffff0000u) + a[1];
                        const float o2 = __uint_as_float(bw[bj][n].y << 16) + a[2], o3 = __uint_as_float(bw[bj][n].y & 0xffff0000u) + a[3];
                        u32x2 w; w.x = pg8::cvt_pk_bf16(o0, o1); w.y = pg8::cvt_pk_bf16(o2, o3); *(u32x2*)(xb + off + bj * pg8::HALF + n * 16) = w;
                        sq += (o0 * o0 + o1 * o1) + (o2 * o2 + o3 * o3); }
                sq += __shfl_xor(sq, 16); sq += __shfl_xor(sq, 32);
                if (fq == 0) ssq[(size_t)row * 16 + u.pn * 4 + wc] = sq;
                if (m & 1) asm volatile("" ::: "memory"); }
    }
};

__device__ __forceinline__ void even_qk_post(bf16_t* proj, const float* qg, const float* kg, int S) {
    MK_IDS();
    const int d = lane, axis = d >> 5, f = d & 15, half = (d >> 4) & 1;
    const float inv = exp2f(-(float)f * (13.287712379549449f / 16.f));
    const float gq = qg[d], gk = kg[d];
    for (int t = gw; t < TS; t += NGW) {
        const int s = t % S; const int pos = axis ? (s & 63) : (s >> 6);
        const float ang = (float)pos * inv; float sn, cs; sincosf(ang, &sn, &cs);
        bf16_t* row = proj + (size_t)t * EIN;
#pragma unroll
        for (int hh = 0; hh < 10; ++hh) {
            const int c0 = hh < 8 ? hh * 64 : 512 + (hh - 8) * 64;
            const float x = bf2f(row[c0 + d]);
            const float ss = wave_sum(x * x);
            const float y = x * (1.f / sqrtf(ss * (1.f / 64.f) + EPS)) * (hh < 8 ? gq : gk);
            const float pr = __shfl_xor(y, 16);
            float o = y * cs + (half ? pr : -pr) * sn;
            if (hh < 8) o *= attn_body::C2;
            row[c0 + d] = (bf16_t)f2bf(o);
        }
    }
}
__device__ __forceinline__ void even_lru_prep(const bf16_t* proj, const float* cw, const float* cb, const bf16_t* GWj, const float* br, const float* bi, const float* lam,
                                              bf16_t* LA, bf16_t* UU, f32x2* AGG, int S, char* lds) {
    MK_IDS();
    constexpr int XST = 1040;
    for (int tile = blockIdx.x; tile < TS / 64; tile += gridDim.x) {
        const int t0 = tile * 64;
        __syncthreads();
#pragma unroll 2
        for (int k = 0; k < 8; ++k) {
            const int idx = tid + k * NT, i = idx >> 6, cgp = idx & 63, t = t0 + i, s = t % S, ch = cgp * 8;
            float acc[8];
#pragma unroll
            for (int e = 0; e < 8; ++e) acc[e] = cb[ch + e];
#pragma unroll
            for (int j = 0; j < 4; ++j) { const int sp = s + j - 2;
                if (sp >= 0 && sp < S) { const u32x4 v = *(const u32x4*)(proj + (size_t)(t + j - 2) * EIN + 768 + ch); float xv[8]; unpack8(v, xv);
#pragma unroll
                    for (int e = 0; e < 8; ++e) acc[e] += cw[j * 512 + ch + e] * xv[e]; } }
            u32x4 o; o.x = pk2(acc[0], acc[1]); o.y = pk2(acc[2], acc[3]); o.z = pk2(acc[4], acc[5]); o.w = pk2(acc[6], acc[7]);
            *(u32x4*)(lds + i * XST + ch * 2) = o;
        }
        __syncthreads();
        const int G = lane >> 4, l16 = lane & 15, ch0 = wave * 64;
        for (int dir = 0; dir < 2; ++dir)
            for (int nt = 0; nt < 4; ++nt) {
                const int e = nt * 16 + l16, ch = ch0 + e;
                bf16x8 Br[2], Bi[2];
#pragma unroll
                for (int kk = 0; kk < 2; ++kk) {
                    Br[kk] = *(const bf16x8*)(GWj + ((((size_t)dir * 2 + 0) * 8 + wave) * 64 + e) * 64 + kk * 32 + G * 8);
                    Bi[kk] = *(const bf16x8*)(GWj + ((((size_t)dir * 2 + 1) * 8 + wave) * 64 + e) * 64 + kk * 32 + G * 8);
                }
                const float brv = br[dir * 512 + ch], biv = bi[dir * 512 + ch], spl = softplus(-lam[dir * 512 + ch]);
#pragma unroll
                for (int mt = 0; mt < 4; ++mt) {
                    f32x4 ar = {0.f, 0.f, 0.f, 0.f}, ai = {0.f, 0.f, 0.f, 0.f};
#pragma unroll
                    for (int kk = 0; kk < 2; ++kk) { const bf16x8 a = *(const bf16x8*)(lds + (mt * 16 + l16) * XST + (ch0 + kk * 32 + G * 8) * 2); ar = MFMA16(a, Br[kk], ar); ai = MFMA16(a, Bi[kk], ai); }
#pragma unroll
                    for (int r = 0; r < 4; ++r) { const int i = mt * 16 + G * 4 + r;
                        const float xc = bf2f(*(const bf16_t*)(lds + i * XST + ch * 2));
                        const float rg = __builtin_amdgcn_rcpf(1.f + __expf(-(ar[r] + brv))), ig = __builtin_amdgcn_rcpf(1.f + __expf(-(ai[r] + biv)));
                        const float la = -8.f * rg * spl; const float uu = __builtin_amdgcn_sqrtf(fmaxf(1.f - __expf(2.f * la), 0.f)) * (ig * xc);
                        const size_t o = ((size_t)dir * TS + t0 + i) * 512 + ch; LA[o] = (bf16_t)f2bf(la); UU[o] = (bf16_t)f2bf(uu); }
                }
            }
        asm volatile("s_waitcnt vmcnt(0)" ::: "memory");
        __syncthreads();
        {
            const int ch = tid;
#pragma unroll
            for (int dir = 0; dir < 2; ++dir) {
                float h = 0.f, P = 0.f;
                const bf16_t* la = LA + ((size_t)dir * TS + t0) * 512 + ch; const bf16_t* uu = UU + ((size_t)dir * TS + t0) * 512 + ch;
#pragma unroll
                for (int q = 0; q < 64; q += 8) {
                    float lv[8], uv[8];
#pragma unroll
                    for (int e = 0; e < 8; ++e) { const int i = dir ? 63 - (q + e) : q + e; lv[e] = bf2f(la[(size_t)i * 512]); uv[e] = bf2f(uu[(size_t)i * 512]); }
#pragma unroll
                    for (int e = 0; e < 8; ++e) { h = __expf(lv[e]) * h + uv[e]; P += lv[e]; }
                }
                AGG[((size_t)dir * (TS / 64) + tile) * 512 + ch] = (f32x2){P, h};
            }
        }
    }
}
__device__ __forceinline__ void even_lru_scan(const bf16_t* LA, const bf16_t* UU, const f32x2* AGG, const bf16_t* proj, bf16_t* Y, int S) {
    MK_IDS();
    const int ch = tid, TPB = S / 64;
    for (int tile = blockIdx.x; tile < TS / 64; tile += gridDim.x) {
        const int t0 = tile * 64, tb0 = (tile / TPB) * TPB;
        float cf = 0.f, cr = 0.f;
        for (int k0 = tb0; k0 < tile; k0 += 8) { f32x2 a[8];
#pragma unroll
            for (int q = 0; q < 8; ++q) { const int k = k0 + q < tile ? k0 + q : tile - 1; a[q] = AGG[(size_t)k * 512 + ch]; }
#pragma unroll
            for (int q = 0; q < 8; ++q) if (k0 + q < tile) cf = cf * __expf(a[q].x) + a[q].y; }
        for (int k0 = tb0 + TPB - 1; k0 > tile; k0 -= 8) { f32x2 a[8];
#pragma unroll
            for (int q = 0; q < 8; ++q) { const int k = k0 - q > tile ? k0 - q : tile + 1; a[q] = AGG[((size_t)(TS / 64) + k) * 512 + ch]; }
#pragma unroll
            for (int q = 0; q < 8; ++q) if (k0 - q > tile) cr = cr * __expf(a[q].x) + a[q].y; }
        float hf[64];
        {
            const bf16_t* la = LA + (size_t)t0 * 512 + ch; const bf16_t* uu = UU + (size_t)t0 * 512 + ch; float h = cf;
#pragma unroll
            for (int q = 0; q < 64; q += 8) {
                float lv[8], uv[8];
#pragma unroll
                for (int e = 0; e < 8; ++e) { lv[e] = bf2f(la[(size_t)(q + e) * 512]); uv[e] = bf2f(uu[(size_t)(q + e) * 512]); }
#pragma unroll
                for (int e = 0; e < 8; ++e) { h = __expf(lv[e]) * h + uv[e]; hf[q + e] = h; }
            }
        }
        {
            const bf16_t* la = LA + ((size_t)TS + t0) * 512 + ch; const bf16_t* uu = UU + ((size_t)TS + t0) * 512 + ch; float h = cr;
#pragma unroll
            for (int q = 0; q < 64; q += 8) {
                float lv[8], uv[8], gv[8];
#pragma unroll
                for (int e = 0; e < 8; ++e) { const int i = 63 - (q + e); lv[e] = bf2f(la[(size_t)i * 512]); uv[e] = bf2f(uu[(size_t)i * 512]); gv[e] = bf2f(proj[(size_t)(t0 + i) * EIN + 1280 + ch]); }
#pragma unroll
                for (int e = 0; e < 8; ++e) { const int i = 63 - (q + e); h = __expf(lv[e]) * h + uv[e]; Y[(size_t)(t0 + i) * DMODEL + 512 + ch] = (bf16_t)f2bf((hf[i] + h) * gelu_tanh(gv[e])); }
            }
        }
    }
}

__device__ __forceinline__ void odd_conv(const bf16_t* proj, const float* cw, bf16_t* QKVP, int S) {
    MK_IDS();
    for (int cr = 0; cr < (TS / 64 + (int)gridDim.x - 1) / (int)gridDim.x; ++cr) {
        const int c = cr * (int)gridDim.x + (int)blockIdx.x; if (c >= TS / 64) break;
        const int tb = c * 64 + wave * 8, sb = tb % S;
#pragma unroll
        for (int blk = 0; blk < 3; ++blk) {
            const int ch = blk * 512 + lane * 8;
            u32x4 rows[11];
#pragma unroll
            for (int q = 0; q < 11; ++q) { const int sp = sb + q - 2; rows[q] = (u32x4){0u, 0u, 0u, 0u};
                if (sp >= 0 && sp < S) rows[q] = *(const u32x4*)(proj + (size_t)(tb + q - 2) * OINP + ch); }
            f32x4 w0[4], w1[4];
#pragma unroll
            for (int j = 0; j < 4; ++j) { w0[j] = *(const f32x4*)(cw + j * 1536 + ch); w1[j] = *(const f32x4*)(cw + j * 1536 + ch + 4); }
#pragma unroll
            for (int i = 0; i < 8; ++i) {
                float acc[8];
#pragma unroll
                for (int e = 0; e < 8; ++e) acc[e] = 0.f;
#pragma unroll
                for (int j = 0; j < 4; ++j) { float xv[8]; unpack8(rows[i + j], xv);
                    acc[0] += w0[j].x * xv[0]; acc[1] += w0[j].y * xv[1]; acc[2] += w0[j].z * xv[2]; acc[3] += w0[j].w * xv[3];
                    acc[4] += w1[j].x * xv[4]; acc[5] += w1[j].y * xv[5]; acc[6] += w1[j].z * xv[6]; acc[7] += w1[j].w * xv[7]; }
                float ss = 0.f;
#pragma unroll
                for (int e = 0; e < 8; ++e) { acc[e] = silu(acc[e]); ss += acc[e] * acc[e]; }
                if (blk < 2) {
                    ss += __shfl_xor(ss, 1); ss += __shfl_xor(ss, 2); ss += __shfl_xor(ss, 4); ss += __shfl_xor(ss, 8);
                    const float rn = 1.f / sqrtf(ss + EPS);
#pragma unroll
                    for (int e = 0; e < 8; ++e) acc[e] *= rn;
                }
                u32x4 o; o.x = pk2(acc[0], acc[1]); o.y = pk2(acc[2], acc[3]); o.z = pk2(acc[4], acc[5]); o.w = pk2(acc[6], acc[7]);
                *(u32x4*)(QKVP + (size_t)(tb + i) * 1536 + ch) = o;
            }
        }
    }
}

__device__ __forceinline__ int frag128(int r, int k) { return ((((r >> 4) * 4 + (k >> 5)) * 64 + ((k >> 3) & 3) * 16 + (r & 15)) << 3) + (k & 7); }
__device__ __forceinline__ int frag64(int r, int k) { return ((((r >> 4) * 2 + (k >> 5)) * 64 + ((k >> 3) & 3) * 16 + (r & 15)) << 3) + (k & 7); }
__device__ __forceinline__ void odd_prep(const bf16_t* QKVP, const bf16_t* proj, const float* alog, const float* dtb, unsigned char* DNI, float* EGL, char* lds) {
    MK_IDS();
    constexpr int RS = 272;
    constexpr int HOFF = 69632;
    const float scale = 0.08838834764831845f;
    for (int itq = 0; itq < (TS / 64 + (int)gridDim.x - 1) / (int)gridDim.x * 4; ++itq) {
        const int c_ = (itq >> 2) * (int)gridDim.x + (int)blockIdx.x; if (c_ >= TS / 64) break; const int it0 = (c_ * 4 + (itq & 3)) * 2;
        int tq_ = tid; asm volatile("" : "+v"(tq_));
        const int half = tq_ >> 8, ht = tq_ & 255, hwave = __builtin_amdgcn_readfirstlane(ht >> 6), G = (tq_ & 63) >> 4, l16 = tq_ & 15;
        char* L = lds + half * HOFF;
        char* KS = L, *QS = L + 17408, *VS = L + 34816; float* LM = (float*)(L + 52224); float* GC = (float*)(L + 68608); float* BT = GC + 64; float* EG = BT + 64;
        const int it = it0 + half; const int d = it & 1, h = (it >> 1) & 3, c = it >> 3, t0 = c * 64;
        __syncthreads();
#pragma unroll
        for (int k = 0; k < 4; ++k) { const int idx = ht + k * 256, i = idx >> 4, pc = idx & 15; const int tk = d ? t0 + 63 - i : t0 + i;
            const bf16_t* src = QKVP + (size_t)tk * 1536 + h * 128 + pc * 8;
            *(u32x4*)(QS + i * RS + pc * 16) = *(const u32x4*)(src);
            *(u32x4*)(KS + i * RS + pc * 16) = *(const u32x4*)(src + 512);
            *(u32x4*)(VS + i * RS + pc * 16) = *(const u32x4*)(src + 1024); }
        if (hwave == 0) {
            const int i = lane; const int tk = d ? t0 + 63 - i : t0 + i;
            const float bl = bf2f(proj[(size_t)tk * OINP + 2048 + d * 4 + h]), al = bf2f(proj[(size_t)tk * OINP + 2056 + d * 4 + h]);
            const float beta = sigm(bl); float g = -__expf(alog[d * 4 + h]) * softplus(al + dtb[d * 4 + h]);
#pragma unroll
            for (int o = 1; o < 64; o <<= 1) { const float v = __shfl_up(g, o); if (lane >= o) g += v; }
            GC[i] = g; BT[i] = beta; EG[i] = __expf(g);
        }
        __syncthreads();
        {
            const bool isq = hwave >= 2; const char* XS = isq ? QS : KS;
#pragma unroll
            for (int mm = 0; mm < 2; ++mm) { const int mt = (hwave & 1) * 2 + mm;
                bf16x8 a[4];
#pragma unroll
                for (int kk = 0; kk < 4; ++kk) a[kk] = *(const bf16x8*)(XS + (mt * 16 + l16) * RS + (kk * 32 + G * 8) * 2);
#pragma unroll
                for (int nt = 0; nt < 4; ++nt) { f32x4 acc = {0.f, 0.f, 0.f, 0.f};
#pragma unroll
                    for (int kk = 0; kk < 4; ++kk) { const bf16x8 bb = *(const bf16x8*)(KS + (nt * 16 + l16) * RS + (kk * 32 + G * 8) * 2); acc = MFMA16(a[kk], bb, acc); }
                    const int j = nt * 16 + l16; const float gj = GC[j];
#pragma unroll
                    for (int r = 0; r < 4; ++r) { const int i = mt * 16 + G * 4 + r; const float dec = __expf(fminf(GC[i] - gj, 0.f));
                        if (!isq) LM[i * 64 + j] = (j < i) ? BT[i] * acc[r] * dec : 0.f;
                        else ((bf16_t*)(DNI + (size_t)it * DNI_BYTES + DNI_A))[frag64(i, j)] = (bf16_t)f2bf((j <= i) ? acc[r] * scale * dec : 0.f); }
                }
            }
        }
        __syncthreads();
        {
            float sol[64];
            const int cc = ht & 127; const bool isw = ht >= 128; const char* XS = isw ? KS : VS;
#pragma unroll
            for (int i = 0; i < 64; ++i) {
                float v = bf2f(*(const bf16_t*)(XS + i * RS + cc * 2)) * BT[i]; if (isw) v *= EG[i];
                float a0 = 0.f, a1 = 0.f;
#pragma unroll
                for (int j4 = 0; j4 < (i + 3) / 4; ++j4) { const f32x4 l4 = *(const f32x4*)(LM + i * 64 + j4 * 4);
                    if (j4 * 4 + 0 < i) a0 += l4.x * sol[j4 * 4 + 0]; if (j4 * 4 + 1 < i) a1 += l4.y * sol[j4 * 4 + 1];
                    if (j4 * 4 + 2 < i) a0 += l4.z * sol[j4 * 4 + 2]; if (j4 * 4 + 3 < i) a1 += l4.w * sol[j4 * 4 + 3];
                    if ((j4 & 1) == 1) asm volatile("" ::: "memory"); }
                v -= a0 + a1;
                sol[i] = v;
                ((bf16_t*)(DNI + (size_t)it * DNI_BYTES + (isw ? DNI_W : DNI_U)))[isw ? frag128(i, cc) : i * 128 + cc] = (bf16_t)f2bf(v);
                asm volatile("" ::: "memory");
            }
        }
        {
            const float gl = GC[63];
#pragma unroll
            for (int k = 0; k < 4; ++k) { const int idx = ht + k * 256;
                {
                    const int i = idx & 63, kg = idx >> 6; const u32x4 raw = *(const u32x4*)(QS + i * RS + kg * 16); float f[8]; unpack8(raw, f); const float sc = scale * EG[i];
                    u32x4 o; o.x = pk2(f[0] * sc, f[1] * sc); o.y = pk2(f[2] * sc, f[3] * sc); o.z = pk2(f[4] * sc, f[5] * sc); o.w = pk2(f[6] * sc, f[7] * sc);
                    *(u32x4*)((bf16_t*)(DNI + (size_t)it * DNI_BYTES + DNI_QT) + frag128(i, kg * 8)) = o; }
                {
                    const int dm = idx & 127, tg = idx >> 7; float f[8];
#pragma unroll
                    for (int q = 0; q < 8; ++q) { const int i = tg * 8 + q; f[q] = bf2f(*(const bf16_t*)(KS + i * RS + dm * 2)) * __expf(gl - GC[i]); }
                    u32x4 o; o.x = pk2(f[0], f[1]); o.y = pk2(f[2], f[3]); o.z = pk2(f[4], f[5]); o.w = pk2(f[6], f[7]);
                    *(u32x4*)((bf16_t*)(DNI + (size_t)it * DNI_BYTES + DNI_KTT) + frag64(dm, tg * 8)) = o; }
            }
            if (ht == 0) EGL[it] = __expf(gl);
        }
    }
}

__device__ __forceinline__ void odd_scan(const unsigned char* DNI, const float* EGL, bf16_t* OB, int S, int nb, char* lds) {
    MK_IDS();
    constexpr int O_SB = 0, O_VN = 4352, O_OUT = 6656, PFD = 7;
    const int NC = S / 64, G = lane >> 4, l16 = lane & 15;
    const int nitems = nb * 64;
    const int mt = wave & 3; const bool lo = wave < 4;
    for (int item = blockIdx.x; item < nitems; item += gridDim.x) {
        const int e = (item >> 3) & 7, sq = (item & 7) | ((item >> 6) << 3); const int d = sq & 1, h = (sq >> 1) & 3, b = sq >> 3;
        __syncthreads();
        for (int i = tid; i < 4352 / 4; i += NT) ((unsigned*)(lds + O_SB))[i] = 0u;
        f32x4 Sreg = {0.f, 0.f, 0.f, 0.f};
        const long dstep = (long)(d ? -8 : 8) * DNI_BYTES;
        const unsigned char* base0 = DNI + (size_t)(((b * NC + (d ? NC - 1 : 0)) * 4 + h) * 2 + d) * DNI_BYTES;
        const unsigned char* pX = base0 + (lo ? DNI_W : DNI_QT) + ((mt * 4) * 64 + lane) * 16;
        const unsigned char* pA = base0 + DNI_A + ((mt * 2) * 64 + lane) * 16;
        const unsigned char* pK = base0 + DNI_KTT + ((wave * 2) * 64 + lane) * 16;
        const unsigned char* pU = base0 + DNI_U + ((mt * 16 + G * 4) * 128 + e * 16 + l16) * 2;
        const float* pE = EGL + (((b * NC + (d ? NC - 1 : 0)) * 4 + h) * 2 + d);
        const unsigned char* pP = base0 + (long)PFD * dstep + e * 9216 + (tid < 144 ? tid : 143) * 64;
        bf16_t* pO = OB + ((size_t)d * TS + (size_t)(b * NC + (d ? NC - 1 : 0)) * 64 + (d ? 63 - (tid >> 3) : (tid >> 3))) * 512 + h * 128 + e * 16 + (tid & 7) * 2;
        const long ostep = (long)(d ? -64 : 64) * 512;
        u32x4 aX[4], aA[2], aK[2], bX[4], bA[2], bK[2], cX[4], cA[2], cK[2];
        unsigned aU[4], bU[4], cU[4]; float aE, bE, cE; unsigned pf_dummy = 0u;
#define DN_LOAD(P) do { \
            _Pragma("unroll") for (int kk = 0; kk < 4; ++kk) P##X[kk] = *(const u32x4*)(pX + kk * 1024); \
            _Pragma("unroll") for (int kk = 0; kk < 2; ++kk) { P##A[kk] = *(const u32x4*)(pA + kk * 1024); P##K[kk] = *(const u32x4*)(pK + kk * 1024); } \
            _Pragma("unroll") for (int r = 0; r < 4; ++r) P##U[r] = *(const bf16_t*)(pU + r * 256); \
            P##E = *pE; pX += dstep; pA += dstep; pK += dstep; pU += dstep; pE += (d ? -8 : 8); } while (0)
#define DN_STEP(P, PL) do { \
            DN_LOAD(PL); \
            if (wave < 3) { asm volatile("global_load_dword %0, %1, off" : "+v"(pf_dummy) : "v"(pP) : "memory"); } \
            pP += dstep; \
            f32x4 acc = {0.f, 0.f, 0.f, 0.f}, acc2 = {0.f, 0.f, 0.f, 0.f}; \
            { bf16x8 sb_[4]; \
              _Pragma("unroll") for (int kk = 0; kk < 4; ++kk) sb_[kk] = *(const bf16x8*)(lds + O_SB + l16 * 272 + (kk * 32 + G * 8) * 2); \
              asm volatile("s_waitcnt lgkmcnt(0)" : "+v"(sb_[0]), "+v"(sb_[1]), "+v"(sb_[2]), "+v"(sb_[3]) :: "memory"); \
              acc = MFMA16(__builtin_bit_cast(bf16x8, P##X[0]), sb_[0], acc); acc2 = MFMA16(__builtin_bit_cast(bf16x8, P##X[1]), sb_[1], acc2); \
              acc = MFMA16(__builtin_bit_cast(bf16x8, P##X[2]), sb_[2], acc); acc2 = MFMA16(__builtin_bit_cast(bf16x8, P##X[3]), sb_[3], acc2); \
              acc = acc + acc2; } \
            if (lo) { u32x2 o; float v[4]; \
              _Pragma("unroll") for (int r = 0; r < 4; ++r) v[r] = __uint_as_float(P##U[r] << 16) - acc[r]; \
              o.x = attn_body::cvtpk_s(v[0], v[1]); o.y = attn_body::cvtpk_s(v[2], v[3]); \
              *(u32x2*)(lds + O_VN + l16 * 144 + (mt * 16 + G * 4) * 2) = o; } \
            asm volatile("s_waitcnt lgkmcnt(0)\n\ts_barrier" ::: "memory"); \
            bf16x8 vb[2]; \
            _Pragma("unroll") for (int kk = 0; kk < 2; ++kk) vb[kk] = *(const bf16x8*)(lds + O_VN + l16 * 144 + (kk * 32 + G * 8) * 2); \
            asm volatile("s_waitcnt lgkmcnt(0)" : "+v"(vb[0]), "+v"(vb[1]) :: "memory"); \
            Sreg = Sreg * P##E; \
            _Pragma("unroll") for (int kk = 0; kk < 2; ++kk) Sreg = MFMA16(__builtin_bit_cast(bf16x8, P##K[kk]), vb[kk], Sreg); \
            { u32x2 o; o.x = attn_body::cvtpk_s(Sreg[0], Sreg[1]); o.y = attn_body::cvtpk_s(Sreg[2], Sreg[3]); \
              *(u32x2*)(lds + O_SB + l16 * 272 + (wave * 16 + G * 4) * 2) = o; } \
            if (!lo) { \
              _Pragma("unroll") for (int kk = 0; kk < 2; ++kk) acc = MFMA16(__builtin_bit_cast(bf16x8, P##A[kk]), vb[kk], acc); \
              const unsigned w0_ = attn_body::cvtpk_s(acc[0], acc[1]), w1_ = attn_body::cvtpk_s(acc[2], acc[3]); \
              bf16_t* op_ = (bf16_t*)(lds + O_OUT + ((mt * 16 + G * 4) * 16 + l16) * 2); \
              op_[0] = (bf16_t)(w0_ & 0xffffu); op_[16] = (bf16_t)(w0_ >> 16); op_[32] = (bf16_t)(w1_ & 0xffffu); op_[48] = (bf16_t)(w1_ >> 16); } \
            asm volatile("s_waitcnt lgkmcnt(0)\n\ts_barrier" ::: "memory"); \
            *(unsigned*)pO = *(const unsigned*)(lds + O_OUT + tid * 4); pO += ostep; } while (0)
        DN_LOAD(a); DN_LOAD(b);
        __syncthreads();
        int n = 0;
        for (; n + 3 <= NC; n += 3) {
            DN_STEP(a, c);
            DN_STEP(b, a);
            DN_STEP(c, b);
        }
        if (n < NC) { DN_STEP(a, c); }
        if (n + 1 < NC) { DN_STEP(b, a); }
#undef DN_STEP
#undef DN_LOAD
        asm volatile("s_waitcnt vmcnt(0)" ::: "memory");
        asm volatile("" :: "v"(pf_dummy));
    }
}

__device__ __forceinline__ int t5_bucket(int rel) {
    const int n = rel < 0 ? -rel : rel; int v;
    if (n < 8) v = n; else v = 8 + (n >= 15) + (n >= 27) + (n >= 50) + (n >= 91) + (n >= 166) + (n >= 305) + (n >= 559);
    return (rel > 0 ? 16 : 0) + v;
}
__device__ __forceinline__ void odd_dilated(bf16_t* proj, const float* relb, float* LSE, int S, char* lds, int first_wg, int n_wg) {
    MK_IDS();
    constexpr int KST = 144, VST = 400, HOFF = 27648 + 25600 + 1024;
    const int half = tid >> 8, ht = tid & 255, wv = ht >> 6, G = lane >> 4, l16 = lane & 15;
    char* L = lds + half * HOFF; char* KS = L; char* VT = L + 27648; float* BIAS = (float*)(L + 27648 + 25600);
    const int NBb = S / 64;
    const int wgi = (int)blockIdx.x - first_wg;
    if (wgi < 0) return;
    for (int it0 = wgi * 2; it0 < 3072; it0 += n_wg * 2) {
        const int it = it0 + half; const int zb = it & 255, sl = (it >> 8) & 3, g = it >> 10;
        const int dil = g == 0 ? 1 : (g == 1 ? 4 : 16), lg = g * 2;
        const int M = S >> lg, MB = M / 64;
        const int b = zb / NBb, r0 = zb % NBb, rho = r0 / MB, n = r0 % MB;
        const int hc = (g * 4 + sl) * 64;
        const size_t tb = (size_t)b * S;
        __syncthreads();
#pragma unroll
        for (int k = 0; k < 6; ++k) { const int idx = ht + k * 256, kj = idx >> 3, pc = idx & 7; const int mk = 64 * n - 64 + kj;
            u32x4 kv = {0u, 0u, 0u, 0u}, vv = {0u, 0u, 0u, 0u};
            if (mk >= 0 && mk < M) { const bf16_t* rowp = proj + (tb + (size_t)mk * dil + rho) * OINP; kv = *(const u32x4*)(rowp + 2832 + hc + pc * 8); vv = *(const u32x4*)(rowp + 3600 + hc + pc * 8); }
            *(u32x4*)(KS + kj * KST + pc * 16) = kv;
            const unsigned w[4] = {vv.x, vv.y, vv.z, vv.w};
#pragma unroll
            for (int q = 0; q < 4; ++q) { *(bf16_t*)(VT + (pc * 8 + 2 * q) * VST + kj * 2) = (bf16_t)(w[q] & 0xffffu); *(bf16_t*)(VT + (pc * 8 + 2 * q + 1) * VST + kj * 2) = (bf16_t)(w[q] >> 16); } }
        if (ht < 129) BIAS[ht] = relb[t5_bucket((ht - 64) * dil) * 12 + g * 4 + sl];
        const int mq = 64 * n + 16 * wv + l16; const size_t tq = tb + (size_t)mq * dil + rho;
        bf16x8 qf[2];
#pragma unroll
        for (int kk = 0; kk < 2; ++kk) qf[kk] = *(const bf16x8*)(proj + tq * OINP + 2064 + hc + kk * 32 + G * 8);
        __syncthreads();
        f32x4 sc[9]; float mx = -1e30f;
#pragma unroll
        for (int kt = 0; kt < 9; ++kt) { f32x4 acc = {0.f, 0.f, 0.f, 0.f};
#pragma unroll
            for (int kk = 0; kk < 2; ++kk) { const bf16x8 a = *(const bf16x8*)(KS + ((wv + kt) * 16 + l16) * KST + (kk * 32 + G * 8) * 2); acc = MFMA16(a, qf[kk], acc); }
#pragma unroll
            for (int r = 0; r < 4; ++r) { const int kj = (wv + kt) * 16 + G * 4 + r; const int delta = kj - 64 - 16 * wv - l16; const int mk = 64 * n - 64 + kj;
                const bool ok = (delta >= -64) && (delta <= 64) && (mk >= 0) && (mk < M);
                const float s = ok ? acc[r] * 0.125f + BIAS[(delta < -64 ? -64 : (delta > 64 ? 64 : delta)) + 64] : -1e30f;
                acc[r] = s; mx = fmaxf(mx, s); }
            sc[kt] = acc; }
        mx = fmaxf(mx, __shfl_xor(mx, 16)); mx = fmaxf(mx, __shfl_xor(mx, 32));
        float sum = 0.f;
#pragma unroll
        for (int kt = 0; kt < 9; ++kt)
#pragma unroll
            for (int r = 0; r < 4; ++r) { const float pv_ = (sc[kt][r] > -1e29f) ? __expf(sc[kt][r] - mx) : 0.f; sc[kt][r] = pv_; sum += pv_; }
        sum += __shfl_xor(sum, 16); sum += __shfl_xor(sum, 32);
        f32x4 ot[4];
#pragma unroll
        for (int dt = 0; dt < 4; ++dt) ot[dt] = (f32x4){0.f, 0.f, 0.f, 0.f};
#pragma unroll
        for (int pp = 0; pp < 5; ++pp) {
            u32x4 pb; pb.x = pk2(sc[2 * pp][0], sc[2 * pp][1]); pb.y = pk2(sc[2 * pp][2], sc[2 * pp][3]);
            if (pp < 4) { pb.z = pk2(sc[2 * pp + 1][0], sc[2 * pp + 1][1]); pb.w = pk2(sc[2 * pp + 1][2], sc[2 * pp + 1][3]); } else { pb.z = 0u; pb.w = 0u; }
            const bf16x8 pbf = __builtin_bit_cast(bf16x8, pb);
#pragma unroll
            for (int dt = 0; dt < 4; ++dt) {
                u32x4 av; const u32x2 lo = *(const u32x2*)(VT + (dt * 16 + l16) * VST + ((wv + 2 * pp) * 16 + G * 4) * 2); av.x = lo.x; av.y = lo.y;
                if (pp < 4) { const u32x2 hi = *(const u32x2*)(VT + (dt * 16 + l16) * VST + ((wv + 2 * pp + 1) * 16 + G * 4) * 2); av.z = hi.x; av.w = hi.y; } else { av.z = 0u; av.w = 0u; }
                ot[dt] = MFMA16(__builtin_bit_cast(bf16x8, av), pbf, ot[dt]);
            }
        }
        const float rs = 1.f / sum;
        float* od = (float*)(proj + tq * OINP) + (g * 4 + sl) * 64;
#pragma unroll
        for (int dt = 0; dt < 4; ++dt) *(f32x4*)(od + dt * 16 + G * 4) = ot[dt] * rs;
        if (G == 0) LSE[tq * 12 + g * 4 + sl] = mx + __logf(sum);
    }
}

__device__ __forceinline__ void odd_combine(const bf16_t* OB, const bf16_t* proj, const float* LSE, const float* og, bf16_t* Y) {
    MK_IDS();
    const float g0 = og[lane * 2], g1 = og[lane * 2 + 1];
    for (int t = gw; t < TS; t += NGW) {
        const bf16_t* prow = proj + (size_t)t * OINP;
#pragma unroll
        for (int hh = 0; hh < 4; ++hh) {
            const unsigned a = *(const unsigned*)(OB + (size_t)t * 512 + hh * 128 + lane * 2), bb = *(const unsigned*)(OB + ((size_t)TS + t) * 512 + hh * 128 + lane * 2);
            const unsigned zz = *(const unsigned*)(prow + 1536 + hh * 128 + lane * 2);
            const float o0 = __uint_as_float(a << 16) + __uint_as_float(bb << 16), o1 = __uint_as_float(a & 0xffff0000u) + __uint_as_float(bb & 0xffff0000u);
            const float ss = wave_sum(o0 * o0 + o1 * o1); const float rn = 1.f / sqrtf(ss * (1.f / 128.f) + EPS);
            const float z0 = __uint_as_float(zz << 16), z1 = __uint_as_float(zz & 0xffff0000u);
            *(unsigned*)(Y + (size_t)t * OOUT + hh * 128 + lane * 2) = pk2(o0 * rn * g0 * silu(z0), o1 * rn * g1 * silu(z1));
        }
        const float* od = (const float*)prow;
#pragma unroll
        for (int sl = 0; sl < 4; ++sl) {
            const float l0 = LSE[(size_t)t * 12 + sl], l1 = LSE[(size_t)t * 12 + 4 + sl], l2 = LSE[(size_t)t * 12 + 8 + sl];
            const float m = fmaxf(l0, fmaxf(l1, l2)); const float w0 = __expf(l0 - m), w1 = __expf(l1 - m), w2 = __expf(l2 - m); const float rs = 1.f / (w0 + w1 + w2);
            const float v = (w0 * od[sl * 64 + lane] + w1 * od[256 + sl * 64 + lane] + w2 * od[512 + sl * 64 + lane]) * rs;
            Y[(size_t)t * OOUT + 512 + sl * 64 + lane] = (bf16_t)f2bf(v);
        }
    }
}

__global__ void __launch_bounds__(NT, 2) fwd_megakernel(Params p) {
    extern __shared__ __attribute__((aligned(16))) unsigned char lds_raw[];
    cg::grid_group grid = cg::this_grid();
    char* lds = (char*)lds_raw;
    PG8_LAS unsigned char* ldsl = (PG8_LAS unsigned char*)lds_raw;
    const int Gr = gridDim.x;
    volatile LAS unsigned* MISC = (volatile LAS unsigned*)((PG8_LAS unsigned char*)lds_raw + (LDS_BYTES - 128));
    if (threadIdx.x < 32) MISC[threadIdx.x] = 0u;
    __syncthreads();
    xb::XcdBarrier bar = xb::xcd_barrier_post((unsigned*)p.ws, MISC + 8);
#define GSYNC() xb::xcd_barrier(bar)
    unsigned char* ws = p.ws;
    bf16_t* H = (bf16_t*)(ws + WS_H); bf16_t* PROJ = (bf16_t*)(ws + WS_PROJ); unsigned char* SCR = ws + WS_SCR;

    phase_prologue(p, lds);
    grid.sync();

    float* SSQA = (float*)(SCR + 232 * MiB); float* SSQB = (float*)(SCR + 234 * MiB);
    bf16_t* YE = (bf16_t*)(SCR + 192 * MiB); bf16_t* YO = (bf16_t*)(SCR + SC_QKVP);
    for (int seg = 0; seg < NSEG; ++seg) {
        const int S = seg < 2 ? 16384 : 2048, nb = seg < 2 ? 1 : 8;
        const float* xin = (seg < 2 ? p.in[0] : p.in[1]) + (size_t)(seg & 1) * TS * DMODEL;
        float* xo = p.out + (size_t)seg * TS * DMODEL;
        phase_x0(xin, H, SSQB);
        GSYNC();
        for (int layer = 0; layer < 4; ++layer) {
            const int j = layer >> 1; const bool odd = layer & 1;
            {
                const int N = odd ? OINP : EIN;
                const bf16_t* Bt = odd ? (const bf16_t*)(ws + WS_WINO) + (size_t)j * OINP * 1024 : (const bf16_t*)(ws + WS_WINE) + (size_t)j * EIN * 1024;
                pg8::Gemm g{H, Bt, TS, N, 1024}; pg8::StaticOrder So; So.init(TS, N, Gr, (int)blockIdx.x);
                pg8::EpiBf16<0> E{PROJ, N, nullptr, 0, 0, 1.f, SSQB};
                pg8::gemm_phase<pg8::EpiBf16<0>, pg8::StaticOrder, true, true>(ldsl, g, So, E);
            }
            GSYNC();
            if (!odd) {
                even_qk_post(PROJ, p.in[10] + j * 64, p.in[11] + j * 64, S);
                even_lru_prep(PROJ, p.in[12] + j * 2048, p.in[13] + j * 512, (const bf16_t*)(ws + WS_GW) + (size_t)j * 2 * 2 * 8 * 4096, p.in[15] + j * 1024, p.in[17] + j * 1024, p.in[18] + j * 1024,
                              (bf16_t*)(SCR + SC_LA), (bf16_t*)(SCR + SC_UU), (f32x2*)(SCR + SC_AGG), S, lds);
                GSYNC();
                {
                    const int nqb = S / 256, nunits = nb * 8 * nqb;
                    for (int u = blockIdx.x; u < nunits; u += Gr) {
                        const int qb = u % nqb, h = (u / nqb) % 8, b = u / (nqb * 8), kvh = h >> 2;
                        const attn_body::bf16* base = (const attn_body::bf16*)PROJ + (size_t)b * S * EIN;
                        attn_body::attn_unit<8>(qb, S, base + h * 64, EIN, base + 512 + kvh * 64, base + 640 + kvh * 64, EIN, (attn_body::bf16*)YE + (size_t)b * S * DMODEL + h * 64, DMODEL, lds);
                    }
                }
                __syncthreads();
                even_lru_scan((const bf16_t*)(SCR + SC_LA), (const bf16_t*)(SCR + SC_UU), (const f32x2*)(SCR + SC_AGG), PROJ, YE, S);
                GSYNC();
                {
                    pg8::Gemm g{YE, (const bf16_t*)(ws + WS_WOUTE) + (size_t)j * 1024 * 1024, TS, 1024, 1024}; pg8::StaticOrder So; So.init(TS, 1024, Gr, (int)blockIdx.x);
                    EpiRes E{H, SSQA, DMODEL};
                    pg8::gemm_phase<EpiRes, pg8::StaticOrder, true, true>(ldsl, g, So, E);
                }
            } else {
                odd_conv(PROJ, p.in[21] + j * 4 * 1536, (bf16_t*)(SCR + SC_QKVP), S);
                asm volatile("s_waitcnt vmcnt(0)" ::: "memory"); __syncthreads();
                odd_prep((const bf16_t*)(SCR + SC_QKVP), PROJ, p.in[22] + j * 8, p.in[23] + j * 8, SCR + SC_DNI, (float*)(SCR + SC_EGL), lds);
                GSYNC();
                {
                    const int nscan = nb * 64;
                    odd_scan(SCR + SC_DNI, (const float*)(SCR + SC_EGL), (bf16_t*)(SCR + SC_OB), S, nb, lds);
                    const int first = nscan < Gr ? nscan : 0;
                    odd_dilated(PROJ, p.in[2], (float*)(SCR + SC_LSE), S, lds, first, Gr - first);
                }
                GSYNC();
                odd_combine((const bf16_t*)(SCR + SC_OB), PROJ, (const float*)(SCR + SC_LSE), p.in[24] + j * 128, YO);
                GSYNC();
                {
                    pg8::Gemm g{YO, (const bf16_t*)(ws + WS_WOUTO) + (size_t)j * 1024 * OOUT, TS, 1024, OOUT}; pg8::StaticOrder So; So.init(TS, 1024, Gr, (int)blockIdx.x);
                    EpiRes E{H, SSQA, DMODEL};
                    pg8::gemm_phase<EpiRes, pg8::StaticOrder, true, true>(ldsl, g, So, E);
                }
            }
            GSYNC();
            {
                pg8::Gemm g{H, (const bf16_t*)(ws + WS_W1T) + (size_t)layer * 4096 * 1024, TS, DFF, 1024}; pg8::StaticOrder So; So.init(TS, DFF, Gr, (int)blockIdx.x);
                pg8::EpiBf16<2> E{(bf16_t*)(SCR + SC_HID), DFF, nullptr, 0, 0, 1.f, SSQA};
                pg8::gemm_phase<pg8::EpiBf16<2>, pg8::StaticOrder, true, true>(ldsl, g, So, E);
            }
            GSYNC();
            {
                pg8::Gemm g{(const bf16_t*)(SCR + SC_HID), (const bf16_t*)(ws + WS_W2T) + (size_t)layer * 1024 * 4096, TS, 1024, DFF}; pg8::StaticOrder So; So.init(TS, 1024, Gr, (int)blockIdx.x);
                EpiRes E{H, SSQB, DMODEL};
                pg8::gemm_phase<EpiRes, pg8::StaticOrder, true, true>(ldsl, g, So, E);
            }
            GSYNC();
        }
        phase_rmsnorm_final(H, xo, p.in[5]);
        GSYNC();
    }
}
}

extern "C" void kernel_launch(void* const* d_in, const int* in_sizes, int n_in, void* d_out, int out_size, void* d_ws, size_t ws_size, hipStream_t stream) {
    static int grid = 0;
    if (grid == 0) {
        if (n_in != 25 || ws_size < mk::WS_END) { fprintf(stderr, "kernel_launch: unexpected n_in %d / ws_size %zu\n", n_in, ws_size); grid = -1; return; }
        int dev = 0, cus = 0, per_cu = 0;
        hipGetDevice(&dev); hipDeviceGetAttribute(&cus, hipDeviceAttributeMultiprocessorCount, dev);
        if (hipFuncSetAttribute((const void*)mk::fwd_megakernel, hipFuncAttributeMaxDynamicSharedMemorySize, mk::LDS_BYTES) != hipSuccess) { fprintf(stderr, "hipFuncSetAttribute failed\n"); }
        hipOccupancyMaxActiveBlocksPerMultiprocessor(&per_cu, (const void*)mk::fwd_megakernel, mk::NT, mk::LDS_BYTES);
        (void)hipGetLastError();
        if (per_cu < 1) per_cu = 1;
        grid = cus * 1;
        fprintf(stderr, "kernel_launch: cus %d per_cu %d grid %d\n", cus, per_cu, grid);
    }
    if (grid < 0) return;
    if (hipMemsetAsync(d_ws, 0, 65536, stream) != hipSuccess) { fprintf(stderr, "memset failed\n"); return; }
    mk::Params p{};
    for (int i = 0; i < 25; ++i) p.in[i] = (const float*)d_in[i];
    p.out = (float*)d_out; p.ws = (unsigned char*)d_ws;
    void* args[] = {&p};
    hipError_t e = hipLaunchCooperativeKernel((const void*)mk::fwd_megakernel, dim3(grid), dim3(mk::NT), args, mk::LDS_BYTES, stream);
    if (e != hipSuccess) fprintf(stderr, "cooperative launch failed: %s (grid %d)\n", hipGetErrorString(e), grid);
}
```

```cpp
#include <hip/hip_runtime.h>
#include <hip/hip_cooperative_groups.h>
#include <hip/hip_bf16.h>
#include <cstdio>
#include <cstdint>
#include <cmath>
namespace cg = cooperative_groups;
namespace pg8 {
#define PG8_LAS __attribute__((address_space(3)))
typedef unsigned short bf16_t;
typedef short bf16x8 __attribute__((ext_vector_type(8)));
typedef float f32x4 __attribute__((ext_vector_type(4)));
typedef unsigned u32x4 __attribute__((ext_vector_type(4)));
constexpr int BM = 256, BK = 64, HALF = 128, HTB = HALF * BK * 2  , STAGE_BYTES = 8 * HTB, NXCD = 8, WGM = 8;

__host__ __device__ __forceinline__ int lds_byte(int r, int c) { const int st = (r >> 4) * 2 + (c >> 5), rr = r & 15, cc = c & 31, ob = rr * 64 + cc * 2; return st * 1024 + (ob ^ (((ob >> 9) & 1) << 5)); }
__host__ __device__ __forceinline__ void stage_rc(int b, int& R, int& C) { const int st = b / 1024, sb = b % 1024, swz = sb ^ (((sb >> 9) & 1) << 5); R = (st >> 1) * 16 + swz / 64; C = (st & 1) * 32 + (swz % 64) / 2; }
__host__ __device__ __forceinline__ int perm32(int rho) { const int n = rho >> 4, i = rho & 15; return 8 * (i >> 2) + 4 * n + (i & 3); }

struct Unit { int pm, pn; };
struct Gemm { const bf16_t* A; const bf16_t* Bt; int M, N, K; };

struct StaticOrder {
    int nM, nN, nwg, G, c;
    __host__ __device__ void init(int M, int N, int G_, int c_) { nM = M / BM; nN = N / BM; nwg = nM * nN; G = G_; c = c_; }
    __host__ __device__ bool next(int i, Unit& u) const {
        const long L = (long)i * G + c; if (L >= nwg) return false;
        int wgid = (int)L; { const int q = nwg / NXCD, r = nwg % NXCD, xcd = wgid % NXCD, off = wgid / NXCD; wgid = (xcd < r ? xcd * (q + 1) : r * (q + 1) + (xcd - r) * q) + off; }
        const int nig = WGM * nN, gid = wgid / nig, fm = gid * WGM, gsz = (nM - fm) < WGM ? (nM - fm) : WGM;
        u.pm = fm + ((wgid % nig) % gsz); u.pn = (wgid % nig) / gsz; return true;
    }
    __device__ __forceinline__ void a_ready(const Unit&) const {}
    __device__ __forceinline__ void done(const Unit&) const {}
};

__device__ __forceinline__ unsigned cvt_pk_bf16(float lo, float hi) { unsigned r; asm volatile("v_cvt_pk_bf16_f32 %0, %1, %2" : "=v"(r) : "v"(lo), "v"(hi)); return r; }
typedef float f32x2 __attribute__((ext_vector_type(2)));
__device__ __forceinline__ f32x2 gelu_pk(f32x2 v) {
    const f32x2 av = __builtin_elementwise_abs(v), d = av * 0.2316418882f + 1.0f;
    f32x2 t; t.x = __builtin_amdgcn_rcpf(d.x); t.y = __builtin_amdgcn_rcpf(d.y);
    f32x2 q = t * 0.5307027145f + (-0.7265760135f); q = q * t + 0.7107068705f; q = q * t + (-0.142248368f); q = q * t + 0.127414796f; q = q * t;
    const f32x2 s = (v * v) * (-0.72134752044f);
    f32x2 e; e.x = __builtin_amdgcn_exp2f(s.x); e.y = __builtin_amdgcn_exp2f(s.y);
    const f32x2 m = v * (q * e), r = v - m;
    f32x2 o; o.x = v.x < 0.f ? m.x : r.x; o.y = v.y < 0.f ? m.y : r.y; return o;
}

template <int ACT  > struct EpiBf16 {
    static constexpr bool PERM = true, AFTER_DRAIN = false; static_assert(ACT == 0 || ACT == 1 || ACT == 2, "EpiBf16: ACT 0 none, 1 gelu, 2 relu^2");
    bf16_t* O; int ldc; const float* bias; int split_cols; size_t split_stride; float scale0; const float* ssq;
    __device__ __forceinline__ void operator()(const f32x4 (&acc)[2][2][4][2], const Unit& u, int wr, int wc, int fr, int fq) const {
        const int row0 = u.pm * BM + wr * 64 + fr; int colt = u.pn * BM; bf16_t* base = O;
        float sc = 1.f; if (split_cols) { const int t = colt / split_cols; base += (size_t)t * split_stride; colt -= t * split_cols; if (t == 0) sc = scale0; }
        const int col0 = colt + wc * 32 + 8 * fq, bcol0 = u.pn * BM + wc * 32 + 8 * fq;
        float rsc[2][4];
        if (ssq) { f32x4 t_[2][4];
#pragma unroll
            for (int ai = 0; ai < 2; ++ai)
#pragma unroll
                for (int m = 0; m < 4; ++m) t_[ai][m] = *(const f32x4*)(ssq + (size_t)(row0 + ai * HALF + m * 16) * 16 + fq * 4);
#pragma unroll
            for (int ai = 0; ai < 2; ++ai)
#pragma unroll
                for (int m = 0; m < 4; ++m) { float s_ = (t_[ai][m][0] + t_[ai][m][1]) + (t_[ai][m][2] + t_[ai][m][3]); s_ += __shfl_xor(s_, 16); s_ += __shfl_xor(s_, 32); rsc[ai][m] = 1.0f / sqrtf(s_ * (1.0f / 1024.0f) + 1e-6f); }
        } else {
#pragma unroll
            for (int ai = 0; ai < 2; ++ai)
#pragma unroll
                for (int m = 0; m < 4; ++m) rsc[ai][m] = 1.0f; }
        f32x4 bv[2][2];
#pragma unroll
        for (int bj = 0; bj < 2; ++bj)
#pragma unroll
            for (int n = 0; n < 2; ++n) bv[bj][n] = bias ? *(const f32x4*)(bias + bcol0 + bj * HALF + 4 * n) : (f32x4){0.f, 0.f, 0.f, 0.f};
#pragma unroll
        for (int ai = 0; ai < 2; ++ai)
#pragma unroll
            for (int m = 0; m < 4; ++m) { bf16_t* rowp = base + (size_t)(row0 + ai * HALF + m * 16) * ldc + col0; const float rsc_ = rsc[ai][m];
#pragma unroll
                for (int bj = 0; bj < 2; ++bj) { f32x4 v0 = (acc[ai][bj][m][0] + bv[bj][0]) * rsc_, v1 = (acc[ai][bj][m][1] + bv[bj][1]) * rsc_;
                    if (ACT == 1) { f32x2 a = gelu_pk((f32x2){v0[0], v0[1]}), b = gelu_pk((f32x2){v0[2], v0[3]}), c = gelu_pk((f32x2){v1[0], v1[1]}), d = gelu_pk((f32x2){v1[2], v1[3]});
                        v0 = (f32x4){a.x, a.y, b.x, b.y}; v1 = (f32x4){c.x, c.y, d.x, d.y}; }
                    if (ACT == 2) { _Pragma("unroll") for (int q_ = 0; q_ < 4; ++q_) { const float a0_ = v0[q_] > 0.f ? v0[q_] : 0.f, a1_ = v1[q_] > 0.f ? v1[q_] : 0.f; v0[q_] = a0_ * a0_; v1[q_] = a1_ * a1_; } }
                    v0 = v0 * sc; v1 = v1 * sc; u32x4 w; w.x = cvt_pk_bf16(v0[0], v0[1]); w.y = cvt_pk_bf16(v0[2], v0[3]); w.z = cvt_pk_bf16(v1[0], v1[1]); w.w = cvt_pk_bf16(v1[2], v1[3]);
                    *(u32x4*)(rowp + bj * HALF) = w; } }
    }
};

template <class Epi, class Sched, bool ALIGN_EPI = false, bool SP2 = false>
__device__ __forceinline__ void gemm_phase(PG8_LAS unsigned char* lds, const Gemm g, const Sched& S, const Epi& E) {
    int tid_ = threadIdx.x; asm volatile("" : "+v"(tid_)); const int tid = tid_, wid = __builtin_amdgcn_readfirstlane(tid >> 6), lane = tid & 63, wr = wid >> 2, wc = wid & 3, fr = lane & 15, fq = lane >> 4;
    const int K = g.K, nt = K / BK;
    unsigned voffA[2], voffB[2];
#pragma unroll
    for (int i = 0; i < 2; ++i) { int R, C; stage_rc(tid * 16 + i * 8192, R, C); const int Rb = Epi::PERM ? ((R & ~31) + perm32(R & 31)) : R;
        voffA[i] = (unsigned)(R * K + C) * 2u; voffB[i] = (unsigned)(Rb * K + C) * 2u; }
    const size_t kstep = (size_t)(BK * 2);
    const size_t hstep = (size_t)HALF * K * 2;
    const size_t tstep = 2 * hstep;
    const unsigned ldsw = (unsigned)wid * 1024u;
    const int aoff = lds_byte(wr * 64 + fr, fq * 8), boff = lds_byte(wc * 32 + fr, fq * 8);
#define PG8_SA(b, h) (((b) * 2 + (h)) * HTB)
#define PG8_SB(b, h) ((4 + (b) * 2 + (h)) * HTB)
#define PG8_STAGE(bufoff, gbase, voff) do { _Pragma("unroll") for (int _i = 0; _i < 2; ++_i) \
        __builtin_amdgcn_global_load_lds((const unsigned*)((const char*)(gbase) + (voff)[_i]), (PG8_LAS unsigned*)(lds + (bufoff) + ldsw + _i * 8192), 16, 0, 0); } while (0)
#define PG8_LDA(dst, b, h) do { _Pragma("unroll") for (int m = 0; m < 4; ++m) _Pragma("unroll") for (int k = 0; k < 2; ++k) dst[m][k] = *(const PG8_LAS bf16x8*)(lds + PG8_SA(b, h) + aoff + m * 2048 + k * 1024); } while (0)
#define PG8_LDB(dst, b, h) do { _Pragma("unroll") for (int n = 0; n < 2; ++n) _Pragma("unroll") for (int k = 0; k < 2; ++k) dst[n][k] = *(const PG8_LAS bf16x8*)(lds + PG8_SB(b, h) + boff + n * 2048 + k * 1024); } while (0)
#define PG8_MMA(ai, bj, At, Bt) do { __builtin_amdgcn_s_setprio(1); _Pragma("unroll") for (int m = 0; m < 4; ++m) _Pragma("unroll") for (int n = 0; n < 2; ++n) _Pragma("unroll") for (int k = 0; k < 2; ++k) \
        acc[ai][bj][m][n] = __builtin_amdgcn_mfma_f32_16x16x32_bf16(Bt[n][k], At[m][k], acc[ai][bj][m][n], 0, 0, 0); __builtin_amdgcn_s_setprio(0); } while (0)
#define PG8_WAIT_V(n) asm volatile("s_waitcnt vmcnt(" #n ")" ::: "memory")
#define PG8_WAIT_L(n) asm volatile("s_waitcnt lgkmcnt(" #n ")" ::: "memory")
#define PG8_BAR __builtin_amdgcn_s_barrier()
#define PG8_SCHED __builtin_amdgcn_sched_barrier(0)
    Unit cur, nxt; int ui = 0;
    if (!S.next(0, cur)) return;
    f32x4 acc[2][2][4][2];
#pragma unroll
    for (int a = 0; a < 2; ++a)
#pragma unroll
        for (int b = 0; b < 2; ++b)
#pragma unroll
            for (int m = 0; m < 4; ++m)
#pragma unroll
                for (int n = 0; n < 2; ++n) acc[a][b][m][n] = (f32x4){0.f, 0.f, 0.f, 0.f};
    bf16x8 At[4][2], B0[2][2], B1[2][2];
    const char* cA = (const char*)g.A + (size_t)cur.pm * tstep; const char* cB = (const char*)g.Bt + (size_t)cur.pn * tstep;
    S.a_ready(cur);
    if constexpr (SP2) {
        PG8_STAGE(PG8_SB(0, 0), cB, voffB); PG8_STAGE(PG8_SB(0, 1), cB + hstep, voffB); PG8_STAGE(PG8_SA(0, 0), cA, voffA); PG8_STAGE(PG8_SA(0, 1), cA + hstep, voffA);
        if (wr == 1) PG8_BAR;
        PG8_WAIT_V(2); PG8_BAR;
        PG8_STAGE(PG8_SB(1, 0), cB + kstep, voffB); PG8_STAGE(PG8_SA(1, 0), cA + kstep, voffA); PG8_STAGE(PG8_SB(1, 1), cB + hstep + kstep, voffB);
        PG8_WAIT_V(6); PG8_BAR;
    } else {
        PG8_STAGE(PG8_SB(0, 0), cB, voffB); PG8_STAGE(PG8_SA(0, 0), cA, voffA); PG8_STAGE(PG8_SB(0, 1), cB + hstep, voffB); PG8_STAGE(PG8_SA(0, 1), cA + hstep, voffA);
        if (wr == 1) PG8_BAR;
        PG8_WAIT_V(4); PG8_BAR;
        PG8_STAGE(PG8_SB(1, 0), cB + kstep, voffB); PG8_STAGE(PG8_SA(1, 0), cA + kstep, voffA); PG8_STAGE(PG8_SB(1, 1), cB + hstep + kstep, voffB);
        PG8_WAIT_V(6); PG8_BAR;
    }
    for (;;) {
        const bool has_next = S.next(ui + 1, nxt);
        const char* nA = has_next ? (const char*)g.A + (size_t)nxt.pm * tstep : cA; const char* nB = has_next ? (const char*)g.Bt + (size_t)nxt.pn * tstep : cB;
        for (int t = 0; t < nt; t += 2) {
            const bool last = (t == nt - 2);
            const char* a1 = cA + (size_t)(t + 1) * kstep;
            const char* a2 = last ? nA : cA + (size_t)(t + 2) * kstep; const char* b2 = last ? nB : cB + (size_t)(t + 2) * kstep;
            const char* a3 = a2 + kstep; const char* b3 = b2 + kstep;
            if (last && has_next) S.a_ready(nxt);
            if constexpr (SP2) {
            PG8_LDB(B0, 0, 0); PG8_LDB(B1, 0, 1); PG8_SCHED; PG8_LDA(At, 0, 0); PG8_STAGE(PG8_SA(1, 1), a1 + hstep, voffA);
            PG8_WAIT_V(8); PG8_WAIT_L(0); PG8_BAR; PG8_MMA(0, 0, At, B0); PG8_MMA(0, 1, At, B1); PG8_BAR; PG8_SCHED;
            PG8_LDA(At, 0, 1); PG8_STAGE(PG8_SB(0, 0), b2, voffB); PG8_STAGE(PG8_SB(0, 1), b2 + hstep, voffB); PG8_STAGE(PG8_SA(0, 0), a2, voffA);
            PG8_WAIT_V(8); PG8_WAIT_L(0); PG8_BAR; PG8_MMA(1, 0, At, B0); PG8_MMA(1, 1, At, B1); PG8_BAR; PG8_SCHED;
            PG8_LDB(B0, 1, 0); PG8_LDB(B1, 1, 1); PG8_SCHED; PG8_LDA(At, 1, 0); PG8_STAGE(PG8_SA(0, 1), a2 + hstep, voffA);
            PG8_WAIT_V(8); PG8_WAIT_L(0); PG8_BAR; PG8_MMA(0, 0, At, B0); PG8_MMA(0, 1, At, B1); PG8_BAR; PG8_SCHED;
            PG8_LDA(At, 1, 1); PG8_STAGE(PG8_SB(1, 0), b3, voffB); PG8_STAGE(PG8_SB(1, 1), b3 + hstep, voffB); PG8_STAGE(PG8_SA(1, 0), a3, voffA);
            PG8_WAIT_V(8); PG8_WAIT_L(0); PG8_BAR; PG8_MMA(1, 0, At, B0); PG8_MMA(1, 1, At, B1); PG8_BAR; PG8_SCHED;
            } else {
            PG8_LDB(B0, 0, 0); PG8_SCHED; PG8_LDA(At, 0, 0); PG8_STAGE(PG8_SA(1, 1), a1 + hstep, voffA);
            PG8_WAIT_L(8); PG8_BAR; PG8_WAIT_L(0); PG8_MMA(0, 0, At, B0); PG8_BAR; PG8_SCHED;
            PG8_LDB(B1, 0, 1); PG8_STAGE(PG8_SB(0, 0), b2, voffB);
            PG8_BAR; PG8_WAIT_L(0); PG8_MMA(0, 1, At, B1); PG8_BAR;
            PG8_LDA(At, 0, 1); PG8_STAGE(PG8_SA(0, 0), a2, voffA);
            PG8_BAR; PG8_WAIT_L(0); PG8_MMA(1, 0, At, B0); PG8_BAR; PG8_SCHED;
            PG8_STAGE(PG8_SB(0, 1), b2 + hstep, voffB);
            PG8_WAIT_V(6); PG8_BAR; PG8_MMA(1, 1, At, B1); PG8_BAR;
            PG8_LDB(B0, 1, 0); PG8_SCHED; PG8_LDA(At, 1, 0); PG8_STAGE(PG8_SA(0, 1), a2 + hstep, voffA);
            PG8_WAIT_L(8); PG8_BAR; PG8_WAIT_L(0); PG8_MMA(0, 0, At, B0); PG8_BAR; PG8_SCHED;
            PG8_LDB(B1, 1, 1); PG8_STAGE(PG8_SB(1, 0), b3, voffB);
            PG8_BAR; PG8_WAIT_L(0); PG8_MMA(0, 1, At, B1); PG8_BAR;
            PG8_LDA(At, 1, 1); PG8_STAGE(PG8_SA(1, 0), a3, voffA);
            PG8_BAR; PG8_WAIT_L(0); PG8_MMA(1, 0, At, B0); PG8_BAR; PG8_SCHED;
            PG8_STAGE(PG8_SB(1, 1), b3 + hstep, voffB);
            PG8_WAIT_V(6); PG8_BAR; PG8_MMA(1, 1, At, B1); PG8_BAR;
            }
        }
        if constexpr (ALIGN_EPI) { if (wr == 0) PG8_BAR; }
        if constexpr (!Epi::AFTER_DRAIN) { E(acc, cur, wr, wc, fr, fq); S.done(cur); }
        if (!has_next) break;
#pragma unroll
        for (int a = 0; a < 2; ++a)
#pragma unroll
            for (int b = 0; b < 2; ++b)
#pragma unroll
                for (int m = 0; m < 4; ++m)
#pragma unroll
                    for (int n = 0; n < 2; ++n) acc[a][b][m][n] = (f32x4){0.f, 0.f, 0.f, 0.f};
        cur = nxt; cA = nA; cB = nB; ++ui;
        if constexpr (ALIGN_EPI) { if (wr == 1) PG8_BAR; }
    }
    PG8_WAIT_V(0);
    if constexpr (!ALIGN_EPI) { if (wr == 0) PG8_BAR; }
    PG8_BAR;
    if constexpr (Epi::AFTER_DRAIN) { E.fused(acc, cur, wr, wc, fr, fq, lds, wid, lane); S.done(cur); }
#undef PG8_SA
#undef PG8_SB
#undef PG8_STAGE
#undef PG8_LDA
#undef PG8_LDB
#undef PG8_MMA
#undef PG8_WAIT_V
#undef PG8_WAIT_L
#undef PG8_BAR
#undef PG8_SCHED
}
}

#ifndef PG8_SP2
#define PG8_SP2 true
#endif
#ifndef PG8_ALIGN
#define PG8_ALIGN true
#endif
#include <hip/hip_bf16.h>
#include <cmath>
namespace attn_body {
using bf16=__hip_bfloat16;
using bf16x8=__attribute__((ext_vector_type(8)))short;
using s16x4=__attribute__((ext_vector_type(4)))short;
using f32x16=__attribute__((ext_vector_type(16)))float;
using u32x4=__attribute__((ext_vector_type(4)))unsigned;
constexpr int D=64;
constexpr int NW=8,QBLK=32,QB=QBLK*NW,KVBLK=64;
__device__ __forceinline__ int crow(int r,int hi){return (r&3)+8*(r>>2)+4*hi;}
#define SBAR() __builtin_amdgcn_sched_barrier(0)
__device__ __forceinline__ void cmask(f32x16&p0,f32x16&p1,int jb,int qrel,int hi){
  const float NEG=-INFINITY; int kb=64*jb+4*hi;
  #pragma unroll
  for(int r=0;r<16;++r){int kv=kb+(r&3)+8*(r>>2); if(kv>qrel)p0[r]=NEG; if(kv+32>qrel)p1[r]=NEG;}
}

constexpr int NSLOT=3, SLOTB=8192;
constexpr int LDS_K=0, LDS_V=NSLOT*SLOTB, LDS_WS=2*NSLOT*SLOTB, LDS_OST=LDS_WS+NW*64*4, LDS_BYTES=LDS_OST+NW*4096;
constexpr float C2=0.125f*1.4426950408889634f;
__device__ __forceinline__ void glds16(const void*gsrc,unsigned lds_dst){unsigned keep;
  asm volatile("s_mov_b32 %0, m0\n\ts_mov_b32 m0, %2\n\ts_nop 0\n\tglobal_load_lds_dwordx4 %1, off\n\ts_mov_b32 m0, %0":"=&s"(keep):"v"(gsrc),"s"(lds_dst):"memory");}
__device__ __forceinline__ float max3f(float a,float b,float c){float r;asm("v_max3_f32 %0, %1, %2, %3":"=v"(r):"v"(a),"v"(b),"v"(c));return r;}
__device__ __forceinline__ float max2f(float a,float b){float r;asm("v_max_f32_e32 %0, %1, %2":"=v"(r):"v"(a),"v"(b));return r;}
__device__ __forceinline__ float fadd_s(float a,float b){float r;asm("v_add_f32_e32 %0, %1, %2":"=v"(r):"v"(a),"v"(b));return r;}
__device__ __forceinline__ float fsub_s(float a,float b){float r;asm("v_sub_f32_e32 %0, %1, %2":"=v"(r):"v"(a),"v"(b));return r;}
typedef float f32x2_t __attribute__((ext_vector_type(2))); typedef __bf16 bf16x2_t __attribute__((ext_vector_type(2)));
__device__ __forceinline__ unsigned cvtpk_s(float lo,float hi){f32x2_t v={lo,hi};bf16x2_t b=__builtin_convertvector(v,bf16x2_t);return __builtin_bit_cast(unsigned,b);}
#define WAIT_BAR(N) asm volatile("s_waitcnt vmcnt(" #N ") lgkmcnt(0)\n\ts_barrier":::"memory")

__device__ __forceinline__ void qkt(f32x16&p0,f32x16&p1,const char*Kslot,const bf16x8*qr,const f32x16&negm,int r32,int hi){
  const char*kb=Kslot+hi*1024+r32*16;
  #pragma unroll
  for(int d0=0;d0<4;++d0){
    const bf16x8 b0=*reinterpret_cast<const bf16x8*>(kb+d0*2048);
    const bf16x8 b1=*reinterpret_cast<const bf16x8*>(kb+d0*2048+512);
    if(d0==0){p0=__builtin_amdgcn_mfma_f32_32x32x16_bf16(b0,qr[0],negm,0,0,0);p1=__builtin_amdgcn_mfma_f32_32x32x16_bf16(b1,qr[0],negm,0,0,0);}
    else{p0=__builtin_amdgcn_mfma_f32_32x32x16_bf16(b0,qr[d0],p0,0,0,0);p1=__builtin_amdgcn_mfma_f32_32x32x16_bf16(b1,qr[d0],p1,0,0,0);}}
}
typedef __attribute__((address_space(3))) const char* lds_cptr;
typedef short v4i16_t __attribute__((ext_vector_type(4)));
__device__ __forceinline__ void kload8(bf16x8*kf,lds_cptr kp){
  kf[0]=*(const __attribute__((address_space(3))) bf16x8*)(kp);      kf[1]=*(const __attribute__((address_space(3))) bf16x8*)(kp+512);
  kf[2]=*(const __attribute__((address_space(3))) bf16x8*)(kp+2048); kf[3]=*(const __attribute__((address_space(3))) bf16x8*)(kp+2560);
  kf[4]=*(const __attribute__((address_space(3))) bf16x8*)(kp+4096); kf[5]=*(const __attribute__((address_space(3))) bf16x8*)(kp+4608);
  kf[6]=*(const __attribute__((address_space(3))) bf16x8*)(kp+6144); kf[7]=*(const __attribute__((address_space(3))) bf16x8*)(kp+6656);
}
__device__ __forceinline__ void kload2(bf16x8*kf,lds_cptr kp,int j){ kf[2*j]=*(const __attribute__((address_space(3))) bf16x8*)(kp+j*2048); kf[2*j+1]=*(const __attribute__((address_space(3))) bf16x8*)(kp+j*2048+512); }
__device__ __forceinline__ s16x4 vtr(lds_cptr p){ return __builtin_bit_cast(s16x4,__builtin_amdgcn_ds_read_tr16_b64_v4i16((__attribute__((address_space(3))) v4i16_t*)p)); }
__device__ __forceinline__ float rowmax(const f32x16&p0,const f32x16&p1){
  float a=max3f(p0[0],p0[1],p1[0]),b=max3f(p0[2],p0[3],p1[1]);a=max3f(a,p1[2],p1[3]);
  #pragma unroll
  for(int r=4;r<16;r+=4){a=max3f(a,p0[r],p0[r+1]);b=max3f(b,p0[r+2],p0[r+3]);a=max3f(a,p1[r],p1[r+1]);b=max3f(b,p1[r+2],p1[r+3]);}
  const float m=max2f(a,b);
  auto rr=__builtin_amdgcn_permlane32_swap(__float_as_uint(m),__float_as_uint(m),false,false);
  return max2f(__uint_as_float(rr[0]),__uint_as_float(rr[1]));
}
__device__ __forceinline__ void pv(f32x16*o,int vb,bf16x8 pa0,bf16x8 pa1,bf16x8 pa2,bf16x8 pa3){
  #pragma unroll
  for(int d0=0;d0<2;++d0){s16x4 lo[4],hi[4];
    #pragma unroll
    for(int ks=0;ks<4;++ks){
      asm volatile("ds_read_b64_tr_b16 %0,%1 offset:%c2":"=&v"(lo[ks]):"v"(vb),"i"(d0*4096+ks*1024):"memory");
      asm volatile("ds_read_b64_tr_b16 %0,%1 offset:%c2":"=&v"(hi[ks]):"v"(vb),"i"(d0*4096+ks*1024+512):"memory");}
    asm volatile("s_waitcnt lgkmcnt(0)":::"memory");SBAR();
    #define PK(k) (bf16x8){lo[k][0],lo[k][1],lo[k][2],lo[k][3],hi[k][0],hi[k][1],hi[k][2],hi[k][3]}
    o[d0]=__builtin_amdgcn_mfma_f32_32x32x16_bf16(pa0,PK(0),o[d0],0,0,0);
    o[d0]=__builtin_amdgcn_mfma_f32_32x32x16_bf16(pa1,PK(1),o[d0],0,0,0);
    o[d0]=__builtin_amdgcn_mfma_f32_32x32x16_bf16(pa2,PK(2),o[d0],0,0,0);
    o[d0]=__builtin_amdgcn_mfma_f32_32x32x16_bf16(pa3,PK(3),o[d0],0,0,0);
    #undef PK
  }
}

#ifndef ATTN_STORE16
#define ATTN_STORE16(p,v) (*(u32x4*)(p)=(v))
#endif
template<int THRL> __device__ __forceinline__ void attn_unit(int qb,int SEQ,const bf16*Q,int QP,const bf16*__restrict__ K,const bf16*__restrict__ V,int KP,bf16*O,int OP,char*shm){
  int tid_=threadIdx.x; asm volatile("":"+v"(tid_)); const int tid=tid_,lane=tid&63,r32=lane&31,hi=lane>>5; const int wid=__builtin_amdgcn_readfirstlane(tid>>6);
  const int q0=qb*QB;
  const bf16*Qw=Q+(long)(q0+wid*QBLK)*QP;
  const bf16*Kh=K,*Vh=V;
  const unsigned lds0=(unsigned)(uintptr_t)shm;
  float*wsf=(float*)(shm+LDS_WS)+wid*64;
  const bf16*ksrc=Kh+(long)lane*KP+wid*8;
  const bf16*vsrc=Vh+(long)(16*(wid&3)+(lane>>2))*KP+(wid>>2)*32+(lane&3)*8;
  const unsigned kdst=lds0+LDS_K+wid*1024, vdst=lds0+LDS_V+wid*1024;
  #define DMA_K(t,slot) glds16(ksrc+(long)(t)*KVBLK*KP,(unsigned)__builtin_amdgcn_readfirstlane(kdst+(slot)))
  #define DMA_V(t,slot) glds16(vsrc+(long)(t)*KVBLK*KP,(unsigned)__builtin_amdgcn_readfirstlane(vdst+(slot)))
  const int vb0=(int)(lds0+LDS_V)+((lane>>4)&1)*32+(lane&3)*8+(4*hi+((lane&15)>>2))*64;
  const char*Kbase=shm+LDS_K; bf16x8 kf[8];
  const lds_cptr shm3=(lds_cptr)shm; const lds_cptr kp0=shm3+LDS_K+hi*1024+r32*16; const lds_cptr vp0=shm3+LDS_V+((lane>>4)&1)*32+(lane&3)*8+(4*hi+((lane&15)>>2))*64;
  const int NT=SEQ/KVBLK;
  DMA_K(0,0);DMA_V(0,0);DMA_K(1,SLOTB);
  bf16x8 qr[4];
  #pragma unroll
  for(int d0=0;d0<4;++d0)qr[d0]=*reinterpret_cast<const bf16x8*>(&Qw[(long)r32*QP+d0*16+hi*8]);
  float mhat=0.f,l_reg=0.f;f32x16 o[2];o[0]=f32x16{};o[1]=f32x16{};f32x16 negm=f32x16{};asm volatile("":"+v"(negm));
  const int qrel=wid*QBLK+r32;
  #define CMASK(P0,P1,t) do{}while(0)
  bool resc=false;
  #define START(P0,P1) do{ const float rm=rowmax(P0,P1); resc=false; \
    { const float dl=rm; mhat=fadd_s(mhat,dl); \
      _Pragma("unroll") for(int r=0;r<16;++r){P0[r]=fsub_s(P0[r],dl);P1[r]=fsub_s(P1[r],dl);} \
      _Pragma("unroll") for(int r=0;r<16;++r)negm[r]=-mhat; asm volatile("":"+v"(negm)); } \
    _Pragma("unroll") for(int r=0;r<16;++r)P0[r]=__builtin_amdgcn_exp2f(P0[r]); }while(0)
  #define RESC() do{ if(resc){ asm volatile("s_waitcnt lgkmcnt(0)":::"memory"); \
      _Pragma("unroll") for(int d_=0;d_<2;++d_) _Pragma("unroll") for(int r=0;r<16;++r)o[d_][r]*=wsf[crow(r,hi)]; } }while(0)
  f32x16 pA0,pA1,pB0,pB1;
  int sl_prev=0,sl_cur=0,sl_next=SLOTB;
  #define ROT() do{sl_prev=sl_cur;sl_cur=sl_next;sl_next=(sl_next==(NSLOT-1)*SLOTB)?0:sl_next+SLOTB;}while(0)
  DMA_K(2,2*SLOTB);
  WAIT_BAR(3);
  qkt(pA0,pA1,Kbase,qr,negm,r32,hi);asm volatile("s_nop 15\n\ts_nop 7":"+v"(pA0),"+v"(pA1));CMASK(pA0,pA1,0);
  START(pA0,pA1);
  _Pragma("unroll") for(int r=0;r<16;++r)pA1[r]=__builtin_amdgcn_exp2f(pA1[r]);
  WAIT_BAR(0);
  DMA_K(3,0);DMA_V(1,SLOTB);
  ROT();
  kload8(kf,kp0+sl_cur);
  WAIT_BAR(2);
  s16x4 vlo[8],vhi[8]; u32x4 pw0,pw1,pw2,pw3;
  #define PKW(P,B) cvtpk_s(P[B],P[B+1])
  #define PAF(k) __builtin_bit_cast(bf16x8,pw##k)
  #define VFR(i) (bf16x8){vlo[i][0],vlo[i][1],vlo[i][2],vlo[i][3],vhi[i][0],vhi[i][1],vhi[i][2],vhi[i][3]}
  #define PIN(x) asm volatile("":"+v"(x))
  #define MX3(a,b,c) __builtin_fmaxf(__builtin_fmaxf((a),(b)),(c))
  #define GAPA(MF,A0,A1,A2,A3,W0,W1,PW) do{ MF; sacc+=A0; sacc+=A1; sacc+=A2; sacc+=A3; PIN(sacc); W0; W1; PIN(PW); SBAR(); }while(0)
  #define EX(v) __builtin_amdgcn_exp2f(v)
  #define GAPB(MF,X,B) do{ MF; X[B]=EX(X[B]); X[B+1]=EX(X[B+1]); X[B+2]=EX(X[B+2]); X[B+3]=EX(X[B+3]); PIN(X); SBAR(); }while(0)
  #define VRD(i) do{ vlo[i]=vtr(vp_+(((i)>>2)*4096+((i)&3)*1024)); vhi[i]=vtr(vp_+(((i)>>2)*4096+((i)&3)*1024+512)); }while(0)
  #define KRD(G,j) do{ if(G){ kload2(kf,kp0+sl_next,j); SBAR(); } }while(0)
  #define STEP(C0,C1,P0,P1,t,GK,GV,GL) do{ SBAR(); \
    const lds_cptr vp_=vp0+sl_prev; \
    VRD(0); SBAR(); float sacc=(P0[0]+P0[1]); \
    GAPA(C0=__builtin_amdgcn_mfma_f32_32x32x16_bf16(kf[0],qr[0],negm,0,0,0), P0[2],P0[3],P0[4],P0[5],     pw0[0]=PKW(P0,0), pw0[1]=PKW(P0,2), pw0); \
    VRD(4); SBAR(); GAPA(C1=__builtin_amdgcn_mfma_f32_32x32x16_bf16(kf[1],qr[0],negm,0,0,0), P0[6],P0[7],P0[8],P0[9],     pw0[2]=PKW(P0,4), pw0[3]=PKW(P0,6), pw0); \
    VRD(1); SBAR(); GAPA(C0=__builtin_amdgcn_mfma_f32_32x32x16_bf16(kf[2],qr[1],C0,0,0,0),   P0[10],P0[11],P0[12],P0[13], pw1[0]=PKW(P0,8), pw1[1]=PKW(P0,10), pw1); \
    VRD(5); SBAR(); GAPA(C1=__builtin_amdgcn_mfma_f32_32x32x16_bf16(kf[3],qr[1],C1,0,0,0),   P0[14],P0[15],P1[0],P1[1],   pw1[2]=PKW(P0,12),pw1[3]=PKW(P0,14), pw1); \
    VRD(2); SBAR(); GAPA(C0=__builtin_amdgcn_mfma_f32_32x32x16_bf16(kf[4],qr[2],C0,0,0,0),   P1[2],P1[3],P1[4],P1[5],     pw2[0]=PKW(P1,0), pw2[1]=PKW(P1,2), pw2); \
    VRD(6); SBAR(); GAPA(C1=__builtin_amdgcn_mfma_f32_32x32x16_bf16(kf[5],qr[2],C1,0,0,0),   P1[6],P1[7],P1[8],P1[9],     pw2[2]=PKW(P1,4), pw2[3]=PKW(P1,6), pw2); \
    VRD(3); SBAR(); GAPA(C0=__builtin_amdgcn_mfma_f32_32x32x16_bf16(kf[6],qr[3],C0,0,0,0),   P1[10],P1[11],P1[12],P1[13], pw3[0]=PKW(P1,8), pw3[1]=PKW(P1,10), pw3); \
    VRD(7); SBAR(); GAPA(C1=__builtin_amdgcn_mfma_f32_32x32x16_bf16(kf[7],qr[3],C1,0,0,0),   P1[14],P1[15],0.f,0.f,       pw3[2]=PKW(P1,12),pw3[3]=PKW(P1,14), pw3); \
    l_reg+=sacc; \
    if(GK){DMA_K((t)+3,sl_cur);} if(GV){DMA_V((t)+1,sl_next);} \
    CMASK(C0,C1,t); \
    { float a=MX3(C0[0],C0[1],C1[0]),b=MX3(C0[2],C0[3],C1[1]); a=MX3(a,C1[2],C1[3]); \
      _Pragma("unroll") for(int r=4;r<16;r+=4){a=MX3(a,C0[r],C0[r+1]);b=MX3(b,C0[r+2],C0[r+3]);a=MX3(a,C1[r],C1[r+1]);b=MX3(b,C1[r+2],C1[r+3]);} \
      float rm=__builtin_fmaxf(a,b); { auto rr=__builtin_amdgcn_permlane32_swap(__float_as_uint(rm),__float_as_uint(rm),false,false); rm=__builtin_fmaxf(__uint_as_float(rr[0]),__uint_as_float(rr[1])); } \
      resc=false; \
      if(__builtin_expect(__any(rm>(float)THRL),0)){ const float dl=__builtin_fmaxf(rm,0.f); mhat+=dl; \
        _Pragma("unroll") for(int r=0;r<16;++r){C0[r]-=dl;C1[r]-=dl;} \
        _Pragma("unroll") for(int r=0;r<16;++r)negm[r]=-mhat; asm volatile("":"+v"(negm)); \
        const float f=__builtin_amdgcn_exp2f(-dl); l_reg*=f; if(hi==0)wsf[r32]=f; resc=true; } } \
    SBAR(); \
    GAPB(o[0]=__builtin_amdgcn_mfma_f32_32x32x16_bf16(PAF(0),VFR(0),o[0],0,0,0), C0,0); \
    GAPB(o[1]=__builtin_amdgcn_mfma_f32_32x32x16_bf16(PAF(0),VFR(4),o[1],0,0,0), C0,4); \
    KRD(GL,0); GAPB(o[0]=__builtin_amdgcn_mfma_f32_32x32x16_bf16(PAF(1),VFR(1),o[0],0,0,0), C0,8); \
    KRD(GL,1); GAPB(o[1]=__builtin_amdgcn_mfma_f32_32x32x16_bf16(PAF(1),VFR(5),o[1],0,0,0), C0,12); \
    KRD(GL,2); GAPB(o[0]=__builtin_amdgcn_mfma_f32_32x32x16_bf16(PAF(2),VFR(2),o[0],0,0,0), C1,0); \
    KRD(GL,3); GAPB(o[1]=__builtin_amdgcn_mfma_f32_32x32x16_bf16(PAF(2),VFR(6),o[1],0,0,0), C1,4); \
    GAPB(o[0]=__builtin_amdgcn_mfma_f32_32x32x16_bf16(PAF(3),VFR(3),o[0],0,0,0), C1,8); \
    GAPB(o[1]=__builtin_amdgcn_mfma_f32_32x32x16_bf16(PAF(3),VFR(7),o[1],0,0,0), C1,12); \
    }while(0)
  int t=1;
  #undef CMASK
  #define CMASK(P0,P1,t) do{}while(0)
  for(;t+5<NT;t+=2){
    STEP(pB0,pB1,pA0,pA1,t,true,true,true);     WAIT_BAR(2); RESC(); ROT();
    STEP(pA0,pA1,pB0,pB1,t+1,true,true,true);   WAIT_BAR(2); RESC(); ROT();
  }
  #undef CMASK
  #define CMASK(P0,P1,t) do{}while(0)
  #define ENDW(tt) do{ if((tt)+3<NT){WAIT_BAR(2);} else if((tt)+2<NT){WAIT_BAR(1);} else {WAIT_BAR(0);} }while(0)
  for(;t+1<NT;t+=2){
    STEP(pB0,pB1,pA0,pA1,t,(t+3<NT),(t+1<NT),(t+1<NT));       ENDW(t);   RESC(); ROT();
    STEP(pA0,pA1,pB0,pB1,t+1,(t+4<NT),(t+2<NT),(t+2<NT));     ENDW(t+1); RESC(); ROT();
  }
  STEP(pB0,pB1,pA0,pA1,NT-1,false,false,false); RESC();
  { float sacc=pB0[0]+pB0[1]; _Pragma("unroll") for(int r=2;r<16;++r)sacc+=pB0[r]; _Pragma("unroll") for(int r=0;r<16;++r)sacc+=pB1[r]; l_reg+=sacc;
    pw0=(u32x4){PKW(pB0,0),PKW(pB0,2),PKW(pB0,4),PKW(pB0,6)};pw1=(u32x4){PKW(pB0,8),PKW(pB0,10),PKW(pB0,12),PKW(pB0,14)};pw2=(u32x4){PKW(pB1,0),PKW(pB1,2),PKW(pB1,4),PKW(pB1,6)};pw3=(u32x4){PKW(pB1,8),PKW(pB1,10),PKW(pB1,12),PKW(pB1,14)};
    SBAR(); pv(o,vb0+sl_cur,PAF(0),PAF(1),PAF(2),PAF(3)); }
  #undef PKW
  #undef PAF
  #undef VFR
  #undef PIN
  #undef MX3
  #undef GAPA
  #undef GAPB
  #undef EX
  #undef VRD
  #undef KRD
  #undef STEP
  #undef ENDW
  {auto rr=__builtin_amdgcn_permlane32_swap(__float_as_uint(l_reg),__float_as_uint(l_reg),false,false);l_reg=__uint_as_float(rr[0])+__uint_as_float(rr[1]);}
  if(hi==0)wsf[32+r32]=l_reg;asm volatile("s_waitcnt lgkmcnt(0)":::"memory");
  float rli[16];
  #pragma unroll
  for(int r=0;r<16;++r)rli[r]=__builtin_amdgcn_rcpf(wsf[32+crow(r,hi)]);
  bf16*Ow=O+(long)(q0+wid*QBLK)*OP;
  { bf16*stg=(bf16*)(shm+LDS_OST)+wid*2048;
    #pragma unroll
    for(int r=0;r<16;++r){const int orow=crow(r,hi);
      #pragma unroll
      for(int d0=0;d0<2;++d0)stg[orow*64+d0*32+r32]=__float2bfloat16(o[d0][r]*rli[r]);}
    asm volatile("s_waitcnt lgkmcnt(0)":::"memory");
    #pragma unroll
    for(int i=0;i<4;++i){const int row=i*8+(lane>>3),ch=lane&7; const u32x4 v=*(const u32x4*)(stg+row*64+ch*8); ATTN_STORE16(Ow+(long)row*OP+ch*8,v);} }
  asm volatile("s_waitcnt lgkmcnt(0)\n\ts_barrier":::"memory");
  #undef DMA_K
  #undef DMA_V
  #undef CMASK
  #undef START
  #undef RESC
  #undef ROT
}
constexpr int ATTN_LDS_BYTES=LDS_BYTES;
#undef SBAR
#undef WAIT_BAR
}
namespace xb {
#define GAS __attribute__((address_space(1)))
#define LAS __attribute__((address_space(3)))
typedef GAS unsigned gu32;
typedef GAS unsigned long long gu64;
#define RLX_AGENT __ATOMIC_RELAXED, __HIP_MEMORY_SCOPE_AGENT
#define LDS_WAIT() asm volatile("s_waitcnt lgkmcnt(0)" ::: "memory")
#define VM_WAIT() asm volatile("s_waitcnt vmcnt(0)" ::: "memory")
__device__ __forceinline__ unsigned long long rt() { return __builtin_amdgcn_s_memrealtime(); }
__device__ __forceinline__ unsigned f2bf(float f) { unsigned u = __builtin_bit_cast(unsigned, f); return (u + 0x7fffu + ((u >> 16) & 1u)) >> 16; }
__device__ __forceinline__ unsigned pk2(float lo, float hi) { return f2bf(lo) | (f2bf(hi) << 16); }

#define XB_TMO      128
#define XB_XCNT(j)  (256  + 64 * (j))
#define XB_XSUB(j)  (1280 + 64 * (j))
#define XB_XGEN(j)  (2304 + 64 * (j))
#define XB_TOP      3328
#define XB_TOPGEN   3392
#define XCD_BAR_WORDS 3456
#define XB_SPIN_CAP (1u << 18)

__device__ __forceinline__ unsigned xb_ld(unsigned* p)              { return __hip_atomic_load(p, __ATOMIC_RELAXED, __HIP_MEMORY_SCOPE_AGENT); }
__device__ __forceinline__ unsigned xb_add(unsigned* p, unsigned v) { return __hip_atomic_fetch_add(p, v, __ATOMIC_RELAXED, __HIP_MEMORY_SCOPE_AGENT); }
__device__ __forceinline__ unsigned xb_xcc_id() { return (unsigned)__builtin_amdgcn_s_getreg((3 << 11) | 20) & 0xFu; }
#define XB_SPIN(cond, bar) do { unsigned _sp = 0; while (cond) { __builtin_amdgcn_s_sleep(1); \
    if ((++_sp & 255u) == 0u) { if (xb_ld(&(bar)[XB_TMO])) break; if (_sp > XB_SPIN_CAP) { atomicAdd(&(bar)[XB_TMO], 1u); break; } } } } while (0)

struct XcdBarrier {
    unsigned* bar; unsigned x;
    volatile LAS unsigned* st;
};

__device__ __forceinline__ XcdBarrier xcd_barrier_post(unsigned* bar, volatile LAS unsigned* st) {
    XcdBarrier b; b.bar = bar; b.x = xb_xcc_id(); b.st = st;
    if (threadIdx.x == 0) (void)xb_add(&bar[XB_XCNT(b.x)], 1u);
    return b;
}
__device__ __forceinline__ void xcd_barrier_complete(unsigned* bar, unsigned x, unsigned& nloc, unsigned& nx) {
    const unsigned G = gridDim.x * gridDim.y * gridDim.z;
    unsigned sum, cnt, mine, sp = 0u;
    for (;;) {
        sum = 0u; cnt = 0u; mine = 0u;
#pragma unroll
        for (unsigned j = 0; j < 16; ++j) { const unsigned c = xb_ld(&bar[XB_XCNT(j)]); sum += c; cnt += (c > 0u) ? 1u : 0u; mine = (j == x) ? c : mine; }
        if (sum == G) break;
        __builtin_amdgcn_s_sleep(1);
        if ((++sp & 255u) == 0u) { if (xb_ld(&bar[XB_TMO])) break; if (sp > XB_SPIN_CAP) { atomicAdd(&bar[XB_TMO], 1u); break; } }
    }
    nloc = mine > 0u ? mine : 1u; nx = cnt > 0u ? cnt : 1u;
}

__device__ __forceinline__ void xcd_barrier(const XcdBarrier& b) {
    asm volatile("s_waitcnt vmcnt(0)" ::: "memory");
    __syncthreads();
    if (threadIdx.x == 0) {
        unsigned* bar = b.bar;
        __builtin_amdgcn_s_waitcnt(0);
        unsigned nloc = b.st[0], nx = b.st[1];
        if (nloc == 0u) { xcd_barrier_complete(bar, b.x, nloc, nx); b.st[0] = nloc; b.st[1] = nx; }
        const unsigned old = xb_add(&bar[XB_XSUB(b.x)], 1u);
        const unsigned gen = old / nloc;
        if (old + 1u == (gen + 1u) * nloc) {
            __builtin_amdgcn_fence(__ATOMIC_RELEASE, "agent");
            asm volatile("s_waitcnt vmcnt(0)" ::: "memory");
            const unsigned og = xb_add(&bar[XB_TOP], 1u);
            const unsigned tg = og / nx;
            if (og + 1u == (tg + 1u) * nx) xb_add(&bar[XB_TOPGEN], 1u);
            else XB_SPIN(xb_ld(&bar[XB_TOPGEN]) == tg, bar);
            __builtin_amdgcn_fence(__ATOMIC_ACQUIRE, "agent");
            xb_add(&bar[XB_XGEN(b.x)], 1u);
            asm volatile("s_waitcnt vmcnt(0)" ::: "memory");
        } else {
            XB_SPIN(xb_ld(&bar[XB_XGEN(b.x)]) == gen, bar);
            __builtin_amdgcn_fence(__ATOMIC_ACQUIRE, "agent");
            asm volatile("s_waitcnt vmcnt(0)" ::: "memory");
        }
    }
    __syncthreads();
}

}

namespace mk {
typedef unsigned short bf16_t;
typedef short bf16x8 __attribute__((ext_vector_type(8)));
typedef float f32x4 __attribute__((ext_vector_type(4)));
typedef unsigned u32x4 __attribute__((ext_vector_type(4)));
typedef unsigned u32x2 __attribute__((ext_vector_type(2)));
typedef float f32x2 __attribute__((ext_vector_type(2)));

constexpr int DMODEL = 1024, TS = 16384, NSEG = 4, DFF = 4096;
constexpr int EIN = 1792, OIN = 4368, OINP = 4608, OOUT = 768;
constexpr float EPS = 1e-6f;
constexpr size_t MiB = (size_t)1 << 20;
constexpr size_t WS_W1T = 1 * MiB, WS_W2T = 33 * MiB, WS_WINE = 65 * MiB, WS_WOUTE = 72 * MiB, WS_WINO = 76 * MiB, WS_WOUTO = 94 * MiB,
                 WS_GW = 97 * MiB, WS_H = 98 * MiB, WS_PROJ = 130 * MiB, WS_SCR = 274 * MiB, WS_END = 512 * MiB;
constexpr size_t SC_HID = 0;
constexpr size_t SC_LA = 0, SC_UU = 64 * MiB, SC_AGG = 128 * MiB;
constexpr size_t SC_QKVP = 0, SC_DNI = 48 * MiB, SC_OB = 192 * MiB, SC_LSE = 224 * MiB, SC_EGL = 225 * MiB;
constexpr int DNI_BYTES = 73728, DNI_W = 0, DNI_QT = 16384, DNI_KTT = 32768, DNI_A = 49152, DNI_U = 57344;
constexpr int LDS_BYTES = 147456;
constexpr int NT = 512, NW = 8;

struct Params { const float* in[25]; float* out; unsigned char* ws; };

__device__ __forceinline__ float bf2f(bf16_t v) { return __uint_as_float(((unsigned)v) << 16); }
__device__ __forceinline__ unsigned f2bf(float f) { unsigned u = __float_as_uint(f); return (u + 0x7fffu + ((u >> 16) & 1u)) >> 16; }
__device__ __forceinline__ unsigned pk2(float lo, float hi) { return f2bf(lo) | (f2bf(hi) << 16); }
__device__ __forceinline__ float wave_sum(float v) {
#pragma unroll
    for (int o = 1; o < 64; o <<= 1) v += __shfl_xor(v, o);
    return v;
}
__device__ __forceinline__ float sigm(float x) { return 1.f / (1.f + __expf(-x)); }
__device__ __forceinline__ float softplus(float x) { return x > 20.f ? x : log1pf(__expf(x)); }
__device__ __forceinline__ float silu(float x) { return x * sigm(x); }
__device__ __forceinline__ float gelu_tanh(float x) { const float t = 0.7978845608028654f * (x + 0.044715f * x * x * x); return 0.5f * x * (1.f + tanhf(t)); }
__device__ __forceinline__ void unpack8(const u32x4 v, float* f) {
    f[0] = __uint_as_float(v.x << 16); f[1] = __uint_as_float(v.x & 0xffff0000u); f[2] = __uint_as_float(v.y << 16); f[3] = __uint_as_float(v.y & 0xffff0000u);
    f[4] = __uint_as_float(v.z << 16); f[5] = __uint_as_float(v.z & 0xffff0000u); f[6] = __uint_as_float(v.w << 16); f[7] = __uint_as_float(v.w & 0xffff0000u);
}
#define MK_IDS() int tid = threadIdx.x; asm volatile("" : "+v"(tid)); const int lane = tid & 63, wave = __builtin_amdgcn_readfirstlane(tid >> 6); const int gw = blockIdx.x * NW + wave, NGW = gridDim.x * NW; (void)lane; (void)wave; (void)gw; (void)NGW
#define MFMA16(a, b, c) __builtin_amdgcn_mfma_f32_16x16x32_bf16((a), (b), (c), 0, 0, 0)

__device__ __forceinline__ void transpose_item(const float* W, int K, int Nsrc, int Npad, bf16_t* WT, float* scr, int item, int lane, const float* gain = nullptr) {
    const int nblk = Npad / 32, kb = item / nblk, nb = item % nblk, k0 = 64 * kb, n0 = 32 * nb;
    const int n = n0 + (lane & 31);
#pragma unroll 8
    for (int i = 0; i < 32; ++i) { const int kk = 2 * i + (lane >> 5); scr[kk * 33 + (lane & 31)] = (n < Nsrc) ? W[(size_t)(k0 + kk) * Nsrc + n] * (gain ? gain[k0 + kk] : 1.f) : 0.f; }
    asm volatile("s_waitcnt lgkmcnt(0)" ::: "memory");
    const int c = lane & 7;
#pragma unroll
    for (int j = 0; j < 4; ++j) { const int nn = (lane >> 3) + 8 * j; const float* s = scr + (8 * c) * 33 + nn;
        u32x4 o; o.x = pk2(s[0 * 33], s[1 * 33]); o.y = pk2(s[2 * 33], s[3 * 33]); o.z = pk2(s[4 * 33], s[5 * 33]); o.w = pk2(s[6 * 33], s[7 * 33]);
        *(u32x4*)(WT + (size_t)(n0 + nn) * K + k0 + 8 * c) = o; }
    asm volatile("s_waitcnt lgkmcnt(0)" ::: "memory");
}
__device__ __forceinline__ void phase_prologue(const Params& p, char* lds) {
    MK_IDS();
    float* scr = (float*)(lds + wave * 16384);
    unsigned char* ws = p.ws;
    constexpr int I_F1 = 16 * 128, I_F2 = 64 * 32, I_IE = 16 * 56, I_OE = 16 * 32, I_IO = 16 * 144, I_OO = 12 * 32;
    constexpr int T_F1 = 4 * I_F1, T_F2 = T_F1 + 4 * I_F2, T_IE = T_F2 + 2 * I_IE, T_OE = T_IE + 2 * I_OE, T_IO = T_OE + 2 * I_IO, T_OO = T_IO + 2 * I_OO;
    for (int it = gw; it < T_OO; it += NGW) {
        if (it < T_F1) { const int l = it / I_F1, r = it % I_F1; transpose_item(p.in[6] + (size_t)l * 1024 * 4096, 1024, 4096, 4096, (bf16_t*)(ws + WS_W1T) + (size_t)l * 4096 * 1024, scr, r, lane, p.in[4] + l * 1024); }
        else if (it < T_F2) { const int q = it - T_F1, l = q / I_F2, r = q % I_F2; transpose_item(p.in[7] + (size_t)l * 4096 * 1024, 4096, 1024, 1024, (bf16_t*)(ws + WS_W2T) + (size_t)l * 1024 * 4096, scr, r, lane); }
        else if (it < T_IE) { const int q = it - T_F2, l = q / I_IE, r = q % I_IE; transpose_item(p.in[8] + (size_t)l * 1024 * EIN, 1024, EIN, EIN, (bf16_t*)(ws + WS_WINE) + (size_t)l * EIN * 1024, scr, r, lane, p.in[3] + (2 * l) * 1024); }
        else if (it < T_OE) { const int q = it - T_IE, l = q / I_OE, r = q % I_OE; transpose_item(p.in[9] + (size_t)l * 1024 * 1024, 1024, 1024, 1024, (bf16_t*)(ws + WS_WOUTE) + (size_t)l * 1024 * 1024, scr, r, lane); }
        else if (it < T_IO) { const int q = it - T_OE, l = q / I_IO, r = q % I_IO; transpose_item(p.in[19] + (size_t)l * 1024 * OIN, 1024, OIN, OINP, (bf16_t*)(ws + WS_WINO) + (size_t)l * OINP * 1024, scr, r, lane, p.in[3] + (2 * l + 1) * 1024); }
        else { const int q = it - T_IO, l = q / I_OO, r = q % I_OO; transpose_item(p.in[20] + (size_t)l * OOUT * 1024, OOUT, 1024, 1024, (bf16_t*)(ws + WS_WOUTO) + (size_t)l * 1024 * OOUT, scr, r, lane); }
    }
    bf16_t* GW = (bf16_t*)(ws + WS_GW);
    const int gt = gw * 64 + lane, NGT = NGW * 64;
    for (int idx = gt; idx < 2 * 2 * 2 * 8 * 4096; idx += NGT) {
        const int d = idx & 63, e = (idx >> 6) & 63, blk = (idx >> 12) & 7, gate = (idx >> 15) & 1, dir = (idx >> 16) & 1, j = (idx >> 17) & 1;
        const float* src = gate ? p.in[16] : p.in[14];
        GW[idx] = (bf16_t)f2bf(src[((((size_t)j * 2 + dir) * 8 + blk) * 64 + d) * 64 + e]);
    }
}

__device__ __forceinline__ void phase_x0(const float* x, bf16_t* xb, float* ssq) {
    MK_IDS();
    for (int m = gw; m < TS; m += NGW) {
        const f32x4* xr = (const f32x4*)(x + (size_t)m * DMODEL) + lane;
        f32x4 v[4]; float s = 0.f;
#pragma unroll
        for (int j = 0; j < 4; ++j) { v[j] = xr[64 * j]; s += (v[j].x * v[j].x + v[j].y * v[j].y) + (v[j].z * v[j].z + v[j].w * v[j].w); }
        s = wave_sum(s);
        u32x2* o8 = (u32x2*)(xb + (size_t)m * DMODEL) + lane;
#pragma unroll
        for (int j = 0; j < 4; ++j) { u32x2 o; o.x = pk2(v[j].x, v[j].y); o.y = pk2(v[j].z, v[j].w); o8[64 * j] = o; }
        if (lane < 16) ssq[(size_t)m * 16 + lane] = lane == 0 ? s : 0.f;
    }
}
__device__ __forceinline__ void zero_f32(float* ptr, int n) {
    MK_IDS();
    for (int i = gw * 64 + lane; i < n; i += NGW * 64) ptr[i] = 0.f;
}
__device__ __forceinline__ void phase_rmsnorm_final(const bf16_t* xb, float* x, const float* g) {
    MK_IDS();
    for (int m = gw; m < TS; m += NGW) {
        const u32x2* xr = (const u32x2*)(xb + (size_t)m * DMODEL) + lane; f32x4* xw = (f32x4*)(x + (size_t)m * DMODEL) + lane; const f32x4* gr = (const f32x4*)g + lane;
        f32x4 v[4]; float s = 0.f;
#pragma unroll
        for (int j = 0; j < 4; ++j) { const u32x2 w = xr[64 * j]; v[j] = (f32x4){__uint_as_float(w.x << 16), __uint_as_float(w.x & 0xffff0000u), __uint_as_float(w.y << 16), __uint_as_float(w.y & 0xffff0000u)};
            s += (v[j].x * v[j].x + v[j].y * v[j].y) + (v[j].z * v[j].z + v[j].w * v[j].w); }
        const float rstd = 1.f / sqrtf(wave_sum(s) * (1.f / DMODEL) + EPS);
#pragma unroll
        for (int j = 0; j < 4; ++j) { const f32x4 gg = gr[64 * j]; xw[64 * j] = v[j] * rstd * gg; }
    }
}
struct EpiRes {
    static constexpr bool PERM = false, AFTER_DRAIN = false;
    bf16_t* xb; float* ssq; int ldc;
    __device__ __forceinline__ void operator()(const pg8::f32x4 (&acc)[2][2][4][2], const pg8::Unit& u, int wr, int wc, int fr, int fq) const {
        const int col0 = u.pn * pg8::BM + wc * 32 + 4 * fq;
#pragma unroll
        for (int ai = 0; ai < 2; ++ai)
#pragma unroll
            for (int m = 0; m < 4; ++m) { const int row = u.pm * pg8::BM + ai * pg8::HALF + wr * 64 + m * 16 + fr; const size_t off = (size_t)row * ldc + col0; float sq = 0.f;
                u32x2 bw[2][2];
#pragma unroll
                for (int bj = 0; bj < 2; ++bj)
#pragma unroll
                    for (int n = 0; n < 2; ++n) bw[bj][n] = *(const u32x2*)(xb + off + bj * pg8::HALF + n * 16);
#pragma unroll
                for (int bj = 0; bj < 2; ++bj)
#pragma unroll
                    for (int n = 0; n < 2; ++n) { const pg8::f32x4 a = acc[ai][bj][m][n];
                        const float o0 = __uint_as_float(bw[bj][n].x << 16) + a[0], o1 = __uint_as_float(bw[bj][n].x & 0xffff0000u) + a[1];
                        const float o2 = __uint_as_float(bw[bj][n].y << 16) + a[2], o3 = __uint_as_float(bw[bj][n].y & 0xffff0000u) + a[3];
                        u32x2 w; w.x = pg8::cvt_pk_bf16(o0, o1); w.y = pg8::cvt_pk_bf16(o2, o3); *(u32x2*)(xb + off + bj * pg8::HALF + n * 16) = w;
                        sq += (o0 * o0 + o1 * o1) + (o2 * o2 + o3 * o3); }
                sq += __shfl_xor(sq, 16); sq += __shfl_xor(sq, 32);
                if (fq == 0) ssq[(size_t)row * 16 + u.pn * 4 + wc] = sq;
                if (m & 1) asm volatile("" ::: "memory"); }
    }
};

__device__ __forceinline__ void even_qk_post(bf16_t* proj, const float* qg, const float* kg, int S) {
    MK_IDS();
    const int d = lane, axis = d >> 5, f = d & 15, half = (d >> 4) & 1;
    const float inv = exp2f(-(float)f * (13.287712379549449f / 16.f));
    const float gq = qg[d], gk = kg[d];
    for (int t = gw; t < TS; t += NGW) {
        const int s = t % S; const int pos = axis ? (s & 63) : (s >> 6);
        const float ang = (float)pos * inv; float sn, cs; sincosf(ang, &sn, &cs);
        bf16_t* row = proj + (size_t)t * EIN;
#pragma unroll
        for (int hh = 0; hh < 10; ++hh) {
            const int c0 = hh < 8 ? hh * 64 : 512 + (hh - 8) * 64;
            const float x = bf2f(row[c0 + d]);
            const float ss = wave_sum(x * x);
            const float y = x * (1.f / sqrtf(ss * (1.f / 64.f) + EPS)) * (hh < 8 ? gq : gk);
            const float pr = __shfl_xor(y, 16);
            float o = y * cs + (half ? pr : -pr) * sn;
            if (hh < 8) o *= attn_body::C2;
            row[c0 + d] = (bf16_t)f2bf(o);
        }
    }
}
__device__ __forceinline__ void even_lru_prep(const bf16_t* proj, const float* cw, const float* cb, const bf16_t* GWj, const float* br, const float* bi, const float* lam,
                                              bf16_t* LA, bf16_t* UU, f32x2* AGG, int S, char* lds) {
    MK_IDS();
    constexpr int XST = 1040;
    for (int tile = blockIdx.x; tile < TS / 64; tile += gridDim.x) {
        const int t0 = tile * 64;
        __syncthreads();
#pragma unroll 2
        for (int k = 0; k < 8; ++k) {
            const int idx = tid + k * NT, i = idx >> 6, cgp = idx & 63, t = t0 + i, s = t % S, ch = cgp * 8;
            float acc[8];
#pragma unroll
            for (int e = 0; e < 8; ++e) acc[e] = cb[ch + e];
#pragma unroll
            for (int j = 0; j < 4; ++j) { const int sp = s + j - 2;
                if (sp >= 0 && sp < S) { const u32x4 v = *(const u32x4*)(proj + (size_t)(t + j - 2) * EIN + 768 + ch); float xv[8]; unpack8(v, xv);
#pragma unroll
                    for (int e = 0; e < 8; ++e) acc[e] += cw[j * 512 + ch + e] * xv[e]; } }
            u32x4 o; o.x = pk2(acc[0], acc[1]); o.y = pk2(acc[2], acc[3]); o.z = pk2(acc[4], acc[5]); o.w = pk2(acc[6], acc[7]);
            *(u32x4*)(lds + i * XST + ch * 2) = o;
        }
        __syncthreads();
        const int G = lane >> 4, l16 = lane & 15, ch0 = wave * 64;
        for (int dir = 0; dir < 2; ++dir)
            for (int nt = 0; nt < 4; ++nt) {
                const int e = nt * 16 + l16, ch = ch0 + e;
                bf16x8 Br[2], Bi[2];
#pragma unroll
                for (int kk = 0; kk < 2; ++kk) {
                    Br[kk] = *(const bf16x8*)(GWj + ((((size_t)dir * 2 + 0) * 8 + wave) * 64 + e) * 64 + kk * 32 + G * 8);
                    Bi[kk] = *(const bf16x8*)(GWj + ((((size_t)dir * 2 + 1) * 8 + wave) * 64 + e) * 64 + kk * 32 + G * 8);
                }
                const float brv = br[dir * 512 + ch], biv = bi[dir * 512 + ch], spl = softplus(-lam[dir * 512 + ch]);
#pragma unroll
                for (int mt = 0; mt < 4; ++mt) {
                    f32x4 ar = {0.f, 0.f, 0.f, 0.f}, ai = {0.f, 0.f, 0.f, 0.f};
#pragma unroll
                    for (int kk = 0; kk < 2; ++kk) { const bf16x8 a = *(const bf16x8*)(lds + (mt * 16 + l16) * XST + (ch0 + kk * 32 + G * 8) * 2); ar = MFMA16(a, Br[kk], ar); ai = MFMA16(a, Bi[kk], ai); }
#pragma unroll
                    for (int r = 0; r < 4; ++r) { const int i = mt * 16 + G * 4 + r;
                        const float xc = bf2f(*(const bf16_t*)(lds + i * XST + ch * 2));
                        const float rg = __builtin_amdgcn_rcpf(1.f + __expf(-(ar[r] + brv))), ig = __builtin_amdgcn_rcpf(1.f + __expf(-(ai[r] + biv)));
                        const float la = -8.f * rg * spl; const float uu = __builtin_amdgcn_sqrtf(fmaxf(1.f - __expf(2.f * la), 0.f)) * (ig * xc);
                        const size_t o = ((size_t)dir * TS + t0 + i) * 512 + ch; LA[o] = (bf16_t)f2bf(la); UU[o] = (bf16_t)f2bf(uu); }
                }
            }
        asm volatile("s_waitcnt vmcnt(0)" ::: "memory");
        __syncthreads();
        {
            const int ch = tid;
#pragma unroll
            for (int dir = 0; dir < 2; ++dir) {
                float h = 0.f, P = 0.f;
                const bf16_t* la = LA + ((size_t)dir * TS + t0) * 512 + ch; const bf16_t* uu = UU + ((size_t)dir * TS + t0) * 512 + ch;
#pragma unroll
                for (int q = 0; q < 64; q += 8) {
                    float lv[8], uv[8];
#pragma unroll
                    for (int e = 0; e < 8; ++e) { const int i = dir ? 63 - (q + e) : q + e; lv[e] = bf2f(la[(size_t)i * 512]); uv[e] = bf2f(uu[(size_t)i * 512]); }
#pragma unroll
                    for (int e = 0; e < 8; ++e) { h = __expf(lv[e]) * h + uv[e]; P += lv[e]; }
                }
                AGG[((size_t)dir * (TS / 64) + tile) * 512 + ch] = (f32x2){P, h};
            }
        }
    }
}
__device__ __forceinline__ void even_lru_scan(const bf16_t* LA, const bf16_t* UU, const f32x2* AGG, const bf16_t* proj, bf16_t* Y, int S) {
    MK_IDS();
    const int ch = tid, TPB = S / 64;
    for (int tile = blockIdx.x; tile < TS / 64; tile += gridDim.x) {
        const int t0 = tile * 64, tb0 = (tile / TPB) * TPB;
        float cf = 0.f, cr = 0.f;
        for (int k0 = tb0; k0 < tile; k0 += 8) { f32x2 a[8];
#pragma unroll
            for (int q = 0; q < 8; ++q) { const int k = k0 + q < tile ? k0 + q : tile - 1; a[q] = AGG[(size_t)k * 512 + ch]; }
#pragma unroll
            for (int q = 0; q < 8; ++q) if (k0 + q < tile) cf = cf * __expf(a[q].x) + a[q].y; }
        for (int k0 = tb0 + TPB - 1; k0 > tile; k0 -= 8) { f32x2 a[8];
#pragma unroll
            for (int q = 0; q < 8; ++q) { const int k = k0 - q > tile ? k0 - q : tile + 1; a[q] = AGG[((size_t)(TS / 64) + k) * 512 + ch]; }
#pragma unroll
            for (int q = 0; q < 8; ++q) if (k0 - q > tile) cr = cr * __expf(a[q].x) + a[q].y; }
        float hf[64];
        {
            const bf16_t* la = LA + (size_t)t0 * 512 + ch; const bf16_t* uu = UU + (size_t)t0 * 512 + ch; float h = cf;
#pragma unroll
            for (int q = 0; q < 64; q += 8) {
                float lv[8], uv[8];
#pragma unroll
                for (int e = 0; e < 8; ++e) { lv[e] = bf2f(la[(size_t)(q + e) * 512]); uv[e] = bf2f(uu[(size_t)(q + e) * 512]); }
#pragma unroll
                for (int e = 0; e < 8; ++e) { h = __expf(lv[e]) * h + uv[e]; hf[q + e] = h; }
            }
        }
        {
            const bf16_t* la = LA + ((size_t)TS + t0) * 512 + ch; const bf16_t* uu = UU + ((size_t)TS + t0) * 512 + ch; float h = cr;
#pragma unroll
            for (int q = 0; q < 64; q += 8) {
                float lv[8], uv[8], gv[8];
#pragma unroll
                for (int e = 0; e < 8; ++e) { const int i = 63 - (q + e); lv[e] = bf2f(la[(size_t)i * 512]); uv[e] = bf2f(uu[(size_t)i * 512]); gv[e] = bf2f(proj[(size_t)(t0 + i) * EIN + 1280 + ch]); }
#pragma unroll
                for (int e = 0; e < 8; ++e) { const int i = 63 - (q + e); h = __expf(lv[e]) * h + uv[e]; Y[(size_t)(t0 + i) * DMODEL + 512 + ch] = (bf16_t)f2bf((hf[i] + h) * gelu_tanh(gv[e])); }
            }
        }
    }
}

__device__ __forceinline__ void odd_conv(const bf16_t* proj, const float* cw, bf16_t* QKVP, int S) {
    MK_IDS();
    for (int cr = 0; cr < (TS / 64 + (int)gridDim.x - 1) / (int)gridDim.x; ++cr) {
        const int c = cr * (int)gridDim.x + (int)blockIdx.x; if (c >= TS / 64) break;
        const int tb = c * 64 + wave * 8, sb = tb % S;
#pragma unroll
        for (int blk = 0; blk < 3; ++blk) {
            const int ch = blk * 512 + lane * 8;
            u32x4 rows[11];
#pragma unroll
            for (int q = 0; q < 11; ++q) { const int sp = sb + q - 2; rows[q] = (u32x4){0u, 0u, 0u, 0u};
                if (sp >= 0 && sp < S) rows[q] = *(const u32x4*)(proj + (size_t)(tb + q - 2) * OINP + ch); }
            f32x4 w0[4], w1[4];
#pragma unroll
            for (int j = 0; j < 4; ++j) { w0[j] = *(const f32x4*)(cw + j * 1536 + ch); w1[j] = *(const f32x4*)(cw + j * 1536 + ch + 4); }
#pragma unroll
            for (int i = 0; i < 8; ++i) {
                float acc[8];
#pragma unroll
                for (int e = 0; e < 8; ++e) acc[e] = 0.f;
#pragma unroll
                for (int j = 0; j < 4; ++j) { float xv[8]; unpack8(rows[i + j], xv);
                    acc[0] += w0[j].x * xv[0]; acc[1] += w0[j].y * xv[1]; acc[2] += w0[j].z * xv[2]; acc[3] += w0[j].w * xv[3];
                    acc[4] += w1[j].x * xv[4]; acc[5] += w1[j].y * xv[5]; acc[6] += w1[j].z * xv[6]; acc[7] += w1[j].w * xv[7]; }
                float ss = 0.f;
#pragma unroll
                for (int e = 0; e < 8; ++e) { acc[e] = silu(acc[e]); ss += acc[e] * acc[e]; }
                if (blk < 2) {
                    ss += __shfl_xor(ss, 1); ss += __shfl_xor(ss, 2); ss += __shfl_xor(ss, 4); ss += __shfl_xor(ss, 8);
                    const float rn = 1.f / sqrtf(ss + EPS);
#pragma unroll
                    for (int e = 0; e < 8; ++e) acc[e] *= rn;
                }
                u32x4 o; o.x = pk2(acc[0], acc[1]); o.y = pk2(acc[2], acc[3]); o.z = pk2(acc[4], acc[5]); o.w = pk2(acc[6], acc[7]);
                *(u32x4*)(QKVP + (size_t)(tb + i) * 1536 + ch) = o;
            }
        }
    }
}

__device__ __forceinline__ int frag128(int r, int k) { return ((((r >> 4) * 4 + (k >> 5)) * 64 + ((k >> 3) & 3) * 16 + (r & 15)) << 3) + (k & 7); }
__device__ __forceinline__ int frag64(int r, int k) { return ((((r >> 4) * 2 + (k >> 5)) * 64 + ((k >> 3) & 3) * 16 + (r & 15)) << 3) + (k & 7); }
__device__ __forceinline__ void odd_prep(const bf16_t* QKVP, const bf16_t* proj, const float* alog, const float* dtb, unsigned char* DNI, float* EGL, char* lds) {
    MK_IDS();
    constexpr int RS = 272;
    constexpr int HOFF = 69632;
    const float scale = 0.08838834764831845f;
    for (int itq = 0; itq < (TS / 64 + (int)gridDim.x - 1) / (int)gridDim.x * 4; ++itq) {
        const int c_ = (itq >> 2) * (int)gridDim.x + (int)blockIdx.x; if (c_ >= TS / 64) break; const int it0 = (c_ * 4 + (itq & 3)) * 2;
        int tq_ = tid; asm volatile("" : "+v"(tq_));
        const int half = tq_ >> 8, ht = tq_ & 255, hwave = __builtin_amdgcn_readfirstlane(ht >> 6), G = (tq_ & 63) >> 4, l16 = tq_ & 15;
        char* L = lds + half * HOFF;
        char* KS = L, *QS = L + 17408, *VS = L + 34816; float* LM = (float*)(L + 52224); float* GC = (float*)(L + 68608); float* BT = GC + 64; float* EG = BT + 64;
        const int it = it0 + half; const int d = it & 1, h = (it >> 1) & 3, c = it >> 3, t0 = c * 64;
        __syncthreads();
#pragma unroll
        for (int k = 0; k < 4; ++k) { const int idx = ht + k * 256, i = idx >> 4, pc = idx & 15; const int tk = d ? t0 + 63 - i : t0 + i;
            const bf16_t* src = QKVP + (size_t)tk * 1536 + h * 128 + pc * 8;
            *(u32x4*)(QS + i * RS + pc * 16) = *(const u32x4*)(src);
            *(u32x4*)(KS + i * RS + pc * 16) = *(const u32x4*)(src + 512);
            *(u32x4*)(VS + i * RS + pc * 16) = *(const u32x4*)(src + 1024); }
        if (hwave == 0) {
            const int i = lane; const int tk = d ? t0 + 63 - i : t0 + i;
            const float bl = bf2f(proj[(size_t)tk * OINP + 2048 + d * 4 + h]), al = bf2f(proj[(size_t)tk * OINP + 2056 + d * 4 + h]);
            const float beta = sigm(bl); float g = -__expf(alog[d * 4 + h]) * softplus(al + dtb[d * 4 + h]);
#pragma unroll
            for (int o = 1; o < 64; o <<= 1) { const float v = __shfl_up(g, o); if (lane >= o) g += v; }
            GC[i] = g; BT[i] = beta; EG[i] = __expf(g);
        }
        __syncthreads();
        {
            const bool isq = hwave >= 2; const char* XS = isq ? QS : KS;
#pragma unroll
            for (int mm = 0; mm < 2; ++mm) { const int mt = (hwave & 1) * 2 + mm;
                bf16x8 a[4];
#pragma unroll
                for (int kk = 0; kk < 4; ++kk) a[kk] = *(const bf16x8*)(XS + (mt * 16 + l16) * RS + (kk * 32 + G * 8) * 2);
#pragma unroll
                for (int nt = 0; nt < 4; ++nt) { f32x4 acc = {0.f, 0.f, 0.f, 0.f};
#pragma unroll
                    for (int kk = 0; kk < 4; ++kk) { const bf16x8 bb = *(const bf16x8*)(KS + (nt * 16 + l16) * RS + (kk * 32 + G * 8) * 2); acc = MFMA16(a[kk], bb, acc); }
                    const int j = nt * 16 + l16; const float gj = GC[j];
#pragma unroll
                    for (int r = 0; r < 4; ++r) { const int i = mt * 16 + G * 4 + r; const float dec = __expf(fminf(GC[i] - gj, 0.f));
                        if (!isq) LM[i * 64 + j] = (j < i) ? BT[i] * acc[r] * dec : 0.f;
                        else ((bf16_t*)(DNI + (size_t)it * DNI_BYTES + DNI_A))[frag64(i, j)] = (bf16_t)f2bf((j <= i) ? acc[r] * scale * dec : 0.f); }
                }
            }
        }
        __syncthreads();
        {
            float sol[64];
            const int cc = ht & 127; const bool isw = ht >= 128; const char* XS = isw ? KS : VS;
#pragma unroll
            for (int i = 0; i < 64; ++i) {
                float v = bf2f(*(const bf16_t*)(XS + i * RS + cc * 2)) * BT[i]; if (isw) v *= EG[i];
                float a0 = 0.f, a1 = 0.f;
#pragma unroll
                for (int j4 = 0; j4 < (i + 3) / 4; ++j4) { const f32x4 l4 = *(const f32x4*)(LM + i * 64 + j4 * 4);
                    if (j4 * 4 + 0 < i) a0 += l4.x * sol[j4 * 4 + 0]; if (j4 * 4 + 1 < i) a1 += l4.y * sol[j4 * 4 + 1];
                    if (j4 * 4 + 2 < i) a0 += l4.z * sol[j4 * 4 + 2]; if (j4 * 4 + 3 < i) a1 += l4.w * sol[j4 * 4 + 3];
                    if ((j4 & 1) == 1) asm volatile("" ::: "memory"); }
                v -= a0 + a1;
                sol[i] = v;
                ((bf16_t*)(DNI + (size_t)it * DNI_BYTES + (isw ? DNI_W : DNI_U)))[isw ? frag128(i, cc) : i * 128 + cc] = (bf16_t)f2bf(v);
                asm volatile("" ::: "memory");
            }
        }
        {
            const float gl = GC[63];
#pragma unroll
            for (int k = 0; k < 4; ++k) { const int idx = ht + k * 256;
                {
                    const int i = idx & 63, kg = idx >> 6; const u32x4 raw = *(const u32x4*)(QS + i * RS + kg * 16); float f[8]; unpack8(raw, f); const float sc = scale * EG[i];
                    u32x4 o; o.x = pk2(f[0] * sc, f[1] * sc); o.y = pk2(f[2] * sc, f[3] * sc); o.z = pk2(f[4] * sc, f[5] * sc); o.w = pk2(f[6] * sc, f[7] * sc);
                    *(u32x4*)((bf16_t*)(DNI + (size_t)it * DNI_BYTES + DNI_QT) + frag128(i, kg * 8)) = o; }
                {
                    const int dm = idx & 127, tg = idx >> 7; float f[8];
#pragma unroll
                    for (int q = 0; q < 8; ++q) { const int i = tg * 8 + q; f[q] = bf2f(*(const bf16_t*)(KS + i * RS + dm * 2)) * __expf(gl - GC[i]); }
                    u32x4 o; o.x = pk2(f[0], f[1]); o.y = pk2(f[2], f[3]); o.z = pk2(f[4], f[5]); o.w = pk2(f[6], f[7]);
                    *(u32x4*)((bf16_t*)(DNI + (size_t)it * DNI_BYTES + DNI_KTT) + frag64(dm, tg * 8)) = o; }
            }
            if (ht == 0) EGL[it] = __expf(gl);
        }
    }
}

__device__ __forceinline__ void odd_scan(const unsigned char* DNI, const float* EGL, bf16_t* OB, int S, int nb, char* lds) {
    MK_IDS();
    constexpr int O_SB = 0, O_VN = 4352, O_OUT = 6656, PFD = 7;
    const int NC = S / 64, G = lane >> 4, l16 = lane & 15;
    const int nitems = nb * 64;
    const int mt = wave & 3; const bool lo = wave < 4;
    for (int item = blockIdx.x; item < nitems; item += gridDim.x) {
        const int e = (item >> 3) & 7, sq = (item & 7) | ((item >> 6) << 3); const int d = sq & 1, h = (sq >> 1) & 3, b = sq >> 3;
        __syncthreads();
        for (int i = tid; i < 4352 / 4; i += NT) ((unsigned*)(lds + O_SB))[i] = 0u;
        f32x4 Sreg = {0.f, 0.f, 0.f, 0.f};
        const long dstep = (long)(d ? -8 : 8) * DNI_BYTES;
        const unsigned char* base0 = DNI + (size_t)(((b * NC + (d ? NC - 1 : 0)) * 4 + h) * 2 + d) * DNI_BYTES;
        const unsigned char* pX = base0 + (lo ? DNI_W : DNI_QT) + ((mt * 4) * 64 + lane) * 16;
        const unsigned char* pA = base0 + DNI_A + ((mt * 2) * 64 + lane) * 16;
        const unsigned char* pK = base0 + DNI_KTT + ((wave * 2) * 64 + lane) * 16;
        const unsigned char* pU = base0 + DNI_U + ((mt * 16 + G * 4) * 128 + e * 16 + l16) * 2;
        const float* pE = EGL + (((b * NC + (d ? NC - 1 : 0)) * 4 + h) * 2 + d);
        const unsigned char* pP = base0 + (long)PFD * dstep + e * 9216 + (tid < 144 ? tid : 143) * 64;
        bf16_t* pO = OB + ((size_t)d * TS + (size_t)(b * NC + (d ? NC - 1 : 0)) * 64 + (d ? 63 - (tid >> 3) : (tid >> 3))) * 512 + h * 128 + e * 16 + (tid & 7) * 2;
        const long ostep = (long)(d ? -64 : 64) * 512;
        u32x4 aX[4], aA[2], aK[2], bX[4], bA[2], bK[2], cX[4], cA[2], cK[2];
        unsigned aU[4], bU[4], cU[4]; float aE, bE, cE; unsigned pf_dummy = 0u;
#define DN_LOAD(P) do { \
            _Pragma("unroll") for (int kk = 0; kk < 4; ++kk) P##X[kk] = *(const u32x4*)(pX + kk * 1024); \
            _Pragma("unroll") for (int kk = 0; kk < 2; ++kk) { P##A[kk] = *(const u32x4*)(pA + kk * 1024); P##K[kk] = *(const u32x4*)(pK + kk * 1024); } \
            _Pragma("unroll") for (int r = 0; r < 4; ++r) P##U[r] = *(const bf16_t*)(pU + r * 256); \
            P##E = *pE; pX += dstep; pA += dstep; pK += dstep; pU += dstep; pE += (d ? -8 : 8); } while (0)
#define DN_STEP(P, PL) do { \
            DN_LOAD(PL); \
            if (wave < 3) { asm volatile("global_load_dword %0, %1, off" : "+v"(pf_dummy) : "v"(pP) : "memory"); } \
            pP += dstep; \
            f32x4 acc = {0.f, 0.f, 0.f, 0.f}, acc2 = {0.f, 0.f, 0.f, 0.f}; \
            { bf16x8 sb_[4]; \
              _Pragma("unroll") for (int kk = 0; kk < 4; ++kk) sb_[kk] = *(const bf16x8*)(lds + O_SB + l16 * 272 + (kk * 32 + G * 8) * 2); \
              asm volatile("s_waitcnt lgkmcnt(0)" : "+v"(sb_[0]), "+v"(sb_[1]), "+v"(sb_[2]), "+v"(sb_[3]) :: "memory"); \
              acc = MFMA16(__builtin_bit_cast(bf16x8, P##X[0]), sb_[0], acc); acc2 = MFMA16(__builtin_bit_cast(bf16x8, P##X[1]), sb_[1], acc2); \
              acc = MFMA16(__builtin_bit_cast(bf16x8, P##X[2]), sb_[2], acc); acc2 = MFMA16(__builtin_bit_cast(bf16x8, P##X[3]), sb_[3], acc2); \
              acc = acc + acc2; } \
            if (lo) { u32x2 o; float v[4]; \
              _Pragma("unroll") for (int r = 0; r < 4; ++r) v[r] = __uint_as_float(P##U[r] << 16) - acc[r]; \
              o.x = attn_body::cvtpk_s(v[0], v[1]); o.y = attn_body::cvtpk_s(v[2], v[3]); \
              *(u32x2*)(lds + O_VN + l16 * 144 + (mt * 16 + G * 4) * 2) = o; } \
            asm volatile("s_waitcnt lgkmcnt(0)\n\ts_barrier" ::: "memory"); \
            bf16x8 vb[2]; \
            _Pragma("unroll") for (int kk = 0; kk < 2; ++kk) vb[kk] = *(const bf16x8*)(lds + O_VN + l16 * 144 + (kk * 32 + G * 8) * 2); \
            asm volatile("s_waitcnt lgkmcnt(0)" : "+v"(vb[0]), "+v"(vb[1]) :: "memory"); \
            Sreg = Sreg * P##E; \
            _Pragma("unroll") for (int kk = 0; kk < 2; ++kk) Sreg = MFMA16(__builtin_bit_cast(bf16x8, P##K[kk]), vb[kk], Sreg); \
            { u32x2 o; o.x = attn_body::cvtpk_s(Sreg[0], Sreg[1]); o.y = attn_body::cvtpk_s(Sreg[2], Sreg[3]); \
              *(u32x2*)(lds + O_SB + l16 * 272 + (wave * 16 + G * 4) * 2) = o; } \
            if (!lo) { \
              _Pragma("unroll") for (int kk = 0; kk < 2; ++kk) acc = MFMA16(__builtin_bit_cast(bf16x8, P##A[kk]), vb[kk], acc); \
              const unsigned w0_ = attn_body::cvtpk_s(acc[0], acc[1]), w1_ = attn_body::cvtpk_s(acc[2], acc[3]); \
              bf16_t* op_ = (bf16_t*)(lds + O_OUT + ((mt * 16 + G * 4) * 16 + l16) * 2); \
              op_[0] = (bf16_t)(w0_ & 0xffffu); op_[16] = (bf16_t)(w0_ >> 16); op_[32] = (bf16_t)(w1_ & 0xffffu); op_[48] = (bf16_t)(w1_ >> 16); } \
            asm volatile("s_waitcnt lgkmcnt(0)\n\ts_barrier" ::: "memory"); \
            *(unsigned*)pO = *(const unsigned*)(lds + O_OUT + tid * 4); pO += ostep; } while (0)
        DN_LOAD(a); DN_LOAD(b);
        __syncthreads();
        int n = 0;
        for (; n + 3 <= NC; n += 3) {
            DN_STEP(a, c);
            DN_STEP(b, a);
            DN_STEP(c, b);
        }
        if (n < NC) { DN_STEP(a, c); }
        if (n + 1 < NC) { DN_STEP(b, a); }
#undef DN_STEP
#undef DN_LOAD
        asm volatile("s_waitcnt vmcnt(0)" ::: "memory");
        asm volatile("" :: "v"(pf_dummy));
    }
}

__device__ __forceinline__ int t5_bucket(int rel) {
    const int n = rel < 0 ? -rel : rel; int v;
    if (n < 8) v = n; else v = 8 + (n >= 15) + (n >= 27) + (n >= 50) + (n >= 91) + (n >= 166) + (n >= 305) + (n >= 559);
    return (rel > 0 ? 16 : 0) + v;
}
__device__ __forceinline__ void odd_dilated(bf16_t* proj, const float* relb, float* LSE, int S, char* lds, int first_wg, int n_wg) {
    MK_IDS();
    constexpr int KST = 144, VST = 400, HOFF = 27648 + 25600 + 1024;
    const int half = tid >> 8, ht = tid & 255, wv = ht >> 6, G = lane >> 4, l16 = lane & 15;
    char* L = lds + half * HOFF; char* KS = L; char* VT = L + 27648; float* BIAS = (float*)(L + 27648 + 25600);
    const int NBb = S / 64;
    const int wgi = (int)blockIdx.x - first_wg;
    if (wgi < 0) return;
    for (int it0 = wgi * 2; it0 < 3072; it0 += n_wg * 2) {
        const int it = it0 + half; const int zb = it & 255, sl = (it >> 8) & 3, g = it >> 10;
        const int dil = g == 0 ? 1 : (g == 1 ? 4 : 16), lg = g * 2;
        const int M = S >> lg, MB = M / 64;
        const int b = zb / NBb, r0 = zb % NBb, rho = r0 / MB, n = r0 % MB;
        const int hc = (g * 4 + sl) * 64;
        const size_t tb = (size_t)b * S;
        __syncthreads();
#pragma unroll
        for (int k = 0; k < 6; ++k) { const int idx = ht + k * 256, kj = idx >> 3, pc = idx & 7; const int mk = 64 * n - 64 + kj;
            u32x4 kv = {0u, 0u, 0u, 0u}, vv = {0u, 0u, 0u, 0u};
            if (mk >= 0 && mk < M) { const bf16_t* rowp = proj + (tb + (size_t)mk * dil + rho) * OINP; kv = *(const u32x4*)(rowp + 2832 + hc + pc * 8); vv = *(const u32x4*)(rowp + 3600 + hc + pc * 8); }
            *(u32x4*)(KS + kj * KST + pc * 16) = kv;
            const unsigned w[4] = {vv.x, vv.y, vv.z, vv.w};
#pragma unroll
            for (int q = 0; q < 4; ++q) { *(bf16_t*)(VT + (pc * 8 + 2 * q) * VST + kj * 2) = (bf16_t)(w[q] & 0xffffu); *(bf16_t*)(VT + (pc * 8 + 2 * q + 1) * VST + kj * 2) = (bf16_t)(w[q] >> 16); } }
        if (ht < 129) BIAS[ht] = relb[t5_bucket((ht - 64) * dil) * 12 + g * 4 + sl];
        const int mq = 64 * n + 16 * wv + l16; const size_t tq = tb + (size_t)mq * dil + rho;
        bf16x8 qf[2];
#pragma unroll
        for (int kk = 0; kk < 2; ++kk) qf[kk] = *(const bf16x8*)(proj + tq * OINP + 2064 + hc + kk * 32 + G * 8);
        __syncthreads();
        f32x4 sc[9]; float mx = -1e30f;
#pragma unroll
        for (int kt = 0; kt < 9; ++kt) { f32x4 acc = {0.f, 0.f, 0.f, 0.f};
#pragma unroll
            for (int kk = 0; kk < 2; ++kk) { const bf16x8 a = *(const bf16x8*)(KS + ((wv + kt) * 16 + l16) * KST + (kk * 32 + G * 8) * 2); acc = MFMA16(a, qf[kk], acc); }
#pragma unroll
            for (int r = 0; r < 4; ++r) { const int kj = (wv + kt) * 16 + G * 4 + r; const int delta = kj - 64 - 16 * wv - l16; const int mk = 64 * n - 64 + kj;
                const bool ok = (delta >= -64) && (delta <= 64) && (mk >= 0) && (mk < M);
                const float s = ok ? acc[r] * 0.125f + BIAS[(delta < -64 ? -64 : (delta > 64 ? 64 : delta)) + 64] : -1e30f;
                acc[r] = s; mx = fmaxf(mx, s); }
            sc[kt] = acc; }
        mx = fmaxf(mx, __shfl_xor(mx, 16)); mx = fmaxf(mx, __shfl_xor(mx, 32));
        float sum = 0.f;
#pragma unroll
        for (int kt = 0; kt < 9; ++kt)
#pragma unroll
            for (int r = 0; r < 4; ++r) { const float pv_ = (sc[kt][r] > -1e29f) ? __expf(sc[kt][r] - mx) : 0.f; sc[kt][r] = pv_; sum += pv_; }
        sum += __shfl_xor(sum, 16); sum += __shfl_xor(sum, 32);
        f32x4 ot[4];
#pragma unroll
        for (int dt = 0; dt < 4; ++dt) ot[dt] = (f32x4){0.f, 0.f, 0.f, 0.f};
#pragma unroll
        for (int pp = 0; pp < 5; ++pp) {
            u32x4 pb; pb.x = pk2(sc[2 * pp][0], sc[2 * pp][1]); pb.y = pk2(sc[2 * pp][2], sc[2 * pp][3]);
            if (pp < 4) { pb.z = pk2(sc[2 * pp + 1][0], sc[2 * pp + 1][1]); pb.w = pk2(sc[2 * pp + 1][2], sc[2 * pp + 1][3]); } else { pb.z = 0u; pb.w = 0u; }
            const bf16x8 pbf = __builtin_bit_cast(bf16x8, pb);
#pragma unroll
            for (int dt = 0; dt < 4; ++dt) {
                u32x4 av; const u32x2 lo = *(const u32x2*)(VT + (dt * 16 + l16) * VST + ((wv + 2 * pp) * 16 + G * 4) * 2); av.x = lo.x; av.y = lo.y;
                if (pp < 4) { const u32x2 hi = *(const u32x2*)(VT + (dt * 16 + l16) * VST + ((wv + 2 * pp + 1) * 16 + G * 4) * 2); av.z = hi.x; av.w = hi.y; } else { av.z = 0u; av.w = 0u; }
                ot[dt] = MFMA16(__builtin_bit_cast(bf16x8, av), pbf, ot[dt]);
            }
        }
        const float rs = 1.f / sum;
        bf16_t* od = proj + tq * OINP + (g * 4 + sl) * 64;
#pragma unroll
        for (int dt = 0; dt < 4; ++dt) { const f32x4 v_ = ot[dt] * rs; u32x2 w_; w_.x = pk2(v_[0], v_[1]); w_.y = pk2(v_[2], v_[3]); *(u32x2*)(od + dt * 16 + G * 4) = w_; }
        if (G == 0) LSE[tq * 12 + g * 4 + sl] = mx + __logf(sum);
    }
}

__device__ __forceinline__ void odd_combine(const bf16_t* OB, const bf16_t* proj, const float* LSE, const float* og, bf16_t* Y) {
    MK_IDS();
    float gn[8];
#pragma unroll
    for (int e = 0; e < 8; ++e) gn[e] = og[(lane & 15) * 8 + e];
    const int sl = lane >> 4;
    for (int t = gw; t < TS; t += NGW) {
        const bf16_t* prow = proj + (size_t)t * OINP;
        const u32x4 fa = *(const u32x4*)(OB + (size_t)t * 512 + lane * 8), ra = *(const u32x4*)(OB + ((size_t)TS + t) * 512 + lane * 8), za = *(const u32x4*)(prow + 1536 + lane * 8);
        const u32x2 d0 = *(const u32x2*)(prow + lane * 4), d1 = *(const u32x2*)(prow + 256 + lane * 4), d2 = *(const u32x2*)(prow + 512 + lane * 4);
        const float l0 = LSE[(size_t)t * 12 + sl], l1 = LSE[(size_t)t * 12 + 4 + sl], l2 = LSE[(size_t)t * 12 + 8 + sl];
        float f[8], r[8], z[8]; unpack8(fa, f); unpack8(ra, r); unpack8(za, z);
        float ss = 0.f;
#pragma unroll
        for (int e = 0; e < 8; ++e) { f[e] += r[e]; ss += f[e] * f[e]; }
        ss += __shfl_xor(ss, 1); ss += __shfl_xor(ss, 2); ss += __shfl_xor(ss, 4); ss += __shfl_xor(ss, 8);
        const float rn = 1.f / sqrtf(ss * (1.f / 128.f) + EPS);
#pragma unroll
        for (int e = 0; e < 8; ++e) f[e] = f[e] * rn * gn[e] * silu(z[e]);
        u32x4 o; o.x = pk2(f[0], f[1]); o.y = pk2(f[2], f[3]); o.z = pk2(f[4], f[5]); o.w = pk2(f[6], f[7]);
        *(u32x4*)(Y + (size_t)t * OOUT + lane * 8) = o;
        const float m = fmaxf(l0, fmaxf(l1, l2)); const float w0 = __expf(l0 - m), w1 = __expf(l1 - m), w2 = __expf(l2 - m); const float rs = 1.f / (w0 + w1 + w2);
        const float a0 = w0 * rs, a1 = w1 * rs, a2 = w2 * rs;
        const float v0 = a0 * __uint_as_float(d0.x << 16) + a1 * __uint_as_float(d1.x << 16) + a2 * __uint_as_float(d2.x << 16);
        const float v1 = a0 * __uint_as_float(d0.x & 0xffff0000u) + a1 * __uint_as_float(d1.x & 0xffff0000u) + a2 * __uint_as_float(d2.x & 0xffff0000u);
        const float v2 = a0 * __uint_as_float(d0.y << 16) + a1 * __uint_as_float(d1.y << 16) + a2 * __uint_as_float(d2.y << 16);
        const float v3 = a0 * __uint_as_float(d0.y & 0xffff0000u) + a1 * __uint_as_float(d1.y & 0xffff0000u) + a2 * __uint_as_float(d2.y & 0xffff0000u);
        u32x2 od; od.x = pk2(v0, v1); od.y = pk2(v2, v3);
        *(u32x2*)(Y + (size_t)t * OOUT + 512 + lane * 4) = od;
    }
}

__global__ void __launch_bounds__(NT, 2) fwd_megakernel(Params p) {
    extern __shared__ __attribute__((aligned(16))) unsigned char lds_raw[];
    cg::grid_group grid = cg::this_grid();
    char* lds = (char*)lds_raw;
    PG8_LAS unsigned char* ldsl = (PG8_LAS unsigned char*)lds_raw;
    const int Gr = gridDim.x;
    volatile LAS unsigned* MISC = (volatile LAS unsigned*)((PG8_LAS unsigned char*)lds_raw + (LDS_BYTES - 128));
    if (threadIdx.x < 32) MISC[threadIdx.x] = 0u;
    __syncthreads();
    xb::XcdBarrier bar = xb::xcd_barrier_post((unsigned*)p.ws, MISC + 8);
#define GSYNC() xb::xcd_barrier(bar)
    unsigned char* ws = p.ws;
    bf16_t* H = (bf16_t*)(ws + WS_H); bf16_t* PROJ = (bf16_t*)(ws + WS_PROJ); unsigned char* SCR = ws + WS_SCR;

    phase_prologue(p, lds);
    grid.sync();

    float* SSQA = (float*)(SCR + 232 * MiB); float* SSQB = (float*)(SCR + 234 * MiB);
    bf16_t* YE = (bf16_t*)(SCR + 192 * MiB); bf16_t* YO = (bf16_t*)(SCR + SC_QKVP);
    for (int seg = 0; seg < NSEG; ++seg) {
        const int S = seg < 2 ? 16384 : 2048, nb = seg < 2 ? 1 : 8;
        const float* xin = (seg < 2 ? p.in[0] : p.in[1]) + (size_t)(seg & 1) * TS * DMODEL;
        float* xo = p.out + (size_t)seg * TS * DMODEL;
        phase_x0(xin, H, SSQB);
        GSYNC();
        for (int layer = 0; layer < 4; ++layer) {
            const int j = layer >> 1; const bool odd = layer & 1;
            {
                const int N = odd ? OINP : EIN;
                const bf16_t* Bt = odd ? (const bf16_t*)(ws + WS_WINO) + (size_t)j * OINP * 1024 : (const bf16_t*)(ws + WS_WINE) + (size_t)j * EIN * 1024;
                pg8::Gemm g{H, Bt, TS, N, 1024}; pg8::StaticOrder So; So.init(TS, N, Gr, (int)blockIdx.x);
                pg8::EpiBf16<0> E{PROJ, N, nullptr, 0, 0, 1.f, SSQB};
                pg8::gemm_phase<pg8::EpiBf16<0>, pg8::StaticOrder, true, true>(ldsl, g, So, E);
            }
            GSYNC();
            if (!odd) {
                even_qk_post(PROJ, p.in[10] + j * 64, p.in[11] + j * 64, S);
                even_lru_prep(PROJ, p.in[12] + j * 2048, p.in[13] + j * 512, (const bf16_t*)(ws + WS_GW) + (size_t)j * 2 * 2 * 8 * 4096, p.in[15] + j * 1024, p.in[17] + j * 1024, p.in[18] + j * 1024,
                              (bf16_t*)(SCR + SC_LA), (bf16_t*)(SCR + SC_UU), (f32x2*)(SCR + SC_AGG), S, lds);
                GSYNC();
                {
                    const int nqb = S / 256, nunits = nb * 8 * nqb;
                    for (int u = blockIdx.x; u < nunits; u += Gr) {
                        const int qb = u % nqb, h = (u / nqb) % 8, b = u / (nqb * 8), kvh = h >> 2;
                        const attn_body::bf16* base = (const attn_body::bf16*)PROJ + (size_t)b * S * EIN;
                        attn_body::attn_unit<8>(qb, S, base + h * 64, EIN, base + 512 + kvh * 64, base + 640 + kvh * 64, EIN, (attn_body::bf16*)YE + (size_t)b * S * DMODEL + h * 64, DMODEL, lds);
                    }
                }
                __syncthreads();
                even_lru_scan((const bf16_t*)(SCR + SC_LA), (const bf16_t*)(SCR + SC_UU), (const f32x2*)(SCR + SC_AGG), PROJ, YE, S);
                GSYNC();
                {
                    pg8::Gemm g{YE, (const bf16_t*)(ws + WS_WOUTE) + (size_t)j * 1024 * 1024, TS, 1024, 1024}; pg8::StaticOrder So; So.init(TS, 1024, Gr, (int)blockIdx.x);
                    EpiRes E{H, SSQA, DMODEL};
                    pg8::gemm_phase<EpiRes, pg8::StaticOrder, true, true>(ldsl, g, So, E);
                }
            } else {
                odd_conv(PROJ, p.in[21] + j * 4 * 1536, (bf16_t*)(SCR + SC_QKVP), S);
                asm volatile("s_waitcnt vmcnt(0)" ::: "memory"); __syncthreads();
                odd_prep((const bf16_t*)(SCR + SC_QKVP), PROJ, p.in[22] + j * 8, p.in[23] + j * 8, SCR + SC_DNI, (float*)(SCR + SC_EGL), lds);
                GSYNC();
                {
                    const int nscan = nb * 64;
                    odd_scan(SCR + SC_DNI, (const float*)(SCR + SC_EGL), (bf16_t*)(SCR + SC_OB), S, nb, lds);
                    const int first = nscan < Gr ? nscan : 0;
                    odd_dilated(PROJ, p.in[2], (float*)(SCR + SC_LSE), S, lds, first, Gr - first);
                }
                GSYNC();
                odd_combine((const bf16_t*)(SCR + SC_OB), PROJ, (const float*)(SCR + SC_LSE), p.in[24] + j * 128, YO);
                GSYNC();
                {
                    pg8::Gemm g{YO, (const bf16_t*)(ws + WS_WOUTO) + (size_t)j * 1024 * OOUT, TS, 1024, OOUT}; pg8::StaticOrder So; So.init(TS, 1024, Gr, (int)blockIdx.x);
                    EpiRes E{H, SSQA, DMODEL};
                    pg8::gemm_phase<EpiRes, pg8::StaticOrder, true, true>(ldsl, g, So, E);
                }
            }
            GSYNC();
            {
                pg8::Gemm g{H, (const bf16_t*)(ws + WS_W1T) + (size_t)layer * 4096 * 1024, TS, DFF, 1024}; pg8::StaticOrder So; So.init(TS, DFF, Gr, (int)blockIdx.x);
                pg8::EpiBf16<2> E{(bf16_t*)(SCR + SC_HID), DFF, nullptr, 0, 0, 1.f, SSQA};
                pg8::gemm_phase<pg8::EpiBf16<2>, pg8::StaticOrder, true, true>(ldsl, g, So, E);
            }
            GSYNC();
            {
                pg8::Gemm g{(const bf16_t*)(SCR + SC_HID), (const bf16_t*)(ws + WS_W2T) + (size_t)layer * 1024 * 4096, TS, 1024, DFF}; pg8::StaticOrder So; So.init(TS, 1024, Gr, (int)blockIdx.x);
                EpiRes E{H, SSQB, DMODEL};
                pg8::gemm_phase<EpiRes, pg8::StaticOrder, true, true>(ldsl, g, So, E);
            }
            GSYNC();
        }
        phase_rmsnorm_final(H, xo, p.in[5]);
        GSYNC();
    }
}
}

extern "C" void kernel_launch(void* const* d_in, const int* in_sizes, int n_in, void* d_out, int out_size, void* d_ws, size_t ws_size, hipStream_t stream) {
    static int grid = 0;
    if (grid == 0) {
        if (n_in != 25 || ws_size < mk::WS_END) { fprintf(stderr, "kernel_launch: unexpected n_in %d / ws_size %zu\n", n_in, ws_size); grid = -1; return; }
        int dev = 0, cus = 0, per_cu = 0;
        hipGetDevice(&dev); hipDeviceGetAttribute(&cus, hipDeviceAttributeMultiprocessorCount, dev);
        if (hipFuncSetAttribute((const void*)mk::fwd_megakernel, hipFuncAttributeMaxDynamicSharedMemorySize, mk::LDS_BYTES) != hipSuccess) { fprintf(stderr, "hipFuncSetAttribute failed\n"); }
        hipOccupancyMaxActiveBlocksPerMultiprocessor(&per_cu, (const void*)mk::fwd_megakernel, mk::NT, mk::LDS_BYTES);
        (void)hipGetLastError();
        if (per_cu < 1) per_cu = 1;
        grid = cus * 1;
        fprintf(stderr, "kernel_launch: cus %d per_cu %d grid %d\n", cus, per_cu, grid);
    }
    if (grid < 0) return;
    if (hipMemsetAsync(d_ws, 0, 65536, stream) != hipSuccess) { fprintf(stderr, "memset failed\n"); return; }
    mk::Params p{};
    for (int i = 0; i < 25; ++i) p.in[i] = (const float*)d_in[i];
    p.out = (float*)d_out; p.ws = (unsigned char*)d_ws;
    void* args[] = {&p};
    hipError_t e = hipLaunchCooperativeKernel((const void*)mk::fwd_megakernel, dim3(grid), dim3(mk::NT), args, mk::LDS_BYTES, stream);
    if (e != hipSuccess) fprintf(stderr, "cooperative launch failed: %s (grid %d)\n", hipGetErrorString(e), grid);
}
```

```cpp
#include <hip/hip_runtime.h>
#include <hip/hip_cooperative_groups.h>
#include <hip/hip_bf16.h>
#include <cstdio>
#include <cstdint>
#include <cmath>
namespace cg = cooperative_groups;
namespace pg8 {
#define PG8_LAS __attribute__((address_space(3)))
typedef unsigned short bf16_t;
typedef short bf16x8 __attribute__((ext_vector_type(8)));
typedef float f32x4 __attribute__((ext_vector_type(4)));
typedef unsigned u32x4 __attribute__((ext_vector_type(4)));
constexpr int BM = 256, BK = 64, HALF = 128, HTB = HALF * BK * 2  , STAGE_BYTES = 8 * HTB, NXCD = 8, WGM = 8;

__host__ __device__ __forceinline__ int lds_byte(int r, int c) { const int st = (r >> 4) * 2 + (c >> 5), rr = r & 15, cc = c & 31, ob = rr * 64 + cc * 2; return st * 1024 + (ob ^ (((ob >> 9) & 1) << 5)); }
__host__ __device__ __forceinline__ void stage_rc(int b, int& R, int& C) { const int st = b / 1024, sb = b % 1024, swz = sb ^ (((sb >> 9) & 1) << 5); R = (st >> 1) * 16 + swz / 64; C = (st & 1) * 32 + (swz % 64) / 2; }
__host__ __device__ __forceinline__ int perm32(int rho) { const int n = rho >> 4, i = rho & 15; return 8 * (i >> 2) + 4 * n + (i & 3); }

struct Unit { int pm, pn; };
struct Gemm { const bf16_t* A; const bf16_t* Bt; int M, N, K; };

struct StaticOrder {
    int nM, nN, nwg, G, c;
    __host__ __device__ void init(int M, int N, int G_, int c_) { nM = M / BM; nN = N / BM; nwg = nM * nN; G = G_; c = c_; }
    __host__ __device__ bool next(int i, Unit& u) const {
        const long L = (long)i * G + c; if (L >= nwg) return false;
        int wgid = (int)L; { const int q = nwg / NXCD, r = nwg % NXCD, xcd = wgid % NXCD, off = wgid / NXCD; wgid = (xcd < r ? xcd * (q + 1) : r * (q + 1) + (xcd - r) * q) + off; }
        const int nig = WGM * nN, gid = wgid / nig, fm = gid * WGM, gsz = (nM - fm) < WGM ? (nM - fm) : WGM;
        u.pm = fm + ((wgid % nig) % gsz); u.pn = (wgid % nig) / gsz; return true;
    }
    __device__ __forceinline__ void a_ready(const Unit&) const {}
    __device__ __forceinline__ void done(const Unit&) const {}
};

__device__ __forceinline__ unsigned cvt_pk_bf16(float lo, float hi) { unsigned r; asm volatile("v_cvt_pk_bf16_f32 %0, %1, %2" : "=v"(r) : "v"(lo), "v"(hi)); return r; }
typedef float f32x2 __attribute__((ext_vector_type(2)));
__device__ __forceinline__ f32x2 gelu_pk(f32x2 v) {
    const f32x2 av = __builtin_elementwise_abs(v), d = av * 0.2316418882f + 1.0f;
    f32x2 t; t.x = __builtin_amdgcn_rcpf(d.x); t.y = __builtin_amdgcn_rcpf(d.y);
    f32x2 q = t * 0.5307027145f + (-0.7265760135f); q = q * t + 0.7107068705f; q = q * t + (-0.142248368f); q = q * t + 0.127414796f; q = q * t;
    const f32x2 s = (v * v) * (-0.72134752044f);
    f32x2 e; e.x = __builtin_amdgcn_exp2f(s.x); e.y = __builtin_amdgcn_exp2f(s.y);
    const f32x2 m = v * (q * e), r = v - m;
    f32x2 o; o.x = v.x < 0.f ? m.x : r.x; o.y = v.y < 0.f ? m.y : r.y; return o;
}

template <int ACT  > struct EpiBf16 {
    static constexpr bool PERM = true, AFTER_DRAIN = false; static_assert(ACT == 0 || ACT == 1 || ACT == 2, "EpiBf16: ACT 0 none, 1 gelu, 2 relu^2");
    bf16_t* O; int ldc; const float* bias; int split_cols; size_t split_stride; float scale0; const float* ssq;
    __device__ __forceinline__ void operator()(const f32x4 (&acc)[2][2][4][2], const Unit& u, int wr, int wc, int fr, int fq) const {
        const int row0 = u.pm * BM + wr * 64 + fr; int colt = u.pn * BM; bf16_t* base = O;
        float sc = 1.f; if (split_cols) { const int t = colt / split_cols; base += (size_t)t * split_stride; colt -= t * split_cols; if (t == 0) sc = scale0; }
        const int col0 = colt + wc * 32 + 8 * fq, bcol0 = u.pn * BM + wc * 32 + 8 * fq;
        float rsc[2][4];
        if (ssq) { f32x4 t_[2][4];
#pragma unroll
            for (int ai = 0; ai < 2; ++ai)
#pragma unroll
                for (int m = 0; m < 4; ++m) t_[ai][m] = *(const f32x4*)(ssq + (size_t)(row0 + ai * HALF + m * 16) * 16 + fq * 4);
#pragma unroll
            for (int ai = 0; ai < 2; ++ai)
#pragma unroll
                for (int m = 0; m < 4; ++m) { float s_ = (t_[ai][m][0] + t_[ai][m][1]) + (t_[ai][m][2] + t_[ai][m][3]); s_ += __shfl_xor(s_, 16); s_ += __shfl_xor(s_, 32); rsc[ai][m] = 1.0f / sqrtf(s_ * (1.0f / 1024.0f) + 1e-6f); }
        } else {
#pragma unroll
            for (int ai = 0; ai < 2; ++ai)
#pragma unroll
                for (int m = 0; m < 4; ++m) rsc[ai][m] = 1.0f; }
        f32x4 bv[2][2];
#pragma unroll
        for (int bj = 0; bj < 2; ++bj)
#pragma unroll
            for (int n = 0; n < 2; ++n) bv[bj][n] = bias ? *(const f32x4*)(bias + bcol0 + bj * HALF + 4 * n) : (f32x4){0.f, 0.f, 0.f, 0.f};
#pragma unroll
        for (int ai = 0; ai < 2; ++ai)
#pragma unroll
            for (int m = 0; m < 4; ++m) { bf16_t* rowp = base + (size_t)(row0 + ai * HALF + m * 16) * ldc + col0; const float rsc_ = rsc[ai][m];
#pragma unroll
                for (int bj = 0; bj < 2; ++bj) { f32x4 v0 = (acc[ai][bj][m][0] + bv[bj][0]) * rsc_, v1 = (acc[ai][bj][m][1] + bv[bj][1]) * rsc_;
                    if (ACT == 1) { f32x2 a = gelu_pk((f32x2){v0[0], v0[1]}), b = gelu_pk((f32x2){v0[2], v0[3]}), c = gelu_pk((f32x2){v1[0], v1[1]}), d = gelu_pk((f32x2){v1[2], v1[3]});
                        v0 = (f32x4){a.x, a.y, b.x, b.y}; v1 = (f32x4){c.x, c.y, d.x, d.y}; }
                    if (ACT == 2) { _Pragma("unroll") for (int q_ = 0; q_ < 4; ++q_) { const float a0_ = v0[q_] > 0.f ? v0[q_] : 0.f, a1_ = v1[q_] > 0.f ? v1[q_] : 0.f; v0[q_] = a0_ * a0_; v1[q_] = a1_ * a1_; } }
                    v0 = v0 * sc; v1 = v1 * sc; u32x4 w; w.x = cvt_pk_bf16(v0[0], v0[1]); w.y = cvt_pk_bf16(v0[2], v0[3]); w.z = cvt_pk_bf16(v1[0], v1[1]); w.w = cvt_pk_bf16(v1[2], v1[3]);
                    *(u32x4*)(rowp + bj * HALF) = w; } }
    }
};

template <class Epi, class Sched, bool ALIGN_EPI = false, bool SP2 = false>
__device__ __forceinline__ void gemm_phase(PG8_LAS unsigned char* lds, const Gemm g, const Sched& S, const Epi& E) {
    int tid_ = threadIdx.x; asm volatile("" : "+v"(tid_)); const int tid = tid_, wid = __builtin_amdgcn_readfirstlane(tid >> 6), lane = tid & 63, wr = wid >> 2, wc = wid & 3, fr = lane & 15, fq = lane >> 4;
    const int K = g.K, nt = K / BK;
    unsigned voffA[2], voffB[2];
#pragma unroll
    for (int i = 0; i < 2; ++i) { int R, C; stage_rc(tid * 16 + i * 8192, R, C); const int Rb = Epi::PERM ? ((R & ~31) + perm32(R & 31)) : R;
        voffA[i] = (unsigned)(R * K + C) * 2u; voffB[i] = (unsigned)(Rb * K + C) * 2u; }
    const size_t kstep = (size_t)(BK * 2);
    const size_t hstep = (size_t)HALF * K * 2;
    const size_t tstep = 2 * hstep;
    const unsigned ldsw = (unsigned)wid * 1024u;
    const int aoff = lds_byte(wr * 64 + fr, fq * 8), boff = lds_byte(wc * 32 + fr, fq * 8);
#define PG8_SA(b, h) (((b) * 2 + (h)) * HTB)
#define PG8_SB(b, h) ((4 + (b) * 2 + (h)) * HTB)
#define PG8_STAGE(bufoff, gbase, voff) do { _Pragma("unroll") for (int _i = 0; _i < 2; ++_i) \
        __builtin_amdgcn_global_load_lds((const unsigned*)((const char*)(gbase) + (voff)[_i]), (PG8_LAS unsigned*)(lds + (bufoff) + ldsw + _i * 8192), 16, 0, 0); } while (0)
#define PG8_LDA(dst, b, h) do { _Pragma("unroll") for (int m = 0; m < 4; ++m) _Pragma("unroll") for (int k = 0; k < 2; ++k) dst[m][k] = *(const PG8_LAS bf16x8*)(lds + PG8_SA(b, h) + aoff + m * 2048 + k * 1024); } while (0)
#define PG8_LDB(dst, b, h) do { _Pragma("unroll") for (int n = 0; n < 2; ++n) _Pragma("unroll") for (int k = 0; k < 2; ++k) dst[n][k] = *(const PG8_LAS bf16x8*)(lds + PG8_SB(b, h) + boff + n * 2048 + k * 1024); } while (0)
#define PG8_MMA(ai, bj, At, Bt) do { __builtin_amdgcn_s_setprio(1); _Pragma("unroll") for (int m = 0; m < 4; ++m) _Pragma("unroll") for (int n = 0; n < 2; ++n) _Pragma("unroll") for (int k = 0; k < 2; ++k) \
        acc[ai][bj][m][n] = __builtin_amdgcn_mfma_f32_16x16x32_bf16(Bt[n][k], At[m][k], acc[ai][bj][m][n], 0, 0, 0); __builtin_amdgcn_s_setprio(0); } while (0)
#define PG8_WAIT_V(n) asm volatile("s_waitcnt vmcnt(" #n ")" ::: "memory")
#define PG8_WAIT_L(n) asm volatile("s_waitcnt lgkmcnt(" #n ")" ::: "memory")
#define PG8_BAR __builtin_amdgcn_s_barrier()
#define PG8_SCHED __builtin_amdgcn_sched_barrier(0)
    Unit cur, nxt; int ui = 0;
    if (!S.next(0, cur)) return;
    f32x4 acc[2][2][4][2];
#pragma unroll
    for (int a = 0; a < 2; ++a)
#pragma unroll
        for (int b = 0; b < 2; ++b)
#pragma unroll
            for (int m = 0; m < 4; ++m)
#pragma unroll
                for (int n = 0; n < 2; ++n) acc[a][b][m][n] = (f32x4){0.f, 0.f, 0.f, 0.f};
    bf16x8 At[4][2], B0[2][2], B1[2][2];
    const char* cA = (const char*)g.A + (size_t)cur.pm * tstep; const char* cB = (const char*)g.Bt + (size_t)cur.pn * tstep;
    S.a_ready(cur);
    if constexpr (SP2) {
        PG8_STAGE(PG8_SB(0, 0), cB, voffB); PG8_STAGE(PG8_SB(0, 1), cB + hstep, voffB); PG8_STAGE(PG8_SA(0, 0), cA, voffA); PG8_STAGE(PG8_SA(0, 1), cA + hstep, voffA);
        if (wr == 1) PG8_BAR;
        PG8_WAIT_V(2); PG8_BAR;
        PG8_STAGE(PG8_SB(1, 0), cB + kstep, voffB); PG8_STAGE(PG8_SA(1, 0), cA + kstep, voffA); PG8_STAGE(PG8_SB(1, 1), cB + hstep + kstep, voffB);
        PG8_WAIT_V(6); PG8_BAR;
    } else {
        PG8_STAGE(PG8_SB(0, 0), cB, voffB); PG8_STAGE(PG8_SA(0, 0), cA, voffA); PG8_STAGE(PG8_SB(0, 1), cB + hstep, voffB); PG8_STAGE(PG8_SA(0, 1), cA + hstep, voffA);
        if (wr == 1) PG8_BAR;
        PG8_WAIT_V(4); PG8_BAR;
        PG8_STAGE(PG8_SB(1, 0), cB + kstep, voffB); PG8_STAGE(PG8_SA(1, 0), cA + kstep, voffA); PG8_STAGE(PG8_SB(1, 1), cB + hstep + kstep, voffB);
        PG8_WAIT_V(6); PG8_BAR;
    }
    for (;;) {
        const bool has_next = S.next(ui + 1, nxt);
        const char* nA = has_next ? (const char*)g.A + (size_t)nxt.pm * tstep : cA; const char* nB = has_next ? (const char*)g.Bt + (size_t)nxt.pn * tstep : cB;
        for (int t = 0; t < nt; t += 2) {
            const bool last = (t == nt - 2);
            const char* a1 = cA + (size_t)(t + 1) * kstep;
            const char* a2 = last ? nA : cA + (size_t)(t + 2) * kstep; const char* b2 = last ? nB : cB + (size_t)(t + 2) * kstep;
            const char* a3 = a2 + kstep; const char* b3 = b2 + kstep;
            if (last && has_next) S.a_ready(nxt);
            if constexpr (SP2) {
            PG8_LDB(B0, 0, 0); PG8_LDB(B1, 0, 1); PG8_SCHED; PG8_LDA(At, 0, 0); PG8_STAGE(PG8_SA(1, 1), a1 + hstep, voffA);
            PG8_WAIT_V(8); PG8_WAIT_L(0); PG8_BAR; PG8_MMA(0, 0, At, B0); PG8_MMA(0, 1, At, B1); PG8_BAR; PG8_SCHED;
            PG8_LDA(At, 0, 1); PG8_STAGE(PG8_SB(0, 0), b2, voffB); PG8_STAGE(PG8_SB(0, 1), b2 + hstep, voffB); PG8_STAGE(PG8_SA(0, 0), a2, voffA);
            PG8_WAIT_V(8); PG8_WAIT_L(0); PG8_BAR; PG8_MMA(1, 0, At, B0); PG8_MMA(1, 1, At, B1); PG8_BAR; PG8_SCHED;
            PG8_LDB(B0, 1, 0); PG8_LDB(B1, 1, 1); PG8_SCHED; PG8_LDA(At, 1, 0); PG8_STAGE(PG8_SA(0, 1), a2 + hstep, voffA);
            PG8_WAIT_V(8); PG8_WAIT_L(0); PG8_BAR; PG8_MMA(0, 0, At, B0); PG8_MMA(0, 1, At, B1); PG8_BAR; PG8_SCHED;
            PG8_LDA(At, 1, 1); PG8_STAGE(PG8_SB(1, 0), b3, voffB); PG8_STAGE(PG8_SB(1, 1), b3 + hstep, voffB); PG8_STAGE(PG8_SA(1, 0), a3, voffA);
            PG8_WAIT_V(8); PG8_WAIT_L(0); PG8_BAR; PG8_MMA(1, 0, At, B0); PG8_MMA(1, 1, At, B1); PG8_BAR; PG8_SCHED;
            } else {
            PG8_LDB(B0, 0, 0); PG8_SCHED; PG8_LDA(At, 0, 0); PG8_STAGE(PG8_SA(1, 1), a1 + hstep, voffA);
            PG8_WAIT_L(8); PG8_BAR; PG8_WAIT_L(0); PG8_MMA(0, 0, At, B0); PG8_BAR; PG8_SCHED;
            PG8_LDB(B1, 0, 1); PG8_STAGE(PG8_SB(0, 0), b2, voffB);
            PG8_BAR; PG8_WAIT_L(0); PG8_MMA(0, 1, At, B1); PG8_BAR;
            PG8_LDA(At, 0, 1); PG8_STAGE(PG8_SA(0, 0), a2, voffA);
            PG8_BAR; PG8_WAIT_L(0); PG8_MMA(1, 0, At, B0); PG8_BAR; PG8_SCHED;
            PG8_STAGE(PG8_SB(0, 1), b2 + hstep, voffB);
            PG8_WAIT_V(6); PG8_BAR; PG8_MMA(1, 1, At, B1); PG8_BAR;
            PG8_LDB(B0, 1, 0); PG8_SCHED; PG8_LDA(At, 1, 0); PG8_STAGE(PG8_SA(0, 1), a2 + hstep, voffA);
            PG8_WAIT_L(8); PG8_BAR; PG8_WAIT_L(0); PG8_MMA(0, 0, At, B0); PG8_BAR; PG8_SCHED;
            PG8_LDB(B1, 1, 1); PG8_STAGE(PG8_SB(1, 0), b3, voffB);
            PG8_BAR; PG8_WAIT_L(0); PG8_MMA(0, 1, At, B1); PG8_BAR;
            PG8_LDA(At, 1, 1); PG8_STAGE(PG8_SA(1, 0), a3, voffA);
            PG8_BAR; PG8_WAIT_L(0); PG8_MMA(1, 0, At, B0); PG8_BAR; PG8_SCHED;
            PG8_STAGE(PG8_SB(1, 1), b3 + hstep, voffB);
            PG8_WAIT_V(6); PG8_BAR; PG8_MMA(1, 1, At, B1); PG8_BAR;
            }
        }
        if constexpr (ALIGN_EPI) { if (wr == 0) PG8_BAR; }
        if constexpr (!Epi::AFTER_DRAIN) { E(acc, cur, wr, wc, fr, fq); S.done(cur); }
        if (!has_next) break;
#pragma unroll
        for (int a = 0; a < 2; ++a)
#pragma unroll
            for (int b = 0; b < 2; ++b)
#pragma unroll
                for (int m = 0; m < 4; ++m)
#pragma unroll
                    for (int n = 0; n < 2; ++n) acc[a][b][m][n] = (f32x4){0.f, 0.f, 0.f, 0.f};
        cur = nxt; cA = nA; cB = nB; ++ui;
        if constexpr (ALIGN_EPI) { if (wr == 1) PG8_BAR; }
    }
    PG8_WAIT_V(0);
    if constexpr (!ALIGN_EPI) { if (wr == 0) PG8_BAR; }
    PG8_BAR;
    if constexpr (Epi::AFTER_DRAIN) { E.fused(acc, cur, wr, wc, fr, fq, lds, wid, lane); S.done(cur); }
#undef PG8_SA
#undef PG8_SB
#undef PG8_STAGE
#undef PG8_LDA
#undef PG8_LDB
#undef PG8_MMA
#undef PG8_WAIT_V
#undef PG8_WAIT_L
#undef PG8_BAR
#undef PG8_SCHED
}
}

#ifndef PG8_SP2
#define PG8_SP2 true
#endif
#ifndef PG8_ALIGN
#define PG8_ALIGN true
#endif
#include <hip/hip_bf16.h>
#include <cmath>
namespace attn_body {
using bf16=__hip_bfloat16;
using bf16x8=__attribute__((ext_vector_type(8)))short;
using s16x4=__attribute__((ext_vector_type(4)))short;
using f32x16=__attribute__((ext_vector_type(16)))float;
using u32x4=__attribute__((ext_vector_type(4)))unsigned;
constexpr int D=64;
constexpr int NW=8,QBLK=32,QB=QBLK*NW,KVBLK=64;
__device__ __forceinline__ int crow(int r,int hi){return (r&3)+8*(r>>2)+4*hi;}
#define SBAR() __builtin_amdgcn_sched_barrier(0)
__device__ __forceinline__ void cmask(f32x16&p0,f32x16&p1,int jb,int qrel,int hi){
  const float NEG=-INFINITY; int kb=64*jb+4*hi;
  #pragma unroll
  for(int r=0;r<16;++r){int kv=kb+(r&3)+8*(r>>2); if(kv>qrel)p0[r]=NEG; if(kv+32>qrel)p1[r]=NEG;}
}

constexpr int NSLOT=3, SLOTB=8192;
constexpr int LDS_K=0, LDS_V=NSLOT*SLOTB, LDS_WS=2*NSLOT*SLOTB, LDS_OST=LDS_WS+NW*64*4, LDS_BYTES=LDS_OST+NW*4096;
constexpr float C2=0.125f*1.4426950408889634f;
__device__ __forceinline__ void glds16(const void*gsrc,unsigned lds_dst){unsigned keep;
  asm volatile("s_mov_b32 %0, m0\n\ts_mov_b32 m0, %2\n\ts_nop 0\n\tglobal_load_lds_dwordx4 %1, off\n\ts_mov_b32 m0, %0":"=&s"(keep):"v"(gsrc),"s"(lds_dst):"memory");}
__device__ __forceinline__ float max3f(float a,float b,float c){float r;asm("v_max3_f32 %0, %1, %2, %3":"=v"(r):"v"(a),"v"(b),"v"(c));return r;}
__device__ __forceinline__ float max2f(float a,float b){float r;asm("v_max_f32_e32 %0, %1, %2":"=v"(r):"v"(a),"v"(b));return r;}
__device__ __forceinline__ float fadd_s(float a,float b){float r;asm("v_add_f32_e32 %0, %1, %2":"=v"(r):"v"(a),"v"(b));return r;}
__device__ __forceinline__ float fsub_s(float a,float b){float r;asm("v_sub_f32_e32 %0, %1, %2":"=v"(r):"v"(a),"v"(b));return r;}
typedef float f32x2_t __attribute__((ext_vector_type(2))); typedef __bf16 bf16x2_t __attribute__((ext_vector_type(2)));
__device__ __forceinline__ unsigned cvtpk_s(float lo,float hi){f32x2_t v={lo,hi};bf16x2_t b=__builtin_convertvector(v,bf16x2_t);return __builtin_bit_cast(unsigned,b);}
#define WAIT_BAR(N) asm volatile("s_waitcnt vmcnt(" #N ") lgkmcnt(0)\n\ts_barrier":::"memory")

__device__ __forceinline__ void qkt(f32x16&p0,f32x16&p1,const char*Kslot,const bf16x8*qr,const f32x16&negm,int r32,int hi){
  const char*kb=Kslot+hi*1024+r32*16;
  #pragma unroll
  for(int d0=0;d0<4;++d0){
    const bf16x8 b0=*reinterpret_cast<const bf16x8*>(kb+d0*2048);
    const bf16x8 b1=*reinterpret_cast<const bf16x8*>(kb+d0*2048+512);
    if(d0==0){p0=__builtin_amdgcn_mfma_f32_32x32x16_bf16(b0,qr[0],negm,0,0,0);p1=__builtin_amdgcn_mfma_f32_32x32x16_bf16(b1,qr[0],negm,0,0,0);}
    else{p0=__builtin_amdgcn_mfma_f32_32x32x16_bf16(b0,qr[d0],p0,0,0,0);p1=__builtin_amdgcn_mfma_f32_32x32x16_bf16(b1,qr[d0],p1,0,0,0);}}
}
typedef __attribute__((address_space(3))) const char* lds_cptr;
typedef short v4i16_t __attribute__((ext_vector_type(4)));
__device__ __forceinline__ void kload8(bf16x8*kf,lds_cptr kp){
  kf[0]=*(const __attribute__((address_space(3))) bf16x8*)(kp);      kf[1]=*(const __attribute__((address_space(3))) bf16x8*)(kp+512);
  kf[2]=*(const __attribute__((address_space(3))) bf16x8*)(kp+2048); kf[3]=*(const __attribute__((address_space(3))) bf16x8*)(kp+2560);
  kf[4]=*(const __attribute__((address_space(3))) bf16x8*)(kp+4096); kf[5]=*(const __attribute__((address_space(3))) bf16x8*)(kp+4608);
  kf[6]=*(const __attribute__((address_space(3))) bf16x8*)(kp+6144); kf[7]=*(const __attribute__((address_space(3))) bf16x8*)(kp+6656);
}
__device__ __forceinline__ void kload2(bf16x8*kf,lds_cptr kp,int j){ kf[2*j]=*(const __attribute__((address_space(3))) bf16x8*)(kp+j*2048); kf[2*j+1]=*(const __attribute__((address_space(3))) bf16x8*)(kp+j*2048+512); }
__device__ __forceinline__ s16x4 vtr(lds_cptr p){ return __builtin_bit_cast(s16x4,__builtin_amdgcn_ds_read_tr16_b64_v4i16((__attribute__((address_space(3))) v4i16_t*)p)); }
__device__ __forceinline__ float rowmax(const f32x16&p0,const f32x16&p1){
  float a=max3f(p0[0],p0[1],p1[0]),b=max3f(p0[2],p0[3],p1[1]);a=max3f(a,p1[2],p1[3]);
  #pragma unroll
  for(int r=4;r<16;r+=4){a=max3f(a,p0[r],p0[r+1]);b=max3f(b,p0[r+2],p0[r+3]);a=max3f(a,p1[r],p1[r+1]);b=max3f(b,p1[r+2],p1[r+3]);}
  const float m=max2f(a,b);
  auto rr=__builtin_amdgcn_permlane32_swap(__float_as_uint(m),__float_as_uint(m),false,false);
  return max2f(__uint_as_float(rr[0]),__uint_as_float(rr[1]));
}
__device__ __forceinline__ void pv(f32x16*o,int vb,bf16x8 pa0,bf16x8 pa1,bf16x8 pa2,bf16x8 pa3){
  #pragma unroll
  for(int d0=0;d0<2;++d0){s16x4 lo[4],hi[4];
    #pragma unroll
    for(int ks=0;ks<4;++ks){
      asm volatile("ds_read_b64_tr_b16 %0,%1 offset:%c2":"=&v"(lo[ks]):"v"(vb),"i"(d0*4096+ks*1024):"memory");
      asm volatile("ds_read_b64_tr_b16 %0,%1 offset:%c2":"=&v"(hi[ks]):"v"(vb),"i"(d0*4096+ks*1024+512):"memory");}
    asm volatile("s_waitcnt lgkmcnt(0)":::"memory");SBAR();
    #define PK(k) (bf16x8){lo[k][0],lo[k][1],lo[k][2],lo[k][3],hi[k][0],hi[k][1],hi[k][2],hi[k][3]}
    o[d0]=__builtin_amdgcn_mfma_f32_32x32x16_bf16(pa0,PK(0),o[d0],0,0,0);
    o[d0]=__builtin_amdgcn_mfma_f32_32x32x16_bf16(pa1,PK(1),o[d0],0,0,0);
    o[d0]=__builtin_amdgcn_mfma_f32_32x32x16_bf16(pa2,PK(2),o[d0],0,0,0);
    o[d0]=__builtin_amdgcn_mfma_f32_32x32x16_bf16(pa3,PK(3),o[d0],0,0,0);
    #undef PK
  }
}

#ifndef ATTN_STORE16
#define ATTN_STORE16(p,v) (*(u32x4*)(p)=(v))
#endif
template<int THRL> __device__ __forceinline__ void attn_unit(int qb,int SEQ,const bf16*Q,int QP,const bf16*__restrict__ K,const bf16*__restrict__ V,int KP,bf16*O,int OP,char*shm){
  int tid_=threadIdx.x; asm volatile("":"+v"(tid_)); const int tid=tid_,lane=tid&63,r32=lane&31,hi=lane>>5; const int wid=__builtin_amdgcn_readfirstlane(tid>>6);
  const int q0=qb*QB;
  const bf16*Qw=Q+(long)(q0+wid*QBLK)*QP;
  const bf16*Kh=K,*Vh=V;
  const unsigned lds0=(unsigned)(uintptr_t)shm;
  float*wsf=(float*)(shm+LDS_WS)+wid*64;
  const bf16*ksrc=Kh+(long)lane*KP+wid*8;
  const bf16*vsrc=Vh+(long)(16*(wid&3)+(lane>>2))*KP+(wid>>2)*32+(lane&3)*8;
  const unsigned kdst=lds0+LDS_K+wid*1024, vdst=lds0+LDS_V+wid*1024;
  #define DMA_K(t,slot) glds16(ksrc+(long)(t)*KVBLK*KP,(unsigned)__builtin_amdgcn_readfirstlane(kdst+(slot)))
  #define DMA_V(t,slot) glds16(vsrc+(long)(t)*KVBLK*KP,(unsigned)__builtin_amdgcn_readfirstlane(vdst+(slot)))
  const int vb0=(int)(lds0+LDS_V)+((lane>>4)&1)*32+(lane&3)*8+(4*hi+((lane&15)>>2))*64;
  const char*Kbase=shm+LDS_K; bf16x8 kf[8];
  const lds_cptr shm3=(lds_cptr)shm; const lds_cptr kp0=shm3+LDS_K+hi*1024+r32*16; const lds_cptr vp0=shm3+LDS_V+((lane>>4)&1)*32+(lane&3)*8+(4*hi+((lane&15)>>2))*64;
  const int NT=SEQ/KVBLK;
  DMA_K(0,0);DMA_V(0,0);DMA_K(1,SLOTB);
  bf16x8 qr[4];
  #pragma unroll
  for(int d0=0;d0<4;++d0)qr[d0]=*reinterpret_cast<const bf16x8*>(&Qw[(long)r32*QP+d0*16+hi*8]);
  float mhat=0.f,l_reg=0.f;f32x16 o[2];o[0]=f32x16{};o[1]=f32x16{};f32x16 negm=f32x16{};asm volatile("":"+v"(negm));
  const int qrel=wid*QBLK+r32;
  #define CMASK(P0,P1,t) do{}while(0)
  bool resc=false;
  #define START(P0,P1) do{ const float rm=rowmax(P0,P1); resc=false; \
    { const float dl=rm; mhat=fadd_s(mhat,dl); \
      _Pragma("unroll") for(int r=0;r<16;++r){P0[r]=fsub_s(P0[r],dl);P1[r]=fsub_s(P1[r],dl);} \
      _Pragma("unroll") for(int r=0;r<16;++r)negm[r]=-mhat; asm volatile("":"+v"(negm)); } \
    _Pragma("unroll") for(int r=0;r<16;++r)P0[r]=__builtin_amdgcn_exp2f(P0[r]); }while(0)
  #define RESC() do{ if(resc){ asm volatile("s_waitcnt lgkmcnt(0)":::"memory"); \
      _Pragma("unroll") for(int d_=0;d_<2;++d_) _Pragma("unroll") for(int r=0;r<16;++r)o[d_][r]*=wsf[crow(r,hi)]; } }while(0)
  f32x16 pA0,pA1,pB0,pB1;
  int sl_prev=0,sl_cur=0,sl_next=SLOTB;
  #define ROT() do{sl_prev=sl_cur;sl_cur=sl_next;sl_next=(sl_next==(NSLOT-1)*SLOTB)?0:sl_next+SLOTB;}while(0)
  DMA_K(2,2*SLOTB);
  WAIT_BAR(3);
  qkt(pA0,pA1,Kbase,qr,negm,r32,hi);asm volatile("s_nop 15\n\ts_nop 7":"+v"(pA0),"+v"(pA1));CMASK(pA0,pA1,0);
  START(pA0,pA1);
  _Pragma("unroll") for(int r=0;r<16;++r)pA1[r]=__builtin_amdgcn_exp2f(pA1[r]);
  WAIT_BAR(0);
  DMA_K(3,0);DMA_V(1,SLOTB);
  ROT();
  kload8(kf,kp0+sl_cur);
  WAIT_BAR(2);
  s16x4 vlo[8],vhi[8]; u32x4 pw0,pw1,pw2,pw3;
  #define PKW(P,B) cvtpk_s(P[B],P[B+1])
  #define PAF(k) __builtin_bit_cast(bf16x8,pw##k)
  #define VFR(i) (bf16x8){vlo[i][0],vlo[i][1],vlo[i][2],vlo[i][3],vhi[i][0],vhi[i][1],vhi[i][2],vhi[i][3]}
  #define PIN(x) asm volatile("":"+v"(x))
  #define MX3(a,b,c) __builtin_fmaxf(__builtin_fmaxf((a),(b)),(c))
  #define GAPA(MF,A0,A1,A2,A3,W0,W1,PW) do{ MF; sacc+=A0; sacc+=A1; sacc+=A2; sacc+=A3; PIN(sacc); W0; W1; PIN(PW); SBAR(); }while(0)
  #define EX(v) __builtin_amdgcn_exp2f(v)
  #define GAPB(MF,X,B) do{ MF; X[B]=EX(X[B]); X[B+1]=EX(X[B+1]); X[B+2]=EX(X[B+2]); X[B+3]=EX(X[B+3]); PIN(X); SBAR(); }while(0)
  #define VRD(i) do{ vlo[i]=vtr(vp_+(((i)>>2)*4096+((i)&3)*1024)); vhi[i]=vtr(vp_+(((i)>>2)*4096+((i)&3)*1024+512)); }while(0)
  #define KRD(G,j) do{ if(G){ kload2(kf,kp0+sl_next,j); SBAR(); } }while(0)
  #define STEP(C0,C1,P0,P1,t,GK,GV,GL) do{ SBAR(); \
    const lds_cptr vp_=vp0+sl_prev; \
    VRD(0); SBAR(); float sacc=(P0[0]+P0[1]); \
    GAPA(C0=__builtin_amdgcn_mfma_f32_32x32x16_bf16(kf[0],qr[0],negm,0,0,0), P0[2],P0[3],P0[4],P0[5],     pw0[0]=PKW(P0,0), pw0[1]=PKW(P0,2), pw0); \
    VRD(4); SBAR(); GAPA(C1=__builtin_amdgcn_mfma_f32_32x32x16_bf16(kf[1],qr[0],negm,0,0,0), P0[6],P0[7],P0[8],P0[9],     pw0[2]=PKW(P0,4), pw0[3]=PKW(P0,6), pw0); \
    VRD(1); SBAR(); GAPA(C0=__builtin_amdgcn_mfma_f32_32x32x16_bf16(kf[2],qr[1],C0,0,0,0),   P0[10],P0[11],P0[12],P0[13], pw1[0]=PKW(P0,8), pw1[1]=PKW(P0,10), pw1); \
    VRD(5); SBAR(); GAPA(C1=__builtin_amdgcn_mfma_f32_32x32x16_bf16(kf[3],qr[1],C1,0,0,0),   P0[14],P0[15],P1[0],P1[1],   pw1[2]=PKW(P0,12),pw1[3]=PKW(P0,14), pw1); \
    VRD(2); SBAR(); GAPA(C0=__builtin_amdgcn_mfma_f32_32x32x16_bf16(kf[4],qr[2],C0,0,0,0),   P1[2],P1[3],P1[4],P1[5],     pw2[0]=PKW(P1,0), pw2[1]=PKW(P1,2), pw2); \
    VRD(6); SBAR(); GAPA(C1=__builtin_amdgcn_mfma_f32_32x32x16_bf16(kf[5],qr[2],C1,0,0,0),   P1[6],P1[7],P1[8],P1[9],     pw2[2]=PKW(P1,4), pw2[3]=PKW(P1,6), pw2); \
    VRD(3); SBAR(); GAPA(C0=__builtin_amdgcn_mfma_f32_32x32x16_bf16(kf[6],qr[3],C0,0,0,0),   P1[10],P1[11],P1[12],P1[13], pw3[0]=PKW(P1,8), pw3[1]=PKW(P1,10), pw3); \
    VRD(7); SBAR(); GAPA(C1=__builtin_amdgcn_mfma_f32_32x32x16_bf16(kf[7],qr[3],C1,0,0,0),   P1[14],P1[15],0.f,0.f,       pw3[2]=PKW(P1,12),pw3[3]=PKW(P1,14), pw3); \
    l_reg+=sacc; \
    if(GK){DMA_K((t)+3,sl_cur);} if(GV){DMA_V((t)+1,sl_next);} \
    CMASK(C0,C1,t); \
    { float a=MX3(C0[0],C0[1],C1[0]),b=MX3(C0[2],C0[3],C1[1]); a=MX3(a,C1[2],C1[3]); \
      _Pragma("unroll") for(int r=4;r<16;r+=4){a=MX3(a,C0[r],C0[r+1]);b=MX3(b,C0[r+2],C0[r+3]);a=MX3(a,C1[r],C1[r+1]);b=MX3(b,C1[r+2],C1[r+3]);} \
      float rm=__builtin_fmaxf(a,b); { auto rr=__builtin_amdgcn_permlane32_swap(__float_as_uint(rm),__float_as_uint(rm),false,false); rm=__builtin_fmaxf(__uint_as_float(rr[0]),__uint_as_float(rr[1])); } \
      resc=false; \
      if(__builtin_expect(__any(rm>(float)THRL),0)){ const float dl=__builtin_fmaxf(rm,0.f); mhat+=dl; \
        _Pragma("unroll") for(int r=0;r<16;++r){C0[r]-=dl;C1[r]-=dl;} \
        _Pragma("unroll") for(int r=0;r<16;++r)negm[r]=-mhat; asm volatile("":"+v"(negm)); \
        const float f=__builtin_amdgcn_exp2f(-dl); l_reg*=f; if(hi==0)wsf[r32]=f; resc=true; } } \
    SBAR(); \
    GAPB(o[0]=__builtin_amdgcn_mfma_f32_32x32x16_bf16(PAF(0),VFR(0),o[0],0,0,0), C0,0); \
    GAPB(o[1]=__builtin_amdgcn_mfma_f32_32x32x16_bf16(PAF(0),VFR(4),o[1],0,0,0), C0,4); \
    KRD(GL,0); GAPB(o[0]=__builtin_amdgcn_mfma_f32_32x32x16_bf16(PAF(1),VFR(1),o[0],0,0,0), C0,8); \
    KRD(GL,1); GAPB(o[1]=__builtin_amdgcn_mfma_f32_32x32x16_bf16(PAF(1),VFR(5),o[1],0,0,0), C0,12); \
    KRD(GL,2); GAPB(o[0]=__builtin_amdgcn_mfma_f32_32x32x16_bf16(PAF(2),VFR(2),o[0],0,0,0), C1,0); \
    KRD(GL,3); GAPB(o[1]=__builtin_amdgcn_mfma_f32_32x32x16_bf16(PAF(2),VFR(6),o[1],0,0,0), C1,4); \
    GAPB(o[0]=__builtin_amdgcn_mfma_f32_32x32x16_bf16(PAF(3),VFR(3),o[0],0,0,0), C1,8); \
    GAPB(o[1]=__builtin_amdgcn_mfma_f32_32x32x16_bf16(PAF(3),VFR(7),o[1],0,0,0), C1,12); \
    }while(0)
  int t=1;
  #undef CMASK
  #define CMASK(P0,P1,t) do{}while(0)
  for(;t+5<NT;t+=2){
    STEP(pB0,pB1,pA0,pA1,t,true,true,true);     WAIT_BAR(2); RESC(); ROT();
    STEP(pA0,pA1,pB0,pB1,t+1,true,true,true);   WAIT_BAR(2); RESC(); ROT();
  }
  #undef CMASK
  #define CMASK(P0,P1,t) do{}while(0)
  #define ENDW(tt) do{ if((tt)+3<NT){WAIT_BAR(2);} else if((tt)+2<NT){WAIT_BAR(1);} else {WAIT_BAR(0);} }while(0)
  for(;t+1<NT;t+=2){
    STEP(pB0,pB1,pA0,pA1,t,(t+3<NT),(t+1<NT),(t+1<NT));       ENDW(t);   RESC(); ROT();
    STEP(pA0,pA1,pB0,pB1,t+1,(t+4<NT),(t+2<NT),(t+2<NT));     ENDW(t+1); RESC(); ROT();
  }
  STEP(pB0,pB1,pA0,pA1,NT-1,false,false,false); RESC();
  { float sacc=pB0[0]+pB0[1]; _Pragma("unroll") for(int r=2;r<16;++r)sacc+=pB0[r]; _Pragma("unroll") for(int r=0;r<16;++r)sacc+=pB1[r]; l_reg+=sacc;
    pw0=(u32x4){PKW(pB0,0),PKW(pB0,2),PKW(pB0,4),PKW(pB0,6)};pw1=(u32x4){PKW(pB0,8),PKW(pB0,10),PKW(pB0,12),PKW(pB0,14)};pw2=(u32x4){PKW(pB1,0),PKW(pB1,2),PKW(pB1,4),PKW(pB1,6)};pw3=(u32x4){PKW(pB1,8),PKW(pB1,10),PKW(pB1,12),PKW(pB1,14)};
    SBAR(); pv(o,vb0+sl_cur,PAF(0),PAF(1),PAF(2),PAF(3)); }
  #undef PKW
  #undef PAF
  #undef VFR
  #undef PIN
  #undef MX3
  #undef GAPA
  #undef GAPB
  #undef EX
  #undef VRD
  #undef KRD
  #undef STEP
  #undef ENDW
  {auto rr=__builtin_amdgcn_permlane32_swap(__float_as_uint(l_reg),__float_as_uint(l_reg),false,false);l_reg=__uint_as_float(rr[0])+__uint_as_float(rr[1]);}
  if(hi==0)wsf[32+r32]=l_reg;asm volatile("s_waitcnt lgkmcnt(0)":::"memory");
  float rli[16];
  #pragma unroll
  for(int r=0;r<16;++r)rli[r]=__builtin_amdgcn_rcpf(wsf[32+crow(r,hi)]);
  bf16*Ow=O+(long)(q0+wid*QBLK)*OP;
  { bf16*stg=(bf16*)(shm+LDS_OST)+wid*2048;
    #pragma unroll
    for(int r=0;r<16;++r){const int orow=crow(r,hi);
      #pragma unroll
      for(int d0=0;d0<2;++d0)stg[orow*64+d0*32+r32]=__float2bfloat16(o[d0][r]*rli[r]);}
    asm volatile("s_waitcnt lgkmcnt(0)":::"memory");
    #pragma unroll
    for(int i=0;i<4;++i){const int row=i*8+(lane>>3),ch=lane&7; const u32x4 v=*(const u32x4*)(stg+row*64+ch*8); ATTN_STORE16(Ow+(long)row*OP+ch*8,v);} }
  asm volatile("s_waitcnt lgkmcnt(0)\n\ts_barrier":::"memory");
  #undef DMA_K
  #undef DMA_V
  #undef CMASK
  #undef START
  #undef RESC
  #undef ROT
}
constexpr int ATTN_LDS_BYTES=LDS_BYTES;
#undef SBAR
#undef WAIT_BAR
}
namespace xb {
#define GAS __attribute__((address_space(1)))
#define LAS __attribute__((address_space(3)))
typedef GAS unsigned gu32;
typedef GAS unsigned long long gu64;
#define RLX_AGENT __ATOMIC_RELAXED, __HIP_MEMORY_SCOPE_AGENT
#define LDS_WAIT() asm volatile("s_waitcnt lgkmcnt(0)" ::: "memory")
#define VM_WAIT() asm volatile("s_waitcnt vmcnt(0)" ::: "memory")
__device__ __forceinline__ unsigned long long rt() { return __builtin_amdgcn_s_memrealtime(); }
__device__ __forceinline__ unsigned f2bf(float f) { unsigned u = __builtin_bit_cast(unsigned, f); return (u + 0x7fffu + ((u >> 16) & 1u)) >> 16; }
__device__ __forceinline__ unsigned pk2(float lo, float hi) { return f2bf(lo) | (f2bf(hi) << 16); }

#define XB_TMO      128
#define XB_XCNT(j)  (256  + 64 * (j))
#define XB_XSUB(j)  (1280 + 64 * (j))
#define XB_XGEN(j)  (2304 + 64 * (j))
#define XB_TOP      3328
#define XB_TOPGEN   3392
#define XCD_BAR_WORDS 3456
#define XB_SPIN_CAP (1u << 18)

__device__ __forceinline__ unsigned xb_ld(unsigned* p)              { return __hip_atomic_load(p, __ATOMIC_RELAXED, __HIP_MEMORY_SCOPE_AGENT); }
__device__ __forceinline__ unsigned xb_add(unsigned* p, unsigned v) { return __hip_atomic_fetch_add(p, v, __ATOMIC_RELAXED, __HIP_MEMORY_SCOPE_AGENT); }
__device__ __forceinline__ unsigned xb_xcc_id() { return (unsigned)__builtin_amdgcn_s_getreg((3 << 11) | 20) & 0xFu; }
#define XB_SPIN(cond, bar) do { unsigned _sp = 0; while (cond) { __builtin_amdgcn_s_sleep(1); \
    if ((++_sp & 255u) == 0u) { if (xb_ld(&(bar)[XB_TMO])) break; if (_sp > XB_SPIN_CAP) { atomicAdd(&(bar)[XB_TMO], 1u); break; } } } } while (0)

struct XcdBarrier {
    unsigned* bar; unsigned x;
    volatile LAS unsigned* st;
};

__device__ __forceinline__ XcdBarrier xcd_barrier_post(unsigned* bar, volatile LAS unsigned* st) {
    XcdBarrier b; b.bar = bar; b.x = xb_xcc_id(); b.st = st;
    if (threadIdx.x == 0) (void)xb_add(&bar[XB_XCNT(b.x)], 1u);
    return b;
}
__device__ __forceinline__ void xcd_barrier_complete(unsigned* bar, unsigned x, unsigned& nloc, unsigned& nx) {
    const unsigned G = gridDim.x * gridDim.y * gridDim.z;
    unsigned sum, cnt, mine, sp = 0u;
    for (;;) {
        sum = 0u; cnt = 0u; mine = 0u;
#pragma unroll
        for (unsigned j = 0; j < 16; ++j) { const unsigned c = xb_ld(&bar[XB_XCNT(j)]); sum += c; cnt += (c > 0u) ? 1u : 0u; mine = (j == x) ? c : mine; }
        if (sum == G) break;
        __builtin_amdgcn_s_sleep(1);
        if ((++sp & 255u) == 0u) { if (xb_ld(&bar[XB_TMO])) break; if (sp > XB_SPIN_CAP) { atomicAdd(&bar[XB_TMO], 1u); break; } }
    }
    nloc = mine > 0u ? mine : 1u; nx = cnt > 0u ? cnt : 1u;
}

__device__ __forceinline__ void xcd_barrier(const XcdBarrier& b) {
    asm volatile("s_waitcnt vmcnt(0)" ::: "memory");
    __syncthreads();
    if (threadIdx.x == 0) {
        unsigned* bar = b.bar;
        __builtin_amdgcn_s_waitcnt(0);
        unsigned nloc = b.st[0], nx = b.st[1];
        if (nloc == 0u) { xcd_barrier_complete(bar, b.x, nloc, nx); b.st[0] = nloc; b.st[1] = nx; }
        const unsigned old = xb_add(&bar[XB_XSUB(b.x)], 1u);
        const unsigned gen = old / nloc;
        if (old + 1u == (gen + 1u) * nloc) {
            __builtin_amdgcn_fence(__ATOMIC_RELEASE, "agent");
            asm volatile("s_waitcnt vmcnt(0)" ::: "memory");
            const unsigned og = xb_add(&bar[XB_TOP], 1u);
            const unsigned tg = og / nx;
            if (og + 1u == (tg + 1u) * nx) xb_add(&bar[XB_TOPGEN], 1u);
            else XB_SPIN(xb_ld(&bar[XB_TOPGEN]) == tg, bar);
            __builtin_amdgcn_fence(__ATOMIC_ACQUIRE, "agent");
            xb_add(&bar[XB_XGEN(b.x)], 1u);
            asm volatile("s_waitcnt vmcnt(0)" ::: "memory");
        } else {
            XB_SPIN(xb_ld(&bar[XB_XGEN(b.x)]) == gen, bar);
            __builtin_amdgcn_fence(__ATOMIC_ACQUIRE, "agent");
            asm volatile("s_waitcnt vmcnt(0)" ::: "memory");
        }
    }
    __syncthreads();
}

}

namespace mk {
typedef unsigned short bf16_t;
typedef short bf16x8 __attribute__((ext_vector_type(8)));
typedef float f32x4 __attribute__((ext_vector_type(4)));
typedef unsigned u32x4 __attribute__((ext_vector_type(4)));
typedef unsigned u32x2 __attribute__((ext_vector_type(2)));
typedef float f32x2 __attribute__((ext_vector_type(2)));

constexpr int DMODEL = 1024, TS = 16384, NSEG = 4, DFF = 4096;
constexpr int EIN = 1792, OIN = 4368, OINP = 4608, OOUT = 768;
constexpr float EPS = 1e-6f;
constexpr size_t MiB = (size_t)1 << 20;
constexpr size_t WS_W1T = 1 * MiB, WS_W2T = 33 * MiB, WS_WINE = 65 * MiB, WS_WOUTE = 72 * MiB, WS_WINO = 76 * MiB, WS_WOUTO = 94 * MiB,
                 WS_GW = 97 * MiB, WS_H = 98 * MiB, WS_PROJ = 130 * MiB, WS_SCR = 274 * MiB, WS_END = 512 * MiB;
constexpr size_t SC_HID = 0;
constexpr size_t SC_LA = 0, SC_UU = 64 * MiB, SC_AGG = 128 * MiB;
constexpr size_t SC_QKVP = 0, SC_DNI = 48 * MiB, SC_OB = 192 * MiB, SC_LSE = 224 * MiB, SC_EGL = 225 * MiB;
constexpr int DNI_BYTES = 73728, DNI_W = 0, DNI_QT = 16384, DNI_KTT = 32768, DNI_A = 49152, DNI_U = 57344;
constexpr int LDS_BYTES = 147456;
constexpr int NT = 512, NW = 8;

struct Params { const float* in[25]; float* out; unsigned char* ws; };

__device__ __forceinline__ float bf2f(bf16_t v) { return __uint_as_float(((unsigned)v) << 16); }
__device__ __forceinline__ unsigned f2bf(float f) { unsigned u = __float_as_uint(f); return (u + 0x7fffu + ((u >> 16) & 1u)) >> 16; }
__device__ __forceinline__ unsigned pk2(float lo, float hi) { return f2bf(lo) | (f2bf(hi) << 16); }
__device__ __forceinline__ float wave_sum(float v) {
#pragma unroll
    for (int o = 1; o < 64; o <<= 1) v += __shfl_xor(v, o);
    return v;
}
__device__ __forceinline__ float sigm(float x) { return 1.f / (1.f + __expf(-x)); }
__device__ __forceinline__ float softplus(float x) { return x > 20.f ? x : log1pf(__expf(x)); }
__device__ __forceinline__ float silu(float x) { return x * sigm(x); }
__device__ __forceinline__ float gelu_tanh(float x) { const float t = 0.7978845608028654f * (x + 0.044715f * x * x * x); return 0.5f * x * (1.f + tanhf(t)); }
__device__ __forceinline__ void unpack8(const u32x4 v, float* f) {
    f[0] = __uint_as_float(v.x << 16); f[1] = __uint_as_float(v.x & 0xffff0000u); f[2] = __uint_as_float(v.y << 16); f[3] = __uint_as_float(v.y & 0xffff0000u);
    f[4] = __uint_as_float(v.z << 16); f[5] = __uint_as_float(v.z & 0xffff0000u); f[6] = __uint_as_float(v.w << 16); f[7] = __uint_as_float(v.w & 0xffff0000u);
}
#define MK_IDS() int tid = threadIdx.x; asm volatile("" : "+v"(tid)); const int lane = tid & 63, wave = __builtin_amdgcn_readfirstlane(tid >> 6); const int gw = blockIdx.x * NW + wave, NGW = gridDim.x * NW; (void)lane; (void)wave; (void)gw; (void)NGW
#define MFMA16(a, b, c) __builtin_amdgcn_mfma_f32_16x16x32_bf16((a), (b), (c), 0, 0, 0)

__device__ __forceinline__ void transpose_item(const float* W, int K, int Nsrc, int Npad, bf16_t* WT, float* scr, int item, int lane, const float* gain = nullptr) {
    const int nblk = Npad / 32, kb = item / nblk, nb = item % nblk, k0 = 64 * kb, n0 = 32 * nb;
    const int n = n0 + (lane & 31);
#pragma unroll 8
    for (int i = 0; i < 32; ++i) { const int kk = 2 * i + (lane >> 5); scr[kk * 33 + (lane & 31)] = (n < Nsrc) ? W[(size_t)(k0 + kk) * Nsrc + n] * (gain ? gain[k0 + kk] : 1.f) : 0.f; }
    asm volatile("s_waitcnt lgkmcnt(0)" ::: "memory");
    const int c = lane & 7;
#pragma unroll
    for (int j = 0; j < 4; ++j) { const int nn = (lane >> 3) + 8 * j; const float* s = scr + (8 * c) * 33 + nn;
        u32x4 o; o.x = pk2(s[0 * 33], s[1 * 33]); o.y = pk2(s[2 * 33], s[3 * 33]); o.z = pk2(s[4 * 33], s[5 * 33]); o.w = pk2(s[6 * 33], s[7 * 33]);
        *(u32x4*)(WT + (size_t)(n0 + nn) * K + k0 + 8 * c) = o; }
    asm volatile("s_waitcnt lgkmcnt(0)" ::: "memory");
}
__device__ __forceinline__ void phase_prologue(const Params& p, char* lds) {
    MK_IDS();
    float* scr = (float*)(lds + wave * 16384);
    unsigned char* ws = p.ws;
    constexpr int I_F1 = 16 * 128, I_F2 = 64 * 32, I_IE = 16 * 56, I_OE = 16 * 32, I_IO = 16 * 144, I_OO = 12 * 32;
    constexpr int T_F1 = 4 * I_F1, T_F2 = T_F1 + 4 * I_F2, T_IE = T_F2 + 2 * I_IE, T_OE = T_IE + 2 * I_OE, T_IO = T_OE + 2 * I_IO, T_OO = T_IO + 2 * I_OO;
    for (int it = gw; it < T_OO; it += NGW) {
        if (it < T_F1) { const int l = it / I_F1, r = it % I_F1; transpose_item(p.in[6] + (size_t)l * 1024 * 4096, 1024, 4096, 4096, (bf16_t*)(ws + WS_W1T) + (size_t)l * 4096 * 1024, scr, r, lane, p.in[4] + l * 1024); }
        else if (it < T_F2) { const int q = it - T_F1, l = q / I_F2, r = q % I_F2; transpose_item(p.in[7] + (size_t)l * 4096 * 1024, 4096, 1024, 1024, (bf16_t*)(ws + WS_W2T) + (size_t)l * 1024 * 4096, scr, r, lane); }
        else if (it < T_IE) { const int q = it - T_F2, l = q / I_IE, r = q % I_IE; transpose_item(p.in[8] + (size_t)l * 1024 * EIN, 1024, EIN, EIN, (bf16_t*)(ws + WS_WINE) + (size_t)l * EIN * 1024, scr, r, lane, p.in[3] + (2 * l) * 1024); }
        else if (it < T_OE) { const int q = it - T_IE, l = q / I_OE, r = q % I_OE; transpose_item(p.in[9] + (size_t)l * 1024 * 1024, 1024, 1024, 1024, (bf16_t*)(ws + WS_WOUTE) + (size_t)l * 1024 * 1024, scr, r, lane); }
        else if (it < T_IO) { const int q = it - T_OE, l = q / I_IO, r = q % I_IO; transpose_item(p.in[19] + (size_t)l * 1024 * OIN, 1024, OIN, OINP, (bf16_t*)(ws + WS_WINO) + (size_t)l * OINP * 1024, scr, r, lane, p.in[3] + (2 * l + 1) * 1024); }
        else { const int q = it - T_IO, l = q / I_OO, r = q % I_OO; transpose_item(p.in[20] + (size_t)l * OOUT * 1024, OOUT, 1024, 1024, (bf16_t*)(ws + WS_WOUTO) + (size_t)l * 1024 * OOUT, scr, r, lane); }
    }
    bf16_t* GW = (bf16_t*)(ws + WS_GW);
    const int gt = gw * 64 + lane, NGT = NGW * 64;
    for (int idx = gt; idx < 2 * 2 * 2 * 8 * 4096; idx += NGT) {
        const int d = idx & 63, e = (idx >> 6) & 63, blk = (idx >> 12) & 7, gate = (idx >> 15) & 1, dir = (idx >> 16) & 1, j = (idx >> 17) & 1;
        const float* src = gate ? p.in[16] : p.in[14];
        GW[idx] = (bf16_t)f2bf(src[((((size_t)j * 2 + dir) * 8 + blk) * 64 + d) * 64 + e]);
    }
}

__device__ __forceinline__ void phase_x0(const float* x, bf16_t* xb, float* ssq) {
    MK_IDS();
    for (int m = gw; m < TS; m += NGW) {
        const f32x4* xr = (const f32x4*)(x + (size_t)m * DMODEL) + lane;
        f32x4 v[4]; float s = 0.f;
#pragma unroll
        for (int j = 0; j < 4; ++j) { v[j] = xr[64 * j]; s += (v[j].x * v[j].x + v[j].y * v[j].y) + (v[j].z * v[j].z + v[j].w * v[j].w); }
        s = wave_sum(s);
        u32x2* o8 = (u32x2*)(xb + (size_t)m * DMODEL) + lane;
#pragma unroll
        for (int j = 0; j < 4; ++j) { u32x2 o; o.x = pk2(v[j].x, v[j].y); o.y = pk2(v[j].z, v[j].w); o8[64 * j] = o; }
        if (lane < 16) ssq[(size_t)m * 16 + lane] = lane == 0 ? s : 0.f;
    }
}
__device__ __forceinline__ void zero_f32(float* ptr, int n) {
    MK_IDS();
    for (int i = gw * 64 + lane; i < n; i += NGW * 64) ptr[i] = 0.f;
}
__device__ __forceinline__ void phase_rmsnorm_final(const bf16_t* xb, float* x, const float* g) {
    MK_IDS();
    for (int m = gw; m < TS; m += NGW) {
        const u32x2* xr = (const u32x2*)(xb + (size_t)m * DMODEL) + lane; f32x4* xw = (f32x4*)(x + (size_t)m * DMODEL) + lane; const f32x4* gr = (const f32x4*)g + lane;
        f32x4 v[4]; float s = 0.f;
#pragma unroll
        for (int j = 0; j < 4; ++j) { const u32x2 w = xr[64 * j]; v[j] = (f32x4){__uint_as_float(w.x << 16), __uint_as_float(w.x & 0xffff0000u), __uint_as_float(w.y << 16), __uint_as_float(w.y & 0xffff0000u)};
            s += (v[j].x * v[j].x + v[j].y * v[j].y) + (v[j].z * v[j].z + v[j].w * v[j].w); }
        const float rstd = 1.f / sqrtf(wave_sum(s) * (1.f / DMODEL) + EPS);
#pragma unroll
        for (int j = 0; j < 4; ++j) { const f32x4 gg = gr[64 * j]; xw[64 * j] = v[j] * rstd * gg; }
    }
}
struct EpiRes {
    static constexpr bool PERM = false, AFTER_DRAIN = false;
    bf16_t* xb; float* ssq; int ldc;
    __device__ __forceinline__ void operator()(const pg8::f32x4 (&acc)[2][2][4][2], const pg8::Unit& u, int wr, int wc, int fr, int fq) const {
        const int col0 = u.pn * pg8::BM + wc * 32 + 4 * fq;
#pragma unroll
        for (int ai = 0; ai < 2; ++ai)
#pragma unroll
            for (int m = 0; m < 4; ++m) { const int row = u.pm * pg8::BM + ai * pg8::HALF + wr * 64 + m * 16 + fr; const size_t off = (size_t)row * ldc + col0; float sq = 0.f;
                u32x2 bw[2][2];
#pragma unroll
                for (int bj = 0; bj < 2; ++bj)
#pragma unroll
                    for (int n = 0; n < 2; ++n) bw[bj][n] = *(const u32x2*)(xb + off + bj * pg8::HALF + n * 16);
#pragma unroll
                for (int bj = 0; bj < 2; ++bj)
#pragma unroll
                    for (int n = 0; n < 2; ++n) { const pg8::f32x4 a = acc[ai][bj][m][n];
                        const float o0 = __uint_as_float(bw[bj][n].x << 16) + a[0], o1 = __uint_as_float(bw[bj][n].x & 0xffff0000u) + a[1];
                        const float o2 = __uint_as_float(bw[bj][n].y << 16) + a[2], o3 = __uint_as_float(bw[bj][n].y & 0xffff0000u) + a[3];
                        u32x2 w; w.x = pg8::cvt_pk_bf16(o0, o1); w.y = pg8::cvt_pk_bf16(o2, o3); *(u32x2*)(xb + off + bj * pg8::HALF + n * 16) = w;
                        sq += (o0 * o0 + o1 * o1) + (o2 * o2 + o3 * o3); }
                sq += __shfl_xor(sq, 16); sq += __shfl_xor(sq, 32);
                if (fq == 0) ssq[(size_t)row * 16 + u.pn * 4 + wc] = sq;
                if (m & 1) asm volatile("" ::: "memory"); }
    }
};

__device__ __forceinline__ void even_qk_post(bf16_t* proj, const float* qg, const float* kg, int S) {
    MK_IDS();
    const int g = lane & 7, axis = g >> 2, half = (g >> 1) & 1;
    float inv[8], gq[8], gk[8];
#pragma unroll
    for (int e = 0; e < 8; ++e) { inv[e] = exp2f(-(float)((g & 1) * 8 + e) * (13.287712379549449f / 16.f)); gq[e] = qg[g * 8 + e] * attn_body::C2; gk[e] = kg[g * 8 + e]; }
    for (int t = gw; t < TS; t += NGW) {
        const int s = t % S; const float pos = (float)(axis ? (s & 63) : (s >> 6));
        bf16_t* row = proj + (size_t)t * EIN;
        const u32x4 qa = *(const u32x4*)(row + lane * 8); u32x4 ka = {0u, 0u, 0u, 0u}; if (lane < 16) ka = *(const u32x4*)(row + 512 + lane * 8);
        float cs[8], sn[8];
#pragma unroll
        for (int e = 0; e < 8; ++e) { const float ang = pos * inv[e]; cs[e] = __cosf(ang); sn[e] = __sinf(ang); }
        float xq[8], xk[8]; unpack8(qa, xq); unpack8(ka, xk);
        float sq = 0.f, sk = 0.f;
#pragma unroll
        for (int e = 0; e < 8; ++e) { sq += xq[e] * xq[e]; sk += xk[e] * xk[e]; }
        sq += __shfl_xor(sq, 1); sq += __shfl_xor(sq, 2); sq += __shfl_xor(sq, 4);
        sk += __shfl_xor(sk, 1); sk += __shfl_xor(sk, 2); sk += __shfl_xor(sk, 4);
        const float rq = 1.f / sqrtf(sq * (1.f / 64.f) + EPS), rk = 1.f / sqrtf(sk * (1.f / 64.f) + EPS);
        float oq[8], ok[8];
#pragma unroll
        for (int e = 0; e < 8; ++e) { const float yq = xq[e] * rq * gq[e], yk = xk[e] * rk * gk[e];
            const float pq = __shfl_xor(yq, 2), pk = __shfl_xor(yk, 2);
            oq[e] = yq * cs[e] + (half ? pq : -pq) * sn[e]; ok[e] = yk * cs[e] + (half ? pk : -pk) * sn[e]; }
        u32x4 o; o.x = pk2(oq[0], oq[1]); o.y = pk2(oq[2], oq[3]); o.z = pk2(oq[4], oq[5]); o.w = pk2(oq[6], oq[7]);
        *(u32x4*)(row + lane * 8) = o;
        if (lane < 16) { u32x4 o2; o2.x = pk2(ok[0], ok[1]); o2.y = pk2(ok[2], ok[3]); o2.z = pk2(ok[4], ok[5]); o2.w = pk2(ok[6], ok[7]); *(u32x4*)(row + 512 + lane * 8) = o2; }
    }
}
__device__ __forceinline__ void even_lru_prep(const bf16_t* proj, const float* cw, const float* cb, const bf16_t* GWj, const float* br, const float* bi, const float* lam,
                                              unsigned* LU, f32x2* AGG, int S, char* lds) {
    MK_IDS();
    constexpr int XST = 1040;
    for (int tile = blockIdx.x; tile < TS / 64; tile += gridDim.x) {
        const int t0 = tile * 64;
        __syncthreads();
#pragma unroll 2
        for (int k = 0; k < 8; ++k) {
            const int idx = tid + k * NT, i = idx >> 6, cgp = idx & 63, t = t0 + i, s = t % S, ch = cgp * 8;
            float acc[8];
#pragma unroll
            for (int e = 0; e < 8; ++e) acc[e] = cb[ch + e];
#pragma unroll
            for (int j = 0; j < 4; ++j) { const int sp = s + j - 2;
                if (sp >= 0 && sp < S) { const u32x4 v = *(const u32x4*)(proj + (size_t)(t + j - 2) * EIN + 768 + ch); float xv[8]; unpack8(v, xv);
#pragma unroll
                    for (int e = 0; e < 8; ++e) acc[e] += cw[j * 512 + ch + e] * xv[e]; } }
            u32x4 o; o.x = pk2(acc[0], acc[1]); o.y = pk2(acc[2], acc[3]); o.z = pk2(acc[4], acc[5]); o.w = pk2(acc[6], acc[7]);
            *(u32x4*)(lds + i * XST + ch * 2) = o;
        }
        __syncthreads();
        const int G = lane >> 4, l16 = lane & 15, ch0 = wave * 64;
        for (int dir = 0; dir < 2; ++dir)
            for (int nt = 0; nt < 4; ++nt) {
                const int e = nt * 16 + l16, ch = ch0 + e;
                bf16x8 Br[2], Bi[2];
#pragma unroll
                for (int kk = 0; kk < 2; ++kk) {
                    Br[kk] = *(const bf16x8*)(GWj + ((((size_t)dir * 2 + 0) * 8 + wave) * 64 + e) * 64 + kk * 32 + G * 8);
                    Bi[kk] = *(const bf16x8*)(GWj + ((((size_t)dir * 2 + 1) * 8 + wave) * 64 + e) * 64 + kk * 32 + G * 8);
                }
                const float brv = br[dir * 512 + ch], biv = bi[dir * 512 + ch], spl = softplus(-lam[dir * 512 + ch]);
#pragma unroll
                for (int mt = 0; mt < 4; ++mt) {
                    f32x4 ar = {0.f, 0.f, 0.f, 0.f}, ai = {0.f, 0.f, 0.f, 0.f};
#pragma unroll
                    for (int kk = 0; kk < 2; ++kk) { const bf16x8 a = *(const bf16x8*)(lds + (mt * 16 + l16) * XST + (ch0 + kk * 32 + G * 8) * 2); ar = MFMA16(a, Br[kk], ar); ai = MFMA16(a, Bi[kk], ai); }
#pragma unroll
                    for (int r = 0; r < 4; ++r) { const int i = mt * 16 + G * 4 + r;
                        const float xc = bf2f(*(const bf16_t*)(lds + i * XST + ch * 2));
                        const float rg = __builtin_amdgcn_rcpf(1.f + __expf(-(ar[r] + brv))), ig = __builtin_amdgcn_rcpf(1.f + __expf(-(ai[r] + biv)));
                        const float la = -8.f * rg * spl; const float uu = __builtin_amdgcn_sqrtf(fmaxf(1.f - __expf(2.f * la), 0.f)) * (ig * xc);
                        LU[((size_t)dir * TS + t0 + i) * 512 + ch] = attn_body::cvtpk_s(la, uu); }
                }
            }
        asm volatile("s_waitcnt vmcnt(0)" ::: "memory");
        __syncthreads();
        {
            const int ch = tid;
#pragma unroll
            for (int dir = 0; dir < 2; ++dir) {
                float h = 0.f, P = 0.f;
                const unsigned* lu = LU + ((size_t)dir * TS + t0) * 512 + ch;
#pragma unroll
                for (int q = 0; q < 64; q += 8) {
                    float lv[8], uv[8];
#pragma unroll
                    for (int e = 0; e < 8; ++e) { const int i = dir ? 63 - (q + e) : q + e; const unsigned w_ = lu[(size_t)i * 512]; lv[e] = __uint_as_float(w_ << 16); uv[e] = __uint_as_float(w_ & 0xffff0000u); }
#pragma unroll
                    for (int e = 0; e < 8; ++e) { h = __expf(lv[e]) * h + uv[e]; P += lv[e]; }
                }
                AGG[((size_t)dir * (TS / 64) + tile) * 512 + ch] = (f32x2){P, h};
            }
        }
    }
}
__device__ __forceinline__ void even_lru_scan(const unsigned* LU, const f32x2* AGG, const bf16_t* proj, bf16_t* Y, int S) {
    MK_IDS();
    const int ch = tid, TPB = S / 64;
    for (int tile = blockIdx.x; tile < TS / 64; tile += gridDim.x) {
        const int t0 = tile * 64, tb0 = (tile / TPB) * TPB;
        float cf = 0.f, cr = 0.f;
        for (int k0 = tb0; k0 < tile; k0 += 8) { f32x2 a[8];
#pragma unroll
            for (int q = 0; q < 8; ++q) { const int k = k0 + q < tile ? k0 + q : tile - 1; a[q] = AGG[(size_t)k * 512 + ch]; }
#pragma unroll
            for (int q = 0; q < 8; ++q) if (k0 + q < tile) cf = cf * __expf(a[q].x) + a[q].y; }
        for (int k0 = tb0 + TPB - 1; k0 > tile; k0 -= 8) { f32x2 a[8];
#pragma unroll
            for (int q = 0; q < 8; ++q) { const int k = k0 - q > tile ? k0 - q : tile + 1; a[q] = AGG[((size_t)(TS / 64) + k) * 512 + ch]; }
#pragma unroll
            for (int q = 0; q < 8; ++q) if (k0 - q > tile) cr = cr * __expf(a[q].x) + a[q].y; }
        float hf[64];
        {
            const unsigned* lu = LU + (size_t)t0 * 512 + ch; float h = cf;
#pragma unroll
            for (int q = 0; q < 64; q += 8) {
                float lv[8], uv[8];
#pragma unroll
                for (int e = 0; e < 8; ++e) { const unsigned w_ = lu[(size_t)(q + e) * 512]; lv[e] = __uint_as_float(w_ << 16); uv[e] = __uint_as_float(w_ & 0xffff0000u); }
#pragma unroll
                for (int e = 0; e < 8; ++e) { h = __expf(lv[e]) * h + uv[e]; hf[q + e] = h; }
            }
        }
        {
            const unsigned* lu = LU + ((size_t)TS + t0) * 512 + ch; float h = cr;
#pragma unroll
            for (int q = 0; q < 64; q += 8) {
                float lv[8], uv[8], gv[8];
#pragma unroll
                for (int e = 0; e < 8; ++e) { const int i = 63 - (q + e); { const unsigned w_ = lu[(size_t)i * 512]; lv[e] = __uint_as_float(w_ << 16); uv[e] = __uint_as_float(w_ & 0xffff0000u); } gv[e] = bf2f(proj[(size_t)(t0 + i) * EIN + 1280 + ch]); }
#pragma unroll
                for (int e = 0; e < 8; ++e) { const int i = 63 - (q + e); h = __expf(lv[e]) * h + uv[e]; Y[(size_t)(t0 + i) * DMODEL + 512 + ch] = (bf16_t)f2bf((hf[i] + h) * gelu_tanh(gv[e])); }
            }
        }
    }
}

__device__ __forceinline__ void odd_conv(const bf16_t* proj, const float* cw, bf16_t* QKVP, int S) {
    MK_IDS();
    for (int cr = 0; cr < (TS / 64 + (int)gridDim.x - 1) / (int)gridDim.x; ++cr) {
        const int c = cr * (int)gridDim.x + (int)blockIdx.x; if (c >= TS / 64) break;
        const int tb = c * 64 + wave * 8, sb = tb % S;
#pragma unroll
        for (int blk = 0; blk < 3; ++blk) {
            const int ch = blk * 512 + lane * 8;
            u32x4 rows[11];
#pragma unroll
            for (int q = 0; q < 11; ++q) { const int sp = sb + q - 2; rows[q] = (u32x4){0u, 0u, 0u, 0u};
                if (sp >= 0 && sp < S) rows[q] = *(const u32x4*)(proj + (size_t)(tb + q - 2) * OINP + ch); }
            f32x4 w0[4], w1[4];
#pragma unroll
            for (int j = 0; j < 4; ++j) { w0[j] = *(const f32x4*)(cw + j * 1536 + ch); w1[j] = *(const f32x4*)(cw + j * 1536 + ch + 4); }
#pragma unroll
            for (int i = 0; i < 8; ++i) {
                float acc[8];
#pragma unroll
                for (int e = 0; e < 8; ++e) acc[e] = 0.f;
#pragma unroll
                for (int j = 0; j < 4; ++j) { float xv[8]; unpack8(rows[i + j], xv);
                    acc[0] += w0[j].x * xv[0]; acc[1] += w0[j].y * xv[1]; acc[2] += w0[j].z * xv[2]; acc[3] += w0[j].w * xv[3];
                    acc[4] += w1[j].x * xv[4]; acc[5] += w1[j].y * xv[5]; acc[6] += w1[j].z * xv[6]; acc[7] += w1[j].w * xv[7]; }
                float ss = 0.f;
#pragma unroll
                for (int e = 0; e < 8; ++e) { acc[e] = silu(acc[e]); ss += acc[e] * acc[e]; }
                if (blk < 2) {
                    ss += __shfl_xor(ss, 1); ss += __shfl_xor(ss, 2); ss += __shfl_xor(ss, 4); ss += __shfl_xor(ss, 8);
                    const float rn = 1.f / sqrtf(ss + EPS);
#pragma unroll
                    for (int e = 0; e < 8; ++e) acc[e] *= rn;
                }
                u32x4 o; o.x = pk2(acc[0], acc[1]); o.y = pk2(acc[2], acc[3]); o.z = pk2(acc[4], acc[5]); o.w = pk2(acc[6], acc[7]);
                *(u32x4*)(QKVP + (size_t)(tb + i) * 1536 + ch) = o;
            }
        }
    }
}

__device__ __forceinline__ int frag128(int r, int k) { return ((((r >> 4) * 4 + (k >> 5)) * 64 + ((k >> 3) & 3) * 16 + (r & 15)) << 3) + (k & 7); }
__device__ __forceinline__ int frag64(int r, int k) { return ((((r >> 4) * 2 + (k >> 5)) * 64 + ((k >> 3) & 3) * 16 + (r & 15)) << 3) + (k & 7); }
__device__ __forceinline__ void odd_prep(const bf16_t* QKVP, const bf16_t* proj, const float* alog, const float* dtb, unsigned char* DNI, float* EGL, char* lds) {
    MK_IDS();
    constexpr int RS = 272;
    constexpr int HOFF = 69632;
    const float scale = 0.08838834764831845f;
    for (int itq = 0; itq < (TS / 64 + (int)gridDim.x - 1) / (int)gridDim.x * 4; ++itq) {
        const int c_ = (itq >> 2) * (int)gridDim.x + (int)blockIdx.x; if (c_ >= TS / 64) break; const int it0 = (c_ * 4 + (itq & 3)) * 2;
        int tq_ = tid; asm volatile("" : "+v"(tq_));
        const int half = tq_ >> 8, ht = tq_ & 255, hwave = __builtin_amdgcn_readfirstlane(ht >> 6), G = (tq_ & 63) >> 4, l16 = tq_ & 15;
        char* L = lds + half * HOFF;
        char* KS = L, *QS = L + 17408, *VS = L + 34816; float* LM = (float*)(L + 52224); float* GC = (float*)(L + 68608); float* BT = GC + 64; float* EG = BT + 64;
        const int it = it0 + half; const int d = it & 1, h = (it >> 1) & 3, c = it >> 3, t0 = c * 64;
        __syncthreads();
#pragma unroll
        for (int k = 0; k < 4; ++k) { const int idx = ht + k * 256, i = idx >> 4, pc = idx & 15; const int tk = d ? t0 + 63 - i : t0 + i;
            const bf16_t* src = QKVP + (size_t)tk * 1536 + h * 128 + pc * 8;
            *(u32x4*)(QS + i * RS + pc * 16) = *(const u32x4*)(src);
            *(u32x4*)(KS + i * RS + pc * 16) = *(const u32x4*)(src + 512);
            *(u32x4*)(VS + i * RS + pc * 16) = *(const u32x4*)(src + 1024); }
        if (hwave == 0) {
            const int i = lane; const int tk = d ? t0 + 63 - i : t0 + i;
            const float bl = bf2f(proj[(size_t)tk * OINP + 2048 + d * 4 + h]), al = bf2f(proj[(size_t)tk * OINP + 2056 + d * 4 + h]);
            const float beta = sigm(bl); float g = -__expf(alog[d * 4 + h]) * softplus(al + dtb[d * 4 + h]);
#pragma unroll
            for (int o = 1; o < 64; o <<= 1) { const float v = __shfl_up(g, o); if (lane >= o) g += v; }
            GC[i] = g; BT[i] = beta; EG[i] = __expf(g);
        }
        __syncthreads();
        {
            const bool isq = hwave >= 2; const char* XS = isq ? QS : KS;
#pragma unroll
            for (int mm = 0; mm < 2; ++mm) { const int mt = (hwave & 1) * 2 + mm;
                bf16x8 a[4];
#pragma unroll
                for (int kk = 0; kk < 4; ++kk) a[kk] = *(const bf16x8*)(XS + (mt * 16 + l16) * RS + (kk * 32 + G * 8) * 2);
#pragma unroll
                for (int nt = 0; nt < 4; ++nt) { f32x4 acc = {0.f, 0.f, 0.f, 0.f};
#pragma unroll
                    for (int kk = 0; kk < 4; ++kk) { const bf16x8 bb = *(const bf16x8*)(KS + (nt * 16 + l16) * RS + (kk * 32 + G * 8) * 2); acc = MFMA16(a[kk], bb, acc); }
                    const int j = nt * 16 + l16; const float gj = GC[j];
#pragma unroll
                    for (int r = 0; r < 4; ++r) { const int i = mt * 16 + G * 4 + r; const float dec = __expf(fminf(GC[i] - gj, 0.f));
                        if (!isq) LM[i * 64 + j] = (j < i) ? BT[i] * acc[r] * dec : 0.f;
                        else ((bf16_t*)(DNI + (size_t)it * DNI_BYTES + DNI_A))[frag64(i, j)] = (bf16_t)f2bf((j <= i) ? acc[r] * scale * dec : 0.f); }
                }
            }
        }
        __syncthreads();
        {
            float sol[64];
            const int cc = ht & 127; const bool isw = ht >= 128; const char* XS = isw ? KS : VS;
#pragma unroll
            for (int i = 0; i < 64; ++i) {
                float v = bf2f(*(const bf16_t*)(XS + i * RS + cc * 2)) * BT[i]; if (isw) v *= EG[i];
                float a0 = 0.f, a1 = 0.f;
#pragma unroll
                for (int j4 = 0; j4 < (i + 3) / 4; ++j4) { const f32x4 l4 = *(const f32x4*)(LM + i * 64 + j4 * 4);
                    if (j4 * 4 + 0 < i) a0 += l4.x * sol[j4 * 4 + 0]; if (j4 * 4 + 1 < i) a1 += l4.y * sol[j4 * 4 + 1];
                    if (j4 * 4 + 2 < i) a0 += l4.z * sol[j4 * 4 + 2]; if (j4 * 4 + 3 < i) a1 += l4.w * sol[j4 * 4 + 3];
                    if ((j4 & 1) == 1) asm volatile("" ::: "memory"); }
                v -= a0 + a1;
                sol[i] = v;
                ((bf16_t*)(DNI + (size_t)it * DNI_BYTES + (isw ? DNI_W : DNI_U)))[isw ? frag128(i, cc) : i * 128 + cc] = (bf16_t)f2bf(v);
                asm volatile("" ::: "memory");
            }
        }
        {
            const float gl = GC[63];
#pragma unroll
            for (int k = 0; k < 4; ++k) { const int idx = ht + k * 256;
                {
                    const int i = idx & 63, kg = idx >> 6; const u32x4 raw = *(const u32x4*)(QS + i * RS + kg * 16); float f[8]; unpack8(raw, f); const float sc = scale * EG[i];
                    u32x4 o; o.x = pk2(f[0] * sc, f[1] * sc); o.y = pk2(f[2] * sc, f[3] * sc); o.z = pk2(f[4] * sc, f[5] * sc); o.w = pk2(f[6] * sc, f[7] * sc);
                    *(u32x4*)((bf16_t*)(DNI + (size_t)it * DNI_BYTES + DNI_QT) + frag128(i, kg * 8)) = o; }
                {
                    const int dm = idx & 127, tg = idx >> 7; float f[8];
#pragma unroll
                    for (int q = 0; q < 8; ++q) { const int i = tg * 8 + q; f[q] = bf2f(*(const bf16_t*)(KS + i * RS + dm * 2)) * __expf(gl - GC[i]); }
                    u32x4 o; o.x = pk2(f[0], f[1]); o.y = pk2(f[2], f[3]); o.z = pk2(f[4], f[5]); o.w = pk2(f[6], f[7]);
                    *(u32x4*)((bf16_t*)(DNI + (size_t)it * DNI_BYTES + DNI_KTT) + frag64(dm, tg * 8)) = o; }
            }
            if (ht == 0) EGL[it] = __expf(gl);
        }
    }
}

__device__ __forceinline__ void odd_scan(const unsigned char* DNI, const float* EGL, bf16_t* OB, int S, int nb, char* lds) {
    MK_IDS();
    constexpr int O_SB = 0, O_VN = 4352, O_OUT = 6656, PFD = 7;
    const int NC = S / 64, G = lane >> 4, l16 = lane & 15;
    const int nitems = nb * 64;
    const int mt = wave & 3; const bool lo = wave < 4;
    for (int item = blockIdx.x; item < nitems; item += gridDim.x) {
        const int e = (item >> 3) & 7, sq = (item & 7) | ((item >> 6) << 3); const int d = sq & 1, h = (sq >> 1) & 3, b = sq >> 3;
        __syncthreads();
        for (int i = tid; i < 4352 / 4; i += NT) ((unsigned*)(lds + O_SB))[i] = 0u;
        f32x4 Sreg = {0.f, 0.f, 0.f, 0.f};
        const long dstep = (long)(d ? -8 : 8) * DNI_BYTES;
        const unsigned char* base0 = DNI + (size_t)(((b * NC + (d ? NC - 1 : 0)) * 4 + h) * 2 + d) * DNI_BYTES;
        const unsigned char* pX = base0 + (lo ? DNI_W : DNI_QT) + ((mt * 4) * 64 + lane) * 16;
        const unsigned char* pA = base0 + DNI_A + ((mt * 2) * 64 + lane) * 16;
        const unsigned char* pK = base0 + DNI_KTT + ((wave * 2) * 64 + lane) * 16;
        const unsigned char* pU = base0 + DNI_U + ((mt * 16 + G * 4) * 128 + e * 16 + l16) * 2;
        const float* pE = EGL + (((b * NC + (d ? NC - 1 : 0)) * 4 + h) * 2 + d);
        const unsigned char* pP = base0 + (long)PFD * dstep + e * 9216 + (tid < 144 ? tid : 143) * 64;
        bf16_t* pO = OB + ((size_t)d * TS + (size_t)(b * NC + (d ? NC - 1 : 0)) * 64 + (d ? 63 - (tid >> 3) : (tid >> 3))) * 512 + h * 128 + e * 16 + (tid & 7) * 2;
        const long ostep = (long)(d ? -64 : 64) * 512;
        u32x4 aX[4], aA[2], aK[2], bX[4], bA[2], bK[2], cX[4], cA[2], cK[2];
        unsigned aU[4], bU[4], cU[4]; float aE, bE, cE; unsigned pf_dummy = 0u;
#define DN_LOAD(P) do { \
            _Pragma("unroll") for (int kk = 0; kk < 4; ++kk) P##X[kk] = *(const u32x4*)(pX + kk * 1024); \
            _Pragma("unroll") for (int kk = 0; kk < 2; ++kk) { P##A[kk] = *(const u32x4*)(pA + kk * 1024); P##K[kk] = *(const u32x4*)(pK + kk * 1024); } \
            _Pragma("unroll") for (int r = 0; r < 4; ++r) P##U[r] = *(const bf16_t*)(pU + r * 256); \
            P##E = *pE; pX += dstep; pA += dstep; pK += dstep; pU += dstep; pE += (d ? -8 : 8); } while (0)
#define DN_STEP(P, PL) do { \
            DN_LOAD(PL); \
            if (wave < 3) { asm volatile("global_load_dword %0, %1, off" : "+v"(pf_dummy) : "v"(pP) : "memory"); } \
            pP += dstep; \
            f32x4 acc = {0.f, 0.f, 0.f, 0.f}, acc2 = {0.f, 0.f, 0.f, 0.f}; \
            { bf16x8 sb_[4]; \
              _Pragma("unroll") for (int kk = 0; kk < 4; ++kk) sb_[kk] = *(const bf16x8*)(lds + O_SB + l16 * 272 + (kk * 32 + G * 8) * 2); \
              asm volatile("s_waitcnt lgkmcnt(0)" : "+v"(sb_[0]), "+v"(sb_[1]), "+v"(sb_[2]), "+v"(sb_[3]) :: "memory"); \
              acc = MFMA16(__builtin_bit_cast(bf16x8, P##X[0]), sb_[0], acc); acc2 = MFMA16(__builtin_bit_cast(bf16x8, P##X[1]), sb_[1], acc2); \
              acc = MFMA16(__builtin_bit_cast(bf16x8, P##X[2]), sb_[2], acc); acc2 = MFMA16(__builtin_bit_cast(bf16x8, P##X[3]), sb_[3], acc2); \
              acc = acc + acc2; } \
            if (lo) { u32x2 o; float v[4]; \
              _Pragma("unroll") for (int r = 0; r < 4; ++r) v[r] = __uint_as_float(P##U[r] << 16) - acc[r]; \
              o.x = attn_body::cvtpk_s(v[0], v[1]); o.y = attn_body::cvtpk_s(v[2], v[3]); \
              *(u32x2*)(lds + O_VN + l16 * 144 + (mt * 16 + G * 4) * 2) = o; } \
            asm volatile("s_waitcnt lgkmcnt(0)\n\ts_barrier" ::: "memory"); \
            bf16x8 vb[2]; \
            _Pragma("unroll") for (int kk = 0; kk < 2; ++kk) vb[kk] = *(const bf16x8*)(lds + O_VN + l16 * 144 + (kk * 32 + G * 8) * 2); \
            asm volatile("s_waitcnt lgkmcnt(0)" : "+v"(vb[0]), "+v"(vb[1]) :: "memory"); \
            Sreg = Sreg * P##E; \
            _Pragma("unroll") for (int kk = 0; kk < 2; ++kk) Sreg = MFMA16(__builtin_bit_cast(bf16x8, P##K[kk]), vb[kk], Sreg); \
            { u32x2 o; o.x = attn_body::cvtpk_s(Sreg[0], Sreg[1]); o.y = attn_body::cvtpk_s(Sreg[2], Sreg[3]); \
              *(u32x2*)(lds + O_SB + l16 * 272 + (wave * 16 + G * 4) * 2) = o; } \
            if (!lo) { \
              _Pragma("unroll") for (int kk = 0; kk < 2; ++kk) acc = MFMA16(__builtin_bit_cast(bf16x8, P##A[kk]), vb[kk], acc); \
              const unsigned w0_ = attn_body::cvtpk_s(acc[0], acc[1]), w1_ = attn_body::cvtpk_s(acc[2], acc[3]); \
              bf16_t* op_ = (bf16_t*)(lds + O_OUT + ((mt * 16 + G * 4) * 16 + l16) * 2); \
              op_[0] = (bf16_t)(w0_ & 0xffffu); op_[16] = (bf16_t)(w0_ >> 16); op_[32] = (bf16_t)(w1_ & 0xffffu); op_[48] = (bf16_t)(w1_ >> 16); } \
            asm volatile("s_waitcnt lgkmcnt(0)\n\ts_barrier" ::: "memory"); \
            *(unsigned*)pO = *(const unsigned*)(lds + O_OUT + tid * 4); pO += ostep; } while (0)
        DN_LOAD(a); DN_LOAD(b);
        __syncthreads();
        int n = 0;
        for (; n + 3 <= NC; n += 3) {
            DN_STEP(a, c);
            DN_STEP(b, a);
            DN_STEP(c, b);
        }
        if (n < NC) { DN_STEP(a, c); }
        if (n + 1 < NC) { DN_STEP(b, a); }
#undef DN_STEP
#undef DN_LOAD
        asm volatile("s_waitcnt vmcnt(0)" ::: "memory");
        asm volatile("" :: "v"(pf_dummy));
    }
}

__device__ __forceinline__ int t5_bucket(int rel) {
    const int n = rel < 0 ? -rel : rel; int v;
    if (n < 8) v = n; else v = 8 + (n >= 15) + (n >= 27) + (n >= 50) + (n >= 91) + (n >= 166) + (n >= 305) + (n >= 559);
    return (rel > 0 ? 16 : 0) + v;
}
__device__ __forceinline__ void odd_dilated(bf16_t* proj, const float* relb, float* LSE, int S, char* lds, int first_wg, int n_wg) {
    MK_IDS();
    constexpr int KST = 144, VST = 400, HOFF = 27648 + 25600 + 1024;
    const int half = tid >> 8, ht = tid & 255, wv = ht >> 6, G = lane >> 4, l16 = lane & 15;
    char* L = lds + half * HOFF; char* KS = L; char* VT = L + 27648; float* BIAS = (float*)(L + 27648 + 25600);
    const int NBb = S / 64;
    const int wgi = (int)blockIdx.x - first_wg;
    if (wgi < 0) return;
    for (int it0 = wgi * 2; it0 < 3072; it0 += n_wg * 2) {
        const int it = it0 + half; const int zb = it & 255, sl = (it >> 8) & 3, g = it >> 10;
        const int dil = g == 0 ? 1 : (g == 1 ? 4 : 16), lg = g * 2;
        const int M = S >> lg, MB = M / 64;
        const int b = zb / NBb, r0 = zb % NBb, rho = r0 / MB, n = r0 % MB;
        const int hc = (g * 4 + sl) * 64;
        const size_t tb = (size_t)b * S;
        __syncthreads();
#pragma unroll
        for (int k = 0; k < 6; ++k) { const int idx = ht + k * 256, kj = idx >> 3, pc = idx & 7; const int mk = 64 * n - 64 + kj;
            u32x4 kv = {0u, 0u, 0u, 0u}, vv = {0u, 0u, 0u, 0u};
            if (mk >= 0 && mk < M) { const bf16_t* rowp = proj + (tb + (size_t)mk * dil + rho) * OINP; kv = *(const u32x4*)(rowp + 2832 + hc + pc * 8); vv = *(const u32x4*)(rowp + 3600 + hc + pc * 8); }
            *(u32x4*)(KS + kj * KST + pc * 16) = kv;
            const unsigned w[4] = {vv.x, vv.y, vv.z, vv.w};
#pragma unroll
            for (int q = 0; q < 4; ++q) { *(bf16_t*)(VT + (pc * 8 + 2 * q) * VST + kj * 2) = (bf16_t)(w[q] & 0xffffu); *(bf16_t*)(VT + (pc * 8 + 2 * q + 1) * VST + kj * 2) = (bf16_t)(w[q] >> 16); } }
        if (ht < 129) BIAS[ht] = relb[t5_bucket((ht - 64) * dil) * 12 + g * 4 + sl];
        const int mq = 64 * n + 16 * wv + l16; const size_t tq = tb + (size_t)mq * dil + rho;
        bf16x8 qf[2];
#pragma unroll
        for (int kk = 0; kk < 2; ++kk) qf[kk] = *(const bf16x8*)(proj + tq * OINP + 2064 + hc + kk * 32 + G * 8);
        __syncthreads();
        f32x4 sc[9]; float mx = -1e30f;
#pragma unroll
        for (int kt = 0; kt < 9; ++kt) { f32x4 acc = {0.f, 0.f, 0.f, 0.f};
#pragma unroll
            for (int kk = 0; kk < 2; ++kk) { const bf16x8 a = *(const bf16x8*)(KS + ((wv + kt) * 16 + l16) * KST + (kk * 32 + G * 8) * 2); acc = MFMA16(a, qf[kk], acc); }
#pragma unroll
            for (int r = 0; r < 4; ++r) { const int kj = (wv + kt) * 16 + G * 4 + r; const int delta = kj - 64 - 16 * wv - l16; const int mk = 64 * n - 64 + kj;
                const bool ok = (delta >= -64) && (delta <= 64) && (mk >= 0) && (mk < M);
                const float s = ok ? acc[r] * 0.125f + BIAS[(delta < -64 ? -64 : (delta > 64 ? 64 : delta)) + 64] : -1e30f;
                acc[r] = s; mx = fmaxf(mx, s); }
            sc[kt] = acc; }
        mx = fmaxf(mx, __shfl_xor(mx, 16)); mx = fmaxf(mx, __shfl_xor(mx, 32));
        float sum = 0.f;
#pragma unroll
        for (int kt = 0; kt < 9; ++kt)
#pragma unroll
            for (int r = 0; r < 4; ++r) { const float pv_ = (sc[kt][r] > -1e29f) ? __expf(sc[kt][r] - mx) : 0.f; sc[kt][r] = pv_; sum += pv_; }
        sum += __shfl_xor(sum, 16); sum += __shfl_xor(sum, 32);
        f32x4 ot[4];
#pragma unroll
        for (int dt = 0; dt < 4; ++dt) ot[dt] = (f32x4){0.f, 0.f, 0.f, 0.f};
#pragma unroll
        for (int pp = 0; pp < 5; ++pp) {
            u32x4 pb; pb.x = pk2(sc[2 * pp][0], sc[2 * pp][1]); pb.y = pk2(sc[2 * pp][2], sc[2 * pp][3]);
            if (pp < 4) { pb.z = pk2(sc[2 * pp + 1][0], sc[2 * pp + 1][1]); pb.w = pk2(sc[2 * pp + 1][2], sc[2 * pp + 1][3]); } else { pb.z = 0u; pb.w = 0u; }
            const bf16x8 pbf = __builtin_bit_cast(bf16x8, pb);
#pragma unroll
            for (int dt = 0; dt < 4; ++dt) {
                u32x4 av; const u32x2 lo = *(const u32x2*)(VT + (dt * 16 + l16) * VST + ((wv + 2 * pp) * 16 + G * 4) * 2); av.x = lo.x; av.y = lo.y;
                if (pp < 4) { const u32x2 hi = *(const u32x2*)(VT + (dt * 16 + l16) * VST + ((wv + 2 * pp + 1) * 16 + G * 4) * 2); av.z = hi.x; av.w = hi.y; } else { av.z = 0u; av.w = 0u; }
                ot[dt] = MFMA16(__builtin_bit_cast(bf16x8, av), pbf, ot[dt]);
            }
        }
        const float rs = 1.f / sum;
        bf16_t* od = proj + tq * OINP + (g * 4 + sl) * 64;
#pragma unroll
        for (int dt = 0; dt < 4; ++dt) { const f32x4 v_ = ot[dt] * rs; u32x2 w_; w_.x = pk2(v_[0], v_[1]); w_.y = pk2(v_[2], v_[3]); *(u32x2*)(od + dt * 16 + G * 4) = w_; }
        if (G == 0) LSE[tq * 12 + g * 4 + sl] = mx + __logf(sum);
    }
}

__device__ __forceinline__ void odd_combine(const bf16_t* OB, const bf16_t* proj, const float* LSE, const float* og, bf16_t* Y) {
    MK_IDS();
    float gn[8];
#pragma unroll
    for (int e = 0; e < 8; ++e) gn[e] = og[(lane & 15) * 8 + e];
    const int sl = lane >> 4;
    for (int t = gw; t < TS; t += NGW) {
        const bf16_t* prow = proj + (size_t)t * OINP;
        const u32x4 fa = *(const u32x4*)(OB + (size_t)t * 512 + lane * 8), ra = *(const u32x4*)(OB + ((size_t)TS + t) * 512 + lane * 8), za = *(const u32x4*)(prow + 1536 + lane * 8);
        const u32x2 d0 = *(const u32x2*)(prow + lane * 4), d1 = *(const u32x2*)(prow + 256 + lane * 4), d2 = *(const u32x2*)(prow + 512 + lane * 4);
        const float l0 = LSE[(size_t)t * 12 + sl], l1 = LSE[(size_t)t * 12 + 4 + sl], l2 = LSE[(size_t)t * 12 + 8 + sl];
        float f[8], r[8], z[8]; unpack8(fa, f); unpack8(ra, r); unpack8(za, z);
        float ss = 0.f;
#pragma unroll
        for (int e = 0; e < 8; ++e) { f[e] += r[e]; ss += f[e] * f[e]; }
        ss += __shfl_xor(ss, 1); ss += __shfl_xor(ss, 2); ss += __shfl_xor(ss, 4); ss += __shfl_xor(ss, 8);
        const float rn = 1.f / sqrtf(ss * (1.f / 128.f) + EPS);
#pragma unroll
        for (int e = 0; e < 8; ++e) f[e] = f[e] * rn * gn[e] * silu(z[e]);
        u32x4 o; o.x = pk2(f[0], f[1]); o.y = pk2(f[2], f[3]); o.z = pk2(f[4], f[5]); o.w = pk2(f[6], f[7]);
        *(u32x4*)(Y + (size_t)t * OOUT + lane * 8) = o;
        const float m = fmaxf(l0, fmaxf(l1, l2)); const float w0 = __expf(l0 - m), w1 = __expf(l1 - m), w2 = __expf(l2 - m); const float rs = 1.f / (w0 + w1 + w2);
        const float a0 = w0 * rs, a1 = w1 * rs, a2 = w2 * rs;
        const float v0 = a0 * __uint_as_float(d0.x << 16) + a1 * __uint_as_float(d1.x << 16) + a2 * __uint_as_float(d2.x << 16);
        const float v1 = a0 * __uint_as_float(d0.x & 0xffff0000u) + a1 * __uint_as_float(d1.x & 0xffff0000u) + a2 * __uint_as_float(d2.x & 0xffff0000u);
        const float v2 = a0 * __uint_as_float(d0.y << 16) + a1 * __uint_as_float(d1.y << 16) + a2 * __uint_as_float(d2.y << 16);
        const float v3 = a0 * __uint_as_float(d0.y & 0xffff0000u) + a1 * __uint_as_float(d1.y & 0xffff0000u) + a2 * __uint_as_float(d2.y & 0xffff0000u);
        u32x2 od; od.x = pk2(v0, v1); od.y = pk2(v2, v3);
        *(u32x2*)(Y + (size_t)t * OOUT + 512 + lane * 4) = od;
    }
}

__global__ void __launch_bounds__(NT, 2) fwd_megakernel(Params p) {
    extern __shared__ __attribute__((aligned(16))) unsigned char lds_raw[];
    cg::grid_group grid = cg::this_grid();
    char* lds = (char*)lds_raw;
    PG8_LAS unsigned char* ldsl = (PG8_LAS unsigned char*)lds_raw;
    const int Gr = gridDim.x;
    volatile LAS unsigned* MISC = (volatile LAS unsigned*)((PG8_LAS unsigned char*)lds_raw + (LDS_BYTES - 128));
    if (threadIdx.x < 32) MISC[threadIdx.x] = 0u;
    __syncthreads();
    xb::XcdBarrier bar = xb::xcd_barrier_post((unsigned*)p.ws, MISC + 8);
#define GSYNC() xb::xcd_barrier(bar)
    unsigned char* ws = p.ws;
    bf16_t* H = (bf16_t*)(ws + WS_H); bf16_t* PROJ = (bf16_t*)(ws + WS_PROJ); unsigned char* SCR = ws + WS_SCR;

    phase_prologue(p, lds);
    grid.sync();

    float* SSQA = (float*)(SCR + 232 * MiB); float* SSQB = (float*)(SCR + 234 * MiB);
    bf16_t* YE = (bf16_t*)(SCR + 192 * MiB); bf16_t* YO = (bf16_t*)(SCR + SC_QKVP);
    for (int seg = 0; seg < NSEG; ++seg) {
        const int S = seg < 2 ? 16384 : 2048, nb = seg < 2 ? 1 : 8;
        const float* xin = (seg < 2 ? p.in[0] : p.in[1]) + (size_t)(seg & 1) * TS * DMODEL;
        float* xo = p.out + (size_t)seg * TS * DMODEL;
        phase_x0(xin, H, SSQB);
        GSYNC();
        for (int layer = 0; layer < 4; ++layer) {
            const int j = layer >> 1; const bool odd = layer & 1;
            {
                const int N = odd ? OINP : EIN;
                const bf16_t* Bt = odd ? (const bf16_t*)(ws + WS_WINO) + (size_t)j * OINP * 1024 : (const bf16_t*)(ws + WS_WINE) + (size_t)j * EIN * 1024;
                pg8::Gemm g{H, Bt, TS, N, 1024}; pg8::StaticOrder So; So.init(TS, N, Gr, (int)blockIdx.x);
                pg8::EpiBf16<0> E{PROJ, N, nullptr, 0, 0, 1.f, SSQB};
                pg8::gemm_phase<pg8::EpiBf16<0>, pg8::StaticOrder, true, true>(ldsl, g, So, E);
            }
            GSYNC();
            if (!odd) {
                even_qk_post(PROJ, p.in[10] + j * 64, p.in[11] + j * 64, S);
                even_lru_prep(PROJ, p.in[12] + j * 2048, p.in[13] + j * 512, (const bf16_t*)(ws + WS_GW) + (size_t)j * 2 * 2 * 8 * 4096, p.in[15] + j * 1024, p.in[17] + j * 1024, p.in[18] + j * 1024,
                              (unsigned*)(SCR + SC_LA), (f32x2*)(SCR + SC_AGG), S, lds);
                GSYNC();
                {
                    const int nqb = S / 256, nunits = nb * 8 * nqb;
                    for (int u = blockIdx.x; u < nunits; u += Gr) {
                        const int qb = u % nqb, h = (u / nqb) % 8, b = u / (nqb * 8), kvh = h >> 2;
                        const attn_body::bf16* base = (const attn_body::bf16*)PROJ + (size_t)b * S * EIN;
                        attn_body::attn_unit<8>(qb, S, base + h * 64, EIN, base + 512 + kvh * 64, base + 640 + kvh * 64, EIN, (attn_body::bf16*)YE + (size_t)b * S * DMODEL + h * 64, DMODEL, lds);
                    }
                }
                __syncthreads();
                even_lru_scan((const unsigned*)(SCR + SC_LA), (const f32x2*)(SCR + SC_AGG), PROJ, YE, S);
                GSYNC();
                {
                    pg8::Gemm g{YE, (const bf16_t*)(ws + WS_WOUTE) + (size_t)j * 1024 * 1024, TS, 1024, 1024}; pg8::StaticOrder So; So.init(TS, 1024, Gr, (int)blockIdx.x);
                    EpiRes E{H, SSQA, DMODEL};
                    pg8::gemm_phase<EpiRes, pg8::StaticOrder, true, true>(ldsl, g, So, E);
                }
            } else {
                odd_conv(PROJ, p.in[21] + j * 4 * 1536, (bf16_t*)(SCR + SC_QKVP), S);
                asm volatile("s_waitcnt vmcnt(0)" ::: "memory"); __syncthreads();
                odd_prep((const bf16_t*)(SCR + SC_QKVP), PROJ, p.in[22] + j * 8, p.in[23] + j * 8, SCR + SC_DNI, (float*)(SCR + SC_EGL), lds);
                GSYNC();
                {
                    const int nscan = nb * 64;
                    odd_scan(SCR + SC_DNI, (const float*)(SCR + SC_EGL), (bf16_t*)(SCR + SC_OB), S, nb, lds);
                    const int first = nscan < Gr ? nscan : 0;
                    odd_dilated(PROJ, p.in[2], (float*)(SCR + SC_LSE), S, lds, first, Gr - first);
                }
                GSYNC();
                odd_combine((const bf16_t*)(SCR + SC_OB), PROJ, (const float*)(SCR + SC_LSE), p.in[24] + j * 128, YO);
                GSYNC();
                {
                    pg8::Gemm g{YO, (const bf16_t*)(ws + WS_WOUTO) + (size_t)j * 1024 * OOUT, TS, 1024, OOUT}; pg8::StaticOrder So; So.init(TS, 1024, Gr, (int)blockIdx.x);
                    EpiRes E{H, SSQA, DMODEL};
                    pg8::gemm_phase<EpiRes, pg8::StaticOrder, true, true>(ldsl, g, So, E);
                }
            }
            GSYNC();
            {
                pg8::Gemm g{H, (const bf16_t*)(ws + WS_W1T) + (size_t)layer * 4096 * 1024, TS, DFF, 1024}; pg8::StaticOrder So; So.init(TS, DFF, Gr, (int)blockIdx.x);
                pg8::EpiBf16<2> E{(bf16_t*)(SCR + SC_HID), DFF, nullptr, 0, 0, 1.f, SSQA};
                pg8::gemm_phase<pg8::EpiBf16<2>, pg8::StaticOrder, true, true>(ldsl, g, So, E);
            }
            GSYNC();
            {
                pg8::Gemm g{(const bf16_t*)(SCR + SC_HID), (const bf16_t*)(ws + WS_W2T) + (size_t)layer * 1024 * 4096, TS, 1024, DFF}; pg8::StaticOrder So; So.init(TS, 1024, Gr, (int)blockIdx.x);
                EpiRes E{H, SSQB, DMODEL};
                pg8::gemm_phase<EpiRes, pg8::StaticOrder, true, true>(ldsl, g, So, E);
            }
            GSYNC();
        }
        phase_rmsnorm_final(H, xo, p.in[5]);
        GSYNC();
    }
}
}

extern "C" void kernel_launch(void* const* d_in, const int* in_sizes, int n_in, void* d_out, int out_size, void* d_ws, size_t ws_size, hipStream_t stream) {
    static int grid = 0;
    if (grid == 0) {
        if (n_in != 25 || ws_size < mk::WS_END) { fprintf(stderr, "kernel_launch: unexpected n_in %d / ws_size %zu\n", n_in, ws_size); grid = -1; return; }
        int dev = 0, cus = 0, per_cu = 0;
        hipGetDevice(&dev); hipDeviceGetAttribute(&cus, hipDeviceAttributeMultiprocessorCount, dev);
        if (hipFuncSetAttribute((const void*)mk::fwd_megakernel, hipFuncAttributeMaxDynamicSharedMemorySize, mk::LDS_BYTES) != hipSuccess) { fprintf(stderr, "hipFuncSetAttribute failed\n"); }
        hipOccupancyMaxActiveBlocksPerMultiprocessor(&per_cu, (const void*)mk::fwd_megakernel, mk::NT, mk::LDS_BYTES);
        (void)hipGetLastError();
        if (per_cu < 1) per_cu = 1;
        grid = cus * 1;
        fprintf(stderr, "kernel_launch: cus %d per_cu %d grid %d\n", cus, per_cu, grid);
    }
    if (grid < 0) return;
    if (hipMemsetAsync(d_ws, 0, 65536, stream) != hipSuccess) { fprintf(stderr, "memset failed\n"); return; }
    mk::Params p{};
    for (int i = 0; i < 25; ++i) p.in[i] = (const float*)d_in[i];
    p.out = (float*)d_out; p.ws = (unsigned char*)d_ws;
    void* args[] = {&p};
    hipError_t e = hipLaunchCooperativeKernel((const void*)mk::fwd_megakernel, dim3(grid), dim3(mk::NT), args, mk::LDS_BYTES, stream);
    if (e != hipSuccess) fprintf(stderr, "cooperative launch failed: %s (grid %d)\n", hipGetErrorString(e), grid);
}
```

```cpp
#include <hip/hip_runtime.h>
#include <hip/hip_cooperative_groups.h>
#include <hip/hip_bf16.h>
#include <cstdio>
#include <cstdint>
#include <cmath>
namespace cg = cooperative_groups;
namespace pg8 {
#define PG8_LAS __attribute__((address_space(3)))
typedef unsigned short bf16_t;
typedef short bf16x8 __attribute__((ext_vector_type(8)));
typedef float f32x4 __attribute__((ext_vector_type(4)));
typedef unsigned u32x4 __attribute__((ext_vector_type(4)));
constexpr int BM = 256, BK = 64, HALF = 128, HTB = HALF * BK * 2  , STAGE_BYTES = 8 * HTB, NXCD = 8, WGM = 8;

__host__ __device__ __forceinline__ int lds_byte(int r, int c) { const int st = (r >> 4) * 2 + (c >> 5), rr = r & 15, cc = c & 31, ob = rr * 64 + cc * 2; return st * 1024 + (ob ^ (((ob >> 9) & 1) << 5)); }
__host__ __device__ __forceinline__ void stage_rc(int b, int& R, int& C) { const int st = b / 1024, sb = b % 1024, swz = sb ^ (((sb >> 9) & 1) << 5); R = (st >> 1) * 16 + swz / 64; C = (st & 1) * 32 + (swz % 64) / 2; }
__host__ __device__ __forceinline__ int perm32(int rho) { const int n = rho >> 4, i = rho & 15; return 8 * (i >> 2) + 4 * n + (i & 3); }

struct Unit { int pm, pn; };
struct Gemm { const bf16_t* A; const bf16_t* Bt; int M, N, K; };

struct StaticOrder {
    int nM, nN, nwg, G, c;
    __host__ __device__ void init(int M, int N, int G_, int c_) { nM = M / BM; nN = N / BM; nwg = nM * nN; G = G_; c = c_; }
    __host__ __device__ bool next(int i, Unit& u) const {
        const long L = (long)i * G + c; if (L >= nwg) return false;
        int wgid = (int)L; { const int q = nwg / NXCD, r = nwg % NXCD, xcd = wgid % NXCD, off = wgid / NXCD; wgid = (xcd < r ? xcd * (q + 1) : r * (q + 1) + (xcd - r) * q) + off; }
        const int nig = WGM * nN, gid = wgid / nig, fm = gid * WGM, gsz = (nM - fm) < WGM ? (nM - fm) : WGM;
        u.pm = fm + ((wgid % nig) % gsz); u.pn = (wgid % nig) / gsz; return true;
    }
    __device__ __forceinline__ void a_ready(const Unit&) const {}
    __device__ __forceinline__ void done(const Unit&) const {}
};

__device__ __forceinline__ unsigned cvt_pk_bf16(float lo, float hi) { unsigned r; asm volatile("v_cvt_pk_bf16_f32 %0, %1, %2" : "=v"(r) : "v"(lo), "v"(hi)); return r; }
typedef float f32x2 __attribute__((ext_vector_type(2)));
__device__ __forceinline__ f32x2 gelu_pk(f32x2 v) {
    const f32x2 av = __builtin_elementwise_abs(v), d = av * 0.2316418882f + 1.0f;
    f32x2 t; t.x = __builtin_amdgcn_rcpf(d.x); t.y = __builtin_amdgcn_rcpf(d.y);
    f32x2 q = t * 0.5307027145f + (-0.7265760135f); q = q * t + 0.7107068705f; q = q * t + (-0.142248368f); q = q * t + 0.127414796f; q = q * t;
    const f32x2 s = (v * v) * (-0.72134752044f);
    f32x2 e; e.x = __builtin_amdgcn_exp2f(s.x); e.y = __builtin_amdgcn_exp2f(s.y);
    const f32x2 m = v * (q * e), r = v - m;
    f32x2 o; o.x = v.x < 0.f ? m.x : r.x; o.y = v.y < 0.f ? m.y : r.y; return o;
}

template <int ACT  > struct EpiBf16 {
    static constexpr bool PERM = true, AFTER_DRAIN = false; static_assert(ACT == 0 || ACT == 1 || ACT == 2, "EpiBf16: ACT 0 none, 1 gelu, 2 relu^2");
    bf16_t* O; int ldc; const float* bias; int split_cols; size_t split_stride; float scale0; const float* ssq;
    __device__ __forceinline__ void operator()(const f32x4 (&acc)[2][2][4][2], const Unit& u, int wr, int wc, int fr, int fq) const {
        const int row0 = u.pm * BM + wr * 64 + fr; int colt = u.pn * BM; bf16_t* base = O;
        float sc = 1.f; if (split_cols) { const int t = colt / split_cols; base += (size_t)t * split_stride; colt -= t * split_cols; if (t == 0) sc = scale0; }
        const int col0 = colt + wc * 32 + 8 * fq, bcol0 = u.pn * BM + wc * 32 + 8 * fq;
        float rsc[2][4];
        if (ssq) { f32x4 t_[2][4];
#pragma unroll
            for (int ai = 0; ai < 2; ++ai)
#pragma unroll
                for (int m = 0; m < 4; ++m) t_[ai][m] = *(const f32x4*)(ssq + (size_t)(row0 + ai * HALF + m * 16) * 16 + fq * 4);
#pragma unroll
            for (int ai = 0; ai < 2; ++ai)
#pragma unroll
                for (int m = 0; m < 4; ++m) { float s_ = (t_[ai][m][0] + t_[ai][m][1]) + (t_[ai][m][2] + t_[ai][m][3]); s_ += __shfl_xor(s_, 16); s_ += __shfl_xor(s_, 32); rsc[ai][m] = 1.0f / sqrtf(s_ * (1.0f / 1024.0f) + 1e-6f); }
        } else {
#pragma unroll
            for (int ai = 0; ai < 2; ++ai)
#pragma unroll
                for (int m = 0; m < 4; ++m) rsc[ai][m] = 1.0f; }
        f32x4 bv[2][2];
#pragma unroll
        for (int bj = 0; bj < 2; ++bj)
#pragma unroll
            for (int n = 0; n < 2; ++n) bv[bj][n] = bias ? *(const f32x4*)(bias + bcol0 + bj * HALF + 4 * n) : (f32x4){0.f, 0.f, 0.f, 0.f};
#pragma unroll
        for (int ai = 0; ai < 2; ++ai)
#pragma unroll
            for (int m = 0; m < 4; ++m) { bf16_t* rowp = base + (size_t)(row0 + ai * HALF + m * 16) * ldc + col0; const float rsc_ = rsc[ai][m];
#pragma unroll
                for (int bj = 0; bj < 2; ++bj) { f32x4 v0 = (acc[ai][bj][m][0] + bv[bj][0]) * rsc_, v1 = (acc[ai][bj][m][1] + bv[bj][1]) * rsc_;
                    if (ACT == 1) { f32x2 a = gelu_pk((f32x2){v0[0], v0[1]}), b = gelu_pk((f32x2){v0[2], v0[3]}), c = gelu_pk((f32x2){v1[0], v1[1]}), d = gelu_pk((f32x2){v1[2], v1[3]});
                        v0 = (f32x4){a.x, a.y, b.x, b.y}; v1 = (f32x4){c.x, c.y, d.x, d.y}; }
                    if (ACT == 2) { _Pragma("unroll") for (int q_ = 0; q_ < 4; ++q_) { const float a0_ = v0[q_] > 0.f ? v0[q_] : 0.f, a1_ = v1[q_] > 0.f ? v1[q_] : 0.f; v0[q_] = a0_ * a0_; v1[q_] = a1_ * a1_; } }
                    v0 = v0 * sc; v1 = v1 * sc; u32x4 w; w.x = cvt_pk_bf16(v0[0], v0[1]); w.y = cvt_pk_bf16(v0[2], v0[3]); w.z = cvt_pk_bf16(v1[0], v1[1]); w.w = cvt_pk_bf16(v1[2], v1[3]);
                    *(u32x4*)(rowp + bj * HALF) = w; } }
    }
};

template <class Epi, class Sched, bool ALIGN_EPI = false, bool SP2 = false>
__device__ __forceinline__ void gemm_phase(PG8_LAS unsigned char* lds, const Gemm g, const Sched& S, const Epi& E) {
    int tid_ = threadIdx.x; asm volatile("" : "+v"(tid_)); const int tid = tid_, wid = __builtin_amdgcn_readfirstlane(tid >> 6), lane = tid & 63, wr = wid >> 2, wc = wid & 3, fr = lane & 15, fq = lane >> 4;
    const int K = g.K, nt = K / BK;
    unsigned voffA[2], voffB[2];
#pragma unroll
    for (int i = 0; i < 2; ++i) { int R, C; stage_rc(tid * 16 + i * 8192, R, C); const int Rb = Epi::PERM ? ((R & ~31) + perm32(R & 31)) : R;
        voffA[i] = (unsigned)(R * K + C) * 2u; voffB[i] = (unsigned)(Rb * K + C) * 2u; }
    const size_t kstep = (size_t)(BK * 2);
    const size_t hstep = (size_t)HALF * K * 2;
    const size_t tstep = 2 * hstep;
    const unsigned ldsw = (unsigned)wid * 1024u;
    const int aoff = lds_byte(wr * 64 + fr, fq * 8), boff = lds_byte(wc * 32 + fr, fq * 8);
#define PG8_SA(b, h) (((b) * 2 + (h)) * HTB)
#define PG8_SB(b, h) ((4 + (b) * 2 + (h)) * HTB)
#define PG8_STAGE(bufoff, gbase, voff) do { _Pragma("unroll") for (int _i = 0; _i < 2; ++_i) \
        __builtin_amdgcn_global_load_lds((const unsigned*)((const char*)(gbase) + (voff)[_i]), (PG8_LAS unsigned*)(lds + (bufoff) + ldsw + _i * 8192), 16, 0, 0); } while (0)
#define PG8_LDA(dst, b, h) do { _Pragma("unroll") for (int m = 0; m < 4; ++m) _Pragma("unroll") for (int k = 0; k < 2; ++k) dst[m][k] = *(const PG8_LAS bf16x8*)(lds + PG8_SA(b, h) + aoff + m * 2048 + k * 1024); } while (0)
#define PG8_LDB(dst, b, h) do { _Pragma("unroll") for (int n = 0; n < 2; ++n) _Pragma("unroll") for (int k = 0; k < 2; ++k) dst[n][k] = *(const PG8_LAS bf16x8*)(lds + PG8_SB(b, h) + boff + n * 2048 + k * 1024); } while (0)
#define PG8_MMA(ai, bj, At, Bt) do { __builtin_amdgcn_s_setprio(1); _Pragma("unroll") for (int m = 0; m < 4; ++m) _Pragma("unroll") for (int n = 0; n < 2; ++n) _Pragma("unroll") for (int k = 0; k < 2; ++k) \
        acc[ai][bj][m][n] = __builtin_amdgcn_mfma_f32_16x16x32_bf16(Bt[n][k], At[m][k], acc[ai][bj][m][n], 0, 0, 0); __builtin_amdgcn_s_setprio(0); } while (0)
#define PG8_WAIT_V(n) asm volatile("s_waitcnt vmcnt(" #n ")" ::: "memory")
#define PG8_WAIT_L(n) asm volatile("s_waitcnt lgkmcnt(" #n ")" ::: "memory")
#define PG8_BAR __builtin_amdgcn_s_barrier()
#define PG8_SCHED __builtin_amdgcn_sched_barrier(0)
    Unit cur, nxt; int ui = 0;
    if (!S.next(0, cur)) return;
    f32x4 acc[2][2][4][2];
#pragma unroll
    for (int a = 0; a < 2; ++a)
#pragma unroll
        for (int b = 0; b < 2; ++b)
#pragma unroll
            for (int m = 0; m < 4; ++m)
#pragma unroll
                for (int n = 0; n < 2; ++n) acc[a][b][m][n] = (f32x4){0.f, 0.f, 0.f, 0.f};
    bf16x8 At[4][2], B0[2][2], B1[2][2];
    const char* cA = (const char*)g.A + (size_t)cur.pm * tstep; const char* cB = (const char*)g.Bt + (size_t)cur.pn * tstep;
    S.a_ready(cur);
    if constexpr (SP2) {
        PG8_STAGE(PG8_SB(0, 0), cB, voffB); PG8_STAGE(PG8_SB(0, 1), cB + hstep, voffB); PG8_STAGE(PG8_SA(0, 0), cA, voffA); PG8_STAGE(PG8_SA(0, 1), cA + hstep, voffA);
        if (wr == 1) PG8_BAR;
        PG8_WAIT_V(2); PG8_BAR;
        PG8_STAGE(PG8_SB(1, 0), cB + kstep, voffB); PG8_STAGE(PG8_SA(1, 0), cA + kstep, voffA); PG8_STAGE(PG8_SB(1, 1), cB + hstep + kstep, voffB);
        PG8_WAIT_V(6); PG8_BAR;
    } else {
        PG8_STAGE(PG8_SB(0, 0), cB, voffB); PG8_STAGE(PG8_SA(0, 0), cA, voffA); PG8_STAGE(PG8_SB(0, 1), cB + hstep, voffB); PG8_STAGE(PG8_SA(0, 1), cA + hstep, voffA);
        if (wr == 1) PG8_BAR;
        PG8_WAIT_V(4); PG8_BAR;
        PG8_STAGE(PG8_SB(1, 0), cB + kstep, voffB); PG8_STAGE(PG8_SA(1, 0), cA + kstep, voffA); PG8_STAGE(PG8_SB(1, 1), cB + hstep + kstep, voffB);
        PG8_WAIT_V(6); PG8_BAR;
    }
    for (;;) {
        const bool has_next = S.next(ui + 1, nxt);
        const char* nA = has_next ? (const char*)g.A + (size_t)nxt.pm * tstep : cA; const char* nB = has_next ? (const char*)g.Bt + (size_t)nxt.pn * tstep : cB;
        for (int t = 0; t < nt; t += 2) {
            const bool last = (t == nt - 2);
            const char* a1 = cA + (size_t)(t + 1) * kstep;
            const char* a2 = last ? nA : cA + (size_t)(t + 2) * kstep; const char* b2 = last ? nB : cB + (size_t)(t + 2) * kstep;
            const char* a3 = a2 + kstep; const char* b3 = b2 + kstep;
            if (last && has_next) S.a_ready(nxt);
            if constexpr (SP2) {
            PG8_LDB(B0, 0, 0); PG8_LDB(B1, 0, 1); PG8_SCHED; PG8_LDA(At, 0, 0); PG8_STAGE(PG8_SA(1, 1), a1 + hstep, voffA);
            PG8_WAIT_V(8); PG8_WAIT_L(0); PG8_BAR; PG8_MMA(0, 0, At, B0); PG8_MMA(0, 1, At, B1); PG8_BAR; PG8_SCHED;
            PG8_LDA(At, 0, 1); PG8_STAGE(PG8_SB(0, 0), b2, voffB); PG8_STAGE(PG8_SB(0, 1), b2 + hstep, voffB); PG8_STAGE(PG8_SA(0, 0), a2, voffA);
            PG8_WAIT_V(8); PG8_WAIT_L(0); PG8_BAR; PG8_MMA(1, 0, At, B0); PG8_MMA(1, 1, At, B1); PG8_BAR; PG8_SCHED;
            PG8_LDB(B0, 1, 0); PG8_LDB(B1, 1, 1); PG8_SCHED; PG8_LDA(At, 1, 0); PG8_STAGE(PG8_SA(0, 1), a2 + hstep, voffA);
            PG8_WAIT_V(8); PG8_WAIT_L(0); PG8_BAR; PG8_MMA(0, 0, At, B0); PG8_MMA(0, 1, At, B1); PG8_BAR; PG8_SCHED;
            PG8_LDA(At, 1, 1); PG8_STAGE(PG8_SB(1, 0), b3, voffB); PG8_STAGE(PG8_SB(1, 1), b3 + hstep, voffB); PG8_STAGE(PG8_SA(1, 0), a3, voffA);
            PG8_WAIT_V(8); PG8_WAIT_L(0); PG8_BAR; PG8_MMA(1, 0, At, B0); PG8_MMA(1, 1, At, B1); PG8_BAR; PG8_SCHED;
            } else {
            PG8_LDB(B0, 0, 0); PG8_SCHED; PG8_LDA(At, 0, 0); PG8_STAGE(PG8_SA(1, 1), a1 + hstep, voffA);
            PG8_WAIT_L(8); PG8_BAR; PG8_WAIT_L(0); PG8_MMA(0, 0, At, B0); PG8_BAR; PG8_SCHED;
            PG8_LDB(B1, 0, 1); PG8_STAGE(PG8_SB(0, 0), b2, voffB);
            PG8_BAR; PG8_WAIT_L(0); PG8_MMA(0, 1, At, B1); PG8_BAR;
            PG8_LDA(At, 0, 1); PG8_STAGE(PG8_SA(0, 0), a2, voffA);
            PG8_BAR; PG8_WAIT_L(0); PG8_MMA(1, 0, At, B0); PG8_BAR; PG8_SCHED;
            PG8_STAGE(PG8_SB(0, 1), b2 + hstep, voffB);
            PG8_WAIT_V(6); PG8_BAR; PG8_MMA(1, 1, At, B1); PG8_BAR;
            PG8_LDB(B0, 1, 0); PG8_SCHED; PG8_LDA(At, 1, 0); PG8_STAGE(PG8_SA(0, 1), a2 + hstep, voffA);
            PG8_WAIT_L(8); PG8_BAR; PG8_WAIT_L(0); PG8_MMA(0, 0, At, B0); PG8_BAR; PG8_SCHED;
            PG8_LDB(B1, 1, 1); PG8_STAGE(PG8_SB(1, 0), b3, voffB);
            PG8_BAR; PG8_WAIT_L(0); PG8_MMA(0, 1, At, B1); PG8_BAR;
            PG8_LDA(At, 1, 1); PG8_STAGE(PG8_SA(1, 0), a3, voffA);
            PG8_BAR; PG8_WAIT_L(0); PG8_MMA(1, 0, At, B0); PG8_BAR; PG8_SCHED;
            PG8_STAGE(PG8_SB(1, 1), b3 + hstep, voffB);
            PG8_WAIT_V(6); PG8_BAR; PG8_MMA(1, 1, At, B1); PG8_BAR;
            }
        }
        if constexpr (ALIGN_EPI) { if (wr == 0) PG8_BAR; }
        if constexpr (!Epi::AFTER_DRAIN) { E(acc, cur, wr, wc, fr, fq); S.done(cur); }
        if (!has_next) break;
#pragma unroll
        for (int a = 0; a < 2; ++a)
#pragma unroll
            for (int b = 0; b < 2; ++b)
#pragma unroll
                for (int m = 0; m < 4; ++m)
#pragma unroll
                    for (int n = 0; n < 2; ++n) acc[a][b][m][n] = (f32x4){0.f, 0.f, 0.f, 0.f};
        cur = nxt; cA = nA; cB = nB; ++ui;
        if constexpr (ALIGN_EPI) { if (wr == 1) PG8_BAR; }
    }
    PG8_WAIT_V(0);
    if constexpr (!ALIGN_EPI) { if (wr == 0) PG8_BAR; }
    PG8_BAR;
    if constexpr (Epi::AFTER_DRAIN) { E.fused(acc, cur, wr, wc, fr, fq, lds, wid, lane); S.done(cur); }
#undef PG8_SA
#undef PG8_SB
#undef PG8_STAGE
#undef PG8_LDA
#undef PG8_LDB
#undef PG8_MMA
#undef PG8_WAIT_V
#undef PG8_WAIT_L
#undef PG8_BAR
#undef PG8_SCHED
}
}

#ifndef PG8_SP2
#define PG8_SP2 true
#endif
#ifndef PG8_ALIGN
#define PG8_ALIGN true
#endif
#include <hip/hip_bf16.h>
#include <cmath>
namespace attn_body {
using bf16=__hip_bfloat16;
using bf16x8=__attribute__((ext_vector_type(8)))short;
using s16x4=__attribute__((ext_vector_type(4)))short;
using f32x16=__attribute__((ext_vector_type(16)))float;
using u32x4=__attribute__((ext_vector_type(4)))unsigned;
constexpr int D=64;
constexpr int NW=8,QBLK=32,QB=QBLK*NW,KVBLK=64;
__device__ __forceinline__ int crow(int r,int hi){return (r&3)+8*(r>>2)+4*hi;}
#define SBAR() __builtin_amdgcn_sched_barrier(0)
__device__ __forceinline__ void cmask(f32x16&p0,f32x16&p1,int jb,int qrel,int hi){
  const float NEG=-INFINITY; int kb=64*jb+4*hi;
  #pragma unroll
  for(int r=0;r<16;++r){int kv=kb+(r&3)+8*(r>>2); if(kv>qrel)p0[r]=NEG; if(kv+32>qrel)p1[r]=NEG;}
}

constexpr int NSLOT=3, SLOTB=8192;
constexpr int LDS_K=0, LDS_V=NSLOT*SLOTB, LDS_WS=2*NSLOT*SLOTB, LDS_OST=LDS_WS+NW*64*4, LDS_BYTES=LDS_OST+NW*4096;
constexpr float C2=0.125f*1.4426950408889634f;
__device__ __forceinline__ void glds16(const void*gsrc,unsigned lds_dst){unsigned keep;
  asm volatile("s_mov_b32 %0, m0\n\ts_mov_b32 m0, %2\n\ts_nop 0\n\tglobal_load_lds_dwordx4 %1, off\n\ts_mov_b32 m0, %0":"=&s"(keep):"v"(gsrc),"s"(lds_dst):"memory");}
__device__ __forceinline__ float max3f(float a,float b,float c){float r;asm("v_max3_f32 %0, %1, %2, %3":"=v"(r):"v"(a),"v"(b),"v"(c));return r;}
__device__ __forceinline__ float max2f(float a,float b){float r;asm("v_max_f32_e32 %0, %1, %2":"=v"(r):"v"(a),"v"(b));return r;}
__device__ __forceinline__ float fadd_s(float a,float b){float r;asm("v_add_f32_e32 %0, %1, %2":"=v"(r):"v"(a),"v"(b));return r;}
__device__ __forceinline__ float fsub_s(float a,float b){float r;asm("v_sub_f32_e32 %0, %1, %2":"=v"(r):"v"(a),"v"(b));return r;}
typedef float f32x2_t __attribute__((ext_vector_type(2))); typedef __bf16 bf16x2_t __attribute__((ext_vector_type(2)));
__device__ __forceinline__ unsigned cvtpk_s(float lo,float hi){f32x2_t v={lo,hi};bf16x2_t b=__builtin_convertvector(v,bf16x2_t);return __builtin_bit_cast(unsigned,b);}
#define WAIT_BAR(N) asm volatile("s_waitcnt vmcnt(" #N ") lgkmcnt(0)\n\ts_barrier":::"memory")

__device__ __forceinline__ void qkt(f32x16&p0,f32x16&p1,const char*Kslot,const bf16x8*qr,const f32x16&negm,int r32,int hi){
  const char*kb=Kslot+hi*1024+r32*16;
  #pragma unroll
  for(int d0=0;d0<4;++d0){
    const bf16x8 b0=*reinterpret_cast<const bf16x8*>(kb+d0*2048);
    const bf16x8 b1=*reinterpret_cast<const bf16x8*>(kb+d0*2048+512);
    if(d0==0){p0=__builtin_amdgcn_mfma_f32_32x32x16_bf16(b0,qr[0],negm,0,0,0);p1=__builtin_amdgcn_mfma_f32_32x32x16_bf16(b1,qr[0],negm,0,0,0);}
    else{p0=__builtin_amdgcn_mfma_f32_32x32x16_bf16(b0,qr[d0],p0,0,0,0);p1=__builtin_amdgcn_mfma_f32_32x32x16_bf16(b1,qr[d0],p1,0,0,0);}}
}
typedef __attribute__((address_space(3))) const char* lds_cptr;
typedef short v4i16_t __attribute__((ext_vector_type(4)));
__device__ __forceinline__ void kload8(bf16x8*kf,lds_cptr kp){
  kf[0]=*(const __attribute__((address_space(3))) bf16x8*)(kp);      kf[1]=*(const __attribute__((address_space(3))) bf16x8*)(kp+512);
  kf[2]=*(const __attribute__((address_space(3))) bf16x8*)(kp+2048); kf[3]=*(const __attribute__((address_space(3))) bf16x8*)(kp+2560);
  kf[4]=*(const __attribute__((address_space(3))) bf16x8*)(kp+4096); kf[5]=*(const __attribute__((address_space(3))) bf16x8*)(kp+4608);
  kf[6]=*(const __attribute__((address_space(3))) bf16x8*)(kp+6144); kf[7]=*(const __attribute__((address_space(3))) bf16x8*)(kp+6656);
}
__device__ __forceinline__ void kload2(bf16x8*kf,lds_cptr kp,int j){ kf[2*j]=*(const __attribute__((address_space(3))) bf16x8*)(kp+j*2048); kf[2*j+1]=*(const __attribute__((address_space(3))) bf16x8*)(kp+j*2048+512); }
__device__ __forceinline__ s16x4 vtr(lds_cptr p){ return __builtin_bit_cast(s16x4,__builtin_amdgcn_ds_read_tr16_b64_v4i16((__attribute__((address_space(3))) v4i16_t*)p)); }
__device__ __forceinline__ float rowmax(const f32x16&p0,const f32x16&p1){
  float a=max3f(p0[0],p0[1],p1[0]),b=max3f(p0[2],p0[3],p1[1]);a=max3f(a,p1[2],p1[3]);
  #pragma unroll
  for(int r=4;r<16;r+=4){a=max3f(a,p0[r],p0[r+1]);b=max3f(b,p0[r+2],p0[r+3]);a=max3f(a,p1[r],p1[r+1]);b=max3f(b,p1[r+2],p1[r+3]);}
  const float m=max2f(a,b);
  auto rr=__builtin_amdgcn_permlane32_swap(__float_as_uint(m),__float_as_uint(m),false,false);
  return max2f(__uint_as_float(rr[0]),__uint_as_float(rr[1]));
}
__device__ __forceinline__ void pv(f32x16*o,int vb,bf16x8 pa0,bf16x8 pa1,bf16x8 pa2,bf16x8 pa3){
  #pragma unroll
  for(int d0=0;d0<2;++d0){s16x4 lo[4],hi[4];
    #pragma unroll
    for(int ks=0;ks<4;++ks){
      asm volatile("ds_read_b64_tr_b16 %0,%1 offset:%c2":"=&v"(lo[ks]):"v"(vb),"i"(d0*4096+ks*1024):"memory");
      asm volatile("ds_read_b64_tr_b16 %0,%1 offset:%c2":"=&v"(hi[ks]):"v"(vb),"i"(d0*4096+ks*1024+512):"memory");}
    asm volatile("s_waitcnt lgkmcnt(0)":::"memory");SBAR();
    #define PK(k) (bf16x8){lo[k][0],lo[k][1],lo[k][2],lo[k][3],hi[k][0],hi[k][1],hi[k][2],hi[k][3]}
    o[d0]=__builtin_amdgcn_mfma_f32_32x32x16_bf16(pa0,PK(0),o[d0],0,0,0);
    o[d0]=__builtin_amdgcn_mfma_f32_32x32x16_bf16(pa1,PK(1),o[d0],0,0,0);
    o[d0]=__builtin_amdgcn_mfma_f32_32x32x16_bf16(pa2,PK(2),o[d0],0,0,0);
    o[d0]=__builtin_amdgcn_mfma_f32_32x32x16_bf16(pa3,PK(3),o[d0],0,0,0);
    #undef PK
  }
}

#ifndef ATTN_STORE16
#define ATTN_STORE16(p,v) (*(u32x4*)(p)=(v))
#endif
template<int THRL> __device__ __forceinline__ void attn_unit(int qb,int SEQ,const bf16*Q,int QP,const bf16*__restrict__ K,const bf16*__restrict__ V,int KP,bf16*O,int OP,char*shm){
  int tid_=threadIdx.x; asm volatile("":"+v"(tid_)); const int tid=tid_,lane=tid&63,r32=lane&31,hi=lane>>5; const int wid=__builtin_amdgcn_readfirstlane(tid>>6);
  const int q0=qb*QB;
  const bf16*Qw=Q+(long)(q0+wid*QBLK)*QP;
  const bf16*Kh=K,*Vh=V;
  const unsigned lds0=(unsigned)(uintptr_t)shm;
  float*wsf=(float*)(shm+LDS_WS)+wid*64;
  const bf16*ksrc=Kh+(long)lane*KP+wid*8;
  const bf16*vsrc=Vh+(long)(16*(wid&3)+(lane>>2))*KP+(wid>>2)*32+(lane&3)*8;
  const unsigned kdst=lds0+LDS_K+wid*1024, vdst=lds0+LDS_V+wid*1024;
  #define DMA_K(t,slot) glds16(ksrc+(long)(t)*KVBLK*KP,(unsigned)__builtin_amdgcn_readfirstlane(kdst+(slot)))
  #define DMA_V(t,slot) glds16(vsrc+(long)(t)*KVBLK*KP,(unsigned)__builtin_amdgcn_readfirstlane(vdst+(slot)))
  const int vb0=(int)(lds0+LDS_V)+((lane>>4)&1)*32+(lane&3)*8+(4*hi+((lane&15)>>2))*64;
  const char*Kbase=shm+LDS_K; bf16x8 kf[8];
  const lds_cptr shm3=(lds_cptr)shm; const lds_cptr kp0=shm3+LDS_K+hi*1024+r32*16; const lds_cptr vp0=shm3+LDS_V+((lane>>4)&1)*32+(lane&3)*8+(4*hi+((lane&15)>>2))*64;
  const int NT=SEQ/KVBLK;
  DMA_K(0,0);DMA_V(0,0);DMA_K(1,SLOTB);
  bf16x8 qr[4];
  #pragma unroll
  for(int d0=0;d0<4;++d0)qr[d0]=*reinterpret_cast<const bf16x8*>(&Qw[(long)r32*QP+d0*16+hi*8]);
  float mhat=0.f,l_reg=0.f;f32x16 o[2];o[0]=f32x16{};o[1]=f32x16{};f32x16 negm=f32x16{};asm volatile("":"+v"(negm));
  const int qrel=wid*QBLK+r32;
  #define CMASK(P0,P1,t) do{}while(0)
  bool resc=false;
  #define START(P0,P1) do{ const float rm=rowmax(P0,P1); resc=false; \
    { const float dl=rm; mhat=fadd_s(mhat,dl); \
      _Pragma("unroll") for(int r=0;r<16;++r){P0[r]=fsub_s(P0[r],dl);P1[r]=fsub_s(P1[r],dl);} \
      _Pragma("unroll") for(int r=0;r<16;++r)negm[r]=-mhat; asm volatile("":"+v"(negm)); } \
    _Pragma("unroll") for(int r=0;r<16;++r)P0[r]=__builtin_amdgcn_exp2f(P0[r]); }while(0)
  #define RESC() do{ if(resc){ asm volatile("s_waitcnt lgkmcnt(0)":::"memory"); \
      _Pragma("unroll") for(int d_=0;d_<2;++d_) _Pragma("unroll") for(int r=0;r<16;++r)o[d_][r]*=wsf[crow(r,hi)]; } }while(0)
  f32x16 pA0,pA1,pB0,pB1;
  int sl_prev=0,sl_cur=0,sl_next=SLOTB;
  #define ROT() do{sl_prev=sl_cur;sl_cur=sl_next;sl_next=(sl_next==(NSLOT-1)*SLOTB)?0:sl_next+SLOTB;}while(0)
  DMA_K(2,2*SLOTB);
  WAIT_BAR(3);
  qkt(pA0,pA1,Kbase,qr,negm,r32,hi);asm volatile("s_nop 15\n\ts_nop 7":"+v"(pA0),"+v"(pA1));CMASK(pA0,pA1,0);
  START(pA0,pA1);
  _Pragma("unroll") for(int r=0;r<16;++r)pA1[r]=__builtin_amdgcn_exp2f(pA1[r]);
  WAIT_BAR(0);
  DMA_K(3,0);DMA_V(1,SLOTB);
  ROT();
  kload8(kf,kp0+sl_cur);
  WAIT_BAR(2);
  s16x4 vlo[8],vhi[8]; u32x4 pw0,pw1,pw2,pw3;
  #define PKW(P,B) cvtpk_s(P[B],P[B+1])
  #define PAF(k) __builtin_bit_cast(bf16x8,pw##k)
  #define VFR(i) (bf16x8){vlo[i][0],vlo[i][1],vlo[i][2],vlo[i][3],vhi[i][0],vhi[i][1],vhi[i][2],vhi[i][3]}
  #define PIN(x) asm volatile("":"+v"(x))
  #define MX3(a,b,c) __builtin_fmaxf(__builtin_fmaxf((a),(b)),(c))
  #define GAPA(MF,A0,A1,A2,A3,W0,W1,PW) do{ MF; sacc+=A0; sacc+=A1; sacc+=A2; sacc+=A3; PIN(sacc); W0; W1; PIN(PW); SBAR(); }while(0)
  #define EX(v) __builtin_amdgcn_exp2f(v)
  #define GAPB(MF,X,B) do{ MF; X[B]=EX(X[B]); X[B+1]=EX(X[B+1]); X[B+2]=EX(X[B+2]); X[B+3]=EX(X[B+3]); PIN(X); SBAR(); }while(0)
  #define VRD(i) do{ vlo[i]=vtr(vp_+(((i)>>2)*4096+((i)&3)*1024)); vhi[i]=vtr(vp_+(((i)>>2)*4096+((i)&3)*1024+512)); }while(0)
  #define KRD(G,j) do{ if(G){ kload2(kf,kp0+sl_next,j); SBAR(); } }while(0)
  #define STEP(C0,C1,P0,P1,t,GK,GV,GL) do{ SBAR(); \
    const lds_cptr vp_=vp0+sl_prev; \
    VRD(0); SBAR(); float sacc=(P0[0]+P0[1]); \
    GAPA(C0=__builtin_amdgcn_mfma_f32_32x32x16_bf16(kf[0],qr[0],negm,0,0,0), P0[2],P0[3],P0[4],P0[5],     pw0[0]=PKW(P0,0), pw0[1]=PKW(P0,2), pw0); \
    VRD(4); SBAR(); GAPA(C1=__builtin_amdgcn_mfma_f32_32x32x16_bf16(kf[1],qr[0],negm,0,0,0), P0[6],P0[7],P0[8],P0[9],     pw0[2]=PKW(P0,4), pw0[3]=PKW(P0,6), pw0); \
    VRD(1); SBAR(); GAPA(C0=__builtin_amdgcn_mfma_f32_32x32x16_bf16(kf[2],qr[1],C0,0,0,0),   P0[10],P0[11],P0[12],P0[13], pw1[0]=PKW(P0,8), pw1[1]=PKW(P0,10), pw1); \
    VRD(5); SBAR(); GAPA(C1=__builtin_amdgcn_mfma_f32_32x32x16_bf16(kf[3],qr[1],C1,0,0,0),   P0[14],P0[15],P1[0],P1[1],   pw1[2]=PKW(P0,12),pw1[3]=PKW(P0,14), pw1); \
    VRD(2); SBAR(); GAPA(C0=__builtin_amdgcn_mfma_f32_32x32x16_bf16(kf[4],qr[2],C0,0,0,0),   P1[2],P1[3],P1[4],P1[5],     pw2[0]=PKW(P1,0), pw2[1]=PKW(P1,2), pw2); \
    VRD(6); SBAR(); GAPA(C1=__builtin_amdgcn_mfma_f32_32x32x16_bf16(kf[5],qr[2],C1,0,0,0),   P1[6],P1[7],P1[8],P1[9],     pw2[2]=PKW(P1,4), pw2[3]=PKW(P1,6), pw2); \
    VRD(3); SBAR(); GAPA(C0=__builtin_amdgcn_mfma_f32_32x32x16_bf16(kf[6],qr[3],C0,0,0,0),   P1[10],P1[11],P1[12],P1[13], pw3[0]=PKW(P1,8), pw3[1]=PKW(P1,10), pw3); \
    VRD(7); SBAR(); GAPA(C1=__builtin_amdgcn_mfma_f32_32x32x16_bf16(kf[7],qr[3],C1,0,0,0),   P1[14],P1[15],0.f,0.f,       pw3[2]=PKW(P1,12),pw3[3]=PKW(P1,14), pw3); \
    l_reg+=sacc; \
    if(GK){DMA_K((t)+3,sl_cur);} if(GV){DMA_V((t)+1,sl_next);} \
    CMASK(C0,C1,t); \
    { float a=MX3(C0[0],C0[1],C1[0]),b=MX3(C0[2],C0[3],C1[1]); a=MX3(a,C1[2],C1[3]); \
      _Pragma("unroll") for(int r=4;r<16;r+=4){a=MX3(a,C0[r],C0[r+1]);b=MX3(b,C0[r+2],C0[r+3]);a=MX3(a,C1[r],C1[r+1]);b=MX3(b,C1[r+2],C1[r+3]);} \
      float rm=__builtin_fmaxf(a,b); { auto rr=__builtin_amdgcn_permlane32_swap(__float_as_uint(rm),__float_as_uint(rm),false,false); rm=__builtin_fmaxf(__uint_as_float(rr[0]),__uint_as_float(rr[1])); } \
      resc=false; \
      if(__builtin_expect(__any(rm>(float)THRL),0)){ const float dl=__builtin_fmaxf(rm,0.f); mhat+=dl; \
        _Pragma("unroll") for(int r=0;r<16;++r){C0[r]-=dl;C1[r]-=dl;} \
        _Pragma("unroll") for(int r=0;r<16;++r)negm[r]=-mhat; asm volatile("":"+v"(negm)); \
        const float f=__builtin_amdgcn_exp2f(-dl); l_reg*=f; if(hi==0)wsf[r32]=f; resc=true; } } \
    SBAR(); \
    GAPB(o[0]=__builtin_amdgcn_mfma_f32_32x32x16_bf16(PAF(0),VFR(0),o[0],0,0,0), C0,0); \
    GAPB(o[1]=__builtin_amdgcn_mfma_f32_32x32x16_bf16(PAF(0),VFR(4),o[1],0,0,0), C0,4); \
    KRD(GL,0); GAPB(o[0]=__builtin_amdgcn_mfma_f32_32x32x16_bf16(PAF(1),VFR(1),o[0],0,0,0), C0,8); \
    KRD(GL,1); GAPB(o[1]=__builtin_amdgcn_mfma_f32_32x32x16_bf16(PAF(1),VFR(5),o[1],0,0,0), C0,12); \
    KRD(GL,2); GAPB(o[0]=__builtin_amdgcn_mfma_f32_32x32x16_bf16(PAF(2),VFR(2),o[0],0,0,0), C1,0); \
    KRD(GL,3); GAPB(o[1]=__builtin_amdgcn_mfma_f32_32x32x16_bf16(PAF(2),VFR(6),o[1],0,0,0), C1,4); \
    GAPB(o[0]=__builtin_amdgcn_mfma_f32_32x32x16_bf16(PAF(3),VFR(3),o[0],0,0,0), C1,8); \
    GAPB(o[1]=__builtin_amdgcn_mfma_f32_32x32x16_bf16(PAF(3),VFR(7),o[1],0,0,0), C1,12); \
    }while(0)
  int t=1;
  #undef CMASK
  #define CMASK(P0,P1,t) do{}while(0)
  for(;t+5<NT;t+=2){
    STEP(pB0,pB1,pA0,pA1,t,true,true,true);     WAIT_BAR(2); RESC(); ROT();
    STEP(pA0,pA1,pB0,pB1,t+1,true,true,true);   WAIT_BAR(2); RESC(); ROT();
  }
  #undef CMASK
  #define CMASK(P0,P1,t) do{}while(0)
  #define ENDW(tt) do{ if((tt)+3<NT){WAIT_BAR(2);} else if((tt)+2<NT){WAIT_BAR(1);} else {WAIT_BAR(0);} }while(0)
  for(;t+1<NT;t+=2){
    STEP(pB0,pB1,pA0,pA1,t,(t+3<NT),(t+1<NT),(t+1<NT));       ENDW(t);   RESC(); ROT();
    STEP(pA0,pA1,pB0,pB1,t+1,(t+4<NT),(t+2<NT),(t+2<NT));     ENDW(t+1); RESC(); ROT();
  }
  STEP(pB0,pB1,pA0,pA1,NT-1,false,false,false); RESC();
  { float sacc=pB0[0]+pB0[1]; _Pragma("unroll") for(int r=2;r<16;++r)sacc+=pB0[r]; _Pragma("unroll") for(int r=0;r<16;++r)sacc+=pB1[r]; l_reg+=sacc;
    pw0=(u32x4){PKW(pB0,0),PKW(pB0,2),PKW(pB0,4),PKW(pB0,6)};pw1=(u32x4){PKW(pB0,8),PKW(pB0,10),PKW(pB0,12),PKW(pB0,14)};pw2=(u32x4){PKW(pB1,0),PKW(pB1,2),PKW(pB1,4),PKW(pB1,6)};pw3=(u32x4){PKW(pB1,8),PKW(pB1,10),PKW(pB1,12),PKW(pB1,14)};
    SBAR(); pv(o,vb0+sl_cur,PAF(0),PAF(1),PAF(2),PAF(3)); }
  #undef PKW
  #undef PAF
  #undef VFR
  #undef PIN
  #undef MX3
  #undef GAPA
  #undef GAPB
  #undef EX
  #undef VRD
  #undef KRD
  #undef STEP
  #undef ENDW
  {auto rr=__builtin_amdgcn_permlane32_swap(__float_as_uint(l_reg),__float_as_uint(l_reg),false,false);l_reg=__uint_as_float(rr[0])+__uint_as_float(rr[1]);}
  if(hi==0)wsf[32+r32]=l_reg;asm volatile("s_waitcnt lgkmcnt(0)":::"memory");
  float rli[16];
  #pragma unroll
  for(int r=0;r<16;++r)rli[r]=__builtin_amdgcn_rcpf(wsf[32+crow(r,hi)]);
  bf16*Ow=O+(long)(q0+wid*QBLK)*OP;
  { bf16*stg=(bf16*)(shm+LDS_OST)+wid*2048;
    #pragma unroll
    for(int r=0;r<16;++r){const int orow=crow(r,hi);
      #pragma unroll
      for(int d0=0;d0<2;++d0)stg[orow*64+d0*32+r32]=__float2bfloat16(o[d0][r]*rli[r]);}
    asm volatile("s_waitcnt lgkmcnt(0)":::"memory");
    #pragma unroll
    for(int i=0;i<4;++i){const int row=i*8+(lane>>3),ch=lane&7; const u32x4 v=*(const u32x4*)(stg+row*64+ch*8); ATTN_STORE16(Ow+(long)row*OP+ch*8,v);} }
  asm volatile("s_waitcnt lgkmcnt(0)\n\ts_barrier":::"memory");
  #undef DMA_K
  #undef DMA_V
  #undef CMASK
  #undef START
  #undef RESC
  #undef ROT
}
constexpr int ATTN_LDS_BYTES=LDS_BYTES;
#undef SBAR
#undef WAIT_BAR
}
namespace xb {
#define GAS __attribute__((address_space(1)))
#define LAS __attribute__((address_space(3)))
typedef GAS unsigned gu32;
typedef GAS unsigned long long gu64;
#define RLX_AGENT __ATOMIC_RELAXED, __HIP_MEMORY_SCOPE_AGENT
#define LDS_WAIT() asm volatile("s_waitcnt lgkmcnt(0)" ::: "memory")
#define VM_WAIT() asm volatile("s_waitcnt vmcnt(0)" ::: "memory")
__device__ __forceinline__ unsigned long long rt() { return __builtin_amdgcn_s_memrealtime(); }
__device__ __forceinline__ unsigned f2bf(float f) { unsigned u = __builtin_bit_cast(unsigned, f); return (u + 0x7fffu + ((u >> 16) & 1u)) >> 16; }
__device__ __forceinline__ unsigned pk2(float lo, float hi) { return f2bf(lo) | (f2bf(hi) << 16); }

#define XB_TMO      128
#define XB_XCNT(j)  (256  + 64 * (j))
#define XB_XSUB(j)  (1280 + 64 * (j))
#define XB_XGEN(j)  (2304 + 64 * (j))
#define XB_TOP      3328
#define XB_TOPGEN   3392
#define XCD_BAR_WORDS 3456
#define XB_SPIN_CAP (1u << 18)

__device__ __forceinline__ unsigned xb_ld(unsigned* p)              { return __hip_atomic_load(p, __ATOMIC_RELAXED, __HIP_MEMORY_SCOPE_AGENT); }
__device__ __forceinline__ unsigned xb_add(unsigned* p, unsigned v) { return __hip_atomic_fetch_add(p, v, __ATOMIC_RELAXED, __HIP_MEMORY_SCOPE_AGENT); }
__device__ __forceinline__ unsigned xb_xcc_id() { return (unsigned)__builtin_amdgcn_s_getreg((3 << 11) | 20) & 0xFu; }
#define XB_SPIN(cond, bar) do { unsigned _sp = 0; while (cond) { __builtin_amdgcn_s_sleep(1); \
    if ((++_sp & 255u) == 0u) { if (xb_ld(&(bar)[XB_TMO])) break; if (_sp > XB_SPIN_CAP) { atomicAdd(&(bar)[XB_TMO], 1u); break; } } } } while (0)

struct XcdBarrier {
    unsigned* bar; unsigned x;
    volatile LAS unsigned* st;
};

__device__ __forceinline__ XcdBarrier xcd_barrier_post(unsigned* bar, volatile LAS unsigned* st) {
    XcdBarrier b; b.bar = bar; b.x = xb_xcc_id(); b.st = st;
    if (threadIdx.x == 0) (void)xb_add(&bar[XB_XCNT(b.x)], 1u);
    return b;
}
__device__ __forceinline__ void xcd_barrier_complete(unsigned* bar, unsigned x, unsigned& nloc, unsigned& nx) {
    const unsigned G = gridDim.x * gridDim.y * gridDim.z;
    unsigned sum, cnt, mine, sp = 0u;
    for (;;) {
        sum = 0u; cnt = 0u; mine = 0u;
#pragma unroll
        for (unsigned j = 0; j < 16; ++j) { const unsigned c = xb_ld(&bar[XB_XCNT(j)]); sum += c; cnt += (c > 0u) ? 1u : 0u; mine = (j == x) ? c : mine; }
        if (sum == G) break;
        __builtin_amdgcn_s_sleep(1);
        if ((++sp & 255u) == 0u) { if (xb_ld(&bar[XB_TMO])) break; if (sp > XB_SPIN_CAP) { atomicAdd(&bar[XB_TMO], 1u); break; } }
    }
    nloc = mine > 0u ? mine : 1u; nx = cnt > 0u ? cnt : 1u;
}

__device__ __forceinline__ void xcd_barrier(const XcdBarrier& b) {
    asm volatile("s_waitcnt vmcnt(0)" ::: "memory");
    __syncthreads();
    if (threadIdx.x == 0) {
        unsigned* bar = b.bar;
        __builtin_amdgcn_s_waitcnt(0);
        unsigned nloc = b.st[0], nx = b.st[1];
        if (nloc == 0u) { xcd_barrier_complete(bar, b.x, nloc, nx); b.st[0] = nloc; b.st[1] = nx; }
        const unsigned old = xb_add(&bar[XB_XSUB(b.x)], 1u);
        const unsigned gen = old / nloc;
        if (old + 1u == (gen + 1u) * nloc) {
            __builtin_amdgcn_fence(__ATOMIC_RELEASE, "agent");
            asm volatile("s_waitcnt vmcnt(0)" ::: "memory");
            const unsigned og = xb_add(&bar[XB_TOP], 1u);
            const unsigned tg = og / nx;
            if (og + 1u == (tg + 1u) * nx) xb_add(&bar[XB_TOPGEN], 1u);
            else XB_SPIN(xb_ld(&bar[XB_TOPGEN]) == tg, bar);
            __builtin_amdgcn_fence(__ATOMIC_ACQUIRE, "agent");
            xb_add(&bar[XB_XGEN(b.x)], 1u);
            asm volatile("s_waitcnt vmcnt(0)" ::: "memory");
        } else {
            XB_SPIN(xb_ld(&bar[XB_XGEN(b.x)]) == gen, bar);
            __builtin_amdgcn_fence(__ATOMIC_ACQUIRE, "agent");
            asm volatile("s_waitcnt vmcnt(0)" ::: "memory");
        }
    }
    __syncthreads();
}

}

namespace mk {
typedef unsigned short bf16_t;
typedef short bf16x8 __attribute__((ext_vector_type(8)));
typedef float f32x4 __attribute__((ext_vector_type(4)));
typedef unsigned u32x4 __attribute__((ext_vector_type(4)));
typedef unsigned u32x2 __attribute__((ext_vector_type(2)));
typedef float f32x2 __attribute__((ext_vector_type(2)));

constexpr int DMODEL = 1024, TS = 16384, NSEG = 4, DFF = 4096;
constexpr int EIN = 1792, OIN = 4368, OINP = 4608, OOUT = 768;
constexpr float EPS = 1e-6f;
constexpr size_t MiB = (size_t)1 << 20;
constexpr size_t WS_W1T = 1 * MiB, WS_W2T = 33 * MiB, WS_WINE = 65 * MiB, WS_WOUTE = 72 * MiB, WS_WINO = 76 * MiB, WS_WOUTO = 94 * MiB,
                 WS_GW = 97 * MiB, WS_H = 98 * MiB, WS_PROJ = 130 * MiB, WS_SCR = 274 * MiB, WS_END = 512 * MiB;
constexpr size_t SC_HID = 0;
constexpr size_t SC_LA = 0, SC_UU = 64 * MiB, SC_AGG = 128 * MiB;
constexpr size_t SC_QKVP = 0, SC_DNI = 48 * MiB, SC_OB = 192 * MiB, SC_LSE = 224 * MiB, SC_EGL = 225 * MiB;
constexpr int DNI_BYTES = 73728, DNI_W = 0, DNI_QT = 16384, DNI_KTT = 32768, DNI_A = 49152, DNI_U = 57344;
constexpr int LDS_BYTES = 147456;
constexpr int NT = 512, NW = 8;

struct Params { const float* in[25]; float* out; unsigned char* ws; };

__device__ __forceinline__ float bf2f(bf16_t v) { return __uint_as_float(((unsigned)v) << 16); }
__device__ __forceinline__ unsigned f2bf(float f) { unsigned u = __float_as_uint(f); return (u + 0x7fffu + ((u >> 16) & 1u)) >> 16; }
__device__ __forceinline__ unsigned pk2(float lo, float hi) { return f2bf(lo) | (f2bf(hi) << 16); }
__device__ __forceinline__ float wave_sum(float v) {
#pragma unroll
    for (int o = 1; o < 64; o <<= 1) v += __shfl_xor(v, o);
    return v;
}
__device__ __forceinline__ float sigm(float x) { return 1.f / (1.f + __expf(-x)); }
__device__ __forceinline__ float softplus(float x) { return x > 20.f ? x : log1pf(__expf(x)); }
__device__ __forceinline__ float silu(float x) { return x * sigm(x); }
__device__ __forceinline__ float gelu_tanh(float x) { const float t = 0.7978845608028654f * (x + 0.044715f * x * x * x); return 0.5f * x * (1.f + tanhf(t)); }
__device__ __forceinline__ void unpack8(const u32x4 v, float* f) {
    f[0] = __uint_as_float(v.x << 16); f[1] = __uint_as_float(v.x & 0xffff0000u); f[2] = __uint_as_float(v.y << 16); f[3] = __uint_as_float(v.y & 0xffff0000u);
    f[4] = __uint_as_float(v.z << 16); f[5] = __uint_as_float(v.z & 0xffff0000u); f[6] = __uint_as_float(v.w << 16); f[7] = __uint_as_float(v.w & 0xffff0000u);
}
#define MK_IDS() int tid = threadIdx.x; asm volatile("" : "+v"(tid)); const int lane = tid & 63, wave = __builtin_amdgcn_readfirstlane(tid >> 6); const int gw = blockIdx.x * NW + wave, NGW = gridDim.x * NW; (void)lane; (void)wave; (void)gw; (void)NGW
#define MFMA16(a, b, c) __builtin_amdgcn_mfma_f32_16x16x32_bf16((a), (b), (c), 0, 0, 0)

__device__ __forceinline__ void transpose_item(const float* W, int K, int Nsrc, int Npad, bf16_t* WT, float* scr, int item, int lane, const float* gain = nullptr) {
    const int nblk = Npad / 32, kb = item / nblk, nb = item % nblk, k0 = 64 * kb, n0 = 32 * nb;
    const int n = n0 + (lane & 31);
#pragma unroll 8
    for (int i = 0; i < 32; ++i) { const int kk = 2 * i + (lane >> 5); scr[kk * 33 + (lane & 31)] = (n < Nsrc) ? W[(size_t)(k0 + kk) * Nsrc + n] * (gain ? gain[k0 + kk] : 1.f) : 0.f; }
    asm volatile("s_waitcnt lgkmcnt(0)" ::: "memory");
    const int c = lane & 7;
#pragma unroll
    for (int j = 0; j < 4; ++j) { const int nn = (lane >> 3) + 8 * j; const float* s = scr + (8 * c) * 33 + nn;
        u32x4 o; o.x = pk2(s[0 * 33], s[1 * 33]); o.y = pk2(s[2 * 33], s[3 * 33]); o.z = pk2(s[4 * 33], s[5 * 33]); o.w = pk2(s[6 * 33], s[7 * 33]);
        *(u32x4*)(WT + (size_t)(n0 + nn) * K + k0 + 8 * c) = o; }
    asm volatile("s_waitcnt lgkmcnt(0)" ::: "memory");
}
__device__ __forceinline__ void phase_prologue(const Params& p, char* lds) {
    MK_IDS();
    float* scr = (float*)(lds + wave * 16384);
    unsigned char* ws = p.ws;
    constexpr int I_F1 = 16 * 128, I_F2 = 64 * 32, I_IE = 16 * 56, I_OE = 16 * 32, I_IO = 16 * 144, I_OO = 12 * 32;
    constexpr int T_F1 = 4 * I_F1, T_F2 = T_F1 + 4 * I_F2, T_IE = T_F2 + 2 * I_IE, T_OE = T_IE + 2 * I_OE, T_IO = T_OE + 2 * I_IO, T_OO = T_IO + 2 * I_OO;
    for (int it = gw; it < T_OO; it += NGW) {
        if (it < T_F1) { const int l = it / I_F1, r = it % I_F1; transpose_item(p.in[6] + (size_t)l * 1024 * 4096, 1024, 4096, 4096, (bf16_t*)(ws + WS_W1T) + (size_t)l * 4096 * 1024, scr, r, lane, p.in[4] + l * 1024); }
        else if (it < T_F2) { const int q = it - T_F1, l = q / I_F2, r = q % I_F2; transpose_item(p.in[7] + (size_t)l * 4096 * 1024, 4096, 1024, 1024, (bf16_t*)(ws + WS_W2T) + (size_t)l * 1024 * 4096, scr, r, lane); }
        else if (it < T_IE) { const int q = it - T_F2, l = q / I_IE, r = q % I_IE; transpose_item(p.in[8] + (size_t)l * 1024 * EIN, 1024, EIN, EIN, (bf16_t*)(ws + WS_WINE) + (size_t)l * EIN * 1024, scr, r, lane, p.in[3] + (2 * l) * 1024); }
        else if (it < T_OE) { const int q = it - T_IE, l = q / I_OE, r = q % I_OE; transpose_item(p.in[9] + (size_t)l * 1024 * 1024, 1024, 1024, 1024, (bf16_t*)(ws + WS_WOUTE) + (size_t)l * 1024 * 1024, scr, r, lane); }
        else if (it < T_IO) { const int q = it - T_OE, l = q / I_IO, r = q % I_IO; transpose_item(p.in[19] + (size_t)l * 1024 * OIN, 1024, OIN, OINP, (bf16_t*)(ws + WS_WINO) + (size_t)l * OINP * 1024, scr, r, lane, p.in[3] + (2 * l + 1) * 1024); }
        else { const int q = it - T_IO, l = q / I_OO, r = q % I_OO; transpose_item(p.in[20] + (size_t)l * OOUT * 1024, OOUT, 1024, 1024, (bf16_t*)(ws + WS_WOUTO) + (size_t)l * 1024 * OOUT, scr, r, lane); }
    }
    bf16_t* GW = (bf16_t*)(ws + WS_GW);
    const int gt = gw * 64 + lane, NGT = NGW * 64;
    for (int idx = gt; idx < 2 * 2 * 2 * 8 * 4096; idx += NGT) {
        const int d = idx & 63, e = (idx >> 6) & 63, blk = (idx >> 12) & 7, gate = (idx >> 15) & 1, dir = (idx >> 16) & 1, j = (idx >> 17) & 1;
        const float* src = gate ? p.in[16] : p.in[14];
        GW[idx] = (bf16_t)f2bf(src[((((size_t)j * 2 + dir) * 8 + blk) * 64 + d) * 64 + e]);
    }
}

__device__ __forceinline__ void phase_x0(const float* x, bf16_t* xb, float* ssq) {
    MK_IDS();
    for (int m = gw; m < TS; m += NGW) {
        const f32x4* xr = (const f32x4*)(x + (size_t)m * DMODEL) + lane;
        f32x4 v[4]; float s = 0.f;
#pragma unroll
        for (int j = 0; j < 4; ++j) { v[j] = xr[64 * j]; s += (v[j].x * v[j].x + v[j].y * v[j].y) + (v[j].z * v[j].z + v[j].w * v[j].w); }
        s = wave_sum(s);
        u32x2* o8 = (u32x2*)(xb + (size_t)m * DMODEL) + lane;
#pragma unroll
        for (int j = 0; j < 4; ++j) { u32x2 o; o.x = pk2(v[j].x, v[j].y); o.y = pk2(v[j].z, v[j].w); o8[64 * j] = o; }
        if (lane < 16) ssq[(size_t)m * 16 + lane] = lane == 0 ? s : 0.f;
    }
}
__device__ __forceinline__ void zero_f32(float* ptr, int n) {
    MK_IDS();
    for (int i = gw * 64 + lane; i < n; i += NGW * 64) ptr[i] = 0.f;
}
__device__ __forceinline__ void phase_rmsnorm_final(const bf16_t* xb, float* x, const float* g) {
    MK_IDS();
    for (int m = gw; m < TS; m += NGW) {
        const u32x2* xr = (const u32x2*)(xb + (size_t)m * DMODEL) + lane; f32x4* xw = (f32x4*)(x + (size_t)m * DMODEL) + lane; const f32x4* gr = (const f32x4*)g + lane;
        f32x4 v[4]; float s = 0.f;
#pragma unroll
        for (int j = 0; j < 4; ++j) { const u32x2 w = xr[64 * j]; v[j] = (f32x4){__uint_as_float(w.x << 16), __uint_as_float(w.x & 0xffff0000u), __uint_as_float(w.y << 16), __uint_as_float(w.y & 0xffff0000u)};
            s += (v[j].x * v[j].x + v[j].y * v[j].y) + (v[j].z * v[j].z + v[j].w * v[j].w); }
        const float rstd = 1.f / sqrtf(wave_sum(s) * (1.f / DMODEL) + EPS);
#pragma unroll
        for (int j = 0; j < 4; ++j) { const f32x4 gg = gr[64 * j]; xw[64 * j] = v[j] * rstd * gg; }
    }
}
struct EpiRes {
    static constexpr bool PERM = true, AFTER_DRAIN = false;
    bf16_t* xb; float* ssq; int ldc;
    __device__ __forceinline__ void operator()(const pg8::f32x4 (&acc)[2][2][4][2], const pg8::Unit& u, int wr, int wc, int fr, int fq) const {
        const int col0 = u.pn * pg8::BM + wc * 32 + 8 * fq;
#pragma unroll
        for (int ai = 0; ai < 2; ++ai)
#pragma unroll
            for (int m = 0; m < 4; ++m) { const int row = u.pm * pg8::BM + ai * pg8::HALF + wr * 64 + m * 16 + fr; const size_t off = (size_t)row * ldc + col0; float sq = 0.f;
                u32x4 bw[2];
#pragma unroll
                for (int bj = 0; bj < 2; ++bj) bw[bj] = *(const u32x4*)(xb + off + bj * pg8::HALF);
#pragma unroll
                for (int bj = 0; bj < 2; ++bj) { float b[8]; unpack8(bw[bj], b); const pg8::f32x4 a0 = acc[ai][bj][m][0], a1 = acc[ai][bj][m][1];
                    const float o0 = b[0] + a0[0], o1 = b[1] + a0[1], o2 = b[2] + a0[2], o3 = b[3] + a0[3], o4 = b[4] + a1[0], o5 = b[5] + a1[1], o6 = b[6] + a1[2], o7 = b[7] + a1[3];
                    u32x4 w; w.x = pg8::cvt_pk_bf16(o0, o1); w.y = pg8::cvt_pk_bf16(o2, o3); w.z = pg8::cvt_pk_bf16(o4, o5); w.w = pg8::cvt_pk_bf16(o6, o7);
                    *(u32x4*)(xb + off + bj * pg8::HALF) = w;
                    sq += ((o0 * o0 + o1 * o1) + (o2 * o2 + o3 * o3)) + ((o4 * o4 + o5 * o5) + (o6 * o6 + o7 * o7)); }
                sq += __shfl_xor(sq, 16); sq += __shfl_xor(sq, 32);
                if (fq == 0) ssq[(size_t)row * 16 + u.pn * 4 + wc] = sq;
                if (m & 1) asm volatile("" ::: "memory"); }
    }
};

__device__ __forceinline__ void even_qk_post(bf16_t* proj, const float* qg, const float* kg, int S) {
    MK_IDS();
    const int g = lane & 7, axis = g >> 2, half = (g >> 1) & 1;
    float inv[8], gq[8], gk[8];
#pragma unroll
    for (int e = 0; e < 8; ++e) { inv[e] = exp2f(-(float)((g & 1) * 8 + e) * (13.287712379549449f / 16.f)); gq[e] = qg[g * 8 + e] * attn_body::C2; gk[e] = kg[g * 8 + e]; }
    for (int t = gw; t < TS; t += NGW) {
        const int s = t % S; const float pos = (float)(axis ? (s & 63) : (s >> 6));
        bf16_t* row = proj + (size_t)t * EIN;
        const u32x4 qa = *(const u32x4*)(row + lane * 8); u32x4 ka = {0u, 0u, 0u, 0u}; if (lane < 16) ka = *(const u32x4*)(row + 512 + lane * 8);
        float cs[8], sn[8];
#pragma unroll
        for (int e = 0; e < 8; ++e) { const float ang = pos * inv[e]; cs[e] = __cosf(ang); sn[e] = __sinf(ang); }
        float xq[8], xk[8]; unpack8(qa, xq); unpack8(ka, xk);
        float sq = 0.f, sk = 0.f;
#pragma unroll
        for (int e = 0; e < 8; ++e) { sq += xq[e] * xq[e]; sk += xk[e] * xk[e]; }
        sq += __shfl_xor(sq, 1); sq += __shfl_xor(sq, 2); sq += __shfl_xor(sq, 4);
        sk += __shfl_xor(sk, 1); sk += __shfl_xor(sk, 2); sk += __shfl_xor(sk, 4);
        const float rq = 1.f / sqrtf(sq * (1.f / 64.f) + EPS), rk = 1.f / sqrtf(sk * (1.f / 64.f) + EPS);
        float oq[8], ok[8];
#pragma unroll
        for (int e = 0; e < 8; ++e) { const float yq = xq[e] * rq * gq[e], yk = xk[e] * rk * gk[e];
            const float pq = __shfl_xor(yq, 2), pk = __shfl_xor(yk, 2);
            oq[e] = yq * cs[e] + (half ? pq : -pq) * sn[e]; ok[e] = yk * cs[e] + (half ? pk : -pk) * sn[e]; }
        u32x4 o; o.x = pk2(oq[0], oq[1]); o.y = pk2(oq[2], oq[3]); o.z = pk2(oq[4], oq[5]); o.w = pk2(oq[6], oq[7]);
        *(u32x4*)(row + lane * 8) = o;
        if (lane < 16) { u32x4 o2; o2.x = pk2(ok[0], ok[1]); o2.y = pk2(ok[2], ok[3]); o2.z = pk2(ok[4], ok[5]); o2.w = pk2(ok[6], ok[7]); *(u32x4*)(row + 512 + lane * 8) = o2; }
    }
}
__device__ __forceinline__ void even_lru_prep(const bf16_t* proj, const float* cw, const float* cb, const bf16_t* GWj, const float* br, const float* bi, const float* lam,
                                              unsigned* LU, f32x2* AGG, int S, char* lds) {
    MK_IDS();
    constexpr int XST = 1040;
    for (int tile = blockIdx.x; tile < TS / 64; tile += gridDim.x) {
        const int t0 = tile * 64;
        __syncthreads();
#pragma unroll 2
        for (int k = 0; k < 8; ++k) {
            const int idx = tid + k * NT, i = idx >> 6, cgp = idx & 63, t = t0 + i, s = t % S, ch = cgp * 8;
            float acc[8];
#pragma unroll
            for (int e = 0; e < 8; ++e) acc[e] = cb[ch + e];
#pragma unroll
            for (int j = 0; j < 4; ++j) { const int sp = s + j - 2;
                if (sp >= 0 && sp < S) { const u32x4 v = *(const u32x4*)(proj + (size_t)(t + j - 2) * EIN + 768 + ch); float xv[8]; unpack8(v, xv);
#pragma unroll
                    for (int e = 0; e < 8; ++e) acc[e] += cw[j * 512 + ch + e] * xv[e]; } }
            u32x4 o; o.x = pk2(acc[0], acc[1]); o.y = pk2(acc[2], acc[3]); o.z = pk2(acc[4], acc[5]); o.w = pk2(acc[6], acc[7]);
            *(u32x4*)(lds + i * XST + ch * 2) = o;
        }
        __syncthreads();
        const int G = lane >> 4, l16 = lane & 15, ch0 = wave * 64;
        for (int dir = 0; dir < 2; ++dir)
            for (int nt = 0; nt < 4; ++nt) {
                const int e = nt * 16 + l16, ch = ch0 + e;
                bf16x8 Br[2], Bi[2];
#pragma unroll
                for (int kk = 0; kk < 2; ++kk) {
                    Br[kk] = *(const bf16x8*)(GWj + ((((size_t)dir * 2 + 0) * 8 + wave) * 64 + e) * 64 + kk * 32 + G * 8);
                    Bi[kk] = *(const bf16x8*)(GWj + ((((size_t)dir * 2 + 1) * 8 + wave) * 64 + e) * 64 + kk * 32 + G * 8);
                }
                const float brv = br[dir * 512 + ch], biv = bi[dir * 512 + ch], spl = softplus(-lam[dir * 512 + ch]);
#pragma unroll
                for (int mt = 0; mt < 4; ++mt) {
                    f32x4 ar = {0.f, 0.f, 0.f, 0.f}, ai = {0.f, 0.f, 0.f, 0.f};
#pragma unroll
                    for (int kk = 0; kk < 2; ++kk) { const bf16x8 a = *(const bf16x8*)(lds + (mt * 16 + l16) * XST + (ch0 + kk * 32 + G * 8) * 2); ar = MFMA16(a, Br[kk], ar); ai = MFMA16(a, Bi[kk], ai); }
#pragma unroll
                    for (int r = 0; r < 4; ++r) { const int i = mt * 16 + G * 4 + r;
                        const float xc = bf2f(*(const bf16_t*)(lds + i * XST + ch * 2));
                        const float rg = __builtin_amdgcn_rcpf(1.f + __expf(-(ar[r] + brv))), ig = __builtin_amdgcn_rcpf(1.f + __expf(-(ai[r] + biv)));
                        const float la = -8.f * rg * spl; const float uu = __builtin_amdgcn_sqrtf(fmaxf(1.f - __expf(2.f * la), 0.f)) * (ig * xc);
                        LU[((size_t)dir * TS + t0 + i) * 512 + ch] = attn_body::cvtpk_s(la, uu); }
                }
            }
        asm volatile("s_waitcnt vmcnt(0)" ::: "memory");
        __syncthreads();
        {
            const int ch = tid;
#pragma unroll
            for (int dir = 0; dir < 2; ++dir) {
                float h = 0.f, P = 0.f;
                const unsigned* lu = LU + ((size_t)dir * TS + t0) * 512 + ch;
#pragma unroll
                for (int q = 0; q < 64; q += 8) {
                    float lv[8], uv[8];
#pragma unroll
                    for (int e = 0; e < 8; ++e) { const int i = dir ? 63 - (q + e) : q + e; const unsigned w_ = lu[(size_t)i * 512]; lv[e] = __uint_as_float(w_ << 16); uv[e] = __uint_as_float(w_ & 0xffff0000u); }
#pragma unroll
                    for (int e = 0; e < 8; ++e) { h = __expf(lv[e]) * h + uv[e]; P += lv[e]; }
                }
                AGG[((size_t)dir * (TS / 64) + tile) * 512 + ch] = (f32x2){P, h};
            }
        }
    }
}
__device__ __forceinline__ void even_lru_scan(const unsigned* LU, const f32x2* AGG, const bf16_t* proj, bf16_t* Y, int S) {
    MK_IDS();
    const int ch = tid, TPB = S / 64;
    for (int tile = blockIdx.x; tile < TS / 64; tile += gridDim.x) {
        const int t0 = tile * 64, tb0 = (tile / TPB) * TPB;
        float cf = 0.f, cr = 0.f;
        for (int k0 = tb0; k0 < tile; k0 += 8) { f32x2 a[8];
#pragma unroll
            for (int q = 0; q < 8; ++q) { const int k = k0 + q < tile ? k0 + q : tile - 1; a[q] = AGG[(size_t)k * 512 + ch]; }
#pragma unroll
            for (int q = 0; q < 8; ++q) if (k0 + q < tile) cf = cf * __expf(a[q].x) + a[q].y; }
        for (int k0 = tb0 + TPB - 1; k0 > tile; k0 -= 8) { f32x2 a[8];
#pragma unroll
            for (int q = 0; q < 8; ++q) { const int k = k0 - q > tile ? k0 - q : tile + 1; a[q] = AGG[((size_t)(TS / 64) + k) * 512 + ch]; }
#pragma unroll
            for (int q = 0; q < 8; ++q) if (k0 - q > tile) cr = cr * __expf(a[q].x) + a[q].y; }
        float hf[64];
        {
            const unsigned* lu = LU + (size_t)t0 * 512 + ch; float h = cf;
#pragma unroll
            for (int q = 0; q < 64; q += 8) {
                float lv[8], uv[8];
#pragma unroll
                for (int e = 0; e < 8; ++e) { const unsigned w_ = lu[(size_t)(q + e) * 512]; lv[e] = __uint_as_float(w_ << 16); uv[e] = __uint_as_float(w_ & 0xffff0000u); }
#pragma unroll
                for (int e = 0; e < 8; ++e) { h = __expf(lv[e]) * h + uv[e]; hf[q + e] = h; }
            }
        }
        {
            const unsigned* lu = LU + ((size_t)TS + t0) * 512 + ch; float h = cr;
#pragma unroll
            for (int q = 0; q < 64; q += 8) {
                float lv[8], uv[8], gv[8];
#pragma unroll
                for (int e = 0; e < 8; ++e) { const int i = 63 - (q + e); { const unsigned w_ = lu[(size_t)i * 512]; lv[e] = __uint_as_float(w_ << 16); uv[e] = __uint_as_float(w_ & 0xffff0000u); } gv[e] = bf2f(proj[(size_t)(t0 + i) * EIN + 1280 + ch]); }
#pragma unroll
                for (int e = 0; e < 8; ++e) { const int i = 63 - (q + e); h = __expf(lv[e]) * h + uv[e]; Y[(size_t)(t0 + i) * DMODEL + 512 + ch] = (bf16_t)f2bf((hf[i] + h) * gelu_tanh(gv[e])); }
            }
        }
    }
}

__device__ __forceinline__ void odd_conv(const bf16_t* proj, const float* cw, bf16_t* QKVP, int S) {
    MK_IDS();
    for (int cr = 0; cr < (TS / 64 + (int)gridDim.x - 1) / (int)gridDim.x; ++cr) {
        const int c = cr * (int)gridDim.x + (int)blockIdx.x; if (c >= TS / 64) break;
        const int tb = c * 64 + wave * 8, sb = tb % S;
#pragma unroll
        for (int blk = 0; blk < 3; ++blk) {
            const int ch = blk * 512 + lane * 8;
            u32x4 rows[11];
#pragma unroll
            for (int q = 0; q < 11; ++q) { const int sp = sb + q - 2; rows[q] = (u32x4){0u, 0u, 0u, 0u};
                if (sp >= 0 && sp < S) rows[q] = *(const u32x4*)(proj + (size_t)(tb + q - 2) * OINP + ch); }
            f32x4 w0[4], w1[4];
#pragma unroll
            for (int j = 0; j < 4; ++j) { w0[j] = *(const f32x4*)(cw + j * 1536 + ch); w1[j] = *(const f32x4*)(cw + j * 1536 + ch + 4); }
#pragma unroll
            for (int i = 0; i < 8; ++i) {
                float acc[8];
#pragma unroll
                for (int e = 0; e < 8; ++e) acc[e] = 0.f;
#pragma unroll
                for (int j = 0; j < 4; ++j) { float xv[8]; unpack8(rows[i + j], xv);
                    acc[0] += w0[j].x * xv[0]; acc[1] += w0[j].y * xv[1]; acc[2] += w0[j].z * xv[2]; acc[3] += w0[j].w * xv[3];
                    acc[4] += w1[j].x * xv[4]; acc[5] += w1[j].y * xv[5]; acc[6] += w1[j].z * xv[6]; acc[7] += w1[j].w * xv[7]; }
                float ss = 0.f;
#pragma unroll
                for (int e = 0; e < 8; ++e) { acc[e] = silu(acc[e]); ss += acc[e] * acc[e]; }
                if (blk < 2) {
                    ss += __shfl_xor(ss, 1); ss += __shfl_xor(ss, 2); ss += __shfl_xor(ss, 4); ss += __shfl_xor(ss, 8);
                    const float rn = 1.f / sqrtf(ss + EPS);
#pragma unroll
                    for (int e = 0; e < 8; ++e) acc[e] *= rn;
                }
                u32x4 o; o.x = pk2(acc[0], acc[1]); o.y = pk2(acc[2], acc[3]); o.z = pk2(acc[4], acc[5]); o.w = pk2(acc[6], acc[7]);
                *(u32x4*)(QKVP + (size_t)(tb + i) * 1536 + ch) = o;
            }
        }
    }
}

__device__ __forceinline__ int frag128(int r, int k) { return ((((r >> 4) * 4 + (k >> 5)) * 64 + ((k >> 3) & 3) * 16 + (r & 15)) << 3) + (k & 7); }
__device__ __forceinline__ int frag64(int r, int k) { return ((((r >> 4) * 2 + (k >> 5)) * 64 + ((k >> 3) & 3) * 16 + (r & 15)) << 3) + (k & 7); }
__device__ __forceinline__ void odd_prep(const bf16_t* QKVP, const bf16_t* proj, const float* alog, const float* dtb, unsigned char* DNI, float* EGL, char* lds) {
    MK_IDS();
    constexpr int RS = 272;
    constexpr int HOFF = 69632;
    const float scale = 0.08838834764831845f;
    for (int itq = 0; itq < (TS / 64 + (int)gridDim.x - 1) / (int)gridDim.x * 4; ++itq) {
        const int c_ = (itq >> 2) * (int)gridDim.x + (int)blockIdx.x; if (c_ >= TS / 64) break; const int it0 = (c_ * 4 + (itq & 3)) * 2;
        int tq_ = tid; asm volatile("" : "+v"(tq_));
        const int half = tq_ >> 8, ht = tq_ & 255, hwave = __builtin_amdgcn_readfirstlane(ht >> 6), G = (tq_ & 63) >> 4, l16 = tq_ & 15;
        char* L = lds + half * HOFF;
        char* KS = L, *QS = L + 17408, *VS = L + 34816; float* LM = (float*)(L + 52224); float* GC = (float*)(L + 68608); float* BT = GC + 64; float* EG = BT + 64;
        const int it = it0 + half; const int d = it & 1, h = (it >> 1) & 3, c = it >> 3, t0 = c * 64;
        __syncthreads();
#pragma unroll
        for (int k = 0; k < 4; ++k) { const int idx = ht + k * 256, i = idx >> 4, pc = idx & 15; const int tk = d ? t0 + 63 - i : t0 + i;
            const bf16_t* src = QKVP + (size_t)tk * 1536 + h * 128 + pc * 8;
            *(u32x4*)(QS + i * RS + pc * 16) = *(const u32x4*)(src);
            *(u32x4*)(KS + i * RS + pc * 16) = *(const u32x4*)(src + 512);
            *(u32x4*)(VS + i * RS + pc * 16) = *(const u32x4*)(src + 1024); }
        if (hwave == 0) {
            const int i = lane; const int tk = d ? t0 + 63 - i : t0 + i;
            const float bl = bf2f(proj[(size_t)tk * OINP + 2048 + d * 4 + h]), al = bf2f(proj[(size_t)tk * OINP + 2056 + d * 4 + h]);
            const float beta = sigm(bl); float g = -__expf(alog[d * 4 + h]) * softplus(al + dtb[d * 4 + h]);
#pragma unroll
            for (int o = 1; o < 64; o <<= 1) { const float v = __shfl_up(g, o); if (lane >= o) g += v; }
            GC[i] = g; BT[i] = beta; EG[i] = __expf(g);
        }
        __syncthreads();
        {
            const bool isq = hwave >= 2; const char* XS = isq ? QS : KS;
#pragma unroll
            for (int mm = 0; mm < 2; ++mm) { const int mt = (hwave & 1) * 2 + mm;
                bf16x8 a[4];
#pragma unroll
                for (int kk = 0; kk < 4; ++kk) a[kk] = *(const bf16x8*)(XS + (mt * 16 + l16) * RS + (kk * 32 + G * 8) * 2);
#pragma unroll
                for (int nt = 0; nt < 4; ++nt) { f32x4 acc = {0.f, 0.f, 0.f, 0.f};
#pragma unroll
                    for (int kk = 0; kk < 4; ++kk) { const bf16x8 bb = *(const bf16x8*)(KS + (nt * 16 + l16) * RS + (kk * 32 + G * 8) * 2); acc = MFMA16(a[kk], bb, acc); }
                    const int j = nt * 16 + l16; const float gj = GC[j];
#pragma unroll
                    for (int r = 0; r < 4; ++r) { const int i = mt * 16 + G * 4 + r; const float dec = __expf(fminf(GC[i] - gj, 0.f));
                        if (!isq) LM[i * 64 + j] = (j < i) ? BT[i] * acc[r] * dec : 0.f;
                        else ((bf16_t*)(DNI + (size_t)it * DNI_BYTES + DNI_A))[frag64(i, j)] = (bf16_t)f2bf((j <= i) ? acc[r] * scale * dec : 0.f); }
                }
            }
        }
        __syncthreads();
        {
            float sol[64];
            const int cc = ht & 127; const bool isw = ht >= 128; const char* XS = isw ? KS : VS;
#pragma unroll
            for (int i = 0; i < 64; ++i) {
                float v = bf2f(*(const bf16_t*)(XS + i * RS + cc * 2)) * BT[i]; if (isw) v *= EG[i];
                float a0 = 0.f, a1 = 0.f;
#pragma unroll
                for (int j4 = 0; j4 < (i + 3) / 4; ++j4) { const f32x4 l4 = *(const f32x4*)(LM + i * 64 + j4 * 4);
                    if (j4 * 4 + 0 < i) a0 += l4.x * sol[j4 * 4 + 0]; if (j4 * 4 + 1 < i) a1 += l4.y * sol[j4 * 4 + 1];
                    if (j4 * 4 + 2 < i) a0 += l4.z * sol[j4 * 4 + 2]; if (j4 * 4 + 3 < i) a1 += l4.w * sol[j4 * 4 + 3];
                    if ((j4 & 1) == 1) asm volatile("" ::: "memory"); }
                v -= a0 + a1;
                sol[i] = v;
                ((bf16_t*)(DNI + (size_t)it * DNI_BYTES + (isw ? DNI_W : DNI_U)))[isw ? frag128(i, cc) : i * 128 + cc] = (bf16_t)f2bf(v);
                asm volatile("" ::: "memory");
            }
        }
        {
            const float gl = GC[63];
#pragma unroll
            for (int k = 0; k < 4; ++k) { const int idx = ht + k * 256;
                {
                    const int i = idx & 63, kg = idx >> 6; const u32x4 raw = *(const u32x4*)(QS + i * RS + kg * 16); float f[8]; unpack8(raw, f); const float sc = scale * EG[i];
                    u32x4 o; o.x = pk2(f[0] * sc, f[1] * sc); o.y = pk2(f[2] * sc, f[3] * sc); o.z = pk2(f[4] * sc, f[5] * sc); o.w = pk2(f[6] * sc, f[7] * sc);
                    *(u32x4*)((bf16_t*)(DNI + (size_t)it * DNI_BYTES + DNI_QT) + frag128(i, kg * 8)) = o; }
                {
                    const int dm = idx & 127, tg = idx >> 7; float f[8];
#pragma unroll
                    for (int q = 0; q < 8; ++q) { const int i = tg * 8 + q; f[q] = bf2f(*(const bf16_t*)(KS + i * RS + dm * 2)) * __expf(gl - GC[i]); }
                    u32x4 o; o.x = pk2(f[0], f[1]); o.y = pk2(f[2], f[3]); o.z = pk2(f[4], f[5]); o.w = pk2(f[6], f[7]);
                    *(u32x4*)((bf16_t*)(DNI + (size_t)it * DNI_BYTES + DNI_KTT) + frag64(dm, tg * 8)) = o; }
            }
            if (ht == 0) EGL[it] = __expf(gl);
        }
    }
}

__device__ __forceinline__ void odd_scan(const unsigned char* DNI, const float* EGL, bf16_t* OB, int S, int nb, char* lds) {
    MK_IDS();
    constexpr int O_SB = 0, O_VN = 4352, O_OUT = 6656, PFD = 7;
    const int NC = S / 64, G = lane >> 4, l16 = lane & 15;
    const int nitems = nb * 64;
    const int mt = wave & 3; const bool lo = wave < 4;
    for (int item = blockIdx.x; item < nitems; item += gridDim.x) {
        const int e = (item >> 3) & 7, sq = (item & 7) | ((item >> 6) << 3); const int d = sq & 1, h = (sq >> 1) & 3, b = sq >> 3;
        __syncthreads();
        for (int i = tid; i < 4352 / 4; i += NT) ((unsigned*)(lds + O_SB))[i] = 0u;
        f32x4 Sreg = {0.f, 0.f, 0.f, 0.f};
        const long dstep = (long)(d ? -8 : 8) * DNI_BYTES;
        const unsigned char* base0 = DNI + (size_t)(((b * NC + (d ? NC - 1 : 0)) * 4 + h) * 2 + d) * DNI_BYTES;
        const unsigned char* pX = base0 + (lo ? DNI_W : DNI_QT) + ((mt * 4) * 64 + lane) * 16;
        const unsigned char* pA = base0 + DNI_A + ((mt * 2) * 64 + lane) * 16;
        const unsigned char* pK = base0 + DNI_KTT + ((wave * 2) * 64 + lane) * 16;
        const unsigned char* pU = base0 + DNI_U + ((mt * 16 + G * 4) * 128 + e * 16 + l16) * 2;
        const float* pE = EGL + (((b * NC + (d ? NC - 1 : 0)) * 4 + h) * 2 + d);
        const unsigned char* pP = base0 + (long)PFD * dstep + e * 9216 + (tid < 144 ? tid : 143) * 64;
        bf16_t* pO = OB + ((size_t)d * TS + (size_t)(b * NC + (d ? NC - 1 : 0)) * 64 + (d ? 63 - (tid >> 3) : (tid >> 3))) * 512 + h * 128 + e * 16 + (tid & 7) * 2;
        const long ostep = (long)(d ? -64 : 64) * 512;
        u32x4 aX[4], aA[2], aK[2], bX[4], bA[2], bK[2], cX[4], cA[2], cK[2];
        unsigned aU[4], bU[4], cU[4]; float aE, bE, cE; unsigned pf_dummy = 0u;
#define DN_LOAD(P) do { \
            _Pragma("unroll") for (int kk = 0; kk < 4; ++kk) P##X[kk] = *(const u32x4*)(pX + kk * 1024); \
            _Pragma("unroll") for (int kk = 0; kk < 2; ++kk) { P##A[kk] = *(const u32x4*)(pA + kk * 1024); P##K[kk] = *(const u32x4*)(pK + kk * 1024); } \
            _Pragma("unroll") for (int r = 0; r < 4; ++r) P##U[r] = *(const bf16_t*)(pU + r * 256); \
            P##E = *pE; pX += dstep; pA += dstep; pK += dstep; pU += dstep; pE += (d ? -8 : 8); } while (0)
#define DN_STEP(P, PL) do { \
            DN_LOAD(PL); \
            if (wave < 3) { asm volatile("global_load_dword %0, %1, off" : "+v"(pf_dummy) : "v"(pP) : "memory"); } \
            pP += dstep; \
            f32x4 acc = {0.f, 0.f, 0.f, 0.f}, acc2 = {0.f, 0.f, 0.f, 0.f}; \
            { bf16x8 sb_[4]; \
              _Pragma("unroll") for (int kk = 0; kk < 4; ++kk) sb_[kk] = *(const bf16x8*)(lds + O_SB + l16 * 272 + (kk * 32 + G * 8) * 2); \
              asm volatile("s_waitcnt lgkmcnt(0)" : "+v"(sb_[0]), "+v"(sb_[1]), "+v"(sb_[2]), "+v"(sb_[3]) :: "memory"); \
              acc = MFMA16(__builtin_bit_cast(bf16x8, P##X[0]), sb_[0], acc); acc2 = MFMA16(__builtin_bit_cast(bf16x8, P##X[1]), sb_[1], acc2); \
              acc = MFMA16(__builtin_bit_cast(bf16x8, P##X[2]), sb_[2], acc); acc2 = MFMA16(__builtin_bit_cast(bf16x8, P##X[3]), sb_[3], acc2); \
              acc = acc + acc2; } \
            if (lo) { u32x2 o; float v[4]; \
              _Pragma("unroll") for (int r = 0; r < 4; ++r) v[r] = __uint_as_float(P##U[r] << 16) - acc[r]; \
              o.x = attn_body::cvtpk_s(v[0], v[1]); o.y = attn_body::cvtpk_s(v[2], v[3]); \
              *(u32x2*)(lds + O_VN + l16 * 144 + (mt * 16 + G * 4) * 2) = o; } \
            asm volatile("s_waitcnt lgkmcnt(0)\n\ts_barrier" ::: "memory"); \
            bf16x8 vb[2]; \
            _Pragma("unroll") for (int kk = 0; kk < 2; ++kk) vb[kk] = *(const bf16x8*)(lds + O_VN + l16 * 144 + (kk * 32 + G * 8) * 2); \
            asm volatile("s_waitcnt lgkmcnt(0)" : "+v"(vb[0]), "+v"(vb[1]) :: "memory"); \
            Sreg = Sreg * P##E; \
            _Pragma("unroll") for (int kk = 0; kk < 2; ++kk) Sreg = MFMA16(__builtin_bit_cast(bf16x8, P##K[kk]), vb[kk], Sreg); \
            { u32x2 o; o.x = attn_body::cvtpk_s(Sreg[0], Sreg[1]); o.y = attn_body::cvtpk_s(Sreg[2], Sreg[3]); \
              *(u32x2*)(lds + O_SB + l16 * 272 + (wave * 16 + G * 4) * 2) = o; } \
            if (!lo) { \
              _Pragma("unroll") for (int kk = 0; kk < 2; ++kk) acc = MFMA16(__builtin_bit_cast(bf16x8, P##A[kk]), vb[kk], acc); \
              const unsigned w0_ = attn_body::cvtpk_s(acc[0], acc[1]), w1_ = attn_body::cvtpk_s(acc[2], acc[3]); \
              bf16_t* op_ = (bf16_t*)(lds + O_OUT + ((mt * 16 + G * 4) * 16 + l16) * 2); \
              op_[0] = (bf16_t)(w0_ & 0xffffu); op_[16] = (bf16_t)(w0_ >> 16); op_[32] = (bf16_t)(w1_ & 0xffffu); op_[48] = (bf16_t)(w1_ >> 16); } \
            asm volatile("s_waitcnt lgkmcnt(0)\n\ts_barrier" ::: "memory"); \
            *(unsigned*)pO = *(const unsigned*)(lds + O_OUT + tid * 4); pO += ostep; } while (0)
        DN_LOAD(a); DN_LOAD(b);
        __syncthreads();
        int n = 0;
        for (; n + 3 <= NC; n += 3) {
            DN_STEP(a, c);
            DN_STEP(b, a);
            DN_STEP(c, b);
        }
        if (n < NC) { DN_STEP(a, c); }
        if (n + 1 < NC) { DN_STEP(b, a); }
#undef DN_STEP
#undef DN_LOAD
        asm volatile("s_waitcnt vmcnt(0)" ::: "memory");
        asm volatile("" :: "v"(pf_dummy));
    }
}

__device__ __forceinline__ int t5_bucket(int rel) {
    const int n = rel < 0 ? -rel : rel; int v;
    if (n < 8) v = n; else v = 8 + (n >= 15) + (n >= 27) + (n >= 50) + (n >= 91) + (n >= 166) + (n >= 305) + (n >= 559);
    return (rel > 0 ? 16 : 0) + v;
}
__device__ __forceinline__ void odd_dilated(bf16_t* proj, const float* relb, float* LSE, int S, char* lds, int first_wg, int n_wg) {
    MK_IDS();
    constexpr int KST = 144, VST = 400, HOFF = 27648 + 25600 + 1024;
    const int half = tid >> 8, ht = tid & 255, wv = ht >> 6, G = lane >> 4, l16 = lane & 15;
    char* L = lds + half * HOFF; char* KS = L; char* VT = L + 27648; float* BIAS = (float*)(L + 27648 + 25600);
    const int NBb = S / 64;
    const int wgi = (int)blockIdx.x - first_wg;
    if (wgi < 0) return;
    for (int it0 = wgi * 2; it0 < 3072; it0 += n_wg * 2) {
        const int it = it0 + half; const int zb = it & 255, sl = (it >> 8) & 3, g = it >> 10;
        const int dil = g == 0 ? 1 : (g == 1 ? 4 : 16), lg = g * 2;
        const int M = S >> lg, MB = M / 64;
        const int b = zb / NBb, r0 = zb % NBb, rho = r0 / MB, n = r0 % MB;
        const int hc = (g * 4 + sl) * 64;
        const size_t tb = (size_t)b * S;
        __syncthreads();
#pragma unroll
        for (int k = 0; k < 6; ++k) { const int idx = ht + k * 256, kj = idx >> 3, pc = idx & 7; const int mk = 64 * n - 64 + kj;
            u32x4 kv = {0u, 0u, 0u, 0u}, vv = {0u, 0u, 0u, 0u};
            if (mk >= 0 && mk < M) { const bf16_t* rowp = proj + (tb + (size_t)mk * dil + rho) * OINP; kv = *(const u32x4*)(rowp + 2832 + hc + pc * 8); vv = *(const u32x4*)(rowp + 3600 + hc + pc * 8); }
            *(u32x4*)(KS + kj * KST + pc * 16) = kv;
            const unsigned w[4] = {vv.x, vv.y, vv.z, vv.w};
#pragma unroll
            for (int q = 0; q < 4; ++q) { *(bf16_t*)(VT + (pc * 8 + 2 * q) * VST + kj * 2) = (bf16_t)(w[q] & 0xffffu); *(bf16_t*)(VT + (pc * 8 + 2 * q + 1) * VST + kj * 2) = (bf16_t)(w[q] >> 16); } }
        if (ht < 129) BIAS[ht] = relb[t5_bucket((ht - 64) * dil) * 12 + g * 4 + sl];
        const int mq = 64 * n + 16 * wv + l16; const size_t tq = tb + (size_t)mq * dil + rho;
        bf16x8 qf[2];
#pragma unroll
        for (int kk = 0; kk < 2; ++kk) qf[kk] = *(const bf16x8*)(proj + tq * OINP + 2064 + hc + kk * 32 + G * 8);
        __syncthreads();
        f32x4 sc[9]; float mx = -1e30f;
#pragma unroll
        for (int kt = 0; kt < 9; ++kt) { f32x4 acc = {0.f, 0.f, 0.f, 0.f};
#pragma unroll
            for (int kk = 0; kk < 2; ++kk) { const bf16x8 a = *(const bf16x8*)(KS + ((wv + kt) * 16 + l16) * KST + (kk * 32 + G * 8) * 2); acc = MFMA16(a, qf[kk], acc); }
#pragma unroll
            for (int r = 0; r < 4; ++r) { const int kj = (wv + kt) * 16 + G * 4 + r; const int delta = kj - 64 - 16 * wv - l16; const int mk = 64 * n - 64 + kj;
                const bool ok = (delta >= -64) && (delta <= 64) && (mk >= 0) && (mk < M);
                const float s = ok ? acc[r] * 0.125f + BIAS[(delta < -64 ? -64 : (delta > 64 ? 64 : delta)) + 64] : -1e30f;
                acc[r] = s; mx = fmaxf(mx, s); }
            sc[kt] = acc; }
        mx = fmaxf(mx, __shfl_xor(mx, 16)); mx = fmaxf(mx, __shfl_xor(mx, 32));
        float sum = 0.f;
#pragma unroll
        for (int kt = 0; kt < 9; ++kt)
#pragma unroll
            for (int r = 0; r < 4; ++r) { const float pv_ = (sc[kt][r] > -1e29f) ? __expf(sc[kt][r] - mx) : 0.f; sc[kt][r] = pv_; sum += pv_; }
        sum += __shfl_xor(sum, 16); sum += __shfl_xor(sum, 32);
        f32x4 ot[4];
#pragma unroll
        for (int dt = 0; dt < 4; ++dt) ot[dt] = (f32x4){0.f, 0.f, 0.f, 0.f};
#pragma unroll
        for (int pp = 0; pp < 5; ++pp) {
            u32x4 pb; pb.x = pk2(sc[2 * pp][0], sc[2 * pp][1]); pb.y = pk2(sc[2 * pp][2], sc[2 * pp][3]);
            if (pp < 4) { pb.z = pk2(sc[2 * pp + 1][0], sc[2 * pp + 1][1]); pb.w = pk2(sc[2 * pp + 1][2], sc[2 * pp + 1][3]); } else { pb.z = 0u; pb.w = 0u; }
            const bf16x8 pbf = __builtin_bit_cast(bf16x8, pb);
#pragma unroll
            for (int dt = 0; dt < 4; ++dt) {
                u32x4 av; const u32x2 lo = *(const u32x2*)(VT + (dt * 16 + l16) * VST + ((wv + 2 * pp) * 16 + G * 4) * 2); av.x = lo.x; av.y = lo.y;
                if (pp < 4) { const u32x2 hi = *(const u32x2*)(VT + (dt * 16 + l16) * VST + ((wv + 2 * pp + 1) * 16 + G * 4) * 2); av.z = hi.x; av.w = hi.y; } else { av.z = 0u; av.w = 0u; }
                ot[dt] = MFMA16(__builtin_bit_cast(bf16x8, av), pbf, ot[dt]);
            }
        }
        const float rs = 1.f / sum;
        bf16_t* od = proj + tq * OINP + (g * 4 + sl) * 64;
#pragma unroll
        for (int dt = 0; dt < 4; ++dt) { const f32x4 v_ = ot[dt] * rs; u32x2 w_; w_.x = pk2(v_[0], v_[1]); w_.y = pk2(v_[2], v_[3]); *(u32x2*)(od + dt * 16 + G * 4) = w_; }
        if (G == 0) LSE[tq * 12 + g * 4 + sl] = mx + __logf(sum);
    }
}

__device__ __forceinline__ void odd_combine(const bf16_t* OB, const bf16_t* proj, const float* LSE, const float* og, bf16_t* Y) {
    MK_IDS();
    float gn[8];
#pragma unroll
    for (int e = 0; e < 8; ++e) gn[e] = og[(lane & 15) * 8 + e];
    const int sl = lane >> 4;
    for (int t = gw; t < TS; t += NGW) {
        const bf16_t* prow = proj + (size_t)t * OINP;
        const u32x4 fa = *(const u32x4*)(OB + (size_t)t * 512 + lane * 8), ra = *(const u32x4*)(OB + ((size_t)TS + t) * 512 + lane * 8), za = *(const u32x4*)(prow + 1536 + lane * 8);
        const u32x2 d0 = *(const u32x2*)(prow + lane * 4), d1 = *(const u32x2*)(prow + 256 + lane * 4), d2 = *(const u32x2*)(prow + 512 + lane * 4);
        const float l0 = LSE[(size_t)t * 12 + sl], l1 = LSE[(size_t)t * 12 + 4 + sl], l2 = LSE[(size_t)t * 12 + 8 + sl];
        float f[8], r[8], z[8]; unpack8(fa, f); unpack8(ra, r); unpack8(za, z);
        float ss = 0.f;
#pragma unroll
        for (int e = 0; e < 8; ++e) { f[e] += r[e]; ss += f[e] * f[e]; }
        ss += __shfl_xor(ss, 1); ss += __shfl_xor(ss, 2); ss += __shfl_xor(ss, 4); ss += __shfl_xor(ss, 8);
        const float rn = 1.f / sqrtf(ss * (1.f / 128.f) + EPS);
#pragma unroll
        for (int e = 0; e < 8; ++e) f[e] = f[e] * rn * gn[e] * silu(z[e]);
        u32x4 o; o.x = pk2(f[0], f[1]); o.y = pk2(f[2], f[3]); o.z = pk2(f[4], f[5]); o.w = pk2(f[6], f[7]);
        *(u32x4*)(Y + (size_t)t * OOUT + lane * 8) = o;
        const float m = fmaxf(l0, fmaxf(l1, l2)); const float w0 = __expf(l0 - m), w1 = __expf(l1 - m), w2 = __expf(l2 - m); const float rs = 1.f / (w0 + w1 + w2);
        const float a0 = w0 * rs, a1 = w1 * rs, a2 = w2 * rs;
        const float v0 = a0 * __uint_as_float(d0.x << 16) + a1 * __uint_as_float(d1.x << 16) + a2 * __uint_as_float(d2.x << 16);
        const float v1 = a0 * __uint_as_float(d0.x & 0xffff0000u) + a1 * __uint_as_float(d1.x & 0xffff0000u) + a2 * __uint_as_float(d2.x & 0xffff0000u);
        const float v2 = a0 * __uint_as_float(d0.y << 16) + a1 * __uint_as_float(d1.y << 16) + a2 * __uint_as_float(d2.y << 16);
        const float v3 = a0 * __uint_as_float(d0.y & 0xffff0000u) + a1 * __uint_as_float(d1.y & 0xffff0000u) + a2 * __uint_as_float(d2.y & 0xffff0000u);
        u32x2 od; od.x = pk2(v0, v1); od.y = pk2(v2, v3);
        *(u32x2*)(Y + (size_t)t * OOUT + 512 + lane * 4) = od;
    }
}

__global__ void __launch_bounds__(NT, 2) fwd_megakernel(Params p) {
    extern __shared__ __attribute__((aligned(16))) unsigned char lds_raw[];
    cg::grid_group grid = cg::this_grid();
    char* lds = (char*)lds_raw;
    PG8_LAS unsigned char* ldsl = (PG8_LAS unsigned char*)lds_raw;
    const int Gr = gridDim.x;
    volatile LAS unsigned* MISC = (volatile LAS unsigned*)((PG8_LAS unsigned char*)lds_raw + (LDS_BYTES - 128));
    if (threadIdx.x < 32) MISC[threadIdx.x] = 0u;
    __syncthreads();
    xb::XcdBarrier bar = xb::xcd_barrier_post((unsigned*)p.ws, MISC + 8);
#define GSYNC() xb::xcd_barrier(bar)
    unsigned char* ws = p.ws;
    bf16_t* H = (bf16_t*)(ws + WS_H); bf16_t* PROJ = (bf16_t*)(ws + WS_PROJ); unsigned char* SCR = ws + WS_SCR;

    phase_prologue(p, lds);
    grid.sync();

    float* SSQA = (float*)(SCR + 232 * MiB); float* SSQB = (float*)(SCR + 234 * MiB);
    bf16_t* YE = (bf16_t*)(SCR + 192 * MiB); bf16_t* YO = (bf16_t*)(SCR + SC_QKVP);
    for (int seg = 0; seg < NSEG; ++seg) {
        const int S = seg < 2 ? 16384 : 2048, nb = seg < 2 ? 1 : 8;
        const float* xin = (seg < 2 ? p.in[0] : p.in[1]) + (size_t)(seg & 1) * TS * DMODEL;
        float* xo = p.out + (size_t)seg * TS * DMODEL;
        phase_x0(xin, H, SSQB);
        GSYNC();
        for (int layer = 0; layer < 4; ++layer) {
            const int j = layer >> 1; const bool odd = layer & 1;
            {
                const int N = odd ? OINP : EIN;
                const bf16_t* Bt = odd ? (const bf16_t*)(ws + WS_WINO) + (size_t)j * OINP * 1024 : (const bf16_t*)(ws + WS_WINE) + (size_t)j * EIN * 1024;
                pg8::Gemm g{H, Bt, TS, N, 1024}; pg8::StaticOrder So; So.init(TS, N, Gr, (int)blockIdx.x);
                pg8::EpiBf16<0> E{PROJ, N, nullptr, 0, 0, 1.f, SSQB};
                pg8::gemm_phase<pg8::EpiBf16<0>, pg8::StaticOrder, true, true>(ldsl, g, So, E);
            }
            GSYNC();
            if (!odd) {
                even_qk_post(PROJ, p.in[10] + j * 64, p.in[11] + j * 64, S);
                even_lru_prep(PROJ, p.in[12] + j * 2048, p.in[13] + j * 512, (const bf16_t*)(ws + WS_GW) + (size_t)j * 2 * 2 * 8 * 4096, p.in[15] + j * 1024, p.in[17] + j * 1024, p.in[18] + j * 1024,
                              (unsigned*)(SCR + SC_LA), (f32x2*)(SCR + SC_AGG), S, lds);
                GSYNC();
                {
                    const int nqb = S / 256, nunits = nb * 8 * nqb;
                    for (int u = blockIdx.x; u < nunits; u += Gr) {
                        const int qb = u % nqb, h = (u / nqb) % 8, b = u / (nqb * 8), kvh = h >> 2;
                        const attn_body::bf16* base = (const attn_body::bf16*)PROJ + (size_t)b * S * EIN;
                        attn_body::attn_unit<8>(qb, S, base + h * 64, EIN, base + 512 + kvh * 64, base + 640 + kvh * 64, EIN, (attn_body::bf16*)YE + (size_t)b * S * DMODEL + h * 64, DMODEL, lds);
                    }
                }
                __syncthreads();
                even_lru_scan((const unsigned*)(SCR + SC_LA), (const f32x2*)(SCR + SC_AGG), PROJ, YE, S);
                GSYNC();
                {
                    pg8::Gemm g{YE, (const bf16_t*)(ws + WS_WOUTE) + (size_t)j * 1024 * 1024, TS, 1024, 1024}; pg8::StaticOrder So; So.init(TS, 1024, Gr, (int)blockIdx.x);
                    EpiRes E{H, SSQA, DMODEL};
                    pg8::gemm_phase<EpiRes, pg8::StaticOrder, true, true>(ldsl, g, So, E);
                }
            } else {
                odd_conv(PROJ, p.in[21] + j * 4 * 1536, (bf16_t*)(SCR + SC_QKVP), S);
                asm volatile("s_waitcnt vmcnt(0)" ::: "memory"); __syncthreads();
                odd_prep((const bf16_t*)(SCR + SC_QKVP), PROJ, p.in[22] + j * 8, p.in[23] + j * 8, SCR + SC_DNI, (float*)(SCR + SC_EGL), lds);
                GSYNC();
                {
                    const int nscan = nb * 64;
                    odd_scan(SCR + SC_DNI, (const float*)(SCR + SC_EGL), (bf16_t*)(SCR + SC_OB), S, nb, lds);
                    const int first = nscan < Gr ? nscan : 0;
                    odd_dilated(PROJ, p.in[2], (float*)(SCR + SC_LSE), S, lds, first, Gr - first);
                }
                GSYNC();
                odd_combine((const bf16_t*)(SCR + SC_OB), PROJ, (const float*)(SCR + SC_LSE), p.in[24] + j * 128, YO);
                GSYNC();
                {
                    pg8::Gemm g{YO, (const bf16_t*)(ws + WS_WOUTO) + (size_t)j * 1024 * OOUT, TS, 1024, OOUT}; pg8::StaticOrder So; So.init(TS, 1024, Gr, (int)blockIdx.x);
                    EpiRes E{H, SSQA, DMODEL};
                    pg8::gemm_phase<EpiRes, pg8::StaticOrder, true, true>(ldsl, g, So, E);
                }
            }
            GSYNC();
            {
                pg8::Gemm g{H, (const bf16_t*)(ws + WS_W1T) + (size_t)layer * 4096 * 1024, TS, DFF, 1024}; pg8::StaticOrder So; So.init(TS, DFF, Gr, (int)blockIdx.x);
                pg8::EpiBf16<2> E{(bf16_t*)(SCR + SC_HID), DFF, nullptr, 0, 0, 1.f, SSQA};
                pg8::gemm_phase<pg8::EpiBf16<2>, pg8::StaticOrder, true, true>(ldsl, g, So, E);
            }
            GSYNC();
            {
                pg8::Gemm g{(const bf16_t*)(SCR + SC_HID), (const bf16_t*)(ws + WS_W2T) + (size_t)layer * 1024 * 4096, TS, 1024, DFF}; pg8::StaticOrder So; So.init(TS, 1024, Gr, (int)blockIdx.x);
                EpiRes E{H, SSQB, DMODEL};
                pg8::gemm_phase<EpiRes, pg8::StaticOrder, true, true>(ldsl, g, So, E);
            }
            GSYNC();
        }
        phase_rmsnorm_final(H, xo, p.in[5]);
        GSYNC();
    }
}
}

extern "C" void kernel_launch(void* const* d_in, const int* in_sizes, int n_in, void* d_out, int out_size, void* d_ws, size_t ws_size, hipStream_t stream) {
    static int grid = 0;
    if (grid == 0) {
        if (n_in != 25 || ws_size < mk::WS_END) { fprintf(stderr, "kernel_launch: unexpected n_in %d / ws_size %zu\n", n_in, ws_size); grid = -1; return; }
        int dev = 0, cus = 0, per_cu = 0;
        hipGetDevice(&dev); hipDeviceGetAttribute(&cus, hipDeviceAttributeMultiprocessorCount, dev);
        if (hipFuncSetAttribute((const void*)mk::fwd_megakernel, hipFuncAttributeMaxDynamicSharedMemorySize, mk::LDS_BYTES) != hipSuccess) { fprintf(stderr, "hipFuncSetAttribute failed\n"); }
        hipOccupancyMaxActiveBlocksPerMultiprocessor(&per_cu, (const void*)mk::fwd_megakernel, mk::NT, mk::LDS_BYTES);
        (void)hipGetLastError();
        if (per_cu < 1) per_cu = 1;
        grid = cus * 1;
        fprintf(stderr, "kernel_launch: cus %d per_cu %d grid %d\n", cus, per_cu, grid);
    }
    if (grid < 0) return;
    if (hipMemsetAsync(d_ws, 0, 65536, stream) != hipSuccess) { fprintf(stderr, "memset failed\n"); return; }
    mk::Params p{};
    for (int i = 0; i < 25; ++i) p.in[i] = (const float*)d_in[i];
    p.out = (float*)d_out; p.ws = (unsigned char*)d_ws;
    void* args[] = {&p};
    hipError_t e = hipLaunchCooperativeKernel((const void*)mk::fwd_megakernel, dim3(grid), dim3(mk::NT), args, mk::LDS_BYTES, stream);
    if (e != hipSuccess) fprintf(stderr, "cooperative launch failed: %s (grid %d)\n", hipGetErrorString(e), grid);
}
```

```cpp
#include <hip/hip_runtime.h>
#include <hip/hip_cooperative_groups.h>
#include <hip/hip_bf16.h>
#include <cstdio>
#include <cstdint>
#include <cmath>
namespace cg = cooperative_groups;
namespace pg8 {
#define PG8_LAS __attribute__((address_space(3)))
typedef unsigned short bf16_t;
typedef short bf16x8 __attribute__((ext_vector_type(8)));
typedef float f32x4 __attribute__((ext_vector_type(4)));
typedef unsigned u32x4 __attribute__((ext_vector_type(4)));
constexpr int BM = 256, BK = 64, HALF = 128, HTB = HALF * BK * 2  , STAGE_BYTES = 8 * HTB, NXCD = 8, WGM = 8;

__host__ __device__ __forceinline__ int lds_byte(int r, int c) { const int st = (r >> 4) * 2 + (c >> 5), rr = r & 15, cc = c & 31, ob = rr * 64 + cc * 2; return st * 1024 + (ob ^ (((ob >> 9) & 1) << 5)); }
__host__ __device__ __forceinline__ void stage_rc(int b, int& R, int& C) { const int st = b / 1024, sb = b % 1024, swz = sb ^ (((sb >> 9) & 1) << 5); R = (st >> 1) * 16 + swz / 64; C = (st & 1) * 32 + (swz % 64) / 2; }
__host__ __device__ __forceinline__ int perm32(int rho) { const int n = rho >> 4, i = rho & 15; return 8 * (i >> 2) + 4 * n + (i & 3); }

struct Unit { int pm, pn; };
struct Gemm { const bf16_t* A; const bf16_t* Bt; int M, N, K; };

struct StaticOrder {
    int nM, nN, nwg, G, c;
    __host__ __device__ void init(int M, int N, int G_, int c_) { nM = M / BM; nN = N / BM; nwg = nM * nN; G = G_; c = c_; }
    __host__ __device__ bool next(int i, Unit& u) const {
        const long L = (long)i * G + c; if (L >= nwg) return false;
        int wgid = (int)L; { const int q = nwg / NXCD, r = nwg % NXCD, xcd = wgid % NXCD, off = wgid / NXCD; wgid = (xcd < r ? xcd * (q + 1) : r * (q + 1) + (xcd - r) * q) + off; }
        const int nig = WGM * nN, gid = wgid / nig, fm = gid * WGM, gsz = (nM - fm) < WGM ? (nM - fm) : WGM;
        u.pm = fm + ((wgid % nig) % gsz); u.pn = (wgid % nig) / gsz; return true;
    }
    __device__ __forceinline__ void a_ready(const Unit&) const {}
    __device__ __forceinline__ void done(const Unit&) const {}
};

__device__ __forceinline__ unsigned cvt_pk_bf16(float lo, float hi) { unsigned r; asm volatile("v_cvt_pk_bf16_f32 %0, %1, %2" : "=v"(r) : "v"(lo), "v"(hi)); return r; }
typedef float f32x2 __attribute__((ext_vector_type(2)));
__device__ __forceinline__ f32x2 gelu_pk(f32x2 v) {
    const f32x2 av = __builtin_elementwise_abs(v), d = av * 0.2316418882f + 1.0f;
    f32x2 t; t.x = __builtin_amdgcn_rcpf(d.x); t.y = __builtin_amdgcn_rcpf(d.y);
    f32x2 q = t * 0.5307027145f + (-0.7265760135f); q = q * t + 0.7107068705f; q = q * t + (-0.142248368f); q = q * t + 0.127414796f; q = q * t;
    const f32x2 s = (v * v) * (-0.72134752044f);
    f32x2 e; e.x = __builtin_amdgcn_exp2f(s.x); e.y = __builtin_amdgcn_exp2f(s.y);
    const f32x2 m = v * (q * e), r = v - m;
    f32x2 o; o.x = v.x < 0.f ? m.x : r.x; o.y = v.y < 0.f ? m.y : r.y; return o;
}

template <int ACT  > struct EpiBf16 {
    static constexpr bool PERM = true, AFTER_DRAIN = false; static_assert(ACT == 0 || ACT == 1 || ACT == 2, "EpiBf16: ACT 0 none, 1 gelu, 2 relu^2");
    bf16_t* O; int ldc; const float* bias; int split_cols; size_t split_stride; float scale0; const float* ssq;
    __device__ __forceinline__ void operator()(const f32x4 (&acc)[2][2][4][2], const Unit& u, int wr, int wc, int fr, int fq) const {
        const int row0 = u.pm * BM + wr * 64 + fr; int colt = u.pn * BM; bf16_t* base = O;
        float sc = 1.f; if (split_cols) { const int t = colt / split_cols; base += (size_t)t * split_stride; colt -= t * split_cols; if (t == 0) sc = scale0; }
        const int col0 = colt + wc * 32 + 8 * fq, bcol0 = u.pn * BM + wc * 32 + 8 * fq;
        float rsc[2][4];
        if (ssq) { f32x4 t_[2][4];
#pragma unroll
            for (int ai = 0; ai < 2; ++ai)
#pragma unroll
                for (int m = 0; m < 4; ++m) t_[ai][m] = *(const f32x4*)(ssq + (size_t)(row0 + ai * HALF + m * 16) * 16 + fq * 4);
#pragma unroll
            for (int ai = 0; ai < 2; ++ai)
#pragma unroll
                for (int m = 0; m < 4; ++m) { float s_ = (t_[ai][m][0] + t_[ai][m][1]) + (t_[ai][m][2] + t_[ai][m][3]); s_ += __shfl_xor(s_, 16); s_ += __shfl_xor(s_, 32); rsc[ai][m] = 1.0f / sqrtf(s_ * (1.0f / 1024.0f) + 1e-6f); }
        } else {
#pragma unroll
            for (int ai = 0; ai < 2; ++ai)
#pragma unroll
                for (int m = 0; m < 4; ++m) rsc[ai][m] = 1.0f; }
        f32x4 bv[2][2];
#pragma unroll
        for (int bj = 0; bj < 2; ++bj)
#pragma unroll
            for (int n = 0; n < 2; ++n) bv[bj][n] = bias ? *(const f32x4*)(bias + bcol0 + bj * HALF + 4 * n) : (f32x4){0.f, 0.f, 0.f, 0.f};
#pragma unroll
        for (int ai = 0; ai < 2; ++ai)
#pragma unroll
            for (int m = 0; m < 4; ++m) { bf16_t* rowp = base + (size_t)(row0 + ai * HALF + m * 16) * ldc + col0; const float rsc_ = rsc[ai][m];
#pragma unroll
                for (int bj = 0; bj < 2; ++bj) { f32x4 v0 = (acc[ai][bj][m][0] + bv[bj][0]) * rsc_, v1 = (acc[ai][bj][m][1] + bv[bj][1]) * rsc_;
                    if (ACT == 1) { f32x2 a = gelu_pk((f32x2){v0[0], v0[1]}), b = gelu_pk((f32x2){v0[2], v0[3]}), c = gelu_pk((f32x2){v1[0], v1[1]}), d = gelu_pk((f32x2){v1[2], v1[3]});
                        v0 = (f32x4){a.x, a.y, b.x, b.y}; v1 = (f32x4){c.x, c.y, d.x, d.y}; }
                    if (ACT == 2) { _Pragma("unroll") for (int q_ = 0; q_ < 4; ++q_) { const float a0_ = v0[q_] > 0.f ? v0[q_] : 0.f, a1_ = v1[q_] > 0.f ? v1[q_] : 0.f; v0[q_] = a0_ * a0_; v1[q_] = a1_ * a1_; } }
                    v0 = v0 * sc; v1 = v1 * sc; u32x4 w; w.x = cvt_pk_bf16(v0[0], v0[1]); w.y = cvt_pk_bf16(v0[2], v0[3]); w.z = cvt_pk_bf16(v1[0], v1[1]); w.w = cvt_pk_bf16(v1[2], v1[3]);
                    *(u32x4*)(rowp + bj * HALF) = w; } }
    }
};

template <class Epi, class Sched, bool ALIGN_EPI = false, bool SP2 = false>
__device__ __forceinline__ void gemm_phase(PG8_LAS unsigned char* lds, const Gemm g, const Sched& S, const Epi& E) {
    int tid_ = threadIdx.x; asm volatile("" : "+v"(tid_)); const int tid = tid_, wid = __builtin_amdgcn_readfirstlane(tid >> 6), lane = tid & 63, wr = wid >> 2, wc = wid & 3, fr = lane & 15, fq = lane >> 4;
    const int K = g.K, nt = K / BK;
    unsigned voffA[2], voffB[2];
#pragma unroll
    for (int i = 0; i < 2; ++i) { int R, C; stage_rc(tid * 16 + i * 8192, R, C); const int Rb = Epi::PERM ? ((R & ~31) + perm32(R & 31)) : R;
        voffA[i] = (unsigned)(R * K + C) * 2u; voffB[i] = (unsigned)(Rb * K + C) * 2u; }
    const size_t kstep = (size_t)(BK * 2);
    const size_t hstep = (size_t)HALF * K * 2;
    const size_t tstep = 2 * hstep;
    const unsigned ldsw = (unsigned)wid * 1024u;
    const int aoff = lds_byte(wr * 64 + fr, fq * 8), boff = lds_byte(wc * 32 + fr, fq * 8);
#define PG8_SA(b, h) (((b) * 2 + (h)) * HTB)
#define PG8_SB(b, h) ((4 + (b) * 2 + (h)) * HTB)
#define PG8_STAGE(bufoff, gbase, voff) do { _Pragma("unroll") for (int _i = 0; _i < 2; ++_i) \
        __builtin_amdgcn_global_load_lds((const unsigned*)((const char*)(gbase) + (voff)[_i]), (PG8_LAS unsigned*)(lds + (bufoff) + ldsw + _i * 8192), 16, 0, 0); } while (0)
#define PG8_LDA(dst, b, h) do { _Pragma("unroll") for (int m = 0; m < 4; ++m) _Pragma("unroll") for (int k = 0; k < 2; ++k) dst[m][k] = *(const PG8_LAS bf16x8*)(lds + PG8_SA(b, h) + aoff + m * 2048 + k * 1024); } while (0)
#define PG8_LDB(dst, b, h) do { _Pragma("unroll") for (int n = 0; n < 2; ++n) _Pragma("unroll") for (int k = 0; k < 2; ++k) dst[n][k] = *(const PG8_LAS bf16x8*)(lds + PG8_SB(b, h) + boff + n * 2048 + k * 1024); } while (0)
#define PG8_MMA(ai, bj, At, Bt) do { __builtin_amdgcn_s_setprio(1); _Pragma("unroll") for (int m = 0; m < 4; ++m) _Pragma("unroll") for (int n = 0; n < 2; ++n) _Pragma("unroll") for (int k = 0; k < 2; ++k) \
        acc[ai][bj][m][n] = __builtin_amdgcn_mfma_f32_16x16x32_bf16(Bt[n][k], At[m][k], acc[ai][bj][m][n], 0, 0, 0); __builtin_amdgcn_s_setprio(0); } while (0)
#define PG8_WAIT_V(n) asm volatile("s_waitcnt vmcnt(" #n ")" ::: "memory")
#define PG8_WAIT_L(n) asm volatile("s_waitcnt lgkmcnt(" #n ")" ::: "memory")
#define PG8_BAR __builtin_amdgcn_s_barrier()
#define PG8_SCHED __builtin_amdgcn_sched_barrier(0)
    Unit cur, nxt; int ui = 0;
    if (!S.next(0, cur)) return;
    f32x4 acc[2][2][4][2];
#pragma unroll
    for (int a = 0; a < 2; ++a)
#pragma unroll
        for (int b = 0; b < 2; ++b)
#pragma unroll
            for (int m = 0; m < 4; ++m)
#pragma unroll
                for (int n = 0; n < 2; ++n) acc[a][b][m][n] = (f32x4){0.f, 0.f, 0.f, 0.f};
    bf16x8 At[4][2], B0[2][2], B1[2][2];
    const char* cA = (const char*)g.A + (size_t)cur.pm * tstep; const char* cB = (const char*)g.Bt + (size_t)cur.pn * tstep;
    S.a_ready(cur);
    if constexpr (SP2) {
        PG8_STAGE(PG8_SB(0, 0), cB, voffB); PG8_STAGE(PG8_SB(0, 1), cB + hstep, voffB); PG8_STAGE(PG8_SA(0, 0), cA, voffA); PG8_STAGE(PG8_SA(0, 1), cA + hstep, voffA);
        if (wr == 1) PG8_BAR;
        PG8_WAIT_V(2); PG8_BAR;
        PG8_STAGE(PG8_SB(1, 0), cB + kstep, voffB); PG8_STAGE(PG8_SA(1, 0), cA + kstep, voffA); PG8_STAGE(PG8_SB(1, 1), cB + hstep + kstep, voffB);
        PG8_WAIT_V(6); PG8_BAR;
    } else {
        PG8_STAGE(PG8_SB(0, 0), cB, voffB); PG8_STAGE(PG8_SA(0, 0), cA, voffA); PG8_STAGE(PG8_SB(0, 1), cB + hstep, voffB); PG8_STAGE(PG8_SA(0, 1), cA + hstep, voffA);
        if (wr == 1) PG8_BAR;
        PG8_WAIT_V(4); PG8_BAR;
        PG8_STAGE(PG8_SB(1, 0), cB + kstep, voffB); PG8_STAGE(PG8_SA(1, 0), cA + kstep, voffA); PG8_STAGE(PG8_SB(1, 1), cB + hstep + kstep, voffB);
        PG8_WAIT_V(6); PG8_BAR;
    }
    for (;;) {
        const bool has_next = S.next(ui + 1, nxt);
        const char* nA = has_next ? (const char*)g.A + (size_t)nxt.pm * tstep : cA; const char* nB = has_next ? (const char*)g.Bt + (size_t)nxt.pn * tstep : cB;
        for (int t = 0; t < nt; t += 2) {
            const bool last = (t == nt - 2);
            const char* a1 = cA + (size_t)(t + 1) * kstep;
            const char* a2 = last ? nA : cA + (size_t)(t + 2) * kstep; const char* b2 = last ? nB : cB + (size_t)(t + 2) * kstep;
            const char* a3 = a2 + kstep; const char* b3 = b2 + kstep;
            if (last && has_next) S.a_ready(nxt);
            if constexpr (SP2) {
            PG8_LDB(B0, 0, 0); PG8_LDB(B1, 0, 1); PG8_SCHED; PG8_LDA(At, 0, 0); PG8_STAGE(PG8_SA(1, 1), a1 + hstep, voffA);
            PG8_WAIT_V(8); PG8_WAIT_L(0); PG8_BAR; PG8_MMA(0, 0, At, B0); PG8_MMA(0, 1, At, B1); PG8_BAR; PG8_SCHED;
            PG8_LDA(At, 0, 1); PG8_STAGE(PG8_SB(0, 0), b2, voffB); PG8_STAGE(PG8_SB(0, 1), b2 + hstep, voffB); PG8_STAGE(PG8_SA(0, 0), a2, voffA);
            PG8_WAIT_V(8); PG8_WAIT_L(0); PG8_BAR; PG8_MMA(1, 0, At, B0); PG8_MMA(1, 1, At, B1); PG8_BAR; PG8_SCHED;
            PG8_LDB(B0, 1, 0); PG8_LDB(B1, 1, 1); PG8_SCHED; PG8_LDA(At, 1, 0); PG8_STAGE(PG8_SA(0, 1), a2 + hstep, voffA);
            PG8_WAIT_V(8); PG8_WAIT_L(0); PG8_BAR; PG8_MMA(0, 0, At, B0); PG8_MMA(0, 1, At, B1); PG8_BAR; PG8_SCHED;
            PG8_LDA(At, 1, 1); PG8_STAGE(PG8_SB(1, 0), b3, voffB); PG8_STAGE(PG8_SB(1, 1), b3 + hstep, voffB); PG8_STAGE(PG8_SA(1, 0), a3, voffA);
            PG8_WAIT_V(8); PG8_WAIT_L(0); PG8_BAR; PG8_MMA(1, 0, At, B0); PG8_MMA(1, 1, At, B1); PG8_BAR; PG8_SCHED;
            } else {
            PG8_LDB(B0, 0, 0); PG8_SCHED; PG8_LDA(At, 0, 0); PG8_STAGE(PG8_SA(1, 1), a1 + hstep, voffA);
            PG8_WAIT_L(8); PG8_BAR; PG8_WAIT_L(0); PG8_MMA(0, 0, At, B0); PG8_BAR; PG8_SCHED;
            PG8_LDB(B1, 0, 1); PG8_STAGE(PG8_SB(0, 0), b2, voffB);
            PG8_BAR; PG8_WAIT_L(0); PG8_MMA(0, 1, At, B1); PG8_BAR;
            PG8_LDA(At, 0, 1); PG8_STAGE(PG8_SA(0, 0), a2, voffA);
            PG8_BAR; PG8_WAIT_L(0); PG8_MMA(1, 0, At, B0); PG8_BAR; PG8_SCHED;
            PG8_STAGE(PG8_SB(0, 1), b2 + hstep, voffB);
            PG8_WAIT_V(6); PG8_BAR; PG8_MMA(1, 1, At, B1); PG8_BAR;
            PG8_LDB(B0, 1, 0); PG8_SCHED; PG8_LDA(At, 1, 0); PG8_STAGE(PG8_SA(0, 1), a2 + hstep, voffA);
            PG8_WAIT_L(8); PG8_BAR; PG8_WAIT_L(0); PG8_MMA(0, 0, At, B0); PG8_BAR; PG8_SCHED;
            PG8_LDB(B1, 1, 1); PG8_STAGE(PG8_SB(1, 0), b3, voffB);
            PG8_BAR; PG8_WAIT_L(0); PG8_MMA(0, 1, At, B1); PG8_BAR;
            PG8_LDA(At, 1, 1); PG8_STAGE(PG8_SA(1, 0), a3, voffA);
            PG8_BAR; PG8_WAIT_L(0); PG8_MMA(1, 0, At, B0); PG8_BAR; PG8_SCHED;
            PG8_STAGE(PG8_SB(1, 1), b3 + hstep, voffB);
            PG8_WAIT_V(6); PG8_BAR; PG8_MMA(1, 1, At, B1); PG8_BAR;
            }
        }
        if constexpr (ALIGN_EPI) { if (wr == 0) PG8_BAR; }
        if constexpr (!Epi::AFTER_DRAIN) { E(acc, cur, wr, wc, fr, fq); S.done(cur); }
        if (!has_next) break;
#pragma unroll
        for (int a = 0; a < 2; ++a)
#pragma unroll
            for (int b = 0; b < 2; ++b)
#pragma unroll
                for (int m = 0; m < 4; ++m)
#pragma unroll
                    for (int n = 0; n < 2; ++n) acc[a][b][m][n] = (f32x4){0.f, 0.f, 0.f, 0.f};
        cur = nxt; cA = nA; cB = nB; ++ui;
        if constexpr (ALIGN_EPI) { if (wr == 1) PG8_BAR; }
    }
    PG8_WAIT_V(0);
    if constexpr (!ALIGN_EPI) { if (wr == 0) PG8_BAR; }
    PG8_BAR;
    if constexpr (Epi::AFTER_DRAIN) { E.fused(acc, cur, wr, wc, fr, fq, lds, wid, lane); S.done(cur); }
#undef PG8_SA
#undef PG8_SB
#undef PG8_STAGE
#undef PG8_LDA
#undef PG8_LDB
#undef PG8_MMA
#undef PG8_WAIT_V
#undef PG8_WAIT_L
#undef PG8_BAR
#undef PG8_SCHED
}
}

#ifndef PG8_SP2
#define PG8_SP2 true
#endif
#ifndef PG8_ALIGN
#define PG8_ALIGN true
#endif
#include <hip/hip_bf16.h>
#include <cmath>
namespace attn_body {
using bf16=__hip_bfloat16;
using bf16x8=__attribute__((ext_vector_type(8)))short;
using s16x4=__attribute__((ext_vector_type(4)))short;
using f32x16=__attribute__((ext_vector_type(16)))float;
using u32x4=__attribute__((ext_vector_type(4)))unsigned;
constexpr int D=64;
constexpr int NW=8,QBLK=32,QB=QBLK*NW,KVBLK=64;
__device__ __forceinline__ int crow(int r,int hi){return (r&3)+8*(r>>2)+4*hi;}
#define SBAR() __builtin_amdgcn_sched_barrier(0)
__device__ __forceinline__ void cmask(f32x16&p0,f32x16&p1,int jb,int qrel,int hi){
  const float NEG=-INFINITY; int kb=64*jb+4*hi;
  #pragma unroll
  for(int r=0;r<16;++r){int kv=kb+(r&3)+8*(r>>2); if(kv>qrel)p0[r]=NEG; if(kv+32>qrel)p1[r]=NEG;}
}

constexpr int NSLOT=3, SLOTB=8192;
constexpr int LDS_K=0, LDS_V=NSLOT*SLOTB, LDS_WS=2*NSLOT*SLOTB, LDS_OST=LDS_WS+NW*64*4, LDS_BYTES=LDS_OST+NW*4096;
constexpr float C2=0.125f*1.4426950408889634f;
__device__ __forceinline__ void glds16(const void*gsrc,unsigned lds_dst){unsigned keep;
  asm volatile("s_mov_b32 %0, m0\n\ts_mov_b32 m0, %2\n\ts_nop 0\n\tglobal_load_lds_dwordx4 %1, off\n\ts_mov_b32 m0, %0":"=&s"(keep):"v"(gsrc),"s"(lds_dst):"memory");}
__device__ __forceinline__ float max3f(float a,float b,float c){float r;asm("v_max3_f32 %0, %1, %2, %3":"=v"(r):"v"(a),"v"(b),"v"(c));return r;}
__device__ __forceinline__ float max2f(float a,float b){float r;asm("v_max_f32_e32 %0, %1, %2":"=v"(r):"v"(a),"v"(b));return r;}
__device__ __forceinline__ float fadd_s(float a,float b){float r;asm("v_add_f32_e32 %0, %1, %2":"=v"(r):"v"(a),"v"(b));return r;}
__device__ __forceinline__ float fsub_s(float a,float b){float r;asm("v_sub_f32_e32 %0, %1, %2":"=v"(r):"v"(a),"v"(b));return r;}
typedef float f32x2_t __attribute__((ext_vector_type(2))); typedef __bf16 bf16x2_t __attribute__((ext_vector_type(2)));
__device__ __forceinline__ unsigned cvtpk_s(float lo,float hi){f32x2_t v={lo,hi};bf16x2_t b=__builtin_convertvector(v,bf16x2_t);return __builtin_bit_cast(unsigned,b);}
#define WAIT_BAR(N) asm volatile("s_waitcnt vmcnt(" #N ") lgkmcnt(0)\n\ts_barrier":::"memory")

__device__ __forceinline__ void qkt(f32x16&p0,f32x16&p1,const char*Kslot,const bf16x8*qr,const f32x16&negm,int r32,int hi){
  const char*kb=Kslot+hi*1024+r32*16;
  #pragma unroll
  for(int d0=0;d0<4;++d0){
    const bf16x8 b0=*reinterpret_cast<const bf16x8*>(kb+d0*2048);
    const bf16x8 b1=*reinterpret_cast<const bf16x8*>(kb+d0*2048+512);
    if(d0==0){p0=__builtin_amdgcn_mfma_f32_32x32x16_bf16(b0,qr[0],negm,0,0,0);p1=__builtin_amdgcn_mfma_f32_32x32x16_bf16(b1,qr[0],negm,0,0,0);}
    else{p0=__builtin_amdgcn_mfma_f32_32x32x16_bf16(b0,qr[d0],p0,0,0,0);p1=__builtin_amdgcn_mfma_f32_32x32x16_bf16(b1,qr[d0],p1,0,0,0);}}
}
typedef __attribute__((address_space(3))) const char* lds_cptr;
typedef short v4i16_t __attribute__((ext_vector_type(4)));
__device__ __forceinline__ void kload8(bf16x8*kf,lds_cptr kp){
  kf[0]=*(const __attribute__((address_space(3))) bf16x8*)(kp);      kf[1]=*(const __attribute__((address_space(3))) bf16x8*)(kp+512);
  kf[2]=*(const __attribute__((address_space(3))) bf16x8*)(kp+2048); kf[3]=*(const __attribute__((address_space(3))) bf16x8*)(kp+2560);
  kf[4]=*(const __attribute__((address_space(3))) bf16x8*)(kp+4096); kf[5]=*(const __attribute__((address_space(3))) bf16x8*)(kp+4608);
  kf[6]=*(const __attribute__((address_space(3))) bf16x8*)(kp+6144); kf[7]=*(const __attribute__((address_space(3))) bf16x8*)(kp+6656);
}
__device__ __forceinline__ void kload2(bf16x8*kf,lds_cptr kp,int j){ kf[2*j]=*(const __attribute__((address_space(3))) bf16x8*)(kp+j*2048); kf[2*j+1]=*(const __attribute__((address_space(3))) bf16x8*)(kp+j*2048+512); }
__device__ __forceinline__ s16x4 vtr(lds_cptr p){ return __builtin_bit_cast(s16x4,__builtin_amdgcn_ds_read_tr16_b64_v4i16((__attribute__((address_space(3))) v4i16_t*)p)); }
__device__ __forceinline__ float rowmax(const f32x16&p0,const f32x16&p1){
  float a=max3f(p0[0],p0[1],p1[0]),b=max3f(p0[2],p0[3],p1[1]);a=max3f(a,p1[2],p1[3]);
  #pragma unroll
  for(int r=4;r<16;r+=4){a=max3f(a,p0[r],p0[r+1]);b=max3f(b,p0[r+2],p0[r+3]);a=max3f(a,p1[r],p1[r+1]);b=max3f(b,p1[r+2],p1[r+3]);}
  const float m=max2f(a,b);
  auto rr=__builtin_amdgcn_permlane32_swap(__float_as_uint(m),__float_as_uint(m),false,false);
  return max2f(__uint_as_float(rr[0]),__uint_as_float(rr[1]));
}
__device__ __forceinline__ void pv(f32x16*o,int vb,bf16x8 pa0,bf16x8 pa1,bf16x8 pa2,bf16x8 pa3){
  #pragma unroll
  for(int d0=0;d0<2;++d0){s16x4 lo[4],hi[4];
    #pragma unroll
    for(int ks=0;ks<4;++ks){
      asm volatile("ds_read_b64_tr_b16 %0,%1 offset:%c2":"=&v"(lo[ks]):"v"(vb),"i"(d0*4096+ks*1024):"memory");
      asm volatile("ds_read_b64_tr_b16 %0,%1 offset:%c2":"=&v"(hi[ks]):"v"(vb),"i"(d0*4096+ks*1024+512):"memory");}
    asm volatile("s_waitcnt lgkmcnt(0)":::"memory");SBAR();
    #define PK(k) (bf16x8){lo[k][0],lo[k][1],lo[k][2],lo[k][3],hi[k][0],hi[k][1],hi[k][2],hi[k][3]}
    o[d0]=__builtin_amdgcn_mfma_f32_32x32x16_bf16(pa0,PK(0),o[d0],0,0,0);
    o[d0]=__builtin_amdgcn_mfma_f32_32x32x16_bf16(pa1,PK(1),o[d0],0,0,0);
    o[d0]=__builtin_amdgcn_mfma_f32_32x32x16_bf16(pa2,PK(2),o[d0],0,0,0);
    o[d0]=__builtin_amdgcn_mfma_f32_32x32x16_bf16(pa3,PK(3),o[d0],0,0,0);
    #undef PK
  }
}

#ifndef ATTN_STORE16
#define ATTN_STORE16(p,v) (*(u32x4*)(p)=(v))
#endif
template<int THRL> __device__ __forceinline__ void attn_unit(int qb,int SEQ,const bf16*Q,int QP,const bf16*__restrict__ K,const bf16*__restrict__ V,int KP,bf16*O,int OP,char*shm){
  int tid_=threadIdx.x; asm volatile("":"+v"(tid_)); const int tid=tid_,lane=tid&63,r32=lane&31,hi=lane>>5; const int wid=__builtin_amdgcn_readfirstlane(tid>>6);
  const int q0=qb*QB;
  const bf16*Qw=Q+(long)(q0+wid*QBLK)*QP;
  const bf16*Kh=K,*Vh=V;
  const unsigned lds0=(unsigned)(uintptr_t)shm;
  float*wsf=(float*)(shm+LDS_WS)+wid*64;
  const bf16*ksrc=Kh+(long)lane*KP+wid*8;
  const bf16*vsrc=Vh+(long)(16*(wid&3)+(lane>>2))*KP+(wid>>2)*32+(lane&3)*8;
  const unsigned kdst=lds0+LDS_K+wid*1024, vdst=lds0+LDS_V+wid*1024;
  #define DMA_K(t,slot) glds16(ksrc+(long)(t)*KVBLK*KP,(unsigned)__builtin_amdgcn_readfirstlane(kdst+(slot)))
  #define DMA_V(t,slot) glds16(vsrc+(long)(t)*KVBLK*KP,(unsigned)__builtin_amdgcn_readfirstlane(vdst+(slot)))
  const int vb0=(int)(lds0+LDS_V)+((lane>>4)&1)*32+(lane&3)*8+(4*hi+((lane&15)>>2))*64;
  const char*Kbase=shm+LDS_K; bf16x8 kf[8];
  const lds_cptr shm3=(lds_cptr)shm; const lds_cptr kp0=shm3+LDS_K+hi*1024+r32*16; const lds_cptr vp0=shm3+LDS_V+((lane>>4)&1)*32+(lane&3)*8+(4*hi+((lane&15)>>2))*64;
  const int NT=SEQ/KVBLK;
  DMA_K(0,0);DMA_V(0,0);DMA_K(1,SLOTB);
  bf16x8 qr[4];
  #pragma unroll
  for(int d0=0;d0<4;++d0)qr[d0]=*reinterpret_cast<const bf16x8*>(&Qw[(long)r32*QP+d0*16+hi*8]);
  float mhat=0.f,l_reg=0.f;f32x16 o[2];o[0]=f32x16{};o[1]=f32x16{};f32x16 negm=f32x16{};asm volatile("":"+v"(negm));
  const int qrel=wid*QBLK+r32;
  #define CMASK(P0,P1,t) do{}while(0)
  bool resc=false;
  #define START(P0,P1) do{ const float rm=rowmax(P0,P1); resc=false; \
    { const float dl=rm; mhat=fadd_s(mhat,dl); \
      _Pragma("unroll") for(int r=0;r<16;++r){P0[r]=fsub_s(P0[r],dl);P1[r]=fsub_s(P1[r],dl);} \
      _Pragma("unroll") for(int r=0;r<16;++r)negm[r]=-mhat; asm volatile("":"+v"(negm)); } \
    _Pragma("unroll") for(int r=0;r<16;++r)P0[r]=__builtin_amdgcn_exp2f(P0[r]); }while(0)
  #define RESC() do{ if(resc){ asm volatile("s_waitcnt lgkmcnt(0)":::"memory"); \
      _Pragma("unroll") for(int d_=0;d_<2;++d_) _Pragma("unroll") for(int r=0;r<16;++r)o[d_][r]*=wsf[crow(r,hi)]; } }while(0)
  f32x16 pA0,pA1,pB0,pB1;
  int sl_prev=0,sl_cur=0,sl_next=SLOTB;
  #define ROT() do{sl_prev=sl_cur;sl_cur=sl_next;sl_next=(sl_next==(NSLOT-1)*SLOTB)?0:sl_next+SLOTB;}while(0)
  DMA_K(2,2*SLOTB);
  WAIT_BAR(3);
  qkt(pA0,pA1,Kbase,qr,negm,r32,hi);asm volatile("s_nop 15\n\ts_nop 7":"+v"(pA0),"+v"(pA1));CMASK(pA0,pA1,0);
  START(pA0,pA1);
  _Pragma("unroll") for(int r=0;r<16;++r)pA1[r]=__builtin_amdgcn_exp2f(pA1[r]);
  WAIT_BAR(0);
  DMA_K(3,0);DMA_V(1,SLOTB);
  ROT();
  kload8(kf,kp0+sl_cur);
  WAIT_BAR(2);
  s16x4 vlo[8],vhi[8]; u32x4 pw0,pw1,pw2,pw3;
  #define PKW(P,B) cvtpk_s(P[B],P[B+1])
  #define PAF(k) __builtin_bit_cast(bf16x8,pw##k)
  #define VFR(i) (bf16x8){vlo[i][0],vlo[i][1],vlo[i][2],vlo[i][3],vhi[i][0],vhi[i][1],vhi[i][2],vhi[i][3]}
  #define PIN(x) asm volatile("":"+v"(x))
  #define MX3(a,b,c) __builtin_fmaxf(__builtin_fmaxf((a),(b)),(c))
  #define GAPA(MF,A0,A1,A2,A3,W0,W1,PW) do{ MF; sacc+=A0; sacc+=A1; sacc+=A2; sacc+=A3; PIN(sacc); W0; W1; PIN(PW); SBAR(); }while(0)
  #define EX(v) __builtin_amdgcn_exp2f(v)
  #define GAPB(MF,X,B) do{ MF; X[B]=EX(X[B]); X[B+1]=EX(X[B+1]); X[B+2]=EX(X[B+2]); X[B+3]=EX(X[B+3]); PIN(X); SBAR(); }while(0)
  #define VRD(i) do{ vlo[i]=vtr(vp_+(((i)>>2)*4096+((i)&3)*1024)); vhi[i]=vtr(vp_+(((i)>>2)*4096+((i)&3)*1024+512)); }while(0)
  #define KRD(G,j) do{ if(G){ kload2(kf,kp0+sl_next,j); SBAR(); } }while(0)
  #define STEP(C0,C1,P0,P1,t,GK,GV,GL) do{ SBAR(); \
    const lds_cptr vp_=vp0+sl_prev; \
    VRD(0); SBAR(); float sacc=(P0[0]+P0[1]); \
    GAPA(C0=__builtin_amdgcn_mfma_f32_32x32x16_bf16(kf[0],qr[0],negm,0,0,0), P0[2],P0[3],P0[4],P0[5],     pw0[0]=PKW(P0,0), pw0[1]=PKW(P0,2), pw0); \
    VRD(4); SBAR(); GAPA(C1=__builtin_amdgcn_mfma_f32_32x32x16_bf16(kf[1],qr[0],negm,0,0,0), P0[6],P0[7],P0[8],P0[9],     pw0[2]=PKW(P0,4), pw0[3]=PKW(P0,6), pw0); \
    VRD(1); SBAR(); GAPA(C0=__builtin_amdgcn_mfma_f32_32x32x16_bf16(kf[2],qr[1],C0,0,0,0),   P0[10],P0[11],P0[12],P0[13], pw1[0]=PKW(P0,8), pw1[1]=PKW(P0,10), pw1); \
    VRD(5); SBAR(); GAPA(C1=__builtin_amdgcn_mfma_f32_32x32x16_bf16(kf[3],qr[1],C1,0,0,0),   P0[14],P0[15],P1[0],P1[1],   pw1[2]=PKW(P0,12),pw1[3]=PKW(P0,14), pw1); \
    VRD(2); SBAR(); GAPA(C0=__builtin_amdgcn_mfma_f32_32x32x16_bf16(kf[4],qr[2],C0,0,0,0),   P1[2],P1[3],P1[4],P1[5],     pw2[0]=PKW(P1,0), pw2[1]=PKW(P1,2), pw2); \
    VRD(6); SBAR(); GAPA(C1=__builtin_amdgcn_mfma_f32_32x32x16_bf16(kf[5],qr[2],C1,0,0,0),   P1[6],P1[7],P1[8],P1[9],     pw2[2]=PKW(P1,4), pw2[3]=PKW(P1,6), pw2); \
    VRD(3); SBAR(); GAPA(C0=__builtin_amdgcn_mfma_f32_32x32x16_bf16(kf[6],qr[3],C0,0,0,0),   P1[10],P1[11],P1[12],P1[13], pw3[0]=PKW(P1,8), pw3[1]=PKW(P1,10), pw3); \
    VRD(7); SBAR(); GAPA(C1=__builtin_amdgcn_mfma_f32_32x32x16_bf16(kf[7],qr[3],C1,0,0,0),   P1[14],P1[15],0.f,0.f,       pw3[2]=PKW(P1,12),pw3[3]=PKW(P1,14), pw3); \
    l_reg+=sacc; \
    if(GK){DMA_K((t)+3,sl_cur);} if(GV){DMA_V((t)+1,sl_next);} \
    CMASK(C0,C1,t); \
    { float a=MX3(C0[0],C0[1],C1[0]),b=MX3(C0[2],C0[3],C1[1]); a=MX3(a,C1[2],C1[3]); \
      _Pragma("unroll") for(int r=4;r<16;r+=4){a=MX3(a,C0[r],C0[r+1]);b=MX3(b,C0[r+2],C0[r+3]);a=MX3(a,C1[r],C1[r+1]);b=MX3(b,C1[r+2],C1[r+3]);} \
      float rm=__builtin_fmaxf(a,b); { auto rr=__builtin_amdgcn_permlane32_swap(__float_as_uint(rm),__float_as_uint(rm),false,false); rm=__builtin_fmaxf(__uint_as_float(rr[0]),__uint_as_float(rr[1])); } \
      resc=false; \
      if(__builtin_expect(__any(rm>(float)THRL),0)){ const float dl=__builtin_fmaxf(rm,0.f); mhat+=dl; \
        _Pragma("unroll") for(int r=0;r<16;++r){C0[r]-=dl;C1[r]-=dl;} \
        _Pragma("unroll") for(int r=0;r<16;++r)negm[r]=-mhat; asm volatile("":"+v"(negm)); \
        const float f=__builtin_amdgcn_exp2f(-dl); l_reg*=f; if(hi==0)wsf[r32]=f; resc=true; } } \
    SBAR(); \
    GAPB(o[0]=__builtin_amdgcn_mfma_f32_32x32x16_bf16(PAF(0),VFR(0),o[0],0,0,0), C0,0); \
    GAPB(o[1]=__builtin_amdgcn_mfma_f32_32x32x16_bf16(PAF(0),VFR(4),o[1],0,0,0), C0,4); \
    KRD(GL,0); GAPB(o[0]=__builtin_amdgcn_mfma_f32_32x32x16_bf16(PAF(1),VFR(1),o[0],0,0,0), C0,8); \
    KRD(GL,1); GAPB(o[1]=__builtin_amdgcn_mfma_f32_32x32x16_bf16(PAF(1),VFR(5),o[1],0,0,0), C0,12); \
    KRD(GL,2); GAPB(o[0]=__builtin_amdgcn_mfma_f32_32x32x16_bf16(PAF(2),VFR(2),o[0],0,0,0), C1,0); \
    KRD(GL,3); GAPB(o[1]=__builtin_amdgcn_mfma_f32_32x32x16_bf16(PAF(2),VFR(6),o[1],0,0,0), C1,4); \
    GAPB(o[0]=__builtin_amdgcn_mfma_f32_32x32x16_bf16(PAF(3),VFR(3),o[0],0,0,0), C1,8); \
    GAPB(o[1]=__builtin_amdgcn_mfma_f32_32x32x16_bf16(PAF(3),VFR(7),o[1],0,0,0), C1,12); \
    }while(0)
  int t=1;
  #undef CMASK
  #define CMASK(P0,P1,t) do{}while(0)
  for(;t+5<NT;t+=2){
    STEP(pB0,pB1,pA0,pA1,t,true,true,true);     WAIT_BAR(2); RESC(); ROT();
    STEP(pA0,pA1,pB0,pB1,t+1,true,true,true);   WAIT_BAR(2); RESC(); ROT();
  }
  #undef CMASK
  #define CMASK(P0,P1,t) do{}while(0)
  #define ENDW(tt) do{ if((tt)+3<NT){WAIT_BAR(2);} else if((tt)+2<NT){WAIT_BAR(1);} else {WAIT_BAR(0);} }while(0)
  for(;t+1<NT;t+=2){
    STEP(pB0,pB1,pA0,pA1,t,(t+3<NT),(t+1<NT),(t+1<NT));       ENDW(t);   RESC(); ROT();
    STEP(pA0,pA1,pB0,pB1,t+1,(t+4<NT),(t+2<NT),(t+2<NT));     ENDW(t+1); RESC(); ROT();
  }
  STEP(pB0,pB1,pA0,pA1,NT-1,false,false,false); RESC();
  { float sacc=pB0[0]+pB0[1]; _Pragma("unroll") for(int r=2;r<16;++r)sacc+=pB0[r]; _Pragma("unroll") for(int r=0;r<16;++r)sacc+=pB1[r]; l_reg+=sacc;
    pw0=(u32x4){PKW(pB0,0),PKW(pB0,2),PKW(pB0,4),PKW(pB0,6)};pw1=(u32x4){PKW(pB0,8),PKW(pB0,10),PKW(pB0,12),PKW(pB0,14)};pw2=(u32x4){PKW(pB1,0),PKW(pB1,2),PKW(pB1,4),PKW(pB1,6)};pw3=(u32x4){PKW(pB1,8),PKW(pB1,10),PKW(pB1,12),PKW(pB1,14)};
    SBAR(); pv(o,vb0+sl_cur,PAF(0),PAF(1),PAF(2),PAF(3)); }
  #undef PKW
  #undef PAF
  #undef VFR
  #undef PIN
  #undef MX3
  #undef GAPA
  #undef GAPB
  #undef EX
  #undef VRD
  #undef KRD
  #undef STEP
  #undef ENDW
  {auto rr=__builtin_amdgcn_permlane32_swap(__float_as_uint(l_reg),__float_as_uint(l_reg),false,false);l_reg=__uint_as_float(rr[0])+__uint_as_float(rr[1]);}
  if(hi==0)wsf[32+r32]=l_reg;asm volatile("s_waitcnt lgkmcnt(0)":::"memory");
  float rli[16];
  #pragma unroll
  for(int r=0;r<16;++r)rli[r]=__builtin_amdgcn_rcpf(wsf[32+crow(r,hi)]);
  bf16*Ow=O+(long)(q0+wid*QBLK)*OP;
  { bf16*stg=(bf16*)(shm+LDS_OST)+wid*2048;
    #pragma unroll
    for(int r=0;r<16;++r){const int orow=crow(r,hi);
      #pragma unroll
      for(int d0=0;d0<2;++d0)stg[orow*64+d0*32+r32]=__float2bfloat16(o[d0][r]*rli[r]);}
    asm volatile("s_waitcnt lgkmcnt(0)":::"memory");
    #pragma unroll
    for(int i=0;i<4;++i){const int row=i*8+(lane>>3),ch=lane&7; const u32x4 v=*(const u32x4*)(stg+row*64+ch*8); ATTN_STORE16(Ow+(long)row*OP+ch*8,v);} }
  asm volatile("s_waitcnt lgkmcnt(0)\n\ts_barrier":::"memory");
  #undef DMA_K
  #undef DMA_V
  #undef CMASK
  #undef START
  #undef RESC
  #undef ROT
}
constexpr int ATTN_LDS_BYTES=LDS_BYTES;
#undef SBAR
#undef WAIT_BAR
}
namespace xb {
#define GAS __attribute__((address_space(1)))
#define LAS __attribute__((address_space(3)))
typedef GAS unsigned gu32;
typedef GAS unsigned long long gu64;
#define RLX_AGENT __ATOMIC_RELAXED, __HIP_MEMORY_SCOPE_AGENT
#define LDS_WAIT() asm volatile("s_waitcnt lgkmcnt(0)" ::: "memory")
#define VM_WAIT() asm volatile("s_waitcnt vmcnt(0)" ::: "memory")
__device__ __forceinline__ unsigned long long rt() { return __builtin_amdgcn_s_memrealtime(); }
__device__ __forceinline__ unsigned f2bf(float f) { unsigned u = __builtin_bit_cast(unsigned, f); return (u + 0x7fffu + ((u >> 16) & 1u)) >> 16; }
__device__ __forceinline__ unsigned pk2(float lo, float hi) { return f2bf(lo) | (f2bf(hi) << 16); }

#define XB_TMO      128
#define XB_XCNT(j)  (256  + 64 * (j))
#define XB_XSUB(j)  (1280 + 64 * (j))
#define XB_XGEN(j)  (2304 + 64 * (j))
#define XB_TOP      3328
#define XB_TOPGEN   3392
#define XCD_BAR_WORDS 3456
#define XB_SPIN_CAP (1u << 18)

__device__ __forceinline__ unsigned xb_ld(unsigned* p)              { return __hip_atomic_load(p, __ATOMIC_RELAXED, __HIP_MEMORY_SCOPE_AGENT); }
__device__ __forceinline__ unsigned xb_add(unsigned* p, unsigned v) { return __hip_atomic_fetch_add(p, v, __ATOMIC_RELAXED, __HIP_MEMORY_SCOPE_AGENT); }
__device__ __forceinline__ unsigned xb_xcc_id() { return (unsigned)__builtin_amdgcn_s_getreg((3 << 11) | 20) & 0xFu; }
#define XB_SPIN(cond, bar) do { unsigned _sp = 0; while (cond) { __builtin_amdgcn_s_sleep(1); \
    if ((++_sp & 255u) == 0u) { if (xb_ld(&(bar)[XB_TMO])) break; if (_sp > XB_SPIN_CAP) { atomicAdd(&(bar)[XB_TMO], 1u); break; } } } } while (0)

struct XcdBarrier {
    unsigned* bar; unsigned x;
    volatile LAS unsigned* st;
};

__device__ __forceinline__ XcdBarrier xcd_barrier_post(unsigned* bar, volatile LAS unsigned* st) {
    XcdBarrier b; b.bar = bar; b.x = xb_xcc_id(); b.st = st;
    if (threadIdx.x == 0) (void)xb_add(&bar[XB_XCNT(b.x)], 1u);
    return b;
}
__device__ __forceinline__ void xcd_barrier_complete(unsigned* bar, unsigned x, unsigned& nloc, unsigned& nx) {
    const unsigned G = gridDim.x * gridDim.y * gridDim.z;
    unsigned sum, cnt, mine, sp = 0u;
    for (;;) {
        sum = 0u; cnt = 0u; mine = 0u;
#pragma unroll
        for (unsigned j = 0; j < 16; ++j) { const unsigned c = xb_ld(&bar[XB_XCNT(j)]); sum += c; cnt += (c > 0u) ? 1u : 0u; mine = (j == x) ? c : mine; }
        if (sum == G) break;
        __builtin_amdgcn_s_sleep(1);
        if ((++sp & 255u) == 0u) { if (xb_ld(&bar[XB_TMO])) break; if (sp > XB_SPIN_CAP) { atomicAdd(&bar[XB_TMO], 1u); break; } }
    }
    nloc = mine > 0u ? mine : 1u; nx = cnt > 0u ? cnt : 1u;
}

__device__ __forceinline__ void xcd_barrier(const XcdBarrier& b) {
    asm volatile("s_waitcnt vmcnt(0)" ::: "memory");
    __syncthreads();
    if (threadIdx.x == 0) {
        unsigned* bar = b.bar;
        __builtin_amdgcn_s_waitcnt(0);
        unsigned nloc = b.st[0], nx = b.st[1];
        if (nloc == 0u) { xcd_barrier_complete(bar, b.x, nloc, nx); b.st[0] = nloc; b.st[1] = nx; }
        const unsigned old = xb_add(&bar[XB_XSUB(b.x)], 1u);
        const unsigned gen = old / nloc;
        if (old + 1u == (gen + 1u) * nloc) {
            __builtin_amdgcn_fence(__ATOMIC_RELEASE, "agent");
            asm volatile("s_waitcnt vmcnt(0)" ::: "memory");
            const unsigned og = xb_add(&bar[XB_TOP], 1u);
            const unsigned tg = og / nx;
            if (og + 1u == (tg + 1u) * nx) xb_add(&bar[XB_TOPGEN], 1u);
            else XB_SPIN(xb_ld(&bar[XB_TOPGEN]) == tg, bar);
            __builtin_amdgcn_fence(__ATOMIC_ACQUIRE, "agent");
            xb_add(&bar[XB_XGEN(b.x)], 1u);
            asm volatile("s_waitcnt vmcnt(0)" ::: "memory");
        } else {
            XB_SPIN(xb_ld(&bar[XB_XGEN(b.x)]) == gen, bar);
            __builtin_amdgcn_fence(__ATOMIC_ACQUIRE, "agent");
            asm volatile("s_waitcnt vmcnt(0)" ::: "memory");
        }
    }
    __syncthreads();
}

}

namespace mk {
typedef unsigned short bf16_t;
typedef short bf16x8 __attribute__((ext_vector_type(8)));
typedef float f32x4 __attribute__((ext_vector_type(4)));
typedef unsigned u32x4 __attribute__((ext_vector_type(4)));
typedef unsigned u32x2 __attribute__((ext_vector_type(2)));
typedef float f32x2 __attribute__((ext_vector_type(2)));

constexpr int DMODEL = 1024, TS = 16384, NSEG = 4, DFF = 4096;
constexpr int EIN = 1792, OIN = 4368, OINP = 4608, OOUT = 768;
constexpr float EPS = 1e-6f;
constexpr size_t MiB = (size_t)1 << 20;
constexpr size_t WS_W1T = 1 * MiB, WS_W2T = 33 * MiB, WS_WINE = 65 * MiB, WS_WOUTE = 72 * MiB, WS_WINO = 76 * MiB, WS_WOUTO = 94 * MiB,
                 WS_GW = 97 * MiB, WS_H = 98 * MiB, WS_PROJ = 130 * MiB, WS_SCR = 274 * MiB, WS_END = 512 * MiB;
constexpr size_t SC_HID = 0;
constexpr size_t SC_LA = 0, SC_UU = 64 * MiB, SC_AGG = 128 * MiB;
constexpr size_t SC_QKVP = 0, SC_DNI = 48 * MiB, SC_OB = 192 * MiB, SC_LSE = 224 * MiB, SC_EGL = 225 * MiB;
constexpr int DNI_BYTES = 73728, DNI_W = 0, DNI_QT = 16384, DNI_KTT = 32768, DNI_A = 49152, DNI_U = 57344;
constexpr int LDS_BYTES = 147456;
constexpr int NT = 512, NW = 8;

struct Params { const float* in[25]; float* out; unsigned char* ws; };

__device__ __forceinline__ float bf2f(bf16_t v) { return __uint_as_float(((unsigned)v) << 16); }
__device__ __forceinline__ unsigned f2bf(float f) { unsigned u = __float_as_uint(f); return (u + 0x7fffu + ((u >> 16) & 1u)) >> 16; }
__device__ __forceinline__ unsigned pk2(float lo, float hi) { return f2bf(lo) | (f2bf(hi) << 16); }
__device__ __forceinline__ float wave_sum(float v) {
#pragma unroll
    for (int o = 1; o < 64; o <<= 1) v += __shfl_xor(v, o);
    return v;
}
__device__ __forceinline__ float sigm(float x) { return 1.f / (1.f + __expf(-x)); }
__device__ __forceinline__ float softplus(float x) { return x > 20.f ? x : log1pf(__expf(x)); }
__device__ __forceinline__ float silu(float x) { return x * sigm(x); }
__device__ __forceinline__ float gelu_tanh(float x) { const float t = 0.7978845608028654f * (x + 0.044715f * x * x * x); return 0.5f * x * (1.f + tanhf(t)); }
__device__ __forceinline__ void unpack8(const u32x4 v, float* f) {
    f[0] = __uint_as_float(v.x << 16); f[1] = __uint_as_float(v.x & 0xffff0000u); f[2] = __uint_as_float(v.y << 16); f[3] = __uint_as_float(v.y & 0xffff0000u);
    f[4] = __uint_as_float(v.z << 16); f[5] = __uint_as_float(v.z & 0xffff0000u); f[6] = __uint_as_float(v.w << 16); f[7] = __uint_as_float(v.w & 0xffff0000u);
}
#define MK_IDS() int tid = threadIdx.x; asm volatile("" : "+v"(tid)); const int lane = tid & 63, wave = __builtin_amdgcn_readfirstlane(tid >> 6); const int gw = blockIdx.x * NW + wave, NGW = gridDim.x * NW; (void)lane; (void)wave; (void)gw; (void)NGW
#define MFMA16(a, b, c) __builtin_amdgcn_mfma_f32_16x16x32_bf16((a), (b), (c), 0, 0, 0)

__device__ __forceinline__ void transpose_item(const float* W, int K, int Nsrc, int Npad, bf16_t* WT, float* scr, int item, int lane, const float* gain = nullptr) {
    const int nblk = Npad / 32, kb = item / nblk, nb = item % nblk, k0 = 64 * kb, n0 = 32 * nb;
    const int n = n0 + (lane & 31);
#pragma unroll 8
    for (int i = 0; i < 32; ++i) { const int kk = 2 * i + (lane >> 5); scr[kk * 33 + (lane & 31)] = (n < Nsrc) ? W[(size_t)(k0 + kk) * Nsrc + n] * (gain ? gain[k0 + kk] : 1.f) : 0.f; }
    asm volatile("s_waitcnt lgkmcnt(0)" ::: "memory");
    const int c = lane & 7;
#pragma unroll
    for (int j = 0; j < 4; ++j) { const int nn = (lane >> 3) + 8 * j; const float* s = scr + (8 * c) * 33 + nn;
        u32x4 o; o.x = pk2(s[0 * 33], s[1 * 33]); o.y = pk2(s[2 * 33], s[3 * 33]); o.z = pk2(s[4 * 33], s[5 * 33]); o.w = pk2(s[6 * 33], s[7 * 33]);
        *(u32x4*)(WT + (size_t)(n0 + nn) * K + k0 + 8 * c) = o; }
    asm volatile("s_waitcnt lgkmcnt(0)" ::: "memory");
}
__device__ __forceinline__ void phase_prologue(const Params& p, char* lds) {
    MK_IDS();
    float* scr = (float*)(lds + wave * 16384);
    unsigned char* ws = p.ws;
    constexpr int I_F1 = 16 * 128, I_F2 = 64 * 32, I_IE = 16 * 56, I_OE = 16 * 32, I_IO = 16 * 144, I_OO = 12 * 32;
    constexpr int T_F1 = 4 * I_F1, T_F2 = T_F1 + 4 * I_F2, T_IE = T_F2 + 2 * I_IE, T_OE = T_IE + 2 * I_OE, T_IO = T_OE + 2 * I_IO, T_OO = T_IO + 2 * I_OO;
    for (int it = gw; it < T_OO; it += NGW) {
        if (it < T_F1) { const int l = it / I_F1, r = it % I_F1; transpose_item(p.in[6] + (size_t)l * 1024 * 4096, 1024, 4096, 4096, (bf16_t*)(ws + WS_W1T) + (size_t)l * 4096 * 1024, scr, r, lane, p.in[4] + l * 1024); }
        else if (it < T_F2) { const int q = it - T_F1, l = q / I_F2, r = q % I_F2; transpose_item(p.in[7] + (size_t)l * 4096 * 1024, 4096, 1024, 1024, (bf16_t*)(ws + WS_W2T) + (size_t)l * 1024 * 4096, scr, r, lane); }
        else if (it < T_IE) { const int q = it - T_F2, l = q / I_IE, r = q % I_IE; transpose_item(p.in[8] + (size_t)l * 1024 * EIN, 1024, EIN, EIN, (bf16_t*)(ws + WS_WINE) + (size_t)l * EIN * 1024, scr, r, lane, p.in[3] + (2 * l) * 1024); }
        else if (it < T_OE) { const int q = it - T_IE, l = q / I_OE, r = q % I_OE; transpose_item(p.in[9] + (size_t)l * 1024 * 1024, 1024, 1024, 1024, (bf16_t*)(ws + WS_WOUTE) + (size_t)l * 1024 * 1024, scr, r, lane); }
        else if (it < T_IO) { const int q = it - T_OE, l = q / I_IO, r = q % I_IO; transpose_item(p.in[19] + (size_t)l * 1024 * OIN, 1024, OIN, OINP, (bf16_t*)(ws + WS_WINO) + (size_t)l * OINP * 1024, scr, r, lane, p.in[3] + (2 * l + 1) * 1024); }
        else { const int q = it - T_IO, l = q / I_OO, r = q % I_OO; transpose_item(p.in[20] + (size_t)l * OOUT * 1024, OOUT, 1024, 1024, (bf16_t*)(ws + WS_WOUTO) + (size_t)l * 1024 * OOUT, scr, r, lane); }
    }
    bf16_t* GW = (bf16_t*)(ws + WS_GW);
    const int gt = gw * 64 + lane, NGT = NGW * 64;
    for (int idx = gt; idx < 2 * 2 * 2 * 8 * 4096; idx += NGT) {
        const int d = idx & 63, e = (idx >> 6) & 63, blk = (idx >> 12) & 7, gate = (idx >> 15) & 1, dir = (idx >> 16) & 1, j = (idx >> 17) & 1;
        const float* src = gate ? p.in[16] : p.in[14];
        GW[idx] = (bf16_t)f2bf(src[((((size_t)j * 2 + dir) * 8 + blk) * 64 + d) * 64 + e]);
    }
}

__device__ __forceinline__ void phase_x0(const float* x, bf16_t* xb, float* ssq) {
    MK_IDS();
    for (int m = gw; m < TS; m += NGW) {
        const f32x4* xr = (const f32x4*)(x + (size_t)m * DMODEL) + lane;
        f32x4 v[4]; float s = 0.f;
#pragma unroll
        for (int j = 0; j < 4; ++j) { v[j] = xr[64 * j]; s += (v[j].x * v[j].x + v[j].y * v[j].y) + (v[j].z * v[j].z + v[j].w * v[j].w); }
        s = wave_sum(s);
        u32x2* o8 = (u32x2*)(xb + (size_t)m * DMODEL) + lane;
#pragma unroll
        for (int j = 0; j < 4; ++j) { u32x2 o; o.x = pk2(v[j].x, v[j].y); o.y = pk2(v[j].z, v[j].w); o8[64 * j] = o; }
        if (lane < 16) ssq[(size_t)m * 16 + lane] = lane == 0 ? s : 0.f;
    }
}
__device__ __forceinline__ void zero_f32(float* ptr, int n) {
    MK_IDS();
    for (int i = gw * 64 + lane; i < n; i += NGW * 64) ptr[i] = 0.f;
}
__device__ __forceinline__ void phase_rmsnorm_final(const bf16_t* xb, float* x, const float* g) {
    MK_IDS();
    for (int m = gw; m < TS; m += NGW) {
        const u32x2* xr = (const u32x2*)(xb + (size_t)m * DMODEL) + lane; f32x4* xw = (f32x4*)(x + (size_t)m * DMODEL) + lane; const f32x4* gr = (const f32x4*)g + lane;
        f32x4 v[4]; float s = 0.f;
#pragma unroll
        for (int j = 0; j < 4; ++j) { const u32x2 w = xr[64 * j]; v[j] = (f32x4){__uint_as_float(w.x << 16), __uint_as_float(w.x & 0xffff0000u), __uint_as_float(w.y << 16), __uint_as_float(w.y & 0xffff0000u)};
            s += (v[j].x * v[j].x + v[j].y * v[j].y) + (v[j].z * v[j].z + v[j].w * v[j].w); }
        const float rstd = 1.f / sqrtf(wave_sum(s) * (1.f / DMODEL) + EPS);
#pragma unroll
        for (int j = 0; j < 4; ++j) { const f32x4 gg = gr[64 * j]; xw[64 * j] = v[j] * rstd * gg; }
    }
}
struct EpiRes {
    static constexpr bool PERM = true, AFTER_DRAIN = false;
    bf16_t* xb; float* ssq; int ldc;
    __device__ __forceinline__ void operator()(const pg8::f32x4 (&acc)[2][2][4][2], const pg8::Unit& u, int wr, int wc, int fr, int fq) const {
        const int col0 = u.pn * pg8::BM + wc * 32 + 8 * fq;
#pragma unroll
        for (int ai = 0; ai < 2; ++ai)
#pragma unroll
            for (int m = 0; m < 4; ++m) { const int row = u.pm * pg8::BM + ai * pg8::HALF + wr * 64 + m * 16 + fr; const size_t off = (size_t)row * ldc + col0; float sq = 0.f;
                u32x4 bw[2];
#pragma unroll
                for (int bj = 0; bj < 2; ++bj) bw[bj] = *(const u32x4*)(xb + off + bj * pg8::HALF);
#pragma unroll
                for (int bj = 0; bj < 2; ++bj) { float b[8]; unpack8(bw[bj], b); const pg8::f32x4 a0 = acc[ai][bj][m][0], a1 = acc[ai][bj][m][1];
                    const float o0 = b[0] + a0[0], o1 = b[1] + a0[1], o2 = b[2] + a0[2], o3 = b[3] + a0[3], o4 = b[4] + a1[0], o5 = b[5] + a1[1], o6 = b[6] + a1[2], o7 = b[7] + a1[3];
                    u32x4 w; w.x = pg8::cvt_pk_bf16(o0, o1); w.y = pg8::cvt_pk_bf16(o2, o3); w.z = pg8::cvt_pk_bf16(o4, o5); w.w = pg8::cvt_pk_bf16(o6, o7);
                    *(u32x4*)(xb + off + bj * pg8::HALF) = w;
                    sq += ((o0 * o0 + o1 * o1) + (o2 * o2 + o3 * o3)) + ((o4 * o4 + o5 * o5) + (o6 * o6 + o7 * o7)); }
                sq += __shfl_xor(sq, 16); sq += __shfl_xor(sq, 32);
                if (fq == 0) ssq[(size_t)row * 16 + u.pn * 4 + wc] = sq;
                if (m & 1) asm volatile("" ::: "memory"); }
    }
};

__device__ __forceinline__ void even_qk_post(bf16_t* proj, const float* qg, const float* kg, int S) {
    MK_IDS();
    const int g = lane & 7, axis = g >> 2, half = (g >> 1) & 1;
    float inv[8], gq[8], gk[8];
#pragma unroll
    for (int e = 0; e < 8; ++e) { inv[e] = exp2f(-(float)((g & 1) * 8 + e) * (13.287712379549449f / 16.f)); gq[e] = qg[g * 8 + e] * attn_body::C2; gk[e] = kg[g * 8 + e]; }
    for (int t = gw; t < TS; t += NGW) {
        const int s = t % S; const float pos = (float)(axis ? (s & 63) : (s >> 6));
        bf16_t* row = proj + (size_t)t * EIN;
        const u32x4 qa = *(const u32x4*)(row + lane * 8); u32x4 ka = {0u, 0u, 0u, 0u}; if (lane < 16) ka = *(const u32x4*)(row + 512 + lane * 8);
        float cs[8], sn[8];
#pragma unroll
        for (int e = 0; e < 8; ++e) { const float ang = pos * inv[e]; cs[e] = __cosf(ang); sn[e] = __sinf(ang); }
        float xq[8], xk[8]; unpack8(qa, xq); unpack8(ka, xk);
        float sq = 0.f, sk = 0.f;
#pragma unroll
        for (int e = 0; e < 8; ++e) { sq += xq[e] * xq[e]; sk += xk[e] * xk[e]; }
        sq += __shfl_xor(sq, 1); sq += __shfl_xor(sq, 2); sq += __shfl_xor(sq, 4);
        sk += __shfl_xor(sk, 1); sk += __shfl_xor(sk, 2); sk += __shfl_xor(sk, 4);
        const float rq = 1.f / sqrtf(sq * (1.f / 64.f) + EPS), rk = 1.f / sqrtf(sk * (1.f / 64.f) + EPS);
        float oq[8], ok[8];
#pragma unroll
        for (int e = 0; e < 8; ++e) { const float yq = xq[e] * rq * gq[e], yk = xk[e] * rk * gk[e];
            const float pq = __shfl_xor(yq, 2), pk = __shfl_xor(yk, 2);
            oq[e] = yq * cs[e] + (half ? pq : -pq) * sn[e]; ok[e] = yk * cs[e] + (half ? pk : -pk) * sn[e]; }
        u32x4 o; o.x = pk2(oq[0], oq[1]); o.y = pk2(oq[2], oq[3]); o.z = pk2(oq[4], oq[5]); o.w = pk2(oq[6], oq[7]);
        *(u32x4*)(row + lane * 8) = o;
        if (lane < 16) { u32x4 o2; o2.x = pk2(ok[0], ok[1]); o2.y = pk2(ok[2], ok[3]); o2.z = pk2(ok[4], ok[5]); o2.w = pk2(ok[6], ok[7]); *(u32x4*)(row + 512 + lane * 8) = o2; }
    }
}
__device__ __forceinline__ void even_lru_prep(const bf16_t* proj, const float* cw, const float* cb, const bf16_t* GWj, const float* br, const float* bi, const float* lam,
                                              unsigned* LU, f32x2* AGG, int S, char* lds) {
    MK_IDS();
    constexpr int XST = 1040;
    for (int tile = blockIdx.x; tile < TS / 64; tile += gridDim.x) {
        const int t0 = tile * 64;
        __syncthreads();
#pragma unroll 2
        for (int k = 0; k < 8; ++k) {
            const int idx = tid + k * NT, i = idx >> 6, cgp = idx & 63, t = t0 + i, s = t % S, ch = cgp * 8;
            float acc[8];
#pragma unroll
            for (int e = 0; e < 8; ++e) acc[e] = cb[ch + e];
#pragma unroll
            for (int j = 0; j < 4; ++j) { const int sp = s + j - 2;
                if (sp >= 0 && sp < S) { const u32x4 v = *(const u32x4*)(proj + (size_t)(t + j - 2) * EIN + 768 + ch); float xv[8]; unpack8(v, xv);
#pragma unroll
                    for (int e = 0; e < 8; ++e) acc[e] += cw[j * 512 + ch + e] * xv[e]; } }
            u32x4 o; o.x = pk2(acc[0], acc[1]); o.y = pk2(acc[2], acc[3]); o.z = pk2(acc[4], acc[5]); o.w = pk2(acc[6], acc[7]);
            *(u32x4*)(lds + i * XST + ch * 2) = o;
        }
        __syncthreads();
        const int G = lane >> 4, l16 = lane & 15, ch0 = wave * 64;
        for (int dir = 0; dir < 2; ++dir)
            for (int nt = 0; nt < 4; ++nt) {
                const int e = nt * 16 + l16, ch = ch0 + e;
                bf16x8 Br[2], Bi[2];
#pragma unroll
                for (int kk = 0; kk < 2; ++kk) {
                    Br[kk] = *(const bf16x8*)(GWj + ((((size_t)dir * 2 + 0) * 8 + wave) * 64 + e) * 64 + kk * 32 + G * 8);
                    Bi[kk] = *(const bf16x8*)(GWj + ((((size_t)dir * 2 + 1) * 8 + wave) * 64 + e) * 64 + kk * 32 + G * 8);
                }
                const float brv = br[dir * 512 + ch], biv = bi[dir * 512 + ch], spl = softplus(-lam[dir * 512 + ch]);
#pragma unroll
                for (int mt = 0; mt < 4; ++mt) {
                    f32x4 ar = {0.f, 0.f, 0.f, 0.f}, ai = {0.f, 0.f, 0.f, 0.f};
#pragma unroll
                    for (int kk = 0; kk < 2; ++kk) { const bf16x8 a = *(const bf16x8*)(lds + (mt * 16 + l16) * XST + (ch0 + kk * 32 + G * 8) * 2); ar = MFMA16(a, Br[kk], ar); ai = MFMA16(a, Bi[kk], ai); }
#pragma unroll
                    for (int r = 0; r < 4; ++r) { const int i = mt * 16 + G * 4 + r;
                        const float xc = bf2f(*(const bf16_t*)(lds + i * XST + ch * 2));
                        const float rg = __builtin_amdgcn_rcpf(1.f + __expf(-(ar[r] + brv))), ig = __builtin_amdgcn_rcpf(1.f + __expf(-(ai[r] + biv)));
                        const float la = -8.f * rg * spl; const float uu = __builtin_amdgcn_sqrtf(fmaxf(1.f - __expf(2.f * la), 0.f)) * (ig * xc);
                        LU[((size_t)dir * TS + t0 + i) * 512 + ch] = attn_body::cvtpk_s(la, uu); }
                }
            }
        asm volatile("s_waitcnt vmcnt(0)" ::: "memory");
        __syncthreads();
        {
            const int ch = tid;
#pragma unroll
            for (int dir = 0; dir < 2; ++dir) {
                float h = 0.f, P = 0.f;
                const unsigned* lu = LU + ((size_t)dir * TS + t0) * 512 + ch;
#pragma unroll
                for (int q = 0; q < 64; q += 8) {
                    float lv[8], uv[8];
#pragma unroll
                    for (int e = 0; e < 8; ++e) { const int i = dir ? 63 - (q + e) : q + e; const unsigned w_ = lu[(size_t)i * 512]; lv[e] = __uint_as_float(w_ << 16); uv[e] = __uint_as_float(w_ & 0xffff0000u); }
#pragma unroll
                    for (int e = 0; e < 8; ++e) { h = __expf(lv[e]) * h + uv[e]; P += lv[e]; }
                }
                AGG[((size_t)dir * (TS / 64) + tile) * 512 + ch] = (f32x2){P, h};
            }
        }
    }
}
__device__ __forceinline__ void even_lru_scan(const unsigned* LU, const f32x2* AGG, const bf16_t* proj, bf16_t* Y, int S) {
    MK_IDS();
    const int ch = tid, TPB = S / 64;
    for (int tile = blockIdx.x; tile < TS / 64; tile += gridDim.x) {
        const int t0 = tile * 64, tb0 = (tile / TPB) * TPB;
        float cf = 0.f, cr = 0.f;
        for (int k0 = tb0; k0 < tile; k0 += 8) { f32x2 a[8];
#pragma unroll
            for (int q = 0; q < 8; ++q) { const int k = k0 + q < tile ? k0 + q : tile - 1; a[q] = AGG[(size_t)k * 512 + ch]; }
#pragma unroll
            for (int q = 0; q < 8; ++q) if (k0 + q < tile) cf = cf * __expf(a[q].x) + a[q].y; }
        for (int k0 = tb0 + TPB - 1; k0 > tile; k0 -= 8) { f32x2 a[8];
#pragma unroll
            for (int q = 0; q < 8; ++q) { const int k = k0 - q > tile ? k0 - q : tile + 1; a[q] = AGG[((size_t)(TS / 64) + k) * 512 + ch]; }
#pragma unroll
            for (int q = 0; q < 8; ++q) if (k0 - q > tile) cr = cr * __expf(a[q].x) + a[q].y; }
        float hf[64];
        {
            const unsigned* lu = LU + (size_t)t0 * 512 + ch; float h = cf;
#pragma unroll
            for (int q = 0; q < 64; q += 8) {
                float lv[8], uv[8];
#pragma unroll
                for (int e = 0; e < 8; ++e) { const unsigned w_ = lu[(size_t)(q + e) * 512]; lv[e] = __uint_as_float(w_ << 16); uv[e] = __uint_as_float(w_ & 0xffff0000u); }
#pragma unroll
                for (int e = 0; e < 8; ++e) { h = __expf(lv[e]) * h + uv[e]; hf[q + e] = h; }
            }
        }
        {
            const unsigned* lu = LU + ((size_t)TS + t0) * 512 + ch; float h = cr;
#pragma unroll
            for (int q = 0; q < 64; q += 8) {
                float lv[8], uv[8], gv[8];
#pragma unroll
                for (int e = 0; e < 8; ++e) { const int i = 63 - (q + e); { const unsigned w_ = lu[(size_t)i * 512]; lv[e] = __uint_as_float(w_ << 16); uv[e] = __uint_as_float(w_ & 0xffff0000u); } gv[e] = bf2f(proj[(size_t)(t0 + i) * EIN + 1280 + ch]); }
#pragma unroll
                for (int e = 0; e < 8; ++e) { const int i = 63 - (q + e); h = __expf(lv[e]) * h + uv[e]; Y[(size_t)(t0 + i) * DMODEL + 512 + ch] = (bf16_t)f2bf((hf[i] + h) * gelu_tanh(gv[e])); }
            }
        }
    }
}

__device__ __forceinline__ void odd_conv(const bf16_t* proj, const float* cw, bf16_t* QKVP, int S) {
    MK_IDS();
    for (int cr = 0; cr < (TS / 64 + (int)gridDim.x - 1) / (int)gridDim.x; ++cr) {
        const int c = cr * (int)gridDim.x + (int)blockIdx.x; if (c >= TS / 64) break;
        const int tb = c * 64 + wave * 8, sb = tb % S;
#pragma unroll
        for (int blk = 0; blk < 3; ++blk) {
            const int ch = blk * 512 + lane * 8;
            u32x4 rows[11];
#pragma unroll
            for (int q = 0; q < 11; ++q) { const int sp = sb + q - 2; rows[q] = (u32x4){0u, 0u, 0u, 0u};
                if (sp >= 0 && sp < S) rows[q] = *(const u32x4*)(proj + (size_t)(tb + q - 2) * OINP + ch); }
            f32x4 w0[4], w1[4];
#pragma unroll
            for (int j = 0; j < 4; ++j) { w0[j] = *(const f32x4*)(cw + j * 1536 + ch); w1[j] = *(const f32x4*)(cw + j * 1536 + ch + 4); }
#pragma unroll
            for (int i = 0; i < 8; ++i) {
                float acc[8];
#pragma unroll
                for (int e = 0; e < 8; ++e) acc[e] = 0.f;
#pragma unroll
                for (int j = 0; j < 4; ++j) { float xv[8]; unpack8(rows[i + j], xv);
                    acc[0] += w0[j].x * xv[0]; acc[1] += w0[j].y * xv[1]; acc[2] += w0[j].z * xv[2]; acc[3] += w0[j].w * xv[3];
                    acc[4] += w1[j].x * xv[4]; acc[5] += w1[j].y * xv[5]; acc[6] += w1[j].z * xv[6]; acc[7] += w1[j].w * xv[7]; }
                float ss = 0.f;
#pragma unroll
                for (int e = 0; e < 8; ++e) { acc[e] = silu(acc[e]); ss += acc[e] * acc[e]; }
                if (blk < 2) {
                    ss += __shfl_xor(ss, 1); ss += __shfl_xor(ss, 2); ss += __shfl_xor(ss, 4); ss += __shfl_xor(ss, 8);
                    const float rn = 1.f / sqrtf(ss + EPS);
#pragma unroll
                    for (int e = 0; e < 8; ++e) acc[e] *= rn;
                }
                u32x4 o; o.x = pk2(acc[0], acc[1]); o.y = pk2(acc[2], acc[3]); o.z = pk2(acc[4], acc[5]); o.w = pk2(acc[6], acc[7]);
                *(u32x4*)(QKVP + (size_t)(tb + i) * 1536 + ch) = o;
            }
        }
    }
}

__device__ __forceinline__ int frag128(int r, int k) { return ((((r >> 4) * 4 + (k >> 5)) * 64 + ((k >> 3) & 3) * 16 + (r & 15)) << 3) + (k & 7); }
__device__ __forceinline__ int frag64(int r, int k) { return ((((r >> 4) * 2 + (k >> 5)) * 64 + ((k >> 3) & 3) * 16 + (r & 15)) << 3) + (k & 7); }
__device__ __forceinline__ void odd_prep(const bf16_t* QKVP, const bf16_t* proj, const float* alog, const float* dtb, unsigned char* DNI, float* EGL, char* lds) {
    MK_IDS();
    constexpr int RS = 272;
    constexpr int HOFF = 69632;
    const float scale = 0.08838834764831845f;
    for (int itq = 0; itq < (TS / 64 + (int)gridDim.x - 1) / (int)gridDim.x * 4; ++itq) {
        const int c_ = (itq >> 2) * (int)gridDim.x + (int)blockIdx.x; if (c_ >= TS / 64) break; const int it0 = (c_ * 4 + (itq & 3)) * 2;
        int tq_ = tid; asm volatile("" : "+v"(tq_));
        const int half = tq_ >> 8, ht = tq_ & 255, hwave = __builtin_amdgcn_readfirstlane(ht >> 6), G = (tq_ & 63) >> 4, l16 = tq_ & 15;
        char* L = lds + half * HOFF;
        char* KS = L, *QS = L + 17408, *VS = L + 34816; float* LM = (float*)(L + 52224); float* GC = (float*)(L + 68608); float* BT = GC + 64; float* EG = BT + 64;
        const int it = it0 + half; const int d = it & 1, h = (it >> 1) & 3, c = it >> 3, t0 = c * 64;
        __syncthreads();
#pragma unroll
        for (int k = 0; k < 4; ++k) { const int idx = ht + k * 256, i = idx >> 4, pc = idx & 15; const int tk = d ? t0 + 63 - i : t0 + i;
            const bf16_t* src = QKVP + (size_t)tk * 1536 + h * 128 + pc * 8;
            *(u32x4*)(QS + i * RS + pc * 16) = *(const u32x4*)(src);
            *(u32x4*)(KS + i * RS + pc * 16) = *(const u32x4*)(src + 512);
            *(u32x4*)(VS + i * RS + pc * 16) = *(const u32x4*)(src + 1024); }
        if (hwave == 0) {
            const int i = lane; const int tk = d ? t0 + 63 - i : t0 + i;
            const float bl = bf2f(proj[(size_t)tk * OINP + 2048 + d * 4 + h]), al = bf2f(proj[(size_t)tk * OINP + 2056 + d * 4 + h]);
            const float beta = sigm(bl); float g = -__expf(alog[d * 4 + h]) * softplus(al + dtb[d * 4 + h]);
#pragma unroll
            for (int o = 1; o < 64; o <<= 1) { const float v = __shfl_up(g, o); if (lane >= o) g += v; }
            GC[i] = g; BT[i] = beta; EG[i] = __expf(g);
        }
        __syncthreads();
        {
            const bool isq = hwave >= 2; const char* XS = isq ? QS : KS;
#pragma unroll
            for (int mm = 0; mm < 2; ++mm) { const int mt = (hwave & 1) * 2 + mm;
                bf16x8 a[4];
#pragma unroll
                for (int kk = 0; kk < 4; ++kk) a[kk] = *(const bf16x8*)(XS + (mt * 16 + l16) * RS + (kk * 32 + G * 8) * 2);
#pragma unroll
                for (int nt = 0; nt < 4; ++nt) { f32x4 acc = {0.f, 0.f, 0.f, 0.f};
#pragma unroll
                    for (int kk = 0; kk < 4; ++kk) { const bf16x8 bb = *(const bf16x8*)(KS + (nt * 16 + l16) * RS + (kk * 32 + G * 8) * 2); acc = MFMA16(a[kk], bb, acc); }
                    const int j = nt * 16 + l16; const float gj = GC[j];
#pragma unroll
                    for (int r = 0; r < 4; ++r) { const int i = mt * 16 + G * 4 + r; const float dec = __expf(fminf(GC[i] - gj, 0.f));
                        if (!isq) LM[i * 64 + j] = (j < i) ? BT[i] * acc[r] * dec : 0.f;
                        else ((bf16_t*)(DNI + (size_t)it * DNI_BYTES + DNI_A))[frag64(i, j)] = (bf16_t)f2bf((j <= i) ? acc[r] * scale * dec : 0.f); }
                }
            }
        }
        __syncthreads();
        {
            float sol[64];
            const int cc = ht & 127; const bool isw = ht >= 128; const char* XS = isw ? KS : VS;
#pragma unroll
            for (int i = 0; i < 64; ++i) {
                float v = bf2f(*(const bf16_t*)(XS + i * RS + cc * 2)) * BT[i]; if (isw) v *= EG[i];
                float a0 = 0.f, a1 = 0.f;
#pragma unroll
                for (int j4 = 0; j4 < (i + 3) / 4; ++j4) { const f32x4 l4 = *(const f32x4*)(LM + i * 64 + j4 * 4);
                    if (j4 * 4 + 0 < i) a0 += l4.x * sol[j4 * 4 + 0]; if (j4 * 4 + 1 < i) a1 += l4.y * sol[j4 * 4 + 1];
                    if (j4 * 4 + 2 < i) a0 += l4.z * sol[j4 * 4 + 2]; if (j4 * 4 + 3 < i) a1 += l4.w * sol[j4 * 4 + 3];
                    if ((j4 & 1) == 1) asm volatile("" ::: "memory"); }
                v -= a0 + a1;
                sol[i] = v;
                ((bf16_t*)(DNI + (size_t)it * DNI_BYTES + (isw ? DNI_W : DNI_U)))[isw ? frag128(i, cc) : i * 128 + cc] = (bf16_t)f2bf(v);
                asm volatile("" ::: "memory");
            }
        }
        {
            const float gl = GC[63];
#pragma unroll
            for (int k = 0; k < 4; ++k) { const int idx = ht + k * 256;
                {
                    const int i = idx & 63, kg = idx >> 6; const u32x4 raw = *(const u32x4*)(QS + i * RS + kg * 16); float f[8]; unpack8(raw, f); const float sc = scale * EG[i];
                    u32x4 o; o.x = pk2(f[0] * sc, f[1] * sc); o.y = pk2(f[2] * sc, f[3] * sc); o.z = pk2(f[4] * sc, f[5] * sc); o.w = pk2(f[6] * sc, f[7] * sc);
                    *(u32x4*)((bf16_t*)(DNI + (size_t)it * DNI_BYTES + DNI_QT) + frag128(i, kg * 8)) = o; }
                {
                    const int dm = idx & 127, tg = idx >> 7; float f[8];
#pragma unroll
                    for (int q = 0; q < 8; ++q) { const int i = tg * 8 + q; f[q] = bf2f(*(const bf16_t*)(KS + i * RS + dm * 2)) * __expf(gl - GC[i]); }
                    u32x4 o; o.x = pk2(f[0], f[1]); o.y = pk2(f[2], f[3]); o.z = pk2(f[4], f[5]); o.w = pk2(f[6], f[7]);
                    *(u32x4*)((bf16_t*)(DNI + (size_t)it * DNI_BYTES + DNI_KTT) + frag64(dm, tg * 8)) = o; }
            }
            if (ht == 0) EGL[it] = __expf(gl);
        }
    }
}

template <int NS> __device__ __forceinline__ void odd_scan(const unsigned char* DNI, const float* EGL, bf16_t* OB, int S, int nb, char* lds) {
    MK_IDS();
    constexpr int O_SB = 0, O_VN = NS * 4352, O_OUT = O_VN + NS * 2304, PFD = 7, EB = NS == 1 ? 3 : 2, NCOL = NS * 16;
    const int NC = S / 64, G = lane >> 4, l16 = lane & 15;
    const int nitems = nb * 64 / NS;
    const int mt = wave & 3; const bool lo = wave < 4;
    for (int item = blockIdx.x; item < nitems; item += gridDim.x) {
        const int e = (item >> 3) & ((1 << EB) - 1), sq = (item & 7) | ((item >> (3 + EB)) << 3); const int d = sq & 1, h = (sq >> 1) & 3, b = sq >> 3, cb = e * NCOL;
        __syncthreads();
        for (int i = tid; i < NS * 4352 / 4; i += NT) ((unsigned*)(lds + O_SB))[i] = 0u;
        f32x4 Sreg[NS];
#pragma unroll
        for (int ns = 0; ns < NS; ++ns) Sreg[ns] = (f32x4){0.f, 0.f, 0.f, 0.f};
        const long dstep = (long)(d ? -8 : 8) * DNI_BYTES;
        const unsigned char* base0 = DNI + (size_t)(((b * NC + (d ? NC - 1 : 0)) * 4 + h) * 2 + d) * DNI_BYTES;
        const unsigned char* pX = base0 + (lo ? DNI_W : DNI_QT) + ((mt * 4) * 64 + lane) * 16;
        const unsigned char* pA = base0 + DNI_A + ((mt * 2) * 64 + lane) * 16;
        const unsigned char* pK = base0 + DNI_KTT + ((wave * 2) * 64 + lane) * 16;
        const unsigned char* pU = base0 + DNI_U + ((mt * 16 + G * 4) * 128 + cb + l16) * 2;
        const float* pE = EGL + (((b * NC + (d ? NC - 1 : 0)) * 4 + h) * 2 + d);
        const unsigned char* pP = base0 + (long)PFD * dstep + e * (9216 * NS) + (tid < 144 * NS ? tid : 144 * NS - 1) * 64;
        bf16_t* pO = OB + ((size_t)d * TS + (size_t)(b * NC + (d ? NC - 1 : 0)) * 64 + (d ? 63 - (tid >> 3) : (tid >> 3))) * 512 + h * 128 + cb + (tid & 7) * 2 * NS;
        const long ostep = (long)(d ? -64 : 64) * 512;
        u32x4 aX[4], aA[2], aK[2], bX[4], bA[2], bK[2], cX[4], cA[2], cK[2];
        unsigned aU[NS][4], bU[NS][4], cU[NS][4]; float aE, bE, cE; unsigned pf_dummy = 0u;
#define DN_LOAD(P) do { \
            _Pragma("unroll") for (int kk = 0; kk < 4; ++kk) P##X[kk] = *(const u32x4*)(pX + kk * 1024); \
            _Pragma("unroll") for (int kk = 0; kk < 2; ++kk) { P##A[kk] = *(const u32x4*)(pA + kk * 1024); P##K[kk] = *(const u32x4*)(pK + kk * 1024); } \
            _Pragma("unroll") for (int ns = 0; ns < NS; ++ns) _Pragma("unroll") for (int r = 0; r < 4; ++r) P##U[ns][r] = *(const bf16_t*)(pU + r * 256 + ns * 32); \
            P##E = *pE; pX += dstep; pA += dstep; pK += dstep; pU += dstep; pE += (d ? -8 : 8); } while (0)
#define DN_STEP(P, PL) do { \
            DN_LOAD(PL); \
            if (wave < (NS == 1 ? 3 : 5)) { asm volatile("global_load_dword %0, %1, off" : "+v"(pf_dummy) : "v"(pP) : "memory"); } \
            pP += dstep; \
            f32x4 acc[NS], acc2[NS]; \
            { bf16x8 sb_[NS][4]; \
              _Pragma("unroll") for (int ns = 0; ns < NS; ++ns) { acc[ns] = (f32x4){0.f, 0.f, 0.f, 0.f}; acc2[ns] = (f32x4){0.f, 0.f, 0.f, 0.f}; \
                _Pragma("unroll") for (int kk = 0; kk < 4; ++kk) sb_[ns][kk] = *(const bf16x8*)(lds + O_SB + (ns * 16 + l16) * 272 + (kk * 32 + G * 8) * 2); } \
              if constexpr (NS == 1) asm volatile("s_waitcnt lgkmcnt(0)" : "+v"(sb_[0][0]), "+v"(sb_[0][1]), "+v"(sb_[0][2]), "+v"(sb_[0][3]) :: "memory"); \
              else asm volatile("s_waitcnt lgkmcnt(0)" : "+v"(sb_[0][0]), "+v"(sb_[0][1]), "+v"(sb_[0][2]), "+v"(sb_[0][3]), "+v"(sb_[NS - 1][0]), "+v"(sb_[NS - 1][1]), "+v"(sb_[NS - 1][2]), "+v"(sb_[NS - 1][3]) :: "memory"); \
              _Pragma("unroll") for (int ns = 0; ns < NS; ++ns) { \
                acc[ns] = MFMA16(__builtin_bit_cast(bf16x8, P##X[0]), sb_[ns][0], acc[ns]); acc2[ns] = MFMA16(__builtin_bit_cast(bf16x8, P##X[1]), sb_[ns][1], acc2[ns]); \
                acc[ns] = MFMA16(__builtin_bit_cast(bf16x8, P##X[2]), sb_[ns][2], acc[ns]); acc2[ns] = MFMA16(__builtin_bit_cast(bf16x8, P##X[3]), sb_[ns][3], acc2[ns]); } \
              _Pragma("unroll") for (int ns = 0; ns < NS; ++ns) acc[ns] = acc[ns] + acc2[ns]; } \
            if (lo) { _Pragma("unroll") for (int ns = 0; ns < NS; ++ns) { u32x2 o; float v[4]; \
              _Pragma("unroll") for (int r = 0; r < 4; ++r) v[r] = __uint_as_float(P##U[ns][r] << 16) - acc[ns][r]; \
              o.x = attn_body::cvtpk_s(v[0], v[1]); o.y = attn_body::cvtpk_s(v[2], v[3]); \
              *(u32x2*)(lds + O_VN + (ns * 16 + l16) * 144 + (mt * 16 + G * 4) * 2) = o; } } \
            asm volatile("s_waitcnt lgkmcnt(0)\n\ts_barrier" ::: "memory"); \
            bf16x8 vb[NS][2]; \
            _Pragma("unroll") for (int ns = 0; ns < NS; ++ns) _Pragma("unroll") for (int kk = 0; kk < 2; ++kk) vb[ns][kk] = *(const bf16x8*)(lds + O_VN + (ns * 16 + l16) * 144 + (kk * 32 + G * 8) * 2); \
            if constexpr (NS == 1) asm volatile("s_waitcnt lgkmcnt(0)" : "+v"(vb[0][0]), "+v"(vb[0][1]) :: "memory"); \
            else asm volatile("s_waitcnt lgkmcnt(0)" : "+v"(vb[0][0]), "+v"(vb[0][1]), "+v"(vb[NS - 1][0]), "+v"(vb[NS - 1][1]) :: "memory"); \
            _Pragma("unroll") for (int ns = 0; ns < NS; ++ns) { Sreg[ns] = Sreg[ns] * P##E; \
              _Pragma("unroll") for (int kk = 0; kk < 2; ++kk) Sreg[ns] = MFMA16(__builtin_bit_cast(bf16x8, P##K[kk]), vb[ns][kk], Sreg[ns]); } \
            _Pragma("unroll") for (int ns = 0; ns < NS; ++ns) { u32x2 o; o.x = attn_body::cvtpk_s(Sreg[ns][0], Sreg[ns][1]); o.y = attn_body::cvtpk_s(Sreg[ns][2], Sreg[ns][3]); \
              *(u32x2*)(lds + O_SB + (ns * 16 + l16) * 272 + (wave * 16 + G * 4) * 2) = o; } \
            if (!lo) { _Pragma("unroll") for (int ns = 0; ns < NS; ++ns) { \
              _Pragma("unroll") for (int kk = 0; kk < 2; ++kk) acc[ns] = MFMA16(__builtin_bit_cast(bf16x8, P##A[kk]), vb[ns][kk], acc[ns]); \
              const unsigned w0_ = attn_body::cvtpk_s(acc[ns][0], acc[ns][1]), w1_ = attn_body::cvtpk_s(acc[ns][2], acc[ns][3]); \
              bf16_t* op_ = (bf16_t*)(lds + O_OUT + ((mt * 16 + G * 4) * NCOL + ns * 16 + l16) * 2); \
              op_[0] = (bf16_t)(w0_ & 0xffffu); op_[NCOL] = (bf16_t)(w0_ >> 16); op_[2 * NCOL] = (bf16_t)(w1_ & 0xffffu); op_[3 * NCOL] = (bf16_t)(w1_ >> 16); } } \
            asm volatile("s_waitcnt lgkmcnt(0)\n\ts_barrier" ::: "memory"); \
            if constexpr (NS == 1) *(unsigned*)pO = *(const unsigned*)(lds + O_OUT + tid * 4); else *(u32x2*)pO = *(const u32x2*)(lds + O_OUT + tid * 8); \
            pO += ostep; } while (0)
        DN_LOAD(a); DN_LOAD(b);
        __syncthreads();
        int n = 0;
        for (; n + 3 <= NC; n += 3) {
            DN_STEP(a, c);
            DN_STEP(b, a);
            DN_STEP(c, b);
        }
        if (n < NC) { DN_STEP(a, c); }
        if (n + 1 < NC) { DN_STEP(b, a); }
#undef DN_STEP
#undef DN_LOAD
        asm volatile("s_waitcnt vmcnt(0)" ::: "memory");
        asm volatile("" :: "v"(pf_dummy));
    }
}

__device__ __forceinline__ int t5_bucket(int rel) {
    const int n = rel < 0 ? -rel : rel; int v;
    if (n < 8) v = n; else v = 8 + (n >= 15) + (n >= 27) + (n >= 50) + (n >= 91) + (n >= 166) + (n >= 305) + (n >= 559);
    return (rel > 0 ? 16 : 0) + v;
}
__device__ __forceinline__ void odd_dilated(bf16_t* proj, const float* relb, float* LSE, int S, char* lds, int first_wg, int n_wg) {
    MK_IDS();
    constexpr int KST = 144, VST = 400, HOFF = 27648 + 25600 + 1024;
    const int half = tid >> 8, ht = tid & 255, wv = ht >> 6, G = lane >> 4, l16 = lane & 15;
    char* L = lds + half * HOFF; char* KS = L; char* VT = L + 27648; float* BIAS = (float*)(L + 27648 + 25600);
    const int NBb = S / 64;
    const int wgi = (int)blockIdx.x - first_wg;
    if (wgi < 0) return;
    for (int it0 = wgi * 2; it0 < 3072; it0 += n_wg * 2) {
        const int it = it0 + half; const int zb = it & 255, sl = (it >> 8) & 3, g = it >> 10;
        const int dil = g == 0 ? 1 : (g == 1 ? 4 : 16), lg = g * 2;
        const int M = S >> lg, MB = M / 64;
        const int b = zb / NBb, r0 = zb % NBb, rho = r0 / MB, n = r0 % MB;
        const int hc = (g * 4 + sl) * 64;
        const size_t tb = (size_t)b * S;
        __syncthreads();
#pragma unroll
        for (int k = 0; k < 6; ++k) { const int idx = ht + k * 256, kj = idx >> 3, pc = idx & 7; const int mk = 64 * n - 64 + kj;
            u32x4 kv = {0u, 0u, 0u, 0u}, vv = {0u, 0u, 0u, 0u};
            if (mk >= 0 && mk < M) { const bf16_t* rowp = proj + (tb + (size_t)mk * dil + rho) * OINP; kv = *(const u32x4*)(rowp + 2832 + hc + pc * 8); vv = *(const u32x4*)(rowp + 3600 + hc + pc * 8); }
            *(u32x4*)(KS + kj * KST + pc * 16) = kv;
            const unsigned w[4] = {vv.x, vv.y, vv.z, vv.w};
#pragma unroll
            for (int q = 0; q < 4; ++q) { *(bf16_t*)(VT + (pc * 8 + 2 * q) * VST + kj * 2) = (bf16_t)(w[q] & 0xffffu); *(bf16_t*)(VT + (pc * 8 + 2 * q + 1) * VST + kj * 2) = (bf16_t)(w[q] >> 16); } }
        if (ht < 129) BIAS[ht] = relb[t5_bucket((ht - 64) * dil) * 12 + g * 4 + sl];
        const int mq = 64 * n + 16 * wv + l16; const size_t tq = tb + (size_t)mq * dil + rho;
        bf16x8 qf[2];
#pragma unroll
        for (int kk = 0; kk < 2; ++kk) qf[kk] = *(const bf16x8*)(proj + tq * OINP + 2064 + hc + kk * 32 + G * 8);
        __syncthreads();
        f32x4 sc[9]; float mx = -1e30f;
#pragma unroll
        for (int kt = 0; kt < 9; ++kt) { f32x4 acc = {0.f, 0.f, 0.f, 0.f};
#pragma unroll
            for (int kk = 0; kk < 2; ++kk) { const bf16x8 a = *(const bf16x8*)(KS + ((wv + kt) * 16 + l16) * KST + (kk * 32 + G * 8) * 2); acc = MFMA16(a, qf[kk], acc); }
#pragma unroll
            for (int r = 0; r < 4; ++r) { const int kj = (wv + kt) * 16 + G * 4 + r; const int delta = kj - 64 - 16 * wv - l16; const int mk = 64 * n - 64 + kj;
                const bool ok = (delta >= -64) && (delta <= 64) && (mk >= 0) && (mk < M);
                const float s = ok ? acc[r] * 0.125f + BIAS[(delta < -64 ? -64 : (delta > 64 ? 64 : delta)) + 64] : -1e30f;
                acc[r] = s; mx = fmaxf(mx, s); }
            sc[kt] = acc; }
        mx = fmaxf(mx, __shfl_xor(mx, 16)); mx = fmaxf(mx, __shfl_xor(mx, 32));
        float sum = 0.f;
#pragma unroll
        for (int kt = 0; kt < 9; ++kt)
#pragma unroll
            for (int r = 0; r < 4; ++r) { const float pv_ = (sc[kt][r] > -1e29f) ? __expf(sc[kt][r] - mx) : 0.f; sc[kt][r] = pv_; sum += pv_; }
        sum += __shfl_xor(sum, 16); sum += __shfl_xor(sum, 32);
        f32x4 ot[4];
#pragma unroll
        for (int dt = 0; dt < 4; ++dt) ot[dt] = (f32x4){0.f, 0.f, 0.f, 0.f};
#pragma unroll
        for (int pp = 0; pp < 5; ++pp) {
            u32x4 pb; pb.x = pk2(sc[2 * pp][0], sc[2 * pp][1]); pb.y = pk2(sc[2 * pp][2], sc[2 * pp][3]);
            if (pp < 4) { pb.z = pk2(sc[2 * pp + 1][0], sc[2 * pp + 1][1]); pb.w = pk2(sc[2 * pp + 1][2], sc[2 * pp + 1][3]); } else { pb.z = 0u; pb.w = 0u; }
            const bf16x8 pbf = __builtin_bit_cast(bf16x8, pb);
#pragma unroll
            for (int dt = 0; dt < 4; ++dt) {
                u32x4 av; const u32x2 lo = *(const u32x2*)(VT + (dt * 16 + l16) * VST + ((wv + 2 * pp) * 16 + G * 4) * 2); av.x = lo.x; av.y = lo.y;
                if (pp < 4) { const u32x2 hi = *(const u32x2*)(VT + (dt * 16 + l16) * VST + ((wv + 2 * pp + 1) * 16 + G * 4) * 2); av.z = hi.x; av.w = hi.y; } else { av.z = 0u; av.w = 0u; }
                ot[dt] = MFMA16(__builtin_bit_cast(bf16x8, av), pbf, ot[dt]);
            }
        }
        const float rs = 1.f / sum;
        bf16_t* od = proj + tq * OINP + (g * 4 + sl) * 64;
#pragma unroll
        for (int dt = 0; dt < 4; ++dt) { const f32x4 v_ = ot[dt] * rs; u32x2 w_; w_.x = pk2(v_[0], v_[1]); w_.y = pk2(v_[2], v_[3]); *(u32x2*)(od + dt * 16 + G * 4) = w_; }
        if (G == 0) LSE[tq * 12 + g * 4 + sl] = mx + __logf(sum);
    }
}

__device__ __forceinline__ void odd_combine(const bf16_t* OB, const bf16_t* proj, const float* LSE, const float* og, bf16_t* Y) {
    MK_IDS();
    float gn[8];
#pragma unroll
    for (int e = 0; e < 8; ++e) gn[e] = og[(lane & 15) * 8 + e];
    const int sl = lane >> 4;
    for (int t = gw; t < TS; t += NGW) {
        const bf16_t* prow = proj + (size_t)t * OINP;
        const u32x4 fa = *(const u32x4*)(OB + (size_t)t * 512 + lane * 8), ra = *(const u32x4*)(OB + ((size_t)TS + t) * 512 + lane * 8), za = *(const u32x4*)(prow + 1536 + lane * 8);
        const u32x2 d0 = *(const u32x2*)(prow + lane * 4), d1 = *(const u32x2*)(prow + 256 + lane * 4), d2 = *(const u32x2*)(prow + 512 + lane * 4);
        const float l0 = LSE[(size_t)t * 12 + sl], l1 = LSE[(size_t)t * 12 + 4 + sl], l2 = LSE[(size_t)t * 12 + 8 + sl];
        float f[8], r[8], z[8]; unpack8(fa, f); unpack8(ra, r); unpack8(za, z);
        float ss = 0.f;
#pragma unroll
        for (int e = 0; e < 8; ++e) { f[e] += r[e]; ss += f[e] * f[e]; }
        ss += __shfl_xor(ss, 1); ss += __shfl_xor(ss, 2); ss += __shfl_xor(ss, 4); ss += __shfl_xor(ss, 8);
        const float rn = 1.f / sqrtf(ss * (1.f / 128.f) + EPS);
#pragma unroll
        for (int e = 0; e < 8; ++e) f[e] = f[e] * rn * gn[e] * silu(z[e]);
        u32x4 o; o.x = pk2(f[0], f[1]); o.y = pk2(f[2], f[3]); o.z = pk2(f[4], f[5]); o.w = pk2(f[6], f[7]);
        *(u32x4*)(Y + (size_t)t * OOUT + lane * 8) = o;
        const float m = fmaxf(l0, fmaxf(l1, l2)); const float w0 = __expf(l0 - m), w1 = __expf(l1 - m), w2 = __expf(l2 - m); const float rs = 1.f / (w0 + w1 + w2);
        const float a0 = w0 * rs, a1 = w1 * rs, a2 = w2 * rs;
        const float v0 = a0 * __uint_as_float(d0.x << 16) + a1 * __uint_as_float(d1.x << 16) + a2 * __uint_as_float(d2.x << 16);
        const float v1 = a0 * __uint_as_float(d0.x & 0xffff0000u) + a1 * __uint_as_float(d1.x & 0xffff0000u) + a2 * __uint_as_float(d2.x & 0xffff0000u);
        const float v2 = a0 * __uint_as_float(d0.y << 16) + a1 * __uint_as_float(d1.y << 16) + a2 * __uint_as_float(d2.y << 16);
        const float v3 = a0 * __uint_as_float(d0.y & 0xffff0000u) + a1 * __uint_as_float(d1.y & 0xffff0000u) + a2 * __uint_as_float(d2.y & 0xffff0000u);
        u32x2 od; od.x = pk2(v0, v1); od.y = pk2(v2, v3);
        *(u32x2*)(Y + (size_t)t * OOUT + 512 + lane * 4) = od;
    }
}

__global__ void __launch_bounds__(NT, 2) fwd_megakernel(Params p) {
    extern __shared__ __attribute__((aligned(16))) unsigned char lds_raw[];
    cg::grid_group grid = cg::this_grid();
    char* lds = (char*)lds_raw;
    PG8_LAS unsigned char* ldsl = (PG8_LAS unsigned char*)lds_raw;
    const int Gr = gridDim.x;
    volatile LAS unsigned* MISC = (volatile LAS unsigned*)((PG8_LAS unsigned char*)lds_raw + (LDS_BYTES - 128));
    if (threadIdx.x < 32) MISC[threadIdx.x] = 0u;
    __syncthreads();
    xb::XcdBarrier bar = xb::xcd_barrier_post((unsigned*)p.ws, MISC + 8);
#define GSYNC() xb::xcd_barrier(bar)
    unsigned char* ws = p.ws;
    bf16_t* H = (bf16_t*)(ws + WS_H); bf16_t* PROJ = (bf16_t*)(ws + WS_PROJ); unsigned char* SCR = ws + WS_SCR;

    phase_prologue(p, lds);
    grid.sync();

    float* SSQA = (float*)(SCR + 232 * MiB); float* SSQB = (float*)(SCR + 234 * MiB);
    bf16_t* YE = (bf16_t*)(SCR + 192 * MiB); bf16_t* YO = (bf16_t*)(SCR + SC_QKVP);
    for (int seg = 0; seg < NSEG; ++seg) {
        const int S = seg < 2 ? 16384 : 2048, nb = seg < 2 ? 1 : 8;
        const float* xin = (seg < 2 ? p.in[0] : p.in[1]) + (size_t)(seg & 1) * TS * DMODEL;
        float* xo = p.out + (size_t)seg * TS * DMODEL;
        phase_x0(xin, H, SSQB);
        GSYNC();
        for (int layer = 0; layer < 4; ++layer) {
            const int j = layer >> 1; const bool odd = layer & 1;
            {
                const int N = odd ? OINP : EIN;
                const bf16_t* Bt = odd ? (const bf16_t*)(ws + WS_WINO) + (size_t)j * OINP * 1024 : (const bf16_t*)(ws + WS_WINE) + (size_t)j * EIN * 1024;
                pg8::Gemm g{H, Bt, TS, N, 1024}; pg8::StaticOrder So; So.init(TS, N, Gr, (int)blockIdx.x);
                pg8::EpiBf16<0> E{PROJ, N, nullptr, 0, 0, 1.f, SSQB};
                pg8::gemm_phase<pg8::EpiBf16<0>, pg8::StaticOrder, true, true>(ldsl, g, So, E);
            }
            GSYNC();
            if (!odd) {
                even_qk_post(PROJ, p.in[10] + j * 64, p.in[11] + j * 64, S);
                even_lru_prep(PROJ, p.in[12] + j * 2048, p.in[13] + j * 512, (const bf16_t*)(ws + WS_GW) + (size_t)j * 2 * 2 * 8 * 4096, p.in[15] + j * 1024, p.in[17] + j * 1024, p.in[18] + j * 1024,
                              (unsigned*)(SCR + SC_LA), (f32x2*)(SCR + SC_AGG), S, lds);
                GSYNC();
                {
                    const int nqb = S / 256, nunits = nb * 8 * nqb;
                    for (int u = blockIdx.x; u < nunits; u += Gr) {
                        const int qb = u % nqb, h = (u / nqb) % 8, b = u / (nqb * 8), kvh = h >> 2;
                        const attn_body::bf16* base = (const attn_body::bf16*)PROJ + (size_t)b * S * EIN;
                        attn_body::attn_unit<8>(qb, S, base + h * 64, EIN, base + 512 + kvh * 64, base + 640 + kvh * 64, EIN, (attn_body::bf16*)YE + (size_t)b * S * DMODEL + h * 64, DMODEL, lds);
                    }
                }
                __syncthreads();
                even_lru_scan((const unsigned*)(SCR + SC_LA), (const f32x2*)(SCR + SC_AGG), PROJ, YE, S);
                GSYNC();
                {
                    pg8::Gemm g{YE, (const bf16_t*)(ws + WS_WOUTE) + (size_t)j * 1024 * 1024, TS, 1024, 1024}; pg8::StaticOrder So; So.init(TS, 1024, Gr, (int)blockIdx.x);
                    EpiRes E{H, SSQA, DMODEL};
                    pg8::gemm_phase<EpiRes, pg8::StaticOrder, true, true>(ldsl, g, So, E);
                }
            } else {
                odd_conv(PROJ, p.in[21] + j * 4 * 1536, (bf16_t*)(SCR + SC_QKVP), S);
                asm volatile("s_waitcnt vmcnt(0)" ::: "memory"); __syncthreads();
                odd_prep((const bf16_t*)(SCR + SC_QKVP), PROJ, p.in[22] + j * 8, p.in[23] + j * 8, SCR + SC_DNI, (float*)(SCR + SC_EGL), lds);
                GSYNC();
                {
                    const int nscan = nb * 64;
                    if (nscan <= Gr) odd_scan<1>(SCR + SC_DNI, (const float*)(SCR + SC_EGL), (bf16_t*)(SCR + SC_OB), S, nb, lds);
                    else odd_scan<2>(SCR + SC_DNI, (const float*)(SCR + SC_EGL), (bf16_t*)(SCR + SC_OB), S, nb, lds);
                    const int first = nscan < Gr ? nscan : 0;
                    odd_dilated(PROJ, p.in[2], (float*)(SCR + SC_LSE), S, lds, first, Gr - first);
                }
                GSYNC();
                odd_combine((const bf16_t*)(SCR + SC_OB), PROJ, (const float*)(SCR + SC_LSE), p.in[24] + j * 128, YO);
                GSYNC();
                {
                    pg8::Gemm g{YO, (const bf16_t*)(ws + WS_WOUTO) + (size_t)j * 1024 * OOUT, TS, 1024, OOUT}; pg8::StaticOrder So; So.init(TS, 1024, Gr, (int)blockIdx.x);
                    EpiRes E{H, SSQA, DMODEL};
                    pg8::gemm_phase<EpiRes, pg8::StaticOrder, true, true>(ldsl, g, So, E);
                }
            }
            GSYNC();
            {
                pg8::Gemm g{H, (const bf16_t*)(ws + WS_W1T) + (size_t)layer * 4096 * 1024, TS, DFF, 1024}; pg8::StaticOrder So; So.init(TS, DFF, Gr, (int)blockIdx.x);
                pg8::EpiBf16<2> E{(bf16_t*)(SCR + SC_HID), DFF, nullptr, 0, 0, 1.f, SSQA};
                pg8::gemm_phase<pg8::EpiBf16<2>, pg8::StaticOrder, true, true>(ldsl, g, So, E);
            }
            GSYNC();
            {
                pg8::Gemm g{(const bf16_t*)(SCR + SC_HID), (const bf16_t*)(ws + WS_W2T) + (size_t)layer * 1024 * 4096, TS, 1024, DFF}; pg8::StaticOrder So; So.init(TS, 1024, Gr, (int)blockIdx.x);
                EpiRes E{H, SSQB, DMODEL};
                pg8::gemm_phase<EpiRes, pg8::StaticOrder, true, true>(ldsl, g, So, E);
            }
            GSYNC();
        }
        phase_rmsnorm_final(H, xo, p.in[5]);
        GSYNC();
    }
}
}

extern "C" void kernel_launch(void* const* d_in, const int* in_sizes, int n_in, void* d_out, int out_size, void* d_ws, size_t ws_size, hipStream_t stream) {
    static int grid = 0;
    if (grid == 0) {
        if (n_in != 25 || ws_size < mk::WS_END) { fprintf(stderr, "kernel_launch: unexpected n_in %d / ws_size %zu\n", n_in, ws_size); grid = -1; return; }
        int dev = 0, cus = 0, per_cu = 0;
        hipGetDevice(&dev); hipDeviceGetAttribute(&cus, hipDeviceAttributeMultiprocessorCount, dev);
        if (hipFuncSetAttribute((const void*)mk::fwd_megakernel, hipFuncAttributeMaxDynamicSharedMemorySize, mk::LDS_BYTES) != hipSuccess) { fprintf(stderr, "hipFuncSetAttribute failed\n"); }
        hipOccupancyMaxActiveBlocksPerMultiprocessor(&per_cu, (const void*)mk::fwd_megakernel, mk::NT, mk::LDS_BYTES);
        (void)hipGetLastError();
        if (per_cu < 1) per_cu = 1;
        grid = cus * 1;
        fprintf(stderr, "kernel_launch: cus %d per_cu %d grid %d\n", cus, per_cu, grid);
    }
    if (grid < 0) return;
    if (hipMemsetAsync(d_ws, 0, 65536, stream) != hipSuccess) { fprintf(stderr, "memset failed\n"); return; }
    mk::Params p{};
    for (int i = 0; i < 25; ++i) p.in[i] = (const float*)d_in[i];
    p.out = (float*)d_out; p.ws = (unsigned char*)d_ws;
    void* args[] = {&p};
    hipError_t e = hipLaunchCooperativeKernel((const void*)mk::fwd_megakernel, dim3(grid), dim3(mk::NT), args, mk::LDS_BYTES, stream);
    if (e != hipSuccess) fprintf(stderr, "cooperative launch failed: %s (grid %d)\n", hipGetErrorString(e), grid);
}
```

```cpp
#include <hip/hip_runtime.h>
#include <hip/hip_cooperative_groups.h>
#include <hip/hip_bf16.h>
#include <cstdio>
#include <cstdint>
#include <cmath>
namespace cg = cooperative_groups;
namespace pg8 {
#define PG8_LAS __attribute__((address_space(3)))
typedef unsigned short bf16_t;
typedef short bf16x8 __attribute__((ext_vector_type(8)));
typedef float f32x4 __attribute__((ext_vector_type(4)));
typedef unsigned u32x4 __attribute__((ext_vector_type(4)));
constexpr int BM = 256, BK = 64, HALF = 128, HTB = HALF * BK * 2  , STAGE_BYTES = 8 * HTB, NXCD = 8, WGM = 8;

__host__ __device__ __forceinline__ int lds_byte(int r, int c) { const int st = (r >> 4) * 2 + (c >> 5), rr = r & 15, cc = c & 31, ob = rr * 64 + cc * 2; return st * 1024 + (ob ^ (((ob >> 9) & 1) << 5)); }
__host__ __device__ __forceinline__ void stage_rc(int b, int& R, int& C) { const int st = b / 1024, sb = b % 1024, swz = sb ^ (((sb >> 9) & 1) << 5); R = (st >> 1) * 16 + swz / 64; C = (st & 1) * 32 + (swz % 64) / 2; }
__host__ __device__ __forceinline__ int perm32(int rho) { const int n = rho >> 4, i = rho & 15; return 8 * (i >> 2) + 4 * n + (i & 3); }

struct Unit { int pm, pn; };
struct Gemm { const bf16_t* A; const bf16_t* Bt; int M, N, K; };

struct StaticOrder {
    int nM, nN, nwg, G, c;
    __host__ __device__ void init(int M, int N, int G_, int c_) { nM = M / BM; nN = N / BM; nwg = nM * nN; G = G_; c = c_; }
    __host__ __device__ bool next(int i, Unit& u) const {
        const long L = (long)i * G + c; if (L >= nwg) return false;
        int wgid = (int)L; { const int q = nwg / NXCD, r = nwg % NXCD, xcd = wgid % NXCD, off = wgid / NXCD; wgid = (xcd < r ? xcd * (q + 1) : r * (q + 1) + (xcd - r) * q) + off; }
        const int nig = WGM * nN, gid = wgid / nig, fm = gid * WGM, gsz = (nM - fm) < WGM ? (nM - fm) : WGM;
        u.pm = fm + ((wgid % nig) % gsz); u.pn = (wgid % nig) / gsz; return true;
    }
    __device__ __forceinline__ void a_ready(const Unit&) const {}
    __device__ __forceinline__ void done(const Unit&) const {}
};

__device__ __forceinline__ unsigned cvt_pk_bf16(float lo, float hi) { unsigned r; asm volatile("v_cvt_pk_bf16_f32 %0, %1, %2" : "=v"(r) : "v"(lo), "v"(hi)); return r; }
typedef float f32x2 __attribute__((ext_vector_type(2)));
__device__ __forceinline__ f32x2 gelu_pk(f32x2 v) {
    const f32x2 av = __builtin_elementwise_abs(v), d = av * 0.2316418882f + 1.0f;
    f32x2 t; t.x = __builtin_amdgcn_rcpf(d.x); t.y = __builtin_amdgcn_rcpf(d.y);
    f32x2 q = t * 0.5307027145f + (-0.7265760135f); q = q * t + 0.7107068705f; q = q * t + (-0.142248368f); q = q * t + 0.127414796f; q = q * t;
    const f32x2 s = (v * v) * (-0.72134752044f);
    f32x2 e; e.x = __builtin_amdgcn_exp2f(s.x); e.y = __builtin_amdgcn_exp2f(s.y);
    const f32x2 m = v * (q * e), r = v - m;
    f32x2 o; o.x = v.x < 0.f ? m.x : r.x; o.y = v.y < 0.f ? m.y : r.y; return o;
}

template <int ACT  > struct EpiBf16 {
    static constexpr bool PERM = true, AFTER_DRAIN = false; static_assert(ACT == 0 || ACT == 1 || ACT == 2, "EpiBf16: ACT 0 none, 1 gelu, 2 relu^2");
    bf16_t* O; int ldc; const float* bias; int split_cols; size_t split_stride; float scale0; const float* ssq;
    __device__ __forceinline__ void operator()(const f32x4 (&acc)[2][2][4][2], const Unit& u, int wr, int wc, int fr, int fq) const {
        const int row0 = u.pm * BM + wr * 64 + fr; int colt = u.pn * BM; bf16_t* base = O;
        float sc = 1.f; if (split_cols) { const int t = colt / split_cols; base += (size_t)t * split_stride; colt -= t * split_cols; if (t == 0) sc = scale0; }
        const int col0 = colt + wc * 32 + 8 * fq, bcol0 = u.pn * BM + wc * 32 + 8 * fq;
        float rsc[2][4];
        if (ssq) { f32x4 t_[2][4];
#pragma unroll
            for (int ai = 0; ai < 2; ++ai)
#pragma unroll
                for (int m = 0; m < 4; ++m) t_[ai][m] = *(const f32x4*)(ssq + (size_t)(row0 + ai * HALF + m * 16) * 16 + fq * 4);
#pragma unroll
            for (int ai = 0; ai < 2; ++ai)
#pragma unroll
                for (int m = 0; m < 4; ++m) { float s_ = (t_[ai][m][0] + t_[ai][m][1]) + (t_[ai][m][2] + t_[ai][m][3]); s_ += __shfl_xor(s_, 16); s_ += __shfl_xor(s_, 32); rsc[ai][m] = 1.0f / sqrtf(s_ * (1.0f / 1024.0f) + 1e-6f); }
        } else {
#pragma unroll
            for (int ai = 0; ai < 2; ++ai)
#pragma unroll
                for (int m = 0; m < 4; ++m) rsc[ai][m] = 1.0f; }
        f32x4 bv[2][2];
#pragma unroll
        for (int bj = 0; bj < 2; ++bj)
#pragma unroll
            for (int n = 0; n < 2; ++n) bv[bj][n] = bias ? *(const f32x4*)(bias + bcol0 + bj * HALF + 4 * n) : (f32x4){0.f, 0.f, 0.f, 0.f};
#pragma unroll
        for (int ai = 0; ai < 2; ++ai)
#pragma unroll
            for (int m = 0; m < 4; ++m) { bf16_t* rowp = base + (size_t)(row0 + ai * HALF + m * 16) * ldc + col0; const float rsc_ = rsc[ai][m];
#pragma unroll
                for (int bj = 0; bj < 2; ++bj) { f32x4 v0 = (acc[ai][bj][m][0] + bv[bj][0]) * rsc_, v1 = (acc[ai][bj][m][1] + bv[bj][1]) * rsc_;
                    if (ACT == 1) { f32x2 a = gelu_pk((f32x2){v0[0], v0[1]}), b = gelu_pk((f32x2){v0[2], v0[3]}), c = gelu_pk((f32x2){v1[0], v1[1]}), d = gelu_pk((f32x2){v1[2], v1[3]});
                        v0 = (f32x4){a.x, a.y, b.x, b.y}; v1 = (f32x4){c.x, c.y, d.x, d.y}; }
                    if (ACT == 2) { _Pragma("unroll") for (int q_ = 0; q_ < 4; ++q_) { const float a0_ = v0[q_] > 0.f ? v0[q_] : 0.f, a1_ = v1[q_] > 0.f ? v1[q_] : 0.f; v0[q_] = a0_ * a0_; v1[q_] = a1_ * a1_; } }
                    v0 = v0 * sc; v1 = v1 * sc; u32x4 w; w.x = cvt_pk_bf16(v0[0], v0[1]); w.y = cvt_pk_bf16(v0[2], v0[3]); w.z = cvt_pk_bf16(v1[0], v1[1]); w.w = cvt_pk_bf16(v1[2], v1[3]);
                    *(u32x4*)(rowp + bj * HALF) = w; } }
    }
};

template <class Epi, class Sched, bool ALIGN_EPI = false, bool SP2 = false>
__device__ __forceinline__ void gemm_phase(PG8_LAS unsigned char* lds, const Gemm g, const Sched& S, const Epi& E) {
    int tid_ = threadIdx.x; asm volatile("" : "+v"(tid_)); const int tid = tid_, wid = __builtin_amdgcn_readfirstlane(tid >> 6), lane = tid & 63, wr = wid >> 2, wc = wid & 3, fr = lane & 15, fq = lane >> 4;
    const int K = g.K, nt = K / BK;
    unsigned voffA[2], voffB[2];
#pragma unroll
    for (int i = 0; i < 2; ++i) { int R, C; stage_rc(tid * 16 + i * 8192, R, C); const int Rb = Epi::PERM ? ((R & ~31) + perm32(R & 31)) : R;
        voffA[i] = (unsigned)(R * K + C) * 2u; voffB[i] = (unsigned)(Rb * K + C) * 2u; }
    const size_t kstep = (size_t)(BK * 2);
    const size_t hstep = (size_t)HALF * K * 2;
    const size_t tstep = 2 * hstep;
    const unsigned ldsw = (unsigned)wid * 1024u;
    const int aoff = lds_byte(wr * 64 + fr, fq * 8), boff = lds_byte(wc * 32 + fr, fq * 8);
#define PG8_SA(b, h) (((b) * 2 + (h)) * HTB)
#define PG8_SB(b, h) ((4 + (b) * 2 + (h)) * HTB)
#define PG8_STAGE(bufoff, gbase, voff) do { _Pragma("unroll") for (int _i = 0; _i < 2; ++_i) \
        __builtin_amdgcn_global_load_lds((const unsigned*)((const char*)(gbase) + (voff)[_i]), (PG8_LAS unsigned*)(lds + (bufoff) + ldsw + _i * 8192), 16, 0, 0); } while (0)
#define PG8_LDA(dst, b, h) do { _Pragma("unroll") for (int m = 0; m < 4; ++m) _Pragma("unroll") for (int k = 0; k < 2; ++k) dst[m][k] = *(const PG8_LAS bf16x8*)(lds + PG8_SA(b, h) + aoff + m * 2048 + k * 1024); } while (0)
#define PG8_LDB(dst, b, h) do { _Pragma("unroll") for (int n = 0; n < 2; ++n) _Pragma("unroll") for (int k = 0; k < 2; ++k) dst[n][k] = *(const PG8_LAS bf16x8*)(lds + PG8_SB(b, h) + boff + n * 2048 + k * 1024); } while (0)
#define PG8_MMA(ai, bj, At, Bt) do { __builtin_amdgcn_s_setprio(1); _Pragma("unroll") for (int m = 0; m < 4; ++m) _Pragma("unroll") for (int n = 0; n < 2; ++n) _Pragma("unroll") for (int k = 0; k < 2; ++k) \
        acc[ai][bj][m][n] = __builtin_amdgcn_mfma_f32_16x16x32_bf16(Bt[n][k], At[m][k], acc[ai][bj][m][n], 0, 0, 0); __builtin_amdgcn_s_setprio(0); } while (0)
#define PG8_WAIT_V(n) asm volatile("s_waitcnt vmcnt(" #n ")" ::: "memory")
#define PG8_WAIT_L(n) asm volatile("s_waitcnt lgkmcnt(" #n ")" ::: "memory")
#define PG8_BAR __builtin_amdgcn_s_barrier()
#define PG8_SCHED __builtin_amdgcn_sched_barrier(0)
    Unit cur, nxt; int ui = 0;
    if (!S.next(0, cur)) return;
    f32x4 acc[2][2][4][2];
#pragma unroll
    for (int a = 0; a < 2; ++a)
#pragma unroll
        for (int b = 0; b < 2; ++b)
#pragma unroll
            for (int m = 0; m < 4; ++m)
#pragma unroll
                for (int n = 0; n < 2; ++n) acc[a][b][m][n] = (f32x4){0.f, 0.f, 0.f, 0.f};
    bf16x8 At[4][2], B0[2][2], B1[2][2];
    const char* cA = (const char*)g.A + (size_t)cur.pm * tstep; const char* cB = (const char*)g.Bt + (size_t)cur.pn * tstep;
    S.a_ready(cur);
    if constexpr (SP2) {
        PG8_STAGE(PG8_SB(0, 0), cB, voffB); PG8_STAGE(PG8_SB(0, 1), cB + hstep, voffB); PG8_STAGE(PG8_SA(0, 0), cA, voffA); PG8_STAGE(PG8_SA(0, 1), cA + hstep, voffA);
        if (wr == 1) PG8_BAR;
        PG8_WAIT_V(2); PG8_BAR;
        PG8_STAGE(PG8_SB(1, 0), cB + kstep, voffB); PG8_STAGE(PG8_SA(1, 0), cA + kstep, voffA); PG8_STAGE(PG8_SB(1, 1), cB + hstep + kstep, voffB);
        PG8_WAIT_V(6); PG8_BAR;
    } else {
        PG8_STAGE(PG8_SB(0, 0), cB, voffB); PG8_STAGE(PG8_SA(0, 0), cA, voffA); PG8_STAGE(PG8_SB(0, 1), cB + hstep, voffB); PG8_STAGE(PG8_SA(0, 1), cA + hstep, voffA);
        if (wr == 1) PG8_BAR;
        PG8_WAIT_V(4); PG8_BAR;
        PG8_STAGE(PG8_SB(1, 0), cB + kstep, voffB); PG8_STAGE(PG8_SA(1, 0), cA + kstep, voffA); PG8_STAGE(PG8_SB(1, 1), cB + hstep + kstep, voffB);
        PG8_WAIT_V(6); PG8_BAR;
    }
    for (;;) {
        const bool has_next = S.next(ui + 1, nxt);
        const char* nA = has_next ? (const char*)g.A + (size_t)nxt.pm * tstep : cA; const char* nB = has_next ? (const char*)g.Bt + (size_t)nxt.pn * tstep : cB;
        for (int t = 0; t < nt; t += 2) {
            const bool last = (t == nt - 2);
            const char* a1 = cA + (size_t)(t + 1) * kstep;
            const char* a2 = last ? nA : cA + (size_t)(t + 2) * kstep; const char* b2 = last ? nB : cB + (size_t)(t + 2) * kstep;
            const char* a3 = a2 + kstep; const char* b3 = b2 + kstep;
            if (last && has_next) S.a_ready(nxt);
            if constexpr (SP2) {
            PG8_LDB(B0, 0, 0); PG8_LDB(B1, 0, 1); PG8_SCHED; PG8_LDA(At, 0, 0); PG8_STAGE(PG8_SA(1, 1), a1 + hstep, voffA);
            PG8_WAIT_V(8); PG8_WAIT_L(0); PG8_BAR; PG8_MMA(0, 0, At, B0); PG8_MMA(0, 1, At, B1); PG8_BAR; PG8_SCHED;
            PG8_LDA(At, 0, 1); PG8_STAGE(PG8_SB(0, 0), b2, voffB); PG8_STAGE(PG8_SB(0, 1), b2 + hstep, voffB); PG8_STAGE(PG8_SA(0, 0), a2, voffA);
            PG8_WAIT_V(8); PG8_WAIT_L(0); PG8_BAR; PG8_MMA(1, 0, At, B0); PG8_MMA(1, 1, At, B1); PG8_BAR; PG8_SCHED;
            PG8_LDB(B0, 1, 0); PG8_LDB(B1, 1, 1); PG8_SCHED; PG8_LDA(At, 1, 0); PG8_STAGE(PG8_SA(0, 1), a2 + hstep, voffA);
            PG8_WAIT_V(8); PG8_WAIT_L(0); PG8_BAR; PG8_MMA(0, 0, At, B0); PG8_MMA(0, 1, At, B1); PG8_BAR; PG8_SCHED;
            PG8_LDA(At, 1, 1); PG8_STAGE(PG8_SB(1, 0), b3, voffB); PG8_STAGE(PG8_SB(1, 1), b3 + hstep, voffB); PG8_STAGE(PG8_SA(1, 0), a3, voffA);
            PG8_WAIT_V(8); PG8_WAIT_L(0); PG8_BAR; PG8_MMA(1, 0, At, B0); PG8_MMA(1, 1, At, B1); PG8_BAR; PG8_SCHED;
            } else {
            PG8_LDB(B0, 0, 0); PG8_SCHED; PG8_LDA(At, 0, 0); PG8_STAGE(PG8_SA(1, 1), a1 + hstep, voffA);
            PG8_WAIT_L(8); PG8_BAR; PG8_WAIT_L(0); PG8_MMA(0, 0, At, B0); PG8_BAR; PG8_SCHED;
            PG8_LDB(B1, 0, 1); PG8_STAGE(PG8_SB(0, 0), b2, voffB);
            PG8_BAR; PG8_WAIT_L(0); PG8_MMA(0, 1, At, B1); PG8_BAR;
            PG8_LDA(At, 0, 1); PG8_STAGE(PG8_SA(0, 0), a2, voffA);
            PG8_BAR; PG8_WAIT_L(0); PG8_MMA(1, 0, At, B0); PG8_BAR; PG8_SCHED;
            PG8_STAGE(PG8_SB(0, 1), b2 + hstep, voffB);
            PG8_WAIT_V(6); PG8_BAR; PG8_MMA(1, 1, At, B1); PG8_BAR;
            PG8_LDB(B0, 1, 0); PG8_SCHED; PG8_LDA(At, 1, 0); PG8_STAGE(PG8_SA(0, 1), a2 + hstep, voffA);
            PG8_WAIT_L(8); PG8_BAR; PG8_WAIT_L(0); PG8_MMA(0, 0, At, B0); PG8_BAR; PG8_SCHED;
            PG8_LDB(B1, 1, 1); PG8_STAGE(PG8_SB(1, 0), b3, voffB);
            PG8_BAR; PG8_WAIT_L(0); PG8_MMA(0, 1, At, B1); PG8_BAR;
            PG8_LDA(At, 1, 1); PG8_STAGE(PG8_SA(1, 0), a3, voffA);
            PG8_BAR; PG8_WAIT_L(0); PG8_MMA(1, 0, At, B0); PG8_BAR; PG8_SCHED;
            PG8_STAGE(PG8_SB(1, 1), b3 + hstep, voffB);
            PG8_WAIT_V(6); PG8_BAR; PG8_MMA(1, 1, At, B1); PG8_BAR;
            }
        }
        if constexpr (ALIGN_EPI) { if (wr == 0) PG8_BAR; }
        if constexpr (!Epi::AFTER_DRAIN) { E(acc, cur, wr, wc, fr, fq); S.done(cur); }
        if (!has_next) break;
#pragma unroll
        for (int a = 0; a < 2; ++a)
#pragma unroll
            for (int b = 0; b < 2; ++b)
#pragma unroll
                for (int m = 0; m < 4; ++m)
#pragma unroll
                    for (int n = 0; n < 2; ++n) acc[a][b][m][n] = (f32x4){0.f, 0.f, 0.f, 0.f};
        cur = nxt; cA = nA; cB = nB; ++ui;
        if constexpr (ALIGN_EPI) { if (wr == 1) PG8_BAR; }
    }
    PG8_WAIT_V(0);
    if constexpr (!ALIGN_EPI) { if (wr == 0) PG8_BAR; }
    PG8_BAR;
    if constexpr (Epi::AFTER_DRAIN) { E.fused(acc, cur, wr, wc, fr, fq, lds, wid, lane); S.done(cur); }
#undef PG8_SA
#undef PG8_SB
#undef PG8_STAGE
#undef PG8_LDA
#undef PG8_LDB
#undef PG8_MMA
#undef PG8_WAIT_V
#undef PG8_WAIT_L
#undef PG8_BAR
#undef PG8_SCHED
}
}

#ifndef PG8_SP2
#define PG8_SP2 true
#endif
#ifndef PG8_ALIGN
#define PG8_ALIGN true
#endif
#include <hip/hip_bf16.h>
#include <cmath>
namespace attn_body {
using bf16=__hip_bfloat16;
using bf16x8=__attribute__((ext_vector_type(8)))short;
using s16x4=__attribute__((ext_vector_type(4)))short;
using f32x16=__attribute__((ext_vector_type(16)))float;
using u32x4=__attribute__((ext_vector_type(4)))unsigned;
constexpr int D=64;
constexpr int NW=8,QBLK=32,QB=QBLK*NW,KVBLK=64;
__device__ __forceinline__ int crow(int r,int hi){return (r&3)+8*(r>>2)+4*hi;}
#define SBAR() __builtin_amdgcn_sched_barrier(0)
__device__ __forceinline__ void cmask(f32x16&p0,f32x16&p1,int jb,int qrel,int hi){
  const float NEG=-INFINITY; int kb=64*jb+4*hi;
  #pragma unroll
  for(int r=0;r<16;++r){int kv=kb+(r&3)+8*(r>>2); if(kv>qrel)p0[r]=NEG; if(kv+32>qrel)p1[r]=NEG;}
}

constexpr int NSLOT=3, SLOTB=8192;
constexpr int LDS_K=0, LDS_V=NSLOT*SLOTB, LDS_WS=2*NSLOT*SLOTB, LDS_OST=LDS_WS+NW*64*4, LDS_BYTES=LDS_OST+NW*4096;
constexpr float C2=0.125f*1.4426950408889634f;
__device__ __forceinline__ void glds16(const void*gsrc,unsigned lds_dst){unsigned keep;
  asm volatile("s_mov_b32 %0, m0\n\ts_mov_b32 m0, %2\n\ts_nop 0\n\tglobal_load_lds_dwordx4 %1, off\n\ts_mov_b32 m0, %0":"=&s"(keep):"v"(gsrc),"s"(lds_dst):"memory");}
__device__ __forceinline__ float max3f(float a,float b,float c){float r;asm("v_max3_f32 %0, %1, %2, %3":"=v"(r):"v"(a),"v"(b),"v"(c));return r;}
__device__ __forceinline__ float max2f(float a,float b){float r;asm("v_max_f32_e32 %0, %1, %2":"=v"(r):"v"(a),"v"(b));return r;}
__device__ __forceinline__ float fadd_s(float a,float b){float r;asm("v_add_f32_e32 %0, %1, %2":"=v"(r):"v"(a),"v"(b));return r;}
__device__ __forceinline__ float fsub_s(float a,float b){float r;asm("v_sub_f32_e32 %0, %1, %2":"=v"(r):"v"(a),"v"(b));return r;}
typedef float f32x2_t __attribute__((ext_vector_type(2))); typedef __bf16 bf16x2_t __attribute__((ext_vector_type(2)));
__device__ __forceinline__ unsigned cvtpk_s(float lo,float hi){f32x2_t v={lo,hi};bf16x2_t b=__builtin_convertvector(v,bf16x2_t);return __builtin_bit_cast(unsigned,b);}
#define WAIT_BAR(N) asm volatile("s_waitcnt vmcnt(" #N ") lgkmcnt(0)\n\ts_barrier":::"memory")

__device__ __forceinline__ void qkt(f32x16&p0,f32x16&p1,const char*Kslot,const bf16x8*qr,const f32x16&negm,int r32,int hi){
  const char*kb=Kslot+hi*1024+r32*16;
  #pragma unroll
  for(int d0=0;d0<4;++d0){
    const bf16x8 b0=*reinterpret_cast<const bf16x8*>(kb+d0*2048);
    const bf16x8 b1=*reinterpret_cast<const bf16x8*>(kb+d0*2048+512);
    if(d0==0){p0=__builtin_amdgcn_mfma_f32_32x32x16_bf16(b0,qr[0],negm,0,0,0);p1=__builtin_amdgcn_mfma_f32_32x32x16_bf16(b1,qr[0],negm,0,0,0);}
    else{p0=__builtin_amdgcn_mfma_f32_32x32x16_bf16(b0,qr[d0],p0,0,0,0);p1=__builtin_amdgcn_mfma_f32_32x32x16_bf16(b1,qr[d0],p1,0,0,0);}}
}
typedef __attribute__((address_space(3))) const char* lds_cptr;
typedef short v4i16_t __attribute__((ext_vector_type(4)));
__device__ __forceinline__ void kload8(bf16x8*kf,lds_cptr kp){
  kf[0]=*(const __attribute__((address_space(3))) bf16x8*)(kp);      kf[1]=*(const __attribute__((address_space(3))) bf16x8*)(kp+512);
  kf[2]=*(const __attribute__((address_space(3))) bf16x8*)(kp+2048); kf[3]=*(const __attribute__((address_space(3))) bf16x8*)(kp+2560);
  kf[4]=*(const __attribute__((address_space(3))) bf16x8*)(kp+4096); kf[5]=*(const __attribute__((address_space(3))) bf16x8*)(kp+4608);
  kf[6]=*(const __attribute__((address_space(3))) bf16x8*)(kp+6144); kf[7]=*(const __attribute__((address_space(3))) bf16x8*)(kp+6656);
}
__device__ __forceinline__ void kload2(bf16x8*kf,lds_cptr kp,int j){ kf[2*j]=*(const __attribute__((address_space(3))) bf16x8*)(kp+j*2048); kf[2*j+1]=*(const __attribute__((address_space(3))) bf16x8*)(kp+j*2048+512); }
__device__ __forceinline__ s16x4 vtr(lds_cptr p){ return __builtin_bit_cast(s16x4,__builtin_amdgcn_ds_read_tr16_b64_v4i16((__attribute__((address_space(3))) v4i16_t*)p)); }
__device__ __forceinline__ float rowmax(const f32x16&p0,const f32x16&p1){
  float a=max3f(p0[0],p0[1],p1[0]),b=max3f(p0[2],p0[3],p1[1]);a=max3f(a,p1[2],p1[3]);
  #pragma unroll
  for(int r=4;r<16;r+=4){a=max3f(a,p0[r],p0[r+1]);b=max3f(b,p0[r+2],p0[r+3]);a=max3f(a,p1[r],p1[r+1]);b=max3f(b,p1[r+2],p1[r+3]);}
  const float m=max2f(a,b);
  auto rr=__builtin_amdgcn_permlane32_swap(__float_as_uint(m),__float_as_uint(m),false,false);
  return max2f(__uint_as_float(rr[0]),__uint_as_float(rr[1]));
}
__device__ __forceinline__ void pv(f32x16*o,int vb,bf16x8 pa0,bf16x8 pa1,bf16x8 pa2,bf16x8 pa3){
  #pragma unroll
  for(int d0=0;d0<2;++d0){s16x4 lo[4],hi[4];
    #pragma unroll
    for(int ks=0;ks<4;++ks){
      asm volatile("ds_read_b64_tr_b16 %0,%1 offset:%c2":"=&v"(lo[ks]):"v"(vb),"i"(d0*4096+ks*1024):"memory");
      asm volatile("ds_read_b64_tr_b16 %0,%1 offset:%c2":"=&v"(hi[ks]):"v"(vb),"i"(d0*4096+ks*1024+512):"memory");}
    asm volatile("s_waitcnt lgkmcnt(0)":::"memory");SBAR();
    #define PK(k) (bf16x8){lo[k][0],lo[k][1],lo[k][2],lo[k][3],hi[k][0],hi[k][1],hi[k][2],hi[k][3]}
    o[d0]=__builtin_amdgcn_mfma_f32_32x32x16_bf16(pa0,PK(0),o[d0],0,0,0);
    o[d0]=__builtin_amdgcn_mfma_f32_32x32x16_bf16(pa1,PK(1),o[d0],0,0,0);
    o[d0]=__builtin_amdgcn_mfma_f32_32x32x16_bf16(pa2,PK(2),o[d0],0,0,0);
    o[d0]=__builtin_amdgcn_mfma_f32_32x32x16_bf16(pa3,PK(3),o[d0],0,0,0);
    #undef PK
  }
}

#ifndef ATTN_STORE16
#define ATTN_STORE16(p,v) (*(u32x4*)(p)=(v))
#endif
template<int THRL> __device__ __forceinline__ void attn_unit(int qb,int SEQ,const bf16*Q,int QP,const bf16*__restrict__ K,const bf16*__restrict__ V,int KP,bf16*O,int OP,char*shm){
  int tid_=threadIdx.x; asm volatile("":"+v"(tid_)); const int tid=tid_,lane=tid&63,r32=lane&31,hi=lane>>5; const int wid=__builtin_amdgcn_readfirstlane(tid>>6);
  const int q0=qb*QB;
  const bf16*Qw=Q+(long)(q0+wid*QBLK)*QP;
  const bf16*Kh=K,*Vh=V;
  const unsigned lds0=(unsigned)(uintptr_t)shm;
  float*wsf=(float*)(shm+LDS_WS)+wid*64;
  const bf16*ksrc=Kh+(long)lane*KP+wid*8;
  const bf16*vsrc=Vh+(long)(16*(wid&3)+(lane>>2))*KP+(wid>>2)*32+(lane&3)*8;
  const unsigned kdst=lds0+LDS_K+wid*1024, vdst=lds0+LDS_V+wid*1024;
  #define DMA_K(t,slot) glds16(ksrc+(long)(t)*KVBLK*KP,(unsigned)__builtin_amdgcn_readfirstlane(kdst+(slot)))
  #define DMA_V(t,slot) glds16(vsrc+(long)(t)*KVBLK*KP,(unsigned)__builtin_amdgcn_readfirstlane(vdst+(slot)))
  const int vb0=(int)(lds0+LDS_V)+((lane>>4)&1)*32+(lane&3)*8+(4*hi+((lane&15)>>2))*64;
  const char*Kbase=shm+LDS_K; bf16x8 kf[8];
  const lds_cptr shm3=(lds_cptr)shm; const lds_cptr kp0=shm3+LDS_K+hi*1024+r32*16; const lds_cptr vp0=shm3+LDS_V+((lane>>4)&1)*32+(lane&3)*8+(4*hi+((lane&15)>>2))*64;
  const int NT=SEQ/KVBLK;
  DMA_K(0,0);DMA_V(0,0);DMA_K(1,SLOTB);
  bf16x8 qr[4];
  #pragma unroll
  for(int d0=0;d0<4;++d0)qr[d0]=*reinterpret_cast<const bf16x8*>(&Qw[(long)r32*QP+d0*16+hi*8]);
  float mhat=0.f,l_reg=0.f;f32x16 o[2];o[0]=f32x16{};o[1]=f32x16{};f32x16 negm=f32x16{};asm volatile("":"+v"(negm));
  const int qrel=wid*QBLK+r32;
  #define CMASK(P0,P1,t) do{}while(0)
  bool resc=false;
  #define START(P0,P1) do{ const float rm=rowmax(P0,P1); resc=false; \
    { const float dl=rm; mhat=fadd_s(mhat,dl); \
      _Pragma("unroll") for(int r=0;r<16;++r){P0[r]=fsub_s(P0[r],dl);P1[r]=fsub_s(P1[r],dl);} \
      _Pragma("unroll") for(int r=0;r<16;++r)negm[r]=-mhat; asm volatile("":"+v"(negm)); } \
    _Pragma("unroll") for(int r=0;r<16;++r)P0[r]=__builtin_amdgcn_exp2f(P0[r]); }while(0)
  #define RESC() do{ if(resc){ asm volatile("s_waitcnt lgkmcnt(0)":::"memory"); \
      _Pragma("unroll") for(int d_=0;d_<2;++d_) _Pragma("unroll") for(int r=0;r<16;++r)o[d_][r]*=wsf[crow(r,hi)]; } }while(0)
  f32x16 pA0,pA1,pB0,pB1;
  int sl_prev=0,sl_cur=0,sl_next=SLOTB;
  #define ROT() do{sl_prev=sl_cur;sl_cur=sl_next;sl_next=(sl_next==(NSLOT-1)*SLOTB)?0:sl_next+SLOTB;}while(0)
  DMA_K(2,2*SLOTB);
  WAIT_BAR(3);
  qkt(pA0,pA1,Kbase,qr,negm,r32,hi);asm volatile("s_nop 15\n\ts_nop 7":"+v"(pA0),"+v"(pA1));CMASK(pA0,pA1,0);
  START(pA0,pA1);
  _Pragma("unroll") for(int r=0;r<16;++r)pA1[r]=__builtin_amdgcn_exp2f(pA1[r]);
  WAIT_BAR(0);
  DMA_K(3,0);DMA_V(1,SLOTB);
  ROT();
  kload8(kf,kp0+sl_cur);
  WAIT_BAR(2);
  s16x4 vlo[8],vhi[8]; u32x4 pw0,pw1,pw2,pw3;
  #define PKW(P,B) cvtpk_s(P[B],P[B+1])
  #define PAF(k) __builtin_bit_cast(bf16x8,pw##k)
  #define VFR(i) (bf16x8){vlo[i][0],vlo[i][1],vlo[i][2],vlo[i][3],vhi[i][0],vhi[i][1],vhi[i][2],vhi[i][3]}
  #define PIN(x) asm volatile("":"+v"(x))
  #define MX3(a,b,c) __builtin_fmaxf(__builtin_fmaxf((a),(b)),(c))
  #define GAPA(MF,A0,A1,A2,A3,W0,W1,PW) do{ MF; sacc+=A0; sacc+=A1; sacc+=A2; sacc+=A3; PIN(sacc); W0; W1; PIN(PW); SBAR(); }while(0)
  #define EX(v) __builtin_amdgcn_exp2f(v)
  #define GAPB(MF,X,B) do{ MF; X[B]=EX(X[B]); X[B+1]=EX(X[B+1]); X[B+2]=EX(X[B+2]); X[B+3]=EX(X[B+3]); PIN(X); SBAR(); }while(0)
  #define VRD(i) do{ vlo[i]=vtr(vp_+(((i)>>2)*4096+((i)&3)*1024)); vhi[i]=vtr(vp_+(((i)>>2)*4096+((i)&3)*1024+512)); }while(0)
  #define KRD(G,j) do{ if(G){ kload2(kf,kp0+sl_next,j); SBAR(); } }while(0)
  #define STEP(C0,C1,P0,P1,t,GK,GV,GL) do{ SBAR(); \
    const lds_cptr vp_=vp0+sl_prev; \
    VRD(0); SBAR(); float sacc=(P0[0]+P0[1]); \
    GAPA(C0=__builtin_amdgcn_mfma_f32_32x32x16_bf16(kf[0],qr[0],negm,0,0,0), P0[2],P0[3],P0[4],P0[5],     pw0[0]=PKW(P0,0), pw0[1]=PKW(P0,2), pw0); \
    VRD(4); SBAR(); GAPA(C1=__builtin_amdgcn_mfma_f32_32x32x16_bf16(kf[1],qr[0],negm,0,0,0), P0[6],P0[7],P0[8],P0[9],     pw0[2]=PKW(P0,4), pw0[3]=PKW(P0,6), pw0); \
    VRD(1); SBAR(); GAPA(C0=__builtin_amdgcn_mfma_f32_32x32x16_bf16(kf[2],qr[1],C0,0,0,0),   P0[10],P0[11],P0[12],P0[13], pw1[0]=PKW(P0,8), pw1[1]=PKW(P0,10), pw1); \
    VRD(5); SBAR(); GAPA(C1=__builtin_amdgcn_mfma_f32_32x32x16_bf16(kf[3],qr[1],C1,0,0,0),   P0[14],P0[15],P1[0],P1[1],   pw1[2]=PKW(P0,12),pw1[3]=PKW(P0,14), pw1); \
    VRD(2); SBAR(); GAPA(C0=__builtin_amdgcn_mfma_f32_32x32x16_bf16(kf[4],qr[2],C0,0,0,0),   P1[2],P1[3],P1[4],P1[5],     pw2[0]=PKW(P1,0), pw2[1]=PKW(P1,2), pw2); \
    VRD(6); SBAR(); GAPA(C1=__builtin_amdgcn_mfma_f32_32x32x16_bf16(kf[5],qr[2],C1,0,0,0),   P1[6],P1[7],P1[8],P1[9],     pw2[2]=PKW(P1,4), pw2[3]=PKW(P1,6), pw2); \
    VRD(3); SBAR(); GAPA(C0=__builtin_amdgcn_mfma_f32_32x32x16_bf16(kf[6],qr[3],C0,0,0,0),   P1[10],P1[11],P1[12],P1[13], pw3[0]=PKW(P1,8), pw3[1]=PKW(P1,10), pw3); \
    VRD(7); SBAR(); GAPA(C1=__builtin_amdgcn_mfma_f32_32x32x16_bf16(kf[7],qr[3],C1,0,0,0),   P1[14],P1[15],0.f,0.f,       pw3[2]=PKW(P1,12),pw3[3]=PKW(P1,14), pw3); \
    l_reg+=sacc; \
    if(GK){DMA_K((t)+3,sl_cur);} if(GV){DMA_V((t)+1,sl_next);} \
    CMASK(C0,C1,t); \
    { float a=MX3(C0[0],C0[1],C1[0]),b=MX3(C0[2],C0[3],C1[1]); a=MX3(a,C1[2],C1[3]); \
      _Pragma("unroll") for(int r=4;r<16;r+=4){a=MX3(a,C0[r],C0[r+1]);b=MX3(b,C0[r+2],C0[r+3]);a=MX3(a,C1[r],C1[r+1]);b=MX3(b,C1[r+2],C1[r+3]);} \
      float rm=__builtin_fmaxf(a,b); { auto rr=__builtin_amdgcn_permlane32_swap(__float_as_uint(rm),__float_as_uint(rm),false,false); rm=__builtin_fmaxf(__uint_as_float(rr[0]),__uint_as_float(rr[1])); } \
      resc=false; \
      if(__builtin_expect(__any(rm>(float)THRL),0)){ const float dl=__builtin_fmaxf(rm,0.f); mhat+=dl; \
        _Pragma("unroll") for(int r=0;r<16;++r){C0[r]-=dl;C1[r]-=dl;} \
        _Pragma("unroll") for(int r=0;r<16;++r)negm[r]=-mhat; asm volatile("":"+v"(negm)); \
        const float f=__builtin_amdgcn_exp2f(-dl); l_reg*=f; if(hi==0)wsf[r32]=f; resc=true; } } \
    SBAR(); \
    GAPB(o[0]=__builtin_amdgcn_mfma_f32_32x32x16_bf16(PAF(0),VFR(0),o[0],0,0,0), C0,0); \
    GAPB(o[1]=__builtin_amdgcn_mfma_f32_32x32x16_bf16(PAF(0),VFR(4),o[1],0,0,0), C0,4); \
    KRD(GL,0); GAPB(o[0]=__builtin_amdgcn_mfma_f32_32x32x16_bf16(PAF(1),VFR(1),o[0],0,0,0), C0,8); \
    KRD(GL,1); GAPB(o[1]=__builtin_amdgcn_mfma_f32_32x32x16_bf16(PAF(1),VFR(5),o[1],0,0,0), C0,12); \
    KRD(GL,2); GAPB(o[0]=__builtin_amdgcn_mfma_f32_32x32x16_bf16(PAF(2),VFR(2),o[0],0,0,0), C1,0); \
    KRD(GL,3); GAPB(o[1]=__builtin_amdgcn_mfma_f32_32x32x16_bf16(PAF(2),VFR(6),o[1],0,0,0), C1,4); \
    GAPB(o[0]=__builtin_amdgcn_mfma_f32_32x32x16_bf16(PAF(3),VFR(3),o[0],0,0,0), C1,8); \
    GAPB(o[1]=__builtin_amdgcn_mfma_f32_32x32x16_bf16(PAF(3),VFR(7),o[1],0,0,0), C1,12); \
    }while(0)
  int t=1;
  #undef CMASK
  #define CMASK(P0,P1,t) do{}while(0)
  for(;t+5<NT;t+=2){
    STEP(pB0,pB1,pA0,pA1,t,true,true,true);     WAIT_BAR(2); RESC(); ROT();
    STEP(pA0,pA1,pB0,pB1,t+1,true,true,true);   WAIT_BAR(2); RESC(); ROT();
  }
  #undef CMASK
  #define CMASK(P0,P1,t) do{}while(0)
  #define ENDW(tt) do{ if((tt)+3<NT){WAIT_BAR(2);} else if((tt)+2<NT){WAIT_BAR(1);} else {WAIT_BAR(0);} }while(0)
  for(;t+1<NT;t+=2){
    STEP(pB0,pB1,pA0,pA1,t,(t+3<NT),(t+1<NT),(t+1<NT));       ENDW(t);   RESC(); ROT();
    STEP(pA0,pA1,pB0,pB1,t+1,(t+4<NT),(t+2<NT),(t+2<NT));     ENDW(t+1); RESC(); ROT();
  }
  STEP(pB0,pB1,pA0,pA1,NT-1,false,false,false); RESC();
  { float sacc=pB0[0]+pB0[1]; _Pragma("unroll") for(int r=2;r<16;++r)sacc+=pB0[r]; _Pragma("unroll") for(int r=0;r<16;++r)sacc+=pB1[r]; l_reg+=sacc;
    pw0=(u32x4){PKW(pB0,0),PKW(pB0,2),PKW(pB0,4),PKW(pB0,6)};pw1=(u32x4){PKW(pB0,8),PKW(pB0,10),PKW(pB0,12),PKW(pB0,14)};pw2=(u32x4){PKW(pB1,0),PKW(pB1,2),PKW(pB1,4),PKW(pB1,6)};pw3=(u32x4){PKW(pB1,8),PKW(pB1,10),PKW(pB1,12),PKW(pB1,14)};
    SBAR(); pv(o,vb0+sl_cur,PAF(0),PAF(1),PAF(2),PAF(3)); }
  #undef PKW
  #undef PAF
  #undef VFR
  #undef PIN
  #undef MX3
  #undef GAPA
  #undef GAPB
  #undef EX
  #undef VRD
  #undef KRD
  #undef STEP
  #undef ENDW
  {auto rr=__builtin_amdgcn_permlane32_swap(__float_as_uint(l_reg),__float_as_uint(l_reg),false,false);l_reg=__uint_as_float(rr[0])+__uint_as_float(rr[1]);}
  if(hi==0)wsf[32+r32]=l_reg;asm volatile("s_waitcnt lgkmcnt(0)":::"memory");
  float rli[16];
  #pragma unroll
  for(int r=0;r<16;++r)rli[r]=__builtin_amdgcn_rcpf(wsf[32+crow(r,hi)]);
  bf16*Ow=O+(long)(q0+wid*QBLK)*OP;
  { bf16*stg=(bf16*)(shm+LDS_OST)+wid*2048;
    #pragma unroll
    for(int r=0;r<16;++r){const int orow=crow(r,hi);
      #pragma unroll
      for(int d0=0;d0<2;++d0)stg[orow*64+d0*32+r32]=__float2bfloat16(o[d0][r]*rli[r]);}
    asm volatile("s_waitcnt lgkmcnt(0)":::"memory");
    #pragma unroll
    for(int i=0;i<4;++i){const int row=i*8+(lane>>3),ch=lane&7; const u32x4 v=*(const u32x4*)(stg+row*64+ch*8); ATTN_STORE16(Ow+(long)row*OP+ch*8,v);} }
  asm volatile("s_waitcnt lgkmcnt(0)\n\ts_barrier":::"memory");
  #undef DMA_K
  #undef DMA_V
  #undef CMASK
  #undef START
  #undef RESC
  #undef ROT
}
constexpr int ATTN_LDS_BYTES=LDS_BYTES;
#undef SBAR
#undef WAIT_BAR
}
namespace xb {
#define GAS __attribute__((address_space(1)))
#define LAS __attribute__((address_space(3)))
typedef GAS unsigned gu32;
typedef GAS unsigned long long gu64;
#define RLX_AGENT __ATOMIC_RELAXED, __HIP_MEMORY_SCOPE_AGENT
#define LDS_WAIT() asm volatile("s_waitcnt lgkmcnt(0)" ::: "memory")
#define VM_WAIT() asm volatile("s_waitcnt vmcnt(0)" ::: "memory")
__device__ __forceinline__ unsigned long long rt() { return __builtin_amdgcn_s_memrealtime(); }
__device__ __forceinline__ unsigned f2bf(float f) { unsigned u = __builtin_bit_cast(unsigned, f); return (u + 0x7fffu + ((u >> 16) & 1u)) >> 16; }
__device__ __forceinline__ unsigned pk2(float lo, float hi) { return f2bf(lo) | (f2bf(hi) << 16); }

#define XB_TMO      128
#define XB_XCNT(j)  (256  + 64 * (j))
#define XB_XSUB(j)  (1280 + 64 * (j))
#define XB_XGEN(j)  (2304 + 64 * (j))
#define XB_TOP      3328
#define XB_TOPGEN   3392
#define XCD_BAR_WORDS 3456
#define XB_SPIN_CAP (1u << 18)

__device__ __forceinline__ unsigned xb_ld(unsigned* p)              { return __hip_atomic_load(p, __ATOMIC_RELAXED, __HIP_MEMORY_SCOPE_AGENT); }
__device__ __forceinline__ unsigned xb_add(unsigned* p, unsigned v) { return __hip_atomic_fetch_add(p, v, __ATOMIC_RELAXED, __HIP_MEMORY_SCOPE_AGENT); }
__device__ __forceinline__ unsigned xb_xcc_id() { return (unsigned)__builtin_amdgcn_s_getreg((3 << 11) | 20) & 0xFu; }
#define XB_SPIN(cond, bar) do { unsigned _sp = 0; while (cond) { __builtin_amdgcn_s_sleep(1); \
    if ((++_sp & 255u) == 0u) { if (xb_ld(&(bar)[XB_TMO])) break; if (_sp > XB_SPIN_CAP) { atomicAdd(&(bar)[XB_TMO], 1u); break; } } } } while (0)

struct XcdBarrier {
    unsigned* bar; unsigned x;
    volatile LAS unsigned* st;
};

__device__ __forceinline__ XcdBarrier xcd_barrier_post(unsigned* bar, volatile LAS unsigned* st) {
    XcdBarrier b; b.bar = bar; b.x = xb_xcc_id(); b.st = st;
    if (threadIdx.x == 0) (void)xb_add(&bar[XB_XCNT(b.x)], 1u);
    return b;
}
__device__ __forceinline__ void xcd_barrier_complete(unsigned* bar, unsigned x, unsigned& nloc, unsigned& nx) {
    const unsigned G = gridDim.x * gridDim.y * gridDim.z;
    unsigned sum, cnt, mine, sp = 0u;
    for (;;) {
        sum = 0u; cnt = 0u; mine = 0u;
#pragma unroll
        for (unsigned j = 0; j < 16; ++j) { const unsigned c = xb_ld(&bar[XB_XCNT(j)]); sum += c; cnt += (c > 0u) ? 1u : 0u; mine = (j == x) ? c : mine; }
        if (sum == G) break;
        __builtin_amdgcn_s_sleep(1);
        if ((++sp & 255u) == 0u) { if (xb_ld(&bar[XB_TMO])) break; if (sp > XB_SPIN_CAP) { atomicAdd(&bar[XB_TMO], 1u); break; } }
    }
    nloc = mine > 0u ? mine : 1u; nx = cnt > 0u ? cnt : 1u;
}

__device__ __forceinline__ void xcd_barrier(const XcdBarrier& b) {
    asm volatile("s_waitcnt vmcnt(0)" ::: "memory");
    __syncthreads();
    if (threadIdx.x == 0) {
        unsigned* bar = b.bar;
        __builtin_amdgcn_s_waitcnt(0);
        unsigned nloc = b.st[0], nx = b.st[1];
        if (nloc == 0u) { xcd_barrier_complete(bar, b.x, nloc, nx); b.st[0] = nloc; b.st[1] = nx; }
        const unsigned old = xb_add(&bar[XB_XSUB(b.x)], 1u);
        const unsigned gen = old / nloc;
        if (old + 1u == (gen + 1u) * nloc) {
            __builtin_amdgcn_fence(__ATOMIC_RELEASE, "agent");
            asm volatile("s_waitcnt vmcnt(0)" ::: "memory");
            const unsigned og = xb_add(&bar[XB_TOP], 1u);
            const unsigned tg = og / nx;
            if (og + 1u == (tg + 1u) * nx) xb_add(&bar[XB_TOPGEN], 1u);
            else XB_SPIN(xb_ld(&bar[XB_TOPGEN]) == tg, bar);
            __builtin_amdgcn_fence(__ATOMIC_ACQUIRE, "agent");
            xb_add(&bar[XB_XGEN(b.x)], 1u);
            asm volatile("s_waitcnt vmcnt(0)" ::: "memory");
        } else {
            XB_SPIN(xb_ld(&bar[XB_XGEN(b.x)]) == gen, bar);
            __builtin_amdgcn_fence(__ATOMIC_ACQUIRE, "agent");
            asm volatile("s_waitcnt vmcnt(0)" ::: "memory");
        }
    }
    __syncthreads();
}

}

namespace mk {
typedef unsigned short bf16_t;
typedef short bf16x8 __attribute__((ext_vector_type(8)));
typedef float f32x4 __attribute__((ext_vector_type(4)));
typedef unsigned u32x4 __attribute__((ext_vector_type(4)));
typedef unsigned u32x2 __attribute__((ext_vector_type(2)));
typedef float f32x2 __attribute__((ext_vector_type(2)));

constexpr int DMODEL = 1024, TS = 16384, NSEG = 4, DFF = 4096;
constexpr int EIN = 1792, OIN = 4368, OINP = 4608, OOUT = 768;
constexpr float EPS = 1e-6f;
constexpr size_t MiB = (size_t)1 << 20;
constexpr size_t WS_W1T = 1 * MiB, WS_W2T = 33 * MiB, WS_WINE = 65 * MiB, WS_WOUTE = 72 * MiB, WS_WINO = 76 * MiB, WS_WOUTO = 94 * MiB,
                 WS_GW = 97 * MiB, WS_H = 98 * MiB, WS_PROJ = 130 * MiB, WS_SCR = 274 * MiB, WS_END = 512 * MiB;
constexpr size_t SC_HID = 0;
constexpr size_t SC_LA = 0, SC_UU = 64 * MiB, SC_AGG = 128 * MiB;
constexpr size_t SC_QKVP = 0, SC_DNI = 48 * MiB, SC_OB = 192 * MiB, SC_LSE = 224 * MiB, SC_EGL = 225 * MiB;
constexpr int DNI_BYTES = 73728, DNI_W = 0, DNI_QT = 16384, DNI_KTT = 32768, DNI_A = 49152, DNI_U = 57344;
constexpr int LDS_BYTES = 147456;
constexpr int NT = 512, NW = 8;

struct Params { const float* in[25]; float* out; unsigned char* ws; };

__device__ __forceinline__ float bf2f(bf16_t v) { return __uint_as_float(((unsigned)v) << 16); }
__device__ __forceinline__ unsigned f2bf(float f) { unsigned u = __float_as_uint(f); return (u + 0x7fffu + ((u >> 16) & 1u)) >> 16; }
__device__ __forceinline__ unsigned pk2(float lo, float hi) { return f2bf(lo) | (f2bf(hi) << 16); }
__device__ __forceinline__ float wave_sum(float v) {
#pragma unroll
    for (int o = 1; o < 64; o <<= 1) v += __shfl_xor(v, o);
    return v;
}
__device__ __forceinline__ float sigm(float x) { return 1.f / (1.f + __expf(-x)); }
__device__ __forceinline__ float softplus(float x) { return x > 20.f ? x : log1pf(__expf(x)); }
__device__ __forceinline__ float silu(float x) { return x * sigm(x); }
__device__ __forceinline__ float gelu_tanh(float x) { const float t = 0.7978845608028654f * (x + 0.044715f * x * x * x); return 0.5f * x * (1.f + tanhf(t)); }
__device__ __forceinline__ void unpack8(const u32x4 v, float* f) {
    f[0] = __uint_as_float(v.x << 16); f[1] = __uint_as_float(v.x & 0xffff0000u); f[2] = __uint_as_float(v.y << 16); f[3] = __uint_as_float(v.y & 0xffff0000u);
    f[4] = __uint_as_float(v.z << 16); f[5] = __uint_as_float(v.z & 0xffff0000u); f[6] = __uint_as_float(v.w << 16); f[7] = __uint_as_float(v.w & 0xffff0000u);
}
#define MK_IDS() int tid = threadIdx.x; asm volatile("" : "+v"(tid)); const int lane = tid & 63, wave = __builtin_amdgcn_readfirstlane(tid >> 6); const int gw = blockIdx.x * NW + wave, NGW = gridDim.x * NW; (void)lane; (void)wave; (void)gw; (void)NGW
#define MFMA16(a, b, c) __builtin_amdgcn_mfma_f32_16x16x32_bf16((a), (b), (c), 0, 0, 0)

__device__ __forceinline__ void transpose_item(const float* W, int K, int Nsrc, int Npad, bf16_t* WT, float* scr, int item, int lane, const float* gain = nullptr) {
    const int nblk = Npad / 32, kb = item / nblk, nb = item % nblk, k0 = 64 * kb, n0 = 32 * nb;
    const int n = n0 + (lane & 31);
#pragma unroll 8
    for (int i = 0; i < 32; ++i) { const int kk = 2 * i + (lane >> 5); scr[kk * 33 + (lane & 31)] = (n < Nsrc) ? W[(size_t)(k0 + kk) * Nsrc + n] * (gain ? gain[k0 + kk] : 1.f) : 0.f; }
    asm volatile("s_waitcnt lgkmcnt(0)" ::: "memory");
    const int c = lane & 7;
#pragma unroll
    for (int j = 0; j < 4; ++j) { const int nn = (lane >> 3) + 8 * j; const float* s = scr + (8 * c) * 33 + nn;
        u32x4 o; o.x = pk2(s[0 * 33], s[1 * 33]); o.y = pk2(s[2 * 33], s[3 * 33]); o.z = pk2(s[4 * 33], s[5 * 33]); o.w = pk2(s[6 * 33], s[7 * 33]);
        *(u32x4*)(WT + (size_t)(n0 + nn) * K + k0 + 8 * c) = o; }
    asm volatile("s_waitcnt lgkmcnt(0)" ::: "memory");
}
__device__ __forceinline__ void phase_prologue(const Params& p, char* lds) {
    MK_IDS();
    float* scr = (float*)(lds + wave * 16384);
    unsigned char* ws = p.ws;
    constexpr int I_F1 = 16 * 128, I_F2 = 64 * 32, I_IE = 16 * 56, I_OE = 16 * 32, I_IO = 16 * 144, I_OO = 12 * 32;
    constexpr int T_F1 = 4 * I_F1, T_F2 = T_F1 + 4 * I_F2, T_IE = T_F2 + 2 * I_IE, T_OE = T_IE + 2 * I_OE, T_IO = T_OE + 2 * I_IO, T_OO = T_IO + 2 * I_OO;
    for (int it = gw; it < T_OO; it += NGW) {
        if (it < T_F1) { const int l = it / I_F1, r = it % I_F1; transpose_item(p.in[6] + (size_t)l * 1024 * 4096, 1024, 4096, 4096, (bf16_t*)(ws + WS_W1T) + (size_t)l * 4096 * 1024, scr, r, lane, p.in[4] + l * 1024); }
        else if (it < T_F2) { const int q = it - T_F1, l = q / I_F2, r = q % I_F2; transpose_item(p.in[7] + (size_t)l * 4096 * 1024, 4096, 1024, 1024, (bf16_t*)(ws + WS_W2T) + (size_t)l * 1024 * 4096, scr, r, lane); }
        else if (it < T_IE) { const int q = it - T_F2, l = q / I_IE, r = q % I_IE; transpose_item(p.in[8] + (size_t)l * 1024 * EIN, 1024, EIN, EIN, (bf16_t*)(ws + WS_WINE) + (size_t)l * EIN * 1024, scr, r, lane, p.in[3] + (2 * l) * 1024); }
        else if (it < T_OE) { const int q = it - T_IE, l = q / I_OE, r = q % I_OE; transpose_item(p.in[9] + (size_t)l * 1024 * 1024, 1024, 1024, 1024, (bf16_t*)(ws + WS_WOUTE) + (size_t)l * 1024 * 1024, scr, r, lane); }
        else if (it < T_IO) { const int q = it - T_OE, l = q / I_IO, r = q % I_IO; transpose_item(p.in[19] + (size_t)l * 1024 * OIN, 1024, OIN, OINP, (bf16_t*)(ws + WS_WINO) + (size_t)l * OINP * 1024, scr, r, lane, p.in[3] + (2 * l + 1) * 1024); }
        else { const int q = it - T_IO, l = q / I_OO, r = q % I_OO; transpose_item(p.in[20] + (size_t)l * OOUT * 1024, OOUT, 1024, 1024, (bf16_t*)(ws + WS_WOUTO) + (size_t)l * 1024 * OOUT, scr, r, lane); }
    }
    bf16_t* GW = (bf16_t*)(ws + WS_GW);
    const int gt = gw * 64 + lane, NGT = NGW * 64;
    for (int idx = gt; idx < 2 * 2 * 2 * 8 * 4096; idx += NGT) {
        const int d = idx & 63, e = (idx >> 6) & 63, blk = (idx >> 12) & 7, gate = (idx >> 15) & 1, dir = (idx >> 16) & 1, j = (idx >> 17) & 1;
        const float* src = gate ? p.in[16] : p.in[14];
        GW[idx] = (bf16_t)f2bf(src[((((size_t)j * 2 + dir) * 8 + blk) * 64 + d) * 64 + e]);
    }
}

__device__ __forceinline__ void phase_x0(const float* x, bf16_t* xb, float* ssq) {
    MK_IDS();
    for (int m = gw; m < TS; m += NGW) {
        const f32x4* xr = (const f32x4*)(x + (size_t)m * DMODEL) + lane;
        f32x4 v[4]; float s = 0.f;
#pragma unroll
        for (int j = 0; j < 4; ++j) { v[j] = xr[64 * j]; s += (v[j].x * v[j].x + v[j].y * v[j].y) + (v[j].z * v[j].z + v[j].w * v[j].w); }
        s = wave_sum(s);
        u32x2* o8 = (u32x2*)(xb + (size_t)m * DMODEL) + lane;
#pragma unroll
        for (int j = 0; j < 4; ++j) { u32x2 o; o.x = pk2(v[j].x, v[j].y); o.y = pk2(v[j].z, v[j].w); o8[64 * j] = o; }
        if (lane < 16) ssq[(size_t)m * 16 + lane] = lane == 0 ? s : 0.f;
    }
}
__device__ __forceinline__ void zero_f32(float* ptr, int n) {
    MK_IDS();
    for (int i = gw * 64 + lane; i < n; i += NGW * 64) ptr[i] = 0.f;
}
__device__ __forceinline__ void phase_rmsnorm_final(const bf16_t* xb, float* x, const float* g) {
    MK_IDS();
    for (int m = gw; m < TS; m += NGW) {
        const u32x2* xr = (const u32x2*)(xb + (size_t)m * DMODEL) + lane; f32x4* xw = (f32x4*)(x + (size_t)m * DMODEL) + lane; const f32x4* gr = (const f32x4*)g + lane;
        f32x4 v[4]; float s = 0.f;
#pragma unroll
        for (int j = 0; j < 4; ++j) { const u32x2 w = xr[64 * j]; v[j] = (f32x4){__uint_as_float(w.x << 16), __uint_as_float(w.x & 0xffff0000u), __uint_as_float(w.y << 16), __uint_as_float(w.y & 0xffff0000u)};
            s += (v[j].x * v[j].x + v[j].y * v[j].y) + (v[j].z * v[j].z + v[j].w * v[j].w); }
        const float rstd = 1.f / sqrtf(wave_sum(s) * (1.f / DMODEL) + EPS);
#pragma unroll
        for (int j = 0; j < 4; ++j) { const f32x4 gg = gr[64 * j]; xw[64 * j] = v[j] * rstd * gg; }
    }
}
struct EpiRes {
    static constexpr bool PERM = true, AFTER_DRAIN = false;
    bf16_t* xb; float* ssq; int ldc; const float* sin;
    __device__ __forceinline__ void operator()(const pg8::f32x4 (&acc)[2][2][4][2], const pg8::Unit& u, int wr, int wc, int fr, int fq) const {
        const int col0 = u.pn * pg8::BM + wc * 32 + 8 * fq;
#pragma unroll
        for (int ai = 0; ai < 2; ++ai)
#pragma unroll
            for (int m = 0; m < 4; ++m) { const int row = u.pm * pg8::BM + ai * pg8::HALF + wr * 64 + m * 16 + fr; const size_t off = (size_t)row * ldc + col0; float sq = 0.f;
                float rs2 = 1.f;
                if (sin) { const pg8::f32x4 t_ = *(const pg8::f32x4*)(sin + (size_t)row * 16 + fq * 4); float s_ = (t_[0] + t_[1]) + (t_[2] + t_[3]); s_ += __shfl_xor(s_, 16); s_ += __shfl_xor(s_, 32); rs2 = 1.0f / (s_ * (1.0f / 1024.0f) + 1e-6f); }
                u32x4 bw[2];
#pragma unroll
                for (int bj = 0; bj < 2; ++bj) bw[bj] = *(const u32x4*)(xb + off + bj * pg8::HALF);
#pragma unroll
                for (int bj = 0; bj < 2; ++bj) { float b[8]; unpack8(bw[bj], b); const pg8::f32x4 a0 = acc[ai][bj][m][0] * rs2, a1 = acc[ai][bj][m][1] * rs2;
                    const float o0 = b[0] + a0[0], o1 = b[1] + a0[1], o2 = b[2] + a0[2], o3 = b[3] + a0[3], o4 = b[4] + a1[0], o5 = b[5] + a1[1], o6 = b[6] + a1[2], o7 = b[7] + a1[3];
                    u32x4 w; w.x = pg8::cvt_pk_bf16(o0, o1); w.y = pg8::cvt_pk_bf16(o2, o3); w.z = pg8::cvt_pk_bf16(o4, o5); w.w = pg8::cvt_pk_bf16(o6, o7);
                    *(u32x4*)(xb + off + bj * pg8::HALF) = w;
                    sq += ((o0 * o0 + o1 * o1) + (o2 * o2 + o3 * o3)) + ((o4 * o4 + o5 * o5) + (o6 * o6 + o7 * o7)); }
                sq += __shfl_xor(sq, 16); sq += __shfl_xor(sq, 32);
                if (fq == 0) ssq[(size_t)row * 16 + u.pn * 4 + wc] = sq;
                if (m & 1) asm volatile("" ::: "memory"); }
    }
};

__device__ __forceinline__ void even_qk_post(bf16_t* proj, const float* qg, const float* kg, int S) {
    MK_IDS();
    const int g = lane & 7, axis = g >> 2, half = (g >> 1) & 1;
    float inv[8], gq[8], gk[8];
#pragma unroll
    for (int e = 0; e < 8; ++e) { inv[e] = exp2f(-(float)((g & 1) * 8 + e) * (13.287712379549449f / 16.f)); gq[e] = qg[g * 8 + e] * attn_body::C2; gk[e] = kg[g * 8 + e]; }
    for (int t = gw; t < TS; t += NGW) {
        const int s = t % S; const float pos = (float)(axis ? (s & 63) : (s >> 6));
        bf16_t* row = proj + (size_t)t * EIN;
        const u32x4 qa = *(const u32x4*)(row + lane * 8); u32x4 ka = {0u, 0u, 0u, 0u}; if (lane < 16) ka = *(const u32x4*)(row + 512 + lane * 8);
        float cs[8], sn[8];
#pragma unroll
        for (int e = 0; e < 8; ++e) { const float ang = pos * inv[e]; cs[e] = __cosf(ang); sn[e] = __sinf(ang); }
        float xq[8], xk[8]; unpack8(qa, xq); unpack8(ka, xk);
        float sq = 0.f, sk = 0.f;
#pragma unroll
        for (int e = 0; e < 8; ++e) { sq += xq[e] * xq[e]; sk += xk[e] * xk[e]; }
        sq += __shfl_xor(sq, 1); sq += __shfl_xor(sq, 2); sq += __shfl_xor(sq, 4);
        sk += __shfl_xor(sk, 1); sk += __shfl_xor(sk, 2); sk += __shfl_xor(sk, 4);
        const float rq = 1.f / sqrtf(sq * (1.f / 64.f) + EPS), rk = 1.f / sqrtf(sk * (1.f / 64.f) + EPS);
        float oq[8], ok[8];
#pragma unroll
        for (int e = 0; e < 8; ++e) { const float yq = xq[e] * rq * gq[e], yk = xk[e] * rk * gk[e];
            const float pq = __shfl_xor(yq, 2), pk = __shfl_xor(yk, 2);
            oq[e] = yq * cs[e] + (half ? pq : -pq) * sn[e]; ok[e] = yk * cs[e] + (half ? pk : -pk) * sn[e]; }
        u32x4 o; o.x = pk2(oq[0], oq[1]); o.y = pk2(oq[2], oq[3]); o.z = pk2(oq[4], oq[5]); o.w = pk2(oq[6], oq[7]);
        *(u32x4*)(row + lane * 8) = o;
        if (lane < 16) { u32x4 o2; o2.x = pk2(ok[0], ok[1]); o2.y = pk2(ok[2], ok[3]); o2.z = pk2(ok[4], ok[5]); o2.w = pk2(ok[6], ok[7]); *(u32x4*)(row + 512 + lane * 8) = o2; }
    }
}
__device__ __forceinline__ void even_lru_prep(const bf16_t* proj, const float* cw, const float* cb, const bf16_t* GWj, const float* br, const float* bi, const float* lam,
                                              unsigned* LU, f32x2* AGG, int S, char* lds) {
    MK_IDS();
    constexpr int XST = 1040;
    for (int tile = blockIdx.x; tile < TS / 64; tile += gridDim.x) {
        const int t0 = tile * 64;
        __syncthreads();
#pragma unroll 2
        for (int k = 0; k < 8; ++k) {
            const int idx = tid + k * NT, i = idx >> 6, cgp = idx & 63, t = t0 + i, s = t % S, ch = cgp * 8;
            float acc[8];
#pragma unroll
            for (int e = 0; e < 8; ++e) acc[e] = cb[ch + e];
#pragma unroll
            for (int j = 0; j < 4; ++j) { const int sp = s + j - 2;
                if (sp >= 0 && sp < S) { const u32x4 v = *(const u32x4*)(proj + (size_t)(t + j - 2) * EIN + 768 + ch); float xv[8]; unpack8(v, xv);
#pragma unroll
                    for (int e = 0; e < 8; ++e) acc[e] += cw[j * 512 + ch + e] * xv[e]; } }
            u32x4 o; o.x = pk2(acc[0], acc[1]); o.y = pk2(acc[2], acc[3]); o.z = pk2(acc[4], acc[5]); o.w = pk2(acc[6], acc[7]);
            *(u32x4*)(lds + i * XST + ch * 2) = o;
        }
        __syncthreads();
        const int G = lane >> 4, l16 = lane & 15, ch0 = wave * 64;
        for (int dir = 0; dir < 2; ++dir)
            for (int nt = 0; nt < 4; ++nt) {
                const int e = nt * 16 + l16, ch = ch0 + e;
                bf16x8 Br[2], Bi[2];
#pragma unroll
                for (int kk = 0; kk < 2; ++kk) {
                    Br[kk] = *(const bf16x8*)(GWj + ((((size_t)dir * 2 + 0) * 8 + wave) * 64 + e) * 64 + kk * 32 + G * 8);
                    Bi[kk] = *(const bf16x8*)(GWj + ((((size_t)dir * 2 + 1) * 8 + wave) * 64 + e) * 64 + kk * 32 + G * 8);
                }
                const float brv = br[dir * 512 + ch], biv = bi[dir * 512 + ch], spl = softplus(-lam[dir * 512 + ch]);
#pragma unroll
                for (int mt = 0; mt < 4; ++mt) {
                    f32x4 ar = {0.f, 0.f, 0.f, 0.f}, ai = {0.f, 0.f, 0.f, 0.f};
#pragma unroll
                    for (int kk = 0; kk < 2; ++kk) { const bf16x8 a = *(const bf16x8*)(lds + (mt * 16 + l16) * XST + (ch0 + kk * 32 + G * 8) * 2); ar = MFMA16(a, Br[kk], ar); ai = MFMA16(a, Bi[kk], ai); }
#pragma unroll
                    for (int r = 0; r < 4; ++r) { const int i = mt * 16 + G * 4 + r;
                        const float xc = bf2f(*(const bf16_t*)(lds + i * XST + ch * 2));
                        const float rg = __builtin_amdgcn_rcpf(1.f + __expf(-(ar[r] + brv))), ig = __builtin_amdgcn_rcpf(1.f + __expf(-(ai[r] + biv)));
                        const float la = -8.f * rg * spl; const float uu = __builtin_amdgcn_sqrtf(fmaxf(1.f - __expf(2.f * la), 0.f)) * (ig * xc);
                        LU[((size_t)dir * TS + t0 + i) * 512 + ch] = attn_body::cvtpk_s(la, uu); }
                }
            }
        asm volatile("s_waitcnt vmcnt(0)" ::: "memory");
        __syncthreads();
        {
            const int ch = tid;
#pragma unroll
            for (int dir = 0; dir < 2; ++dir) {
                float h = 0.f, P = 0.f;
                const unsigned* lu = LU + ((size_t)dir * TS + t0) * 512 + ch;
#pragma unroll
                for (int q = 0; q < 64; q += 8) {
                    float lv[8], uv[8];
#pragma unroll
                    for (int e = 0; e < 8; ++e) { const int i = dir ? 63 - (q + e) : q + e; const unsigned w_ = lu[(size_t)i * 512]; lv[e] = __uint_as_float(w_ << 16); uv[e] = __uint_as_float(w_ & 0xffff0000u); }
#pragma unroll
                    for (int e = 0; e < 8; ++e) { h = __expf(lv[e]) * h + uv[e]; P += lv[e]; }
                }
                AGG[((size_t)dir * (TS / 64) + tile) * 512 + ch] = (f32x2){P, h};
            }
        }
    }
}
__device__ __forceinline__ void even_lru_scan(const unsigned* LU, const f32x2* AGG, const bf16_t* proj, bf16_t* Y, int S) {
    MK_IDS();
    const int ch = tid, TPB = S / 64;
    for (int tile = blockIdx.x; tile < TS / 64; tile += gridDim.x) {
        const int t0 = tile * 64, tb0 = (tile / TPB) * TPB;
        float cf = 0.f, cr = 0.f;
        for (int k0 = tb0; k0 < tile; k0 += 8) { f32x2 a[8];
#pragma unroll
            for (int q = 0; q < 8; ++q) { const int k = k0 + q < tile ? k0 + q : tile - 1; a[q] = AGG[(size_t)k * 512 + ch]; }
#pragma unroll
            for (int q = 0; q < 8; ++q) if (k0 + q < tile) cf = cf * __expf(a[q].x) + a[q].y; }
        for (int k0 = tb0 + TPB - 1; k0 > tile; k0 -= 8) { f32x2 a[8];
#pragma unroll
            for (int q = 0; q < 8; ++q) { const int k = k0 - q > tile ? k0 - q : tile + 1; a[q] = AGG[((size_t)(TS / 64) + k) * 512 + ch]; }
#pragma unroll
            for (int q = 0; q < 8; ++q) if (k0 - q > tile) cr = cr * __expf(a[q].x) + a[q].y; }
        float hf[64];
        {
            const unsigned* lu = LU + (size_t)t0 * 512 + ch; float h = cf;
#pragma unroll
            for (int q = 0; q < 64; q += 8) {
                float lv[8], uv[8];
#pragma unroll
                for (int e = 0; e < 8; ++e) { const unsigned w_ = lu[(size_t)(q + e) * 512]; lv[e] = __uint_as_float(w_ << 16); uv[e] = __uint_as_float(w_ & 0xffff0000u); }
#pragma unroll
                for (int e = 0; e < 8; ++e) { h = __expf(lv[e]) * h + uv[e]; hf[q + e] = h; }
            }
        }
        {
            const unsigned* lu = LU + ((size_t)TS + t0) * 512 + ch; float h = cr;
#pragma unroll
            for (int q = 0; q < 64; q += 8) {
                float lv[8], uv[8], gv[8];
#pragma unroll
                for (int e = 0; e < 8; ++e) { const int i = 63 - (q + e); { const unsigned w_ = lu[(size_t)i * 512]; lv[e] = __uint_as_float(w_ << 16); uv[e] = __uint_as_float(w_ & 0xffff0000u); } gv[e] = bf2f(proj[(size_t)(t0 + i) * EIN + 1280 + ch]); }
#pragma unroll
                for (int e = 0; e < 8; ++e) { const int i = 63 - (q + e); h = __expf(lv[e]) * h + uv[e]; Y[(size_t)(t0 + i) * DMODEL + 512 + ch] = (bf16_t)f2bf((hf[i] + h) * gelu_tanh(gv[e])); }
            }
        }
    }
}

__device__ __forceinline__ void odd_conv(const bf16_t* proj, const float* cw, bf16_t* QKVP, int S) {
    MK_IDS();
    for (int cr = 0; cr < (TS / 64 + (int)gridDim.x - 1) / (int)gridDim.x; ++cr) {
        const int c = cr * (int)gridDim.x + (int)blockIdx.x; if (c >= TS / 64) break;
        const int tb = c * 64 + wave * 8, sb = tb % S;
#pragma unroll
        for (int blk = 0; blk < 3; ++blk) {
            const int ch = blk * 512 + lane * 8;
            u32x4 rows[11];
#pragma unroll
            for (int q = 0; q < 11; ++q) { const int sp = sb + q - 2; rows[q] = (u32x4){0u, 0u, 0u, 0u};
                if (sp >= 0 && sp < S) rows[q] = *(const u32x4*)(proj + (size_t)(tb + q - 2) * OINP + ch); }
            f32x4 w0[4], w1[4];
#pragma unroll
            for (int j = 0; j < 4; ++j) { w0[j] = *(const f32x4*)(cw + j * 1536 + ch); w1[j] = *(const f32x4*)(cw + j * 1536 + ch + 4); }
#pragma unroll
            for (int i = 0; i < 8; ++i) {
                float acc[8];
#pragma unroll
                for (int e = 0; e < 8; ++e) acc[e] = 0.f;
#pragma unroll
                for (int j = 0; j < 4; ++j) { float xv[8]; unpack8(rows[i + j], xv);
                    acc[0] += w0[j].x * xv[0]; acc[1] += w0[j].y * xv[1]; acc[2] += w0[j].z * xv[2]; acc[3] += w0[j].w * xv[3];
                    acc[4] += w1[j].x * xv[4]; acc[5] += w1[j].y * xv[5]; acc[6] += w1[j].z * xv[6]; acc[7] += w1[j].w * xv[7]; }
                float ss = 0.f;
#pragma unroll
                for (int e = 0; e < 8; ++e) { acc[e] = silu(acc[e]); ss += acc[e] * acc[e]; }
                if (blk < 2) {
                    ss += __shfl_xor(ss, 1); ss += __shfl_xor(ss, 2); ss += __shfl_xor(ss, 4); ss += __shfl_xor(ss, 8);
                    const float rn = 1.f / sqrtf(ss + EPS);
#pragma unroll
                    for (int e = 0; e < 8; ++e) acc[e] *= rn;
                }
                u32x4 o; o.x = pk2(acc[0], acc[1]); o.y = pk2(acc[2], acc[3]); o.z = pk2(acc[4], acc[5]); o.w = pk2(acc[6], acc[7]);
                *(u32x4*)(QKVP + (size_t)(tb + i) * 1536 + ch) = o;
            }
        }
    }
}

__device__ __forceinline__ int frag128(int r, int k) { return ((((r >> 4) * 4 + (k >> 5)) * 64 + ((k >> 3) & 3) * 16 + (r & 15)) << 3) + (k & 7); }
__device__ __forceinline__ int frag64(int r, int k) { return ((((r >> 4) * 2 + (k >> 5)) * 64 + ((k >> 3) & 3) * 16 + (r & 15)) << 3) + (k & 7); }
__device__ __forceinline__ void odd_prep(const bf16_t* QKVP, const bf16_t* proj, const float* alog, const float* dtb, unsigned char* DNI, float* EGL, char* lds) {
    MK_IDS();
    constexpr int RS = 272;
    constexpr int HOFF = 69632;
    const float scale = 0.08838834764831845f;
    for (int itq = 0; itq < (TS / 64 + (int)gridDim.x - 1) / (int)gridDim.x * 4; ++itq) {
        const int c_ = (itq >> 2) * (int)gridDim.x + (int)blockIdx.x; if (c_ >= TS / 64) break; const int it0 = (c_ * 4 + (itq & 3)) * 2;
        int tq_ = tid; asm volatile("" : "+v"(tq_));
        const int half = tq_ >> 8, ht = tq_ & 255, hwave = __builtin_amdgcn_readfirstlane(ht >> 6), G = (tq_ & 63) >> 4, l16 = tq_ & 15;
        char* L = lds + half * HOFF;
        char* KS = L, *QS = L + 17408, *VS = L + 34816; float* LM = (float*)(L + 52224); float* GC = (float*)(L + 68608); float* BT = GC + 64; float* EG = BT + 64;
        const int it = it0 + half; const int d = it & 1, h = (it >> 1) & 3, c = it >> 3, t0 = c * 64;
        __syncthreads();
#pragma unroll
        for (int k = 0; k < 4; ++k) { const int idx = ht + k * 256, i = idx >> 4, pc = idx & 15; const int tk = d ? t0 + 63 - i : t0 + i;
            const bf16_t* src = QKVP + (size_t)tk * 1536 + h * 128 + pc * 8;
            *(u32x4*)(QS + i * RS + pc * 16) = *(const u32x4*)(src);
            *(u32x4*)(KS + i * RS + pc * 16) = *(const u32x4*)(src + 512);
            *(u32x4*)(VS + i * RS + pc * 16) = *(const u32x4*)(src + 1024); }
        if (hwave == 0) {
            const int i = lane; const int tk = d ? t0 + 63 - i : t0 + i;
            const float bl = bf2f(proj[(size_t)tk * OINP + 2048 + d * 4 + h]), al = bf2f(proj[(size_t)tk * OINP + 2056 + d * 4 + h]);
            const float beta = sigm(bl); float g = -__expf(alog[d * 4 + h]) * softplus(al + dtb[d * 4 + h]);
#pragma unroll
            for (int o = 1; o < 64; o <<= 1) { const float v = __shfl_up(g, o); if (lane >= o) g += v; }
            GC[i] = g; BT[i] = beta; EG[i] = __expf(g);
        }
        __syncthreads();
        {
            const bool isq = hwave >= 2; const char* XS = isq ? QS : KS;
#pragma unroll
            for (int mm = 0; mm < 2; ++mm) { const int mt = (hwave & 1) * 2 + mm;
                bf16x8 a[4];
#pragma unroll
                for (int kk = 0; kk < 4; ++kk) a[kk] = *(const bf16x8*)(XS + (mt * 16 + l16) * RS + (kk * 32 + G * 8) * 2);
#pragma unroll
                for (int nt = 0; nt < 4; ++nt) { f32x4 acc = {0.f, 0.f, 0.f, 0.f};
#pragma unroll
                    for (int kk = 0; kk < 4; ++kk) { const bf16x8 bb = *(const bf16x8*)(KS + (nt * 16 + l16) * RS + (kk * 32 + G * 8) * 2); acc = MFMA16(a[kk], bb, acc); }
                    const int j = nt * 16 + l16; const float gj = GC[j];
#pragma unroll
                    for (int r = 0; r < 4; ++r) { const int i = mt * 16 + G * 4 + r; const float dec = __expf(fminf(GC[i] - gj, 0.f));
                        if (!isq) LM[i * 64 + j] = (j < i) ? BT[i] * acc[r] * dec : 0.f;
                        else ((bf16_t*)(DNI + (size_t)it * DNI_BYTES + DNI_A))[frag64(i, j)] = (bf16_t)f2bf((j <= i) ? acc[r] * scale * dec : 0.f); }
                }
            }
        }
        __syncthreads();
        {
            float sol[64];
            const int cc = ht & 127; const bool isw = ht >= 128; const char* XS = isw ? KS : VS;
#pragma unroll
            for (int i = 0; i < 64; ++i) {
                float v = bf2f(*(const bf16_t*)(XS + i * RS + cc * 2)) * BT[i]; if (isw) v *= EG[i];
                float a0 = 0.f, a1 = 0.f;
#pragma unroll
                for (int j4 = 0; j4 < (i + 3) / 4; ++j4) { const f32x4 l4 = *(const f32x4*)(LM + i * 64 + j4 * 4);
                    if (j4 * 4 + 0 < i) a0 += l4.x * sol[j4 * 4 + 0]; if (j4 * 4 + 1 < i) a1 += l4.y * sol[j4 * 4 + 1];
                    if (j4 * 4 + 2 < i) a0 += l4.z * sol[j4 * 4 + 2]; if (j4 * 4 + 3 < i) a1 += l4.w * sol[j4 * 4 + 3];
                    if ((j4 & 1) == 1) asm volatile("" ::: "memory"); }
                v -= a0 + a1;
                sol[i] = v;
                ((bf16_t*)(DNI + (size_t)it * DNI_BYTES + (isw ? DNI_W : DNI_U)))[isw ? frag128(i, cc) : i * 128 + cc] = (bf16_t)f2bf(v);
                asm volatile("" ::: "memory");
            }
        }
        {
            const float gl = GC[63];
#pragma unroll
            for (int k = 0; k < 4; ++k) { const int idx = ht + k * 256;
                {
                    const int i = idx & 63, kg = idx >> 6; const u32x4 raw = *(const u32x4*)(QS + i * RS + kg * 16); float f[8]; unpack8(raw, f); const float sc = scale * EG[i];
                    u32x4 o; o.x = pk2(f[0] * sc, f[1] * sc); o.y = pk2(f[2] * sc, f[3] * sc); o.z = pk2(f[4] * sc, f[5] * sc); o.w = pk2(f[6] * sc, f[7] * sc);
                    *(u32x4*)((bf16_t*)(DNI + (size_t)it * DNI_BYTES + DNI_QT) + frag128(i, kg * 8)) = o; }
                {
                    const int dm = idx & 127, tg = idx >> 7; float f[8];
#pragma unroll
                    for (int q = 0; q < 8; ++q) { const int i = tg * 8 + q; f[q] = bf2f(*(const bf16_t*)(KS + i * RS + dm * 2)) * __expf(gl - GC[i]); }
                    u32x4 o; o.x = pk2(f[0], f[1]); o.y = pk2(f[2], f[3]); o.z = pk2(f[4], f[5]); o.w = pk2(f[6], f[7]);
                    *(u32x4*)((bf16_t*)(DNI + (size_t)it * DNI_BYTES + DNI_KTT) + frag64(dm, tg * 8)) = o; }
            }
            if (ht == 0) EGL[it] = __expf(gl);
        }
    }
}

template <int NS> __device__ __forceinline__ void odd_scan(const unsigned char* DNI, const float* EGL, bf16_t* OB, int S, int nb, char* lds) {
    MK_IDS();
    constexpr int O_SB = 0, O_VN = NS * 4352, O_OUT = O_VN + NS * 2304, PFD = 7, EB = NS == 1 ? 3 : 2, NCOL = NS * 16;
    const int NC = S / 64, G = lane >> 4, l16 = lane & 15;
    const int nitems = nb * 64 / NS;
    const int mt = wave & 3; const bool lo = wave < 4;
    for (int item = blockIdx.x; item < nitems; item += gridDim.x) {
        const int e = (item >> 3) & ((1 << EB) - 1), sq = (item & 7) | ((item >> (3 + EB)) << 3); const int d = sq & 1, h = (sq >> 1) & 3, b = sq >> 3, cb = e * NCOL;
        __syncthreads();
        for (int i = tid; i < NS * 4352 / 4; i += NT) ((unsigned*)(lds + O_SB))[i] = 0u;
        f32x4 Sreg[NS];
#pragma unroll
        for (int ns = 0; ns < NS; ++ns) Sreg[ns] = (f32x4){0.f, 0.f, 0.f, 0.f};
        const long dstep = (long)(d ? -8 : 8) * DNI_BYTES;
        const unsigned char* base0 = DNI + (size_t)(((b * NC + (d ? NC - 1 : 0)) * 4 + h) * 2 + d) * DNI_BYTES;
        const unsigned char* pX = base0 + (lo ? DNI_W : DNI_QT) + ((mt * 4) * 64 + lane) * 16;
        const unsigned char* pA = base0 + DNI_A + ((mt * 2) * 64 + lane) * 16;
        const unsigned char* pK = base0 + DNI_KTT + ((wave * 2) * 64 + lane) * 16;
        const unsigned char* pU = base0 + DNI_U + ((mt * 16 + G * 4) * 128 + cb + l16) * 2;
        const float* pE = EGL + (((b * NC + (d ? NC - 1 : 0)) * 4 + h) * 2 + d);
        const unsigned char* pP = base0 + (long)PFD * dstep + e * (9216 * NS) + (tid < 144 * NS ? tid : 144 * NS - 1) * 64;
        bf16_t* pO = OB + ((size_t)d * TS + (size_t)(b * NC + (d ? NC - 1 : 0)) * 64 + (d ? 63 - (tid >> 3) : (tid >> 3))) * 512 + h * 128 + cb + (tid & 7) * 2 * NS;
        const long ostep = (long)(d ? -64 : 64) * 512;
        u32x4 aX[4], aA[2], aK[2], bX[4], bA[2], bK[2], cX[4], cA[2], cK[2];
        unsigned aU[NS][4], bU[NS][4], cU[NS][4]; float aE, bE, cE; unsigned pf_dummy = 0u;
#define DN_LOAD(P) do { \
            _Pragma("unroll") for (int kk = 0; kk < 4; ++kk) P##X[kk] = *(const u32x4*)(pX + kk * 1024); \
            _Pragma("unroll") for (int kk = 0; kk < 2; ++kk) { P##A[kk] = *(const u32x4*)(pA + kk * 1024); P##K[kk] = *(const u32x4*)(pK + kk * 1024); } \
            _Pragma("unroll") for (int ns = 0; ns < NS; ++ns) _Pragma("unroll") for (int r = 0; r < 4; ++r) P##U[ns][r] = *(const bf16_t*)(pU + r * 256 + ns * 32); \
            P##E = *pE; pX += dstep; pA += dstep; pK += dstep; pU += dstep; pE += (d ? -8 : 8); } while (0)
#define DN_STEP(P, PL) do { \
            DN_LOAD(PL); \
            if (wave < (NS == 1 ? 3 : 5)) { asm volatile("global_load_dword %0, %1, off" : "+v"(pf_dummy) : "v"(pP) : "memory"); } \
            pP += dstep; \
            f32x4 acc[NS], acc2[NS]; \
            { bf16x8 sb_[NS][4]; \
              _Pragma("unroll") for (int ns = 0; ns < NS; ++ns) { acc[ns] = (f32x4){0.f, 0.f, 0.f, 0.f}; acc2[ns] = (f32x4){0.f, 0.f, 0.f, 0.f}; \
                _Pragma("unroll") for (int kk = 0; kk < 4; ++kk) sb_[ns][kk] = *(const bf16x8*)(lds + O_SB + (ns * 16 + l16) * 272 + (kk * 32 + G * 8) * 2); } \
              if constexpr (NS == 1) asm volatile("s_waitcnt lgkmcnt(0)" : "+v"(sb_[0][0]), "+v"(sb_[0][1]), "+v"(sb_[0][2]), "+v"(sb_[0][3]) :: "memory"); \
              else asm volatile("s_waitcnt lgkmcnt(0)" : "+v"(sb_[0][0]), "+v"(sb_[0][1]), "+v"(sb_[0][2]), "+v"(sb_[0][3]), "+v"(sb_[NS - 1][0]), "+v"(sb_[NS - 1][1]), "+v"(sb_[NS - 1][2]), "+v"(sb_[NS - 1][3]) :: "memory"); \
              _Pragma("unroll") for (int ns = 0; ns < NS; ++ns) { \
                acc[ns] = MFMA16(__builtin_bit_cast(bf16x8, P##X[0]), sb_[ns][0], acc[ns]); acc2[ns] = MFMA16(__builtin_bit_cast(bf16x8, P##X[1]), sb_[ns][1], acc2[ns]); \
                acc[ns] = MFMA16(__builtin_bit_cast(bf16x8, P##X[2]), sb_[ns][2], acc[ns]); acc2[ns] = MFMA16(__builtin_bit_cast(bf16x8, P##X[3]), sb_[ns][3], acc2[ns]); } \
              _Pragma("unroll") for (int ns = 0; ns < NS; ++ns) acc[ns] = acc[ns] + acc2[ns]; } \
            if (lo) { _Pragma("unroll") for (int ns = 0; ns < NS; ++ns) { u32x2 o; float v[4]; \
              _Pragma("unroll") for (int r = 0; r < 4; ++r) v[r] = __uint_as_float(P##U[ns][r] << 16) - acc[ns][r]; \
              o.x = attn_body::cvtpk_s(v[0], v[1]); o.y = attn_body::cvtpk_s(v[2], v[3]); \
              *(u32x2*)(lds + O_VN + (ns * 16 + l16) * 144 + (mt * 16 + G * 4) * 2) = o; } } \
            asm volatile("s_waitcnt lgkmcnt(0)\n\ts_barrier" ::: "memory"); \
            bf16x8 vb[NS][2]; \
            _Pragma("unroll") for (int ns = 0; ns < NS; ++ns) _Pragma("unroll") for (int kk = 0; kk < 2; ++kk) vb[ns][kk] = *(const bf16x8*)(lds + O_VN + (ns * 16 + l16) * 144 + (kk * 32 + G * 8) * 2); \
            if constexpr (NS == 1) asm volatile("s_waitcnt lgkmcnt(0)" : "+v"(vb[0][0]), "+v"(vb[0][1]) :: "memory"); \
            else asm volatile("s_waitcnt lgkmcnt(0)" : "+v"(vb[0][0]), "+v"(vb[0][1]), "+v"(vb[NS - 1][0]), "+v"(vb[NS - 1][1]) :: "memory"); \
            _Pragma("unroll") for (int ns = 0; ns < NS; ++ns) { Sreg[ns] = Sreg[ns] * P##E; \
              _Pragma("unroll") for (int kk = 0; kk < 2; ++kk) Sreg[ns] = MFMA16(__builtin_bit_cast(bf16x8, P##K[kk]), vb[ns][kk], Sreg[ns]); } \
            _Pragma("unroll") for (int ns = 0; ns < NS; ++ns) { u32x2 o; o.x = attn_body::cvtpk_s(Sreg[ns][0], Sreg[ns][1]); o.y = attn_body::cvtpk_s(Sreg[ns][2], Sreg[ns][3]); \
              *(u32x2*)(lds + O_SB + (ns * 16 + l16) * 272 + (wave * 16 + G * 4) * 2) = o; } \
            if (!lo) { _Pragma("unroll") for (int ns = 0; ns < NS; ++ns) { \
              _Pragma("unroll") for (int kk = 0; kk < 2; ++kk) acc[ns] = MFMA16(__builtin_bit_cast(bf16x8, P##A[kk]), vb[ns][kk], acc[ns]); \
              const unsigned w0_ = attn_body::cvtpk_s(acc[ns][0], acc[ns][1]), w1_ = attn_body::cvtpk_s(acc[ns][2], acc[ns][3]); \
              bf16_t* op_ = (bf16_t*)(lds + O_OUT + ((mt * 16 + G * 4) * NCOL + ns * 16 + l16) * 2); \
              op_[0] = (bf16_t)(w0_ & 0xffffu); op_[NCOL] = (bf16_t)(w0_ >> 16); op_[2 * NCOL] = (bf16_t)(w1_ & 0xffffu); op_[3 * NCOL] = (bf16_t)(w1_ >> 16); } } \
            asm volatile("s_waitcnt lgkmcnt(0)\n\ts_barrier" ::: "memory"); \
            if constexpr (NS == 1) *(unsigned*)pO = *(const unsigned*)(lds + O_OUT + tid * 4); else *(u32x2*)pO = *(const u32x2*)(lds + O_OUT + tid * 8); \
            pO += ostep; } while (0)
        DN_LOAD(a); DN_LOAD(b);
        __syncthreads();
        int n = 0;
        for (; n + 3 <= NC; n += 3) {
            DN_STEP(a, c);
            DN_STEP(b, a);
            DN_STEP(c, b);
        }
        if (n < NC) { DN_STEP(a, c); }
        if (n + 1 < NC) { DN_STEP(b, a); }
#undef DN_STEP
#undef DN_LOAD
        asm volatile("s_waitcnt vmcnt(0)" ::: "memory");
        asm volatile("" :: "v"(pf_dummy));
    }
}

__device__ __forceinline__ int t5_bucket(int rel) {
    const int n = rel < 0 ? -rel : rel; int v;
    if (n < 8) v = n; else v = 8 + (n >= 15) + (n >= 27) + (n >= 50) + (n >= 91) + (n >= 166) + (n >= 305) + (n >= 559);
    return (rel > 0 ? 16 : 0) + v;
}
__device__ __forceinline__ void odd_dilated(bf16_t* proj, const float* relb, float* LSE, int S, char* lds, int first_wg, int n_wg) {
    MK_IDS();
    constexpr int KST = 144, VST = 400, HOFF = 27648 + 25600 + 1024;
    const int half = tid >> 8, ht = tid & 255, wv = ht >> 6, G = lane >> 4, l16 = lane & 15;
    char* L = lds + half * HOFF; char* KS = L; char* VT = L + 27648; float* BIAS = (float*)(L + 27648 + 25600);
    const int NBb = S / 64;
    const int wgi = (int)blockIdx.x - first_wg;
    if (wgi < 0) return;
    for (int it0 = wgi * 2; it0 < 3072; it0 += n_wg * 2) {
        const int it = it0 + half; const int zb = it & 255, sl = (it >> 8) & 3, g = it >> 10;
        const int dil = g == 0 ? 1 : (g == 1 ? 4 : 16), lg = g * 2;
        const int M = S >> lg, MB = M / 64;
        const int b = zb / NBb, r0 = zb % NBb, rho = r0 / MB, n = r0 % MB;
        const int hc = (g * 4 + sl) * 64;
        const size_t tb = (size_t)b * S;
        __syncthreads();
#pragma unroll
        for (int k = 0; k < 6; ++k) { const int idx = ht + k * 256, kj = idx >> 3, pc = idx & 7; const int mk = 64 * n - 64 + kj;
            u32x4 kv = {0u, 0u, 0u, 0u}, vv = {0u, 0u, 0u, 0u};
            if (mk >= 0 && mk < M) { const bf16_t* rowp = proj + (tb + (size_t)mk * dil + rho) * OINP; kv = *(const u32x4*)(rowp + 2832 + hc + pc * 8); vv = *(const u32x4*)(rowp + 3600 + hc + pc * 8); }
            *(u32x4*)(KS + kj * KST + pc * 16) = kv;
            const unsigned w[4] = {vv.x, vv.y, vv.z, vv.w};
#pragma unroll
            for (int q = 0; q < 4; ++q) { *(bf16_t*)(VT + (pc * 8 + 2 * q) * VST + kj * 2) = (bf16_t)(w[q] & 0xffffu); *(bf16_t*)(VT + (pc * 8 + 2 * q + 1) * VST + kj * 2) = (bf16_t)(w[q] >> 16); } }
        if (ht < 129) BIAS[ht] = relb[t5_bucket((ht - 64) * dil) * 12 + g * 4 + sl];
        const int mq = 64 * n + 16 * wv + l16; const size_t tq = tb + (size_t)mq * dil + rho;
        bf16x8 qf[2];
#pragma unroll
        for (int kk = 0; kk < 2; ++kk) qf[kk] = *(const bf16x8*)(proj + tq * OINP + 2064 + hc + kk * 32 + G * 8);
        __syncthreads();
        f32x4 sc[9]; float mx = -1e30f;
#pragma unroll
        for (int kt = 0; kt < 9; ++kt) { f32x4 acc = {0.f, 0.f, 0.f, 0.f};
#pragma unroll
            for (int kk = 0; kk < 2; ++kk) { const bf16x8 a = *(const bf16x8*)(KS + ((wv + kt) * 16 + l16) * KST + (kk * 32 + G * 8) * 2); acc = MFMA16(a, qf[kk], acc); }
#pragma unroll
            for (int r = 0; r < 4; ++r) { const int kj = (wv + kt) * 16 + G * 4 + r; const int delta = kj - 64 - 16 * wv - l16; const int mk = 64 * n - 64 + kj;
                const bool ok = (delta >= -64) && (delta <= 64) && (mk >= 0) && (mk < M);
                const float s = ok ? acc[r] * 0.125f + BIAS[(delta < -64 ? -64 : (delta > 64 ? 64 : delta)) + 64] : -1e30f;
                acc[r] = s; mx = fmaxf(mx, s); }
            sc[kt] = acc; }
        mx = fmaxf(mx, __shfl_xor(mx, 16)); mx = fmaxf(mx, __shfl_xor(mx, 32));
        float sum = 0.f;
#pragma unroll
        for (int kt = 0; kt < 9; ++kt)
#pragma unroll
            for (int r = 0; r < 4; ++r) { const float pv_ = (sc[kt][r] > -1e29f) ? __expf(sc[kt][r] - mx) : 0.f; sc[kt][r] = pv_; sum += pv_; }
        sum += __shfl_xor(sum, 16); sum += __shfl_xor(sum, 32);
        f32x4 ot[4];
#pragma unroll
        for (int dt = 0; dt < 4; ++dt) ot[dt] = (f32x4){0.f, 0.f, 0.f, 0.f};
#pragma unroll
        for (int pp = 0; pp < 5; ++pp) {
            u32x4 pb; pb.x = pk2(sc[2 * pp][0], sc[2 * pp][1]); pb.y = pk2(sc[2 * pp][2], sc[2 * pp][3]);
            if (pp < 4) { pb.z = pk2(sc[2 * pp + 1][0], sc[2 * pp + 1][1]); pb.w = pk2(sc[2 * pp + 1][2], sc[2 * pp + 1][3]); } else { pb.z = 0u; pb.w = 0u; }
            const bf16x8 pbf = __builtin_bit_cast(bf16x8, pb);
#pragma unroll
            for (int dt = 0; dt < 4; ++dt) {
                u32x4 av; const u32x2 lo = *(const u32x2*)(VT + (dt * 16 + l16) * VST + ((wv + 2 * pp) * 16 + G * 4) * 2); av.x = lo.x; av.y = lo.y;
                if (pp < 4) { const u32x2 hi = *(const u32x2*)(VT + (dt * 16 + l16) * VST + ((wv + 2 * pp + 1) * 16 + G * 4) * 2); av.z = hi.x; av.w = hi.y; } else { av.z = 0u; av.w = 0u; }
                ot[dt] = MFMA16(__builtin_bit_cast(bf16x8, av), pbf, ot[dt]);
            }
        }
        const float rs = 1.f / sum;
        bf16_t* od = proj + tq * OINP + (g * 4 + sl) * 64;
#pragma unroll
        for (int dt = 0; dt < 4; ++dt) { const f32x4 v_ = ot[dt] * rs; u32x2 w_; w_.x = pk2(v_[0], v_[1]); w_.y = pk2(v_[2], v_[3]); *(u32x2*)(od + dt * 16 + G * 4) = w_; }
        if (G == 0) LSE[tq * 12 + g * 4 + sl] = mx + __logf(sum);
    }
}

__device__ __forceinline__ void odd_combine(const bf16_t* OB, const bf16_t* proj, const float* LSE, const float* og, bf16_t* Y) {
    MK_IDS();
    float gn[8];
#pragma unroll
    for (int e = 0; e < 8; ++e) gn[e] = og[(lane & 15) * 8 + e];
    const int sl = lane >> 4;
    for (int t = gw; t < TS; t += NGW) {
        const bf16_t* prow = proj + (size_t)t * OINP;
        const u32x4 fa = *(const u32x4*)(OB + (size_t)t * 512 + lane * 8), ra = *(const u32x4*)(OB + ((size_t)TS + t) * 512 + lane * 8), za = *(const u32x4*)(prow + 1536 + lane * 8);
        const u32x2 d0 = *(const u32x2*)(prow + lane * 4), d1 = *(const u32x2*)(prow + 256 + lane * 4), d2 = *(const u32x2*)(prow + 512 + lane * 4);
        const float l0 = LSE[(size_t)t * 12 + sl], l1 = LSE[(size_t)t * 12 + 4 + sl], l2 = LSE[(size_t)t * 12 + 8 + sl];
        float f[8], r[8], z[8]; unpack8(fa, f); unpack8(ra, r); unpack8(za, z);
        float ss = 0.f;
#pragma unroll
        for (int e = 0; e < 8; ++e) { f[e] += r[e]; ss += f[e] * f[e]; }
        ss += __shfl_xor(ss, 1); ss += __shfl_xor(ss, 2); ss += __shfl_xor(ss, 4); ss += __shfl_xor(ss, 8);
        const float rn = 1.f / sqrtf(ss * (1.f / 128.f) + EPS);
#pragma unroll
        for (int e = 0; e < 8; ++e) f[e] = f[e] * rn * gn[e] * silu(z[e]);
        u32x4 o; o.x = pk2(f[0], f[1]); o.y = pk2(f[2], f[3]); o.z = pk2(f[4], f[5]); o.w = pk2(f[6], f[7]);
        *(u32x4*)(Y + (size_t)t * OOUT + lane * 8) = o;
        const float m = fmaxf(l0, fmaxf(l1, l2)); const float w0 = __expf(l0 - m), w1 = __expf(l1 - m), w2 = __expf(l2 - m); const float rs = 1.f / (w0 + w1 + w2);
        const float a0 = w0 * rs, a1 = w1 * rs, a2 = w2 * rs;
        const float v0 = a0 * __uint_as_float(d0.x << 16) + a1 * __uint_as_float(d1.x << 16) + a2 * __uint_as_float(d2.x << 16);
        const float v1 = a0 * __uint_as_float(d0.x & 0xffff0000u) + a1 * __uint_as_float(d1.x & 0xffff0000u) + a2 * __uint_as_float(d2.x & 0xffff0000u);
        const float v2 = a0 * __uint_as_float(d0.y << 16) + a1 * __uint_as_float(d1.y << 16) + a2 * __uint_as_float(d2.y << 16);
        const float v3 = a0 * __uint_as_float(d0.y & 0xffff0000u) + a1 * __uint_as_float(d1.y & 0xffff0000u) + a2 * __uint_as_float(d2.y & 0xffff0000u);
        u32x2 od; od.x = pk2(v0, v1); od.y = pk2(v2, v3);
        *(u32x2*)(Y + (size_t)t * OOUT + 512 + lane * 4) = od;
    }
}

__global__ void __launch_bounds__(NT, 2) fwd_megakernel(Params p) {
    extern __shared__ __attribute__((aligned(16))) unsigned char lds_raw[];
    cg::grid_group grid = cg::this_grid();
    char* lds = (char*)lds_raw;
    PG8_LAS unsigned char* ldsl = (PG8_LAS unsigned char*)lds_raw;
    const int Gr = gridDim.x;
    volatile LAS unsigned* MISC = (volatile LAS unsigned*)((PG8_LAS unsigned char*)lds_raw + (LDS_BYTES - 128));
    if (threadIdx.x < 32) MISC[threadIdx.x] = 0u;
    __syncthreads();
    xb::XcdBarrier bar = xb::xcd_barrier_post((unsigned*)p.ws, MISC + 8);
#define GSYNC() xb::xcd_barrier(bar)
    unsigned char* ws = p.ws;
    bf16_t* H = (bf16_t*)(ws + WS_H); bf16_t* PROJ = (bf16_t*)(ws + WS_PROJ); unsigned char* SCR = ws + WS_SCR;

    phase_prologue(p, lds);
    grid.sync();

    float* SSQA = (float*)(SCR + 232 * MiB); float* SSQB = (float*)(SCR + 234 * MiB);
    bf16_t* YE = (bf16_t*)(SCR + 192 * MiB); bf16_t* YO = (bf16_t*)(SCR + SC_QKVP);
    for (int seg = 0; seg < NSEG; ++seg) {
        const int S = seg < 2 ? 16384 : 2048, nb = seg < 2 ? 1 : 8;
        const float* xin = (seg < 2 ? p.in[0] : p.in[1]) + (size_t)(seg & 1) * TS * DMODEL;
        float* xo = p.out + (size_t)seg * TS * DMODEL;
        phase_x0(xin, H, SSQB);
        GSYNC();
        for (int layer = 0; layer < 4; ++layer) {
            const int j = layer >> 1; const bool odd = layer & 1;
            {
                const int N = odd ? OINP : EIN;
                const bf16_t* Bt = odd ? (const bf16_t*)(ws + WS_WINO) + (size_t)j * OINP * 1024 : (const bf16_t*)(ws + WS_WINE) + (size_t)j * EIN * 1024;
                pg8::Gemm g{H, Bt, TS, N, 1024}; pg8::StaticOrder So; So.init(TS, N, Gr, (int)blockIdx.x);
                pg8::EpiBf16<0> E{PROJ, N, nullptr, 0, 0, 1.f, SSQB};
                pg8::gemm_phase<pg8::EpiBf16<0>, pg8::StaticOrder, true, true>(ldsl, g, So, E);
            }
            GSYNC();
            if (!odd) {
                even_qk_post(PROJ, p.in[10] + j * 64, p.in[11] + j * 64, S);
                even_lru_prep(PROJ, p.in[12] + j * 2048, p.in[13] + j * 512, (const bf16_t*)(ws + WS_GW) + (size_t)j * 2 * 2 * 8 * 4096, p.in[15] + j * 1024, p.in[17] + j * 1024, p.in[18] + j * 1024,
                              (unsigned*)(SCR + SC_LA), (f32x2*)(SCR + SC_AGG), S, lds);
                GSYNC();
                {
                    const int nqb = S / 256, nunits = nb * 8 * nqb;
                    for (int u = blockIdx.x; u < nunits; u += Gr) {
                        const int qb = u % nqb, h = (u / nqb) % 8, b = u / (nqb * 8), kvh = h >> 2;
                        const attn_body::bf16* base = (const attn_body::bf16*)PROJ + (size_t)b * S * EIN;
                        attn_body::attn_unit<8>(qb, S, base + h * 64, EIN, base + 512 + kvh * 64, base + 640 + kvh * 64, EIN, (attn_body::bf16*)YE + (size_t)b * S * DMODEL + h * 64, DMODEL, lds);
                    }
                }
                __syncthreads();
                even_lru_scan((const unsigned*)(SCR + SC_LA), (const f32x2*)(SCR + SC_AGG), PROJ, YE, S);
                GSYNC();
                {
                    pg8::Gemm g{YE, (const bf16_t*)(ws + WS_WOUTE) + (size_t)j * 1024 * 1024, TS, 1024, 1024}; pg8::StaticOrder So; So.init(TS, 1024, Gr, (int)blockIdx.x);
                    EpiRes E{H, SSQA, DMODEL, nullptr};
                    pg8::gemm_phase<EpiRes, pg8::StaticOrder, true, true>(ldsl, g, So, E);
                }
            } else {
                odd_conv(PROJ, p.in[21] + j * 4 * 1536, (bf16_t*)(SCR + SC_QKVP), S);
                asm volatile("s_waitcnt vmcnt(0)" ::: "memory"); __syncthreads();
                odd_prep((const bf16_t*)(SCR + SC_QKVP), PROJ, p.in[22] + j * 8, p.in[23] + j * 8, SCR + SC_DNI, (float*)(SCR + SC_EGL), lds);
                GSYNC();
                {
                    const int nscan = nb * 64;
                    if (nscan <= Gr) odd_scan<1>(SCR + SC_DNI, (const float*)(SCR + SC_EGL), (bf16_t*)(SCR + SC_OB), S, nb, lds);
                    else odd_scan<2>(SCR + SC_DNI, (const float*)(SCR + SC_EGL), (bf16_t*)(SCR + SC_OB), S, nb, lds);
                    const int first = nscan < Gr ? nscan : 0;
                    odd_dilated(PROJ, p.in[2], (float*)(SCR + SC_LSE), S, lds, first, Gr - first);
                }
                GSYNC();
                odd_combine((const bf16_t*)(SCR + SC_OB), PROJ, (const float*)(SCR + SC_LSE), p.in[24] + j * 128, YO);
                GSYNC();
                {
                    pg8::Gemm g{YO, (const bf16_t*)(ws + WS_WOUTO) + (size_t)j * 1024 * OOUT, TS, 1024, OOUT}; pg8::StaticOrder So; So.init(TS, 1024, Gr, (int)blockIdx.x);
                    EpiRes E{H, SSQA, DMODEL, nullptr};
                    pg8::gemm_phase<EpiRes, pg8::StaticOrder, true, true>(ldsl, g, So, E);
                }
            }
            GSYNC();
            {
                pg8::Gemm g{H, (const bf16_t*)(ws + WS_W1T) + (size_t)layer * 4096 * 1024, TS, DFF, 1024}; pg8::StaticOrder So; So.init(TS, DFF, Gr, (int)blockIdx.x);
                pg8::EpiBf16<2> E{(bf16_t*)(SCR + SC_HID), DFF, nullptr, 0, 0, 1.f, nullptr};
                pg8::gemm_phase<pg8::EpiBf16<2>, pg8::StaticOrder, true, true>(ldsl, g, So, E);
            }
            GSYNC();
            {
                pg8::Gemm g{(const bf16_t*)(SCR + SC_HID), (const bf16_t*)(ws + WS_W2T) + (size_t)layer * 1024 * 4096, TS, 1024, DFF}; pg8::StaticOrder So; So.init(TS, 1024, Gr, (int)blockIdx.x);
                EpiRes E{H, SSQB, DMODEL, SSQA};
                pg8::gemm_phase<EpiRes, pg8::StaticOrder, true, true>(ldsl, g, So, E);
            }
            GSYNC();
        }
        phase_rmsnorm_final(H, xo, p.in[5]);
        GSYNC();
    }
}
}

extern "C" void kernel_launch(void* const* d_in, const int* in_sizes, int n_in, void* d_out, int out_size, void* d_ws, size_t ws_size, hipStream_t stream) {
    static int grid = 0;
    if (grid == 0) {
        if (n_in != 25 || ws_size < mk::WS_END) { fprintf(stderr, "kernel_launch: unexpected n_in %d / ws_size %zu\n", n_in, ws_size); grid = -1; return; }
        int dev = 0, cus = 0, per_cu = 0;
        hipGetDevice(&dev); hipDeviceGetAttribute(&cus, hipDeviceAttributeMultiprocessorCount, dev);
        if (hipFuncSetAttribute((const void*)mk::fwd_megakernel, hipFuncAttributeMaxDynamicSharedMemorySize, mk::LDS_BYTES) != hipSuccess) { fprintf(stderr, "hipFuncSetAttribute failed\n"); }
        hipOccupancyMaxActiveBlocksPerMultiprocessor(&per_cu, (const void*)mk::fwd_megakernel, mk::NT, mk::LDS_BYTES);
        (void)hipGetLastError();
        if (per_cu < 1) per_cu = 1;
        grid = cus * 1;
        fprintf(stderr, "kernel_launch: cus %d per_cu %d grid %d\n", cus, per_cu, grid);
    }
    if (grid < 0) return;
    if (hipMemsetAsync(d_ws, 0, 65536, stream) != hipSuccess) { fprintf(stderr, "memset failed\n"); return; }
    mk::Params p{};
    for (int i = 0; i < 25; ++i) p.in[i] = (const float*)d_in[i];
    p.out = (float*)d_out; p.ws = (unsigned char*)d_ws;
    void* args[] = {&p};
    hipError_t e = hipLaunchCooperativeKernel((const void*)mk::fwd_megakernel, dim3(grid), dim3(mk::NT), args, mk::LDS_BYTES, stream);
    if (e != hipSuccess) fprintf(stderr, "cooperative launch failed: %s (grid %d)\n", hipGetErrorString(e), grid);
}
```

```cpp
#include <hip/hip_runtime.h>
#include <hip/hip_cooperative_groups.h>
#include <hip/hip_bf16.h>
#include <cstdio>
#include <cstdint>
#include <cmath>
namespace cg = cooperative_groups;
namespace pg8 {
#define PG8_LAS __attribute__((address_space(3)))
typedef unsigned short bf16_t;
typedef short bf16x8 __attribute__((ext_vector_type(8)));
typedef float f32x4 __attribute__((ext_vector_type(4)));
typedef unsigned u32x4 __attribute__((ext_vector_type(4)));
constexpr int BM = 256, BK = 64, HALF = 128, HTB = HALF * BK * 2  , STAGE_BYTES = 8 * HTB, NXCD = 8, WGM = 8;

__host__ __device__ __forceinline__ int lds_byte(int r, int c) { const int st = (r >> 4) * 2 + (c >> 5), rr = r & 15, cc = c & 31, ob = rr * 64 + cc * 2; return st * 1024 + (ob ^ (((ob >> 9) & 1) << 5)); }
__host__ __device__ __forceinline__ void stage_rc(int b, int& R, int& C) { const int st = b / 1024, sb = b % 1024, swz = sb ^ (((sb >> 9) & 1) << 5); R = (st >> 1) * 16 + swz / 64; C = (st & 1) * 32 + (swz % 64) / 2; }
__host__ __device__ __forceinline__ int perm32(int rho) { const int n = rho >> 4, i = rho & 15; return 8 * (i >> 2) + 4 * n + (i & 3); }

struct Unit { int pm, pn; };
struct Gemm { const bf16_t* A; const bf16_t* Bt; int M, N, K; };

struct StaticOrder {
    int nM, nN, nwg, G, c;
    __host__ __device__ void init(int M, int N, int G_, int c_) { nM = M / BM; nN = N / BM; nwg = nM * nN; G = G_; c = c_; }
    __host__ __device__ bool next(int i, Unit& u) const {
        const long L = (long)i * G + c; if (L >= nwg) return false;
        int wgid = (int)L; { const int q = nwg / NXCD, r = nwg % NXCD, xcd = wgid % NXCD, off = wgid / NXCD; wgid = (xcd < r ? xcd * (q + 1) : r * (q + 1) + (xcd - r) * q) + off; }
        const int nig = WGM * nN, gid = wgid / nig, fm = gid * WGM, gsz = (nM - fm) < WGM ? (nM - fm) : WGM;
        u.pm = fm + ((wgid % nig) % gsz); u.pn = (wgid % nig) / gsz; return true;
    }
    __device__ __forceinline__ void a_ready(const Unit&) const {}
    __device__ __forceinline__ void done(const Unit&) const {}
};

__device__ __forceinline__ unsigned cvt_pk_bf16(float lo, float hi) { unsigned r; asm volatile("v_cvt_pk_bf16_f32 %0, %1, %2" : "=v"(r) : "v"(lo), "v"(hi)); return r; }
typedef float f32x2 __attribute__((ext_vector_type(2)));
__device__ __forceinline__ f32x2 gelu_pk(f32x2 v) {
    const f32x2 av = __builtin_elementwise_abs(v), d = av * 0.2316418882f + 1.0f;
    f32x2 t; t.x = __builtin_amdgcn_rcpf(d.x); t.y = __builtin_amdgcn_rcpf(d.y);
    f32x2 q = t * 0.5307027145f + (-0.7265760135f); q = q * t + 0.7107068705f; q = q * t + (-0.142248368f); q = q * t + 0.127414796f; q = q * t;
    const f32x2 s = (v * v) * (-0.72134752044f);
    f32x2 e; e.x = __builtin_amdgcn_exp2f(s.x); e.y = __builtin_amdgcn_exp2f(s.y);
    const f32x2 m = v * (q * e), r = v - m;
    f32x2 o; o.x = v.x < 0.f ? m.x : r.x; o.y = v.y < 0.f ? m.y : r.y; return o;
}

template <int ACT  > struct EpiBf16 {
    static constexpr bool PERM = true, AFTER_DRAIN = false; static_assert(ACT == 0 || ACT == 1 || ACT == 2, "EpiBf16: ACT 0 none, 1 gelu, 2 relu^2");
    bf16_t* O; int ldc; const float* bias; int split_cols; size_t split_stride; float scale0; const float* ssq;
    __device__ __forceinline__ void operator()(const f32x4 (&acc)[2][2][4][2], const Unit& u, int wr, int wc, int fr, int fq) const {
        const int row0 = u.pm * BM + wr * 64 + fr; int colt = u.pn * BM; bf16_t* base = O;
        float sc = 1.f; if (split_cols) { const int t = colt / split_cols; base += (size_t)t * split_stride; colt -= t * split_cols; if (t == 0) sc = scale0; }
        const int col0 = colt + wc * 32 + 8 * fq, bcol0 = u.pn * BM + wc * 32 + 8 * fq;
        float rsc[2][4];
        if (ssq) { f32x4 t_[2][4];
#pragma unroll
            for (int ai = 0; ai < 2; ++ai)
#pragma unroll
                for (int m = 0; m < 4; ++m) t_[ai][m] = *(const f32x4*)(ssq + (size_t)(row0 + ai * HALF + m * 16) * 16 + fq * 4);
#pragma unroll
            for (int ai = 0; ai < 2; ++ai)
#pragma unroll
                for (int m = 0; m < 4; ++m) { float s_ = (t_[ai][m][0] + t_[ai][m][1]) + (t_[ai][m][2] + t_[ai][m][3]); s_ += __shfl_xor(s_, 16); s_ += __shfl_xor(s_, 32); rsc[ai][m] = 1.0f / sqrtf(s_ * (1.0f / 1024.0f) + 1e-6f); }
        } else {
#pragma unroll
            for (int ai = 0; ai < 2; ++ai)
#pragma unroll
                for (int m = 0; m < 4; ++m) rsc[ai][m] = 1.0f; }
        f32x4 bv[2][2];
#pragma unroll
        for (int bj = 0; bj < 2; ++bj)
#pragma unroll
            for (int n = 0; n < 2; ++n) bv[bj][n] = bias ? *(const f32x4*)(bias + bcol0 + bj * HALF + 4 * n) : (f32x4){0.f, 0.f, 0.f, 0.f};
#pragma unroll
        for (int ai = 0; ai < 2; ++ai)
#pragma unroll
            for (int m = 0; m < 4; ++m) { bf16_t* rowp = base + (size_t)(row0 + ai * HALF + m * 16) * ldc + col0; const float rsc_ = rsc[ai][m];
#pragma unroll
                for (int bj = 0; bj < 2; ++bj) { f32x4 v0 = (acc[ai][bj][m][0] + bv[bj][0]) * rsc_, v1 = (acc[ai][bj][m][1] + bv[bj][1]) * rsc_;
                    if (ACT == 1) { f32x2 a = gelu_pk((f32x2){v0[0], v0[1]}), b = gelu_pk((f32x2){v0[2], v0[3]}), c = gelu_pk((f32x2){v1[0], v1[1]}), d = gelu_pk((f32x2){v1[2], v1[3]});
                        v0 = (f32x4){a.x, a.y, b.x, b.y}; v1 = (f32x4){c.x, c.y, d.x, d.y}; }
                    if (ACT == 2) { _Pragma("unroll") for (int q_ = 0; q_ < 4; ++q_) { const float a0_ = v0[q_] > 0.f ? v0[q_] : 0.f, a1_ = v1[q_] > 0.f ? v1[q_] : 0.f; v0[q_] = a0_ * a0_; v1[q_] = a1_ * a1_; } }
                    v0 = v0 * sc; v1 = v1 * sc; u32x4 w; w.x = cvt_pk_bf16(v0[0], v0[1]); w.y = cvt_pk_bf16(v0[2], v0[3]); w.z = cvt_pk_bf16(v1[0], v1[1]); w.w = cvt_pk_bf16(v1[2], v1[3]);
                    *(u32x4*)(rowp + bj * HALF) = w; } }
    }
};

template <class Epi, class Sched, bool ALIGN_EPI = false, bool SP2 = false>
__device__ __forceinline__ void gemm_phase(PG8_LAS unsigned char* lds, const Gemm g, const Sched& S, const Epi& E) {
    int tid_ = threadIdx.x; asm volatile("" : "+v"(tid_)); const int tid = tid_, wid = __builtin_amdgcn_readfirstlane(tid >> 6), lane = tid & 63, wr = wid >> 2, wc = wid & 3, fr = lane & 15, fq = lane >> 4;
    const int K = g.K, nt = K / BK;
    unsigned voffA[2], voffB[2];
#pragma unroll
    for (int i = 0; i < 2; ++i) { int R, C; stage_rc(tid * 16 + i * 8192, R, C); const int Rb = Epi::PERM ? ((R & ~31) + perm32(R & 31)) : R;
        voffA[i] = (unsigned)(R * K + C) * 2u; voffB[i] = (unsigned)(Rb * K + C) * 2u; }
    const size_t kstep = (size_t)(BK * 2);
    const size_t hstep = (size_t)HALF * K * 2;
    const size_t tstep = 2 * hstep;
    const unsigned ldsw = (unsigned)wid * 1024u;
    const int aoff = lds_byte(wr * 64 + fr, fq * 8), boff = lds_byte(wc * 32 + fr, fq * 8);
#define PG8_SA(b, h) (((b) * 2 + (h)) * HTB)
#define PG8_SB(b, h) ((4 + (b) * 2 + (h)) * HTB)
#define PG8_STAGE(bufoff, gbase, voff) do { _Pragma("unroll") for (int _i = 0; _i < 2; ++_i) \
        __builtin_amdgcn_global_load_lds((const unsigned*)((const char*)(gbase) + (voff)[_i]), (PG8_LAS unsigned*)(lds + (bufoff) + ldsw + _i * 8192), 16, 0, 0); } while (0)
#define PG8_LDA(dst, b, h) do { _Pragma("unroll") for (int m = 0; m < 4; ++m) _Pragma("unroll") for (int k = 0; k < 2; ++k) dst[m][k] = *(const PG8_LAS bf16x8*)(lds + PG8_SA(b, h) + aoff + m * 2048 + k * 1024); } while (0)
#define PG8_LDB(dst, b, h) do { _Pragma("unroll") for (int n = 0; n < 2; ++n) _Pragma("unroll") for (int k = 0; k < 2; ++k) dst[n][k] = *(const PG8_LAS bf16x8*)(lds + PG8_SB(b, h) + boff + n * 2048 + k * 1024); } while (0)
#define PG8_MMA(ai, bj, At, Bt) do { __builtin_amdgcn_s_setprio(1); _Pragma("unroll") for (int m = 0; m < 4; ++m) _Pragma("unroll") for (int n = 0; n < 2; ++n) _Pragma("unroll") for (int k = 0; k < 2; ++k) \
        acc[ai][bj][m][n] = __builtin_amdgcn_mfma_f32_16x16x32_bf16(Bt[n][k], At[m][k], acc[ai][bj][m][n], 0, 0, 0); __builtin_amdgcn_s_setprio(0); } while (0)
#define PG8_WAIT_V(n) asm volatile("s_waitcnt vmcnt(" #n ")" ::: "memory")
#define PG8_WAIT_L(n) asm volatile("s_waitcnt lgkmcnt(" #n ")" ::: "memory")
#define PG8_BAR __builtin_amdgcn_s_barrier()
#define PG8_SCHED __builtin_amdgcn_sched_barrier(0)
    Unit cur, nxt; int ui = 0;
    if (!S.next(0, cur)) return;
    f32x4 acc[2][2][4][2];
#pragma unroll
    for (int a = 0; a < 2; ++a)
#pragma unroll
        for (int b = 0; b < 2; ++b)
#pragma unroll
            for (int m = 0; m < 4; ++m)
#pragma unroll
                for (int n = 0; n < 2; ++n) acc[a][b][m][n] = (f32x4){0.f, 0.f, 0.f, 0.f};
    bf16x8 At[4][2], B0[2][2], B1[2][2];
    const char* cA = (const char*)g.A + (size_t)cur.pm * tstep; const char* cB = (const char*)g.Bt + (size_t)cur.pn * tstep;
    S.a_ready(cur);
    if constexpr (SP2) {
        PG8_STAGE(PG8_SB(0, 0), cB, voffB); PG8_STAGE(PG8_SB(0, 1), cB + hstep, voffB); PG8_STAGE(PG8_SA(0, 0), cA, voffA); PG8_STAGE(PG8_SA(0, 1), cA + hstep, voffA);
        if (wr == 1) PG8_BAR;
        PG8_WAIT_V(2); PG8_BAR;
        PG8_STAGE(PG8_SB(1, 0), cB + kstep, voffB); PG8_STAGE(PG8_SA(1, 0), cA + kstep, voffA); PG8_STAGE(PG8_SB(1, 1), cB + hstep + kstep, voffB);
        PG8_WAIT_V(6); PG8_BAR;
    } else {
        PG8_STAGE(PG8_SB(0, 0), cB, voffB); PG8_STAGE(PG8_SA(0, 0), cA, voffA); PG8_STAGE(PG8_SB(0, 1), cB + hstep, voffB); PG8_STAGE(PG8_SA(0, 1), cA + hstep, voffA);
        if (wr == 1) PG8_BAR;
        PG8_WAIT_V(4); PG8_BAR;
        PG8_STAGE(PG8_SB(1, 0), cB + kstep, voffB); PG8_STAGE(PG8_SA(1, 0), cA + kstep, voffA); PG8_STAGE(PG8_SB(1, 1), cB + hstep + kstep, voffB);
        PG8_WAIT_V(6); PG8_BAR;
    }
    for (;;) {
        const bool has_next = S.next(ui + 1, nxt);
        const char* nA = has_next ? (const char*)g.A + (size_t)nxt.pm * tstep : cA; const char* nB = has_next ? (const char*)g.Bt + (size_t)nxt.pn * tstep : cB;
        for (int t = 0; t < nt; t += 2) {
            const bool last = (t == nt - 2);
            const char* a1 = cA + (size_t)(t + 1) * kstep;
            const char* a2 = last ? nA : cA + (size_t)(t + 2) * kstep; const char* b2 = last ? nB : cB + (size_t)(t + 2) * kstep;
            const char* a3 = a2 + kstep; const char* b3 = b2 + kstep;
            if (last && has_next) S.a_ready(nxt);
            if constexpr (SP2) {
            PG8_LDB(B0, 0, 0); PG8_LDB(B1, 0, 1); PG8_SCHED; PG8_LDA(At, 0, 0); PG8_STAGE(PG8_SA(1, 1), a1 + hstep, voffA);
            PG8_WAIT_V(8); PG8_WAIT_L(0); PG8_BAR; PG8_MMA(0, 0, At, B0); PG8_MMA(0, 1, At, B1); PG8_BAR; PG8_SCHED;
            PG8_LDA(At, 0, 1); PG8_STAGE(PG8_SB(0, 0), b2, voffB); PG8_STAGE(PG8_SB(0, 1), b2 + hstep, voffB); PG8_STAGE(PG8_SA(0, 0), a2, voffA);
            PG8_WAIT_V(8); PG8_WAIT_L(0); PG8_BAR; PG8_MMA(1, 0, At, B0); PG8_MMA(1, 1, At, B1); PG8_BAR; PG8_SCHED;
            PG8_LDB(B0, 1, 0); PG8_LDB(B1, 1, 1); PG8_SCHED; PG8_LDA(At, 1, 0); PG8_STAGE(PG8_SA(0, 1), a2 + hstep, voffA);
            PG8_WAIT_V(8); PG8_WAIT_L(0); PG8_BAR; PG8_MMA(0, 0, At, B0); PG8_MMA(0, 1, At, B1); PG8_BAR; PG8_SCHED;
            PG8_LDA(At, 1, 1); PG8_STAGE(PG8_SB(1, 0), b3, voffB); PG8_STAGE(PG8_SB(1, 1), b3 + hstep, voffB); PG8_STAGE(PG8_SA(1, 0), a3, voffA);
            PG8_WAIT_V(8); PG8_WAIT_L(0); PG8_BAR; PG8_MMA(1, 0, At, B0); PG8_MMA(1, 1, At, B1); PG8_BAR; PG8_SCHED;
            } else {
            PG8_LDB(B0, 0, 0); PG8_SCHED; PG8_LDA(At, 0, 0); PG8_STAGE(PG8_SA(1, 1), a1 + hstep, voffA);
            PG8_WAIT_L(8); PG8_BAR; PG8_WAIT_L(0); PG8_MMA(0, 0, At, B0); PG8_BAR; PG8_SCHED;
            PG8_LDB(B1, 0, 1); PG8_STAGE(PG8_SB(0, 0), b2, voffB);
            PG8_BAR; PG8_WAIT_L(0); PG8_MMA(0, 1, At, B1); PG8_BAR;
            PG8_LDA(At, 0, 1); PG8_STAGE(PG8_SA(0, 0), a2, voffA);
            PG8_BAR; PG8_WAIT_L(0); PG8_MMA(1, 0, At, B0); PG8_BAR; PG8_SCHED;
            PG8_STAGE(PG8_SB(0, 1), b2 + hstep, voffB);
            PG8_WAIT_V(6); PG8_BAR; PG8_MMA(1, 1, At, B1); PG8_BAR;
            PG8_LDB(B0, 1, 0); PG8_SCHED; PG8_LDA(At, 1, 0); PG8_STAGE(PG8_SA(0, 1), a2 + hstep, voffA);
            PG8_WAIT_L(8); PG8_BAR; PG8_WAIT_L(0); PG8_MMA(0, 0, At, B0); PG8_BAR; PG8_SCHED;
            PG8_LDB(B1, 1, 1); PG8_STAGE(PG8_SB(1, 0), b3, voffB);
            PG8_BAR; PG8_WAIT_L(0); PG8_MMA(0, 1, At, B1); PG8_BAR;
            PG8_LDA(At, 1, 1); PG8_STAGE(PG8_SA(1, 0), a3, voffA);
            PG8_BAR; PG8_WAIT_L(0); PG8_MMA(1, 0, At, B0); PG8_BAR; PG8_SCHED;
            PG8_STAGE(PG8_SB(1, 1), b3 + hstep, voffB);
            PG8_WAIT_V(6); PG8_BAR; PG8_MMA(1, 1, At, B1); PG8_BAR;
            }
        }
        if constexpr (ALIGN_EPI) { if (wr == 0) PG8_BAR; }
        if constexpr (!Epi::AFTER_DRAIN) { E(acc, cur, wr, wc, fr, fq); S.done(cur); }
        if (!has_next) break;
#pragma unroll
        for (int a = 0; a < 2; ++a)
#pragma unroll
            for (int b = 0; b < 2; ++b)
#pragma unroll
                for (int m = 0; m < 4; ++m)
#pragma unroll
                    for (int n = 0; n < 2; ++n) acc[a][b][m][n] = (f32x4){0.f, 0.f, 0.f, 0.f};
        cur = nxt; cA = nA; cB = nB; ++ui;
        if constexpr (ALIGN_EPI) { if (wr == 1) PG8_BAR; }
    }
    PG8_WAIT_V(0);
    if constexpr (!ALIGN_EPI) { if (wr == 0) PG8_BAR; }
    PG8_BAR;
    if constexpr (Epi::AFTER_DRAIN) { E.fused(acc, cur, wr, wc, fr, fq, lds, wid, lane); S.done(cur); }
#undef PG8_SA
#undef PG8_SB
#undef PG8_STAGE
#undef PG8_LDA
#undef PG8_LDB
#undef PG8_MMA
#undef PG8_WAIT_V
#undef PG8_WAIT_L
#undef PG8_BAR
#undef PG8_SCHED
}
}

#ifndef PG8_SP2
#define PG8_SP2 true
#endif
#ifndef PG8_ALIGN
#define PG8_ALIGN true
#endif
#include <hip/hip_bf16.h>
#include <cmath>
namespace attn_body {
using bf16=__hip_bfloat16;
using bf16x8=__attribute__((ext_vector_type(8)))short;
using s16x4=__attribute__((ext_vector_type(4)))short;
using f32x16=__attribute__((ext_vector_type(16)))float;
using u32x4=__attribute__((ext_vector_type(4)))unsigned;
constexpr int D=64;
constexpr int NW=8,QBLK=32,QB=QBLK*NW,KVBLK=64;
__device__ __forceinline__ int crow(int r,int hi){return (r&3)+8*(r>>2)+4*hi;}
#define SBAR() __builtin_amdgcn_sched_barrier(0)
__device__ __forceinline__ void cmask(f32x16&p0,f32x16&p1,int jb,int qrel,int hi){
  const float NEG=-INFINITY; int kb=64*jb+4*hi;
  #pragma unroll
  for(int r=0;r<16;++r){int kv=kb+(r&3)+8*(r>>2); if(kv>qrel)p0[r]=NEG; if(kv+32>qrel)p1[r]=NEG;}
}

constexpr int NSLOT=3, SLOTB=8192;
constexpr int LDS_K=0, LDS_V=NSLOT*SLOTB, LDS_WS=2*NSLOT*SLOTB, LDS_OST=LDS_WS+NW*64*4, LDS_BYTES=LDS_OST+NW*4096;
constexpr float C2=0.125f*1.4426950408889634f;
__device__ __forceinline__ void glds16(const void*gsrc,unsigned lds_dst){unsigned keep;
  asm volatile("s_mov_b32 %0, m0\n\ts_mov_b32 m0, %2\n\ts_nop 0\n\tglobal_load_lds_dwordx4 %1, off\n\ts_mov_b32 m0, %0":"=&s"(keep):"v"(gsrc),"s"(lds_dst):"memory");}
__device__ __forceinline__ float max3f(float a,float b,float c){float r;asm("v_max3_f32 %0, %1, %2, %3":"=v"(r):"v"(a),"v"(b),"v"(c));return r;}
__device__ __forceinline__ float max2f(float a,float b){float r;asm("v_max_f32_e32 %0, %1, %2":"=v"(r):"v"(a),"v"(b));return r;}
__device__ __forceinline__ float fadd_s(float a,float b){float r;asm("v_add_f32_e32 %0, %1, %2":"=v"(r):"v"(a),"v"(b));return r;}
__device__ __forceinline__ float fsub_s(float a,float b){float r;asm("v_sub_f32_e32 %0, %1, %2":"=v"(r):"v"(a),"v"(b));return r;}
typedef float f32x2_t __attribute__((ext_vector_type(2))); typedef __bf16 bf16x2_t __attribute__((ext_vector_type(2)));
__device__ __forceinline__ unsigned cvtpk_s(float lo,float hi){f32x2_t v={lo,hi};bf16x2_t b=__builtin_convertvector(v,bf16x2_t);return __builtin_bit_cast(unsigned,b);}
#define WAIT_BAR(N) asm volatile("s_waitcnt vmcnt(" #N ") lgkmcnt(0)\n\ts_barrier":::"memory")

__device__ __forceinline__ void qkt(f32x16&p0,f32x16&p1,const char*Kslot,const bf16x8*qr,const f32x16&negm,int r32,int hi){
  const char*kb=Kslot+hi*1024+r32*16;
  #pragma unroll
  for(int d0=0;d0<4;++d0){
    const bf16x8 b0=*reinterpret_cast<const bf16x8*>(kb+d0*2048);
    const bf16x8 b1=*reinterpret_cast<const bf16x8*>(kb+d0*2048+512);
    if(d0==0){p0=__builtin_amdgcn_mfma_f32_32x32x16_bf16(b0,qr[0],negm,0,0,0);p1=__builtin_amdgcn_mfma_f32_32x32x16_bf16(b1,qr[0],negm,0,0,0);}
    else{p0=__builtin_amdgcn_mfma_f32_32x32x16_bf16(b0,qr[d0],p0,0,0,0);p1=__builtin_amdgcn_mfma_f32_32x32x16_bf16(b1,qr[d0],p1,0,0,0);}}
}
typedef __attribute__((address_space(3))) const char* lds_cptr;
typedef short v4i16_t __attribute__((ext_vector_type(4)));
__device__ __forceinline__ void kload8(bf16x8*kf,lds_cptr kp){
  kf[0]=*(const __attribute__((address_space(3))) bf16x8*)(kp);      kf[1]=*(const __attribute__((address_space(3))) bf16x8*)(kp+512);
  kf[2]=*(const __attribute__((address_space(3))) bf16x8*)(kp+2048); kf[3]=*(const __attribute__((address_space(3))) bf16x8*)(kp+2560);
  kf[4]=*(const __attribute__((address_space(3))) bf16x8*)(kp+4096); kf[5]=*(const __attribute__((address_space(3))) bf16x8*)(kp+4608);
  kf[6]=*(const __attribute__((address_space(3))) bf16x8*)(kp+6144); kf[7]=*(const __attribute__((address_space(3))) bf16x8*)(kp+6656);
}
__device__ __forceinline__ void kload2(bf16x8*kf,lds_cptr kp,int j){ kf[2*j]=*(const __attribute__((address_space(3))) bf16x8*)(kp+j*2048); kf[2*j+1]=*(const __attribute__((address_space(3))) bf16x8*)(kp+j*2048+512); }
__device__ __forceinline__ s16x4 vtr(lds_cptr p){ return __builtin_bit_cast(s16x4,__builtin_amdgcn_ds_read_tr16_b64_v4i16((__attribute__((address_space(3))) v4i16_t*)p)); }
__device__ __forceinline__ float rowmax(const f32x16&p0,const f32x16&p1){
  float a=max3f(p0[0],p0[1],p1[0]),b=max3f(p0[2],p0[3],p1[1]);a=max3f(a,p1[2],p1[3]);
  #pragma unroll
  for(int r=4;r<16;r+=4){a=max3f(a,p0[r],p0[r+1]);b=max3f(b,p0[r+2],p0[r+3]);a=max3f(a,p1[r],p1[r+1]);b=max3f(b,p1[r+2],p1[r+3]);}
  const float m=max2f(a,b);
  auto rr=__builtin_amdgcn_permlane32_swap(__float_as_uint(m),__float_as_uint(m),false,false);
  return max2f(__uint_as_float(rr[0]),__uint_as_float(rr[1]));
}
__device__ __forceinline__ void pv(f32x16*o,int vb,bf16x8 pa0,bf16x8 pa1,bf16x8 pa2,bf16x8 pa3){
  #pragma unroll
  for(int d0=0;d0<2;++d0){s16x4 lo[4],hi[4];
    #pragma unroll
    for(int ks=0;ks<4;++ks){
      asm volatile("ds_read_b64_tr_b16 %0,%1 offset:%c2":"=&v"(lo[ks]):"v"(vb),"i"(d0*4096+ks*1024):"memory");
      asm volatile("ds_read_b64_tr_b16 %0,%1 offset:%c2":"=&v"(hi[ks]):"v"(vb),"i"(d0*4096+ks*1024+512):"memory");}
    asm volatile("s_waitcnt lgkmcnt(0)":::"memory");SBAR();
    #define PK(k) (bf16x8){lo[k][0],lo[k][1],lo[k][2],lo[k][3],hi[k][0],hi[k][1],hi[k][2],hi[k][3]}
    o[d0]=__builtin_amdgcn_mfma_f32_32x32x16_bf16(pa0,PK(0),o[d0],0,0,0);
    o[d0]=__builtin_amdgcn_mfma_f32_32x32x16_bf16(pa1,PK(1),o[d0],0,0,0);
    o[d0]=__builtin_amdgcn_mfma_f32_32x32x16_bf16(pa2,PK(2),o[d0],0,0,0);
    o[d0]=__builtin_amdgcn_mfma_f32_32x32x16_bf16(pa3,PK(3),o[d0],0,0,0);
    #undef PK
  }
}

#ifndef ATTN_STORE16
#define ATTN_STORE16(p,v) (*(u32x4*)(p)=(v))
#endif
template<int THRL> __device__ __forceinline__ void attn_unit(int qb,int SEQ,const bf16*Q,int QP,const bf16*__restrict__ K,const bf16*__restrict__ V,int KP,bf16*O,int OP,char*shm){
  int tid_=threadIdx.x; asm volatile("":"+v"(tid_)); const int tid=tid_,lane=tid&63,r32=lane&31,hi=lane>>5; const int wid=__builtin_amdgcn_readfirstlane(tid>>6);
  const int q0=qb*QB;
  const bf16*Qw=Q+(long)(q0+wid*QBLK)*QP;
  const bf16*Kh=K,*Vh=V;
  const unsigned lds0=(unsigned)(uintptr_t)shm;
  float*wsf=(float*)(shm+LDS_WS)+wid*64;
  const bf16*ksrc=Kh+(long)lane*KP+wid*8;
  const bf16*vsrc=Vh+(long)(16*(wid&3)+(lane>>2))*KP+(wid>>2)*32+(lane&3)*8;
  const unsigned kdst=lds0+LDS_K+wid*1024, vdst=lds0+LDS_V+wid*1024;
  #define DMA_K(t,slot) glds16(ksrc+(long)(t)*KVBLK*KP,(unsigned)__builtin_amdgcn_readfirstlane(kdst+(slot)))
  #define DMA_V(t,slot) glds16(vsrc+(long)(t)*KVBLK*KP,(unsigned)__builtin_amdgcn_readfirstlane(vdst+(slot)))
  const int vb0=(int)(lds0+LDS_V)+((lane>>4)&1)*32+(lane&3)*8+(4*hi+((lane&15)>>2))*64;
  const char*Kbase=shm+LDS_K; bf16x8 kf[8];
  const lds_cptr shm3=(lds_cptr)shm; const lds_cptr kp0=shm3+LDS_K+hi*1024+r32*16; const lds_cptr vp0=shm3+LDS_V+((lane>>4)&1)*32+(lane&3)*8+(4*hi+((lane&15)>>2))*64;
  const int NT=SEQ/KVBLK;
  DMA_K(0,0);DMA_V(0,0);DMA_K(1,SLOTB);
  bf16x8 qr[4];
  #pragma unroll
  for(int d0=0;d0<4;++d0)qr[d0]=*reinterpret_cast<const bf16x8*>(&Qw[(long)r32*QP+d0*16+hi*8]);
  float mhat=0.f,l_reg=0.f;f32x16 o[2];o[0]=f32x16{};o[1]=f32x16{};f32x16 negm=f32x16{};asm volatile("":"+v"(negm));
  const int qrel=wid*QBLK+r32;
  #define CMASK(P0,P1,t) do{}while(0)
  bool resc=false;
  #define START(P0,P1) do{ const float rm=rowmax(P0,P1); resc=false; \
    { const float dl=rm; mhat=fadd_s(mhat,dl); \
      _Pragma("unroll") for(int r=0;r<16;++r){P0[r]=fsub_s(P0[r],dl);P1[r]=fsub_s(P1[r],dl);} \
      _Pragma("unroll") for(int r=0;r<16;++r)negm[r]=-mhat; asm volatile("":"+v"(negm)); } \
    _Pragma("unroll") for(int r=0;r<16;++r)P0[r]=__builtin_amdgcn_exp2f(P0[r]); }while(0)
  #define RESC() do{ if(resc){ asm volatile("s_waitcnt lgkmcnt(0)":::"memory"); \
      _Pragma("unroll") for(int d_=0;d_<2;++d_) _Pragma("unroll") for(int r=0;r<16;++r)o[d_][r]*=wsf[crow(r,hi)]; } }while(0)
  f32x16 pA0,pA1,pB0,pB1;
  int sl_prev=0,sl_cur=0,sl_next=SLOTB;
  #define ROT() do{sl_prev=sl_cur;sl_cur=sl_next;sl_next=(sl_next==(NSLOT-1)*SLOTB)?0:sl_next+SLOTB;}while(0)
  DMA_K(2,2*SLOTB);
  WAIT_BAR(3);
  qkt(pA0,pA1,Kbase,qr,negm,r32,hi);asm volatile("s_nop 15\n\ts_nop 7":"+v"(pA0),"+v"(pA1));CMASK(pA0,pA1,0);
  START(pA0,pA1);
  _Pragma("unroll") for(int r=0;r<16;++r)pA1[r]=__builtin_amdgcn_exp2f(pA1[r]);
  WAIT_BAR(0);
  DMA_K(3,0);DMA_V(1,SLOTB);
  ROT();
  kload8(kf,kp0+sl_cur);
  WAIT_BAR(2);
  s16x4 vlo[8],vhi[8]; u32x4 pw0,pw1,pw2,pw3;
  #define PKW(P,B) cvtpk_s(P[B],P[B+1])
  #define PAF(k) __builtin_bit_cast(bf16x8,pw##k)
  #define VFR(i) (bf16x8){vlo[i][0],vlo[i][1],vlo[i][2],vlo[i][3],vhi[i][0],vhi[i][1],vhi[i][2],vhi[i][3]}
  #define PIN(x) asm volatile("":"+v"(x))
  #define MX3(a,b,c) __builtin_fmaxf(__builtin_fmaxf((a),(b)),(c))
  #define GAPA(MF,A0,A1,A2,A3,W0,W1,PW) do{ MF; sacc+=A0; sacc+=A1; sacc+=A2; sacc+=A3; PIN(sacc); W0; W1; PIN(PW); SBAR(); }while(0)
  #define EX(v) __builtin_amdgcn_exp2f(v)
  #define GAPB(MF,X,B) do{ MF; X[B]=EX(X[B]); X[B+1]=EX(X[B+1]); X[B+2]=EX(X[B+2]); X[B+3]=EX(X[B+3]); PIN(X); SBAR(); }while(0)
  #define VRD(i) do{ vlo[i]=vtr(vp_+(((i)>>2)*4096+((i)&3)*1024)); vhi[i]=vtr(vp_+(((i)>>2)*4096+((i)&3)*1024+512)); }while(0)
  #define KRD(G,j) do{ if(G){ kload2(kf,kp0+sl_next,j); SBAR(); } }while(0)
  #define STEP(C0,C1,P0,P1,t,GK,GV,GL) do{ SBAR(); \
    const lds_cptr vp_=vp0+sl_prev; \
    VRD(0); SBAR(); float sacc=(P0[0]+P0[1]); \
    GAPA(C0=__builtin_amdgcn_mfma_f32_32x32x16_bf16(kf[0],qr[0],negm,0,0,0), P0[2],P0[3],P0[4],P0[5],     pw0[0]=PKW(P0,0), pw0[1]=PKW(P0,2), pw0); \
    VRD(4); SBAR(); GAPA(C1=__builtin_amdgcn_mfma_f32_32x32x16_bf16(kf[1],qr[0],negm,0,0,0), P0[6],P0[7],P0[8],P0[9],     pw0[2]=PKW(P0,4), pw0[3]=PKW(P0,6), pw0); \
    VRD(1); SBAR(); GAPA(C0=__builtin_amdgcn_mfma_f32_32x32x16_bf16(kf[2],qr[1],C0,0,0,0),   P0[10],P0[11],P0[12],P0[13], pw1[0]=PKW(P0,8), pw1[1]=PKW(P0,10), pw1); \
    VRD(5); SBAR(); GAPA(C1=__builtin_amdgcn_mfma_f32_32x32x16_bf16(kf[3],qr[1],C1,0,0,0),   P0[14],P0[15],P1[0],P1[1],   pw1[2]=PKW(P0,12),pw1[3]=PKW(P0,14), pw1); \
    VRD(2); SBAR(); GAPA(C0=__builtin_amdgcn_mfma_f32_32x32x16_bf16(kf[4],qr[2],C0,0,0,0),   P1[2],P1[3],P1[4],P1[5],     pw2[0]=PKW(P1,0), pw2[1]=PKW(P1,2), pw2); \
    VRD(6); SBAR(); GAPA(C1=__builtin_amdgcn_mfma_f32_32x32x16_bf16(kf[5],qr[2],C1,0,0,0),   P1[6],P1[7],P1[8],P1[9],     pw2[2]=PKW(P1,4), pw2[3]=PKW(P1,6), pw2); \
    VRD(3); SBAR(); GAPA(C0=__builtin_amdgcn_mfma_f32_32x32x16_bf16(kf[6],qr[3],C0,0,0,0),   P1[10],P1[11],P1[12],P1[13], pw3[0]=PKW(P1,8), pw3[1]=PKW(P1,10), pw3); \
    VRD(7); SBAR(); GAPA(C1=__builtin_amdgcn_mfma_f32_32x32x16_bf16(kf[7],qr[3],C1,0,0,0),   P1[14],P1[15],0.f,0.f,       pw3[2]=PKW(P1,12),pw3[3]=PKW(P1,14), pw3); \
    l_reg+=sacc; \
    if(GK){DMA_K((t)+3,sl_cur);} if(GV){DMA_V((t)+1,sl_next);} \
    CMASK(C0,C1,t); \
    { float a=MX3(C0[0],C0[1],C1[0]),b=MX3(C0[2],C0[3],C1[1]); a=MX3(a,C1[2],C1[3]); \
      _Pragma("unroll") for(int r=4;r<16;r+=4){a=MX3(a,C0[r],C0[r+1]);b=MX3(b,C0[r+2],C0[r+3]);a=MX3(a,C1[r],C1[r+1]);b=MX3(b,C1[r+2],C1[r+3]);} \
      float rm=__builtin_fmaxf(a,b); { auto rr=__builtin_amdgcn_permlane32_swap(__float_as_uint(rm),__float_as_uint(rm),false,false); rm=__builtin_fmaxf(__uint_as_float(rr[0]),__uint_as_float(rr[1])); } \
      resc=false; \
      if(__builtin_expect(__any(rm>(float)THRL),0)){ const float dl=__builtin_fmaxf(rm,0.f); mhat+=dl; \
        _Pragma("unroll") for(int r=0;r<16;++r){C0[r]-=dl;C1[r]-=dl;} \
        _Pragma("unroll") for(int r=0;r<16;++r)negm[r]=-mhat; asm volatile("":"+v"(negm)); \
        const float f=__builtin_amdgcn_exp2f(-dl); l_reg*=f; if(hi==0)wsf[r32]=f; resc=true; } } \
    SBAR(); \
    GAPB(o[0]=__builtin_amdgcn_mfma_f32_32x32x16_bf16(PAF(0),VFR(0),o[0],0,0,0), C0,0); \
    GAPB(o[1]=__builtin_amdgcn_mfma_f32_32x32x16_bf16(PAF(0),VFR(4),o[1],0,0,0), C0,4); \
    KRD(GL,0); GAPB(o[0]=__builtin_amdgcn_mfma_f32_32x32x16_bf16(PAF(1),VFR(1),o[0],0,0,0), C0,8); \
    KRD(GL,1); GAPB(o[1]=__builtin_amdgcn_mfma_f32_32x32x16_bf16(PAF(1),VFR(5),o[1],0,0,0), C0,12); \
    KRD(GL,2); GAPB(o[0]=__builtin_amdgcn_mfma_f32_32x32x16_bf16(PAF(2),VFR(2),o[0],0,0,0), C1,0); \
    KRD(GL,3); GAPB(o[1]=__builtin_amdgcn_mfma_f32_32x32x16_bf16(PAF(2),VFR(6),o[1],0,0,0), C1,4); \
    GAPB(o[0]=__builtin_amdgcn_mfma_f32_32x32x16_bf16(PAF(3),VFR(3),o[0],0,0,0), C1,8); \
    GAPB(o[1]=__builtin_amdgcn_mfma_f32_32x32x16_bf16(PAF(3),VFR(7),o[1],0,0,0), C1,12); \
    }while(0)
  int t=1;
  #undef CMASK
  #define CMASK(P0,P1,t) do{}while(0)
  for(;t+5<NT;t+=2){
    STEP(pB0,pB1,pA0,pA1,t,true,true,true);     WAIT_BAR(2); RESC(); ROT();
    STEP(pA0,pA1,pB0,pB1,t+1,true,true,true);   WAIT_BAR(2); RESC(); ROT();
  }
  #undef CMASK
  #define CMASK(P0,P1,t) do{}while(0)
  #define ENDW(tt) do{ if((tt)+3<NT){WAIT_BAR(2);} else if((tt)+2<NT){WAIT_BAR(1);} else {WAIT_BAR(0);} }while(0)
  for(;t+1<NT;t+=2){
    STEP(pB0,pB1,pA0,pA1,t,(t+3<NT),(t+1<NT),(t+1<NT));       ENDW(t);   RESC(); ROT();
    STEP(pA0,pA1,pB0,pB1,t+1,(t+4<NT),(t+2<NT),(t+2<NT));     ENDW(t+1); RESC(); ROT();
  }
  STEP(pB0,pB1,pA0,pA1,NT-1,false,false,false); RESC();
  { float sacc=pB0[0]+pB0[1]; _Pragma("unroll") for(int r=2;r<16;++r)sacc+=pB0[r]; _Pragma("unroll") for(int r=0;r<16;++r)sacc+=pB1[r]; l_reg+=sacc;
    pw0=(u32x4){PKW(pB0,0),PKW(pB0,2),PKW(pB0,4),PKW(pB0,6)};pw1=(u32x4){PKW(pB0,8),PKW(pB0,10),PKW(pB0,12),PKW(pB0,14)};pw2=(u32x4){PKW(pB1,0),PKW(pB1,2),PKW(pB1,4),PKW(pB1,6)};pw3=(u32x4){PKW(pB1,8),PKW(pB1,10),PKW(pB1,12),PKW(pB1,14)};
    SBAR(); pv(o,vb0+sl_cur,PAF(0),PAF(1),PAF(2),PAF(3)); }
  #undef PKW
  #undef PAF
  #undef VFR
  #undef PIN
  #undef MX3
  #undef GAPA
  #undef GAPB
  #undef EX
  #undef VRD
  #undef KRD
  #undef STEP
  #undef ENDW
  {auto rr=__builtin_amdgcn_permlane32_swap(__float_as_uint(l_reg),__float_as_uint(l_reg),false,false);l_reg=__uint_as_float(rr[0])+__uint_as_float(rr[1]);}
  if(hi==0)wsf[32+r32]=l_reg;asm volatile("s_waitcnt lgkmcnt(0)":::"memory");
  float rli[16];
  #pragma unroll
  for(int r=0;r<16;++r)rli[r]=__builtin_amdgcn_rcpf(wsf[32+crow(r,hi)]);
  bf16*Ow=O+(long)(q0+wid*QBLK)*OP;
  { bf16*stg=(bf16*)(shm+LDS_OST)+wid*2048;
    #pragma unroll
    for(int r=0;r<16;++r){const int orow=crow(r,hi);
      #pragma unroll
      for(int d0=0;d0<2;++d0)stg[orow*64+d0*32+r32]=__float2bfloat16(o[d0][r]*rli[r]);}
    asm volatile("s_waitcnt lgkmcnt(0)":::"memory");
    #pragma unroll
    for(int i=0;i<4;++i){const int row=i*8+(lane>>3),ch=lane&7; const u32x4 v=*(const u32x4*)(stg+row*64+ch*8); ATTN_STORE16(Ow+(long)row*OP+ch*8,v);} }
  asm volatile("s_waitcnt lgkmcnt(0)\n\ts_barrier":::"memory");
  #undef DMA_K
  #undef DMA_V
  #undef CMASK
  #undef START
  #undef RESC
  #undef ROT
}
constexpr int ATTN_LDS_BYTES=LDS_BYTES;
#undef SBAR
#undef WAIT_BAR
}
namespace xb {
#define GAS __attribute__((address_space(1)))
#define LAS __attribute__((address_space(3)))
typedef GAS unsigned gu32;
typedef GAS unsigned long long gu64;
#define RLX_AGENT __ATOMIC_RELAXED, __HIP_MEMORY_SCOPE_AGENT
#define LDS_WAIT() asm volatile("s_waitcnt lgkmcnt(0)" ::: "memory")
#define VM_WAIT() asm volatile("s_waitcnt vmcnt(0)" ::: "memory")
__device__ __forceinline__ unsigned long long rt() { return __builtin_amdgcn_s_memrealtime(); }
__device__ __forceinline__ unsigned f2bf(float f) { unsigned u = __builtin_bit_cast(unsigned, f); return (u + 0x7fffu + ((u >> 16) & 1u)) >> 16; }
__device__ __forceinline__ unsigned pk2(float lo, float hi) { return f2bf(lo) | (f2bf(hi) << 16); }

#define XB_TMO      128
#define XB_XCNT(j)  (256  + 64 * (j))
#define XB_XSUB(j)  (1280 + 64 * (j))
#define XB_XGEN(j)  (2304 + 64 * (j))
#define XB_TOP      3328
#define XB_TOPGEN   3392
#define XCD_BAR_WORDS 3456
#define XB_SPIN_CAP (1u << 18)

__device__ __forceinline__ unsigned xb_ld(unsigned* p)              { return __hip_atomic_load(p, __ATOMIC_RELAXED, __HIP_MEMORY_SCOPE_AGENT); }
__device__ __forceinline__ unsigned xb_add(unsigned* p, unsigned v) { return __hip_atomic_fetch_add(p, v, __ATOMIC_RELAXED, __HIP_MEMORY_SCOPE_AGENT); }
__device__ __forceinline__ unsigned xb_xcc_id() { return (unsigned)__builtin_amdgcn_s_getreg((3 << 11) | 20) & 0xFu; }
#define XB_SPIN(cond, bar) do { unsigned _sp = 0; while (cond) { __builtin_amdgcn_s_sleep(1); \
    if ((++_sp & 255u) == 0u) { if (xb_ld(&(bar)[XB_TMO])) break; if (_sp > XB_SPIN_CAP) { atomicAdd(&(bar)[XB_TMO], 1u); break; } } } } while (0)

struct XcdBarrier {
    unsigned* bar; unsigned x;
    volatile LAS unsigned* st;
};

__device__ __forceinline__ XcdBarrier xcd_barrier_post(unsigned* bar, volatile LAS unsigned* st) {
    XcdBarrier b; b.bar = bar; b.x = xb_xcc_id(); b.st = st;
    if (threadIdx.x == 0) (void)xb_add(&bar[XB_XCNT(b.x)], 1u);
    return b;
}
__device__ __forceinline__ void xcd_barrier_complete(unsigned* bar, unsigned x, unsigned& nloc, unsigned& nx) {
    const unsigned G = gridDim.x * gridDim.y * gridDim.z;
    unsigned sum, cnt, mine, sp = 0u;
    for (;;) {
        sum = 0u; cnt = 0u; mine = 0u;
#pragma unroll
        for (unsigned j = 0; j < 16; ++j) { const unsigned c = xb_ld(&bar[XB_XCNT(j)]); sum += c; cnt += (c > 0u) ? 1u : 0u; mine = (j == x) ? c : mine; }
        if (sum == G) break;
        __builtin_amdgcn_s_sleep(1);
        if ((++sp & 255u) == 0u) { if (xb_ld(&bar[XB_TMO])) break; if (sp > XB_SPIN_CAP) { atomicAdd(&bar[XB_TMO], 1u); break; } }
    }
    nloc = mine > 0u ? mine : 1u; nx = cnt > 0u ? cnt : 1u;
}

__device__ __forceinline__ void xcd_barrier(const XcdBarrier& b) {
    asm volatile("s_waitcnt vmcnt(0)" ::: "memory");
    __syncthreads();
    if (threadIdx.x == 0) {
        unsigned* bar = b.bar;
        __builtin_amdgcn_s_waitcnt(0);
        unsigned nloc = b.st[0], nx = b.st[1];
        if (nloc == 0u) { xcd_barrier_complete(bar, b.x, nloc, nx); b.st[0] = nloc; b.st[1] = nx; }
        const unsigned old = xb_add(&bar[XB_XSUB(b.x)], 1u);
        const unsigned gen = old / nloc;
        if (old + 1u == (gen + 1u) * nloc) {
            __builtin_amdgcn_fence(__ATOMIC_RELEASE, "agent");
            asm volatile("s_waitcnt vmcnt(0)" ::: "memory");
            const unsigned og = xb_add(&bar[XB_TOP], 1u);
            const unsigned tg = og / nx;
            if (og + 1u == (tg + 1u) * nx) xb_add(&bar[XB_TOPGEN], 1u);
            else XB_SPIN(xb_ld(&bar[XB_TOPGEN]) == tg, bar);
            __builtin_amdgcn_fence(__ATOMIC_ACQUIRE, "agent");
            xb_add(&bar[XB_XGEN(b.x)], 1u);
            asm volatile("s_waitcnt vmcnt(0)" ::: "memory");
        } else {
            XB_SPIN(xb_ld(&bar[XB_XGEN(b.x)]) == gen, bar);
            __builtin_amdgcn_fence(__ATOMIC_ACQUIRE, "agent");
            asm volatile("s_waitcnt vmcnt(0)" ::: "memory");
        }
    }
    __syncthreads();
}

}

namespace mk {
typedef unsigned short bf16_t;
typedef short bf16x8 __attribute__((ext_vector_type(8)));
typedef float f32x4 __attribute__((ext_vector_type(4)));
typedef unsigned u32x4 __attribute__((ext_vector_type(4)));
typedef unsigned u32x2 __attribute__((ext_vector_type(2)));
typedef float f32x2 __attribute__((ext_vector_type(2)));

constexpr int DMODEL = 1024, TS = 16384, NSEG = 4, DFF = 4096;
constexpr int EIN = 1792, OIN = 4368, OINP = 4608, OOUT = 768;
constexpr float EPS = 1e-6f;
constexpr size_t MiB = (size_t)1 << 20;
constexpr size_t WS_W1T = 1 * MiB, WS_W2T = 33 * MiB, WS_WINE = 65 * MiB, WS_WOUTE = 72 * MiB, WS_WINO = 76 * MiB, WS_WOUTO = 94 * MiB,
                 WS_GW = 97 * MiB, WS_H = 98 * MiB, WS_PROJ = 130 * MiB, WS_SCR = 274 * MiB, WS_END = 512 * MiB;
constexpr size_t SC_HID = 0;
constexpr size_t SC_LA = 0, SC_UU = 64 * MiB, SC_AGG = 128 * MiB;
constexpr size_t SC_QKVP = 0, SC_DNI = 48 * MiB, SC_OB = 192 * MiB, SC_LSE = 224 * MiB, SC_EGL = 225 * MiB;
constexpr int DNI_BYTES = 73728, DNI_W = 0, DNI_QT = 16384, DNI_KTT = 32768, DNI_A = 49152, DNI_U = 57344;
constexpr int LDS_BYTES = 147456;
constexpr int NT = 512, NW = 8;

struct Params { const float* in[25]; float* out; unsigned char* ws; };

__device__ __forceinline__ float bf2f(bf16_t v) { return __uint_as_float(((unsigned)v) << 16); }
__device__ __forceinline__ unsigned f2bf(float f) { unsigned u = __float_as_uint(f); return (u + 0x7fffu + ((u >> 16) & 1u)) >> 16; }
__device__ __forceinline__ unsigned pk2(float lo, float hi) { return f2bf(lo) | (f2bf(hi) << 16); }
__device__ __forceinline__ float wave_sum(float v) {
#pragma unroll
    for (int o = 1; o < 64; o <<= 1) v += __shfl_xor(v, o);
    return v;
}
__device__ __forceinline__ float sigm(float x) { return 1.f / (1.f + __expf(-x)); }
__device__ __forceinline__ float softplus(float x) { return x > 20.f ? x : log1pf(__expf(x)); }
__device__ __forceinline__ float silu(float x) { return x * sigm(x); }
__device__ __forceinline__ float gelu_tanh(float x) { const float t = 0.7978845608028654f * (x + 0.044715f * x * x * x); return 0.5f * x * (1.f + tanhf(t)); }
__device__ __forceinline__ void unpack8(const u32x4 v, float* f) {
    f[0] = __uint_as_float(v.x << 16); f[1] = __uint_as_float(v.x & 0xffff0000u); f[2] = __uint_as_float(v.y << 16); f[3] = __uint_as_float(v.y & 0xffff0000u);
    f[4] = __uint_as_float(v.z << 16); f[5] = __uint_as_float(v.z & 0xffff0000u); f[6] = __uint_as_float(v.w << 16); f[7] = __uint_as_float(v.w & 0xffff0000u);
}
#define MK_IDS() int tid = threadIdx.x; asm volatile("" : "+v"(tid)); const int lane = tid & 63, wave = __builtin_amdgcn_readfirstlane(tid >> 6); const int gw = blockIdx.x * NW + wave, NGW = gridDim.x * NW; (void)lane; (void)wave; (void)gw; (void)NGW
#define MFMA16(a, b, c) __builtin_amdgcn_mfma_f32_16x16x32_bf16((a), (b), (c), 0, 0, 0)

__device__ __forceinline__ void transpose_item(const float* W, int K, int Nsrc, int Npad, bf16_t* WT, float* scr, int item, int lane, const float* gain = nullptr) {
    const int nblk = Npad / 32, kb = item / nblk, nb = item % nblk, k0 = 64 * kb, n0 = 32 * nb;
    const int n = n0 + (lane & 31);
#pragma unroll 8
    for (int i = 0; i < 32; ++i) { const int kk = 2 * i + (lane >> 5); scr[kk * 33 + (lane & 31)] = (n < Nsrc) ? W[(size_t)(k0 + kk) * Nsrc + n] * (gain ? gain[k0 + kk] : 1.f) : 0.f; }
    asm volatile("s_waitcnt lgkmcnt(0)" ::: "memory");
    const int c = lane & 7;
#pragma unroll
    for (int j = 0; j < 4; ++j) { const int nn = (lane >> 3) + 8 * j; const float* s = scr + (8 * c) * 33 + nn;
        u32x4 o; o.x = pk2(s[0 * 33], s[1 * 33]); o.y = pk2(s[2 * 33], s[3 * 33]); o.z = pk2(s[4 * 33], s[5 * 33]); o.w = pk2(s[6 * 33], s[7 * 33]);
        *(u32x4*)(WT + (size_t)(n0 + nn) * K + k0 + 8 * c) = o; }
    asm volatile("s_waitcnt lgkmcnt(0)" ::: "memory");
}
__device__ __forceinline__ void phase_prologue(const Params& p, char* lds) {
    MK_IDS();
    float* scr = (float*)(lds + wave * 16384);
    unsigned char* ws = p.ws;
    constexpr int I_F1 = 16 * 128, I_F2 = 64 * 32, I_IE = 16 * 56, I_OE = 16 * 32, I_IO = 16 * 144, I_OO = 12 * 32;
    constexpr int T_F1 = 4 * I_F1, T_F2 = T_F1 + 4 * I_F2, T_IE = T_F2 + 2 * I_IE, T_OE = T_IE + 2 * I_OE, T_IO = T_OE + 2 * I_IO, T_OO = T_IO + 2 * I_OO;
    for (int it = gw; it < T_OO; it += NGW) {
        if (it < T_F1) { const int l = it / I_F1, r = it % I_F1; transpose_item(p.in[6] + (size_t)l * 1024 * 4096, 1024, 4096, 4096, (bf16_t*)(ws + WS_W1T) + (size_t)l * 4096 * 1024, scr, r, lane, p.in[4] + l * 1024); }
        else if (it < T_F2) { const int q = it - T_F1, l = q / I_F2, r = q % I_F2; transpose_item(p.in[7] + (size_t)l * 4096 * 1024, 4096, 1024, 1024, (bf16_t*)(ws + WS_W2T) + (size_t)l * 1024 * 4096, scr, r, lane); }
        else if (it < T_IE) { const int q = it - T_F2, l = q / I_IE, r = q % I_IE; transpose_item(p.in[8] + (size_t)l * 1024 * EIN, 1024, EIN, EIN, (bf16_t*)(ws + WS_WINE) + (size_t)l * EIN * 1024, scr, r, lane, p.in[3] + (2 * l) * 1024); }
        else if (it < T_OE) { const int q = it - T_IE, l = q / I_OE, r = q % I_OE; transpose_item(p.in[9] + (size_t)l * 1024 * 1024, 1024, 1024, 1024, (bf16_t*)(ws + WS_WOUTE) + (size_t)l * 1024 * 1024, scr, r, lane); }
        else if (it < T_IO) { const int q = it - T_OE, l = q / I_IO, r = q % I_IO; transpose_item(p.in[19] + (size_t)l * 1024 * OIN, 1024, OIN, OINP, (bf16_t*)(ws + WS_WINO) + (size_t)l * OINP * 1024, scr, r, lane, p.in[3] + (2 * l + 1) * 1024); }
        else { const int q = it - T_IO, l = q / I_OO, r = q % I_OO; transpose_item(p.in[20] + (size_t)l * OOUT * 1024, OOUT, 1024, 1024, (bf16_t*)(ws + WS_WOUTO) + (size_t)l * 1024 * OOUT, scr, r, lane); }
    }
    bf16_t* GW = (bf16_t*)(ws + WS_GW);
    const int gt = gw * 64 + lane, NGT = NGW * 64;
    for (int idx = gt; idx < 2 * 2 * 2 * 8 * 4096; idx += NGT) {
        const int d = idx & 63, e = (idx >> 6) & 63, blk = (idx >> 12) & 7, gate = (idx >> 15) & 1, dir = (idx >> 16) & 1, j = (idx >> 17) & 1;
        const float* src = gate ? p.in[16] : p.in[14];
        GW[idx] = (bf16_t)f2bf(src[((((size_t)j * 2 + dir) * 8 + blk) * 64 + d) * 64 + e]);
    }
}

__device__ __forceinline__ void phase_x0(const float* x, bf16_t* xb, float* ssq) {
    MK_IDS();
    for (int m = gw; m < TS; m += NGW) {
        const f32x4* xr = (const f32x4*)(x + (size_t)m * DMODEL) + lane;
        f32x4 v[4]; float s = 0.f;
#pragma unroll
        for (int j = 0; j < 4; ++j) { v[j] = xr[64 * j]; s += (v[j].x * v[j].x + v[j].y * v[j].y) + (v[j].z * v[j].z + v[j].w * v[j].w); }
        s = wave_sum(s);
        u32x2* o8 = (u32x2*)(xb + (size_t)m * DMODEL) + lane;
#pragma unroll
        for (int j = 0; j < 4; ++j) { u32x2 o; o.x = pk2(v[j].x, v[j].y); o.y = pk2(v[j].z, v[j].w); o8[64 * j] = o; }
        if (lane < 16) ssq[(size_t)m * 16 + lane] = lane == 0 ? s : 0.f;
    }
}
__device__ __forceinline__ void zero_f32(float* ptr, int n) {
    MK_IDS();
    for (int i = gw * 64 + lane; i < n; i += NGW * 64) ptr[i] = 0.f;
}
__device__ __forceinline__ void phase_rmsnorm_final(const bf16_t* xb, float* x, const float* g) {
    MK_IDS();
    for (int m = gw; m < TS; m += NGW) {
        const u32x2* xr = (const u32x2*)(xb + (size_t)m * DMODEL) + lane; f32x4* xw = (f32x4*)(x + (size_t)m * DMODEL) + lane; const f32x4* gr = (const f32x4*)g + lane;
        f32x4 v[4]; float s = 0.f;
#pragma unroll
        for (int j = 0; j < 4; ++j) { const u32x2 w = xr[64 * j]; v[j] = (f32x4){__uint_as_float(w.x << 16), __uint_as_float(w.x & 0xffff0000u), __uint_as_float(w.y << 16), __uint_as_float(w.y & 0xffff0000u)};
            s += (v[j].x * v[j].x + v[j].y * v[j].y) + (v[j].z * v[j].z + v[j].w * v[j].w); }
        const float rstd = 1.f / sqrtf(wave_sum(s) * (1.f / DMODEL) + EPS);
#pragma unroll
        for (int j = 0; j < 4; ++j) { const f32x4 gg = gr[64 * j]; xw[64 * j] = v[j] * rstd * gg; }
    }
}
struct EpiRes {
    static constexpr bool PERM = true, AFTER_DRAIN = false;
    bf16_t* xb; float* ssq; int ldc; const float* sin;
    __device__ __forceinline__ void operator()(const pg8::f32x4 (&acc)[2][2][4][2], const pg8::Unit& u, int wr, int wc, int fr, int fq) const {
        const int col0 = u.pn * pg8::BM + wc * 32 + 8 * fq;
        float rs2a[2][4];
        if (sin) { pg8::f32x4 t_[2][4];
#pragma unroll
            for (int ai = 0; ai < 2; ++ai)
#pragma unroll
                for (int m = 0; m < 4; ++m) t_[ai][m] = *(const pg8::f32x4*)(sin + (size_t)(u.pm * pg8::BM + ai * pg8::HALF + wr * 64 + m * 16 + fr) * 16 + fq * 4);
#pragma unroll
            for (int ai = 0; ai < 2; ++ai)
#pragma unroll
                for (int m = 0; m < 4; ++m) { float s_ = (t_[ai][m][0] + t_[ai][m][1]) + (t_[ai][m][2] + t_[ai][m][3]); s_ += __shfl_xor(s_, 16); s_ += __shfl_xor(s_, 32); rs2a[ai][m] = 1.0f / (s_ * (1.0f / 1024.0f) + 1e-6f); }
        } else {
#pragma unroll
            for (int ai = 0; ai < 2; ++ai)
#pragma unroll
                for (int m = 0; m < 4; ++m) rs2a[ai][m] = 1.f; }
#pragma unroll
        for (int ai = 0; ai < 2; ++ai)
#pragma unroll
            for (int m = 0; m < 4; ++m) { const int row = u.pm * pg8::BM + ai * pg8::HALF + wr * 64 + m * 16 + fr; const size_t off = (size_t)row * ldc + col0; float sq = 0.f;
                const float rs2 = rs2a[ai][m];
                u32x4 bw[2];
#pragma unroll
                for (int bj = 0; bj < 2; ++bj) bw[bj] = *(const u32x4*)(xb + off + bj * pg8::HALF);
#pragma unroll
                for (int bj = 0; bj < 2; ++bj) { float b[8]; unpack8(bw[bj], b); const pg8::f32x4 a0 = acc[ai][bj][m][0] * rs2, a1 = acc[ai][bj][m][1] * rs2;
                    const float o0 = b[0] + a0[0], o1 = b[1] + a0[1], o2 = b[2] + a0[2], o3 = b[3] + a0[3], o4 = b[4] + a1[0], o5 = b[5] + a1[1], o6 = b[6] + a1[2], o7 = b[7] + a1[3];
                    u32x4 w; w.x = pg8::cvt_pk_bf16(o0, o1); w.y = pg8::cvt_pk_bf16(o2, o3); w.z = pg8::cvt_pk_bf16(o4, o5); w.w = pg8::cvt_pk_bf16(o6, o7);
                    *(u32x4*)(xb + off + bj * pg8::HALF) = w;
                    sq += ((o0 * o0 + o1 * o1) + (o2 * o2 + o3 * o3)) + ((o4 * o4 + o5 * o5) + (o6 * o6 + o7 * o7)); }
                sq += __shfl_xor(sq, 16); sq += __shfl_xor(sq, 32);
                if (fq == 0) ssq[(size_t)row * 16 + u.pn * 4 + wc] = sq;
                if (m & 1) asm volatile("" ::: "memory"); }
    }
};

__device__ __forceinline__ void even_qk_post(bf16_t* proj, const float* qg, const float* kg, int S) {
    MK_IDS();
    const int g = lane & 7, axis = g >> 2, half = (g >> 1) & 1;
    float inv[8], gq[8], gk[8];
#pragma unroll
    for (int e = 0; e < 8; ++e) { inv[e] = exp2f(-(float)((g & 1) * 8 + e) * (13.287712379549449f / 16.f)); gq[e] = qg[g * 8 + e] * attn_body::C2; gk[e] = kg[g * 8 + e]; }
    for (int t = gw; t < TS; t += NGW) {
        const int s = t % S; const float pos = (float)(axis ? (s & 63) : (s >> 6));
        bf16_t* row = proj + (size_t)t * EIN;
        const u32x4 qa = *(const u32x4*)(row + lane * 8); u32x4 ka = {0u, 0u, 0u, 0u}; if (lane < 16) ka = *(const u32x4*)(row + 512 + lane * 8);
        float cs[8], sn[8];
#pragma unroll
        for (int e = 0; e < 8; ++e) { const float ang = pos * inv[e]; cs[e] = __cosf(ang); sn[e] = __sinf(ang); }
        float xq[8], xk[8]; unpack8(qa, xq); unpack8(ka, xk);
        float sq = 0.f, sk = 0.f;
#pragma unroll
        for (int e = 0; e < 8; ++e) { sq += xq[e] * xq[e]; sk += xk[e] * xk[e]; }
        sq += __shfl_xor(sq, 1); sq += __shfl_xor(sq, 2); sq += __shfl_xor(sq, 4);
        sk += __shfl_xor(sk, 1); sk += __shfl_xor(sk, 2); sk += __shfl_xor(sk, 4);
        const float rq = 1.f / sqrtf(sq * (1.f / 64.f) + EPS), rk = 1.f / sqrtf(sk * (1.f / 64.f) + EPS);
        float oq[8], ok[8];
#pragma unroll
        for (int e = 0; e < 8; ++e) { const float yq = xq[e] * rq * gq[e], yk = xk[e] * rk * gk[e];
            const float pq = __shfl_xor(yq, 2), pk = __shfl_xor(yk, 2);
            oq[e] = yq * cs[e] + (half ? pq : -pq) * sn[e]; ok[e] = yk * cs[e] + (half ? pk : -pk) * sn[e]; }
        u32x4 o; o.x = pk2(oq[0], oq[1]); o.y = pk2(oq[2], oq[3]); o.z = pk2(oq[4], oq[5]); o.w = pk2(oq[6], oq[7]);
        *(u32x4*)(row + lane * 8) = o;
        if (lane < 16) { u32x4 o2; o2.x = pk2(ok[0], ok[1]); o2.y = pk2(ok[2], ok[3]); o2.z = pk2(ok[4], ok[5]); o2.w = pk2(ok[6], ok[7]); *(u32x4*)(row + 512 + lane * 8) = o2; }
    }
}
__device__ __forceinline__ void even_lru_prep(const bf16_t* proj, const float* cw, const float* cb, const bf16_t* GWj, const float* br, const float* bi, const float* lam,
                                              unsigned* LU, f32x2* AGG, int S, char* lds) {
    MK_IDS();
    constexpr int XST = 1040;
    for (int tile = blockIdx.x; tile < TS / 64; tile += gridDim.x) {
        const int t0 = tile * 64;
        __syncthreads();
#pragma unroll 2
        for (int k = 0; k < 8; ++k) {
            const int idx = tid + k * NT, i = idx >> 6, cgp = idx & 63, t = t0 + i, s = t % S, ch = cgp * 8;
            float acc[8];
#pragma unroll
            for (int e = 0; e < 8; ++e) acc[e] = cb[ch + e];
#pragma unroll
            for (int j = 0; j < 4; ++j) { const int sp = s + j - 2;
                if (sp >= 0 && sp < S) { const u32x4 v = *(const u32x4*)(proj + (size_t)(t + j - 2) * EIN + 768 + ch); float xv[8]; unpack8(v, xv);
#pragma unroll
                    for (int e = 0; e < 8; ++e) acc[e] += cw[j * 512 + ch + e] * xv[e]; } }
            u32x4 o; o.x = pk2(acc[0], acc[1]); o.y = pk2(acc[2], acc[3]); o.z = pk2(acc[4], acc[5]); o.w = pk2(acc[6], acc[7]);
            *(u32x4*)(lds + i * XST + ch * 2) = o;
        }
        __syncthreads();
        const int G = lane >> 4, l16 = lane & 15, ch0 = wave * 64;
        for (int dir = 0; dir < 2; ++dir)
            for (int nt = 0; nt < 4; ++nt) {
                const int e = nt * 16 + l16, ch = ch0 + e;
                bf16x8 Br[2], Bi[2];
#pragma unroll
                for (int kk = 0; kk < 2; ++kk) {
                    Br[kk] = *(const bf16x8*)(GWj + ((((size_t)dir * 2 + 0) * 8 + wave) * 64 + e) * 64 + kk * 32 + G * 8);
                    Bi[kk] = *(const bf16x8*)(GWj + ((((size_t)dir * 2 + 1) * 8 + wave) * 64 + e) * 64 + kk * 32 + G * 8);
                }
                const float brv = br[dir * 512 + ch], biv = bi[dir * 512 + ch], spl = softplus(-lam[dir * 512 + ch]);
#pragma unroll
                for (int mt = 0; mt < 4; ++mt) {
                    f32x4 ar = {0.f, 0.f, 0.f, 0.f}, ai = {0.f, 0.f, 0.f, 0.f};
#pragma unroll
                    for (int kk = 0; kk < 2; ++kk) { const bf16x8 a = *(const bf16x8*)(lds + (mt * 16 + l16) * XST + (ch0 + kk * 32 + G * 8) * 2); ar = MFMA16(a, Br[kk], ar); ai = MFMA16(a, Bi[kk], ai); }
#pragma unroll
                    for (int r = 0; r < 4; ++r) { const int i = mt * 16 + G * 4 + r;
                        const float xc = bf2f(*(const bf16_t*)(lds + i * XST + ch * 2));
                        const float rg = __builtin_amdgcn_rcpf(1.f + __expf(-(ar[r] + brv))), ig = __builtin_amdgcn_rcpf(1.f + __expf(-(ai[r] + biv)));
                        const float la = -8.f * rg * spl; const float uu = __builtin_amdgcn_sqrtf(fmaxf(1.f - __expf(2.f * la), 0.f)) * (ig * xc);
                        LU[((size_t)dir * TS + t0 + i) * 512 + ch] = attn_body::cvtpk_s(la, uu); }
                }
            }
        asm volatile("s_waitcnt vmcnt(0)" ::: "memory");
        __syncthreads();
        {
            const int ch = tid;
#pragma unroll
            for (int dir = 0; dir < 2; ++dir) {
                float h = 0.f, P = 0.f;
                const unsigned* lu = LU + ((size_t)dir * TS + t0) * 512 + ch;
#pragma unroll
                for (int q = 0; q < 64; q += 8) {
                    float lv[8], uv[8];
#pragma unroll
                    for (int e = 0; e < 8; ++e) { const int i = dir ? 63 - (q + e) : q + e; const unsigned w_ = lu[(size_t)i * 512]; lv[e] = __uint_as_float(w_ << 16); uv[e] = __uint_as_float(w_ & 0xffff0000u); }
#pragma unroll
                    for (int e = 0; e < 8; ++e) { h = __expf(lv[e]) * h + uv[e]; P += lv[e]; }
                }
                AGG[((size_t)dir * (TS / 64) + tile) * 512 + ch] = (f32x2){P, h};
            }
        }
    }
}
__device__ __forceinline__ void even_lru_scan(const unsigned* LU, const f32x2* AGG, const bf16_t* proj, bf16_t* Y, int S) {
    MK_IDS();
    const int ch = tid, TPB = S / 64;
    for (int tile = blockIdx.x; tile < TS / 64; tile += gridDim.x) {
        const int t0 = tile * 64, tb0 = (tile / TPB) * TPB;
        float cf = 0.f, cr = 0.f;
        for (int k0 = tb0; k0 < tile; k0 += 8) { f32x2 a[8];
#pragma unroll
            for (int q = 0; q < 8; ++q) { const int k = k0 + q < tile ? k0 + q : tile - 1; a[q] = AGG[(size_t)k * 512 + ch]; }
#pragma unroll
            for (int q = 0; q < 8; ++q) if (k0 + q < tile) cf = cf * __expf(a[q].x) + a[q].y; }
        for (int k0 = tb0 + TPB - 1; k0 > tile; k0 -= 8) { f32x2 a[8];
#pragma unroll
            for (int q = 0; q < 8; ++q) { const int k = k0 - q > tile ? k0 - q : tile + 1; a[q] = AGG[((size_t)(TS / 64) + k) * 512 + ch]; }
#pragma unroll
            for (int q = 0; q < 8; ++q) if (k0 - q > tile) cr = cr * __expf(a[q].x) + a[q].y; }
        float hf[64];
        {
            const unsigned* lu = LU + (size_t)t0 * 512 + ch; float h = cf;
#pragma unroll
            for (int q = 0; q < 64; q += 8) {
                float lv[8], uv[8];
#pragma unroll
                for (int e = 0; e < 8; ++e) { const unsigned w_ = lu[(size_t)(q + e) * 512]; lv[e] = __uint_as_float(w_ << 16); uv[e] = __uint_as_float(w_ & 0xffff0000u); }
#pragma unroll
                for (int e = 0; e < 8; ++e) { h = __expf(lv[e]) * h + uv[e]; hf[q + e] = h; }
            }
        }
        {
            const unsigned* lu = LU + ((size_t)TS + t0) * 512 + ch; float h = cr;
#pragma unroll
            for (int q = 0; q < 64; q += 8) {
                float lv[8], uv[8], gv[8];
#pragma unroll
                for (int e = 0; e < 8; ++e) { const int i = 63 - (q + e); { const unsigned w_ = lu[(size_t)i * 512]; lv[e] = __uint_as_float(w_ << 16); uv[e] = __uint_as_float(w_ & 0xffff0000u); } gv[e] = bf2f(proj[(size_t)(t0 + i) * EIN + 1280 + ch]); }
#pragma unroll
                for (int e = 0; e < 8; ++e) { const int i = 63 - (q + e); h = __expf(lv[e]) * h + uv[e]; Y[(size_t)(t0 + i) * DMODEL + 512 + ch] = (bf16_t)f2bf((hf[i] + h) * gelu_tanh(gv[e])); }
            }
        }
    }
}

__device__ __forceinline__ void odd_conv(const bf16_t* proj, const float* cw, bf16_t* QKVP, int S) {
    MK_IDS();
    for (int cr = 0; cr < (TS / 64 + (int)gridDim.x - 1) / (int)gridDim.x; ++cr) {
        const int c = cr * (int)gridDim.x + (int)blockIdx.x; if (c >= TS / 64) break;
        const int tb = c * 64 + wave * 8, sb = tb % S;
#pragma unroll
        for (int blk = 0; blk < 3; ++blk) {
            const int ch = blk * 512 + lane * 8;
            u32x4 rows[11];
#pragma unroll
            for (int q = 0; q < 11; ++q) { const int sp = sb + q - 2; rows[q] = (u32x4){0u, 0u, 0u, 0u};
                if (sp >= 0 && sp < S) rows[q] = *(const u32x4*)(proj + (size_t)(tb + q - 2) * OINP + ch); }
            f32x4 w0[4], w1[4];
#pragma unroll
            for (int j = 0; j < 4; ++j) { w0[j] = *(const f32x4*)(cw + j * 1536 + ch); w1[j] = *(const f32x4*)(cw + j * 1536 + ch + 4); }
#pragma unroll
            for (int i = 0; i < 8; ++i) {
                float acc[8];
#pragma unroll
                for (int e = 0; e < 8; ++e) acc[e] = 0.f;
#pragma unroll
                for (int j = 0; j < 4; ++j) { float xv[8]; unpack8(rows[i + j], xv);
                    acc[0] += w0[j].x * xv[0]; acc[1] += w0[j].y * xv[1]; acc[2] += w0[j].z * xv[2]; acc[3] += w0[j].w * xv[3];
                    acc[4] += w1[j].x * xv[4]; acc[5] += w1[j].y * xv[5]; acc[6] += w1[j].z * xv[6]; acc[7] += w1[j].w * xv[7]; }
                float ss = 0.f;
#pragma unroll
                for (int e = 0; e < 8; ++e) { acc[e] = silu(acc[e]); ss += acc[e] * acc[e]; }
                if (blk < 2) {
                    ss += __shfl_xor(ss, 1); ss += __shfl_xor(ss, 2); ss += __shfl_xor(ss, 4); ss += __shfl_xor(ss, 8);
                    const float rn = 1.f / sqrtf(ss + EPS);
#pragma unroll
                    for (int e = 0; e < 8; ++e) acc[e] *= rn;
                }
                u32x4 o; o.x = pk2(acc[0], acc[1]); o.y = pk2(acc[2], acc[3]); o.z = pk2(acc[4], acc[5]); o.w = pk2(acc[6], acc[7]);
                *(u32x4*)(QKVP + (size_t)(tb + i) * 1536 + ch) = o;
            }
        }
    }
}

__device__ __forceinline__ int frag128(int r, int k) { return ((((r >> 4) * 4 + (k >> 5)) * 64 + ((k >> 3) & 3) * 16 + (r & 15)) << 3) + (k & 7); }
__device__ __forceinline__ int frag64(int r, int k) { return ((((r >> 4) * 2 + (k >> 5)) * 64 + ((k >> 3) & 3) * 16 + (r & 15)) << 3) + (k & 7); }
__device__ __forceinline__ void odd_prep(const bf16_t* QKVP, const bf16_t* proj, const float* alog, const float* dtb, unsigned char* DNI, float* EGL, char* lds) {
    MK_IDS();
    constexpr int RS = 272;
    constexpr int HOFF = 69632;
    const float scale = 0.08838834764831845f;
    for (int itq = 0; itq < (TS / 64 + (int)gridDim.x - 1) / (int)gridDim.x * 4; ++itq) {
        const int c_ = (itq >> 2) * (int)gridDim.x + (int)blockIdx.x; if (c_ >= TS / 64) break; const int it0 = (c_ * 4 + (itq & 3)) * 2;
        int tq_ = tid; asm volatile("" : "+v"(tq_));
        const int half = tq_ >> 8, ht = tq_ & 255, hwave = __builtin_amdgcn_readfirstlane(ht >> 6), G = (tq_ & 63) >> 4, l16 = tq_ & 15;
        char* L = lds + half * HOFF;
        char* KS = L, *QS = L + 17408, *VS = L + 34816; float* LM = (float*)(L + 52224); float* GC = (float*)(L + 68608); float* BT = GC + 64; float* EG = BT + 64;
        const int it = it0 + half; const int d = it & 1, h = (it >> 1) & 3, c = it >> 3, t0 = c * 64;
        __syncthreads();
#pragma unroll
        for (int k = 0; k < 4; ++k) { const int idx = ht + k * 256, i = idx >> 4, pc = idx & 15; const int tk = d ? t0 + 63 - i : t0 + i;
            const bf16_t* src = QKVP + (size_t)tk * 1536 + h * 128 + pc * 8;
            *(u32x4*)(QS + i * RS + pc * 16) = *(const u32x4*)(src);
            *(u32x4*)(KS + i * RS + pc * 16) = *(const u32x4*)(src + 512);
            *(u32x4*)(VS + i * RS + pc * 16) = *(const u32x4*)(src + 1024); }
        if (hwave == 0) {
            const int i = lane; const int tk = d ? t0 + 63 - i : t0 + i;
            const float bl = bf2f(proj[(size_t)tk * OINP + 2048 + d * 4 + h]), al = bf2f(proj[(size_t)tk * OINP + 2056 + d * 4 + h]);
            const float beta = sigm(bl); float g = -__expf(alog[d * 4 + h]) * softplus(al + dtb[d * 4 + h]);
#pragma unroll
            for (int o = 1; o < 64; o <<= 1) { const float v = __shfl_up(g, o); if (lane >= o) g += v; }
            GC[i] = g; BT[i] = beta; EG[i] = __expf(g);
        }
        __syncthreads();
        {
            const bool isq = hwave >= 2; const char* XS = isq ? QS : KS;
#pragma unroll
            for (int mm = 0; mm < 2; ++mm) { const int mt = (hwave & 1) * 2 + mm;
                bf16x8 a[4];
#pragma unroll
                for (int kk = 0; kk < 4; ++kk) a[kk] = *(const bf16x8*)(XS + (mt * 16 + l16) * RS + (kk * 32 + G * 8) * 2);
#pragma unroll
                for (int nt = 0; nt < 4; ++nt) { f32x4 acc = {0.f, 0.f, 0.f, 0.f};
#pragma unroll
                    for (int kk = 0; kk < 4; ++kk) { const bf16x8 bb = *(const bf16x8*)(KS + (nt * 16 + l16) * RS + (kk * 32 + G * 8) * 2); acc = MFMA16(a[kk], bb, acc); }
                    const int j = nt * 16 + l16; const float gj = GC[j];
#pragma unroll
                    for (int r = 0; r < 4; ++r) { const int i = mt * 16 + G * 4 + r; const float dec = __expf(fminf(GC[i] - gj, 0.f));
                        if (!isq) LM[i * 64 + j] = (j < i) ? BT[i] * acc[r] * dec : 0.f;
                        else ((bf16_t*)(DNI + (size_t)it * DNI_BYTES + DNI_A))[frag64(i, j)] = (bf16_t)f2bf((j <= i) ? acc[r] * scale * dec : 0.f); }
                }
            }
        }
        __syncthreads();
        {
            float sol[64];
            const int cc = ht & 127; const bool isw = ht >= 128; const char* XS = isw ? KS : VS;
#pragma unroll
            for (int i = 0; i < 64; ++i) {
                float v = bf2f(*(const bf16_t*)(XS + i * RS + cc * 2)) * BT[i]; if (isw) v *= EG[i];
                float a0 = 0.f, a1 = 0.f;
#pragma unroll
                for (int j4 = 0; j4 < (i + 3) / 4; ++j4) { const f32x4 l4 = *(const f32x4*)(LM + i * 64 + j4 * 4);
                    if (j4 * 4 + 0 < i) a0 += l4.x * sol[j4 * 4 + 0]; if (j4 * 4 + 1 < i) a1 += l4.y * sol[j4 * 4 + 1];
                    if (j4 * 4 + 2 < i) a0 += l4.z * sol[j4 * 4 + 2]; if (j4 * 4 + 3 < i) a1 += l4.w * sol[j4 * 4 + 3];
                    if ((j4 & 1) == 1) asm volatile("" ::: "memory"); }
                v -= a0 + a1;
                sol[i] = v;
                ((bf16_t*)(DNI + (size_t)it * DNI_BYTES + (isw ? DNI_W : DNI_U)))[isw ? frag128(i, cc) : i * 128 + cc] = (bf16_t)f2bf(v);
                asm volatile("" ::: "memory");
            }
        }
        {
            const float gl = GC[63];
#pragma unroll
            for (int k = 0; k < 4; ++k) { const int idx = ht + k * 256;
                {
                    const int i = idx & 63, kg = idx >> 6; const u32x4 raw = *(const u32x4*)(QS + i * RS + kg * 16); float f[8]; unpack8(raw, f); const float sc = scale * EG[i];
                    u32x4 o; o.x = pk2(f[0] * sc, f[1] * sc); o.y = pk2(f[2] * sc, f[3] * sc); o.z = pk2(f[4] * sc, f[5] * sc); o.w = pk2(f[6] * sc, f[7] * sc);
                    *(u32x4*)((bf16_t*)(DNI + (size_t)it * DNI_BYTES + DNI_QT) + frag128(i, kg * 8)) = o; }
                {
                    const int dm = idx & 127, tg = idx >> 7; float f[8];
#pragma unroll
                    for (int q = 0; q < 8; ++q) { const int i = tg * 8 + q; f[q] = bf2f(*(const bf16_t*)(KS + i * RS + dm * 2)) * __expf(gl - GC[i]); }
                    u32x4 o; o.x = pk2(f[0], f[1]); o.y = pk2(f[2], f[3]); o.z = pk2(f[4], f[5]); o.w = pk2(f[6], f[7]);
                    *(u32x4*)((bf16_t*)(DNI + (size_t)it * DNI_BYTES + DNI_KTT) + frag64(dm, tg * 8)) = o; }
            }
            if (ht == 0) EGL[it] = __expf(gl);
        }
    }
}

template <int NS> __device__ __forceinline__ void odd_scan(const unsigned char* DNI, const float* EGL, bf16_t* OB, int S, int nb, char* lds) {
    MK_IDS();
    constexpr int O_SB = 0, O_VN = NS * 4352, O_OUT = O_VN + NS * 2304, PFD = 7, EB = NS == 1 ? 3 : 2, NCOL = NS * 16;
    const int NC = S / 64, G = lane >> 4, l16 = lane & 15;
    const int nitems = nb * 64 / NS;
    const int mt = wave & 3; const bool lo = wave < 4;
    for (int item = blockIdx.x; item < nitems; item += gridDim.x) {
        const int e = (item >> 3) & ((1 << EB) - 1), sq = (item & 7) | ((item >> (3 + EB)) << 3); const int d = sq & 1, h = (sq >> 1) & 3, b = sq >> 3, cb = e * NCOL;
        __syncthreads();
        for (int i = tid; i < NS * 4352 / 4; i += NT) ((unsigned*)(lds + O_SB))[i] = 0u;
        f32x4 Sreg[NS];
#pragma unroll
        for (int ns = 0; ns < NS; ++ns) Sreg[ns] = (f32x4){0.f, 0.f, 0.f, 0.f};
        const long dstep = (long)(d ? -8 : 8) * DNI_BYTES;
        const unsigned char* base0 = DNI + (size_t)(((b * NC + (d ? NC - 1 : 0)) * 4 + h) * 2 + d) * DNI_BYTES;
        const unsigned char* pX = base0 + (lo ? DNI_W : DNI_QT) + ((mt * 4) * 64 + lane) * 16;
        const unsigned char* pA = base0 + DNI_A + ((mt * 2) * 64 + lane) * 16;
        const unsigned char* pK = base0 + DNI_KTT + ((wave * 2) * 64 + lane) * 16;
        const unsigned char* pU = base0 + DNI_U + ((mt * 16 + G * 4) * 128 + cb + l16) * 2;
        const float* pE = EGL + (((b * NC + (d ? NC - 1 : 0)) * 4 + h) * 2 + d);
        const unsigned char* pP = base0 + (long)PFD * dstep + e * (9216 * NS) + (tid < 144 * NS ? tid : 144 * NS - 1) * 64;
        bf16_t* pO = OB + ((size_t)d * TS + (size_t)(b * NC + (d ? NC - 1 : 0)) * 64 + (d ? 63 - (tid >> 3) : (tid >> 3))) * 512 + h * 128 + cb + (tid & 7) * 2 * NS;
        const long ostep = (long)(d ? -64 : 64) * 512;
        u32x4 aX[4], aA[2], aK[2], bX[4], bA[2], bK[2], cX[4], cA[2], cK[2];
        unsigned aU[NS][4], bU[NS][4], cU[NS][4]; float aE, bE, cE; unsigned pf_dummy = 0u;
#define DN_LOAD(P) do { \
            _Pragma("unroll") for (int kk = 0; kk < 4; ++kk) P##X[kk] = *(const u32x4*)(pX + kk * 1024); \
            _Pragma("unroll") for (int kk = 0; kk < 2; ++kk) { P##A[kk] = *(const u32x4*)(pA + kk * 1024); P##K[kk] = *(const u32x4*)(pK + kk * 1024); } \
            _Pragma("unroll") for (int ns = 0; ns < NS; ++ns) _Pragma("unroll") for (int r = 0; r < 4; ++r) P##U[ns][r] = *(const bf16_t*)(pU + r * 256 + ns * 32); \
            P##E = *pE; pX += dstep; pA += dstep; pK += dstep; pU += dstep; pE += (d ? -8 : 8); } while (0)
#define DN_STEP(P, PL) do { \
            DN_LOAD(PL); \
            if (wave < (NS == 1 ? 3 : 5)) { asm volatile("global_load_dword %0, %1, off" : "+v"(pf_dummy) : "v"(pP) : "memory"); } \
            pP += dstep; \
            f32x4 acc[NS], acc2[NS]; \
            { bf16x8 sb_[NS][4]; \
              _Pragma("unroll") for (int ns = 0; ns < NS; ++ns) { acc[ns] = (f32x4){0.f, 0.f, 0.f, 0.f}; acc2[ns] = (f32x4){0.f, 0.f, 0.f, 0.f}; \
                _Pragma("unroll") for (int kk = 0; kk < 4; ++kk) sb_[ns][kk] = *(const bf16x8*)(lds + O_SB + (ns * 16 + l16) * 272 + (kk * 32 + G * 8) * 2); } \
              if constexpr (NS == 1) asm volatile("s_waitcnt lgkmcnt(0)" : "+v"(sb_[0][0]), "+v"(sb_[0][1]), "+v"(sb_[0][2]), "+v"(sb_[0][3]) :: "memory"); \
              else asm volatile("s_waitcnt lgkmcnt(0)" : "+v"(sb_[0][0]), "+v"(sb_[0][1]), "+v"(sb_[0][2]), "+v"(sb_[0][3]), "+v"(sb_[NS - 1][0]), "+v"(sb_[NS - 1][1]), "+v"(sb_[NS - 1][2]), "+v"(sb_[NS - 1][3]) :: "memory"); \
              _Pragma("unroll") for (int ns = 0; ns < NS; ++ns) { \
                acc[ns] = MFMA16(__builtin_bit_cast(bf16x8, P##X[0]), sb_[ns][0], acc[ns]); acc2[ns] = MFMA16(__builtin_bit_cast(bf16x8, P##X[1]), sb_[ns][1], acc2[ns]); \
                acc[ns] = MFMA16(__builtin_bit_cast(bf16x8, P##X[2]), sb_[ns][2], acc[ns]); acc2[ns] = MFMA16(__builtin_bit_cast(bf16x8, P##X[3]), sb_[ns][3], acc2[ns]); } \
              _Pragma("unroll") for (int ns = 0; ns < NS; ++ns) acc[ns] = acc[ns] + acc2[ns]; } \
            if (lo) { _Pragma("unroll") for (int ns = 0; ns < NS; ++ns) { u32x2 o; float v[4]; \
              _Pragma("unroll") for (int r = 0; r < 4; ++r) v[r] = __uint_as_float(P##U[ns][r] << 16) - acc[ns][r]; \
              o.x = attn_body::cvtpk_s(v[0], v[1]); o.y = attn_body::cvtpk_s(v[2], v[3]); \
              *(u32x2*)(lds + O_VN + (ns * 16 + l16) * 144 + (mt * 16 + G * 4) * 2) = o; } } \
            asm volatile("s_waitcnt lgkmcnt(0)\n\ts_barrier" ::: "memory"); \
            bf16x8 vb[NS][2]; \
            _Pragma("unroll") for (int ns = 0; ns < NS; ++ns) _Pragma("unroll") for (int kk = 0; kk < 2; ++kk) vb[ns][kk] = *(const bf16x8*)(lds + O_VN + (ns * 16 + l16) * 144 + (kk * 32 + G * 8) * 2); \
            if constexpr (NS == 1) asm volatile("s_waitcnt lgkmcnt(0)" : "+v"(vb[0][0]), "+v"(vb[0][1]) :: "memory"); \
            else asm volatile("s_waitcnt lgkmcnt(0)" : "+v"(vb[0][0]), "+v"(vb[0][1]), "+v"(vb[NS - 1][0]), "+v"(vb[NS - 1][1]) :: "memory"); \
            _Pragma("unroll") for (int ns = 0; ns < NS; ++ns) { Sreg[ns] = Sreg[ns] * P##E; \
              _Pragma("unroll") for (int kk = 0; kk < 2; ++kk) Sreg[ns] = MFMA16(__builtin_bit_cast(bf16x8, P##K[kk]), vb[ns][kk], Sreg[ns]); } \
            _Pragma("unroll") for (int ns = 0; ns < NS; ++ns) { u32x2 o; o.x = attn_body::cvtpk_s(Sreg[ns][0], Sreg[ns][1]); o.y = attn_body::cvtpk_s(Sreg[ns][2], Sreg[ns][3]); \
              *(u32x2*)(lds + O_SB + (ns * 16 + l16) * 272 + (wave * 16 + G * 4) * 2) = o; } \
            if (!lo) { _Pragma("unroll") for (int ns = 0; ns < NS; ++ns) { \
              _Pragma("unroll") for (int kk = 0; kk < 2; ++kk) acc[ns] = MFMA16(__builtin_bit_cast(bf16x8, P##A[kk]), vb[ns][kk], acc[ns]); \
              const unsigned w0_ = attn_body::cvtpk_s(acc[ns][0], acc[ns][1]), w1_ = attn_body::cvtpk_s(acc[ns][2], acc[ns][3]); \
              bf16_t* op_ = (bf16_t*)(lds + O_OUT + ((mt * 16 + G * 4) * NCOL + ns * 16 + l16) * 2); \
              op_[0] = (bf16_t)(w0_ & 0xffffu); op_[NCOL] = (bf16_t)(w0_ >> 16); op_[2 * NCOL] = (bf16_t)(w1_ & 0xffffu); op_[3 * NCOL] = (bf16_t)(w1_ >> 16); } } \
            asm volatile("s_waitcnt lgkmcnt(0)\n\ts_barrier" ::: "memory"); \
            if constexpr (NS == 1) *(unsigned*)pO = *(const unsigned*)(lds + O_OUT + tid * 4); else *(u32x2*)pO = *(const u32x2*)(lds + O_OUT + tid * 8); \
            pO += ostep; } while (0)
        DN_LOAD(a); DN_LOAD(b);
        __syncthreads();
        int n = 0;
        for (; n + 3 <= NC; n += 3) {
            DN_STEP(a, c);
            DN_STEP(b, a);
            DN_STEP(c, b);
        }
        if (n < NC) { DN_STEP(a, c); }
        if (n + 1 < NC) { DN_STEP(b, a); }
#undef DN_STEP
#undef DN_LOAD
        asm volatile("s_waitcnt vmcnt(0)" ::: "memory");
        asm volatile("" :: "v"(pf_dummy));
    }
}

__device__ __forceinline__ int t5_bucket(int rel) {
    const int n = rel < 0 ? -rel : rel; int v;
    if (n < 8) v = n; else v = 8 + (n >= 15) + (n >= 27) + (n >= 50) + (n >= 91) + (n >= 166) + (n >= 305) + (n >= 559);
    return (rel > 0 ? 16 : 0) + v;
}
__device__ __forceinline__ void odd_dilated(bf16_t* proj, const float* relb, float* LSE, int S, char* lds, int first_wg, int n_wg) {
    MK_IDS();
    constexpr int KST = 144, VST = 400, HOFF = 27648 + 25600 + 1024;
    const int half = tid >> 8, ht = tid & 255, wv = ht >> 6, G = lane >> 4, l16 = lane & 15;
    char* L = lds + half * HOFF; char* KS = L; char* VT = L + 27648; float* BIAS = (float*)(L + 27648 + 25600);
    const int NBb = S / 64;
    const int wgi = (int)blockIdx.x - first_wg;
    if (wgi < 0) return;
    for (int it0 = wgi * 2; it0 < 3072; it0 += n_wg * 2) {
        const int it = it0 + half; const int zb = it & 255, sl = (it >> 8) & 3, g = it >> 10;
        const int dil = g == 0 ? 1 : (g == 1 ? 4 : 16), lg = g * 2;
        const int M = S >> lg, MB = M / 64;
        const int b = zb / NBb, r0 = zb % NBb, rho = r0 / MB, n = r0 % MB;
        const int hc = (g * 4 + sl) * 64;
        const size_t tb = (size_t)b * S;
        __syncthreads();
#pragma unroll
        for (int k = 0; k < 6; ++k) { const int idx = ht + k * 256, kj = idx >> 3, pc = idx & 7; const int mk = 64 * n - 64 + kj;
            u32x4 kv = {0u, 0u, 0u, 0u}, vv = {0u, 0u, 0u, 0u};
            if (mk >= 0 && mk < M) { const bf16_t* rowp = proj + (tb + (size_t)mk * dil + rho) * OINP; kv = *(const u32x4*)(rowp + 2832 + hc + pc * 8); vv = *(const u32x4*)(rowp + 3600 + hc + pc * 8); }
            *(u32x4*)(KS + kj * KST + pc * 16) = kv;
            const unsigned w[4] = {vv.x, vv.y, vv.z, vv.w};
#pragma unroll
            for (int q = 0; q < 4; ++q) { *(bf16_t*)(VT + (pc * 8 + 2 * q) * VST + kj * 2) = (bf16_t)(w[q] & 0xffffu); *(bf16_t*)(VT + (pc * 8 + 2 * q + 1) * VST + kj * 2) = (bf16_t)(w[q] >> 16); } }
        if (ht < 129) BIAS[ht] = relb[t5_bucket((ht - 64) * dil) * 12 + g * 4 + sl];
        const int mq = 64 * n + 16 * wv + l16; const size_t tq = tb + (size_t)mq * dil + rho;
        bf16x8 qf[2];
#pragma unroll
        for (int kk = 0; kk < 2; ++kk) qf[kk] = *(const bf16x8*)(proj + tq * OINP + 2064 + hc + kk * 32 + G * 8);
        __syncthreads();
        f32x4 sc[9]; float mx = -1e30f;
#pragma unroll
        for (int kt = 0; kt < 9; ++kt) { f32x4 acc = {0.f, 0.f, 0.f, 0.f};
#pragma unroll
            for (int kk = 0; kk < 2; ++kk) { const bf16x8 a = *(const bf16x8*)(KS + ((wv + kt) * 16 + l16) * KST + (kk * 32 + G * 8) * 2); acc = MFMA16(a, qf[kk], acc); }
#pragma unroll
            for (int r = 0; r < 4; ++r) { const int kj = (wv + kt) * 16 + G * 4 + r; const int delta = kj - 64 - 16 * wv - l16; const int mk = 64 * n - 64 + kj;
                const bool ok = (delta >= -64) && (delta <= 64) && (mk >= 0) && (mk < M);
                const float s = ok ? acc[r] * 0.125f + BIAS[(delta < -64 ? -64 : (delta > 64 ? 64 : delta)) + 64] : -1e30f;
                acc[r] = s; mx = fmaxf(mx, s); }
            sc[kt] = acc; }
        mx = fmaxf(mx, __shfl_xor(mx, 16)); mx = fmaxf(mx, __shfl_xor(mx, 32));
        float sum = 0.f;
#pragma unroll
        for (int kt = 0; kt < 9; ++kt)
#pragma unroll
            for (int r = 0; r < 4; ++r) { const float pv_ = (sc[kt][r] > -1e29f) ? __expf(sc[kt][r] - mx) : 0.f; sc[kt][r] = pv_; sum += pv_; }
        sum += __shfl_xor(sum, 16); sum += __shfl_xor(sum, 32);
        f32x4 ot[4];
#pragma unroll
        for (int dt = 0; dt < 4; ++dt) ot[dt] = (f32x4){0.f, 0.f, 0.f, 0.f};
#pragma unroll
        for (int pp = 0; pp < 5; ++pp) {
            u32x4 pb; pb.x = pk2(sc[2 * pp][0], sc[2 * pp][1]); pb.y = pk2(sc[2 * pp][2], sc[2 * pp][3]);
            if (pp < 4) { pb.z = pk2(sc[2 * pp + 1][0], sc[2 * pp + 1][1]); pb.w = pk2(sc[2 * pp + 1][2], sc[2 * pp + 1][3]); } else { pb.z = 0u; pb.w = 0u; }
            const bf16x8 pbf = __builtin_bit_cast(bf16x8, pb);
#pragma unroll
            for (int dt = 0; dt < 4; ++dt) {
                u32x4 av; const u32x2 lo = *(const u32x2*)(VT + (dt * 16 + l16) * VST + ((wv + 2 * pp) * 16 + G * 4) * 2); av.x = lo.x; av.y = lo.y;
                if (pp < 4) { const u32x2 hi = *(const u32x2*)(VT + (dt * 16 + l16) * VST + ((wv + 2 * pp + 1) * 16 + G * 4) * 2); av.z = hi.x; av.w = hi.y; } else { av.z = 0u; av.w = 0u; }
                ot[dt] = MFMA16(__builtin_bit_cast(bf16x8, av), pbf, ot[dt]);
            }
        }
        const float rs = 1.f / sum;
        bf16_t* od = proj + tq * OINP + (g * 4 + sl) * 64;
#pragma unroll
        for (int dt = 0; dt < 4; ++dt) { const f32x4 v_ = ot[dt] * rs; u32x2 w_; w_.x = pk2(v_[0], v_[1]); w_.y = pk2(v_[2], v_[3]); *(u32x2*)(od + dt * 16 + G * 4) = w_; }
        if (G == 0) LSE[tq * 12 + g * 4 + sl] = mx + __logf(sum);
    }
}

__device__ __forceinline__ void odd_combine(const bf16_t* OB, const bf16_t* proj, const float* LSE, const float* og, bf16_t* Y) {
    MK_IDS();
    float gn[8];
#pragma unroll
    for (int e = 0; e < 8; ++e) gn[e] = og[(lane & 15) * 8 + e];
    const int sl = lane >> 4;
    for (int t = gw; t < TS; t += NGW) {
        const bf16_t* prow = proj + (size_t)t * OINP;
        const u32x4 fa = *(const u32x4*)(OB + (size_t)t * 512 + lane * 8), ra = *(const u32x4*)(OB + ((size_t)TS + t) * 512 + lane * 8), za = *(const u32x4*)(prow + 1536 + lane * 8);
        const u32x2 d0 = *(const u32x2*)(prow + lane * 4), d1 = *(const u32x2*)(prow + 256 + lane * 4), d2 = *(const u32x2*)(prow + 512 + lane * 4);
        const float l0 = LSE[(size_t)t * 12 + sl], l1 = LSE[(size_t)t * 12 + 4 + sl], l2 = LSE[(size_t)t * 12 + 8 + sl];
        float f[8], r[8], z[8]; unpack8(fa, f); unpack8(ra, r); unpack8(za, z);
        float ss = 0.f;
#pragma unroll
        for (int e = 0; e < 8; ++e) { f[e] += r[e]; ss += f[e] * f[e]; }
        ss += __shfl_xor(ss, 1); ss += __shfl_xor(ss, 2); ss += __shfl_xor(ss, 4); ss += __shfl_xor(ss, 8);
        const float rn = 1.f / sqrtf(ss * (1.f / 128.f) + EPS);
#pragma unroll
        for (int e = 0; e < 8; ++e) f[e] = f[e] * rn * gn[e] * silu(z[e]);
        u32x4 o; o.x = pk2(f[0], f[1]); o.y = pk2(f[2], f[3]); o.z = pk2(f[4], f[5]); o.w = pk2(f[6], f[7]);
        *(u32x4*)(Y + (size_t)t * OOUT + lane * 8) = o;
        const float m = fmaxf(l0, fmaxf(l1, l2)); const float w0 = __expf(l0 - m), w1 = __expf(l1 - m), w2 = __expf(l2 - m); const float rs = 1.f / (w0 + w1 + w2);
        const float a0 = w0 * rs, a1 = w1 * rs, a2 = w2 * rs;
        const float v0 = a0 * __uint_as_float(d0.x << 16) + a1 * __uint_as_float(d1.x << 16) + a2 * __uint_as_float(d2.x << 16);
        const float v1 = a0 * __uint_as_float(d0.x & 0xffff0000u) + a1 * __uint_as_float(d1.x & 0xffff0000u) + a2 * __uint_as_float(d2.x & 0xffff0000u);
        const float v2 = a0 * __uint_as_float(d0.y << 16) + a1 * __uint_as_float(d1.y << 16) + a2 * __uint_as_float(d2.y << 16);
        const float v3 = a0 * __uint_as_float(d0.y & 0xffff0000u) + a1 * __uint_as_float(d1.y & 0xffff0000u) + a2 * __uint_as_float(d2.y & 0xffff0000u);
        u32x2 od; od.x = pk2(v0, v1); od.y = pk2(v2, v3);
        *(u32x2*)(Y + (size_t)t * OOUT + 512 + lane * 4) = od;
    }
}

__global__ void __launch_bounds__(NT, 2) fwd_megakernel(Params p) {
    extern __shared__ __attribute__((aligned(16))) unsigned char lds_raw[];
    cg::grid_group grid = cg::this_grid();
    char* lds = (char*)lds_raw;
    PG8_LAS unsigned char* ldsl = (PG8_LAS unsigned char*)lds_raw;
    const int Gr = gridDim.x;
    volatile LAS unsigned* MISC = (volatile LAS unsigned*)((PG8_LAS unsigned char*)lds_raw + (LDS_BYTES - 128));
    if (threadIdx.x < 32) MISC[threadIdx.x] = 0u;
    __syncthreads();
    xb::XcdBarrier bar = xb::xcd_barrier_post((unsigned*)p.ws, MISC + 8);
#define GSYNC() xb::xcd_barrier(bar)
    unsigned char* ws = p.ws;
    bf16_t* H = (bf16_t*)(ws + WS_H); bf16_t* PROJ = (bf16_t*)(ws + WS_PROJ); unsigned char* SCR = ws + WS_SCR;

    phase_prologue(p, lds);
    grid.sync();

    float* SSQA = (float*)(SCR + 232 * MiB); float* SSQB = (float*)(SCR + 234 * MiB);
    bf16_t* YE = (bf16_t*)(SCR + 192 * MiB); bf16_t* YO = (bf16_t*)(SCR + SC_QKVP);
    for (int seg = 0; seg < NSEG; ++seg) {
        const int S = seg < 2 ? 16384 : 2048, nb = seg < 2 ? 1 : 8;
        const float* xin = (seg < 2 ? p.in[0] : p.in[1]) + (size_t)(seg & 1) * TS * DMODEL;
        float* xo = p.out + (size_t)seg * TS * DMODEL;
        phase_x0(xin, H, SSQB);
        GSYNC();
        for (int layer = 0; layer < 4; ++layer) {
            const int j = layer >> 1; const bool odd = layer & 1;
            {
                const int N = odd ? OINP : EIN;
                const bf16_t* Bt = odd ? (const bf16_t*)(ws + WS_WINO) + (size_t)j * OINP * 1024 : (const bf16_t*)(ws + WS_WINE) + (size_t)j * EIN * 1024;
                pg8::Gemm g{H, Bt, TS, N, 1024}; pg8::StaticOrder So; So.init(TS, N, Gr, (int)blockIdx.x);
                pg8::EpiBf16<0> E{PROJ, N, nullptr, 0, 0, 1.f, SSQB};
                pg8::gemm_phase<pg8::EpiBf16<0>, pg8::StaticOrder, true, true>(ldsl, g, So, E);
            }
            GSYNC();
            if (!odd) {
                even_qk_post(PROJ, p.in[10] + j * 64, p.in[11] + j * 64, S);
                even_lru_prep(PROJ, p.in[12] + j * 2048, p.in[13] + j * 512, (const bf16_t*)(ws + WS_GW) + (size_t)j * 2 * 2 * 8 * 4096, p.in[15] + j * 1024, p.in[17] + j * 1024, p.in[18] + j * 1024,
                              (unsigned*)(SCR + SC_LA), (f32x2*)(SCR + SC_AGG), S, lds);
                GSYNC();
                {
                    const int nqb = S / 256, nunits = nb * 8 * nqb;
                    for (int u = blockIdx.x; u < nunits; u += Gr) {
                        const int qb = u % nqb, h = (u / nqb) % 8, b = u / (nqb * 8), kvh = h >> 2;
                        const attn_body::bf16* base = (const attn_body::bf16*)PROJ + (size_t)b * S * EIN;
                        attn_body::attn_unit<8>(qb, S, base + h * 64, EIN, base + 512 + kvh * 64, base + 640 + kvh * 64, EIN, (attn_body::bf16*)YE + (size_t)b * S * DMODEL + h * 64, DMODEL, lds);
                    }
                }
                __syncthreads();
                even_lru_scan((const unsigned*)(SCR + SC_LA), (const f32x2*)(SCR + SC_AGG), PROJ, YE, S);
                GSYNC();
                {
                    pg8::Gemm g{YE, (const bf16_t*)(ws + WS_WOUTE) + (size_t)j * 1024 * 1024, TS, 1024, 1024}; pg8::StaticOrder So; So.init(TS, 1024, Gr, (int)blockIdx.x);
                    EpiRes E{H, SSQA, DMODEL, nullptr};
                    pg8::gemm_phase<EpiRes, pg8::StaticOrder, true, true>(ldsl, g, So, E);
                }
            } else {
                odd_conv(PROJ, p.in[21] + j * 4 * 1536, (bf16_t*)(SCR + SC_QKVP), S);
                asm volatile("s_waitcnt vmcnt(0)" ::: "memory"); __syncthreads();
                odd_prep((const bf16_t*)(SCR + SC_QKVP), PROJ, p.in[22] + j * 8, p.in[23] + j * 8, SCR + SC_DNI, (float*)(SCR + SC_EGL), lds);
                GSYNC();
                {
                    const int nscan = nb * 64;
                    if (nscan <= Gr) odd_scan<1>(SCR + SC_DNI, (const float*)(SCR + SC_EGL), (bf16_t*)(SCR + SC_OB), S, nb, lds);
                    else odd_scan<2>(SCR + SC_DNI, (const float*)(SCR + SC_EGL), (bf16_t*)(SCR + SC_OB), S, nb, lds);
                    const int first = nscan < Gr ? nscan : 0;
                    odd_dilated(PROJ, p.in[2], (float*)(SCR + SC_LSE), S, lds, first, Gr - first);
                }
                GSYNC();
                odd_combine((const bf16_t*)(SCR + SC_OB), PROJ, (const float*)(SCR + SC_LSE), p.in[24] + j * 128, YO);
                GSYNC();
                {
                    pg8::Gemm g{YO, (const bf16_t*)(ws + WS_WOUTO) + (size_t)j * 1024 * OOUT, TS, 1024, OOUT}; pg8::StaticOrder So; So.init(TS, 1024, Gr, (int)blockIdx.x);
                    EpiRes E{H, SSQA, DMODEL, nullptr};
                    pg8::gemm_phase<EpiRes, pg8::StaticOrder, true, true>(ldsl, g, So, E);
                }
            }
            GSYNC();
            {
                pg8::Gemm g{H, (const bf16_t*)(ws + WS_W1T) + (size_t)layer * 4096 * 1024, TS, DFF, 1024}; pg8::StaticOrder So; So.init(TS, DFF, Gr, (int)blockIdx.x);
                pg8::EpiBf16<2> E{(bf16_t*)(SCR + SC_HID), DFF, nullptr, 0, 0, 1.f, nullptr};
                pg8::gemm_phase<pg8::EpiBf16<2>, pg8::StaticOrder, true, true>(ldsl, g, So, E);
            }
            GSYNC();
            {
                pg8::Gemm g{(const bf16_t*)(SCR + SC_HID), (const bf16_t*)(ws + WS_W2T) + (size_t)layer * 1024 * 4096, TS, 1024, DFF}; pg8::StaticOrder So; So.init(TS, 1024, Gr, (int)blockIdx.x);
                EpiRes E{H, SSQB, DMODEL, SSQA};
                pg8::gemm_phase<EpiRes, pg8::StaticOrder, true, true>(ldsl, g, So, E);
            }
            GSYNC();
        }
        phase_rmsnorm_final(H, xo, p.in[5]);
        GSYNC();
    }
}
}

extern "C" void kernel_launch(void* const* d_in, const int* in_sizes, int n_in, void* d_out, int out_size, void* d_ws, size_t ws_size, hipStream_t stream) {
    static int grid = 0;
    if (grid == 0) {
        if (n_in != 25 || ws_size < mk::WS_END) { fprintf(stderr, "kernel_launch: unexpected n_in %d / ws_size %zu\n", n_in, ws_size); grid = -1; return; }
        int dev = 0, cus = 0, per_cu = 0;
        hipGetDevice(&dev); hipDeviceGetAttribute(&cus, hipDeviceAttributeMultiprocessorCount, dev);
        if (hipFuncSetAttribute((const void*)mk::fwd_megakernel, hipFuncAttributeMaxDynamicSharedMemorySize, mk::LDS_BYTES) != hipSuccess) { fprintf(stderr, "hipFuncSetAttribute failed\n"); }
        hipOccupancyMaxActiveBlocksPerMultiprocessor(&per_cu, (const void*)mk::fwd_megakernel, mk::NT, mk::LDS_BYTES);
        (void)hipGetLastError();
        if (per_cu < 1) per_cu = 1;
        grid = cus * 1;
        fprintf(stderr, "kernel_launch: cus %d per_cu %d grid %d\n", cus, per_cu, grid);
    }
    if (grid < 0) return;
    if (hipMemsetAsync(d_ws, 0, 65536, stream) != hipSuccess) { fprintf(stderr, "memset failed\n"); return; }
    mk::Params p{};
    for (int i = 0; i < 25; ++i) p.in[i] = (const float*)d_in[i];
    p.out = (float*)d_out; p.ws = (unsigned char*)d_ws;
    void* args[] = {&p};
    hipError_t e = hipLaunchCooperativeKernel((const void*)mk::fwd_megakernel, dim3(grid), dim3(mk::NT), args, mk::LDS_BYTES, stream);
    if (e != hipSuccess) fprintf(stderr, "cooperative launch failed: %s (grid %d)\n", hipGetErrorString(e), grid);
}
```

```cpp
#include <hip/hip_runtime.h>
#include <hip/hip_cooperative_groups.h>
#include <hip/hip_bf16.h>
#include <cstdio>
#include <cstdint>
#include <cmath>
namespace cg = cooperative_groups;
namespace pg8 {
#define PG8_LAS __attribute__((address_space(3)))
typedef unsigned short bf16_t;
typedef short bf16x8 __attribute__((ext_vector_type(8)));
typedef float f32x4 __attribute__((ext_vector_type(4)));
typedef unsigned u32x4 __attribute__((ext_vector_type(4)));
constexpr int BM = 256, BK = 64, HALF = 128, HTB = HALF * BK * 2  , STAGE_BYTES = 8 * HTB, NXCD = 8, WGM = 8;

__host__ __device__ __forceinline__ int lds_byte(int r, int c) { const int st = (r >> 4) * 2 + (c >> 5), rr = r & 15, cc = c & 31, ob = rr * 64 + cc * 2; return st * 1024 + (ob ^ (((ob >> 9) & 1) << 5)); }
__host__ __device__ __forceinline__ void stage_rc(int b, int& R, int& C) { const int st = b / 1024, sb = b % 1024, swz = sb ^ (((sb >> 9) & 1) << 5); R = (st >> 1) * 16 + swz / 64; C = (st & 1) * 32 + (swz % 64) / 2; }
__host__ __device__ __forceinline__ int perm32(int rho) { const int n = rho >> 4, i = rho & 15; return 8 * (i >> 2) + 4 * n + (i & 3); }

struct Unit { int pm, pn; };
struct Gemm { const bf16_t* A; const bf16_t* Bt; int M, N, K; };

struct StaticOrder {
    int nM, nN, nwg, G, c;
    __host__ __device__ void init(int M, int N, int G_, int c_) { nM = M / BM; nN = N / BM; nwg = nM * nN; G = G_; c = c_; }
    __host__ __device__ bool next(int i, Unit& u) const {
        const long L = (long)i * G + c; if (L >= nwg) return false;
        int wgid = (int)L; { const int q = nwg / NXCD, r = nwg % NXCD, xcd = wgid % NXCD, off = wgid / NXCD; wgid = (xcd < r ? xcd * (q + 1) : r * (q + 1) + (xcd - r) * q) + off; }
        const int nig = WGM * nN, gid = wgid / nig, fm = gid * WGM, gsz = (nM - fm) < WGM ? (nM - fm) : WGM;
        u.pm = fm + ((wgid % nig) % gsz); u.pn = (wgid % nig) / gsz; return true;
    }
    __device__ __forceinline__ void a_ready(const Unit&) const {}
    __device__ __forceinline__ void done(const Unit&) const {}
};

__device__ __forceinline__ unsigned cvt_pk_bf16(float lo, float hi) { unsigned r; asm volatile("v_cvt_pk_bf16_f32 %0, %1, %2" : "=v"(r) : "v"(lo), "v"(hi)); return r; }
typedef float f32x2 __attribute__((ext_vector_type(2)));
__device__ __forceinline__ f32x2 gelu_pk(f32x2 v) {
    const f32x2 av = __builtin_elementwise_abs(v), d = av * 0.2316418882f + 1.0f;
    f32x2 t; t.x = __builtin_amdgcn_rcpf(d.x); t.y = __builtin_amdgcn_rcpf(d.y);
    f32x2 q = t * 0.5307027145f + (-0.7265760135f); q = q * t + 0.7107068705f; q = q * t + (-0.142248368f); q = q * t + 0.127414796f; q = q * t;
    const f32x2 s = (v * v) * (-0.72134752044f);
    f32x2 e; e.x = __builtin_amdgcn_exp2f(s.x); e.y = __builtin_amdgcn_exp2f(s.y);
    const f32x2 m = v * (q * e), r = v - m;
    f32x2 o; o.x = v.x < 0.f ? m.x : r.x; o.y = v.y < 0.f ? m.y : r.y; return o;
}

template <int ACT  > struct EpiBf16 {
    static constexpr bool PERM = true, AFTER_DRAIN = false; static_assert(ACT == 0 || ACT == 1 || ACT == 2, "EpiBf16: ACT 0 none, 1 gelu, 2 relu^2");
    bf16_t* O; int ldc; const float* bias; int split_cols; size_t split_stride; float scale0; const float* ssq;
    __device__ __forceinline__ void operator()(const f32x4 (&acc)[2][2][4][2], const Unit& u, int wr, int wc, int fr, int fq) const {
        const int row0 = u.pm * BM + wr * 64 + fr; int colt = u.pn * BM; bf16_t* base = O;
        float sc = 1.f; if (split_cols) { const int t = colt / split_cols; base += (size_t)t * split_stride; colt -= t * split_cols; if (t == 0) sc = scale0; }
        const int col0 = colt + wc * 32 + 8 * fq, bcol0 = u.pn * BM + wc * 32 + 8 * fq;
        float rsc[2][4];
        if (ssq) { f32x4 t_[2][4];
#pragma unroll
            for (int ai = 0; ai < 2; ++ai)
#pragma unroll
                for (int m = 0; m < 4; ++m) t_[ai][m] = *(const f32x4*)(ssq + (size_t)(row0 + ai * HALF + m * 16) * 16 + fq * 4);
#pragma unroll
            for (int ai = 0; ai < 2; ++ai)
#pragma unroll
                for (int m = 0; m < 4; ++m) { float s_ = (t_[ai][m][0] + t_[ai][m][1]) + (t_[ai][m][2] + t_[ai][m][3]); s_ += __shfl_xor(s_, 16); s_ += __shfl_xor(s_, 32); rsc[ai][m] = __builtin_amdgcn_rsqf(s_ * (1.0f / 1024.0f) + 1e-6f); }
        } else {
#pragma unroll
            for (int ai = 0; ai < 2; ++ai)
#pragma unroll
                for (int m = 0; m < 4; ++m) rsc[ai][m] = 1.0f; }
        f32x4 bv[2][2];
#pragma unroll
        for (int bj = 0; bj < 2; ++bj)
#pragma unroll
            for (int n = 0; n < 2; ++n) bv[bj][n] = bias ? *(const f32x4*)(bias + bcol0 + bj * HALF + 4 * n) : (f32x4){0.f, 0.f, 0.f, 0.f};
#pragma unroll
        for (int ai = 0; ai < 2; ++ai)
#pragma unroll
            for (int m = 0; m < 4; ++m) { bf16_t* rowp = base + (size_t)(row0 + ai * HALF + m * 16) * ldc + col0; const float rsc_ = rsc[ai][m];
#pragma unroll
                for (int bj = 0; bj < 2; ++bj) { f32x4 v0 = (acc[ai][bj][m][0] + bv[bj][0]) * rsc_, v1 = (acc[ai][bj][m][1] + bv[bj][1]) * rsc_;
                    if (ACT == 1) { f32x2 a = gelu_pk((f32x2){v0[0], v0[1]}), b = gelu_pk((f32x2){v0[2], v0[3]}), c = gelu_pk((f32x2){v1[0], v1[1]}), d = gelu_pk((f32x2){v1[2], v1[3]});
                        v0 = (f32x4){a.x, a.y, b.x, b.y}; v1 = (f32x4){c.x, c.y, d.x, d.y}; }
                    if (ACT == 2) { _Pragma("unroll") for (int q_ = 0; q_ < 4; ++q_) { const float a0_ = v0[q_] > 0.f ? v0[q_] : 0.f, a1_ = v1[q_] > 0.f ? v1[q_] : 0.f; v0[q_] = a0_ * a0_; v1[q_] = a1_ * a1_; } }
                    v0 = v0 * sc; v1 = v1 * sc; u32x4 w; w.x = cvt_pk_bf16(v0[0], v0[1]); w.y = cvt_pk_bf16(v0[2], v0[3]); w.z = cvt_pk_bf16(v1[0], v1[1]); w.w = cvt_pk_bf16(v1[2], v1[3]);
                    *(u32x4*)(rowp + bj * HALF) = w; } }
    }
};

template <class Epi, class Sched, bool ALIGN_EPI = false, bool SP2 = false>
__device__ __forceinline__ void gemm_phase(PG8_LAS unsigned char* lds, const Gemm g, const Sched& S, const Epi& E) {
    int tid_ = threadIdx.x; asm volatile("" : "+v"(tid_)); const int tid = tid_, wid = __builtin_amdgcn_readfirstlane(tid >> 6), lane = tid & 63, wr = wid >> 2, wc = wid & 3, fr = lane & 15, fq = lane >> 4;
    const int K = g.K, nt = K / BK;
    unsigned voffA[2], voffB[2];
#pragma unroll
    for (int i = 0; i < 2; ++i) { int R, C; stage_rc(tid * 16 + i * 8192, R, C); const int Rb = Epi::PERM ? ((R & ~31) + perm32(R & 31)) : R;
        voffA[i] = (unsigned)(R * K + C) * 2u; voffB[i] = (unsigned)(Rb * K + C) * 2u; }
    const size_t kstep = (size_t)(BK * 2);
    const size_t hstep = (size_t)HALF * K * 2;
    const size_t tstep = 2 * hstep;
    const unsigned ldsw = (unsigned)wid * 1024u;
    const int aoff = lds_byte(wr * 64 + fr, fq * 8), boff = lds_byte(wc * 32 + fr, fq * 8);
#define PG8_SA(b, h) (((b) * 2 + (h)) * HTB)
#define PG8_SB(b, h) ((4 + (b) * 2 + (h)) * HTB)
#define PG8_STAGE(bufoff, gbase, voff) do { _Pragma("unroll") for (int _i = 0; _i < 2; ++_i) \
        __builtin_amdgcn_global_load_lds((const unsigned*)((const char*)(gbase) + (voff)[_i]), (PG8_LAS unsigned*)(lds + (bufoff) + ldsw + _i * 8192), 16, 0, 0); } while (0)
#define PG8_LDA(dst, b, h) do { _Pragma("unroll") for (int m = 0; m < 4; ++m) _Pragma("unroll") for (int k = 0; k < 2; ++k) dst[m][k] = *(const PG8_LAS bf16x8*)(lds + PG8_SA(b, h) + aoff + m * 2048 + k * 1024); } while (0)
#define PG8_LDB(dst, b, h) do { _Pragma("unroll") for (int n = 0; n < 2; ++n) _Pragma("unroll") for (int k = 0; k < 2; ++k) dst[n][k] = *(const PG8_LAS bf16x8*)(lds + PG8_SB(b, h) + boff + n * 2048 + k * 1024); } while (0)
#define PG8_MMA(ai, bj, At, Bt) do { __builtin_amdgcn_s_setprio(1); _Pragma("unroll") for (int m = 0; m < 4; ++m) _Pragma("unroll") for (int n = 0; n < 2; ++n) _Pragma("unroll") for (int k = 0; k < 2; ++k) \
        acc[ai][bj][m][n] = __builtin_amdgcn_mfma_f32_16x16x32_bf16(Bt[n][k], At[m][k], acc[ai][bj][m][n], 0, 0, 0); __builtin_amdgcn_s_setprio(0); } while (0)
#define PG8_WAIT_V(n) asm volatile("s_waitcnt vmcnt(" #n ")" ::: "memory")
#define PG8_WAIT_L(n) asm volatile("s_waitcnt lgkmcnt(" #n ")" ::: "memory")
#define PG8_BAR __builtin_amdgcn_s_barrier()
#define PG8_SCHED __builtin_amdgcn_sched_barrier(0)
    Unit cur, nxt; int ui = 0;
    if (!S.next(0, cur)) return;
    f32x4 acc[2][2][4][2];
#pragma unroll
    for (int a = 0; a < 2; ++a)
#pragma unroll
        for (int b = 0; b < 2; ++b)
#pragma unroll
            for (int m = 0; m < 4; ++m)
#pragma unroll
                for (int n = 0; n < 2; ++n) acc[a][b][m][n] = (f32x4){0.f, 0.f, 0.f, 0.f};
    bf16x8 At[4][2], B0[2][2], B1[2][2];
    const char* cA = (const char*)g.A + (size_t)cur.pm * tstep; const char* cB = (const char*)g.Bt + (size_t)cur.pn * tstep;
    S.a_ready(cur);
    if constexpr (SP2) {
        PG8_STAGE(PG8_SB(0, 0), cB, voffB); PG8_STAGE(PG8_SB(0, 1), cB + hstep, voffB); PG8_STAGE(PG8_SA(0, 0), cA, voffA); PG8_STAGE(PG8_SA(0, 1), cA + hstep, voffA);
        if (wr == 1) PG8_BAR;
        PG8_WAIT_V(2); PG8_BAR;
        PG8_STAGE(PG8_SB(1, 0), cB + kstep, voffB); PG8_STAGE(PG8_SA(1, 0), cA + kstep, voffA); PG8_STAGE(PG8_SB(1, 1), cB + hstep + kstep, voffB);
        PG8_WAIT_V(6); PG8_BAR;
    } else {
        PG8_STAGE(PG8_SB(0, 0), cB, voffB); PG8_STAGE(PG8_SA(0, 0), cA, voffA); PG8_STAGE(PG8_SB(0, 1), cB + hstep, voffB); PG8_STAGE(PG8_SA(0, 1), cA + hstep, voffA);
        if (wr == 1) PG8_BAR;
        PG8_WAIT_V(4); PG8_BAR;
        PG8_STAGE(PG8_SB(1, 0), cB + kstep, voffB); PG8_STAGE(PG8_SA(1, 0), cA + kstep, voffA); PG8_STAGE(PG8_SB(1, 1), cB + hstep + kstep, voffB);
        PG8_WAIT_V(6); PG8_BAR;
    }
    for (;;) {
        const bool has_next = S.next(ui + 1, nxt);
        const char* nA = has_next ? (const char*)g.A + (size_t)nxt.pm * tstep : cA; const char* nB = has_next ? (const char*)g.Bt + (size_t)nxt.pn * tstep : cB;
        for (int t = 0; t < nt; t += 2) {
            const bool last = (t == nt - 2);
            const char* a1 = cA + (size_t)(t + 1) * kstep;
            const char* a2 = last ? nA : cA + (size_t)(t + 2) * kstep; const char* b2 = last ? nB : cB + (size_t)(t + 2) * kstep;
            const char* a3 = a2 + kstep; const char* b3 = b2 + kstep;
            if (last && has_next) S.a_ready(nxt);
            if constexpr (SP2) {
            PG8_LDB(B0, 0, 0); PG8_LDB(B1, 0, 1); PG8_SCHED; PG8_LDA(At, 0, 0); PG8_STAGE(PG8_SA(1, 1), a1 + hstep, voffA);
            PG8_WAIT_V(8); PG8_WAIT_L(0); PG8_BAR; PG8_MMA(0, 0, At, B0); PG8_MMA(0, 1, At, B1); PG8_BAR; PG8_SCHED;
            PG8_LDA(At, 0, 1); PG8_STAGE(PG8_SB(0, 0), b2, voffB); PG8_STAGE(PG8_SB(0, 1), b2 + hstep, voffB); PG8_STAGE(PG8_SA(0, 0), a2, voffA);
            PG8_WAIT_V(8); PG8_WAIT_L(0); PG8_BAR; PG8_MMA(1, 0, At, B0); PG8_MMA(1, 1, At, B1); PG8_BAR; PG8_SCHED;
            PG8_LDB(B0, 1, 0); PG8_LDB(B1, 1, 1); PG8_SCHED; PG8_LDA(At, 1, 0); PG8_STAGE(PG8_SA(0, 1), a2 + hstep, voffA);
            PG8_WAIT_V(8); PG8_WAIT_L(0); PG8_BAR; PG8_MMA(0, 0, At, B0); PG8_MMA(0, 1, At, B1); PG8_BAR; PG8_SCHED;
            PG8_LDA(At, 1, 1); PG8_STAGE(PG8_SB(1, 0), b3, voffB); PG8_STAGE(PG8_SB(1, 1), b3 + hstep, voffB); PG8_STAGE(PG8_SA(1, 0), a3, voffA);
            PG8_WAIT_V(8); PG8_WAIT_L(0); PG8_BAR; PG8_MMA(1, 0, At, B0); PG8_MMA(1, 1, At, B1); PG8_BAR; PG8_SCHED;
            } else {
            PG8_LDB(B0, 0, 0); PG8_SCHED; PG8_LDA(At, 0, 0); PG8_STAGE(PG8_SA(1, 1), a1 + hstep, voffA);
            PG8_WAIT_L(8); PG8_BAR; PG8_WAIT_L(0); PG8_MMA(0, 0, At, B0); PG8_BAR; PG8_SCHED;
            PG8_LDB(B1, 0, 1); PG8_STAGE(PG8_SB(0, 0), b2, voffB);
            PG8_BAR; PG8_WAIT_L(0); PG8_MMA(0, 1, At, B1); PG8_BAR;
            PG8_LDA(At, 0, 1); PG8_STAGE(PG8_SA(0, 0), a2, voffA);
            PG8_BAR; PG8_WAIT_L(0); PG8_MMA(1, 0, At, B0); PG8_BAR; PG8_SCHED;
            PG8_STAGE(PG8_SB(0, 1), b2 + hstep, voffB);
            PG8_WAIT_V(6); PG8_BAR; PG8_MMA(1, 1, At, B1); PG8_BAR;
            PG8_LDB(B0, 1, 0); PG8_SCHED; PG8_LDA(At, 1, 0); PG8_STAGE(PG8_SA(0, 1), a2 + hstep, voffA);
            PG8_WAIT_L(8); PG8_BAR; PG8_WAIT_L(0); PG8_MMA(0, 0, At, B0); PG8_BAR; PG8_SCHED;
            PG8_LDB(B1, 1, 1); PG8_STAGE(PG8_SB(1, 0), b3, voffB);
            PG8_BAR; PG8_WAIT_L(0); PG8_MMA(0, 1, At, B1); PG8_BAR;
            PG8_LDA(At, 1, 1); PG8_STAGE(PG8_SA(1, 0), a3, voffA);
            PG8_BAR; PG8_WAIT_L(0); PG8_MMA(1, 0, At, B0); PG8_BAR; PG8_SCHED;
            PG8_STAGE(PG8_SB(1, 1), b3 + hstep, voffB);
            PG8_WAIT_V(6); PG8_BAR; PG8_MMA(1, 1, At, B1); PG8_BAR;
            }
        }
        if constexpr (ALIGN_EPI) { if (wr == 0) PG8_BAR; }
        if constexpr (!Epi::AFTER_DRAIN) { E(acc, cur, wr, wc, fr, fq); S.done(cur); }
        if (!has_next) break;
#pragma unroll
        for (int a = 0; a < 2; ++a)
#pragma unroll
            for (int b = 0; b < 2; ++b)
#pragma unroll
                for (int m = 0; m < 4; ++m)
#pragma unroll
                    for (int n = 0; n < 2; ++n) acc[a][b][m][n] = (f32x4){0.f, 0.f, 0.f, 0.f};
        cur = nxt; cA = nA; cB = nB; ++ui;
        if constexpr (ALIGN_EPI) { if (wr == 1) PG8_BAR; }
    }
    PG8_WAIT_V(0);
    if constexpr (!ALIGN_EPI) { if (wr == 0) PG8_BAR; }
    PG8_BAR;
    if constexpr (Epi::AFTER_DRAIN) { E.fused(acc, cur, wr, wc, fr, fq, lds, wid, lane); S.done(cur); }
#undef PG8_SA
#undef PG8_SB
#undef PG8_STAGE
#undef PG8_LDA
#undef PG8_LDB
#undef PG8_MMA
#undef PG8_WAIT_V
#undef PG8_WAIT_L
#undef PG8_BAR
#undef PG8_SCHED
}
}

#ifndef PG8_SP2
#define PG8_SP2 true
#endif
#ifndef PG8_ALIGN
#define PG8_ALIGN true
#endif
#include <hip/hip_bf16.h>
#include <cmath>
namespace attn_body {
using bf16=__hip_bfloat16;
using bf16x8=__attribute__((ext_vector_type(8)))short;
using s16x4=__attribute__((ext_vector_type(4)))short;
using f32x16=__attribute__((ext_vector_type(16)))float;
using u32x4=__attribute__((ext_vector_type(4)))unsigned;
constexpr int D=64;
constexpr int NW=8,QBLK=32,QB=QBLK*NW,KVBLK=64;
__device__ __forceinline__ int crow(int r,int hi){return (r&3)+8*(r>>2)+4*hi;}
#define SBAR() __builtin_amdgcn_sched_barrier(0)
__device__ __forceinline__ void cmask(f32x16&p0,f32x16&p1,int jb,int qrel,int hi){
  const float NEG=-INFINITY; int kb=64*jb+4*hi;
  #pragma unroll
  for(int r=0;r<16;++r){int kv=kb+(r&3)+8*(r>>2); if(kv>qrel)p0[r]=NEG; if(kv+32>qrel)p1[r]=NEG;}
}

constexpr int NSLOT=3, SLOTB=8192;
constexpr int LDS_K=0, LDS_V=NSLOT*SLOTB, LDS_WS=2*NSLOT*SLOTB, LDS_OST=LDS_WS+NW*64*4, LDS_BYTES=LDS_OST+NW*4096;
constexpr float C2=0.125f*1.4426950408889634f;
__device__ __forceinline__ void glds16(const void*gsrc,unsigned lds_dst){unsigned keep;
  asm volatile("s_mov_b32 %0, m0\n\ts_mov_b32 m0, %2\n\ts_nop 0\n\tglobal_load_lds_dwordx4 %1, off\n\ts_mov_b32 m0, %0":"=&s"(keep):"v"(gsrc),"s"(lds_dst):"memory");}
__device__ __forceinline__ float max3f(float a,float b,float c){float r;asm("v_max3_f32 %0, %1, %2, %3":"=v"(r):"v"(a),"v"(b),"v"(c));return r;}
__device__ __forceinline__ float max2f(float a,float b){float r;asm("v_max_f32_e32 %0, %1, %2":"=v"(r):"v"(a),"v"(b));return r;}
__device__ __forceinline__ float fadd_s(float a,float b){float r;asm("v_add_f32_e32 %0, %1, %2":"=v"(r):"v"(a),"v"(b));return r;}
__device__ __forceinline__ float fsub_s(float a,float b){float r;asm("v_sub_f32_e32 %0, %1, %2":"=v"(r):"v"(a),"v"(b));return r;}
typedef float f32x2_t __attribute__((ext_vector_type(2))); typedef __bf16 bf16x2_t __attribute__((ext_vector_type(2)));
__device__ __forceinline__ unsigned cvtpk_s(float lo,float hi){f32x2_t v={lo,hi};bf16x2_t b=__builtin_convertvector(v,bf16x2_t);return __builtin_bit_cast(unsigned,b);}
#define WAIT_BAR(N) asm volatile("s_waitcnt vmcnt(" #N ") lgkmcnt(0)\n\ts_barrier":::"memory")

__device__ __forceinline__ void qkt(f32x16&p0,f32x16&p1,const char*Kslot,const bf16x8*qr,const f32x16&negm,int r32,int hi){
  const char*kb=Kslot+hi*1024+r32*16;
  #pragma unroll
  for(int d0=0;d0<4;++d0){
    const bf16x8 b0=*reinterpret_cast<const bf16x8*>(kb+d0*2048);
    const bf16x8 b1=*reinterpret_cast<const bf16x8*>(kb+d0*2048+512);
    if(d0==0){p0=__builtin_amdgcn_mfma_f32_32x32x16_bf16(b0,qr[0],negm,0,0,0);p1=__builtin_amdgcn_mfma_f32_32x32x16_bf16(b1,qr[0],negm,0,0,0);}
    else{p0=__builtin_amdgcn_mfma_f32_32x32x16_bf16(b0,qr[d0],p0,0,0,0);p1=__builtin_amdgcn_mfma_f32_32x32x16_bf16(b1,qr[d0],p1,0,0,0);}}
}
typedef __attribute__((address_space(3))) const char* lds_cptr;
typedef short v4i16_t __attribute__((ext_vector_type(4)));
__device__ __forceinline__ void kload8(bf16x8*kf,lds_cptr kp){
  kf[0]=*(const __attribute__((address_space(3))) bf16x8*)(kp);      kf[1]=*(const __attribute__((address_space(3))) bf16x8*)(kp+512);
  kf[2]=*(const __attribute__((address_space(3))) bf16x8*)(kp+2048); kf[3]=*(const __attribute__((address_space(3))) bf16x8*)(kp+2560);
  kf[4]=*(const __attribute__((address_space(3))) bf16x8*)(kp+4096); kf[5]=*(const __attribute__((address_space(3))) bf16x8*)(kp+4608);
  kf[6]=*(const __attribute__((address_space(3))) bf16x8*)(kp+6144); kf[7]=*(const __attribute__((address_space(3))) bf16x8*)(kp+6656);
}
__device__ __forceinline__ void kload2(bf16x8*kf,lds_cptr kp,int j){ kf[2*j]=*(const __attribute__((address_space(3))) bf16x8*)(kp+j*2048); kf[2*j+1]=*(const __attribute__((address_space(3))) bf16x8*)(kp+j*2048+512); }
__device__ __forceinline__ s16x4 vtr(lds_cptr p){ return __builtin_bit_cast(s16x4,__builtin_amdgcn_ds_read_tr16_b64_v4i16((__attribute__((address_space(3))) v4i16_t*)p)); }
__device__ __forceinline__ float rowmax(const f32x16&p0,const f32x16&p1){
  float a=max3f(p0[0],p0[1],p1[0]),b=max3f(p0[2],p0[3],p1[1]);a=max3f(a,p1[2],p1[3]);
  #pragma unroll
  for(int r=4;r<16;r+=4){a=max3f(a,p0[r],p0[r+1]);b=max3f(b,p0[r+2],p0[r+3]);a=max3f(a,p1[r],p1[r+1]);b=max3f(b,p1[r+2],p1[r+3]);}
  const float m=max2f(a,b);
  auto rr=__builtin_amdgcn_permlane32_swap(__float_as_uint(m),__float_as_uint(m),false,false);
  return max2f(__uint_as_float(rr[0]),__uint_as_float(rr[1]));
}
__device__ __forceinline__ void pv(f32x16*o,int vb,bf16x8 pa0,bf16x8 pa1,bf16x8 pa2,bf16x8 pa3){
  #pragma unroll
  for(int d0=0;d0<2;++d0){s16x4 lo[4],hi[4];
    #pragma unroll
    for(int ks=0;ks<4;++ks){
      asm volatile("ds_read_b64_tr_b16 %0,%1 offset:%c2":"=&v"(lo[ks]):"v"(vb),"i"(d0*4096+ks*1024):"memory");
      asm volatile("ds_read_b64_tr_b16 %0,%1 offset:%c2":"=&v"(hi[ks]):"v"(vb),"i"(d0*4096+ks*1024+512):"memory");}
    asm volatile("s_waitcnt lgkmcnt(0)":::"memory");SBAR();
    #define PK(k) (bf16x8){lo[k][0],lo[k][1],lo[k][2],lo[k][3],hi[k][0],hi[k][1],hi[k][2],hi[k][3]}
    o[d0]=__builtin_amdgcn_mfma_f32_32x32x16_bf16(pa0,PK(0),o[d0],0,0,0);
    o[d0]=__builtin_amdgcn_mfma_f32_32x32x16_bf16(pa1,PK(1),o[d0],0,0,0);
    o[d0]=__builtin_amdgcn_mfma_f32_32x32x16_bf16(pa2,PK(2),o[d0],0,0,0);
    o[d0]=__builtin_amdgcn_mfma_f32_32x32x16_bf16(pa3,PK(3),o[d0],0,0,0);
    #undef PK
  }
}

#ifndef ATTN_STORE16
#define ATTN_STORE16(p,v) (*(u32x4*)(p)=(v))
#endif
template<int THRL> __device__ __forceinline__ void attn_unit(int qb,int SEQ,const bf16*Q,int QP,const bf16*__restrict__ K,const bf16*__restrict__ V,int KP,bf16*O,int OP,char*shm){
  int tid_=threadIdx.x; asm volatile("":"+v"(tid_)); const int tid=tid_,lane=tid&63,r32=lane&31,hi=lane>>5; const int wid=__builtin_amdgcn_readfirstlane(tid>>6);
  const int q0=qb*QB;
  const bf16*Qw=Q+(long)(q0+wid*QBLK)*QP;
  const bf16*Kh=K,*Vh=V;
  const unsigned lds0=(unsigned)(uintptr_t)shm;
  float*wsf=(float*)(shm+LDS_WS)+wid*64;
  const bf16*ksrc=Kh+(long)lane*KP+wid*8;
  const bf16*vsrc=Vh+(long)(16*(wid&3)+(lane>>2))*KP+(wid>>2)*32+(lane&3)*8;
  const unsigned kdst=lds0+LDS_K+wid*1024, vdst=lds0+LDS_V+wid*1024;
  #define DMA_K(t,slot) glds16(ksrc+(long)(t)*KVBLK*KP,(unsigned)__builtin_amdgcn_readfirstlane(kdst+(slot)))
  #define DMA_V(t,slot) glds16(vsrc+(long)(t)*KVBLK*KP,(unsigned)__builtin_amdgcn_readfirstlane(vdst+(slot)))
  const int vb0=(int)(lds0+LDS_V)+((lane>>4)&1)*32+(lane&3)*8+(4*hi+((lane&15)>>2))*64;
  const char*Kbase=shm+LDS_K; bf16x8 kf[8];
  const lds_cptr shm3=(lds_cptr)shm; const lds_cptr kp0=shm3+LDS_K+hi*1024+r32*16; const lds_cptr vp0=shm3+LDS_V+((lane>>4)&1)*32+(lane&3)*8+(4*hi+((lane&15)>>2))*64;
  const int NT=SEQ/KVBLK;
  DMA_K(0,0);DMA_V(0,0);DMA_K(1,SLOTB);
  bf16x8 qr[4];
  #pragma unroll
  for(int d0=0;d0<4;++d0)qr[d0]=*reinterpret_cast<const bf16x8*>(&Qw[(long)r32*QP+d0*16+hi*8]);
  float mhat=0.f,l_reg=0.f;f32x16 o[2];o[0]=f32x16{};o[1]=f32x16{};f32x16 negm=f32x16{};asm volatile("":"+v"(negm));
  const int qrel=wid*QBLK+r32;
  #define CMASK(P0,P1,t) do{}while(0)
  bool resc=false;
  #define START(P0,P1) do{ const float rm=rowmax(P0,P1); resc=false; \
    { const float dl=rm; mhat=fadd_s(mhat,dl); \
      _Pragma("unroll") for(int r=0;r<16;++r){P0[r]=fsub_s(P0[r],dl);P1[r]=fsub_s(P1[r],dl);} \
      _Pragma("unroll") for(int r=0;r<16;++r)negm[r]=-mhat; asm volatile("":"+v"(negm)); } \
    _Pragma("unroll") for(int r=0;r<16;++r)P0[r]=__builtin_amdgcn_exp2f(P0[r]); }while(0)
  #define RESC() do{ if(resc){ asm volatile("s_waitcnt lgkmcnt(0)":::"memory"); \
      _Pragma("unroll") for(int d_=0;d_<2;++d_) _Pragma("unroll") for(int r=0;r<16;++r)o[d_][r]*=wsf[crow(r,hi)]; } }while(0)
  f32x16 pA0,pA1,pB0,pB1;
  int sl_prev=0,sl_cur=0,sl_next=SLOTB;
  #define ROT() do{sl_prev=sl_cur;sl_cur=sl_next;sl_next=(sl_next==(NSLOT-1)*SLOTB)?0:sl_next+SLOTB;}while(0)
  DMA_K(2,2*SLOTB);
  WAIT_BAR(3);
  qkt(pA0,pA1,Kbase,qr,negm,r32,hi);asm volatile("s_nop 15\n\ts_nop 7":"+v"(pA0),"+v"(pA1));CMASK(pA0,pA1,0);
  START(pA0,pA1);
  _Pragma("unroll") for(int r=0;r<16;++r)pA1[r]=__builtin_amdgcn_exp2f(pA1[r]);
  WAIT_BAR(0);
  DMA_K(3,0);DMA_V(1,SLOTB);
  ROT();
  kload8(kf,kp0+sl_cur);
  WAIT_BAR(2);
  s16x4 vlo[8],vhi[8]; u32x4 pw0,pw1,pw2,pw3;
  #define PKW(P,B) cvtpk_s(P[B],P[B+1])
  #define PAF(k) __builtin_bit_cast(bf16x8,pw##k)
  #define VFR(i) (bf16x8){vlo[i][0],vlo[i][1],vlo[i][2],vlo[i][3],vhi[i][0],vhi[i][1],vhi[i][2],vhi[i][3]}
  #define PIN(x) asm volatile("":"+v"(x))
  #define MX3(a,b,c) __builtin_fmaxf(__builtin_fmaxf((a),(b)),(c))
  #define GAPA(MF,A0,A1,A2,A3,W0,W1,PW) do{ MF; sacc+=A0; sacc+=A1; sacc+=A2; sacc+=A3; PIN(sacc); W0; W1; PIN(PW); SBAR(); }while(0)
  #define EX(v) __builtin_amdgcn_exp2f(v)
  #define GAPB(MF,X,B) do{ MF; X[B]=EX(X[B]); X[B+1]=EX(X[B+1]); X[B+2]=EX(X[B+2]); X[B+3]=EX(X[B+3]); PIN(X); SBAR(); }while(0)
  #define VRD(i) do{ vlo[i]=vtr(vp_+(((i)>>2)*4096+((i)&3)*1024)); vhi[i]=vtr(vp_+(((i)>>2)*4096+((i)&3)*1024+512)); }while(0)
  #define KRD(G,j) do{ if(G){ kload2(kf,kp0+sl_next,j); SBAR(); } }while(0)
  #define STEP(C0,C1,P0,P1,t,GK,GV,GL) do{ SBAR(); \
    const lds_cptr vp_=vp0+sl_prev; \
    VRD(0); SBAR(); float sacc=(P0[0]+P0[1]); \
    GAPA(C0=__builtin_amdgcn_mfma_f32_32x32x16_bf16(kf[0],qr[0],negm,0,0,0), P0[2],P0[3],P0[4],P0[5],     pw0[0]=PKW(P0,0), pw0[1]=PKW(P0,2), pw0); \
    VRD(4); SBAR(); GAPA(C1=__builtin_amdgcn_mfma_f32_32x32x16_bf16(kf[1],qr[0],negm,0,0,0), P0[6],P0[7],P0[8],P0[9],     pw0[2]=PKW(P0,4), pw0[3]=PKW(P0,6), pw0); \
    VRD(1); SBAR(); GAPA(C0=__builtin_amdgcn_mfma_f32_32x32x16_bf16(kf[2],qr[1],C0,0,0,0),   P0[10],P0[11],P0[12],P0[13], pw1[0]=PKW(P0,8), pw1[1]=PKW(P0,10), pw1); \
    VRD(5); SBAR(); GAPA(C1=__builtin_amdgcn_mfma_f32_32x32x16_bf16(kf[3],qr[1],C1,0,0,0),   P0[14],P0[15],P1[0],P1[1],   pw1[2]=PKW(P0,12),pw1[3]=PKW(P0,14), pw1); \
    VRD(2); SBAR(); GAPA(C0=__builtin_amdgcn_mfma_f32_32x32x16_bf16(kf[4],qr[2],C0,0,0,0),   P1[2],P1[3],P1[4],P1[5],     pw2[0]=PKW(P1,0), pw2[1]=PKW(P1,2), pw2); \
    VRD(6); SBAR(); GAPA(C1=__builtin_amdgcn_mfma_f32_32x32x16_bf16(kf[5],qr[2],C1,0,0,0),   P1[6],P1[7],P1[8],P1[9],     pw2[2]=PKW(P1,4), pw2[3]=PKW(P1,6), pw2); \
    VRD(3); SBAR(); GAPA(C0=__builtin_amdgcn_mfma_f32_32x32x16_bf16(kf[6],qr[3],C0,0,0,0),   P1[10],P1[11],P1[12],P1[13], pw3[0]=PKW(P1,8), pw3[1]=PKW(P1,10), pw3); \
    VRD(7); SBAR(); GAPA(C1=__builtin_amdgcn_mfma_f32_32x32x16_bf16(kf[7],qr[3],C1,0,0,0),   P1[14],P1[15],0.f,0.f,       pw3[2]=PKW(P1,12),pw3[3]=PKW(P1,14), pw3); \
    l_reg+=sacc; \
    if(GK){DMA_K((t)+3,sl_cur);} if(GV){DMA_V((t)+1,sl_next);} \
    CMASK(C0,C1,t); \
    { float a=MX3(C0[0],C0[1],C1[0]),b=MX3(C0[2],C0[3],C1[1]); a=MX3(a,C1[2],C1[3]); \
      _Pragma("unroll") for(int r=4;r<16;r+=4){a=MX3(a,C0[r],C0[r+1]);b=MX3(b,C0[r+2],C0[r+3]);a=MX3(a,C1[r],C1[r+1]);b=MX3(b,C1[r+2],C1[r+3]);} \
      float rm=__builtin_fmaxf(a,b); { auto rr=__builtin_amdgcn_permlane32_swap(__float_as_uint(rm),__float_as_uint(rm),false,false); rm=__builtin_fmaxf(__uint_as_float(rr[0]),__uint_as_float(rr[1])); } \
      resc=false; \
      if(__builtin_expect(__any(rm>(float)THRL),0)){ const float dl=__builtin_fmaxf(rm,0.f); mhat+=dl; \
        _Pragma("unroll") for(int r=0;r<16;++r){C0[r]-=dl;C1[r]-=dl;} \
        _Pragma("unroll") for(int r=0;r<16;++r)negm[r]=-mhat; asm volatile("":"+v"(negm)); \
        const float f=__builtin_amdgcn_exp2f(-dl); l_reg*=f; if(hi==0)wsf[r32]=f; resc=true; } } \
    SBAR(); \
    GAPB(o[0]=__builtin_amdgcn_mfma_f32_32x32x16_bf16(PAF(0),VFR(0),o[0],0,0,0), C0,0); \
    GAPB(o[1]=__builtin_amdgcn_mfma_f32_32x32x16_bf16(PAF(0),VFR(4),o[1],0,0,0), C0,4); \
    KRD(GL,0); GAPB(o[0]=__builtin_amdgcn_mfma_f32_32x32x16_bf16(PAF(1),VFR(1),o[0],0,0,0), C0,8); \
    KRD(GL,1); GAPB(o[1]=__builtin_amdgcn_mfma_f32_32x32x16_bf16(PAF(1),VFR(5),o[1],0,0,0), C0,12); \
    KRD(GL,2); GAPB(o[0]=__builtin_amdgcn_mfma_f32_32x32x16_bf16(PAF(2),VFR(2),o[0],0,0,0), C1,0); \
    KRD(GL,3); GAPB(o[1]=__builtin_amdgcn_mfma_f32_32x32x16_bf16(PAF(2),VFR(6),o[1],0,0,0), C1,4); \
    GAPB(o[0]=__builtin_amdgcn_mfma_f32_32x32x16_bf16(PAF(3),VFR(3),o[0],0,0,0), C1,8); \
    GAPB(o[1]=__builtin_amdgcn_mfma_f32_32x32x16_bf16(PAF(3),VFR(7),o[1],0,0,0), C1,12); \
    }while(0)
  int t=1;
  #undef CMASK
  #define CMASK(P0,P1,t) do{}while(0)
  for(;t+5<NT;t+=2){
    STEP(pB0,pB1,pA0,pA1,t,true,true,true);     WAIT_BAR(2); RESC(); ROT();
    STEP(pA0,pA1,pB0,pB1,t+1,true,true,true);   WAIT_BAR(2); RESC(); ROT();
  }
  #undef CMASK
  #define CMASK(P0,P1,t) do{}while(0)
  #define ENDW(tt) do{ if((tt)+3<NT){WAIT_BAR(2);} else if((tt)+2<NT){WAIT_BAR(1);} else {WAIT_BAR(0);} }while(0)
  for(;t+1<NT;t+=2){
    STEP(pB0,pB1,pA0,pA1,t,(t+3<NT),(t+1<NT),(t+1<NT));       ENDW(t);   RESC(); ROT();
    STEP(pA0,pA1,pB0,pB1,t+1,(t+4<NT),(t+2<NT),(t+2<NT));     ENDW(t+1); RESC(); ROT();
  }
  STEP(pB0,pB1,pA0,pA1,NT-1,false,false,false); RESC();
  { float sacc=pB0[0]+pB0[1]; _Pragma("unroll") for(int r=2;r<16;++r)sacc+=pB0[r]; _Pragma("unroll") for(int r=0;r<16;++r)sacc+=pB1[r]; l_reg+=sacc;
    pw0=(u32x4){PKW(pB0,0),PKW(pB0,2),PKW(pB0,4),PKW(pB0,6)};pw1=(u32x4){PKW(pB0,8),PKW(pB0,10),PKW(pB0,12),PKW(pB0,14)};pw2=(u32x4){PKW(pB1,0),PKW(pB1,2),PKW(pB1,4),PKW(pB1,6)};pw3=(u32x4){PKW(pB1,8),PKW(pB1,10),PKW(pB1,12),PKW(pB1,14)};
    SBAR(); pv(o,vb0+sl_cur,PAF(0),PAF(1),PAF(2),PAF(3)); }
  #undef PKW
  #undef PAF
  #undef VFR
  #undef PIN
  #undef MX3
  #undef GAPA
  #undef GAPB
  #undef EX
  #undef VRD
  #undef KRD
  #undef STEP
  #undef ENDW
  {auto rr=__builtin_amdgcn_permlane32_swap(__float_as_uint(l_reg),__float_as_uint(l_reg),false,false);l_reg=__uint_as_float(rr[0])+__uint_as_float(rr[1]);}
  if(hi==0)wsf[32+r32]=l_reg;asm volatile("s_waitcnt lgkmcnt(0)":::"memory");
  float rli[16];
  #pragma unroll
  for(int r=0;r<16;++r)rli[r]=__builtin_amdgcn_rcpf(wsf[32+crow(r,hi)]);
  bf16*Ow=O+(long)(q0+wid*QBLK)*OP;
  { bf16*stg=(bf16*)(shm+LDS_OST)+wid*2048;
    #pragma unroll
    for(int r=0;r<16;++r){const int orow=crow(r,hi);
      #pragma unroll
      for(int d0=0;d0<2;++d0)stg[orow*64+d0*32+r32]=__float2bfloat16(o[d0][r]*rli[r]);}
    asm volatile("s_waitcnt lgkmcnt(0)":::"memory");
    #pragma unroll
    for(int i=0;i<4;++i){const int row=i*8+(lane>>3),ch=lane&7; const u32x4 v=*(const u32x4*)(stg+row*64+ch*8); ATTN_STORE16(Ow+(long)row*OP+ch*8,v);} }
  asm volatile("s_waitcnt lgkmcnt(0)\n\ts_barrier":::"memory");
  #undef DMA_K
  #undef DMA_V
  #undef CMASK
  #undef START
  #undef RESC
  #undef ROT
}
constexpr int ATTN_LDS_BYTES=LDS_BYTES;
#undef SBAR
#undef WAIT_BAR
}
namespace xb {
#define GAS __attribute__((address_space(1)))
#define LAS __attribute__((address_space(3)))
typedef GAS unsigned gu32;
typedef GAS unsigned long long gu64;
#define RLX_AGENT __ATOMIC_RELAXED, __HIP_MEMORY_SCOPE_AGENT
#define LDS_WAIT() asm volatile("s_waitcnt lgkmcnt(0)" ::: "memory")
#define VM_WAIT() asm volatile("s_waitcnt vmcnt(0)" ::: "memory")
__device__ __forceinline__ unsigned long long rt() { return __builtin_amdgcn_s_memrealtime(); }
__device__ __forceinline__ unsigned f2bf(float f) { unsigned u = __builtin_bit_cast(unsigned, f); return (u + 0x7fffu + ((u >> 16) & 1u)) >> 16; }
__device__ __forceinline__ unsigned pk2(float lo, float hi) { return f2bf(lo) | (f2bf(hi) << 16); }

#define XB_TMO      128
#define XB_XCNT(j)  (256  + 64 * (j))
#define XB_XSUB(j)  (1280 + 64 * (j))
#define XB_XGEN(j)  (2304 + 64 * (j))
#define XB_TOP      3328
#define XB_TOPGEN   3392
#define XCD_BAR_WORDS 3456
#define XB_SPIN_CAP (1u << 18)

__device__ __forceinline__ unsigned xb_ld(unsigned* p)              { return __hip_atomic_load(p, __ATOMIC_RELAXED, __HIP_MEMORY_SCOPE_AGENT); }
__device__ __forceinline__ unsigned xb_add(unsigned* p, unsigned v) { return __hip_atomic_fetch_add(p, v, __ATOMIC_RELAXED, __HIP_MEMORY_SCOPE_AGENT); }
__device__ __forceinline__ unsigned xb_xcc_id() { return (unsigned)__builtin_amdgcn_s_getreg((3 << 11) | 20) & 0xFu; }
#define XB_SPIN(cond, bar) do { unsigned _sp = 0; while (cond) { __builtin_amdgcn_s_sleep(1); \
    if ((++_sp & 255u) == 0u) { if (xb_ld(&(bar)[XB_TMO])) break; if (_sp > XB_SPIN_CAP) { atomicAdd(&(bar)[XB_TMO], 1u); break; } } } } while (0)

struct XcdBarrier {
    unsigned* bar; unsigned x;
    volatile LAS unsigned* st;
};

__device__ __forceinline__ XcdBarrier xcd_barrier_post(unsigned* bar, volatile LAS unsigned* st) {
    XcdBarrier b; b.bar = bar; b.x = xb_xcc_id(); b.st = st;
    if (threadIdx.x == 0) (void)xb_add(&bar[XB_XCNT(b.x)], 1u);
    return b;
}
__device__ __forceinline__ void xcd_barrier_complete(unsigned* bar, unsigned x, unsigned& nloc, unsigned& nx) {
    const unsigned G = gridDim.x * gridDim.y * gridDim.z;
    unsigned sum, cnt, mine, sp = 0u;
    for (;;) {
        sum = 0u; cnt = 0u; mine = 0u;
#pragma unroll
        for (unsigned j = 0; j < 16; ++j) { const unsigned c = xb_ld(&bar[XB_XCNT(j)]); sum += c; cnt += (c > 0u) ? 1u : 0u; mine = (j == x) ? c : mine; }
        if (sum == G) break;
        __builtin_amdgcn_s_sleep(1);
        if ((++sp & 255u) == 0u) { if (xb_ld(&bar[XB_TMO])) break; if (sp > XB_SPIN_CAP) { atomicAdd(&bar[XB_TMO], 1u); break; } }
    }
    nloc = mine > 0u ? mine : 1u; nx = cnt > 0u ? cnt : 1u;
}

__device__ __forceinline__ void xcd_barrier(const XcdBarrier& b) {
    asm volatile("s_waitcnt vmcnt(0)" ::: "memory");
    __syncthreads();
    if (threadIdx.x == 0) {
        unsigned* bar = b.bar;
        __builtin_amdgcn_s_waitcnt(0);
        unsigned nloc = b.st[0], nx = b.st[1];
        if (nloc == 0u) { xcd_barrier_complete(bar, b.x, nloc, nx); b.st[0] = nloc; b.st[1] = nx; }
        const unsigned old = xb_add(&bar[XB_XSUB(b.x)], 1u);
        const unsigned gen = old / nloc;
        if (old + 1u == (gen + 1u) * nloc) {
            __builtin_amdgcn_fence(__ATOMIC_RELEASE, "agent");
            asm volatile("s_waitcnt vmcnt(0)" ::: "memory");
            const unsigned og = xb_add(&bar[XB_TOP], 1u);
            const unsigned tg = og / nx;
            if (og + 1u == (tg + 1u) * nx) xb_add(&bar[XB_TOPGEN], 1u);
            else XB_SPIN(xb_ld(&bar[XB_TOPGEN]) == tg, bar);
            __builtin_amdgcn_fence(__ATOMIC_ACQUIRE, "agent");
            xb_add(&bar[XB_XGEN(b.x)], 1u);
            asm volatile("s_waitcnt vmcnt(0)" ::: "memory");
        } else {
            XB_SPIN(xb_ld(&bar[XB_XGEN(b.x)]) == gen, bar);
            __builtin_amdgcn_fence(__ATOMIC_ACQUIRE, "agent");
            asm volatile("s_waitcnt vmcnt(0)" ::: "memory");
        }
    }
    __syncthreads();
}

}

namespace mk {
typedef unsigned short bf16_t;
typedef short bf16x8 __attribute__((ext_vector_type(8)));
typedef float f32x4 __attribute__((ext_vector_type(4)));
typedef unsigned u32x4 __attribute__((ext_vector_type(4)));
typedef unsigned u32x2 __attribute__((ext_vector_type(2)));
typedef float f32x2 __attribute__((ext_vector_type(2)));

constexpr int DMODEL = 1024, TS = 16384, NSEG = 4, DFF = 4096;
constexpr int EIN = 1792, OIN = 4368, OINP = 4608, OOUT = 768;
constexpr float EPS = 1e-6f;
constexpr size_t MiB = (size_t)1 << 20;
constexpr size_t WS_W1T = 1 * MiB, WS_W2T = 33 * MiB, WS_WINE = 65 * MiB, WS_WOUTE = 72 * MiB, WS_WINO = 76 * MiB, WS_WOUTO = 94 * MiB,
                 WS_GW = 97 * MiB, WS_H = 98 * MiB, WS_PROJ = 130 * MiB, WS_SCR = 274 * MiB, WS_END = 512 * MiB;
constexpr size_t SC_HID = 0;
constexpr size_t SC_LA = 0, SC_UU = 64 * MiB, SC_AGG = 128 * MiB;
constexpr size_t SC_QKVP = 0, SC_DNI = 48 * MiB, SC_OB = 192 * MiB, SC_LSE = 224 * MiB, SC_EGL = 225 * MiB;
constexpr int DNI_BYTES = 73728, DNI_W = 0, DNI_QT = 16384, DNI_KTT = 32768, DNI_A = 49152, DNI_U = 57344;
constexpr int LDS_BYTES = 147456;
constexpr int NT = 512, NW = 8;

struct Params { const float* in[25]; float* out; unsigned char* ws; };

__device__ __forceinline__ float bf2f(bf16_t v) { return __uint_as_float(((unsigned)v) << 16); }
__device__ __forceinline__ unsigned f2bf(float f) { unsigned u = __float_as_uint(f); return (u + 0x7fffu + ((u >> 16) & 1u)) >> 16; }
__device__ __forceinline__ unsigned pk2(float lo, float hi) { return f2bf(lo) | (f2bf(hi) << 16); }
__device__ __forceinline__ float wave_sum(float v) {
#pragma unroll
    for (int o = 1; o < 64; o <<= 1) v += __shfl_xor(v, o);
    return v;
}
__device__ __forceinline__ float sigm(float x) { return 1.f / (1.f + __expf(-x)); }
__device__ __forceinline__ float softplus(float x) { return x > 20.f ? x : log1pf(__expf(x)); }
__device__ __forceinline__ float silu(float x) { return x * sigm(x); }
__device__ __forceinline__ float gelu_tanh(float x) { const float t = 0.7978845608028654f * (x + 0.044715f * x * x * x); return 0.5f * x * (1.f + tanhf(t)); }
__device__ __forceinline__ void unpack8(const u32x4 v, float* f) {
    f[0] = __uint_as_float(v.x << 16); f[1] = __uint_as_float(v.x & 0xffff0000u); f[2] = __uint_as_float(v.y << 16); f[3] = __uint_as_float(v.y & 0xffff0000u);
    f[4] = __uint_as_float(v.z << 16); f[5] = __uint_as_float(v.z & 0xffff0000u); f[6] = __uint_as_float(v.w << 16); f[7] = __uint_as_float(v.w & 0xffff0000u);
}
#define MK_IDS() int tid = threadIdx.x; asm volatile("" : "+v"(tid)); const int lane = tid & 63, wave = __builtin_amdgcn_readfirstlane(tid >> 6); const int gw = blockIdx.x * NW + wave, NGW = gridDim.x * NW; (void)lane; (void)wave; (void)gw; (void)NGW
#define MFMA16(a, b, c) __builtin_amdgcn_mfma_f32_16x16x32_bf16((a), (b), (c), 0, 0, 0)

__device__ __forceinline__ void transpose_item(const float* W, int K, int Nsrc, int Npad, bf16_t* WT, float* scr, int item, int lane, const float* gain = nullptr) {
    const int nblk = Npad / 32, kb = item / nblk, nb = item % nblk, k0 = 64 * kb, n0 = 32 * nb;
    const int n = n0 + (lane & 31);
#pragma unroll 8
    for (int i = 0; i < 32; ++i) { const int kk = 2 * i + (lane >> 5); scr[kk * 33 + (lane & 31)] = (n < Nsrc) ? W[(size_t)(k0 + kk) * Nsrc + n] * (gain ? gain[k0 + kk] : 1.f) : 0.f; }
    asm volatile("s_waitcnt lgkmcnt(0)" ::: "memory");
    const int c = lane & 7;
#pragma unroll
    for (int j = 0; j < 4; ++j) { const int nn = (lane >> 3) + 8 * j; const float* s = scr + (8 * c) * 33 + nn;
        u32x4 o; o.x = pk2(s[0 * 33], s[1 * 33]); o.y = pk2(s[2 * 33], s[3 * 33]); o.z = pk2(s[4 * 33], s[5 * 33]); o.w = pk2(s[6 * 33], s[7 * 33]);
        *(u32x4*)(WT + (size_t)(n0 + nn) * K + k0 + 8 * c) = o; }
    asm volatile("s_waitcnt lgkmcnt(0)" ::: "memory");
}
__device__ __forceinline__ void phase_prologue(const Params& p, char* lds) {
    MK_IDS();
    float* scr = (float*)(lds + wave * 16384);
    unsigned char* ws = p.ws;
    constexpr int I_F1 = 16 * 128, I_F2 = 64 * 32, I_IE = 16 * 56, I_OE = 16 * 32, I_IO = 16 * 144, I_OO = 12 * 32;
    constexpr int T_F1 = 4 * I_F1, T_F2 = T_F1 + 4 * I_F2, T_IE = T_F2 + 2 * I_IE, T_OE = T_IE + 2 * I_OE, T_IO = T_OE + 2 * I_IO, T_OO = T_IO + 2 * I_OO;
    for (int it = gw; it < T_OO; it += NGW) {
        if (it < T_F1) { const int l = it / I_F1, r = it % I_F1; transpose_item(p.in[6] + (size_t)l * 1024 * 4096, 1024, 4096, 4096, (bf16_t*)(ws + WS_W1T) + (size_t)l * 4096 * 1024, scr, r, lane, p.in[4] + l * 1024); }
        else if (it < T_F2) { const int q = it - T_F1, l = q / I_F2, r = q % I_F2; transpose_item(p.in[7] + (size_t)l * 4096 * 1024, 4096, 1024, 1024, (bf16_t*)(ws + WS_W2T) + (size_t)l * 1024 * 4096, scr, r, lane); }
        else if (it < T_IE) { const int q = it - T_F2, l = q / I_IE, r = q % I_IE; transpose_item(p.in[8] + (size_t)l * 1024 * EIN, 1024, EIN, EIN, (bf16_t*)(ws + WS_WINE) + (size_t)l * EIN * 1024, scr, r, lane, p.in[3] + (2 * l) * 1024); }
        else if (it < T_OE) { const int q = it - T_IE, l = q / I_OE, r = q % I_OE; transpose_item(p.in[9] + (size_t)l * 1024 * 1024, 1024, 1024, 1024, (bf16_t*)(ws + WS_WOUTE) + (size_t)l * 1024 * 1024, scr, r, lane); }
        else if (it < T_IO) { const int q = it - T_OE, l = q / I_IO, r = q % I_IO; transpose_item(p.in[19] + (size_t)l * 1024 * OIN, 1024, OIN, OINP, (bf16_t*)(ws + WS_WINO) + (size_t)l * OINP * 1024, scr, r, lane, p.in[3] + (2 * l + 1) * 1024); }
        else { const int q = it - T_IO, l = q / I_OO, r = q % I_OO; transpose_item(p.in[20] + (size_t)l * OOUT * 1024, OOUT, 1024, 1024, (bf16_t*)(ws + WS_WOUTO) + (size_t)l * 1024 * OOUT, scr, r, lane); }
    }
    bf16_t* GW = (bf16_t*)(ws + WS_GW);
    const int gt = gw * 64 + lane, NGT = NGW * 64;
    for (int idx = gt; idx < 2 * 2 * 2 * 8 * 4096; idx += NGT) {
        const int d = idx & 63, e = (idx >> 6) & 63, blk = (idx >> 12) & 7, gate = (idx >> 15) & 1, dir = (idx >> 16) & 1, j = (idx >> 17) & 1;
        const float* src = gate ? p.in[16] : p.in[14];
        GW[idx] = (bf16_t)f2bf(src[((((size_t)j * 2 + dir) * 8 + blk) * 64 + d) * 64 + e]);
    }
}

__device__ __forceinline__ void phase_x0(const float* x, bf16_t* xb, float* ssq) {
    MK_IDS();
    for (int m = gw; m < TS; m += NGW) {
        const f32x4* xr = (const f32x4*)(x + (size_t)m * DMODEL) + lane;
        f32x4 v[4]; float s = 0.f;
#pragma unroll
        for (int j = 0; j < 4; ++j) { v[j] = xr[64 * j]; s += (v[j].x * v[j].x + v[j].y * v[j].y) + (v[j].z * v[j].z + v[j].w * v[j].w); }
        s = wave_sum(s);
        u32x2* o8 = (u32x2*)(xb + (size_t)m * DMODEL) + lane;
#pragma unroll
        for (int j = 0; j < 4; ++j) { u32x2 o; o.x = pk2(v[j].x, v[j].y); o.y = pk2(v[j].z, v[j].w); o8[64 * j] = o; }
        if (lane < 16) ssq[(size_t)m * 16 + lane] = lane == 0 ? s : 0.f;
    }
}
__device__ __forceinline__ void zero_f32(float* ptr, int n) {
    MK_IDS();
    for (int i = gw * 64 + lane; i < n; i += NGW * 64) ptr[i] = 0.f;
}
__device__ __forceinline__ void phase_rmsnorm_final(const bf16_t* xb, float* x, const float* g) {
    MK_IDS();
    for (int m = gw; m < TS; m += NGW) {
        const u32x2* xr = (const u32x2*)(xb + (size_t)m * DMODEL) + lane; f32x4* xw = (f32x4*)(x + (size_t)m * DMODEL) + lane; const f32x4* gr = (const f32x4*)g + lane;
        f32x4 v[4]; float s = 0.f;
#pragma unroll
        for (int j = 0; j < 4; ++j) { const u32x2 w = xr[64 * j]; v[j] = (f32x4){__uint_as_float(w.x << 16), __uint_as_float(w.x & 0xffff0000u), __uint_as_float(w.y << 16), __uint_as_float(w.y & 0xffff0000u)};
            s += (v[j].x * v[j].x + v[j].y * v[j].y) + (v[j].z * v[j].z + v[j].w * v[j].w); }
        const float rstd = 1.f / sqrtf(wave_sum(s) * (1.f / DMODEL) + EPS);
#pragma unroll
        for (int j = 0; j < 4; ++j) { const f32x4 gg = gr[64 * j]; xw[64 * j] = v[j] * rstd * gg; }
    }
}
struct EpiRes {
    static constexpr bool PERM = true, AFTER_DRAIN = false;
    bf16_t* xb; float* ssq; int ldc; const float* sin;
    __device__ __forceinline__ void operator()(const pg8::f32x4 (&acc)[2][2][4][2], const pg8::Unit& u, int wr, int wc, int fr, int fq) const {
        const int col0 = u.pn * pg8::BM + wc * 32 + 8 * fq;
        float rs2a[2][4];
        if (sin) { pg8::f32x4 t_[2][4];
#pragma unroll
            for (int ai = 0; ai < 2; ++ai)
#pragma unroll
                for (int m = 0; m < 4; ++m) t_[ai][m] = *(const pg8::f32x4*)(sin + (size_t)(u.pm * pg8::BM + ai * pg8::HALF + wr * 64 + m * 16 + fr) * 16 + fq * 4);
#pragma unroll
            for (int ai = 0; ai < 2; ++ai)
#pragma unroll
                for (int m = 0; m < 4; ++m) { float s_ = (t_[ai][m][0] + t_[ai][m][1]) + (t_[ai][m][2] + t_[ai][m][3]); s_ += __shfl_xor(s_, 16); s_ += __shfl_xor(s_, 32); rs2a[ai][m] = __builtin_amdgcn_rcpf(s_ * (1.0f / 1024.0f) + 1e-6f); }
        } else {
#pragma unroll
            for (int ai = 0; ai < 2; ++ai)
#pragma unroll
                for (int m = 0; m < 4; ++m) rs2a[ai][m] = 1.f; }
#pragma unroll
        for (int ai = 0; ai < 2; ++ai)
#pragma unroll
            for (int m = 0; m < 4; ++m) { const int row = u.pm * pg8::BM + ai * pg8::HALF + wr * 64 + m * 16 + fr; const size_t off = (size_t)row * ldc + col0; float sq = 0.f;
                const float rs2 = rs2a[ai][m];
                u32x4 bw[2];
#pragma unroll
                for (int bj = 0; bj < 2; ++bj) bw[bj] = *(const u32x4*)(xb + off + bj * pg8::HALF);
#pragma unroll
                for (int bj = 0; bj < 2; ++bj) { float b[8]; unpack8(bw[bj], b); const pg8::f32x4 a0 = acc[ai][bj][m][0] * rs2, a1 = acc[ai][bj][m][1] * rs2;
                    const float o0 = b[0] + a0[0], o1 = b[1] + a0[1], o2 = b[2] + a0[2], o3 = b[3] + a0[3], o4 = b[4] + a1[0], o5 = b[5] + a1[1], o6 = b[6] + a1[2], o7 = b[7] + a1[3];
                    u32x4 w; w.x = pg8::cvt_pk_bf16(o0, o1); w.y = pg8::cvt_pk_bf16(o2, o3); w.z = pg8::cvt_pk_bf16(o4, o5); w.w = pg8::cvt_pk_bf16(o6, o7);
                    *(u32x4*)(xb + off + bj * pg8::HALF) = w;
                    sq += ((o0 * o0 + o1 * o1) + (o2 * o2 + o3 * o3)) + ((o4 * o4 + o5 * o5) + (o6 * o6 + o7 * o7)); }
                sq += __shfl_xor(sq, 16); sq += __shfl_xor(sq, 32);
                if (fq == 0) ssq[(size_t)row * 16 + u.pn * 4 + wc] = sq;
                if (m & 1) asm volatile("" ::: "memory"); }
    }
};

__device__ __forceinline__ void even_qk_post(bf16_t* proj, const float* qg, const float* kg, int S) {
    MK_IDS();
    const int g = lane & 7, axis = g >> 2, half = (g >> 1) & 1;
    float inv[8], gq[8], gk[8];
#pragma unroll
    for (int e = 0; e < 8; ++e) { inv[e] = exp2f(-(float)((g & 1) * 8 + e) * (13.287712379549449f / 16.f)); gq[e] = qg[g * 8 + e] * attn_body::C2; gk[e] = kg[g * 8 + e]; }
    for (int t = gw; t < TS; t += NGW) {
        const int s = t % S; const float pos = (float)(axis ? (s & 63) : (s >> 6));
        bf16_t* row = proj + (size_t)t * EIN;
        const u32x4 qa = *(const u32x4*)(row + lane * 8); u32x4 ka = {0u, 0u, 0u, 0u}; if (lane < 16) ka = *(const u32x4*)(row + 512 + lane * 8);
        float cs[8], sn[8];
#pragma unroll
        for (int e = 0; e < 8; ++e) { const float ang = pos * inv[e]; cs[e] = __cosf(ang); sn[e] = __sinf(ang); }
        float xq[8], xk[8]; unpack8(qa, xq); unpack8(ka, xk);
        float sq = 0.f, sk = 0.f;
#pragma unroll
        for (int e = 0; e < 8; ++e) { sq += xq[e] * xq[e]; sk += xk[e] * xk[e]; }
        sq += __shfl_xor(sq, 1); sq += __shfl_xor(sq, 2); sq += __shfl_xor(sq, 4);
        sk += __shfl_xor(sk, 1); sk += __shfl_xor(sk, 2); sk += __shfl_xor(sk, 4);
        const float rq = __builtin_amdgcn_rsqf(sq * (1.f / 64.f) + EPS), rk = __builtin_amdgcn_rsqf(sk * (1.f / 64.f) + EPS);
        float oq[8], ok[8];
#pragma unroll
        for (int e = 0; e < 8; ++e) { const float yq = xq[e] * rq * gq[e], yk = xk[e] * rk * gk[e];
            const float pq = __shfl_xor(yq, 2), pk = __shfl_xor(yk, 2);
            oq[e] = yq * cs[e] + (half ? pq : -pq) * sn[e]; ok[e] = yk * cs[e] + (half ? pk : -pk) * sn[e]; }
        u32x4 o; o.x = pk2(oq[0], oq[1]); o.y = pk2(oq[2], oq[3]); o.z = pk2(oq[4], oq[5]); o.w = pk2(oq[6], oq[7]);
        *(u32x4*)(row + lane * 8) = o;
        if (lane < 16) { u32x4 o2; o2.x = pk2(ok[0], ok[1]); o2.y = pk2(ok[2], ok[3]); o2.z = pk2(ok[4], ok[5]); o2.w = pk2(ok[6], ok[7]); *(u32x4*)(row + 512 + lane * 8) = o2; }
    }
}
__device__ __forceinline__ void even_lru_prep(const bf16_t* proj, const float* cw, const float* cb, const bf16_t* GWj, const float* br, const float* bi, const float* lam,
                                              unsigned* LU, f32x2* AGG, int S, char* lds) {
    MK_IDS();
    constexpr int XST = 1040;
    for (int tile = blockIdx.x; tile < TS / 64; tile += gridDim.x) {
        const int t0 = tile * 64;
        __syncthreads();
#pragma unroll 2
        for (int k = 0; k < 8; ++k) {
            const int idx = tid + k * NT, i = idx >> 6, cgp = idx & 63, t = t0 + i, s = t % S, ch = cgp * 8;
            float acc[8];
#pragma unroll
            for (int e = 0; e < 8; ++e) acc[e] = cb[ch + e];
#pragma unroll
            for (int j = 0; j < 4; ++j) { const int sp = s + j - 2;
                if (sp >= 0 && sp < S) { const u32x4 v = *(const u32x4*)(proj + (size_t)(t + j - 2) * EIN + 768 + ch); float xv[8]; unpack8(v, xv);
#pragma unroll
                    for (int e = 0; e < 8; ++e) acc[e] += cw[j * 512 + ch + e] * xv[e]; } }
            u32x4 o; o.x = pk2(acc[0], acc[1]); o.y = pk2(acc[2], acc[3]); o.z = pk2(acc[4], acc[5]); o.w = pk2(acc[6], acc[7]);
            *(u32x4*)(lds + i * XST + ch * 2) = o;
        }
        __syncthreads();
        const int G = lane >> 4, l16 = lane & 15, ch0 = wave * 64;
        for (int dir = 0; dir < 2; ++dir)
            for (int nt = 0; nt < 4; ++nt) {
                const int e = nt * 16 + l16, ch = ch0 + e;
                bf16x8 Br[2], Bi[2];
#pragma unroll
                for (int kk = 0; kk < 2; ++kk) {
                    Br[kk] = *(const bf16x8*)(GWj + ((((size_t)dir * 2 + 0) * 8 + wave) * 64 + e) * 64 + kk * 32 + G * 8);
                    Bi[kk] = *(const bf16x8*)(GWj + ((((size_t)dir * 2 + 1) * 8 + wave) * 64 + e) * 64 + kk * 32 + G * 8);
                }
                const float brv = br[dir * 512 + ch], biv = bi[dir * 512 + ch], spl = softplus(-lam[dir * 512 + ch]);
#pragma unroll
                for (int mt = 0; mt < 4; ++mt) {
                    f32x4 ar = {0.f, 0.f, 0.f, 0.f}, ai = {0.f, 0.f, 0.f, 0.f};
#pragma unroll
                    for (int kk = 0; kk < 2; ++kk) { const bf16x8 a = *(const bf16x8*)(lds + (mt * 16 + l16) * XST + (ch0 + kk * 32 + G * 8) * 2); ar = MFMA16(a, Br[kk], ar); ai = MFMA16(a, Bi[kk], ai); }
#pragma unroll
                    for (int r = 0; r < 4; ++r) { const int i = mt * 16 + G * 4 + r;
                        const float xc = bf2f(*(const bf16_t*)(lds + i * XST + ch * 2));
                        const float rg = __builtin_amdgcn_rcpf(1.f + __expf(-(ar[r] + brv))), ig = __builtin_amdgcn_rcpf(1.f + __expf(-(ai[r] + biv)));
                        const float la = -8.f * rg * spl; const float uu = __builtin_amdgcn_sqrtf(fmaxf(1.f - __expf(2.f * la), 0.f)) * (ig * xc);
                        LU[((size_t)dir * TS + t0 + i) * 512 + ch] = attn_body::cvtpk_s(la, uu); }
                }
            }
        asm volatile("s_waitcnt vmcnt(0)" ::: "memory");
        __syncthreads();
        {
            const int ch = tid;
#pragma unroll
            for (int dir = 0; dir < 2; ++dir) {
                float h = 0.f, P = 0.f;
                const unsigned* lu = LU + ((size_t)dir * TS + t0) * 512 + ch;
#pragma unroll
                for (int q = 0; q < 64; q += 8) {
                    float lv[8], uv[8];
#pragma unroll
                    for (int e = 0; e < 8; ++e) { const int i = dir ? 63 - (q + e) : q + e; const unsigned w_ = lu[(size_t)i * 512]; lv[e] = __uint_as_float(w_ << 16); uv[e] = __uint_as_float(w_ & 0xffff0000u); }
#pragma unroll
                    for (int e = 0; e < 8; ++e) { h = __expf(lv[e]) * h + uv[e]; P += lv[e]; }
                }
                AGG[((size_t)dir * (TS / 64) + tile) * 512 + ch] = (f32x2){P, h};
            }
        }
    }
}
__device__ __forceinline__ void even_lru_scan(const unsigned* LU, const f32x2* AGG, const bf16_t* proj, bf16_t* Y, int S) {
    MK_IDS();
    const int ch = tid, TPB = S / 64;
    for (int tile = blockIdx.x; tile < TS / 64; tile += gridDim.x) {
        const int t0 = tile * 64, tb0 = (tile / TPB) * TPB;
        float cf = 0.f, cr = 0.f;
        for (int k0 = tb0; k0 < tile; k0 += 8) { f32x2 a[8];
#pragma unroll
            for (int q = 0; q < 8; ++q) { const int k = k0 + q < tile ? k0 + q : tile - 1; a[q] = AGG[(size_t)k * 512 + ch]; }
#pragma unroll
            for (int q = 0; q < 8; ++q) if (k0 + q < tile) cf = cf * __expf(a[q].x) + a[q].y; }
        for (int k0 = tb0 + TPB - 1; k0 > tile; k0 -= 8) { f32x2 a[8];
#pragma unroll
            for (int q = 0; q < 8; ++q) { const int k = k0 - q > tile ? k0 - q : tile + 1; a[q] = AGG[((size_t)(TS / 64) + k) * 512 + ch]; }
#pragma unroll
            for (int q = 0; q < 8; ++q) if (k0 - q > tile) cr = cr * __expf(a[q].x) + a[q].y; }
        float hf[64];
        {
            const unsigned* lu = LU + (size_t)t0 * 512 + ch; float h = cf;
#pragma unroll
            for (int q = 0; q < 64; q += 8) {
                float lv[8], uv[8];
#pragma unroll
                for (int e = 0; e < 8; ++e) { const unsigned w_ = lu[(size_t)(q + e) * 512]; lv[e] = __uint_as_float(w_ << 16); uv[e] = __uint_as_float(w_ & 0xffff0000u); }
#pragma unroll
                for (int e = 0; e < 8; ++e) { h = __expf(lv[e]) * h + uv[e]; hf[q + e] = h; }
            }
        }
        {
            const unsigned* lu = LU + ((size_t)TS + t0) * 512 + ch; float h = cr;
#pragma unroll
            for (int q = 0; q < 64; q += 8) {
                float lv[8], uv[8], gv[8];
#pragma unroll
                for (int e = 0; e < 8; ++e) { const int i = 63 - (q + e); { const unsigned w_ = lu[(size_t)i * 512]; lv[e] = __uint_as_float(w_ << 16); uv[e] = __uint_as_float(w_ & 0xffff0000u); } gv[e] = bf2f(proj[(size_t)(t0 + i) * EIN + 1280 + ch]); }
#pragma unroll
                for (int e = 0; e < 8; ++e) { const int i = 63 - (q + e); h = __expf(lv[e]) * h + uv[e]; Y[(size_t)(t0 + i) * DMODEL + 512 + ch] = (bf16_t)f2bf((hf[i] + h) * gelu_tanh(gv[e])); }
            }
        }
    }
}

__device__ __forceinline__ void odd_conv(const bf16_t* proj, const float* cw, bf16_t* QKVP, int S) {
    MK_IDS();
    for (int cr = 0; cr < (TS / 64 + (int)gridDim.x - 1) / (int)gridDim.x; ++cr) {
        const int c = cr * (int)gridDim.x + (int)blockIdx.x; if (c >= TS / 64) break;
        const int tb = c * 64 + wave * 8, sb = tb % S;
#pragma unroll
        for (int blk = 0; blk < 3; ++blk) {
            const int ch = blk * 512 + lane * 8;
            u32x4 rows[11];
#pragma unroll
            for (int q = 0; q < 11; ++q) { const int sp = sb + q - 2; rows[q] = (u32x4){0u, 0u, 0u, 0u};
                if (sp >= 0 && sp < S) rows[q] = *(const u32x4*)(proj + (size_t)(tb + q - 2) * OINP + ch); }
            f32x4 w0[4], w1[4];
#pragma unroll
            for (int j = 0; j < 4; ++j) { w0[j] = *(const f32x4*)(cw + j * 1536 + ch); w1[j] = *(const f32x4*)(cw + j * 1536 + ch + 4); }
#pragma unroll
            for (int i = 0; i < 8; ++i) {
                float acc[8];
#pragma unroll
                for (int e = 0; e < 8; ++e) acc[e] = 0.f;
#pragma unroll
                for (int j = 0; j < 4; ++j) { float xv[8]; unpack8(rows[i + j], xv);
                    acc[0] += w0[j].x * xv[0]; acc[1] += w0[j].y * xv[1]; acc[2] += w0[j].z * xv[2]; acc[3] += w0[j].w * xv[3];
                    acc[4] += w1[j].x * xv[4]; acc[5] += w1[j].y * xv[5]; acc[6] += w1[j].z * xv[6]; acc[7] += w1[j].w * xv[7]; }
                float ss = 0.f;
#pragma unroll
                for (int e = 0; e < 8; ++e) { acc[e] = silu(acc[e]); ss += acc[e] * acc[e]; }
                if (blk < 2) {
                    ss += __shfl_xor(ss, 1); ss += __shfl_xor(ss, 2); ss += __shfl_xor(ss, 4); ss += __shfl_xor(ss, 8);
                    const float rn = __builtin_amdgcn_rsqf(ss + EPS);
#pragma unroll
                    for (int e = 0; e < 8; ++e) acc[e] *= rn;
                }
                u32x4 o; o.x = pk2(acc[0], acc[1]); o.y = pk2(acc[2], acc[3]); o.z = pk2(acc[4], acc[5]); o.w = pk2(acc[6], acc[7]);
                *(u32x4*)(QKVP + (size_t)(tb + i) * 1536 + ch) = o;
            }
        }
    }
}

__device__ __forceinline__ int frag128(int r, int k) { return ((((r >> 4) * 4 + (k >> 5)) * 64 + ((k >> 3) & 3) * 16 + (r & 15)) << 3) + (k & 7); }
__device__ __forceinline__ int frag64(int r, int k) { return ((((r >> 4) * 2 + (k >> 5)) * 64 + ((k >> 3) & 3) * 16 + (r & 15)) << 3) + (k & 7); }
__device__ __forceinline__ void odd_prep(const bf16_t* QKVP, const bf16_t* proj, const float* alog, const float* dtb, unsigned char* DNI, float* EGL, char* lds) {
    MK_IDS();
    constexpr int RS = 272;
    constexpr int HOFF = 69632;
    const float scale = 0.08838834764831845f;
    for (int itq = 0; itq < (TS / 64 + (int)gridDim.x - 1) / (int)gridDim.x * 4; ++itq) {
        const int c_ = (itq >> 2) * (int)gridDim.x + (int)blockIdx.x; if (c_ >= TS / 64) break; const int it0 = (c_ * 4 + (itq & 3)) * 2;
        int tq_ = tid; asm volatile("" : "+v"(tq_));
        const int half = tq_ >> 8, ht = tq_ & 255, hwave = __builtin_amdgcn_readfirstlane(ht >> 6), G = (tq_ & 63) >> 4, l16 = tq_ & 15;
        char* L = lds + half * HOFF;
        char* KS = L, *QS = L + 17408, *VS = L + 34816; float* LM = (float*)(L + 52224); float* GC = (float*)(L + 68608); float* BT = GC + 64; float* EG = BT + 64;
        const int it = it0 + half; const int d = it & 1, h = (it >> 1) & 3, c = it >> 3, t0 = c * 64;
        __syncthreads();
#pragma unroll
        for (int k = 0; k < 4; ++k) { const int idx = ht + k * 256, i = idx >> 4, pc = idx & 15; const int tk = d ? t0 + 63 - i : t0 + i;
            const bf16_t* src = QKVP + (size_t)tk * 1536 + h * 128 + pc * 8;
            *(u32x4*)(QS + i * RS + pc * 16) = *(const u32x4*)(src);
            *(u32x4*)(KS + i * RS + pc * 16) = *(const u32x4*)(src + 512);
            *(u32x4*)(VS + i * RS + pc * 16) = *(const u32x4*)(src + 1024); }
        if (hwave == 0) {
            const int i = lane; const int tk = d ? t0 + 63 - i : t0 + i;
            const float bl = bf2f(proj[(size_t)tk * OINP + 2048 + d * 4 + h]), al = bf2f(proj[(size_t)tk * OINP + 2056 + d * 4 + h]);
            const float beta = sigm(bl); float g = -__expf(alog[d * 4 + h]) * softplus(al + dtb[d * 4 + h]);
#pragma unroll
            for (int o = 1; o < 64; o <<= 1) { const float v = __shfl_up(g, o); if (lane >= o) g += v; }
            GC[i] = g; BT[i] = beta; EG[i] = __expf(g);
        }
        __syncthreads();
        {
            const bool isq = hwave >= 2; const char* XS = isq ? QS : KS;
#pragma unroll
            for (int mm = 0; mm < 2; ++mm) { const int mt = (hwave & 1) * 2 + mm;
                bf16x8 a[4];
#pragma unroll
                for (int kk = 0; kk < 4; ++kk) a[kk] = *(const bf16x8*)(XS + (mt * 16 + l16) * RS + (kk * 32 + G * 8) * 2);
#pragma unroll
                for (int nt = 0; nt < 4; ++nt) { f32x4 acc = {0.f, 0.f, 0.f, 0.f};
#pragma unroll
                    for (int kk = 0; kk < 4; ++kk) { const bf16x8 bb = *(const bf16x8*)(KS + (nt * 16 + l16) * RS + (kk * 32 + G * 8) * 2); acc = MFMA16(a[kk], bb, acc); }
                    const int j = nt * 16 + l16; const float gj = GC[j];
#pragma unroll
                    for (int r = 0; r < 4; ++r) { const int i = mt * 16 + G * 4 + r; const float dec = __expf(fminf(GC[i] - gj, 0.f));
                        if (!isq) LM[i * 64 + j] = (j < i) ? BT[i] * acc[r] * dec : 0.f;
                        else ((bf16_t*)(DNI + (size_t)it * DNI_BYTES + DNI_A))[frag64(i, j)] = (bf16_t)f2bf((j <= i) ? acc[r] * scale * dec : 0.f); }
                }
            }
        }
        __syncthreads();
        {
            float sol[64];
            const int cc = ht & 127; const bool isw = ht >= 128; const char* XS = isw ? KS : VS;
#pragma unroll
            for (int i = 0; i < 64; ++i) {
                float v = bf2f(*(const bf16_t*)(XS + i * RS + cc * 2)) * BT[i]; if (isw) v *= EG[i];
                float a0 = 0.f, a1 = 0.f;
#pragma unroll
                for (int j4 = 0; j4 < (i + 3) / 4; ++j4) { const f32x4 l4 = *(const f32x4*)(LM + i * 64 + j4 * 4);
                    if (j4 * 4 + 0 < i) a0 += l4.x * sol[j4 * 4 + 0]; if (j4 * 4 + 1 < i) a1 += l4.y * sol[j4 * 4 + 1];
                    if (j4 * 4 + 2 < i) a0 += l4.z * sol[j4 * 4 + 2]; if (j4 * 4 + 3 < i) a1 += l4.w * sol[j4 * 4 + 3];
                    if ((j4 & 1) == 1) asm volatile("" ::: "memory"); }
                v -= a0 + a1;
                sol[i] = v;
                ((bf16_t*)(DNI + (size_t)it * DNI_BYTES + (isw ? DNI_W : DNI_U)))[isw ? frag128(i, cc) : i * 128 + cc] = (bf16_t)f2bf(v);
                asm volatile("" ::: "memory");
            }
        }
        {
            const float gl = GC[63];
#pragma unroll
            for (int k = 0; k < 4; ++k) { const int idx = ht + k * 256;
                {
                    const int i = idx & 63, kg = idx >> 6; const u32x4 raw = *(const u32x4*)(QS + i * RS + kg * 16); float f[8]; unpack8(raw, f); const float sc = scale * EG[i];
                    u32x4 o; o.x = pk2(f[0] * sc, f[1] * sc); o.y = pk2(f[2] * sc, f[3] * sc); o.z = pk2(f[4] * sc, f[5] * sc); o.w = pk2(f[6] * sc, f[7] * sc);
                    *(u32x4*)((bf16_t*)(DNI + (size_t)it * DNI_BYTES + DNI_QT) + frag128(i, kg * 8)) = o; }
                {
                    const int dm = idx & 127, tg = idx >> 7; float f[8];
#pragma unroll
                    for (int q = 0; q < 8; ++q) { const int i = tg * 8 + q; f[q] = bf2f(*(const bf16_t*)(KS + i * RS + dm * 2)) * __expf(gl - GC[i]); }
                    u32x4 o; o.x = pk2(f[0], f[1]); o.y = pk2(f[2], f[3]); o.z = pk2(f[4], f[5]); o.w = pk2(f[6], f[7]);
                    *(u32x4*)((bf16_t*)(DNI + (size_t)it * DNI_BYTES + DNI_KTT) + frag64(dm, tg * 8)) = o; }
            }
            if (ht == 0) EGL[it] = __expf(gl);
        }
    }
}

template <int NS> __device__ __forceinline__ void odd_scan(const unsigned char* DNI, const float* EGL, bf16_t* OB, int S, int nb, char* lds) {
    MK_IDS();
    constexpr int O_SB = 0, O_VN = NS * 4352, O_OUT = O_VN + NS * 2304, PFD = 7, EB = NS == 1 ? 3 : 2, NCOL = NS * 16;
    const int NC = S / 64, G = lane >> 4, l16 = lane & 15;
    const int nitems = nb * 64 / NS;
    const int mt = wave & 3; const bool lo = wave < 4;
    for (int item = blockIdx.x; item < nitems; item += gridDim.x) {
        const int e = (item >> 3) & ((1 << EB) - 1), sq = (item & 7) | ((item >> (3 + EB)) << 3); const int d = sq & 1, h = (sq >> 1) & 3, b = sq >> 3, cb = e * NCOL;
        __syncthreads();
        for (int i = tid; i < NS * 4352 / 4; i += NT) ((unsigned*)(lds + O_SB))[i] = 0u;
        f32x4 Sreg[NS];
#pragma unroll
        for (int ns = 0; ns < NS; ++ns) Sreg[ns] = (f32x4){0.f, 0.f, 0.f, 0.f};
        const long dstep = (long)(d ? -8 : 8) * DNI_BYTES;
        const unsigned char* base0 = DNI + (size_t)(((b * NC + (d ? NC - 1 : 0)) * 4 + h) * 2 + d) * DNI_BYTES;
        const unsigned char* pX = base0 + (lo ? DNI_W : DNI_QT) + ((mt * 4) * 64 + lane) * 16;
        const unsigned char* pA = base0 + DNI_A + ((mt * 2) * 64 + lane) * 16;
        const unsigned char* pK = base0 + DNI_KTT + ((wave * 2) * 64 + lane) * 16;
        const unsigned char* pU = base0 + DNI_U + ((mt * 16 + G * 4) * 128 + cb + l16) * 2;
        const float* pE = EGL + (((b * NC + (d ? NC - 1 : 0)) * 4 + h) * 2 + d);
        const unsigned char* pP = base0 + (long)PFD * dstep + e * (9216 * NS) + (tid < 144 * NS ? tid : 144 * NS - 1) * 64;
        bf16_t* pO = OB + ((size_t)d * TS + (size_t)(b * NC + (d ? NC - 1 : 0)) * 64 + (d ? 63 - (tid >> 3) : (tid >> 3))) * 512 + h * 128 + cb + (tid & 7) * 2 * NS;
        const long ostep = (long)(d ? -64 : 64) * 512;
        u32x4 aX[4], aA[2], aK[2], bX[4], bA[2], bK[2], cX[4], cA[2], cK[2];
        unsigned aU[NS][4], bU[NS][4], cU[NS][4]; float aE, bE, cE; unsigned pf_dummy = 0u;
#define DN_LOAD(P) do { \
            _Pragma("unroll") for (int kk = 0; kk < 4; ++kk) P##X[kk] = *(const u32x4*)(pX + kk * 1024); \
            _Pragma("unroll") for (int kk = 0; kk < 2; ++kk) { P##A[kk] = *(const u32x4*)(pA + kk * 1024); P##K[kk] = *(const u32x4*)(pK + kk * 1024); } \
            _Pragma("unroll") for (int ns = 0; ns < NS; ++ns) _Pragma("unroll") for (int r = 0; r < 4; ++r) P##U[ns][r] = *(const bf16_t*)(pU + r * 256 + ns * 32); \
            P##E = *pE; pX += dstep; pA += dstep; pK += dstep; pU += dstep; pE += (d ? -8 : 8); } while (0)
#define DN_STEP(P, PL) do { \
            DN_LOAD(PL); \
            if (wave < (NS == 1 ? 3 : 5)) { asm volatile("global_load_dword %0, %1, off" : "+v"(pf_dummy) : "v"(pP) : "memory"); } \
            pP += dstep; \
            f32x4 acc[NS], acc2[NS]; \
            { bf16x8 sb_[NS][4]; \
              _Pragma("unroll") for (int ns = 0; ns < NS; ++ns) { acc[ns] = (f32x4){0.f, 0.f, 0.f, 0.f}; acc2[ns] = (f32x4){0.f, 0.f, 0.f, 0.f}; \
                _Pragma("unroll") for (int kk = 0; kk < 4; ++kk) sb_[ns][kk] = *(const bf16x8*)(lds + O_SB + (ns * 16 + l16) * 272 + (kk * 32 + G * 8) * 2); } \
              if constexpr (NS == 1) asm volatile("s_waitcnt lgkmcnt(0)" : "+v"(sb_[0][0]), "+v"(sb_[0][1]), "+v"(sb_[0][2]), "+v"(sb_[0][3]) :: "memory"); \
              else asm volatile("s_waitcnt lgkmcnt(0)" : "+v"(sb_[0][0]), "+v"(sb_[0][1]), "+v"(sb_[0][2]), "+v"(sb_[0][3]), "+v"(sb_[NS - 1][0]), "+v"(sb_[NS - 1][1]), "+v"(sb_[NS - 1][2]), "+v"(sb_[NS - 1][3]) :: "memory"); \
              _Pragma("unroll") for (int ns = 0; ns < NS; ++ns) { \
                acc[ns] = MFMA16(__builtin_bit_cast(bf16x8, P##X[0]), sb_[ns][0], acc[ns]); acc2[ns] = MFMA16(__builtin_bit_cast(bf16x8, P##X[1]), sb_[ns][1], acc2[ns]); \
                acc[ns] = MFMA16(__builtin_bit_cast(bf16x8, P##X[2]), sb_[ns][2], acc[ns]); acc2[ns] = MFMA16(__builtin_bit_cast(bf16x8, P##X[3]), sb_[ns][3], acc2[ns]); } \
              _Pragma("unroll") for (int ns = 0; ns < NS; ++ns) acc[ns] = acc[ns] + acc2[ns]; } \
            if (lo) { _Pragma("unroll") for (int ns = 0; ns < NS; ++ns) { u32x2 o; float v[4]; \
              _Pragma("unroll") for (int r = 0; r < 4; ++r) v[r] = __uint_as_float(P##U[ns][r] << 16) - acc[ns][r]; \
              o.x = attn_body::cvtpk_s(v[0], v[1]); o.y = attn_body::cvtpk_s(v[2], v[3]); \
              *(u32x2*)(lds + O_VN + (ns * 16 + l16) * 144 + (mt * 16 + G * 4) * 2) = o; } } \
            asm volatile("s_waitcnt lgkmcnt(0)\n\ts_barrier" ::: "memory"); \
            bf16x8 vb[NS][2]; \
            _Pragma("unroll") for (int ns = 0; ns < NS; ++ns) _Pragma("unroll") for (int kk = 0; kk < 2; ++kk) vb[ns][kk] = *(const bf16x8*)(lds + O_VN + (ns * 16 + l16) * 144 + (kk * 32 + G * 8) * 2); \
            if constexpr (NS == 1) asm volatile("s_waitcnt lgkmcnt(0)" : "+v"(vb[0][0]), "+v"(vb[0][1]) :: "memory"); \
            else asm volatile("s_waitcnt lgkmcnt(0)" : "+v"(vb[0][0]), "+v"(vb[0][1]), "+v"(vb[NS - 1][0]), "+v"(vb[NS - 1][1]) :: "memory"); \
            _Pragma("unroll") for (int ns = 0; ns < NS; ++ns) { Sreg[ns] = Sreg[ns] * P##E; \
              _Pragma("unroll") for (int kk = 0; kk < 2; ++kk) Sreg[ns] = MFMA16(__builtin_bit_cast(bf16x8, P##K[kk]), vb[ns][kk], Sreg[ns]); } \
            _Pragma("unroll") for (int ns = 0; ns < NS; ++ns) { u32x2 o; o.x = attn_body::cvtpk_s(Sreg[ns][0], Sreg[ns][1]); o.y = attn_body::cvtpk_s(Sreg[ns][2], Sreg[ns][3]); \
              *(u32x2*)(lds + O_SB + (ns * 16 + l16) * 272 + (wave * 16 + G * 4) * 2) = o; } \
            if (!lo) { _Pragma("unroll") for (int ns = 0; ns < NS; ++ns) { \
              _Pragma("unroll") for (int kk = 0; kk < 2; ++kk) acc[ns] = MFMA16(__builtin_bit_cast(bf16x8, P##A[kk]), vb[ns][kk], acc[ns]); \
              const unsigned w0_ = attn_body::cvtpk_s(acc[ns][0], acc[ns][1]), w1_ = attn_body::cvtpk_s(acc[ns][2], acc[ns][3]); \
              bf16_t* op_ = (bf16_t*)(lds + O_OUT + ((mt * 16 + G * 4) * NCOL + ns * 16 + l16) * 2); \
              op_[0] = (bf16_t)(w0_ & 0xffffu); op_[NCOL] = (bf16_t)(w0_ >> 16); op_[2 * NCOL] = (bf16_t)(w1_ & 0xffffu); op_[3 * NCOL] = (bf16_t)(w1_ >> 16); } } \
            asm volatile("s_waitcnt lgkmcnt(0)\n\ts_barrier" ::: "memory"); \
            if constexpr (NS == 1) *(unsigned*)pO = *(const unsigned*)(lds + O_OUT + tid * 4); else *(u32x2*)pO = *(const u32x2*)(lds + O_OUT + tid * 8); \
            pO += ostep; } while (0)
        DN_LOAD(a); DN_LOAD(b);
        __syncthreads();
        int n = 0;
        for (; n + 3 <= NC; n += 3) {
            DN_STEP(a, c);
            DN_STEP(b, a);
            DN_STEP(c, b);
        }
        if (n < NC) { DN_STEP(a, c); }
        if (n + 1 < NC) { DN_STEP(b, a); }
#undef DN_STEP
#undef DN_LOAD
        asm volatile("s_waitcnt vmcnt(0)" ::: "memory");
        asm volatile("" :: "v"(pf_dummy));
    }
}

__device__ __forceinline__ int t5_bucket(int rel) {
    const int n = rel < 0 ? -rel : rel; int v;
    if (n < 8) v = n; else v = 8 + (n >= 15) + (n >= 27) + (n >= 50) + (n >= 91) + (n >= 166) + (n >= 305) + (n >= 559);
    return (rel > 0 ? 16 : 0) + v;
}
__device__ __forceinline__ void odd_dilated(bf16_t* proj, const float* relb, float* LSE, int S, char* lds, int first_wg, int n_wg) {
    MK_IDS();
    constexpr int KST = 144, VST = 400, HOFF = 27648 + 25600 + 1024;
    const int half = tid >> 8, ht = tid & 255, wv = ht >> 6, G = lane >> 4, l16 = lane & 15;
    char* L = lds + half * HOFF; char* KS = L; char* VT = L + 27648; float* BIAS = (float*)(L + 27648 + 25600);
    const int NBb = S / 64;
    const int wgi = (int)blockIdx.x - first_wg;
    if (wgi < 0) return;
    for (int it0 = wgi * 2; it0 < 3072; it0 += n_wg * 2) {
        const int it = it0 + half; const int zb = it & 255, sl = (it >> 8) & 3, g = it >> 10;
        const int dil = g == 0 ? 1 : (g == 1 ? 4 : 16), lg = g * 2;
        const int M = S >> lg, MB = M / 64;
        const int b = zb / NBb, r0 = zb % NBb, rho = r0 / MB, n = r0 % MB;
        const int hc = (g * 4 + sl) * 64;
        const size_t tb = (size_t)b * S;
        __syncthreads();
#pragma unroll
        for (int k = 0; k < 6; ++k) { const int idx = ht + k * 256, kj = idx >> 3, pc = idx & 7; const int mk = 64 * n - 64 + kj;
            u32x4 kv = {0u, 0u, 0u, 0u}, vv = {0u, 0u, 0u, 0u};
            if (mk >= 0 && mk < M) { const bf16_t* rowp = proj + (tb + (size_t)mk * dil + rho) * OINP; kv = *(const u32x4*)(rowp + 2832 + hc + pc * 8); vv = *(const u32x4*)(rowp + 3600 + hc + pc * 8); }
            *(u32x4*)(KS + kj * KST + pc * 16) = kv;
            const unsigned w[4] = {vv.x, vv.y, vv.z, vv.w};
#pragma unroll
            for (int q = 0; q < 4; ++q) { *(bf16_t*)(VT + (pc * 8 + 2 * q) * VST + kj * 2) = (bf16_t)(w[q] & 0xffffu); *(bf16_t*)(VT + (pc * 8 + 2 * q + 1) * VST + kj * 2) = (bf16_t)(w[q] >> 16); } }
        if (ht < 129) BIAS[ht] = relb[t5_bucket((ht - 64) * dil) * 12 + g * 4 + sl];
        const int mq = 64 * n + 16 * wv + l16; const size_t tq = tb + (size_t)mq * dil + rho;
        bf16x8 qf[2];
#pragma unroll
        for (int kk = 0; kk < 2; ++kk) qf[kk] = *(const bf16x8*)(proj + tq * OINP + 2064 + hc + kk * 32 + G * 8);
        __syncthreads();
        f32x4 sc[9]; float mx = -1e30f;
#pragma unroll
        for (int kt = 0; kt < 9; ++kt) { f32x4 acc = {0.f, 0.f, 0.f, 0.f};
#pragma unroll
            for (int kk = 0; kk < 2; ++kk) { const bf16x8 a = *(const bf16x8*)(KS + ((wv + kt) * 16 + l16) * KST + (kk * 32 + G * 8) * 2); acc = MFMA16(a, qf[kk], acc); }
#pragma unroll
            for (int r = 0; r < 4; ++r) { const int kj = (wv + kt) * 16 + G * 4 + r; const int delta = kj - 64 - 16 * wv - l16; const int mk = 64 * n - 64 + kj;
                const bool ok = (delta >= -64) && (delta <= 64) && (mk >= 0) && (mk < M);
                const float s = ok ? acc[r] * 0.125f + BIAS[(delta < -64 ? -64 : (delta > 64 ? 64 : delta)) + 64] : -1e30f;
                acc[r] = s; mx = fmaxf(mx, s); }
            sc[kt] = acc; }
        mx = fmaxf(mx, __shfl_xor(mx, 16)); mx = fmaxf(mx, __shfl_xor(mx, 32));
        float sum = 0.f;
#pragma unroll
        for (int kt = 0; kt < 9; ++kt)
#pragma unroll
            for (int r = 0; r < 4; ++r) { const float pv_ = (sc[kt][r] > -1e29f) ? __expf(sc[kt][r] - mx) : 0.f; sc[kt][r] = pv_; sum += pv_; }
        sum += __shfl_xor(sum, 16); sum += __shfl_xor(sum, 32);
        f32x4 ot[4];
#pragma unroll
        for (int dt = 0; dt < 4; ++dt) ot[dt] = (f32x4){0.f, 0.f, 0.f, 0.f};
#pragma unroll
        for (int pp = 0; pp < 5; ++pp) {
            u32x4 pb; pb.x = pk2(sc[2 * pp][0], sc[2 * pp][1]); pb.y = pk2(sc[2 * pp][2], sc[2 * pp][3]);
            if (pp < 4) { pb.z = pk2(sc[2 * pp + 1][0], sc[2 * pp + 1][1]); pb.w = pk2(sc[2 * pp + 1][2], sc[2 * pp + 1][3]); } else { pb.z = 0u; pb.w = 0u; }
            const bf16x8 pbf = __builtin_bit_cast(bf16x8, pb);
#pragma unroll
            for (int dt = 0; dt < 4; ++dt) {
                u32x4 av; const u32x2 lo = *(const u32x2*)(VT + (dt * 16 + l16) * VST + ((wv + 2 * pp) * 16 + G * 4) * 2); av.x = lo.x; av.y = lo.y;
                if (pp < 4) { const u32x2 hi = *(const u32x2*)(VT + (dt * 16 + l16) * VST + ((wv + 2 * pp + 1) * 16 + G * 4) * 2); av.z = hi.x; av.w = hi.y; } else { av.z = 0u; av.w = 0u; }
                ot[dt] = MFMA16(__builtin_bit_cast(bf16x8, av), pbf, ot[dt]);
            }
        }
        const float rs = 1.f / sum;
        bf16_t* od = proj + tq * OINP + (g * 4 + sl) * 64;
#pragma unroll
        for (int dt = 0; dt < 4; ++dt) { const f32x4 v_ = ot[dt] * rs; u32x2 w_; w_.x = pk2(v_[0], v_[1]); w_.y = pk2(v_[2], v_[3]); *(u32x2*)(od + dt * 16 + G * 4) = w_; }
        if (G == 0) LSE[tq * 12 + g * 4 + sl] = mx + __logf(sum);
    }
}

__device__ __forceinline__ void odd_combine(const bf16_t* OB, const bf16_t* proj, const float* LSE, const float* og, bf16_t* Y) {
    MK_IDS();
    float gn[8];
#pragma unroll
    for (int e = 0; e < 8; ++e) gn[e] = og[(lane & 15) * 8 + e];
    const int sl = lane >> 4;
    for (int t = gw; t < TS; t += NGW) {
        const bf16_t* prow = proj + (size_t)t * OINP;
        const u32x4 fa = *(const u32x4*)(OB + (size_t)t * 512 + lane * 8), ra = *(const u32x4*)(OB + ((size_t)TS + t) * 512 + lane * 8), za = *(const u32x4*)(prow + 1536 + lane * 8);
        const u32x2 d0 = *(const u32x2*)(prow + lane * 4), d1 = *(const u32x2*)(prow + 256 + lane * 4), d2 = *(const u32x2*)(prow + 512 + lane * 4);
        const float l0 = LSE[(size_t)t * 12 + sl], l1 = LSE[(size_t)t * 12 + 4 + sl], l2 = LSE[(size_t)t * 12 + 8 + sl];
        float f[8], r[8], z[8]; unpack8(fa, f); unpack8(ra, r); unpack8(za, z);
        float ss = 0.f;
#pragma unroll
        for (int e = 0; e < 8; ++e) { f[e] += r[e]; ss += f[e] * f[e]; }
        ss += __shfl_xor(ss, 1); ss += __shfl_xor(ss, 2); ss += __shfl_xor(ss, 4); ss += __shfl_xor(ss, 8);
        const float rn = __builtin_amdgcn_rsqf(ss * (1.f / 128.f) + EPS);
#pragma unroll
        for (int e = 0; e < 8; ++e) f[e] = f[e] * rn * gn[e] * silu(z[e]);
        u32x4 o; o.x = pk2(f[0], f[1]); o.y = pk2(f[2], f[3]); o.z = pk2(f[4], f[5]); o.w = pk2(f[6], f[7]);
        *(u32x4*)(Y + (size_t)t * OOUT + lane * 8) = o;
        const float m = fmaxf(l0, fmaxf(l1, l2)); const float w0 = __expf(l0 - m), w1 = __expf(l1 - m), w2 = __expf(l2 - m); const float rs = 1.f / (w0 + w1 + w2);
        const float a0 = w0 * rs, a1 = w1 * rs, a2 = w2 * rs;
        const float v0 = a0 * __uint_as_float(d0.x << 16) + a1 * __uint_as_float(d1.x << 16) + a2 * __uint_as_float(d2.x << 16);
        const float v1 = a0 * __uint_as_float(d0.x & 0xffff0000u) + a1 * __uint_as_float(d1.x & 0xffff0000u) + a2 * __uint_as_float(d2.x & 0xffff0000u);
        const float v2 = a0 * __uint_as_float(d0.y << 16) + a1 * __uint_as_float(d1.y << 16) + a2 * __uint_as_float(d2.y << 16);
        const float v3 = a0 * __uint_as_float(d0.y & 0xffff0000u) + a1 * __uint_as_float(d1.y & 0xffff0000u) + a2 * __uint_as_float(d2.y & 0xffff0000u);
        u32x2 od; od.x = pk2(v0, v1); od.y = pk2(v2, v3);
        *(u32x2*)(Y + (size_t)t * OOUT + 512 + lane * 4) = od;
    }
}

__global__ void __launch_bounds__(NT, 2) fwd_megakernel(Params p) {
    extern __shared__ __attribute__((aligned(16))) unsigned char lds_raw[];
    cg::grid_group grid = cg::this_grid();
    char* lds = (char*)lds_raw;
    PG8_LAS unsigned char* ldsl = (PG8_LAS unsigned char*)lds_raw;
    const int Gr = gridDim.x;
    volatile LAS unsigned* MISC = (volatile LAS unsigned*)((PG8_LAS unsigned char*)lds_raw + (LDS_BYTES - 128));
    if (threadIdx.x < 32) MISC[threadIdx.x] = 0u;
    __syncthreads();
    xb::XcdBarrier bar = xb::xcd_barrier_post((unsigned*)p.ws, MISC + 8);
#define GSYNC() xb::xcd_barrier(bar)
    unsigned char* ws = p.ws;
    bf16_t* H = (bf16_t*)(ws + WS_H); bf16_t* PROJ = (bf16_t*)(ws + WS_PROJ); unsigned char* SCR = ws + WS_SCR;

    phase_prologue(p, lds);
    grid.sync();

    float* SSQA = (float*)(SCR + 232 * MiB); float* SSQB = (float*)(SCR + 234 * MiB);
    bf16_t* YE = (bf16_t*)(SCR + 192 * MiB); bf16_t* YO = (bf16_t*)(SCR + SC_QKVP);
    for (int seg = 0; seg < NSEG; ++seg) {
        const int S = seg < 2 ? 16384 : 2048, nb = seg < 2 ? 1 : 8;
        const float* xin = (seg < 2 ? p.in[0] : p.in[1]) + (size_t)(seg & 1) * TS * DMODEL;
        float* xo = p.out + (size_t)seg * TS * DMODEL;
        phase_x0(xin, H, SSQB);
        GSYNC();
        for (int layer = 0; layer < 4; ++layer) {
            const int j = layer >> 1; const bool odd = layer & 1;
            {
                const int N = odd ? OINP : EIN;
                const bf16_t* Bt = odd ? (const bf16_t*)(ws + WS_WINO) + (size_t)j * OINP * 1024 : (const bf16_t*)(ws + WS_WINE) + (size_t)j * EIN * 1024;
                pg8::Gemm g{H, Bt, TS, N, 1024}; pg8::StaticOrder So; So.init(TS, N, Gr, (int)blockIdx.x);
                pg8::EpiBf16<0> E{PROJ, N, nullptr, 0, 0, 1.f, SSQB};
                pg8::gemm_phase<pg8::EpiBf16<0>, pg8::StaticOrder, true, true>(ldsl, g, So, E);
            }
            GSYNC();
            if (!odd) {
                even_qk_post(PROJ, p.in[10] + j * 64, p.in[11] + j * 64, S);
                even_lru_prep(PROJ, p.in[12] + j * 2048, p.in[13] + j * 512, (const bf16_t*)(ws + WS_GW) + (size_t)j * 2 * 2 * 8 * 4096, p.in[15] + j * 1024, p.in[17] + j * 1024, p.in[18] + j * 1024,
                              (unsigned*)(SCR + SC_LA), (f32x2*)(SCR + SC_AGG), S, lds);
                GSYNC();
                {
                    const int nqb = S / 256, nunits = nb * 8 * nqb;
                    for (int u = blockIdx.x; u < nunits; u += Gr) {
                        const int qb = u % nqb, h = (u / nqb) % 8, b = u / (nqb * 8), kvh = h >> 2;
                        const attn_body::bf16* base = (const attn_body::bf16*)PROJ + (size_t)b * S * EIN;
                        attn_body::attn_unit<8>(qb, S, base + h * 64, EIN, base + 512 + kvh * 64, base + 640 + kvh * 64, EIN, (attn_body::bf16*)YE + (size_t)b * S * DMODEL + h * 64, DMODEL, lds);
                    }
                }
                __syncthreads();
                even_lru_scan((const unsigned*)(SCR + SC_LA), (const f32x2*)(SCR + SC_AGG), PROJ, YE, S);
                GSYNC();
                {
                    pg8::Gemm g{YE, (const bf16_t*)(ws + WS_WOUTE) + (size_t)j * 1024 * 1024, TS, 1024, 1024}; pg8::StaticOrder So; So.init(TS, 1024, Gr, (int)blockIdx.x);
                    EpiRes E{H, SSQA, DMODEL, nullptr};
                    pg8::gemm_phase<EpiRes, pg8::StaticOrder, true, true>(ldsl, g, So, E);
                }
            } else {
                odd_conv(PROJ, p.in[21] + j * 4 * 1536, (bf16_t*)(SCR + SC_QKVP), S);
                asm volatile("s_waitcnt vmcnt(0)" ::: "memory"); __syncthreads();
                odd_prep((const bf16_t*)(SCR + SC_QKVP), PROJ, p.in[22] + j * 8, p.in[23] + j * 8, SCR + SC_DNI, (float*)(SCR + SC_EGL), lds);
                GSYNC();
                {
                    const int nscan = nb * 64;
                    if (nscan <= Gr) odd_scan<1>(SCR + SC_DNI, (const float*)(SCR + SC_EGL), (bf16_t*)(SCR + SC_OB), S, nb, lds);
                    else odd_scan<2>(SCR + SC_DNI, (const float*)(SCR + SC_EGL), (bf16_t*)(SCR + SC_OB), S, nb, lds);
                    const int first = nscan < Gr ? nscan : 0;
                    odd_dilated(PROJ, p.in[2], (float*)(SCR + SC_LSE), S, lds, first, Gr - first);
                }
                GSYNC();
                odd_combine((const bf16_t*)(SCR + SC_OB), PROJ, (const float*)(SCR + SC_LSE), p.in[24] + j * 128, YO);
                GSYNC();
                {
                    pg8::Gemm g{YO, (const bf16_t*)(ws + WS_WOUTO) + (size_t)j * 1024 * OOUT, TS, 1024, OOUT}; pg8::StaticOrder So; So.init(TS, 1024, Gr, (int)blockIdx.x);
                    EpiRes E{H, SSQA, DMODEL, nullptr};
                    pg8::gemm_phase<EpiRes, pg8::StaticOrder, true, true>(ldsl, g, So, E);
                }
            }
            GSYNC();
            {
                pg8::Gemm g{H, (const bf16_t*)(ws + WS_W1T) + (size_t)layer * 4096 * 1024, TS, DFF, 1024}; pg8::StaticOrder So; So.init(TS, DFF, Gr, (int)blockIdx.x);
                pg8::EpiBf16<2> E{(bf16_t*)(SCR + SC_HID), DFF, nullptr, 0, 0, 1.f, nullptr};
                pg8::gemm_phase<pg8::EpiBf16<2>, pg8::StaticOrder, true, true>(ldsl, g, So, E);
            }
            GSYNC();
            {
                pg8::Gemm g{(const bf16_t*)(SCR + SC_HID), (const bf16_t*)(ws + WS_W2T) + (size_t)layer * 1024 * 4096, TS, 1024, DFF}; pg8::StaticOrder So; So.init(TS, 1024, Gr, (int)blockIdx.x);
                EpiRes E{H, SSQB, DMODEL, SSQA};
                pg8::gemm_phase<EpiRes, pg8::StaticOrder, true, true>(ldsl, g, So, E);
            }
            GSYNC();
        }
        phase_rmsnorm_final(H, xo, p.in[5]);
        GSYNC();
    }
}
}

extern "C" void kernel_launch(void* const* d_in, const int* in_sizes, int n_in, void* d_out, int out_size, void* d_ws, size_t ws_size, hipStream_t stream) {
    static int grid = 0;
    if (grid == 0) {
        if (n_in != 25 || ws_size < mk::WS_END) { fprintf(stderr, "kernel_launch: unexpected n_in %d / ws_size %zu\n", n_in, ws_size); grid = -1; return; }
        int dev = 0, cus = 0, per_cu = 0;
        hipGetDevice(&dev); hipDeviceGetAttribute(&cus, hipDeviceAttributeMultiprocessorCount, dev);
        if (hipFuncSetAttribute((const void*)mk::fwd_megakernel, hipFuncAttributeMaxDynamicSharedMemorySize, mk::LDS_BYTES) != hipSuccess) { fprintf(stderr, "hipFuncSetAttribute failed\n"); }
        hipOccupancyMaxActiveBlocksPerMultiprocessor(&per_cu, (const void*)mk::fwd_megakernel, mk::NT, mk::LDS_BYTES);
        (void)hipGetLastError();
        if (per_cu < 1) per_cu = 1;
        grid = cus * 1;
        fprintf(stderr, "kernel_launch: cus %d per_cu %d grid %d\n", cus, per_cu, grid);
    }
    if (grid < 0) return;
    if (hipMemsetAsync(d_ws, 0, 65536, stream) != hipSuccess) { fprintf(stderr, "memset failed\n"); return; }
    mk::Params p{};
    for (int i = 0; i < 25; ++i) p.in[i] = (const float*)d_in[i];
    p.out = (float*)d_out; p.ws = (unsigned char*)d_ws;
    void* args[] = {&p};
    hipError_t e = hipLaunchCooperativeKernel((const void*)mk::fwd_megakernel, dim3(grid), dim3(mk::NT), args, mk::LDS_BYTES, stream);
    if (e != hipSuccess) fprintf(stderr, "cooperative launch failed: %s (grid %d)\n", hipGetErrorString(e), grid);
}
```

```cpp
#include <hip/hip_runtime.h>
#include <hip/hip_cooperative_groups.h>
#include <hip/hip_bf16.h>
#include <cstdio>
#include <cstdint>
#include <cmath>
namespace cg = cooperative_groups;
namespace pg8 {
#define PG8_LAS __attribute__((address_space(3)))
typedef unsigned short bf16_t;
typedef short bf16x8 __attribute__((ext_vector_type(8)));
typedef float f32x4 __attribute__((ext_vector_type(4)));
typedef unsigned u32x4 __attribute__((ext_vector_type(4)));
constexpr int BM = 256, BK = 64, HALF = 128, HTB = HALF * BK * 2  , STAGE_BYTES = 8 * HTB, NXCD = 8, WGM = 8;

__host__ __device__ __forceinline__ int lds_byte(int r, int c) { const int st = (r >> 4) * 2 + (c >> 5), rr = r & 15, cc = c & 31, ob = rr * 64 + cc * 2; return st * 1024 + (ob ^ (((ob >> 9) & 1) << 5)); }
__host__ __device__ __forceinline__ void stage_rc(int b, int& R, int& C) { const int st = b / 1024, sb = b % 1024, swz = sb ^ (((sb >> 9) & 1) << 5); R = (st >> 1) * 16 + swz / 64; C = (st & 1) * 32 + (swz % 64) / 2; }
__host__ __device__ __forceinline__ int perm32(int rho) { const int n = rho >> 4, i = rho & 15; return 8 * (i >> 2) + 4 * n + (i & 3); }

struct Unit { int pm, pn; };
struct Gemm { const bf16_t* A; const bf16_t* Bt; int M, N, K; };

struct StaticOrder {
    int nM, nN, nwg, G, c;
    __host__ __device__ void init(int M, int N, int G_, int c_) { nM = M / BM; nN = N / BM; nwg = nM * nN; G = G_; c = c_; }
    __host__ __device__ bool next(int i, Unit& u) const {
        const long L = (long)i * G + c; if (L >= nwg) return false;
        int wgid = (int)L; { const int q = nwg / NXCD, r = nwg % NXCD, xcd = wgid % NXCD, off = wgid / NXCD; wgid = (xcd < r ? xcd * (q + 1) : r * (q + 1) + (xcd - r) * q) + off; }
        const int nig = WGM * nN, gid = wgid / nig, fm = gid * WGM, gsz = (nM - fm) < WGM ? (nM - fm) : WGM;
        u.pm = fm + ((wgid % nig) % gsz); u.pn = (wgid % nig) / gsz; return true;
    }
    __device__ __forceinline__ void a_ready(const Unit&) const {}
    __device__ __forceinline__ void done(const Unit&) const {}
};

__device__ __forceinline__ unsigned cvt_pk_bf16(float lo, float hi) { unsigned r; asm volatile("v_cvt_pk_bf16_f32 %0, %1, %2" : "=v"(r) : "v"(lo), "v"(hi)); return r; }
typedef float f32x2 __attribute__((ext_vector_type(2)));
__device__ __forceinline__ f32x2 gelu_pk(f32x2 v) {
    const f32x2 av = __builtin_elementwise_abs(v), d = av * 0.2316418882f + 1.0f;
    f32x2 t; t.x = __builtin_amdgcn_rcpf(d.x); t.y = __builtin_amdgcn_rcpf(d.y);
    f32x2 q = t * 0.5307027145f + (-0.7265760135f); q = q * t + 0.7107068705f; q = q * t + (-0.142248368f); q = q * t + 0.127414796f; q = q * t;
    const f32x2 s = (v * v) * (-0.72134752044f);
    f32x2 e; e.x = __builtin_amdgcn_exp2f(s.x); e.y = __builtin_amdgcn_exp2f(s.y);
    const f32x2 m = v * (q * e), r = v - m;
    f32x2 o; o.x = v.x < 0.f ? m.x : r.x; o.y = v.y < 0.f ? m.y : r.y; return o;
}

template <int ACT  > struct EpiBf16 {
    static constexpr bool PERM = true, AFTER_DRAIN = false; static_assert(ACT == 0 || ACT == 1 || ACT == 2, "EpiBf16: ACT 0 none, 1 gelu, 2 relu^2");
    bf16_t* O; int ldc; const float* bias; int split_cols; size_t split_stride; float scale0; const float* ssq;
    __device__ __forceinline__ void operator()(const f32x4 (&acc)[2][2][4][2], const Unit& u, int wr, int wc, int fr, int fq) const {
        const int row0 = u.pm * BM + wr * 64 + fr; int colt = u.pn * BM; bf16_t* base = O;
        float sc = 1.f; if (split_cols) { const int t = colt / split_cols; base += (size_t)t * split_stride; colt -= t * split_cols; if (t == 0) sc = scale0; }
        const int col0 = colt + wc * 32 + 8 * fq, bcol0 = u.pn * BM + wc * 32 + 8 * fq;
        float rsc[2][4];
        if (ssq) { f32x4 t_[2][4];
#pragma unroll
            for (int ai = 0; ai < 2; ++ai)
#pragma unroll
                for (int m = 0; m < 4; ++m) t_[ai][m] = *(const f32x4*)(ssq + (size_t)(row0 + ai * HALF + m * 16) * 16 + fq * 4);
#pragma unroll
            for (int ai = 0; ai < 2; ++ai)
#pragma unroll
                for (int m = 0; m < 4; ++m) { float s_ = (t_[ai][m][0] + t_[ai][m][1]) + (t_[ai][m][2] + t_[ai][m][3]); s_ += __shfl_xor(s_, 16); s_ += __shfl_xor(s_, 32); rsc[ai][m] = __builtin_amdgcn_rsqf(s_ * (1.0f / 1024.0f) + 1e-6f); }
        } else {
#pragma unroll
            for (int ai = 0; ai < 2; ++ai)
#pragma unroll
                for (int m = 0; m < 4; ++m) rsc[ai][m] = 1.0f; }
        f32x4 bv[2][2];
#pragma unroll
        for (int bj = 0; bj < 2; ++bj)
#pragma unroll
            for (int n = 0; n < 2; ++n) bv[bj][n] = bias ? *(const f32x4*)(bias + bcol0 + bj * HALF + 4 * n) : (f32x4){0.f, 0.f, 0.f, 0.f};
#pragma unroll
        for (int ai = 0; ai < 2; ++ai)
#pragma unroll
            for (int m = 0; m < 4; ++m) { bf16_t* rowp = base + (size_t)(row0 + ai * HALF + m * 16) * ldc + col0; const float rsc_ = rsc[ai][m];
#pragma unroll
                for (int bj = 0; bj < 2; ++bj) { f32x4 v0 = (acc[ai][bj][m][0] + bv[bj][0]) * rsc_, v1 = (acc[ai][bj][m][1] + bv[bj][1]) * rsc_;
                    if (ACT == 1) { f32x2 a = gelu_pk((f32x2){v0[0], v0[1]}), b = gelu_pk((f32x2){v0[2], v0[3]}), c = gelu_pk((f32x2){v1[0], v1[1]}), d = gelu_pk((f32x2){v1[2], v1[3]});
                        v0 = (f32x4){a.x, a.y, b.x, b.y}; v1 = (f32x4){c.x, c.y, d.x, d.y}; }
                    if (ACT == 2) { _Pragma("unroll") for (int q_ = 0; q_ < 4; ++q_) { const float a0_ = v0[q_] > 0.f ? v0[q_] : 0.f, a1_ = v1[q_] > 0.f ? v1[q_] : 0.f; v0[q_] = a0_ * a0_; v1[q_] = a1_ * a1_; } }
                    v0 = v0 * sc; v1 = v1 * sc; u32x4 w; w.x = cvt_pk_bf16(v0[0], v0[1]); w.y = cvt_pk_bf16(v0[2], v0[3]); w.z = cvt_pk_bf16(v1[0], v1[1]); w.w = cvt_pk_bf16(v1[2], v1[3]);
                    *(u32x4*)(rowp + bj * HALF) = w; } }
    }
};

template <class Epi, class Sched, bool ALIGN_EPI = false, bool SP2 = false>
__device__ __forceinline__ void gemm_phase(PG8_LAS unsigned char* lds, const Gemm g, const Sched& S, const Epi& E) {
    int tid_ = threadIdx.x; asm volatile("" : "+v"(tid_)); const int tid = tid_, wid = __builtin_amdgcn_readfirstlane(tid >> 6), lane = tid & 63, wr = wid >> 2, wc = wid & 3, fr = lane & 15, fq = lane >> 4;
    const int K = g.K, nt = K / BK;
    unsigned voffA[2], voffB[2];
#pragma unroll
    for (int i = 0; i < 2; ++i) { int R, C; stage_rc(tid * 16 + i * 8192, R, C); const int Rb = Epi::PERM ? ((R & ~31) + perm32(R & 31)) : R;
        voffA[i] = (unsigned)(R * K + C) * 2u; voffB[i] = (unsigned)(Rb * K + C) * 2u; }
    const size_t kstep = (size_t)(BK * 2);
    const size_t hstep = (size_t)HALF * K * 2;
    const size_t tstep = 2 * hstep;
    const unsigned ldsw = (unsigned)wid * 1024u;
    const int aoff = lds_byte(wr * 64 + fr, fq * 8), boff = lds_byte(wc * 32 + fr, fq * 8);
#define PG8_SA(b, h) (((b) * 2 + (h)) * HTB)
#define PG8_SB(b, h) ((4 + (b) * 2 + (h)) * HTB)
#define PG8_STAGE(bufoff, gbase, voff) do { _Pragma("unroll") for (int _i = 0; _i < 2; ++_i) \
        __builtin_amdgcn_global_load_lds((const unsigned*)((const char*)(gbase) + (voff)[_i]), (PG8_LAS unsigned*)(lds + (bufoff) + ldsw + _i * 8192), 16, 0, 0); } while (0)
#define PG8_LDA(dst, b, h) do { _Pragma("unroll") for (int m = 0; m < 4; ++m) _Pragma("unroll") for (int k = 0; k < 2; ++k) dst[m][k] = *(const PG8_LAS bf16x8*)(lds + PG8_SA(b, h) + aoff + m * 2048 + k * 1024); } while (0)
#define PG8_LDB(dst, b, h) do { _Pragma("unroll") for (int n = 0; n < 2; ++n) _Pragma("unroll") for (int k = 0; k < 2; ++k) dst[n][k] = *(const PG8_LAS bf16x8*)(lds + PG8_SB(b, h) + boff + n * 2048 + k * 1024); } while (0)
#define PG8_MMA(ai, bj, At, Bt) do { __builtin_amdgcn_s_setprio(1); _Pragma("unroll") for (int m = 0; m < 4; ++m) _Pragma("unroll") for (int n = 0; n < 2; ++n) _Pragma("unroll") for (int k = 0; k < 2; ++k) \
        acc[ai][bj][m][n] = __builtin_amdgcn_mfma_f32_16x16x32_bf16(Bt[n][k], At[m][k], acc[ai][bj][m][n], 0, 0, 0); __builtin_amdgcn_s_setprio(0); } while (0)
#define PG8_WAIT_V(n) asm volatile("s_waitcnt vmcnt(" #n ")" ::: "memory")
#define PG8_WAIT_L(n) asm volatile("s_waitcnt lgkmcnt(" #n ")" ::: "memory")
#define PG8_BAR __builtin_amdgcn_s_barrier()
#define PG8_SCHED __builtin_amdgcn_sched_barrier(0)
    Unit cur, nxt; int ui = 0;
    if (!S.next(0, cur)) return;
    f32x4 acc[2][2][4][2];
#pragma unroll
    for (int a = 0; a < 2; ++a)
#pragma unroll
        for (int b = 0; b < 2; ++b)
#pragma unroll
            for (int m = 0; m < 4; ++m)
#pragma unroll
                for (int n = 0; n < 2; ++n) acc[a][b][m][n] = (f32x4){0.f, 0.f, 0.f, 0.f};
    bf16x8 At[4][2], B0[2][2], B1[2][2];
    const char* cA = (const char*)g.A + (size_t)cur.pm * tstep; const char* cB = (const char*)g.Bt + (size_t)cur.pn * tstep;
    S.a_ready(cur);
    if constexpr (SP2) {
        PG8_STAGE(PG8_SB(0, 0), cB, voffB); PG8_STAGE(PG8_SB(0, 1), cB + hstep, voffB); PG8_STAGE(PG8_SA(0, 0), cA, voffA); PG8_STAGE(PG8_SA(0, 1), cA + hstep, voffA);
        if (wr == 1) PG8_BAR;
        PG8_WAIT_V(2); PG8_BAR;
        PG8_STAGE(PG8_SB(1, 0), cB + kstep, voffB); PG8_STAGE(PG8_SA(1, 0), cA + kstep, voffA); PG8_STAGE(PG8_SB(1, 1), cB + hstep + kstep, voffB);
        PG8_WAIT_V(6); PG8_BAR;
    } else {
        PG8_STAGE(PG8_SB(0, 0), cB, voffB); PG8_STAGE(PG8_SA(0, 0), cA, voffA); PG8_STAGE(PG8_SB(0, 1), cB + hstep, voffB); PG8_STAGE(PG8_SA(0, 1), cA + hstep, voffA);
        if (wr == 1) PG8_BAR;
        PG8_WAIT_V(4); PG8_BAR;
        PG8_STAGE(PG8_SB(1, 0), cB + kstep, voffB); PG8_STAGE(PG8_SA(1, 0), cA + kstep, voffA); PG8_STAGE(PG8_SB(1, 1), cB + hstep + kstep, voffB);
        PG8_WAIT_V(6); PG8_BAR;
    }
    for (;;) {
        const bool has_next = S.next(ui + 1, nxt);
        const char* nA = has_next ? (const char*)g.A + (size_t)nxt.pm * tstep : cA; const char* nB = has_next ? (const char*)g.Bt + (size_t)nxt.pn * tstep : cB;
        for (int t = 0; t < nt; t += 2) {
            const bool last = (t == nt - 2);
            const char* a1 = cA + (size_t)(t + 1) * kstep;
            const char* a2 = last ? nA : cA + (size_t)(t + 2) * kstep; const char* b2 = last ? nB : cB + (size_t)(t + 2) * kstep;
            const char* a3 = a2 + kstep; const char* b3 = b2 + kstep;
            if (last && has_next) S.a_ready(nxt);
            if constexpr (SP2) {
            PG8_LDB(B0, 0, 0); PG8_LDB(B1, 0, 1); PG8_SCHED; PG8_LDA(At, 0, 0); PG8_STAGE(PG8_SA(1, 1), a1 + hstep, voffA);
            PG8_WAIT_V(8); PG8_WAIT_L(0); PG8_BAR; PG8_MMA(0, 0, At, B0); PG8_MMA(0, 1, At, B1); PG8_BAR; PG8_SCHED;
            PG8_LDA(At, 0, 1); PG8_STAGE(PG8_SB(0, 0), b2, voffB); PG8_STAGE(PG8_SB(0, 1), b2 + hstep, voffB); PG8_STAGE(PG8_SA(0, 0), a2, voffA);
            PG8_WAIT_V(8); PG8_WAIT_L(0); PG8_BAR; PG8_MMA(1, 0, At, B0); PG8_MMA(1, 1, At, B1); PG8_BAR; PG8_SCHED;
            PG8_LDB(B0, 1, 0); PG8_LDB(B1, 1, 1); PG8_SCHED; PG8_LDA(At, 1, 0); PG8_STAGE(PG8_SA(0, 1), a2 + hstep, voffA);
            PG8_WAIT_V(8); PG8_WAIT_L(0); PG8_BAR; PG8_MMA(0, 0, At, B0); PG8_MMA(0, 1, At, B1); PG8_BAR; PG8_SCHED;
            PG8_LDA(At, 1, 1); PG8_STAGE(PG8_SB(1, 0), b3, voffB); PG8_STAGE(PG8_SB(1, 1), b3 + hstep, voffB); PG8_STAGE(PG8_SA(1, 0), a3, voffA);
            PG8_WAIT_V(8); PG8_WAIT_L(0); PG8_BAR; PG8_MMA(1, 0, At, B0); PG8_MMA(1, 1, At, B1); PG8_BAR; PG8_SCHED;
            } else {
            PG8_LDB(B0, 0, 0); PG8_SCHED; PG8_LDA(At, 0, 0); PG8_STAGE(PG8_SA(1, 1), a1 + hstep, voffA);
            PG8_WAIT_L(8); PG8_BAR; PG8_WAIT_L(0); PG8_MMA(0, 0, At, B0); PG8_BAR; PG8_SCHED;
            PG8_LDB(B1, 0, 1); PG8_STAGE(PG8_SB(0, 0), b2, voffB);
            PG8_BAR; PG8_WAIT_L(0); PG8_MMA(0, 1, At, B1); PG8_BAR;
            PG8_LDA(At, 0, 1); PG8_STAGE(PG8_SA(0, 0), a2, voffA);
            PG8_BAR; PG8_WAIT_L(0); PG8_MMA(1, 0, At, B0); PG8_BAR; PG8_SCHED;
            PG8_STAGE(PG8_SB(0, 1), b2 + hstep, voffB);
            PG8_WAIT_V(6); PG8_BAR; PG8_MMA(1, 1, At, B1); PG8_BAR;
            PG8_LDB(B0, 1, 0); PG8_SCHED; PG8_LDA(At, 1, 0); PG8_STAGE(PG8_SA(0, 1), a2 + hstep, voffA);
            PG8_WAIT_L(8); PG8_BAR; PG8_WAIT_L(0); PG8_MMA(0, 0, At, B0); PG8_BAR; PG8_SCHED;
            PG8_LDB(B1, 1, 1); PG8_STAGE(PG8_SB(1, 0), b3, voffB);
            PG8_BAR; PG8_WAIT_L(0); PG8_MMA(0, 1, At, B1); PG8_BAR;
            PG8_LDA(At, 1, 1); PG8_STAGE(PG8_SA(1, 0), a3, voffA);
            PG8_BAR; PG8_WAIT_L(0); PG8_MMA(1, 0, At, B0); PG8_BAR; PG8_SCHED;
            PG8_STAGE(PG8_SB(1, 1), b3 + hstep, voffB);
            PG8_WAIT_V(6); PG8_BAR; PG8_MMA(1, 1, At, B1); PG8_BAR;
            }
        }
        if constexpr (ALIGN_EPI) { if (wr == 0) PG8_BAR; }
        if constexpr (!Epi::AFTER_DRAIN) { E(acc, cur, wr, wc, fr, fq); S.done(cur); }
        if (!has_next) break;
#pragma unroll
        for (int a = 0; a < 2; ++a)
#pragma unroll
            for (int b = 0; b < 2; ++b)
#pragma unroll
                for (int m = 0; m < 4; ++m)
#pragma unroll
                    for (int n = 0; n < 2; ++n) acc[a][b][m][n] = (f32x4){0.f, 0.f, 0.f, 0.f};
        cur = nxt; cA = nA; cB = nB; ++ui;
        if constexpr (ALIGN_EPI) { if (wr == 1) PG8_BAR; }
    }
    PG8_WAIT_V(0);
    if constexpr (!ALIGN_EPI) { if (wr == 0) PG8_BAR; }
    PG8_BAR;
    if constexpr (Epi::AFTER_DRAIN) { E.fused(acc, cur, wr, wc, fr, fq, lds, wid, lane); S.done(cur); }
#undef PG8_SA
#undef PG8_SB
#undef PG8_STAGE
#undef PG8_LDA
#undef PG8_LDB
#undef PG8_MMA
#undef PG8_WAIT_V
#undef PG8_WAIT_L
#undef PG8_BAR
#undef PG8_SCHED
}
}

#ifndef PG8_SP2
#define PG8_SP2 true
#endif
#ifndef PG8_ALIGN
#define PG8_ALIGN true
#endif
#include <hip/hip_bf16.h>
#include <cmath>
namespace attn_body {
using bf16=__hip_bfloat16;
using bf16x8=__attribute__((ext_vector_type(8)))short;
using s16x4=__attribute__((ext_vector_type(4)))short;
using f32x16=__attribute__((ext_vector_type(16)))float;
using u32x4=__attribute__((ext_vector_type(4)))unsigned;
constexpr int D=64;
constexpr int NW=8,QBLK=32,QB=QBLK*NW,KVBLK=64;
__device__ __forceinline__ int crow(int r,int hi){return (r&3)+8*(r>>2)+4*hi;}
#define SBAR() __builtin_amdgcn_sched_barrier(0)
__device__ __forceinline__ void cmask(f32x16&p0,f32x16&p1,int jb,int qrel,int hi){
  const float NEG=-INFINITY; int kb=64*jb+4*hi;
  #pragma unroll
  for(int r=0;r<16;++r){int kv=kb+(r&3)+8*(r>>2); if(kv>qrel)p0[r]=NEG; if(kv+32>qrel)p1[r]=NEG;}
}

constexpr int NSLOT=3, SLOTB=8192;
constexpr int LDS_K=0, LDS_V=NSLOT*SLOTB, LDS_WS=2*NSLOT*SLOTB, LDS_OST=LDS_WS+NW*64*4, LDS_BYTES=LDS_OST+NW*4096;
constexpr float C2=0.125f*1.4426950408889634f;
__device__ __forceinline__ void glds16(const void*gsrc,unsigned lds_dst){unsigned keep;
  asm volatile("s_mov_b32 %0, m0\n\ts_mov_b32 m0, %2\n\ts_nop 0\n\tglobal_load_lds_dwordx4 %1, off\n\ts_mov_b32 m0, %0":"=&s"(keep):"v"(gsrc),"s"(lds_dst):"memory");}
__device__ __forceinline__ float max3f(float a,float b,float c){float r;asm("v_max3_f32 %0, %1, %2, %3":"=v"(r):"v"(a),"v"(b),"v"(c));return r;}
__device__ __forceinline__ float max2f(float a,float b){float r;asm("v_max_f32_e32 %0, %1, %2":"=v"(r):"v"(a),"v"(b));return r;}
__device__ __forceinline__ float fadd_s(float a,float b){float r;asm("v_add_f32_e32 %0, %1, %2":"=v"(r):"v"(a),"v"(b));return r;}
__device__ __forceinline__ float fsub_s(float a,float b){float r;asm("v_sub_f32_e32 %0, %1, %2":"=v"(r):"v"(a),"v"(b));return r;}
typedef float f32x2_t __attribute__((ext_vector_type(2))); typedef __bf16 bf16x2_t __attribute__((ext_vector_type(2)));
__device__ __forceinline__ unsigned cvtpk_s(float lo,float hi){f32x2_t v={lo,hi};bf16x2_t b=__builtin_convertvector(v,bf16x2_t);return __builtin_bit_cast(unsigned,b);}
#define WAIT_BAR(N) asm volatile("s_waitcnt vmcnt(" #N ") lgkmcnt(0)\n\ts_barrier":::"memory")

__device__ __forceinline__ void qkt(f32x16&p0,f32x16&p1,const char*Kslot,const bf16x8*qr,const f32x16&negm,int r32,int hi){
  const char*kb=Kslot+hi*1024+r32*16;
  #pragma unroll
  for(int d0=0;d0<4;++d0){
    const bf16x8 b0=*reinterpret_cast<const bf16x8*>(kb+d0*2048);
    const bf16x8 b1=*reinterpret_cast<const bf16x8*>(kb+d0*2048+512);
    if(d0==0){p0=__builtin_amdgcn_mfma_f32_32x32x16_bf16(b0,qr[0],negm,0,0,0);p1=__builtin_amdgcn_mfma_f32_32x32x16_bf16(b1,qr[0],negm,0,0,0);}
    else{p0=__builtin_amdgcn_mfma_f32_32x32x16_bf16(b0,qr[d0],p0,0,0,0);p1=__builtin_amdgcn_mfma_f32_32x32x16_bf16(b1,qr[d0],p1,0,0,0);}}
}
typedef __attribute__((address_space(3))) const char* lds_cptr;
typedef short v4i16_t __attribute__((ext_vector_type(4)));
__device__ __forceinline__ void kload8(bf16x8*kf,lds_cptr kp){
  kf[0]=*(const __attribute__((address_space(3))) bf16x8*)(kp);      kf[1]=*(const __attribute__((address_space(3))) bf16x8*)(kp+512);
  kf[2]=*(const __attribute__((address_space(3))) bf16x8*)(kp+2048); kf[3]=*(const __attribute__((address_space(3))) bf16x8*)(kp+2560);
  kf[4]=*(const __attribute__((address_space(3))) bf16x8*)(kp+4096); kf[5]=*(const __attribute__((address_space(3))) bf16x8*)(kp+4608);
  kf[6]=*(const __attribute__((address_space(3))) bf16x8*)(kp+6144); kf[7]=*(const __attribute__((address_space(3))) bf16x8*)(kp+6656);
}
__device__ __forceinline__ void kload2(bf16x8*kf,lds_cptr kp,int j){ kf[2*j]=*(const __attribute__((address_space(3))) bf16x8*)(kp+j*2048); kf[2*j+1]=*(const __attribute__((address_space(3))) bf16x8*)(kp+j*2048+512); }
__device__ __forceinline__ s16x4 vtr(lds_cptr p){ return __builtin_bit_cast(s16x4,__builtin_amdgcn_ds_read_tr16_b64_v4i16((__attribute__((address_space(3))) v4i16_t*)p)); }
__device__ __forceinline__ float rowmax(const f32x16&p0,const f32x16&p1){
  float a=max3f(p0[0],p0[1],p1[0]),b=max3f(p0[2],p0[3],p1[1]);a=max3f(a,p1[2],p1[3]);
  #pragma unroll
  for(int r=4;r<16;r+=4){a=max3f(a,p0[r],p0[r+1]);b=max3f(b,p0[r+2],p0[r+3]);a=max3f(a,p1[r],p1[r+1]);b=max3f(b,p1[r+2],p1[r+3]);}
  const float m=max2f(a,b);
  auto rr=__builtin_amdgcn_permlane32_swap(__float_as_uint(m),__float_as_uint(m),false,false);
  return max2f(__uint_as_float(rr[0]),__uint_as_float(rr[1]));
}
__device__ __forceinline__ void pv(f32x16*o,int vb,bf16x8 pa0,bf16x8 pa1,bf16x8 pa2,bf16x8 pa3){
  #pragma unroll
  for(int d0=0;d0<2;++d0){s16x4 lo[4],hi[4];
    #pragma unroll
    for(int ks=0;ks<4;++ks){
      asm volatile("ds_read_b64_tr_b16 %0,%1 offset:%c2":"=&v"(lo[ks]):"v"(vb),"i"(d0*4096+ks*1024):"memory");
      asm volatile("ds_read_b64_tr_b16 %0,%1 offset:%c2":"=&v"(hi[ks]):"v"(vb),"i"(d0*4096+ks*1024+512):"memory");}
    asm volatile("s_waitcnt lgkmcnt(0)":::"memory");SBAR();
    #define PK(k) (bf16x8){lo[k][0],lo[k][1],lo[k][2],lo[k][3],hi[k][0],hi[k][1],hi[k][2],hi[k][3]}
    o[d0]=__builtin_amdgcn_mfma_f32_32x32x16_bf16(pa0,PK(0),o[d0],0,0,0);
    o[d0]=__builtin_amdgcn_mfma_f32_32x32x16_bf16(pa1,PK(1),o[d0],0,0,0);
    o[d0]=__builtin_amdgcn_mfma_f32_32x32x16_bf16(pa2,PK(2),o[d0],0,0,0);
    o[d0]=__builtin_amdgcn_mfma_f32_32x32x16_bf16(pa3,PK(3),o[d0],0,0,0);
    #undef PK
  }
}

#ifndef ATTN_STORE16
#define ATTN_STORE16(p,v) (*(u32x4*)(p)=(v))
#endif
template<int THRL> __device__ __forceinline__ void attn_unit(int qb,int SEQ,const bf16*Q,int QP,const bf16*__restrict__ K,const bf16*__restrict__ V,int KP,bf16*O,int OP,char*shm){
  int tid_=threadIdx.x; asm volatile("":"+v"(tid_)); const int tid=tid_,lane=tid&63,r32=lane&31,hi=lane>>5; const int wid=__builtin_amdgcn_readfirstlane(tid>>6);
  const int q0=qb*QB;
  const bf16*Qw=Q+(long)(q0+wid*QBLK)*QP;
  const bf16*Kh=K,*Vh=V;
  const unsigned lds0=(unsigned)(uintptr_t)shm;
  float*wsf=(float*)(shm+LDS_WS)+wid*64;
  const bf16*ksrc=Kh+(long)lane*KP+wid*8;
  const bf16*vsrc=Vh+(long)(16*(wid&3)+(lane>>2))*KP+(wid>>2)*32+(lane&3)*8;
  const unsigned kdst=lds0+LDS_K+wid*1024, vdst=lds0+LDS_V+wid*1024;
  #define DMA_K(t,slot) glds16(ksrc+(long)(t)*KVBLK*KP,(unsigned)__builtin_amdgcn_readfirstlane(kdst+(slot)))
  #define DMA_V(t,slot) glds16(vsrc+(long)(t)*KVBLK*KP,(unsigned)__builtin_amdgcn_readfirstlane(vdst+(slot)))
  const int vb0=(int)(lds0+LDS_V)+((lane>>4)&1)*32+(lane&3)*8+(4*hi+((lane&15)>>2))*64;
  const char*Kbase=shm+LDS_K; bf16x8 kf[8];
  const lds_cptr shm3=(lds_cptr)shm; const lds_cptr kp0=shm3+LDS_K+hi*1024+r32*16; const lds_cptr vp0=shm3+LDS_V+((lane>>4)&1)*32+(lane&3)*8+(4*hi+((lane&15)>>2))*64;
  const int NT=SEQ/KVBLK;
  DMA_K(0,0);DMA_V(0,0);DMA_K(1,SLOTB);
  bf16x8 qr[4];
  #pragma unroll
  for(int d0=0;d0<4;++d0)qr[d0]=*reinterpret_cast<const bf16x8*>(&Qw[(long)r32*QP+d0*16+hi*8]);
  float mhat=0.f,l_reg=0.f;f32x16 o[2];o[0]=f32x16{};o[1]=f32x16{};f32x16 negm=f32x16{};asm volatile("":"+v"(negm));
  const int qrel=wid*QBLK+r32;
  #define CMASK(P0,P1,t) do{}while(0)
  bool resc=false;
  #define START(P0,P1) do{ const float rm=rowmax(P0,P1); resc=false; \
    { const float dl=rm; mhat=fadd_s(mhat,dl); \
      _Pragma("unroll") for(int r=0;r<16;++r){P0[r]=fsub_s(P0[r],dl);P1[r]=fsub_s(P1[r],dl);} \
      _Pragma("unroll") for(int r=0;r<16;++r)negm[r]=-mhat; asm volatile("":"+v"(negm)); } \
    _Pragma("unroll") for(int r=0;r<16;++r)P0[r]=__builtin_amdgcn_exp2f(P0[r]); }while(0)
  #define RESC() do{ if(resc){ asm volatile("s_waitcnt lgkmcnt(0)":::"memory"); \
      _Pragma("unroll") for(int d_=0;d_<2;++d_) _Pragma("unroll") for(int r=0;r<16;++r)o[d_][r]*=wsf[crow(r,hi)]; } }while(0)
  f32x16 pA0,pA1,pB0,pB1;
  int sl_prev=0,sl_cur=0,sl_next=SLOTB;
  #define ROT() do{sl_prev=sl_cur;sl_cur=sl_next;sl_next=(sl_next==(NSLOT-1)*SLOTB)?0:sl_next+SLOTB;}while(0)
  DMA_K(2,2*SLOTB);
  WAIT_BAR(3);
  qkt(pA0,pA1,Kbase,qr,negm,r32,hi);asm volatile("s_nop 15\n\ts_nop 7":"+v"(pA0),"+v"(pA1));CMASK(pA0,pA1,0);
  START(pA0,pA1);
  _Pragma("unroll") for(int r=0;r<16;++r)pA1[r]=__builtin_amdgcn_exp2f(pA1[r]);
  WAIT_BAR(0);
  DMA_K(3,0);DMA_V(1,SLOTB);
  ROT();
  kload8(kf,kp0+sl_cur);
  WAIT_BAR(2);
  s16x4 vlo[8],vhi[8]; u32x4 pw0,pw1,pw2,pw3;
  #define PKW(P,B) cvtpk_s(P[B],P[B+1])
  #define PAF(k) __builtin_bit_cast(bf16x8,pw##k)
  #define VFR(i) (bf16x8){vlo[i][0],vlo[i][1],vlo[i][2],vlo[i][3],vhi[i][0],vhi[i][1],vhi[i][2],vhi[i][3]}
  #define PIN(x) asm volatile("":"+v"(x))
  #define MX3(a,b,c) __builtin_fmaxf(__builtin_fmaxf((a),(b)),(c))
  #define GAPA(MF,A0,A1,A2,A3,W0,W1,PW) do{ MF; sacc+=A0; sacc+=A1; sacc+=A2; sacc+=A3; PIN(sacc); W0; W1; PIN(PW); SBAR(); }while(0)
  #define EX(v) __builtin_amdgcn_exp2f(v)
  #define GAPB(MF,X,B) do{ MF; X[B]=EX(X[B]); X[B+1]=EX(X[B+1]); X[B+2]=EX(X[B+2]); X[B+3]=EX(X[B+3]); PIN(X); SBAR(); }while(0)
  #define VRD(i) do{ vlo[i]=vtr(vp_+(((i)>>2)*4096+((i)&3)*1024)); vhi[i]=vtr(vp_+(((i)>>2)*4096+((i)&3)*1024+512)); }while(0)
  #define KRD(G,j) do{ if(G){ kload2(kf,kp0+sl_next,j); SBAR(); } }while(0)
  #define STEP(C0,C1,P0,P1,t,GK,GV,GL) do{ SBAR(); \
    const lds_cptr vp_=vp0+sl_prev; \
    VRD(0); SBAR(); float sacc=(P0[0]+P0[1]); \
    GAPA(C0=__builtin_amdgcn_mfma_f32_32x32x16_bf16(kf[0],qr[0],negm,0,0,0), P0[2],P0[3],P0[4],P0[5],     pw0[0]=PKW(P0,0), pw0[1]=PKW(P0,2), pw0); \
    VRD(4); SBAR(); GAPA(C1=__builtin_amdgcn_mfma_f32_32x32x16_bf16(kf[1],qr[0],negm,0,0,0), P0[6],P0[7],P0[8],P0[9],     pw0[2]=PKW(P0,4), pw0[3]=PKW(P0,6), pw0); \
    VRD(1); SBAR(); GAPA(C0=__builtin_amdgcn_mfma_f32_32x32x16_bf16(kf[2],qr[1],C0,0,0,0),   P0[10],P0[11],P0[12],P0[13], pw1[0]=PKW(P0,8), pw1[1]=PKW(P0,10), pw1); \
    VRD(5); SBAR(); GAPA(C1=__builtin_amdgcn_mfma_f32_32x32x16_bf16(kf[3],qr[1],C1,0,0,0),   P0[14],P0[15],P1[0],P1[1],   pw1[2]=PKW(P0,12),pw1[3]=PKW(P0,14), pw1); \
    VRD(2); SBAR(); GAPA(C0=__builtin_amdgcn_mfma_f32_32x32x16_bf16(kf[4],qr[2],C0,0,0,0),   P1[2],P1[3],P1[4],P1[5],     pw2[0]=PKW(P1,0), pw2[1]=PKW(P1,2), pw2); \
    VRD(6); SBAR(); GAPA(C1=__builtin_amdgcn_mfma_f32_32x32x16_bf16(kf[5],qr[2],C1,0,0,0),   P1[6],P1[7],P1[8],P1[9],     pw2[2]=PKW(P1,4), pw2[3]=PKW(P1,6), pw2); \
    VRD(3); SBAR(); GAPA(C0=__builtin_amdgcn_mfma_f32_32x32x16_bf16(kf[6],qr[3],C0,0,0,0),   P1[10],P1[11],P1[12],P1[13], pw3[0]=PKW(P1,8), pw3[1]=PKW(P1,10), pw3); \
    VRD(7); SBAR(); GAPA(C1=__builtin_amdgcn_mfma_f32_32x32x16_bf16(kf[7],qr[3],C1,0,0,0),   P1[14],P1[15],0.f,0.f,       pw3[2]=PKW(P1,12),pw3[3]=PKW(P1,14), pw3); \
    l_reg+=sacc; \
    if(GK){DMA_K((t)+3,sl_cur);} if(GV){DMA_V((t)+1,sl_next);} \
    CMASK(C0,C1,t); \
    { float a=MX3(C0[0],C0[1],C1[0]),b=MX3(C0[2],C0[3],C1[1]); a=MX3(a,C1[2],C1[3]); \
      _Pragma("unroll") for(int r=4;r<16;r+=4){a=MX3(a,C0[r],C0[r+1]);b=MX3(b,C0[r+2],C0[r+3]);a=MX3(a,C1[r],C1[r+1]);b=MX3(b,C1[r+2],C1[r+3]);} \
      float rm=__builtin_fmaxf(a,b); { auto rr=__builtin_amdgcn_permlane32_swap(__float_as_uint(rm),__float_as_uint(rm),false,false); rm=__builtin_fmaxf(__uint_as_float(rr[0]),__uint_as_float(rr[1])); } \
      resc=false; \
      if(__builtin_expect(__any(rm>(float)THRL),0)){ const float dl=__builtin_fmaxf(rm,0.f); mhat+=dl; \
        _Pragma("unroll") for(int r=0;r<16;++r){C0[r]-=dl;C1[r]-=dl;} \
        _Pragma("unroll") for(int r=0;r<16;++r)negm[r]=-mhat; asm volatile("":"+v"(negm)); \
        const float f=__builtin_amdgcn_exp2f(-dl); l_reg*=f; if(hi==0)wsf[r32]=f; resc=true; } } \
    SBAR(); \
    GAPB(o[0]=__builtin_amdgcn_mfma_f32_32x32x16_bf16(PAF(0),VFR(0),o[0],0,0,0), C0,0); \
    GAPB(o[1]=__builtin_amdgcn_mfma_f32_32x32x16_bf16(PAF(0),VFR(4),o[1],0,0,0), C0,4); \
    KRD(GL,0); GAPB(o[0]=__builtin_amdgcn_mfma_f32_32x32x16_bf16(PAF(1),VFR(1),o[0],0,0,0), C0,8); \
    KRD(GL,1); GAPB(o[1]=__builtin_amdgcn_mfma_f32_32x32x16_bf16(PAF(1),VFR(5),o[1],0,0,0), C0,12); \
    KRD(GL,2); GAPB(o[0]=__builtin_amdgcn_mfma_f32_32x32x16_bf16(PAF(2),VFR(2),o[0],0,0,0), C1,0); \
    KRD(GL,3); GAPB(o[1]=__builtin_amdgcn_mfma_f32_32x32x16_bf16(PAF(2),VFR(6),o[1],0,0,0), C1,4); \
    GAPB(o[0]=__builtin_amdgcn_mfma_f32_32x32x16_bf16(PAF(3),VFR(3),o[0],0,0,0), C1,8); \
    GAPB(o[1]=__builtin_amdgcn_mfma_f32_32x32x16_bf16(PAF(3),VFR(7),o[1],0,0,0), C1,12); \
    }while(0)
  int t=1;
  #undef CMASK
  #define CMASK(P0,P1,t) do{}while(0)
  for(;t+5<NT;t+=2){
    STEP(pB0,pB1,pA0,pA1,t,true,true,true);     WAIT_BAR(2); RESC(); ROT();
    STEP(pA0,pA1,pB0,pB1,t+1,true,true,true);   WAIT_BAR(2); RESC(); ROT();
  }
  #undef CMASK
  #define CMASK(P0,P1,t) do{}while(0)
  #define ENDW(tt) do{ if((tt)+3<NT){WAIT_BAR(2);} else if((tt)+2<NT){WAIT_BAR(1);} else {WAIT_BAR(0);} }while(0)
  for(;t+1<NT;t+=2){
    STEP(pB0,pB1,pA0,pA1,t,(t+3<NT),(t+1<NT),(t+1<NT));       ENDW(t);   RESC(); ROT();
    STEP(pA0,pA1,pB0,pB1,t+1,(t+4<NT),(t+2<NT),(t+2<NT));     ENDW(t+1); RESC(); ROT();
  }
  STEP(pB0,pB1,pA0,pA1,NT-1,false,false,false); RESC();
  { float sacc=pB0[0]+pB0[1]; _Pragma("unroll") for(int r=2;r<16;++r)sacc+=pB0[r]; _Pragma("unroll") for(int r=0;r<16;++r)sacc+=pB1[r]; l_reg+=sacc;
    pw0=(u32x4){PKW(pB0,0),PKW(pB0,2),PKW(pB0,4),PKW(pB0,6)};pw1=(u32x4){PKW(pB0,8),PKW(pB0,10),PKW(pB0,12),PKW(pB0,14)};pw2=(u32x4){PKW(pB1,0),PKW(pB1,2),PKW(pB1,4),PKW(pB1,6)};pw3=(u32x4){PKW(pB1,8),PKW(pB1,10),PKW(pB1,12),PKW(pB1,14)};
    SBAR(); pv(o,vb0+sl_cur,PAF(0),PAF(1),PAF(2),PAF(3)); }
  #undef PKW
  #undef PAF
  #undef VFR
  #undef PIN
  #undef MX3
  #undef GAPA
  #undef GAPB
  #undef EX
  #undef VRD
  #undef KRD
  #undef STEP
  #undef ENDW
  {auto rr=__builtin_amdgcn_permlane32_swap(__float_as_uint(l_reg),__float_as_uint(l_reg),false,false);l_reg=__uint_as_float(rr[0])+__uint_as_float(rr[1]);}
  if(hi==0)wsf[32+r32]=l_reg;asm volatile("s_waitcnt lgkmcnt(0)":::"memory");
  float rli[16];
  #pragma unroll
  for(int r=0;r<16;++r)rli[r]=__builtin_amdgcn_rcpf(wsf[32+crow(r,hi)]);
  bf16*Ow=O+(long)(q0+wid*QBLK)*OP;
  { bf16*stg=(bf16*)(shm+LDS_OST)+wid*2048;
    #pragma unroll
    for(int r=0;r<16;++r){const int orow=crow(r,hi);
      #pragma unroll
      for(int d0=0;d0<2;++d0)stg[orow*64+d0*32+r32]=__float2bfloat16(o[d0][r]*rli[r]);}
    asm volatile("s_waitcnt lgkmcnt(0)":::"memory");
    #pragma unroll
    for(int i=0;i<4;++i){const int row=i*8+(lane>>3),ch=lane&7; const u32x4 v=*(const u32x4*)(stg+row*64+ch*8); ATTN_STORE16(Ow+(long)row*OP+ch*8,v);} }
  asm volatile("s_waitcnt lgkmcnt(0)\n\ts_barrier":::"memory");
  #undef DMA_K
  #undef DMA_V
  #undef CMASK
  #undef START
  #undef RESC
  #undef ROT
}
constexpr int ATTN_LDS_BYTES=LDS_BYTES;
#undef SBAR
#undef WAIT_BAR
}
namespace xb {
#define GAS __attribute__((address_space(1)))
#define LAS __attribute__((address_space(3)))
typedef GAS unsigned gu32;
typedef GAS unsigned long long gu64;
#define RLX_AGENT __ATOMIC_RELAXED, __HIP_MEMORY_SCOPE_AGENT
#define LDS_WAIT() asm volatile("s_waitcnt lgkmcnt(0)" ::: "memory")
#define VM_WAIT() asm volatile("s_waitcnt vmcnt(0)" ::: "memory")
__device__ __forceinline__ unsigned long long rt() { return __builtin_amdgcn_s_memrealtime(); }
__device__ __forceinline__ unsigned f2bf(float f) { unsigned u = __builtin_bit_cast(unsigned, f); return (u + 0x7fffu + ((u >> 16) & 1u)) >> 16; }
__device__ __forceinline__ unsigned pk2(float lo, float hi) { return f2bf(lo) | (f2bf(hi) << 16); }

#define XB_TMO      128
#define XB_XCNT(j)  (256  + 64 * (j))
#define XB_XSUB(j)  (1280 + 64 * (j))
#define XB_XGEN(j)  (2304 + 64 * (j))
#define XB_TOP      3328
#define XB_TOPGEN   3392
#define XCD_BAR_WORDS 3456
#define XB_SPIN_CAP (1u << 18)

__device__ __forceinline__ unsigned xb_ld(unsigned* p)              { return __hip_atomic_load(p, __ATOMIC_RELAXED, __HIP_MEMORY_SCOPE_AGENT); }
__device__ __forceinline__ unsigned xb_add(unsigned* p, unsigned v) { return __hip_atomic_fetch_add(p, v, __ATOMIC_RELAXED, __HIP_MEMORY_SCOPE_AGENT); }
__device__ __forceinline__ unsigned xb_xcc_id() { return (unsigned)__builtin_amdgcn_s_getreg((3 << 11) | 20) & 0xFu; }
#define XB_SPIN(cond, bar) do { unsigned _sp = 0; while (cond) { __builtin_amdgcn_s_sleep(1); \
    if ((++_sp & 255u) == 0u) { if (xb_ld(&(bar)[XB_TMO])) break; if (_sp > XB_SPIN_CAP) { atomicAdd(&(bar)[XB_TMO], 1u); break; } } } } while (0)

struct XcdBarrier {
    unsigned* bar; unsigned x;
    volatile LAS unsigned* st;
};

__device__ __forceinline__ XcdBarrier xcd_barrier_post(unsigned* bar, volatile LAS unsigned* st) {
    XcdBarrier b; b.bar = bar; b.x = xb_xcc_id(); b.st = st;
    if (threadIdx.x == 0) (void)xb_add(&bar[XB_XCNT(b.x)], 1u);
    return b;
}
__device__ __forceinline__ void xcd_barrier_complete(unsigned* bar, unsigned x, unsigned& nloc, unsigned& nx) {
    const unsigned G = gridDim.x * gridDim.y * gridDim.z;
    unsigned sum, cnt, mine, sp = 0u;
    for (;;) {
        sum = 0u; cnt = 0u; mine = 0u;
#pragma unroll
        for (unsigned j = 0; j < 16; ++j) { const unsigned c = xb_ld(&bar[XB_XCNT(j)]); sum += c; cnt += (c > 0u) ? 1u : 0u; mine = (j == x) ? c : mine; }
        if (sum == G) break;
        __builtin_amdgcn_s_sleep(1);
        if ((++sp & 255u) == 0u) { if (xb_ld(&bar[XB_TMO])) break; if (sp > XB_SPIN_CAP) { atomicAdd(&bar[XB_TMO], 1u); break; } }
    }
    nloc = mine > 0u ? mine : 1u; nx = cnt > 0u ? cnt : 1u;
}

__device__ __forceinline__ void xcd_barrier(const XcdBarrier& b) {
    asm volatile("s_waitcnt vmcnt(0)" ::: "memory");
    __syncthreads();
    if (threadIdx.x == 0) {
        unsigned* bar = b.bar;
        __builtin_amdgcn_s_waitcnt(0);
        unsigned nloc = b.st[0], nx = b.st[1];
        if (nloc == 0u) { xcd_barrier_complete(bar, b.x, nloc, nx); b.st[0] = nloc; b.st[1] = nx; }
        const unsigned old = xb_add(&bar[XB_XSUB(b.x)], 1u);
        const unsigned gen = old / nloc;
        if (old + 1u == (gen + 1u) * nloc) {
            __builtin_amdgcn_fence(__ATOMIC_RELEASE, "agent");
            asm volatile("s_waitcnt vmcnt(0)" ::: "memory");
            const unsigned og = xb_add(&bar[XB_TOP], 1u);
            const unsigned tg = og / nx;
            if (og + 1u == (tg + 1u) * nx) xb_add(&bar[XB_TOPGEN], 1u);
            else XB_SPIN(xb_ld(&bar[XB_TOPGEN]) == tg, bar);
            __builtin_amdgcn_fence(__ATOMIC_ACQUIRE, "agent");
            xb_add(&bar[XB_XGEN(b.x)], 1u);
            asm volatile("s_waitcnt vmcnt(0)" ::: "memory");
        } else {
            XB_SPIN(xb_ld(&bar[XB_XGEN(b.x)]) == gen, bar);
            __builtin_amdgcn_fence(__ATOMIC_ACQUIRE, "agent");
            asm volatile("s_waitcnt vmcnt(0)" ::: "memory");
        }
    }
    __syncthreads();
}

}

namespace mk {
typedef unsigned short bf16_t;
typedef short bf16x8 __attribute__((ext_vector_type(8)));
typedef float f32x4 __attribute__((ext_vector_type(4)));
typedef unsigned u32x4 __attribute__((ext_vector_type(4)));
typedef unsigned u32x2 __attribute__((ext_vector_type(2)));
typedef float f32x2 __attribute__((ext_vector_type(2)));

constexpr int DMODEL = 1024, TS = 16384, NSEG = 4, DFF = 4096;
constexpr int EIN = 1792, OIN = 4368, OINP = 4608, OOUT = 768;
constexpr float EPS = 1e-6f;
constexpr size_t MiB = (size_t)1 << 20;
constexpr size_t WS_W1T = 1 * MiB, WS_W2T = 33 * MiB, WS_WINE = 65 * MiB, WS_WOUTE = 72 * MiB, WS_WINO = 76 * MiB, WS_WOUTO = 94 * MiB,
                 WS_GW = 97 * MiB, WS_H = 98 * MiB, WS_PROJ = 130 * MiB, WS_SCR = 274 * MiB, WS_END = 512 * MiB;
constexpr size_t SC_HID = 0;
constexpr size_t SC_LA = 0, SC_UU = 64 * MiB, SC_AGG = 128 * MiB;
constexpr size_t SC_QKVP = 0, SC_DNI = 48 * MiB, SC_OB = 192 * MiB, SC_LSE = 224 * MiB, SC_EGL = 225 * MiB;
constexpr int DNI_BYTES = 73728, DNI_W = 0, DNI_QT = 16384, DNI_KTT = 32768, DNI_A = 49152, DNI_U = 57344;
constexpr int LDS_BYTES = 147456;
constexpr int NT = 512, NW = 8;

struct Params { const float* in[25]; float* out; unsigned char* ws; };

__device__ __forceinline__ float bf2f(bf16_t v) { return __uint_as_float(((unsigned)v) << 16); }
__device__ __forceinline__ unsigned f2bf(float f) { unsigned u = __float_as_uint(f); return (u + 0x7fffu + ((u >> 16) & 1u)) >> 16; }
__device__ __forceinline__ unsigned pk2(float lo, float hi) { return attn_body::cvtpk_s(lo, hi); }
__device__ __forceinline__ float wave_sum(float v) {
#pragma unroll
    for (int o = 1; o < 64; o <<= 1) v += __shfl_xor(v, o);
    return v;
}
__device__ __forceinline__ float sigm(float x) { return __builtin_amdgcn_rcpf(1.f + __expf(-x)); }
__device__ __forceinline__ float softplus(float x) { return x > 20.f ? x : log1pf(__expf(x)); }
__device__ __forceinline__ float silu(float x) { return x * sigm(x); }
__device__ __forceinline__ float gelu_tanh(float x) { const float t = 0.7978845608028654f * (x + 0.044715f * x * x * x); return x * __builtin_amdgcn_rcpf(1.f + __expf(-2.f * t)); }
__device__ __forceinline__ void unpack8(const u32x4 v, float* f) {
    f[0] = __uint_as_float(v.x << 16); f[1] = __uint_as_float(v.x & 0xffff0000u); f[2] = __uint_as_float(v.y << 16); f[3] = __uint_as_float(v.y & 0xffff0000u);
    f[4] = __uint_as_float(v.z << 16); f[5] = __uint_as_float(v.z & 0xffff0000u); f[6] = __uint_as_float(v.w << 16); f[7] = __uint_as_float(v.w & 0xffff0000u);
}
#define MK_IDS() int tid = threadIdx.x; asm volatile("" : "+v"(tid)); const int lane = tid & 63, wave = __builtin_amdgcn_readfirstlane(tid >> 6); const int gw = blockIdx.x * NW + wave, NGW = gridDim.x * NW; (void)lane; (void)wave; (void)gw; (void)NGW
#define MFMA16(a, b, c) __builtin_amdgcn_mfma_f32_16x16x32_bf16((a), (b), (c), 0, 0, 0)

__device__ __forceinline__ void transpose_item(const float* W, int K, int Nsrc, int Npad, bf16_t* WT, float* scr, int item, int lane, const float* gain = nullptr) {
    const int nblk = Npad / 32, kb = item / nblk, nb = item % nblk, k0 = 64 * kb, n0 = 32 * nb;
    const int n = n0 + (lane & 31);
#pragma unroll 8
    for (int i = 0; i < 32; ++i) { const int kk = 2 * i + (lane >> 5); scr[kk * 33 + (lane & 31)] = (n < Nsrc) ? W[(size_t)(k0 + kk) * Nsrc + n] * (gain ? gain[k0 + kk] : 1.f) : 0.f; }
    asm volatile("s_waitcnt lgkmcnt(0)" ::: "memory");
    const int c = lane & 7;
#pragma unroll
    for (int j = 0; j < 4; ++j) { const int nn = (lane >> 3) + 8 * j; const float* s = scr + (8 * c) * 33 + nn;
        u32x4 o; o.x = pk2(s[0 * 33], s[1 * 33]); o.y = pk2(s[2 * 33], s[3 * 33]); o.z = pk2(s[4 * 33], s[5 * 33]); o.w = pk2(s[6 * 33], s[7 * 33]);
        *(u32x4*)(WT + (size_t)(n0 + nn) * K + k0 + 8 * c) = o; }
    asm volatile("s_waitcnt lgkmcnt(0)" ::: "memory");
}
__device__ __forceinline__ void phase_prologue(const Params& p, char* lds) {
    MK_IDS();
    float* scr = (float*)(lds + wave * 16384);
    unsigned char* ws = p.ws;
    constexpr int I_F1 = 16 * 128, I_F2 = 64 * 32, I_IE = 16 * 56, I_OE = 16 * 32, I_IO = 16 * 144, I_OO = 12 * 32;
    constexpr int T_F1 = 4 * I_F1, T_F2 = T_F1 + 4 * I_F2, T_IE = T_F2 + 2 * I_IE, T_OE = T_IE + 2 * I_OE, T_IO = T_OE + 2 * I_IO, T_OO = T_IO + 2 * I_OO;
    for (int it = gw; it < T_OO; it += NGW) {
        if (it < T_F1) { const int l = it / I_F1, r = it % I_F1; transpose_item(p.in[6] + (size_t)l * 1024 * 4096, 1024, 4096, 4096, (bf16_t*)(ws + WS_W1T) + (size_t)l * 4096 * 1024, scr, r, lane, p.in[4] + l * 1024); }
        else if (it < T_F2) { const int q = it - T_F1, l = q / I_F2, r = q % I_F2; transpose_item(p.in[7] + (size_t)l * 4096 * 1024, 4096, 1024, 1024, (bf16_t*)(ws + WS_W2T) + (size_t)l * 1024 * 4096, scr, r, lane); }
        else if (it < T_IE) { const int q = it - T_F2, l = q / I_IE, r = q % I_IE; transpose_item(p.in[8] + (size_t)l * 1024 * EIN, 1024, EIN, EIN, (bf16_t*)(ws + WS_WINE) + (size_t)l * EIN * 1024, scr, r, lane, p.in[3] + (2 * l) * 1024); }
        else if (it < T_OE) { const int q = it - T_IE, l = q / I_OE, r = q % I_OE; transpose_item(p.in[9] + (size_t)l * 1024 * 1024, 1024, 1024, 1024, (bf16_t*)(ws + WS_WOUTE) + (size_t)l * 1024 * 1024, scr, r, lane); }
        else if (it < T_IO) { const int q = it - T_OE, l = q / I_IO, r = q % I_IO; transpose_item(p.in[19] + (size_t)l * 1024 * OIN, 1024, OIN, OINP, (bf16_t*)(ws + WS_WINO) + (size_t)l * OINP * 1024, scr, r, lane, p.in[3] + (2 * l + 1) * 1024); }
        else { const int q = it - T_IO, l = q / I_OO, r = q % I_OO; transpose_item(p.in[20] + (size_t)l * OOUT * 1024, OOUT, 1024, 1024, (bf16_t*)(ws + WS_WOUTO) + (size_t)l * 1024 * OOUT, scr, r, lane); }
    }
    bf16_t* GW = (bf16_t*)(ws + WS_GW);
    const int gt = gw * 64 + lane, NGT = NGW * 64;
    for (int idx = gt; idx < 2 * 2 * 2 * 8 * 4096; idx += NGT) {
        const int d = idx & 63, e = (idx >> 6) & 63, blk = (idx >> 12) & 7, gate = (idx >> 15) & 1, dir = (idx >> 16) & 1, j = (idx >> 17) & 1;
        const float* src = gate ? p.in[16] : p.in[14];
        GW[idx] = (bf16_t)f2bf(src[((((size_t)j * 2 + dir) * 8 + blk) * 64 + d) * 64 + e]);
    }
}

__device__ __forceinline__ void phase_x0(const float* x, bf16_t* xb, float* ssq) {
    MK_IDS();
    for (int m = gw; m < TS; m += NGW) {
        const f32x4* xr = (const f32x4*)(x + (size_t)m * DMODEL) + lane;
        f32x4 v[4]; float s = 0.f;
#pragma unroll
        for (int j = 0; j < 4; ++j) { v[j] = xr[64 * j]; s += (v[j].x * v[j].x + v[j].y * v[j].y) + (v[j].z * v[j].z + v[j].w * v[j].w); }
        s = wave_sum(s);
        u32x2* o8 = (u32x2*)(xb + (size_t)m * DMODEL) + lane;
#pragma unroll
        for (int j = 0; j < 4; ++j) { u32x2 o; o.x = pk2(v[j].x, v[j].y); o.y = pk2(v[j].z, v[j].w); o8[64 * j] = o; }
        if (lane < 16) ssq[(size_t)m * 16 + lane] = lane == 0 ? s : 0.f;
    }
}
__device__ __forceinline__ void zero_f32(float* ptr, int n) {
    MK_IDS();
    for (int i = gw * 64 + lane; i < n; i += NGW * 64) ptr[i] = 0.f;
}
__device__ __forceinline__ void phase_rmsnorm_final(const bf16_t* xb, float* x, const float* g) {
    MK_IDS();
    for (int m = gw; m < TS; m += NGW) {
        const u32x2* xr = (const u32x2*)(xb + (size_t)m * DMODEL) + lane; f32x4* xw = (f32x4*)(x + (size_t)m * DMODEL) + lane; const f32x4* gr = (const f32x4*)g + lane;
        f32x4 v[4]; float s = 0.f;
#pragma unroll
        for (int j = 0; j < 4; ++j) { const u32x2 w = xr[64 * j]; v[j] = (f32x4){__uint_as_float(w.x << 16), __uint_as_float(w.x & 0xffff0000u), __uint_as_float(w.y << 16), __uint_as_float(w.y & 0xffff0000u)};
            s += (v[j].x * v[j].x + v[j].y * v[j].y) + (v[j].z * v[j].z + v[j].w * v[j].w); }
        const float rstd = 1.f / sqrtf(wave_sum(s) * (1.f / DMODEL) + EPS);
#pragma unroll
        for (int j = 0; j < 4; ++j) { const f32x4 gg = gr[64 * j]; xw[64 * j] = v[j] * rstd * gg; }
    }
}
struct EpiRes {
    static constexpr bool PERM = true, AFTER_DRAIN = false;
    bf16_t* xb; float* ssq; int ldc; const float* sin;
    __device__ __forceinline__ void operator()(const pg8::f32x4 (&acc)[2][2][4][2], const pg8::Unit& u, int wr, int wc, int fr, int fq) const {
        const int col0 = u.pn * pg8::BM + wc * 32 + 8 * fq;
        float rs2a[2][4];
        if (sin) { pg8::f32x4 t_[2][4];
#pragma unroll
            for (int ai = 0; ai < 2; ++ai)
#pragma unroll
                for (int m = 0; m < 4; ++m) t_[ai][m] = *(const pg8::f32x4*)(sin + (size_t)(u.pm * pg8::BM + ai * pg8::HALF + wr * 64 + m * 16 + fr) * 16 + fq * 4);
#pragma unroll
            for (int ai = 0; ai < 2; ++ai)
#pragma unroll
                for (int m = 0; m < 4; ++m) { float s_ = (t_[ai][m][0] + t_[ai][m][1]) + (t_[ai][m][2] + t_[ai][m][3]); s_ += __shfl_xor(s_, 16); s_ += __shfl_xor(s_, 32); rs2a[ai][m] = __builtin_amdgcn_rcpf(s_ * (1.0f / 1024.0f) + 1e-6f); }
        } else {
#pragma unroll
            for (int ai = 0; ai < 2; ++ai)
#pragma unroll
                for (int m = 0; m < 4; ++m) rs2a[ai][m] = 1.f; }
#pragma unroll
        for (int ai = 0; ai < 2; ++ai)
#pragma unroll
            for (int m = 0; m < 4; ++m) { const int row = u.pm * pg8::BM + ai * pg8::HALF + wr * 64 + m * 16 + fr; const size_t off = (size_t)row * ldc + col0; float sq = 0.f;
                const float rs2 = rs2a[ai][m];
                u32x4 bw[2];
#pragma unroll
                for (int bj = 0; bj < 2; ++bj) bw[bj] = *(const u32x4*)(xb + off + bj * pg8::HALF);
#pragma unroll
                for (int bj = 0; bj < 2; ++bj) { float b[8]; unpack8(bw[bj], b); const pg8::f32x4 a0 = acc[ai][bj][m][0] * rs2, a1 = acc[ai][bj][m][1] * rs2;
                    const float o0 = b[0] + a0[0], o1 = b[1] + a0[1], o2 = b[2] + a0[2], o3 = b[3] + a0[3], o4 = b[4] + a1[0], o5 = b[5] + a1[1], o6 = b[6] + a1[2], o7 = b[7] + a1[3];
                    u32x4 w; w.x = pg8::cvt_pk_bf16(o0, o1); w.y = pg8::cvt_pk_bf16(o2, o3); w.z = pg8::cvt_pk_bf16(o4, o5); w.w = pg8::cvt_pk_bf16(o6, o7);
                    *(u32x4*)(xb + off + bj * pg8::HALF) = w;
                    sq += ((o0 * o0 + o1 * o1) + (o2 * o2 + o3 * o3)) + ((o4 * o4 + o5 * o5) + (o6 * o6 + o7 * o7)); }
                sq += __shfl_xor(sq, 16); sq += __shfl_xor(sq, 32);
                if (fq == 0) ssq[(size_t)row * 16 + u.pn * 4 + wc] = sq;
                if (m & 1) asm volatile("" ::: "memory"); }
    }
};

__device__ __forceinline__ void even_qk_post(bf16_t* proj, const float* qg, const float* kg, int S) {
    MK_IDS();
    const int g = lane & 7, axis = g >> 2, half = (g >> 1) & 1;
    float inv[8], gq[8], gk[8];
#pragma unroll
    for (int e = 0; e < 8; ++e) { inv[e] = exp2f(-(float)((g & 1) * 8 + e) * (13.287712379549449f / 16.f)); gq[e] = qg[g * 8 + e] * attn_body::C2; gk[e] = kg[g * 8 + e]; }
    for (int t = gw; t < TS; t += NGW) {
        const int s = t % S; const float pos = (float)(axis ? (s & 63) : (s >> 6));
        bf16_t* row = proj + (size_t)t * EIN;
        const u32x4 qa = *(const u32x4*)(row + lane * 8); u32x4 ka = {0u, 0u, 0u, 0u}; if (lane < 16) ka = *(const u32x4*)(row + 512 + lane * 8);
        float cs[8], sn[8];
#pragma unroll
        for (int e = 0; e < 8; ++e) { const float ang = pos * inv[e]; cs[e] = __cosf(ang); sn[e] = __sinf(ang); }
        float xq[8], xk[8]; unpack8(qa, xq); unpack8(ka, xk);
        float sq = 0.f, sk = 0.f;
#pragma unroll
        for (int e = 0; e < 8; ++e) { sq += xq[e] * xq[e]; sk += xk[e] * xk[e]; }
        sq += __shfl_xor(sq, 1); sq += __shfl_xor(sq, 2); sq += __shfl_xor(sq, 4);
        sk += __shfl_xor(sk, 1); sk += __shfl_xor(sk, 2); sk += __shfl_xor(sk, 4);
        const float rq = __builtin_amdgcn_rsqf(sq * (1.f / 64.f) + EPS), rk = __builtin_amdgcn_rsqf(sk * (1.f / 64.f) + EPS);
        float oq[8], ok[8];
#pragma unroll
        for (int e = 0; e < 8; ++e) { const float yq = xq[e] * rq * gq[e], yk = xk[e] * rk * gk[e];
            const float pq = __shfl_xor(yq, 2), pk = __shfl_xor(yk, 2);
            oq[e] = yq * cs[e] + (half ? pq : -pq) * sn[e]; ok[e] = yk * cs[e] + (half ? pk : -pk) * sn[e]; }
        u32x4 o; o.x = pk2(oq[0], oq[1]); o.y = pk2(oq[2], oq[3]); o.z = pk2(oq[4], oq[5]); o.w = pk2(oq[6], oq[7]);
        *(u32x4*)(row + lane * 8) = o;
        if (lane < 16) { u32x4 o2; o2.x = pk2(ok[0], ok[1]); o2.y = pk2(ok[2], ok[3]); o2.z = pk2(ok[4], ok[5]); o2.w = pk2(ok[6], ok[7]); *(u32x4*)(row + 512 + lane * 8) = o2; }
    }
}
__device__ __forceinline__ void even_lru_prep(const bf16_t* proj, const float* cw, const float* cb, const bf16_t* GWj, const float* br, const float* bi, const float* lam,
                                              unsigned* LU, f32x2* AGG, int S, char* lds) {
    MK_IDS();
    constexpr int XST = 1040;
    for (int tile = blockIdx.x; tile < TS / 64; tile += gridDim.x) {
        const int t0 = tile * 64;
        __syncthreads();
#pragma unroll 2
        for (int k = 0; k < 8; ++k) {
            const int idx = tid + k * NT, i = idx >> 6, cgp = idx & 63, t = t0 + i, s = t % S, ch = cgp * 8;
            float acc[8];
#pragma unroll
            for (int e = 0; e < 8; ++e) acc[e] = cb[ch + e];
#pragma unroll
            for (int j = 0; j < 4; ++j) { const int sp = s + j - 2;
                if (sp >= 0 && sp < S) { const u32x4 v = *(const u32x4*)(proj + (size_t)(t + j - 2) * EIN + 768 + ch); float xv[8]; unpack8(v, xv);
#pragma unroll
                    for (int e = 0; e < 8; ++e) acc[e] += cw[j * 512 + ch + e] * xv[e]; } }
            u32x4 o; o.x = pk2(acc[0], acc[1]); o.y = pk2(acc[2], acc[3]); o.z = pk2(acc[4], acc[5]); o.w = pk2(acc[6], acc[7]);
            *(u32x4*)(lds + i * XST + ch * 2) = o;
        }
        __syncthreads();
        const int G = lane >> 4, l16 = lane & 15, ch0 = wave * 64;
        for (int dir = 0; dir < 2; ++dir)
            for (int nt = 0; nt < 4; ++nt) {
                const int e = nt * 16 + l16, ch = ch0 + e;
                bf16x8 Br[2], Bi[2];
#pragma unroll
                for (int kk = 0; kk < 2; ++kk) {
                    Br[kk] = *(const bf16x8*)(GWj + ((((size_t)dir * 2 + 0) * 8 + wave) * 64 + e) * 64 + kk * 32 + G * 8);
                    Bi[kk] = *(const bf16x8*)(GWj + ((((size_t)dir * 2 + 1) * 8 + wave) * 64 + e) * 64 + kk * 32 + G * 8);
                }
                const float brv = br[dir * 512 + ch], biv = bi[dir * 512 + ch], spl = softplus(-lam[dir * 512 + ch]);
#pragma unroll
                for (int mt = 0; mt < 4; ++mt) {
                    f32x4 ar = {0.f, 0.f, 0.f, 0.f}, ai = {0.f, 0.f, 0.f, 0.f};
#pragma unroll
                    for (int kk = 0; kk < 2; ++kk) { const bf16x8 a = *(const bf16x8*)(lds + (mt * 16 + l16) * XST + (ch0 + kk * 32 + G * 8) * 2); ar = MFMA16(a, Br[kk], ar); ai = MFMA16(a, Bi[kk], ai); }
#pragma unroll
                    for (int r = 0; r < 4; ++r) { const int i = mt * 16 + G * 4 + r;
                        const float xc = bf2f(*(const bf16_t*)(lds + i * XST + ch * 2));
                        const float rg = __builtin_amdgcn_rcpf(1.f + __expf(-(ar[r] + brv))), ig = __builtin_amdgcn_rcpf(1.f + __expf(-(ai[r] + biv)));
                        const float la = -8.f * rg * spl; const float uu = __builtin_amdgcn_sqrtf(fmaxf(1.f - __expf(2.f * la), 0.f)) * (ig * xc);
                        LU[((size_t)dir * TS + t0 + i) * 512 + ch] = attn_body::cvtpk_s(la, uu); }
                }
            }
        asm volatile("s_waitcnt vmcnt(0)" ::: "memory");
        __syncthreads();
        {
            const int ch = tid;
#pragma unroll
            for (int dir = 0; dir < 2; ++dir) {
                float h = 0.f, P = 0.f;
                const unsigned* lu = LU + ((size_t)dir * TS + t0) * 512 + ch;
#pragma unroll
                for (int q = 0; q < 64; q += 8) {
                    float lv[8], uv[8];
#pragma unroll
                    for (int e = 0; e < 8; ++e) { const int i = dir ? 63 - (q + e) : q + e; const unsigned w_ = lu[(size_t)i * 512]; lv[e] = __uint_as_float(w_ << 16); uv[e] = __uint_as_float(w_ & 0xffff0000u); }
#pragma unroll
                    for (int e = 0; e < 8; ++e) { h = __expf(lv[e]) * h + uv[e]; P += lv[e]; }
                }
                AGG[((size_t)dir * (TS / 64) + tile) * 512 + ch] = (f32x2){P, h};
            }
        }
    }
}
__device__ __forceinline__ void even_lru_scan(const unsigned* LU, const f32x2* AGG, const bf16_t* proj, bf16_t* Y, int S) {
    MK_IDS();
    const int ch = tid, TPB = S / 64;
    for (int tile = blockIdx.x; tile < TS / 64; tile += gridDim.x) {
        const int t0 = tile * 64, tb0 = (tile / TPB) * TPB;
        float cf = 0.f, cr = 0.f;
        for (int k0 = tb0; k0 < tile; k0 += 8) { f32x2 a[8];
#pragma unroll
            for (int q = 0; q < 8; ++q) { const int k = k0 + q < tile ? k0 + q : tile - 1; a[q] = AGG[(size_t)k * 512 + ch]; }
#pragma unroll
            for (int q = 0; q < 8; ++q) if (k0 + q < tile) cf = cf * __expf(a[q].x) + a[q].y; }
        for (int k0 = tb0 + TPB - 1; k0 > tile; k0 -= 8) { f32x2 a[8];
#pragma unroll
            for (int q = 0; q < 8; ++q) { const int k = k0 - q > tile ? k0 - q : tile + 1; a[q] = AGG[((size_t)(TS / 64) + k) * 512 + ch]; }
#pragma unroll
            for (int q = 0; q < 8; ++q) if (k0 - q > tile) cr = cr * __expf(a[q].x) + a[q].y; }
        float hf[64];
        {
            const unsigned* lu = LU + (size_t)t0 * 512 + ch; float h = cf;
#pragma unroll
            for (int q = 0; q < 64; q += 8) {
                float lv[8], uv[8];
#pragma unroll
                for (int e = 0; e < 8; ++e) { const unsigned w_ = lu[(size_t)(q + e) * 512]; lv[e] = __uint_as_float(w_ << 16); uv[e] = __uint_as_float(w_ & 0xffff0000u); }
#pragma unroll
                for (int e = 0; e < 8; ++e) { h = __expf(lv[e]) * h + uv[e]; hf[q + e] = h; }
            }
        }
        {
            const unsigned* lu = LU + ((size_t)TS + t0) * 512 + ch; float h = cr;
#pragma unroll
            for (int q = 0; q < 64; q += 8) {
                float lv[8], uv[8], gv[8];
#pragma unroll
                for (int e = 0; e < 8; ++e) { const int i = 63 - (q + e); { const unsigned w_ = lu[(size_t)i * 512]; lv[e] = __uint_as_float(w_ << 16); uv[e] = __uint_as_float(w_ & 0xffff0000u); } gv[e] = bf2f(proj[(size_t)(t0 + i) * EIN + 1280 + ch]); }
#pragma unroll
                for (int e = 0; e < 8; ++e) { const int i = 63 - (q + e); h = __expf(lv[e]) * h + uv[e]; Y[(size_t)(t0 + i) * DMODEL + 512 + ch] = (bf16_t)f2bf((hf[i] + h) * gelu_tanh(gv[e])); }
            }
        }
    }
}

__device__ __forceinline__ void odd_conv(const bf16_t* proj, const float* cw, bf16_t* QKVP, int S) {
    MK_IDS();
    for (int cr = 0; cr < (TS / 64 + (int)gridDim.x - 1) / (int)gridDim.x; ++cr) {
        const int c = cr * (int)gridDim.x + (int)blockIdx.x; if (c >= TS / 64) break;
        const int tb = c * 64 + wave * 8, sb = tb % S;
#pragma unroll
        for (int blk = 0; blk < 3; ++blk) {
            const int ch = blk * 512 + lane * 8;
            u32x4 rows[11];
#pragma unroll
            for (int q = 0; q < 11; ++q) { const int sp = sb + q - 2; rows[q] = (u32x4){0u, 0u, 0u, 0u};
                if (sp >= 0 && sp < S) rows[q] = *(const u32x4*)(proj + (size_t)(tb + q - 2) * OINP + ch); }
            f32x4 w0[4], w1[4];
#pragma unroll
            for (int j = 0; j < 4; ++j) { w0[j] = *(const f32x4*)(cw + j * 1536 + ch); w1[j] = *(const f32x4*)(cw + j * 1536 + ch + 4); }
#pragma unroll
            for (int i = 0; i < 8; ++i) {
                float acc[8];
#pragma unroll
                for (int e = 0; e < 8; ++e) acc[e] = 0.f;
#pragma unroll
                for (int j = 0; j < 4; ++j) { float xv[8]; unpack8(rows[i + j], xv);
                    acc[0] += w0[j].x * xv[0]; acc[1] += w0[j].y * xv[1]; acc[2] += w0[j].z * xv[2]; acc[3] += w0[j].w * xv[3];
                    acc[4] += w1[j].x * xv[4]; acc[5] += w1[j].y * xv[5]; acc[6] += w1[j].z * xv[6]; acc[7] += w1[j].w * xv[7]; }
                float ss = 0.f;
#pragma unroll
                for (int e = 0; e < 8; ++e) { acc[e] = silu(acc[e]); ss += acc[e] * acc[e]; }
                if (blk < 2) {
                    ss += __shfl_xor(ss, 1); ss += __shfl_xor(ss, 2); ss += __shfl_xor(ss, 4); ss += __shfl_xor(ss, 8);
                    const float rn = __builtin_amdgcn_rsqf(ss + EPS);
#pragma unroll
                    for (int e = 0; e < 8; ++e) acc[e] *= rn;
                }
                u32x4 o; o.x = pk2(acc[0], acc[1]); o.y = pk2(acc[2], acc[3]); o.z = pk2(acc[4], acc[5]); o.w = pk2(acc[6], acc[7]);
                *(u32x4*)(QKVP + (size_t)(tb + i) * 1536 + ch) = o;
            }
        }
    }
}

__device__ __forceinline__ int frag128(int r, int k) { return ((((r >> 4) * 4 + (k >> 5)) * 64 + ((k >> 3) & 3) * 16 + (r & 15)) << 3) + (k & 7); }
__device__ __forceinline__ int frag64(int r, int k) { return ((((r >> 4) * 2 + (k >> 5)) * 64 + ((k >> 3) & 3) * 16 + (r & 15)) << 3) + (k & 7); }
__device__ __forceinline__ void odd_prep(const bf16_t* QKVP, const bf16_t* proj, const float* alog, const float* dtb, unsigned char* DNI, float* EGL, char* lds) {
    MK_IDS();
    constexpr int RS = 272;
    constexpr int HOFF = 69632;
    const float scale = 0.08838834764831845f;
    for (int itq = 0; itq < (TS / 64 + (int)gridDim.x - 1) / (int)gridDim.x * 4; ++itq) {
        const int c_ = (itq >> 2) * (int)gridDim.x + (int)blockIdx.x; if (c_ >= TS / 64) break; const int it0 = (c_ * 4 + (itq & 3)) * 2;
        int tq_ = tid; asm volatile("" : "+v"(tq_));
        const int half = tq_ >> 8, ht = tq_ & 255, hwave = __builtin_amdgcn_readfirstlane(ht >> 6), G = (tq_ & 63) >> 4, l16 = tq_ & 15;
        char* L = lds + half * HOFF;
        char* KS = L, *QS = L + 17408, *VS = L + 34816; float* LM = (float*)(L + 52224); float* GC = (float*)(L + 68608); float* BT = GC + 64; float* EG = BT + 64;
        const int it = it0 + half; const int d = it & 1, h = (it >> 1) & 3, c = it >> 3, t0 = c * 64;
        __syncthreads();
#pragma unroll
        for (int k = 0; k < 4; ++k) { const int idx = ht + k * 256, i = idx >> 4, pc = idx & 15; const int tk = d ? t0 + 63 - i : t0 + i;
            const bf16_t* src = QKVP + (size_t)tk * 1536 + h * 128 + pc * 8;
            *(u32x4*)(QS + i * RS + pc * 16) = *(const u32x4*)(src);
            *(u32x4*)(KS + i * RS + pc * 16) = *(const u32x4*)(src + 512);
            *(u32x4*)(VS + i * RS + pc * 16) = *(const u32x4*)(src + 1024); }
        if (hwave == 0) {
            const int i = lane; const int tk = d ? t0 + 63 - i : t0 + i;
            const float bl = bf2f(proj[(size_t)tk * OINP + 2048 + d * 4 + h]), al = bf2f(proj[(size_t)tk * OINP + 2056 + d * 4 + h]);
            const float beta = sigm(bl); float g = -__expf(alog[d * 4 + h]) * softplus(al + dtb[d * 4 + h]);
#pragma unroll
            for (int o = 1; o < 64; o <<= 1) { const float v = __shfl_up(g, o); if (lane >= o) g += v; }
            GC[i] = g; BT[i] = beta; EG[i] = __expf(g);
        }
        __syncthreads();
        {
            const bool isq = hwave >= 2; const char* XS = isq ? QS : KS;
#pragma unroll
            for (int mm = 0; mm < 2; ++mm) { const int mt = (hwave & 1) * 2 + mm;
                bf16x8 a[4];
#pragma unroll
                for (int kk = 0; kk < 4; ++kk) a[kk] = *(const bf16x8*)(XS + (mt * 16 + l16) * RS + (kk * 32 + G * 8) * 2);
#pragma unroll
                for (int nt = 0; nt < 4; ++nt) { f32x4 acc = {0.f, 0.f, 0.f, 0.f};
#pragma unroll
                    for (int kk = 0; kk < 4; ++kk) { const bf16x8 bb = *(const bf16x8*)(KS + (nt * 16 + l16) * RS + (kk * 32 + G * 8) * 2); acc = MFMA16(a[kk], bb, acc); }
                    const int j = nt * 16 + l16; const float gj = GC[j];
#pragma unroll
                    for (int r = 0; r < 4; ++r) { const int i = mt * 16 + G * 4 + r; const float dec = __expf(fminf(GC[i] - gj, 0.f));
                        if (!isq) LM[i * 64 + j] = (j < i) ? BT[i] * acc[r] * dec : 0.f;
                        else ((bf16_t*)(DNI + (size_t)it * DNI_BYTES + DNI_A))[frag64(i, j)] = (bf16_t)f2bf((j <= i) ? acc[r] * scale * dec : 0.f); }
                }
            }
        }
        __syncthreads();
        {
            float sol[64];
            const int cc = ht & 127; const bool isw = ht >= 128; const char* XS = isw ? KS : VS;
#pragma unroll
            for (int i = 0; i < 64; ++i) {
                float v = bf2f(*(const bf16_t*)(XS + i * RS + cc * 2)) * BT[i]; if (isw) v *= EG[i];
                float a0 = 0.f, a1 = 0.f;
#pragma unroll
                for (int j4 = 0; j4 < (i + 3) / 4; ++j4) { const f32x4 l4 = *(const f32x4*)(LM + i * 64 + j4 * 4);
                    if (j4 * 4 + 0 < i) a0 += l4.x * sol[j4 * 4 + 0]; if (j4 * 4 + 1 < i) a1 += l4.y * sol[j4 * 4 + 1];
                    if (j4 * 4 + 2 < i) a0 += l4.z * sol[j4 * 4 + 2]; if (j4 * 4 + 3 < i) a1 += l4.w * sol[j4 * 4 + 3];
                    if ((j4 & 1) == 1) asm volatile("" ::: "memory"); }
                v -= a0 + a1;
                sol[i] = v;
                ((bf16_t*)(DNI + (size_t)it * DNI_BYTES + (isw ? DNI_W : DNI_U)))[isw ? frag128(i, cc) : i * 128 + cc] = (bf16_t)f2bf(v);
                asm volatile("" ::: "memory");
            }
        }
        {
            const float gl = GC[63];
#pragma unroll
            for (int k = 0; k < 4; ++k) { const int idx = ht + k * 256;
                {
                    const int i = idx & 63, kg = idx >> 6; const u32x4 raw = *(const u32x4*)(QS + i * RS + kg * 16); float f[8]; unpack8(raw, f); const float sc = scale * EG[i];
                    u32x4 o; o.x = pk2(f[0] * sc, f[1] * sc); o.y = pk2(f[2] * sc, f[3] * sc); o.z = pk2(f[4] * sc, f[5] * sc); o.w = pk2(f[6] * sc, f[7] * sc);
                    *(u32x4*)((bf16_t*)(DNI + (size_t)it * DNI_BYTES + DNI_QT) + frag128(i, kg * 8)) = o; }
                {
                    const int dm = idx & 127, tg = idx >> 7; float f[8];
#pragma unroll
                    for (int q = 0; q < 8; ++q) { const int i = tg * 8 + q; f[q] = bf2f(*(const bf16_t*)(KS + i * RS + dm * 2)) * __expf(gl - GC[i]); }
                    u32x4 o; o.x = pk2(f[0], f[1]); o.y = pk2(f[2], f[3]); o.z = pk2(f[4], f[5]); o.w = pk2(f[6], f[7]);
                    *(u32x4*)((bf16_t*)(DNI + (size_t)it * DNI_BYTES + DNI_KTT) + frag64(dm, tg * 8)) = o; }
            }
            if (ht == 0) EGL[it] = __expf(gl);
        }
    }
}

template <int NS> __device__ __forceinline__ void odd_scan(const unsigned char* DNI, const float* EGL, bf16_t* OB, int S, int nb, char* lds) {
    MK_IDS();
    constexpr int O_SB = 0, O_VN = NS * 4352, O_OUT = O_VN + NS * 2304, PFD = 7, EB = NS == 1 ? 3 : 2, NCOL = NS * 16;
    const int NC = S / 64, G = lane >> 4, l16 = lane & 15;
    const int nitems = nb * 64 / NS;
    const int mt = wave & 3; const bool lo = wave < 4;
    for (int item = blockIdx.x; item < nitems; item += gridDim.x) {
        const int e = (item >> 3) & ((1 << EB) - 1), sq = (item & 7) | ((item >> (3 + EB)) << 3); const int d = sq & 1, h = (sq >> 1) & 3, b = sq >> 3, cb = e * NCOL;
        __syncthreads();
        for (int i = tid; i < NS * 4352 / 4; i += NT) ((unsigned*)(lds + O_SB))[i] = 0u;
        f32x4 Sreg[NS];
#pragma unroll
        for (int ns = 0; ns < NS; ++ns) Sreg[ns] = (f32x4){0.f, 0.f, 0.f, 0.f};
        const long dstep = (long)(d ? -8 : 8) * DNI_BYTES;
        const unsigned char* base0 = DNI + (size_t)(((b * NC + (d ? NC - 1 : 0)) * 4 + h) * 2 + d) * DNI_BYTES;
        const unsigned char* pX = base0 + (lo ? DNI_W : DNI_QT) + ((mt * 4) * 64 + lane) * 16;
        const unsigned char* pA = base0 + DNI_A + ((mt * 2) * 64 + lane) * 16;
        const unsigned char* pK = base0 + DNI_KTT + ((wave * 2) * 64 + lane) * 16;
        const unsigned char* pU = base0 + DNI_U + ((mt * 16 + G * 4) * 128 + cb + l16) * 2;
        const float* pE = EGL + (((b * NC + (d ? NC - 1 : 0)) * 4 + h) * 2 + d);
        const unsigned char* pP = base0 + (long)PFD * dstep + e * (9216 * NS) + (tid < 144 * NS ? tid : 144 * NS - 1) * 64;
        bf16_t* pO = OB + ((size_t)d * TS + (size_t)(b * NC + (d ? NC - 1 : 0)) * 64 + (d ? 63 - (tid >> 3) : (tid >> 3))) * 512 + h * 128 + cb + (tid & 7) * 2 * NS;
        const long ostep = (long)(d ? -64 : 64) * 512;
        u32x4 aX[4], aA[2], aK[2], bX[4], bA[2], bK[2], cX[4], cA[2], cK[2];
        unsigned aU[NS][4], bU[NS][4], cU[NS][4]; float aE, bE, cE; unsigned pf_dummy = 0u;
#define DN_LOAD(P) do { \
            _Pragma("unroll") for (int kk = 0; kk < 4; ++kk) P##X[kk] = *(const u32x4*)(pX + kk * 1024); \
            _Pragma("unroll") for (int kk = 0; kk < 2; ++kk) { P##A[kk] = *(const u32x4*)(pA + kk * 1024); P##K[kk] = *(const u32x4*)(pK + kk * 1024); } \
            _Pragma("unroll") for (int ns = 0; ns < NS; ++ns) _Pragma("unroll") for (int r = 0; r < 4; ++r) P##U[ns][r] = *(const bf16_t*)(pU + r * 256 + ns * 32); \
            P##E = *pE; pX += dstep; pA += dstep; pK += dstep; pU += dstep; pE += (d ? -8 : 8); } while (0)
#define DN_STEP(P, PL) do { \
            DN_LOAD(PL); \
            if (wave < (NS == 1 ? 3 : 5)) { asm volatile("global_load_dword %0, %1, off" : "+v"(pf_dummy) : "v"(pP) : "memory"); } \
            pP += dstep; \
            f32x4 acc[NS], acc2[NS]; \
            { bf16x8 sb_[NS][4]; \
              _Pragma("unroll") for (int ns = 0; ns < NS; ++ns) { acc[ns] = (f32x4){0.f, 0.f, 0.f, 0.f}; acc2[ns] = (f32x4){0.f, 0.f, 0.f, 0.f}; \
                _Pragma("unroll") for (int kk = 0; kk < 4; ++kk) sb_[ns][kk] = *(const bf16x8*)(lds + O_SB + (ns * 16 + l16) * 272 + (kk * 32 + G * 8) * 2); } \
              if constexpr (NS == 1) asm volatile("s_waitcnt lgkmcnt(0)" : "+v"(sb_[0][0]), "+v"(sb_[0][1]), "+v"(sb_[0][2]), "+v"(sb_[0][3]) :: "memory"); \
              else asm volatile("s_waitcnt lgkmcnt(0)" : "+v"(sb_[0][0]), "+v"(sb_[0][1]), "+v"(sb_[0][2]), "+v"(sb_[0][3]), "+v"(sb_[NS - 1][0]), "+v"(sb_[NS - 1][1]), "+v"(sb_[NS - 1][2]), "+v"(sb_[NS - 1][3]) :: "memory"); \
              _Pragma("unroll") for (int ns = 0; ns < NS; ++ns) { \
                acc[ns] = MFMA16(__builtin_bit_cast(bf16x8, P##X[0]), sb_[ns][0], acc[ns]); acc2[ns] = MFMA16(__builtin_bit_cast(bf16x8, P##X[1]), sb_[ns][1], acc2[ns]); \
                acc[ns] = MFMA16(__builtin_bit_cast(bf16x8, P##X[2]), sb_[ns][2], acc[ns]); acc2[ns] = MFMA16(__builtin_bit_cast(bf16x8, P##X[3]), sb_[ns][3], acc2[ns]); } \
              _Pragma("unroll") for (int ns = 0; ns < NS; ++ns) acc[ns] = acc[ns] + acc2[ns]; } \
            if (lo) { _Pragma("unroll") for (int ns = 0; ns < NS; ++ns) { u32x2 o; float v[4]; \
              _Pragma("unroll") for (int r = 0; r < 4; ++r) v[r] = __uint_as_float(P##U[ns][r] << 16) - acc[ns][r]; \
              o.x = attn_body::cvtpk_s(v[0], v[1]); o.y = attn_body::cvtpk_s(v[2], v[3]); \
              *(u32x2*)(lds + O_VN + (ns * 16 + l16) * 144 + (mt * 16 + G * 4) * 2) = o; } } \
            asm volatile("s_waitcnt lgkmcnt(0)\n\ts_barrier" ::: "memory"); \
            bf16x8 vb[NS][2]; \
            _Pragma("unroll") for (int ns = 0; ns < NS; ++ns) _Pragma("unroll") for (int kk = 0; kk < 2; ++kk) vb[ns][kk] = *(const bf16x8*)(lds + O_VN + (ns * 16 + l16) * 144 + (kk * 32 + G * 8) * 2); \
            if constexpr (NS == 1) asm volatile("s_waitcnt lgkmcnt(0)" : "+v"(vb[0][0]), "+v"(vb[0][1]) :: "memory"); \
            else asm volatile("s_waitcnt lgkmcnt(0)" : "+v"(vb[0][0]), "+v"(vb[0][1]), "+v"(vb[NS - 1][0]), "+v"(vb[NS - 1][1]) :: "memory"); \
            _Pragma("unroll") for (int ns = 0; ns < NS; ++ns) { Sreg[ns] = Sreg[ns] * P##E; \
              _Pragma("unroll") for (int kk = 0; kk < 2; ++kk) Sreg[ns] = MFMA16(__builtin_bit_cast(bf16x8, P##K[kk]), vb[ns][kk], Sreg[ns]); } \
            _Pragma("unroll") for (int ns = 0; ns < NS; ++ns) { u32x2 o; o.x = attn_body::cvtpk_s(Sreg[ns][0], Sreg[ns][1]); o.y = attn_body::cvtpk_s(Sreg[ns][2], Sreg[ns][3]); \
              *(u32x2*)(lds + O_SB + (ns * 16 + l16) * 272 + (wave * 16 + G * 4) * 2) = o; } \
            if (!lo) { _Pragma("unroll") for (int ns = 0; ns < NS; ++ns) { \
              _Pragma("unroll") for (int kk = 0; kk < 2; ++kk) acc[ns] = MFMA16(__builtin_bit_cast(bf16x8, P##A[kk]), vb[ns][kk], acc[ns]); \
              const unsigned w0_ = attn_body::cvtpk_s(acc[ns][0], acc[ns][1]), w1_ = attn_body::cvtpk_s(acc[ns][2], acc[ns][3]); \
              bf16_t* op_ = (bf16_t*)(lds + O_OUT + ((mt * 16 + G * 4) * NCOL + ns * 16 + l16) * 2); \
              op_[0] = (bf16_t)(w0_ & 0xffffu); op_[NCOL] = (bf16_t)(w0_ >> 16); op_[2 * NCOL] = (bf16_t)(w1_ & 0xffffu); op_[3 * NCOL] = (bf16_t)(w1_ >> 16); } } \
            asm volatile("s_waitcnt lgkmcnt(0)\n\ts_barrier" ::: "memory"); \
            if constexpr (NS == 1) *(unsigned*)pO = *(const unsigned*)(lds + O_OUT + tid * 4); else *(u32x2*)pO = *(const u32x2*)(lds + O_OUT + tid * 8); \
            pO += ostep; } while (0)
        DN_LOAD(a); DN_LOAD(b);
        __syncthreads();
        int n = 0;
        for (; n + 3 <= NC; n += 3) {
            DN_STEP(a, c);
            DN_STEP(b, a);
            DN_STEP(c, b);
        }
        if (n < NC) { DN_STEP(a, c); }
        if (n + 1 < NC) { DN_STEP(b, a); }
#undef DN_STEP
#undef DN_LOAD
        asm volatile("s_waitcnt vmcnt(0)" ::: "memory");
        asm volatile("" :: "v"(pf_dummy));
    }
}

__device__ __forceinline__ int t5_bucket(int rel) {
    const int n = rel < 0 ? -rel : rel; int v;
    if (n < 8) v = n; else v = 8 + (n >= 15) + (n >= 27) + (n >= 50) + (n >= 91) + (n >= 166) + (n >= 305) + (n >= 559);
    return (rel > 0 ? 16 : 0) + v;
}
__device__ __forceinline__ void odd_dilated(bf16_t* proj, const float* relb, float* LSE, int S, char* lds, int first_wg, int n_wg) {
    MK_IDS();
    constexpr int KST = 144, VST = 400, HOFF = 27648 + 25600 + 1024;
    const int half = tid >> 8, ht = tid & 255, wv = ht >> 6, G = lane >> 4, l16 = lane & 15;
    char* L = lds + half * HOFF; char* KS = L; char* VT = L + 27648; float* BIAS = (float*)(L + 27648 + 25600);
    const int NBb = S / 64;
    const int wgi = (int)blockIdx.x - first_wg;
    if (wgi < 0) return;
    for (int it0 = wgi * 2; it0 < 3072; it0 += n_wg * 2) {
        const int it = it0 + half; const int zb = it & 255, sl = (it >> 8) & 3, g = it >> 10;
        const int dil = g == 0 ? 1 : (g == 1 ? 4 : 16), lg = g * 2;
        const int M = S >> lg, MB = M / 64;
        const int b = zb / NBb, r0 = zb % NBb, rho = r0 / MB, n = r0 % MB;
        const int hc = (g * 4 + sl) * 64;
        const size_t tb = (size_t)b * S;
        __syncthreads();
#pragma unroll
        for (int k = 0; k < 6; ++k) { const int idx = ht + k * 256, kj = idx >> 3, pc = idx & 7; const int mk = 64 * n - 64 + kj;
            u32x4 kv = {0u, 0u, 0u, 0u}, vv = {0u, 0u, 0u, 0u};
            if (mk >= 0 && mk < M) { const bf16_t* rowp = proj + (tb + (size_t)mk * dil + rho) * OINP; kv = *(const u32x4*)(rowp + 2832 + hc + pc * 8); vv = *(const u32x4*)(rowp + 3600 + hc + pc * 8); }
            *(u32x4*)(KS + kj * KST + pc * 16) = kv;
            const unsigned w[4] = {vv.x, vv.y, vv.z, vv.w};
#pragma unroll
            for (int q = 0; q < 4; ++q) { *(bf16_t*)(VT + (pc * 8 + 2 * q) * VST + kj * 2) = (bf16_t)(w[q] & 0xffffu); *(bf16_t*)(VT + (pc * 8 + 2 * q + 1) * VST + kj * 2) = (bf16_t)(w[q] >> 16); } }
        if (ht < 129) BIAS[ht] = relb[t5_bucket((ht - 64) * dil) * 12 + g * 4 + sl];
        const int mq = 64 * n + 16 * wv + l16; const size_t tq = tb + (size_t)mq * dil + rho;
        bf16x8 qf[2];
#pragma unroll
        for (int kk = 0; kk < 2; ++kk) qf[kk] = *(const bf16x8*)(proj + tq * OINP + 2064 + hc + kk * 32 + G * 8);
        __syncthreads();
        f32x4 sc[9]; float mx = -1e30f;
#pragma unroll
        for (int kt = 0; kt < 9; ++kt) { f32x4 acc = {0.f, 0.f, 0.f, 0.f};
#pragma unroll
            for (int kk = 0; kk < 2; ++kk) { const bf16x8 a = *(const bf16x8*)(KS + ((wv + kt) * 16 + l16) * KST + (kk * 32 + G * 8) * 2); acc = MFMA16(a, qf[kk], acc); }
#pragma unroll
            for (int r = 0; r < 4; ++r) { const int kj = (wv + kt) * 16 + G * 4 + r; const int delta = kj - 64 - 16 * wv - l16; const int mk = 64 * n - 64 + kj;
                const bool ok = (delta >= -64) && (delta <= 64) && (mk >= 0) && (mk < M);
                const float s = ok ? acc[r] * 0.125f + BIAS[(delta < -64 ? -64 : (delta > 64 ? 64 : delta)) + 64] : -1e30f;
                acc[r] = s; mx = fmaxf(mx, s); }
            sc[kt] = acc; }
        mx = fmaxf(mx, __shfl_xor(mx, 16)); mx = fmaxf(mx, __shfl_xor(mx, 32));
        float sum = 0.f;
#pragma unroll
        for (int kt = 0; kt < 9; ++kt)
#pragma unroll
            for (int r = 0; r < 4; ++r) { const float pv_ = (sc[kt][r] > -1e29f) ? __expf(sc[kt][r] - mx) : 0.f; sc[kt][r] = pv_; sum += pv_; }
        sum += __shfl_xor(sum, 16); sum += __shfl_xor(sum, 32);
        f32x4 ot[4];
#pragma unroll
        for (int dt = 0; dt < 4; ++dt) ot[dt] = (f32x4){0.f, 0.f, 0.f, 0.f};
#pragma unroll
        for (int pp = 0; pp < 5; ++pp) {
            u32x4 pb; pb.x = pk2(sc[2 * pp][0], sc[2 * pp][1]); pb.y = pk2(sc[2 * pp][2], sc[2 * pp][3]);
            if (pp < 4) { pb.z = pk2(sc[2 * pp + 1][0], sc[2 * pp + 1][1]); pb.w = pk2(sc[2 * pp + 1][2], sc[2 * pp + 1][3]); } else { pb.z = 0u; pb.w = 0u; }
            const bf16x8 pbf = __builtin_bit_cast(bf16x8, pb);
#pragma unroll
            for (int dt = 0; dt < 4; ++dt) {
                u32x4 av; const u32x2 lo = *(const u32x2*)(VT + (dt * 16 + l16) * VST + ((wv + 2 * pp) * 16 + G * 4) * 2); av.x = lo.x; av.y = lo.y;
                if (pp < 4) { const u32x2 hi = *(const u32x2*)(VT + (dt * 16 + l16) * VST + ((wv + 2 * pp + 1) * 16 + G * 4) * 2); av.z = hi.x; av.w = hi.y; } else { av.z = 0u; av.w = 0u; }
                ot[dt] = MFMA16(__builtin_bit_cast(bf16x8, av), pbf, ot[dt]);
            }
        }
        const float rs = 1.f / sum;
        bf16_t* od = proj + tq * OINP + (g * 4 + sl) * 64;
#pragma unroll
        for (int dt = 0; dt < 4; ++dt) { const f32x4 v_ = ot[dt] * rs; u32x2 w_; w_.x = pk2(v_[0], v_[1]); w_.y = pk2(v_[2], v_[3]); *(u32x2*)(od + dt * 16 + G * 4) = w_; }
        if (G == 0) LSE[tq * 12 + g * 4 + sl] = mx + __logf(sum);
    }
}

__device__ __forceinline__ void odd_combine(const bf16_t* OB, const bf16_t* proj, const float* LSE, const float* og, bf16_t* Y) {
    MK_IDS();
    float gn[8];
#pragma unroll
    for (int e = 0; e < 8; ++e) gn[e] = og[(lane & 15) * 8 + e];
    const int sl = lane >> 4;
    for (int t = gw; t < TS; t += NGW) {
        const bf16_t* prow = proj + (size_t)t * OINP;
        const u32x4 fa = *(const u32x4*)(OB + (size_t)t * 512 + lane * 8), ra = *(const u32x4*)(OB + ((size_t)TS + t) * 512 + lane * 8), za = *(const u32x4*)(prow + 1536 + lane * 8);
        const u32x2 d0 = *(const u32x2*)(prow + lane * 4), d1 = *(const u32x2*)(prow + 256 + lane * 4), d2 = *(const u32x2*)(prow + 512 + lane * 4);
        const float l0 = LSE[(size_t)t * 12 + sl], l1 = LSE[(size_t)t * 12 + 4 + sl], l2 = LSE[(size_t)t * 12 + 8 + sl];
        float f[8], r[8], z[8]; unpack8(fa, f); unpack8(ra, r); unpack8(za, z);
        float ss = 0.f;
#pragma unroll
        for (int e = 0; e < 8; ++e) { f[e] += r[e]; ss += f[e] * f[e]; }
        ss += __shfl_xor(ss, 1); ss += __shfl_xor(ss, 2); ss += __shfl_xor(ss, 4); ss += __shfl_xor(ss, 8);
        const float rn = __builtin_amdgcn_rsqf(ss * (1.f / 128.f) + EPS);
#pragma unroll
        for (int e = 0; e < 8; ++e) f[e] = f[e] * rn * gn[e] * silu(z[e]);
        u32x4 o; o.x = pk2(f[0], f[1]); o.y = pk2(f[2], f[3]); o.z = pk2(f[4], f[5]); o.w = pk2(f[6], f[7]);
        *(u32x4*)(Y + (size_t)t * OOUT + lane * 8) = o;
        const float m = fmaxf(l0, fmaxf(l1, l2)); const float w0 = __expf(l0 - m), w1 = __expf(l1 - m), w2 = __expf(l2 - m); const float rs = 1.f / (w0 + w1 + w2);
        const float a0 = w0 * rs, a1 = w1 * rs, a2 = w2 * rs;
        const float v0 = a0 * __uint_as_float(d0.x << 16) + a1 * __uint_as_float(d1.x << 16) + a2 * __uint_as_float(d2.x << 16);
        const float v1 = a0 * __uint_as_float(d0.x & 0xffff0000u) + a1 * __uint_as_float(d1.x & 0xffff0000u) + a2 * __uint_as_float(d2.x & 0xffff0000u);
        const float v2 = a0 * __uint_as_float(d0.y << 16) + a1 * __uint_as_float(d1.y << 16) + a2 * __uint_as_float(d2.y << 16);
        const float v3 = a0 * __uint_as_float(d0.y & 0xffff0000u) + a1 * __uint_as_float(d1.y & 0xffff0000u) + a2 * __uint_as_float(d2.y & 0xffff0000u);
        u32x2 od; od.x = pk2(v0, v1); od.y = pk2(v2, v3);
        *(u32x2*)(Y + (size_t)t * OOUT + 512 + lane * 4) = od;
    }
}

__global__ void __launch_bounds__(NT, 2) fwd_megakernel(Params p) {
    extern __shared__ __attribute__((aligned(16))) unsigned char lds_raw[];
    cg::grid_group grid = cg::this_grid();
    char* lds = (char*)lds_raw;
    PG8_LAS unsigned char* ldsl = (PG8_LAS unsigned char*)lds_raw;
    const int Gr = gridDim.x;
    volatile LAS unsigned* MISC = (volatile LAS unsigned*)((PG8_LAS unsigned char*)lds_raw + (LDS_BYTES - 128));
    if (threadIdx.x < 32) MISC[threadIdx.x] = 0u;
    __syncthreads();
    xb::XcdBarrier bar = xb::xcd_barrier_post((unsigned*)p.ws, MISC + 8);
#define GSYNC() xb::xcd_barrier(bar)
    unsigned char* ws = p.ws;
    bf16_t* H = (bf16_t*)(ws + WS_H); bf16_t* PROJ = (bf16_t*)(ws + WS_PROJ); unsigned char* SCR = ws + WS_SCR;

    phase_prologue(p, lds);
    grid.sync();

    float* SSQA = (float*)(SCR + 232 * MiB); float* SSQB = (float*)(SCR + 234 * MiB);
    bf16_t* YE = (bf16_t*)(SCR + 192 * MiB); bf16_t* YO = (bf16_t*)(SCR + SC_QKVP);
    for (int seg = 0; seg < NSEG; ++seg) {
        const int S = seg < 2 ? 16384 : 2048, nb = seg < 2 ? 1 : 8;
        const float* xin = (seg < 2 ? p.in[0] : p.in[1]) + (size_t)(seg & 1) * TS * DMODEL;
        float* xo = p.out + (size_t)seg * TS * DMODEL;
        phase_x0(xin, H, SSQB);
        GSYNC();
        for (int layer = 0; layer < 4; ++layer) {
            const int j = layer >> 1; const bool odd = layer & 1;
            {
                const int N = odd ? OINP : EIN;
                const bf16_t* Bt = odd ? (const bf16_t*)(ws + WS_WINO) + (size_t)j * OINP * 1024 : (const bf16_t*)(ws + WS_WINE) + (size_t)j * EIN * 1024;
                pg8::Gemm g{H, Bt, TS, N, 1024}; pg8::StaticOrder So; So.init(TS, N, Gr, (int)blockIdx.x);
                pg8::EpiBf16<0> E{PROJ, N, nullptr, 0, 0, 1.f, SSQB};
                pg8::gemm_phase<pg8::EpiBf16<0>, pg8::StaticOrder, true, true>(ldsl, g, So, E);
            }
            GSYNC();
            if (!odd) {
                even_qk_post(PROJ, p.in[10] + j * 64, p.in[11] + j * 64, S);
                even_lru_prep(PROJ, p.in[12] + j * 2048, p.in[13] + j * 512, (const bf16_t*)(ws + WS_GW) + (size_t)j * 2 * 2 * 8 * 4096, p.in[15] + j * 1024, p.in[17] + j * 1024, p.in[18] + j * 1024,
                              (unsigned*)(SCR + SC_LA), (f32x2*)(SCR + SC_AGG), S, lds);
                GSYNC();
                {
                    const int nqb = S / 256, nunits = nb * 8 * nqb;
                    for (int u = blockIdx.x; u < nunits; u += Gr) {
                        const int qb = u % nqb, h = (u / nqb) % 8, b = u / (nqb * 8), kvh = h >> 2;
                        const attn_body::bf16* base = (const attn_body::bf16*)PROJ + (size_t)b * S * EIN;
                        attn_body::attn_unit<8>(qb, S, base + h * 64, EIN, base + 512 + kvh * 64, base + 640 + kvh * 64, EIN, (attn_body::bf16*)YE + (size_t)b * S * DMODEL + h * 64, DMODEL, lds);
                    }
                }
                __syncthreads();
                even_lru_scan((const unsigned*)(SCR + SC_LA), (const f32x2*)(SCR + SC_AGG), PROJ, YE, S);
                GSYNC();
                {
                    pg8::Gemm g{YE, (const bf16_t*)(ws + WS_WOUTE) + (size_t)j * 1024 * 1024, TS, 1024, 1024}; pg8::StaticOrder So; So.init(TS, 1024, Gr, (int)blockIdx.x);
                    EpiRes E{H, SSQA, DMODEL, nullptr};
                    pg8::gemm_phase<EpiRes, pg8::StaticOrder, true, true>(ldsl, g, So, E);
                }
            } else {
                odd_conv(PROJ, p.in[21] + j * 4 * 1536, (bf16_t*)(SCR + SC_QKVP), S);
                asm volatile("s_waitcnt vmcnt(0)" ::: "memory"); __syncthreads();
                odd_prep((const bf16_t*)(SCR + SC_QKVP), PROJ, p.in[22] + j * 8, p.in[23] + j * 8, SCR + SC_DNI, (float*)(SCR + SC_EGL), lds);
                GSYNC();
                {
                    const int nscan = nb * 64;
                    if (nscan <= Gr) odd_scan<1>(SCR + SC_DNI, (const float*)(SCR + SC_EGL), (bf16_t*)(SCR + SC_OB), S, nb, lds);
                    else odd_scan<2>(SCR + SC_DNI, (const float*)(SCR + SC_EGL), (bf16_t*)(SCR + SC_OB), S, nb, lds);
                    const int first = nscan < Gr ? nscan : 0;
                    odd_dilated(PROJ, p.in[2], (float*)(SCR + SC_LSE), S, lds, first, Gr - first);
                }
                GSYNC();
                odd_combine((const bf16_t*)(SCR + SC_OB), PROJ, (const float*)(SCR + SC_LSE), p.in[24] + j * 128, YO);
                GSYNC();
                {
                    pg8::Gemm g{YO, (const bf16_t*)(ws + WS_WOUTO) + (size_t)j * 1024 * OOUT, TS, 1024, OOUT}; pg8::StaticOrder So; So.init(TS, 1024, Gr, (int)blockIdx.x);
                    EpiRes E{H, SSQA, DMODEL, nullptr};
                    pg8::gemm_phase<EpiRes, pg8::StaticOrder, true, true>(ldsl, g, So, E);
                }
            }
            GSYNC();
            {
                pg8::Gemm g{H, (const bf16_t*)(ws + WS_W1T) + (size_t)layer * 4096 * 1024, TS, DFF, 1024}; pg8::StaticOrder So; So.init(TS, DFF, Gr, (int)blockIdx.x);
                pg8::EpiBf16<2> E{(bf16_t*)(SCR + SC_HID), DFF, nullptr, 0, 0, 1.f, nullptr};
                pg8::gemm_phase<pg8::EpiBf16<2>, pg8::StaticOrder, true, true>(ldsl, g, So, E);
            }
            GSYNC();
            {
                pg8::Gemm g{(const bf16_t*)(SCR + SC_HID), (const bf16_t*)(ws + WS_W2T) + (size_t)layer * 1024 * 4096, TS, 1024, DFF}; pg8::StaticOrder So; So.init(TS, 1024, Gr, (int)blockIdx.x);
                EpiRes E{H, SSQB, DMODEL, SSQA};
                pg8::gemm_phase<EpiRes, pg8::StaticOrder, true, true>(ldsl, g, So, E);
            }
            GSYNC();
        }
        phase_rmsnorm_final(H, xo, p.in[5]);
        GSYNC();
    }
}
}

extern "C" void kernel_launch(void* const* d_in, const int* in_sizes, int n_in, void* d_out, int out_size, void* d_ws, size_t ws_size, hipStream_t stream) {
    static int grid = 0;
    if (grid == 0) {
        if (n_in != 25 || ws_size < mk::WS_END) { fprintf(stderr, "kernel_launch: unexpected n_in %d / ws_size %zu\n", n_in, ws_size); grid = -1; return; }
        int dev = 0, cus = 0, per_cu = 0;
        hipGetDevice(&dev); hipDeviceGetAttribute(&cus, hipDeviceAttributeMultiprocessorCount, dev);
        if (hipFuncSetAttribute((const void*)mk::fwd_megakernel, hipFuncAttributeMaxDynamicSharedMemorySize, mk::LDS_BYTES) != hipSuccess) { fprintf(stderr, "hipFuncSetAttribute failed\n"); }
        hipOccupancyMaxActiveBlocksPerMultiprocessor(&per_cu, (const void*)mk::fwd_megakernel, mk::NT, mk::LDS_BYTES);
        (void)hipGetLastError();
        if (per_cu < 1) per_cu = 1;
        grid = cus * 1;
        fprintf(stderr, "kernel_launch: cus %d per_cu %d grid %d\n", cus, per_cu, grid);
    }
    if (grid < 0) return;
    if (hipMemsetAsync(d_ws, 0, 65536, stream) != hipSuccess) { fprintf(stderr, "memset failed\n"); return; }
    mk::Params p{};
    for (int i = 0; i < 25; ++i) p.in[i] = (const float*)d_in[i];
    p.out = (float*)d_out; p.ws = (unsigned char*)d_ws;
    void* args[] = {&p};
    hipError_t e = hipLaunchCooperativeKernel((const void*)mk::fwd_megakernel, dim3(grid), dim3(mk::NT), args, mk::LDS_BYTES, stream);
    if (e != hipSuccess) fprintf(stderr, "cooperative launch failed: %s (grid %d)\n", hipGetErrorString(e), grid);
}
```

```cpp
#include <hip/hip_runtime.h>
#include <hip/hip_cooperative_groups.h>
#include <hip/hip_bf16.h>
#include <cstdio>
#include <cstdint>
#include <cmath>
namespace cg = cooperative_groups;
namespace pg8 {
#define PG8_LAS __attribute__((address_space(3)))
typedef unsigned short bf16_t;
typedef short bf16x8 __attribute__((ext_vector_type(8)));
typedef float f32x4 __attribute__((ext_vector_type(4)));
typedef unsigned u32x4 __attribute__((ext_vector_type(4)));
constexpr int BM = 256, BK = 64, HALF = 128, HTB = HALF * BK * 2  , STAGE_BYTES = 8 * HTB, NXCD = 8, WGM = 8;

__host__ __device__ __forceinline__ int lds_byte(int r, int c) { const int st = (r >> 4) * 2 + (c >> 5), rr = r & 15, cc = c & 31, ob = rr * 64 + cc * 2; return st * 1024 + (ob ^ (((ob >> 9) & 1) << 5)); }
__host__ __device__ __forceinline__ void stage_rc(int b, int& R, int& C) { const int st = b / 1024, sb = b % 1024, swz = sb ^ (((sb >> 9) & 1) << 5); R = (st >> 1) * 16 + swz / 64; C = (st & 1) * 32 + (swz % 64) / 2; }
__host__ __device__ __forceinline__ int perm32(int rho) { const int n = rho >> 4, i = rho & 15; return 8 * (i >> 2) + 4 * n + (i & 3); }

struct Unit { int pm, pn; };
struct Gemm { const bf16_t* A; const bf16_t* Bt; int M, N, K; };

struct StaticOrder {
    int nM, nN, nwg, G, c;
    __host__ __device__ void init(int M, int N, int G_, int c_) { nM = M / BM; nN = N / BM; nwg = nM * nN; G = G_; c = c_; }
    __host__ __device__ bool next(int i, Unit& u) const {
        const long L = (long)i * G + c; if (L >= nwg) return false;
        int wgid = (int)L; { const int q = nwg / NXCD, r = nwg % NXCD, xcd = wgid % NXCD, off = wgid / NXCD; wgid = (xcd < r ? xcd * (q + 1) : r * (q + 1) + (xcd - r) * q) + off; }
        const int nig = WGM * nN, gid = wgid / nig, fm = gid * WGM, gsz = (nM - fm) < WGM ? (nM - fm) : WGM;
        u.pm = fm + ((wgid % nig) % gsz); u.pn = (wgid % nig) / gsz; return true;
    }
    __device__ __forceinline__ void a_ready(const Unit&) const {}
    __device__ __forceinline__ void done(const Unit&) const {}
};

__device__ __forceinline__ unsigned cvt_pk_bf16(float lo, float hi) { unsigned r; asm volatile("v_cvt_pk_bf16_f32 %0, %1, %2" : "=v"(r) : "v"(lo), "v"(hi)); return r; }
typedef float f32x2 __attribute__((ext_vector_type(2)));
__device__ __forceinline__ f32x2 gelu_pk(f32x2 v) {
    const f32x2 av = __builtin_elementwise_abs(v), d = av * 0.2316418882f + 1.0f;
    f32x2 t; t.x = __builtin_amdgcn_rcpf(d.x); t.y = __builtin_amdgcn_rcpf(d.y);
    f32x2 q = t * 0.5307027145f + (-0.7265760135f); q = q * t + 0.7107068705f; q = q * t + (-0.142248368f); q = q * t + 0.127414796f; q = q * t;
    const f32x2 s = (v * v) * (-0.72134752044f);
    f32x2 e; e.x = __builtin_amdgcn_exp2f(s.x); e.y = __builtin_amdgcn_exp2f(s.y);
    const f32x2 m = v * (q * e), r = v - m;
    f32x2 o; o.x = v.x < 0.f ? m.x : r.x; o.y = v.y < 0.f ? m.y : r.y; return o;
}

template <int ACT  > struct EpiBf16 {
    static constexpr bool PERM = true, AFTER_DRAIN = false; static_assert(ACT == 0 || ACT == 1 || ACT == 2, "EpiBf16: ACT 0 none, 1 gelu, 2 relu^2");
    bf16_t* O; int ldc; const float* bias; int split_cols; size_t split_stride; float scale0; const float* ssq;
    __device__ __forceinline__ void operator()(const f32x4 (&acc)[2][2][4][2], const Unit& u, int wr, int wc, int fr, int fq) const {
        const int row0 = u.pm * BM + wr * 64 + fr; int colt = u.pn * BM; bf16_t* base = O;
        float sc = 1.f; if (split_cols) { const int t = colt / split_cols; base += (size_t)t * split_stride; colt -= t * split_cols; if (t == 0) sc = scale0; }
        const int col0 = colt + wc * 32 + 8 * fq, bcol0 = u.pn * BM + wc * 32 + 8 * fq;
        float rsc[2][4];
        if (ssq) { f32x4 t_[2][4];
#pragma unroll
            for (int ai = 0; ai < 2; ++ai)
#pragma unroll
                for (int m = 0; m < 4; ++m) t_[ai][m] = *(const f32x4*)(ssq + (size_t)(row0 + ai * HALF + m * 16) * 16 + fq * 4);
#pragma unroll
            for (int ai = 0; ai < 2; ++ai)
#pragma unroll
                for (int m = 0; m < 4; ++m) { float s_ = (t_[ai][m][0] + t_[ai][m][1]) + (t_[ai][m][2] + t_[ai][m][3]); s_ += __shfl_xor(s_, 16); s_ += __shfl_xor(s_, 32); rsc[ai][m] = __builtin_amdgcn_rsqf(s_ * (1.0f / 1024.0f) + 1e-6f); }
        } else {
#pragma unroll
            for (int ai = 0; ai < 2; ++ai)
#pragma unroll
                for (int m = 0; m < 4; ++m) rsc[ai][m] = 1.0f; }
        f32x4 bv[2][2];
#pragma unroll
        for (int bj = 0; bj < 2; ++bj)
#pragma unroll
            for (int n = 0; n < 2; ++n) bv[bj][n] = bias ? *(const f32x4*)(bias + bcol0 + bj * HALF + 4 * n) : (f32x4){0.f, 0.f, 0.f, 0.f};
#pragma unroll
        for (int ai = 0; ai < 2; ++ai)
#pragma unroll
            for (int m = 0; m < 4; ++m) { bf16_t* rowp = base + (size_t)(row0 + ai * HALF + m * 16) * ldc + col0; const float rsc_ = rsc[ai][m];
#pragma unroll
                for (int bj = 0; bj < 2; ++bj) { f32x4 v0 = (acc[ai][bj][m][0] + bv[bj][0]) * rsc_, v1 = (acc[ai][bj][m][1] + bv[bj][1]) * rsc_;
                    if (ACT == 1) { f32x2 a = gelu_pk((f32x2){v0[0], v0[1]}), b = gelu_pk((f32x2){v0[2], v0[3]}), c = gelu_pk((f32x2){v1[0], v1[1]}), d = gelu_pk((f32x2){v1[2], v1[3]});
                        v0 = (f32x4){a.x, a.y, b.x, b.y}; v1 = (f32x4){c.x, c.y, d.x, d.y}; }
                    if (ACT == 2) { _Pragma("unroll") for (int q_ = 0; q_ < 4; ++q_) { const float a0_ = v0[q_] > 0.f ? v0[q_] : 0.f, a1_ = v1[q_] > 0.f ? v1[q_] : 0.f; v0[q_] = a0_ * a0_; v1[q_] = a1_ * a1_; } }
                    v0 = v0 * sc; v1 = v1 * sc; u32x4 w; w.x = cvt_pk_bf16(v0[0], v0[1]); w.y = cvt_pk_bf16(v0[2], v0[3]); w.z = cvt_pk_bf16(v1[0], v1[1]); w.w = cvt_pk_bf16(v1[2], v1[3]);
                    *(u32x4*)(rowp + bj * HALF) = w; } }
    }
};

template <class Epi, class Sched, bool ALIGN_EPI = false, bool SP2 = false>
__device__ __forceinline__ void gemm_phase(PG8_LAS unsigned char* lds, const Gemm g, const Sched& S, const Epi& E) {
    int tid_ = threadIdx.x; asm volatile("" : "+v"(tid_)); const int tid = tid_, wid = __builtin_amdgcn_readfirstlane(tid >> 6), lane = tid & 63, wr = wid >> 2, wc = wid & 3, fr = lane & 15, fq = lane >> 4;
    const int K = g.K, nt = K / BK;
    unsigned voffA[2], voffB[2];
#pragma unroll
    for (int i = 0; i < 2; ++i) { int R, C; stage_rc(tid * 16 + i * 8192, R, C); const int Rb = Epi::PERM ? ((R & ~31) + perm32(R & 31)) : R;
        voffA[i] = (unsigned)(R * K + C) * 2u; voffB[i] = (unsigned)(Rb * K + C) * 2u; }
    const size_t kstep = (size_t)(BK * 2);
    const size_t hstep = (size_t)HALF * K * 2;
    const size_t tstep = 2 * hstep;
    const unsigned ldsw = (unsigned)wid * 1024u;
    const int aoff = lds_byte(wr * 64 + fr, fq * 8), boff = lds_byte(wc * 32 + fr, fq * 8);
#define PG8_SA(b, h) (((b) * 2 + (h)) * HTB)
#define PG8_SB(b, h) ((4 + (b) * 2 + (h)) * HTB)
#define PG8_STAGE(bufoff, gbase, voff) do { _Pragma("unroll") for (int _i = 0; _i < 2; ++_i) \
        __builtin_amdgcn_global_load_lds((const unsigned*)((const char*)(gbase) + (voff)[_i]), (PG8_LAS unsigned*)(lds + (bufoff) + ldsw + _i * 8192), 16, 0, 0); } while (0)
#define PG8_LDA(dst, b, h) do { _Pragma("unroll") for (int m = 0; m < 4; ++m) _Pragma("unroll") for (int k = 0; k < 2; ++k) dst[m][k] = *(const PG8_LAS bf16x8*)(lds + PG8_SA(b, h) + aoff + m * 2048 + k * 1024); } while (0)
#define PG8_LDB(dst, b, h) do { _Pragma("unroll") for (int n = 0; n < 2; ++n) _Pragma("unroll") for (int k = 0; k < 2; ++k) dst[n][k] = *(const PG8_LAS bf16x8*)(lds + PG8_SB(b, h) + boff + n * 2048 + k * 1024); } while (0)
#define PG8_MMA(ai, bj, At, Bt) do { __builtin_amdgcn_s_setprio(1); _Pragma("unroll") for (int m = 0; m < 4; ++m) _Pragma("unroll") for (int n = 0; n < 2; ++n) _Pragma("unroll") for (int k = 0; k < 2; ++k) \
        acc[ai][bj][m][n] = __builtin_amdgcn_mfma_f32_16x16x32_bf16(Bt[n][k], At[m][k], acc[ai][bj][m][n], 0, 0, 0); __builtin_amdgcn_s_setprio(0); } while (0)
#define PG8_WAIT_V(n) asm volatile("s_waitcnt vmcnt(" #n ")" ::: "memory")
#define PG8_WAIT_L(n) asm volatile("s_waitcnt lgkmcnt(" #n ")" ::: "memory")
#define PG8_BAR __builtin_amdgcn_s_barrier()
#define PG8_SCHED __builtin_amdgcn_sched_barrier(0)
    Unit cur, nxt; int ui = 0;
    if (!S.next(0, cur)) return;
    f32x4 acc[2][2][4][2];
#pragma unroll
    for (int a = 0; a < 2; ++a)
#pragma unroll
        for (int b = 0; b < 2; ++b)
#pragma unroll
            for (int m = 0; m < 4; ++m)
#pragma unroll
                for (int n = 0; n < 2; ++n) acc[a][b][m][n] = (f32x4){0.f, 0.f, 0.f, 0.f};
    bf16x8 At[4][2], B0[2][2], B1[2][2];
    const char* cA = (const char*)g.A + (size_t)cur.pm * tstep; const char* cB = (const char*)g.Bt + (size_t)cur.pn * tstep;
    S.a_ready(cur);
    if constexpr (SP2) {
        PG8_STAGE(PG8_SB(0, 0), cB, voffB); PG8_STAGE(PG8_SB(0, 1), cB + hstep, voffB); PG8_STAGE(PG8_SA(0, 0), cA, voffA); PG8_STAGE(PG8_SA(0, 1), cA + hstep, voffA);
        if (wr == 1) PG8_BAR;
        PG8_WAIT_V(2); PG8_BAR;
        PG8_STAGE(PG8_SB(1, 0), cB + kstep, voffB); PG8_STAGE(PG8_SA(1, 0), cA + kstep, voffA); PG8_STAGE(PG8_SB(1, 1), cB + hstep + kstep, voffB);
        PG8_WAIT_V(6); PG8_BAR;
    } else {
        PG8_STAGE(PG8_SB(0, 0), cB, voffB); PG8_STAGE(PG8_SA(0, 0), cA, voffA); PG8_STAGE(PG8_SB(0, 1), cB + hstep, voffB); PG8_STAGE(PG8_SA(0, 1), cA + hstep, voffA);
        if (wr == 1) PG8_BAR;
        PG8_WAIT_V(4); PG8_BAR;
        PG8_STAGE(PG8_SB(1, 0), cB + kstep, voffB); PG8_STAGE(PG8_SA(1, 0), cA + kstep, voffA); PG8_STAGE(PG8_SB(1, 1), cB + hstep + kstep, voffB);
        PG8_WAIT_V(6); PG8_BAR;
    }
    for (;;) {
        const bool has_next = S.next(ui + 1, nxt);
        const char* nA = has_next ? (const char*)g.A + (size_t)nxt.pm * tstep : cA; const char* nB = has_next ? (const char*)g.Bt + (size_t)nxt.pn * tstep : cB;
        for (int t = 0; t < nt; t += 2) {
            const bool last = (t == nt - 2);
            const char* a1 = cA + (size_t)(t + 1) * kstep;
            const char* a2 = last ? nA : cA + (size_t)(t + 2) * kstep; const char* b2 = last ? nB : cB + (size_t)(t + 2) * kstep;
            const char* a3 = a2 + kstep; const char* b3 = b2 + kstep;
            if (last && has_next) S.a_ready(nxt);
            if constexpr (SP2) {
            PG8_LDB(B0, 0, 0); PG8_LDB(B1, 0, 1); PG8_SCHED; PG8_LDA(At, 0, 0); PG8_STAGE(PG8_SA(1, 1), a1 + hstep, voffA);
            PG8_WAIT_V(8); PG8_WAIT_L(0); PG8_BAR; PG8_MMA(0, 0, At, B0); PG8_MMA(0, 1, At, B1); PG8_BAR; PG8_SCHED;
            PG8_LDA(At, 0, 1); PG8_STAGE(PG8_SB(0, 0), b2, voffB); PG8_STAGE(PG8_SB(0, 1), b2 + hstep, voffB); PG8_STAGE(PG8_SA(0, 0), a2, voffA);
            PG8_WAIT_V(8); PG8_WAIT_L(0); PG8_BAR; PG8_MMA(1, 0, At, B0); PG8_MMA(1, 1, At, B1); PG8_BAR; PG8_SCHED;
            PG8_LDB(B0, 1, 0); PG8_LDB(B1, 1, 1); PG8_SCHED; PG8_LDA(At, 1, 0); PG8_STAGE(PG8_SA(0, 1), a2 + hstep, voffA);
            PG8_WAIT_V(8); PG8_WAIT_L(0); PG8_BAR; PG8_MMA(0, 0, At, B0); PG8_MMA(0, 1, At, B1); PG8_BAR; PG8_SCHED;
            PG8_LDA(At, 1, 1); PG8_STAGE(PG8_SB(1, 0), b3, voffB); PG8_STAGE(PG8_SB(1, 1), b3 + hstep, voffB); PG8_STAGE(PG8_SA(1, 0), a3, voffA);
            PG8_WAIT_V(8); PG8_WAIT_L(0); PG8_BAR; PG8_MMA(1, 0, At, B0); PG8_MMA(1, 1, At, B1); PG8_BAR; PG8_SCHED;
            } else {
            PG8_LDB(B0, 0, 0); PG8_SCHED; PG8_LDA(At, 0, 0); PG8_STAGE(PG8_SA(1, 1), a1 + hstep, voffA);
            PG8_WAIT_L(8); PG8_BAR; PG8_WAIT_L(0); PG8_MMA(0, 0, At, B0); PG8_BAR; PG8_SCHED;
            PG8_LDB(B1, 0, 1); PG8_STAGE(PG8_SB(0, 0), b2, voffB);
            PG8_BAR; PG8_WAIT_L(0); PG8_MMA(0, 1, At, B1); PG8_BAR;
            PG8_LDA(At, 0, 1); PG8_STAGE(PG8_SA(0, 0), a2, voffA);
            PG8_BAR; PG8_WAIT_L(0); PG8_MMA(1, 0, At, B0); PG8_BAR; PG8_SCHED;
            PG8_STAGE(PG8_SB(0, 1), b2 + hstep, voffB);
            PG8_WAIT_V(6); PG8_BAR; PG8_MMA(1, 1, At, B1); PG8_BAR;
            PG8_LDB(B0, 1, 0); PG8_SCHED; PG8_LDA(At, 1, 0); PG8_STAGE(PG8_SA(0, 1), a2 + hstep, voffA);
            PG8_WAIT_L(8); PG8_BAR; PG8_WAIT_L(0); PG8_MMA(0, 0, At, B0); PG8_BAR; PG8_SCHED;
            PG8_LDB(B1, 1, 1); PG8_STAGE(PG8_SB(1, 0), b3, voffB);
            PG8_BAR; PG8_WAIT_L(0); PG8_MMA(0, 1, At, B1); PG8_BAR;
            PG8_LDA(At, 1, 1); PG8_STAGE(PG8_SA(1, 0), a3, voffA);
            PG8_BAR; PG8_WAIT_L(0); PG8_MMA(1, 0, At, B0); PG8_BAR; PG8_SCHED;
            PG8_STAGE(PG8_SB(1, 1), b3 + hstep, voffB);
            PG8_WAIT_V(6); PG8_BAR; PG8_MMA(1, 1, At, B1); PG8_BAR;
            }
        }
        if constexpr (ALIGN_EPI) { if (wr == 0) PG8_BAR; }
        if constexpr (!Epi::AFTER_DRAIN) { E(acc, cur, wr, wc, fr, fq); S.done(cur); }
        if (!has_next) break;
#pragma unroll
        for (int a = 0; a < 2; ++a)
#pragma unroll
            for (int b = 0; b < 2; ++b)
#pragma unroll
                for (int m = 0; m < 4; ++m)
#pragma unroll
                    for (int n = 0; n < 2; ++n) acc[a][b][m][n] = (f32x4){0.f, 0.f, 0.f, 0.f};
        cur = nxt; cA = nA; cB = nB; ++ui;
        if constexpr (ALIGN_EPI) { if (wr == 1) PG8_BAR; }
    }
    PG8_WAIT_V(0);
    if constexpr (!ALIGN_EPI) { if (wr == 0) PG8_BAR; }
    PG8_BAR;
    if constexpr (Epi::AFTER_DRAIN) { E.fused(acc, cur, wr, wc, fr, fq, lds, wid, lane); S.done(cur); }
#undef PG8_SA
#undef PG8_SB
#undef PG8_STAGE
#undef PG8_LDA
#undef PG8_LDB
#undef PG8_MMA
#undef PG8_WAIT_V
#undef PG8_WAIT_L
#undef PG8_BAR
#undef PG8_SCHED
}
}

#ifndef PG8_SP2
#define PG8_SP2 true
#endif
#ifndef PG8_ALIGN
#define PG8_ALIGN true
#endif
#include <hip/hip_bf16.h>
#include <cmath>
namespace attn_body {
using bf16=__hip_bfloat16;
using bf16x8=__attribute__((ext_vector_type(8)))short;
using s16x4=__attribute__((ext_vector_type(4)))short;
using f32x16=__attribute__((ext_vector_type(16)))float;
using u32x4=__attribute__((ext_vector_type(4)))unsigned;
constexpr int D=64;
constexpr int NW=8,QBLK=32,QB=QBLK*NW,KVBLK=64;
__device__ __forceinline__ int crow(int r,int hi){return (r&3)+8*(r>>2)+4*hi;}
#define SBAR() __builtin_amdgcn_sched_barrier(0)
__device__ __forceinline__ void cmask(f32x16&p0,f32x16&p1,int jb,int qrel,int hi){
  const float NEG=-INFINITY; int kb=64*jb+4*hi;
  #pragma unroll
  for(int r=0;r<16;++r){int kv=kb+(r&3)+8*(r>>2); if(kv>qrel)p0[r]=NEG; if(kv+32>qrel)p1[r]=NEG;}
}

constexpr int NSLOT=3, SLOTB=8192;
constexpr int LDS_K=0, LDS_V=NSLOT*SLOTB, LDS_WS=2*NSLOT*SLOTB, LDS_OST=LDS_WS+NW*64*4, LDS_BYTES=LDS_OST+NW*4096;
constexpr float C2=0.125f*1.4426950408889634f;
__device__ __forceinline__ void glds16(const void*gsrc,unsigned lds_dst){unsigned keep;
  asm volatile("s_mov_b32 %0, m0\n\ts_mov_b32 m0, %2\n\ts_nop 0\n\tglobal_load_lds_dwordx4 %1, off\n\ts_mov_b32 m0, %0":"=&s"(keep):"v"(gsrc),"s"(lds_dst):"memory");}
__device__ __forceinline__ float max3f(float a,float b,float c){float r;asm("v_max3_f32 %0, %1, %2, %3":"=v"(r):"v"(a),"v"(b),"v"(c));return r;}
__device__ __forceinline__ float max2f(float a,float b){float r;asm("v_max_f32_e32 %0, %1, %2":"=v"(r):"v"(a),"v"(b));return r;}
__device__ __forceinline__ float fadd_s(float a,float b){float r;asm("v_add_f32_e32 %0, %1, %2":"=v"(r):"v"(a),"v"(b));return r;}
__device__ __forceinline__ float fsub_s(float a,float b){float r;asm("v_sub_f32_e32 %0, %1, %2":"=v"(r):"v"(a),"v"(b));return r;}
typedef float f32x2_t __attribute__((ext_vector_type(2))); typedef __bf16 bf16x2_t __attribute__((ext_vector_type(2)));
__device__ __forceinline__ unsigned cvtpk_s(float lo,float hi){f32x2_t v={lo,hi};bf16x2_t b=__builtin_convertvector(v,bf16x2_t);return __builtin_bit_cast(unsigned,b);}
#define WAIT_BAR(N) asm volatile("s_waitcnt vmcnt(" #N ") lgkmcnt(0)\n\ts_barrier":::"memory")

__device__ __forceinline__ void qkt(f32x16&p0,f32x16&p1,const char*Kslot,const bf16x8*qr,const f32x16&negm,int r32,int hi){
  const char*kb=Kslot+hi*1024+r32*16;
  #pragma unroll
  for(int d0=0;d0<4;++d0){
    const bf16x8 b0=*reinterpret_cast<const bf16x8*>(kb+d0*2048);
    const bf16x8 b1=*reinterpret_cast<const bf16x8*>(kb+d0*2048+512);
    if(d0==0){p0=__builtin_amdgcn_mfma_f32_32x32x16_bf16(b0,qr[0],negm,0,0,0);p1=__builtin_amdgcn_mfma_f32_32x32x16_bf16(b1,qr[0],negm,0,0,0);}
    else{p0=__builtin_amdgcn_mfma_f32_32x32x16_bf16(b0,qr[d0],p0,0,0,0);p1=__builtin_amdgcn_mfma_f32_32x32x16_bf16(b1,qr[d0],p1,0,0,0);}}
}
typedef __attribute__((address_space(3))) const char* lds_cptr;
typedef short v4i16_t __attribute__((ext_vector_type(4)));
__device__ __forceinline__ void kload8(bf16x8*kf,lds_cptr kp){
  kf[0]=*(const __attribute__((address_space(3))) bf16x8*)(kp);      kf[1]=*(const __attribute__((address_space(3))) bf16x8*)(kp+512);
  kf[2]=*(const __attribute__((address_space(3))) bf16x8*)(kp+2048); kf[3]=*(const __attribute__((address_space(3))) bf16x8*)(kp+2560);
  kf[4]=*(const __attribute__((address_space(3))) bf16x8*)(kp+4096); kf[5]=*(const __attribute__((address_space(3))) bf16x8*)(kp+4608);
  kf[6]=*(const __attribute__((address_space(3))) bf16x8*)(kp+6144); kf[7]=*(const __attribute__((address_space(3))) bf16x8*)(kp+6656);
}
__device__ __forceinline__ void kload2(bf16x8*kf,lds_cptr kp,int j){ kf[2*j]=*(const __attribute__((address_space(3))) bf16x8*)(kp+j*2048); kf[2*j+1]=*(const __attribute__((address_space(3))) bf16x8*)(kp+j*2048+512); }
__device__ __forceinline__ s16x4 vtr(lds_cptr p){ return __builtin_bit_cast(s16x4,__builtin_amdgcn_ds_read_tr16_b64_v4i16((__attribute__((address_space(3))) v4i16_t*)p)); }
__device__ __forceinline__ float rowmax(const f32x16&p0,const f32x16&p1){
  float a=max3f(p0[0],p0[1],p1[0]),b=max3f(p0[2],p0[3],p1[1]);a=max3f(a,p1[2],p1[3]);
  #pragma unroll
  for(int r=4;r<16;r+=4){a=max3f(a,p0[r],p0[r+1]);b=max3f(b,p0[r+2],p0[r+3]);a=max3f(a,p1[r],p1[r+1]);b=max3f(b,p1[r+2],p1[r+3]);}
  const float m=max2f(a,b);
  auto rr=__builtin_amdgcn_permlane32_swap(__float_as_uint(m),__float_as_uint(m),false,false);
  return max2f(__uint_as_float(rr[0]),__uint_as_float(rr[1]));
}
__device__ __forceinline__ void pv(f32x16*o,int vb,bf16x8 pa0,bf16x8 pa1,bf16x8 pa2,bf16x8 pa3){
  #pragma unroll
  for(int d0=0;d0<2;++d0){s16x4 lo[4],hi[4];
    #pragma unroll
    for(int ks=0;ks<4;++ks){
      asm volatile("ds_read_b64_tr_b16 %0,%1 offset:%c2":"=&v"(lo[ks]):"v"(vb),"i"(d0*4096+ks*1024):"memory");
      asm volatile("ds_read_b64_tr_b16 %0,%1 offset:%c2":"=&v"(hi[ks]):"v"(vb),"i"(d0*4096+ks*1024+512):"memory");}
    asm volatile("s_waitcnt lgkmcnt(0)":::"memory");SBAR();
    #define PK(k) (bf16x8){lo[k][0],lo[k][1],lo[k][2],lo[k][3],hi[k][0],hi[k][1],hi[k][2],hi[k][3]}
    o[d0]=__builtin_amdgcn_mfma_f32_32x32x16_bf16(pa0,PK(0),o[d0],0,0,0);
    o[d0]=__builtin_amdgcn_mfma_f32_32x32x16_bf16(pa1,PK(1),o[d0],0,0,0);
    o[d0]=__builtin_amdgcn_mfma_f32_32x32x16_bf16(pa2,PK(2),o[d0],0,0,0);
    o[d0]=__builtin_amdgcn_mfma_f32_32x32x16_bf16(pa3,PK(3),o[d0],0,0,0);
    #undef PK
  }
}

#ifndef ATTN_STORE16
#define ATTN_STORE16(p,v) (*(u32x4*)(p)=(v))
#endif
template<int THRL> __device__ __forceinline__ void attn_unit(int qb,int SEQ,const bf16*Q,int QP,const bf16*__restrict__ K,const bf16*__restrict__ V,int KP,bf16*O,int OP,char*shm){
  int tid_=threadIdx.x; asm volatile("":"+v"(tid_)); const int tid=tid_,lane=tid&63,r32=lane&31,hi=lane>>5; const int wid=__builtin_amdgcn_readfirstlane(tid>>6);
  const int q0=qb*QB;
  const bf16*Qw=Q+(long)(q0+wid*QBLK)*QP;
  const bf16*Kh=K,*Vh=V;
  const unsigned lds0=(unsigned)(uintptr_t)shm;
  float*wsf=(float*)(shm+LDS_WS)+wid*64;
  const bf16*ksrc=Kh+(long)lane*KP+wid*8;
  const bf16*vsrc=Vh+(long)(16*(wid&3)+(lane>>2))*KP+(wid>>2)*32+(lane&3)*8;
  const unsigned kdst=lds0+LDS_K+wid*1024, vdst=lds0+LDS_V+wid*1024;
  #define DMA_K(t,slot) glds16(ksrc+(long)(t)*KVBLK*KP,(unsigned)__builtin_amdgcn_readfirstlane(kdst+(slot)))
  #define DMA_V(t,slot) glds16(vsrc+(long)(t)*KVBLK*KP,(unsigned)__builtin_amdgcn_readfirstlane(vdst+(slot)))
  const int vb0=(int)(lds0+LDS_V)+((lane>>4)&1)*32+(lane&3)*8+(4*hi+((lane&15)>>2))*64;
  const char*Kbase=shm+LDS_K; bf16x8 kf[8];
  const lds_cptr shm3=(lds_cptr)shm; const lds_cptr kp0=shm3+LDS_K+hi*1024+r32*16; const lds_cptr vp0=shm3+LDS_V+((lane>>4)&1)*32+(lane&3)*8+(4*hi+((lane&15)>>2))*64;
  const int NT=SEQ/KVBLK;
  DMA_K(0,0);DMA_V(0,0);DMA_K(1,SLOTB);
  bf16x8 qr[4];
  #pragma unroll
  for(int d0=0;d0<4;++d0)qr[d0]=*reinterpret_cast<const bf16x8*>(&Qw[(long)r32*QP+d0*16+hi*8]);
  float mhat=0.f,l_reg=0.f;f32x16 o[2];o[0]=f32x16{};o[1]=f32x16{};f32x16 negm=f32x16{};asm volatile("":"+v"(negm));
  const int qrel=wid*QBLK+r32;
  #define CMASK(P0,P1,t) do{}while(0)
  bool resc=false;
  #define START(P0,P1) do{ const float rm=rowmax(P0,P1); resc=false; \
    { const float dl=rm; mhat=fadd_s(mhat,dl); \
      _Pragma("unroll") for(int r=0;r<16;++r){P0[r]=fsub_s(P0[r],dl);P1[r]=fsub_s(P1[r],dl);} \
      _Pragma("unroll") for(int r=0;r<16;++r)negm[r]=-mhat; asm volatile("":"+v"(negm)); } \
    _Pragma("unroll") for(int r=0;r<16;++r)P0[r]=__builtin_amdgcn_exp2f(P0[r]); }while(0)
  #define RESC() do{ if(resc){ asm volatile("s_waitcnt lgkmcnt(0)":::"memory"); \
      _Pragma("unroll") for(int d_=0;d_<2;++d_) _Pragma("unroll") for(int r=0;r<16;++r)o[d_][r]*=wsf[crow(r,hi)]; } }while(0)
  f32x16 pA0,pA1,pB0,pB1;
  int sl_prev=0,sl_cur=0,sl_next=SLOTB;
  #define ROT() do{sl_prev=sl_cur;sl_cur=sl_next;sl_next=(sl_next==(NSLOT-1)*SLOTB)?0:sl_next+SLOTB;}while(0)
  DMA_K(2,2*SLOTB);
  WAIT_BAR(3);
  qkt(pA0,pA1,Kbase,qr,negm,r32,hi);asm volatile("s_nop 15\n\ts_nop 7":"+v"(pA0),"+v"(pA1));CMASK(pA0,pA1,0);
  START(pA0,pA1);
  _Pragma("unroll") for(int r=0;r<16;++r)pA1[r]=__builtin_amdgcn_exp2f(pA1[r]);
  WAIT_BAR(0);
  DMA_K(3,0);DMA_V(1,SLOTB);
  ROT();
  kload8(kf,kp0+sl_cur);
  WAIT_BAR(2);
  s16x4 vlo[8],vhi[8]; u32x4 pw0,pw1,pw2,pw3;
  #define PKW(P,B) cvtpk_s(P[B],P[B+1])
  #define PAF(k) __builtin_bit_cast(bf16x8,pw##k)
  #define VFR(i) (bf16x8){vlo[i][0],vlo[i][1],vlo[i][2],vlo[i][3],vhi[i][0],vhi[i][1],vhi[i][2],vhi[i][3]}
  #define PIN(x) asm volatile("":"+v"(x))
  #define MX3(a,b,c) __builtin_fmaxf(__builtin_fmaxf((a),(b)),(c))
  #define GAPA(MF,A0,A1,A2,A3,W0,W1,PW) do{ MF; sacc+=A0; sacc+=A1; sacc+=A2; sacc+=A3; PIN(sacc); W0; W1; PIN(PW); SBAR(); }while(0)
  #define EX(v) __builtin_amdgcn_exp2f(v)
  #define GAPB(MF,X,B) do{ MF; X[B]=EX(X[B]); X[B+1]=EX(X[B+1]); X[B+2]=EX(X[B+2]); X[B+3]=EX(X[B+3]); PIN(X); SBAR(); }while(0)
  #define VRD(i) do{ vlo[i]=vtr(vp_+(((i)>>2)*4096+((i)&3)*1024)); vhi[i]=vtr(vp_+(((i)>>2)*4096+((i)&3)*1024+512)); }while(0)
  #define KRD(G,j) do{ if(G){ kload2(kf,kp0+sl_next,j); SBAR(); } }while(0)
  #define STEP(C0,C1,P0,P1,t,GK,GV,GL) do{ SBAR(); \
    const lds_cptr vp_=vp0+sl_prev; \
    VRD(0); SBAR(); float sacc=(P0[0]+P0[1]); \
    GAPA(C0=__builtin_amdgcn_mfma_f32_32x32x16_bf16(kf[0],qr[0],negm,0,0,0), P0[2],P0[3],P0[4],P0[5],     pw0[0]=PKW(P0,0), pw0[1]=PKW(P0,2), pw0); \
    VRD(4); SBAR(); GAPA(C1=__builtin_amdgcn_mfma_f32_32x32x16_bf16(kf[1],qr[0],negm,0,0,0), P0[6],P0[7],P0[8],P0[9],     pw0[2]=PKW(P0,4), pw0[3]=PKW(P0,6), pw0); \
    VRD(1); SBAR(); GAPA(C0=__builtin_amdgcn_mfma_f32_32x32x16_bf16(kf[2],qr[1],C0,0,0,0),   P0[10],P0[11],P0[12],P0[13], pw1[0]=PKW(P0,8), pw1[1]=PKW(P0,10), pw1); \
    VRD(5); SBAR(); GAPA(C1=__builtin_amdgcn_mfma_f32_32x32x16_bf16(kf[3],qr[1],C1,0,0,0),   P0[14],P0[15],P1[0],P1[1],   pw1[2]=PKW(P0,12),pw1[3]=PKW(P0,14), pw1); \
    VRD(2); SBAR(); GAPA(C0=__builtin_amdgcn_mfma_f32_32x32x16_bf16(kf[4],qr[2],C0,0,0,0),   P1[2],P1[3],P1[4],P1[5],     pw2[0]=PKW(P1,0), pw2[1]=PKW(P1,2), pw2); \
    VRD(6); SBAR(); GAPA(C1=__builtin_amdgcn_mfma_f32_32x32x16_bf16(kf[5],qr[2],C1,0,0,0),   P1[6],P1[7],P1[8],P1[9],     pw2[2]=PKW(P1,4), pw2[3]=PKW(P1,6), pw2); \
    VRD(3); SBAR(); GAPA(C0=__builtin_amdgcn_mfma_f32_32x32x16_bf16(kf[6],qr[3],C0,0,0,0),   P1[10],P1[11],P1[12],P1[13], pw3[0]=PKW(P1,8), pw3[1]=PKW(P1,10), pw3); \
    VRD(7); SBAR(); GAPA(C1=__builtin_amdgcn_mfma_f32_32x32x16_bf16(kf[7],qr[3],C1,0,0,0),   P1[14],P1[15],0.f,0.f,       pw3[2]=PKW(P1,12),pw3[3]=PKW(P1,14), pw3); \
    l_reg+=sacc; \
    if(GK){DMA_K((t)+3,sl_cur);} if(GV){DMA_V((t)+1,sl_next);} \
    CMASK(C0,C1,t); \
    { float a=MX3(C0[0],C0[1],C1[0]),b=MX3(C0[2],C0[3],C1[1]); a=MX3(a,C1[2],C1[3]); \
      _Pragma("unroll") for(int r=4;r<16;r+=4){a=MX3(a,C0[r],C0[r+1]);b=MX3(b,C0[r+2],C0[r+3]);a=MX3(a,C1[r],C1[r+1]);b=MX3(b,C1[r+2],C1[r+3]);} \
      float rm=__builtin_fmaxf(a,b); { auto rr=__builtin_amdgcn_permlane32_swap(__float_as_uint(rm),__float_as_uint(rm),false,false); rm=__builtin_fmaxf(__uint_as_float(rr[0]),__uint_as_float(rr[1])); } \
      resc=false; \
      if(__builtin_expect(__any(rm>(float)THRL),0)){ const float dl=__builtin_fmaxf(rm,0.f); mhat+=dl; \
        _Pragma("unroll") for(int r=0;r<16;++r){C0[r]-=dl;C1[r]-=dl;} \
        _Pragma("unroll") for(int r=0;r<16;++r)negm[r]=-mhat; asm volatile("":"+v"(negm)); \
        const float f=__builtin_amdgcn_exp2f(-dl); l_reg*=f; if(hi==0)wsf[r32]=f; resc=true; } } \
    SBAR(); \
    GAPB(o[0]=__builtin_amdgcn_mfma_f32_32x32x16_bf16(PAF(0),VFR(0),o[0],0,0,0), C0,0); \
    GAPB(o[1]=__builtin_amdgcn_mfma_f32_32x32x16_bf16(PAF(0),VFR(4),o[1],0,0,0), C0,4); \
    KRD(GL,0); GAPB(o[0]=__builtin_amdgcn_mfma_f32_32x32x16_bf16(PAF(1),VFR(1),o[0],0,0,0), C0,8); \
    KRD(GL,1); GAPB(o[1]=__builtin_amdgcn_mfma_f32_32x32x16_bf16(PAF(1),VFR(5),o[1],0,0,0), C0,12); \
    KRD(GL,2); GAPB(o[0]=__builtin_amdgcn_mfma_f32_32x32x16_bf16(PAF(2),VFR(2),o[0],0,0,0), C1,0); \
    KRD(GL,3); GAPB(o[1]=__builtin_amdgcn_mfma_f32_32x32x16_bf16(PAF(2),VFR(6),o[1],0,0,0), C1,4); \
    GAPB(o[0]=__builtin_amdgcn_mfma_f32_32x32x16_bf16(PAF(3),VFR(3),o[0],0,0,0), C1,8); \
    GAPB(o[1]=__builtin_amdgcn_mfma_f32_32x32x16_bf16(PAF(3),VFR(7),o[1],0,0,0), C1,12); \
    }while(0)
  int t=1;
  #undef CMASK
  #define CMASK(P0,P1,t) do{}while(0)
  for(;t+5<NT;t+=2){
    STEP(pB0,pB1,pA0,pA1,t,true,true,true);     WAIT_BAR(2); RESC(); ROT();
    STEP(pA0,pA1,pB0,pB1,t+1,true,true,true);   WAIT_BAR(2); RESC(); ROT();
  }
  #undef CMASK
  #define CMASK(P0,P1,t) do{}while(0)
  #define ENDW(tt) do{ if((tt)+3<NT){WAIT_BAR(2);} else if((tt)+2<NT){WAIT_BAR(1);} else {WAIT_BAR(0);} }while(0)
  for(;t+1<NT;t+=2){
    STEP(pB0,pB1,pA0,pA1,t,(t+3<NT),(t+1<NT),(t+1<NT));       ENDW(t);   RESC(); ROT();
    STEP(pA0,pA1,pB0,pB1,t+1,(t+4<NT),(t+2<NT),(t+2<NT));     ENDW(t+1); RESC(); ROT();
  }
  STEP(pB0,pB1,pA0,pA1,NT-1,false,false,false); RESC();
  { float sacc=pB0[0]+pB0[1]; _Pragma("unroll") for(int r=2;r<16;++r)sacc+=pB0[r]; _Pragma("unroll") for(int r=0;r<16;++r)sacc+=pB1[r]; l_reg+=sacc;
    pw0=(u32x4){PKW(pB0,0),PKW(pB0,2),PKW(pB0,4),PKW(pB0,6)};pw1=(u32x4){PKW(pB0,8),PKW(pB0,10),PKW(pB0,12),PKW(pB0,14)};pw2=(u32x4){PKW(pB1,0),PKW(pB1,2),PKW(pB1,4),PKW(pB1,6)};pw3=(u32x4){PKW(pB1,8),PKW(pB1,10),PKW(pB1,12),PKW(pB1,14)};
    SBAR(); pv(o,vb0+sl_cur,PAF(0),PAF(1),PAF(2),PAF(3)); }
  #undef PKW
  #undef PAF
  #undef VFR
  #undef PIN
  #undef MX3
  #undef GAPA
  #undef GAPB
  #undef EX
  #undef VRD
  #undef KRD
  #undef STEP
  #undef ENDW
  {auto rr=__builtin_amdgcn_permlane32_swap(__float_as_uint(l_reg),__float_as_uint(l_reg),false,false);l_reg=__uint_as_float(rr[0])+__uint_as_float(rr[1]);}
  if(hi==0)wsf[32+r32]=l_reg;asm volatile("s_waitcnt lgkmcnt(0)":::"memory");
  float rli[16];
  #pragma unroll
  for(int r=0;r<16;++r)rli[r]=__builtin_amdgcn_rcpf(wsf[32+crow(r,hi)]);
  bf16*Ow=O+(long)(q0+wid*QBLK)*OP;
  { bf16*stg=(bf16*)(shm+LDS_OST)+wid*2048;
    #pragma unroll
    for(int r=0;r<16;++r){const int orow=crow(r,hi);
      #pragma unroll
      for(int d0=0;d0<2;++d0)stg[orow*64+d0*32+r32]=__float2bfloat16(o[d0][r]*rli[r]);}
    asm volatile("s_waitcnt lgkmcnt(0)":::"memory");
    #pragma unroll
    for(int i=0;i<4;++i){const int row=i*8+(lane>>3),ch=lane&7; const u32x4 v=*(const u32x4*)(stg+row*64+ch*8); ATTN_STORE16(Ow+(long)row*OP+ch*8,v);} }
  asm volatile("s_waitcnt lgkmcnt(0)\n\ts_barrier":::"memory");
  #undef DMA_K
  #undef DMA_V
  #undef CMASK
  #undef START
  #undef RESC
  #undef ROT
}
constexpr int ATTN_LDS_BYTES=LDS_BYTES;
#undef SBAR
#undef WAIT_BAR
}
namespace xb {
#define GAS __attribute__((address_space(1)))
#define LAS __attribute__((address_space(3)))
typedef GAS unsigned gu32;
typedef GAS unsigned long long gu64;
#define RLX_AGENT __ATOMIC_RELAXED, __HIP_MEMORY_SCOPE_AGENT
#define LDS_WAIT() asm volatile("s_waitcnt lgkmcnt(0)" ::: "memory")
#define VM_WAIT() asm volatile("s_waitcnt vmcnt(0)" ::: "memory")
__device__ __forceinline__ unsigned long long rt() { return __builtin_amdgcn_s_memrealtime(); }
__device__ __forceinline__ unsigned f2bf(float f) { unsigned u = __builtin_bit_cast(unsigned, f); return (u + 0x7fffu + ((u >> 16) & 1u)) >> 16; }
__device__ __forceinline__ unsigned pk2(float lo, float hi) { return f2bf(lo) | (f2bf(hi) << 16); }

#define XB_TMO      128
#define XB_XCNT(j)  (256  + 64 * (j))
#define XB_XSUB(j)  (1280 + 64 * (j))
#define XB_XGEN(j)  (2304 + 64 * (j))
#define XB_TOP      3328
#define XB_TOPGEN   3392
#define XCD_BAR_WORDS 3456
#define XB_SPIN_CAP (1u << 18)

__device__ __forceinline__ unsigned xb_ld(unsigned* p)              { return __hip_atomic_load(p, __ATOMIC_RELAXED, __HIP_MEMORY_SCOPE_AGENT); }
__device__ __forceinline__ unsigned xb_add(unsigned* p, unsigned v) { return __hip_atomic_fetch_add(p, v, __ATOMIC_RELAXED, __HIP_MEMORY_SCOPE_AGENT); }
__device__ __forceinline__ unsigned xb_xcc_id() { return (unsigned)__builtin_amdgcn_s_getreg((3 << 11) | 20) & 0xFu; }
#define XB_SPIN(cond, bar) do { unsigned _sp = 0; while (cond) { __builtin_amdgcn_s_sleep(1); \
    if ((++_sp & 255u) == 0u) { if (xb_ld(&(bar)[XB_TMO])) break; if (_sp > XB_SPIN_CAP) { atomicAdd(&(bar)[XB_TMO], 1u); break; } } } } while (0)

struct XcdBarrier {
    unsigned* bar; unsigned x;
    volatile LAS unsigned* st;
};

__device__ __forceinline__ XcdBarrier xcd_barrier_post(unsigned* bar, volatile LAS unsigned* st) {
    XcdBarrier b; b.bar = bar; b.x = xb_xcc_id(); b.st = st;
    if (threadIdx.x == 0) (void)xb_add(&bar[XB_XCNT(b.x)], 1u);
    return b;
}
__device__ __forceinline__ void xcd_barrier_complete(unsigned* bar, unsigned x, unsigned& nloc, unsigned& nx) {
    const unsigned G = gridDim.x * gridDim.y * gridDim.z;
    unsigned sum, cnt, mine, sp = 0u;
    for (;;) {
        sum = 0u; cnt = 0u; mine = 0u;
#pragma unroll
        for (unsigned j = 0; j < 16; ++j) { const unsigned c = xb_ld(&bar[XB_XCNT(j)]); sum += c; cnt += (c > 0u) ? 1u : 0u; mine = (j == x) ? c : mine; }
        if (sum == G) break;
        __builtin_amdgcn_s_sleep(1);
        if ((++sp & 255u) == 0u) { if (xb_ld(&bar[XB_TMO])) break; if (sp > XB_SPIN_CAP) { atomicAdd(&bar[XB_TMO], 1u); break; } }
    }
    nloc = mine > 0u ? mine : 1u; nx = cnt > 0u ? cnt : 1u;
}

__device__ __forceinline__ void xcd_barrier(const XcdBarrier& b) {
    asm volatile("s_waitcnt vmcnt(0)" ::: "memory");
    __syncthreads();
    if (threadIdx.x == 0) {
        unsigned* bar = b.bar;
        __builtin_amdgcn_s_waitcnt(0);
        unsigned nloc = b.st[0], nx = b.st[1];
        if (nloc == 0u) { xcd_barrier_complete(bar, b.x, nloc, nx); b.st[0] = nloc; b.st[1] = nx; }
        const unsigned old = xb_add(&bar[XB_XSUB(b.x)], 1u);
        const unsigned gen = old / nloc;
        if (old + 1u == (gen + 1u) * nloc) {
            __builtin_amdgcn_fence(__ATOMIC_RELEASE, "agent");
            asm volatile("s_waitcnt vmcnt(0)" ::: "memory");
            const unsigned og = xb_add(&bar[XB_TOP], 1u);
            const unsigned tg = og / nx;
            if (og + 1u == (tg + 1u) * nx) xb_add(&bar[XB_TOPGEN], 1u);
            else XB_SPIN(xb_ld(&bar[XB_TOPGEN]) == tg, bar);
            __builtin_amdgcn_fence(__ATOMIC_ACQUIRE, "agent");
            xb_add(&bar[XB_XGEN(b.x)], 1u);
            asm volatile("s_waitcnt vmcnt(0)" ::: "memory");
        } else {
            XB_SPIN(xb_ld(&bar[XB_XGEN(b.x)]) == gen, bar);
            __builtin_amdgcn_fence(__ATOMIC_ACQUIRE, "agent");
            asm volatile("s_waitcnt vmcnt(0)" ::: "memory");
        }
    }
    __syncthreads();
}

}

namespace mk {
typedef unsigned short bf16_t;
typedef short bf16x8 __attribute__((ext_vector_type(8)));
typedef float f32x4 __attribute__((ext_vector_type(4)));
typedef unsigned u32x4 __attribute__((ext_vector_type(4)));
typedef unsigned u32x2 __attribute__((ext_vector_type(2)));
typedef float f32x2 __attribute__((ext_vector_type(2)));

constexpr int DMODEL = 1024, TS = 16384, NSEG = 4, DFF = 4096;
constexpr int EIN = 1792, OIN = 4368, OINP = 4608, OOUT = 768;
constexpr float EPS = 1e-6f;
constexpr size_t MiB = (size_t)1 << 20;
constexpr size_t WS_W1T = 1 * MiB, WS_W2T = 33 * MiB, WS_WINE = 65 * MiB, WS_WOUTE = 72 * MiB, WS_WINO = 76 * MiB, WS_WOUTO = 94 * MiB,
                 WS_GW = 97 * MiB, WS_H = 98 * MiB, WS_PROJ = 130 * MiB, WS_SCR = 274 * MiB, WS_END = 512 * MiB;
constexpr size_t SC_HID = 0;
constexpr size_t SC_LA = 0, SC_UU = 64 * MiB, SC_AGG = 128 * MiB;
constexpr size_t SC_QKVP = 0, SC_DNI = 48 * MiB, SC_OB = 192 * MiB, SC_LSE = 224 * MiB, SC_EGL = 225 * MiB;
constexpr int DNI_BYTES = 73728, DNI_W = 0, DNI_QT = 16384, DNI_KTT = 32768, DNI_A = 49152, DNI_U = 57344;
constexpr int LDS_BYTES = 147456;
constexpr int NT = 512, NW = 8;

struct Params { const float* in[25]; float* out; unsigned char* ws; };

__device__ __forceinline__ float bf2f(bf16_t v) { return __uint_as_float(((unsigned)v) << 16); }
__device__ __forceinline__ unsigned f2bf(float f) { return attn_body::cvtpk_s(f, 0.f) & 0xffffu; }
__device__ __forceinline__ unsigned pk2(float lo, float hi) { return attn_body::cvtpk_s(lo, hi); }
__device__ __forceinline__ float wave_sum(float v) {
#pragma unroll
    for (int o = 1; o < 64; o <<= 1) v += __shfl_xor(v, o);
    return v;
}
__device__ __forceinline__ float sigm(float x) { return __builtin_amdgcn_rcpf(1.f + __expf(-x)); }
__device__ __forceinline__ float softplus(float x) { return x > 20.f ? x : log1pf(__expf(x)); }
__device__ __forceinline__ float silu(float x) { return x * sigm(x); }
__device__ __forceinline__ float gelu_tanh(float x) { const float t = 0.7978845608028654f * (x + 0.044715f * x * x * x); return x * __builtin_amdgcn_rcpf(1.f + __expf(-2.f * t)); }
__device__ __forceinline__ void unpack8(const u32x4 v, float* f) {
    f[0] = __uint_as_float(v.x << 16); f[1] = __uint_as_float(v.x & 0xffff0000u); f[2] = __uint_as_float(v.y << 16); f[3] = __uint_as_float(v.y & 0xffff0000u);
    f[4] = __uint_as_float(v.z << 16); f[5] = __uint_as_float(v.z & 0xffff0000u); f[6] = __uint_as_float(v.w << 16); f[7] = __uint_as_float(v.w & 0xffff0000u);
}
#define MK_IDS() int tid = threadIdx.x; asm volatile("" : "+v"(tid)); const int lane = tid & 63, wave = __builtin_amdgcn_readfirstlane(tid >> 6); const int gw = blockIdx.x * NW + wave, NGW = gridDim.x * NW; (void)lane; (void)wave; (void)gw; (void)NGW
#define MFMA16(a, b, c) __builtin_amdgcn_mfma_f32_16x16x32_bf16((a), (b), (c), 0, 0, 0)

__device__ __forceinline__ void transpose_item(const float* W, int K, int Nsrc, int Npad, bf16_t* WT, float* scr, int item, int lane, const float* gain = nullptr) {
    const int nblk = Npad / 32, kb = item / nblk, nb = item % nblk, k0 = 64 * kb, n0 = 32 * nb;
    const int n = n0 + (lane & 31);
#pragma unroll 8
    for (int i = 0; i < 32; ++i) { const int kk = 2 * i + (lane >> 5); scr[kk * 33 + (lane & 31)] = (n < Nsrc) ? W[(size_t)(k0 + kk) * Nsrc + n] * (gain ? gain[k0 + kk] : 1.f) : 0.f; }
    asm volatile("s_waitcnt lgkmcnt(0)" ::: "memory");
    const int c = lane & 7;
#pragma unroll
    for (int j = 0; j < 4; ++j) { const int nn = (lane >> 3) + 8 * j; const float* s = scr + (8 * c) * 33 + nn;
        u32x4 o; o.x = pk2(s[0 * 33], s[1 * 33]); o.y = pk2(s[2 * 33], s[3 * 33]); o.z = pk2(s[4 * 33], s[5 * 33]); o.w = pk2(s[6 * 33], s[7 * 33]);
        *(u32x4*)(WT + (size_t)(n0 + nn) * K + k0 + 8 * c) = o; }
    asm volatile("s_waitcnt lgkmcnt(0)" ::: "memory");
}
__device__ __forceinline__ void phase_prologue(const Params& p, char* lds) {
    MK_IDS();
    float* scr = (float*)(lds + wave * 16384);
    unsigned char* ws = p.ws;
    constexpr int I_F1 = 16 * 128, I_F2 = 64 * 32, I_IE = 16 * 56, I_OE = 16 * 32, I_IO = 16 * 144, I_OO = 12 * 32;
    constexpr int T_F1 = 4 * I_F1, T_F2 = T_F1 + 4 * I_F2, T_IE = T_F2 + 2 * I_IE, T_OE = T_IE + 2 * I_OE, T_IO = T_OE + 2 * I_IO, T_OO = T_IO + 2 * I_OO;
    for (int it = gw; it < T_OO; it += NGW) {
        if (it < T_F1) { const int l = it / I_F1, r = it % I_F1; transpose_item(p.in[6] + (size_t)l * 1024 * 4096, 1024, 4096, 4096, (bf16_t*)(ws + WS_W1T) + (size_t)l * 4096 * 1024, scr, r, lane, p.in[4] + l * 1024); }
        else if (it < T_F2) { const int q = it - T_F1, l = q / I_F2, r = q % I_F2; transpose_item(p.in[7] + (size_t)l * 4096 * 1024, 4096, 1024, 1024, (bf16_t*)(ws + WS_W2T) + (size_t)l * 1024 * 4096, scr, r, lane); }
        else if (it < T_IE) { const int q = it - T_F2, l = q / I_IE, r = q % I_IE; transpose_item(p.in[8] + (size_t)l * 1024 * EIN, 1024, EIN, EIN, (bf16_t*)(ws + WS_WINE) + (size_t)l * EIN * 1024, scr, r, lane, p.in[3] + (2 * l) * 1024); }
        else if (it < T_OE) { const int q = it - T_IE, l = q / I_OE, r = q % I_OE; transpose_item(p.in[9] + (size_t)l * 1024 * 1024, 1024, 1024, 1024, (bf16_t*)(ws + WS_WOUTE) + (size_t)l * 1024 * 1024, scr, r, lane); }
        else if (it < T_IO) { const int q = it - T_OE, l = q / I_IO, r = q % I_IO; transpose_item(p.in[19] + (size_t)l * 1024 * OIN, 1024, OIN, OINP, (bf16_t*)(ws + WS_WINO) + (size_t)l * OINP * 1024, scr, r, lane, p.in[3] + (2 * l + 1) * 1024); }
        else { const int q = it - T_IO, l = q / I_OO, r = q % I_OO; transpose_item(p.in[20] + (size_t)l * OOUT * 1024, OOUT, 1024, 1024, (bf16_t*)(ws + WS_WOUTO) + (size_t)l * 1024 * OOUT, scr, r, lane); }
    }
    bf16_t* GW = (bf16_t*)(ws + WS_GW);
    const int gt = gw * 64 + lane, NGT = NGW * 64;
    for (int idx = gt; idx < 2 * 2 * 2 * 8 * 4096; idx += NGT) {
        const int d = idx & 63, e = (idx >> 6) & 63, blk = (idx >> 12) & 7, gate = (idx >> 15) & 1, dir = (idx >> 16) & 1, j = (idx >> 17) & 1;
        const float* src = gate ? p.in[16] : p.in[14];
        GW[idx] = (bf16_t)f2bf(src[((((size_t)j * 2 + dir) * 8 + blk) * 64 + d) * 64 + e]);
    }
}

__device__ __forceinline__ void phase_x0(const float* x, bf16_t* xb, float* ssq) {
    MK_IDS();
    for (int m = gw; m < TS; m += NGW) {
        const f32x4* xr = (const f32x4*)(x + (size_t)m * DMODEL) + lane;
        f32x4 v[4]; float s = 0.f;
#pragma unroll
        for (int j = 0; j < 4; ++j) { v[j] = xr[64 * j]; s += (v[j].x * v[j].x + v[j].y * v[j].y) + (v[j].z * v[j].z + v[j].w * v[j].w); }
        s = wave_sum(s);
        u32x2* o8 = (u32x2*)(xb + (size_t)m * DMODEL) + lane;
#pragma unroll
        for (int j = 0; j < 4; ++j) { u32x2 o; o.x = pk2(v[j].x, v[j].y); o.y = pk2(v[j].z, v[j].w); o8[64 * j] = o; }
        if (lane < 16) ssq[(size_t)m * 16 + lane] = lane == 0 ? s : 0.f;
    }
}
__device__ __forceinline__ void zero_f32(float* ptr, int n) {
    MK_IDS();
    for (int i = gw * 64 + lane; i < n; i += NGW * 64) ptr[i] = 0.f;
}
__device__ __forceinline__ void phase_rmsnorm_final(const bf16_t* xb, float* x, const float* g) {
    MK_IDS();
    for (int m = gw; m < TS; m += NGW) {
        const u32x2* xr = (const u32x2*)(xb + (size_t)m * DMODEL) + lane; f32x4* xw = (f32x4*)(x + (size_t)m * DMODEL) + lane; const f32x4* gr = (const f32x4*)g + lane;
        f32x4 v[4]; float s = 0.f;
#pragma unroll
        for (int j = 0; j < 4; ++j) { const u32x2 w = xr[64 * j]; v[j] = (f32x4){__uint_as_float(w.x << 16), __uint_as_float(w.x & 0xffff0000u), __uint_as_float(w.y << 16), __uint_as_float(w.y & 0xffff0000u)};
            s += (v[j].x * v[j].x + v[j].y * v[j].y) + (v[j].z * v[j].z + v[j].w * v[j].w); }
        const float rstd = 1.f / sqrtf(wave_sum(s) * (1.f / DMODEL) + EPS);
#pragma unroll
        for (int j = 0; j < 4; ++j) { const f32x4 gg = gr[64 * j]; xw[64 * j] = v[j] * rstd * gg; }
    }
}
struct EpiRes {
    static constexpr bool PERM = true, AFTER_DRAIN = false;
    bf16_t* xb; float* ssq; int ldc; const float* sin;
    __device__ __forceinline__ void operator()(const pg8::f32x4 (&acc)[2][2][4][2], const pg8::Unit& u, int wr, int wc, int fr, int fq) const {
        const int col0 = u.pn * pg8::BM + wc * 32 + 8 * fq;
        float rs2a[2][4];
        if (sin) { pg8::f32x4 t_[2][4];
#pragma unroll
            for (int ai = 0; ai < 2; ++ai)
#pragma unroll
                for (int m = 0; m < 4; ++m) t_[ai][m] = *(const pg8::f32x4*)(sin + (size_t)(u.pm * pg8::BM + ai * pg8::HALF + wr * 64 + m * 16 + fr) * 16 + fq * 4);
#pragma unroll
            for (int ai = 0; ai < 2; ++ai)
#pragma unroll
                for (int m = 0; m < 4; ++m) { float s_ = (t_[ai][m][0] + t_[ai][m][1]) + (t_[ai][m][2] + t_[ai][m][3]); s_ += __shfl_xor(s_, 16); s_ += __shfl_xor(s_, 32); rs2a[ai][m] = __builtin_amdgcn_rcpf(s_ * (1.0f / 1024.0f) + 1e-6f); }
        } else {
#pragma unroll
            for (int ai = 0; ai < 2; ++ai)
#pragma unroll
                for (int m = 0; m < 4; ++m) rs2a[ai][m] = 1.f; }
#pragma unroll
        for (int ai = 0; ai < 2; ++ai)
#pragma unroll
            for (int m = 0; m < 4; ++m) { const int row = u.pm * pg8::BM + ai * pg8::HALF + wr * 64 + m * 16 + fr; const size_t off = (size_t)row * ldc + col0; float sq = 0.f;
                const float rs2 = rs2a[ai][m];
                u32x4 bw[2];
#pragma unroll
                for (int bj = 0; bj < 2; ++bj) bw[bj] = *(const u32x4*)(xb + off + bj * pg8::HALF);
#pragma unroll
                for (int bj = 0; bj < 2; ++bj) { float b[8]; unpack8(bw[bj], b); const pg8::f32x4 a0 = acc[ai][bj][m][0] * rs2, a1 = acc[ai][bj][m][1] * rs2;
                    const float o0 = b[0] + a0[0], o1 = b[1] + a0[1], o2 = b[2] + a0[2], o3 = b[3] + a0[3], o4 = b[4] + a1[0], o5 = b[5] + a1[1], o6 = b[6] + a1[2], o7 = b[7] + a1[3];
                    u32x4 w; w.x = pg8::cvt_pk_bf16(o0, o1); w.y = pg8::cvt_pk_bf16(o2, o3); w.z = pg8::cvt_pk_bf16(o4, o5); w.w = pg8::cvt_pk_bf16(o6, o7);
                    *(u32x4*)(xb + off + bj * pg8::HALF) = w;
                    sq += ((o0 * o0 + o1 * o1) + (o2 * o2 + o3 * o3)) + ((o4 * o4 + o5 * o5) + (o6 * o6 + o7 * o7)); }
                sq += __shfl_xor(sq, 16); sq += __shfl_xor(sq, 32);
                if (fq == 0) ssq[(size_t)row * 16 + u.pn * 4 + wc] = sq;
                if (m & 1) asm volatile("" ::: "memory"); }
    }
};

__device__ __forceinline__ void even_qk_post(bf16_t* proj, const float* qg, const float* kg, int S) {
    MK_IDS();
    const int g = lane & 7, axis = g >> 2, half = (g >> 1) & 1;
    float inv[8], gq[8], gk[8];
#pragma unroll
    for (int e = 0; e < 8; ++e) { inv[e] = exp2f(-(float)((g & 1) * 8 + e) * (13.287712379549449f / 16.f)); gq[e] = qg[g * 8 + e] * attn_body::C2; gk[e] = kg[g * 8 + e]; }
    for (int t = gw; t < TS; t += NGW) {
        const int s = t % S; const float pos = (float)(axis ? (s & 63) : (s >> 6));
        bf16_t* row = proj + (size_t)t * EIN;
        const u32x4 qa = *(const u32x4*)(row + lane * 8); u32x4 ka = {0u, 0u, 0u, 0u}; if (lane < 16) ka = *(const u32x4*)(row + 512 + lane * 8);
        float cs[8], sn[8];
#pragma unroll
        for (int e = 0; e < 8; ++e) { const float ang = pos * inv[e]; cs[e] = __cosf(ang); sn[e] = __sinf(ang); }
        float xq[8], xk[8]; unpack8(qa, xq); unpack8(ka, xk);
        float sq = 0.f, sk = 0.f;
#pragma unroll
        for (int e = 0; e < 8; ++e) { sq += xq[e] * xq[e]; sk += xk[e] * xk[e]; }
        sq += __shfl_xor(sq, 1); sq += __shfl_xor(sq, 2); sq += __shfl_xor(sq, 4);
        sk += __shfl_xor(sk, 1); sk += __shfl_xor(sk, 2); sk += __shfl_xor(sk, 4);
        const float rq = __builtin_amdgcn_rsqf(sq * (1.f / 64.f) + EPS), rk = __builtin_amdgcn_rsqf(sk * (1.f / 64.f) + EPS);
        float oq[8], ok[8];
#pragma unroll
        for (int e = 0; e < 8; ++e) { const float yq = xq[e] * rq * gq[e], yk = xk[e] * rk * gk[e];
            const float pq = __shfl_xor(yq, 2), pk = __shfl_xor(yk, 2);
            oq[e] = yq * cs[e] + (half ? pq : -pq) * sn[e]; ok[e] = yk * cs[e] + (half ? pk : -pk) * sn[e]; }
        u32x4 o; o.x = pk2(oq[0], oq[1]); o.y = pk2(oq[2], oq[3]); o.z = pk2(oq[4], oq[5]); o.w = pk2(oq[6], oq[7]);
        *(u32x4*)(row + lane * 8) = o;
        if (lane < 16) { u32x4 o2; o2.x = pk2(ok[0], ok[1]); o2.y = pk2(ok[2], ok[3]); o2.z = pk2(ok[4], ok[5]); o2.w = pk2(ok[6], ok[7]); *(u32x4*)(row + 512 + lane * 8) = o2; }
    }
}
__device__ __forceinline__ void even_lru_prep(const bf16_t* proj, const float* cw, const float* cb, const bf16_t* GWj, const float* br, const float* bi, const float* lam,
                                              unsigned* LU, f32x2* AGG, int S, char* lds) {
    MK_IDS();
    constexpr int XST = 1040;
    for (int tile = blockIdx.x; tile < TS / 64; tile += gridDim.x) {
        const int t0 = tile * 64;
        __syncthreads();
#pragma unroll 2
        for (int k = 0; k < 8; ++k) {
            const int idx = tid + k * NT, i = idx >> 6, cgp = idx & 63, t = t0 + i, s = t % S, ch = cgp * 8;
            float acc[8];
#pragma unroll
            for (int e = 0; e < 8; ++e) acc[e] = cb[ch + e];
#pragma unroll
            for (int j = 0; j < 4; ++j) { const int sp = s + j - 2;
                if (sp >= 0 && sp < S) { const u32x4 v = *(const u32x4*)(proj + (size_t)(t + j - 2) * EIN + 768 + ch); float xv[8]; unpack8(v, xv);
#pragma unroll
                    for (int e = 0; e < 8; ++e) acc[e] += cw[j * 512 + ch + e] * xv[e]; } }
            u32x4 o; o.x = pk2(acc[0], acc[1]); o.y = pk2(acc[2], acc[3]); o.z = pk2(acc[4], acc[5]); o.w = pk2(acc[6], acc[7]);
            *(u32x4*)(lds + i * XST + ch * 2) = o;
        }
        __syncthreads();
        const int G = lane >> 4, l16 = lane & 15, ch0 = wave * 64;
        for (int dir = 0; dir < 2; ++dir)
            for (int nt = 0; nt < 4; ++nt) {
                const int e = nt * 16 + l16, ch = ch0 + e;
                bf16x8 Br[2], Bi[2];
#pragma unroll
                for (int kk = 0; kk < 2; ++kk) {
                    Br[kk] = *(const bf16x8*)(GWj + ((((size_t)dir * 2 + 0) * 8 + wave) * 64 + e) * 64 + kk * 32 + G * 8);
                    Bi[kk] = *(const bf16x8*)(GWj + ((((size_t)dir * 2 + 1) * 8 + wave) * 64 + e) * 64 + kk * 32 + G * 8);
                }
                const float brv = br[dir * 512 + ch], biv = bi[dir * 512 + ch], spl = softplus(-lam[dir * 512 + ch]);
#pragma unroll
                for (int mt = 0; mt < 4; ++mt) {
                    f32x4 ar = {0.f, 0.f, 0.f, 0.f}, ai = {0.f, 0.f, 0.f, 0.f};
#pragma unroll
                    for (int kk = 0; kk < 2; ++kk) { const bf16x8 a = *(const bf16x8*)(lds + (mt * 16 + l16) * XST + (ch0 + kk * 32 + G * 8) * 2); ar = MFMA16(a, Br[kk], ar); ai = MFMA16(a, Bi[kk], ai); }
#pragma unroll
                    for (int r = 0; r < 4; ++r) { const int i = mt * 16 + G * 4 + r;
                        const float xc = bf2f(*(const bf16_t*)(lds + i * XST + ch * 2));
                        const float rg = __builtin_amdgcn_rcpf(1.f + __expf(-(ar[r] + brv))), ig = __builtin_amdgcn_rcpf(1.f + __expf(-(ai[r] + biv)));
                        const float la = -8.f * rg * spl; const float uu = __builtin_amdgcn_sqrtf(fmaxf(1.f - __expf(2.f * la), 0.f)) * (ig * xc);
                        LU[((size_t)dir * TS + t0 + i) * 512 + ch] = attn_body::cvtpk_s(la, uu); }
                }
            }
        asm volatile("s_waitcnt vmcnt(0)" ::: "memory");
        __syncthreads();
        {
            const int ch = tid;
#pragma unroll
            for (int dir = 0; dir < 2; ++dir) {
                float h = 0.f, P = 0.f;
                const unsigned* lu = LU + ((size_t)dir * TS + t0) * 512 + ch;
#pragma unroll
                for (int q = 0; q < 64; q += 8) {
                    float lv[8], uv[8];
#pragma unroll
                    for (int e = 0; e < 8; ++e) { const int i = dir ? 63 - (q + e) : q + e; const unsigned w_ = lu[(size_t)i * 512]; lv[e] = __uint_as_float(w_ << 16); uv[e] = __uint_as_float(w_ & 0xffff0000u); }
#pragma unroll
                    for (int e = 0; e < 8; ++e) { h = __expf(lv[e]) * h + uv[e]; P += lv[e]; }
                }
                AGG[((size_t)dir * (TS / 64) + tile) * 512 + ch] = (f32x2){P, h};
            }
        }
    }
}
__device__ __forceinline__ void even_lru_scan(const unsigned* LU, const f32x2* AGG, const bf16_t* proj, bf16_t* Y, int S) {
    MK_IDS();
    const int ch = tid, TPB = S / 64;
    for (int tile = blockIdx.x; tile < TS / 64; tile += gridDim.x) {
        const int t0 = tile * 64, tb0 = (tile / TPB) * TPB;
        float cf = 0.f, cr = 0.f;
        for (int k0 = tb0; k0 < tile; k0 += 8) { f32x2 a[8];
#pragma unroll
            for (int q = 0; q < 8; ++q) { const int k = k0 + q < tile ? k0 + q : tile - 1; a[q] = AGG[(size_t)k * 512 + ch]; }
#pragma unroll
            for (int q = 0; q < 8; ++q) if (k0 + q < tile) cf = cf * __expf(a[q].x) + a[q].y; }
        for (int k0 = tb0 + TPB - 1; k0 > tile; k0 -= 8) { f32x2 a[8];
#pragma unroll
            for (int q = 0; q < 8; ++q) { const int k = k0 - q > tile ? k0 - q : tile + 1; a[q] = AGG[((size_t)(TS / 64) + k) * 512 + ch]; }
#pragma unroll
            for (int q = 0; q < 8; ++q) if (k0 - q > tile) cr = cr * __expf(a[q].x) + a[q].y; }
        float hf[64];
        {
            const unsigned* lu = LU + (size_t)t0 * 512 + ch; float h = cf;
#pragma unroll
            for (int q = 0; q < 64; q += 8) {
                float lv[8], uv[8];
#pragma unroll
                for (int e = 0; e < 8; ++e) { const unsigned w_ = lu[(size_t)(q + e) * 512]; lv[e] = __uint_as_float(w_ << 16); uv[e] = __uint_as_float(w_ & 0xffff0000u); }
#pragma unroll
                for (int e = 0; e < 8; ++e) { h = __expf(lv[e]) * h + uv[e]; hf[q + e] = h; }
            }
        }
        {
            const unsigned* lu = LU + ((size_t)TS + t0) * 512 + ch; float h = cr;
#pragma unroll
            for (int q = 0; q < 64; q += 8) {
                float lv[8], uv[8], gv[8];
#pragma unroll
                for (int e = 0; e < 8; ++e) { const int i = 63 - (q + e); { const unsigned w_ = lu[(size_t)i * 512]; lv[e] = __uint_as_float(w_ << 16); uv[e] = __uint_as_float(w_ & 0xffff0000u); } gv[e] = bf2f(proj[(size_t)(t0 + i) * EIN + 1280 + ch]); }
#pragma unroll
                for (int e = 0; e < 8; ++e) { const int i = 63 - (q + e); h = __expf(lv[e]) * h + uv[e]; Y[(size_t)(t0 + i) * DMODEL + 512 + ch] = (bf16_t)f2bf((hf[i] + h) * gelu_tanh(gv[e])); }
            }
        }
    }
}

__device__ __forceinline__ void odd_conv(const bf16_t* proj, const float* cw, bf16_t* QKVP, int S) {
    MK_IDS();
    for (int cr = 0; cr < (TS / 64 + (int)gridDim.x - 1) / (int)gridDim.x; ++cr) {
        const int c = cr * (int)gridDim.x + (int)blockIdx.x; if (c >= TS / 64) break;
        const int tb = c * 64 + wave * 8, sb = tb % S;
#pragma unroll
        for (int blk = 0; blk < 3; ++blk) {
            const int ch = blk * 512 + lane * 8;
            u32x4 rows[11];
#pragma unroll
            for (int q = 0; q < 11; ++q) { const int sp = sb + q - 2; rows[q] = (u32x4){0u, 0u, 0u, 0u};
                if (sp >= 0 && sp < S) rows[q] = *(const u32x4*)(proj + (size_t)(tb + q - 2) * OINP + ch); }
            f32x4 w0[4], w1[4];
#pragma unroll
            for (int j = 0; j < 4; ++j) { w0[j] = *(const f32x4*)(cw + j * 1536 + ch); w1[j] = *(const f32x4*)(cw + j * 1536 + ch + 4); }
#pragma unroll
            for (int i = 0; i < 8; ++i) {
                float acc[8];
#pragma unroll
                for (int e = 0; e < 8; ++e) acc[e] = 0.f;
#pragma unroll
                for (int j = 0; j < 4; ++j) { float xv[8]; unpack8(rows[i + j], xv);
                    acc[0] += w0[j].x * xv[0]; acc[1] += w0[j].y * xv[1]; acc[2] += w0[j].z * xv[2]; acc[3] += w0[j].w * xv[3];
                    acc[4] += w1[j].x * xv[4]; acc[5] += w1[j].y * xv[5]; acc[6] += w1[j].z * xv[6]; acc[7] += w1[j].w * xv[7]; }
                float ss = 0.f;
#pragma unroll
                for (int e = 0; e < 8; ++e) { acc[e] = silu(acc[e]); ss += acc[e] * acc[e]; }
                if (blk < 2) {
                    ss += __shfl_xor(ss, 1); ss += __shfl_xor(ss, 2); ss += __shfl_xor(ss, 4); ss += __shfl_xor(ss, 8);
                    const float rn = __builtin_amdgcn_rsqf(ss + EPS);
#pragma unroll
                    for (int e = 0; e < 8; ++e) acc[e] *= rn;
                }
                u32x4 o; o.x = pk2(acc[0], acc[1]); o.y = pk2(acc[2], acc[3]); o.z = pk2(acc[4], acc[5]); o.w = pk2(acc[6], acc[7]);
                *(u32x4*)(QKVP + (size_t)(tb + i) * 1536 + ch) = o;
            }
        }
    }
}

__device__ __forceinline__ int frag128(int r, int k) { return ((((r >> 4) * 4 + (k >> 5)) * 64 + ((k >> 3) & 3) * 16 + (r & 15)) << 3) + (k & 7); }
__device__ __forceinline__ int frag64(int r, int k) { return ((((r >> 4) * 2 + (k >> 5)) * 64 + ((k >> 3) & 3) * 16 + (r & 15)) << 3) + (k & 7); }
__device__ __forceinline__ void odd_prep(const bf16_t* QKVP, const bf16_t* proj, const float* alog, const float* dtb, unsigned char* DNI, float* EGL, char* lds) {
    MK_IDS();
    constexpr int RS = 272;
    constexpr int HOFF = 69632;
    const float scale = 0.08838834764831845f;
    for (int itq = 0; itq < (TS / 64 + (int)gridDim.x - 1) / (int)gridDim.x * 4; ++itq) {
        const int c_ = (itq >> 2) * (int)gridDim.x + (int)blockIdx.x; if (c_ >= TS / 64) break; const int it0 = (c_ * 4 + (itq & 3)) * 2;
        int tq_ = tid; asm volatile("" : "+v"(tq_));
        const int half = tq_ >> 8, ht = tq_ & 255, hwave = __builtin_amdgcn_readfirstlane(ht >> 6), G = (tq_ & 63) >> 4, l16 = tq_ & 15;
        char* L = lds + half * HOFF;
        char* KS = L, *QS = L + 17408, *VS = L + 34816; float* LM = (float*)(L + 52224); float* GC = (float*)(L + 68608); float* BT = GC + 64; float* EG = BT + 64;
        const int it = it0 + half; const int d = it & 1, h = (it >> 1) & 3, c = it >> 3, t0 = c * 64;
        __syncthreads();
#pragma unroll
        for (int k = 0; k < 4; ++k) { const int idx = ht + k * 256, i = idx >> 4, pc = idx & 15; const int tk = d ? t0 + 63 - i : t0 + i;
            const bf16_t* src = QKVP + (size_t)tk * 1536 + h * 128 + pc * 8;
            *(u32x4*)(QS + i * RS + pc * 16) = *(const u32x4*)(src);
            *(u32x4*)(KS + i * RS + pc * 16) = *(const u32x4*)(src + 512);
            *(u32x4*)(VS + i * RS + pc * 16) = *(const u32x4*)(src + 1024); }
        if (hwave == 0) {
            const int i = lane; const int tk = d ? t0 + 63 - i : t0 + i;
            const float bl = bf2f(proj[(size_t)tk * OINP + 2048 + d * 4 + h]), al = bf2f(proj[(size_t)tk * OINP + 2056 + d * 4 + h]);
            const float beta = sigm(bl); float g = -__expf(alog[d * 4 + h]) * softplus(al + dtb[d * 4 + h]);
#pragma unroll
            for (int o = 1; o < 64; o <<= 1) { const float v = __shfl_up(g, o); if (lane >= o) g += v; }
            GC[i] = g; BT[i] = beta; EG[i] = __expf(g);
        }
        __syncthreads();
        {
            const bool isq = hwave >= 2; const char* XS = isq ? QS : KS;
#pragma unroll
            for (int mm = 0; mm < 2; ++mm) { const int mt = (hwave & 1) * 2 + mm;
                bf16x8 a[4];
#pragma unroll
                for (int kk = 0; kk < 4; ++kk) a[kk] = *(const bf16x8*)(XS + (mt * 16 + l16) * RS + (kk * 32 + G * 8) * 2);
#pragma unroll
                for (int nt = 0; nt < 4; ++nt) { f32x4 acc = {0.f, 0.f, 0.f, 0.f};
#pragma unroll
                    for (int kk = 0; kk < 4; ++kk) { const bf16x8 bb = *(const bf16x8*)(KS + (nt * 16 + l16) * RS + (kk * 32 + G * 8) * 2); acc = MFMA16(a[kk], bb, acc); }
                    const int j = nt * 16 + l16; const float gj = GC[j];
#pragma unroll
                    for (int r = 0; r < 4; ++r) { const int i = mt * 16 + G * 4 + r; const float dec = __expf(fminf(GC[i] - gj, 0.f));
                        if (!isq) LM[i * 64 + j] = (j < i) ? BT[i] * acc[r] * dec : 0.f;
                        else ((bf16_t*)(DNI + (size_t)it * DNI_BYTES + DNI_A))[frag64(i, j)] = (bf16_t)f2bf((j <= i) ? acc[r] * scale * dec : 0.f); }
                }
            }
        }
        __syncthreads();
        {
            float sol[64];
            const int cc = ht & 127; const bool isw = ht >= 128; const char* XS = isw ? KS : VS;
#pragma unroll
            for (int i = 0; i < 64; ++i) {
                float v = bf2f(*(const bf16_t*)(XS + i * RS + cc * 2)) * BT[i]; if (isw) v *= EG[i];
                float a0 = 0.f, a1 = 0.f;
#pragma unroll
                for (int j4 = 0; j4 < (i + 3) / 4; ++j4) { const f32x4 l4 = *(const f32x4*)(LM + i * 64 + j4 * 4);
                    if (j4 * 4 + 0 < i) a0 += l4.x * sol[j4 * 4 + 0]; if (j4 * 4 + 1 < i) a1 += l4.y * sol[j4 * 4 + 1];
                    if (j4 * 4 + 2 < i) a0 += l4.z * sol[j4 * 4 + 2]; if (j4 * 4 + 3 < i) a1 += l4.w * sol[j4 * 4 + 3];
                    if ((j4 & 1) == 1) asm volatile("" ::: "memory"); }
                v -= a0 + a1;
                sol[i] = v;
                ((bf16_t*)(DNI + (size_t)it * DNI_BYTES + (isw ? DNI_W : DNI_U)))[isw ? frag128(i, cc) : i * 128 + cc] = (bf16_t)f2bf(v);
                asm volatile("" ::: "memory");
            }
        }
        {
            const float gl = GC[63];
#pragma unroll
            for (int k = 0; k < 4; ++k) { const int idx = ht + k * 256;
                {
                    const int i = idx & 63, kg = idx >> 6; const u32x4 raw = *(const u32x4*)(QS + i * RS + kg * 16); float f[8]; unpack8(raw, f); const float sc = scale * EG[i];
                    u32x4 o; o.x = pk2(f[0] * sc, f[1] * sc); o.y = pk2(f[2] * sc, f[3] * sc); o.z = pk2(f[4] * sc, f[5] * sc); o.w = pk2(f[6] * sc, f[7] * sc);
                    *(u32x4*)((bf16_t*)(DNI + (size_t)it * DNI_BYTES + DNI_QT) + frag128(i, kg * 8)) = o; }
                {
                    const int dm = idx & 127, tg = idx >> 7; float f[8];
#pragma unroll
                    for (int q = 0; q < 8; ++q) { const int i = tg * 8 + q; f[q] = bf2f(*(const bf16_t*)(KS + i * RS + dm * 2)) * __expf(gl - GC[i]); }
                    u32x4 o; o.x = pk2(f[0], f[1]); o.y = pk2(f[2], f[3]); o.z = pk2(f[4], f[5]); o.w = pk2(f[6], f[7]);
                    *(u32x4*)((bf16_t*)(DNI + (size_t)it * DNI_BYTES + DNI_KTT) + frag64(dm, tg * 8)) = o; }
            }
            if (ht == 0) EGL[it] = __expf(gl);
        }
    }
}

template <int NS> __device__ __forceinline__ void odd_scan(const unsigned char* DNI, const float* EGL, bf16_t* OB, int S, int nb, char* lds) {
    MK_IDS();
    constexpr int O_SB = 0, O_VN = NS * 4352, O_OUT = O_VN + NS * 2304, PFD = 7, EB = NS == 1 ? 3 : 2, NCOL = NS * 16;
    const int NC = S / 64, G = lane >> 4, l16 = lane & 15;
    const int nitems = nb * 64 / NS;
    const int mt = wave & 3; const bool lo = wave < 4;
    for (int item = blockIdx.x; item < nitems; item += gridDim.x) {
        const int e = (item >> 3) & ((1 << EB) - 1), sq = (item & 7) | ((item >> (3 + EB)) << 3); const int d = sq & 1, h = (sq >> 1) & 3, b = sq >> 3, cb = e * NCOL;
        __syncthreads();
        for (int i = tid; i < NS * 4352 / 4; i += NT) ((unsigned*)(lds + O_SB))[i] = 0u;
        f32x4 Sreg[NS];
#pragma unroll
        for (int ns = 0; ns < NS; ++ns) Sreg[ns] = (f32x4){0.f, 0.f, 0.f, 0.f};
        const long dstep = (long)(d ? -8 : 8) * DNI_BYTES;
        const unsigned char* base0 = DNI + (size_t)(((b * NC + (d ? NC - 1 : 0)) * 4 + h) * 2 + d) * DNI_BYTES;
        const unsigned char* pX = base0 + (lo ? DNI_W : DNI_QT) + ((mt * 4) * 64 + lane) * 16;
        const unsigned char* pA = base0 + DNI_A + ((mt * 2) * 64 + lane) * 16;
        const unsigned char* pK = base0 + DNI_KTT + ((wave * 2) * 64 + lane) * 16;
        const unsigned char* pU = base0 + DNI_U + ((mt * 16 + G * 4) * 128 + cb + l16) * 2;
        const float* pE = EGL + (((b * NC + (d ? NC - 1 : 0)) * 4 + h) * 2 + d);
        const unsigned char* pP = base0 + (long)PFD * dstep + e * (9216 * NS) + (tid < 144 * NS ? tid : 144 * NS - 1) * 64;
        bf16_t* pO = OB + ((size_t)d * TS + (size_t)(b * NC + (d ? NC - 1 : 0)) * 64 + (d ? 63 - (tid >> 3) : (tid >> 3))) * 512 + h * 128 + cb + (tid & 7) * 2 * NS;
        const long ostep = (long)(d ? -64 : 64) * 512;
        u32x4 aX[4], aA[2], aK[2], bX[4], bA[2], bK[2], cX[4], cA[2], cK[2];
        unsigned aU[NS][4], bU[NS][4], cU[NS][4]; float aE, bE, cE; unsigned pf_dummy = 0u;
#define DN_LOAD(P) do { \
            _Pragma("unroll") for (int kk = 0; kk < 4; ++kk) P##X[kk] = *(const u32x4*)(pX + kk * 1024); \
            _Pragma("unroll") for (int kk = 0; kk < 2; ++kk) { P##A[kk] = *(const u32x4*)(pA + kk * 1024); P##K[kk] = *(const u32x4*)(pK + kk * 1024); } \
            _Pragma("unroll") for (int ns = 0; ns < NS; ++ns) _Pragma("unroll") for (int r = 0; r < 4; ++r) P##U[ns][r] = *(const bf16_t*)(pU + r * 256 + ns * 32); \
            P##E = *pE; pX += dstep; pA += dstep; pK += dstep; pU += dstep; pE += (d ? -8 : 8); } while (0)
#define DN_STEP(P, PL) do { \
            DN_LOAD(PL); \
            if (wave < (NS == 1 ? 3 : 5)) { asm volatile("global_load_dword %0, %1, off" : "+v"(pf_dummy) : "v"(pP) : "memory"); } \
            pP += dstep; \
            f32x4 acc[NS], acc2[NS]; \
            { bf16x8 sb_[NS][4]; \
              _Pragma("unroll") for (int ns = 0; ns < NS; ++ns) { acc[ns] = (f32x4){0.f, 0.f, 0.f, 0.f}; acc2[ns] = (f32x4){0.f, 0.f, 0.f, 0.f}; \
                _Pragma("unroll") for (int kk = 0; kk < 4; ++kk) sb_[ns][kk] = *(const bf16x8*)(lds + O_SB + (ns * 16 + l16) * 272 + (kk * 32 + G * 8) * 2); } \
              if constexpr (NS == 1) asm volatile("s_waitcnt lgkmcnt(0)" : "+v"(sb_[0][0]), "+v"(sb_[0][1]), "+v"(sb_[0][2]), "+v"(sb_[0][3]) :: "memory"); \
              else asm volatile("s_waitcnt lgkmcnt(0)" : "+v"(sb_[0][0]), "+v"(sb_[0][1]), "+v"(sb_[0][2]), "+v"(sb_[0][3]), "+v"(sb_[NS - 1][0]), "+v"(sb_[NS - 1][1]), "+v"(sb_[NS - 1][2]), "+v"(sb_[NS - 1][3]) :: "memory"); \
              _Pragma("unroll") for (int ns = 0; ns < NS; ++ns) { \
                acc[ns] = MFMA16(__builtin_bit_cast(bf16x8, P##X[0]), sb_[ns][0], acc[ns]); acc2[ns] = MFMA16(__builtin_bit_cast(bf16x8, P##X[1]), sb_[ns][1], acc2[ns]); \
                acc[ns] = MFMA16(__builtin_bit_cast(bf16x8, P##X[2]), sb_[ns][2], acc[ns]); acc2[ns] = MFMA16(__builtin_bit_cast(bf16x8, P##X[3]), sb_[ns][3], acc2[ns]); } \
              _Pragma("unroll") for (int ns = 0; ns < NS; ++ns) acc[ns] = acc[ns] + acc2[ns]; } \
            if (lo) { _Pragma("unroll") for (int ns = 0; ns < NS; ++ns) { u32x2 o; float v[4]; \
              _Pragma("unroll") for (int r = 0; r < 4; ++r) v[r] = __uint_as_float(P##U[ns][r] << 16) - acc[ns][r]; \
              o.x = attn_body::cvtpk_s(v[0], v[1]); o.y = attn_body::cvtpk_s(v[2], v[3]); \
              *(u32x2*)(lds + O_VN + (ns * 16 + l16) * 144 + (mt * 16 + G * 4) * 2) = o; } } \
            asm volatile("s_waitcnt lgkmcnt(0)\n\ts_barrier" ::: "memory"); \
            bf16x8 vb[NS][2]; \
            _Pragma("unroll") for (int ns = 0; ns < NS; ++ns) _Pragma("unroll") for (int kk = 0; kk < 2; ++kk) vb[ns][kk] = *(const bf16x8*)(lds + O_VN + (ns * 16 + l16) * 144 + (kk * 32 + G * 8) * 2); \
            if constexpr (NS == 1) asm volatile("s_waitcnt lgkmcnt(0)" : "+v"(vb[0][0]), "+v"(vb[0][1]) :: "memory"); \
            else asm volatile("s_waitcnt lgkmcnt(0)" : "+v"(vb[0][0]), "+v"(vb[0][1]), "+v"(vb[NS - 1][0]), "+v"(vb[NS - 1][1]) :: "memory"); \
            _Pragma("unroll") for (int ns = 0; ns < NS; ++ns) { Sreg[ns] = Sreg[ns] * P##E; \
              _Pragma("unroll") for (int kk = 0; kk < 2; ++kk) Sreg[ns] = MFMA16(__builtin_bit_cast(bf16x8, P##K[kk]), vb[ns][kk], Sreg[ns]); } \
            _Pragma("unroll") for (int ns = 0; ns < NS; ++ns) { u32x2 o; o.x = attn_body::cvtpk_s(Sreg[ns][0], Sreg[ns][1]); o.y = attn_body::cvtpk_s(Sreg[ns][2], Sreg[ns][3]); \
              *(u32x2*)(lds + O_SB + (ns * 16 + l16) * 272 + (wave * 16 + G * 4) * 2) = o; } \
            if (!lo) { _Pragma("unroll") for (int ns = 0; ns < NS; ++ns) { \
              _Pragma("unroll") for (int kk = 0; kk < 2; ++kk) acc[ns] = MFMA16(__builtin_bit_cast(bf16x8, P##A[kk]), vb[ns][kk], acc[ns]); \
              const unsigned w0_ = attn_body::cvtpk_s(acc[ns][0], acc[ns][1]), w1_ = attn_body::cvtpk_s(acc[ns][2], acc[ns][3]); \
              bf16_t* op_ = (bf16_t*)(lds + O_OUT + ((mt * 16 + G * 4) * NCOL + ns * 16 + l16) * 2); \
              op_[0] = (bf16_t)(w0_ & 0xffffu); op_[NCOL] = (bf16_t)(w0_ >> 16); op_[2 * NCOL] = (bf16_t)(w1_ & 0xffffu); op_[3 * NCOL] = (bf16_t)(w1_ >> 16); } } \
            asm volatile("s_waitcnt lgkmcnt(0)\n\ts_barrier" ::: "memory"); \
            if constexpr (NS == 1) *(unsigned*)pO = *(const unsigned*)(lds + O_OUT + tid * 4); else *(u32x2*)pO = *(const u32x2*)(lds + O_OUT + tid * 8); \
            pO += ostep; } while (0)
        DN_LOAD(a); DN_LOAD(b);
        __syncthreads();
        int n = 0;
        for (; n + 3 <= NC; n += 3) {
            DN_STEP(a, c);
            DN_STEP(b, a);
            DN_STEP(c, b);
        }
        if (n < NC) { DN_STEP(a, c); }
        if (n + 1 < NC) { DN_STEP(b, a); }
#undef DN_STEP
#undef DN_LOAD
        asm volatile("s_waitcnt vmcnt(0)" ::: "memory");
        asm volatile("" :: "v"(pf_dummy));
    }
}

__device__ __forceinline__ int t5_bucket(int rel) {
    const int n = rel < 0 ? -rel : rel; int v;
    if (n < 8) v = n; else v = 8 + (n >= 15) + (n >= 27) + (n >= 50) + (n >= 91) + (n >= 166) + (n >= 305) + (n >= 559);
    return (rel > 0 ? 16 : 0) + v;
}
__device__ __forceinline__ void odd_dilated(bf16_t* proj, const float* relb, float* LSE, int S, char* lds, int first_wg, int n_wg) {
    MK_IDS();
    constexpr int KST = 144, VST = 400, HOFF = 27648 + 25600 + 1024;
    const int half = tid >> 8, ht = tid & 255, wv = ht >> 6, G = lane >> 4, l16 = lane & 15;
    char* L = lds + half * HOFF; char* KS = L; char* VT = L + 27648; float* BIAS = (float*)(L + 27648 + 25600);
    const int NBb = S / 64;
    const int wgi = (int)blockIdx.x - first_wg;
    if (wgi < 0) return;
    for (int it0 = wgi * 2; it0 < 3072; it0 += n_wg * 2) {
        const int it = it0 + half; const int zb = it & 255, sl = (it >> 8) & 3, g = it >> 10;
        const int dil = g == 0 ? 1 : (g == 1 ? 4 : 16), lg = g * 2;
        const int M = S >> lg, MB = M / 64;
        const int b = zb / NBb, r0 = zb % NBb, rho = r0 / MB, n = r0 % MB;
        const int hc = (g * 4 + sl) * 64;
        const size_t tb = (size_t)b * S;
        __syncthreads();
#pragma unroll
        for (int k = 0; k < 6; ++k) { const int idx = ht + k * 256, kj = idx >> 3, pc = idx & 7; const int mk = 64 * n - 64 + kj;
            u32x4 kv = {0u, 0u, 0u, 0u}, vv = {0u, 0u, 0u, 0u};
            if (mk >= 0 && mk < M) { const bf16_t* rowp = proj + (tb + (size_t)mk * dil + rho) * OINP; kv = *(const u32x4*)(rowp + 2832 + hc + pc * 8); vv = *(const u32x4*)(rowp + 3600 + hc + pc * 8); }
            *(u32x4*)(KS + kj * KST + pc * 16) = kv;
            const unsigned w[4] = {vv.x, vv.y, vv.z, vv.w};
#pragma unroll
            for (int q = 0; q < 4; ++q) { *(bf16_t*)(VT + (pc * 8 + 2 * q) * VST + kj * 2) = (bf16_t)(w[q] & 0xffffu); *(bf16_t*)(VT + (pc * 8 + 2 * q + 1) * VST + kj * 2) = (bf16_t)(w[q] >> 16); } }
        if (ht < 129) BIAS[ht] = relb[t5_bucket((ht - 64) * dil) * 12 + g * 4 + sl];
        const int mq = 64 * n + 16 * wv + l16; const size_t tq = tb + (size_t)mq * dil + rho;
        bf16x8 qf[2];
#pragma unroll
        for (int kk = 0; kk < 2; ++kk) qf[kk] = *(const bf16x8*)(proj + tq * OINP + 2064 + hc + kk * 32 + G * 8);
        __syncthreads();
        f32x4 sc[9]; float mx = -1e30f;
#pragma unroll
        for (int kt = 0; kt < 9; ++kt) { f32x4 acc = {0.f, 0.f, 0.f, 0.f};
#pragma unroll
            for (int kk = 0; kk < 2; ++kk) { const bf16x8 a = *(const bf16x8*)(KS + ((wv + kt) * 16 + l16) * KST + (kk * 32 + G * 8) * 2); acc = MFMA16(a, qf[kk], acc); }
#pragma unroll
            for (int r = 0; r < 4; ++r) { const int kj = (wv + kt) * 16 + G * 4 + r; const int delta = kj - 64 - 16 * wv - l16; const int mk = 64 * n - 64 + kj;
                const bool ok = (delta >= -64) && (delta <= 64) && (mk >= 0) && (mk < M);
                const float s = ok ? acc[r] * 0.125f + BIAS[(delta < -64 ? -64 : (delta > 64 ? 64 : delta)) + 64] : -1e30f;
                acc[r] = s; mx = fmaxf(mx, s); }
            sc[kt] = acc; }
        mx = fmaxf(mx, __shfl_xor(mx, 16)); mx = fmaxf(mx, __shfl_xor(mx, 32));
        float sum = 0.f;
#pragma unroll
        for (int kt = 0; kt < 9; ++kt)
#pragma unroll
            for (int r = 0; r < 4; ++r) { const float pv_ = (sc[kt][r] > -1e29f) ? __expf(sc[kt][r] - mx) : 0.f; sc[kt][r] = pv_; sum += pv_; }
        sum += __shfl_xor(sum, 16); sum += __shfl_xor(sum, 32);
        f32x4 ot[4];
#pragma unroll
        for (int dt = 0; dt < 4; ++dt) ot[dt] = (f32x4){0.f, 0.f, 0.f, 0.f};
#pragma unroll
        for (int pp = 0; pp < 5; ++pp) {
            u32x4 pb; pb.x = pk2(sc[2 * pp][0], sc[2 * pp][1]); pb.y = pk2(sc[2 * pp][2], sc[2 * pp][3]);
            if (pp < 4) { pb.z = pk2(sc[2 * pp + 1][0], sc[2 * pp + 1][1]); pb.w = pk2(sc[2 * pp + 1][2], sc[2 * pp + 1][3]); } else { pb.z = 0u; pb.w = 0u; }
            const bf16x8 pbf = __builtin_bit_cast(bf16x8, pb);
#pragma unroll
            for (int dt = 0; dt < 4; ++dt) {
                u32x4 av; const u32x2 lo = *(const u32x2*)(VT + (dt * 16 + l16) * VST + ((wv + 2 * pp) * 16 + G * 4) * 2); av.x = lo.x; av.y = lo.y;
                if (pp < 4) { const u32x2 hi = *(const u32x2*)(VT + (dt * 16 + l16) * VST + ((wv + 2 * pp + 1) * 16 + G * 4) * 2); av.z = hi.x; av.w = hi.y; } else { av.z = 0u; av.w = 0u; }
                ot[dt] = MFMA16(__builtin_bit_cast(bf16x8, av), pbf, ot[dt]);
            }
        }
        const float rs = 1.f / sum;
        bf16_t* od = proj + tq * OINP + (g * 4 + sl) * 64;
#pragma unroll
        for (int dt = 0; dt < 4; ++dt) { const f32x4 v_ = ot[dt] * rs; u32x2 w_; w_.x = pk2(v_[0], v_[1]); w_.y = pk2(v_[2], v_[3]); *(u32x2*)(od + dt * 16 + G * 4) = w_; }
        if (G == 0) LSE[tq * 12 + g * 4 + sl] = mx + __logf(sum);
    }
}

__device__ __forceinline__ void odd_combine(const bf16_t* OB, const bf16_t* proj, const float* LSE, const float* og, bf16_t* Y) {
    MK_IDS();
    float gn[8];
#pragma unroll
    for (int e = 0; e < 8; ++e) gn[e] = og[(lane & 15) * 8 + e];
    const int sl = lane >> 4;
    for (int t = gw; t < TS; t += NGW) {
        const bf16_t* prow = proj + (size_t)t * OINP;
        const u32x4 fa = *(const u32x4*)(OB + (size_t)t * 512 + lane * 8), ra = *(const u32x4*)(OB + ((size_t)TS + t) * 512 + lane * 8), za = *(const u32x4*)(prow + 1536 + lane * 8);
        const u32x2 d0 = *(const u32x2*)(prow + lane * 4), d1 = *(const u32x2*)(prow + 256 + lane * 4), d2 = *(const u32x2*)(prow + 512 + lane * 4);
        const float l0 = LSE[(size_t)t * 12 + sl], l1 = LSE[(size_t)t * 12 + 4 + sl], l2 = LSE[(size_t)t * 12 + 8 + sl];
        float f[8], r[8], z[8]; unpack8(fa, f); unpack8(ra, r); unpack8(za, z);
        float ss = 0.f;
#pragma unroll
        for (int e = 0; e < 8; ++e) { f[e] += r[e]; ss += f[e] * f[e]; }
        ss += __shfl_xor(ss, 1); ss += __shfl_xor(ss, 2); ss += __shfl_xor(ss, 4); ss += __shfl_xor(ss, 8);
        const float rn = __builtin_amdgcn_rsqf(ss * (1.f / 128.f) + EPS);
#pragma unroll
        for (int e = 0; e < 8; ++e) f[e] = f[e] * rn * gn[e] * silu(z[e]);
        u32x4 o; o.x = pk2(f[0], f[1]); o.y = pk2(f[2], f[3]); o.z = pk2(f[4], f[5]); o.w = pk2(f[6], f[7]);
        *(u32x4*)(Y + (size_t)t * OOUT + lane * 8) = o;
        const float m = fmaxf(l0, fmaxf(l1, l2)); const float w0 = __expf(l0 - m), w1 = __expf(l1 - m), w2 = __expf(l2 - m); const float rs = 1.f / (w0 + w1 + w2);
        const float a0 = w0 * rs, a1 = w1 * rs, a2 = w2 * rs;
        const float v0 = a0 * __uint_as_float(d0.x << 16) + a1 * __uint_as_float(d1.x << 16) + a2 * __uint_as_float(d2.x << 16);
        const float v1 = a0 * __uint_as_float(d0.x & 0xffff0000u) + a1 * __uint_as_float(d1.x & 0xffff0000u) + a2 * __uint_as_float(d2.x & 0xffff0000u);
        const float v2 = a0 * __uint_as_float(d0.y << 16) + a1 * __uint_as_float(d1.y << 16) + a2 * __uint_as_float(d2.y << 16);
        const float v3 = a0 * __uint_as_float(d0.y & 0xffff0000u) + a1 * __uint_as_float(d1.y & 0xffff0000u) + a2 * __uint_as_float(d2.y & 0xffff0000u);
        u32x2 od; od.x = pk2(v0, v1); od.y = pk2(v2, v3);
        *(u32x2*)(Y + (size_t)t * OOUT + 512 + lane * 4) = od;
    }
}

__global__ void __launch_bounds__(NT, 2) fwd_megakernel(Params p) {
    extern __shared__ __attribute__((aligned(16))) unsigned char lds_raw[];
    cg::grid_group grid = cg::this_grid();
    char* lds = (char*)lds_raw;
    PG8_LAS unsigned char* ldsl = (PG8_LAS unsigned char*)lds_raw;
    const int Gr = gridDim.x;
    volatile LAS unsigned* MISC = (volatile LAS unsigned*)((PG8_LAS unsigned char*)lds_raw + (LDS_BYTES - 128));
    if (threadIdx.x < 32) MISC[threadIdx.x] = 0u;
    __syncthreads();
    xb::XcdBarrier bar = xb::xcd_barrier_post((unsigned*)p.ws, MISC + 8);
#define GSYNC() xb::xcd_barrier(bar)
    unsigned char* ws = p.ws;
    bf16_t* H = (bf16_t*)(ws + WS_H); bf16_t* PROJ = (bf16_t*)(ws + WS_PROJ); unsigned char* SCR = ws + WS_SCR;

    phase_prologue(p, lds);
    grid.sync();

    float* SSQA = (float*)(SCR + 232 * MiB); float* SSQB = (float*)(SCR + 234 * MiB);
    bf16_t* YE = (bf16_t*)(SCR + 192 * MiB); bf16_t* YO = (bf16_t*)(SCR + SC_QKVP);
    for (int seg = 0; seg < NSEG; ++seg) {
        const int S = seg < 2 ? 16384 : 2048, nb = seg < 2 ? 1 : 8;
        const float* xin = (seg < 2 ? p.in[0] : p.in[1]) + (size_t)(seg & 1) * TS * DMODEL;
        float* xo = p.out + (size_t)seg * TS * DMODEL;
        phase_x0(xin, H, SSQB);
        GSYNC();
        for (int layer = 0; layer < 4; ++layer) {
            const int j = layer >> 1; const bool odd = layer & 1;
            {
                const int N = odd ? OINP : EIN;
                const bf16_t* Bt = odd ? (const bf16_t*)(ws + WS_WINO) + (size_t)j * OINP * 1024 : (const bf16_t*)(ws + WS_WINE) + (size_t)j * EIN * 1024;
                pg8::Gemm g{H, Bt, TS, N, 1024}; pg8::StaticOrder So; So.init(TS, N, Gr, (int)blockIdx.x);
                pg8::EpiBf16<0> E{PROJ, N, nullptr, 0, 0, 1.f, SSQB};
                pg8::gemm_phase<pg8::EpiBf16<0>, pg8::StaticOrder, true, true>(ldsl, g, So, E);
            }
            GSYNC();
            if (!odd) {
                even_qk_post(PROJ, p.in[10] + j * 64, p.in[11] + j * 64, S);
                even_lru_prep(PROJ, p.in[12] + j * 2048, p.in[13] + j * 512, (const bf16_t*)(ws + WS_GW) + (size_t)j * 2 * 2 * 8 * 4096, p.in[15] + j * 1024, p.in[17] + j * 1024, p.in[18] + j * 1024,
                              (unsigned*)(SCR + SC_LA), (f32x2*)(SCR + SC_AGG), S, lds);
                GSYNC();
                {
                    const int nqb = S / 256, nunits = nb * 8 * nqb;
                    for (int u = blockIdx.x; u < nunits; u += Gr) {
                        const int qb = u % nqb, h = (u / nqb) % 8, b = u / (nqb * 8), kvh = h >> 2;
                        const attn_body::bf16* base = (const attn_body::bf16*)PROJ + (size_t)b * S * EIN;
                        attn_body::attn_unit<8>(qb, S, base + h * 64, EIN, base + 512 + kvh * 64, base + 640 + kvh * 64, EIN, (attn_body::bf16*)YE + (size_t)b * S * DMODEL + h * 64, DMODEL, lds);
                    }
                }
                __syncthreads();
                even_lru_scan((const unsigned*)(SCR + SC_LA), (const f32x2*)(SCR + SC_AGG), PROJ, YE, S);
                GSYNC();
                {
                    pg8::Gemm g{YE, (const bf16_t*)(ws + WS_WOUTE) + (size_t)j * 1024 * 1024, TS, 1024, 1024}; pg8::StaticOrder So; So.init(TS, 1024, Gr, (int)blockIdx.x);
                    EpiRes E{H, SSQA, DMODEL, nullptr};
                    pg8::gemm_phase<EpiRes, pg8::StaticOrder, true, true>(ldsl, g, So, E);
                }
            } else {
                odd_conv(PROJ, p.in[21] + j * 4 * 1536, (bf16_t*)(SCR + SC_QKVP), S);
                asm volatile("s_waitcnt vmcnt(0)" ::: "memory"); __syncthreads();
                odd_prep((const bf16_t*)(SCR + SC_QKVP), PROJ, p.in[22] + j * 8, p.in[23] + j * 8, SCR + SC_DNI, (float*)(SCR + SC_EGL), lds);
                GSYNC();
                {
                    const int nscan = nb * 64;
                    if (nscan <= Gr) odd_scan<1>(SCR + SC_DNI, (const float*)(SCR + SC_EGL), (bf16_t*)(SCR + SC_OB), S, nb, lds);
                    else odd_scan<2>(SCR + SC_DNI, (const float*)(SCR + SC_EGL), (bf16_t*)(SCR + SC_OB), S, nb, lds);
                    const int first = nscan < Gr ? nscan : 0;
                    odd_dilated(PROJ, p.in[2], (float*)(SCR + SC_LSE), S, lds, first, Gr - first);
                }
                GSYNC();
                odd_combine((const bf16_t*)(SCR + SC_OB), PROJ, (const float*)(SCR + SC_LSE), p.in[24] + j * 128, YO);
                GSYNC();
                {
                    pg8::Gemm g{YO, (const bf16_t*)(ws + WS_WOUTO) + (size_t)j * 1024 * OOUT, TS, 1024, OOUT}; pg8::StaticOrder So; So.init(TS, 1024, Gr, (int)blockIdx.x);
                    EpiRes E{H, SSQA, DMODEL, nullptr};
                    pg8::gemm_phase<EpiRes, pg8::StaticOrder, true, true>(ldsl, g, So, E);
                }
            }
            GSYNC();
            {
                pg8::Gemm g{H, (const bf16_t*)(ws + WS_W1T) + (size_t)layer * 4096 * 1024, TS, DFF, 1024}; pg8::StaticOrder So; So.init(TS, DFF, Gr, (int)blockIdx.x);
                pg8::EpiBf16<2> E{(bf16_t*)(SCR + SC_HID), DFF, nullptr, 0, 0, 1.f, nullptr};
                pg8::gemm_phase<pg8::EpiBf16<2>, pg8::StaticOrder, true, true>(ldsl, g, So, E);
            }
            GSYNC();
            {
                pg8::Gemm g{(const bf16_t*)(SCR + SC_HID), (const bf16_t*)(ws + WS_W2T) + (size_t)layer * 1024 * 4096, TS, 1024, DFF}; pg8::StaticOrder So; So.init(TS, 1024, Gr, (int)blockIdx.x);
                EpiRes E{H, SSQB, DMODEL, SSQA};
                pg8::gemm_phase<EpiRes, pg8::StaticOrder, true, true>(ldsl, g, So, E);
            }
            GSYNC();
        }
        phase_rmsnorm_final(H, xo, p.in[5]);
        GSYNC();
    }
}
}

extern "C" void kernel_launch(void* const* d_in, const int* in_sizes, int n_in, void* d_out, int out_size, void* d_ws, size_t ws_size, hipStream_t stream) {
    static int grid = 0;
    if (grid == 0) {
        if (n_in != 25 || ws_size < mk::WS_END) { fprintf(stderr, "kernel_launch: unexpected n_in %d / ws_size %zu\n", n_in, ws_size); grid = -1; return; }
        int dev = 0, cus = 0, per_cu = 0;
        hipGetDevice(&dev); hipDeviceGetAttribute(&cus, hipDeviceAttributeMultiprocessorCount, dev);
        if (hipFuncSetAttribute((const void*)mk::fwd_megakernel, hipFuncAttributeMaxDynamicSharedMemorySize, mk::LDS_BYTES) != hipSuccess) { fprintf(stderr, "hipFuncSetAttribute failed\n"); }
        hipOccupancyMaxActiveBlocksPerMultiprocessor(&per_cu, (const void*)mk::fwd_megakernel, mk::NT, mk::LDS_BYTES);
        (void)hipGetLastError();
        if (per_cu < 1) per_cu = 1;
        grid = cus * 1;
        fprintf(stderr, "kernel_launch: cus %d per_cu %d grid %d\n", cus, per_cu, grid);
    }
    if (grid < 0) return;
    if (hipMemsetAsync(d_ws, 0, 65536, stream) != hipSuccess) { fprintf(stderr, "memset failed\n"); return; }
    mk::Params p{};
    for (int i = 0; i < 25; ++i) p.in[i] = (const float*)d_in[i];
    p.out = (float*)d_out; p.ws = (unsigned char*)d_ws;
    void* args[] = {&p};
    hipError_t e = hipLaunchCooperativeKernel((const void*)mk::fwd_megakernel, dim3(grid), dim3(mk::NT), args, mk::LDS_BYTES, stream);
    if (e != hipSuccess) fprintf(stderr, "cooperative launch failed: %s (grid %d)\n", hipGetErrorString(e), grid);
}
```
